# Optimizing an MI355X kernel written in HIP

```python
import jax, jax.numpy as jnp
from jax import lax
import numpy as np

D_MODEL = 1024
BATCH = 32
SEQ = 256
DEPTH = 2
DEC_BATCH = 4
DEC_SEQ = 2048
PAST_LEN = 512

GRID_W = 64
HA = 4
DKA = 128
DVA = 128
WA = HA * DVA
HB = 8
NB = 64
WB = HB * NB
R_DECAY = 64
R_AAA = 64
R_GATE = 128
RWKV_COLS = 3 * WB + 2 * R_DECAY + 2 * R_AAA + R_GATE
HC = 4
DHC = 128
WC = HC * DHC
D_FF = 2816
HGRN_CHUNK = 32
MLSTM_CHUNK = 64
RMS_EPS = 1e-6
RWKV_LN_EPS = 64e-5
IN_WIDTHS = (HA * DKA, HA * DKA, HA * DKA, WA, WA, RWKV_COLS, WC, WC, WC, WC, 4 * HC, 3 * D_MODEL)
D_IN = 3 * HA * DKA + 2 * WA + RWKV_COLS + 4 * WC + 4 * HC + 3 * D_MODEL
F32 = jnp.float32

kernel_name = 'hybrid_bidir_recurrent_diffusion_step'


def _split(y, widths):
    idx = np.cumsum(np.asarray(widths))[:-1].tolist()
    return jnp.split(y, idx, axis=-1)


def _rms(x, w, eps=RMS_EPS):
    x32 = x.astype(F32)
    y = x32 * lax.rsqrt(jnp.mean(x32 * x32, axis=-1, keepdims=True) + eps)
    return (y * w.astype(F32)).astype(x.dtype)


def _shift_pair(y, axis):
    n = y.shape[axis]
    yp = jnp.pad(y, [(1, 1) if a == axis else (0, 0) for a in range(y.ndim)])
    return lax.slice_in_dim(yp, 0, n, axis=axis), lax.slice_in_dim(yp, 2, n + 2, axis=axis)


def _token_shift(y, mu, grid):
    if grid:
        B, T, C = y.shape
        g = y.reshape(B, T // GRID_W, GRID_W, C)
        left, right = _shift_pair(g, 2)
        up, down = _shift_pair(g, 1)
        g = g + mu[0] * (left - g) + mu[1] * (right - g) + mu[2] * (up - g) + mu[3] * (down - g)
        return g.reshape(B, T, C)
    prev, nxt = _shift_pair(y, 1)
    return y + mu[0] * (prev - y) + mu[1] * (nxt - y)


def _gla_chunk_scan(q, k, v, logf, s0):
    B, T, H, K = q.shape
    V = v.shape[-1]
    L = HGRN_CHUNK
    n = T // L

    def chunks(a):
        return a.astype(F32).reshape(B, n, L, H, a.shape[-1]).transpose(1, 0, 3, 2, 4)

    causal = jnp.tril(jnp.ones((L, L), dtype=bool))[:, :, None]

    def step(S, inp):
        qc, kc, vc, gc = inp
        b = jnp.cumsum(gc, axis=2)
        rel = jnp.exp(jnp.where(causal, b[:, :, :, None, :] - b[:, :, None, :, :], -jnp.inf))
        A = jnp.einsum('bhtk,bhsk,bhtsk->bhts', qc, kc, rel)
        o = jnp.einsum('bhts,bhsv->bhtv', A, vc) + jnp.einsum('bhtk,bhkv->bhtv', qc * jnp.exp(b), S)
        b_end = b[:, :, -1:, :]
        S = jnp.exp(b_end[:, :, 0, :, None]) * S + jnp.einsum('bhsk,bhsv->bhkv', kc * jnp.exp(b_end - b), vc)
        return S, o

    S, o = lax.scan(step, s0.astype(F32), (chunks(q), chunks(k), chunks(v), chunks(logf)))
    return S, o.transpose(1, 0, 3, 2, 4).reshape(B, T, H, V)


def _hgrn2(hq, hf_fwd, hf_bwd, hi, hg, lb, norm_w, s0):
    B, T, _ = hq.shape
    q = hq.astype(F32).reshape(B, T, HA, DKA) * (DKA ** -0.5)
    v = hi.astype(F32).reshape(B, T, HA, DVA)
    log_lb = jnp.log(lb)
    log_ub = jnp.log1p(-lb)
    outs, finals = [], []
    for d, fpre in enumerate((hf_fwd, hf_bwd)):
        z = fpre.astype(F32)
        logf = jnp.logaddexp(log_lb, log_ub + jax.nn.log_sigmoid(z)).reshape(B, T, HA, DKA)
        k = ((1.0 - lb) * jax.nn.sigmoid(-z)).reshape(B, T, HA, DKA)
        seqs = (q, k, v, logf)
        if d == 1:
            seqs = tuple(jnp.flip(a, axis=1) for a in seqs)
        s_fin, o = _gla_chunk_scan(*seqs, s0[:, d])
        outs.append(jnp.flip(o, axis=1) if d == 1 else o)
        finals.append(s_fin)
    o = _rms(outs[0] + outs[1], norm_w.reshape(HA, DVA)).reshape(B, T, WA)
    return o * jax.nn.silu(hg.astype(F32)), jnp.stack(finals, axis=1)


def _rwkv_scan(r, w, k, v, kk, a, s0):
    def step(S, inp):
        rt, wt, kt, vt, kkt, at = inp
        sa = jnp.einsum('bhvk,bhk->bhv', S, -kkt)
        S = S * wt[:, :, None, :] + sa[..., None] * (kkt * at)[:, :, None, :] + vt[..., None] * kt[:, :, None, :]
        return S, jnp.einsum('bhvk,bhk->bhv', S, rt)

    xs = tuple(jnp.moveaxis(t.astype(F32), 1, 0) for t in (r, w, k, v, kk, a))
    S, o = lax.scan(step, s0.astype(F32), xs)
    return S, jnp.moveaxis(o, 0, 1)


def _rwkv7(rw, grid, mu, w0, w2, a0, a2, g2, k_k, k_a, r_k, ln, s0):
    B, T, _ = rw.shape
    rw = _token_shift(rw, mu, grid)
    r, k, v, wlo_f, wlo_b, alo_f, alo_b, glo = _split(rw, (WB, WB, WB, R_DECAY, R_DECAY, R_AAA, R_AAA, R_GATE))

    def heads(a):
        return a.astype(F32).reshape(B, T, HB, NB)

    r_h, k_h, v_h = heads(r), heads(k), heads(v)
    kk = heads(k * k_k)
    kk = kk / jnp.maximum(jnp.sqrt(jnp.sum(kk * kk, axis=-1, keepdims=True)), 1e-12)
    k_a_h = k_a.astype(F32).reshape(HB, NB)
    outs, finals = [], []
    for d, (wlo, alo) in enumerate(((wlo_f, alo_f), (wlo_b, alo_b))):
        wlog = -jax.nn.softplus(-(w0[d] + jnp.tanh(wlo) @ w2[d]).astype(F32)) - 0.5
        decay = heads(jnp.exp(-jnp.exp(wlog)))
        a_h = heads(jax.nn.sigmoid((a0[d] + alo @ a2[d]).astype(F32)))
        k_d = k_h * (1.0 + (a_h - 1.0) * k_a_h)
        seqs = (r_h, decay, k_d, v_h, kk, a_h)
        if d == 1:
            seqs = tuple(jnp.flip(t, axis=1) for t in seqs)
        s_fin, o = _rwkv_scan(*seqs, s0[:, d])
        outs.append(jnp.flip(o, axis=1) if d == 1 else o)
        finals.append(s_fin)
    o = outs[0] + outs[1]
    mean = jnp.mean(o, axis=-1, keepdims=True)
    var = jnp.mean(jnp.square(o - mean), axis=-1, keepdims=True)
    o = (o - mean) * lax.rsqrt(var + RWKV_LN_EPS) * ln[0].astype(F32).reshape(HB, NB) + ln[1].astype(F32).reshape(HB, NB)
    bonus = jnp.sum(r_h * k_h * r_k.astype(F32).reshape(HB, NB), axis=-1, keepdims=True) * v_h
    o = (o + bonus).reshape(B, T, WB) * (jax.nn.sigmoid(glo) @ g2)
    return o, jnp.stack(finals, axis=1)


def _mlstm_chunk_scan(q, k, v, ig, logf, C0, n0, m0):
    B, T, H, Dh = q.shape
    L = MLSTM_CHUNK
    n = T // L

    def vec(a):
        return a.reshape(B, n, L, H, Dh).transpose(1, 0, 3, 2, 4)

    def sca(a):
        return a.reshape(B, n, L, H).transpose(1, 0, 3, 2)

    causal = jnp.tril(jnp.ones((L, L), dtype=bool))

    def step(carry, inp):
        C, nv, m = carry
        qc, kc, vc, ic, fc = inp
        g = jnp.cumsum(fc, axis=-1)
        a_inter = g + m[..., None]
        d_intra = jnp.where(causal, g[..., :, None] - g[..., None, :] + ic[..., None, :], -jnp.inf)
        m_t = jnp.maximum(a_inter, jnp.max(d_intra, axis=-1))
        w_inter = jnp.exp(a_inter - m_t)
        p = jnp.exp(d_intra - m_t[..., None]) * jnp.einsum('bhtd,bhsd->bhts', qc, kc)
        num = w_inter[..., None] * jnp.einsum('bhtd,bhde->bhte', qc, C) + jnp.einsum('bhts,bhse->bhte', p, vc)
        den = w_inter * jnp.einsum('bhtd,bhd->bht', qc, nv) + jnp.sum(p, axis=-1)
        h = num / jnp.maximum(jnp.abs(den), jnp.exp(-m_t))[..., None]
        g_end = g[..., -1]
        w_src = g_end[..., None] - g + ic
        m_new = jnp.maximum(g_end + m, jnp.max(w_src, axis=-1))
        carry_scale = jnp.exp(g_end + m - m_new)
        w_src = jnp.exp(w_src - m_new[..., None])
        C = carry_scale[..., None, None] * C + jnp.einsum('bhs,bhsd,bhse->bhde', w_src, kc, vc)
        nv = carry_scale[..., None] * nv + jnp.einsum('bhs,bhsd->bhd', w_src, kc)
        return (C, nv, m_new), h

    init = (C0.astype(F32), n0.astype(F32), m0.astype(F32))
    (C, nv, m), h = lax.scan(step, init, (vec(q), vec(k), vec(v), sca(ig), sca(logf)))
    return (C, nv, m), h.transpose(1, 0, 3, 2, 4).reshape(B, T, H, Dh)


def _mlstm(mq, mk, mv, mo, mg, gate_b, norm_w, C0, n0, m0):
    B, T, _ = mq.shape

    def heads(a):
        return a.astype(F32).reshape(B, T, HC, DHC)

    q, k, v = heads(mq), heads(mk) * (DHC ** -0.5), heads(mv)
    gt = mg.astype(F32).reshape(B, T, 4, HC) + gate_b.astype(F32)
    hs, Cs, ns, ms = [], [], [], []
    for d in range(2):
        seqs = (q, k, v, gt[:, :, 2 * d], jax.nn.log_sigmoid(gt[:, :, 2 * d + 1]))
        if d == 1:
            seqs = tuple(jnp.flip(t, axis=1) for t in seqs)
        (C, nv, m), h = _mlstm_chunk_scan(*seqs, C0[:, d], n0[:, d], m0[:, d])
        hs.append(jnp.flip(h, axis=1) if d == 1 else h)
        Cs.append(C)
        ns.append(nv)
        ms.append(m)
    h = _rms(hs[0] + hs[1], norm_w.reshape(HC, DHC)).reshape(B, T, WC)
    return h * jax.nn.sigmoid(mo.astype(F32)), (jnp.stack(Cs, axis=1), jnp.stack(ns, axis=1), jnp.stack(ms, axis=1))


def _mixer(h, l, grid, st, P):
    (hq, hf_f, hf_b, hi, hg, rw, mq, mk, mv, mo, mg, gates) = _split(h @ P['w_in'][l], IN_WIDTHS)
    s_hgrn, s_rwkv, s_C, s_n, s_m = st
    y_a, new_a = _hgrn2(hq, hf_f, hf_b, hi, hg, P['lbs'][l], P['hgrn_norm'][l], s_hgrn)
    y_b, new_b = _rwkv7(rw, grid, P['rwkv_mu'][l], P['rwkv_w0'][l], P['rwkv_w2'][l], P['rwkv_a0'][l],
                        P['rwkv_a2'][l], P['rwkv_g2'][l], P['rwkv_kk'][l], P['rwkv_ka'][l], P['rwkv_rk'][l],
                        P['rwkv_ln'][l], s_rwkv)
    y_c, (new_C, new_n, new_m) = _mlstm(mq, mk, mv, mo, mg, P['mlstm_gate_b'][l], P['mlstm_norm'][l], s_C, s_n, s_m)
    g_a, g_b, g_c = jnp.split(jax.nn.sigmoid(gates.astype(F32)), 3, axis=-1)
    wb = P['w_branch'][l]
    merged = g_a * (y_a @ wb[0]) + g_b * (y_b @ wb[1]) + g_c * (y_c @ wb[2])
    return (merged @ P['w_out'][l]).astype(h.dtype), (new_a, new_b, new_C, new_n, new_m)


def _trunk(x, cond, states, grid, P):
    new = ([], [], [], [], [])
    for l in range(DEPTH):
        mod = (jax.nn.silu(cond) @ P['w_ada'][l] + P['b_ada'][l])[:, None, :]
        sh1, sc1, g1, sh2, sc2, g2 = jnp.split(mod, 6, axis=-1)
        nw = P['norms'][l]
        h = _rms(x, nw[0]) * (1 + sc1) + sh1
        y, st = _mixer(h, l, grid, tuple(s[:, l] for s in states), P)
        x = x + g1 * _rms(y, nw[1])
        h = _rms(x, nw[2]) * (1 + sc2) + sh2
        u, gt = jnp.split(h @ P['w_ffn_in'][l], 2, axis=-1)
        y = (jax.nn.silu(gt) * u) @ P['w_ffn_out'][l]
        x = x + g2 * _rms(y, nw[3])
        for lst, s in zip(new, st):
            lst.append(s)
    return x, tuple(jnp.stack(lst, axis=1) for lst in new)


def setup_inputs(seed: int = 0) -> dict:
    key = jax.random.key(seed)
    ks = jax.random.split(key, 32)

    def nrm(i, shape, scale):
        return jax.random.normal(ks[i], shape, F32) * scale

    return {
        'x_prompt': nrm(0, (BATCH, SEQ, D_MODEL), 1.0),
        'x_sample': nrm(1, (DEC_BATCH, DEC_SEQ, D_MODEL), 1.0),
        'state_hgrn': nrm(2, (DEC_BATCH, DEPTH, 2, HA, DKA, DVA), 0.3),
        'state_rwkv': nrm(3, (DEC_BATCH, DEPTH, 2, HB, NB, NB), 0.3),
        'state_mlstm_C': nrm(4, (DEC_BATCH, DEPTH, 2, HC, DHC, DHC), 0.3),
        'state_mlstm_n': nrm(5, (DEC_BATCH, DEPTH, 2, HC, DHC), 0.3),
        'state_mlstm_m': nrm(6, (DEC_BATCH, DEPTH, 2, HC), 0.5),
        'c': nrm(7, (DEC_BATCH, D_MODEL), 1.0),
        'c_ctx': nrm(8, (D_MODEL,), 1.0),
        'w_ada': nrm(9, (DEPTH, D_MODEL, 6 * D_MODEL), 0.5 * D_MODEL ** -0.5),
        'b_ada': nrm(10, (DEPTH, 6 * D_MODEL), 0.02),
        'norms': 1.0 + nrm(11, (DEPTH, 4, D_MODEL), 0.05),
        'w_in': nrm(12, (DEPTH, D_MODEL, D_IN), D_MODEL ** -0.5),
        'hgrn_lb': nrm(13, (DEPTH, HA * DKA), 1.0),
        'hgrn_norm': 1.0 + nrm(14, (DEPTH, WA), 0.05),
        'rwkv_mu': 0.2 + nrm(15, (DEPTH, 4, RWKV_COLS), 0.05),
        'rwkv_w0': nrm(16, (DEPTH, 2, WB), 0.5),
        'rwkv_w2': nrm(17, (DEPTH, 2, R_DECAY, WB), R_DECAY ** -0.5),
        'rwkv_a0': nrm(18, (DEPTH, 2, WB), 0.1),
        'rwkv_a2': nrm(19, (DEPTH, 2, R_AAA, WB), R_AAA ** -0.5),
        'rwkv_g2': nrm(20, (DEPTH, R_GATE, WB), R_GATE ** -0.5),
        'rwkv_kk': 0.85 + nrm(21, (DEPTH, WB), 0.05),
        'rwkv_ka': 1.0 + nrm(22, (DEPTH, WB), 0.05),
        'rwkv_rk': nrm(23, (DEPTH, WB), 0.1),
        'rwkv_ln': nrm(24, (DEPTH, 2, WB), 0.05) + jnp.array([1.0, 0.0], F32)[None, :, None],
        'mlstm_gate_b': nrm(25, (DEPTH, 4, HC), 0.1) + jnp.array([0.0, 3.0, 0.0, 3.0], F32)[None, :, None],
        'mlstm_norm': 1.0 + nrm(26, (DEPTH, WC), 0.05),
        'w_branch': nrm(27, (DEPTH, 3, WA, D_MODEL), WA ** -0.5),
        'w_out': nrm(28, (DEPTH, D_MODEL, D_MODEL), D_MODEL ** -0.5),
        'w_ffn_in': nrm(29, (DEPTH, D_MODEL, 2 * D_FF), D_MODEL ** -0.5),
        'w_ffn_out': nrm(30, (DEPTH, D_FF, D_MODEL), D_FF ** -0.5),
    }


def reference(x_prompt, x_sample, state_hgrn, state_rwkv, state_mlstm_C, state_mlstm_n, state_mlstm_m,
              c, c_ctx, w_ada, b_ada, norms, w_in, hgrn_lb, hgrn_norm, rwkv_mu, rwkv_w0, rwkv_w2,
              rwkv_a0, rwkv_a2, rwkv_g2, rwkv_kk, rwkv_ka, rwkv_rk, rwkv_ln, mlstm_gate_b, mlstm_norm,
              w_branch, w_out, w_ffn_in, w_ffn_out):
    lbs = jnp.cumsum(jax.nn.softmax(hgrn_lb.astype(F32), axis=0), axis=0)
    lbs = lbs - lbs[0:1]
    P = {'w_ada': w_ada, 'b_ada': b_ada, 'norms': norms, 'w_in': w_in, 'lbs': lbs, 'hgrn_norm': hgrn_norm,
         'rwkv_mu': rwkv_mu, 'rwkv_w0': rwkv_w0, 'rwkv_w2': rwkv_w2, 'rwkv_a0': rwkv_a0, 'rwkv_a2': rwkv_a2,
         'rwkv_g2': rwkv_g2, 'rwkv_kk': rwkv_kk, 'rwkv_ka': rwkv_ka, 'rwkv_rk': rwkv_rk, 'rwkv_ln': rwkv_ln,
         'mlstm_gate_b': mlstm_gate_b, 'mlstm_norm': mlstm_norm, 'w_branch': w_branch, 'w_out': w_out,
         'w_ffn_in': w_ffn_in, 'w_ffn_out': w_ffn_out}
    b = x_prompt.shape[0]
    zero_states = (jnp.zeros((b, DEPTH, 2, HA, DKA, DVA), F32),
                   jnp.zeros((b, DEPTH, 2, HB, NB, NB), F32),
                   jnp.zeros((b, DEPTH, 2, HC, DHC, DHC), F32),
                   jnp.zeros((b, DEPTH, 2, HC, DHC), F32),
                   jnp.zeros((b, DEPTH, 2, HC), F32))
    y_prompt, ctx_states = _trunk(x_prompt, c_ctx[None, :], zero_states, False, P)
    new_hgrn, new_rwkv, new_C, new_n, new_m = ctx_states
    cache = (state_hgrn, state_rwkv, state_mlstm_C, state_mlstm_n, state_mlstm_m)
    y_sample, _ = _trunk(x_sample, c, cache, True, P)
    return (y_prompt, y_sample, new_hgrn, new_rwkv, new_C, new_n, new_m)
```

```cpp
#include <hip/hip_runtime.h>
#include <hip/hip_cooperative_groups.h>
#include <cstdio>
namespace cg = cooperative_groups;

typedef unsigned short bf16_t;
typedef short bf16x8 __attribute__((ext_vector_type(8)));
typedef float f32x4 __attribute__((ext_vector_type(4)));
typedef float f32x16 __attribute__((ext_vector_type(16)));
typedef unsigned short u16x4 __attribute__((ext_vector_type(4)));

#define DI __device__ __forceinline__

constexpr int NT = 16384;
constexpr int DM = 1024;
constexpr int NTHR = 256;
constexpr int DIN = 9616;
constexpr int ZHW = 2560, ZRW = 1920, ZMW = 2048;
constexpr int WTIN_ROWS = 9728;
constexpr int DFF = 2816;

constexpr size_t OFF_WTIN = 0;
constexpr size_t OFF_WTBR = OFF_WTIN + (size_t)WTIN_ROWS * 1024 * 2;
constexpr size_t OFF_H    = OFF_WTBR + (size_t)3 * 1024 * 512 * 2;
constexpr size_t OFF_ZH   = OFF_H + (size_t)NT * 1024 * 2;
constexpr size_t OFF_ZR   = OFF_ZH + (size_t)NT * ZHW * 2;
constexpr size_t OFF_ZM   = OFF_ZR + (size_t)NT * ZRW * 2;
constexpr size_t OFF_MG   = OFF_ZM + (size_t)NT * ZMW * 2;
constexpr size_t OFF_O    = OFF_MG + (size_t)NT * 16 * 4;
constexpr size_t OFF_MOD  = OFF_O + (size_t)NT * 1024 * 2;
constexpr size_t OFF_LBS  = OFF_MOD + (size_t)2 * 5 * 6144 * 4;
constexpr size_t OFF_CTR  = OFF_LBS + 2 * 512 * 4;
constexpr size_t WS_NEED  = OFF_CTR + 256;
constexpr size_t OFF_MODP = OFF_ZH;
constexpr size_t OFF_WTOUT = OFF_ZR;
constexpr size_t OFF_WTFI  = OFF_WTOUT + (size_t)1024 * 1024 * 2;
constexpr size_t OFF_WTFO  = OFF_WTFI + (size_t)5632 * 1024 * 2;
constexpr size_t OFF_MERGED = OFF_WTFO + (size_t)1024 * 2816 * 2;
constexpr size_t OFF_Y    = OFF_ZH;
constexpr size_t OFF_ACT  = OFF_ZM;

constexpr size_t OUT_HG = 16777216, OUT_RW = 25165824, OUT_C = 29360128, OUT_N = 37748736, OUT_M = 37814272;

enum { I_XP = 0, I_XS, I_SH, I_SR, I_SC, I_SN, I_SM, I_C, I_CCTX, I_WADA, I_BADA, I_NORMS, I_WIN, I_HLB, I_HNORM, I_MU, I_W0, I_W2,
       I_A0, I_A2, I_G2, I_KK, I_KA, I_RK, I_LN, I_GB, I_MNORM, I_WBR, I_WOUT, I_WFI, I_WFO, N_IN };

struct Params { const float* in[N_IN]; float* out; char* ws; };

constexpr int LDS_BYTES = 77824;

DI bf16_t f2bf(float f) { unsigned u = __float_as_uint(f); u += 0x7fffu + ((u >> 16) & 1u); return (bf16_t)(u >> 16); }
DI float bf2f(bf16_t h) { return __uint_as_float(((unsigned)h) << 16); }
DI float sigmoidf_(float x) { return 1.0f / (1.0f + __expf(-x)); }
DI float siluf_(float x) { return x / (1.0f + __expf(-x)); }
DI float softplusf_(float x) { return x > 20.f ? x : log1pf(__expf(x)); }
DI float wave_sum(float v) { for (int o = 32; o > 0; o >>= 1) v += __shfl_xor(v, o); return v; }
DI float dpp_xor1(float x) { return __int_as_float(__builtin_amdgcn_mov_dpp(__float_as_int(x), 0xB1, 0xF, 0xF, true)); }
DI float dpp_xor2(float x) { return __int_as_float(__builtin_amdgcn_mov_dpp(__float_as_int(x), 0x4E, 0xF, 0xF, true)); }
DI int ltid() { int t = threadIdx.x; asm volatile("" : "+v"(t)); return t; }
DI int crow(int reg, int h) { return (reg & 3) + 8 * (reg >> 2) + 4 * h; }

DI int tok_cond(int tok) { return tok < 8192 ? 0 : 1 + ((tok - 8192) >> 11); }
DI const float* x_in_row(const Params& p, int tok) { return tok < 8192 ? p.in[I_XP] + (size_t)tok * DM : p.in[I_XS] + (size_t)(tok - 8192) * DM; }

DI void mma32(f32x16& acc, const bf16_t* A, int lda, const bf16_t* B, int ldb, int K, int lane) {
  const int r = lane & 31, h = lane >> 5;
#pragma unroll 2
  for (int kk = 0; kk < K; kk += 16) {
    bf16x8 a = *(const bf16x8*)(A + r * lda + kk + 8 * h);
    bf16x8 b = *(const bf16x8*)(B + r * ldb + kk + 8 * h);
    acc = __builtin_amdgcn_mfma_f32_32x32x16_bf16(a, b, acc, 0, 0, 0);
  }
}

template <int BN>
DI void gemm_main(f32x4 (&acc)[4][BN / 32], const bf16_t* __restrict__ A, int lda, const bf16_t* __restrict__ B, int ldb, int K, bf16_t* sm) {
  constexpr int NJ = BN / 32, BCH = BN / 64;
  const int tid = ltid(), lane = tid & 63, w = tid >> 6, wm = w >> 1, wn = w & 1;
  bf16_t* As = sm; bf16_t* Bs = sm + 2 * 128 * 40;
  bf16x8 ra[2], rb[BCH];
  const int nk = K / 32;
#pragma unroll
  for (int i = 0; i < 2; ++i) { int c = tid + i * 256; ra[i] = *(const bf16x8*)(A + (size_t)(c >> 2) * lda + (c & 3) * 8); }
#pragma unroll
  for (int i = 0; i < BCH; ++i) { int c = tid + i * 256; rb[i] = *(const bf16x8*)(B + (size_t)(c >> 2) * ldb + (c & 3) * 8); }
  __syncthreads();
#pragma unroll
  for (int i = 0; i < 2; ++i) { int c = tid + i * 256; *(bf16x8*)(As + (c >> 2) * 40 + (c & 3) * 8) = ra[i]; }
#pragma unroll
  for (int i = 0; i < BCH; ++i) { int c = tid + i * 256; *(bf16x8*)(Bs + (c >> 2) * 40 + (c & 3) * 8) = rb[i]; }
  __syncthreads();
  for (int kt = 0; kt < nk; ++kt) {
    const int buf = kt & 1;
    if (kt + 1 < nk) {
      const int k0 = (kt + 1) * 32;
#pragma unroll
      for (int i = 0; i < 2; ++i) { int c = tid + i * 256; ra[i] = *(const bf16x8*)(A + (size_t)(c >> 2) * lda + k0 + (c & 3) * 8); }
#pragma unroll
      for (int i = 0; i < BCH; ++i) { int c = tid + i * 256; rb[i] = *(const bf16x8*)(B + (size_t)(c >> 2) * ldb + k0 + (c & 3) * 8); }
    }
    bf16x8 af[4], bfr[NJ];
    const bf16_t* as = As + buf * 128 * 40 + (wm * 64 + (lane & 15)) * 40 + (lane >> 4) * 8;
    const bf16_t* bs = Bs + buf * BN * 40 + (wn * (BN / 2) + (lane & 15)) * 40 + (lane >> 4) * 8;
#pragma unroll
    for (int i = 0; i < 4; ++i) af[i] = *(const bf16x8*)(as + i * 16 * 40);
#pragma unroll
    for (int j = 0; j < NJ; ++j) bfr[j] = *(const bf16x8*)(bs + j * 16 * 40);
#pragma unroll
    for (int i = 0; i < 4; ++i)
#pragma unroll
      for (int j = 0; j < NJ; ++j) acc[i][j] = __builtin_amdgcn_mfma_f32_16x16x32_bf16(bfr[j], af[i], acc[i][j], 0, 0, 0);
    if (kt + 1 < nk) {
      const int nb = buf ^ 1;
#pragma unroll
      for (int i = 0; i < 2; ++i) { int c = tid + i * 256; *(bf16x8*)(As + nb * 128 * 40 + (c >> 2) * 40 + (c & 3) * 8) = ra[i]; }
#pragma unroll
      for (int i = 0; i < BCH; ++i) { int c = tid + i * 256; *(bf16x8*)(Bs + nb * BN * 40 + (c >> 2) * 40 + (c & 3) * 8) = rb[i]; }
    }
    __syncthreads();
  }
}

template <int NJ> DI void zero_acc(f32x4 (&acc)[4][NJ]) {
#pragma unroll
  for (int i = 0; i < 4; ++i)
#pragma unroll
    for (int j = 0; j < NJ; ++j) acc[i][j] = (f32x4){0.f, 0.f, 0.f, 0.f};
}
DI void store_bf4(bf16_t* dst, f32x4 v) { u16x4 o; o[0] = f2bf(v[0]); o[1] = f2bf(v[1]); o[2] = f2bf(v[2]); o[3] = f2bf(v[3]); *(u16x4*)dst = o; }

DI int map_col(int mode, int n) {
  if (mode == 0) return n < 6544 ? n : (n < 6656 ? -1 : n - 112);
  if (mode == 2) return ((n >> 4) & 1) ? DFF + (n >> 5) * 16 + (n & 15) : (n >> 5) * 16 + (n & 15);
  return n;
}
DI void conv_tile(const float* __restrict__ src, int ld_src, bf16_t* __restrict__ dst, int K, int mode, int tk, int tn, float* sm) {
  const int tid = ltid();
  __syncthreads();
  {
    const int nn = tid & 63, col = map_col(mode, tn * 64 + nn);
#pragma unroll
    for (int i = 0; i < 16; ++i) { int kk = (tid >> 6) + 4 * i; sm[kk * 65 + nn] = col >= 0 ? src[(size_t)(tk * 64 + kk) * ld_src + col] : 0.f; }
  }
  __syncthreads();
  {
    const int kk = tid & 63;
#pragma unroll
    for (int i = 0; i < 16; ++i) { int nn = (tid >> 6) + 4 * i; dst[(size_t)(tn * 64 + nn) * K + tk * 64 + kk] = f2bf(sm[kk * 65 + nn]); }
  }
}
DI void conv_weight(const float* src, int ld_src, bf16_t* dst, int K, int Ndst, int mode, float* sm, int bid, int nb) {
  const int tkn = K / 64, nt = tkn * (Ndst / 64);
  for (int t = bid; t < nt; t += nb) conv_tile(src, ld_src, dst, K, mode, t % tkn, t / tkn, sm);
}

DI void phase0(const Params& p, char* smem) {
  const int tid = ltid(), bid = blockIdx.x, nb = gridDim.x;
  float* MODP = (float*)(p.ws + OFF_MODP);
  float* sm = (float*)smem;
  if (bid == 0 && tid < 64) ((int*)(p.ws + OFF_CTR))[tid] = 0;
  for (int i = bid * NTHR + tid; i < 512; i += nb * NTHR) {
    float a = p.in[I_HLB][i], b = p.in[I_HLB][512 + i];
    float* L = (float*)(p.ws + OFF_LBS); L[i] = 0.f; L[512 + i] = 1.0f / (1.0f + expf(a - b));
  }
  for (int it = bid; it < 2 * 24 * 16; it += nb) {
    const int ks = it & 15, jb = (it >> 4) % 24, l = it / (16 * 24);
    __syncthreads();
    for (int e = tid; e < 5 * 64; e += NTHR) { int ci = e >> 6, k = ks * 64 + (e & 63); float cv = ci == 0 ? p.in[I_CCTX][k] : p.in[I_C][(ci - 1) * DM + k]; sm[e] = siluf_(cv); }
    __syncthreads();
    const int j = jb * 256 + tid;
    float a0 = 0, a1 = 0, a2 = 0, a3 = 0, a4 = 0;
    const float* W = p.in[I_WADA] + ((size_t)l * DM + ks * 64) * 6144 + j;
    for (int k = 0; k < 64; ++k) { float w = W[(size_t)k * 6144]; a0 += sm[k] * w; a1 += sm[64 + k] * w; a2 += sm[128 + k] * w; a3 += sm[192 + k] * w; a4 += sm[256 + k] * w; }
    float* dst = MODP + ((size_t)(ks * 2 + l) * 5) * 6144 + j;
    dst[0] = a0; dst[6144] = a1; dst[2 * 6144] = a2; dst[3 * 6144] = a3; dst[4 * 6144] = a4;
  }
  conv_weight(p.in[I_WIN], DIN, (bf16_t*)(p.ws + OFF_WTIN), 1024, WTIN_ROWS, 0, sm, bid, nb);
  for (int br = 0; br < 3; ++br) conv_weight(p.in[I_WBR] + (size_t)br * 512 * 1024, 1024, (bf16_t*)(p.ws + OFF_WTBR) + (size_t)br * 1024 * 512, 512, 1024, 1, sm, bid, nb);
}
DI void phase1(const Params& p) {
  const float* MODP = (const float*)(p.ws + OFF_MODP);
  float* MOD = (float*)(p.ws + OFF_MOD);
  for (int i = blockIdx.x * NTHR + ltid(); i < 2 * 5 * 6144; i += gridDim.x * NTHR) {
    const int j = i % 6144, l = i / (5 * 6144);
    float s = p.in[I_BADA][l * 6144 + j];
    for (int ks = 0; ks < 16; ++ks) s += MODP[(size_t)ks * 2 * 5 * 6144 + i];
    MOD[i] = s;
  }
}

DI void norm_mod_store(const f32x4 (&x)[4], const float* nw, const float* sc, const float* sh, bf16_t* hrow, int lane) {
  float ss = 0.f;
#pragma unroll
  for (int i = 0; i < 4; ++i) ss += x[i][0] * x[i][0] + x[i][1] * x[i][1] + x[i][2] * x[i][2] + x[i][3] * x[i][3];
  ss = wave_sum(ss);
  const float rs = rsqrtf(ss * (1.0f / DM) + 1e-6f);
#pragma unroll
  for (int i = 0; i < 4; ++i) {
    const int c = i * 256 + lane * 4;
    f32x4 w = *(const f32x4*)(nw + c), s1 = *(const f32x4*)(sc + c), s0 = *(const f32x4*)(sh + c), o;
#pragma unroll
    for (int e = 0; e < 4; ++e) o[e] = x[i][e] * rs * w[e] * (1.0f + s1[e]) + s0[e];
    store_bf4(hrow + c, o);
  }
}
DI void tok_one(const Params& p, int l, int mode, int tok, int lane) {
  const float* MOD = (const float*)(p.ws + OFF_MOD);
  bf16_t* H = (bf16_t*)(p.ws + OFF_H);
  const float* Y = (const float*)(p.ws + OFF_Y);
  const int ci = tok_cond(tok);
  const float* modl = MOD + (size_t)(l * 5 + ci) * 6144;
  const float* nwl = p.in[I_NORMS] + (size_t)l * 4 * DM;
  const bool from_in = (l == 0 && (mode == 0 || mode == 1 || mode == 3));
  const float* xr = from_in ? x_in_row(p, tok) : p.out + (size_t)tok * DM;
  f32x4 x[4];
#pragma unroll
  for (int i = 0; i < 4; ++i) x[i] = *(const f32x4*)(xr + i * 256 + lane * 4);
  if (mode == 1 || mode == 2) {
    f32x4 y[4]; float ss = 0.f;
#pragma unroll
    for (int i = 0; i < 4; ++i) { y[i] = *(const f32x4*)(Y + (size_t)tok * DM + i * 256 + lane * 4); ss += y[i][0] * y[i][0] + y[i][1] * y[i][1] + y[i][2] * y[i][2] + y[i][3] * y[i][3]; }
    ss = wave_sum(ss);
    const float rs = rsqrtf(ss * (1.0f / DM) + 1e-6f);
    const float* nw = nwl + (mode == 1 ? 1 : 3) * DM;
    const float* g = modl + (mode == 1 ? 2 : 5) * DM;
#pragma unroll
    for (int i = 0; i < 4; ++i) {
      const int c = i * 256 + lane * 4;
      f32x4 w = *(const f32x4*)(nw + c), gg = *(const f32x4*)(g + c);
#pragma unroll
      for (int e = 0; e < 4; ++e) x[i][e] += gg[e] * (y[i][e] * rs * w[e]);
      *(f32x4*)(p.out + (size_t)tok * DM + c) = x[i];
    }
  }
  if (mode == 0 || mode == 3) norm_mod_store(x, nwl, modl + 1 * DM, modl + 0 * DM, H + (size_t)tok * DM, lane);
  else if (mode == 1) norm_mod_store(x, nwl + 2 * DM, modl + 4 * DM, modl + 3 * DM, H + (size_t)tok * DM, lane);
  else if (mode == 2 && l + 1 < 2) {
    const float* modn = MOD + (size_t)((l + 1) * 5 + ci) * 6144;
    norm_mod_store(x, p.in[I_NORMS] + (size_t)(l + 1) * 4 * DM, modn + 1 * DM, modn + 0 * DM, H + (size_t)tok * DM, lane);
  }
}
DI void tok_phase(const Params& p, int l, int mode) {
  const int lane = ltid() & 63, gw = blockIdx.x * 4 + (ltid() >> 6), nw = gridDim.x * 4;
  for (int tok = gw; tok < NT; tok += nw) tok_one(p, l, mode, tok, lane);
}

DI void phase_inproj(const Params& p, char* smem) {
  const bf16_t* H = (const bf16_t*)(p.ws + OFF_H);
  const bf16_t* WT = (const bf16_t*)(p.ws + OFF_WTIN);
  bf16_t* ZH = (bf16_t*)(p.ws + OFF_ZH); bf16_t* ZR = (bf16_t*)(p.ws + OFF_ZR); bf16_t* ZM = (bf16_t*)(p.ws + OFF_ZM);
  float* MG = (float*)(p.ws + OFF_MG);
  const int lane = ltid() & 63, w = ltid() >> 6, wm = w >> 1, wn = w & 1;
  for (int tile = blockIdx.x; tile < 52 * 128; tile += gridDim.x) {
    const int nt = tile % 52, mt = tile / 52;
    f32x4 acc[4][4]; zero_acc<4>(acc);
    gemm_main<128>(acc, H + (size_t)mt * 128 * 1024, 1024, WT + (size_t)nt * 128 * 1024, 1024, 1024, (bf16_t*)smem);
    const int n0 = nt * 128;
#pragma unroll
    for (int i = 0; i < 4; ++i) {
      const int row = mt * 128 + wm * 64 + i * 16 + (lane & 15);
#pragma unroll
      for (int j = 0; j < 4; ++j) {
        const int col = n0 + wn * 64 + j * 16 + 4 * (lane >> 4);
        if (n0 < 2560) store_bf4(ZH + (size_t)row * ZHW + col, acc[i][j]);
        else if (n0 < 4480) store_bf4(ZR + (size_t)row * ZRW + (col - 2560), acc[i][j]);
        else if (n0 < 6528) store_bf4(ZM + (size_t)row * ZMW + (col - 4480), acc[i][j]);
        else if (col - 6528 < 16) *(f32x4*)(MG + (size_t)row * 16 + (col - 6528)) = acc[i][j];
      }
    }
  }
}

DI void phase_merge(const Params& p, int l, char* smem) {
  const bf16_t* H = (const bf16_t*)(p.ws + OFF_H);
  const bf16_t* WT = (const bf16_t*)(p.ws + OFF_WTIN);
  const bf16_t* WBR = (const bf16_t*)(p.ws + OFF_WTBR);
  const bf16_t* ZH = (const bf16_t*)(p.ws + OFF_ZH); const bf16_t* ZM = (const bf16_t*)(p.ws + OFF_ZM); const bf16_t* O = (const bf16_t*)(p.ws + OFF_O);
  bf16_t* MER = (bf16_t*)(p.ws + OFF_MERGED);
  const int lane = ltid() & 63, w = ltid() >> 6, wm = w >> 1, wn = w & 1;
  for (int tile = blockIdx.x; tile < 16 * 128; tile += gridDim.x) {
    const int nt = tile % 16, mt = tile / 16;
    f32x4 accM[4][2]; zero_acc<2>(accM);
#pragma unroll 1
    for (int br = 0; br < 3; ++br) {
      f32x4 accG[4][2], accP[4][2]; zero_acc<2>(accG); zero_acc<2>(accP);
      gemm_main<64>(accG, H + (size_t)mt * 128 * 1024, 1024, WT + (size_t)(6656 + br * 1024 + nt * 64) * 1024, 1024, 1024, (bf16_t*)smem);
      const bf16_t* Ab; int lda;
      if (br == 0) { Ab = ZH + 2048; lda = ZHW; } else if (br == 1) { Ab = O; lda = 1024; } else { Ab = ZM + 1536; lda = ZMW; }
      gemm_main<64>(accP, Ab + (size_t)mt * 128 * lda, lda, WBR + ((size_t)br * 1024 + nt * 64) * 512, 512, 512, (bf16_t*)smem);
#pragma unroll
      for (int i = 0; i < 4; ++i)
#pragma unroll
        for (int j = 0; j < 2; ++j)
#pragma unroll
          for (int e = 0; e < 4; ++e) accM[i][j][e] += sigmoidf_(accG[i][j][e]) * accP[i][j][e];
    }
#pragma unroll
    for (int i = 0; i < 4; ++i) {
      const int row = mt * 128 + wm * 64 + i * 16 + (lane & 15);
#pragma unroll
      for (int j = 0; j < 2; ++j) store_bf4(MER + (size_t)row * 1024 + nt * 64 + wn * 32 + j * 16 + 4 * (lane >> 4), accM[i][j]);
    }
  }
  float* sm = (float*)smem;
  conv_weight(p.in[I_WOUT] + (size_t)l * 1024 * 1024, 1024, (bf16_t*)(p.ws + OFF_WTOUT), 1024, 1024, 1, sm, blockIdx.x, gridDim.x);
  conv_weight(p.in[I_WFI] + (size_t)l * 1024 * 5632, 5632, (bf16_t*)(p.ws + OFF_WTFI), 1024, 5632, 2, sm, blockIdx.x, gridDim.x);
  conv_weight(p.in[I_WFO] + (size_t)l * DFF * 1024, 1024, (bf16_t*)(p.ws + OFF_WTFO), DFF, 1024, 1, sm, blockIdx.x, gridDim.x);
}

DI void phase_gemm_f32(const Params& p, const bf16_t* A, int K, const bf16_t* Wt, char* smem) {
  float* Y = (float*)(p.ws + OFF_Y);
  const int lane = ltid() & 63, w = ltid() >> 6, wm = w >> 1, wn = w & 1;
  for (int tile = blockIdx.x; tile < 8 * 128; tile += gridDim.x) {
    const int nt = tile % 8, mt = tile / 8;
    f32x4 acc[4][4]; zero_acc<4>(acc);
    gemm_main<128>(acc, A + (size_t)mt * 128 * K, K, Wt + (size_t)nt * 128 * K, K, K, (bf16_t*)smem);
#pragma unroll
    for (int i = 0; i < 4; ++i) {
      const int row = mt * 128 + wm * 64 + i * 16 + (lane & 15);
#pragma unroll
      for (int j = 0; j < 4; ++j) *(f32x4*)(Y + (size_t)row * 1024 + nt * 128 + wn * 64 + j * 16 + 4 * (lane >> 4)) = acc[i][j];
    }
  }
}
DI void phase_ffn_in(const Params& p, char* smem) {
  const bf16_t* H = (const bf16_t*)(p.ws + OFF_H);
  const bf16_t* Wt = (const bf16_t*)(p.ws + OFF_WTFI);
  bf16_t* ACT = (bf16_t*)(p.ws + OFF_ACT);
  const int lane = ltid() & 63, w = ltid() >> 6, wm = w >> 1, wn = w & 1;
  for (int tile = blockIdx.x; tile < 44 * 128; tile += gridDim.x) {
    const int nt = tile % 44, mt = tile / 44;
    f32x4 acc[4][4]; zero_acc<4>(acc);
    gemm_main<128>(acc, H + (size_t)mt * 128 * 1024, 1024, Wt + (size_t)nt * 128 * 1024, 1024, 1024, (bf16_t*)smem);
#pragma unroll
    for (int i = 0; i < 4; ++i) {
      const int row = mt * 128 + wm * 64 + i * 16 + (lane & 15);
#pragma unroll
      for (int jj = 0; jj < 2; ++jj) {
        f32x4 u = acc[i][2 * jj], g = acc[i][2 * jj + 1], o;
#pragma unroll
        for (int e = 0; e < 4; ++e) o[e] = siluf_(g[e]) * u[e];
        const int col = (nt * 128 + wn * 64 + jj * 32) / 2 + 4 * (lane >> 4);
        store_bf4(ACT + (size_t)row * DFF + col, o);
      }
    }
  }
}

struct Seq { int base, T, grid, b; bool sample; };
DI Seq get_seq(int s) { Seq q; if (s < 32) { q.base = s * 256; q.T = 256; q.grid = 0; q.b = s; q.sample = false; } else { q.b = s - 32; q.base = 8192 + q.b * 2048; q.T = 2048; q.grid = 1; q.sample = true; } return q; }

DI float rw_shift(const bf16_t* ZR, const float* mu, int base, int t, int T, int grid, int col) {
  const bf16_t* pp = ZR + (size_t)(base + t) * ZRW + col;
  const float y = bf2f(*pp);
  if (!grid) {
    const float prev = t > 0 ? bf2f(pp[-ZRW]) : 0.f, nxt = t < T - 1 ? bf2f(pp[ZRW]) : 0.f;
    return y + mu[col] * (prev - y) + mu[ZRW + col] * (nxt - y);
  }
  const int gc = t & 63, gr = t >> 6;
  const float left = gc > 0 ? bf2f(pp[-ZRW]) : 0.f, right = gc < 63 ? bf2f(pp[ZRW]) : 0.f;
  const float up = gr > 0 ? bf2f(pp[-64 * ZRW]) : 0.f, down = gr < 31 ? bf2f(pp[64 * ZRW]) : 0.f;
  return y + mu[col] * (left - y) + mu[ZRW + col] * (right - y) + mu[2 * ZRW + col] * (up - y) + mu[3 * ZRW + col] * (down - y);
}

DI void rw_shift8(const bf16_t* ZR, const float* mu, int base, int t, int T, int grid, int col0, float (&out)[8]) {
  const bf16_t* pp = ZR + (size_t)(base + t) * ZRW + col0;
  const bf16x8 y = *(const bf16x8*)pp;
  float yv[8];
#pragma unroll
  for (int e = 0; e < 8; ++e) { yv[e] = bf2f((bf16_t)y[e]); out[e] = yv[e]; }
  const int nn = grid ? 4 : 2;
#pragma unroll 1
  for (int n = 0; n < nn; ++n) {
    bool valid; int off;
    if (!grid) { valid = n == 0 ? t > 0 : t < T - 1; off = n == 0 ? -ZRW : ZRW; }
    else { const int gc = t & 63, gr = t >> 6; valid = n == 0 ? gc > 0 : n == 1 ? gc < 63 : n == 2 ? gr > 0 : gr < 31; off = n == 0 ? -ZRW : n == 1 ? ZRW : n == 2 ? -64 * ZRW : 64 * ZRW; }
    const f32x4 m0 = *(const f32x4*)(mu + n * ZRW + col0), m1 = *(const f32x4*)(mu + n * ZRW + col0 + 4);
    bf16x8 nb = y;
    if (valid) nb = *(const bf16x8*)(pp + off);
#pragma unroll
    for (int e = 0; e < 8; ++e) { const float nv_ = valid ? bf2f((bf16_t)nb[e]) : 0.f; const float mm = e < 4 ? m0[e & 3] : m1[e & 3]; out[e] += mm * (nv_ - yv[e]); }
  }
}

DI void rwkv_item(const Params& p, int l, int s, int hh, int d, char* smem) {
  const Seq q = get_seq(s);
  const int tid = ltid();
  const bf16_t* ZR = (const bf16_t*)(p.ws + OFF_ZR);
  bf16_t* O = (bf16_t*)(p.ws + OFF_O);
  const float* mu = p.in[I_MU] + (size_t)l * 4 * ZRW;
  float* W2 = (float*)smem;
  float* A2 = W2 + 4096;
  float* sh = A2 + 4096;
  float* vW = sh + 5 * 1024;
  float* vKK = vW + 1024; float* vKKA = vKK + 1024; float* vKD = vKKA + 1024; float* outb = vKD + 1024;
  __syncthreads();
  for (int e = tid; e < 4096; e += NTHR) {
    const int i = e >> 6, c = e & 63;
    W2[e] = p.in[I_W2][((size_t)(l * 2 + d) * 64 + i) * 512 + 64 * hh + c];
    A2[e] = p.in[I_A2][((size_t)(l * 2 + d) * 64 + i) * 512 + 64 * hh + c];
  }
  const int cB = tid & 63, jg = tid >> 6;
  const float w0c = p.in[I_W0][(l * 2 + d) * 512 + 64 * hh + cB], a0c = p.in[I_A0][(l * 2 + d) * 512 + 64 * hh + cB];
  const float kkc = p.in[I_KK][l * 512 + 64 * hh + cB], kac = p.in[I_KA][l * 512 + 64 * hh + cB];
  const int v = tid >> 2, kq = tid & 3;
  float S[16];
  if (q.sample) {
    const float* st = p.in[I_SR] + ((((size_t)q.b * 2 + l) * 2 + d) * 8 + hh) * 4096 + v * 64 + kq * 16;
#pragma unroll
    for (int i = 0; i < 16; ++i) S[i] = st[i];
  } else {
#pragma unroll
    for (int i = 0; i < 16; ++i) S[i] = 0.f;
  }
  const int nch = q.T / 16;
#pragma unroll 1
  for (int ch = 0; ch < nch; ++ch) {
    __syncthreads();
#pragma unroll 1
    for (int g = tid; g < 640; g += NTHR) {
      const int arr = g >> 7, rem = g & 127, j = rem >> 3, c8 = (rem & 7) * 8;
      const int pos = ch * 16 + j, t = d ? q.T - 1 - pos : pos;
      const int col = arr == 0 ? 64 * hh + c8 : arr == 1 ? 512 + 64 * hh + c8 : arr == 2 ? 1024 + 64 * hh + c8 : arr == 3 ? 1536 + 64 * d + c8 : 1664 + 64 * d + c8;
      float val[8];
      rw_shift8(ZR, mu, q.base, t, q.T, q.grid, col, val);
      if (arr == 3) {
#pragma unroll
        for (int e = 0; e < 8; ++e) val[e] = tanhf(val[e]);
      }
      *(f32x4*)(sh + arr * 1024 + j * 64 + c8) = (f32x4){val[0], val[1], val[2], val[3]};
      *(f32x4*)(sh + arr * 1024 + j * 64 + c8 + 4) = (f32x4){val[4], val[5], val[6], val[7]};
    }
    __syncthreads();
    {
      float wl[4], al[4];
#pragma unroll
      for (int jj = 0; jj < 4; ++jj) { wl[jj] = w0c; al[jj] = a0c; }
#pragma unroll 1
      for (int i = 0; i < 64; i += 4) {
        float w2v[4], a2v[4];
#pragma unroll
        for (int u = 0; u < 4; ++u) { w2v[u] = W2[(i + u) * 64 + cB]; a2v[u] = A2[(i + u) * 64 + cB]; }
#pragma unroll
        for (int jj = 0; jj < 4; ++jj) {
          const int j = jg * 4 + jj;
          f32x4 tw = *(const f32x4*)(sh + 3 * 1024 + j * 64 + i), ta = *(const f32x4*)(sh + 4 * 1024 + j * 64 + i);
#pragma unroll
          for (int u = 0; u < 4; ++u) { wl[jj] += tw[u] * w2v[u]; al[jj] += ta[u] * a2v[u]; }
        }
      }
#pragma unroll
      for (int jj = 0; jj < 4; ++jj) {
        const int j = jg * 4 + jj;
        const float wlog = -softplusf_(-wl[jj]) - 0.5f;
        const float decay = __expf(-__expf(wlog));
        const float a = sigmoidf_(al[jj]);
        const float k = sh[1024 + j * 64 + cB];
        const float kkr = k * kkc;
        const float ss = wave_sum(kkr * kkr);
        const float kk = kkr / fmaxf(sqrtf(ss), 1e-12f);
        vW[j * 64 + cB] = decay; vKK[j * 64 + cB] = kk; vKKA[j * 64 + cB] = kk * a; vKD[j * 64 + cB] = k * (1.0f + (a - 1.0f) * kac);
      }
    }
    __syncthreads();
#pragma unroll 1
    for (int j = 0; j < 16; ++j) {
      const float* pk = vKK + j * 64 + kq * 16; const float* pw = vW + j * 64 + kq * 16; const float* pa = vKKA + j * 64 + kq * 16;
      const float* pd = vKD + j * 64 + kq * 16; const float* pr = sh + j * 64 + kq * 16;
      const float vv = sh[2048 + j * 64 + v];
      float kk[16], ww[16], ka[16], kd[16], rr[16];
#pragma unroll
      for (int u = 0; u < 4; ++u) {
        f32x4 t0 = *(const f32x4*)(pk + 4 * u), t1 = *(const f32x4*)(pw + 4 * u), t2 = *(const f32x4*)(pa + 4 * u), t3 = *(const f32x4*)(pd + 4 * u), t4 = *(const f32x4*)(pr + 4 * u);
#pragma unroll
        for (int e = 0; e < 4; ++e) { kk[4 * u + e] = t0[e]; ww[4 * u + e] = t1[e]; ka[4 * u + e] = t2[e]; kd[4 * u + e] = t3[e]; rr[4 * u + e] = t4[e]; }
      }
      float dot = 0.f;
#pragma unroll
      for (int i = 0; i < 16; ++i) dot += S[i] * kk[i];
      dot += dpp_xor1(dot); dot += dpp_xor2(dot);
      const float sa = -dot;
      float od = 0.f;
#pragma unroll
      for (int i = 0; i < 16; ++i) { S[i] = S[i] * ww[i] + sa * ka[i] + vv * kd[i]; od += S[i] * rr[i]; }
      od += dpp_xor1(od); od += dpp_xor2(od);
      if (kq == 0) outb[j * 64 + v] = od;
    }
    __syncthreads();
    for (int e = tid; e < 1024; e += NTHR) {
      const int j = e >> 6, c = e & 63, pos = ch * 16 + j, t = d ? q.T - 1 - pos : pos;
      O[(size_t)(q.base + t) * 1024 + d * 512 + 64 * hh + c] = f2bf(outb[e]);
    }
  }
  if (!q.sample) {
    float* dst = p.out + OUT_RW + ((((size_t)q.b * 2 + l) * 2 + d) * 8 + hh) * 4096 + v * 64 + kq * 16;
#pragma unroll
    for (int i = 0; i < 16; ++i) dst[i] = S[i];
  }
}

DI void hgrn_item(const Params& p, int l, int s, int hh, int d, char* smem) {
  const Seq q = get_seq(s);
  const int tid = ltid(), lane = tid & 63, w = tid >> 6, r = lane & 31, h = lane >> 5;
  bf16_t* ZH = (bf16_t*)(p.ws + OFF_ZH);
  bf16_t* Qt = (bf16_t*)smem;
  bf16_t* Kt = Qt + 32 * 136;
  bf16_t* KhT = Kt + 32 * 136;
  bf16_t* VT = KhT + 128 * 40;
  bf16_t* Sb = VT + 128 * 40;
  bf16_t* At = Sb + 4 * 32 * 136;
  float* dL = (float*)(At + 32 * 40);
  float* tot = dL + 128;
  const float lb = ((const float*)(p.ws + OFF_LBS))[l * 512 + 128 * hh + (tid & 127)];
  f32x16 S[4];
  if (q.sample) {
    const float* st = p.in[I_SH] + ((((size_t)q.b * 2 + l) * 2 + d) * 4 + hh) * 16384;
#pragma unroll
    for (int kb = 0; kb < 4; ++kb)
#pragma unroll
      for (int g = 0; g < 16; ++g) S[kb][g] = st[(size_t)(32 * kb + crow(g, h)) * 128 + 32 * w + r];
  } else {
#pragma unroll
    for (int kb = 0; kb < 4; ++kb)
#pragma unroll
      for (int g = 0; g < 16; ++g) S[kb][g] = 0.f;
  }
  const int k = tid & 127, half = tid >> 7;
  const int nch = q.T / 32;
#pragma unroll 1
  for (int ch = 0; ch < nch; ++ch) {
    __syncthreads();
    float bl[16], kc[16];
    {
      float b = 0.f;
#pragma unroll
      for (int jj = 0; jj < 16; ++jj) {
        const int pos = ch * 32 + half * 16 + jj, t = d ? q.T - 1 - pos : pos;
        const size_t rowo = (size_t)(q.base + t) * ZHW;
        const float z = bf2f(ZH[rowo + 512 * (1 + d) + 128 * hh + k]);
        const float kcoef = (1.0f - lb) * sigmoidf_(-z);
        const float f = 1.0f - kcoef;
        b += fmaxf(__logf(f), -80.f);
        bl[jj] = b; kc[jj] = kcoef;
        VT[k * 40 + half * 16 + jj] = ZH[rowo + 1536 + 128 * hh + k];
      }
      tot[half * 128 + k] = b;
    }
    __syncthreads();
    {
      const float off = half ? tot[k] : 0.f;
      const float bL = fmaxf(tot[k] + tot[128 + k], -80.f);
      if (half == 0) dL[k] = __expf(bL);
#pragma unroll
      for (int jj = 0; jj < 16; ++jj) {
        const int j = half * 16 + jj, pos = ch * 32 + j, t = d ? q.T - 1 - pos : pos;
        const float bj = fmaxf(off + bl[jj], -80.f);
        const float qv = bf2f(ZH[(size_t)(q.base + t) * ZHW + 128 * hh + k]) * 0.08838834764831845f;
        Qt[j * 136 + k] = f2bf(qv * __expf(bj));
        Kt[j * 136 + k] = f2bf(kc[jj] * __expf(-bj));
        KhT[k * 40 + j] = f2bf(kc[jj] * __expf(fminf(bL - bj, 0.f)));
      }
    }
    bf16_t* Sbw = Sb + w * 32 * 136;
#pragma unroll
    for (int kb = 0; kb < 4; ++kb)
#pragma unroll
      for (int g = 0; g < 16; ++g) Sbw[r * 136 + 32 * kb + crow(g, h)] = f2bf(S[kb][g]);
    __syncthreads();
    bf16_t* Atw = At;
    {
      f32x16 A;
#pragma unroll
      for (int g = 0; g < 16; ++g) A[g] = 0.f;
      mma32(A, Qt, 136, Kt, 136, 128, lane);
#pragma unroll
      for (int g = 0; g < 16; ++g) { const int t = crow(g, h); Atw[t * 40 + r] = f2bf(r <= t ? A[g] : 0.f); }
    }
    __syncthreads();
    {
      f32x16 o;
#pragma unroll
      for (int g = 0; g < 16; ++g) o[g] = 0.f;
      mma32(o, Atw, 40, VT + 32 * w * 40, 40, 32, lane);
      mma32(o, Qt, 136, Sbw, 136, 128, lane);
#pragma unroll
      for (int g = 0; g < 16; ++g) {
        const int j = crow(g, h), pos = ch * 32 + j, t = d ? q.T - 1 - pos : pos;
        ZH[(size_t)(q.base + t) * ZHW + 512 * (1 + d) + 128 * hh + 32 * w + r] = f2bf(o[g]);
      }
#pragma unroll
      for (int kb = 0; kb < 4; ++kb) {
#pragma unroll
        for (int g = 0; g < 16; ++g) S[kb][g] *= dL[32 * kb + crow(g, h)];
        mma32(S[kb], KhT + 32 * kb * 40, 40, VT + 32 * w * 40, 40, 32, lane);
      }
    }
  }
  if (!q.sample) {
    float* dst = p.out + OUT_HG + ((((size_t)q.b * 2 + l) * 2 + d) * 4 + hh) * 16384;
#pragma unroll
    for (int kb = 0; kb < 4; ++kb)
#pragma unroll
      for (int g = 0; g < 16; ++g) dst[(size_t)(32 * kb + crow(g, h)) * 128 + 32 * w + r] = S[kb][g];
  }
}

DI void mlstm_item(const Params& p, int l, int s, int hh, int d, char* smem) {
  const Seq q = get_seq(s);
  const int tid = ltid(), lane = tid & 63, w = tid >> 6, r = lane & 31, h = lane >> 5;
  const bf16_t* ZM = (const bf16_t*)(p.ws + OFF_ZM);
  const float* MG = (const float*)(p.ws + OFF_MG);
  bf16_t* Hb = (bf16_t*)(p.ws + OFF_H);
  bf16_t* Qm = (bf16_t*)smem;
  bf16_t* Km = Qm + 32 * 136;
  bf16_t* KwT = Km + 32 * 136;
  bf16_t* VT = KwT + 128 * 40;
  bf16_t* Cb = VT + 128 * 40;
  bf16_t* Pt = Cb + 4 * 32 * 136;
  float* nv = (float*)(Pt + 32 * 40);
  float* sc = nv + 128;
  float* ig = sc; float* lf = sc + 32; float* gg = sc + 64; float* mtv = sc + 96; float* wi = sc + 128; float* wsr = sc + 160; float* qn = sc + 192; float* misc = sc + 224;
  float* dnw = sc + 232;
  const float gbi = p.in[I_GB][l * 16 + (2 * d) * 4 + hh], gbf = p.in[I_GB][l * 16 + (2 * d + 1) * 4 + hh];
  f32x16 C[4];
  float m;
  __syncthreads();
  if (q.sample) {
    const size_t sb = (((size_t)q.b * 2 + l) * 2 + d) * 4 + hh;
    const float* st = p.in[I_SC] + sb * 16384;
#pragma unroll
    for (int kb = 0; kb < 4; ++kb)
#pragma unroll
      for (int g = 0; g < 16; ++g) C[kb][g] = st[(size_t)(32 * kb + crow(g, h)) * 128 + 32 * w + r];
    if (tid < 128) nv[tid] = p.in[I_SN][sb * 128 + tid];
    m = p.in[I_SM][sb];
  } else {
#pragma unroll
    for (int kb = 0; kb < 4; ++kb)
#pragma unroll
      for (int g = 0; g < 16; ++g) C[kb][g] = 0.f;
    if (tid < 128) nv[tid] = 0.f;
    m = 0.f;
  }
  const int nch = q.T / 32;
#pragma unroll 1
  for (int ch = 0; ch < nch; ++ch) {
    __syncthreads();
    {
      const int dd = tid & 127, half = tid >> 7;
#pragma unroll 4
      for (int jj = 0; jj < 16; ++jj) {
        const int j = half * 16 + jj, pos = ch * 32 + j, t = d ? q.T - 1 - pos : pos;
        const size_t rowo = (size_t)(q.base + t) * ZMW + 128 * hh + dd;
        Qm[j * 136 + dd] = ZM[rowo];
        Km[j * 136 + dd] = f2bf(bf2f(ZM[rowo + 512]) * 0.08838834764831845f);
        VT[dd * 40 + j] = ZM[rowo + 1024];
      }
      if (tid < 32) {
        const int pos = ch * 32 + tid, t = d ? q.T - 1 - pos : pos;
        const float* mg = MG + (size_t)(q.base + t) * 16;
        ig[tid] = mg[(2 * d) * 4 + hh] + gbi;
        lf[tid] = -softplusf_(-(mg[(2 * d + 1) * 4 + hh] + gbf));
      }
    }
    __syncthreads();
    if (tid < 32) { float a = 0.f; for (int i = 0; i <= tid; ++i) a += lf[i]; gg[tid] = a; }
    __syncthreads();
    if (tid < 32) {
      const float gt = gg[tid];
      float mx = gt + m;
      for (int i = 0; i <= tid; ++i) mx = fmaxf(mx, gt - gg[i] + ig[i]);
      mtv[tid] = mx; wi[tid] = __expf(gt + m - mx);
      const float gend = gg[31];
      float mn = gend + m;
      for (int i = 0; i < 32; ++i) mn = fmaxf(mn, gend - gg[i] + ig[i]);
      wsr[tid] = __expf(gend - gt + ig[tid] - mn);
      if (tid == 0) { misc[0] = mn; misc[1] = __expf(gend + m - mn); }
    }
    __syncthreads();
    {
      const int dd = tid & 127, half = tid >> 7;
#pragma unroll 4
      for (int jj = 0; jj < 16; ++jj) { const int j = half * 16 + jj; KwT[dd * 40 + j] = f2bf(bf2f(Km[j * 136 + dd]) * wsr[j]); }
      const int j = tid >> 3, seg = tid & 7;
      float a = 0.f;
#pragma unroll
      for (int i = 0; i < 16; ++i) a += bf2f(Qm[j * 136 + seg * 16 + i]) * nv[seg * 16 + i];
      a += __shfl_xor(a, 1); a += __shfl_xor(a, 2); a += __shfl_xor(a, 4);
      if (seg == 0) qn[j] = a;
    }
    const float m_new = misc[0], carry = misc[1];
    bf16_t* Cbw = Cb + w * 32 * 136; bf16_t* Ptw = Pt;
#pragma unroll
    for (int kb = 0; kb < 4; ++kb)
#pragma unroll
      for (int g = 0; g < 16; ++g) Cbw[r * 136 + 32 * kb + crow(g, h)] = f2bf(C[kb][g]);
    {
      f32x16 Sc;
#pragma unroll
      for (int g = 0; g < 16; ++g) Sc[g] = 0.f;
      mma32(Sc, Qm, 136, Km, 136, 128, lane);
      const float gs = gg[r], is = ig[r];
#pragma unroll
      for (int g = 0; g < 16; ++g) {
        const int t = crow(g, h);
        const float pv = (r <= t) ? __expf(gg[t] - gs + is - mtv[t]) * Sc[g] : 0.f;
        Ptw[t * 40 + r] = f2bf(pv);
      }
    }
    __syncthreads();
    if (lane < 32) {
      float a = 0.f;
#pragma unroll 4
      for (int i = 0; i < 32; ++i) a += bf2f(Ptw[lane * 40 + i]);
      const float den = wi[lane] * qn[lane] + a;
      dnw[lane] = 1.0f / fmaxf(fabsf(den), __expf(-mtv[lane]));
    }
    if (tid < 128) {
      float a = 0.f;
#pragma unroll 4
      for (int i = 0; i < 32; ++i) a += bf2f(KwT[tid * 40 + i]);
      nv[tid] = carry * nv[tid] + a;
    }
    __syncthreads();
    {
      f32x16 a1;
#pragma unroll
      for (int g = 0; g < 16; ++g) a1[g] = 0.f;
      mma32(a1, Qm, 136, Cbw, 136, 128, lane);
#pragma unroll
      for (int g = 0; g < 16; ++g) a1[g] *= wi[crow(g, h)];
      mma32(a1, Ptw, 40, VT + 32 * w * 40, 40, 32, lane);
#pragma unroll
      for (int g = 0; g < 16; ++g) {
        const int j = crow(g, h), pos = ch * 32 + j, t = d ? q.T - 1 - pos : pos;
        const float hv = a1[g] * dnw[j];
        Hb[(size_t)(q.base + t) * 1024 + d * 512 + 128 * hh + 32 * w + r] = f2bf(hv);
      }
#pragma unroll
      for (int kb = 0; kb < 4; ++kb) {
#pragma unroll
        for (int g = 0; g < 16; ++g) C[kb][g] *= carry;
        mma32(C[kb], KwT + 32 * kb * 40, 40, VT + 32 * w * 40, 40, 32, lane);
      }
    }
    m = m_new;
  }
  __syncthreads();
  if (!q.sample) {
    const size_t sb = (((size_t)q.b * 2 + l) * 2 + d) * 4 + hh;
    float* dst = p.out + OUT_C + sb * 16384;
#pragma unroll
    for (int kb = 0; kb < 4; ++kb)
#pragma unroll
      for (int g = 0; g < 16; ++g) dst[(size_t)(32 * kb + crow(g, h)) * 128 + 32 * w + r] = C[kb][g];
    if (tid < 128) p.out[OUT_N + sb * 128 + tid] = nv[tid];
    if (tid == 0) p.out[OUT_M + sb] = m;
  }
}

DI void phase_scan(const Params& p, int l, char* smem) {
  int* ctr = (int*)(p.ws + OFF_CTR) + l;
  int* sit = (int*)(smem + LDS_BYTES - 16);
  for (;;) {
    __syncthreads();
    if (ltid() == 0) *sit = atomicAdd(ctr, 1);
    __syncthreads();
    int it = *sit;
    if (it >= 1152) break;
    int ty, s_, hh_, d_;
    if (it < 64) { ty = 0; s_ = 32 + (it >> 4); hh_ = (it >> 1) & 7; d_ = it & 1; }
    else if (it < 96) { it -= 64; ty = 1; s_ = 32 + (it >> 3); hh_ = (it >> 1) & 3; d_ = it & 1; }
    else if (it < 128) { it -= 96; ty = 2; s_ = 32 + (it >> 3); hh_ = (it >> 1) & 3; d_ = it & 1; }
    else if (it < 640) { it -= 128; ty = 0; s_ = it >> 4; hh_ = (it >> 1) & 7; d_ = it & 1; }
    else if (it < 896) { it -= 640; ty = 1; s_ = it >> 3; hh_ = (it >> 1) & 3; d_ = it & 1; }
    else { it -= 896; ty = 2; s_ = it >> 3; hh_ = (it >> 1) & 3; d_ = it & 1; }
    if (ty == 0) rwkv_item(p, l, s_, hh_, d_, smem);
    else if (ty == 1) hgrn_item(p, l, s_, hh_, d_, smem);
    else mlstm_item(p, l, s_, hh_, d_, smem);
  }
}

DI void phase_combine(const Params& p, int l, char* smem) {
  const int tid = ltid(), lane = tid & 63, w = tid >> 6;
  bf16_t* ZH = (bf16_t*)(p.ws + OFF_ZH); bf16_t* ZM = (bf16_t*)(p.ws + OFF_ZM); const bf16_t* ZR = (const bf16_t*)(p.ws + OFF_ZR);
  bf16_t* O = (bf16_t*)(p.ws + OFF_O); const bf16_t* Hb = (const bf16_t*)(p.ws + OFF_H);
  const float* mu = p.in[I_MU] + (size_t)l * 4 * ZRW;
  const float* g2 = p.in[I_G2] + (size_t)l * 128 * 512;
  float* sg = (float*)smem;
  float* gt = sg + 128 * 16;
  for (int blk = blockIdx.x; blk < NT / 16; blk += gridDim.x) {
    const int tok0 = blk * 16;
    int sidx, t0;
    if (tok0 < 8192) { sidx = tok0 >> 8; t0 = tok0 & 255; } else { sidx = 32 + ((tok0 - 8192) >> 11); t0 = (tok0 - 8192) & 2047; }
    const Seq q = get_seq(sidx);
    __syncthreads();
    { const int j = tid >> 4, rr0 = (tid & 15) * 8; float val[8]; rw_shift8(ZR, mu, q.base, t0 + j, q.T, q.grid, 1792 + rr0, val);
#pragma unroll
      for (int e = 0; e < 8; ++e) sg[(rr0 + e) * 16 + j] = sigmoidf_(val[e]); }
    __syncthreads();
    {
      float a0[16], a1[16];
#pragma unroll
      for (int j = 0; j < 16; ++j) { a0[j] = 0.f; a1[j] = 0.f; }
#pragma unroll 1
      for (int rr = 0; rr < 128; ++rr) {
        const float w0 = g2[rr * 512 + tid], w1 = g2[rr * 512 + 256 + tid];
#pragma unroll
        for (int u = 0; u < 4; ++u) {
          f32x4 sv = *(const f32x4*)(sg + rr * 16 + 4 * u);
#pragma unroll
          for (int e = 0; e < 4; ++e) { a0[4 * u + e] += sv[e] * w0; a1[4 * u + e] += sv[e] * w1; }
        }
      }
#pragma unroll
      for (int j = 0; j < 16; ++j) { gt[j * 512 + tid] = a0[j]; gt[j * 512 + 256 + tid] = a1[j]; }
    }
    __syncthreads();
#pragma unroll 1
    for (int jj = 0; jj < 4; ++jj) {
      const int j = w * 4 + jj, tok = tok0 + j, t = t0 + j, c0 = lane * 8;
      {
        float o[8], rs[8], ks[8], vs[8];
        float sum = 0.f, bon = 0.f;
        rw_shift8(ZR, mu, q.base, t, q.T, q.grid, c0, rs);
        rw_shift8(ZR, mu, q.base, t, q.T, q.grid, 512 + c0, ks);
        rw_shift8(ZR, mu, q.base, t, q.T, q.grid, 1024 + c0, vs);
        const bf16x8 of = *(const bf16x8*)(O + (size_t)tok * 1024 + c0), ob = *(const bf16x8*)(O + (size_t)tok * 1024 + 512 + c0);
        const f32x4 rk0 = *(const f32x4*)(p.in[I_RK] + l * 512 + c0), rk1 = *(const f32x4*)(p.in[I_RK] + l * 512 + c0 + 4);
#pragma unroll
        for (int e = 0; e < 8; ++e) {
          o[e] = bf2f((bf16_t)of[e]) + bf2f((bf16_t)ob[e]);
          sum += o[e];
          bon += rs[e] * ks[e] * (e < 4 ? rk0[e & 3] : rk1[e & 3]);
        }
        sum += __shfl_xor(sum, 1); sum += __shfl_xor(sum, 2); sum += __shfl_xor(sum, 4);
        bon += __shfl_xor(bon, 1); bon += __shfl_xor(bon, 2); bon += __shfl_xor(bon, 4);
        const float mean = sum * (1.0f / 64.f);
        float var = 0.f;
#pragma unroll
        for (int e = 0; e < 8; ++e) { const float dv = o[e] - mean; var += dv * dv; }
        var += __shfl_xor(var, 1); var += __shfl_xor(var, 2); var += __shfl_xor(var, 4);
        const float rstd = rsqrtf(var * (1.0f / 64.f) + 64e-5f);
        const f32x4 lw0 = *(const f32x4*)(p.in[I_LN] + (l * 2 + 0) * 512 + c0), lw1 = *(const f32x4*)(p.in[I_LN] + (l * 2 + 0) * 512 + c0 + 4);
        const f32x4 lb0 = *(const f32x4*)(p.in[I_LN] + (l * 2 + 1) * 512 + c0), lb1 = *(const f32x4*)(p.in[I_LN] + (l * 2 + 1) * 512 + c0 + 4);
        const f32x4 gt0 = *(const f32x4*)(gt + j * 512 + c0), gt1 = *(const f32x4*)(gt + j * 512 + c0 + 4);
        bf16x8 ov;
#pragma unroll
        for (int e = 0; e < 8; ++e) {
          const float ln = (o[e] - mean) * rstd * (e < 4 ? lw0[e & 3] : lw1[e & 3]) + (e < 4 ? lb0[e & 3] : lb1[e & 3]);
          ov[e] = (short)f2bf((ln + bon * vs[e]) * (e < 4 ? gt0[e & 3] : gt1[e & 3]));
        }
        *(bf16x8*)(O + (size_t)tok * 1024 + c0) = ov;
      }
      {
        float o[8]; float ss = 0.f;
        bf16_t* zr_ = ZH + (size_t)tok * ZHW + c0;
        const bf16x8 of = *(const bf16x8*)(zr_ + 512), ob = *(const bf16x8*)(zr_ + 1024), hgv = *(const bf16x8*)(zr_ + 2048);
        const f32x4 nw0 = *(const f32x4*)(p.in[I_HNORM] + l * 512 + c0), nw1 = *(const f32x4*)(p.in[I_HNORM] + l * 512 + c0 + 4);
#pragma unroll
        for (int e = 0; e < 8; ++e) { o[e] = bf2f((bf16_t)of[e]) + bf2f((bf16_t)ob[e]); ss += o[e] * o[e]; }
        ss += __shfl_xor(ss, 1); ss += __shfl_xor(ss, 2); ss += __shfl_xor(ss, 4); ss += __shfl_xor(ss, 8);
        const float rsd = rsqrtf(ss * (1.0f / 128.f) + 1e-6f);
        bf16x8 ov;
#pragma unroll
        for (int e = 0; e < 8; ++e) ov[e] = (short)f2bf(o[e] * rsd * (e < 4 ? nw0[e & 3] : nw1[e & 3]) * siluf_(bf2f((bf16_t)hgv[e])));
        *(bf16x8*)(zr_ + 2048) = ov;
      }
      {
        float o[8]; float ss = 0.f;
        bf16_t* zm_ = ZM + (size_t)tok * ZMW + 1536 + c0;
        const bf16x8 of = *(const bf16x8*)(Hb + (size_t)tok * 1024 + c0), ob = *(const bf16x8*)(Hb + (size_t)tok * 1024 + 512 + c0), mov = *(const bf16x8*)zm_;
        const f32x4 nw0 = *(const f32x4*)(p.in[I_MNORM] + l * 512 + c0), nw1 = *(const f32x4*)(p.in[I_MNORM] + l * 512 + c0 + 4);
#pragma unroll
        for (int e = 0; e < 8; ++e) { o[e] = bf2f((bf16_t)of[e]) + bf2f((bf16_t)ob[e]); ss += o[e] * o[e]; }
        ss += __shfl_xor(ss, 1); ss += __shfl_xor(ss, 2); ss += __shfl_xor(ss, 4); ss += __shfl_xor(ss, 8);
        const float rsd = rsqrtf(ss * (1.0f / 128.f) + 1e-6f);
        bf16x8 ov;
#pragma unroll
        for (int e = 0; e < 8; ++e) ov[e] = (short)f2bf(o[e] * rsd * (e < 4 ? nw0[e & 3] : nw1[e & 3]) * sigmoidf_(bf2f((bf16_t)mov[e])));
        *(bf16x8*)zm_ = ov;
      }
    }
    __syncthreads();
#pragma unroll 1
    for (int jj = 0; jj < 4; ++jj) tok_one(p, l, 3, tok0 + w * 4 + jj, lane);
  }
}

constexpr int NPHASE = 3 + 9 * 2;
DI void run_phase(const Params& p0, int ph, char* smem) {
  Params p = p0;
  asm volatile("" : "+s"(p.ws), "+s"(p.out));
  if (ph == 0) { phase0(p, smem); return; }
  if (ph == 1) { phase1(p); return; }
  if (ph == 2) { tok_phase(p, 0, 0); return; }
  const int l = (ph - 3) / 9, s = (ph - 3) % 9;
  switch (s) {
    case 0: phase_inproj(p, smem); break;
    case 1: phase_scan(p, l, smem); break;
    case 2: phase_combine(p, l, smem); break;
    case 3: phase_merge(p, l, smem); break;
    case 4: phase_gemm_f32(p, (const bf16_t*)(p.ws + OFF_MERGED), 1024, (const bf16_t*)(p.ws + OFF_WTOUT), smem); break;
    case 5: tok_phase(p, l, 1); break;
    case 6: phase_ffn_in(p, smem); break;
    case 7: phase_gemm_f32(p, (const bf16_t*)(p.ws + OFF_ACT), DFF, (const bf16_t*)(p.ws + OFF_WTFO), smem); break;
    case 8:
      tok_phase(p, l, 2);
      if (l + 1 < 2) {
        conv_weight(p.in[I_WIN] + (size_t)(l + 1) * 1024 * DIN, DIN, (bf16_t*)(p.ws + OFF_WTIN), 1024, WTIN_ROWS, 0, (float*)smem, blockIdx.x, gridDim.x);
        for (int br = 0; br < 3; ++br) conv_weight(p.in[I_WBR] + ((size_t)(l + 1) * 3 + br) * 512 * 1024, 1024, (bf16_t*)(p.ws + OFF_WTBR) + (size_t)br * 1024 * 512, 512, 1024, 1, (float*)smem, blockIdx.x, gridDim.x);
      }
      break;
  }
}

template <bool COOP>
__global__ void __launch_bounds__(NTHR, 2) mega(Params p, int lo, int hi) {
  __shared__ __attribute__((aligned(16))) char smem[LDS_BYTES];
  for (int ph = lo; ph < hi; ++ph) {
    run_phase(p, ph, smem);
    if (COOP) { if (ph + 1 < hi) cg::this_grid().sync(); }
  }
}

extern "C" void kernel_launch(void* const* d_in, const int* in_sizes, int n_in, void* d_out, int out_size, void* d_ws, size_t ws_size, hipStream_t stream) {
  Params p{};
  for (int i = 0; i < N_IN; ++i) p.in[i] = (const float*)d_in[i];
  p.out = (float*)d_out; p.ws = (char*)d_ws;
  if (ws_size < WS_NEED) fprintf(stderr, "workspace too small: %zu < %zu\n", ws_size, (size_t)WS_NEED);
  for (int ph = 0; ph < NPHASE; ++ph) hipLaunchKernelGGL(mega<false>, dim3(512), dim3(NTHR), 0, stream, p, ph, ph + 1);
}
```

```cpp
#include <hip/hip_runtime.h>
#include <hip/hip_cooperative_groups.h>
#include <cstdio>
namespace cg = cooperative_groups;

typedef unsigned short bf16_t;
typedef short bf16x8 __attribute__((ext_vector_type(8)));
typedef float f32x4 __attribute__((ext_vector_type(4)));
typedef float f32x16 __attribute__((ext_vector_type(16)));
typedef unsigned short u16x4 __attribute__((ext_vector_type(4)));

#define DI __device__ __forceinline__

constexpr int NT = 16384;
constexpr int DM = 1024;
constexpr int NTHR = 256;
constexpr int DIN = 9616;
constexpr int ZHW = 2560, ZRW = 1920, ZMW = 2048;
constexpr int WTIN_ROWS = 9728;
constexpr int DFF = 2816;

constexpr size_t OFF_WTIN = 0;
constexpr size_t OFF_WTBR = OFF_WTIN + (size_t)WTIN_ROWS * 1024 * 2;
constexpr size_t OFF_H    = OFF_WTBR + (size_t)3 * 1024 * 512 * 2;
constexpr size_t OFF_ZH   = OFF_H + (size_t)NT * 1024 * 2;
constexpr size_t OFF_ZR   = OFF_ZH + (size_t)NT * ZHW * 2;
constexpr size_t OFF_ZM   = OFF_ZR + (size_t)NT * ZRW * 2;
constexpr size_t OFF_MG   = OFF_ZM + (size_t)NT * ZMW * 2;
constexpr size_t OFF_O    = OFF_MG + (size_t)NT * 16 * 4;
constexpr size_t OFF_MOD  = OFF_O + (size_t)NT * 1024 * 2;
constexpr size_t OFF_LBS  = OFF_MOD + (size_t)2 * 5 * 6144 * 4;
constexpr size_t OFF_CTR  = OFF_LBS + 2 * 512 * 4;
constexpr size_t WS_NEED  = OFF_CTR + 256;
constexpr size_t OFF_MODP = OFF_ZH;
constexpr size_t OFF_WTOUT = OFF_ZR;
constexpr size_t OFF_WTFI  = OFF_WTOUT + (size_t)1024 * 1024 * 2;
constexpr size_t OFF_WTFO  = OFF_WTFI + (size_t)5632 * 1024 * 2;
constexpr size_t OFF_MERGED = OFF_WTFO + (size_t)1024 * 2816 * 2;
constexpr size_t OFF_Y    = OFF_ZH;
constexpr size_t OFF_ACT  = OFF_ZM;

constexpr size_t OUT_HG = 16777216, OUT_RW = 25165824, OUT_C = 29360128, OUT_N = 37748736, OUT_M = 37814272;

enum { I_XP = 0, I_XS, I_SH, I_SR, I_SC, I_SN, I_SM, I_C, I_CCTX, I_WADA, I_BADA, I_NORMS, I_WIN, I_HLB, I_HNORM, I_MU, I_W0, I_W2,
       I_A0, I_A2, I_G2, I_KK, I_KA, I_RK, I_LN, I_GB, I_MNORM, I_WBR, I_WOUT, I_WFI, I_WFO, N_IN };

struct Params { const float* in[N_IN]; float* out; char* ws; };

constexpr int LDS_BYTES = 77824;

DI bf16_t f2bf(float f) { unsigned u = __float_as_uint(f); u += 0x7fffu + ((u >> 16) & 1u); return (bf16_t)(u >> 16); }
DI float bf2f(bf16_t h) { return __uint_as_float(((unsigned)h) << 16); }
DI float sigmoidf_(float x) { return 1.0f / (1.0f + __expf(-x)); }
DI float siluf_(float x) { return x / (1.0f + __expf(-x)); }
DI float softplusf_(float x) { return x > 20.f ? x : log1pf(__expf(x)); }
DI float wave_sum(float v) { for (int o = 32; o > 0; o >>= 1) v += __shfl_xor(v, o); return v; }
DI float dpp_xor1(float x) { return __int_as_float(__builtin_amdgcn_mov_dpp(__float_as_int(x), 0xB1, 0xF, 0xF, true)); }
DI float dpp_xor2(float x) { return __int_as_float(__builtin_amdgcn_mov_dpp(__float_as_int(x), 0x4E, 0xF, 0xF, true)); }
DI int ltid() { int t = threadIdx.x; asm volatile("" : "+v"(t)); return t; }
DI int crow(int reg, int h) { return (reg & 3) + 8 * (reg >> 2) + 4 * h; }

DI int tok_cond(int tok) { return tok < 8192 ? 0 : 1 + ((tok - 8192) >> 11); }
DI const float* x_in_row(const Params& p, int tok) { return tok < 8192 ? p.in[I_XP] + (size_t)tok * DM : p.in[I_XS] + (size_t)(tok - 8192) * DM; }

DI void mma32(f32x16& acc, const bf16_t* A, int lda, const bf16_t* B, int ldb, int K, int lane) {
  const int r = lane & 31, h = lane >> 5;
#pragma unroll 2
  for (int kk = 0; kk < K; kk += 16) {
    bf16x8 a = *(const bf16x8*)(A + r * lda + kk + 8 * h);
    bf16x8 b = *(const bf16x8*)(B + r * ldb + kk + 8 * h);
    acc = __builtin_amdgcn_mfma_f32_32x32x16_bf16(a, b, acc, 0, 0, 0);
  }
}

template <int BN>
DI void gemm_main(f32x4 (&acc)[4][BN / 32], const bf16_t* __restrict__ A, int lda, const bf16_t* __restrict__ B, int ldb, int K, bf16_t* sm) {
  constexpr int NJ = BN / 32, BCH = BN / 64;
  const int tid = ltid(), lane = tid & 63, w = tid >> 6, wm = w >> 1, wn = w & 1;
  bf16_t* As = sm; bf16_t* Bs = sm + 2 * 128 * 40;
  bf16x8 ra[2], rb[BCH];
  const int nk = K / 32;
#pragma unroll
  for (int i = 0; i < 2; ++i) { int c = tid + i * 256; ra[i] = *(const bf16x8*)(A + (size_t)(c >> 2) * lda + (c & 3) * 8); }
#pragma unroll
  for (int i = 0; i < BCH; ++i) { int c = tid + i * 256; rb[i] = *(const bf16x8*)(B + (size_t)(c >> 2) * ldb + (c & 3) * 8); }
  __syncthreads();
#pragma unroll
  for (int i = 0; i < 2; ++i) { int c = tid + i * 256; *(bf16x8*)(As + (c >> 2) * 40 + (c & 3) * 8) = ra[i]; }
#pragma unroll
  for (int i = 0; i < BCH; ++i) { int c = tid + i * 256; *(bf16x8*)(Bs + (c >> 2) * 40 + (c & 3) * 8) = rb[i]; }
  __syncthreads();
  for (int kt = 0; kt < nk; ++kt) {
    const int buf = kt & 1;
    if (kt + 1 < nk) {
      const int k0 = (kt + 1) * 32;
#pragma unroll
      for (int i = 0; i < 2; ++i) { int c = tid + i * 256; ra[i] = *(const bf16x8*)(A + (size_t)(c >> 2) * lda + k0 + (c & 3) * 8); }
#pragma unroll
      for (int i = 0; i < BCH; ++i) { int c = tid + i * 256; rb[i] = *(const bf16x8*)(B + (size_t)(c >> 2) * ldb + k0 + (c & 3) * 8); }
    }
    bf16x8 af[4], bfr[NJ];
    const bf16_t* as = As + buf * 128 * 40 + (wm * 64 + (lane & 15)) * 40 + (lane >> 4) * 8;
    const bf16_t* bs = Bs + buf * BN * 40 + (wn * (BN / 2) + (lane & 15)) * 40 + (lane >> 4) * 8;
#pragma unroll
    for (int i = 0; i < 4; ++i) af[i] = *(const bf16x8*)(as + i * 16 * 40);
#pragma unroll
    for (int j = 0; j < NJ; ++j) bfr[j] = *(const bf16x8*)(bs + j * 16 * 40);
#pragma unroll
    for (int i = 0; i < 4; ++i)
#pragma unroll
      for (int j = 0; j < NJ; ++j) acc[i][j] = __builtin_amdgcn_mfma_f32_16x16x32_bf16(bfr[j], af[i], acc[i][j], 0, 0, 0);
    if (kt + 1 < nk) {
      const int nb = buf ^ 1;
#pragma unroll
      for (int i = 0; i < 2; ++i) { int c = tid + i * 256; *(bf16x8*)(As + nb * 128 * 40 + (c >> 2) * 40 + (c & 3) * 8) = ra[i]; }
#pragma unroll
      for (int i = 0; i < BCH; ++i) { int c = tid + i * 256; *(bf16x8*)(Bs + nb * BN * 40 + (c >> 2) * 40 + (c & 3) * 8) = rb[i]; }
    }
    __syncthreads();
  }
}

template <int NJ> DI void zero_acc(f32x4 (&acc)[4][NJ]) {
#pragma unroll
  for (int i = 0; i < 4; ++i)
#pragma unroll
    for (int j = 0; j < NJ; ++j) acc[i][j] = (f32x4){0.f, 0.f, 0.f, 0.f};
}
DI void store_bf4(bf16_t* dst, f32x4 v) { u16x4 o; o[0] = f2bf(v[0]); o[1] = f2bf(v[1]); o[2] = f2bf(v[2]); o[3] = f2bf(v[3]); *(u16x4*)dst = o; }

DI int map_col(int mode, int n) {
  if (mode == 0) return n < 6544 ? n : (n < 6656 ? -1 : n - 112);
  if (mode == 2) return ((n >> 4) & 1) ? DFF + (n >> 5) * 16 + (n & 15) : (n >> 5) * 16 + (n & 15);
  return n;
}
DI void conv_tile(const float* __restrict__ src, int ld_src, bf16_t* __restrict__ dst, int K, int mode, int tk, int tn, float* sm) {
  const int tid = ltid();
  __syncthreads();
  {
    const int nn = tid & 63, col = map_col(mode, tn * 64 + nn);
#pragma unroll
    for (int i = 0; i < 16; ++i) { int kk = (tid >> 6) + 4 * i; sm[kk * 65 + nn] = col >= 0 ? src[(size_t)(tk * 64 + kk) * ld_src + col] : 0.f; }
  }
  __syncthreads();
  {
    const int kk = tid & 63;
#pragma unroll
    for (int i = 0; i < 16; ++i) { int nn = (tid >> 6) + 4 * i; dst[(size_t)(tn * 64 + nn) * K + tk * 64 + kk] = f2bf(sm[kk * 65 + nn]); }
  }
}
DI void conv_weight(const float* src, int ld_src, bf16_t* dst, int K, int Ndst, int mode, float* sm, int bid, int nb) {
  const int tkn = K / 64, nt = tkn * (Ndst / 64);
  for (int t = bid; t < nt; t += nb) conv_tile(src, ld_src, dst, K, mode, t % tkn, t / tkn, sm);
}

DI void phase0(const Params& p, char* smem) {
  const int tid = ltid(), bid = blockIdx.x, nb = gridDim.x;
  float* MODP = (float*)(p.ws + OFF_MODP);
  float* sm = (float*)smem;
  if (bid == 0 && tid < 64) ((int*)(p.ws + OFF_CTR))[tid] = 0;
  for (int i = bid * NTHR + tid; i < 512; i += nb * NTHR) {
    float a = p.in[I_HLB][i], b = p.in[I_HLB][512 + i];
    float* L = (float*)(p.ws + OFF_LBS); L[i] = 0.f; L[512 + i] = 1.0f / (1.0f + expf(a - b));
  }
  for (int it = bid; it < 2 * 24 * 16; it += nb) {
    const int ks = it & 15, jb = (it >> 4) % 24, l = it / (16 * 24);
    __syncthreads();
    for (int e = tid; e < 5 * 64; e += NTHR) { int ci = e >> 6, k = ks * 64 + (e & 63); float cv = ci == 0 ? p.in[I_CCTX][k] : p.in[I_C][(ci - 1) * DM + k]; sm[e] = siluf_(cv); }
    __syncthreads();
    const int j = jb * 256 + tid;
    float a0 = 0, a1 = 0, a2 = 0, a3 = 0, a4 = 0;
    const float* W = p.in[I_WADA] + ((size_t)l * DM + ks * 64) * 6144 + j;
    for (int k = 0; k < 64; ++k) { float w = W[(size_t)k * 6144]; a0 += sm[k] * w; a1 += sm[64 + k] * w; a2 += sm[128 + k] * w; a3 += sm[192 + k] * w; a4 += sm[256 + k] * w; }
    float* dst = MODP + ((size_t)(ks * 2 + l) * 5) * 6144 + j;
    dst[0] = a0; dst[6144] = a1; dst[2 * 6144] = a2; dst[3 * 6144] = a3; dst[4 * 6144] = a4;
  }
  conv_weight(p.in[I_WIN], DIN, (bf16_t*)(p.ws + OFF_WTIN), 1024, WTIN_ROWS, 0, sm, bid, nb);
  for (int br = 0; br < 3; ++br) conv_weight(p.in[I_WBR] + (size_t)br * 512 * 1024, 1024, (bf16_t*)(p.ws + OFF_WTBR) + (size_t)br * 1024 * 512, 512, 1024, 1, sm, bid, nb);
}
DI void phase1(const Params& p) {
  const float* MODP = (const float*)(p.ws + OFF_MODP);
  float* MOD = (float*)(p.ws + OFF_MOD);
  for (int i = blockIdx.x * NTHR + ltid(); i < 2 * 5 * 6144; i += gridDim.x * NTHR) {
    const int j = i % 6144, l = i / (5 * 6144);
    float s = p.in[I_BADA][l * 6144 + j];
    for (int ks = 0; ks < 16; ++ks) s += MODP[(size_t)ks * 2 * 5 * 6144 + i];
    MOD[i] = s;
  }
}

DI void norm_mod_store(const f32x4 (&x)[4], const float* nw, const float* sc, const float* sh, bf16_t* hrow, int lane) {
  float ss = 0.f;
#pragma unroll
  for (int i = 0; i < 4; ++i) ss += x[i][0] * x[i][0] + x[i][1] * x[i][1] + x[i][2] * x[i][2] + x[i][3] * x[i][3];
  ss = wave_sum(ss);
  const float rs = rsqrtf(ss * (1.0f / DM) + 1e-6f);
#pragma unroll
  for (int i = 0; i < 4; ++i) {
    const int c = i * 256 + lane * 4;
    f32x4 w = *(const f32x4*)(nw + c), s1 = *(const f32x4*)(sc + c), s0 = *(const f32x4*)(sh + c), o;
#pragma unroll
    for (int e = 0; e < 4; ++e) o[e] = x[i][e] * rs * w[e] * (1.0f + s1[e]) + s0[e];
    store_bf4(hrow + c, o);
  }
}
DI void tok_one(const Params& p, int l, int mode, int tok, int lane) {
  const float* MOD = (const float*)(p.ws + OFF_MOD);
  bf16_t* H = (bf16_t*)(p.ws + OFF_H);
  const float* Y = (const float*)(p.ws + OFF_Y);
  const int ci = tok_cond(tok);
  const float* modl = MOD + (size_t)(l * 5 + ci) * 6144;
  const float* nwl = p.in[I_NORMS] + (size_t)l * 4 * DM;
  const bool from_in = (l == 0 && (mode == 0 || mode == 1 || mode == 3));
  const float* xr = from_in ? x_in_row(p, tok) : p.out + (size_t)tok * DM;
  f32x4 x[4];
#pragma unroll
  for (int i = 0; i < 4; ++i) x[i] = *(const f32x4*)(xr + i * 256 + lane * 4);
  if (mode == 1 || mode == 2) {
    f32x4 y[4]; float ss = 0.f;
#pragma unroll
    for (int i = 0; i < 4; ++i) { y[i] = *(const f32x4*)(Y + (size_t)tok * DM + i * 256 + lane * 4); ss += y[i][0] * y[i][0] + y[i][1] * y[i][1] + y[i][2] * y[i][2] + y[i][3] * y[i][3]; }
    ss = wave_sum(ss);
    const float rs = rsqrtf(ss * (1.0f / DM) + 1e-6f);
    const float* nw = nwl + (mode == 1 ? 1 : 3) * DM;
    const float* g = modl + (mode == 1 ? 2 : 5) * DM;
#pragma unroll
    for (int i = 0; i < 4; ++i) {
      const int c = i * 256 + lane * 4;
      f32x4 w = *(const f32x4*)(nw + c), gg = *(const f32x4*)(g + c);
#pragma unroll
      for (int e = 0; e < 4; ++e) x[i][e] += gg[e] * (y[i][e] * rs * w[e]);
      *(f32x4*)(p.out + (size_t)tok * DM + c) = x[i];
    }
  }
  if (mode == 0 || mode == 3) norm_mod_store(x, nwl, modl + 1 * DM, modl + 0 * DM, H + (size_t)tok * DM, lane);
  else if (mode == 1) norm_mod_store(x, nwl + 2 * DM, modl + 4 * DM, modl + 3 * DM, H + (size_t)tok * DM, lane);
  else if (mode == 2 && l + 1 < 2) {
    const float* modn = MOD + (size_t)((l + 1) * 5 + ci) * 6144;
    norm_mod_store(x, p.in[I_NORMS] + (size_t)(l + 1) * 4 * DM, modn + 1 * DM, modn + 0 * DM, H + (size_t)tok * DM, lane);
  }
}
DI void tok_phase(const Params& p, int l, int mode) {
  const int lane = ltid() & 63, gw = blockIdx.x * 4 + (ltid() >> 6), nw = gridDim.x * 4;
  for (int tok = gw; tok < NT; tok += nw) tok_one(p, l, mode, tok, lane);
}

DI void phase_inproj(const Params& p, char* smem) {
  const bf16_t* H = (const bf16_t*)(p.ws + OFF_H);
  const bf16_t* WT = (const bf16_t*)(p.ws + OFF_WTIN);
  bf16_t* ZH = (bf16_t*)(p.ws + OFF_ZH); bf16_t* ZR = (bf16_t*)(p.ws + OFF_ZR); bf16_t* ZM = (bf16_t*)(p.ws + OFF_ZM);
  float* MG = (float*)(p.ws + OFF_MG);
  const int lane = ltid() & 63, w = ltid() >> 6, wm = w >> 1, wn = w & 1;
  for (int tile = blockIdx.x; tile < 52 * 128; tile += gridDim.x) {
    const int nt = tile % 52, mt = tile / 52;
    f32x4 acc[4][4]; zero_acc<4>(acc);
    gemm_main<128>(acc, H + (size_t)mt * 128 * 1024, 1024, WT + (size_t)nt * 128 * 1024, 1024, 1024, (bf16_t*)smem);
    const int n0 = nt * 128;
#pragma unroll
    for (int i = 0; i < 4; ++i) {
      const int row = mt * 128 + wm * 64 + i * 16 + (lane & 15);
#pragma unroll
      for (int j = 0; j < 4; ++j) {
        const int col = n0 + wn * 64 + j * 16 + 4 * (lane >> 4);
        if (n0 < 2560) store_bf4(ZH + (size_t)row * ZHW + col, acc[i][j]);
        else if (n0 < 4480) store_bf4(ZR + (size_t)row * ZRW + (col - 2560), acc[i][j]);
        else if (n0 < 6528) store_bf4(ZM + (size_t)row * ZMW + (col - 4480), acc[i][j]);
        else if (col - 6528 < 16) *(f32x4*)(MG + (size_t)row * 16 + (col - 6528)) = acc[i][j];
      }
    }
  }
}

DI void phase_merge(const Params& p, int l, char* smem) {
  const bf16_t* H = (const bf16_t*)(p.ws + OFF_H);
  const bf16_t* WT = (const bf16_t*)(p.ws + OFF_WTIN);
  const bf16_t* WBR = (const bf16_t*)(p.ws + OFF_WTBR);
  const bf16_t* ZH = (const bf16_t*)(p.ws + OFF_ZH); const bf16_t* ZM = (const bf16_t*)(p.ws + OFF_ZM); const bf16_t* O = (const bf16_t*)(p.ws + OFF_O);
  bf16_t* MER = (bf16_t*)(p.ws + OFF_MERGED);
  const int lane = ltid() & 63, w = ltid() >> 6, wm = w >> 1, wn = w & 1;
  for (int tile = blockIdx.x; tile < 16 * 128; tile += gridDim.x) {
    const int nt = tile % 16, mt = tile / 16;
    f32x4 accM[4][2]; zero_acc<2>(accM);
#pragma unroll 1
    for (int br = 0; br < 3; ++br) {
      f32x4 accG[4][2], accP[4][2]; zero_acc<2>(accG); zero_acc<2>(accP);
      gemm_main<64>(accG, H + (size_t)mt * 128 * 1024, 1024, WT + (size_t)(6656 + br * 1024 + nt * 64) * 1024, 1024, 1024, (bf16_t*)smem);
      const bf16_t* Ab; int lda;
      if (br == 0) { Ab = ZH + 2048; lda = ZHW; } else if (br == 1) { Ab = O; lda = 1024; } else { Ab = ZM + 1536; lda = ZMW; }
      gemm_main<64>(accP, Ab + (size_t)mt * 128 * lda, lda, WBR + ((size_t)br * 1024 + nt * 64) * 512, 512, 512, (bf16_t*)smem);
#pragma unroll
      for (int i = 0; i < 4; ++i)
#pragma unroll
        for (int j = 0; j < 2; ++j)
#pragma unroll
          for (int e = 0; e < 4; ++e) accM[i][j][e] += sigmoidf_(accG[i][j][e]) * accP[i][j][e];
    }
#pragma unroll
    for (int i = 0; i < 4; ++i) {
      const int row = mt * 128 + wm * 64 + i * 16 + (lane & 15);
#pragma unroll
      for (int j = 0; j < 2; ++j) store_bf4(MER + (size_t)row * 1024 + nt * 64 + wn * 32 + j * 16 + 4 * (lane >> 4), accM[i][j]);
    }
  }
  float* sm = (float*)smem;
  conv_weight(p.in[I_WOUT] + (size_t)l * 1024 * 1024, 1024, (bf16_t*)(p.ws + OFF_WTOUT), 1024, 1024, 1, sm, blockIdx.x, gridDim.x);
  conv_weight(p.in[I_WFI] + (size_t)l * 1024 * 5632, 5632, (bf16_t*)(p.ws + OFF_WTFI), 1024, 5632, 2, sm, blockIdx.x, gridDim.x);
  conv_weight(p.in[I_WFO] + (size_t)l * DFF * 1024, 1024, (bf16_t*)(p.ws + OFF_WTFO), DFF, 1024, 1, sm, blockIdx.x, gridDim.x);
}

DI void phase_gemm_f32(const Params& p, const bf16_t* A, int K, const bf16_t* Wt, char* smem) {
  float* Y = (float*)(p.ws + OFF_Y);
  const int lane = ltid() & 63, w = ltid() >> 6, wm = w >> 1, wn = w & 1;
  for (int tile = blockIdx.x; tile < 8 * 128; tile += gridDim.x) {
    const int nt = tile % 8, mt = tile / 8;
    f32x4 acc[4][4]; zero_acc<4>(acc);
    gemm_main<128>(acc, A + (size_t)mt * 128 * K, K, Wt + (size_t)nt * 128 * K, K, K, (bf16_t*)smem);
#pragma unroll
    for (int i = 0; i < 4; ++i) {
      const int row = mt * 128 + wm * 64 + i * 16 + (lane & 15);
#pragma unroll
      for (int j = 0; j < 4; ++j) *(f32x4*)(Y + (size_t)row * 1024 + nt * 128 + wn * 64 + j * 16 + 4 * (lane >> 4)) = acc[i][j];
    }
  }
}
DI void phase_ffn_in(const Params& p, char* smem) {
  const bf16_t* H = (const bf16_t*)(p.ws + OFF_H);
  const bf16_t* Wt = (const bf16_t*)(p.ws + OFF_WTFI);
  bf16_t* ACT = (bf16_t*)(p.ws + OFF_ACT);
  const int lane = ltid() & 63, w = ltid() >> 6, wm = w >> 1, wn = w & 1;
  for (int tile = blockIdx.x; tile < 44 * 128; tile += gridDim.x) {
    const int nt = tile % 44, mt = tile / 44;
    f32x4 acc[4][4]; zero_acc<4>(acc);
    gemm_main<128>(acc, H + (size_t)mt * 128 * 1024, 1024, Wt + (size_t)nt * 128 * 1024, 1024, 1024, (bf16_t*)smem);
#pragma unroll
    for (int i = 0; i < 4; ++i) {
      const int row = mt * 128 + wm * 64 + i * 16 + (lane & 15);
#pragma unroll
      for (int jj = 0; jj < 2; ++jj) {
        f32x4 u = acc[i][2 * jj], g = acc[i][2 * jj + 1], o;
#pragma unroll
        for (int e = 0; e < 4; ++e) o[e] = siluf_(g[e]) * u[e];
        const int col = (nt * 128 + wn * 64 + jj * 32) / 2 + 4 * (lane >> 4);
        store_bf4(ACT + (size_t)row * DFF + col, o);
      }
    }
  }
}

struct Seq { int base, T, grid, b; bool sample; };
DI Seq get_seq(int s) { Seq q; if (s < 32) { q.base = s * 256; q.T = 256; q.grid = 0; q.b = s; q.sample = false; } else { q.b = s - 32; q.base = 8192 + q.b * 2048; q.T = 2048; q.grid = 1; q.sample = true; } return q; }

DI float rw_shift(const bf16_t* ZR, const float* mu, int base, int t, int T, int grid, int col) {
  const bf16_t* pp = ZR + (size_t)(base + t) * ZRW + col;
  const float y = bf2f(*pp);
  if (!grid) {
    const float prev = t > 0 ? bf2f(pp[-ZRW]) : 0.f, nxt = t < T - 1 ? bf2f(pp[ZRW]) : 0.f;
    return y + mu[col] * (prev - y) + mu[ZRW + col] * (nxt - y);
  }
  const int gc = t & 63, gr = t >> 6;
  const float left = gc > 0 ? bf2f(pp[-ZRW]) : 0.f, right = gc < 63 ? bf2f(pp[ZRW]) : 0.f;
  const float up = gr > 0 ? bf2f(pp[-64 * ZRW]) : 0.f, down = gr < 31 ? bf2f(pp[64 * ZRW]) : 0.f;
  return y + mu[col] * (left - y) + mu[ZRW + col] * (right - y) + mu[2 * ZRW + col] * (up - y) + mu[3 * ZRW + col] * (down - y);
}

DI void rw_shift8(const bf16_t* ZR, const float* mu, int base, int t, int T, int grid, int col0, float (&out)[8]) {
  const bf16_t* pp = ZR + (size_t)(base + t) * ZRW + col0;
  const bf16x8 y = *(const bf16x8*)pp;
  float yv[8];
#pragma unroll
  for (int e = 0; e < 8; ++e) { yv[e] = bf2f((bf16_t)y[e]); out[e] = yv[e]; }
  const int nn = grid ? 4 : 2;
#pragma unroll 1
  for (int n = 0; n < nn; ++n) {
    bool valid; int off;
    if (!grid) { valid = n == 0 ? t > 0 : t < T - 1; off = n == 0 ? -ZRW : ZRW; }
    else { const int gc = t & 63, gr = t >> 6; valid = n == 0 ? gc > 0 : n == 1 ? gc < 63 : n == 2 ? gr > 0 : gr < 31; off = n == 0 ? -ZRW : n == 1 ? ZRW : n == 2 ? -64 * ZRW : 64 * ZRW; }
    const f32x4 m0 = *(const f32x4*)(mu + n * ZRW + col0), m1 = *(const f32x4*)(mu + n * ZRW + col0 + 4);
    bf16x8 nb = y;
    if (valid) nb = *(const bf16x8*)(pp + off);
#pragma unroll
    for (int e = 0; e < 8; ++e) { const float nv_ = valid ? bf2f((bf16_t)nb[e]) : 0.f; const float mm = e < 4 ? m0[e & 3] : m1[e & 3]; out[e] += mm * (nv_ - yv[e]); }
  }
}

DI void rwkv_item(const Params& p, int l, int s, int hh, int d, char* smem) {
  const Seq q = get_seq(s);
  const int tid = ltid();
  const bf16_t* ZR = (const bf16_t*)(p.ws + OFF_ZR);
  bf16_t* O = (bf16_t*)(p.ws + OFF_O);
  const float* mu = p.in[I_MU] + (size_t)l * 4 * ZRW;
  float* W2 = (float*)smem;
  float* A2 = W2 + 4096;
  float* sh = A2 + 4096;
  float* vW = sh + 5 * 1024;
  float* vKK = vW + 1024; float* vKKA = vKK + 1024; float* vKD = vKKA + 1024; float* outb = vKD + 1024;
  __syncthreads();
  for (int e = tid; e < 4096; e += NTHR) {
    const int i = e >> 6, c = e & 63;
    W2[e] = p.in[I_W2][((size_t)(l * 2 + d) * 64 + i) * 512 + 64 * hh + c];
    A2[e] = p.in[I_A2][((size_t)(l * 2 + d) * 64 + i) * 512 + 64 * hh + c];
  }
  const int cB = tid & 63, jg = tid >> 6;
  const float w0c = p.in[I_W0][(l * 2 + d) * 512 + 64 * hh + cB], a0c = p.in[I_A0][(l * 2 + d) * 512 + 64 * hh + cB];
  const float kkc = p.in[I_KK][l * 512 + 64 * hh + cB], kac = p.in[I_KA][l * 512 + 64 * hh + cB];
  const int v = tid >> 2, kq = tid & 3;
  float S[16];
  if (q.sample) {
    const float* st = p.in[I_SR] + ((((size_t)q.b * 2 + l) * 2 + d) * 8 + hh) * 4096 + v * 64 + kq * 16;
#pragma unroll
    for (int i = 0; i < 16; ++i) S[i] = st[i];
  } else {
#pragma unroll
    for (int i = 0; i < 16; ++i) S[i] = 0.f;
  }
  const int nch = q.T / 16;
#pragma unroll 1
  for (int ch = 0; ch < nch; ++ch) {
    __syncthreads();
#pragma unroll 1
    for (int g = tid; g < 640; g += NTHR) {
      const int arr = g >> 7, rem = g & 127, j = rem >> 3, c8 = (rem & 7) * 8;
      const int pos = ch * 16 + j, t = d ? q.T - 1 - pos : pos;
      const int col = arr == 0 ? 64 * hh + c8 : arr == 1 ? 512 + 64 * hh + c8 : arr == 2 ? 1024 + 64 * hh + c8 : arr == 3 ? 1536 + 64 * d + c8 : 1664 + 64 * d + c8;
      float val[8];
      rw_shift8(ZR, mu, q.base, t, q.T, q.grid, col, val);
      if (arr == 3) {
#pragma unroll
        for (int e = 0; e < 8; ++e) val[e] = tanhf(val[e]);
      }
      *(f32x4*)(sh + arr * 1024 + j * 64 + c8) = (f32x4){val[0], val[1], val[2], val[3]};
      *(f32x4*)(sh + arr * 1024 + j * 64 + c8 + 4) = (f32x4){val[4], val[5], val[6], val[7]};
    }
    __syncthreads();
    {
      float wl[4], al[4];
#pragma unroll
      for (int jj = 0; jj < 4; ++jj) { wl[jj] = w0c; al[jj] = a0c; }
#pragma unroll 1
      for (int i = 0; i < 64; i += 4) {
        float w2v[4], a2v[4];
#pragma unroll
        for (int u = 0; u < 4; ++u) { w2v[u] = W2[(i + u) * 64 + cB]; a2v[u] = A2[(i + u) * 64 + cB]; }
#pragma unroll
        for (int jj = 0; jj < 4; ++jj) {
          const int j = jg * 4 + jj;
          f32x4 tw = *(const f32x4*)(sh + 3 * 1024 + j * 64 + i), ta = *(const f32x4*)(sh + 4 * 1024 + j * 64 + i);
#pragma unroll
          for (int u = 0; u < 4; ++u) { wl[jj] += tw[u] * w2v[u]; al[jj] += ta[u] * a2v[u]; }
        }
      }
#pragma unroll
      for (int jj = 0; jj < 4; ++jj) {
        const int j = jg * 4 + jj;
        const float wlog = -softplusf_(-wl[jj]) - 0.5f;
        const float decay = __expf(-__expf(wlog));
        const float a = sigmoidf_(al[jj]);
        const float k = sh[1024 + j * 64 + cB];
        const float kkr = k * kkc;
        const float ss = wave_sum(kkr * kkr);
        const float kk = kkr / fmaxf(sqrtf(ss), 1e-12f);
        vW[j * 64 + cB] = decay; vKK[j * 64 + cB] = kk; vKKA[j * 64 + cB] = kk * a; vKD[j * 64 + cB] = k * (1.0f + (a - 1.0f) * kac);
      }
    }
    __syncthreads();
#pragma unroll 1
    for (int j = 0; j < 16; ++j) {
      const float* pk = vKK + j * 64 + kq * 16; const float* pw = vW + j * 64 + kq * 16; const float* pa = vKKA + j * 64 + kq * 16;
      const float* pd = vKD + j * 64 + kq * 16; const float* pr = sh + j * 64 + kq * 16;
      const float vv = sh[2048 + j * 64 + v];
      float kk[16], ww[16], ka[16], kd[16], rr[16];
#pragma unroll
      for (int u = 0; u < 4; ++u) {
        f32x4 t0 = *(const f32x4*)(pk + 4 * u), t1 = *(const f32x4*)(pw + 4 * u), t2 = *(const f32x4*)(pa + 4 * u), t3 = *(const f32x4*)(pd + 4 * u), t4 = *(const f32x4*)(pr + 4 * u);
#pragma unroll
        for (int e = 0; e < 4; ++e) { kk[4 * u + e] = t0[e]; ww[4 * u + e] = t1[e]; ka[4 * u + e] = t2[e]; kd[4 * u + e] = t3[e]; rr[4 * u + e] = t4[e]; }
      }
      float dot = 0.f;
#pragma unroll
      for (int i = 0; i < 16; ++i) dot += S[i] * kk[i];
      dot += dpp_xor1(dot); dot += dpp_xor2(dot);
      const float sa = -dot;
      float od = 0.f;
#pragma unroll
      for (int i = 0; i < 16; ++i) { S[i] = S[i] * ww[i] + sa * ka[i] + vv * kd[i]; od += S[i] * rr[i]; }
      od += dpp_xor1(od); od += dpp_xor2(od);
      if (kq == 0) outb[j * 64 + v] = od;
    }
    __syncthreads();
    for (int e = tid; e < 1024; e += NTHR) {
      const int j = e >> 6, c = e & 63, pos = ch * 16 + j, t = d ? q.T - 1 - pos : pos;
      O[(size_t)(q.base + t) * 1024 + d * 512 + 64 * hh + c] = f2bf(outb[e]);
    }
  }
  if (!q.sample) {
    float* dst = p.out + OUT_RW + ((((size_t)q.b * 2 + l) * 2 + d) * 8 + hh) * 4096 + v * 64 + kq * 16;
#pragma unroll
    for (int i = 0; i < 16; ++i) dst[i] = S[i];
  }
}

DI void hgrn_item(const Params& p, int l, int s, int hh, int d, char* smem) {
  const Seq q = get_seq(s);
  const int tid = ltid(), lane = tid & 63, w = tid >> 6, r = lane & 31, h = lane >> 5;
  bf16_t* ZH = (bf16_t*)(p.ws + OFF_ZH);
  bf16_t* Qt = (bf16_t*)smem;
  bf16_t* Kt = Qt + 32 * 136;
  bf16_t* KhT = Kt + 32 * 136;
  bf16_t* VT = KhT + 128 * 40;
  bf16_t* Sb = VT + 128 * 40;
  bf16_t* At = Sb + 4 * 32 * 136;
  float* dL = (float*)(At + 32 * 40);
  float* tot = dL + 128;
  const float lb = ((const float*)(p.ws + OFF_LBS))[l * 512 + 128 * hh + (tid & 127)];
  f32x16 S[4];
  if (q.sample) {
    const float* st = p.in[I_SH] + ((((size_t)q.b * 2 + l) * 2 + d) * 4 + hh) * 16384;
#pragma unroll
    for (int kb = 0; kb < 4; ++kb)
#pragma unroll
      for (int g = 0; g < 16; ++g) S[kb][g] = st[(size_t)(32 * kb + crow(g, h)) * 128 + 32 * w + r];
  } else {
#pragma unroll
    for (int kb = 0; kb < 4; ++kb)
#pragma unroll
      for (int g = 0; g < 16; ++g) S[kb][g] = 0.f;
  }
  const int k = tid & 127, half = tid >> 7;
  const int nch = q.T / 32;
#pragma unroll 1
  for (int ch = 0; ch < nch; ++ch) {
    __syncthreads();
    float bl[16], kc[16];
    {
      float b = 0.f;
#pragma unroll
      for (int jj = 0; jj < 16; ++jj) {
        const int pos = ch * 32 + half * 16 + jj, t = d ? q.T - 1 - pos : pos;
        const size_t rowo = (size_t)(q.base + t) * ZHW;
        const float z = bf2f(ZH[rowo + 512 * (1 + d) + 128 * hh + k]);
        const float kcoef = (1.0f - lb) * sigmoidf_(-z);
        const float f = 1.0f - kcoef;
        b += fmaxf(__logf(f), -80.f);
        bl[jj] = b; kc[jj] = kcoef;
        VT[k * 40 + half * 16 + jj] = ZH[rowo + 1536 + 128 * hh + k];
      }
      tot[half * 128 + k] = b;
    }
    __syncthreads();
    {
      const float off = half ? tot[k] : 0.f;
      const float bL = fmaxf(tot[k] + tot[128 + k], -80.f);
      if (half == 0) dL[k] = __expf(bL);
#pragma unroll
      for (int jj = 0; jj < 16; ++jj) {
        const int j = half * 16 + jj, pos = ch * 32 + j, t = d ? q.T - 1 - pos : pos;
        const float bj = fmaxf(off + bl[jj], -80.f);
        const float qv = bf2f(ZH[(size_t)(q.base + t) * ZHW + 128 * hh + k]) * 0.08838834764831845f;
        Qt[j * 136 + k] = f2bf(qv * __expf(bj));
        Kt[j * 136 + k] = f2bf(kc[jj] * __expf(-bj));
        KhT[k * 40 + j] = f2bf(kc[jj] * __expf(fminf(bL - bj, 0.f)));
      }
    }
    bf16_t* Sbw = Sb + w * 32 * 136;
#pragma unroll
    for (int kb = 0; kb < 4; ++kb)
#pragma unroll
      for (int g = 0; g < 16; ++g) Sbw[r * 136 + 32 * kb + crow(g, h)] = f2bf(S[kb][g]);
    __syncthreads();
    bf16_t* Atw = At;
    {
      f32x16 A;
#pragma unroll
      for (int g = 0; g < 16; ++g) A[g] = 0.f;
      mma32(A, Qt, 136, Kt, 136, 128, lane);
#pragma unroll
      for (int g = 0; g < 16; ++g) { const int t = crow(g, h); Atw[t * 40 + r] = f2bf(r <= t ? A[g] : 0.f); }
    }
    __syncthreads();
    {
      f32x16 o;
#pragma unroll
      for (int g = 0; g < 16; ++g) o[g] = 0.f;
      mma32(o, Atw, 40, VT + 32 * w * 40, 40, 32, lane);
      mma32(o, Qt, 136, Sbw, 136, 128, lane);
#pragma unroll
      for (int g = 0; g < 16; ++g) {
        const int j = crow(g, h), pos = ch * 32 + j, t = d ? q.T - 1 - pos : pos;
        ZH[(size_t)(q.base + t) * ZHW + 512 * (1 + d) + 128 * hh + 32 * w + r] = f2bf(o[g]);
      }
#pragma unroll
      for (int kb = 0; kb < 4; ++kb) {
#pragma unroll
        for (int g = 0; g < 16; ++g) S[kb][g] *= dL[32 * kb + crow(g, h)];
        mma32(S[kb], KhT + 32 * kb * 40, 40, VT + 32 * w * 40, 40, 32, lane);
      }
    }
  }
  if (!q.sample) {
    float* dst = p.out + OUT_HG + ((((size_t)q.b * 2 + l) * 2 + d) * 4 + hh) * 16384;
#pragma unroll
    for (int kb = 0; kb < 4; ++kb)
#pragma unroll
      for (int g = 0; g < 16; ++g) dst[(size_t)(32 * kb + crow(g, h)) * 128 + 32 * w + r] = S[kb][g];
  }
}

DI void mlstm_item(const Params& p, int l, int s, int hh, int d, char* smem) {
  const Seq q = get_seq(s);
  const int tid = ltid(), lane = tid & 63, w = tid >> 6, r = lane & 31, h = lane >> 5;
  const bf16_t* ZM = (const bf16_t*)(p.ws + OFF_ZM);
  const float* MG = (const float*)(p.ws + OFF_MG);
  bf16_t* Hb = (bf16_t*)(p.ws + OFF_H);
  bf16_t* Qm = (bf16_t*)smem;
  bf16_t* Km = Qm + 32 * 136;
  bf16_t* KwT = Km + 32 * 136;
  bf16_t* VT = KwT + 128 * 40;
  bf16_t* Cb = VT + 128 * 40;
  bf16_t* Pt = Cb + 4 * 32 * 136;
  float* nv = (float*)(Pt + 32 * 40);
  float* sc = nv + 128;
  float* ig = sc; float* lf = sc + 32; float* gg = sc + 64; float* mtv = sc + 96; float* wi = sc + 128; float* wsr = sc + 160; float* qn = sc + 192; float* misc = sc + 224;
  float* dnw = sc + 232;
  const float gbi = p.in[I_GB][l * 16 + (2 * d) * 4 + hh], gbf = p.in[I_GB][l * 16 + (2 * d + 1) * 4 + hh];
  f32x16 C[4];
  float m;
  __syncthreads();
  if (q.sample) {
    const size_t sb = (((size_t)q.b * 2 + l) * 2 + d) * 4 + hh;
    const float* st = p.in[I_SC] + sb * 16384;
#pragma unroll
    for (int kb = 0; kb < 4; ++kb)
#pragma unroll
      for (int g = 0; g < 16; ++g) C[kb][g] = st[(size_t)(32 * kb + crow(g, h)) * 128 + 32 * w + r];
    if (tid < 128) nv[tid] = p.in[I_SN][sb * 128 + tid];
    m = p.in[I_SM][sb];
  } else {
#pragma unroll
    for (int kb = 0; kb < 4; ++kb)
#pragma unroll
      for (int g = 0; g < 16; ++g) C[kb][g] = 0.f;
    if (tid < 128) nv[tid] = 0.f;
    m = 0.f;
  }
  const int nch = q.T / 32;
#pragma unroll 1
  for (int ch = 0; ch < nch; ++ch) {
    __syncthreads();
    {
      const int dd = tid & 127, half = tid >> 7;
#pragma unroll 4
      for (int jj = 0; jj < 16; ++jj) {
        const int j = half * 16 + jj, pos = ch * 32 + j, t = d ? q.T - 1 - pos : pos;
        const size_t rowo = (size_t)(q.base + t) * ZMW + 128 * hh + dd;
        Qm[j * 136 + dd] = ZM[rowo];
        Km[j * 136 + dd] = f2bf(bf2f(ZM[rowo + 512]) * 0.08838834764831845f);
        VT[dd * 40 + j] = ZM[rowo + 1024];
      }
      if (tid < 32) {
        const int pos = ch * 32 + tid, t = d ? q.T - 1 - pos : pos;
        const float* mg = MG + (size_t)(q.base + t) * 16;
        ig[tid] = mg[(2 * d) * 4 + hh] + gbi;
        lf[tid] = -softplusf_(-(mg[(2 * d + 1) * 4 + hh] + gbf));
      }
    }
    __syncthreads();
    if (tid < 32) { float a = 0.f; for (int i = 0; i <= tid; ++i) a += lf[i]; gg[tid] = a; }
    __syncthreads();
    if (tid < 32) {
      const float gt = gg[tid];
      float mx = gt + m;
      for (int i = 0; i <= tid; ++i) mx = fmaxf(mx, gt - gg[i] + ig[i]);
      mtv[tid] = mx; wi[tid] = __expf(gt + m - mx);
      const float gend = gg[31];
      float mn = gend + m;
      for (int i = 0; i < 32; ++i) mn = fmaxf(mn, gend - gg[i] + ig[i]);
      wsr[tid] = __expf(gend - gt + ig[tid] - mn);
      if (tid == 0) { misc[0] = mn; misc[1] = __expf(gend + m - mn); }
    }
    __syncthreads();
    {
      const int dd = tid & 127, half = tid >> 7;
#pragma unroll 4
      for (int jj = 0; jj < 16; ++jj) { const int j = half * 16 + jj; KwT[dd * 40 + j] = f2bf(bf2f(Km[j * 136 + dd]) * wsr[j]); }
      const int j = tid >> 3, seg = tid & 7;
      float a = 0.f;
#pragma unroll
      for (int i = 0; i < 16; ++i) a += bf2f(Qm[j * 136 + seg * 16 + i]) * nv[seg * 16 + i];
      a += __shfl_xor(a, 1); a += __shfl_xor(a, 2); a += __shfl_xor(a, 4);
      if (seg == 0) qn[j] = a;
    }
    const float m_new = misc[0], carry = misc[1];
    bf16_t* Cbw = Cb + w * 32 * 136; bf16_t* Ptw = Pt;
#pragma unroll
    for (int kb = 0; kb < 4; ++kb)
#pragma unroll
      for (int g = 0; g < 16; ++g) Cbw[r * 136 + 32 * kb + crow(g, h)] = f2bf(C[kb][g]);
    {
      f32x16 Sc;
#pragma unroll
      for (int g = 0; g < 16; ++g) Sc[g] = 0.f;
      mma32(Sc, Qm, 136, Km, 136, 128, lane);
      const float gs = gg[r], is = ig[r];
#pragma unroll
      for (int g = 0; g < 16; ++g) {
        const int t = crow(g, h);
        const float pv = (r <= t) ? __expf(gg[t] - gs + is - mtv[t]) * Sc[g] : 0.f;
        Ptw[t * 40 + r] = f2bf(pv);
      }
    }
    __syncthreads();
    if (lane < 32) {
      float a = 0.f;
#pragma unroll 4
      for (int i = 0; i < 32; ++i) a += bf2f(Ptw[lane * 40 + i]);
      const float den = wi[lane] * qn[lane] + a;
      dnw[lane] = 1.0f / fmaxf(fabsf(den), __expf(-mtv[lane]));
    }
    if (tid < 128) {
      float a = 0.f;
#pragma unroll 4
      for (int i = 0; i < 32; ++i) a += bf2f(KwT[tid * 40 + i]);
      nv[tid] = carry * nv[tid] + a;
    }
    __syncthreads();
    {
      f32x16 a1;
#pragma unroll
      for (int g = 0; g < 16; ++g) a1[g] = 0.f;
      mma32(a1, Qm, 136, Cbw, 136, 128, lane);
#pragma unroll
      for (int g = 0; g < 16; ++g) a1[g] *= wi[crow(g, h)];
      mma32(a1, Ptw, 40, VT + 32 * w * 40, 40, 32, lane);
#pragma unroll
      for (int g = 0; g < 16; ++g) {
        const int j = crow(g, h), pos = ch * 32 + j, t = d ? q.T - 1 - pos : pos;
        const float hv = a1[g] * dnw[j];
        Hb[(size_t)(q.base + t) * 1024 + d * 512 + 128 * hh + 32 * w + r] = f2bf(hv);
      }
#pragma unroll
      for (int kb = 0; kb < 4; ++kb) {
#pragma unroll
        for (int g = 0; g < 16; ++g) C[kb][g] *= carry;
        mma32(C[kb], KwT + 32 * kb * 40, 40, VT + 32 * w * 40, 40, 32, lane);
      }
    }
    m = m_new;
  }
  __syncthreads();
  if (!q.sample) {
    const size_t sb = (((size_t)q.b * 2 + l) * 2 + d) * 4 + hh;
    float* dst = p.out + OUT_C + sb * 16384;
#pragma unroll
    for (int kb = 0; kb < 4; ++kb)
#pragma unroll
      for (int g = 0; g < 16; ++g) dst[(size_t)(32 * kb + crow(g, h)) * 128 + 32 * w + r] = C[kb][g];
    if (tid < 128) p.out[OUT_N + sb * 128 + tid] = nv[tid];
    if (tid == 0) p.out[OUT_M + sb] = m;
  }
}

DI void phase_scan(const Params& p, int l, char* smem) {
  int* ctr = (int*)(p.ws + OFF_CTR) + l;
  int* sit = (int*)(smem + LDS_BYTES - 16);
  for (;;) {
    __syncthreads();
    if (ltid() == 0) *sit = atomicAdd(ctr, 1);
    __syncthreads();
    int it = *sit;
    if (it >= 1152) break;
    int ty, s_, hh_, d_;
    if (it < 64) { ty = 0; s_ = 32 + (it >> 4); hh_ = (it >> 1) & 7; d_ = it & 1; }
    else if (it < 96) { it -= 64; ty = 1; s_ = 32 + (it >> 3); hh_ = (it >> 1) & 3; d_ = it & 1; }
    else if (it < 128) { it -= 96; ty = 2; s_ = 32 + (it >> 3); hh_ = (it >> 1) & 3; d_ = it & 1; }
    else if (it < 640) { it -= 128; ty = 0; s_ = it >> 4; hh_ = (it >> 1) & 7; d_ = it & 1; }
    else if (it < 896) { it -= 640; ty = 1; s_ = it >> 3; hh_ = (it >> 1) & 3; d_ = it & 1; }
    else { it -= 896; ty = 2; s_ = it >> 3; hh_ = (it >> 1) & 3; d_ = it & 1; }
    if (ty == 0) rwkv_item(p, l, s_, hh_, d_, smem);
    else if (ty == 1) hgrn_item(p, l, s_, hh_, d_, smem);
    else mlstm_item(p, l, s_, hh_, d_, smem);
  }
}

DI void phase_combine(const Params& p, int l, char* smem) {
  const int tid = ltid(), lane = tid & 63, w = tid >> 6;
  bf16_t* ZH = (bf16_t*)(p.ws + OFF_ZH); bf16_t* ZM = (bf16_t*)(p.ws + OFF_ZM); const bf16_t* ZR = (const bf16_t*)(p.ws + OFF_ZR);
  bf16_t* O = (bf16_t*)(p.ws + OFF_O); const bf16_t* Hb = (const bf16_t*)(p.ws + OFF_H);
  const float* mu = p.in[I_MU] + (size_t)l * 4 * ZRW;
  const float* g2 = p.in[I_G2] + (size_t)l * 128 * 512;
  float* sg = (float*)smem;
  float* gt = sg + 128 * 16;
  for (int blk = blockIdx.x; blk < NT / 16; blk += gridDim.x) {
    const int tok0 = blk * 16;
    int sidx, t0;
    if (tok0 < 8192) { sidx = tok0 >> 8; t0 = tok0 & 255; } else { sidx = 32 + ((tok0 - 8192) >> 11); t0 = (tok0 - 8192) & 2047; }
    const Seq q = get_seq(sidx);
    __syncthreads();
    { const int j = tid >> 4, rr0 = (tid & 15) * 8; float val[8]; rw_shift8(ZR, mu, q.base, t0 + j, q.T, q.grid, 1792 + rr0, val);
#pragma unroll
      for (int e = 0; e < 8; ++e) sg[(rr0 + e) * 16 + j] = sigmoidf_(val[e]); }
    __syncthreads();
    {
      float a0[16], a1[16];
#pragma unroll
      for (int j = 0; j < 16; ++j) { a0[j] = 0.f; a1[j] = 0.f; }
#pragma unroll 1
      for (int rr = 0; rr < 128; ++rr) {
        const float w0 = g2[rr * 512 + tid], w1 = g2[rr * 512 + 256 + tid];
#pragma unroll
        for (int u = 0; u < 4; ++u) {
          f32x4 sv = *(const f32x4*)(sg + rr * 16 + 4 * u);
#pragma unroll
          for (int e = 0; e < 4; ++e) { a0[4 * u + e] += sv[e] * w0; a1[4 * u + e] += sv[e] * w1; }
        }
      }
#pragma unroll
      for (int j = 0; j < 16; ++j) { gt[j * 512 + tid] = a0[j]; gt[j * 512 + 256 + tid] = a1[j]; }
    }
    __syncthreads();
#pragma unroll 1
    for (int jj = 0; jj < 4; ++jj) {
      const int j = w * 4 + jj, tok = tok0 + j, t = t0 + j, c0 = lane * 8;
      {
        float o[8], rs[8], ks[8], vs[8];
        float sum = 0.f, bon = 0.f;
        rw_shift8(ZR, mu, q.base, t, q.T, q.grid, c0, rs);
        rw_shift8(ZR, mu, q.base, t, q.T, q.grid, 512 + c0, ks);
        rw_shift8(ZR, mu, q.base, t, q.T, q.grid, 1024 + c0, vs);
        const bf16x8 of = *(const bf16x8*)(O + (size_t)tok * 1024 + c0), ob = *(const bf16x8*)(O + (size_t)tok * 1024 + 512 + c0);
        const f32x4 rk0 = *(const f32x4*)(p.in[I_RK] + l * 512 + c0), rk1 = *(const f32x4*)(p.in[I_RK] + l * 512 + c0 + 4);
#pragma unroll
        for (int e = 0; e < 8; ++e) {
          o[e] = bf2f((bf16_t)of[e]) + bf2f((bf16_t)ob[e]);
          sum += o[e];
          bon += rs[e] * ks[e] * (e < 4 ? rk0[e & 3] : rk1[e & 3]);
        }
        sum += __shfl_xor(sum, 1); sum += __shfl_xor(sum, 2); sum += __shfl_xor(sum, 4);
        bon += __shfl_xor(bon, 1); bon += __shfl_xor(bon, 2); bon += __shfl_xor(bon, 4);
        const float mean = sum * (1.0f / 64.f);
        float var = 0.f;
#pragma unroll
        for (int e = 0; e < 8; ++e) { const float dv = o[e] - mean; var += dv * dv; }
        var += __shfl_xor(var, 1); var += __shfl_xor(var, 2); var += __shfl_xor(var, 4);
        const float rstd = rsqrtf(var * (1.0f / 64.f) + 64e-5f);
        const f32x4 lw0 = *(const f32x4*)(p.in[I_LN] + (l * 2 + 0) * 512 + c0), lw1 = *(const f32x4*)(p.in[I_LN] + (l * 2 + 0) * 512 + c0 + 4);
        const f32x4 lb0 = *(const f32x4*)(p.in[I_LN] + (l * 2 + 1) * 512 + c0), lb1 = *(const f32x4*)(p.in[I_LN] + (l * 2 + 1) * 512 + c0 + 4);
        const f32x4 gt0 = *(const f32x4*)(gt + j * 512 + c0), gt1 = *(const f32x4*)(gt + j * 512 + c0 + 4);
        bf16x8 ov;
#pragma unroll
        for (int e = 0; e < 8; ++e) {
          const float ln = (o[e] - mean) * rstd * (e < 4 ? lw0[e & 3] : lw1[e & 3]) + (e < 4 ? lb0[e & 3] : lb1[e & 3]);
          ov[e] = (short)f2bf((ln + bon * vs[e]) * (e < 4 ? gt0[e & 3] : gt1[e & 3]));
        }
        *(bf16x8*)(O + (size_t)tok * 1024 + c0) = ov;
      }
      {
        float o[8]; float ss = 0.f;
        bf16_t* zr_ = ZH + (size_t)tok * ZHW + c0;
        const bf16x8 of = *(const bf16x8*)(zr_ + 512), ob = *(const bf16x8*)(zr_ + 1024), hgv = *(const bf16x8*)(zr_ + 2048);
        const f32x4 nw0 = *(const f32x4*)(p.in[I_HNORM] + l * 512 + c0), nw1 = *(const f32x4*)(p.in[I_HNORM] + l * 512 + c0 + 4);
#pragma unroll
        for (int e = 0; e < 8; ++e) { o[e] = bf2f((bf16_t)of[e]) + bf2f((bf16_t)ob[e]); ss += o[e] * o[e]; }
        ss += __shfl_xor(ss, 1); ss += __shfl_xor(ss, 2); ss += __shfl_xor(ss, 4); ss += __shfl_xor(ss, 8);
        const float rsd = rsqrtf(ss * (1.0f / 128.f) + 1e-6f);
        bf16x8 ov;
#pragma unroll
        for (int e = 0; e < 8; ++e) ov[e] = (short)f2bf(o[e] * rsd * (e < 4 ? nw0[e & 3] : nw1[e & 3]) * siluf_(bf2f((bf16_t)hgv[e])));
        *(bf16x8*)(zr_ + 2048) = ov;
      }
      {
        float o[8]; float ss = 0.f;
        bf16_t* zm_ = ZM + (size_t)tok * ZMW + 1536 + c0;
        const bf16x8 of = *(const bf16x8*)(Hb + (size_t)tok * 1024 + c0), ob = *(const bf16x8*)(Hb + (size_t)tok * 1024 + 512 + c0), mov = *(const bf16x8*)zm_;
        const f32x4 nw0 = *(const f32x4*)(p.in[I_MNORM] + l * 512 + c0), nw1 = *(const f32x4*)(p.in[I_MNORM] + l * 512 + c0 + 4);
#pragma unroll
        for (int e = 0; e < 8; ++e) { o[e] = bf2f((bf16_t)of[e]) + bf2f((bf16_t)ob[e]); ss += o[e] * o[e]; }
        ss += __shfl_xor(ss, 1); ss += __shfl_xor(ss, 2); ss += __shfl_xor(ss, 4); ss += __shfl_xor(ss, 8);
        const float rsd = rsqrtf(ss * (1.0f / 128.f) + 1e-6f);
        bf16x8 ov;
#pragma unroll
        for (int e = 0; e < 8; ++e) ov[e] = (short)f2bf(o[e] * rsd * (e < 4 ? nw0[e & 3] : nw1[e & 3]) * sigmoidf_(bf2f((bf16_t)mov[e])));
        *(bf16x8*)zm_ = ov;
      }
    }
    __syncthreads();
#pragma unroll 1
    for (int jj = 0; jj < 4; ++jj) tok_one(p, l, 3, tok0 + w * 4 + jj, lane);
  }
}

constexpr int NPHASE = 3 + 9 * 2;
DI void run_phase(const Params& p0, int ph, char* smem) {
  Params p = p0;
  asm volatile("" : "+s"(p.ws), "+s"(p.out));
  if (ph == 0) { phase0(p, smem); return; }
  if (ph == 1) { phase1(p); return; }
  if (ph == 2) { tok_phase(p, 0, 0); return; }
  const int l = (ph - 3) / 9, s = (ph - 3) % 9;
  switch (s) {
    case 0: phase_inproj(p, smem); break;
    case 1: phase_scan(p, l, smem); break;
    case 2: phase_combine(p, l, smem); break;
    case 3: phase_merge(p, l, smem); break;
    case 4: phase_gemm_f32(p, (const bf16_t*)(p.ws + OFF_MERGED), 1024, (const bf16_t*)(p.ws + OFF_WTOUT), smem); break;
    case 5: tok_phase(p, l, 1); break;
    case 6: phase_ffn_in(p, smem); break;
    case 7: phase_gemm_f32(p, (const bf16_t*)(p.ws + OFF_ACT), DFF, (const bf16_t*)(p.ws + OFF_WTFO), smem); break;
    case 8:
      tok_phase(p, l, 2);
      if (l + 1 < 2) {
        conv_weight(p.in[I_WIN] + (size_t)(l + 1) * 1024 * DIN, DIN, (bf16_t*)(p.ws + OFF_WTIN), 1024, WTIN_ROWS, 0, (float*)smem, blockIdx.x, gridDim.x);
        for (int br = 0; br < 3; ++br) conv_weight(p.in[I_WBR] + ((size_t)(l + 1) * 3 + br) * 512 * 1024, 1024, (bf16_t*)(p.ws + OFF_WTBR) + (size_t)br * 1024 * 512, 512, 1024, 1, (float*)smem, blockIdx.x, gridDim.x);
      }
      break;
  }
}

template <bool COOP>
__global__ void __launch_bounds__(NTHR, 2) mega(Params p, int lo, int hi) {
  __shared__ __attribute__((aligned(16))) char smem[LDS_BYTES];
  for (int ph = lo; ph < hi; ++ph) {
    run_phase(p, ph, smem);
    if (COOP) { if (ph + 1 < hi) cg::this_grid().sync(); }
  }
}

extern "C" void kernel_launch(void* const* d_in, const int* in_sizes, int n_in, void* d_out, int out_size, void* d_ws, size_t ws_size, hipStream_t stream) {
  Params p{};
  for (int i = 0; i < N_IN; ++i) p.in[i] = (const float*)d_in[i];
  p.out = (float*)d_out; p.ws = (char*)d_ws;
  if (ws_size < WS_NEED) fprintf(stderr, "workspace too small: %zu < %zu\n", ws_size, (size_t)WS_NEED);
  static int grid_blocks = 0;
  if (!grid_blocks) {
    int dev = 0, cus = 0, per_cu = 0;
    hipGetDevice(&dev);
    hipDeviceGetAttribute(&cus, hipDeviceAttributeMultiprocessorCount, dev);
    hipOccupancyMaxActiveBlocksPerMultiprocessor(&per_cu, mega<true>, NTHR, 0);
    if (per_cu > 2) per_cu = 2;
    grid_blocks = cus * per_cu;
  }
  int lo = 0, hi = NPHASE;
  void* args[] = {&p, &lo, &hi};
  hipError_t e = hipLaunchCooperativeKernel((void*)mega<true>, dim3(grid_blocks), dim3(NTHR), args, 0, stream);
  if (e != hipSuccess) fprintf(stderr, "cooperative launch failed: %s (grid %d)\n", hipGetErrorString(e), grid_blocks);
}
```

```cpp
#include <hip/hip_runtime.h>
#include <hip/hip_cooperative_groups.h>
#include <cstdio>
namespace cg = cooperative_groups;

typedef unsigned short bf16_t;
typedef short bf16x8 __attribute__((ext_vector_type(8)));
typedef float f32x4 __attribute__((ext_vector_type(4)));
typedef float f32x16 __attribute__((ext_vector_type(16)));
typedef unsigned short u16x4 __attribute__((ext_vector_type(4)));
typedef unsigned short u16x2 __attribute__((ext_vector_type(2)));

#define DI __device__ __forceinline__

constexpr int NT = 16384;
constexpr int DM = 1024;
constexpr int NTHR = 256;
constexpr int DIN = 9616;
constexpr int ZHW = 2560, ZRW = 1920, ZMW = 2048;
constexpr int WTIN_ROWS = 9728;
constexpr int DFF = 2816;

constexpr size_t OFF_WTIN = 0;
constexpr size_t OFF_WTBR = OFF_WTIN + (size_t)WTIN_ROWS * 1024 * 2;
constexpr size_t OFF_H    = OFF_WTBR + (size_t)3 * 1024 * 512 * 2;
constexpr size_t OFF_ZH   = OFF_H + (size_t)NT * 1024 * 2;
constexpr size_t OFF_ZR   = OFF_ZH + (size_t)NT * ZHW * 2;
constexpr size_t OFF_ZM   = OFF_ZR + (size_t)NT * ZRW * 2;
constexpr size_t OFF_MG   = OFF_ZM + (size_t)NT * ZMW * 2;
constexpr size_t OFF_O    = OFF_MG + (size_t)NT * 16 * 4;
constexpr size_t OFF_MOD  = OFF_O + (size_t)NT * 1024 * 2;
constexpr size_t OFF_LBS  = OFF_MOD + (size_t)2 * 5 * 6144 * 4;
constexpr size_t OFF_CTR  = OFF_LBS + 2 * 512 * 4;
constexpr size_t OFF_BAR  = OFF_CTR + 256;
constexpr size_t WS_NEED  = OFF_BAR + 3456 * 4;
constexpr size_t OFF_MODP = OFF_ZH;
constexpr size_t OFF_WTOUT = OFF_ZR;
constexpr size_t OFF_WTFI  = OFF_WTOUT + (size_t)1024 * 1024 * 2;
constexpr size_t OFF_WTFO  = OFF_WTFI + (size_t)5632 * 1024 * 2;
constexpr size_t OFF_MERGED = OFF_WTFO + (size_t)1024 * 2816 * 2;
constexpr size_t OFF_Y    = OFF_ZH;
constexpr size_t OFF_ACT  = OFF_ZM;

constexpr size_t OUT_HG = 16777216, OUT_RW = 25165824, OUT_C = 29360128, OUT_N = 37748736, OUT_M = 37814272;

enum { I_XP = 0, I_XS, I_SH, I_SR, I_SC, I_SN, I_SM, I_C, I_CCTX, I_WADA, I_BADA, I_NORMS, I_WIN, I_HLB, I_HNORM, I_MU, I_W0, I_W2,
       I_A0, I_A2, I_G2, I_KK, I_KA, I_RK, I_LN, I_GB, I_MNORM, I_WBR, I_WOUT, I_WFI, I_WFO, N_IN };

struct Params { const float* in[N_IN]; float* out; char* ws; int wb; int pad_; };

constexpr int LDS_BYTES = 77824;

DI bf16_t f2bf(float f) { return __builtin_bit_cast(unsigned short, (__bf16)f); }
DI float bf2f(bf16_t h) { return __uint_as_float(((unsigned)h) << 16); }
DI float sigmoidf_(float x) { return 1.0f / (1.0f + __expf(-x)); }
DI float siluf_(float x) { return x / (1.0f + __expf(-x)); }
DI float softplusf_(float x) { return x > 20.f ? x : log1pf(__expf(x)); }
DI float wave_sum(float v) { for (int o = 32; o > 0; o >>= 1) v += __shfl_xor(v, o); return v; }
DI float dpp_xor1(float x) { return __int_as_float(__builtin_amdgcn_mov_dpp(__float_as_int(x), 0xB1, 0xF, 0xF, true)); }
DI float dpp_xor2(float x) { return __int_as_float(__builtin_amdgcn_mov_dpp(__float_as_int(x), 0x4E, 0xF, 0xF, true)); }
DI int ltid_(int wb) { int t = wb + (int)__builtin_amdgcn_mbcnt_hi(~0u, __builtin_amdgcn_mbcnt_lo(~0u, 0u)); asm volatile("" : "+v"(t)); return t; }
#define ltid() ltid_(p.wb)
DI int crow(int reg, int h) { return (reg & 3) + 8 * (reg >> 2) + 4 * h; }

DI int tok_cond(int tok) { return tok < 8192 ? 0 : 1 + ((tok - 8192) >> 11); }
DI const float* x_in_row(const Params& p, int tok) { return tok < 8192 ? p.in[I_XP] + (size_t)tok * DM : p.in[I_XS] + (size_t)(tok - 8192) * DM; }

DI void mma32(f32x16& acc, const bf16_t* A, int lda, const bf16_t* B, int ldb, int K, int lane) {
  const int r = lane & 31, h = lane >> 5;
#pragma unroll 2
  for (int kk = 0; kk < K; kk += 16) {
    bf16x8 a = *(const bf16x8*)(A + r * lda + kk + 8 * h);
    bf16x8 b = *(const bf16x8*)(B + r * ldb + kk + 8 * h);
    acc = __builtin_amdgcn_mfma_f32_32x32x16_bf16(a, b, acc, 0, 0, 0);
  }
}

template <int BN>
DI void gemm_main(const Params& p, f32x4 (&acc)[4][BN / 32], const bf16_t* __restrict__ A, int lda, const bf16_t* __restrict__ B, int ldb, int K, bf16_t* sm) {
  constexpr int NJ = BN / 32, BCH = BN / 32, LS = 72;
  const int tid = ltid(), lane = tid & 63, w = tid >> 6, wm = w >> 1, wn = w & 1;
  bf16_t* As = sm; bf16_t* Bs = sm + 2 * 128 * LS;
  bf16x8 ra[4], rb[BCH];
  const int nk = K / 64;
  const int lrow = tid >> 3, lkc = (tid & 7) * 8;
#pragma unroll
  for (int i = 0; i < 4; ++i) ra[i] = *(const bf16x8*)(A + (size_t)(lrow + 32 * i) * lda + lkc);
#pragma unroll
  for (int i = 0; i < BCH; ++i) rb[i] = *(const bf16x8*)(B + (size_t)(lrow + 32 * i) * ldb + lkc);
  __syncthreads();
#pragma unroll
  for (int i = 0; i < 4; ++i) *(bf16x8*)(As + (lrow + 32 * i) * LS + lkc) = ra[i];
#pragma unroll
  for (int i = 0; i < BCH; ++i) *(bf16x8*)(Bs + (lrow + 32 * i) * LS + lkc) = rb[i];
  __syncthreads();
  for (int kt = 0; kt < nk; ++kt) {
    const int buf = kt & 1;
    if (kt + 1 < nk) {
      const int k0 = (kt + 1) * 64 + lkc;
#pragma unroll
      for (int i = 0; i < 4; ++i) ra[i] = *(const bf16x8*)(A + (size_t)(lrow + 32 * i) * lda + k0);
#pragma unroll
      for (int i = 0; i < BCH; ++i) rb[i] = *(const bf16x8*)(B + (size_t)(lrow + 32 * i) * ldb + k0);
    }
    const bf16_t* as = As + buf * 128 * LS + (wm * 64 + (lane & 15)) * LS + (lane >> 4) * 8;
    const bf16_t* bs = Bs + buf * BN * LS + (wn * (BN / 2) + (lane & 15)) * LS + (lane >> 4) * 8;
#pragma unroll
    for (int ks = 0; ks < 2; ++ks) {
      bf16x8 af[4], bfr[NJ];
#pragma unroll
      for (int i = 0; i < 4; ++i) af[i] = *(const bf16x8*)(as + i * 16 * LS + ks * 32);
#pragma unroll
      for (int j = 0; j < NJ; ++j) bfr[j] = *(const bf16x8*)(bs + j * 16 * LS + ks * 32);
#pragma unroll
      for (int i = 0; i < 4; ++i)
#pragma unroll
        for (int j = 0; j < NJ; ++j) acc[i][j] = __builtin_amdgcn_mfma_f32_16x16x32_bf16(bfr[j], af[i], acc[i][j], 0, 0, 0);
    }
    if (kt + 1 < nk) {
      const int nb = buf ^ 1;
#pragma unroll
      for (int i = 0; i < 4; ++i) *(bf16x8*)(As + nb * 128 * LS + (lrow + 32 * i) * LS + lkc) = ra[i];
#pragma unroll
      for (int i = 0; i < BCH; ++i) *(bf16x8*)(Bs + nb * BN * LS + (lrow + 32 * i) * LS + lkc) = rb[i];
    }
    __syncthreads();
  }
}

template <int NJ> DI void zero_acc(f32x4 (&acc)[4][NJ]) {
#pragma unroll
  for (int i = 0; i < 4; ++i)
#pragma unroll
    for (int j = 0; j < NJ; ++j) acc[i][j] = (f32x4){0.f, 0.f, 0.f, 0.f};
}
DI void store_bf4(bf16_t* dst, f32x4 v) { u16x4 o; o[0] = f2bf(v[0]); o[1] = f2bf(v[1]); o[2] = f2bf(v[2]); o[3] = f2bf(v[3]); *(u16x4*)dst = o; }

DI int map_col(int mode, int n) {
  if (mode == 0) return n < 6544 ? n : (n < 6656 ? -1 : n - 112);
  if (mode == 2) return ((n >> 4) & 1) ? DFF + (n >> 5) * 16 + (n & 15) : (n >> 5) * 16 + (n & 15);
  return n;
}
DI void conv_tile(const Params& p, const float* __restrict__ src, int ld_src, bf16_t* __restrict__ dst, int K, int mode, int tk, int tn, float* sm) {
  const int tid = ltid();
  __syncthreads();
  {
    const int nn = tid & 63, col = map_col(mode, tn * 64 + nn);
#pragma unroll
    for (int i = 0; i < 16; ++i) { int kk = (tid >> 6) + 4 * i; sm[kk * 65 + nn] = col >= 0 ? src[(size_t)(tk * 64 + kk) * ld_src + col] : 0.f; }
  }
  __syncthreads();
  {
    const int kk = tid & 63;
#pragma unroll
    for (int i = 0; i < 16; ++i) { int nn = (tid >> 6) + 4 * i; dst[(size_t)(tn * 64 + nn) * K + tk * 64 + kk] = f2bf(sm[kk * 65 + nn]); }
  }
}
DI void conv_weight(const Params& p, const float* src, int ld_src, bf16_t* dst, int K, int Ndst, int mode, float* sm, int bid, int nb) {
  const int tkn = K / 64, nt = tkn * (Ndst / 64);
  for (int t = bid; t < nt; t += nb) conv_tile(p, src, ld_src, dst, K, mode, t % tkn, t / tkn, sm);
}

DI void phase0(const Params& p, char* smem) {
  const int tid = ltid(), bid = blockIdx.x, nb = gridDim.x;
  float* MODP = (float*)(p.ws + OFF_MODP);
  float* sm = (float*)smem;
  if (bid == 0) { if (tid < 64) ((int*)(p.ws + OFF_CTR))[tid] = 0; for (int i = tid; i < 3456; i += NTHR) ((unsigned*)(p.ws + OFF_BAR))[i] = 0u; }
  for (int i = bid * NTHR + tid; i < 512; i += nb * NTHR) {
    float a = p.in[I_HLB][i], b = p.in[I_HLB][512 + i];
    float* L = (float*)(p.ws + OFF_LBS); L[i] = 0.f; L[512 + i] = 1.0f / (1.0f + expf(a - b));
  }
  for (int it = bid; it < 2 * 24 * 16; it += nb) {
    const int ks = it & 15, jb = (it >> 4) % 24, l = it / (16 * 24);
    __syncthreads();
    for (int e = tid; e < 5 * 64; e += NTHR) { int ci = e >> 6, k = ks * 64 + (e & 63); float cv = ci == 0 ? p.in[I_CCTX][k] : p.in[I_C][(ci - 1) * DM + k]; sm[e] = siluf_(cv); }
    __syncthreads();
    const int j = jb * 256 + tid;
    float a0 = 0, a1 = 0, a2 = 0, a3 = 0, a4 = 0;
    const float* W = p.in[I_WADA] + ((size_t)l * DM + ks * 64) * 6144 + j;
#pragma unroll 1
    for (int k0 = 0; k0 < 64; k0 += 16) {
      float wv[16];
#pragma unroll
      for (int u = 0; u < 16; ++u) wv[u] = W[(size_t)(k0 + u) * 6144];
#pragma unroll
      for (int u = 0; u < 16; ++u) { const int k = k0 + u; const float w = wv[u]; a0 += sm[k] * w; a1 += sm[64 + k] * w; a2 += sm[128 + k] * w; a3 += sm[192 + k] * w; a4 += sm[256 + k] * w; }
    }
    float* dst = MODP + ((size_t)(ks * 2 + l) * 5) * 6144 + j;
    dst[0] = a0; dst[6144] = a1; dst[2 * 6144] = a2; dst[3 * 6144] = a3; dst[4 * 6144] = a4;
  }
  conv_weight(p, p.in[I_WIN], DIN, (bf16_t*)(p.ws + OFF_WTIN), 1024, WTIN_ROWS, 0, sm, bid, nb);
  for (int br = 0; br < 3; ++br) conv_weight(p, p.in[I_WBR] + (size_t)br * 512 * 1024, 1024, (bf16_t*)(p.ws + OFF_WTBR) + (size_t)br * 1024 * 512, 512, 1024, 1, sm, bid, nb);
}
DI void phase1(const Params& p) {
  const float* MODP = (const float*)(p.ws + OFF_MODP);
  float* MOD = (float*)(p.ws + OFF_MOD);
  for (int i = blockIdx.x * NTHR + ltid(); i < 2 * 5 * 6144; i += gridDim.x * NTHR) {
    const int j = i % 6144, l = i / (5 * 6144);
    float s = p.in[I_BADA][l * 6144 + j];
    for (int ks = 0; ks < 16; ++ks) s += MODP[(size_t)ks * 2 * 5 * 6144 + i];
    MOD[i] = s;
  }
}

DI void norm_mod_store(const f32x4 (&x)[4], const float* nw, const float* sc, const float* sh, bf16_t* hrow, int lane) {
  float ss = 0.f;
#pragma unroll
  for (int i = 0; i < 4; ++i) ss += x[i][0] * x[i][0] + x[i][1] * x[i][1] + x[i][2] * x[i][2] + x[i][3] * x[i][3];
  ss = wave_sum(ss);
  const float rs = rsqrtf(ss * (1.0f / DM) + 1e-6f);
#pragma unroll
  for (int i = 0; i < 4; ++i) {
    const int c = i * 256 + lane * 4;
    f32x4 w = *(const f32x4*)(nw + c), s1 = *(const f32x4*)(sc + c), s0 = *(const f32x4*)(sh + c), o;
#pragma unroll
    for (int e = 0; e < 4; ++e) o[e] = x[i][e] * rs * w[e] * (1.0f + s1[e]) + s0[e];
    store_bf4(hrow + c, o);
  }
}
DI void tok_one(const Params& p, int l, int mode, int tok, int lane) {
  const float* MOD = (const float*)(p.ws + OFF_MOD);
  bf16_t* H = (bf16_t*)(p.ws + OFF_H);
  const float* Y = (const float*)(p.ws + OFF_Y);
  const int ci = tok_cond(tok);
  const float* modl = MOD + (size_t)(l * 5 + ci) * 6144;
  const float* nwl = p.in[I_NORMS] + (size_t)l * 4 * DM;
  const bool from_in = (l == 0 && (mode == 0 || mode == 1 || mode == 3));
  const float* xr = from_in ? x_in_row(p, tok) : p.out + (size_t)tok * DM;
  f32x4 x[4];
#pragma unroll
  for (int i = 0; i < 4; ++i) x[i] = *(const f32x4*)(xr + i * 256 + lane * 4);
  if (mode == 1 || mode == 2) {
    f32x4 y[4]; float ss = 0.f;
#pragma unroll
    for (int i = 0; i < 4; ++i) { y[i] = *(const f32x4*)(Y + (size_t)tok * DM + i * 256 + lane * 4); ss += y[i][0] * y[i][0] + y[i][1] * y[i][1] + y[i][2] * y[i][2] + y[i][3] * y[i][3]; }
    ss = wave_sum(ss);
    const float rs = rsqrtf(ss * (1.0f / DM) + 1e-6f);
    const float* nw = nwl + (mode == 1 ? 1 : 3) * DM;
    const float* g = modl + (mode == 1 ? 2 : 5) * DM;
#pragma unroll
    for (int i = 0; i < 4; ++i) {
      const int c = i * 256 + lane * 4;
      f32x4 w = *(const f32x4*)(nw + c), gg = *(const f32x4*)(g + c);
#pragma unroll
      for (int e = 0; e < 4; ++e) x[i][e] += gg[e] * (y[i][e] * rs * w[e]);
      *(f32x4*)(p.out + (size_t)tok * DM + c) = x[i];
    }
  }
  if (mode == 0 || mode == 3) norm_mod_store(x, nwl, modl + 1 * DM, modl + 0 * DM, H + (size_t)tok * DM, lane);
  else if (mode == 1) norm_mod_store(x, nwl + 2 * DM, modl + 4 * DM, modl + 3 * DM, H + (size_t)tok * DM, lane);
  else if (mode == 2 && l + 1 < 2) {
    const float* modn = MOD + (size_t)((l + 1) * 5 + ci) * 6144;
    norm_mod_store(x, p.in[I_NORMS] + (size_t)(l + 1) * 4 * DM, modn + 1 * DM, modn + 0 * DM, H + (size_t)tok * DM, lane);
  }
}
DI void tok_phase(const Params& p, int l, int mode) {
  const int lane = ltid() & 63, gw = blockIdx.x * 4 + (ltid() >> 6), nw = gridDim.x * 4;
  for (int tok = gw; tok < NT; tok += nw) tok_one(p, l, mode, tok, lane);
}

DI void phase_inproj(const Params& p, char* smem) {
  const bf16_t* H = (const bf16_t*)(p.ws + OFF_H);
  const bf16_t* WT = (const bf16_t*)(p.ws + OFF_WTIN);
  bf16_t* ZH = (bf16_t*)(p.ws + OFF_ZH); bf16_t* ZR = (bf16_t*)(p.ws + OFF_ZR); bf16_t* ZM = (bf16_t*)(p.ws + OFF_ZM);
  float* MG = (float*)(p.ws + OFF_MG);
  const int lane = ltid() & 63, w = ltid() >> 6, wm = w >> 1, wn = w & 1;
  for (int tile = blockIdx.x; tile < 52 * 128; tile += gridDim.x) {
    const int nt = tile % 52, mt = tile / 52;
    f32x4 acc[4][4]; zero_acc<4>(acc);
    gemm_main<128>(p, acc, H + (size_t)mt * 128 * 1024, 1024, WT + (size_t)nt * 128 * 1024, 1024, 1024, (bf16_t*)smem);
    const int n0 = nt * 128;
#pragma unroll
    for (int i = 0; i < 4; ++i) {
      const int row = mt * 128 + wm * 64 + i * 16 + (lane & 15);
#pragma unroll
      for (int j = 0; j < 4; ++j) {
        const int col = n0 + wn * 64 + j * 16 + 4 * (lane >> 4);
        if (n0 < 2560) store_bf4(ZH + (size_t)row * ZHW + col, acc[i][j]);
        else if (n0 < 4480) store_bf4(ZR + (size_t)row * ZRW + (col - 2560), acc[i][j]);
        else if (n0 < 6528) store_bf4(ZM + (size_t)row * ZMW + (col - 4480), acc[i][j]);
        else if (col - 6528 < 16) *(f32x4*)(MG + (size_t)row * 16 + (col - 6528)) = acc[i][j];
      }
    }
  }
}

DI void phase_merge(const Params& p, int l, char* smem) {
  const bf16_t* H = (const bf16_t*)(p.ws + OFF_H);
  const bf16_t* WT = (const bf16_t*)(p.ws + OFF_WTIN);
  const bf16_t* WBR = (const bf16_t*)(p.ws + OFF_WTBR);
  const bf16_t* ZH = (const bf16_t*)(p.ws + OFF_ZH); const bf16_t* ZM = (const bf16_t*)(p.ws + OFF_ZM); const bf16_t* O = (const bf16_t*)(p.ws + OFF_O);
  bf16_t* MER = (bf16_t*)(p.ws + OFF_MERGED);
  const int lane = ltid() & 63, w = ltid() >> 6, wm = w >> 1, wn = w & 1;
  for (int tile = blockIdx.x; tile < 16 * 128; tile += gridDim.x) {
    const int nt = tile % 16, mt = tile / 16;
    f32x4 accM[4][2]; zero_acc<2>(accM);
#pragma unroll 1
    for (int br = 0; br < 3; ++br) {
      f32x4 accG[4][2], accP[4][2]; zero_acc<2>(accG); zero_acc<2>(accP);
      gemm_main<64>(p, accG, H + (size_t)mt * 128 * 1024, 1024, WT + (size_t)(6656 + br * 1024 + nt * 64) * 1024, 1024, 1024, (bf16_t*)smem);
      const bf16_t* Ab; int lda;
      if (br == 0) { Ab = ZH + 2048; lda = ZHW; } else if (br == 1) { Ab = O; lda = 1024; } else { Ab = ZM + 1536; lda = ZMW; }
      gemm_main<64>(p, accP, Ab + (size_t)mt * 128 * lda, lda, WBR + ((size_t)br * 1024 + nt * 64) * 512, 512, 512, (bf16_t*)smem);
#pragma unroll
      for (int i = 0; i < 4; ++i)
#pragma unroll
        for (int j = 0; j < 2; ++j)
#pragma unroll
          for (int e = 0; e < 4; ++e) accM[i][j][e] += sigmoidf_(accG[i][j][e]) * accP[i][j][e];
    }
#pragma unroll
    for (int i = 0; i < 4; ++i) {
      const int row = mt * 128 + wm * 64 + i * 16 + (lane & 15);
#pragma unroll
      for (int j = 0; j < 2; ++j) store_bf4(MER + (size_t)row * 1024 + nt * 64 + wn * 32 + j * 16 + 4 * (lane >> 4), accM[i][j]);
    }
  }
  float* sm = (float*)smem;
  conv_weight(p, p.in[I_WOUT] + (size_t)l * 1024 * 1024, 1024, (bf16_t*)(p.ws + OFF_WTOUT), 1024, 1024, 1, sm, blockIdx.x, gridDim.x);
  conv_weight(p, p.in[I_WFI] + (size_t)l * 1024 * 5632, 5632, (bf16_t*)(p.ws + OFF_WTFI), 1024, 5632, 2, sm, blockIdx.x, gridDim.x);
  conv_weight(p, p.in[I_WFO] + (size_t)l * DFF * 1024, 1024, (bf16_t*)(p.ws + OFF_WTFO), DFF, 1024, 1, sm, blockIdx.x, gridDim.x);
}

DI void phase_gemm_f32(const Params& p, const bf16_t* A, int K, const bf16_t* Wt, char* smem) {
  float* Y = (float*)(p.ws + OFF_Y);
  const int lane = ltid() & 63, w = ltid() >> 6, wm = w >> 1, wn = w & 1;
  for (int tile = blockIdx.x; tile < 8 * 128; tile += gridDim.x) {
    const int nt = tile % 8, mt = tile / 8;
    f32x4 acc[4][4]; zero_acc<4>(acc);
    gemm_main<128>(p, acc, A + (size_t)mt * 128 * K, K, Wt + (size_t)nt * 128 * K, K, K, (bf16_t*)smem);
#pragma unroll
    for (int i = 0; i < 4; ++i) {
      const int row = mt * 128 + wm * 64 + i * 16 + (lane & 15);
#pragma unroll
      for (int j = 0; j < 4; ++j) *(f32x4*)(Y + (size_t)row * 1024 + nt * 128 + wn * 64 + j * 16 + 4 * (lane >> 4)) = acc[i][j];
    }
  }
}
DI void phase_ffn_in(const Params& p, char* smem) {
  const bf16_t* H = (const bf16_t*)(p.ws + OFF_H);
  const bf16_t* Wt = (const bf16_t*)(p.ws + OFF_WTFI);
  bf16_t* ACT = (bf16_t*)(p.ws + OFF_ACT);
  const int lane = ltid() & 63, w = ltid() >> 6, wm = w >> 1, wn = w & 1;
  for (int tile = blockIdx.x; tile < 44 * 128; tile += gridDim.x) {
    const int nt = tile % 44, mt = tile / 44;
    f32x4 acc[4][4]; zero_acc<4>(acc);
    gemm_main<128>(p, acc, H + (size_t)mt * 128 * 1024, 1024, Wt + (size_t)nt * 128 * 1024, 1024, 1024, (bf16_t*)smem);
#pragma unroll
    for (int i = 0; i < 4; ++i) {
      const int row = mt * 128 + wm * 64 + i * 16 + (lane & 15);
#pragma unroll
      for (int jj = 0; jj < 2; ++jj) {
        f32x4 u = acc[i][2 * jj], g = acc[i][2 * jj + 1], o;
#pragma unroll
        for (int e = 0; e < 4; ++e) o[e] = siluf_(g[e]) * u[e];
        const int col = (nt * 128 + wn * 64 + jj * 32) / 2 + 4 * (lane >> 4);
        store_bf4(ACT + (size_t)row * DFF + col, o);
      }
    }
  }
}

struct Seq { int base, T, grid, b; bool sample; };
DI Seq get_seq(int s) { Seq q; if (s < 32) { q.base = s * 256; q.T = 256; q.grid = 0; q.b = s; q.sample = false; } else { q.b = s - 32; q.base = 8192 + q.b * 2048; q.T = 2048; q.grid = 1; q.sample = true; } return q; }

DI float rw_shift(const bf16_t* ZR, const float* mu, int base, int t, int T, int grid, int col) {
  const bf16_t* pp = ZR + (size_t)(base + t) * ZRW + col;
  const float y = bf2f(*pp);
  if (!grid) {
    const float prev = t > 0 ? bf2f(pp[-ZRW]) : 0.f, nxt = t < T - 1 ? bf2f(pp[ZRW]) : 0.f;
    return y + mu[col] * (prev - y) + mu[ZRW + col] * (nxt - y);
  }
  const int gc = t & 63, gr = t >> 6;
  const float left = gc > 0 ? bf2f(pp[-ZRW]) : 0.f, right = gc < 63 ? bf2f(pp[ZRW]) : 0.f;
  const float up = gr > 0 ? bf2f(pp[-64 * ZRW]) : 0.f, down = gr < 31 ? bf2f(pp[64 * ZRW]) : 0.f;
  return y + mu[col] * (left - y) + mu[ZRW + col] * (right - y) + mu[2 * ZRW + col] * (up - y) + mu[3 * ZRW + col] * (down - y);
}

DI void rw_shift8(const bf16_t* ZR, const float* mu, int base, int t, int T, int grid, int col0, float (&out)[8]) {
  const bf16_t* pp = ZR + (size_t)(base + t) * ZRW + col0;
  const bf16x8 y = *(const bf16x8*)pp;
  float yv[8];
#pragma unroll
  for (int e = 0; e < 8; ++e) { yv[e] = bf2f((bf16_t)y[e]); out[e] = yv[e]; }
  const int nn = grid ? 4 : 2;
#pragma unroll 1
  for (int n = 0; n < nn; ++n) {
    bool valid; int off;
    if (!grid) { valid = n == 0 ? t > 0 : t < T - 1; off = n == 0 ? -ZRW : ZRW; }
    else { const int gc = t & 63, gr = t >> 6; valid = n == 0 ? gc > 0 : n == 1 ? gc < 63 : n == 2 ? gr > 0 : gr < 31; off = n == 0 ? -ZRW : n == 1 ? ZRW : n == 2 ? -64 * ZRW : 64 * ZRW; }
    const f32x4 m0 = *(const f32x4*)(mu + n * ZRW + col0), m1 = *(const f32x4*)(mu + n * ZRW + col0 + 4);
    bf16x8 nb = y;
    if (valid) nb = *(const bf16x8*)(pp + off);
#pragma unroll
    for (int e = 0; e < 8; ++e) { const float nv_ = valid ? bf2f((bf16_t)nb[e]) : 0.f; const float mm = e < 4 ? m0[e & 3] : m1[e & 3]; out[e] += mm * (nv_ - yv[e]); }
  }
}

DI void rw_load8(const bf16_t* ZR, int base, int t, int T, int grid, int col0, bf16x8 (&v)[5]) {
  const bf16_t* pp = ZR + (size_t)(base + t) * ZRW + col0;
  const bf16x8 z = (bf16x8){0, 0, 0, 0, 0, 0, 0, 0};
  v[0] = *(const bf16x8*)pp;
  if (!grid) {
    v[1] = t > 0 ? *(const bf16x8*)(pp - ZRW) : z; v[2] = t < T - 1 ? *(const bf16x8*)(pp + ZRW) : z; v[3] = z; v[4] = z;
  } else {
    const int gc = t & 63, gr = t >> 6;
    v[1] = gc > 0 ? *(const bf16x8*)(pp - ZRW) : z; v[2] = gc < 63 ? *(const bf16x8*)(pp + ZRW) : z;
    v[3] = gr > 0 ? *(const bf16x8*)(pp - 64 * ZRW) : z; v[4] = gr < 31 ? *(const bf16x8*)(pp + 64 * ZRW) : z;
  }
}
DI void rw_apply8(const bf16x8 (&v)[5], const float* mu, int grid, int col0, float (&out)[8]) {
  float yv[8];
#pragma unroll
  for (int e = 0; e < 8; ++e) { yv[e] = bf2f((bf16_t)v[0][e]); out[e] = yv[e]; }
#pragma unroll
  for (int n = 0; n < 4; ++n) {
    if (n < 2 || grid) {
      const f32x4 m0 = *(const f32x4*)(mu + n * ZRW + col0), m1 = *(const f32x4*)(mu + n * ZRW + col0 + 4);
#pragma unroll
      for (int e = 0; e < 8; ++e) out[e] += (e < 4 ? m0[e & 3] : m1[e & 3]) * (bf2f((bf16_t)v[1 + n][e]) - yv[e]);
    }
  }
}

DI float dpp_ror8(float x) { return __int_as_float(__builtin_amdgcn_mov_dpp(__float_as_int(x), 0x128, 0xF, 0xF, true)); }
DI float dpp_ror4(float x) { return __int_as_float(__builtin_amdgcn_mov_dpp(__float_as_int(x), 0x124, 0xF, 0xF, true)); }
DI float fast_tanh(float x) { return 1.0f - 2.0f / (1.0f + __expf(2.0f * x)); }

template <int KPL>
DI void rwkv_item(const Params& p, int l, int s, int hh, int d, int rb, char* smem) {
  constexpr int LPR = 64 / KPL, RPB = NTHR / LPR;
  const Seq q = get_seq(s);
  const int tid = ltid(), lane = tid & 63, w = tid >> 6;
  const bf16_t* ZR = (const bf16_t*)(p.ws + OFF_ZR);
  bf16_t* O = (bf16_t*)(p.ws + OFF_O);
  const float* mu = p.in[I_MU] + (size_t)l * 4 * ZRW;
  bf16_t* Wb2 = (bf16_t*)smem;
  bf16_t* Ab2 = Wb2 + 64 * 72;
  bf16_t* actW = Ab2 + 64 * 72;
  bf16_t* actA = actW + 16 * 72;
  float* sh = (float*)(actA + 16 * 72);
  float* vW = sh + 3 * 1024;
  float* vKK = vW + 1024; float* vKKA = vKK + 1024; float* vKD = vKKA + 1024; float* outb = vKD + 1024;
  float* part = outb + 1024;
  __syncthreads();
  for (int e = tid; e < 4096; e += NTHR) {
    const int i = e >> 6, c = e & 63;
    Wb2[c * 72 + i] = f2bf(p.in[I_W2][((size_t)(l * 2 + d) * 64 + i) * 512 + 64 * hh + c]);
    Ab2[c * 72 + i] = f2bf(p.in[I_A2][((size_t)(l * 2 + d) * 64 + i) * 512 + 64 * hh + c]);
  }
  const int cB = 16 * w + (lane & 15), qB = lane >> 4;
  const float w0c = p.in[I_W0][(l * 2 + d) * 512 + 64 * hh + cB], a0c = p.in[I_A0][(l * 2 + d) * 512 + 64 * hh + cB];
  const float kkc = p.in[I_KK][l * 512 + 64 * hh + cB], kac = p.in[I_KA][l * 512 + 64 * hh + cB];
  const int rowl = tid / LPR, row = rb * RPB + rowl, kb0 = (tid % LPR) * KPL;
  float S[KPL];
  if (q.sample) {
    const float* st = p.in[I_SR] + ((((size_t)q.b * 2 + l) * 2 + d) * 8 + hh) * 4096 + row * 64 + kb0;
#pragma unroll
    for (int i = 0; i < KPL; ++i) S[i] = st[i];
  } else {
#pragma unroll
    for (int i = 0; i < KPL; ++i) S[i] = 0.f;
  }
  __syncthreads();
  bf16x8 bW[2], bA[2];
#pragma unroll
  for (int ks = 0; ks < 2; ++ks) { bW[ks] = *(const bf16x8*)(Wb2 + cB * 72 + ks * 32 + qB * 8); bA[ks] = *(const bf16x8*)(Ab2 + cB * 72 + ks * 32 + qB * 8); }
  const int nch = q.T / 16;
  bf16x8 pf[3][5];
#define RW_COL(arr, c8) ((arr) == 0 ? 64 * hh + (c8) : (arr) == 1 ? 512 + 64 * hh + (c8) : (arr) == 2 ? 1024 + 64 * hh + (c8) : (arr) == 3 ? 1536 + 64 * d + (c8) : 1664 + 64 * d + (c8))
#define RW_ISSUE(chn) { _Pragma("unroll") for (int gi = 0; gi < 3; ++gi) { const int g = tid + gi * NTHR; if (g < 640) { \
      const int arr = g >> 7, rem = g & 127, j = rem >> 3, c8 = (rem & 7) * 8; const int pos = (chn) * 16 + j, t = d ? q.T - 1 - pos : pos; \
      rw_load8(ZR, q.base, t, q.T, q.grid, RW_COL(arr, c8), pf[gi]); } } }
  RW_ISSUE(0)
#pragma unroll 1
  for (int ch = 0; ch < nch; ++ch) {
    __syncthreads();
#pragma unroll
    for (int gi = 0; gi < 3; ++gi) {
      const int g = tid + gi * NTHR;
      if (g < 640) {
        const int arr = g >> 7, rem = g & 127, j = rem >> 3, c8 = (rem & 7) * 8;
        float val[8];
        rw_apply8(pf[gi], mu, q.grid, RW_COL(arr, c8), val);
        if (arr < 3) {
          *(f32x4*)(sh + arr * 1024 + j * 64 + c8) = (f32x4){val[0], val[1], val[2], val[3]};
          *(f32x4*)(sh + arr * 1024 + j * 64 + c8 + 4) = (f32x4){val[4], val[5], val[6], val[7]};
        } else {
          bf16x8 o8;
#pragma unroll
          for (int e = 0; e < 8; ++e) o8[e] = (short)f2bf(arr == 3 ? fast_tanh(val[e]) : val[e]);
          *(bf16x8*)((arr == 3 ? actW : actA) + j * 72 + c8) = o8;
        }
      }
    }
    if (ch + 1 < nch) RW_ISSUE(ch + 1)
    __syncthreads();
    {
      f32x4 aw = (f32x4){0.f, 0.f, 0.f, 0.f}, aa = (f32x4){0.f, 0.f, 0.f, 0.f};
#pragma unroll
      for (int ks = 0; ks < 2; ++ks) {
        const bf16x8 fw = *(const bf16x8*)(actW + (lane & 15) * 72 + ks * 32 + qB * 8);
        const bf16x8 fa = *(const bf16x8*)(actA + (lane & 15) * 72 + ks * 32 + qB * 8);
        aw = __builtin_amdgcn_mfma_f32_16x16x32_bf16(fw, bW[ks], aw, 0, 0, 0);
        aa = __builtin_amdgcn_mfma_f32_16x16x32_bf16(fa, bA[ks], aa, 0, 0, 0);
      }
      float ssq[4];
#pragma unroll
      for (int jj = 0; jj < 4; ++jj) {
        const int j = qB * 4 + jj;
        const float wl = aw[jj] + w0c, al = aa[jj] + a0c;
        const float wlog = -softplusf_(-wl) - 0.5f;
        const float decay = __expf(-__expf(wlog));
        const float a = sigmoidf_(al);
        const float k = sh[1024 + j * 64 + cB];
        const float kkr = k * kkc;
        ssq[jj] = kkr * kkr;
        vW[j * 64 + cB] = decay; vKK[j * 64 + cB] = kkr; vKKA[j * 64 + cB] = kkr * a; vKD[j * 64 + cB] = k * (1.0f + (a - 1.0f) * kac);
      }
#pragma unroll
      for (int jj = 0; jj < 4; ++jj) { float v_ = ssq[jj]; v_ += dpp_ror8(v_); v_ += dpp_ror4(v_); v_ += dpp_xor2(v_); v_ += dpp_xor1(v_); ssq[jj] = v_; }
      if ((lane & 15) == 0) {
#pragma unroll
        for (int jj = 0; jj < 4; ++jj) part[w * 16 + qB * 4 + jj] = ssq[jj];
      }
    }
    __syncthreads();
#pragma unroll 1
    for (int j = 0; j < 16; ++j) {
      const float inv2 = 1.0f / fmaxf(part[j] + part[16 + j] + part[32 + j] + part[48 + j], 1e-24f);
      const float vv = sh[2048 + j * 64 + row];
      float kk[KPL], ww[KPL], ka[KPL], kd[KPL], rr[KPL];
#pragma unroll
      for (int u = 0; u < KPL / 4; ++u) {
        const int o = j * 64 + kb0 + 4 * u;
        f32x4 t0 = *(const f32x4*)(vKK + o), t1 = *(const f32x4*)(vW + o), t2 = *(const f32x4*)(vKKA + o), t3 = *(const f32x4*)(vKD + o), t4 = *(const f32x4*)(sh + o);
#pragma unroll
        for (int e = 0; e < 4; ++e) { kk[4 * u + e] = t0[e]; ww[4 * u + e] = t1[e]; ka[4 * u + e] = t2[e]; kd[4 * u + e] = t3[e]; rr[4 * u + e] = t4[e]; }
      }
      float dp[4] = {0.f, 0.f, 0.f, 0.f};
#pragma unroll
      for (int i = 0; i < KPL; ++i) dp[i & 3] += S[i] * kk[i];
      float dot = (dp[0] + dp[1]) + (dp[2] + dp[3]);
      if (LPR == 16) { dot += dpp_ror8(dot); dot += dpp_ror4(dot); }
      dot += dpp_xor2(dot); dot += dpp_xor1(dot);
      const float sa = -dot * inv2;
      float op[4] = {0.f, 0.f, 0.f, 0.f};
#pragma unroll
      for (int i = 0; i < KPL; ++i) { S[i] = S[i] * ww[i] + sa * ka[i] + vv * kd[i]; op[i & 3] += S[i] * rr[i]; }
      float od = (op[0] + op[1]) + (op[2] + op[3]);
      if (LPR == 16) { od += dpp_ror8(od); od += dpp_ror4(od); }
      od += dpp_xor2(od); od += dpp_xor1(od);
      if ((tid % LPR) == 0) outb[j * RPB + rowl] = od;
    }
    __syncthreads();
    for (int e = tid; e < 16 * RPB; e += NTHR) {
      const int j = e / RPB, c = e % RPB, pos = ch * 16 + j, t = d ? q.T - 1 - pos : pos;
      O[(size_t)(q.base + t) * 1024 + d * 512 + 64 * hh + rb * RPB + c] = f2bf(outb[e]);
    }
  }
  if (!q.sample) {
    float* dst = p.out + OUT_RW + ((((size_t)q.b * 2 + l) * 2 + d) * 8 + hh) * 4096 + row * 64 + kb0;
#pragma unroll
    for (int i = 0; i < KPL; ++i) dst[i] = S[i];
  }
}

DI void hgrn_item(const Params& p, int l, int s, int hh, int d, char* smem) {
  const Seq q = get_seq(s);
  const int tid = ltid(), lane = tid & 63, w = tid >> 6, r = lane & 31, h = lane >> 5;
  bf16_t* ZH = (bf16_t*)(p.ws + OFF_ZH);
  bf16_t* Qt = (bf16_t*)smem;
  bf16_t* Kt = Qt + 32 * 136;
  bf16_t* KhT = Kt + 32 * 136;
  bf16_t* VT = KhT + 128 * 40;
  bf16_t* Sb = VT + 128 * 40;
  bf16_t* At = Sb + 4 * 32 * 136;
  float* dL = (float*)(At + 32 * 40);
  float* tot = dL + 128;
  const float lb = ((const float*)(p.ws + OFF_LBS))[l * 512 + 128 * hh + (tid & 127)];
  f32x16 S[4];
  if (q.sample) {
    const float* st = p.in[I_SH] + ((((size_t)q.b * 2 + l) * 2 + d) * 4 + hh) * 16384;
#pragma unroll
    for (int kb = 0; kb < 4; ++kb)
#pragma unroll
      for (int g = 0; g < 16; ++g) S[kb][g] = st[(size_t)(32 * kb + crow(g, h)) * 128 + 32 * w + r];
  } else {
#pragma unroll
    for (int kb = 0; kb < 4; ++kb)
#pragma unroll
      for (int g = 0; g < 16; ++g) S[kb][g] = 0.f;
  }
  const int k = tid & 127, half = tid >> 7;
  const int nch = q.T / 32;
  u16x2 pzq[16], pv2[8];
#define HG_ISSUE(chn) { _Pragma("unroll") for (int jj = 0; jj < 16; ++jj) { const int pos = (chn) * 32 + half * 16 + jj, t = d ? q.T - 1 - pos : pos; \
      const size_t rowo = (size_t)(q.base + t) * ZHW + 128 * hh + k; pzq[jj][0] = ZH[rowo + 512 * (1 + d)]; pzq[jj][1] = ZH[rowo]; pv2[jj >> 1][jj & 1] = ZH[rowo + 1536]; } }
  HG_ISSUE(0)
#pragma unroll 1
  for (int ch = 0; ch < nch; ++ch) {
    __syncthreads();
    float bl[16], kc[16], qs[16];
    {
      float b = 0.f;
#pragma unroll
      for (int jj = 0; jj < 16; ++jj) {
        const float z = bf2f(pzq[jj][0]);
        const float kcoef = (1.0f - lb) * sigmoidf_(-z);
        const float f = 1.0f - kcoef;
        b += fmaxf(__logf(f), -80.f);
        bl[jj] = b; kc[jj] = kcoef; qs[jj] = bf2f(pzq[jj][1]) * 0.08838834764831845f;
        VT[k * 40 + half * 16 + jj] = pv2[jj >> 1][jj & 1];
      }
      tot[half * 128 + k] = b;
    }
    if (ch + 1 < nch) HG_ISSUE(ch + 1)
    __syncthreads();
    {
      const float off = half ? tot[k] : 0.f;
      const float bL = fmaxf(tot[k] + tot[128 + k], -80.f);
      if (half == 0) dL[k] = __expf(bL);
#pragma unroll
      for (int jj = 0; jj < 16; ++jj) {
        const int j = half * 16 + jj;
        const float bj = fmaxf(off + bl[jj], -80.f);
        Qt[j * 136 + k] = f2bf(qs[jj] * __expf(bj));
        Kt[j * 136 + k] = f2bf(kc[jj] * __expf(-bj));
        KhT[k * 40 + j] = f2bf(kc[jj] * __expf(fminf(bL - bj, 0.f)));
      }
    }
    bf16_t* Sbw = Sb + w * 32 * 136;
#pragma unroll
    for (int kb = 0; kb < 4; ++kb)
#pragma unroll
      for (int g = 0; g < 16; ++g) Sbw[r * 136 + 32 * kb + crow(g, h)] = f2bf(S[kb][g]);
    __syncthreads();
    bf16_t* Atw = At;
    {
      f32x16 A;
#pragma unroll
      for (int g = 0; g < 16; ++g) A[g] = 0.f;
      mma32(A, Qt, 136, Kt, 136, 128, lane);
#pragma unroll
      for (int g = 0; g < 16; ++g) { const int t = crow(g, h); Atw[t * 40 + r] = f2bf(r <= t ? A[g] : 0.f); }
    }
    __syncthreads();
    {
      f32x16 o;
#pragma unroll
      for (int g = 0; g < 16; ++g) o[g] = 0.f;
      mma32(o, Atw, 40, VT + 32 * w * 40, 40, 32, lane);
      mma32(o, Qt, 136, Sbw, 136, 128, lane);
#pragma unroll
      for (int g = 0; g < 16; ++g) {
        const int j = crow(g, h), pos = ch * 32 + j, t = d ? q.T - 1 - pos : pos;
        ZH[(size_t)(q.base + t) * ZHW + 512 * (1 + d) + 128 * hh + 32 * w + r] = f2bf(o[g]);
      }
#pragma unroll
      for (int kb = 0; kb < 4; ++kb) {
#pragma unroll
        for (int g = 0; g < 16; ++g) S[kb][g] *= dL[32 * kb + crow(g, h)];
        mma32(S[kb], KhT + 32 * kb * 40, 40, VT + 32 * w * 40, 40, 32, lane);
      }
    }
  }
  if (!q.sample) {
    float* dst = p.out + OUT_HG + ((((size_t)q.b * 2 + l) * 2 + d) * 4 + hh) * 16384;
#pragma unroll
    for (int kb = 0; kb < 4; ++kb)
#pragma unroll
      for (int g = 0; g < 16; ++g) dst[(size_t)(32 * kb + crow(g, h)) * 128 + 32 * w + r] = S[kb][g];
  }
}

DI void mlstm_item(const Params& p, int l, int s, int hh, int d, char* smem) {
  const Seq q = get_seq(s);
  const int tid = ltid(), lane = tid & 63, w = tid >> 6, r = lane & 31, h = lane >> 5;
  const bf16_t* ZM = (const bf16_t*)(p.ws + OFF_ZM);
  const float* MG = (const float*)(p.ws + OFF_MG);
  bf16_t* Hb = (bf16_t*)(p.ws + OFF_H);
  bf16_t* Qm = (bf16_t*)smem;
  bf16_t* Km = Qm + 32 * 136;
  bf16_t* KwT = Km + 32 * 136;
  bf16_t* VT = KwT + 128 * 40;
  bf16_t* Cb = VT + 128 * 40;
  bf16_t* Pt = Cb + 4 * 32 * 136;
  float* nv = (float*)(Pt + 32 * 40);
  float* sc = nv + 128;
  float* ig = sc; float* lf = sc + 32; float* gg = sc + 64; float* mtv = sc + 96; float* wi = sc + 128; float* wsr = sc + 160; float* qn = sc + 192; float* misc = sc + 224;
  float* dnw = sc + 232;
  const float gbi = p.in[I_GB][l * 16 + (2 * d) * 4 + hh], gbf = p.in[I_GB][l * 16 + (2 * d + 1) * 4 + hh];
  f32x16 C[4];
  float m;
  __syncthreads();
  if (q.sample) {
    const size_t sb = (((size_t)q.b * 2 + l) * 2 + d) * 4 + hh;
    const float* st = p.in[I_SC] + sb * 16384;
#pragma unroll
    for (int kb = 0; kb < 4; ++kb)
#pragma unroll
      for (int g = 0; g < 16; ++g) C[kb][g] = st[(size_t)(32 * kb + crow(g, h)) * 128 + 32 * w + r];
    if (tid < 128) nv[tid] = p.in[I_SN][sb * 128 + tid];
    m = p.in[I_SM][sb];
  } else {
#pragma unroll
    for (int kb = 0; kb < 4; ++kb)
#pragma unroll
      for (int g = 0; g < 16; ++g) C[kb][g] = 0.f;
    if (tid < 128) nv[tid] = 0.f;
    m = 0.f;
  }
  const int nch = q.T / 32;
  const int dd = tid & 127, half = tid >> 7;
  u16x2 pqk[16], pv2[8]; float pgi = 0.f, pgf = 0.f;
#define ML_ISSUE(chn) { _Pragma("unroll") for (int jj = 0; jj < 16; ++jj) { const int pos = (chn) * 32 + half * 16 + jj, t = d ? q.T - 1 - pos : pos; \
      const size_t rowo = (size_t)(q.base + t) * ZMW + 128 * hh + dd; pqk[jj][0] = ZM[rowo]; pqk[jj][1] = ZM[rowo + 512]; pv2[jj >> 1][jj & 1] = ZM[rowo + 1024]; } \
    if (tid < 32) { const int pos = (chn) * 32 + tid, t = d ? q.T - 1 - pos : pos; const float* mg = MG + (size_t)(q.base + t) * 16; pgi = mg[(2 * d) * 4 + hh]; pgf = mg[(2 * d + 1) * 4 + hh]; } }
  ML_ISSUE(0)
#pragma unroll 1
  for (int ch = 0; ch < nch; ++ch) {
    __syncthreads();
    {
#pragma unroll
      for (int jj = 0; jj < 16; ++jj) {
        const int j = half * 16 + jj;
        Qm[j * 136 + dd] = pqk[jj][0];
        Km[j * 136 + dd] = f2bf(bf2f(pqk[jj][1]) * 0.08838834764831845f);
        VT[dd * 40 + j] = pv2[jj >> 1][jj & 1];
      }
      if (tid < 32) {
        const float igv = pgi + gbi;
        const float lfv = -softplusf_(-(pgf + gbf));
        float g = lfv;
#pragma unroll
        for (int o = 1; o < 32; o <<= 1) { const float tt = __shfl_up(g, o); if (tid >= o) g += tt; }
        const float cs = igv - g;
        float pm = cs;
#pragma unroll
        for (int o = 1; o < 32; o <<= 1) { const float tt = __shfl_up(pm, o); if (tid >= o) pm = fmaxf(pm, tt); }
        const float mt = g + fmaxf(m, pm);
        const float gend = __shfl(g, 31), mn = __shfl(mt, 31);
        ig[tid] = igv; gg[tid] = g; mtv[tid] = mt; wi[tid] = __expf(g + m - mt);
        wsr[tid] = __expf(gend + cs - mn);
        if (tid == 0) { misc[0] = mn; misc[1] = __expf(gend + m - mn); }
      }
    }
    if (ch + 1 < nch) ML_ISSUE(ch + 1)
    __syncthreads();
    {
#pragma unroll 4
      for (int jj = 0; jj < 16; ++jj) { const int j = half * 16 + jj; KwT[dd * 40 + j] = f2bf(bf2f(Km[j * 136 + dd]) * wsr[j]); }
      const int j = tid >> 3, seg = tid & 7;
      float a = 0.f;
#pragma unroll
      for (int i = 0; i < 16; ++i) a += bf2f(Qm[j * 136 + seg * 16 + i]) * nv[seg * 16 + i];
      a += __shfl_xor(a, 1); a += __shfl_xor(a, 2); a += __shfl_xor(a, 4);
      if (seg == 0) qn[j] = a;
    }
    const float m_new = misc[0], carry = misc[1];
    bf16_t* Cbw = Cb + w * 32 * 136; bf16_t* Ptw = Pt;
#pragma unroll
    for (int kb = 0; kb < 4; ++kb)
#pragma unroll
      for (int g = 0; g < 16; ++g) Cbw[r * 136 + 32 * kb + crow(g, h)] = f2bf(C[kb][g]);
    {
      f32x16 Sc;
#pragma unroll
      for (int g = 0; g < 16; ++g) Sc[g] = 0.f;
      mma32(Sc, Qm, 136, Km, 136, 128, lane);
      const float gs = gg[r], is = ig[r];
#pragma unroll
      for (int g = 0; g < 16; ++g) {
        const int t = crow(g, h);
        const float pv = (r <= t) ? __expf(gg[t] - gs + is - mtv[t]) * Sc[g] : 0.f;
        Ptw[t * 40 + r] = f2bf(pv);
      }
    }
    __syncthreads();
    if (lane < 32) {
      float a = 0.f;
#pragma unroll 4
      for (int i = 0; i < 32; ++i) a += bf2f(Ptw[lane * 40 + i]);
      const float den = wi[lane] * qn[lane] + a;
      dnw[lane] = 1.0f / fmaxf(fabsf(den), __expf(-mtv[lane]));
    }
    if (tid < 128) {
      float a = 0.f;
#pragma unroll 4
      for (int i = 0; i < 32; ++i) a += bf2f(KwT[tid * 40 + i]);
      nv[tid] = carry * nv[tid] + a;
    }
    __syncthreads();
    {
      f32x16 a1;
#pragma unroll
      for (int g = 0; g < 16; ++g) a1[g] = 0.f;
      mma32(a1, Qm, 136, Cbw, 136, 128, lane);
#pragma unroll
      for (int g = 0; g < 16; ++g) a1[g] *= wi[crow(g, h)];
      mma32(a1, Ptw, 40, VT + 32 * w * 40, 40, 32, lane);
#pragma unroll
      for (int g = 0; g < 16; ++g) {
        const int j = crow(g, h), pos = ch * 32 + j, t = d ? q.T - 1 - pos : pos;
        const float hv = a1[g] * dnw[j];
        Hb[(size_t)(q.base + t) * 1024 + d * 512 + 128 * hh + 32 * w + r] = f2bf(hv);
      }
#pragma unroll
      for (int kb = 0; kb < 4; ++kb) {
#pragma unroll
        for (int g = 0; g < 16; ++g) C[kb][g] *= carry;
        mma32(C[kb], KwT + 32 * kb * 40, 40, VT + 32 * w * 40, 40, 32, lane);
      }
    }
    m = m_new;
  }
  __syncthreads();
  if (!q.sample) {
    const size_t sb = (((size_t)q.b * 2 + l) * 2 + d) * 4 + hh;
    float* dst = p.out + OUT_C + sb * 16384;
#pragma unroll
    for (int kb = 0; kb < 4; ++kb)
#pragma unroll
      for (int g = 0; g < 16; ++g) dst[(size_t)(32 * kb + crow(g, h)) * 128 + 32 * w + r] = C[kb][g];
    if (tid < 128) p.out[OUT_N + sb * 128 + tid] = nv[tid];
    if (tid == 0) p.out[OUT_M + sb] = m;
  }
}

DI void phase_scan(const Params& p, int l, char* smem) {
  int* ctr = (int*)(p.ws + OFF_CTR) + l;
  int* sit = (int*)(smem + LDS_BYTES - 16);
  for (;;) {
    __syncthreads();
    if (ltid() == 0) *sit = atomicAdd(ctr, 1);
    __syncthreads();
    int it = __builtin_amdgcn_readfirstlane(*sit);
    if (it >= 1344) break;
    int ty, s_, hh_, d_, rb_ = 0;
    if (it < 256) { ty = 3; rb_ = it & 3; d_ = (it >> 2) & 1; hh_ = (it >> 3) & 7; s_ = 32 + (it >> 6); }
    else if (it < 288) { it -= 256; ty = 1; s_ = 32 + (it >> 3); hh_ = (it >> 1) & 3; d_ = it & 1; }
    else if (it < 320) { it -= 288; ty = 2; s_ = 32 + (it >> 3); hh_ = (it >> 1) & 3; d_ = it & 1; }
    else if (it < 832) { it -= 320; ty = 0; s_ = it >> 4; hh_ = (it >> 1) & 7; d_ = it & 1; }
    else if (it < 1088) { it -= 832; ty = 1; s_ = it >> 3; hh_ = (it >> 1) & 3; d_ = it & 1; }
    else { it -= 1088; ty = 2; s_ = it >> 3; hh_ = (it >> 1) & 3; d_ = it & 1; }
    if (ty == 0) rwkv_item<16>(p, l, s_, hh_, d_, 0, smem);
    else if (ty == 3) rwkv_item<4>(p, l, s_, hh_, d_, rb_, smem);
    else if (ty == 1) hgrn_item(p, l, s_, hh_, d_, smem);
    else mlstm_item(p, l, s_, hh_, d_, smem);
  }
}

DI void phase_combine(const Params& p, int l, char* smem) {
  const int tid = ltid(), lane = tid & 63, w = tid >> 6;
  bf16_t* ZH = (bf16_t*)(p.ws + OFF_ZH); bf16_t* ZM = (bf16_t*)(p.ws + OFF_ZM); const bf16_t* ZR = (const bf16_t*)(p.ws + OFF_ZR);
  bf16_t* O = (bf16_t*)(p.ws + OFF_O); const bf16_t* Hb = (const bf16_t*)(p.ws + OFF_H);
  const float* mu = p.in[I_MU] + (size_t)l * 4 * ZRW;
  const float* g2 = p.in[I_G2] + (size_t)l * 128 * 512;
  float* sg = (float*)smem;
  float* gt = sg + 128 * 16;
  for (int blk = blockIdx.x; blk < NT / 16; blk += gridDim.x) {
    const int tok0 = blk * 16;
    int sidx, t0;
    if (tok0 < 8192) { sidx = tok0 >> 8; t0 = tok0 & 255; } else { sidx = 32 + ((tok0 - 8192) >> 11); t0 = (tok0 - 8192) & 2047; }
    const Seq q = get_seq(sidx);
    __syncthreads();
    { const int j = tid >> 4, rr0 = (tid & 15) * 8; float val[8]; bf16x8 pv[5]; rw_load8(ZR, q.base, t0 + j, q.T, q.grid, 1792 + rr0, pv); rw_apply8(pv, mu, q.grid, 1792 + rr0, val);
#pragma unroll
      for (int e = 0; e < 8; ++e) sg[(rr0 + e) * 16 + j] = sigmoidf_(val[e]); }
    __syncthreads();
    {
      float a0[16], a1[16];
#pragma unroll
      for (int j = 0; j < 16; ++j) { a0[j] = 0.f; a1[j] = 0.f; }
#pragma unroll 1
      for (int r0 = 0; r0 < 128; r0 += 8) {
        float w0v[8], w1v[8];
#pragma unroll
        for (int q8 = 0; q8 < 8; ++q8) { w0v[q8] = g2[(r0 + q8) * 512 + tid]; w1v[q8] = g2[(r0 + q8) * 512 + 256 + tid]; }
#pragma unroll
        for (int q8 = 0; q8 < 8; ++q8) {
          const int rr = r0 + q8; const float w0 = w0v[q8], w1 = w1v[q8];
#pragma unroll
          for (int u = 0; u < 4; ++u) {
            f32x4 sv = *(const f32x4*)(sg + rr * 16 + 4 * u);
#pragma unroll
            for (int e = 0; e < 4; ++e) { a0[4 * u + e] += sv[e] * w0; a1[4 * u + e] += sv[e] * w1; }
          }
        }
      }
#pragma unroll
      for (int j = 0; j < 16; ++j) { gt[j * 512 + tid] = a0[j]; gt[j * 512 + 256 + tid] = a1[j]; }
    }
    __syncthreads();
#pragma unroll 1
    for (int jj = 0; jj < 4; ++jj) {
      const int j = w * 4 + jj, tok = tok0 + j, t = t0 + j; int c0 = lane * 8; asm volatile("" : "+v"(c0));
      {
        float o[8], rs[8], ks[8], vs[8];
        float sum = 0.f, bon = 0.f;
        {
          bf16x8 pr_[5], pk_[5], pv_[5];
          rw_load8(ZR, q.base, t, q.T, q.grid, c0, pr_); rw_load8(ZR, q.base, t, q.T, q.grid, 512 + c0, pk_); rw_load8(ZR, q.base, t, q.T, q.grid, 1024 + c0, pv_);
          rw_apply8(pr_, mu, q.grid, c0, rs); rw_apply8(pk_, mu, q.grid, 512 + c0, ks); rw_apply8(pv_, mu, q.grid, 1024 + c0, vs);
        }
        const bf16x8 of = *(const bf16x8*)(O + (size_t)tok * 1024 + c0), ob = *(const bf16x8*)(O + (size_t)tok * 1024 + 512 + c0);
        const f32x4 rk0 = *(const f32x4*)(p.in[I_RK] + l * 512 + c0), rk1 = *(const f32x4*)(p.in[I_RK] + l * 512 + c0 + 4);
#pragma unroll
        for (int e = 0; e < 8; ++e) {
          o[e] = bf2f((bf16_t)of[e]) + bf2f((bf16_t)ob[e]);
          sum += o[e];
          bon += rs[e] * ks[e] * (e < 4 ? rk0[e & 3] : rk1[e & 3]);
        }
        sum += __shfl_xor(sum, 1); sum += __shfl_xor(sum, 2); sum += __shfl_xor(sum, 4);
        bon += __shfl_xor(bon, 1); bon += __shfl_xor(bon, 2); bon += __shfl_xor(bon, 4);
        const float mean = sum * (1.0f / 64.f);
        float var = 0.f;
#pragma unroll
        for (int e = 0; e < 8; ++e) { const float dv = o[e] - mean; var += dv * dv; }
        var += __shfl_xor(var, 1); var += __shfl_xor(var, 2); var += __shfl_xor(var, 4);
        const float rstd = rsqrtf(var * (1.0f / 64.f) + 64e-5f);
        const f32x4 lw0 = *(const f32x4*)(p.in[I_LN] + (l * 2 + 0) * 512 + c0), lw1 = *(const f32x4*)(p.in[I_LN] + (l * 2 + 0) * 512 + c0 + 4);
        const f32x4 lb0 = *(const f32x4*)(p.in[I_LN] + (l * 2 + 1) * 512 + c0), lb1 = *(const f32x4*)(p.in[I_LN] + (l * 2 + 1) * 512 + c0 + 4);
        const f32x4 gt0 = *(const f32x4*)(gt + j * 512 + c0), gt1 = *(const f32x4*)(gt + j * 512 + c0 + 4);
        bf16x8 ov;
#pragma unroll
        for (int e = 0; e < 8; ++e) {
          const float ln = (o[e] - mean) * rstd * (e < 4 ? lw0[e & 3] : lw1[e & 3]) + (e < 4 ? lb0[e & 3] : lb1[e & 3]);
          ov[e] = (short)f2bf((ln + bon * vs[e]) * (e < 4 ? gt0[e & 3] : gt1[e & 3]));
        }
        *(bf16x8*)(O + (size_t)tok * 1024 + c0) = ov;
      }
      {
        float o[8]; float ss = 0.f;
        bf16_t* zr_ = ZH + (size_t)tok * ZHW + c0;
        const bf16x8 of = *(const bf16x8*)(zr_ + 512), ob = *(const bf16x8*)(zr_ + 1024), hgv = *(const bf16x8*)(zr_ + 2048);
        const f32x4 nw0 = *(const f32x4*)(p.in[I_HNORM] + l * 512 + c0), nw1 = *(const f32x4*)(p.in[I_HNORM] + l * 512 + c0 + 4);
#pragma unroll
        for (int e = 0; e < 8; ++e) { o[e] = bf2f((bf16_t)of[e]) + bf2f((bf16_t)ob[e]); ss += o[e] * o[e]; }
        ss += __shfl_xor(ss, 1); ss += __shfl_xor(ss, 2); ss += __shfl_xor(ss, 4); ss += __shfl_xor(ss, 8);
        const float rsd = rsqrtf(ss * (1.0f / 128.f) + 1e-6f);
        bf16x8 ov;
#pragma unroll
        for (int e = 0; e < 8; ++e) ov[e] = (short)f2bf(o[e] * rsd * (e < 4 ? nw0[e & 3] : nw1[e & 3]) * siluf_(bf2f((bf16_t)hgv[e])));
        *(bf16x8*)(zr_ + 2048) = ov;
      }
      {
        float o[8]; float ss = 0.f;
        bf16_t* zm_ = ZM + (size_t)tok * ZMW + 1536 + c0;
        const bf16x8 of = *(const bf16x8*)(Hb + (size_t)tok * 1024 + c0), ob = *(const bf16x8*)(Hb + (size_t)tok * 1024 + 512 + c0), mov = *(const bf16x8*)zm_;
        const f32x4 nw0 = *(const f32x4*)(p.in[I_MNORM] + l * 512 + c0), nw1 = *(const f32x4*)(p.in[I_MNORM] + l * 512 + c0 + 4);
#pragma unroll
        for (int e = 0; e < 8; ++e) { o[e] = bf2f((bf16_t)of[e]) + bf2f((bf16_t)ob[e]); ss += o[e] * o[e]; }
        ss += __shfl_xor(ss, 1); ss += __shfl_xor(ss, 2); ss += __shfl_xor(ss, 4); ss += __shfl_xor(ss, 8);
        const float rsd = rsqrtf(ss * (1.0f / 128.f) + 1e-6f);
        bf16x8 ov;
#pragma unroll
        for (int e = 0; e < 8; ++e) ov[e] = (short)f2bf(o[e] * rsd * (e < 4 ? nw0[e & 3] : nw1[e & 3]) * sigmoidf_(bf2f((bf16_t)mov[e])));
        *(bf16x8*)zm_ = ov;
      }
    }
    __syncthreads();
#pragma unroll 1
    for (int jj = 0; jj < 4; ++jj) tok_one(p, l, 3, tok0 + w * 4 + jj, lane);
  }
}

#define XB_TMO      128
#define XB_XCNT(j)  (256  + 64 * (j))
#define XB_XSUB(j)  (1280 + 64 * (j))
#define XB_XGEN(j)  (2304 + 64 * (j))
#define XB_TOP      3328
#define XB_TOPGEN   3392
#define XCD_BAR_WORDS 3456
#define XB_SPIN_CAP (1u << 20)
#define LAS __attribute__((address_space(3)))
DI unsigned xb_ld(unsigned* p)              { return __hip_atomic_load(p, __ATOMIC_RELAXED, __HIP_MEMORY_SCOPE_AGENT); }
DI unsigned xb_add(unsigned* p, unsigned v) { return __hip_atomic_fetch_add(p, v, __ATOMIC_RELAXED, __HIP_MEMORY_SCOPE_AGENT); }
DI unsigned xb_xcc_id() { return (unsigned)__builtin_amdgcn_s_getreg((3 << 11) | 20) & 0xFu; }
#define XB_SPIN(cond, bar) do { unsigned _sp = 0; while (cond) { __builtin_amdgcn_s_sleep(1); \
    if ((++_sp & 255u) == 0u) { if (xb_ld(&(bar)[XB_TMO])) break; if (_sp > XB_SPIN_CAP) { atomicAdd(&(bar)[XB_TMO], 1u); break; } } } } while (0)
struct XcdBarrier { unsigned* bar; unsigned x; volatile LAS unsigned* st; };
DI XcdBarrier xcd_barrier_post(const Params& p, unsigned* bar, volatile LAS unsigned* st) {
  XcdBarrier b; b.bar = bar; b.x = xb_xcc_id(); b.st = st;
  if (ltid() == 0) (void)xb_add(&bar[XB_XCNT(b.x)], 1u);
  return b;
}
DI void xcd_barrier_complete(unsigned* bar, unsigned x, unsigned& nloc, unsigned& nx) {
  const unsigned G = gridDim.x * gridDim.y * gridDim.z;
  unsigned sum, cnt, mine, sp = 0u;
  for (;;) {
    sum = 0u; cnt = 0u; mine = 0u;
#pragma unroll
    for (unsigned j = 0; j < 16; ++j) { const unsigned c = xb_ld(&bar[XB_XCNT(j)]); sum += c; cnt += (c > 0u) ? 1u : 0u; mine = (j == x) ? c : mine; }
    if (sum == G) break;
    __builtin_amdgcn_s_sleep(1);
    if ((++sp & 255u) == 0u) { if (xb_ld(&bar[XB_TMO])) break; if (sp > XB_SPIN_CAP) { atomicAdd(&bar[XB_TMO], 1u); break; } }
  }
  nloc = mine > 0u ? mine : 1u; nx = cnt > 0u ? cnt : 1u;
}
DI void xcd_barrier(const Params& p, const XcdBarrier& b) {
  asm volatile("s_waitcnt vmcnt(0)" ::: "memory");
  __syncthreads();
  if (ltid() == 0) {
    unsigned* bar = b.bar;
    __builtin_amdgcn_s_waitcnt(0);
    unsigned nloc = b.st[0], nx = b.st[1];
    if (nloc == 0u) { xcd_barrier_complete(bar, b.x, nloc, nx); b.st[0] = nloc; b.st[1] = nx; }
    const unsigned old = xb_add(&bar[XB_XSUB(b.x)], 1u);
    const unsigned gen = old / nloc;
    if (old + 1u == (gen + 1u) * nloc) {
      __builtin_amdgcn_fence(__ATOMIC_RELEASE, "agent");
      asm volatile("s_waitcnt vmcnt(0)" ::: "memory");
      const unsigned og = xb_add(&bar[XB_TOP], 1u);
      const unsigned tg = og / nx;
      if (og + 1u == (tg + 1u) * nx) xb_add(&bar[XB_TOPGEN], 1u);
      else XB_SPIN(xb_ld(&bar[XB_TOPGEN]) == tg, bar);
      __builtin_amdgcn_fence(__ATOMIC_ACQUIRE, "agent");
      xb_add(&bar[XB_XGEN(b.x)], 1u);
      asm volatile("s_waitcnt vmcnt(0)" ::: "memory");
    } else {
      XB_SPIN(xb_ld(&bar[XB_XGEN(b.x)]) == gen, bar);
      __builtin_amdgcn_fence(__ATOMIC_ACQUIRE, "agent");
      asm volatile("s_waitcnt vmcnt(0)" ::: "memory");
    }
  }
  __syncthreads();
}

constexpr int NPHASE = 3 + 9 * 2;
DI void run_phase(const Params& p0, int ph, char* smem) {
  Params p = p0;
  asm volatile("" : "+s"(p.ws), "+s"(p.out));
  if (ph == 0) { phase0(p, smem); return; }
  if (ph == 1) { phase1(p); return; }
  if (ph == 2) { tok_phase(p, 0, 0); return; }
  const int l = (ph - 3) / 9, s = (ph - 3) % 9;
  switch (s) {
    case 0: phase_inproj(p, smem); break;
    case 1: phase_scan(p, l, smem); break;
    case 2: phase_combine(p, l, smem); break;
    case 3: phase_merge(p, l, smem); break;
    case 4: phase_gemm_f32(p, (const bf16_t*)(p.ws + OFF_MERGED), 1024, (const bf16_t*)(p.ws + OFF_WTOUT), smem); break;
    case 5: tok_phase(p, l, 1); break;
    case 6: phase_ffn_in(p, smem); break;
    case 7: phase_gemm_f32(p, (const bf16_t*)(p.ws + OFF_ACT), DFF, (const bf16_t*)(p.ws + OFF_WTFO), smem); break;
    case 8:
      tok_phase(p, l, 2);
      if (l + 1 < 2) {
        conv_weight(p, p.in[I_WIN] + (size_t)(l + 1) * 1024 * DIN, DIN, (bf16_t*)(p.ws + OFF_WTIN), 1024, WTIN_ROWS, 0, (float*)smem, blockIdx.x, gridDim.x);
        for (int br = 0; br < 3; ++br) conv_weight(p, p.in[I_WBR] + ((size_t)(l + 1) * 3 + br) * 512 * 1024, 1024, (bf16_t*)(p.ws + OFF_WTBR) + (size_t)br * 1024 * 512, 512, 1024, 1, (float*)smem, blockIdx.x, gridDim.x);
      }
      break;
  }
}

template <bool COOP>
__global__ void __launch_bounds__(NTHR, 2) mega(Params pk, int lo, int hi) {
  __shared__ __attribute__((aligned(16))) char smem[LDS_BYTES];
  Params p = pk;
  p.wb = __builtin_amdgcn_readfirstlane((int)threadIdx.x) & ~63;
  if (COOP) {
    volatile LAS unsigned* st = (volatile LAS unsigned*)(smem + LDS_BYTES - 32);
    if (ltid() == 0) { st[0] = 0u; st[1] = 0u; }
    __syncthreads();
    phase0(p, smem);
    cg::this_grid().sync();
    XcdBarrier b = xcd_barrier_post(p, (unsigned*)(p.ws + OFF_BAR), st);
    for (int ph = 1; ph < hi; ++ph) {
      run_phase(p, ph, smem);
      if (ph + 1 < hi) xcd_barrier(p, b);
    }
  } else {
    for (int ph = lo; ph < hi; ++ph) run_phase(p, ph, smem);
  }
}

extern "C" void kernel_launch(void* const* d_in, const int* in_sizes, int n_in, void* d_out, int out_size, void* d_ws, size_t ws_size, hipStream_t stream) {
  Params p{};
  for (int i = 0; i < N_IN; ++i) p.in[i] = (const float*)d_in[i];
  p.out = (float*)d_out; p.ws = (char*)d_ws;
  if (ws_size < WS_NEED) fprintf(stderr, "workspace too small: %zu < %zu\n", ws_size, (size_t)WS_NEED);
  static int grid_blocks = 0;
  if (!grid_blocks) {
    int dev = 0, cus = 0, per_cu = 0;
    hipGetDevice(&dev);
    hipDeviceGetAttribute(&cus, hipDeviceAttributeMultiprocessorCount, dev);
    hipOccupancyMaxActiveBlocksPerMultiprocessor(&per_cu, mega<true>, NTHR, 0);
    if (per_cu > 2) per_cu = 2;
    grid_blocks = cus * per_cu;
  }
  int lo = 0, hi = NPHASE;
  void* args[] = {&p, &lo, &hi};
  hipError_t e = hipLaunchCooperativeKernel((void*)mega<true>, dim3(grid_blocks), dim3(NTHR), args, 0, stream);
  if (e != hipSuccess) fprintf(stderr, "cooperative launch failed: %s (grid %d)\n", hipGetErrorString(e), grid_blocks);
}
```

```cpp
#include <hip/hip_runtime.h>
#include <hip/hip_cooperative_groups.h>
#include <cstdio>
namespace cg = cooperative_groups;

typedef unsigned short bf16_t;
typedef short bf16x8 __attribute__((ext_vector_type(8)));
typedef float f32x4 __attribute__((ext_vector_type(4)));
typedef float f32x2 __attribute__((ext_vector_type(2)));
typedef float f32x16 __attribute__((ext_vector_type(16)));
typedef unsigned short u16x4 __attribute__((ext_vector_type(4)));
typedef unsigned short u16x2 __attribute__((ext_vector_type(2)));
typedef unsigned u32x4 __attribute__((ext_vector_type(4)));
typedef unsigned u32x2 __attribute__((ext_vector_type(2)));
static __device__ __forceinline__ unsigned pk2(float lo, float hi) { typedef __bf16 b2 __attribute__((ext_vector_type(2))); typedef float f2 __attribute__((ext_vector_type(2))); return __builtin_bit_cast(unsigned, __builtin_convertvector((f2){lo, hi}, b2)); }

#define DI __device__ __forceinline__

constexpr int NT = 16384;
constexpr int DM = 1024;
constexpr int NTHR = 256;
constexpr int DIN = 9616;
constexpr int ZHW = 2560, ZRW = 1920, ZMW = 2048;
constexpr int WTIN_ROWS = 9728;
constexpr int DFF = 2816;

constexpr size_t OFF_WTIN = 0;
constexpr size_t OFF_WTBR = OFF_WTIN + (size_t)WTIN_ROWS * 1024 * 2;
constexpr size_t OFF_H    = OFF_WTBR + (size_t)3 * 1024 * 512 * 2;
constexpr size_t OFF_ZH   = OFF_H + (size_t)NT * 1024 * 2;
constexpr size_t OFF_ZR   = OFF_ZH + (size_t)NT * ZHW * 2;
constexpr size_t OFF_ZM   = OFF_ZR + (size_t)NT * ZRW * 2;
constexpr size_t OFF_MG   = OFF_ZM + (size_t)NT * ZMW * 2;
constexpr size_t OFF_O    = OFF_MG + (size_t)NT * 16 * 4;
constexpr size_t OFF_MOD  = OFF_O + (size_t)NT * 1024 * 2;
constexpr size_t OFF_LBS  = OFF_MOD + (size_t)2 * 5 * 6144 * 4;
constexpr size_t OFF_CTR  = OFF_LBS + 2 * 512 * 4;
constexpr size_t OFF_BAR  = OFF_CTR + 256;
constexpr size_t OFF_ROLE = OFF_BAR + 3456 * 4;
constexpr size_t WS_NEED  = OFF_ROLE + 4096 * 4;
constexpr size_t OFF_MODP = OFF_ZH;
constexpr size_t OFF_WTOUT = OFF_ZR;
constexpr size_t OFF_WTFI  = OFF_WTOUT + (size_t)1024 * 1024 * 2;
constexpr size_t OFF_WTFO  = OFF_WTFI + (size_t)5632 * 1024 * 2;
constexpr size_t OFF_MERGED = OFF_WTFO + (size_t)1024 * 2816 * 2;
constexpr size_t OFF_Y    = OFF_ZH;
constexpr size_t OFF_ACT  = OFF_ZM;

constexpr size_t OUT_HG = 16777216, OUT_RW = 25165824, OUT_C = 29360128, OUT_N = 37748736, OUT_M = 37814272;

enum { I_XP = 0, I_XS, I_SH, I_SR, I_SC, I_SN, I_SM, I_C, I_CCTX, I_WADA, I_BADA, I_NORMS, I_WIN, I_HLB, I_HNORM, I_MU, I_W0, I_W2,
       I_A0, I_A2, I_G2, I_KK, I_KA, I_RK, I_LN, I_GB, I_MNORM, I_WBR, I_WOUT, I_WFI, I_WFO, N_IN };

struct Params { const float* in[N_IN]; float* out; char* ws; int wb; int role; };

constexpr int LDS_BYTES = 77824;

DI bf16_t f2bf(float f) { return __builtin_bit_cast(unsigned short, (__bf16)f); }
DI float bf2f(bf16_t h) { return __uint_as_float(((unsigned)h) << 16); }
DI float sigmoidf_(float x) { return 1.0f / (1.0f + __expf(-x)); }
DI float siluf_(float x) { return x / (1.0f + __expf(-x)); }
DI float softplusf_(float x) { return x > 20.f ? x : __logf(1.0f + __expf(x)); }
DI float dpp_xor1(float x) { return __int_as_float(__builtin_amdgcn_mov_dpp(__float_as_int(x), 0xB1, 0xF, 0xF, true)); }
DI float dpp_xor2(float x) { return __int_as_float(__builtin_amdgcn_mov_dpp(__float_as_int(x), 0x4E, 0xF, 0xF, true)); }
DI float shfl_lane(float v, int src) { return __int_as_float(__builtin_amdgcn_ds_bpermute(src << 2, __float_as_int(v))); }
#define SHX(v, m) shfl_lane((v), lane ^ (m))
DI float wave_sum(float v, int lane) { v += dpp_xor1(v); v += dpp_xor2(v); v += SHX(v, 4); v += SHX(v, 8); v += SHX(v, 16); v += SHX(v, 32); return v; }
DI int ltid_(int wb) { int t = wb + (int)__builtin_amdgcn_mbcnt_hi(~0u, __builtin_amdgcn_mbcnt_lo(~0u, 0u)); asm volatile("" : "+v"(t)); return t; }
#define ltid() ltid_(p.wb)
DI int crow(int reg, int h) { return (reg & 3) + 8 * (reg >> 2) + 4 * h; }

DI int tok_cond(int tok) { return tok < 8192 ? 0 : 1 + ((tok - 8192) >> 11); }
DI const float* x_in_row(const Params& p, int tok) { return tok < 8192 ? p.in[I_XP] + (size_t)tok * DM : p.in[I_XS] + (size_t)(tok - 8192) * DM; }

DI void mma32(f32x16& acc, const bf16_t* A, int lda, const bf16_t* B, int ldb, int K, int lane) {
  const int r = lane & 31, h = lane >> 5;
#pragma unroll 2
  for (int kk = 0; kk < K; kk += 16) {
    bf16x8 a = *(const bf16x8*)(A + r * lda + kk + 8 * h);
    bf16x8 b = *(const bf16x8*)(B + r * ldb + kk + 8 * h);
    acc = __builtin_amdgcn_mfma_f32_32x32x16_bf16(a, b, acc, 0, 0, 0);
  }
}

template <int BN>
DI void gemm_main(const Params& p, f32x4 (&acc)[4][BN / 32], const bf16_t* __restrict__ A, int lda, const bf16_t* __restrict__ B, int ldb, int K, bf16_t* sm) {
  constexpr int NJ = BN / 32, BCH = BN / 32, LS = 72;
  const int tid = ltid(), lane = tid & 63, w = tid >> 6, wm = w >> 1, wn = w & 1;
  bf16_t* As = sm; bf16_t* Bs = sm + 2 * 128 * LS;
  bf16x8 ra[4], rb[BCH];
  const int nk = K / 64;
  const int lrow = tid >> 3, lkc = (tid & 7) * 8;
#pragma unroll
  for (int i = 0; i < 4; ++i) ra[i] = *(const bf16x8*)(A + (size_t)(lrow + 32 * i) * lda + lkc);
#pragma unroll
  for (int i = 0; i < BCH; ++i) rb[i] = *(const bf16x8*)(B + (size_t)(lrow + 32 * i) * ldb + lkc);
  __syncthreads();
#pragma unroll
  for (int i = 0; i < 4; ++i) *(bf16x8*)(As + (lrow + 32 * i) * LS + lkc) = ra[i];
#pragma unroll
  for (int i = 0; i < BCH; ++i) *(bf16x8*)(Bs + (lrow + 32 * i) * LS + lkc) = rb[i];
  __syncthreads();
  for (int kt = 0; kt < nk; ++kt) {
    const int buf = kt & 1;
    if (kt + 1 < nk) {
      const int k0 = (kt + 1) * 64 + lkc;
#pragma unroll
      for (int i = 0; i < 4; ++i) ra[i] = *(const bf16x8*)(A + (size_t)(lrow + 32 * i) * lda + k0);
#pragma unroll
      for (int i = 0; i < BCH; ++i) rb[i] = *(const bf16x8*)(B + (size_t)(lrow + 32 * i) * ldb + k0);
    }
    const bf16_t* as = As + buf * 128 * LS + (wm * 64 + (lane & 15)) * LS + (lane >> 4) * 8;
    const bf16_t* bs = Bs + buf * BN * LS + (wn * (BN / 2) + (lane & 15)) * LS + (lane >> 4) * 8;
#pragma unroll
    for (int ks = 0; ks < 2; ++ks) {
      bf16x8 af[4], bfr[NJ];
#pragma unroll
      for (int i = 0; i < 4; ++i) af[i] = *(const bf16x8*)(as + i * 16 * LS + ks * 32);
#pragma unroll
      for (int j = 0; j < NJ; ++j) bfr[j] = *(const bf16x8*)(bs + j * 16 * LS + ks * 32);
#pragma unroll
      for (int i = 0; i < 4; ++i)
#pragma unroll
        for (int j = 0; j < NJ; ++j) acc[i][j] = __builtin_amdgcn_mfma_f32_16x16x32_bf16(bfr[j], af[i], acc[i][j], 0, 0, 0);
    }
    if (kt + 1 < nk) {
      const int nb = buf ^ 1;
#pragma unroll
      for (int i = 0; i < 4; ++i) *(bf16x8*)(As + nb * 128 * LS + (lrow + 32 * i) * LS + lkc) = ra[i];
#pragma unroll
      for (int i = 0; i < BCH; ++i) *(bf16x8*)(Bs + nb * BN * LS + (lrow + 32 * i) * LS + lkc) = rb[i];
    }
    __syncthreads();
  }
}

template <int NJ> DI void zero_acc(f32x4 (&acc)[4][NJ]) {
#pragma unroll
  for (int i = 0; i < 4; ++i)
#pragma unroll
    for (int j = 0; j < NJ; ++j) acc[i][j] = (f32x4){0.f, 0.f, 0.f, 0.f};
}
DI void store_bf4(bf16_t* dst, f32x4 v) { u16x4 o; o[0] = f2bf(v[0]); o[1] = f2bf(v[1]); o[2] = f2bf(v[2]); o[3] = f2bf(v[3]); *(u16x4*)dst = o; }

DI int map_col(int mode, int n) {
  if (mode == 0) return n < 6544 ? n : (n < 6656 ? -1 : n - 112);
  if (mode == 2) return ((n >> 4) & 1) ? DFF + (n >> 5) * 16 + (n & 15) : (n >> 5) * 16 + (n & 15);
  return n;
}
DI void conv_tile(const Params& p, const float* __restrict__ src, int ld_src, bf16_t* __restrict__ dst, int K, int mode, int tk, int tn, float* sm) {
  const int tid = ltid();
  __syncthreads();
  {
    const int nn = tid & 63, col = map_col(mode, tn * 64 + nn);
#pragma unroll
    for (int i = 0; i < 16; ++i) { int kk = (tid >> 6) + 4 * i; sm[kk * 65 + nn] = col >= 0 ? src[(size_t)(tk * 64 + kk) * ld_src + col] : 0.f; }
  }
  __syncthreads();
  {
    const int kk = tid & 63;
#pragma unroll
    for (int i = 0; i < 16; ++i) { int nn = (tid >> 6) + 4 * i; dst[(size_t)(tn * 64 + nn) * K + tk * 64 + kk] = f2bf(sm[kk * 65 + nn]); }
  }
}
DI void conv_weight(const Params& p, const float* src, int ld_src, bf16_t* dst, int K, int Ndst, int mode, float* sm, int bid, int nb) {
  const int tkn = K / 64, nt = tkn * (Ndst / 64);
  for (int t = bid; t < nt; t += nb) conv_tile(p, src, ld_src, dst, K, mode, t % tkn, t / tkn, sm);
}

DI void phase0(const Params& p, char* smem) {
  const int tid = ltid(), bid = blockIdx.x, nb = gridDim.x;
  float* MODP = (float*)(p.ws + OFF_MODP);
  float* sm = (float*)smem;
  if (bid == 0) { if (tid < 64) ((int*)(p.ws + OFF_CTR))[tid] = 0; for (int i = tid; i < 3456; i += NTHR) ((unsigned*)(p.ws + OFF_BAR))[i] = 0u; for (int i = tid; i < 4096; i += NTHR) ((unsigned*)(p.ws + OFF_ROLE))[i] = 0u; }
  for (int i = bid * NTHR + tid; i < 512; i += nb * NTHR) {
    float a = p.in[I_HLB][i], b = p.in[I_HLB][512 + i];
    float* L = (float*)(p.ws + OFF_LBS); L[i] = 0.f; L[512 + i] = 1.0f / (1.0f + expf(a - b));
  }
  for (int it = bid; it < 2 * 24 * 16; it += nb) {
    const int ks = it & 15, jb = (it >> 4) % 24, l = it / (16 * 24);
    __syncthreads();
    for (int e = tid; e < 5 * 64; e += NTHR) { int ci = e >> 6, k = ks * 64 + (e & 63); float cv = ci == 0 ? p.in[I_CCTX][k] : p.in[I_C][(ci - 1) * DM + k]; sm[e] = siluf_(cv); }
    __syncthreads();
    const int j = jb * 256 + tid;
    float a0 = 0, a1 = 0, a2 = 0, a3 = 0, a4 = 0;
    const float* W = p.in[I_WADA] + ((size_t)l * DM + ks * 64) * 6144 + j;
#pragma unroll 1
    for (int k0 = 0; k0 < 64; k0 += 16) {
      float wv[16];
#pragma unroll
      for (int u = 0; u < 16; ++u) wv[u] = W[(size_t)(k0 + u) * 6144];
#pragma unroll
      for (int u = 0; u < 16; ++u) { const int k = k0 + u; const float w = wv[u]; a0 += sm[k] * w; a1 += sm[64 + k] * w; a2 += sm[128 + k] * w; a3 += sm[192 + k] * w; a4 += sm[256 + k] * w; }
    }
    float* dst = MODP + ((size_t)(ks * 2 + l) * 5) * 6144 + j;
    dst[0] = a0; dst[6144] = a1; dst[2 * 6144] = a2; dst[3 * 6144] = a3; dst[4 * 6144] = a4;
  }
  conv_weight(p, p.in[I_WIN], DIN, (bf16_t*)(p.ws + OFF_WTIN), 1024, WTIN_ROWS, 0, sm, bid, nb);
  for (int br = 0; br < 3; ++br) conv_weight(p, p.in[I_WBR] + (size_t)br * 512 * 1024, 1024, (bf16_t*)(p.ws + OFF_WTBR) + (size_t)br * 1024 * 512, 512, 1024, 1, sm, bid, nb);
}
DI void phase1(const Params& p) {
  const float* MODP = (const float*)(p.ws + OFF_MODP);
  float* MOD = (float*)(p.ws + OFF_MOD);
  for (int i = blockIdx.x * NTHR + ltid(); i < 2 * 5 * 6144; i += gridDim.x * NTHR) {
    const int j = i % 6144, l = i / (5 * 6144);
    float s = p.in[I_BADA][l * 6144 + j];
    for (int ks = 0; ks < 16; ++ks) s += MODP[(size_t)ks * 2 * 5 * 6144 + i];
    MOD[i] = s;
  }
}

DI void norm_mod_store(const f32x4 (&x)[4], const float* nw, const float* sc, const float* sh, bf16_t* hrow, int lane) {
  float ss = 0.f;
#pragma unroll
  for (int i = 0; i < 4; ++i) ss += x[i][0] * x[i][0] + x[i][1] * x[i][1] + x[i][2] * x[i][2] + x[i][3] * x[i][3];
  ss = wave_sum(ss, lane);
  const float rs = rsqrtf(ss * (1.0f / DM) + 1e-6f);
#pragma unroll
  for (int i = 0; i < 4; ++i) {
    const int c = i * 256 + lane * 4;
    f32x4 w = *(const f32x4*)(nw + c), s1 = *(const f32x4*)(sc + c), s0 = *(const f32x4*)(sh + c), o;
#pragma unroll
    for (int e = 0; e < 4; ++e) o[e] = x[i][e] * rs * w[e] * (1.0f + s1[e]) + s0[e];
    store_bf4(hrow + c, o);
  }
}
DI void tok_one(const Params& p, int l, int mode, int tok, int lane) {
  const float* MOD = (const float*)(p.ws + OFF_MOD);
  bf16_t* H = (bf16_t*)(p.ws + OFF_H);
  const float* Y = (const float*)(p.ws + OFF_Y);
  const int ci = tok_cond(tok);
  const float* modl = MOD + (size_t)(l * 5 + ci) * 6144;
  const float* nwl = p.in[I_NORMS] + (size_t)l * 4 * DM;
  const bool from_in = (l == 0 && (mode == 0 || mode == 1 || mode == 3));
  const float* xr = from_in ? x_in_row(p, tok) : p.out + (size_t)tok * DM;
  f32x4 x[4];
#pragma unroll
  for (int i = 0; i < 4; ++i) x[i] = *(const f32x4*)(xr + i * 256 + lane * 4);
  if (mode == 1 || mode == 2) {
    f32x4 y[4]; float ss = 0.f;
#pragma unroll
    for (int i = 0; i < 4; ++i) { y[i] = *(const f32x4*)(Y + (size_t)tok * DM + i * 256 + lane * 4); ss += y[i][0] * y[i][0] + y[i][1] * y[i][1] + y[i][2] * y[i][2] + y[i][3] * y[i][3]; }
    ss = wave_sum(ss, lane);
    const float rs = rsqrtf(ss * (1.0f / DM) + 1e-6f);
    const float* nw = nwl + (mode == 1 ? 1 : 3) * DM;
    const float* g = modl + (mode == 1 ? 2 : 5) * DM;
#pragma unroll
    for (int i = 0; i < 4; ++i) {
      const int c = i * 256 + lane * 4;
      f32x4 w = *(const f32x4*)(nw + c), gg = *(const f32x4*)(g + c);
#pragma unroll
      for (int e = 0; e < 4; ++e) x[i][e] += gg[e] * (y[i][e] * rs * w[e]);
      *(f32x4*)(p.out + (size_t)tok * DM + c) = x[i];
    }
  }
  if (mode == 0 || mode == 3) norm_mod_store(x, nwl, modl + 1 * DM, modl + 0 * DM, H + (size_t)tok * DM, lane);
  else if (mode == 1) norm_mod_store(x, nwl + 2 * DM, modl + 4 * DM, modl + 3 * DM, H + (size_t)tok * DM, lane);
  else if (mode == 2 && l + 1 < 2) {
    const float* modn = MOD + (size_t)((l + 1) * 5 + ci) * 6144;
    norm_mod_store(x, p.in[I_NORMS] + (size_t)(l + 1) * 4 * DM, modn + 1 * DM, modn + 0 * DM, H + (size_t)tok * DM, lane);
  }
}
DI void tok_phase(const Params& p, int l, int mode) {
  const int lane = ltid() & 63, gw = blockIdx.x * 4 + (ltid() >> 6), nw = gridDim.x * 4;
  for (int tok = gw; tok < NT; tok += nw) tok_one(p, l, mode, tok, lane);
}

DI bool tile_xcd(int i, int NTN, int& mt, int& nt) {
  const int G = gridDim.x, b = blockIdx.x, x = b & 7, j = b >> 3, nbx = (G - x + 7) >> 3;
  const int u = j + i * nbx;
  if (u >= 16 * NTN) return false;
  mt = 16 * x + (u & 15); nt = u >> 4;
  return true;
}
DI void phase_inproj(const Params& p, char* smem) {
  const bf16_t* H = (const bf16_t*)(p.ws + OFF_H);
  const bf16_t* WT = (const bf16_t*)(p.ws + OFF_WTIN);
  bf16_t* ZH = (bf16_t*)(p.ws + OFF_ZH); bf16_t* ZR = (bf16_t*)(p.ws + OFF_ZR); bf16_t* ZM = (bf16_t*)(p.ws + OFF_ZM);
  float* MG = (float*)(p.ws + OFF_MG);
  const int lane = ltid() & 63, w = ltid() >> 6, wm = w >> 1, wn = w & 1;
  int mt, nt;
  for (int ti = 0; tile_xcd(ti, 52, mt, nt); ++ti) {
    f32x4 acc[4][4]; zero_acc<4>(acc);
    gemm_main<128>(p, acc, H + (size_t)mt * 128 * 1024, 1024, WT + (size_t)nt * 128 * 1024, 1024, 1024, (bf16_t*)smem);
    const int n0 = nt * 128;
#pragma unroll
    for (int i = 0; i < 4; ++i) {
      const int row = mt * 128 + wm * 64 + i * 16 + (lane & 15);
#pragma unroll
      for (int j = 0; j < 4; ++j) {
        const int col = n0 + wn * 64 + j * 16 + 4 * (lane >> 4);
        if (n0 < 2560) store_bf4(ZH + (size_t)row * ZHW + col, acc[i][j]);
        else if (n0 < 4480) store_bf4(ZR + (size_t)row * ZRW + (col - 2560), acc[i][j]);
        else if (n0 < 6528) store_bf4(ZM + (size_t)row * ZMW + (col - 4480), acc[i][j]);
        else if (col - 6528 < 16) *(f32x4*)(MG + (size_t)row * 16 + (col - 6528)) = acc[i][j];
      }
    }
  }
}

DI void phase_merge(const Params& p, int l, char* smem) {
  const bf16_t* H = (const bf16_t*)(p.ws + OFF_H);
  const bf16_t* WT = (const bf16_t*)(p.ws + OFF_WTIN);
  const bf16_t* WBR = (const bf16_t*)(p.ws + OFF_WTBR);
  const bf16_t* ZH = (const bf16_t*)(p.ws + OFF_ZH); const bf16_t* ZM = (const bf16_t*)(p.ws + OFF_ZM); const bf16_t* O = (const bf16_t*)(p.ws + OFF_O);
  bf16_t* MER = (bf16_t*)(p.ws + OFF_MERGED);
  const int lane = ltid() & 63, w = ltid() >> 6, wm = w >> 1, wn = w & 1;
  int mt, nt;
  for (int ti = 0; tile_xcd(ti, 16, mt, nt); ++ti) {
    f32x4 accM[4][2]; zero_acc<2>(accM);
#pragma unroll 1
    for (int br = 0; br < 3; ++br) {
      f32x4 accG[4][2], accP[4][2]; zero_acc<2>(accG); zero_acc<2>(accP);
      gemm_main<64>(p, accG, H + (size_t)mt * 128 * 1024, 1024, WT + (size_t)(6656 + br * 1024 + nt * 64) * 1024, 1024, 1024, (bf16_t*)smem);
      const bf16_t* Ab; int lda;
      if (br == 0) { Ab = ZH + 2048; lda = ZHW; } else if (br == 1) { Ab = O; lda = 1024; } else { Ab = ZM + 1536; lda = ZMW; }
      gemm_main<64>(p, accP, Ab + (size_t)mt * 128 * lda, lda, WBR + ((size_t)br * 1024 + nt * 64) * 512, 512, 512, (bf16_t*)smem);
#pragma unroll
      for (int i = 0; i < 4; ++i)
#pragma unroll
        for (int j = 0; j < 2; ++j)
#pragma unroll
          for (int e = 0; e < 4; ++e) accM[i][j][e] += sigmoidf_(accG[i][j][e]) * accP[i][j][e];
    }
#pragma unroll
    for (int i = 0; i < 4; ++i) {
      const int row = mt * 128 + wm * 64 + i * 16 + (lane & 15);
#pragma unroll
      for (int j = 0; j < 2; ++j) store_bf4(MER + (size_t)row * 1024 + nt * 64 + wn * 32 + j * 16 + 4 * (lane >> 4), accM[i][j]);
    }
  }
  float* sm = (float*)smem;
  conv_weight(p, p.in[I_WOUT] + (size_t)l * 1024 * 1024, 1024, (bf16_t*)(p.ws + OFF_WTOUT), 1024, 1024, 1, sm, blockIdx.x, gridDim.x);
  conv_weight(p, p.in[I_WFI] + (size_t)l * 1024 * 5632, 5632, (bf16_t*)(p.ws + OFF_WTFI), 1024, 5632, 2, sm, blockIdx.x, gridDim.x);
  conv_weight(p, p.in[I_WFO] + (size_t)l * DFF * 1024, 1024, (bf16_t*)(p.ws + OFF_WTFO), DFF, 1024, 1, sm, blockIdx.x, gridDim.x);
}

DI void phase_gemm_f32(const Params& p, const bf16_t* A, int K, const bf16_t* Wt, char* smem) {
  float* Y = (float*)(p.ws + OFF_Y);
  const int lane = ltid() & 63, w = ltid() >> 6, wm = w >> 1, wn = w & 1;
  int mt, nt;
  for (int ti = 0; tile_xcd(ti, 8, mt, nt); ++ti) {
    f32x4 acc[4][4]; zero_acc<4>(acc);
    gemm_main<128>(p, acc, A + (size_t)mt * 128 * K, K, Wt + (size_t)nt * 128 * K, K, K, (bf16_t*)smem);
#pragma unroll
    for (int i = 0; i < 4; ++i) {
      const int row = mt * 128 + wm * 64 + i * 16 + (lane & 15);
#pragma unroll
      for (int j = 0; j < 4; ++j) *(f32x4*)(Y + (size_t)row * 1024 + nt * 128 + wn * 64 + j * 16 + 4 * (lane >> 4)) = acc[i][j];
    }
  }
}
DI void phase_ffn_in(const Params& p, char* smem) {
  const bf16_t* H = (const bf16_t*)(p.ws + OFF_H);
  const bf16_t* Wt = (const bf16_t*)(p.ws + OFF_WTFI);
  bf16_t* ACT = (bf16_t*)(p.ws + OFF_ACT);
  const int lane = ltid() & 63, w = ltid() >> 6, wm = w >> 1, wn = w & 1;
  int mt, nt;
  for (int ti = 0; tile_xcd(ti, 44, mt, nt); ++ti) {
    f32x4 acc[4][4]; zero_acc<4>(acc);
    gemm_main<128>(p, acc, H + (size_t)mt * 128 * 1024, 1024, Wt + (size_t)nt * 128 * 1024, 1024, 1024, (bf16_t*)smem);
#pragma unroll
    for (int i = 0; i < 4; ++i) {
      const int row = mt * 128 + wm * 64 + i * 16 + (lane & 15);
#pragma unroll
      for (int jj = 0; jj < 2; ++jj) {
        f32x4 u = acc[i][2 * jj], g = acc[i][2 * jj + 1], o;
#pragma unroll
        for (int e = 0; e < 4; ++e) o[e] = siluf_(g[e]) * u[e];
        const int col = (nt * 128 + wn * 64 + jj * 32) / 2 + 4 * (lane >> 4);
        store_bf4(ACT + (size_t)row * DFF + col, o);
      }
    }
  }
}

struct Seq { int base, T, grid, b; bool sample; };
DI Seq get_seq(int s) { Seq q; if (s < 32) { q.base = s * 256; q.T = 256; q.grid = 0; q.b = s; q.sample = false; } else { q.b = s - 32; q.base = 8192 + q.b * 2048; q.T = 2048; q.grid = 1; q.sample = true; } return q; }

DI float rw_shift(const bf16_t* ZR, const float* mu, int base, int t, int T, int grid, int col) {
  const bf16_t* pp = ZR + (size_t)(base + t) * ZRW + col;
  const float y = bf2f(*pp);
  if (!grid) {
    const float prev = t > 0 ? bf2f(pp[-ZRW]) : 0.f, nxt = t < T - 1 ? bf2f(pp[ZRW]) : 0.f;
    return y + mu[col] * (prev - y) + mu[ZRW + col] * (nxt - y);
  }
  const int gc = t & 63, gr = t >> 6;
  const float left = gc > 0 ? bf2f(pp[-ZRW]) : 0.f, right = gc < 63 ? bf2f(pp[ZRW]) : 0.f;
  const float up = gr > 0 ? bf2f(pp[-64 * ZRW]) : 0.f, down = gr < 31 ? bf2f(pp[64 * ZRW]) : 0.f;
  return y + mu[col] * (left - y) + mu[ZRW + col] * (right - y) + mu[2 * ZRW + col] * (up - y) + mu[3 * ZRW + col] * (down - y);
}

DI void rw_shift8(const bf16_t* ZR, const float* mu, int base, int t, int T, int grid, int col0, float (&out)[8]) {
  const bf16_t* pp = ZR + (size_t)(base + t) * ZRW + col0;
  const bf16x8 y = *(const bf16x8*)pp;
  float yv[8];
#pragma unroll
  for (int e = 0; e < 8; ++e) { yv[e] = bf2f((bf16_t)y[e]); out[e] = yv[e]; }
  const int nn = grid ? 4 : 2;
#pragma unroll 1
  for (int n = 0; n < nn; ++n) {
    bool valid; int off;
    if (!grid) { valid = n == 0 ? t > 0 : t < T - 1; off = n == 0 ? -ZRW : ZRW; }
    else { const int gc = t & 63, gr = t >> 6; valid = n == 0 ? gc > 0 : n == 1 ? gc < 63 : n == 2 ? gr > 0 : gr < 31; off = n == 0 ? -ZRW : n == 1 ? ZRW : n == 2 ? -64 * ZRW : 64 * ZRW; }
    const f32x4 m0 = *(const f32x4*)(mu + n * ZRW + col0), m1 = *(const f32x4*)(mu + n * ZRW + col0 + 4);
    bf16x8 nb = y;
    if (valid) nb = *(const bf16x8*)(pp + off);
#pragma unroll
    for (int e = 0; e < 8; ++e) { const float nv_ = valid ? bf2f((bf16_t)nb[e]) : 0.f; const float mm = e < 4 ? m0[e & 3] : m1[e & 3]; out[e] += mm * (nv_ - yv[e]); }
  }
}

DI void rw_load8(const bf16_t* ZR, int base, int t, int T, int grid, int col0, bf16x8 (&v)[5]) {
  const bf16_t* pp = ZR + (size_t)(base + t) * ZRW + col0;
  const bf16x8 z = (bf16x8){0, 0, 0, 0, 0, 0, 0, 0};
  v[0] = *(const bf16x8*)pp;
  if (!grid) {
    v[1] = t > 0 ? *(const bf16x8*)(pp - ZRW) : z; v[2] = t < T - 1 ? *(const bf16x8*)(pp + ZRW) : z; v[3] = z; v[4] = z;
  } else {
    const int gc = t & 63, gr = t >> 6;
    v[1] = gc > 0 ? *(const bf16x8*)(pp - ZRW) : z; v[2] = gc < 63 ? *(const bf16x8*)(pp + ZRW) : z;
    v[3] = gr > 0 ? *(const bf16x8*)(pp - 64 * ZRW) : z; v[4] = gr < 31 ? *(const bf16x8*)(pp + 64 * ZRW) : z;
  }
}
DI void rw_apply8(const bf16x8 (&v)[5], const float* mu, int grid, int col0, float (&out)[8]) {
  float yv[8];
#pragma unroll
  for (int e = 0; e < 8; ++e) { yv[e] = bf2f((bf16_t)v[0][e]); out[e] = yv[e]; }
#pragma unroll
  for (int n = 0; n < 4; ++n) {
    if (n < 2 || grid) {
      const f32x4 m0 = *(const f32x4*)(mu + n * ZRW + col0), m1 = *(const f32x4*)(mu + n * ZRW + col0 + 4);
#pragma unroll
      for (int e = 0; e < 8; ++e) out[e] += (e < 4 ? m0[e & 3] : m1[e & 3]) * (bf2f((bf16_t)v[1 + n][e]) - yv[e]);
    }
  }
}

DI float dpp_ror8(float x) { return __int_as_float(__builtin_amdgcn_mov_dpp(__float_as_int(x), 0x128, 0xF, 0xF, true)); }
DI float dpp_ror4(float x) { return __int_as_float(__builtin_amdgcn_mov_dpp(__float_as_int(x), 0x124, 0xF, 0xF, true)); }
DI float dpp_hmirror(float x) { return __int_as_float(__builtin_amdgcn_mov_dpp(__float_as_int(x), 0x141, 0xF, 0xF, true)); }
DI float fast_tanh(float x) { return 1.0f - 2.0f / (1.0f + __expf(2.0f * x)); }

template <int KPL>
DI void rwkv_item(const Params& p, int l, int s, int hh, int d, int rb, char* smem) {
  constexpr int LPR = 64 / KPL, RPB = NTHR / LPR;
  const Seq q = get_seq(s);
  const int tid = ltid(), lane = tid & 63, w = tid >> 6;
  const bf16_t* ZR = (const bf16_t*)(p.ws + OFF_ZR);
  bf16_t* O = (bf16_t*)(p.ws + OFF_O);
  const float* mu = p.in[I_MU] + (size_t)l * 4 * ZRW;
  bf16_t* Wb2 = (bf16_t*)smem;
  bf16_t* Ab2 = Wb2 + 64 * 72;
  bf16_t* actW = Ab2 + 64 * 72;
  bf16_t* actA = actW + 16 * 72;
  float* sh = (float*)(actA + 16 * 72);
  float* vW = sh + 3 * 1024;
  float* vKK = vW + 1024; float* vKKA = vKK + 1024; float* vKD = vKKA + 1024; float* outb = vKD + 1024;
  float* part = outb + 1024;
  __syncthreads();
  for (int e = tid; e < 4096; e += NTHR) {
    const int i = e >> 6, c = e & 63;
    Wb2[c * 72 + i] = f2bf(p.in[I_W2][((size_t)(l * 2 + d) * 64 + i) * 512 + 64 * hh + c]);
    Ab2[c * 72 + i] = f2bf(p.in[I_A2][((size_t)(l * 2 + d) * 64 + i) * 512 + 64 * hh + c]);
  }
  const int cB = 16 * w + (lane & 15), qB = lane >> 4;
  const float w0c = p.in[I_W0][(l * 2 + d) * 512 + 64 * hh + cB], a0c = p.in[I_A0][(l * 2 + d) * 512 + 64 * hh + cB];
  const float kkc = p.in[I_KK][l * 512 + 64 * hh + cB], kac = p.in[I_KA][l * 512 + 64 * hh + cB];
  const int rowl = tid / LPR, row = rb * RPB + rowl, kb0 = (tid % LPR) * KPL;
  float S[KPL];
  if (q.sample) {
    const float* st = p.in[I_SR] + ((((size_t)q.b * 2 + l) * 2 + d) * 8 + hh) * 4096 + row * 64 + kb0;
#pragma unroll
    for (int i = 0; i < KPL; ++i) S[i] = st[i];
  } else {
#pragma unroll
    for (int i = 0; i < KPL; ++i) S[i] = 0.f;
  }
  __syncthreads();
  bf16x8 bW[2], bA[2];
#pragma unroll
  for (int ks = 0; ks < 2; ++ks) { bW[ks] = *(const bf16x8*)(Wb2 + cB * 72 + ks * 32 + qB * 8); bA[ks] = *(const bf16x8*)(Ab2 + cB * 72 + ks * 32 + qB * 8); }
  const int nch = q.T / 16;
  bf16x8 pf[3][5];
#define RW_COL(arr, c8) ((arr) == 0 ? 64 * hh + (c8) : (arr) == 1 ? 512 + 64 * hh + (c8) : (arr) == 2 ? 1024 + 64 * hh + (c8) : (arr) == 3 ? 1536 + 64 * d + (c8) : 1664 + 64 * d + (c8))
#define RW_ISSUE(chn) { _Pragma("unroll") for (int gi = 0; gi < 3; ++gi) { const int g = tid + gi * NTHR; if (g < 640) { \
      const int arr = g >> 7, rem = g & 127, j = rem >> 3, c8 = (rem & 7) * 8; const int pos = (chn) * 16 + j, t = d ? q.T - 1 - pos : pos; \
      rw_load8(ZR, q.base, t, q.T, q.grid, RW_COL(arr, c8), pf[gi]); } } }
  RW_ISSUE(0)
#pragma unroll 1
  for (int ch = 0; ch < nch; ++ch) {
    __syncthreads();
#pragma unroll
    for (int gi = 0; gi < 3; ++gi) {
      const int g = tid + gi * NTHR;
      if (g < 640) {
        const int arr = g >> 7, rem = g & 127, j = rem >> 3, c8 = (rem & 7) * 8;
        float val[8];
        rw_apply8(pf[gi], mu, q.grid, RW_COL(arr, c8), val);
        if (arr < 3) {
          *(f32x4*)(sh + arr * 1024 + j * 64 + c8) = (f32x4){val[0], val[1], val[2], val[3]};
          *(f32x4*)(sh + arr * 1024 + j * 64 + c8 + 4) = (f32x4){val[4], val[5], val[6], val[7]};
        } else {
          bf16x8 o8;
#pragma unroll
          for (int e = 0; e < 8; ++e) o8[e] = (short)f2bf(arr == 3 ? fast_tanh(val[e]) : val[e]);
          *(bf16x8*)((arr == 3 ? actW : actA) + j * 72 + c8) = o8;
        }
      }
    }
    if (ch + 1 < nch) RW_ISSUE(ch + 1)
    __syncthreads();
    {
      f32x4 aw = (f32x4){0.f, 0.f, 0.f, 0.f}, aa = (f32x4){0.f, 0.f, 0.f, 0.f};
#pragma unroll
      for (int ks = 0; ks < 2; ++ks) {
        const bf16x8 fw = *(const bf16x8*)(actW + (lane & 15) * 72 + ks * 32 + qB * 8);
        const bf16x8 fa = *(const bf16x8*)(actA + (lane & 15) * 72 + ks * 32 + qB * 8);
        aw = __builtin_amdgcn_mfma_f32_16x16x32_bf16(fw, bW[ks], aw, 0, 0, 0);
        aa = __builtin_amdgcn_mfma_f32_16x16x32_bf16(fa, bA[ks], aa, 0, 0, 0);
      }
      float ssq[4];
#pragma unroll
      for (int jj = 0; jj < 4; ++jj) {
        const int j = qB * 4 + jj;
        const float wl = aw[jj] + w0c, al = aa[jj] + a0c;
        const float wlog = -softplusf_(-wl) - 0.5f;
        const float decay = __expf(-__expf(wlog));
        const float a = sigmoidf_(al);
        const float k = sh[1024 + j * 64 + cB];
        const float kkr = k * kkc;
        ssq[jj] = kkr * kkr;
        vW[j * 64 + cB] = decay; vKK[j * 64 + cB] = kkr; vKKA[j * 64 + cB] = kkr * a; vKD[j * 64 + cB] = k * (1.0f + (a - 1.0f) * kac);
      }
#pragma unroll
      for (int jj = 0; jj < 4; ++jj) { float v_ = ssq[jj]; v_ += dpp_ror8(v_); v_ += dpp_ror4(v_); v_ += dpp_xor2(v_); v_ += dpp_xor1(v_); ssq[jj] = v_; }
      if ((lane & 15) == 0) {
#pragma unroll
        for (int jj = 0; jj < 4; ++jj) part[w * 16 + qB * 4 + jj] = ssq[jj];
      }
    }
    __syncthreads();
#pragma unroll 2
    for (int j = 0; j < 16; ++j) {
      const float inv2 = 1.0f / fmaxf(part[j] + part[16 + j] + part[32 + j] + part[48 + j], 1e-24f);
      const float vv = sh[2048 + j * 64 + row];
      float kk[KPL], ww[KPL], ka[KPL], kd[KPL], rr[KPL];
#pragma unroll
      for (int u = 0; u < KPL / 4; ++u) {
        const int o = j * 64 + kb0 + 4 * u;
        f32x4 t0 = *(const f32x4*)(vKK + o), t1 = *(const f32x4*)(vW + o), t2 = *(const f32x4*)(vKKA + o), t3 = *(const f32x4*)(vKD + o), t4 = *(const f32x4*)(sh + o);
#pragma unroll
        for (int e = 0; e < 4; ++e) { kk[4 * u + e] = t0[e]; ww[4 * u + e] = t1[e]; ka[4 * u + e] = t2[e]; kd[4 * u + e] = t3[e]; rr[4 * u + e] = t4[e]; }
      }
      f32x2 dp2 = (f32x2){0.f, 0.f}, dq2 = (f32x2){0.f, 0.f};
#pragma unroll
      for (int i = 0; i < KPL; i += 4) {
        dp2 += (f32x2){S[i], S[i + 1]} * (f32x2){kk[i], kk[i + 1]};
        dq2 += (f32x2){S[i + 2], S[i + 3]} * (f32x2){kk[i + 2], kk[i + 3]};
      }
      float dot = (dp2[0] + dp2[1]) + (dq2[0] + dq2[1]);
      if (LPR == 16) { dot += dpp_ror8(dot); dot += dpp_ror4(dot); }
      dot += dpp_xor2(dot); dot += dpp_xor1(dot);
      if (LPR == 8) dot += dpp_hmirror(dot);
      const float sa = -dot * inv2;
      const f32x2 sa2 = (f32x2){sa, sa}, vv2 = (f32x2){vv, vv};
      f32x2 op2 = (f32x2){0.f, 0.f}, oq2 = (f32x2){0.f, 0.f};
#pragma unroll
      for (int i = 0; i < KPL; i += 4) {
        f32x2 s0 = (f32x2){S[i], S[i + 1]}, s1 = (f32x2){S[i + 2], S[i + 3]};
        s0 = s0 * (f32x2){ww[i], ww[i + 1]} + (sa2 * (f32x2){ka[i], ka[i + 1]} + vv2 * (f32x2){kd[i], kd[i + 1]});
        s1 = s1 * (f32x2){ww[i + 2], ww[i + 3]} + (sa2 * (f32x2){ka[i + 2], ka[i + 3]} + vv2 * (f32x2){kd[i + 2], kd[i + 3]});
        op2 += s0 * (f32x2){rr[i], rr[i + 1]}; oq2 += s1 * (f32x2){rr[i + 2], rr[i + 3]};
        S[i] = s0[0]; S[i + 1] = s0[1]; S[i + 2] = s1[0]; S[i + 3] = s1[1];
      }
      float od = (op2[0] + op2[1]) + (oq2[0] + oq2[1]);
      if (LPR == 16) { od += dpp_ror8(od); od += dpp_ror4(od); }
      od += dpp_xor2(od); od += dpp_xor1(od);
      if (LPR == 8) od += dpp_hmirror(od);
      if ((tid % LPR) == 0) outb[j * RPB + rowl] = od;
    }
    __syncthreads();
    for (int e = tid; e < 16 * RPB; e += NTHR) {
      const int j = e / RPB, c = e % RPB, pos = ch * 16 + j, t = d ? q.T - 1 - pos : pos;
      O[(size_t)(q.base + t) * 1024 + d * 512 + 64 * hh + rb * RPB + c] = f2bf(outb[e]);
    }
  }
  if (!q.sample) {
    float* dst = p.out + OUT_RW + ((((size_t)q.b * 2 + l) * 2 + d) * 8 + hh) * 4096 + row * 64 + kb0;
#pragma unroll
    for (int i = 0; i < KPL; ++i) dst[i] = S[i];
  }
}

DI void hgrn_item(const Params& p, int l, int s, int hh, int d, char* smem) {
  const Seq q = get_seq(s);
  const int tid = ltid(), lane = tid & 63, w = tid >> 6, r = lane & 31, h = lane >> 5;
  bf16_t* ZH = (bf16_t*)(p.ws + OFF_ZH);
  bf16_t* Qt = (bf16_t*)smem;
  bf16_t* Kt = Qt + 32 * 136;
  bf16_t* KhT = Kt + 32 * 136;
  bf16_t* VT = KhT + 128 * 40;
  bf16_t* Sb = VT + 128 * 40;
  bf16_t* At = Sb + 4 * 32 * 136;
  float* dL = (float*)(At + 32 * 40);
  float* tot = dL + 128;
  const float lb = ((const float*)(p.ws + OFF_LBS))[l * 512 + 128 * hh + (tid & 127)];
  f32x16 S[4];
  if (q.sample) {
    const float* st = p.in[I_SH] + ((((size_t)q.b * 2 + l) * 2 + d) * 4 + hh) * 16384;
#pragma unroll
    for (int kb = 0; kb < 4; ++kb)
#pragma unroll
      for (int g = 0; g < 16; ++g) S[kb][g] = st[(size_t)(32 * kb + crow(g, h)) * 128 + 32 * w + r];
  } else {
#pragma unroll
    for (int kb = 0; kb < 4; ++kb)
#pragma unroll
      for (int g = 0; g < 16; ++g) S[kb][g] = 0.f;
  }
  const int k = tid & 127, half = tid >> 7;
  const int nch = q.T / 32;
  u16x2 pzq[16], pv2[8];
#define HG_ISSUE(chn) { _Pragma("unroll") for (int jj = 0; jj < 16; ++jj) { const int pos = (chn) * 32 + half * 16 + jj, t = d ? q.T - 1 - pos : pos; \
      const size_t rowo = (size_t)(q.base + t) * ZHW + 128 * hh + k; pzq[jj][0] = ZH[rowo + 512 * (1 + d)]; pzq[jj][1] = ZH[rowo]; pv2[jj >> 1][jj & 1] = ZH[rowo + 1536]; } }
  HG_ISSUE(0)
#pragma unroll 1
  for (int ch = 0; ch < nch; ++ch) {
    __syncthreads();
    float bl[16], kc[16], qs[16];
    {
      float b = 0.f;
#pragma unroll
      for (int jj = 0; jj < 16; ++jj) {
        const float z = bf2f(pzq[jj][0]);
        const float kcoef = (1.0f - lb) * sigmoidf_(-z);
        const float f = 1.0f - kcoef;
        b += fmaxf(__logf(f), -80.f);
        bl[jj] = b; kc[jj] = kcoef; qs[jj] = bf2f(pzq[jj][1]) * 0.08838834764831845f;
      }
      *(u32x4*)(VT + k * 40 + half * 16) = (u32x4){__builtin_bit_cast(unsigned, pv2[0]), __builtin_bit_cast(unsigned, pv2[1]), __builtin_bit_cast(unsigned, pv2[2]), __builtin_bit_cast(unsigned, pv2[3])};
      *(u32x4*)(VT + k * 40 + half * 16 + 8) = (u32x4){__builtin_bit_cast(unsigned, pv2[4]), __builtin_bit_cast(unsigned, pv2[5]), __builtin_bit_cast(unsigned, pv2[6]), __builtin_bit_cast(unsigned, pv2[7])};
      tot[half * 128 + k] = b;
    }
    if (ch + 1 < nch) HG_ISSUE(ch + 1)
    __syncthreads();
    {
      const float off = half ? tot[k] : 0.f;
      const float bL = fmaxf(tot[k] + tot[128 + k], -80.f);
      if (half == 0) dL[k] = __expf(bL);
      float kh[16];
#pragma unroll
      for (int jj = 0; jj < 16; ++jj) {
        const int j = half * 16 + jj;
        const float bj = fmaxf(off + bl[jj], -80.f);
        Qt[j * 136 + k] = f2bf(qs[jj] * __expf(bj));
        Kt[j * 136 + k] = f2bf(kc[jj] * __expf(-bj));
        kh[jj] = kc[jj] * __expf(fminf(bL - bj, 0.f));
      }
      *(u32x4*)(KhT + k * 40 + half * 16) = (u32x4){pk2(kh[0], kh[1]), pk2(kh[2], kh[3]), pk2(kh[4], kh[5]), pk2(kh[6], kh[7])};
      *(u32x4*)(KhT + k * 40 + half * 16 + 8) = (u32x4){pk2(kh[8], kh[9]), pk2(kh[10], kh[11]), pk2(kh[12], kh[13]), pk2(kh[14], kh[15])};
    }
    bf16_t* Sbw = Sb + w * 32 * 136;
#pragma unroll
    for (int kb = 0; kb < 4; ++kb)
#pragma unroll
      for (int g4 = 0; g4 < 4; ++g4) *(u32x2*)(Sbw + r * 136 + 32 * kb + crow(4 * g4, h)) = (u32x2){pk2(S[kb][4 * g4], S[kb][4 * g4 + 1]), pk2(S[kb][4 * g4 + 2], S[kb][4 * g4 + 3])};
    __syncthreads();
    bf16_t* Atw = At;
    {
      f32x16 A;
#pragma unroll
      for (int g = 0; g < 16; ++g) A[g] = 0.f;
      mma32(A, Qt, 136, Kt, 136, 128, lane);
#pragma unroll
      for (int g = 0; g < 16; ++g) { const int t = crow(g, h); Atw[t * 40 + r] = f2bf(r <= t ? A[g] : 0.f); }
    }
    __syncthreads();
    {
      f32x16 o;
#pragma unroll
      for (int g = 0; g < 16; ++g) o[g] = 0.f;
      mma32(o, Atw, 40, VT + 32 * w * 40, 40, 32, lane);
      mma32(o, Qt, 136, Sbw, 136, 128, lane);
#pragma unroll
      for (int g = 0; g < 16; ++g) {
        const int j = crow(g, h), pos = ch * 32 + j, t = d ? q.T - 1 - pos : pos;
        ZH[(size_t)(q.base + t) * ZHW + 512 * (1 + d) + 128 * hh + 32 * w + r] = f2bf(o[g]);
      }
#pragma unroll
      for (int kb = 0; kb < 4; ++kb) {
#pragma unroll
        for (int g = 0; g < 16; ++g) S[kb][g] *= dL[32 * kb + crow(g, h)];
        mma32(S[kb], KhT + 32 * kb * 40, 40, VT + 32 * w * 40, 40, 32, lane);
      }
    }
  }
  if (!q.sample) {
    float* dst = p.out + OUT_HG + ((((size_t)q.b * 2 + l) * 2 + d) * 4 + hh) * 16384;
#pragma unroll
    for (int kb = 0; kb < 4; ++kb)
#pragma unroll
      for (int g = 0; g < 16; ++g) dst[(size_t)(32 * kb + crow(g, h)) * 128 + 32 * w + r] = S[kb][g];
  }
}

DI void mlstm_item(const Params& p, int l, int s, int hh, int d, char* smem) {
  const Seq q = get_seq(s);
  const int tid = ltid(), lane = tid & 63, w = tid >> 6, r = lane & 31, h = lane >> 5;
  const bf16_t* ZM = (const bf16_t*)(p.ws + OFF_ZM);
  const float* MG = (const float*)(p.ws + OFF_MG);
  bf16_t* Hb = (bf16_t*)(p.ws + OFF_H);
  bf16_t* Qm = (bf16_t*)smem;
  bf16_t* Km = Qm + 32 * 136;
  bf16_t* KwT = Km + 32 * 136;
  bf16_t* VT = KwT + 128 * 40;
  bf16_t* Cb = VT + 128 * 40;
  bf16_t* Pt = Cb + 4 * 32 * 136;
  float* nv = (float*)(Pt + 32 * 40);
  float* sc = nv + 128;
  float* ig = sc; float* lf = sc + 32; float* gg = sc + 64; float* mtv = sc + 96; float* wi = sc + 128; float* wsr = sc + 160; float* qn = sc + 192; float* misc = sc + 224;
  float* dnw = sc + 232;
  const float gbi = p.in[I_GB][l * 16 + (2 * d) * 4 + hh], gbf = p.in[I_GB][l * 16 + (2 * d + 1) * 4 + hh];
  f32x16 C[4];
  float m;
  __syncthreads();
  if (q.sample) {
    const size_t sb = (((size_t)q.b * 2 + l) * 2 + d) * 4 + hh;
    const float* st = p.in[I_SC] + sb * 16384;
#pragma unroll
    for (int kb = 0; kb < 4; ++kb)
#pragma unroll
      for (int g = 0; g < 16; ++g) C[kb][g] = st[(size_t)(32 * kb + crow(g, h)) * 128 + 32 * w + r];
    if (tid < 128) nv[tid] = p.in[I_SN][sb * 128 + tid];
    m = p.in[I_SM][sb];
  } else {
#pragma unroll
    for (int kb = 0; kb < 4; ++kb)
#pragma unroll
      for (int g = 0; g < 16; ++g) C[kb][g] = 0.f;
    if (tid < 128) nv[tid] = 0.f;
    m = 0.f;
  }
  const int nch = q.T / 32;
  const int dd = tid & 127, half = tid >> 7;
  u16x2 pqk[16], pv2[8]; float pgi = 0.f, pgf = 0.f;
#define ML_ISSUE(chn) { _Pragma("unroll") for (int jj = 0; jj < 16; ++jj) { const int pos = (chn) * 32 + half * 16 + jj, t = d ? q.T - 1 - pos : pos; \
      const size_t rowo = (size_t)(q.base + t) * ZMW + 128 * hh + dd; pqk[jj][0] = ZM[rowo]; pqk[jj][1] = ZM[rowo + 512]; pv2[jj >> 1][jj & 1] = ZM[rowo + 1024]; } \
    if (tid < 32) { const int pos = (chn) * 32 + tid, t = d ? q.T - 1 - pos : pos; const float* mg = MG + (size_t)(q.base + t) * 16; pgi = mg[(2 * d) * 4 + hh]; pgf = mg[(2 * d + 1) * 4 + hh]; } }
  ML_ISSUE(0)
#pragma unroll 1
  for (int ch = 0; ch < nch; ++ch) {
    __syncthreads();
    {
#pragma unroll
      for (int jj = 0; jj < 16; ++jj) {
        const int j = half * 16 + jj;
        Qm[j * 136 + dd] = pqk[jj][0];
        Km[j * 136 + dd] = f2bf(bf2f(pqk[jj][1]) * 0.08838834764831845f);
      }
      *(u32x4*)(VT + dd * 40 + half * 16) = (u32x4){__builtin_bit_cast(unsigned, pv2[0]), __builtin_bit_cast(unsigned, pv2[1]), __builtin_bit_cast(unsigned, pv2[2]), __builtin_bit_cast(unsigned, pv2[3])};
      *(u32x4*)(VT + dd * 40 + half * 16 + 8) = (u32x4){__builtin_bit_cast(unsigned, pv2[4]), __builtin_bit_cast(unsigned, pv2[5]), __builtin_bit_cast(unsigned, pv2[6]), __builtin_bit_cast(unsigned, pv2[7])};
      if (tid < 32) {
        const float igv = pgi + gbi;
        const float lfv = -softplusf_(-(pgf + gbf));
        float g = lfv;
#pragma unroll
        for (int o = 1; o < 32; o <<= 1) { const float tt = shfl_lane(g, (lane - o) & 63); if (tid >= o) g += tt; }
        const float cs = igv - g;
        float pm = cs;
#pragma unroll
        for (int o = 1; o < 32; o <<= 1) { const float tt = shfl_lane(pm, (lane - o) & 63); if (tid >= o) pm = fmaxf(pm, tt); }
        const float mt = g + fmaxf(m, pm);
        const float gend = shfl_lane(g, 31), mn = shfl_lane(mt, 31);
        ig[tid] = igv; gg[tid] = g; mtv[tid] = mt; wi[tid] = __expf(g + m - mt);
        wsr[tid] = __expf(gend + cs - mn);
        if (tid == 0) { misc[0] = mn; misc[1] = __expf(gend + m - mn); }
      }
    }
    if (ch + 1 < nch) ML_ISSUE(ch + 1)
    __syncthreads();
    {
      {
        float kw[16];
#pragma unroll
        for (int jj = 0; jj < 16; ++jj) { const int j = half * 16 + jj; kw[jj] = bf2f(Km[j * 136 + dd]) * wsr[j]; }
        *(u32x4*)(KwT + dd * 40 + half * 16) = (u32x4){pk2(kw[0], kw[1]), pk2(kw[2], kw[3]), pk2(kw[4], kw[5]), pk2(kw[6], kw[7])};
        *(u32x4*)(KwT + dd * 40 + half * 16 + 8) = (u32x4){pk2(kw[8], kw[9]), pk2(kw[10], kw[11]), pk2(kw[12], kw[13]), pk2(kw[14], kw[15])};
      }
      const int j = tid >> 3, seg = tid & 7;
      float a = 0.f;
#pragma unroll
      for (int i = 0; i < 16; ++i) a += bf2f(Qm[j * 136 + seg * 16 + i]) * nv[seg * 16 + i];
      a += SHX(a, 1); a += SHX(a, 2); a += SHX(a, 4);
      if (seg == 0) qn[j] = a;
    }
    const float m_new = misc[0], carry = misc[1];
    bf16_t* Cbw = Cb + w * 32 * 136; bf16_t* Ptw = Pt;
#pragma unroll
    for (int kb = 0; kb < 4; ++kb)
#pragma unroll
      for (int g4 = 0; g4 < 4; ++g4) *(u32x2*)(Cbw + r * 136 + 32 * kb + crow(4 * g4, h)) = (u32x2){pk2(C[kb][4 * g4], C[kb][4 * g4 + 1]), pk2(C[kb][4 * g4 + 2], C[kb][4 * g4 + 3])};
    {
      f32x16 Sc;
#pragma unroll
      for (int g = 0; g < 16; ++g) Sc[g] = 0.f;
      mma32(Sc, Qm, 136, Km, 136, 128, lane);
      const float gs = gg[r], is = ig[r];
#pragma unroll
      for (int g = 0; g < 16; ++g) {
        const int t = crow(g, h);
        const float pv = (r <= t) ? __expf(gg[t] - gs + is - mtv[t]) * Sc[g] : 0.f;
        Ptw[t * 40 + r] = f2bf(pv);
      }
    }
    __syncthreads();
    if (lane < 32) {
      float a = 0.f;
#pragma unroll 4
      for (int i = 0; i < 32; ++i) a += bf2f(Ptw[lane * 40 + i]);
      const float den = wi[lane] * qn[lane] + a;
      dnw[lane] = 1.0f / fmaxf(fabsf(den), __expf(-mtv[lane]));
    }
    if (tid < 128) {
      float a = 0.f;
#pragma unroll 4
      for (int i = 0; i < 32; ++i) a += bf2f(KwT[tid * 40 + i]);
      nv[tid] = carry * nv[tid] + a;
    }
    __syncthreads();
    {
      f32x16 a1;
#pragma unroll
      for (int g = 0; g < 16; ++g) a1[g] = 0.f;
      mma32(a1, Qm, 136, Cbw, 136, 128, lane);
#pragma unroll
      for (int g = 0; g < 16; ++g) a1[g] *= wi[crow(g, h)];
      mma32(a1, Ptw, 40, VT + 32 * w * 40, 40, 32, lane);
#pragma unroll
      for (int g = 0; g < 16; ++g) {
        const int j = crow(g, h), pos = ch * 32 + j, t = d ? q.T - 1 - pos : pos;
        const float hv = a1[g] * dnw[j];
        Hb[(size_t)(q.base + t) * 1024 + d * 512 + 128 * hh + 32 * w + r] = f2bf(hv);
      }
#pragma unroll
      for (int kb = 0; kb < 4; ++kb) {
#pragma unroll
        for (int g = 0; g < 16; ++g) C[kb][g] *= carry;
        mma32(C[kb], KwT + 32 * kb * 40, 40, VT + 32 * w * 40, 40, 32, lane);
      }
    }
    m = m_new;
  }
  __syncthreads();
  if (!q.sample) {
    const size_t sb = (((size_t)q.b * 2 + l) * 2 + d) * 4 + hh;
    float* dst = p.out + OUT_C + sb * 16384;
#pragma unroll
    for (int kb = 0; kb < 4; ++kb)
#pragma unroll
      for (int g = 0; g < 16; ++g) dst[(size_t)(32 * kb + crow(g, h)) * 128 + 32 * w + r] = C[kb][g];
    if (tid < 128) p.out[OUT_N + sb * 128 + tid] = nv[tid];
    if (tid == 0) p.out[OUT_M + sb] = m;
  }
}

DI void phase_scan(const Params& p, int l, char* smem) {
  int* ctrL = (int*)(p.ws + OFF_CTR) + 2 * l;
  int* ctrS = ctrL + 1;
  int* sit = (int*)(smem + LDS_BYTES - 16);
  const int role = p.role;
  bool longDone = false, shortDone = false;
  for (;;) {
    const bool wantLong = (role == 0) ? !longDone : shortDone;
    if (longDone && shortDone) break;
    __syncthreads();
    if (ltid() == 0) *sit = atomicAdd(wantLong ? ctrL : ctrS, 1);
    __syncthreads();
    int it = __builtin_amdgcn_readfirstlane(*sit);
    int ty, s_, hh_, d_, rb_ = 0;
    if (wantLong) {
      if (it >= 192) { longDone = true; continue; }
      if (it < 128) { ty = 3; rb_ = it & 1; d_ = (it >> 1) & 1; hh_ = (it >> 2) & 7; s_ = 32 + (it >> 5); }
      else if (it < 160) { it -= 128; ty = 1; s_ = 32 + (it >> 3); hh_ = (it >> 1) & 3; d_ = it & 1; }
      else { it -= 160; ty = 2; s_ = 32 + (it >> 3); hh_ = (it >> 1) & 3; d_ = it & 1; }
    } else {
      if (it >= 1024) { shortDone = true; continue; }
      if (it < 512) { ty = 0; s_ = it >> 4; hh_ = (it >> 1) & 7; d_ = it & 1; }
      else if (it < 768) { it -= 512; ty = 1; s_ = it >> 3; hh_ = (it >> 1) & 3; d_ = it & 1; }
      else { it -= 768; ty = 2; s_ = it >> 3; hh_ = (it >> 1) & 3; d_ = it & 1; }
    }
    if (ty == 0) rwkv_item<16>(p, l, s_, hh_, d_, 0, smem);
    else if (ty == 3) rwkv_item<8>(p, l, s_, hh_, d_, rb_, smem);
    else if (ty == 1) hgrn_item(p, l, s_, hh_, d_, smem);
    else mlstm_item(p, l, s_, hh_, d_, smem);
  }
}

DI void phase_combine(const Params& p, int l, char* smem) {
  const int tid = ltid(), lane = tid & 63, w = tid >> 6;
  bf16_t* ZH = (bf16_t*)(p.ws + OFF_ZH); bf16_t* ZM = (bf16_t*)(p.ws + OFF_ZM); const bf16_t* ZR = (const bf16_t*)(p.ws + OFF_ZR);
  bf16_t* O = (bf16_t*)(p.ws + OFF_O); const bf16_t* Hb = (const bf16_t*)(p.ws + OFF_H);
  const float* mu = p.in[I_MU] + (size_t)l * 4 * ZRW;
  const float* g2 = p.in[I_G2] + (size_t)l * 128 * 512;
  float* sg = (float*)smem;
  float* gt = sg + 128 * 16;
  for (int blk = blockIdx.x; blk < NT / 16; blk += gridDim.x) {
    const int tok0 = blk * 16;
    int sidx, t0;
    if (tok0 < 8192) { sidx = tok0 >> 8; t0 = tok0 & 255; } else { sidx = 32 + ((tok0 - 8192) >> 11); t0 = (tok0 - 8192) & 2047; }
    const Seq q = get_seq(sidx);
    __syncthreads();
    { const int j = tid >> 4, rr0 = (tid & 15) * 8; float val[8]; bf16x8 pv[5]; rw_load8(ZR, q.base, t0 + j, q.T, q.grid, 1792 + rr0, pv); rw_apply8(pv, mu, q.grid, 1792 + rr0, val);
#pragma unroll
      for (int e = 0; e < 8; ++e) sg[(rr0 + e) * 16 + j] = sigmoidf_(val[e]); }
    __syncthreads();
    {
      float a0[16], a1[16];
#pragma unroll
      for (int j = 0; j < 16; ++j) { a0[j] = 0.f; a1[j] = 0.f; }
#pragma unroll 1
      for (int r0 = 0; r0 < 128; r0 += 8) {
        float w0v[8], w1v[8];
#pragma unroll
        for (int q8 = 0; q8 < 8; ++q8) { w0v[q8] = g2[(r0 + q8) * 512 + tid]; w1v[q8] = g2[(r0 + q8) * 512 + 256 + tid]; }
#pragma unroll
        for (int q8 = 0; q8 < 8; ++q8) {
          const int rr = r0 + q8; const float w0 = w0v[q8], w1 = w1v[q8];
#pragma unroll
          for (int u = 0; u < 4; ++u) {
            f32x4 sv = *(const f32x4*)(sg + rr * 16 + 4 * u);
#pragma unroll
            for (int e = 0; e < 4; ++e) { a0[4 * u + e] += sv[e] * w0; a1[4 * u + e] += sv[e] * w1; }
          }
        }
      }
#pragma unroll
      for (int j = 0; j < 16; ++j) { gt[j * 512 + tid] = a0[j]; gt[j * 512 + 256 + tid] = a1[j]; }
    }
    __syncthreads();
#pragma unroll 1
    for (int jj = 0; jj < 4; ++jj) {
      const int j = w * 4 + jj, tok = tok0 + j, t = t0 + j; int c0 = lane * 8; asm volatile("" : "+v"(c0));
      {
        float o[8], rs[8], ks[8], vs[8];
        float sum = 0.f, bon = 0.f;
        {
          bf16x8 pr_[5], pk_[5], pv_[5];
          rw_load8(ZR, q.base, t, q.T, q.grid, c0, pr_); rw_load8(ZR, q.base, t, q.T, q.grid, 512 + c0, pk_); rw_load8(ZR, q.base, t, q.T, q.grid, 1024 + c0, pv_);
          rw_apply8(pr_, mu, q.grid, c0, rs); rw_apply8(pk_, mu, q.grid, 512 + c0, ks); rw_apply8(pv_, mu, q.grid, 1024 + c0, vs);
        }
        const bf16x8 of = *(const bf16x8*)(O + (size_t)tok * 1024 + c0), ob = *(const bf16x8*)(O + (size_t)tok * 1024 + 512 + c0);
        const f32x4 rk0 = *(const f32x4*)(p.in[I_RK] + l * 512 + c0), rk1 = *(const f32x4*)(p.in[I_RK] + l * 512 + c0 + 4);
#pragma unroll
        for (int e = 0; e < 8; ++e) {
          o[e] = bf2f((bf16_t)of[e]) + bf2f((bf16_t)ob[e]);
          sum += o[e];
          bon += rs[e] * ks[e] * (e < 4 ? rk0[e & 3] : rk1[e & 3]);
        }
        sum += SHX(sum, 1); sum += SHX(sum, 2); sum += SHX(sum, 4);
        bon += SHX(bon, 1); bon += SHX(bon, 2); bon += SHX(bon, 4);
        const float mean = sum * (1.0f / 64.f);
        float var = 0.f;
#pragma unroll
        for (int e = 0; e < 8; ++e) { const float dv = o[e] - mean; var += dv * dv; }
        var += SHX(var, 1); var += SHX(var, 2); var += SHX(var, 4);
        const float rstd = rsqrtf(var * (1.0f / 64.f) + 64e-5f);
        const f32x4 lw0 = *(const f32x4*)(p.in[I_LN] + (l * 2 + 0) * 512 + c0), lw1 = *(const f32x4*)(p.in[I_LN] + (l * 2 + 0) * 512 + c0 + 4);
        const f32x4 lb0 = *(const f32x4*)(p.in[I_LN] + (l * 2 + 1) * 512 + c0), lb1 = *(const f32x4*)(p.in[I_LN] + (l * 2 + 1) * 512 + c0 + 4);
        const f32x4 gt0 = *(const f32x4*)(gt + j * 512 + c0), gt1 = *(const f32x4*)(gt + j * 512 + c0 + 4);
        bf16x8 ov;
#pragma unroll
        for (int e = 0; e < 8; ++e) {
          const float ln = (o[e] - mean) * rstd * (e < 4 ? lw0[e & 3] : lw1[e & 3]) + (e < 4 ? lb0[e & 3] : lb1[e & 3]);
          ov[e] = (short)f2bf((ln + bon * vs[e]) * (e < 4 ? gt0[e & 3] : gt1[e & 3]));
        }
        *(bf16x8*)(O + (size_t)tok * 1024 + c0) = ov;
      }
      {
        float o[8]; float ss = 0.f;
        bf16_t* zr_ = ZH + (size_t)tok * ZHW + c0;
        const bf16x8 of = *(const bf16x8*)(zr_ + 512), ob = *(const bf16x8*)(zr_ + 1024), hgv = *(const bf16x8*)(zr_ + 2048);
        const f32x4 nw0 = *(const f32x4*)(p.in[I_HNORM] + l * 512 + c0), nw1 = *(const f32x4*)(p.in[I_HNORM] + l * 512 + c0 + 4);
#pragma unroll
        for (int e = 0; e < 8; ++e) { o[e] = bf2f((bf16_t)of[e]) + bf2f((bf16_t)ob[e]); ss += o[e] * o[e]; }
        ss += SHX(ss, 1); ss += SHX(ss, 2); ss += SHX(ss, 4); ss += SHX(ss, 8);
        const float rsd = rsqrtf(ss * (1.0f / 128.f) + 1e-6f);
        bf16x8 ov;
#pragma unroll
        for (int e = 0; e < 8; ++e) ov[e] = (short)f2bf(o[e] * rsd * (e < 4 ? nw0[e & 3] : nw1[e & 3]) * siluf_(bf2f((bf16_t)hgv[e])));
        *(bf16x8*)(zr_ + 2048) = ov;
      }
      {
        float o[8]; float ss = 0.f;
        bf16_t* zm_ = ZM + (size_t)tok * ZMW + 1536 + c0;
        const bf16x8 of = *(const bf16x8*)(Hb + (size_t)tok * 1024 + c0), ob = *(const bf16x8*)(Hb + (size_t)tok * 1024 + 512 + c0), mov = *(const bf16x8*)zm_;
        const f32x4 nw0 = *(const f32x4*)(p.in[I_MNORM] + l * 512 + c0), nw1 = *(const f32x4*)(p.in[I_MNORM] + l * 512 + c0 + 4);
#pragma unroll
        for (int e = 0; e < 8; ++e) { o[e] = bf2f((bf16_t)of[e]) + bf2f((bf16_t)ob[e]); ss += o[e] * o[e]; }
        ss += SHX(ss, 1); ss += SHX(ss, 2); ss += SHX(ss, 4); ss += SHX(ss, 8);
        const float rsd = rsqrtf(ss * (1.0f / 128.f) + 1e-6f);
        bf16x8 ov;
#pragma unroll
        for (int e = 0; e < 8; ++e) ov[e] = (short)f2bf(o[e] * rsd * (e < 4 ? nw0[e & 3] : nw1[e & 3]) * sigmoidf_(bf2f((bf16_t)mov[e])));
        *(bf16x8*)zm_ = ov;
      }
    }
    __syncthreads();
#pragma unroll 1
    for (int jj = 0; jj < 4; ++jj) tok_one(p, l, 3, tok0 + w * 4 + jj, lane);
  }
}

#define XB_TMO      128
#define XB_XCNT(j)  (256  + 64 * (j))
#define XB_XSUB(j)  (1280 + 64 * (j))
#define XB_XGEN(j)  (2304 + 64 * (j))
#define XB_TOP      3328
#define XB_TOPGEN   3392
#define XCD_BAR_WORDS 3456
#define XB_SPIN_CAP (1u << 20)
#define LAS __attribute__((address_space(3)))
DI unsigned xb_ld(unsigned* p)              { return __hip_atomic_load(p, __ATOMIC_RELAXED, __HIP_MEMORY_SCOPE_AGENT); }
DI unsigned xb_add(unsigned* p, unsigned v) { return __hip_atomic_fetch_add(p, v, __ATOMIC_RELAXED, __HIP_MEMORY_SCOPE_AGENT); }
DI unsigned xb_xcc_id() { return (unsigned)__builtin_amdgcn_s_getreg((3 << 11) | 20) & 0xFu; }
#define XB_SPIN(cond, bar) do { unsigned _sp = 0; while (cond) { __builtin_amdgcn_s_sleep(1); \
    if ((++_sp & 255u) == 0u) { if (xb_ld(&(bar)[XB_TMO])) break; if (_sp > XB_SPIN_CAP) { atomicAdd(&(bar)[XB_TMO], 1u); break; } } } } while (0)
struct XcdBarrier { unsigned* bar; unsigned x; volatile LAS unsigned* st; };
DI XcdBarrier xcd_barrier_post(const Params& p, unsigned* bar, volatile LAS unsigned* st) {
  XcdBarrier b; b.bar = bar; b.x = xb_xcc_id(); b.st = st;
  if (ltid() == 0) (void)xb_add(&bar[XB_XCNT(b.x)], 1u);
  return b;
}
DI void xcd_barrier_complete(unsigned* bar, unsigned x, unsigned& nloc, unsigned& nx) {
  const unsigned G = gridDim.x * gridDim.y * gridDim.z;
  unsigned sum, cnt, mine, sp = 0u;
  for (;;) {
    sum = 0u; cnt = 0u; mine = 0u;
#pragma unroll
    for (unsigned j = 0; j < 16; ++j) { const unsigned c = xb_ld(&bar[XB_XCNT(j)]); sum += c; cnt += (c > 0u) ? 1u : 0u; mine = (j == x) ? c : mine; }
    if (sum == G) break;
    __builtin_amdgcn_s_sleep(1);
    if ((++sp & 255u) == 0u) { if (xb_ld(&bar[XB_TMO])) break; if (sp > XB_SPIN_CAP) { atomicAdd(&bar[XB_TMO], 1u); break; } }
  }
  nloc = mine > 0u ? mine : 1u; nx = cnt > 0u ? cnt : 1u;
}
DI void xcd_barrier(const Params& p, const XcdBarrier& b) {
  asm volatile("s_waitcnt vmcnt(0)" ::: "memory");
  __syncthreads();
  if (ltid() == 0) {
    unsigned* bar = b.bar;
    __builtin_amdgcn_s_waitcnt(0);
    unsigned nloc = b.st[0], nx = b.st[1];
    if (nloc == 0u) { xcd_barrier_complete(bar, b.x, nloc, nx); b.st[0] = nloc; b.st[1] = nx; }
    const unsigned old = xb_add(&bar[XB_XSUB(b.x)], 1u);
    const unsigned gen = old / nloc;
    if (old + 1u == (gen + 1u) * nloc) {
      __builtin_amdgcn_fence(__ATOMIC_RELEASE, "agent");
      asm volatile("s_waitcnt vmcnt(0)" ::: "memory");
      const unsigned og = xb_add(&bar[XB_TOP], 1u);
      const unsigned tg = og / nx;
      if (og + 1u == (tg + 1u) * nx) xb_add(&bar[XB_TOPGEN], 1u);
      else XB_SPIN(xb_ld(&bar[XB_TOPGEN]) == tg, bar);
      __builtin_amdgcn_fence(__ATOMIC_ACQUIRE, "agent");
      xb_add(&bar[XB_XGEN(b.x)], 1u);
      asm volatile("s_waitcnt vmcnt(0)" ::: "memory");
    } else {
      XB_SPIN(xb_ld(&bar[XB_XGEN(b.x)]) == gen, bar);
      __builtin_amdgcn_fence(__ATOMIC_ACQUIRE, "agent");
      asm volatile("s_waitcnt vmcnt(0)" ::: "memory");
    }
  }
  __syncthreads();
}

constexpr int NPHASE = 3 + 9 * 2;
DI void run_phase(const Params& p0, int ph, char* smem) {
  Params p = p0;
  asm volatile("" : "+s"(p.ws), "+s"(p.out));
  if (ph == 0) { phase0(p, smem); return; }
  if (ph == 1) { phase1(p); return; }
  if (ph == 2) { tok_phase(p, 0, 0); return; }
  const int l = (ph - 3) / 9, s = (ph - 3) % 9;
  switch (s) {
    case 0: phase_inproj(p, smem); break;
    case 1: phase_scan(p, l, smem); break;
    case 2: phase_combine(p, l, smem); break;
    case 3: phase_merge(p, l, smem); break;
    case 4: phase_gemm_f32(p, (const bf16_t*)(p.ws + OFF_MERGED), 1024, (const bf16_t*)(p.ws + OFF_WTOUT), smem); break;
    case 5: tok_phase(p, l, 1); break;
    case 6: phase_ffn_in(p, smem); break;
    case 7: phase_gemm_f32(p, (const bf16_t*)(p.ws + OFF_ACT), DFF, (const bf16_t*)(p.ws + OFF_WTFO), smem); break;
    case 8:
      tok_phase(p, l, 2);
      if (l + 1 < 2) {
        conv_weight(p, p.in[I_WIN] + (size_t)(l + 1) * 1024 * DIN, DIN, (bf16_t*)(p.ws + OFF_WTIN), 1024, WTIN_ROWS, 0, (float*)smem, blockIdx.x, gridDim.x);
        for (int br = 0; br < 3; ++br) conv_weight(p, p.in[I_WBR] + ((size_t)(l + 1) * 3 + br) * 512 * 1024, 1024, (bf16_t*)(p.ws + OFF_WTBR) + (size_t)br * 1024 * 512, 512, 1024, 1, (float*)smem, blockIdx.x, gridDim.x);
      }
      break;
  }
}

template <bool COOP>
__global__ void __launch_bounds__(NTHR, 2) mega(Params pk, int lo, int hi) {
  __shared__ __attribute__((aligned(16))) char smem[LDS_BYTES];
  Params p = pk;
  p.wb = __builtin_amdgcn_readfirstlane((int)threadIdx.x) & ~63;
  if (COOP) {
    volatile LAS unsigned* st = (volatile LAS unsigned*)(smem + LDS_BYTES - 32);
    if (ltid() == 0) { st[0] = 0u; st[1] = 0u; }
    __syncthreads();
    phase0(p, smem);
    cg::this_grid().sync();
    XcdBarrier b = xcd_barrier_post(p, (unsigned*)(p.ws + OFF_BAR), st);
    if (ltid() == 0) {
      const unsigned hwid = (unsigned)__builtin_amdgcn_s_getreg((31 << 11) | 4);
      const unsigned key = (xb_xcc_id() << 8) | ((hwid >> 8) & 0xFFu);
      ((int*)smem)[(LDS_BYTES - 12) / 4] = (int)xb_add((unsigned*)(p.ws + OFF_ROLE) + key, 1u);
    }
    __syncthreads();
    p.role = __builtin_amdgcn_readfirstlane(((int*)smem)[(LDS_BYTES - 12) / 4]);
    for (int ph = 1; ph < hi; ++ph) {
      run_phase(p, ph, smem);
      if (ph + 1 < hi) xcd_barrier(p, b);
    }
  } else {
    for (int ph = lo; ph < hi; ++ph) run_phase(p, ph, smem);
  }
}

extern "C" void kernel_launch(void* const* d_in, const int* in_sizes, int n_in, void* d_out, int out_size, void* d_ws, size_t ws_size, hipStream_t stream) {
  Params p{};
  for (int i = 0; i < N_IN; ++i) p.in[i] = (const float*)d_in[i];
  p.out = (float*)d_out; p.ws = (char*)d_ws;
  if (ws_size < WS_NEED) fprintf(stderr, "workspace too small: %zu < %zu\n", ws_size, (size_t)WS_NEED);
  static int grid_blocks = 0;
  if (!grid_blocks) {
    int dev = 0, cus = 0, per_cu = 0;
    hipGetDevice(&dev);
    hipDeviceGetAttribute(&cus, hipDeviceAttributeMultiprocessorCount, dev);
    hipOccupancyMaxActiveBlocksPerMultiprocessor(&per_cu, mega<true>, NTHR, 0);
    if (per_cu > 2) per_cu = 2;
    grid_blocks = cus * per_cu;
  }
  int lo = 0, hi = NPHASE;
  void* args[] = {&p, &lo, &hi};
  hipError_t e = hipLaunchCooperativeKernel((void*)mega<true>, dim3(grid_blocks), dim3(NTHR), args, 0, stream);
  if (e != hipSuccess) fprintf(stderr, "cooperative launch failed: %s (grid %d)\n", hipGetErrorString(e), grid_blocks);
}
```

```cpp
#include <hip/hip_runtime.h>
#include <hip/hip_cooperative_groups.h>
#include <cstdio>
namespace cg = cooperative_groups;

typedef unsigned short bf16_t;
typedef short bf16x8 __attribute__((ext_vector_type(8)));
typedef float f32x4 __attribute__((ext_vector_type(4)));
typedef float f32x2 __attribute__((ext_vector_type(2)));
typedef float f32x16 __attribute__((ext_vector_type(16)));
typedef unsigned short u16x4 __attribute__((ext_vector_type(4)));
typedef unsigned short u16x2 __attribute__((ext_vector_type(2)));
typedef unsigned u32x4 __attribute__((ext_vector_type(4)));
typedef unsigned u32x2 __attribute__((ext_vector_type(2)));
static __device__ __forceinline__ unsigned pk2(float lo, float hi) { typedef __bf16 b2 __attribute__((ext_vector_type(2))); typedef float f2 __attribute__((ext_vector_type(2))); return __builtin_bit_cast(unsigned, __builtin_convertvector((f2){lo, hi}, b2)); }

#define DI __device__ __forceinline__

constexpr int NT = 16384;
constexpr int DM = 1024;
constexpr int NTHR = 256;
constexpr int DIN = 9616;
constexpr int ZHW = 2560, ZRW = 1920, ZMW = 2048;
constexpr int WTIN_ROWS = 9728;
constexpr int DFF = 2816;

constexpr size_t OFF_WTIN = 0;
constexpr size_t OFF_WTBR = OFF_WTIN + (size_t)WTIN_ROWS * 1024 * 2;
constexpr size_t OFF_H    = OFF_WTBR + (size_t)3 * 1024 * 512 * 2;
constexpr size_t OFF_ZH   = OFF_H + (size_t)NT * 1024 * 2;
constexpr size_t OFF_ZR   = OFF_ZH + (size_t)NT * ZHW * 2;
constexpr size_t OFF_ZM   = OFF_ZR + (size_t)NT * ZRW * 2;
constexpr size_t OFF_MG   = OFF_ZM + (size_t)NT * ZMW * 2;
constexpr size_t OFF_O    = OFF_MG + (size_t)NT * 16 * 4;
constexpr size_t OFF_MOD  = OFF_O + (size_t)NT * 1024 * 2;
constexpr size_t OFF_LBS  = OFF_MOD + (size_t)2 * 5 * 6144 * 4;
constexpr size_t OFF_CTR  = OFF_LBS + 2 * 512 * 4;
constexpr size_t OFF_BAR  = OFF_CTR + 256;
constexpr size_t OFF_ROLE = OFF_BAR + 3456 * 4;
constexpr size_t WS_NEED  = OFF_ROLE + 4096 * 4;
constexpr size_t OFF_MODP = OFF_ZH;
constexpr size_t OFF_WTOUT = OFF_ZR;
constexpr size_t OFF_WTFI  = OFF_WTOUT + (size_t)1024 * 1024 * 2;
constexpr size_t OFF_WTFO  = OFF_WTFI + (size_t)5632 * 1024 * 2;
constexpr size_t OFF_MERGED = OFF_WTFO + (size_t)1024 * 2816 * 2;
constexpr size_t OFF_Y    = OFF_ZH;
constexpr size_t OFF_ACT  = OFF_ZM;

constexpr size_t OUT_HG = 16777216, OUT_RW = 25165824, OUT_C = 29360128, OUT_N = 37748736, OUT_M = 37814272;

enum { I_XP = 0, I_XS, I_SH, I_SR, I_SC, I_SN, I_SM, I_C, I_CCTX, I_WADA, I_BADA, I_NORMS, I_WIN, I_HLB, I_HNORM, I_MU, I_W0, I_W2,
       I_A0, I_A2, I_G2, I_KK, I_KA, I_RK, I_LN, I_GB, I_MNORM, I_WBR, I_WOUT, I_WFI, I_WFO, N_IN };

struct Params { const float* in[N_IN]; float* out; char* ws; int wb; int role; };

constexpr int LDS_BYTES = 77824;

DI bf16_t f2bf(float f) { return __builtin_bit_cast(unsigned short, (__bf16)f); }
DI float bf2f(bf16_t h) { return __uint_as_float(((unsigned)h) << 16); }
DI float sigmoidf_(float x) { return 1.0f / (1.0f + __expf(-x)); }
DI float siluf_(float x) { return x / (1.0f + __expf(-x)); }
DI float softplusf_(float x) { return x > 20.f ? x : __logf(1.0f + __expf(x)); }
DI float dpp_xor1(float x) { return __int_as_float(__builtin_amdgcn_mov_dpp(__float_as_int(x), 0xB1, 0xF, 0xF, true)); }
DI float dpp_xor2(float x) { return __int_as_float(__builtin_amdgcn_mov_dpp(__float_as_int(x), 0x4E, 0xF, 0xF, true)); }
DI float shfl_lane(float v, int src) { return __int_as_float(__builtin_amdgcn_ds_bpermute(src << 2, __float_as_int(v))); }
#define SHX(v, m) shfl_lane((v), lane ^ (m))
DI float wave_sum(float v, int lane) { v += dpp_xor1(v); v += dpp_xor2(v); v += SHX(v, 4); v += SHX(v, 8); v += SHX(v, 16); v += SHX(v, 32); return v; }
DI int ltid_(int wb) { int t = wb + (int)__builtin_amdgcn_mbcnt_hi(~0u, __builtin_amdgcn_mbcnt_lo(~0u, 0u)); asm volatile("" : "+v"(t)); return t; }
#define ltid() ltid_(p.wb)
DI int crow(int reg, int h) { return (reg & 3) + 8 * (reg >> 2) + 4 * h; }

DI int tok_cond(int tok) { return tok < 8192 ? 0 : 1 + ((tok - 8192) >> 11); }
DI const float* x_in_row(const Params& p, int tok) { return tok < 8192 ? p.in[I_XP] + (size_t)tok * DM : p.in[I_XS] + (size_t)(tok - 8192) * DM; }

DI void mma32(f32x16& acc, const bf16_t* A, int lda, const bf16_t* B, int ldb, int K, int lane) {
  const int r = lane & 31, h = lane >> 5;
#pragma unroll 2
  for (int kk = 0; kk < K; kk += 16) {
    bf16x8 a = *(const bf16x8*)(A + r * lda + kk + 8 * h);
    bf16x8 b = *(const bf16x8*)(B + r * ldb + kk + 8 * h);
    acc = __builtin_amdgcn_mfma_f32_32x32x16_bf16(a, b, acc, 0, 0, 0);
  }
}

template <int BM, int BN, int BK>
DI void gemm_main(const Params& p, f32x4 (&acc)[BM / 32][BN / 32], const bf16_t* __restrict__ A, int lda, const bf16_t* __restrict__ B, int ldb, int K, bf16_t* sm) {
  constexpr int MI = BM / 32, NJ = BN / 32, LS = BK + 8, CPR = BK / 8, ACH = BM * BK / 2048, BCH = BN * BK / 2048, KS = BK / 32, RPI = 256 / CPR;
  const int tid = ltid(), lane = tid & 63, w = tid >> 6, wm = w >> 1, wn = w & 1;
  bf16_t* As = sm; bf16_t* Bs = sm + 2 * BM * LS;
  bf16x8 ra[ACH], rb[BCH];
  const int nk = K / BK;
  const int lrow = tid / CPR, lkc = (tid % CPR) * 8;
#pragma unroll
  for (int i = 0; i < ACH; ++i) ra[i] = *(const bf16x8*)(A + (size_t)(lrow + RPI * i) * lda + lkc);
#pragma unroll
  for (int i = 0; i < BCH; ++i) rb[i] = *(const bf16x8*)(B + (size_t)(lrow + RPI * i) * ldb + lkc);
  __syncthreads();
#pragma unroll
  for (int i = 0; i < ACH; ++i) *(bf16x8*)(As + (lrow + RPI * i) * LS + lkc) = ra[i];
#pragma unroll
  for (int i = 0; i < BCH; ++i) *(bf16x8*)(Bs + (lrow + RPI * i) * LS + lkc) = rb[i];
  __syncthreads();
  for (int kt = 0; kt < nk; ++kt) {
    const int buf = kt & 1;
    if (kt + 1 < nk) {
      const int k0 = (kt + 1) * BK + lkc;
#pragma unroll
      for (int i = 0; i < ACH; ++i) ra[i] = *(const bf16x8*)(A + (size_t)(lrow + RPI * i) * lda + k0);
#pragma unroll
      for (int i = 0; i < BCH; ++i) rb[i] = *(const bf16x8*)(B + (size_t)(lrow + RPI * i) * ldb + k0);
    }
    const bf16_t* as = As + buf * BM * LS + (wm * (BM / 2) + (lane & 15)) * LS + (lane >> 4) * 8;
    const bf16_t* bs = Bs + buf * BN * LS + (wn * (BN / 2) + (lane & 15)) * LS + (lane >> 4) * 8;
#pragma unroll
    for (int ks = 0; ks < KS; ++ks) {
      bf16x8 bfr[NJ];
#pragma unroll
      for (int j = 0; j < NJ; ++j) bfr[j] = *(const bf16x8*)(bs + j * 16 * LS + ks * 32);
#pragma unroll
      for (int i = 0; i < MI; ++i) {
        const bf16x8 af = *(const bf16x8*)(as + i * 16 * LS + ks * 32);
#pragma unroll
        for (int j = 0; j < NJ; ++j) acc[i][j] = __builtin_amdgcn_mfma_f32_16x16x32_bf16(bfr[j], af, acc[i][j], 0, 0, 0);
      }
    }
    if (kt + 1 < nk) {
      const int nb = buf ^ 1;
#pragma unroll
      for (int i = 0; i < ACH; ++i) *(bf16x8*)(As + nb * BM * LS + (lrow + RPI * i) * LS + lkc) = ra[i];
#pragma unroll
      for (int i = 0; i < BCH; ++i) *(bf16x8*)(Bs + nb * BN * LS + (lrow + RPI * i) * LS + lkc) = rb[i];
    }
    __syncthreads();
  }
}

template <int MI, int NJ> DI void zero_acc(f32x4 (&acc)[MI][NJ]) {
#pragma unroll
  for (int i = 0; i < MI; ++i)
#pragma unroll
    for (int j = 0; j < NJ; ++j) acc[i][j] = (f32x4){0.f, 0.f, 0.f, 0.f};
}
DI void store_bf4(bf16_t* dst, f32x4 v) { u16x4 o; o[0] = f2bf(v[0]); o[1] = f2bf(v[1]); o[2] = f2bf(v[2]); o[3] = f2bf(v[3]); *(u16x4*)dst = o; }

DI int map_col(int mode, int n) {
  if (mode == 0) return n < 6544 ? n : (n < 6656 ? -1 : n - 112);
  if (mode == 2) return ((n >> 4) & 1) ? DFF + (n >> 5) * 16 + (n & 15) : (n >> 5) * 16 + (n & 15);
  return n;
}
DI void conv_tile(const Params& p, const float* __restrict__ src, int ld_src, bf16_t* __restrict__ dst, int K, int mode, int tk, int tn, float* sm) {
  const int tid = ltid();
  __syncthreads();
  {
    const int nn = tid & 63, col = map_col(mode, tn * 64 + nn);
#pragma unroll
    for (int i = 0; i < 16; ++i) { int kk = (tid >> 6) + 4 * i; sm[kk * 65 + nn] = col >= 0 ? src[(size_t)(tk * 64 + kk) * ld_src + col] : 0.f; }
  }
  __syncthreads();
  {
    const int kk = tid & 63;
#pragma unroll
    for (int i = 0; i < 16; ++i) { int nn = (tid >> 6) + 4 * i; dst[(size_t)(tn * 64 + nn) * K + tk * 64 + kk] = f2bf(sm[kk * 65 + nn]); }
  }
}
DI void conv_weight(const Params& p, const float* src, int ld_src, bf16_t* dst, int K, int Ndst, int mode, float* sm, int bid, int nb) {
  const int tkn = K / 64, nt = tkn * (Ndst / 64);
  for (int t = bid; t < nt; t += nb) conv_tile(p, src, ld_src, dst, K, mode, t % tkn, t / tkn, sm);
}

DI void phase0(const Params& p, char* smem) {
  const int tid = ltid(), bid = blockIdx.x, nb = gridDim.x;
  float* MODP = (float*)(p.ws + OFF_MODP);
  float* sm = (float*)smem;
  if (bid == 0) { if (tid < 64) ((int*)(p.ws + OFF_CTR))[tid] = 0; for (int i = tid; i < 3456; i += NTHR) ((unsigned*)(p.ws + OFF_BAR))[i] = 0u; for (int i = tid; i < 4096; i += NTHR) ((unsigned*)(p.ws + OFF_ROLE))[i] = 0u; }
  for (int i = bid * NTHR + tid; i < 512; i += nb * NTHR) {
    float a = p.in[I_HLB][i], b = p.in[I_HLB][512 + i];
    float* L = (float*)(p.ws + OFF_LBS); L[i] = 0.f; L[512 + i] = 1.0f / (1.0f + expf(a - b));
  }
  for (int it = bid; it < 2 * 24 * 16; it += nb) {
    const int ks = it & 15, jb = (it >> 4) % 24, l = it / (16 * 24);
    __syncthreads();
    for (int e = tid; e < 5 * 64; e += NTHR) { int ci = e >> 6, k = ks * 64 + (e & 63); float cv = ci == 0 ? p.in[I_CCTX][k] : p.in[I_C][(ci - 1) * DM + k]; sm[e] = siluf_(cv); }
    __syncthreads();
    const int j = jb * 256 + tid;
    float a0 = 0, a1 = 0, a2 = 0, a3 = 0, a4 = 0;
    const float* W = p.in[I_WADA] + ((size_t)l * DM + ks * 64) * 6144 + j;
#pragma unroll 1
    for (int k0 = 0; k0 < 64; k0 += 16) {
      float wv[16];
#pragma unroll
      for (int u = 0; u < 16; ++u) wv[u] = W[(size_t)(k0 + u) * 6144];
#pragma unroll
      for (int u = 0; u < 16; ++u) { const int k = k0 + u; const float w = wv[u]; a0 += sm[k] * w; a1 += sm[64 + k] * w; a2 += sm[128 + k] * w; a3 += sm[192 + k] * w; a4 += sm[256 + k] * w; }
    }
    float* dst = MODP + ((size_t)(ks * 2 + l) * 5) * 6144 + j;
    dst[0] = a0; dst[6144] = a1; dst[2 * 6144] = a2; dst[3 * 6144] = a3; dst[4 * 6144] = a4;
  }
  conv_weight(p, p.in[I_WIN], DIN, (bf16_t*)(p.ws + OFF_WTIN), 1024, WTIN_ROWS, 0, sm, bid, nb);
  for (int br = 0; br < 3; ++br) conv_weight(p, p.in[I_WBR] + (size_t)br * 512 * 1024, 1024, (bf16_t*)(p.ws + OFF_WTBR) + (size_t)br * 1024 * 512, 512, 1024, 1, sm, bid, nb);
}
DI void phase1(const Params& p) {
  const float* MODP = (const float*)(p.ws + OFF_MODP);
  float* MOD = (float*)(p.ws + OFF_MOD);
  for (int i = blockIdx.x * NTHR + ltid(); i < 2 * 5 * 6144; i += gridDim.x * NTHR) {
    const int j = i % 6144, l = i / (5 * 6144);
    float s = p.in[I_BADA][l * 6144 + j];
    for (int ks = 0; ks < 16; ++ks) s += MODP[(size_t)ks * 2 * 5 * 6144 + i];
    MOD[i] = s;
  }
}

DI void norm_mod_store(const f32x4 (&x)[4], const float* nw, const float* sc, const float* sh, bf16_t* hrow, int lane) {
  float ss = 0.f;
#pragma unroll
  for (int i = 0; i < 4; ++i) ss += x[i][0] * x[i][0] + x[i][1] * x[i][1] + x[i][2] * x[i][2] + x[i][3] * x[i][3];
  ss = wave_sum(ss, lane);
  const float rs = rsqrtf(ss * (1.0f / DM) + 1e-6f);
#pragma unroll
  for (int i = 0; i < 4; ++i) {
    const int c = i * 256 + lane * 4;
    f32x4 w = *(const f32x4*)(nw + c), s1 = *(const f32x4*)(sc + c), s0 = *(const f32x4*)(sh + c), o;
#pragma unroll
    for (int e = 0; e < 4; ++e) o[e] = x[i][e] * rs * w[e] * (1.0f + s1[e]) + s0[e];
    store_bf4(hrow + c, o);
  }
}
DI void tok_one(const Params& p, int l, int mode, int tok, int lane) {
  const float* MOD = (const float*)(p.ws + OFF_MOD);
  bf16_t* H = (bf16_t*)(p.ws + OFF_H);
  const float* Y = (const float*)(p.ws + OFF_Y);
  const int ci = tok_cond(tok);
  const float* modl = MOD + (size_t)(l * 5 + ci) * 6144;
  const float* nwl = p.in[I_NORMS] + (size_t)l * 4 * DM;
  const bool from_in = (l == 0 && (mode == 0 || mode == 1 || mode == 3));
  const float* xr = from_in ? x_in_row(p, tok) : p.out + (size_t)tok * DM;
  f32x4 x[4];
#pragma unroll
  for (int i = 0; i < 4; ++i) x[i] = *(const f32x4*)(xr + i * 256 + lane * 4);
  if (mode == 1 || mode == 2) {
    f32x4 y[4]; float ss = 0.f;
#pragma unroll
    for (int i = 0; i < 4; ++i) { y[i] = *(const f32x4*)(Y + (size_t)tok * DM + i * 256 + lane * 4); ss += y[i][0] * y[i][0] + y[i][1] * y[i][1] + y[i][2] * y[i][2] + y[i][3] * y[i][3]; }
    ss = wave_sum(ss, lane);
    const float rs = rsqrtf(ss * (1.0f / DM) + 1e-6f);
    const float* nw = nwl + (mode == 1 ? 1 : 3) * DM;
    const float* g = modl + (mode == 1 ? 2 : 5) * DM;
#pragma unroll
    for (int i = 0; i < 4; ++i) {
      const int c = i * 256 + lane * 4;
      f32x4 w = *(const f32x4*)(nw + c), gg = *(const f32x4*)(g + c);
#pragma unroll
      for (int e = 0; e < 4; ++e) x[i][e] += gg[e] * (y[i][e] * rs * w[e]);
      *(f32x4*)(p.out + (size_t)tok * DM + c) = x[i];
    }
  }
  if (mode == 0 || mode == 3) norm_mod_store(x, nwl, modl + 1 * DM, modl + 0 * DM, H + (size_t)tok * DM, lane);
  else if (mode == 1) norm_mod_store(x, nwl + 2 * DM, modl + 4 * DM, modl + 3 * DM, H + (size_t)tok * DM, lane);
  else if (mode == 2 && l + 1 < 2) {
    const float* modn = MOD + (size_t)((l + 1) * 5 + ci) * 6144;
    norm_mod_store(x, p.in[I_NORMS] + (size_t)(l + 1) * 4 * DM, modn + 1 * DM, modn + 0 * DM, H + (size_t)tok * DM, lane);
  }
}
DI void tok_phase(const Params& p, int l, int mode) {
  const int lane = ltid() & 63, gw = blockIdx.x * 4 + (ltid() >> 6), nw = gridDim.x * 4;
  for (int tok = gw; tok < NT; tok += nw) tok_one(p, l, mode, tok, lane);
}

DI bool tile_xcd(int i, int NTN, int MTX, int& mt, int& nt) {
  const int G = gridDim.x, b = blockIdx.x, x = b & 7, j = b >> 3, nbx = (G - x + 7) >> 3;
  const int u = j + i * nbx;
  if (u >= MTX * NTN) return false;
  mt = MTX * x + (u % MTX); nt = u / MTX;
  return true;
}
DI void phase_inproj(const Params& p, char* smem) {
  const bf16_t* H = (const bf16_t*)(p.ws + OFF_H);
  const bf16_t* WT = (const bf16_t*)(p.ws + OFF_WTIN);
  bf16_t* ZH = (bf16_t*)(p.ws + OFF_ZH); bf16_t* ZR = (bf16_t*)(p.ws + OFF_ZR); bf16_t* ZM = (bf16_t*)(p.ws + OFF_ZM);
  float* MG = (float*)(p.ws + OFF_MG);
  const int lane = ltid() & 63, w = ltid() >> 6, wm = w >> 1, wn = w & 1;
  int mt, nt;
  for (int ti = 0; tile_xcd(ti, 52, 8, mt, nt); ++ti) {
    f32x4 acc[8][4]; zero_acc<8, 4>(acc);
    gemm_main<256, 128, 32>(p, acc, H + (size_t)mt * 256 * 1024, 1024, WT + (size_t)nt * 128 * 1024, 1024, 1024, (bf16_t*)smem);
    const int n0 = nt * 128;
#pragma unroll
    for (int i = 0; i < 8; ++i) {
      const int row = mt * 256 + wm * 128 + i * 16 + (lane & 15);
#pragma unroll
      for (int j = 0; j < 4; ++j) {
        const int col = n0 + wn * 64 + j * 16 + 4 * (lane >> 4);
        if (n0 < 2560) store_bf4(ZH + (size_t)row * ZHW + col, acc[i][j]);
        else if (n0 < 4480) store_bf4(ZR + (size_t)row * ZRW + (col - 2560), acc[i][j]);
        else if (n0 < 6528) store_bf4(ZM + (size_t)row * ZMW + (col - 4480), acc[i][j]);
        else if (col - 6528 < 16) *(f32x4*)(MG + (size_t)row * 16 + (col - 6528)) = acc[i][j];
      }
    }
  }
}

DI void phase_merge(const Params& p, int l, char* smem) {
  const bf16_t* H = (const bf16_t*)(p.ws + OFF_H);
  const bf16_t* WT = (const bf16_t*)(p.ws + OFF_WTIN);
  const bf16_t* WBR = (const bf16_t*)(p.ws + OFF_WTBR);
  const bf16_t* ZH = (const bf16_t*)(p.ws + OFF_ZH); const bf16_t* ZM = (const bf16_t*)(p.ws + OFF_ZM); const bf16_t* O = (const bf16_t*)(p.ws + OFF_O);
  bf16_t* MER = (bf16_t*)(p.ws + OFF_MERGED);
  const int lane = ltid() & 63, w = ltid() >> 6, wm = w >> 1, wn = w & 1;
  int mt, nt;
  for (int ti = 0; tile_xcd(ti, 16, 16, mt, nt); ++ti) {
    f32x4 accM[4][2]; zero_acc<4, 2>(accM);
#pragma unroll 1
    for (int br = 0; br < 3; ++br) {
      f32x4 accG[4][2], accP[4][2]; zero_acc<4, 2>(accG); zero_acc<4, 2>(accP);
      gemm_main<128, 64, 64>(p, accG, H + (size_t)mt * 128 * 1024, 1024, WT + (size_t)(6656 + br * 1024 + nt * 64) * 1024, 1024, 1024, (bf16_t*)smem);
      const bf16_t* Ab; int lda;
      if (br == 0) { Ab = ZH + 2048; lda = ZHW; } else if (br == 1) { Ab = O; lda = 1024; } else { Ab = ZM + 1536; lda = ZMW; }
      gemm_main<128, 64, 64>(p, accP, Ab + (size_t)mt * 128 * lda, lda, WBR + ((size_t)br * 1024 + nt * 64) * 512, 512, 512, (bf16_t*)smem);
#pragma unroll
      for (int i = 0; i < 4; ++i)
#pragma unroll
        for (int j = 0; j < 2; ++j)
#pragma unroll
          for (int e = 0; e < 4; ++e) accM[i][j][e] += sigmoidf_(accG[i][j][e]) * accP[i][j][e];
    }
#pragma unroll
    for (int i = 0; i < 4; ++i) {
      const int row = mt * 128 + wm * 64 + i * 16 + (lane & 15);
#pragma unroll
      for (int j = 0; j < 2; ++j) store_bf4(MER + (size_t)row * 1024 + nt * 64 + wn * 32 + j * 16 + 4 * (lane >> 4), accM[i][j]);
    }
  }
  float* sm = (float*)smem;
  conv_weight(p, p.in[I_WOUT] + (size_t)l * 1024 * 1024, 1024, (bf16_t*)(p.ws + OFF_WTOUT), 1024, 1024, 1, sm, blockIdx.x, gridDim.x);
  conv_weight(p, p.in[I_WFI] + (size_t)l * 1024 * 5632, 5632, (bf16_t*)(p.ws + OFF_WTFI), 1024, 5632, 2, sm, blockIdx.x, gridDim.x);
  conv_weight(p, p.in[I_WFO] + (size_t)l * DFF * 1024, 1024, (bf16_t*)(p.ws + OFF_WTFO), DFF, 1024, 1, sm, blockIdx.x, gridDim.x);
}

DI void phase_gemm_f32(const Params& p, const bf16_t* A, int K, const bf16_t* Wt, char* smem) {
  float* Y = (float*)(p.ws + OFF_Y);
  const int lane = ltid() & 63, w = ltid() >> 6, wm = w >> 1, wn = w & 1;
  int mt, nt;
  for (int ti = 0; tile_xcd(ti, 8, 8, mt, nt); ++ti) {
    f32x4 acc[8][4]; zero_acc<8, 4>(acc);
    gemm_main<256, 128, 32>(p, acc, A + (size_t)mt * 256 * K, K, Wt + (size_t)nt * 128 * K, K, K, (bf16_t*)smem);
#pragma unroll
    for (int i = 0; i < 8; ++i) {
      const int row = mt * 256 + wm * 128 + i * 16 + (lane & 15);
#pragma unroll
      for (int j = 0; j < 4; ++j) *(f32x4*)(Y + (size_t)row * 1024 + nt * 128 + wn * 64 + j * 16 + 4 * (lane >> 4)) = acc[i][j];
    }
  }
}
DI void phase_ffn_in(const Params& p, char* smem) {
  const bf16_t* H = (const bf16_t*)(p.ws + OFF_H);
  const bf16_t* Wt = (const bf16_t*)(p.ws + OFF_WTFI);
  bf16_t* ACT = (bf16_t*)(p.ws + OFF_ACT);
  const int lane = ltid() & 63, w = ltid() >> 6, wm = w >> 1, wn = w & 1;
  int mt, nt;
  for (int ti = 0; tile_xcd(ti, 44, 8, mt, nt); ++ti) {
    f32x4 acc[8][4]; zero_acc<8, 4>(acc);
    gemm_main<256, 128, 32>(p, acc, H + (size_t)mt * 256 * 1024, 1024, Wt + (size_t)nt * 128 * 1024, 1024, 1024, (bf16_t*)smem);
#pragma unroll
    for (int i = 0; i < 8; ++i) {
      const int row = mt * 256 + wm * 128 + i * 16 + (lane & 15);
#pragma unroll
      for (int jj = 0; jj < 2; ++jj) {
        f32x4 u = acc[i][2 * jj], g = acc[i][2 * jj + 1], o;
#pragma unroll
        for (int e = 0; e < 4; ++e) o[e] = siluf_(g[e]) * u[e];
        const int col = (nt * 128 + wn * 64 + jj * 32) / 2 + 4 * (lane >> 4);
        store_bf4(ACT + (size_t)row * DFF + col, o);
      }
    }
  }
}

struct Seq { int base, T, grid, b; bool sample; };
DI Seq get_seq(int s) { Seq q; if (s < 32) { q.base = s * 256; q.T = 256; q.grid = 0; q.b = s; q.sample = false; } else { q.b = s - 32; q.base = 8192 + q.b * 2048; q.T = 2048; q.grid = 1; q.sample = true; } return q; }

DI float rw_shift(const bf16_t* ZR, const float* mu, int base, int t, int T, int grid, int col) {
  const bf16_t* pp = ZR + (size_t)(base + t) * ZRW + col;
  const float y = bf2f(*pp);
  if (!grid) {
    const float prev = t > 0 ? bf2f(pp[-ZRW]) : 0.f, nxt = t < T - 1 ? bf2f(pp[ZRW]) : 0.f;
    return y + mu[col] * (prev - y) + mu[ZRW + col] * (nxt - y);
  }
  const int gc = t & 63, gr = t >> 6;
  const float left = gc > 0 ? bf2f(pp[-ZRW]) : 0.f, right = gc < 63 ? bf2f(pp[ZRW]) : 0.f;
  const float up = gr > 0 ? bf2f(pp[-64 * ZRW]) : 0.f, down = gr < 31 ? bf2f(pp[64 * ZRW]) : 0.f;
  return y + mu[col] * (left - y) + mu[ZRW + col] * (right - y) + mu[2 * ZRW + col] * (up - y) + mu[3 * ZRW + col] * (down - y);
}

DI void rw_shift8(const bf16_t* ZR, const float* mu, int base, int t, int T, int grid, int col0, float (&out)[8]) {
  const bf16_t* pp = ZR + (size_t)(base + t) * ZRW + col0;
  const bf16x8 y = *(const bf16x8*)pp;
  float yv[8];
#pragma unroll
  for (int e = 0; e < 8; ++e) { yv[e] = bf2f((bf16_t)y[e]); out[e] = yv[e]; }
  const int nn = grid ? 4 : 2;
#pragma unroll 1
  for (int n = 0; n < nn; ++n) {
    bool valid; int off;
    if (!grid) { valid = n == 0 ? t > 0 : t < T - 1; off = n == 0 ? -ZRW : ZRW; }
    else { const int gc = t & 63, gr = t >> 6; valid = n == 0 ? gc > 0 : n == 1 ? gc < 63 : n == 2 ? gr > 0 : gr < 31; off = n == 0 ? -ZRW : n == 1 ? ZRW : n == 2 ? -64 * ZRW : 64 * ZRW; }
    const f32x4 m0 = *(const f32x4*)(mu + n * ZRW + col0), m1 = *(const f32x4*)(mu + n * ZRW + col0 + 4);
    bf16x8 nb = y;
    if (valid) nb = *(const bf16x8*)(pp + off);
#pragma unroll
    for (int e = 0; e < 8; ++e) { const float nv_ = valid ? bf2f((bf16_t)nb[e]) : 0.f; const float mm = e < 4 ? m0[e & 3] : m1[e & 3]; out[e] += mm * (nv_ - yv[e]); }
  }
}

DI void rw_load8(const bf16_t* ZR, int base, int t, int T, int grid, int col0, bf16x8 (&v)[5]) {
  const bf16_t* pp = ZR + (size_t)(base + t) * ZRW + col0;
  const bf16x8 z = (bf16x8){0, 0, 0, 0, 0, 0, 0, 0};
  v[0] = *(const bf16x8*)pp;
  if (!grid) {
    v[1] = t > 0 ? *(const bf16x8*)(pp - ZRW) : z; v[2] = t < T - 1 ? *(const bf16x8*)(pp + ZRW) : z; v[3] = z; v[4] = z;
  } else {
    const int gc = t & 63, gr = t >> 6;
    v[1] = gc > 0 ? *(const bf16x8*)(pp - ZRW) : z; v[2] = gc < 63 ? *(const bf16x8*)(pp + ZRW) : z;
    v[3] = gr > 0 ? *(const bf16x8*)(pp - 64 * ZRW) : z; v[4] = gr < 31 ? *(const bf16x8*)(pp + 64 * ZRW) : z;
  }
}
DI void rw_apply8(const bf16x8 (&v)[5], const float* mu, int grid, int col0, float (&out)[8]) {
  float yv[8];
#pragma unroll
  for (int e = 0; e < 8; ++e) { yv[e] = bf2f((bf16_t)v[0][e]); out[e] = yv[e]; }
#pragma unroll
  for (int n = 0; n < 4; ++n) {
    if (n < 2 || grid) {
      const f32x4 m0 = *(const f32x4*)(mu + n * ZRW + col0), m1 = *(const f32x4*)(mu + n * ZRW + col0 + 4);
#pragma unroll
      for (int e = 0; e < 8; ++e) out[e] += (e < 4 ? m0[e & 3] : m1[e & 3]) * (bf2f((bf16_t)v[1 + n][e]) - yv[e]);
    }
  }
}

DI float dpp_ror8(float x) { return __int_as_float(__builtin_amdgcn_mov_dpp(__float_as_int(x), 0x128, 0xF, 0xF, true)); }
DI float dpp_ror4(float x) { return __int_as_float(__builtin_amdgcn_mov_dpp(__float_as_int(x), 0x124, 0xF, 0xF, true)); }
DI float dpp_hmirror(float x) { return __int_as_float(__builtin_amdgcn_mov_dpp(__float_as_int(x), 0x141, 0xF, 0xF, true)); }
DI float fast_tanh(float x) { return 1.0f - 2.0f / (1.0f + __expf(2.0f * x)); }

template <int KPL>
DI void rwkv_item(const Params& p, int l, int s, int hh, int d, int rb, char* smem) {
  constexpr int LPR = 64 / KPL, RPB = NTHR / LPR;
  const Seq q = get_seq(s);
  const int tid = ltid(), lane = tid & 63, w = tid >> 6;
  const bf16_t* ZR = (const bf16_t*)(p.ws + OFF_ZR);
  bf16_t* O = (bf16_t*)(p.ws + OFF_O);
  const float* mu = p.in[I_MU] + (size_t)l * 4 * ZRW;
  bf16_t* Wb2 = (bf16_t*)smem;
  bf16_t* Ab2 = Wb2 + 64 * 72;
  bf16_t* actW = Ab2 + 64 * 72;
  bf16_t* actA = actW + 16 * 72;
  float* sh = (float*)(actA + 16 * 72);
  float* vW = sh + 3 * 1024;
  float* vKK = vW + 1024; float* vKKA = vKK + 1024; float* vKD = vKKA + 1024; float* outb = vKD + 1024;
  float* part = outb + 1024;
  __syncthreads();
  for (int e = tid; e < 4096; e += NTHR) {
    const int i = e >> 6, c = e & 63;
    Wb2[c * 72 + i] = f2bf(p.in[I_W2][((size_t)(l * 2 + d) * 64 + i) * 512 + 64 * hh + c]);
    Ab2[c * 72 + i] = f2bf(p.in[I_A2][((size_t)(l * 2 + d) * 64 + i) * 512 + 64 * hh + c]);
  }
  const int cB = 16 * w + (lane & 15), qB = lane >> 4;
  const float w0c = p.in[I_W0][(l * 2 + d) * 512 + 64 * hh + cB], a0c = p.in[I_A0][(l * 2 + d) * 512 + 64 * hh + cB];
  const float kkc = p.in[I_KK][l * 512 + 64 * hh + cB], kac = p.in[I_KA][l * 512 + 64 * hh + cB];
  const int rowl = tid / LPR, row = rb * RPB + rowl, kb0 = (tid % LPR) * KPL;
  float S[KPL];
  if (q.sample) {
    const float* st = p.in[I_SR] + ((((size_t)q.b * 2 + l) * 2 + d) * 8 + hh) * 4096 + row * 64 + kb0;
#pragma unroll
    for (int i = 0; i < KPL; ++i) S[i] = st[i];
  } else {
#pragma unroll
    for (int i = 0; i < KPL; ++i) S[i] = 0.f;
  }
  __syncthreads();
  bf16x8 bW[2], bA[2];
#pragma unroll
  for (int ks = 0; ks < 2; ++ks) { bW[ks] = *(const bf16x8*)(Wb2 + cB * 72 + ks * 32 + qB * 8); bA[ks] = *(const bf16x8*)(Ab2 + cB * 72 + ks * 32 + qB * 8); }
  const int nch = q.T / 16;
  bf16x8 pf[3][5];
#define RW_COL(arr, c8) ((arr) == 0 ? 64 * hh + (c8) : (arr) == 1 ? 512 + 64 * hh + (c8) : (arr) == 2 ? 1024 + 64 * hh + (c8) : (arr) == 3 ? 1536 + 64 * d + (c8) : 1664 + 64 * d + (c8))
#define RW_ISSUE(chn) { _Pragma("unroll") for (int gi = 0; gi < 3; ++gi) { const int g = tid + gi * NTHR; if (g < 640) { \
      const int arr = g >> 7, rem = g & 127, j = rem >> 3, c8 = (rem & 7) * 8; const int pos = (chn) * 16 + j, t = d ? q.T - 1 - pos : pos; \
      rw_load8(ZR, q.base, t, q.T, q.grid, RW_COL(arr, c8), pf[gi]); } } }
  RW_ISSUE(0)
#pragma unroll 1
  for (int ch = 0; ch < nch; ++ch) {
    __syncthreads();
#pragma unroll
    for (int gi = 0; gi < 3; ++gi) {
      const int g = tid + gi * NTHR;
      if (g < 640) {
        const int arr = g >> 7, rem = g & 127, j = rem >> 3, c8 = (rem & 7) * 8;
        float val[8];
        rw_apply8(pf[gi], mu, q.grid, RW_COL(arr, c8), val);
        if (arr < 3) {
          *(f32x4*)(sh + arr * 1024 + j * 64 + c8) = (f32x4){val[0], val[1], val[2], val[3]};
          *(f32x4*)(sh + arr * 1024 + j * 64 + c8 + 4) = (f32x4){val[4], val[5], val[6], val[7]};
        } else {
          bf16x8 o8;
#pragma unroll
          for (int e = 0; e < 8; ++e) o8[e] = (short)f2bf(arr == 3 ? fast_tanh(val[e]) : val[e]);
          *(bf16x8*)((arr == 3 ? actW : actA) + j * 72 + c8) = o8;
        }
      }
    }
    if (ch + 1 < nch) RW_ISSUE(ch + 1)
    __syncthreads();
    {
      f32x4 aw = (f32x4){0.f, 0.f, 0.f, 0.f}, aa = (f32x4){0.f, 0.f, 0.f, 0.f};
#pragma unroll
      for (int ks = 0; ks < 2; ++ks) {
        const bf16x8 fw = *(const bf16x8*)(actW + (lane & 15) * 72 + ks * 32 + qB * 8);
        const bf16x8 fa = *(const bf16x8*)(actA + (lane & 15) * 72 + ks * 32 + qB * 8);
        aw = __builtin_amdgcn_mfma_f32_16x16x32_bf16(fw, bW[ks], aw, 0, 0, 0);
        aa = __builtin_amdgcn_mfma_f32_16x16x32_bf16(fa, bA[ks], aa, 0, 0, 0);
      }
      float ssq[4];
#pragma unroll
      for (int jj = 0; jj < 4; ++jj) {
        const int j = qB * 4 + jj;
        const float wl = aw[jj] + w0c, al = aa[jj] + a0c;
        const float wlog = -softplusf_(-wl) - 0.5f;
        const float decay = __expf(-__expf(wlog));
        const float a = sigmoidf_(al);
        const float k = sh[1024 + j * 64 + cB];
        const float kkr = k * kkc;
        ssq[jj] = kkr * kkr;
        vW[j * 64 + cB] = decay; vKK[j * 64 + cB] = kkr; vKKA[j * 64 + cB] = kkr * a; vKD[j * 64 + cB] = k * (1.0f + (a - 1.0f) * kac);
      }
#pragma unroll
      for (int jj = 0; jj < 4; ++jj) { float v_ = ssq[jj]; v_ += dpp_ror8(v_); v_ += dpp_ror4(v_); v_ += dpp_xor2(v_); v_ += dpp_xor1(v_); ssq[jj] = v_; }
      if ((lane & 15) == 0) {
#pragma unroll
        for (int jj = 0; jj < 4; ++jj) part[w * 16 + qB * 4 + jj] = ssq[jj];
      }
    }
    __syncthreads();
#pragma unroll 2
    for (int j = 0; j < 16; ++j) {
      const float inv2 = 1.0f / fmaxf(part[j] + part[16 + j] + part[32 + j] + part[48 + j], 1e-24f);
      const float vv = sh[2048 + j * 64 + row];
      float kk[KPL], ww[KPL], ka[KPL], kd[KPL], rr[KPL];
#pragma unroll
      for (int u = 0; u < KPL / 4; ++u) {
        const int o = j * 64 + kb0 + 4 * u;
        f32x4 t0 = *(const f32x4*)(vKK + o), t1 = *(const f32x4*)(vW + o), t2 = *(const f32x4*)(vKKA + o), t3 = *(const f32x4*)(vKD + o), t4 = *(const f32x4*)(sh + o);
#pragma unroll
        for (int e = 0; e < 4; ++e) { kk[4 * u + e] = t0[e]; ww[4 * u + e] = t1[e]; ka[4 * u + e] = t2[e]; kd[4 * u + e] = t3[e]; rr[4 * u + e] = t4[e]; }
      }
      f32x2 dp2 = (f32x2){0.f, 0.f}, dq2 = (f32x2){0.f, 0.f};
#pragma unroll
      for (int i = 0; i < KPL; i += 4) {
        dp2 += (f32x2){S[i], S[i + 1]} * (f32x2){kk[i], kk[i + 1]};
        dq2 += (f32x2){S[i + 2], S[i + 3]} * (f32x2){kk[i + 2], kk[i + 3]};
      }
      float dot = (dp2[0] + dp2[1]) + (dq2[0] + dq2[1]);
      if (LPR == 16) { dot += dpp_ror8(dot); dot += dpp_ror4(dot); }
      dot += dpp_xor2(dot); dot += dpp_xor1(dot);
      if (LPR == 8) dot += dpp_hmirror(dot);
      const float sa = -dot * inv2;
      const f32x2 sa2 = (f32x2){sa, sa}, vv2 = (f32x2){vv, vv};
      f32x2 op2 = (f32x2){0.f, 0.f}, oq2 = (f32x2){0.f, 0.f};
#pragma unroll
      for (int i = 0; i < KPL; i += 4) {
        f32x2 s0 = (f32x2){S[i], S[i + 1]}, s1 = (f32x2){S[i + 2], S[i + 3]};
        s0 = s0 * (f32x2){ww[i], ww[i + 1]} + (sa2 * (f32x2){ka[i], ka[i + 1]} + vv2 * (f32x2){kd[i], kd[i + 1]});
        s1 = s1 * (f32x2){ww[i + 2], ww[i + 3]} + (sa2 * (f32x2){ka[i + 2], ka[i + 3]} + vv2 * (f32x2){kd[i + 2], kd[i + 3]});
        op2 += s0 * (f32x2){rr[i], rr[i + 1]}; oq2 += s1 * (f32x2){rr[i + 2], rr[i + 3]};
        S[i] = s0[0]; S[i + 1] = s0[1]; S[i + 2] = s1[0]; S[i + 3] = s1[1];
      }
      float od = (op2[0] + op2[1]) + (oq2[0] + oq2[1]);
      if (LPR == 16) { od += dpp_ror8(od); od += dpp_ror4(od); }
      od += dpp_xor2(od); od += dpp_xor1(od);
      if (LPR == 8) od += dpp_hmirror(od);
      if ((tid % LPR) == 0) outb[j * RPB + rowl] = od;
    }
    __syncthreads();
    for (int e = tid; e < 16 * RPB; e += NTHR) {
      const int j = e / RPB, c = e % RPB, pos = ch * 16 + j, t = d ? q.T - 1 - pos : pos;
      O[(size_t)(q.base + t) * 1024 + d * 512 + 64 * hh + rb * RPB + c] = f2bf(outb[e]);
    }
  }
  if (!q.sample) {
    float* dst = p.out + OUT_RW + ((((size_t)q.b * 2 + l) * 2 + d) * 8 + hh) * 4096 + row * 64 + kb0;
#pragma unroll
    for (int i = 0; i < KPL; ++i) dst[i] = S[i];
  }
}

DI void hgrn_item(const Params& p, int l, int s, int hh, int d, char* smem) {
  const Seq q = get_seq(s);
  const int tid = ltid(), lane = tid & 63, w = tid >> 6, r = lane & 31, h = lane >> 5;
  bf16_t* ZH = (bf16_t*)(p.ws + OFF_ZH);
  bf16_t* Qt = (bf16_t*)smem;
  bf16_t* Kt = Qt + 32 * 136;
  bf16_t* KhT = Kt + 32 * 136;
  bf16_t* VT = KhT + 128 * 40;
  bf16_t* Sb = VT + 128 * 40;
  bf16_t* At = Sb + 4 * 32 * 136;
  float* dL = (float*)(At + 32 * 40);
  float* tot = dL + 128;
  const float lb = ((const float*)(p.ws + OFF_LBS))[l * 512 + 128 * hh + (tid & 127)];
  f32x16 S[4];
  if (q.sample) {
    const float* st = p.in[I_SH] + ((((size_t)q.b * 2 + l) * 2 + d) * 4 + hh) * 16384;
#pragma unroll
    for (int kb = 0; kb < 4; ++kb)
#pragma unroll
      for (int g = 0; g < 16; ++g) S[kb][g] = st[(size_t)(32 * kb + crow(g, h)) * 128 + 32 * w + r];
  } else {
#pragma unroll
    for (int kb = 0; kb < 4; ++kb)
#pragma unroll
      for (int g = 0; g < 16; ++g) S[kb][g] = 0.f;
  }
  const int k = tid & 127, half = tid >> 7;
  const int nch = q.T / 32;
  u16x2 pzq[16], pv2[8];
#define HG_ISSUE(chn) { _Pragma("unroll") for (int jj = 0; jj < 16; ++jj) { const int pos = (chn) * 32 + half * 16 + jj, t = d ? q.T - 1 - pos : pos; \
      const size_t rowo = (size_t)(q.base + t) * ZHW + 128 * hh + k; pzq[jj][0] = ZH[rowo + 512 * (1 + d)]; pzq[jj][1] = ZH[rowo]; pv2[jj >> 1][jj & 1] = ZH[rowo + 1536]; } }
  HG_ISSUE(0)
#pragma unroll 1
  for (int ch = 0; ch < nch; ++ch) {
    __syncthreads();
    float bl[16], kc[16], qs[16];
    {
      float b = 0.f;
#pragma unroll
      for (int jj = 0; jj < 16; ++jj) {
        const float z = bf2f(pzq[jj][0]);
        const float kcoef = (1.0f - lb) * sigmoidf_(-z);
        const float f = 1.0f - kcoef;
        b += fmaxf(__logf(f), -80.f);
        bl[jj] = b; kc[jj] = kcoef; qs[jj] = bf2f(pzq[jj][1]) * 0.08838834764831845f;
      }
      *(u32x4*)(VT + k * 40 + half * 16) = (u32x4){__builtin_bit_cast(unsigned, pv2[0]), __builtin_bit_cast(unsigned, pv2[1]), __builtin_bit_cast(unsigned, pv2[2]), __builtin_bit_cast(unsigned, pv2[3])};
      *(u32x4*)(VT + k * 40 + half * 16 + 8) = (u32x4){__builtin_bit_cast(unsigned, pv2[4]), __builtin_bit_cast(unsigned, pv2[5]), __builtin_bit_cast(unsigned, pv2[6]), __builtin_bit_cast(unsigned, pv2[7])};
      tot[half * 128 + k] = b;
    }
    if (ch + 1 < nch) HG_ISSUE(ch + 1)
    __syncthreads();
    {
      const float off = half ? tot[k] : 0.f;
      const float bL = fmaxf(tot[k] + tot[128 + k], -80.f);
      if (half == 0) dL[k] = __expf(bL);
      float kh[16];
#pragma unroll
      for (int jj = 0; jj < 16; ++jj) {
        const int j = half * 16 + jj;
        const float bj = fmaxf(off + bl[jj], -80.f);
        Qt[j * 136 + k] = f2bf(qs[jj] * __expf(bj));
        Kt[j * 136 + k] = f2bf(kc[jj] * __expf(-bj));
        kh[jj] = kc[jj] * __expf(fminf(bL - bj, 0.f));
      }
      *(u32x4*)(KhT + k * 40 + half * 16) = (u32x4){pk2(kh[0], kh[1]), pk2(kh[2], kh[3]), pk2(kh[4], kh[5]), pk2(kh[6], kh[7])};
      *(u32x4*)(KhT + k * 40 + half * 16 + 8) = (u32x4){pk2(kh[8], kh[9]), pk2(kh[10], kh[11]), pk2(kh[12], kh[13]), pk2(kh[14], kh[15])};
    }
    bf16_t* Sbw = Sb + w * 32 * 136;
#pragma unroll
    for (int kb = 0; kb < 4; ++kb)
#pragma unroll
      for (int g4 = 0; g4 < 4; ++g4) *(u32x2*)(Sbw + r * 136 + 32 * kb + crow(4 * g4, h)) = (u32x2){pk2(S[kb][4 * g4], S[kb][4 * g4 + 1]), pk2(S[kb][4 * g4 + 2], S[kb][4 * g4 + 3])};
    __syncthreads();
    bf16_t* Atw = At;
    {
      f32x16 A;
#pragma unroll
      for (int g = 0; g < 16; ++g) A[g] = 0.f;
      mma32(A, Qt, 136, Kt, 136, 128, lane);
#pragma unroll
      for (int g = 0; g < 16; ++g) { const int t = crow(g, h); Atw[t * 40 + r] = f2bf(r <= t ? A[g] : 0.f); }
    }
    __syncthreads();
    {
      f32x16 o;
#pragma unroll
      for (int g = 0; g < 16; ++g) o[g] = 0.f;
      mma32(o, Atw, 40, VT + 32 * w * 40, 40, 32, lane);
      mma32(o, Qt, 136, Sbw, 136, 128, lane);
#pragma unroll
      for (int g = 0; g < 16; ++g) {
        const int j = crow(g, h), pos = ch * 32 + j, t = d ? q.T - 1 - pos : pos;
        ZH[(size_t)(q.base + t) * ZHW + 512 * (1 + d) + 128 * hh + 32 * w + r] = f2bf(o[g]);
      }
#pragma unroll
      for (int kb = 0; kb < 4; ++kb) {
#pragma unroll
        for (int g = 0; g < 16; ++g) S[kb][g] *= dL[32 * kb + crow(g, h)];
        mma32(S[kb], KhT + 32 * kb * 40, 40, VT + 32 * w * 40, 40, 32, lane);
      }
    }
  }
  if (!q.sample) {
    float* dst = p.out + OUT_HG + ((((size_t)q.b * 2 + l) * 2 + d) * 4 + hh) * 16384;
#pragma unroll
    for (int kb = 0; kb < 4; ++kb)
#pragma unroll
      for (int g = 0; g < 16; ++g) dst[(size_t)(32 * kb + crow(g, h)) * 128 + 32 * w + r] = S[kb][g];
  }
}

DI void mlstm_item(const Params& p, int l, int s, int hh, int d, char* smem) {
  const Seq q = get_seq(s);
  const int tid = ltid(), lane = tid & 63, w = tid >> 6, r = lane & 31, h = lane >> 5;
  const bf16_t* ZM = (const bf16_t*)(p.ws + OFF_ZM);
  const float* MG = (const float*)(p.ws + OFF_MG);
  bf16_t* Hb = (bf16_t*)(p.ws + OFF_H);
  bf16_t* Qm = (bf16_t*)smem;
  bf16_t* Km = Qm + 32 * 136;
  bf16_t* KwT = Km + 32 * 136;
  bf16_t* VT = KwT + 128 * 40;
  bf16_t* Cb = VT + 128 * 40;
  bf16_t* Pt = Cb + 4 * 32 * 136;
  float* nv = (float*)(Pt + 32 * 40);
  float* sc = nv + 128;
  float* ig = sc; float* lf = sc + 32; float* gg = sc + 64; float* mtv = sc + 96; float* wi = sc + 128; float* wsr = sc + 160; float* qn = sc + 192; float* misc = sc + 224;
  float* dnw = sc + 232;
  const float gbi = p.in[I_GB][l * 16 + (2 * d) * 4 + hh], gbf = p.in[I_GB][l * 16 + (2 * d + 1) * 4 + hh];
  f32x16 C[4];
  float m;
  __syncthreads();
  if (q.sample) {
    const size_t sb = (((size_t)q.b * 2 + l) * 2 + d) * 4 + hh;
    const float* st = p.in[I_SC] + sb * 16384;
#pragma unroll
    for (int kb = 0; kb < 4; ++kb)
#pragma unroll
      for (int g = 0; g < 16; ++g) C[kb][g] = st[(size_t)(32 * kb + crow(g, h)) * 128 + 32 * w + r];
    if (tid < 128) nv[tid] = p.in[I_SN][sb * 128 + tid];
    m = p.in[I_SM][sb];
  } else {
#pragma unroll
    for (int kb = 0; kb < 4; ++kb)
#pragma unroll
      for (int g = 0; g < 16; ++g) C[kb][g] = 0.f;
    if (tid < 128) nv[tid] = 0.f;
    m = 0.f;
  }
  const int nch = q.T / 32;
  const int dd = tid & 127, half = tid >> 7;
  u16x2 pqk[16], pv2[8]; float pgi = 0.f, pgf = 0.f;
#define ML_ISSUE(chn) { _Pragma("unroll") for (int jj = 0; jj < 16; ++jj) { const int pos = (chn) * 32 + half * 16 + jj, t = d ? q.T - 1 - pos : pos; \
      const size_t rowo = (size_t)(q.base + t) * ZMW + 128 * hh + dd; pqk[jj][0] = ZM[rowo]; pqk[jj][1] = ZM[rowo + 512]; pv2[jj >> 1][jj & 1] = ZM[rowo + 1024]; } \
    if (tid < 32) { const int pos = (chn) * 32 + tid, t = d ? q.T - 1 - pos : pos; const float* mg = MG + (size_t)(q.base + t) * 16; pgi = mg[(2 * d) * 4 + hh]; pgf = mg[(2 * d + 1) * 4 + hh]; } }
  ML_ISSUE(0)
#pragma unroll 1
  for (int ch = 0; ch < nch; ++ch) {
    __syncthreads();
    {
#pragma unroll
      for (int jj = 0; jj < 16; ++jj) {
        const int j = half * 16 + jj;
        Qm[j * 136 + dd] = pqk[jj][0];
        Km[j * 136 + dd] = f2bf(bf2f(pqk[jj][1]) * 0.08838834764831845f);
      }
      *(u32x4*)(VT + dd * 40 + half * 16) = (u32x4){__builtin_bit_cast(unsigned, pv2[0]), __builtin_bit_cast(unsigned, pv2[1]), __builtin_bit_cast(unsigned, pv2[2]), __builtin_bit_cast(unsigned, pv2[3])};
      *(u32x4*)(VT + dd * 40 + half * 16 + 8) = (u32x4){__builtin_bit_cast(unsigned, pv2[4]), __builtin_bit_cast(unsigned, pv2[5]), __builtin_bit_cast(unsigned, pv2[6]), __builtin_bit_cast(unsigned, pv2[7])};
      if (tid < 32) {
        const float igv = pgi + gbi;
        const float lfv = -softplusf_(-(pgf + gbf));
        float g = lfv;
#pragma unroll
        for (int o = 1; o < 32; o <<= 1) { const float tt = shfl_lane(g, (lane - o) & 63); if (tid >= o) g += tt; }
        const float cs = igv - g;
        float pm = cs;
#pragma unroll
        for (int o = 1; o < 32; o <<= 1) { const float tt = shfl_lane(pm, (lane - o) & 63); if (tid >= o) pm = fmaxf(pm, tt); }
        const float mt = g + fmaxf(m, pm);
        const float gend = shfl_lane(g, 31), mn = shfl_lane(mt, 31);
        ig[tid] = igv; gg[tid] = g; mtv[tid] = mt; wi[tid] = __expf(g + m - mt);
        wsr[tid] = __expf(gend + cs - mn);
        if (tid == 0) { misc[0] = mn; misc[1] = __expf(gend + m - mn); }
      }
    }
    if (ch + 1 < nch) ML_ISSUE(ch + 1)
    __syncthreads();
    {
      {
        float kw[16];
#pragma unroll
        for (int jj = 0; jj < 16; ++jj) { const int j = half * 16 + jj; kw[jj] = bf2f(Km[j * 136 + dd]) * wsr[j]; }
        *(u32x4*)(KwT + dd * 40 + half * 16) = (u32x4){pk2(kw[0], kw[1]), pk2(kw[2], kw[3]), pk2(kw[4], kw[5]), pk2(kw[6], kw[7])};
        *(u32x4*)(KwT + dd * 40 + half * 16 + 8) = (u32x4){pk2(kw[8], kw[9]), pk2(kw[10], kw[11]), pk2(kw[12], kw[13]), pk2(kw[14], kw[15])};
      }
      const int j = tid >> 3, seg = tid & 7;
      float a = 0.f;
#pragma unroll
      for (int i = 0; i < 16; ++i) a += bf2f(Qm[j * 136 + seg * 16 + i]) * nv[seg * 16 + i];
      a += SHX(a, 1); a += SHX(a, 2); a += SHX(a, 4);
      if (seg == 0) qn[j] = a;
    }
    const float m_new = misc[0], carry = misc[1];
    bf16_t* Cbw = Cb + w * 32 * 136; bf16_t* Ptw = Pt;
#pragma unroll
    for (int kb = 0; kb < 4; ++kb)
#pragma unroll
      for (int g4 = 0; g4 < 4; ++g4) *(u32x2*)(Cbw + r * 136 + 32 * kb + crow(4 * g4, h)) = (u32x2){pk2(C[kb][4 * g4], C[kb][4 * g4 + 1]), pk2(C[kb][4 * g4 + 2], C[kb][4 * g4 + 3])};
    {
      f32x16 Sc;
#pragma unroll
      for (int g = 0; g < 16; ++g) Sc[g] = 0.f;
      mma32(Sc, Qm, 136, Km, 136, 128, lane);
      const float gs = gg[r], is = ig[r];
#pragma unroll
      for (int g = 0; g < 16; ++g) {
        const int t = crow(g, h);
        const float pv = (r <= t) ? __expf(gg[t] - gs + is - mtv[t]) * Sc[g] : 0.f;
        Ptw[t * 40 + r] = f2bf(pv);
      }
    }
    __syncthreads();
    if (lane < 32) {
      float a = 0.f;
#pragma unroll 4
      for (int i = 0; i < 32; ++i) a += bf2f(Ptw[lane * 40 + i]);
      const float den = wi[lane] * qn[lane] + a;
      dnw[lane] = 1.0f / fmaxf(fabsf(den), __expf(-mtv[lane]));
    }
    if (tid < 128) {
      float a = 0.f;
#pragma unroll 4
      for (int i = 0; i < 32; ++i) a += bf2f(KwT[tid * 40 + i]);
      nv[tid] = carry * nv[tid] + a;
    }
    __syncthreads();
    {
      f32x16 a1;
#pragma unroll
      for (int g = 0; g < 16; ++g) a1[g] = 0.f;
      mma32(a1, Qm, 136, Cbw, 136, 128, lane);
#pragma unroll
      for (int g = 0; g < 16; ++g) a1[g] *= wi[crow(g, h)];
      mma32(a1, Ptw, 40, VT + 32 * w * 40, 40, 32, lane);
#pragma unroll
      for (int g = 0; g < 16; ++g) {
        const int j = crow(g, h), pos = ch * 32 + j, t = d ? q.T - 1 - pos : pos;
        const float hv = a1[g] * dnw[j];
        Hb[(size_t)(q.base + t) * 1024 + d * 512 + 128 * hh + 32 * w + r] = f2bf(hv);
      }
#pragma unroll
      for (int kb = 0; kb < 4; ++kb) {
#pragma unroll
        for (int g = 0; g < 16; ++g) C[kb][g] *= carry;
        mma32(C[kb], KwT + 32 * kb * 40, 40, VT + 32 * w * 40, 40, 32, lane);
      }
    }
    m = m_new;
  }
  __syncthreads();
  if (!q.sample) {
    const size_t sb = (((size_t)q.b * 2 + l) * 2 + d) * 4 + hh;
    float* dst = p.out + OUT_C + sb * 16384;
#pragma unroll
    for (int kb = 0; kb < 4; ++kb)
#pragma unroll
      for (int g = 0; g < 16; ++g) dst[(size_t)(32 * kb + crow(g, h)) * 128 + 32 * w + r] = C[kb][g];
    if (tid < 128) p.out[OUT_N + sb * 128 + tid] = nv[tid];
    if (tid == 0) p.out[OUT_M + sb] = m;
  }
}

DI void phase_scan(const Params& p, int l, char* smem) {
  int* ctrL = (int*)(p.ws + OFF_CTR) + 2 * l;
  int* ctrS = ctrL + 1;
  int* sit = (int*)(smem + LDS_BYTES - 16);
  const int role = p.role;
  bool longDone = false, shortDone = false;
  for (;;) {
    const bool wantLong = (role == 0) ? !longDone : shortDone;
    if (longDone && shortDone) break;
    __syncthreads();
    if (ltid() == 0) *sit = atomicAdd(wantLong ? ctrL : ctrS, 1);
    __syncthreads();
    int it = __builtin_amdgcn_readfirstlane(*sit);
    int ty, s_, hh_, d_, rb_ = 0;
    if (wantLong) {
      if (it >= 192) { longDone = true; continue; }
      if (it < 128) { ty = 3; rb_ = it & 1; d_ = (it >> 1) & 1; hh_ = (it >> 2) & 7; s_ = 32 + (it >> 5); }
      else if (it < 160) { it -= 128; ty = 1; s_ = 32 + (it >> 3); hh_ = (it >> 1) & 3; d_ = it & 1; }
      else { it -= 160; ty = 2; s_ = 32 + (it >> 3); hh_ = (it >> 1) & 3; d_ = it & 1; }
    } else {
      if (it >= 1024) { shortDone = true; continue; }
      if (it < 512) { ty = 0; s_ = it >> 4; hh_ = (it >> 1) & 7; d_ = it & 1; }
      else if (it < 768) { it -= 512; ty = 1; s_ = it >> 3; hh_ = (it >> 1) & 3; d_ = it & 1; }
      else { it -= 768; ty = 2; s_ = it >> 3; hh_ = (it >> 1) & 3; d_ = it & 1; }
    }
    if (ty == 0) rwkv_item<16>(p, l, s_, hh_, d_, 0, smem);
    else if (ty == 3) rwkv_item<8>(p, l, s_, hh_, d_, rb_, smem);
    else if (ty == 1) hgrn_item(p, l, s_, hh_, d_, smem);
    else mlstm_item(p, l, s_, hh_, d_, smem);
  }
}

DI void phase_combine(const Params& p, int l, char* smem) {
  const int tid = ltid(), lane = tid & 63, w = tid >> 6;
  bf16_t* ZH = (bf16_t*)(p.ws + OFF_ZH); bf16_t* ZM = (bf16_t*)(p.ws + OFF_ZM); const bf16_t* ZR = (const bf16_t*)(p.ws + OFF_ZR);
  bf16_t* O = (bf16_t*)(p.ws + OFF_O); const bf16_t* Hb = (const bf16_t*)(p.ws + OFF_H);
  const float* mu = p.in[I_MU] + (size_t)l * 4 * ZRW;
  const float* g2 = p.in[I_G2] + (size_t)l * 128 * 512;
  float* sg = (float*)smem;
  float* gt = sg + 128 * 16;
  for (int blk = blockIdx.x; blk < NT / 16; blk += gridDim.x) {
    const int tok0 = blk * 16;
    int sidx, t0;
    if (tok0 < 8192) { sidx = tok0 >> 8; t0 = tok0 & 255; } else { sidx = 32 + ((tok0 - 8192) >> 11); t0 = (tok0 - 8192) & 2047; }
    const Seq q = get_seq(sidx);
    __syncthreads();
    { const int j = tid >> 4, rr0 = (tid & 15) * 8; float val[8]; bf16x8 pv[5]; rw_load8(ZR, q.base, t0 + j, q.T, q.grid, 1792 + rr0, pv); rw_apply8(pv, mu, q.grid, 1792 + rr0, val);
#pragma unroll
      for (int e = 0; e < 8; ++e) sg[(rr0 + e) * 16 + j] = sigmoidf_(val[e]); }
    __syncthreads();
    {
      float a0[16], a1[16];
#pragma unroll
      for (int j = 0; j < 16; ++j) { a0[j] = 0.f; a1[j] = 0.f; }
#pragma unroll 1
      for (int r0 = 0; r0 < 128; r0 += 8) {
        float w0v[8], w1v[8];
#pragma unroll
        for (int q8 = 0; q8 < 8; ++q8) { w0v[q8] = g2[(r0 + q8) * 512 + tid]; w1v[q8] = g2[(r0 + q8) * 512 + 256 + tid]; }
#pragma unroll
        for (int q8 = 0; q8 < 8; ++q8) {
          const int rr = r0 + q8; const float w0 = w0v[q8], w1 = w1v[q8];
#pragma unroll
          for (int u = 0; u < 4; ++u) {
            f32x4 sv = *(const f32x4*)(sg + rr * 16 + 4 * u);
#pragma unroll
            for (int e = 0; e < 4; ++e) { a0[4 * u + e] += sv[e] * w0; a1[4 * u + e] += sv[e] * w1; }
          }
        }
      }
#pragma unroll
      for (int j = 0; j < 16; ++j) { gt[j * 512 + tid] = a0[j]; gt[j * 512 + 256 + tid] = a1[j]; }
    }
    __syncthreads();
#pragma unroll 1
    for (int jj = 0; jj < 4; ++jj) {
      const int j = w * 4 + jj, tok = tok0 + j, t = t0 + j; int c0 = lane * 8; asm volatile("" : "+v"(c0));
      {
        float o[8], rs[8], ks[8], vs[8];
        float sum = 0.f, bon = 0.f;
        {
          bf16x8 pr_[5], pk_[5], pv_[5];
          rw_load8(ZR, q.base, t, q.T, q.grid, c0, pr_); rw_load8(ZR, q.base, t, q.T, q.grid, 512 + c0, pk_); rw_load8(ZR, q.base, t, q.T, q.grid, 1024 + c0, pv_);
          rw_apply8(pr_, mu, q.grid, c0, rs); rw_apply8(pk_, mu, q.grid, 512 + c0, ks); rw_apply8(pv_, mu, q.grid, 1024 + c0, vs);
        }
        const bf16x8 of = *(const bf16x8*)(O + (size_t)tok * 1024 + c0), ob = *(const bf16x8*)(O + (size_t)tok * 1024 + 512 + c0);
        const f32x4 rk0 = *(const f32x4*)(p.in[I_RK] + l * 512 + c0), rk1 = *(const f32x4*)(p.in[I_RK] + l * 512 + c0 + 4);
#pragma unroll
        for (int e = 0; e < 8; ++e) {
          o[e] = bf2f((bf16_t)of[e]) + bf2f((bf16_t)ob[e]);
          sum += o[e];
          bon += rs[e] * ks[e] * (e < 4 ? rk0[e & 3] : rk1[e & 3]);
        }
        sum += SHX(sum, 1); sum += SHX(sum, 2); sum += SHX(sum, 4);
        bon += SHX(bon, 1); bon += SHX(bon, 2); bon += SHX(bon, 4);
        const float mean = sum * (1.0f / 64.f);
        float var = 0.f;
#pragma unroll
        for (int e = 0; e < 8; ++e) { const float dv = o[e] - mean; var += dv * dv; }
        var += SHX(var, 1); var += SHX(var, 2); var += SHX(var, 4);
        const float rstd = rsqrtf(var * (1.0f / 64.f) + 64e-5f);
        const f32x4 lw0 = *(const f32x4*)(p.in[I_LN] + (l * 2 + 0) * 512 + c0), lw1 = *(const f32x4*)(p.in[I_LN] + (l * 2 + 0) * 512 + c0 + 4);
        const f32x4 lb0 = *(const f32x4*)(p.in[I_LN] + (l * 2 + 1) * 512 + c0), lb1 = *(const f32x4*)(p.in[I_LN] + (l * 2 + 1) * 512 + c0 + 4);
        const f32x4 gt0 = *(const f32x4*)(gt + j * 512 + c0), gt1 = *(const f32x4*)(gt + j * 512 + c0 + 4);
        bf16x8 ov;
#pragma unroll
        for (int e = 0; e < 8; ++e) {
          const float ln = (o[e] - mean) * rstd * (e < 4 ? lw0[e & 3] : lw1[e & 3]) + (e < 4 ? lb0[e & 3] : lb1[e & 3]);
          ov[e] = (short)f2bf((ln + bon * vs[e]) * (e < 4 ? gt0[e & 3] : gt1[e & 3]));
        }
        *(bf16x8*)(O + (size_t)tok * 1024 + c0) = ov;
      }
      {
        float o[8]; float ss = 0.f;
        bf16_t* zr_ = ZH + (size_t)tok * ZHW + c0;
        const bf16x8 of = *(const bf16x8*)(zr_ + 512), ob = *(const bf16x8*)(zr_ + 1024), hgv = *(const bf16x8*)(zr_ + 2048);
        const f32x4 nw0 = *(const f32x4*)(p.in[I_HNORM] + l * 512 + c0), nw1 = *(const f32x4*)(p.in[I_HNORM] + l * 512 + c0 + 4);
#pragma unroll
        for (int e = 0; e < 8; ++e) { o[e] = bf2f((bf16_t)of[e]) + bf2f((bf16_t)ob[e]); ss += o[e] * o[e]; }
        ss += SHX(ss, 1); ss += SHX(ss, 2); ss += SHX(ss, 4); ss += SHX(ss, 8);
        const float rsd = rsqrtf(ss * (1.0f / 128.f) + 1e-6f);
        bf16x8 ov;
#pragma unroll
        for (int e = 0; e < 8; ++e) ov[e] = (short)f2bf(o[e] * rsd * (e < 4 ? nw0[e & 3] : nw1[e & 3]) * siluf_(bf2f((bf16_t)hgv[e])));
        *(bf16x8*)(zr_ + 2048) = ov;
      }
      {
        float o[8]; float ss = 0.f;
        bf16_t* zm_ = ZM + (size_t)tok * ZMW + 1536 + c0;
        const bf16x8 of = *(const bf16x8*)(Hb + (size_t)tok * 1024 + c0), ob = *(const bf16x8*)(Hb + (size_t)tok * 1024 + 512 + c0), mov = *(const bf16x8*)zm_;
        const f32x4 nw0 = *(const f32x4*)(p.in[I_MNORM] + l * 512 + c0), nw1 = *(const f32x4*)(p.in[I_MNORM] + l * 512 + c0 + 4);
#pragma unroll
        for (int e = 0; e < 8; ++e) { o[e] = bf2f((bf16_t)of[e]) + bf2f((bf16_t)ob[e]); ss += o[e] * o[e]; }
        ss += SHX(ss, 1); ss += SHX(ss, 2); ss += SHX(ss, 4); ss += SHX(ss, 8);
        const float rsd = rsqrtf(ss * (1.0f / 128.f) + 1e-6f);
        bf16x8 ov;
#pragma unroll
        for (int e = 0; e < 8; ++e) ov[e] = (short)f2bf(o[e] * rsd * (e < 4 ? nw0[e & 3] : nw1[e & 3]) * sigmoidf_(bf2f((bf16_t)mov[e])));
        *(bf16x8*)zm_ = ov;
      }
    }
    __syncthreads();
#pragma unroll 1
    for (int jj = 0; jj < 4; ++jj) tok_one(p, l, 3, tok0 + w * 4 + jj, lane);
  }
}

#define XB_TMO      128
#define XB_XCNT(j)  (256  + 64 * (j))
#define XB_XSUB(j)  (1280 + 64 * (j))
#define XB_XGEN(j)  (2304 + 64 * (j))
#define XB_TOP      3328
#define XB_TOPGEN   3392
#define XCD_BAR_WORDS 3456
#define XB_SPIN_CAP (1u << 20)
#define LAS __attribute__((address_space(3)))
DI unsigned xb_ld(unsigned* p)              { return __hip_atomic_load(p, __ATOMIC_RELAXED, __HIP_MEMORY_SCOPE_AGENT); }
DI unsigned xb_add(unsigned* p, unsigned v) { return __hip_atomic_fetch_add(p, v, __ATOMIC_RELAXED, __HIP_MEMORY_SCOPE_AGENT); }
DI unsigned xb_xcc_id() { return (unsigned)__builtin_amdgcn_s_getreg((3 << 11) | 20) & 0xFu; }
#define XB_SPIN(cond, bar) do { unsigned _sp = 0; while (cond) { __builtin_amdgcn_s_sleep(1); \
    if ((++_sp & 255u) == 0u) { if (xb_ld(&(bar)[XB_TMO])) break; if (_sp > XB_SPIN_CAP) { atomicAdd(&(bar)[XB_TMO], 1u); break; } } } } while (0)
struct XcdBarrier { unsigned* bar; unsigned x; volatile LAS unsigned* st; };
DI XcdBarrier xcd_barrier_post(const Params& p, unsigned* bar, volatile LAS unsigned* st) {
  XcdBarrier b; b.bar = bar; b.x = xb_xcc_id(); b.st = st;
  if (ltid() == 0) (void)xb_add(&bar[XB_XCNT(b.x)], 1u);
  return b;
}
DI void xcd_barrier_complete(unsigned* bar, unsigned x, unsigned& nloc, unsigned& nx) {
  const unsigned G = gridDim.x * gridDim.y * gridDim.z;
  unsigned sum, cnt, mine, sp = 0u;
  for (;;) {
    sum = 0u; cnt = 0u; mine = 0u;
#pragma unroll
    for (unsigned j = 0; j < 16; ++j) { const unsigned c = xb_ld(&bar[XB_XCNT(j)]); sum += c; cnt += (c > 0u) ? 1u : 0u; mine = (j == x) ? c : mine; }
    if (sum == G) break;
    __builtin_amdgcn_s_sleep(1);
    if ((++sp & 255u) == 0u) { if (xb_ld(&bar[XB_TMO])) break; if (sp > XB_SPIN_CAP) { atomicAdd(&bar[XB_TMO], 1u); break; } }
  }
  nloc = mine > 0u ? mine : 1u; nx = cnt > 0u ? cnt : 1u;
}
DI void xcd_barrier(const Params& p, const XcdBarrier& b) {
  asm volatile("s_waitcnt vmcnt(0)" ::: "memory");
  __syncthreads();
  if (ltid() == 0) {
    unsigned* bar = b.bar;
    __builtin_amdgcn_s_waitcnt(0);
    unsigned nloc = b.st[0], nx = b.st[1];
    if (nloc == 0u) { xcd_barrier_complete(bar, b.x, nloc, nx); b.st[0] = nloc; b.st[1] = nx; }
    const unsigned old = xb_add(&bar[XB_XSUB(b.x)], 1u);
    const unsigned gen = old / nloc;
    if (old + 1u == (gen + 1u) * nloc) {
      __builtin_amdgcn_fence(__ATOMIC_RELEASE, "agent");
      asm volatile("s_waitcnt vmcnt(0)" ::: "memory");
      const unsigned og = xb_add(&bar[XB_TOP], 1u);
      const unsigned tg = og / nx;
      if (og + 1u == (tg + 1u) * nx) xb_add(&bar[XB_TOPGEN], 1u);
      else XB_SPIN(xb_ld(&bar[XB_TOPGEN]) == tg, bar);
      __builtin_amdgcn_fence(__ATOMIC_ACQUIRE, "agent");
      xb_add(&bar[XB_XGEN(b.x)], 1u);
      asm volatile("s_waitcnt vmcnt(0)" ::: "memory");
    } else {
      XB_SPIN(xb_ld(&bar[XB_XGEN(b.x)]) == gen, bar);
      __builtin_amdgcn_fence(__ATOMIC_ACQUIRE, "agent");
      asm volatile("s_waitcnt vmcnt(0)" ::: "memory");
    }
  }
  __syncthreads();
}

constexpr int NPHASE = 3 + 9 * 2;
DI void run_phase(const Params& p0, int ph, char* smem) {
  Params p = p0;
  asm volatile("" : "+s"(p.ws), "+s"(p.out));
  if (ph == 0) { phase0(p, smem); return; }
  if (ph == 1) { phase1(p); return; }
  if (ph == 2) { tok_phase(p, 0, 0); return; }
  const int l = (ph - 3) / 9, s = (ph - 3) % 9;
  switch (s) {
    case 0: phase_inproj(p, smem); break;
    case 1: phase_scan(p, l, smem); break;
    case 2: phase_combine(p, l, smem); break;
    case 3: phase_merge(p, l, smem); break;
    case 4: phase_gemm_f32(p, (const bf16_t*)(p.ws + OFF_MERGED), 1024, (const bf16_t*)(p.ws + OFF_WTOUT), smem); break;
    case 5: tok_phase(p, l, 1); break;
    case 6: phase_ffn_in(p, smem); break;
    case 7: phase_gemm_f32(p, (const bf16_t*)(p.ws + OFF_ACT), DFF, (const bf16_t*)(p.ws + OFF_WTFO), smem); break;
    case 8:
      tok_phase(p, l, 2);
      if (l + 1 < 2) {
        conv_weight(p, p.in[I_WIN] + (size_t)(l + 1) * 1024 * DIN, DIN, (bf16_t*)(p.ws + OFF_WTIN), 1024, WTIN_ROWS, 0, (float*)smem, blockIdx.x, gridDim.x);
        for (int br = 0; br < 3; ++br) conv_weight(p, p.in[I_WBR] + ((size_t)(l + 1) * 3 + br) * 512 * 1024, 1024, (bf16_t*)(p.ws + OFF_WTBR) + (size_t)br * 1024 * 512, 512, 1024, 1, (float*)smem, blockIdx.x, gridDim.x);
      }
      break;
  }
}

template <bool COOP>
__global__ void __launch_bounds__(NTHR, 2) mega(Params pk, int lo, int hi) {
  __shared__ __attribute__((aligned(16))) char smem[LDS_BYTES];
  Params p = pk;
  p.wb = __builtin_amdgcn_readfirstlane((int)threadIdx.x) & ~63;
  if (COOP) {
    volatile LAS unsigned* st = (volatile LAS unsigned*)(smem + LDS_BYTES - 32);
    if (ltid() == 0) { st[0] = 0u; st[1] = 0u; }
    __syncthreads();
    phase0(p, smem);
    cg::this_grid().sync();
    XcdBarrier b = xcd_barrier_post(p, (unsigned*)(p.ws + OFF_BAR), st);
    if (ltid() == 0) {
      const unsigned hwid = (unsigned)__builtin_amdgcn_s_getreg((31 << 11) | 4);
      const unsigned key = (xb_xcc_id() << 8) | ((hwid >> 8) & 0xFFu);
      ((int*)smem)[(LDS_BYTES - 12) / 4] = (int)xb_add((unsigned*)(p.ws + OFF_ROLE) + key, 1u);
    }
    __syncthreads();
    p.role = __builtin_amdgcn_readfirstlane(((int*)smem)[(LDS_BYTES - 12) / 4]);
    for (int ph = 1; ph < hi; ++ph) {
      run_phase(p, ph, smem);
      if (ph + 1 < hi) xcd_barrier(p, b);
    }
  } else {
    for (int ph = lo; ph < hi; ++ph) run_phase(p, ph, smem);
  }
}

extern "C" void kernel_launch(void* const* d_in, const int* in_sizes, int n_in, void* d_out, int out_size, void* d_ws, size_t ws_size, hipStream_t stream) {
  Params p{};
  for (int i = 0; i < N_IN; ++i) p.in[i] = (const float*)d_in[i];
  p.out = (float*)d_out; p.ws = (char*)d_ws;
  if (ws_size < WS_NEED) fprintf(stderr, "workspace too small: %zu < %zu\n", ws_size, (size_t)WS_NEED);
  static int grid_blocks = 0;
  if (!grid_blocks) {
    int dev = 0, cus = 0, per_cu = 0;
    hipGetDevice(&dev);
    hipDeviceGetAttribute(&cus, hipDeviceAttributeMultiprocessorCount, dev);
    hipOccupancyMaxActiveBlocksPerMultiprocessor(&per_cu, mega<true>, NTHR, 0);
    if (per_cu > 2) per_cu = 2;
    grid_blocks = cus * per_cu;
  }
  int lo = 0, hi = NPHASE;
  void* args[] = {&p, &lo, &hi};
  hipError_t e = hipLaunchCooperativeKernel((void*)mega<true>, dim3(grid_blocks), dim3(NTHR), args, 0, stream);
  if (e != hipSuccess) fprintf(stderr, "cooperative launch failed: %s (grid %d)\n", hipGetErrorString(e), grid_blocks);
}
```

```cpp
#include <hip/hip_runtime.h>
#include <hip/hip_cooperative_groups.h>
#include <cstdio>
namespace cg = cooperative_groups;

typedef unsigned short bf16_t;
typedef short bf16x8 __attribute__((ext_vector_type(8)));
typedef float f32x4 __attribute__((ext_vector_type(4)));
typedef float f32x2 __attribute__((ext_vector_type(2)));
typedef float f32x16 __attribute__((ext_vector_type(16)));
typedef unsigned short u16x4 __attribute__((ext_vector_type(4)));
typedef unsigned short u16x2 __attribute__((ext_vector_type(2)));
typedef unsigned u32x4 __attribute__((ext_vector_type(4)));
typedef unsigned u32x2 __attribute__((ext_vector_type(2)));
static __device__ __forceinline__ unsigned pk2(float lo, float hi) { typedef __bf16 b2 __attribute__((ext_vector_type(2))); typedef float f2 __attribute__((ext_vector_type(2))); return __builtin_bit_cast(unsigned, __builtin_convertvector((f2){lo, hi}, b2)); }

#define DI __device__ __forceinline__

constexpr int NT = 16384;
constexpr int DM = 1024;
constexpr int NTHR = 256;
constexpr int DIN = 9616;
constexpr int ZHW = 2560, ZRW = 1920, ZMW = 2048;
constexpr int WTIN_ROWS = 9728;
constexpr int DFF = 2816;

constexpr size_t OFF_WTIN = 0;
constexpr size_t OFF_WTBR = OFF_WTIN + (size_t)WTIN_ROWS * 1024 * 2;
constexpr size_t OFF_H    = OFF_WTBR + (size_t)3 * 1024 * 512 * 2;
constexpr size_t OFF_ZH   = OFF_H + (size_t)NT * 1024 * 2;
constexpr size_t OFF_ZR   = OFF_ZH + (size_t)NT * ZHW * 2;
constexpr size_t OFF_ZM   = OFF_ZR + (size_t)NT * ZRW * 2;
constexpr size_t OFF_MG   = OFF_ZM + (size_t)NT * ZMW * 2;
constexpr size_t OFF_O    = OFF_MG + (size_t)NT * 16 * 4;
constexpr size_t OFF_MOD  = OFF_O + (size_t)NT * 1024 * 2;
constexpr size_t OFF_LBS  = OFF_MOD + (size_t)2 * 5 * 6144 * 4;
constexpr size_t OFF_CTR  = OFF_LBS + 2 * 512 * 4;
constexpr size_t OFF_BAR  = OFF_CTR + 256;
constexpr size_t OFF_ROLE = OFF_BAR + 3456 * 4;
constexpr size_t WS_NEED  = OFF_ROLE + 4096 * 4;
constexpr size_t OFF_MODP = OFF_ZH;
constexpr size_t OFF_WTOUT = OFF_ZR;
constexpr size_t OFF_WTFI  = OFF_WTOUT + (size_t)1024 * 1024 * 2;
constexpr size_t OFF_WTFO  = OFF_WTFI + (size_t)5632 * 1024 * 2;
constexpr size_t OFF_MERGED = OFF_WTFO + (size_t)1024 * 2816 * 2;
constexpr size_t OFF_Y    = OFF_ZH;
constexpr size_t OFF_ACT  = OFF_ZM;

constexpr size_t OUT_HG = 16777216, OUT_RW = 25165824, OUT_C = 29360128, OUT_N = 37748736, OUT_M = 37814272;

enum { I_XP = 0, I_XS, I_SH, I_SR, I_SC, I_SN, I_SM, I_C, I_CCTX, I_WADA, I_BADA, I_NORMS, I_WIN, I_HLB, I_HNORM, I_MU, I_W0, I_W2,
       I_A0, I_A2, I_G2, I_KK, I_KA, I_RK, I_LN, I_GB, I_MNORM, I_WBR, I_WOUT, I_WFI, I_WFO, N_IN };

struct Params { const float* in[N_IN]; float* out; char* ws; int wb; int role; };

constexpr int LDS_BYTES = 77824;

DI bf16_t f2bf(float f) { return __builtin_bit_cast(unsigned short, (__bf16)f); }
DI float bf2f(bf16_t h) { return __uint_as_float(((unsigned)h) << 16); }
DI float sigmoidf_(float x) { return 1.0f / (1.0f + __expf(-x)); }
DI float siluf_(float x) { return x / (1.0f + __expf(-x)); }
DI float softplusf_(float x) { return x > 20.f ? x : __logf(1.0f + __expf(x)); }
DI float dpp_xor1(float x) { return __int_as_float(__builtin_amdgcn_mov_dpp(__float_as_int(x), 0xB1, 0xF, 0xF, true)); }
DI float dpp_xor2(float x) { return __int_as_float(__builtin_amdgcn_mov_dpp(__float_as_int(x), 0x4E, 0xF, 0xF, true)); }
DI float shfl_lane(float v, int src) { return __int_as_float(__builtin_amdgcn_ds_bpermute(src << 2, __float_as_int(v))); }
#define SHX(v, m) shfl_lane((v), lane ^ (m))
DI float wave_sum(float v, int lane) { v += dpp_xor1(v); v += dpp_xor2(v); v += SHX(v, 4); v += SHX(v, 8); v += SHX(v, 16); v += SHX(v, 32); return v; }
DI int ltid_(int wb) { int t = wb + (int)__builtin_amdgcn_mbcnt_hi(~0u, __builtin_amdgcn_mbcnt_lo(~0u, 0u)); asm volatile("" : "+v"(t)); return t; }
#define ltid() ltid_(p.wb)
DI int crow(int reg, int h) { return (reg & 3) + 8 * (reg >> 2) + 4 * h; }

DI int tok_cond(int tok) { return tok < 8192 ? 0 : 1 + ((tok - 8192) >> 11); }
DI const float* x_in_row(const Params& p, int tok) { return tok < 8192 ? p.in[I_XP] + (size_t)tok * DM : p.in[I_XS] + (size_t)(tok - 8192) * DM; }

DI void mma32(f32x16& acc, const bf16_t* A, int lda, const bf16_t* B, int ldb, int K, int lane) {
  const int r = lane & 31, h = lane >> 5;
#pragma unroll 2
  for (int kk = 0; kk < K; kk += 16) {
    bf16x8 a = *(const bf16x8*)(A + r * lda + kk + 8 * h);
    bf16x8 b = *(const bf16x8*)(B + r * ldb + kk + 8 * h);
    acc = __builtin_amdgcn_mfma_f32_32x32x16_bf16(a, b, acc, 0, 0, 0);
  }
}

template <int BM, int BN, int BK>
DI void gemm_main(const Params& p, f32x4 (&acc)[BM / 32][BN / 32], const bf16_t* __restrict__ A, int lda, const bf16_t* __restrict__ B, int ldb, int K, bf16_t* sm) {
  constexpr int MI = BM / 32, NJ = BN / 32, LS = BK + 8, CPR = BK / 8, ACH = BM * BK / 2048, BCH = BN * BK / 2048, KS = BK / 32, RPI = 256 / CPR;
  const int tid = ltid(), lane = tid & 63, w = tid >> 6, wm = w >> 1, wn = w & 1;
  bf16_t* As = sm; bf16_t* Bs = sm + 2 * BM * LS;
  bf16x8 ra[ACH], rb[BCH];
  const int nk = K / BK;
  const int lrow = tid / CPR, lkc = (tid % CPR) * 8;
#pragma unroll
  for (int i = 0; i < ACH; ++i) ra[i] = *(const bf16x8*)(A + (size_t)(lrow + RPI * i) * lda + lkc);
#pragma unroll
  for (int i = 0; i < BCH; ++i) rb[i] = *(const bf16x8*)(B + (size_t)(lrow + RPI * i) * ldb + lkc);
  __syncthreads();
#pragma unroll
  for (int i = 0; i < ACH; ++i) *(bf16x8*)(As + (lrow + RPI * i) * LS + lkc) = ra[i];
#pragma unroll
  for (int i = 0; i < BCH; ++i) *(bf16x8*)(Bs + (lrow + RPI * i) * LS + lkc) = rb[i];
  __syncthreads();
  for (int kt = 0; kt < nk; ++kt) {
    const int buf = kt & 1;
    if (kt + 1 < nk) {
      const int k0 = (kt + 1) * BK + lkc;
#pragma unroll
      for (int i = 0; i < ACH; ++i) ra[i] = *(const bf16x8*)(A + (size_t)(lrow + RPI * i) * lda + k0);
#pragma unroll
      for (int i = 0; i < BCH; ++i) rb[i] = *(const bf16x8*)(B + (size_t)(lrow + RPI * i) * ldb + k0);
    }
    const bf16_t* as = As + buf * BM * LS + (wm * (BM / 2) + (lane & 15)) * LS + (lane >> 4) * 8;
    const bf16_t* bs = Bs + buf * BN * LS + (wn * (BN / 2) + (lane & 15)) * LS + (lane >> 4) * 8;
#pragma unroll
    for (int ks = 0; ks < KS; ++ks) {
      bf16x8 bfr[NJ];
#pragma unroll
      for (int j = 0; j < NJ; ++j) bfr[j] = *(const bf16x8*)(bs + j * 16 * LS + ks * 32);
      __builtin_amdgcn_s_setprio(1);
#pragma unroll
      for (int i = 0; i < MI; ++i) {
        const bf16x8 af = *(const bf16x8*)(as + i * 16 * LS + ks * 32);
#pragma unroll
        for (int j = 0; j < NJ; ++j) acc[i][j] = __builtin_amdgcn_mfma_f32_16x16x32_bf16(bfr[j], af, acc[i][j], 0, 0, 0);
      }
      __builtin_amdgcn_s_setprio(0);
    }
    if (kt + 1 < nk) {
      const int nb = buf ^ 1;
#pragma unroll
      for (int i = 0; i < ACH; ++i) *(bf16x8*)(As + nb * BM * LS + (lrow + RPI * i) * LS + lkc) = ra[i];
#pragma unroll
      for (int i = 0; i < BCH; ++i) *(bf16x8*)(Bs + nb * BN * LS + (lrow + RPI * i) * LS + lkc) = rb[i];
    }
    __syncthreads();
  }
}

template <int MI, int NJ> DI void zero_acc(f32x4 (&acc)[MI][NJ]) {
#pragma unroll
  for (int i = 0; i < MI; ++i)
#pragma unroll
    for (int j = 0; j < NJ; ++j) acc[i][j] = (f32x4){0.f, 0.f, 0.f, 0.f};
}
DI void store_bf4(bf16_t* dst, f32x4 v) { u16x4 o; o[0] = f2bf(v[0]); o[1] = f2bf(v[1]); o[2] = f2bf(v[2]); o[3] = f2bf(v[3]); *(u16x4*)dst = o; }

DI int map_col(int mode, int n) {
  if (mode == 0) return n < 6544 ? n : (n < 6656 ? -1 : n - 112);
  if (mode == 2) return ((n >> 4) & 1) ? DFF + (n >> 5) * 16 + (n & 15) : (n >> 5) * 16 + (n & 15);
  return n;
}
DI void conv_tile(const Params& p, const float* __restrict__ src, int ld_src, bf16_t* __restrict__ dst, int K, int mode, int tk, int tn, float* sm) {
  const int tid = ltid();
  __syncthreads();
  {
    const int nn = tid & 63, col = map_col(mode, tn * 64 + nn);
#pragma unroll
    for (int i = 0; i < 16; ++i) { int kk = (tid >> 6) + 4 * i; sm[kk * 65 + nn] = col >= 0 ? src[(size_t)(tk * 64 + kk) * ld_src + col] : 0.f; }
  }
  __syncthreads();
  {
    const int kk = tid & 63;
#pragma unroll
    for (int i = 0; i < 16; ++i) { int nn = (tid >> 6) + 4 * i; dst[(size_t)(tn * 64 + nn) * K + tk * 64 + kk] = f2bf(sm[kk * 65 + nn]); }
  }
}
DI void conv_weight(const Params& p, const float* src, int ld_src, bf16_t* dst, int K, int Ndst, int mode, float* sm, int bid, int nb) {
  const int tkn = K / 64, nt = tkn * (Ndst / 64);
  for (int t = bid; t < nt; t += nb) conv_tile(p, src, ld_src, dst, K, mode, t % tkn, t / tkn, sm);
}

DI void phase0(const Params& p, char* smem) {
  const int tid = ltid(), bid = blockIdx.x, nb = gridDim.x;
  float* MODP = (float*)(p.ws + OFF_MODP);
  float* sm = (float*)smem;
  if (bid == 0) { if (tid < 64) ((int*)(p.ws + OFF_CTR))[tid] = 0; for (int i = tid; i < 3456; i += NTHR) ((unsigned*)(p.ws + OFF_BAR))[i] = 0u; for (int i = tid; i < 4096; i += NTHR) ((unsigned*)(p.ws + OFF_ROLE))[i] = 0u; }
  for (int i = bid * NTHR + tid; i < 512; i += nb * NTHR) {
    float a = p.in[I_HLB][i], b = p.in[I_HLB][512 + i];
    float* L = (float*)(p.ws + OFF_LBS); L[i] = 0.f; L[512 + i] = 1.0f / (1.0f + expf(a - b));
  }
  for (int it = bid; it < 2 * 24 * 16; it += nb) {
    const int ks = it & 15, jb = (it >> 4) % 24, l = it / (16 * 24);
    __syncthreads();
    for (int e = tid; e < 5 * 64; e += NTHR) { int ci = e >> 6, k = ks * 64 + (e & 63); float cv = ci == 0 ? p.in[I_CCTX][k] : p.in[I_C][(ci - 1) * DM + k]; sm[e] = siluf_(cv); }
    __syncthreads();
    const int j = jb * 256 + tid;
    float a0 = 0, a1 = 0, a2 = 0, a3 = 0, a4 = 0;
    const float* W = p.in[I_WADA] + ((size_t)l * DM + ks * 64) * 6144 + j;
#pragma unroll 1
    for (int k0 = 0; k0 < 64; k0 += 16) {
      float wv[16];
#pragma unroll
      for (int u = 0; u < 16; ++u) wv[u] = W[(size_t)(k0 + u) * 6144];
#pragma unroll
      for (int u = 0; u < 16; ++u) { const int k = k0 + u; const float w = wv[u]; a0 += sm[k] * w; a1 += sm[64 + k] * w; a2 += sm[128 + k] * w; a3 += sm[192 + k] * w; a4 += sm[256 + k] * w; }
    }
    float* dst = MODP + ((size_t)(ks * 2 + l) * 5) * 6144 + j;
    dst[0] = a0; dst[6144] = a1; dst[2 * 6144] = a2; dst[3 * 6144] = a3; dst[4 * 6144] = a4;
  }
  conv_weight(p, p.in[I_WIN], DIN, (bf16_t*)(p.ws + OFF_WTIN), 1024, WTIN_ROWS, 0, sm, bid, nb);
  for (int br = 0; br < 3; ++br) conv_weight(p, p.in[I_WBR] + (size_t)br * 512 * 1024, 1024, (bf16_t*)(p.ws + OFF_WTBR) + (size_t)br * 1024 * 512, 512, 1024, 1, sm, bid, nb);
}
DI void phase1(const Params& p) {
  const float* MODP = (const float*)(p.ws + OFF_MODP);
  float* MOD = (float*)(p.ws + OFF_MOD);
  for (int i = blockIdx.x * NTHR + ltid(); i < 2 * 5 * 6144; i += gridDim.x * NTHR) {
    const int j = i % 6144, l = i / (5 * 6144);
    float s = p.in[I_BADA][l * 6144 + j];
    for (int ks = 0; ks < 16; ++ks) s += MODP[(size_t)ks * 2 * 5 * 6144 + i];
    MOD[i] = s;
  }
}

DI void norm_mod_store(const f32x4 (&x)[4], const float* nw, const float* sc, const float* sh, bf16_t* hrow, int lane) {
  float ss = 0.f;
#pragma unroll
  for (int i = 0; i < 4; ++i) ss += x[i][0] * x[i][0] + x[i][1] * x[i][1] + x[i][2] * x[i][2] + x[i][3] * x[i][3];
  ss = wave_sum(ss, lane);
  const float rs = rsqrtf(ss * (1.0f / DM) + 1e-6f);
#pragma unroll
  for (int i = 0; i < 4; ++i) {
    const int c = i * 256 + lane * 4;
    f32x4 w = *(const f32x4*)(nw + c), s1 = *(const f32x4*)(sc + c), s0 = *(const f32x4*)(sh + c), o;
#pragma unroll
    for (int e = 0; e < 4; ++e) o[e] = x[i][e] * rs * w[e] * (1.0f + s1[e]) + s0[e];
    store_bf4(hrow + c, o);
  }
}
DI void tok_one(const Params& p, int l, int mode, int tok, int lane) {
  const float* MOD = (const float*)(p.ws + OFF_MOD);
  bf16_t* H = (bf16_t*)(p.ws + OFF_H);
  const float* Y = (const float*)(p.ws + OFF_Y);
  const int ci = tok_cond(tok);
  const float* modl = MOD + (size_t)(l * 5 + ci) * 6144;
  const float* nwl = p.in[I_NORMS] + (size_t)l * 4 * DM;
  const bool from_in = (l == 0 && (mode == 0 || mode == 1 || mode == 3));
  const float* xr = from_in ? x_in_row(p, tok) : p.out + (size_t)tok * DM;
  f32x4 x[4];
#pragma unroll
  for (int i = 0; i < 4; ++i) x[i] = *(const f32x4*)(xr + i * 256 + lane * 4);
  if (mode == 1 || mode == 2) {
    f32x4 y[4]; float ss = 0.f;
#pragma unroll
    for (int i = 0; i < 4; ++i) { y[i] = *(const f32x4*)(Y + (size_t)tok * DM + i * 256 + lane * 4); ss += y[i][0] * y[i][0] + y[i][1] * y[i][1] + y[i][2] * y[i][2] + y[i][3] * y[i][3]; }
    ss = wave_sum(ss, lane);
    const float rs = rsqrtf(ss * (1.0f / DM) + 1e-6f);
    const float* nw = nwl + (mode == 1 ? 1 : 3) * DM;
    const float* g = modl + (mode == 1 ? 2 : 5) * DM;
#pragma unroll
    for (int i = 0; i < 4; ++i) {
      const int c = i * 256 + lane * 4;
      f32x4 w = *(const f32x4*)(nw + c), gg = *(const f32x4*)(g + c);
#pragma unroll
      for (int e = 0; e < 4; ++e) x[i][e] += gg[e] * (y[i][e] * rs * w[e]);
      *(f32x4*)(p.out + (size_t)tok * DM + c) = x[i];
    }
  }
  if (mode == 0 || mode == 3) norm_mod_store(x, nwl, modl + 1 * DM, modl + 0 * DM, H + (size_t)tok * DM, lane);
  else if (mode == 1) norm_mod_store(x, nwl + 2 * DM, modl + 4 * DM, modl + 3 * DM, H + (size_t)tok * DM, lane);
  else if (mode == 2 && l + 1 < 2) {
    const float* modn = MOD + (size_t)((l + 1) * 5 + ci) * 6144;
    norm_mod_store(x, p.in[I_NORMS] + (size_t)(l + 1) * 4 * DM, modn + 1 * DM, modn + 0 * DM, H + (size_t)tok * DM, lane);
  }
}
DI void tok_phase(const Params& p, int l, int mode) {
  const int lane = ltid() & 63, gw = blockIdx.x * 4 + (ltid() >> 6), nw = gridDim.x * 4;
  for (int tok = gw; tok < NT; tok += nw) tok_one(p, l, mode, tok, lane);
}

DI bool tile_xcd(int i, int NTN, int MTX, int& mt, int& nt) {
  const int G = gridDim.x, b = blockIdx.x, x = b & 7, j = b >> 3, nbx = (G - x + 7) >> 3;
  const int u = j + i * nbx;
  if (u >= MTX * NTN) return false;
  mt = MTX * x + (u % MTX); nt = u / MTX;
  return true;
}
DI void phase_inproj(const Params& p, char* smem) {
  const bf16_t* H = (const bf16_t*)(p.ws + OFF_H);
  const bf16_t* WT = (const bf16_t*)(p.ws + OFF_WTIN);
  bf16_t* ZH = (bf16_t*)(p.ws + OFF_ZH); bf16_t* ZR = (bf16_t*)(p.ws + OFF_ZR); bf16_t* ZM = (bf16_t*)(p.ws + OFF_ZM);
  float* MG = (float*)(p.ws + OFF_MG);
  const int lane = ltid() & 63, w = ltid() >> 6, wm = w >> 1, wn = w & 1;
  int mt, nt;
  for (int ti = 0; tile_xcd(ti, 52, 8, mt, nt); ++ti) {
    f32x4 acc[8][4]; zero_acc<8, 4>(acc);
    gemm_main<256, 128, 32>(p, acc, H + (size_t)mt * 256 * 1024, 1024, WT + (size_t)nt * 128 * 1024, 1024, 1024, (bf16_t*)smem);
    const int n0 = nt * 128;
#pragma unroll
    for (int i = 0; i < 8; ++i) {
      const int row = mt * 256 + wm * 128 + i * 16 + (lane & 15);
#pragma unroll
      for (int j = 0; j < 4; ++j) {
        const int col = n0 + wn * 64 + j * 16 + 4 * (lane >> 4);
        if (n0 < 2560) store_bf4(ZH + (size_t)row * ZHW + col, acc[i][j]);
        else if (n0 < 4480) store_bf4(ZR + (size_t)row * ZRW + (col - 2560), acc[i][j]);
        else if (n0 < 6528) store_bf4(ZM + (size_t)row * ZMW + (col - 4480), acc[i][j]);
        else if (col - 6528 < 16) *(f32x4*)(MG + (size_t)row * 16 + (col - 6528)) = acc[i][j];
      }
    }
  }
}

DI void phase_merge(const Params& p, int l, char* smem) {
  const bf16_t* H = (const bf16_t*)(p.ws + OFF_H);
  const bf16_t* WT = (const bf16_t*)(p.ws + OFF_WTIN);
  const bf16_t* WBR = (const bf16_t*)(p.ws + OFF_WTBR);
  const bf16_t* ZH = (const bf16_t*)(p.ws + OFF_ZH); const bf16_t* ZM = (const bf16_t*)(p.ws + OFF_ZM); const bf16_t* O = (const bf16_t*)(p.ws + OFF_O);
  bf16_t* MER = (bf16_t*)(p.ws + OFF_MERGED);
  const int lane = ltid() & 63, w = ltid() >> 6, wm = w >> 1, wn = w & 1;
  int mt, nt;
  for (int ti = 0; tile_xcd(ti, 16, 16, mt, nt); ++ti) {
    f32x4 accM[4][2]; zero_acc<4, 2>(accM);
#pragma unroll 1
    for (int br = 0; br < 3; ++br) {
      f32x4 accG[4][2], accP[4][2]; zero_acc<4, 2>(accG); zero_acc<4, 2>(accP);
      gemm_main<128, 64, 64>(p, accG, H + (size_t)mt * 128 * 1024, 1024, WT + (size_t)(6656 + br * 1024 + nt * 64) * 1024, 1024, 1024, (bf16_t*)smem);
      const bf16_t* Ab; int lda;
      if (br == 0) { Ab = ZH + 2048; lda = ZHW; } else if (br == 1) { Ab = O; lda = 1024; } else { Ab = ZM + 1536; lda = ZMW; }
      gemm_main<128, 64, 64>(p, accP, Ab + (size_t)mt * 128 * lda, lda, WBR + ((size_t)br * 1024 + nt * 64) * 512, 512, 512, (bf16_t*)smem);
#pragma unroll
      for (int i = 0; i < 4; ++i)
#pragma unroll
        for (int j = 0; j < 2; ++j)
#pragma unroll
          for (int e = 0; e < 4; ++e) accM[i][j][e] += sigmoidf_(accG[i][j][e]) * accP[i][j][e];
    }
#pragma unroll
    for (int i = 0; i < 4; ++i) {
      const int row = mt * 128 + wm * 64 + i * 16 + (lane & 15);
#pragma unroll
      for (int j = 0; j < 2; ++j) store_bf4(MER + (size_t)row * 1024 + nt * 64 + wn * 32 + j * 16 + 4 * (lane >> 4), accM[i][j]);
    }
  }
  float* sm = (float*)smem;
  conv_weight(p, p.in[I_WOUT] + (size_t)l * 1024 * 1024, 1024, (bf16_t*)(p.ws + OFF_WTOUT), 1024, 1024, 1, sm, blockIdx.x, gridDim.x);
  conv_weight(p, p.in[I_WFI] + (size_t)l * 1024 * 5632, 5632, (bf16_t*)(p.ws + OFF_WTFI), 1024, 5632, 2, sm, blockIdx.x, gridDim.x);
  conv_weight(p, p.in[I_WFO] + (size_t)l * DFF * 1024, 1024, (bf16_t*)(p.ws + OFF_WTFO), DFF, 1024, 1, sm, blockIdx.x, gridDim.x);
}

DI void phase_gemm_f32(const Params& p, const bf16_t* A, int K, const bf16_t* Wt, char* smem) {
  float* Y = (float*)(p.ws + OFF_Y);
  const int lane = ltid() & 63, w = ltid() >> 6, wm = w >> 1, wn = w & 1;
  int mt, nt;
  for (int ti = 0; tile_xcd(ti, 8, 8, mt, nt); ++ti) {
    f32x4 acc[8][4]; zero_acc<8, 4>(acc);
    gemm_main<256, 128, 32>(p, acc, A + (size_t)mt * 256 * K, K, Wt + (size_t)nt * 128 * K, K, K, (bf16_t*)smem);
#pragma unroll
    for (int i = 0; i < 8; ++i) {
      const int row = mt * 256 + wm * 128 + i * 16 + (lane & 15);
#pragma unroll
      for (int j = 0; j < 4; ++j) *(f32x4*)(Y + (size_t)row * 1024 + nt * 128 + wn * 64 + j * 16 + 4 * (lane >> 4)) = acc[i][j];
    }
  }
}
DI void phase_ffn_in(const Params& p, char* smem) {
  const bf16_t* H = (const bf16_t*)(p.ws + OFF_H);
  const bf16_t* Wt = (const bf16_t*)(p.ws + OFF_WTFI);
  bf16_t* ACT = (bf16_t*)(p.ws + OFF_ACT);
  const int lane = ltid() & 63, w = ltid() >> 6, wm = w >> 1, wn = w & 1;
  int mt, nt;
  for (int ti = 0; tile_xcd(ti, 44, 8, mt, nt); ++ti) {
    f32x4 acc[8][4]; zero_acc<8, 4>(acc);
    gemm_main<256, 128, 32>(p, acc, H + (size_t)mt * 256 * 1024, 1024, Wt + (size_t)nt * 128 * 1024, 1024, 1024, (bf16_t*)smem);
#pragma unroll
    for (int i = 0; i < 8; ++i) {
      const int row = mt * 256 + wm * 128 + i * 16 + (lane & 15);
#pragma unroll
      for (int jj = 0; jj < 2; ++jj) {
        f32x4 u = acc[i][2 * jj], g = acc[i][2 * jj + 1], o;
#pragma unroll
        for (int e = 0; e < 4; ++e) o[e] = siluf_(g[e]) * u[e];
        const int col = (nt * 128 + wn * 64 + jj * 32) / 2 + 4 * (lane >> 4);
        store_bf4(ACT + (size_t)row * DFF + col, o);
      }
    }
  }
}

struct Seq { int base, T, grid, b; bool sample; };
DI Seq get_seq(int s) { Seq q; if (s < 32) { q.base = s * 256; q.T = 256; q.grid = 0; q.b = s; q.sample = false; } else { q.b = s - 32; q.base = 8192 + q.b * 2048; q.T = 2048; q.grid = 1; q.sample = true; } return q; }

DI float rw_shift(const bf16_t* ZR, const float* mu, int base, int t, int T, int grid, int col) {
  const bf16_t* pp = ZR + (size_t)(base + t) * ZRW + col;
  const float y = bf2f(*pp);
  if (!grid) {
    const float prev = t > 0 ? bf2f(pp[-ZRW]) : 0.f, nxt = t < T - 1 ? bf2f(pp[ZRW]) : 0.f;
    return y + mu[col] * (prev - y) + mu[ZRW + col] * (nxt - y);
  }
  const int gc = t & 63, gr = t >> 6;
  const float left = gc > 0 ? bf2f(pp[-ZRW]) : 0.f, right = gc < 63 ? bf2f(pp[ZRW]) : 0.f;
  const float up = gr > 0 ? bf2f(pp[-64 * ZRW]) : 0.f, down = gr < 31 ? bf2f(pp[64 * ZRW]) : 0.f;
  return y + mu[col] * (left - y) + mu[ZRW + col] * (right - y) + mu[2 * ZRW + col] * (up - y) + mu[3 * ZRW + col] * (down - y);
}

DI void rw_shift8(const bf16_t* ZR, const float* mu, int base, int t, int T, int grid, int col0, float (&out)[8]) {
  const bf16_t* pp = ZR + (size_t)(base + t) * ZRW + col0;
  const bf16x8 y = *(const bf16x8*)pp;
  float yv[8];
#pragma unroll
  for (int e = 0; e < 8; ++e) { yv[e] = bf2f((bf16_t)y[e]); out[e] = yv[e]; }
  const int nn = grid ? 4 : 2;
#pragma unroll 1
  for (int n = 0; n < nn; ++n) {
    bool valid; int off;
    if (!grid) { valid = n == 0 ? t > 0 : t < T - 1; off = n == 0 ? -ZRW : ZRW; }
    else { const int gc = t & 63, gr = t >> 6; valid = n == 0 ? gc > 0 : n == 1 ? gc < 63 : n == 2 ? gr > 0 : gr < 31; off = n == 0 ? -ZRW : n == 1 ? ZRW : n == 2 ? -64 * ZRW : 64 * ZRW; }
    const f32x4 m0 = *(const f32x4*)(mu + n * ZRW + col0), m1 = *(const f32x4*)(mu + n * ZRW + col0 + 4);
    bf16x8 nb = y;
    if (valid) nb = *(const bf16x8*)(pp + off);
#pragma unroll
    for (int e = 0; e < 8; ++e) { const float nv_ = valid ? bf2f((bf16_t)nb[e]) : 0.f; const float mm = e < 4 ? m0[e & 3] : m1[e & 3]; out[e] += mm * (nv_ - yv[e]); }
  }
}

DI void rw_load8(const bf16_t* ZR, int base, int t, int T, int grid, int col0, bf16x8 (&v)[5]) {
  const bf16_t* pp = ZR + (size_t)(base + t) * ZRW + col0;
  const bf16x8 z = (bf16x8){0, 0, 0, 0, 0, 0, 0, 0};
  v[0] = *(const bf16x8*)pp;
  if (!grid) {
    v[1] = t > 0 ? *(const bf16x8*)(pp - ZRW) : z; v[2] = t < T - 1 ? *(const bf16x8*)(pp + ZRW) : z; v[3] = z; v[4] = z;
  } else {
    const int gc = t & 63, gr = t >> 6;
    v[1] = gc > 0 ? *(const bf16x8*)(pp - ZRW) : z; v[2] = gc < 63 ? *(const bf16x8*)(pp + ZRW) : z;
    v[3] = gr > 0 ? *(const bf16x8*)(pp - 64 * ZRW) : z; v[4] = gr < 31 ? *(const bf16x8*)(pp + 64 * ZRW) : z;
  }
}
DI void rw_apply8(const bf16x8 (&v)[5], const float* mu, int grid, int col0, float (&out)[8]) {
  float yv[8];
#pragma unroll
  for (int e = 0; e < 8; ++e) { yv[e] = bf2f((bf16_t)v[0][e]); out[e] = yv[e]; }
#pragma unroll
  for (int n = 0; n < 4; ++n) {
    if (n < 2 || grid) {
      const f32x4 m0 = *(const f32x4*)(mu + n * ZRW + col0), m1 = *(const f32x4*)(mu + n * ZRW + col0 + 4);
#pragma unroll
      for (int e = 0; e < 8; ++e) out[e] += (e < 4 ? m0[e & 3] : m1[e & 3]) * (bf2f((bf16_t)v[1 + n][e]) - yv[e]);
    }
  }
}

DI float dpp_ror8(float x) { return __int_as_float(__builtin_amdgcn_mov_dpp(__float_as_int(x), 0x128, 0xF, 0xF, true)); }
DI float dpp_ror4(float x) { return __int_as_float(__builtin_amdgcn_mov_dpp(__float_as_int(x), 0x124, 0xF, 0xF, true)); }
DI float dpp_hmirror(float x) { return __int_as_float(__builtin_amdgcn_mov_dpp(__float_as_int(x), 0x141, 0xF, 0xF, true)); }
DI float fast_tanh(float x) { return 1.0f - 2.0f / (1.0f + __expf(2.0f * x)); }

template <int KPL>
DI void rwkv_item(const Params& p, int l, int s, int hh, int d, int rb, char* smem) {
  constexpr int LPR = 64 / KPL, RPB = NTHR / LPR;
  const Seq q = get_seq(s);
  const int tid = ltid(), lane = tid & 63, w = tid >> 6;
  const bf16_t* ZR = (const bf16_t*)(p.ws + OFF_ZR);
  bf16_t* O = (bf16_t*)(p.ws + OFF_O);
  const float* mu = p.in[I_MU] + (size_t)l * 4 * ZRW;
  bf16_t* Wb2 = (bf16_t*)smem;
  bf16_t* Ab2 = Wb2 + 64 * 72;
  bf16_t* actW = Ab2 + 64 * 72;
  bf16_t* actA = actW + 16 * 72;
  float* sh = (float*)(actA + 16 * 72);
  float* vW = sh + 3 * 1024;
  float* vKK = vW + 1024; float* vKKA = vKK + 1024; float* vKD = vKKA + 1024; float* outb = vKD + 1024;
  float* part = outb + 1024;
  __syncthreads();
  for (int e = tid; e < 4096; e += NTHR) {
    const int i = e >> 6, c = e & 63;
    Wb2[c * 72 + i] = f2bf(p.in[I_W2][((size_t)(l * 2 + d) * 64 + i) * 512 + 64 * hh + c]);
    Ab2[c * 72 + i] = f2bf(p.in[I_A2][((size_t)(l * 2 + d) * 64 + i) * 512 + 64 * hh + c]);
  }
  const int cB = 16 * w + (lane & 15), qB = lane >> 4;
  const float w0c = p.in[I_W0][(l * 2 + d) * 512 + 64 * hh + cB], a0c = p.in[I_A0][(l * 2 + d) * 512 + 64 * hh + cB];
  const float kkc = p.in[I_KK][l * 512 + 64 * hh + cB], kac = p.in[I_KA][l * 512 + 64 * hh + cB];
  const int rowl = tid / LPR, row = rb * RPB + rowl, kb0 = (tid % LPR) * KPL;
  float S[KPL];
  if (q.sample) {
    const float* st = p.in[I_SR] + ((((size_t)q.b * 2 + l) * 2 + d) * 8 + hh) * 4096 + row * 64 + kb0;
#pragma unroll
    for (int i = 0; i < KPL; ++i) S[i] = st[i];
  } else {
#pragma unroll
    for (int i = 0; i < KPL; ++i) S[i] = 0.f;
  }
  __syncthreads();
  bf16x8 bW[2], bA[2];
#pragma unroll
  for (int ks = 0; ks < 2; ++ks) { bW[ks] = *(const bf16x8*)(Wb2 + cB * 72 + ks * 32 + qB * 8); bA[ks] = *(const bf16x8*)(Ab2 + cB * 72 + ks * 32 + qB * 8); }
  const int nch = q.T / 16;
  bf16x8 pf[3][5];
#define RW_COL(arr, c8) ((arr) == 0 ? 64 * hh + (c8) : (arr) == 1 ? 512 + 64 * hh + (c8) : (arr) == 2 ? 1024 + 64 * hh + (c8) : (arr) == 3 ? 1536 + 64 * d + (c8) : 1664 + 64 * d + (c8))
#define RW_ISSUE(chn) { _Pragma("unroll") for (int gi = 0; gi < 3; ++gi) { const int g = tid + gi * NTHR; if (g < 640) { \
      const int arr = g >> 7, rem = g & 127, j = rem >> 3, c8 = (rem & 7) * 8; const int pos = (chn) * 16 + j, t = d ? q.T - 1 - pos : pos; \
      rw_load8(ZR, q.base, t, q.T, q.grid, RW_COL(arr, c8), pf[gi]); } } }
  RW_ISSUE(0)
#pragma unroll 1
  for (int ch = 0; ch < nch; ++ch) {
    __syncthreads();
#pragma unroll
    for (int gi = 0; gi < 3; ++gi) {
      const int g = tid + gi * NTHR;
      if (g < 640) {
        const int arr = g >> 7, rem = g & 127, j = rem >> 3, c8 = (rem & 7) * 8;
        float val[8];
        rw_apply8(pf[gi], mu, q.grid, RW_COL(arr, c8), val);
        if (arr < 3) {
          *(f32x4*)(sh + arr * 1024 + j * 64 + c8) = (f32x4){val[0], val[1], val[2], val[3]};
          *(f32x4*)(sh + arr * 1024 + j * 64 + c8 + 4) = (f32x4){val[4], val[5], val[6], val[7]};
        } else {
          bf16x8 o8;
#pragma unroll
          for (int e = 0; e < 8; ++e) o8[e] = (short)f2bf(arr == 3 ? fast_tanh(val[e]) : val[e]);
          *(bf16x8*)((arr == 3 ? actW : actA) + j * 72 + c8) = o8;
        }
      }
    }
    if (ch + 1 < nch) RW_ISSUE(ch + 1)
    __syncthreads();
    {
      f32x4 aw = (f32x4){0.f, 0.f, 0.f, 0.f}, aa = (f32x4){0.f, 0.f, 0.f, 0.f};
#pragma unroll
      for (int ks = 0; ks < 2; ++ks) {
        const bf16x8 fw = *(const bf16x8*)(actW + (lane & 15) * 72 + ks * 32 + qB * 8);
        const bf16x8 fa = *(const bf16x8*)(actA + (lane & 15) * 72 + ks * 32 + qB * 8);
        aw = __builtin_amdgcn_mfma_f32_16x16x32_bf16(fw, bW[ks], aw, 0, 0, 0);
        aa = __builtin_amdgcn_mfma_f32_16x16x32_bf16(fa, bA[ks], aa, 0, 0, 0);
      }
      float ssq[4];
#pragma unroll
      for (int jj = 0; jj < 4; ++jj) {
        const int j = qB * 4 + jj;
        const float wl = aw[jj] + w0c, al = aa[jj] + a0c;
        const float wlog = -softplusf_(-wl) - 0.5f;
        const float decay = __expf(-__expf(wlog));
        const float a = sigmoidf_(al);
        const float k = sh[1024 + j * 64 + cB];
        const float kkr = k * kkc;
        ssq[jj] = kkr * kkr;
        vW[j * 64 + cB] = decay; vKK[j * 64 + cB] = kkr; vKKA[j * 64 + cB] = kkr * a; vKD[j * 64 + cB] = k * (1.0f + (a - 1.0f) * kac);
      }
#pragma unroll
      for (int jj = 0; jj < 4; ++jj) { float v_ = ssq[jj]; v_ += dpp_ror8(v_); v_ += dpp_ror4(v_); v_ += dpp_xor2(v_); v_ += dpp_xor1(v_); ssq[jj] = v_; }
      if ((lane & 15) == 0) {
#pragma unroll
        for (int jj = 0; jj < 4; ++jj) part[w * 16 + qB * 4 + jj] = ssq[jj];
      }
    }
    __syncthreads();
#pragma unroll 2
    for (int j = 0; j < 16; ++j) {
      const float inv2 = 1.0f / fmaxf(part[j] + part[16 + j] + part[32 + j] + part[48 + j], 1e-24f);
      const float vv = sh[2048 + j * 64 + row];
      float kk[KPL], ww[KPL], ka[KPL], kd[KPL], rr[KPL];
#pragma unroll
      for (int u = 0; u < KPL / 4; ++u) {
        const int o = j * 64 + kb0 + 4 * u;
        f32x4 t0 = *(const f32x4*)(vKK + o), t1 = *(const f32x4*)(vW + o), t2 = *(const f32x4*)(vKKA + o), t3 = *(const f32x4*)(vKD + o), t4 = *(const f32x4*)(sh + o);
#pragma unroll
        for (int e = 0; e < 4; ++e) { kk[4 * u + e] = t0[e]; ww[4 * u + e] = t1[e]; ka[4 * u + e] = t2[e]; kd[4 * u + e] = t3[e]; rr[4 * u + e] = t4[e]; }
      }
      f32x2 dp2 = (f32x2){0.f, 0.f}, dq2 = (f32x2){0.f, 0.f};
#pragma unroll
      for (int i = 0; i < KPL; i += 4) {
        dp2 += (f32x2){S[i], S[i + 1]} * (f32x2){kk[i], kk[i + 1]};
        dq2 += (f32x2){S[i + 2], S[i + 3]} * (f32x2){kk[i + 2], kk[i + 3]};
      }
      float dot = (dp2[0] + dp2[1]) + (dq2[0] + dq2[1]);
      if (LPR == 16) { dot += dpp_ror8(dot); dot += dpp_ror4(dot); }
      dot += dpp_xor2(dot); dot += dpp_xor1(dot);
      if (LPR == 8) dot += dpp_hmirror(dot);
      const float sa = -dot * inv2;
      const f32x2 sa2 = (f32x2){sa, sa}, vv2 = (f32x2){vv, vv};
      f32x2 op2 = (f32x2){0.f, 0.f}, oq2 = (f32x2){0.f, 0.f};
#pragma unroll
      for (int i = 0; i < KPL; i += 4) {
        f32x2 s0 = (f32x2){S[i], S[i + 1]}, s1 = (f32x2){S[i + 2], S[i + 3]};
        s0 = s0 * (f32x2){ww[i], ww[i + 1]} + (sa2 * (f32x2){ka[i], ka[i + 1]} + vv2 * (f32x2){kd[i], kd[i + 1]});
        s1 = s1 * (f32x2){ww[i + 2], ww[i + 3]} + (sa2 * (f32x2){ka[i + 2], ka[i + 3]} + vv2 * (f32x2){kd[i + 2], kd[i + 3]});
        op2 += s0 * (f32x2){rr[i], rr[i + 1]}; oq2 += s1 * (f32x2){rr[i + 2], rr[i + 3]};
        S[i] = s0[0]; S[i + 1] = s0[1]; S[i + 2] = s1[0]; S[i + 3] = s1[1];
      }
      float od = (op2[0] + op2[1]) + (oq2[0] + oq2[1]);
      if (LPR == 16) { od += dpp_ror8(od); od += dpp_ror4(od); }
      od += dpp_xor2(od); od += dpp_xor1(od);
      if (LPR == 8) od += dpp_hmirror(od);
      if ((tid % LPR) == 0) outb[j * RPB + rowl] = od;
    }
    __syncthreads();
    for (int e = tid; e < 16 * RPB; e += NTHR) {
      const int j = e / RPB, c = e % RPB, pos = ch * 16 + j, t = d ? q.T - 1 - pos : pos;
      O[(size_t)(q.base + t) * 1024 + d * 512 + 64 * hh + rb * RPB + c] = f2bf(outb[e]);
    }
  }
  if (!q.sample) {
    float* dst = p.out + OUT_RW + ((((size_t)q.b * 2 + l) * 2 + d) * 8 + hh) * 4096 + row * 64 + kb0;
#pragma unroll
    for (int i = 0; i < KPL; ++i) dst[i] = S[i];
  }
}

DI void hgrn_item(const Params& p, int l, int s, int hh, int d, char* smem) {
  const Seq q = get_seq(s);
  const int tid = ltid(), lane = tid & 63, w = tid >> 6, r = lane & 31, h = lane >> 5;
  bf16_t* ZH = (bf16_t*)(p.ws + OFF_ZH);
  bf16_t* Qt = (bf16_t*)smem;
  bf16_t* Kt = Qt + 32 * 136;
  bf16_t* KhT = Kt + 32 * 136;
  bf16_t* VT = KhT + 128 * 40;
  bf16_t* Sb = VT + 128 * 40;
  bf16_t* At = Sb + 4 * 32 * 136;
  float* dL = (float*)(At + 32 * 40);
  float* tot = dL + 128;
  const float lb = ((const float*)(p.ws + OFF_LBS))[l * 512 + 128 * hh + (tid & 127)];
  f32x16 S[4];
  if (q.sample) {
    const float* st = p.in[I_SH] + ((((size_t)q.b * 2 + l) * 2 + d) * 4 + hh) * 16384;
#pragma unroll
    for (int kb = 0; kb < 4; ++kb)
#pragma unroll
      for (int g = 0; g < 16; ++g) S[kb][g] = st[(size_t)(32 * kb + crow(g, h)) * 128 + 32 * w + r];
  } else {
#pragma unroll
    for (int kb = 0; kb < 4; ++kb)
#pragma unroll
      for (int g = 0; g < 16; ++g) S[kb][g] = 0.f;
  }
  const int k = tid & 127, half = tid >> 7;
  const int nch = q.T / 32;
  u16x2 pzq[16], pv2[8];
#define HG_ISSUE(chn) { _Pragma("unroll") for (int jj = 0; jj < 16; ++jj) { const int pos = (chn) * 32 + half * 16 + jj, t = d ? q.T - 1 - pos : pos; \
      const size_t rowo = (size_t)(q.base + t) * ZHW + 128 * hh + k; pzq[jj][0] = ZH[rowo + 512 * (1 + d)]; pzq[jj][1] = ZH[rowo]; pv2[jj >> 1][jj & 1] = ZH[rowo + 1536]; } }
  HG_ISSUE(0)
#pragma unroll 1
  for (int ch = 0; ch < nch; ++ch) {
    __syncthreads();
    float bl[16], kc[16], qs[16];
    {
      float b = 0.f;
#pragma unroll
      for (int jj = 0; jj < 16; ++jj) {
        const float z = bf2f(pzq[jj][0]);
        const float kcoef = (1.0f - lb) * sigmoidf_(-z);
        const float f = 1.0f - kcoef;
        b += fmaxf(__logf(f), -80.f);
        bl[jj] = b; kc[jj] = kcoef; qs[jj] = bf2f(pzq[jj][1]) * 0.08838834764831845f;
      }
      *(u32x4*)(VT + k * 40 + half * 16) = (u32x4){__builtin_bit_cast(unsigned, pv2[0]), __builtin_bit_cast(unsigned, pv2[1]), __builtin_bit_cast(unsigned, pv2[2]), __builtin_bit_cast(unsigned, pv2[3])};
      *(u32x4*)(VT + k * 40 + half * 16 + 8) = (u32x4){__builtin_bit_cast(unsigned, pv2[4]), __builtin_bit_cast(unsigned, pv2[5]), __builtin_bit_cast(unsigned, pv2[6]), __builtin_bit_cast(unsigned, pv2[7])};
      tot[half * 128 + k] = b;
    }
    if (ch + 1 < nch) HG_ISSUE(ch + 1)
    __syncthreads();
    {
      const float off = half ? tot[k] : 0.f;
      const float bL = fmaxf(tot[k] + tot[128 + k], -80.f);
      if (half == 0) dL[k] = __expf(bL);
      float kh[16];
#pragma unroll
      for (int jj = 0; jj < 16; ++jj) {
        const int j = half * 16 + jj;
        const float bj = fmaxf(off + bl[jj], -80.f);
        Qt[j * 136 + k] = f2bf(qs[jj] * __expf(bj));
        Kt[j * 136 + k] = f2bf(kc[jj] * __expf(-bj));
        kh[jj] = kc[jj] * __expf(fminf(bL - bj, 0.f));
      }
      *(u32x4*)(KhT + k * 40 + half * 16) = (u32x4){pk2(kh[0], kh[1]), pk2(kh[2], kh[3]), pk2(kh[4], kh[5]), pk2(kh[6], kh[7])};
      *(u32x4*)(KhT + k * 40 + half * 16 + 8) = (u32x4){pk2(kh[8], kh[9]), pk2(kh[10], kh[11]), pk2(kh[12], kh[13]), pk2(kh[14], kh[15])};
    }
    bf16_t* Sbw = Sb + w * 32 * 136;
#pragma unroll
    for (int kb = 0; kb < 4; ++kb)
#pragma unroll
      for (int g4 = 0; g4 < 4; ++g4) *(u32x2*)(Sbw + r * 136 + 32 * kb + crow(4 * g4, h)) = (u32x2){pk2(S[kb][4 * g4], S[kb][4 * g4 + 1]), pk2(S[kb][4 * g4 + 2], S[kb][4 * g4 + 3])};
    __syncthreads();
    bf16_t* Atw = At;
    {
      f32x16 A;
#pragma unroll
      for (int g = 0; g < 16; ++g) A[g] = 0.f;
      mma32(A, Qt, 136, Kt, 136, 128, lane);
#pragma unroll
      for (int g = 0; g < 16; ++g) { const int t = crow(g, h); Atw[t * 40 + r] = f2bf(r <= t ? A[g] : 0.f); }
    }
    __syncthreads();
    {
      f32x16 o;
#pragma unroll
      for (int g = 0; g < 16; ++g) o[g] = 0.f;
      mma32(o, Atw, 40, VT + 32 * w * 40, 40, 32, lane);
      mma32(o, Qt, 136, Sbw, 136, 128, lane);
#pragma unroll
      for (int g = 0; g < 16; ++g) {
        const int j = crow(g, h), pos = ch * 32 + j, t = d ? q.T - 1 - pos : pos;
        ZH[(size_t)(q.base + t) * ZHW + 512 * (1 + d) + 128 * hh + 32 * w + r] = f2bf(o[g]);
      }
#pragma unroll
      for (int kb = 0; kb < 4; ++kb) {
#pragma unroll
        for (int g = 0; g < 16; ++g) S[kb][g] *= dL[32 * kb + crow(g, h)];
        mma32(S[kb], KhT + 32 * kb * 40, 40, VT + 32 * w * 40, 40, 32, lane);
      }
    }
  }
  if (!q.sample) {
    float* dst = p.out + OUT_HG + ((((size_t)q.b * 2 + l) * 2 + d) * 4 + hh) * 16384;
#pragma unroll
    for (int kb = 0; kb < 4; ++kb)
#pragma unroll
      for (int g = 0; g < 16; ++g) dst[(size_t)(32 * kb + crow(g, h)) * 128 + 32 * w + r] = S[kb][g];
  }
}

DI void mlstm_item(const Params& p, int l, int s, int hh, int d, char* smem) {
  const Seq q = get_seq(s);
  const int tid = ltid(), lane = tid & 63, w = tid >> 6, r = lane & 31, h = lane >> 5;
  const bf16_t* ZM = (const bf16_t*)(p.ws + OFF_ZM);
  const float* MG = (const float*)(p.ws + OFF_MG);
  bf16_t* Hb = (bf16_t*)(p.ws + OFF_H);
  bf16_t* Qm = (bf16_t*)smem;
  bf16_t* Km = Qm + 32 * 136;
  bf16_t* KwT = Km + 32 * 136;
  bf16_t* VT = KwT + 128 * 40;
  bf16_t* Cb = VT + 128 * 40;
  bf16_t* Pt = Cb + 4 * 32 * 136;
  float* nv = (float*)(Pt + 32 * 40);
  float* sc = nv + 128;
  float* ig = sc; float* lf = sc + 32; float* gg = sc + 64; float* mtv = sc + 96; float* wi = sc + 128; float* wsr = sc + 160; float* qn = sc + 192; float* misc = sc + 224;
  float* dnw = sc + 232;
  const float gbi = p.in[I_GB][l * 16 + (2 * d) * 4 + hh], gbf = p.in[I_GB][l * 16 + (2 * d + 1) * 4 + hh];
  f32x16 C[4];
  float m;
  __syncthreads();
  if (q.sample) {
    const size_t sb = (((size_t)q.b * 2 + l) * 2 + d) * 4 + hh;
    const float* st = p.in[I_SC] + sb * 16384;
#pragma unroll
    for (int kb = 0; kb < 4; ++kb)
#pragma unroll
      for (int g = 0; g < 16; ++g) C[kb][g] = st[(size_t)(32 * kb + crow(g, h)) * 128 + 32 * w + r];
    if (tid < 128) nv[tid] = p.in[I_SN][sb * 128 + tid];
    m = p.in[I_SM][sb];
  } else {
#pragma unroll
    for (int kb = 0; kb < 4; ++kb)
#pragma unroll
      for (int g = 0; g < 16; ++g) C[kb][g] = 0.f;
    if (tid < 128) nv[tid] = 0.f;
    m = 0.f;
  }
  const int nch = q.T / 32;
  const int dd = tid & 127, half = tid >> 7;
  u16x2 pqk[16], pv2[8]; float pgi = 0.f, pgf = 0.f;
#define ML_ISSUE(chn) { _Pragma("unroll") for (int jj = 0; jj < 16; ++jj) { const int pos = (chn) * 32 + half * 16 + jj, t = d ? q.T - 1 - pos : pos; \
      const size_t rowo = (size_t)(q.base + t) * ZMW + 128 * hh + dd; pqk[jj][0] = ZM[rowo]; pqk[jj][1] = ZM[rowo + 512]; pv2[jj >> 1][jj & 1] = ZM[rowo + 1024]; } \
    if (tid < 32) { const int pos = (chn) * 32 + tid, t = d ? q.T - 1 - pos : pos; const float* mg = MG + (size_t)(q.base + t) * 16; pgi = mg[(2 * d) * 4 + hh]; pgf = mg[(2 * d + 1) * 4 + hh]; } }
  ML_ISSUE(0)
#pragma unroll 1
  for (int ch = 0; ch < nch; ++ch) {
    __syncthreads();
    {
#pragma unroll
      for (int jj = 0; jj < 16; ++jj) {
        const int j = half * 16 + jj;
        Qm[j * 136 + dd] = pqk[jj][0];
        Km[j * 136 + dd] = f2bf(bf2f(pqk[jj][1]) * 0.08838834764831845f);
      }
      *(u32x4*)(VT + dd * 40 + half * 16) = (u32x4){__builtin_bit_cast(unsigned, pv2[0]), __builtin_bit_cast(unsigned, pv2[1]), __builtin_bit_cast(unsigned, pv2[2]), __builtin_bit_cast(unsigned, pv2[3])};
      *(u32x4*)(VT + dd * 40 + half * 16 + 8) = (u32x4){__builtin_bit_cast(unsigned, pv2[4]), __builtin_bit_cast(unsigned, pv2[5]), __builtin_bit_cast(unsigned, pv2[6]), __builtin_bit_cast(unsigned, pv2[7])};
      if (tid < 32) {
        const float igv = pgi + gbi;
        const float lfv = -softplusf_(-(pgf + gbf));
        float g = lfv;
#pragma unroll
        for (int o = 1; o < 32; o <<= 1) { const float tt = shfl_lane(g, (lane - o) & 63); if (tid >= o) g += tt; }
        const float cs = igv - g;
        float pm = cs;
#pragma unroll
        for (int o = 1; o < 32; o <<= 1) { const float tt = shfl_lane(pm, (lane - o) & 63); if (tid >= o) pm = fmaxf(pm, tt); }
        const float mt = g + fmaxf(m, pm);
        const float gend = shfl_lane(g, 31), mn = shfl_lane(mt, 31);
        ig[tid] = igv; gg[tid] = g; mtv[tid] = mt; wi[tid] = __expf(g + m - mt);
        wsr[tid] = __expf(gend + cs - mn);
        if (tid == 0) { misc[0] = mn; misc[1] = __expf(gend + m - mn); }
      }
    }
    if (ch + 1 < nch) ML_ISSUE(ch + 1)
    __syncthreads();
    {
      {
        float kw[16];
#pragma unroll
        for (int jj = 0; jj < 16; ++jj) { const int j = half * 16 + jj; kw[jj] = bf2f(Km[j * 136 + dd]) * wsr[j]; }
        *(u32x4*)(KwT + dd * 40 + half * 16) = (u32x4){pk2(kw[0], kw[1]), pk2(kw[2], kw[3]), pk2(kw[4], kw[5]), pk2(kw[6], kw[7])};
        *(u32x4*)(KwT + dd * 40 + half * 16 + 8) = (u32x4){pk2(kw[8], kw[9]), pk2(kw[10], kw[11]), pk2(kw[12], kw[13]), pk2(kw[14], kw[15])};
      }
      const int j = tid >> 3, seg = tid & 7;
      float a = 0.f;
#pragma unroll
      for (int i = 0; i < 16; ++i) a += bf2f(Qm[j * 136 + seg * 16 + i]) * nv[seg * 16 + i];
      a += SHX(a, 1); a += SHX(a, 2); a += SHX(a, 4);
      if (seg == 0) qn[j] = a;
    }
    const float m_new = misc[0], carry = misc[1];
    bf16_t* Cbw = Cb + w * 32 * 136; bf16_t* Ptw = Pt;
#pragma unroll
    for (int kb = 0; kb < 4; ++kb)
#pragma unroll
      for (int g4 = 0; g4 < 4; ++g4) *(u32x2*)(Cbw + r * 136 + 32 * kb + crow(4 * g4, h)) = (u32x2){pk2(C[kb][4 * g4], C[kb][4 * g4 + 1]), pk2(C[kb][4 * g4 + 2], C[kb][4 * g4 + 3])};
    {
      f32x16 Sc;
#pragma unroll
      for (int g = 0; g < 16; ++g) Sc[g] = 0.f;
      mma32(Sc, Qm, 136, Km, 136, 128, lane);
      const float gs = gg[r], is = ig[r];
#pragma unroll
      for (int g = 0; g < 16; ++g) {
        const int t = crow(g, h);
        const float pv = (r <= t) ? __expf(gg[t] - gs + is - mtv[t]) * Sc[g] : 0.f;
        Ptw[t * 40 + r] = f2bf(pv);
      }
    }
    __syncthreads();
    if (lane < 32) {
      float a = 0.f;
#pragma unroll 4
      for (int i = 0; i < 32; ++i) a += bf2f(Ptw[lane * 40 + i]);
      const float den = wi[lane] * qn[lane] + a;
      dnw[lane] = 1.0f / fmaxf(fabsf(den), __expf(-mtv[lane]));
    }
    if (tid < 128) {
      float a = 0.f;
#pragma unroll 4
      for (int i = 0; i < 32; ++i) a += bf2f(KwT[tid * 40 + i]);
      nv[tid] = carry * nv[tid] + a;
    }
    __syncthreads();
    {
      f32x16 a1;
#pragma unroll
      for (int g = 0; g < 16; ++g) a1[g] = 0.f;
      mma32(a1, Qm, 136, Cbw, 136, 128, lane);
#pragma unroll
      for (int g = 0; g < 16; ++g) a1[g] *= wi[crow(g, h)];
      mma32(a1, Ptw, 40, VT + 32 * w * 40, 40, 32, lane);
#pragma unroll
      for (int g = 0; g < 16; ++g) {
        const int j = crow(g, h), pos = ch * 32 + j, t = d ? q.T - 1 - pos : pos;
        const float hv = a1[g] * dnw[j];
        Hb[(size_t)(q.base + t) * 1024 + d * 512 + 128 * hh + 32 * w + r] = f2bf(hv);
      }
#pragma unroll
      for (int kb = 0; kb < 4; ++kb) {
#pragma unroll
        for (int g = 0; g < 16; ++g) C[kb][g] *= carry;
        mma32(C[kb], KwT + 32 * kb * 40, 40, VT + 32 * w * 40, 40, 32, lane);
      }
    }
    m = m_new;
  }
  __syncthreads();
  if (!q.sample) {
    const size_t sb = (((size_t)q.b * 2 + l) * 2 + d) * 4 + hh;
    float* dst = p.out + OUT_C + sb * 16384;
#pragma unroll
    for (int kb = 0; kb < 4; ++kb)
#pragma unroll
      for (int g = 0; g < 16; ++g) dst[(size_t)(32 * kb + crow(g, h)) * 128 + 32 * w + r] = C[kb][g];
    if (tid < 128) p.out[OUT_N + sb * 128 + tid] = nv[tid];
    if (tid == 0) p.out[OUT_M + sb] = m;
  }
}

DI void phase_scan(const Params& p, int l, char* smem) {
  int* ctrL = (int*)(p.ws + OFF_CTR) + 2 * l;
  int* ctrS = ctrL + 1;
  int* sit = (int*)(smem + LDS_BYTES - 16);
  const int role = p.role;
  bool longDone = false, shortDone = false;
  for (;;) {
    const bool wantLong = (role == 0) ? !longDone : shortDone;
    if (longDone && shortDone) break;
    __syncthreads();
    if (ltid() == 0) *sit = atomicAdd(wantLong ? ctrL : ctrS, 1);
    __syncthreads();
    int it = __builtin_amdgcn_readfirstlane(*sit);
    int ty, s_, hh_, d_, rb_ = 0;
    if (wantLong) {
      if (it >= 192) { longDone = true; continue; }
      if (it < 128) { ty = 3; rb_ = it & 1; d_ = (it >> 1) & 1; hh_ = (it >> 2) & 7; s_ = 32 + (it >> 5); }
      else if (it < 160) { it -= 128; ty = 1; s_ = 32 + (it >> 3); hh_ = (it >> 1) & 3; d_ = it & 1; }
      else { it -= 160; ty = 2; s_ = 32 + (it >> 3); hh_ = (it >> 1) & 3; d_ = it & 1; }
    } else {
      if (it >= 1024) { shortDone = true; continue; }
      if (it < 512) { ty = 0; s_ = it >> 4; hh_ = (it >> 1) & 7; d_ = it & 1; }
      else if (it < 768) { it -= 512; ty = 1; s_ = it >> 3; hh_ = (it >> 1) & 3; d_ = it & 1; }
      else { it -= 768; ty = 2; s_ = it >> 3; hh_ = (it >> 1) & 3; d_ = it & 1; }
    }
    if (ty == 0) rwkv_item<16>(p, l, s_, hh_, d_, 0, smem);
    else if (ty == 3) rwkv_item<8>(p, l, s_, hh_, d_, rb_, smem);
    else if (ty == 1) hgrn_item(p, l, s_, hh_, d_, smem);
    else mlstm_item(p, l, s_, hh_, d_, smem);
  }
}

DI void phase_combine(const Params& p, int l, char* smem) {
  const int tid = ltid(), lane = tid & 63, w = tid >> 6;
  bf16_t* ZH = (bf16_t*)(p.ws + OFF_ZH); bf16_t* ZM = (bf16_t*)(p.ws + OFF_ZM); const bf16_t* ZR = (const bf16_t*)(p.ws + OFF_ZR);
  bf16_t* O = (bf16_t*)(p.ws + OFF_O); const bf16_t* Hb = (const bf16_t*)(p.ws + OFF_H);
  const float* mu = p.in[I_MU] + (size_t)l * 4 * ZRW;
  const float* g2 = p.in[I_G2] + (size_t)l * 128 * 512;
  float* sg = (float*)smem;
  float* gt = sg + 128 * 16;
  for (int blk = blockIdx.x; blk < NT / 16; blk += gridDim.x) {
    const int tok0 = blk * 16;
    int sidx, t0;
    if (tok0 < 8192) { sidx = tok0 >> 8; t0 = tok0 & 255; } else { sidx = 32 + ((tok0 - 8192) >> 11); t0 = (tok0 - 8192) & 2047; }
    const Seq q = get_seq(sidx);
    __syncthreads();
    { const int j = tid >> 4, rr0 = (tid & 15) * 8; float val[8]; bf16x8 pv[5]; rw_load8(ZR, q.base, t0 + j, q.T, q.grid, 1792 + rr0, pv); rw_apply8(pv, mu, q.grid, 1792 + rr0, val);
#pragma unroll
      for (int e = 0; e < 8; ++e) sg[(rr0 + e) * 16 + j] = sigmoidf_(val[e]); }
    __syncthreads();
    {
      float a0[16], a1[16];
#pragma unroll
      for (int j = 0; j < 16; ++j) { a0[j] = 0.f; a1[j] = 0.f; }
#pragma unroll 1
      for (int r0 = 0; r0 < 128; r0 += 8) {
        float w0v[8], w1v[8];
#pragma unroll
        for (int q8 = 0; q8 < 8; ++q8) { w0v[q8] = g2[(r0 + q8) * 512 + tid]; w1v[q8] = g2[(r0 + q8) * 512 + 256 + tid]; }
#pragma unroll
        for (int q8 = 0; q8 < 8; ++q8) {
          const int rr = r0 + q8; const float w0 = w0v[q8], w1 = w1v[q8];
#pragma unroll
          for (int u = 0; u < 4; ++u) {
            f32x4 sv = *(const f32x4*)(sg + rr * 16 + 4 * u);
#pragma unroll
            for (int e = 0; e < 4; ++e) { a0[4 * u + e] += sv[e] * w0; a1[4 * u + e] += sv[e] * w1; }
          }
        }
      }
#pragma unroll
      for (int j = 0; j < 16; ++j) { gt[j * 512 + tid] = a0[j]; gt[j * 512 + 256 + tid] = a1[j]; }
    }
    __syncthreads();
#pragma unroll 1
    for (int jj = 0; jj < 4; ++jj) {
      const int j = w * 4 + jj, tok = tok0 + j, t = t0 + j; int c0 = lane * 8; asm volatile("" : "+v"(c0));
      {
        float o[8], rs[8], ks[8], vs[8];
        float sum = 0.f, bon = 0.f;
        {
          bf16x8 pr_[5], pk_[5], pv_[5];
          rw_load8(ZR, q.base, t, q.T, q.grid, c0, pr_); rw_load8(ZR, q.base, t, q.T, q.grid, 512 + c0, pk_); rw_load8(ZR, q.base, t, q.T, q.grid, 1024 + c0, pv_);
          rw_apply8(pr_, mu, q.grid, c0, rs); rw_apply8(pk_, mu, q.grid, 512 + c0, ks); rw_apply8(pv_, mu, q.grid, 1024 + c0, vs);
        }
        const bf16x8 of = *(const bf16x8*)(O + (size_t)tok * 1024 + c0), ob = *(const bf16x8*)(O + (size_t)tok * 1024 + 512 + c0);
        const f32x4 rk0 = *(const f32x4*)(p.in[I_RK] + l * 512 + c0), rk1 = *(const f32x4*)(p.in[I_RK] + l * 512 + c0 + 4);
#pragma unroll
        for (int e = 0; e < 8; ++e) {
          o[e] = bf2f((bf16_t)of[e]) + bf2f((bf16_t)ob[e]);
          sum += o[e];
          bon += rs[e] * ks[e] * (e < 4 ? rk0[e & 3] : rk1[e & 3]);
        }
        sum += SHX(sum, 1); sum += SHX(sum, 2); sum += SHX(sum, 4);
        bon += SHX(bon, 1); bon += SHX(bon, 2); bon += SHX(bon, 4);
        const float mean = sum * (1.0f / 64.f);
        float var = 0.f;
#pragma unroll
        for (int e = 0; e < 8; ++e) { const float dv = o[e] - mean; var += dv * dv; }
        var += SHX(var, 1); var += SHX(var, 2); var += SHX(var, 4);
        const float rstd = rsqrtf(var * (1.0f / 64.f) + 64e-5f);
        const f32x4 lw0 = *(const f32x4*)(p.in[I_LN] + (l * 2 + 0) * 512 + c0), lw1 = *(const f32x4*)(p.in[I_LN] + (l * 2 + 0) * 512 + c0 + 4);
        const f32x4 lb0 = *(const f32x4*)(p.in[I_LN] + (l * 2 + 1) * 512 + c0), lb1 = *(const f32x4*)(p.in[I_LN] + (l * 2 + 1) * 512 + c0 + 4);
        const f32x4 gt0 = *(const f32x4*)(gt + j * 512 + c0), gt1 = *(const f32x4*)(gt + j * 512 + c0 + 4);
        bf16x8 ov;
#pragma unroll
        for (int e = 0; e < 8; ++e) {
          const float ln = (o[e] - mean) * rstd * (e < 4 ? lw0[e & 3] : lw1[e & 3]) + (e < 4 ? lb0[e & 3] : lb1[e & 3]);
          ov[e] = (short)f2bf((ln + bon * vs[e]) * (e < 4 ? gt0[e & 3] : gt1[e & 3]));
        }
        *(bf16x8*)(O + (size_t)tok * 1024 + c0) = ov;
      }
      {
        float o[8]; float ss = 0.f;
        bf16_t* zr_ = ZH + (size_t)tok * ZHW + c0;
        const bf16x8 of = *(const bf16x8*)(zr_ + 512), ob = *(const bf16x8*)(zr_ + 1024), hgv = *(const bf16x8*)(zr_ + 2048);
        const f32x4 nw0 = *(const f32x4*)(p.in[I_HNORM] + l * 512 + c0), nw1 = *(const f32x4*)(p.in[I_HNORM] + l * 512 + c0 + 4);
#pragma unroll
        for (int e = 0; e < 8; ++e) { o[e] = bf2f((bf16_t)of[e]) + bf2f((bf16_t)ob[e]); ss += o[e] * o[e]; }
        ss += SHX(ss, 1); ss += SHX(ss, 2); ss += SHX(ss, 4); ss += SHX(ss, 8);
        const float rsd = rsqrtf(ss * (1.0f / 128.f) + 1e-6f);
        bf16x8 ov;
#pragma unroll
        for (int e = 0; e < 8; ++e) ov[e] = (short)f2bf(o[e] * rsd * (e < 4 ? nw0[e & 3] : nw1[e & 3]) * siluf_(bf2f((bf16_t)hgv[e])));
        *(bf16x8*)(zr_ + 2048) = ov;
      }
      {
        float o[8]; float ss = 0.f;
        bf16_t* zm_ = ZM + (size_t)tok * ZMW + 1536 + c0;
        const bf16x8 of = *(const bf16x8*)(Hb + (size_t)tok * 1024 + c0), ob = *(const bf16x8*)(Hb + (size_t)tok * 1024 + 512 + c0), mov = *(const bf16x8*)zm_;
        const f32x4 nw0 = *(const f32x4*)(p.in[I_MNORM] + l * 512 + c0), nw1 = *(const f32x4*)(p.in[I_MNORM] + l * 512 + c0 + 4);
#pragma unroll
        for (int e = 0; e < 8; ++e) { o[e] = bf2f((bf16_t)of[e]) + bf2f((bf16_t)ob[e]); ss += o[e] * o[e]; }
        ss += SHX(ss, 1); ss += SHX(ss, 2); ss += SHX(ss, 4); ss += SHX(ss, 8);
        const float rsd = rsqrtf(ss * (1.0f / 128.f) + 1e-6f);
        bf16x8 ov;
#pragma unroll
        for (int e = 0; e < 8; ++e) ov[e] = (short)f2bf(o[e] * rsd * (e < 4 ? nw0[e & 3] : nw1[e & 3]) * sigmoidf_(bf2f((bf16_t)mov[e])));
        *(bf16x8*)zm_ = ov;
      }
    }
    __syncthreads();
#pragma unroll 1
    for (int jj = 0; jj < 4; ++jj) tok_one(p, l, 3, tok0 + w * 4 + jj, lane);
  }
}

#define XB_TMO      128
#define XB_XCNT(j)  (256  + 64 * (j))
#define XB_XSUB(j)  (1280 + 64 * (j))
#define XB_XGEN(j)  (2304 + 64 * (j))
#define XB_TOP      3328
#define XB_TOPGEN   3392
#define XCD_BAR_WORDS 3456
#define XB_SPIN_CAP (1u << 20)
#define LAS __attribute__((address_space(3)))
DI unsigned xb_ld(unsigned* p)              { return __hip_atomic_load(p, __ATOMIC_RELAXED, __HIP_MEMORY_SCOPE_AGENT); }
DI unsigned xb_add(unsigned* p, unsigned v) { return __hip_atomic_fetch_add(p, v, __ATOMIC_RELAXED, __HIP_MEMORY_SCOPE_AGENT); }
DI unsigned xb_xcc_id() { return (unsigned)__builtin_amdgcn_s_getreg((3 << 11) | 20) & 0xFu; }
#define XB_SPIN(cond, bar) do { unsigned _sp = 0; while (cond) { __builtin_amdgcn_s_sleep(1); \
    if ((++_sp & 255u) == 0u) { if (xb_ld(&(bar)[XB_TMO])) break; if (_sp > XB_SPIN_CAP) { atomicAdd(&(bar)[XB_TMO], 1u); break; } } } } while (0)
struct XcdBarrier { unsigned* bar; unsigned x; volatile LAS unsigned* st; };
DI XcdBarrier xcd_barrier_post(const Params& p, unsigned* bar, volatile LAS unsigned* st) {
  XcdBarrier b; b.bar = bar; b.x = xb_xcc_id(); b.st = st;
  if (ltid() == 0) (void)xb_add(&bar[XB_XCNT(b.x)], 1u);
  return b;
}
DI void xcd_barrier_complete(unsigned* bar, unsigned x, unsigned& nloc, unsigned& nx) {
  const unsigned G = gridDim.x * gridDim.y * gridDim.z;
  unsigned sum, cnt, mine, sp = 0u;
  for (;;) {
    sum = 0u; cnt = 0u; mine = 0u;
#pragma unroll
    for (unsigned j = 0; j < 16; ++j) { const unsigned c = xb_ld(&bar[XB_XCNT(j)]); sum += c; cnt += (c > 0u) ? 1u : 0u; mine = (j == x) ? c : mine; }
    if (sum == G) break;
    __builtin_amdgcn_s_sleep(1);
    if ((++sp & 255u) == 0u) { if (xb_ld(&bar[XB_TMO])) break; if (sp > XB_SPIN_CAP) { atomicAdd(&bar[XB_TMO], 1u); break; } }
  }
  nloc = mine > 0u ? mine : 1u; nx = cnt > 0u ? cnt : 1u;
}
DI void xcd_barrier(const Params& p, const XcdBarrier& b) {
  asm volatile("s_waitcnt vmcnt(0)" ::: "memory");
  __syncthreads();
  if (ltid() == 0) {
    unsigned* bar = b.bar;
    __builtin_amdgcn_s_waitcnt(0);
    unsigned nloc = b.st[0], nx = b.st[1];
    if (nloc == 0u) { xcd_barrier_complete(bar, b.x, nloc, nx); b.st[0] = nloc; b.st[1] = nx; }
    const unsigned old = xb_add(&bar[XB_XSUB(b.x)], 1u);
    const unsigned gen = old / nloc;
    if (old + 1u == (gen + 1u) * nloc) {
      __builtin_amdgcn_fence(__ATOMIC_RELEASE, "agent");
      asm volatile("s_waitcnt vmcnt(0)" ::: "memory");
      const unsigned og = xb_add(&bar[XB_TOP], 1u);
      const unsigned tg = og / nx;
      if (og + 1u == (tg + 1u) * nx) xb_add(&bar[XB_TOPGEN], 1u);
      else XB_SPIN(xb_ld(&bar[XB_TOPGEN]) == tg, bar);
      __builtin_amdgcn_fence(__ATOMIC_ACQUIRE, "agent");
      xb_add(&bar[XB_XGEN(b.x)], 1u);
      asm volatile("s_waitcnt vmcnt(0)" ::: "memory");
    } else {
      XB_SPIN(xb_ld(&bar[XB_XGEN(b.x)]) == gen, bar);
      __builtin_amdgcn_fence(__ATOMIC_ACQUIRE, "agent");
      asm volatile("s_waitcnt vmcnt(0)" ::: "memory");
    }
  }
  __syncthreads();
}

constexpr int NPHASE = 3 + 9 * 2;
DI void run_phase(const Params& p0, int ph, char* smem) {
  Params p = p0;
  asm volatile("" : "+s"(p.ws), "+s"(p.out));
  if (ph == 0) { phase0(p, smem); return; }
  if (ph == 1) { phase1(p); return; }
  if (ph == 2) { tok_phase(p, 0, 0); return; }
  const int l = (ph - 3) / 9, s = (ph - 3) % 9;
  switch (s) {
    case 0: phase_inproj(p, smem); break;
    case 1: phase_scan(p, l, smem); break;
    case 2: phase_combine(p, l, smem); break;
    case 3: phase_merge(p, l, smem); break;
    case 4: phase_gemm_f32(p, (const bf16_t*)(p.ws + OFF_MERGED), 1024, (const bf16_t*)(p.ws + OFF_WTOUT), smem); break;
    case 5: tok_phase(p, l, 1); break;
    case 6: phase_ffn_in(p, smem); break;
    case 7: phase_gemm_f32(p, (const bf16_t*)(p.ws + OFF_ACT), DFF, (const bf16_t*)(p.ws + OFF_WTFO), smem); break;
    case 8:
      tok_phase(p, l, 2);
      if (l + 1 < 2) {
        conv_weight(p, p.in[I_WIN] + (size_t)(l + 1) * 1024 * DIN, DIN, (bf16_t*)(p.ws + OFF_WTIN), 1024, WTIN_ROWS, 0, (float*)smem, blockIdx.x, gridDim.x);
        for (int br = 0; br < 3; ++br) conv_weight(p, p.in[I_WBR] + ((size_t)(l + 1) * 3 + br) * 512 * 1024, 1024, (bf16_t*)(p.ws + OFF_WTBR) + (size_t)br * 1024 * 512, 512, 1024, 1, (float*)smem, blockIdx.x, gridDim.x);
      }
      break;
  }
}

template <bool COOP>
__global__ void __launch_bounds__(NTHR, 2) mega(Params pk, int lo, int hi) {
  __shared__ __attribute__((aligned(16))) char smem[LDS_BYTES];
  Params p = pk;
  p.wb = __builtin_amdgcn_readfirstlane((int)threadIdx.x) & ~63;
  if (COOP) {
    volatile LAS unsigned* st = (volatile LAS unsigned*)(smem + LDS_BYTES - 32);
    if (ltid() == 0) { st[0] = 0u; st[1] = 0u; }
    __syncthreads();
    phase0(p, smem);
    cg::this_grid().sync();
    XcdBarrier b = xcd_barrier_post(p, (unsigned*)(p.ws + OFF_BAR), st);
    if (ltid() == 0) {
      const unsigned hwid = (unsigned)__builtin_amdgcn_s_getreg((31 << 11) | 4);
      const unsigned key = (xb_xcc_id() << 8) | ((hwid >> 8) & 0xFFu);
      ((int*)smem)[(LDS_BYTES - 12) / 4] = (int)xb_add((unsigned*)(p.ws + OFF_ROLE) + key, 1u);
    }
    __syncthreads();
    p.role = __builtin_amdgcn_readfirstlane(((int*)smem)[(LDS_BYTES - 12) / 4]);
    for (int ph = 1; ph < hi; ++ph) {
      run_phase(p, ph, smem);
      if (ph + 1 < hi) xcd_barrier(p, b);
    }
  } else {
    for (int ph = lo; ph < hi; ++ph) run_phase(p, ph, smem);
  }
}

extern "C" void kernel_launch(void* const* d_in, const int* in_sizes, int n_in, void* d_out, int out_size, void* d_ws, size_t ws_size, hipStream_t stream) {
  Params p{};
  for (int i = 0; i < N_IN; ++i) p.in[i] = (const float*)d_in[i];
  p.out = (float*)d_out; p.ws = (char*)d_ws;
  if (ws_size < WS_NEED) fprintf(stderr, "workspace too small: %zu < %zu\n", ws_size, (size_t)WS_NEED);
  static int grid_blocks = 0;
  if (!grid_blocks) {
    int dev = 0, cus = 0, per_cu = 0;
    hipGetDevice(&dev);
    hipDeviceGetAttribute(&cus, hipDeviceAttributeMultiprocessorCount, dev);
    hipOccupancyMaxActiveBlocksPerMultiprocessor(&per_cu, mega<true>, NTHR, 0);
    if (per_cu > 2) per_cu = 2;
    grid_blocks = cus * per_cu;
  }
  int lo = 0, hi = NPHASE;
  void* args[] = {&p, &lo, &hi};
  hipError_t e = hipLaunchCooperativeKernel((void*)mega<true>, dim3(grid_blocks), dim3(NTHR), args, 0, stream);
  if (e != hipSuccess) fprintf(stderr, "cooperative launch failed: %s (grid %d)\n", hipGetErrorString(e), grid_blocks);
}
```

```cpp
#include <hip/hip_runtime.h>
#include <hip/hip_cooperative_groups.h>
#include <cstdio>
namespace cg = cooperative_groups;

typedef unsigned short bf16_t;
typedef short bf16x8 __attribute__((ext_vector_type(8)));
typedef float f32x4 __attribute__((ext_vector_type(4)));
typedef float f32x2 __attribute__((ext_vector_type(2)));
typedef float f32x16 __attribute__((ext_vector_type(16)));
typedef unsigned short u16x4 __attribute__((ext_vector_type(4)));
typedef unsigned short u16x2 __attribute__((ext_vector_type(2)));
typedef unsigned u32x4 __attribute__((ext_vector_type(4)));
typedef unsigned u32x2 __attribute__((ext_vector_type(2)));
static __device__ __forceinline__ unsigned pk2(float lo, float hi) { typedef __bf16 b2 __attribute__((ext_vector_type(2))); typedef float f2 __attribute__((ext_vector_type(2))); return __builtin_bit_cast(unsigned, __builtin_convertvector((f2){lo, hi}, b2)); }

#define DI __device__ __forceinline__
#define GAS __attribute__((address_space(1)))
template <class T> static __device__ __forceinline__ T* as_global(T* q) { return (T*)(GAS T*)(unsigned long long)q; }

constexpr int NT = 16384;
constexpr int DM = 1024;
constexpr int NTHR = 256;
constexpr int DIN = 9616;
constexpr int ZHW = 2560, ZRW = 1920, ZMW = 2048;
constexpr int WTIN_ROWS = 9728;
constexpr int DFF = 2816;

constexpr size_t OFF_WTIN = 0;
constexpr size_t OFF_WTBR = OFF_WTIN + (size_t)WTIN_ROWS * 1024 * 2;
constexpr size_t OFF_H    = OFF_WTBR + (size_t)3 * 1024 * 512 * 2;
constexpr size_t OFF_ZH   = OFF_H + (size_t)NT * 1024 * 2;
constexpr size_t OFF_ZR   = OFF_ZH + (size_t)NT * ZHW * 2;
constexpr size_t OFF_ZM   = OFF_ZR + (size_t)NT * ZRW * 2;
constexpr size_t OFF_MG   = OFF_ZM + (size_t)NT * ZMW * 2;
constexpr size_t OFF_O    = OFF_MG + (size_t)NT * 16 * 4;
constexpr size_t OFF_MOD  = OFF_O + (size_t)NT * 1024 * 2;
constexpr size_t OFF_LBS  = OFF_MOD + (size_t)2 * 5 * 6144 * 4;
constexpr size_t OFF_CTR  = OFF_LBS + 2 * 512 * 4;
constexpr size_t OFF_BAR  = OFF_CTR + 256;
constexpr size_t OFF_ROLE = OFF_BAR + 3456 * 4;
constexpr size_t WS_NEED  = OFF_ROLE + 4096 * 4;
constexpr size_t OFF_MODP = OFF_ZH;
constexpr size_t OFF_WTOUT = OFF_ZR;
constexpr size_t OFF_WTFI  = OFF_WTOUT + (size_t)1024 * 1024 * 2;
constexpr size_t OFF_WTFO  = OFF_WTFI + (size_t)5632 * 1024 * 2;
constexpr size_t OFF_MERGED = OFF_WTFO + (size_t)1024 * 2816 * 2;
constexpr size_t OFF_Y    = OFF_ZH;
constexpr size_t OFF_ACT  = OFF_ZM;

constexpr size_t OUT_HG = 16777216, OUT_RW = 25165824, OUT_C = 29360128, OUT_N = 37748736, OUT_M = 37814272;

enum { I_XP = 0, I_XS, I_SH, I_SR, I_SC, I_SN, I_SM, I_C, I_CCTX, I_WADA, I_BADA, I_NORMS, I_WIN, I_HLB, I_HNORM, I_MU, I_W0, I_W2,
       I_A0, I_A2, I_G2, I_KK, I_KA, I_RK, I_LN, I_GB, I_MNORM, I_WBR, I_WOUT, I_WFI, I_WFO, N_IN };

struct Params { const float* in[N_IN]; float* out; char* ws; int wb; int role; };

constexpr int LDS_BYTES = 77824;

DI bf16_t f2bf(float f) { return __builtin_bit_cast(unsigned short, (__bf16)f); }
DI float bf2f(bf16_t h) { return __uint_as_float(((unsigned)h) << 16); }
DI float sigmoidf_(float x) { return 1.0f / (1.0f + __expf(-x)); }
DI float siluf_(float x) { return x / (1.0f + __expf(-x)); }
DI float softplusf_(float x) { return x > 20.f ? x : __logf(1.0f + __expf(x)); }
DI float dpp_xor1(float x) { return __int_as_float(__builtin_amdgcn_mov_dpp(__float_as_int(x), 0xB1, 0xF, 0xF, true)); }
DI float dpp_xor2(float x) { return __int_as_float(__builtin_amdgcn_mov_dpp(__float_as_int(x), 0x4E, 0xF, 0xF, true)); }
DI float shfl_lane(float v, int src) { return __int_as_float(__builtin_amdgcn_ds_bpermute(src << 2, __float_as_int(v))); }
#define SHX(v, m) shfl_lane((v), lane ^ (m))
DI float wave_sum(float v, int lane) { v += dpp_xor1(v); v += dpp_xor2(v); v += SHX(v, 4); v += SHX(v, 8); v += SHX(v, 16); v += SHX(v, 32); return v; }
DI int ltid_(int wb) { int t = wb + (int)__builtin_amdgcn_mbcnt_hi(~0u, __builtin_amdgcn_mbcnt_lo(~0u, 0u)); asm volatile("" : "+v"(t)); return t; }
#define ltid() ltid_(p.wb)
DI int crow(int reg, int h) { return (reg & 3) + 8 * (reg >> 2) + 4 * h; }

DI int tok_cond(int tok) { return tok < 8192 ? 0 : 1 + ((tok - 8192) >> 11); }
DI const float* x_in_row(const Params& p, int tok) { return tok < 8192 ? p.in[I_XP] + (size_t)tok * DM : p.in[I_XS] + (size_t)(tok - 8192) * DM; }

DI void mma32(f32x16& acc, const bf16_t* A, int lda, const bf16_t* B, int ldb, int K, int lane) {
  const int r = lane & 31, h = lane >> 5;
#pragma unroll 2
  for (int kk = 0; kk < K; kk += 16) {
    bf16x8 a = *(const bf16x8*)(A + r * lda + kk + 8 * h);
    bf16x8 b = *(const bf16x8*)(B + r * ldb + kk + 8 * h);
    acc = __builtin_amdgcn_mfma_f32_32x32x16_bf16(a, b, acc, 0, 0, 0);
  }
}

template <int BM, int BN, int BK>
DI void gemm_main(const Params& p, f32x4 (&acc)[BM / 32][BN / 32], const bf16_t* __restrict__ A, int lda, const bf16_t* __restrict__ B, int ldb, int K, bf16_t* sm) {
  constexpr int MI = BM / 32, NJ = BN / 32, LS = BK + 8, CPR = BK / 8, ACH = BM * BK / 2048, BCH = BN * BK / 2048, KS = BK / 32, RPI = 256 / CPR;
  const int tid = ltid(), lane = tid & 63, w = tid >> 6, wm = w >> 1, wn = w & 1;
  bf16_t* As = sm; bf16_t* Bs = sm + 2 * BM * LS;
  bf16x8 ra[ACH], rb[BCH];
  const int nk = K / BK;
  const int lrow = tid / CPR, lkc = (tid % CPR) * 8;
#pragma unroll
  for (int i = 0; i < ACH; ++i) ra[i] = *(const bf16x8*)(A + (size_t)(lrow + RPI * i) * lda + lkc);
#pragma unroll
  for (int i = 0; i < BCH; ++i) rb[i] = *(const bf16x8*)(B + (size_t)(lrow + RPI * i) * ldb + lkc);
  __syncthreads();
#pragma unroll
  for (int i = 0; i < ACH; ++i) *(bf16x8*)(As + (lrow + RPI * i) * LS + lkc) = ra[i];
#pragma unroll
  for (int i = 0; i < BCH; ++i) *(bf16x8*)(Bs + (lrow + RPI * i) * LS + lkc) = rb[i];
  __syncthreads();
  for (int kt = 0; kt < nk; ++kt) {
    const int buf = kt & 1;
    if (kt + 1 < nk) {
      const int k0 = (kt + 1) * BK + lkc;
#pragma unroll
      for (int i = 0; i < ACH; ++i) ra[i] = *(const bf16x8*)(A + (size_t)(lrow + RPI * i) * lda + k0);
#pragma unroll
      for (int i = 0; i < BCH; ++i) rb[i] = *(const bf16x8*)(B + (size_t)(lrow + RPI * i) * ldb + k0);
    }
    const bf16_t* as = As + buf * BM * LS + (wm * (BM / 2) + (lane & 15)) * LS + (lane >> 4) * 8;
    const bf16_t* bs = Bs + buf * BN * LS + (wn * (BN / 2) + (lane & 15)) * LS + (lane >> 4) * 8;
#pragma unroll
    for (int ks = 0; ks < KS; ++ks) {
      bf16x8 bfr[NJ];
#pragma unroll
      for (int j = 0; j < NJ; ++j) bfr[j] = *(const bf16x8*)(bs + j * 16 * LS + ks * 32);
      __builtin_amdgcn_s_setprio(1);
#pragma unroll
      for (int i = 0; i < MI; ++i) {
        const bf16x8 af = *(const bf16x8*)(as + i * 16 * LS + ks * 32);
#pragma unroll
        for (int j = 0; j < NJ; ++j) acc[i][j] = __builtin_amdgcn_mfma_f32_16x16x32_bf16(bfr[j], af, acc[i][j], 0, 0, 0);
      }
      __builtin_amdgcn_s_setprio(0);
    }
    if (kt + 1 < nk) {
      const int nb = buf ^ 1;
#pragma unroll
      for (int i = 0; i < ACH; ++i) *(bf16x8*)(As + nb * BM * LS + (lrow + RPI * i) * LS + lkc) = ra[i];
#pragma unroll
      for (int i = 0; i < BCH; ++i) *(bf16x8*)(Bs + nb * BN * LS + (lrow + RPI * i) * LS + lkc) = rb[i];
    }
    __syncthreads();
  }
}

template <int MI, int NJ> DI void zero_acc(f32x4 (&acc)[MI][NJ]) {
#pragma unroll
  for (int i = 0; i < MI; ++i)
#pragma unroll
    for (int j = 0; j < NJ; ++j) acc[i][j] = (f32x4){0.f, 0.f, 0.f, 0.f};
}
DI void store_bf4(bf16_t* dst, f32x4 v) { u16x4 o; o[0] = f2bf(v[0]); o[1] = f2bf(v[1]); o[2] = f2bf(v[2]); o[3] = f2bf(v[3]); *(u16x4*)dst = o; }

DI int map_col(int mode, int n) {
  if (mode == 0) return n < 6544 ? n : (n < 6656 ? -1 : n - 112);
  if (mode == 2) return ((n >> 4) & 1) ? DFF + (n >> 5) * 16 + (n & 15) : (n >> 5) * 16 + (n & 15);
  return n;
}
DI void conv_tile(const Params& p, const float* __restrict__ src, int ld_src, bf16_t* __restrict__ dst, int K, int mode, int tk, int tn, float* sm) {
  const int tid = ltid();
  __syncthreads();
  {
    const int nn = tid & 63, col = map_col(mode, tn * 64 + nn);
#pragma unroll
    for (int i = 0; i < 16; ++i) { int kk = (tid >> 6) + 4 * i; sm[kk * 65 + nn] = col >= 0 ? src[(size_t)(tk * 64 + kk) * ld_src + col] : 0.f; }
  }
  __syncthreads();
  {
    const int kk = tid & 63;
#pragma unroll
    for (int i = 0; i < 16; ++i) { int nn = (tid >> 6) + 4 * i; dst[(size_t)(tn * 64 + nn) * K + tk * 64 + kk] = f2bf(sm[kk * 65 + nn]); }
  }
}
DI void conv_weight(const Params& p, const float* src, int ld_src, bf16_t* dst, int K, int Ndst, int mode, float* sm, int bid, int nb) {
  const int tkn = K / 64, nt = tkn * (Ndst / 64);
  for (int t = bid; t < nt; t += nb) conv_tile(p, src, ld_src, dst, K, mode, t % tkn, t / tkn, sm);
}

DI void phase0(const Params& p, char* smem) {
  const int tid = ltid(), bid = blockIdx.x, nb = gridDim.x;
  float* MODP = (float*)(p.ws + OFF_MODP);
  float* sm = (float*)smem;
  if (bid == 0) { if (tid < 64) ((int*)(p.ws + OFF_CTR))[tid] = 0; for (int i = tid; i < 3456; i += NTHR) ((unsigned*)(p.ws + OFF_BAR))[i] = 0u; for (int i = tid; i < 4096; i += NTHR) ((unsigned*)(p.ws + OFF_ROLE))[i] = 0u; }
  for (int i = bid * NTHR + tid; i < 512; i += nb * NTHR) {
    float a = p.in[I_HLB][i], b = p.in[I_HLB][512 + i];
    float* L = (float*)(p.ws + OFF_LBS); L[i] = 0.f; L[512 + i] = 1.0f / (1.0f + expf(a - b));
  }
  for (int it = bid; it < 2 * 24 * 16; it += nb) {
    const int ks = it & 15, jb = (it >> 4) % 24, l = it / (16 * 24);
    __syncthreads();
    for (int e = tid; e < 5 * 64; e += NTHR) { int ci = e >> 6, k = ks * 64 + (e & 63); float cv = ci == 0 ? p.in[I_CCTX][k] : p.in[I_C][(ci - 1) * DM + k]; sm[e] = siluf_(cv); }
    __syncthreads();
    const int j = jb * 256 + tid;
    float a0 = 0, a1 = 0, a2 = 0, a3 = 0, a4 = 0;
    const float* W = p.in[I_WADA] + ((size_t)l * DM + ks * 64) * 6144 + j;
#pragma unroll 1
    for (int k0 = 0; k0 < 64; k0 += 16) {
      float wv[16];
#pragma unroll
      for (int u = 0; u < 16; ++u) wv[u] = W[(size_t)(k0 + u) * 6144];
#pragma unroll
      for (int u = 0; u < 16; ++u) { const int k = k0 + u; const float w = wv[u]; a0 += sm[k] * w; a1 += sm[64 + k] * w; a2 += sm[128 + k] * w; a3 += sm[192 + k] * w; a4 += sm[256 + k] * w; }
    }
    float* dst = MODP + ((size_t)(ks * 2 + l) * 5) * 6144 + j;
    dst[0] = a0; dst[6144] = a1; dst[2 * 6144] = a2; dst[3 * 6144] = a3; dst[4 * 6144] = a4;
  }
  conv_weight(p, p.in[I_WIN], DIN, (bf16_t*)(p.ws + OFF_WTIN), 1024, WTIN_ROWS, 0, sm, bid, nb);
  for (int br = 0; br < 3; ++br) conv_weight(p, p.in[I_WBR] + (size_t)br * 512 * 1024, 1024, (bf16_t*)(p.ws + OFF_WTBR) + (size_t)br * 1024 * 512, 512, 1024, 1, sm, bid, nb);
}
DI void phase1(const Params& p) {
  const float* MODP = (const float*)(p.ws + OFF_MODP);
  float* MOD = (float*)(p.ws + OFF_MOD);
  for (int i = blockIdx.x * NTHR + ltid(); i < 2 * 5 * 6144; i += gridDim.x * NTHR) {
    const int j = i % 6144, l = i / (5 * 6144);
    float s = p.in[I_BADA][l * 6144 + j];
    for (int ks = 0; ks < 16; ++ks) s += MODP[(size_t)ks * 2 * 5 * 6144 + i];
    MOD[i] = s;
  }
}

DI void norm_mod_store(const f32x4 (&x)[4], const float* nw, const float* sc, const float* sh, bf16_t* hrow, int lane) {
  float ss = 0.f;
#pragma unroll
  for (int i = 0; i < 4; ++i) ss += x[i][0] * x[i][0] + x[i][1] * x[i][1] + x[i][2] * x[i][2] + x[i][3] * x[i][3];
  ss = wave_sum(ss, lane);
  const float rs = rsqrtf(ss * (1.0f / DM) + 1e-6f);
#pragma unroll
  for (int i = 0; i < 4; ++i) {
    const int c = i * 256 + lane * 4;
    f32x4 w = *(const f32x4*)(nw + c), s1 = *(const f32x4*)(sc + c), s0 = *(const f32x4*)(sh + c), o;
#pragma unroll
    for (int e = 0; e < 4; ++e) o[e] = x[i][e] * rs * w[e] * (1.0f + s1[e]) + s0[e];
    store_bf4(hrow + c, o);
  }
}
DI void tok_one(const Params& p, int l, int mode, int tok, int lane) {
  const float* MOD = (const float*)(p.ws + OFF_MOD);
  bf16_t* H = (bf16_t*)(p.ws + OFF_H);
  const float* Y = (const float*)(p.ws + OFF_Y);
  const int ci = tok_cond(tok);
  const float* modl = MOD + (size_t)(l * 5 + ci) * 6144;
  const float* nwl = p.in[I_NORMS] + (size_t)l * 4 * DM;
  const bool from_in = (l == 0 && (mode == 0 || mode == 1 || mode == 3));
  const float* xr = from_in ? x_in_row(p, tok) : p.out + (size_t)tok * DM;
  f32x4 x[4];
#pragma unroll
  for (int i = 0; i < 4; ++i) x[i] = *(const f32x4*)(xr + i * 256 + lane * 4);
  if (mode == 1 || mode == 2) {
    f32x4 y[4]; float ss = 0.f;
#pragma unroll
    for (int i = 0; i < 4; ++i) { y[i] = *(const f32x4*)(Y + (size_t)tok * DM + i * 256 + lane * 4); ss += y[i][0] * y[i][0] + y[i][1] * y[i][1] + y[i][2] * y[i][2] + y[i][3] * y[i][3]; }
    ss = wave_sum(ss, lane);
    const float rs = rsqrtf(ss * (1.0f / DM) + 1e-6f);
    const float* nw = nwl + (mode == 1 ? 1 : 3) * DM;
    const float* g = modl + (mode == 1 ? 2 : 5) * DM;
#pragma unroll
    for (int i = 0; i < 4; ++i) {
      const int c = i * 256 + lane * 4;
      f32x4 w = *(const f32x4*)(nw + c), gg = *(const f32x4*)(g + c);
#pragma unroll
      for (int e = 0; e < 4; ++e) x[i][e] += gg[e] * (y[i][e] * rs * w[e]);
      *(f32x4*)(p.out + (size_t)tok * DM + c) = x[i];
    }
  }
  if (mode == 0 || mode == 3) norm_mod_store(x, nwl, modl + 1 * DM, modl + 0 * DM, H + (size_t)tok * DM, lane);
  else if (mode == 1) norm_mod_store(x, nwl + 2 * DM, modl + 4 * DM, modl + 3 * DM, H + (size_t)tok * DM, lane);
  else if (mode == 2 && l + 1 < 2) {
    const float* modn = MOD + (size_t)((l + 1) * 5 + ci) * 6144;
    norm_mod_store(x, p.in[I_NORMS] + (size_t)(l + 1) * 4 * DM, modn + 1 * DM, modn + 0 * DM, H + (size_t)tok * DM, lane);
  }
}
DI void tok_phase(const Params& p, int l, int mode) {
  const int lane = ltid() & 63, gw = blockIdx.x * 4 + (ltid() >> 6), nw = gridDim.x * 4;
  for (int tok = gw; tok < NT; tok += nw) tok_one(p, l, mode, tok, lane);
}

DI bool tile_xcd(int i, int NTN, int MTX, int& mt, int& nt) {
  const int G = gridDim.x, b = blockIdx.x, x = b & 7, j = b >> 3, nbx = (G - x + 7) >> 3;
  const int u = j + i * nbx;
  if (u >= MTX * NTN) return false;
  mt = MTX * x + (u % MTX); nt = u / MTX;
  return true;
}
DI void phase_inproj(const Params& p, char* smem) {
  const bf16_t* H = (const bf16_t*)(p.ws + OFF_H);
  const bf16_t* WT = (const bf16_t*)(p.ws + OFF_WTIN);
  bf16_t* ZH = (bf16_t*)(p.ws + OFF_ZH); bf16_t* ZR = (bf16_t*)(p.ws + OFF_ZR); bf16_t* ZM = (bf16_t*)(p.ws + OFF_ZM);
  float* MG = (float*)(p.ws + OFF_MG);
  const int lane = ltid() & 63, w = ltid() >> 6, wm = w >> 1, wn = w & 1;
  int mt, nt;
  for (int ti = 0; tile_xcd(ti, 52, 8, mt, nt); ++ti) {
    f32x4 acc[8][4]; zero_acc<8, 4>(acc);
    gemm_main<256, 128, 32>(p, acc, H + (size_t)mt * 256 * 1024, 1024, WT + (size_t)nt * 128 * 1024, 1024, 1024, (bf16_t*)smem);
    const int n0 = nt * 128;
#pragma unroll
    for (int i = 0; i < 8; ++i) {
      const int row = mt * 256 + wm * 128 + i * 16 + (lane & 15);
#pragma unroll
      for (int j = 0; j < 4; ++j) {
        const int col = n0 + wn * 64 + j * 16 + 4 * (lane >> 4);
        if (n0 < 2560) store_bf4(ZH + (size_t)row * ZHW + col, acc[i][j]);
        else if (n0 < 4480) store_bf4(ZR + (size_t)row * ZRW + (col - 2560), acc[i][j]);
        else if (n0 < 6528) store_bf4(ZM + (size_t)row * ZMW + (col - 4480), acc[i][j]);
        else if (col - 6528 < 16) *(f32x4*)(MG + (size_t)row * 16 + (col - 6528)) = acc[i][j];
      }
    }
  }
}

DI void phase_merge(const Params& p, int l, char* smem) {
  const bf16_t* H = (const bf16_t*)(p.ws + OFF_H);
  const bf16_t* WT = (const bf16_t*)(p.ws + OFF_WTIN);
  const bf16_t* WBR = (const bf16_t*)(p.ws + OFF_WTBR);
  const bf16_t* ZH = (const bf16_t*)(p.ws + OFF_ZH); const bf16_t* ZM = (const bf16_t*)(p.ws + OFF_ZM); const bf16_t* O = (const bf16_t*)(p.ws + OFF_O);
  bf16_t* MER = (bf16_t*)(p.ws + OFF_MERGED);
  const int lane = ltid() & 63, w = ltid() >> 6, wm = w >> 1, wn = w & 1;
  int mt, nt;
  for (int ti = 0; tile_xcd(ti, 16, 16, mt, nt); ++ti) {
    f32x4 accM[4][2]; zero_acc<4, 2>(accM);
#pragma unroll 1
    for (int br = 0; br < 3; ++br) {
      f32x4 accG[4][2], accP[4][2]; zero_acc<4, 2>(accG); zero_acc<4, 2>(accP);
      gemm_main<128, 64, 64>(p, accG, H + (size_t)mt * 128 * 1024, 1024, WT + (size_t)(6656 + br * 1024 + nt * 64) * 1024, 1024, 1024, (bf16_t*)smem);
      const bf16_t* Ab; int lda;
      if (br == 0) { Ab = ZH + 2048; lda = ZHW; } else if (br == 1) { Ab = O; lda = 1024; } else { Ab = ZM + 1536; lda = ZMW; }
      gemm_main<128, 64, 64>(p, accP, Ab + (size_t)mt * 128 * lda, lda, WBR + ((size_t)br * 1024 + nt * 64) * 512, 512, 512, (bf16_t*)smem);
#pragma unroll
      for (int i = 0; i < 4; ++i)
#pragma unroll
        for (int j = 0; j < 2; ++j)
#pragma unroll
          for (int e = 0; e < 4; ++e) accM[i][j][e] += sigmoidf_(accG[i][j][e]) * accP[i][j][e];
    }
#pragma unroll
    for (int i = 0; i < 4; ++i) {
      const int row = mt * 128 + wm * 64 + i * 16 + (lane & 15);
#pragma unroll
      for (int j = 0; j < 2; ++j) store_bf4(MER + (size_t)row * 1024 + nt * 64 + wn * 32 + j * 16 + 4 * (lane >> 4), accM[i][j]);
    }
  }
  float* sm = (float*)smem;
  conv_weight(p, p.in[I_WOUT] + (size_t)l * 1024 * 1024, 1024, (bf16_t*)(p.ws + OFF_WTOUT), 1024, 1024, 1, sm, blockIdx.x, gridDim.x);
  conv_weight(p, p.in[I_WFI] + (size_t)l * 1024 * 5632, 5632, (bf16_t*)(p.ws + OFF_WTFI), 1024, 5632, 2, sm, blockIdx.x, gridDim.x);
  conv_weight(p, p.in[I_WFO] + (size_t)l * DFF * 1024, 1024, (bf16_t*)(p.ws + OFF_WTFO), DFF, 1024, 1, sm, blockIdx.x, gridDim.x);
}

DI void phase_gemm_f32(const Params& p, const bf16_t* A, int K, const bf16_t* Wt, char* smem) {
  float* Y = (float*)(p.ws + OFF_Y);
  const int lane = ltid() & 63, w = ltid() >> 6, wm = w >> 1, wn = w & 1;
  int mt, nt;
  for (int ti = 0; tile_xcd(ti, 8, 8, mt, nt); ++ti) {
    f32x4 acc[8][4]; zero_acc<8, 4>(acc);
    gemm_main<256, 128, 32>(p, acc, A + (size_t)mt * 256 * K, K, Wt + (size_t)nt * 128 * K, K, K, (bf16_t*)smem);
#pragma unroll
    for (int i = 0; i < 8; ++i) {
      const int row = mt * 256 + wm * 128 + i * 16 + (lane & 15);
#pragma unroll
      for (int j = 0; j < 4; ++j) *(f32x4*)(Y + (size_t)row * 1024 + nt * 128 + wn * 64 + j * 16 + 4 * (lane >> 4)) = acc[i][j];
    }
  }
}
DI void phase_ffn_in(const Params& p, char* smem) {
  const bf16_t* H = (const bf16_t*)(p.ws + OFF_H);
  const bf16_t* Wt = (const bf16_t*)(p.ws + OFF_WTFI);
  bf16_t* ACT = (bf16_t*)(p.ws + OFF_ACT);
  const int lane = ltid() & 63, w = ltid() >> 6, wm = w >> 1, wn = w & 1;
  int mt, nt;
  for (int ti = 0; tile_xcd(ti, 44, 8, mt, nt); ++ti) {
    f32x4 acc[8][4]; zero_acc<8, 4>(acc);
    gemm_main<256, 128, 32>(p, acc, H + (size_t)mt * 256 * 1024, 1024, Wt + (size_t)nt * 128 * 1024, 1024, 1024, (bf16_t*)smem);
#pragma unroll
    for (int i = 0; i < 8; ++i) {
      const int row = mt * 256 + wm * 128 + i * 16 + (lane & 15);
#pragma unroll
      for (int jj = 0; jj < 2; ++jj) {
        f32x4 u = acc[i][2 * jj], g = acc[i][2 * jj + 1], o;
#pragma unroll
        for (int e = 0; e < 4; ++e) o[e] = siluf_(g[e]) * u[e];
        const int col = (nt * 128 + wn * 64 + jj * 32) / 2 + 4 * (lane >> 4);
        store_bf4(ACT + (size_t)row * DFF + col, o);
      }
    }
  }
}

struct Seq { int base, T, grid, b; bool sample; };
DI Seq get_seq(int s) { Seq q; if (s < 32) { q.base = s * 256; q.T = 256; q.grid = 0; q.b = s; q.sample = false; } else { q.b = s - 32; q.base = 8192 + q.b * 2048; q.T = 2048; q.grid = 1; q.sample = true; } return q; }

DI float rw_shift(const bf16_t* ZR, const float* mu, int base, int t, int T, int grid, int col) {
  const bf16_t* pp = ZR + (size_t)(base + t) * ZRW + col;
  const float y = bf2f(*pp);
  if (!grid) {
    const float prev = t > 0 ? bf2f(pp[-ZRW]) : 0.f, nxt = t < T - 1 ? bf2f(pp[ZRW]) : 0.f;
    return y + mu[col] * (prev - y) + mu[ZRW + col] * (nxt - y);
  }
  const int gc = t & 63, gr = t >> 6;
  const float left = gc > 0 ? bf2f(pp[-ZRW]) : 0.f, right = gc < 63 ? bf2f(pp[ZRW]) : 0.f;
  const float up = gr > 0 ? bf2f(pp[-64 * ZRW]) : 0.f, down = gr < 31 ? bf2f(pp[64 * ZRW]) : 0.f;
  return y + mu[col] * (left - y) + mu[ZRW + col] * (right - y) + mu[2 * ZRW + col] * (up - y) + mu[3 * ZRW + col] * (down - y);
}

DI void rw_shift8(const bf16_t* ZR, const float* mu, int base, int t, int T, int grid, int col0, float (&out)[8]) {
  const bf16_t* pp = ZR + (size_t)(base + t) * ZRW + col0;
  const bf16x8 y = *(const bf16x8*)pp;
  float yv[8];
#pragma unroll
  for (int e = 0; e < 8; ++e) { yv[e] = bf2f((bf16_t)y[e]); out[e] = yv[e]; }
  const int nn = grid ? 4 : 2;
#pragma unroll 1
  for (int n = 0; n < nn; ++n) {
    bool valid; int off;
    if (!grid) { valid = n == 0 ? t > 0 : t < T - 1; off = n == 0 ? -ZRW : ZRW; }
    else { const int gc = t & 63, gr = t >> 6; valid = n == 0 ? gc > 0 : n == 1 ? gc < 63 : n == 2 ? gr > 0 : gr < 31; off = n == 0 ? -ZRW : n == 1 ? ZRW : n == 2 ? -64 * ZRW : 64 * ZRW; }
    const f32x4 m0 = *(const f32x4*)(mu + n * ZRW + col0), m1 = *(const f32x4*)(mu + n * ZRW + col0 + 4);
    bf16x8 nb = y;
    if (valid) nb = *(const bf16x8*)(pp + off);
#pragma unroll
    for (int e = 0; e < 8; ++e) { const float nv_ = valid ? bf2f((bf16_t)nb[e]) : 0.f; const float mm = e < 4 ? m0[e & 3] : m1[e & 3]; out[e] += mm * (nv_ - yv[e]); }
  }
}

DI void rw_load8(const bf16_t* ZR, int base, int t, int T, int grid, int col0, bf16x8 (&v)[5]) {
  const bf16_t* pp = ZR + (size_t)(base + t) * ZRW + col0;
  const bf16x8 z = (bf16x8){0, 0, 0, 0, 0, 0, 0, 0};
  v[0] = *(const bf16x8*)pp;
  if (!grid) {
    v[1] = t > 0 ? *(const bf16x8*)(pp - ZRW) : z; v[2] = t < T - 1 ? *(const bf16x8*)(pp + ZRW) : z; v[3] = z; v[4] = z;
  } else {
    const int gc = t & 63, gr = t >> 6;
    v[1] = gc > 0 ? *(const bf16x8*)(pp - ZRW) : z; v[2] = gc < 63 ? *(const bf16x8*)(pp + ZRW) : z;
    v[3] = gr > 0 ? *(const bf16x8*)(pp - 64 * ZRW) : z; v[4] = gr < 31 ? *(const bf16x8*)(pp + 64 * ZRW) : z;
  }
}
DI void rw_apply8(const bf16x8 (&v)[5], const float* mu, int grid, int col0, float (&out)[8]) {
  float yv[8];
#pragma unroll
  for (int e = 0; e < 8; ++e) { yv[e] = bf2f((bf16_t)v[0][e]); out[e] = yv[e]; }
#pragma unroll
  for (int n = 0; n < 4; ++n) {
    if (n < 2 || grid) {
      const f32x4 m0 = *(const f32x4*)(mu + n * ZRW + col0), m1 = *(const f32x4*)(mu + n * ZRW + col0 + 4);
#pragma unroll
      for (int e = 0; e < 8; ++e) out[e] += (e < 4 ? m0[e & 3] : m1[e & 3]) * (bf2f((bf16_t)v[1 + n][e]) - yv[e]);
    }
  }
}

DI float dpp_ror8(float x) { return __int_as_float(__builtin_amdgcn_mov_dpp(__float_as_int(x), 0x128, 0xF, 0xF, true)); }
DI float dpp_ror4(float x) { return __int_as_float(__builtin_amdgcn_mov_dpp(__float_as_int(x), 0x124, 0xF, 0xF, true)); }
DI float dpp_hmirror(float x) { return __int_as_float(__builtin_amdgcn_mov_dpp(__float_as_int(x), 0x141, 0xF, 0xF, true)); }
DI float fast_tanh(float x) { return 1.0f - 2.0f / (1.0f + __expf(2.0f * x)); }

DI void rw_apply8_lds(const bf16x8 (&v)[5], const float* mu5c, int grid, float (&out)[8]) {
  float yv[8];
#pragma unroll
  for (int e = 0; e < 8; ++e) { yv[e] = bf2f((bf16_t)v[0][e]); out[e] = yv[e]; }
#pragma unroll
  for (int n = 0; n < 4; ++n) {
    if (n < 2 || grid) {
      const f32x4 m0 = *(const f32x4*)(mu5c + n * 320), m1 = *(const f32x4*)(mu5c + n * 320 + 4);
#pragma unroll
      for (int e = 0; e < 8; ++e) out[e] += (e < 4 ? m0[e & 3] : m1[e & 3]) * (bf2f((bf16_t)v[1 + n][e]) - yv[e]);
    }
  }
}
template <int N> DI float dpp_row_shr0(float x) { return __int_as_float(__builtin_amdgcn_update_dpp(0, __float_as_int(x), 0x110 + N, 0xF, 0xF, false)); }

DI void rwkv_item(const Params& p, int l, int s, int hh, int d, char* smem) {
  const Seq q = get_seq(s);
  const int tid0 = ltid();
  const int w = __builtin_amdgcn_readfirstlane(tid0 >> 6), vb = w >> 1, kb = w & 1;
  int tid = tid0, lane = tid & 63, l15 = lane & 15, qq = lane >> 4, r32 = lane & 31, h = lane >> 5;
  const bf16_t* ZR = (const bf16_t*)(p.ws + OFF_ZR);
  bf16_t* O = (bf16_t*)(p.ws + OFF_O);
  const float* mu = p.in[I_MU] + (size_t)l * 4 * ZRW;
  bf16_t* KHr = (bf16_t*)smem;
  bf16_t* BCr = KHr + 16 * 72;
  bf16_t* KC = BCr + 16 * 72;
  bf16_t* RH = KC + 16 * 72;
  bf16_t* Sb = RH + 16 * 72;
  bf16_t* Wb2 = (bf16_t*)smem;
  bf16_t* Ab2 = Wb2 + 64 * 72;
  float* mu5 = (float*)(smem + 18432);
  bf16_t* actW = (bf16_t*)(smem + 23552);
  bf16_t* actA = actW + 16 * 72;
  float* shR = (float*)(smem + 28160);
  float* shK = shR + 1024; float* shV = shK + 1024;
  bf16_t* VT = (bf16_t*)(smem + 40448);
  bf16_t* UNT = VT + 64 * 40;
  bf16_t* KBT = UNT + 64 * 40;
  bf16_t* BBT = KBT + 64 * 24;
  float* PL = (float*)(smem + 56832);
  float* npart = PL + 64;
  float* MN = (float*)(smem + 57344);
  float* G0 = (float*)(smem + 61440);
  bf16_t* ArkM = (bf16_t*)(smem + 65536);
  bf16_t* ArbM = ArkM + 16 * 40;
  __syncthreads();
  for (int e = tid; e < 4096; e += NTHR) {
    const int i = e >> 6, c = e & 63;
    Wb2[c * 72 + i] = f2bf(p.in[I_W2][((size_t)(l * 2 + d) * 64 + i) * 512 + 64 * hh + c]);
    Ab2[c * 72 + i] = f2bf(p.in[I_A2][((size_t)(l * 2 + d) * 64 + i) * 512 + 64 * hh + c]);
  }
  for (int e = tid; e < 1280; e += NTHR) {
    const int n = e / 320, rem = e % 320, arr = rem >> 6, c = rem & 63;
    const int col = arr == 0 ? 64 * hh + c : arr == 1 ? 512 + 64 * hh + c : arr == 2 ? 1024 + 64 * hh + c : arr == 3 ? 1536 + 64 * d + c : 1664 + 64 * d + c;
    mu5[e] = mu[n * ZRW + col];
  }
  const int cB0 = 16 * w + 4 * qq;
  float w0c[4], a0c[4], kkc[4], kac[4];
#pragma unroll
  for (int g = 0; g < 4; ++g) {
    w0c[g] = p.in[I_W0][(l * 2 + d) * 512 + 64 * hh + cB0 + g]; a0c[g] = p.in[I_A0][(l * 2 + d) * 512 + 64 * hh + cB0 + g];
    kkc[g] = p.in[I_KK][l * 512 + 64 * hh + cB0 + g]; kac[g] = p.in[I_KA][l * 512 + 64 * hh + cB0 + g];
  }
  f32x16 S;
  if (q.sample) {
    const float* st = p.in[I_SR] + ((((size_t)q.b * 2 + l) * 2 + d) * 8 + hh) * 4096;
#pragma unroll
    for (int g = 0; g < 16; ++g) S[g] = st[(32 * vb + crow(g, h)) * 64 + 32 * kb + r32];
  } else {
#pragma unroll
    for (int g = 0; g < 16; ++g) S[g] = 0.f;
  }
  __syncthreads();
  bf16x8 bW[2], bA[2];
#pragma unroll
  for (int ks = 0; ks < 2; ++ks) { bW[ks] = *(const bf16x8*)(Wb2 + (16 * w + l15) * 72 + ks * 32 + qq * 8); bA[ks] = *(const bf16x8*)(Ab2 + (16 * w + l15) * 72 + ks * 32 + qq * 8); }
  __syncthreads();
  for (int e = tid; e < (2 * 64 * 40 + 2 * 64 * 24) / 2; e += NTHR) ((unsigned*)VT)[e] = 0u;
  for (int e = tid; e < (2 * 16 * 40) / 2; e += NTHR) ((unsigned*)ArkM)[e] = 0u;
  const int nch = q.T / 16;
  bf16x8 pf[3][5];
#define RW_COL(arr, c8) ((arr) == 0 ? 64 * hh + (c8) : (arr) == 1 ? 512 + 64 * hh + (c8) : (arr) == 2 ? 1024 + 64 * hh + (c8) : (arr) == 3 ? 1536 + 64 * d + (c8) : 1664 + 64 * d + (c8))
#define RW_ISSUE(chn) { _Pragma("unroll") for (int gi = 0; gi < 3; ++gi) { const int g = tid + gi * NTHR; if (g < 640) { \
      const int arr = g >> 7, rem = g & 127, j = rem >> 3, c8 = (rem & 7) * 8; const int pos = (chn) * 16 + j, t = d ? q.T - 1 - pos : pos; \
      rw_load8(ZR, q.base, t, q.T, q.grid, RW_COL(arr, c8), pf[gi]); } } }
  RW_ISSUE(0)
#pragma unroll 1
  for (int ch = 0; ch < nch; ++ch) {
    tid = tid0; asm volatile("" : "+v"(tid));
    lane = tid & 63; l15 = lane & 15; qq = lane >> 4; r32 = lane & 31; h = lane >> 5;
    __syncthreads();
#pragma unroll
    for (int gi = 0; gi < 3; ++gi) {
      const int g = tid + gi * NTHR;
      if (g < 640) {
        const int arr = g >> 7, rem = g & 127, j = rem >> 3, c8 = (rem & 7) * 8;
        float val[8];
        rw_apply8_lds(pf[gi], mu5 + arr * 64 + c8, q.grid, val);
        if (arr < 3) {
          *(f32x4*)(shR + arr * 1024 + j * 64 + c8) = (f32x4){val[0], val[1], val[2], val[3]};
          *(f32x4*)(shR + arr * 1024 + j * 64 + c8 + 4) = (f32x4){val[4], val[5], val[6], val[7]};
          if (arr == 2) {
#pragma unroll
            for (int e = 0; e < 8; ++e) VT[(c8 + e) * 40 + j] = f2bf(val[e]);
          }
        } else {
          bf16x8 o8;
#pragma unroll
          for (int e = 0; e < 8; ++e) o8[e] = (short)f2bf(arr == 3 ? fast_tanh(val[e]) : val[e]);
          *(bf16x8*)((arr == 3 ? actW : actA) + j * 72 + c8) = o8;
        }
      }
    }
    if (ch + 1 < nch) RW_ISSUE(ch + 1)
    __syncthreads();
    {
      f32x4 aw = (f32x4){0.f, 0.f, 0.f, 0.f}, aa = (f32x4){0.f, 0.f, 0.f, 0.f};
#pragma unroll
      for (int ks = 0; ks < 2; ++ks) {
        const bf16x8 fw = *(const bf16x8*)(actW + l15 * 72 + ks * 32 + qq * 8);
        const bf16x8 fa = *(const bf16x8*)(actA + l15 * 72 + ks * 32 + qq * 8);
        aw = __builtin_amdgcn_mfma_f32_16x16x32_bf16(bW[ks], fw, aw, 0, 0, 0);
        aa = __builtin_amdgcn_mfma_f32_16x16x32_bf16(bA[ks], fa, aa, 0, 0, 0);
      }
      const f32x4 kv = *(const f32x4*)(shK + l15 * 64 + cB0), rv = *(const f32x4*)(shR + l15 * 64 + cB0);
      float lw[4], av[4], kkr[4], kd[4], Lp[4], LpL[4];
      float ssq = 0.f;
#pragma unroll
      for (int g = 0; g < 4; ++g) {
        const float wl = aw[g] + w0c[g], al = aa[g] + a0c[g];
        lw[g] = -__expf(-softplusf_(-wl) - 0.5f);
        av[g] = sigmoidf_(al);
        kkr[g] = kv[g] * kkc[g];
        kd[g] = kv[g] * (1.0f + (av[g] - 1.0f) * kac[g]);
        ssq += kkr[g] * kkr[g];
        float x = lw[g];
        x += dpp_row_shr0<1>(x); x += dpp_row_shr0<2>(x); x += dpp_row_shr0<4>(x); x += dpp_row_shr0<8>(x);
        Lp[g] = x;
      }
#pragma unroll
      for (int g = 0; g < 4; ++g) LpL[g] = shfl_lane(Lp[g], (lane & 48) | 15);
      ssq += SHX(ssq, 16); ssq += SHX(ssq, 32);
      if (qq == 0) npart[w * 16 + l15] = ssq;
      float e_m1[4], e_neg[4], e_pos[4], e_end[4];
#pragma unroll
      for (int g = 0; g < 4; ++g) { e_m1[g] = __expf(Lp[g] - lw[g]); e_neg[g] = __expf(-Lp[g]); e_pos[g] = __expf(Lp[g]); e_end[g] = __expf(LpL[g] - Lp[g]); }
      *(u32x2*)(KHr + l15 * 72 + cB0) = (u32x2){pk2(kkr[0] * e_m1[0], kkr[1] * e_m1[1]), pk2(kkr[2] * e_m1[2], kkr[3] * e_m1[3])};
      *(u32x2*)(BCr + l15 * 72 + cB0) = (u32x2){pk2(kkr[0] * av[0] * e_neg[0], kkr[1] * av[1] * e_neg[1]), pk2(kkr[2] * av[2] * e_neg[2], kkr[3] * av[3] * e_neg[3])};
      *(u32x2*)(KC + l15 * 72 + cB0) = (u32x2){pk2(kd[0] * e_neg[0], kd[1] * e_neg[1]), pk2(kd[2] * e_neg[2], kd[3] * e_neg[3])};
      *(u32x2*)(RH + l15 * 72 + cB0) = (u32x2){pk2(rv[0] * e_pos[0], rv[1] * e_pos[1]), pk2(rv[2] * e_pos[2], rv[3] * e_pos[3])};
#pragma unroll
      for (int g = 0; g < 4; ++g) {
        KBT[(cB0 + g) * 24 + l15] = f2bf(kd[g] * e_end[g]);
        BBT[(cB0 + g) * 24 + l15] = f2bf(kkr[g] * av[g] * e_end[g]);
      }
      if (l15 == 15) *(f32x4*)(PL + cB0) = (f32x4){e_pos[0], e_pos[1], e_pos[2], e_pos[3]};
#pragma unroll
      for (int g = 0; g < 16; ++g) Sb[(32 * vb + crow(g, h)) * 72 + 32 * kb + r32] = f2bf(S[g]);
    }
    __syncthreads();
    f32x4 oacc = (f32x4){0.f, 0.f, 0.f, 0.f};
    {
      const bf16_t* Aop = (w < 2) ? KHr : RH;
      const bf16_t* Bop = (w == 0 || w == 3) ? BCr : KC;
      f32x4 t16 = (f32x4){0.f, 0.f, 0.f, 0.f}, g0 = (f32x4){0.f, 0.f, 0.f, 0.f};
#pragma unroll
      for (int ks = 0; ks < 2; ++ks) {
        const bf16x8 a = *(const bf16x8*)(Aop + l15 * 72 + ks * 32 + qq * 8);
        const bf16x8 b = *(const bf16x8*)(Bop + l15 * 72 + ks * 32 + qq * 8);
        t16 = __builtin_amdgcn_mfma_f32_16x16x32_bf16(a, b, t16, 0, 0, 0);
        const bf16x8 akh = *(const bf16x8*)(KHr + l15 * 72 + ks * 32 + qq * 8);
        const bf16x8 arh = *(const bf16x8*)(RH + l15 * 72 + ks * 32 + qq * 8);
        const bf16x8 bs = *(const bf16x8*)(Sb + (16 * w + l15) * 72 + ks * 32 + qq * 8);
        g0 = __builtin_amdgcn_mfma_f32_16x16x32_bf16(akh, bs, g0, 0, 0, 0);
        oacc = __builtin_amdgcn_mfma_f32_16x16x32_bf16(arh, bs, oacc, 0, 0, 0);
      }
#pragma unroll
      for (int g = 0; g < 4; ++g) G0[(4 * qq + g) * 64 + 16 * w + l15] = g0[g];
      *(f32x4*)(MN + w * 256 + l15 * 16 + 4 * qq) = t16;
    }
    __syncthreads();
    if (w == 0) {
      const float* MrT = MN; const float* NrT = MN + 256;
      float acc[16];
#pragma unroll
      for (int t = 0; t < 16; ++t) acc[t] = G0[t * 64 + lane];
#pragma unroll
      for (int j = 0; j < 16; ++j) {
        const float n2 = 1.0f / fmaxf(npart[j] + npart[16 + j] + npart[32 + j] + npart[48 + j], 1e-24f);
        const float unj = -n2 * acc[j];
        UNT[lane * 40 + j] = f2bf(unj);
        const float vvj = shV[j * 64 + lane];
#pragma unroll
        for (int t4 = 0; t4 < 4; ++t4) {
          if (4 * t4 + 3 > j) {
            const f32x4 nr = *(const f32x4*)(NrT + j * 16 + 4 * t4), mr = *(const f32x4*)(MrT + j * 16 + 4 * t4);
#pragma unroll
            for (int e = 0; e < 4; ++e) if (4 * t4 + e > j) acc[4 * t4 + e] += nr[e] * vvj + mr[e] * unj;
          }
        }
        asm volatile("" ::: "memory");
      }
    } else if (w < 3) {
      const float* src = MN + (w == 1 ? 512 : 768);
      bf16_t* dst = (w == 1) ? ArkM : ArbM;
#pragma unroll
      for (int i = 0; i < 4; ++i) { const int e = lane + 64 * i, j = e >> 4, t = e & 15; dst[t * 40 + j] = f2bf(j <= t ? src[e] : 0.f); }
    }
    __syncthreads();
    {
      const bf16x8 ak = *(const bf16x8*)(ArkM + l15 * 40 + qq * 8), ab = *(const bf16x8*)(ArbM + l15 * 40 + qq * 8);
      const bf16x8 bv = *(const bf16x8*)(VT + (16 * w + l15) * 40 + qq * 8), bu = *(const bf16x8*)(UNT + (16 * w + l15) * 40 + qq * 8);
      oacc = __builtin_amdgcn_mfma_f32_16x16x32_bf16(ak, bv, oacc, 0, 0, 0);
      oacc = __builtin_amdgcn_mfma_f32_16x16x32_bf16(ab, bu, oacc, 0, 0, 0);
#pragma unroll
      for (int g = 0; g < 4; ++g) {
        const int pos = ch * 16 + 4 * qq + g, t = d ? q.T - 1 - pos : pos;
        O[(size_t)(q.base + t) * 1024 + d * 512 + 64 * hh + 16 * w + l15] = f2bf(oacc[g]);
      }
      const float pl = PL[32 * kb + r32];
#pragma unroll
      for (int g = 0; g < 16; ++g) S[g] *= pl;
      const bf16x8 av_ = *(const bf16x8*)(VT + (32 * vb + r32) * 40 + 8 * h), au_ = *(const bf16x8*)(UNT + (32 * vb + r32) * 40 + 8 * h);
      const bf16x8 bk_ = *(const bf16x8*)(KBT + (32 * kb + r32) * 24 + 8 * h), bb_ = *(const bf16x8*)(BBT + (32 * kb + r32) * 24 + 8 * h);
      S = __builtin_amdgcn_mfma_f32_32x32x16_bf16(av_, bk_, S, 0, 0, 0);
      S = __builtin_amdgcn_mfma_f32_32x32x16_bf16(au_, bb_, S, 0, 0, 0);
    }
  }
  if (!q.sample) {
    float* dst = p.out + OUT_RW + ((((size_t)q.b * 2 + l) * 2 + d) * 8 + hh) * 4096;
#pragma unroll
    for (int g = 0; g < 16; ++g) dst[(32 * vb + crow(g, h)) * 64 + 32 * kb + r32] = S[g];
  }
}

DI void hgrn_item(const Params& p, int l, int s, int hh, int d, char* smem) {
  const Seq q = get_seq(s);
  const int tid = ltid(), lane = tid & 63, w = tid >> 6, r = lane & 31, h = lane >> 5;
  bf16_t* ZH = (bf16_t*)(p.ws + OFF_ZH);
  bf16_t* Qt = (bf16_t*)smem;
  bf16_t* Kt = Qt + 32 * 136;
  bf16_t* KhT = Kt + 32 * 136;
  bf16_t* VT = KhT + 128 * 40;
  bf16_t* Sb = VT + 128 * 40;
  bf16_t* At = Sb + 4 * 32 * 136;
  float* dL = (float*)(At + 32 * 40);
  float* tot = dL + 128;
  const float lb = ((const float*)(p.ws + OFF_LBS))[l * 512 + 128 * hh + (tid & 127)];
  f32x16 S[4];
  if (q.sample) {
    const float* st = p.in[I_SH] + ((((size_t)q.b * 2 + l) * 2 + d) * 4 + hh) * 16384;
#pragma unroll
    for (int kb = 0; kb < 4; ++kb)
#pragma unroll
      for (int g = 0; g < 16; ++g) S[kb][g] = st[(size_t)(32 * kb + crow(g, h)) * 128 + 32 * w + r];
  } else {
#pragma unroll
    for (int kb = 0; kb < 4; ++kb)
#pragma unroll
      for (int g = 0; g < 16; ++g) S[kb][g] = 0.f;
  }
  const int k = tid & 127, half = tid >> 7;
  const int nch = q.T / 32;
  u16x2 pzq[16], pv2[8];
#define HG_ISSUE(chn) { _Pragma("unroll") for (int jj = 0; jj < 16; ++jj) { const int pos = (chn) * 32 + half * 16 + jj, t = d ? q.T - 1 - pos : pos; \
      const size_t rowo = (size_t)(q.base + t) * ZHW + 128 * hh + k; pzq[jj][0] = ZH[rowo + 512 * (1 + d)]; pzq[jj][1] = ZH[rowo]; pv2[jj >> 1][jj & 1] = ZH[rowo + 1536]; } }
  HG_ISSUE(0)
#pragma unroll 1
  for (int ch = 0; ch < nch; ++ch) {
    __syncthreads();
    float bl[16], kc[16], qs[16];
    {
      float b = 0.f;
#pragma unroll
      for (int jj = 0; jj < 16; ++jj) {
        const float z = bf2f(pzq[jj][0]);
        const float kcoef = (1.0f - lb) * sigmoidf_(-z);
        const float f = 1.0f - kcoef;
        b += fmaxf(__logf(f), -80.f);
        bl[jj] = b; kc[jj] = kcoef; qs[jj] = bf2f(pzq[jj][1]) * 0.08838834764831845f;
      }
      *(u32x4*)(VT + k * 40 + half * 16) = (u32x4){__builtin_bit_cast(unsigned, pv2[0]), __builtin_bit_cast(unsigned, pv2[1]), __builtin_bit_cast(unsigned, pv2[2]), __builtin_bit_cast(unsigned, pv2[3])};
      *(u32x4*)(VT + k * 40 + half * 16 + 8) = (u32x4){__builtin_bit_cast(unsigned, pv2[4]), __builtin_bit_cast(unsigned, pv2[5]), __builtin_bit_cast(unsigned, pv2[6]), __builtin_bit_cast(unsigned, pv2[7])};
      tot[half * 128 + k] = b;
    }
    if (ch + 1 < nch) HG_ISSUE(ch + 1)
    __syncthreads();
    {
      const float off = half ? tot[k] : 0.f;
      const float bL = fmaxf(tot[k] + tot[128 + k], -80.f);
      if (half == 0) dL[k] = __expf(bL);
      float kh[16];
#pragma unroll
      for (int jj = 0; jj < 16; ++jj) {
        const int j = half * 16 + jj;
        const float bj = fmaxf(off + bl[jj], -80.f);
        Qt[j * 136 + k] = f2bf(qs[jj] * __expf(bj));
        Kt[j * 136 + k] = f2bf(kc[jj] * __expf(-bj));
        kh[jj] = kc[jj] * __expf(fminf(bL - bj, 0.f));
      }
      *(u32x4*)(KhT + k * 40 + half * 16) = (u32x4){pk2(kh[0], kh[1]), pk2(kh[2], kh[3]), pk2(kh[4], kh[5]), pk2(kh[6], kh[7])};
      *(u32x4*)(KhT + k * 40 + half * 16 + 8) = (u32x4){pk2(kh[8], kh[9]), pk2(kh[10], kh[11]), pk2(kh[12], kh[13]), pk2(kh[14], kh[15])};
    }
    bf16_t* Sbw = Sb + w * 32 * 136;
#pragma unroll
    for (int kb = 0; kb < 4; ++kb)
#pragma unroll
      for (int g4 = 0; g4 < 4; ++g4) *(u32x2*)(Sbw + r * 136 + 32 * kb + crow(4 * g4, h)) = (u32x2){pk2(S[kb][4 * g4], S[kb][4 * g4 + 1]), pk2(S[kb][4 * g4 + 2], S[kb][4 * g4 + 3])};
    __syncthreads();
    bf16_t* Atw = At;
    {
      f32x16 A;
#pragma unroll
      for (int g = 0; g < 16; ++g) A[g] = 0.f;
      mma32(A, Qt, 136, Kt, 136, 128, lane);
#pragma unroll
      for (int g = 0; g < 16; ++g) { const int t = crow(g, h); Atw[t * 40 + r] = f2bf(r <= t ? A[g] : 0.f); }
    }
    __syncthreads();
    {
      f32x16 o;
#pragma unroll
      for (int g = 0; g < 16; ++g) o[g] = 0.f;
      mma32(o, Atw, 40, VT + 32 * w * 40, 40, 32, lane);
      mma32(o, Qt, 136, Sbw, 136, 128, lane);
#pragma unroll
      for (int g = 0; g < 16; ++g) {
        const int j = crow(g, h), pos = ch * 32 + j, t = d ? q.T - 1 - pos : pos;
        ZH[(size_t)(q.base + t) * ZHW + 512 * (1 + d) + 128 * hh + 32 * w + r] = f2bf(o[g]);
      }
#pragma unroll
      for (int kb = 0; kb < 4; ++kb) {
#pragma unroll
        for (int g = 0; g < 16; ++g) S[kb][g] *= dL[32 * kb + crow(g, h)];
        mma32(S[kb], KhT + 32 * kb * 40, 40, VT + 32 * w * 40, 40, 32, lane);
      }
    }
  }
  if (!q.sample) {
    float* dst = p.out + OUT_HG + ((((size_t)q.b * 2 + l) * 2 + d) * 4 + hh) * 16384;
#pragma unroll
    for (int kb = 0; kb < 4; ++kb)
#pragma unroll
      for (int g = 0; g < 16; ++g) dst[(size_t)(32 * kb + crow(g, h)) * 128 + 32 * w + r] = S[kb][g];
  }
}

DI void mlstm_item(const Params& p, int l, int s, int hh, int d, char* smem) {
  const Seq q = get_seq(s);
  const int tid = ltid(), lane = tid & 63, w = tid >> 6, r = lane & 31, h = lane >> 5;
  const bf16_t* ZM = (const bf16_t*)(p.ws + OFF_ZM);
  const float* MG = (const float*)(p.ws + OFF_MG);
  bf16_t* Hb = (bf16_t*)(p.ws + OFF_H);
  bf16_t* Qm = (bf16_t*)smem;
  bf16_t* Km = Qm + 32 * 136;
  bf16_t* KwT = Km + 32 * 136;
  bf16_t* VT = KwT + 128 * 40;
  bf16_t* Cb = VT + 128 * 40;
  bf16_t* Pt = Cb + 4 * 32 * 136;
  float* nv = (float*)(Pt + 32 * 40);
  float* sc = nv + 128;
  float* ig = sc; float* lf = sc + 32; float* gg = sc + 64; float* mtv = sc + 96; float* wi = sc + 128; float* wsr = sc + 160; float* qn = sc + 192; float* misc = sc + 224;
  float* dnw = sc + 232;
  const float gbi = p.in[I_GB][l * 16 + (2 * d) * 4 + hh], gbf = p.in[I_GB][l * 16 + (2 * d + 1) * 4 + hh];
  f32x16 C[4];
  float m;
  __syncthreads();
  if (q.sample) {
    const size_t sb = (((size_t)q.b * 2 + l) * 2 + d) * 4 + hh;
    const float* st = p.in[I_SC] + sb * 16384;
#pragma unroll
    for (int kb = 0; kb < 4; ++kb)
#pragma unroll
      for (int g = 0; g < 16; ++g) C[kb][g] = st[(size_t)(32 * kb + crow(g, h)) * 128 + 32 * w + r];
    if (tid < 128) nv[tid] = p.in[I_SN][sb * 128 + tid];
    m = p.in[I_SM][sb];
  } else {
#pragma unroll
    for (int kb = 0; kb < 4; ++kb)
#pragma unroll
      for (int g = 0; g < 16; ++g) C[kb][g] = 0.f;
    if (tid < 128) nv[tid] = 0.f;
    m = 0.f;
  }
  const int nch = q.T / 32;
  const int dd = tid & 127, half = tid >> 7;
  u16x2 pqk[16], pv2[8]; float pgi = 0.f, pgf = 0.f;
#define ML_ISSUE(chn) { _Pragma("unroll") for (int jj = 0; jj < 16; ++jj) { const int pos = (chn) * 32 + half * 16 + jj, t = d ? q.T - 1 - pos : pos; \
      const size_t rowo = (size_t)(q.base + t) * ZMW + 128 * hh + dd; pqk[jj][0] = ZM[rowo]; pqk[jj][1] = ZM[rowo + 512]; pv2[jj >> 1][jj & 1] = ZM[rowo + 1024]; } \
    if (tid < 32) { const int pos = (chn) * 32 + tid, t = d ? q.T - 1 - pos : pos; const float* mg = MG + (size_t)(q.base + t) * 16; pgi = mg[(2 * d) * 4 + hh]; pgf = mg[(2 * d + 1) * 4 + hh]; } }
  ML_ISSUE(0)
#pragma unroll 1
  for (int ch = 0; ch < nch; ++ch) {
    __syncthreads();
    {
#pragma unroll
      for (int jj = 0; jj < 16; ++jj) {
        const int j = half * 16 + jj;
        Qm[j * 136 + dd] = pqk[jj][0];
        Km[j * 136 + dd] = f2bf(bf2f(pqk[jj][1]) * 0.08838834764831845f);
      }
      *(u32x4*)(VT + dd * 40 + half * 16) = (u32x4){__builtin_bit_cast(unsigned, pv2[0]), __builtin_bit_cast(unsigned, pv2[1]), __builtin_bit_cast(unsigned, pv2[2]), __builtin_bit_cast(unsigned, pv2[3])};
      *(u32x4*)(VT + dd * 40 + half * 16 + 8) = (u32x4){__builtin_bit_cast(unsigned, pv2[4]), __builtin_bit_cast(unsigned, pv2[5]), __builtin_bit_cast(unsigned, pv2[6]), __builtin_bit_cast(unsigned, pv2[7])};
      if (tid < 32) {
        const float igv = pgi + gbi;
        const float lfv = -softplusf_(-(pgf + gbf));
        float g = lfv;
#pragma unroll
        for (int o = 1; o < 32; o <<= 1) { const float tt = shfl_lane(g, (lane - o) & 63); if (tid >= o) g += tt; }
        const float cs = igv - g;
        float pm = cs;
#pragma unroll
        for (int o = 1; o < 32; o <<= 1) { const float tt = shfl_lane(pm, (lane - o) & 63); if (tid >= o) pm = fmaxf(pm, tt); }
        const float mt = g + fmaxf(m, pm);
        const float gend = shfl_lane(g, 31), mn = shfl_lane(mt, 31);
        ig[tid] = igv; gg[tid] = g; mtv[tid] = mt; wi[tid] = __expf(g + m - mt);
        wsr[tid] = __expf(gend + cs - mn);
        if (tid == 0) { misc[0] = mn; misc[1] = __expf(gend + m - mn); }
      }
    }
    if (ch + 1 < nch) ML_ISSUE(ch + 1)
    __syncthreads();
    {
      {
        float kw[16];
#pragma unroll
        for (int jj = 0; jj < 16; ++jj) { const int j = half * 16 + jj; kw[jj] = bf2f(Km[j * 136 + dd]) * wsr[j]; }
        *(u32x4*)(KwT + dd * 40 + half * 16) = (u32x4){pk2(kw[0], kw[1]), pk2(kw[2], kw[3]), pk2(kw[4], kw[5]), pk2(kw[6], kw[7])};
        *(u32x4*)(KwT + dd * 40 + half * 16 + 8) = (u32x4){pk2(kw[8], kw[9]), pk2(kw[10], kw[11]), pk2(kw[12], kw[13]), pk2(kw[14], kw[15])};
      }
      const int j = tid >> 3, seg = tid & 7;
      float a = 0.f;
#pragma unroll
      for (int i = 0; i < 16; ++i) a += bf2f(Qm[j * 136 + seg * 16 + i]) * nv[seg * 16 + i];
      a += SHX(a, 1); a += SHX(a, 2); a += SHX(a, 4);
      if (seg == 0) qn[j] = a;
    }
    const float m_new = misc[0], carry = misc[1];
    bf16_t* Cbw = Cb + w * 32 * 136; bf16_t* Ptw = Pt;
#pragma unroll
    for (int kb = 0; kb < 4; ++kb)
#pragma unroll
      for (int g4 = 0; g4 < 4; ++g4) *(u32x2*)(Cbw + r * 136 + 32 * kb + crow(4 * g4, h)) = (u32x2){pk2(C[kb][4 * g4], C[kb][4 * g4 + 1]), pk2(C[kb][4 * g4 + 2], C[kb][4 * g4 + 3])};
    {
      f32x16 Sc;
#pragma unroll
      for (int g = 0; g < 16; ++g) Sc[g] = 0.f;
      mma32(Sc, Qm, 136, Km, 136, 128, lane);
      const float gs = gg[r], is = ig[r];
#pragma unroll
      for (int g = 0; g < 16; ++g) {
        const int t = crow(g, h);
        const float pv = (r <= t) ? __expf(gg[t] - gs + is - mtv[t]) * Sc[g] : 0.f;
        Ptw[t * 40 + r] = f2bf(pv);
      }
    }
    __syncthreads();
    if (lane < 32) {
      float a = 0.f;
#pragma unroll 4
      for (int i = 0; i < 32; ++i) a += bf2f(Ptw[lane * 40 + i]);
      const float den = wi[lane] * qn[lane] + a;
      dnw[lane] = 1.0f / fmaxf(fabsf(den), __expf(-mtv[lane]));
    }
    if (tid < 128) {
      float a = 0.f;
#pragma unroll 4
      for (int i = 0; i < 32; ++i) a += bf2f(KwT[tid * 40 + i]);
      nv[tid] = carry * nv[tid] + a;
    }
    __syncthreads();
    {
      f32x16 a1;
#pragma unroll
      for (int g = 0; g < 16; ++g) a1[g] = 0.f;
      mma32(a1, Qm, 136, Cbw, 136, 128, lane);
#pragma unroll
      for (int g = 0; g < 16; ++g) a1[g] *= wi[crow(g, h)];
      mma32(a1, Ptw, 40, VT + 32 * w * 40, 40, 32, lane);
#pragma unroll
      for (int g = 0; g < 16; ++g) {
        const int j = crow(g, h), pos = ch * 32 + j, t = d ? q.T - 1 - pos : pos;
        const float hv = a1[g] * dnw[j];
        Hb[(size_t)(q.base + t) * 1024 + d * 512 + 128 * hh + 32 * w + r] = f2bf(hv);
      }
#pragma unroll
      for (int kb = 0; kb < 4; ++kb) {
#pragma unroll
        for (int g = 0; g < 16; ++g) C[kb][g] *= carry;
        mma32(C[kb], KwT + 32 * kb * 40, 40, VT + 32 * w * 40, 40, 32, lane);
      }
    }
    m = m_new;
  }
  __syncthreads();
  if (!q.sample) {
    const size_t sb = (((size_t)q.b * 2 + l) * 2 + d) * 4 + hh;
    float* dst = p.out + OUT_C + sb * 16384;
#pragma unroll
    for (int kb = 0; kb < 4; ++kb)
#pragma unroll
      for (int g = 0; g < 16; ++g) dst[(size_t)(32 * kb + crow(g, h)) * 128 + 32 * w + r] = C[kb][g];
    if (tid < 128) p.out[OUT_N + sb * 128 + tid] = nv[tid];
    if (tid == 0) p.out[OUT_M + sb] = m;
  }
}

DI void phase_scan(const Params& p, int l, char* smem) {
  int* ctrL = (int*)(p.ws + OFF_CTR) + 2 * l;
  int* ctrS = ctrL + 1;
  int* sit = (int*)(smem + LDS_BYTES - 16);
  const int role = p.role;
  bool longDone = false, shortDone = false;
  for (;;) {
    const bool wantLong = (role == 0) ? !longDone : shortDone;
    if (longDone && shortDone) break;
    __syncthreads();
    if (ltid() == 0) *sit = atomicAdd(wantLong ? ctrL : ctrS, 1);
    __syncthreads();
    int it = __builtin_amdgcn_readfirstlane(*sit);
    int ty, s_, hh_, d_, rb_ = 0;
    if (wantLong) {
      if (it >= 128) { longDone = true; continue; }
      if (it < 64) { ty = 0; d_ = it & 1; hh_ = (it >> 1) & 7; s_ = 32 + (it >> 4); }
      else if (it < 96) { it -= 64; ty = 1; s_ = 32 + (it >> 3); hh_ = (it >> 1) & 3; d_ = it & 1; }
      else { it -= 96; ty = 2; s_ = 32 + (it >> 3); hh_ = (it >> 1) & 3; d_ = it & 1; }
    } else {
      if (it >= 1024) { shortDone = true; continue; }
      if (it < 512) { ty = 0; s_ = it >> 4; hh_ = (it >> 1) & 7; d_ = it & 1; }
      else if (it < 768) { it -= 512; ty = 1; s_ = it >> 3; hh_ = (it >> 1) & 3; d_ = it & 1; }
      else { it -= 768; ty = 2; s_ = it >> 3; hh_ = (it >> 1) & 3; d_ = it & 1; }
    }
    if (ty == 0) rwkv_item(p, l, s_, hh_, d_, smem);
    else if (ty == 1) hgrn_item(p, l, s_, hh_, d_, smem);
    else mlstm_item(p, l, s_, hh_, d_, smem);
  }
}

DI void phase_combine(const Params& p, int l, char* smem) {
  const int tid = ltid(), lane = tid & 63, w = tid >> 6;
  bf16_t* ZH = (bf16_t*)(p.ws + OFF_ZH); bf16_t* ZM = (bf16_t*)(p.ws + OFF_ZM); const bf16_t* ZR = (const bf16_t*)(p.ws + OFF_ZR);
  bf16_t* O = (bf16_t*)(p.ws + OFF_O); const bf16_t* Hb = (const bf16_t*)(p.ws + OFF_H);
  const float* mu = p.in[I_MU] + (size_t)l * 4 * ZRW;
  const float* g2 = p.in[I_G2] + (size_t)l * 128 * 512;
  float* sg = (float*)smem;
  float* gt = sg + 128 * 16;
  for (int blk = blockIdx.x; blk < NT / 16; blk += gridDim.x) {
    const int tok0 = blk * 16;
    int sidx, t0;
    if (tok0 < 8192) { sidx = tok0 >> 8; t0 = tok0 & 255; } else { sidx = 32 + ((tok0 - 8192) >> 11); t0 = (tok0 - 8192) & 2047; }
    const Seq q = get_seq(sidx);
    __syncthreads();
    { const int j = tid >> 4, rr0 = (tid & 15) * 8; float val[8]; bf16x8 pv[5]; rw_load8(ZR, q.base, t0 + j, q.T, q.grid, 1792 + rr0, pv); rw_apply8(pv, mu, q.grid, 1792 + rr0, val);
#pragma unroll
      for (int e = 0; e < 8; ++e) sg[(rr0 + e) * 16 + j] = sigmoidf_(val[e]); }
    __syncthreads();
    {
      float a0[16], a1[16];
#pragma unroll
      for (int j = 0; j < 16; ++j) { a0[j] = 0.f; a1[j] = 0.f; }
#pragma unroll 1
      for (int r0 = 0; r0 < 128; r0 += 8) {
        float w0v[8], w1v[8];
#pragma unroll
        for (int q8 = 0; q8 < 8; ++q8) { w0v[q8] = g2[(r0 + q8) * 512 + tid]; w1v[q8] = g2[(r0 + q8) * 512 + 256 + tid]; }
#pragma unroll
        for (int q8 = 0; q8 < 8; ++q8) {
          const int rr = r0 + q8; const float w0 = w0v[q8], w1 = w1v[q8];
#pragma unroll
          for (int u = 0; u < 4; ++u) {
            f32x4 sv = *(const f32x4*)(sg + rr * 16 + 4 * u);
#pragma unroll
            for (int e = 0; e < 4; ++e) { a0[4 * u + e] += sv[e] * w0; a1[4 * u + e] += sv[e] * w1; }
          }
        }
      }
#pragma unroll
      for (int j = 0; j < 16; ++j) { gt[j * 512 + tid] = a0[j]; gt[j * 512 + 256 + tid] = a1[j]; }
    }
    __syncthreads();
#pragma unroll 1
    for (int jj = 0; jj < 4; ++jj) {
      const int j = w * 4 + jj, tok = tok0 + j, t = t0 + j; int c0 = lane * 8; asm volatile("" : "+v"(c0));
      {
        float o[8], rs[8], ks[8], vs[8];
        float sum = 0.f, bon = 0.f;
        {
          bf16x8 pr_[5], pk_[5], pv_[5];
          rw_load8(ZR, q.base, t, q.T, q.grid, c0, pr_); rw_load8(ZR, q.base, t, q.T, q.grid, 512 + c0, pk_); rw_load8(ZR, q.base, t, q.T, q.grid, 1024 + c0, pv_);
          rw_apply8(pr_, mu, q.grid, c0, rs); rw_apply8(pk_, mu, q.grid, 512 + c0, ks); rw_apply8(pv_, mu, q.grid, 1024 + c0, vs);
        }
        const bf16x8 of = *(const bf16x8*)(O + (size_t)tok * 1024 + c0), ob = *(const bf16x8*)(O + (size_t)tok * 1024 + 512 + c0);
        const f32x4 rk0 = *(const f32x4*)(p.in[I_RK] + l * 512 + c0), rk1 = *(const f32x4*)(p.in[I_RK] + l * 512 + c0 + 4);
#pragma unroll
        for (int e = 0; e < 8; ++e) {
          o[e] = bf2f((bf16_t)of[e]) + bf2f((bf16_t)ob[e]);
          sum += o[e];
          bon += rs[e] * ks[e] * (e < 4 ? rk0[e & 3] : rk1[e & 3]);
        }
        sum += SHX(sum, 1); sum += SHX(sum, 2); sum += SHX(sum, 4);
        bon += SHX(bon, 1); bon += SHX(bon, 2); bon += SHX(bon, 4);
        const float mean = sum * (1.0f / 64.f);
        float var = 0.f;
#pragma unroll
        for (int e = 0; e < 8; ++e) { const float dv = o[e] - mean; var += dv * dv; }
        var += SHX(var, 1); var += SHX(var, 2); var += SHX(var, 4);
        const float rstd = rsqrtf(var * (1.0f / 64.f) + 64e-5f);
        const f32x4 lw0 = *(const f32x4*)(p.in[I_LN] + (l * 2 + 0) * 512 + c0), lw1 = *(const f32x4*)(p.in[I_LN] + (l * 2 + 0) * 512 + c0 + 4);
        const f32x4 lb0 = *(const f32x4*)(p.in[I_LN] + (l * 2 + 1) * 512 + c0), lb1 = *(const f32x4*)(p.in[I_LN] + (l * 2 + 1) * 512 + c0 + 4);
        const f32x4 gt0 = *(const f32x4*)(gt + j * 512 + c0), gt1 = *(const f32x4*)(gt + j * 512 + c0 + 4);
        bf16x8 ov;
#pragma unroll
        for (int e = 0; e < 8; ++e) {
          const float ln = (o[e] - mean) * rstd * (e < 4 ? lw0[e & 3] : lw1[e & 3]) + (e < 4 ? lb0[e & 3] : lb1[e & 3]);
          ov[e] = (short)f2bf((ln + bon * vs[e]) * (e < 4 ? gt0[e & 3] : gt1[e & 3]));
        }
        *(bf16x8*)(O + (size_t)tok * 1024 + c0) = ov;
      }
      {
        float o[8]; float ss = 0.f;
        bf16_t* zr_ = ZH + (size_t)tok * ZHW + c0;
        const bf16x8 of = *(const bf16x8*)(zr_ + 512), ob = *(const bf16x8*)(zr_ + 1024), hgv = *(const bf16x8*)(zr_ + 2048);
        const f32x4 nw0 = *(const f32x4*)(p.in[I_HNORM] + l * 512 + c0), nw1 = *(const f32x4*)(p.in[I_HNORM] + l * 512 + c0 + 4);
#pragma unroll
        for (int e = 0; e < 8; ++e) { o[e] = bf2f((bf16_t)of[e]) + bf2f((bf16_t)ob[e]); ss += o[e] * o[e]; }
        ss += SHX(ss, 1); ss += SHX(ss, 2); ss += SHX(ss, 4); ss += SHX(ss, 8);
        const float rsd = rsqrtf(ss * (1.0f / 128.f) + 1e-6f);
        bf16x8 ov;
#pragma unroll
        for (int e = 0; e < 8; ++e) ov[e] = (short)f2bf(o[e] * rsd * (e < 4 ? nw0[e & 3] : nw1[e & 3]) * siluf_(bf2f((bf16_t)hgv[e])));
        *(bf16x8*)(zr_ + 2048) = ov;
      }
      {
        float o[8]; float ss = 0.f;
        bf16_t* zm_ = ZM + (size_t)tok * ZMW + 1536 + c0;
        const bf16x8 of = *(const bf16x8*)(Hb + (size_t)tok * 1024 + c0), ob = *(const bf16x8*)(Hb + (size_t)tok * 1024 + 512 + c0), mov = *(const bf16x8*)zm_;
        const f32x4 nw0 = *(const f32x4*)(p.in[I_MNORM] + l * 512 + c0), nw1 = *(const f32x4*)(p.in[I_MNORM] + l * 512 + c0 + 4);
#pragma unroll
        for (int e = 0; e < 8; ++e) { o[e] = bf2f((bf16_t)of[e]) + bf2f((bf16_t)ob[e]); ss += o[e] * o[e]; }
        ss += SHX(ss, 1); ss += SHX(ss, 2); ss += SHX(ss, 4); ss += SHX(ss, 8);
        const float rsd = rsqrtf(ss * (1.0f / 128.f) + 1e-6f);
        bf16x8 ov;
#pragma unroll
        for (int e = 0; e < 8; ++e) ov[e] = (short)f2bf(o[e] * rsd * (e < 4 ? nw0[e & 3] : nw1[e & 3]) * sigmoidf_(bf2f((bf16_t)mov[e])));
        *(bf16x8*)zm_ = ov;
      }
    }
    __syncthreads();
#pragma unroll 1
    for (int jj = 0; jj < 4; ++jj) tok_one(p, l, 3, tok0 + w * 4 + jj, lane);
  }
}

#define XB_TMO      128
#define XB_XCNT(j)  (256  + 64 * (j))
#define XB_XSUB(j)  (1280 + 64 * (j))
#define XB_XGEN(j)  (2304 + 64 * (j))
#define XB_TOP      3328
#define XB_TOPGEN   3392
#define XCD_BAR_WORDS 3456
#define XB_SPIN_CAP (1u << 20)
#define LAS __attribute__((address_space(3)))
DI unsigned xb_ld(unsigned* p)              { return __hip_atomic_load(p, __ATOMIC_RELAXED, __HIP_MEMORY_SCOPE_AGENT); }
DI unsigned xb_add(unsigned* p, unsigned v) { return __hip_atomic_fetch_add(p, v, __ATOMIC_RELAXED, __HIP_MEMORY_SCOPE_AGENT); }
DI unsigned xb_xcc_id() { return (unsigned)__builtin_amdgcn_s_getreg((3 << 11) | 20) & 0xFu; }
#define XB_SPIN(cond, bar) do { unsigned _sp = 0; while (cond) { __builtin_amdgcn_s_sleep(1); \
    if ((++_sp & 255u) == 0u) { if (xb_ld(&(bar)[XB_TMO])) break; if (_sp > XB_SPIN_CAP) { atomicAdd(&(bar)[XB_TMO], 1u); break; } } } } while (0)
struct XcdBarrier { unsigned* bar; unsigned x; volatile LAS unsigned* st; };
DI XcdBarrier xcd_barrier_post(const Params& p, unsigned* bar, volatile LAS unsigned* st) {
  XcdBarrier b; b.bar = bar; b.x = xb_xcc_id(); b.st = st;
  if (ltid() == 0) (void)xb_add(&bar[XB_XCNT(b.x)], 1u);
  return b;
}
DI void xcd_barrier_complete(unsigned* bar, unsigned x, unsigned& nloc, unsigned& nx) {
  const unsigned G = gridDim.x * gridDim.y * gridDim.z;
  unsigned sum, cnt, mine, sp = 0u;
  for (;;) {
    sum = 0u; cnt = 0u; mine = 0u;
#pragma unroll
    for (unsigned j = 0; j < 16; ++j) { const unsigned c = xb_ld(&bar[XB_XCNT(j)]); sum += c; cnt += (c > 0u) ? 1u : 0u; mine = (j == x) ? c : mine; }
    if (sum == G) break;
    __builtin_amdgcn_s_sleep(1);
    if ((++sp & 255u) == 0u) { if (xb_ld(&bar[XB_TMO])) break; if (sp > XB_SPIN_CAP) { atomicAdd(&bar[XB_TMO], 1u); break; } }
  }
  nloc = mine > 0u ? mine : 1u; nx = cnt > 0u ? cnt : 1u;
}
DI void xcd_barrier(const Params& p, const XcdBarrier& b) {
  asm volatile("s_waitcnt vmcnt(0)" ::: "memory");
  __syncthreads();
  if (ltid() == 0) {
    unsigned* bar = b.bar;
    __builtin_amdgcn_s_waitcnt(0);
    unsigned nloc = b.st[0], nx = b.st[1];
    if (nloc == 0u) { xcd_barrier_complete(bar, b.x, nloc, nx); b.st[0] = nloc; b.st[1] = nx; }
    const unsigned old = xb_add(&bar[XB_XSUB(b.x)], 1u);
    const unsigned gen = old / nloc;
    if (old + 1u == (gen + 1u) * nloc) {
      __builtin_amdgcn_fence(__ATOMIC_RELEASE, "agent");
      asm volatile("s_waitcnt vmcnt(0)" ::: "memory");
      const unsigned og = xb_add(&bar[XB_TOP], 1u);
      const unsigned tg = og / nx;
      if (og + 1u == (tg + 1u) * nx) xb_add(&bar[XB_TOPGEN], 1u);
      else XB_SPIN(xb_ld(&bar[XB_TOPGEN]) == tg, bar);
      __builtin_amdgcn_fence(__ATOMIC_ACQUIRE, "agent");
      xb_add(&bar[XB_XGEN(b.x)], 1u);
      asm volatile("s_waitcnt vmcnt(0)" ::: "memory");
    } else {
      XB_SPIN(xb_ld(&bar[XB_XGEN(b.x)]) == gen, bar);
      __builtin_amdgcn_fence(__ATOMIC_ACQUIRE, "agent");
      asm volatile("s_waitcnt vmcnt(0)" ::: "memory");
    }
  }
  __syncthreads();
}

constexpr int NPHASE = 3 + 9 * 2;
DI void run_phase(const Params& p0, int ph, char* smem) {
  Params p = p0;
  asm volatile("" : "+s"(p.ws), "+s"(p.out));
  p.ws = as_global(p.ws); p.out = as_global(p.out);
  if (ph == 0) { phase0(p, smem); return; }
  if (ph == 1) { phase1(p); return; }
  if (ph == 2) { tok_phase(p, 0, 0); return; }
  const int l = (ph - 3) / 9, s = (ph - 3) % 9;
  switch (s) {
    case 0: phase_inproj(p, smem); break;
    case 1: phase_scan(p, l, smem); break;
    case 2: phase_combine(p, l, smem); break;
    case 3: phase_merge(p, l, smem); break;
    case 4: phase_gemm_f32(p, (const bf16_t*)(p.ws + OFF_MERGED), 1024, (const bf16_t*)(p.ws + OFF_WTOUT), smem); break;
    case 5: tok_phase(p, l, 1); break;
    case 6: phase_ffn_in(p, smem); break;
    case 7: phase_gemm_f32(p, (const bf16_t*)(p.ws + OFF_ACT), DFF, (const bf16_t*)(p.ws + OFF_WTFO), smem); break;
    case 8:
      tok_phase(p, l, 2);
      if (l + 1 < 2) {
        conv_weight(p, p.in[I_WIN] + (size_t)(l + 1) * 1024 * DIN, DIN, (bf16_t*)(p.ws + OFF_WTIN), 1024, WTIN_ROWS, 0, (float*)smem, blockIdx.x, gridDim.x);
        for (int br = 0; br < 3; ++br) conv_weight(p, p.in[I_WBR] + ((size_t)(l + 1) * 3 + br) * 512 * 1024, 1024, (bf16_t*)(p.ws + OFF_WTBR) + (size_t)br * 1024 * 512, 512, 1024, 1, (float*)smem, blockIdx.x, gridDim.x);
      }
      break;
  }
}

template <bool COOP>
__global__ void __launch_bounds__(NTHR, 2) mega(Params pk, int lo, int hi) {
  __shared__ __attribute__((aligned(16))) char smem[LDS_BYTES];
  Params p = pk;
#pragma unroll
  for (int i = 0; i < N_IN; ++i) p.in[i] = as_global(p.in[i]);
  p.ws = as_global(p.ws); p.out = as_global(p.out);
  p.wb = __builtin_amdgcn_readfirstlane((int)threadIdx.x) & ~63;
  if (COOP) {
    volatile LAS unsigned* st = (volatile LAS unsigned*)(smem + LDS_BYTES - 32);
    if (ltid() == 0) { st[0] = 0u; st[1] = 0u; }
    __syncthreads();
    phase0(p, smem);
    cg::this_grid().sync();
    XcdBarrier b = xcd_barrier_post(p, (unsigned*)(p.ws + OFF_BAR), st);
    if (ltid() == 0) {
      const unsigned hwid = (unsigned)__builtin_amdgcn_s_getreg((31 << 11) | 4);
      const unsigned key = (xb_xcc_id() << 8) | ((hwid >> 8) & 0xFFu);
      ((int*)smem)[(LDS_BYTES - 12) / 4] = (int)xb_add((unsigned*)(p.ws + OFF_ROLE) + key, 1u);
    }
    __syncthreads();
    p.role = __builtin_amdgcn_readfirstlane(((int*)smem)[(LDS_BYTES - 12) / 4]);
    for (int ph = 1; ph < hi; ++ph) {
      run_phase(p, ph, smem);
      if (ph + 1 < hi) xcd_barrier(p, b);
    }
  } else {
    for (int ph = lo; ph < hi; ++ph) run_phase(p, ph, smem);
  }
}

extern "C" void kernel_launch(void* const* d_in, const int* in_sizes, int n_in, void* d_out, int out_size, void* d_ws, size_t ws_size, hipStream_t stream) {
  Params p{};
  for (int i = 0; i < N_IN; ++i) p.in[i] = (const float*)d_in[i];
  p.out = (float*)d_out; p.ws = (char*)d_ws;
  if (ws_size < WS_NEED) fprintf(stderr, "workspace too small: %zu < %zu\n", ws_size, (size_t)WS_NEED);
  static int grid_blocks = 0;
  if (!grid_blocks) {
    int dev = 0, cus = 0, per_cu = 0;
    hipGetDevice(&dev);
    hipDeviceGetAttribute(&cus, hipDeviceAttributeMultiprocessorCount, dev);
    hipOccupancyMaxActiveBlocksPerMultiprocessor(&per_cu, mega<true>, NTHR, 0);
    if (per_cu > 2) per_cu = 2;
    grid_blocks = cus * per_cu;
  }
  int lo = 0, hi = NPHASE;
  void* args[] = {&p, &lo, &hi};
  hipError_t e = hipLaunchCooperativeKernel((void*)mega<true>, dim3(grid_blocks), dim3(NTHR), args, 0, stream);
  if (e != hipSuccess) fprintf(stderr, "cooperative launch failed: %s (grid %d)\n", hipGetErrorString(e), grid_blocks);
}
```

```cpp
#include <hip/hip_runtime.h>
#include <hip/hip_cooperative_groups.h>
#include <cstdio>
namespace cg = cooperative_groups;

typedef unsigned short bf16_t;
typedef short bf16x8 __attribute__((ext_vector_type(8)));
typedef float f32x4 __attribute__((ext_vector_type(4)));
typedef float f32x2 __attribute__((ext_vector_type(2)));
typedef float f32x16 __attribute__((ext_vector_type(16)));
typedef unsigned short u16x4 __attribute__((ext_vector_type(4)));
typedef unsigned short u16x2 __attribute__((ext_vector_type(2)));
typedef unsigned u32x4 __attribute__((ext_vector_type(4)));
typedef unsigned u32x2 __attribute__((ext_vector_type(2)));
static __device__ __forceinline__ unsigned pk2(float lo, float hi) { typedef __bf16 b2 __attribute__((ext_vector_type(2))); typedef float f2 __attribute__((ext_vector_type(2))); return __builtin_bit_cast(unsigned, __builtin_convertvector((f2){lo, hi}, b2)); }

#define DI __device__ __forceinline__
#define GAS __attribute__((address_space(1)))
template <class T> static __device__ __forceinline__ T* as_global(T* q) { return (T*)(GAS T*)(unsigned long long)q; }

constexpr int NT = 16384;
constexpr int DM = 1024;
constexpr int NTHR = 256;
constexpr int DIN = 9616;
constexpr int ZHW = 2560, ZRW = 1920, ZMW = 2048;
constexpr int WTIN_ROWS = 9728;
constexpr int DFF = 2816;

constexpr size_t OFF_WTIN = 0;
constexpr size_t OFF_WTBR = OFF_WTIN + (size_t)WTIN_ROWS * 1024 * 2;
constexpr size_t OFF_H    = OFF_WTBR + (size_t)3 * 1024 * 512 * 2;
constexpr size_t OFF_ZH   = OFF_H + (size_t)NT * 1024 * 2;
constexpr size_t OFF_ZR   = OFF_ZH + (size_t)NT * ZHW * 2;
constexpr size_t OFF_ZM   = OFF_ZR + (size_t)NT * ZRW * 2;
constexpr size_t OFF_MG   = OFF_ZM + (size_t)NT * ZMW * 2;
constexpr size_t OFF_O    = OFF_MG + (size_t)NT * 16 * 4;
constexpr size_t OFF_MOD  = OFF_O + (size_t)NT * 1024 * 2;
constexpr size_t OFF_LBS  = OFF_MOD + (size_t)2 * 5 * 6144 * 4;
constexpr size_t OFF_CTR  = OFF_LBS + 2 * 512 * 4;
constexpr size_t OFF_BAR  = OFF_CTR + 256;
constexpr size_t OFF_ROLE = OFF_BAR + 3456 * 4;
constexpr size_t WS_NEED  = OFF_ROLE + 4096 * 4;
constexpr size_t OFF_MODP = OFF_ZH;
constexpr size_t OFF_WTOUT = OFF_ZR;
constexpr size_t OFF_WTFI  = OFF_WTOUT + (size_t)1024 * 1024 * 2;
constexpr size_t OFF_WTFO  = OFF_WTFI + (size_t)5632 * 1024 * 2;
constexpr size_t OFF_MERGED = OFF_WTFO + (size_t)1024 * 2816 * 2;
constexpr size_t OFF_Y    = OFF_ZH;
constexpr size_t OFF_ACT  = OFF_ZM;

constexpr size_t OUT_HG = 16777216, OUT_RW = 25165824, OUT_C = 29360128, OUT_N = 37748736, OUT_M = 37814272;

enum { I_XP = 0, I_XS, I_SH, I_SR, I_SC, I_SN, I_SM, I_C, I_CCTX, I_WADA, I_BADA, I_NORMS, I_WIN, I_HLB, I_HNORM, I_MU, I_W0, I_W2,
       I_A0, I_A2, I_G2, I_KK, I_KA, I_RK, I_LN, I_GB, I_MNORM, I_WBR, I_WOUT, I_WFI, I_WFO, N_IN };

struct Params { const float* in[N_IN]; float* out; char* ws; int wb; int role; };

constexpr int LDS_BYTES = 77824;

DI bf16_t f2bf(float f) { return __builtin_bit_cast(unsigned short, (__bf16)f); }
DI float bf2f(bf16_t h) { return __uint_as_float(((unsigned)h) << 16); }
DI float sigmoidf_(float x) { return 1.0f / (1.0f + __expf(-x)); }
DI float siluf_(float x) { return x / (1.0f + __expf(-x)); }
DI float softplusf_(float x) { return x > 20.f ? x : __logf(1.0f + __expf(x)); }
DI float dpp_xor1(float x) { return __int_as_float(__builtin_amdgcn_mov_dpp(__float_as_int(x), 0xB1, 0xF, 0xF, true)); }
DI float dpp_xor2(float x) { return __int_as_float(__builtin_amdgcn_mov_dpp(__float_as_int(x), 0x4E, 0xF, 0xF, true)); }
DI float shfl_lane(float v, int src) { return __int_as_float(__builtin_amdgcn_ds_bpermute(src << 2, __float_as_int(v))); }
#define SHX(v, m) shfl_lane((v), lane ^ (m))
DI float wave_sum(float v, int lane) { v += dpp_xor1(v); v += dpp_xor2(v); v += SHX(v, 4); v += SHX(v, 8); v += SHX(v, 16); v += SHX(v, 32); return v; }
DI int ltid_(int wb) { int t = wb + (int)__builtin_amdgcn_mbcnt_hi(~0u, __builtin_amdgcn_mbcnt_lo(~0u, 0u)); asm volatile("" : "+v"(t)); return t; }
#define ltid() ltid_(p.wb)
DI int crow(int reg, int h) { return (reg & 3) + 8 * (reg >> 2) + 4 * h; }

DI int tok_cond(int tok) { return tok < 8192 ? 0 : 1 + ((tok - 8192) >> 11); }
DI const float* x_in_row(const Params& p, int tok) { return tok < 8192 ? p.in[I_XP] + (size_t)tok * DM : p.in[I_XS] + (size_t)(tok - 8192) * DM; }

DI void mma32(f32x16& acc, const bf16_t* A, int lda, const bf16_t* B, int ldb, int K, int lane) {
  const int r = lane & 31, h = lane >> 5;
#pragma unroll 2
  for (int kk = 0; kk < K; kk += 16) {
    bf16x8 a = *(const bf16x8*)(A + r * lda + kk + 8 * h);
    bf16x8 b = *(const bf16x8*)(B + r * ldb + kk + 8 * h);
    acc = __builtin_amdgcn_mfma_f32_32x32x16_bf16(a, b, acc, 0, 0, 0);
  }
}

template <int BM, int BN, int BK>
DI void gemm_main(const Params& p, f32x4 (&acc)[BM / 32][BN / 32], const bf16_t* __restrict__ A, int lda, const bf16_t* __restrict__ B, int ldb, int K, bf16_t* sm) {
  constexpr int MI = BM / 32, NJ = BN / 32, LS = BK + 8, CPR = BK / 8, ACH = BM * BK / 2048, BCH = BN * BK / 2048, KS = BK / 32, RPI = 256 / CPR;
  const int tid = ltid(), lane = tid & 63, w = tid >> 6, wm = w >> 1, wn = w & 1;
  bf16_t* As = sm; bf16_t* Bs = sm + 2 * BM * LS;
  bf16x8 ra[ACH], rb[BCH];
  const int nk = K / BK;
  const int lrow = tid / CPR, lkc = (tid % CPR) * 8;
#pragma unroll
  for (int i = 0; i < ACH; ++i) ra[i] = *(const bf16x8*)(A + (size_t)(lrow + RPI * i) * lda + lkc);
#pragma unroll
  for (int i = 0; i < BCH; ++i) rb[i] = *(const bf16x8*)(B + (size_t)(lrow + RPI * i) * ldb + lkc);
  __syncthreads();
#pragma unroll
  for (int i = 0; i < ACH; ++i) *(bf16x8*)(As + (lrow + RPI * i) * LS + lkc) = ra[i];
#pragma unroll
  for (int i = 0; i < BCH; ++i) *(bf16x8*)(Bs + (lrow + RPI * i) * LS + lkc) = rb[i];
  __syncthreads();
  for (int kt = 0; kt < nk; ++kt) {
    const int buf = kt & 1;
    if (kt + 1 < nk) {
      const int k0 = (kt + 1) * BK + lkc;
#pragma unroll
      for (int i = 0; i < ACH; ++i) ra[i] = *(const bf16x8*)(A + (size_t)(lrow + RPI * i) * lda + k0);
#pragma unroll
      for (int i = 0; i < BCH; ++i) rb[i] = *(const bf16x8*)(B + (size_t)(lrow + RPI * i) * ldb + k0);
    }
    const bf16_t* as = As + buf * BM * LS + (wm * (BM / 2) + (lane & 15)) * LS + (lane >> 4) * 8;
    const bf16_t* bs = Bs + buf * BN * LS + (wn * (BN / 2) + (lane & 15)) * LS + (lane >> 4) * 8;
#pragma unroll
    for (int ks = 0; ks < KS; ++ks) {
      bf16x8 bfr[NJ];
#pragma unroll
      for (int j = 0; j < NJ; ++j) bfr[j] = *(const bf16x8*)(bs + j * 16 * LS + ks * 32);
      __builtin_amdgcn_s_setprio(1);
#pragma unroll
      for (int i = 0; i < MI; ++i) {
        const bf16x8 af = *(const bf16x8*)(as + i * 16 * LS + ks * 32);
#pragma unroll
        for (int j = 0; j < NJ; ++j) acc[i][j] = __builtin_amdgcn_mfma_f32_16x16x32_bf16(bfr[j], af, acc[i][j], 0, 0, 0);
      }
      __builtin_amdgcn_s_setprio(0);
    }
    if (kt + 1 < nk) {
      const int nb = buf ^ 1;
#pragma unroll
      for (int i = 0; i < ACH; ++i) *(bf16x8*)(As + nb * BM * LS + (lrow + RPI * i) * LS + lkc) = ra[i];
#pragma unroll
      for (int i = 0; i < BCH; ++i) *(bf16x8*)(Bs + nb * BN * LS + (lrow + RPI * i) * LS + lkc) = rb[i];
    }
    __syncthreads();
  }
}

template <int MI, int NJ> DI void zero_acc(f32x4 (&acc)[MI][NJ]) {
#pragma unroll
  for (int i = 0; i < MI; ++i)
#pragma unroll
    for (int j = 0; j < NJ; ++j) acc[i][j] = (f32x4){0.f, 0.f, 0.f, 0.f};
}
DI void store_bf4(bf16_t* dst, f32x4 v) { u16x4 o; o[0] = f2bf(v[0]); o[1] = f2bf(v[1]); o[2] = f2bf(v[2]); o[3] = f2bf(v[3]); *(u16x4*)dst = o; }

DI int map_col(int mode, int n) {
  if (mode == 0) return n < 6544 ? n : (n < 6656 ? -1 : n - 112);
  if (mode == 2) return ((n >> 4) & 1) ? DFF + (n >> 5) * 16 + (n & 15) : (n >> 5) * 16 + (n & 15);
  return n;
}
DI void conv_tile(const Params& p, const float* __restrict__ src, int ld_src, bf16_t* __restrict__ dst, int K, int mode, int tk, int tn, float* sm) {
  const int tid = ltid();
  __syncthreads();
  {
    const int nn = tid & 63, col = map_col(mode, tn * 64 + nn);
#pragma unroll
    for (int i = 0; i < 16; ++i) { int kk = (tid >> 6) + 4 * i; sm[kk * 65 + nn] = col >= 0 ? src[(size_t)(tk * 64 + kk) * ld_src + col] : 0.f; }
  }
  __syncthreads();
  {
    const int kk = tid & 63;
#pragma unroll
    for (int i = 0; i < 16; ++i) { int nn = (tid >> 6) + 4 * i; dst[(size_t)(tn * 64 + nn) * K + tk * 64 + kk] = f2bf(sm[kk * 65 + nn]); }
  }
}
DI void conv_weight(const Params& p, const float* src, int ld_src, bf16_t* dst, int K, int Ndst, int mode, float* sm, int bid, int nb) {
  const int tkn = K / 64, nt = tkn * (Ndst / 64);
  for (int t = bid; t < nt; t += nb) conv_tile(p, src, ld_src, dst, K, mode, t % tkn, t / tkn, sm);
}

DI void phase0(const Params& p, char* smem) {
  const int tid = ltid(), bid = blockIdx.x, nb = gridDim.x;
  float* MODP = (float*)(p.ws + OFF_MODP);
  float* sm = (float*)smem;
  if (bid == 0) { if (tid < 64) ((int*)(p.ws + OFF_CTR))[tid] = 0; for (int i = tid; i < 3456; i += NTHR) ((unsigned*)(p.ws + OFF_BAR))[i] = 0u; for (int i = tid; i < 4096; i += NTHR) ((unsigned*)(p.ws + OFF_ROLE))[i] = 0u; }
  for (int i = bid * NTHR + tid; i < 512; i += nb * NTHR) {
    float a = p.in[I_HLB][i], b = p.in[I_HLB][512 + i];
    float* L = (float*)(p.ws + OFF_LBS); L[i] = 0.f; L[512 + i] = 1.0f / (1.0f + expf(a - b));
  }
  for (int it = bid; it < 2 * 24 * 16; it += nb) {
    const int ks = it & 15, jb = (it >> 4) % 24, l = it / (16 * 24);
    __syncthreads();
    for (int e = tid; e < 5 * 64; e += NTHR) { int ci = e >> 6, k = ks * 64 + (e & 63); float cv = ci == 0 ? p.in[I_CCTX][k] : p.in[I_C][(ci - 1) * DM + k]; sm[e] = siluf_(cv); }
    __syncthreads();
    const int j = jb * 256 + tid;
    float a0 = 0, a1 = 0, a2 = 0, a3 = 0, a4 = 0;
    const float* W = p.in[I_WADA] + ((size_t)l * DM + ks * 64) * 6144 + j;
#pragma unroll 1
    for (int k0 = 0; k0 < 64; k0 += 16) {
      float wv[16];
#pragma unroll
      for (int u = 0; u < 16; ++u) wv[u] = W[(size_t)(k0 + u) * 6144];
#pragma unroll
      for (int u = 0; u < 16; ++u) { const int k = k0 + u; const float w = wv[u]; a0 += sm[k] * w; a1 += sm[64 + k] * w; a2 += sm[128 + k] * w; a3 += sm[192 + k] * w; a4 += sm[256 + k] * w; }
    }
    float* dst = MODP + ((size_t)(ks * 2 + l) * 5) * 6144 + j;
    dst[0] = a0; dst[6144] = a1; dst[2 * 6144] = a2; dst[3 * 6144] = a3; dst[4 * 6144] = a4;
  }
  conv_weight(p, p.in[I_WIN], DIN, (bf16_t*)(p.ws + OFF_WTIN), 1024, WTIN_ROWS, 0, sm, bid, nb);
  for (int br = 0; br < 3; ++br) conv_weight(p, p.in[I_WBR] + (size_t)br * 512 * 1024, 1024, (bf16_t*)(p.ws + OFF_WTBR) + (size_t)br * 1024 * 512, 512, 1024, 1, sm, bid, nb);
}
DI void phase1(const Params& p) {
  const float* MODP = (const float*)(p.ws + OFF_MODP);
  float* MOD = (float*)(p.ws + OFF_MOD);
  for (int i = blockIdx.x * NTHR + ltid(); i < 2 * 5 * 6144; i += gridDim.x * NTHR) {
    const int j = i % 6144, l = i / (5 * 6144);
    float s = p.in[I_BADA][l * 6144 + j];
    for (int ks = 0; ks < 16; ++ks) s += MODP[(size_t)ks * 2 * 5 * 6144 + i];
    MOD[i] = s;
  }
}

DI void norm_mod_store(const f32x4 (&x)[4], const float* nw, const float* sc, const float* sh, bf16_t* hrow, int lane) {
  float ss = 0.f;
#pragma unroll
  for (int i = 0; i < 4; ++i) ss += x[i][0] * x[i][0] + x[i][1] * x[i][1] + x[i][2] * x[i][2] + x[i][3] * x[i][3];
  ss = wave_sum(ss, lane);
  const float rs = rsqrtf(ss * (1.0f / DM) + 1e-6f);
#pragma unroll
  for (int i = 0; i < 4; ++i) {
    const int c = i * 256 + lane * 4;
    f32x4 w = *(const f32x4*)(nw + c), s1 = *(const f32x4*)(sc + c), s0 = *(const f32x4*)(sh + c), o;
#pragma unroll
    for (int e = 0; e < 4; ++e) o[e] = x[i][e] * rs * w[e] * (1.0f + s1[e]) + s0[e];
    store_bf4(hrow + c, o);
  }
}
DI void tok_one(const Params& p, int l, int mode, int tok, int lane) {
  const float* MOD = (const float*)(p.ws + OFF_MOD);
  bf16_t* H = (bf16_t*)(p.ws + OFF_H);
  const float* Y = (const float*)(p.ws + OFF_Y);
  const int ci = tok_cond(tok);
  const float* modl = MOD + (size_t)(l * 5 + ci) * 6144;
  const float* nwl = p.in[I_NORMS] + (size_t)l * 4 * DM;
  const bool from_in = (l == 0 && (mode == 0 || mode == 1 || mode == 3));
  const float* xr = from_in ? x_in_row(p, tok) : p.out + (size_t)tok * DM;
  f32x4 x[4];
#pragma unroll
  for (int i = 0; i < 4; ++i) x[i] = *(const f32x4*)(xr + i * 256 + lane * 4);
  if (mode == 1 || mode == 2) {
    f32x4 y[4]; float ss = 0.f;
#pragma unroll
    for (int i = 0; i < 4; ++i) { y[i] = *(const f32x4*)(Y + (size_t)tok * DM + i * 256 + lane * 4); ss += y[i][0] * y[i][0] + y[i][1] * y[i][1] + y[i][2] * y[i][2] + y[i][3] * y[i][3]; }
    ss = wave_sum(ss, lane);
    const float rs = rsqrtf(ss * (1.0f / DM) + 1e-6f);
    const float* nw = nwl + (mode == 1 ? 1 : 3) * DM;
    const float* g = modl + (mode == 1 ? 2 : 5) * DM;
#pragma unroll
    for (int i = 0; i < 4; ++i) {
      const int c = i * 256 + lane * 4;
      f32x4 w = *(const f32x4*)(nw + c), gg = *(const f32x4*)(g + c);
#pragma unroll
      for (int e = 0; e < 4; ++e) x[i][e] += gg[e] * (y[i][e] * rs * w[e]);
      *(f32x4*)(p.out + (size_t)tok * DM + c) = x[i];
    }
  }
  if (mode == 0 || mode == 3) norm_mod_store(x, nwl, modl + 1 * DM, modl + 0 * DM, H + (size_t)tok * DM, lane);
  else if (mode == 1) norm_mod_store(x, nwl + 2 * DM, modl + 4 * DM, modl + 3 * DM, H + (size_t)tok * DM, lane);
  else if (mode == 2 && l + 1 < 2) {
    const float* modn = MOD + (size_t)((l + 1) * 5 + ci) * 6144;
    norm_mod_store(x, p.in[I_NORMS] + (size_t)(l + 1) * 4 * DM, modn + 1 * DM, modn + 0 * DM, H + (size_t)tok * DM, lane);
  }
}
DI void tok_phase(const Params& p, int l, int mode) {
  const int lane = ltid() & 63, gw = blockIdx.x * 4 + (ltid() >> 6), nw = gridDim.x * 4;
  for (int tok = gw; tok < NT; tok += nw) tok_one(p, l, mode, tok, lane);
}

DI bool tile_xcd(int i, int NTN, int MTX, int& mt, int& nt) {
  const int G = gridDim.x, b = blockIdx.x, x = b & 7, j = b >> 3, nbx = (G - x + 7) >> 3;
  const int u = j + i * nbx;
  if (u >= MTX * NTN) return false;
  mt = MTX * x + (u % MTX); nt = u / MTX;
  return true;
}
DI void phase_inproj(const Params& p, char* smem) {
  const bf16_t* H = (const bf16_t*)(p.ws + OFF_H);
  const bf16_t* WT = (const bf16_t*)(p.ws + OFF_WTIN);
  bf16_t* ZH = (bf16_t*)(p.ws + OFF_ZH); bf16_t* ZR = (bf16_t*)(p.ws + OFF_ZR); bf16_t* ZM = (bf16_t*)(p.ws + OFF_ZM);
  float* MG = (float*)(p.ws + OFF_MG);
  const int lane = ltid() & 63, w = ltid() >> 6, wm = w >> 1, wn = w & 1;
  int mt, nt;
  for (int ti = 0; tile_xcd(ti, 52, 8, mt, nt); ++ti) {
    f32x4 acc[8][4]; zero_acc<8, 4>(acc);
    gemm_main<256, 128, 32>(p, acc, H + (size_t)mt * 256 * 1024, 1024, WT + (size_t)nt * 128 * 1024, 1024, 1024, (bf16_t*)smem);
    const int n0 = nt * 128;
#pragma unroll
    for (int i = 0; i < 8; ++i) {
      const int row = mt * 256 + wm * 128 + i * 16 + (lane & 15);
#pragma unroll
      for (int j = 0; j < 4; ++j) {
        const int col = n0 + wn * 64 + j * 16 + 4 * (lane >> 4);
        if (n0 < 2560) store_bf4(ZH + (size_t)row * ZHW + col, acc[i][j]);
        else if (n0 < 4480) store_bf4(ZR + (size_t)row * ZRW + (col - 2560), acc[i][j]);
        else if (n0 < 6528) store_bf4(ZM + (size_t)row * ZMW + (col - 4480), acc[i][j]);
        else if (col - 6528 < 16) *(f32x4*)(MG + (size_t)row * 16 + (col - 6528)) = acc[i][j];
      }
    }
  }
}

DI void phase_merge(const Params& p, int l, char* smem) {
  const bf16_t* H = (const bf16_t*)(p.ws + OFF_H);
  const bf16_t* WT = (const bf16_t*)(p.ws + OFF_WTIN);
  const bf16_t* WBR = (const bf16_t*)(p.ws + OFF_WTBR);
  const bf16_t* ZH = (const bf16_t*)(p.ws + OFF_ZH); const bf16_t* ZM = (const bf16_t*)(p.ws + OFF_ZM); const bf16_t* O = (const bf16_t*)(p.ws + OFF_O);
  bf16_t* MER = (bf16_t*)(p.ws + OFF_MERGED);
  const int lane = ltid() & 63, w = ltid() >> 6, wm = w >> 1, wn = w & 1;
  int mt, nt;
  for (int ti = 0; tile_xcd(ti, 16, 16, mt, nt); ++ti) {
    f32x4 accM[4][2]; zero_acc<4, 2>(accM);
#pragma unroll 1
    for (int br = 0; br < 3; ++br) {
      f32x4 accG[4][2], accP[4][2]; zero_acc<4, 2>(accG); zero_acc<4, 2>(accP);
      gemm_main<128, 64, 64>(p, accG, H + (size_t)mt * 128 * 1024, 1024, WT + (size_t)(6656 + br * 1024 + nt * 64) * 1024, 1024, 1024, (bf16_t*)smem);
      const bf16_t* Ab; int lda;
      if (br == 0) { Ab = ZH + 2048; lda = ZHW; } else if (br == 1) { Ab = O; lda = 1024; } else { Ab = ZM + 1536; lda = ZMW; }
      gemm_main<128, 64, 64>(p, accP, Ab + (size_t)mt * 128 * lda, lda, WBR + ((size_t)br * 1024 + nt * 64) * 512, 512, 512, (bf16_t*)smem);
#pragma unroll
      for (int i = 0; i < 4; ++i)
#pragma unroll
        for (int j = 0; j < 2; ++j)
#pragma unroll
          for (int e = 0; e < 4; ++e) accM[i][j][e] += sigmoidf_(accG[i][j][e]) * accP[i][j][e];
    }
#pragma unroll
    for (int i = 0; i < 4; ++i) {
      const int row = mt * 128 + wm * 64 + i * 16 + (lane & 15);
#pragma unroll
      for (int j = 0; j < 2; ++j) store_bf4(MER + (size_t)row * 1024 + nt * 64 + wn * 32 + j * 16 + 4 * (lane >> 4), accM[i][j]);
    }
  }
  float* sm = (float*)smem;
  conv_weight(p, p.in[I_WOUT] + (size_t)l * 1024 * 1024, 1024, (bf16_t*)(p.ws + OFF_WTOUT), 1024, 1024, 1, sm, blockIdx.x, gridDim.x);
  conv_weight(p, p.in[I_WFI] + (size_t)l * 1024 * 5632, 5632, (bf16_t*)(p.ws + OFF_WTFI), 1024, 5632, 2, sm, blockIdx.x, gridDim.x);
  conv_weight(p, p.in[I_WFO] + (size_t)l * DFF * 1024, 1024, (bf16_t*)(p.ws + OFF_WTFO), DFF, 1024, 1, sm, blockIdx.x, gridDim.x);
}

DI void phase_gemm_f32(const Params& p, const bf16_t* A, int K, const bf16_t* Wt, char* smem) {
  float* Y = (float*)(p.ws + OFF_Y);
  const int lane = ltid() & 63, w = ltid() >> 6, wm = w >> 1, wn = w & 1;
  int mt, nt;
  for (int ti = 0; tile_xcd(ti, 8, 8, mt, nt); ++ti) {
    f32x4 acc[8][4]; zero_acc<8, 4>(acc);
    gemm_main<256, 128, 32>(p, acc, A + (size_t)mt * 256 * K, K, Wt + (size_t)nt * 128 * K, K, K, (bf16_t*)smem);
#pragma unroll
    for (int i = 0; i < 8; ++i) {
      const int row = mt * 256 + wm * 128 + i * 16 + (lane & 15);
#pragma unroll
      for (int j = 0; j < 4; ++j) *(f32x4*)(Y + (size_t)row * 1024 + nt * 128 + wn * 64 + j * 16 + 4 * (lane >> 4)) = acc[i][j];
    }
  }
}
DI void phase_ffn_in(const Params& p, char* smem) {
  const bf16_t* H = (const bf16_t*)(p.ws + OFF_H);
  const bf16_t* Wt = (const bf16_t*)(p.ws + OFF_WTFI);
  bf16_t* ACT = (bf16_t*)(p.ws + OFF_ACT);
  const int lane = ltid() & 63, w = ltid() >> 6, wm = w >> 1, wn = w & 1;
  int mt, nt;
  for (int ti = 0; tile_xcd(ti, 44, 8, mt, nt); ++ti) {
    f32x4 acc[8][4]; zero_acc<8, 4>(acc);
    gemm_main<256, 128, 32>(p, acc, H + (size_t)mt * 256 * 1024, 1024, Wt + (size_t)nt * 128 * 1024, 1024, 1024, (bf16_t*)smem);
#pragma unroll
    for (int i = 0; i < 8; ++i) {
      const int row = mt * 256 + wm * 128 + i * 16 + (lane & 15);
#pragma unroll
      for (int jj = 0; jj < 2; ++jj) {
        f32x4 u = acc[i][2 * jj], g = acc[i][2 * jj + 1], o;
#pragma unroll
        for (int e = 0; e < 4; ++e) o[e] = siluf_(g[e]) * u[e];
        const int col = (nt * 128 + wn * 64 + jj * 32) / 2 + 4 * (lane >> 4);
        store_bf4(ACT + (size_t)row * DFF + col, o);
      }
    }
  }
}

struct Seq { int base, T, grid, b; bool sample; };
DI Seq get_seq(int s) { Seq q; if (s < 32) { q.base = s * 256; q.T = 256; q.grid = 0; q.b = s; q.sample = false; } else { q.b = s - 32; q.base = 8192 + q.b * 2048; q.T = 2048; q.grid = 1; q.sample = true; } return q; }

DI float rw_shift(const bf16_t* ZR, const float* mu, int base, int t, int T, int grid, int col) {
  const bf16_t* pp = ZR + (size_t)(base + t) * ZRW + col;
  const float y = bf2f(*pp);
  if (!grid) {
    const float prev = t > 0 ? bf2f(pp[-ZRW]) : 0.f, nxt = t < T - 1 ? bf2f(pp[ZRW]) : 0.f;
    return y + mu[col] * (prev - y) + mu[ZRW + col] * (nxt - y);
  }
  const int gc = t & 63, gr = t >> 6;
  const float left = gc > 0 ? bf2f(pp[-ZRW]) : 0.f, right = gc < 63 ? bf2f(pp[ZRW]) : 0.f;
  const float up = gr > 0 ? bf2f(pp[-64 * ZRW]) : 0.f, down = gr < 31 ? bf2f(pp[64 * ZRW]) : 0.f;
  return y + mu[col] * (left - y) + mu[ZRW + col] * (right - y) + mu[2 * ZRW + col] * (up - y) + mu[3 * ZRW + col] * (down - y);
}

DI void rw_shift8(const bf16_t* ZR, const float* mu, int base, int t, int T, int grid, int col0, float (&out)[8]) {
  const bf16_t* pp = ZR + (size_t)(base + t) * ZRW + col0;
  const bf16x8 y = *(const bf16x8*)pp;
  float yv[8];
#pragma unroll
  for (int e = 0; e < 8; ++e) { yv[e] = bf2f((bf16_t)y[e]); out[e] = yv[e]; }
  const int nn = grid ? 4 : 2;
#pragma unroll 1
  for (int n = 0; n < nn; ++n) {
    bool valid; int off;
    if (!grid) { valid = n == 0 ? t > 0 : t < T - 1; off = n == 0 ? -ZRW : ZRW; }
    else { const int gc = t & 63, gr = t >> 6; valid = n == 0 ? gc > 0 : n == 1 ? gc < 63 : n == 2 ? gr > 0 : gr < 31; off = n == 0 ? -ZRW : n == 1 ? ZRW : n == 2 ? -64 * ZRW : 64 * ZRW; }
    const f32x4 m0 = *(const f32x4*)(mu + n * ZRW + col0), m1 = *(const f32x4*)(mu + n * ZRW + col0 + 4);
    bf16x8 nb = y;
    if (valid) nb = *(const bf16x8*)(pp + off);
#pragma unroll
    for (int e = 0; e < 8; ++e) { const float nv_ = valid ? bf2f((bf16_t)nb[e]) : 0.f; const float mm = e < 4 ? m0[e & 3] : m1[e & 3]; out[e] += mm * (nv_ - yv[e]); }
  }
}

DI void rw_load8(const bf16_t* ZR, int base, int t, int T, int grid, int col0, bf16x8 (&v)[5]) {
  const bf16_t* pp = ZR + (size_t)(base + t) * ZRW + col0;
  const bf16x8 z = (bf16x8){0, 0, 0, 0, 0, 0, 0, 0};
  v[0] = *(const bf16x8*)pp;
  if (!grid) {
    v[1] = t > 0 ? *(const bf16x8*)(pp - ZRW) : z; v[2] = t < T - 1 ? *(const bf16x8*)(pp + ZRW) : z; v[3] = z; v[4] = z;
  } else {
    const int gc = t & 63, gr = t >> 6;
    v[1] = gc > 0 ? *(const bf16x8*)(pp - ZRW) : z; v[2] = gc < 63 ? *(const bf16x8*)(pp + ZRW) : z;
    v[3] = gr > 0 ? *(const bf16x8*)(pp - 64 * ZRW) : z; v[4] = gr < 31 ? *(const bf16x8*)(pp + 64 * ZRW) : z;
  }
}
DI void rw_apply8(const bf16x8 (&v)[5], const float* mu, int grid, int col0, float (&out)[8]) {
  float yv[8];
#pragma unroll
  for (int e = 0; e < 8; ++e) { yv[e] = bf2f((bf16_t)v[0][e]); out[e] = yv[e]; }
#pragma unroll
  for (int n = 0; n < 4; ++n) {
    if (n < 2 || grid) {
      const f32x4 m0 = *(const f32x4*)(mu + n * ZRW + col0), m1 = *(const f32x4*)(mu + n * ZRW + col0 + 4);
#pragma unroll
      for (int e = 0; e < 8; ++e) out[e] += (e < 4 ? m0[e & 3] : m1[e & 3]) * (bf2f((bf16_t)v[1 + n][e]) - yv[e]);
    }
  }
}

DI float dpp_ror8(float x) { return __int_as_float(__builtin_amdgcn_mov_dpp(__float_as_int(x), 0x128, 0xF, 0xF, true)); }
DI float dpp_ror4(float x) { return __int_as_float(__builtin_amdgcn_mov_dpp(__float_as_int(x), 0x124, 0xF, 0xF, true)); }
DI float dpp_hmirror(float x) { return __int_as_float(__builtin_amdgcn_mov_dpp(__float_as_int(x), 0x141, 0xF, 0xF, true)); }
DI float fast_tanh(float x) { return 1.0f - 2.0f / (1.0f + __expf(2.0f * x)); }

DI void rw_apply8_lds(const bf16x8 (&v)[5], const float* mu5c, const float* c0c, int grid, float (&out)[8]) {
  {
    const f32x4 c0 = *(const f32x4*)c0c, c1 = *(const f32x4*)(c0c + 4);
#pragma unroll
    for (int e = 0; e < 8; ++e) out[e] = bf2f((bf16_t)v[0][e]) * (e < 4 ? c0[e & 3] : c1[e & 3]);
  }
#pragma unroll
  for (int n = 0; n < 4; ++n) {
    if (n < 2 || grid) {
      const f32x4 m0 = *(const f32x4*)(mu5c + n * 320), m1 = *(const f32x4*)(mu5c + n * 320 + 4);
#pragma unroll
      for (int e = 0; e < 8; ++e) out[e] += (e < 4 ? m0[e & 3] : m1[e & 3]) * bf2f((bf16_t)v[1 + n][e]);
    }
  }
}
template <int N> DI float dpp_row_shr0(float x) { return __int_as_float(__builtin_amdgcn_update_dpp(0, __float_as_int(x), 0x110 + N, 0xF, 0xF, false)); }

DI void rwkv_item(const Params& p, int l, int s, int hh, int d, char* smem) {
  const Seq q = get_seq(s);
  const int tid0 = ltid();
  const int w = __builtin_amdgcn_readfirstlane(tid0 >> 6), vb = w >> 1, kb = w & 1;
  int tid = tid0, lane = tid & 63, l15 = lane & 15, qq = lane >> 4, r32 = lane & 31, h = lane >> 5;
  const bf16_t* ZR = (const bf16_t*)(p.ws + OFF_ZR);
  bf16_t* O = (bf16_t*)(p.ws + OFF_O);
  const float* mu = p.in[I_MU] + (size_t)l * 4 * ZRW;
  bf16_t* KHr = (bf16_t*)smem;
  bf16_t* BCr = KHr + 16 * 72;
  bf16_t* KC = BCr + 16 * 72;
  bf16_t* RH = KC + 16 * 72;
  bf16_t* Sb = RH + 16 * 72;
  bf16_t* Wb2 = (bf16_t*)smem;
  bf16_t* Ab2 = Wb2 + 64 * 72;
  float* mu5 = (float*)(smem + 18432);
  bf16_t* actW = (bf16_t*)(smem + 23552);
  bf16_t* actA = actW + 16 * 72;
  float* shR = (float*)(smem + 28160);
  float* shK = shR + 1024; float* shV = shK + 1024;
  bf16_t* VT = (bf16_t*)(smem + 40448);
  bf16_t* UNT = VT + 64 * 40;
  bf16_t* KBT = UNT + 64 * 40;
  bf16_t* BBT = KBT + 64 * 24;
  float* PL = (float*)(smem + 56832);
  float* npart = PL + 64;
  float* MN = (float*)(smem + 57344);
  float* G0 = (float*)(smem + 61440);
  bf16_t* ArkM = (bf16_t*)(smem + 65536);
  bf16_t* ArbM = ArkM + 16 * 40;
  float* c0t = (float*)(smem + 68096);
  __syncthreads();
  for (int e = tid; e < 4096; e += NTHR) {
    const int i = e >> 6, c = e & 63;
    Wb2[c * 72 + i] = f2bf(p.in[I_W2][((size_t)(l * 2 + d) * 64 + i) * 512 + 64 * hh + c]);
    Ab2[c * 72 + i] = f2bf(p.in[I_A2][((size_t)(l * 2 + d) * 64 + i) * 512 + 64 * hh + c]);
  }
  for (int e = tid; e < 1280; e += NTHR) {
    const int n = e / 320, rem = e % 320, arr = rem >> 6, c = rem & 63;
    const int col = arr == 0 ? 64 * hh + c : arr == 1 ? 512 + 64 * hh + c : arr == 2 ? 1024 + 64 * hh + c : arr == 3 ? 1536 + 64 * d + c : 1664 + 64 * d + c;
    mu5[e] = mu[n * ZRW + col];
  }
  for (int e = tid; e < 320; e += NTHR) {
    const int arr = e >> 6, c = e & 63;
    const int col = arr == 0 ? 64 * hh + c : arr == 1 ? 512 + 64 * hh + c : arr == 2 ? 1024 + 64 * hh + c : arr == 3 ? 1536 + 64 * d + c : 1664 + 64 * d + c;
    float sm_ = mu[col] + mu[ZRW + col];
    if (q.grid) sm_ += mu[2 * ZRW + col] + mu[3 * ZRW + col];
    c0t[e] = 1.0f - sm_;
  }
  const int cB0 = 16 * w + 4 * qq;
  float w0c[4], a0c[4], kkc[4], kac[4];
#pragma unroll
  for (int g = 0; g < 4; ++g) {
    w0c[g] = p.in[I_W0][(l * 2 + d) * 512 + 64 * hh + cB0 + g]; a0c[g] = p.in[I_A0][(l * 2 + d) * 512 + 64 * hh + cB0 + g];
    kkc[g] = p.in[I_KK][l * 512 + 64 * hh + cB0 + g]; kac[g] = p.in[I_KA][l * 512 + 64 * hh + cB0 + g];
  }
  f32x16 S;
  if (q.sample) {
    const float* st = p.in[I_SR] + ((((size_t)q.b * 2 + l) * 2 + d) * 8 + hh) * 4096;
#pragma unroll
    for (int g = 0; g < 16; ++g) S[g] = st[(32 * vb + crow(g, h)) * 64 + 32 * kb + r32];
  } else {
#pragma unroll
    for (int g = 0; g < 16; ++g) S[g] = 0.f;
  }
  __syncthreads();
  bf16x8 bW[2], bA[2];
#pragma unroll
  for (int ks = 0; ks < 2; ++ks) { bW[ks] = *(const bf16x8*)(Wb2 + (16 * w + l15) * 72 + ks * 32 + qq * 8); bA[ks] = *(const bf16x8*)(Ab2 + (16 * w + l15) * 72 + ks * 32 + qq * 8); }
  __syncthreads();
  for (int e = tid; e < (2 * 64 * 40 + 2 * 64 * 24) / 2; e += NTHR) ((unsigned*)VT)[e] = 0u;
  for (int e = tid; e < (2 * 16 * 40) / 2; e += NTHR) ((unsigned*)ArkM)[e] = 0u;
  const int nch = q.T / 16;
  bf16x8 pf[3][5];
#define RW_COL(arr, c8) ((arr) == 0 ? 64 * hh + (c8) : (arr) == 1 ? 512 + 64 * hh + (c8) : (arr) == 2 ? 1024 + 64 * hh + (c8) : (arr) == 3 ? 1536 + 64 * d + (c8) : 1664 + 64 * d + (c8))
#define RW_ISSUE(chn) { _Pragma("unroll") for (int gi = 0; gi < 3; ++gi) { const int g = tid + gi * NTHR; if (g < 640) { \
      const int arr = g >> 7, rem = g & 127, j = rem >> 3, c8 = (rem & 7) * 8; const int pos = (chn) * 16 + j, t = d ? q.T - 1 - pos : pos; \
      rw_load8(ZR, q.base, t, q.T, q.grid, RW_COL(arr, c8), pf[gi]); } } }
  RW_ISSUE(0)
#pragma unroll 1
  for (int ch = 0; ch < nch; ++ch) {
    tid = tid0; asm volatile("" : "+v"(tid));
    lane = tid & 63; l15 = lane & 15; qq = lane >> 4; r32 = lane & 31; h = lane >> 5;
    __syncthreads();
#pragma unroll
    for (int gi = 0; gi < 3; ++gi) {
      const int g = tid + gi * NTHR;
      if (g < 640) {
        const int arr = g >> 7, rem = g & 127, j = rem >> 3, c8 = (rem & 7) * 8;
        float val[8];
        rw_apply8_lds(pf[gi], mu5 + arr * 64 + c8, c0t + arr * 64 + c8, q.grid, val);
        if (arr < 3) {
          *(f32x4*)(shR + arr * 1024 + j * 64 + c8) = (f32x4){val[0], val[1], val[2], val[3]};
          *(f32x4*)(shR + arr * 1024 + j * 64 + c8 + 4) = (f32x4){val[4], val[5], val[6], val[7]};
          if (arr == 2) {
#pragma unroll
            for (int e = 0; e < 8; ++e) VT[(c8 + e) * 40 + j] = f2bf(val[e]);
          }
        } else {
          bf16x8 o8;
#pragma unroll
          for (int e = 0; e < 8; ++e) o8[e] = (short)f2bf(arr == 3 ? fast_tanh(val[e]) : val[e]);
          *(bf16x8*)((arr == 3 ? actW : actA) + j * 72 + c8) = o8;
        }
      }
    }
    if (ch + 1 < nch) RW_ISSUE(ch + 1)
    __syncthreads();
    {
      f32x4 aw = (f32x4){0.f, 0.f, 0.f, 0.f}, aa = (f32x4){0.f, 0.f, 0.f, 0.f};
#pragma unroll
      for (int ks = 0; ks < 2; ++ks) {
        const bf16x8 fw = *(const bf16x8*)(actW + l15 * 72 + ks * 32 + qq * 8);
        const bf16x8 fa = *(const bf16x8*)(actA + l15 * 72 + ks * 32 + qq * 8);
        aw = __builtin_amdgcn_mfma_f32_16x16x32_bf16(bW[ks], fw, aw, 0, 0, 0);
        aa = __builtin_amdgcn_mfma_f32_16x16x32_bf16(bA[ks], fa, aa, 0, 0, 0);
      }
      const f32x4 kv = *(const f32x4*)(shK + l15 * 64 + cB0), rv = *(const f32x4*)(shR + l15 * 64 + cB0);
      float lw[4], av[4], kkr[4], kd[4], Lp[4], LpL[4];
      float ssq = 0.f;
#pragma unroll
      for (int g = 0; g < 4; ++g) {
        const float wl = aw[g] + w0c[g], al = aa[g] + a0c[g];
        lw[g] = -__expf(-softplusf_(-wl) - 0.5f);
        av[g] = sigmoidf_(al);
        kkr[g] = kv[g] * kkc[g];
        kd[g] = kv[g] * (1.0f + (av[g] - 1.0f) * kac[g]);
        ssq += kkr[g] * kkr[g];
        float x = lw[g];
        x += dpp_row_shr0<1>(x); x += dpp_row_shr0<2>(x); x += dpp_row_shr0<4>(x); x += dpp_row_shr0<8>(x);
        Lp[g] = x;
      }
#pragma unroll
      for (int g = 0; g < 4; ++g) LpL[g] = shfl_lane(Lp[g], (lane & 48) | 15);
      ssq += SHX(ssq, 16); ssq += SHX(ssq, 32);
      if (qq == 0) npart[w * 16 + l15] = ssq;
      float e_m1[4], e_neg[4], e_pos[4], e_end[4];
#pragma unroll
      for (int g = 0; g < 4; ++g) { e_m1[g] = __expf(Lp[g] - lw[g]); e_neg[g] = __expf(-Lp[g]); e_pos[g] = __expf(Lp[g]); e_end[g] = __expf(LpL[g] - Lp[g]); }
      *(u32x2*)(KHr + l15 * 72 + cB0) = (u32x2){pk2(kkr[0] * e_m1[0], kkr[1] * e_m1[1]), pk2(kkr[2] * e_m1[2], kkr[3] * e_m1[3])};
      *(u32x2*)(BCr + l15 * 72 + cB0) = (u32x2){pk2(kkr[0] * av[0] * e_neg[0], kkr[1] * av[1] * e_neg[1]), pk2(kkr[2] * av[2] * e_neg[2], kkr[3] * av[3] * e_neg[3])};
      *(u32x2*)(KC + l15 * 72 + cB0) = (u32x2){pk2(kd[0] * e_neg[0], kd[1] * e_neg[1]), pk2(kd[2] * e_neg[2], kd[3] * e_neg[3])};
      *(u32x2*)(RH + l15 * 72 + cB0) = (u32x2){pk2(rv[0] * e_pos[0], rv[1] * e_pos[1]), pk2(rv[2] * e_pos[2], rv[3] * e_pos[3])};
#pragma unroll
      for (int g = 0; g < 4; ++g) {
        KBT[(cB0 + g) * 24 + l15] = f2bf(kd[g] * e_end[g]);
        BBT[(cB0 + g) * 24 + l15] = f2bf(kkr[g] * av[g] * e_end[g]);
      }
      if (l15 == 15) *(f32x4*)(PL + cB0) = (f32x4){e_pos[0], e_pos[1], e_pos[2], e_pos[3]};
#pragma unroll
      for (int g = 0; g < 16; ++g) Sb[(32 * vb + crow(g, h)) * 72 + 32 * kb + r32] = f2bf(S[g]);
    }
    __syncthreads();
    f32x4 oacc = (f32x4){0.f, 0.f, 0.f, 0.f};
    {
      const bf16_t* Aop = (w < 2) ? KHr : RH;
      const bf16_t* Bop = (w == 0 || w == 3) ? BCr : KC;
      f32x4 t16 = (f32x4){0.f, 0.f, 0.f, 0.f}, g0 = (f32x4){0.f, 0.f, 0.f, 0.f};
#pragma unroll
      for (int ks = 0; ks < 2; ++ks) {
        const bf16x8 a = *(const bf16x8*)(Aop + l15 * 72 + ks * 32 + qq * 8);
        const bf16x8 b = *(const bf16x8*)(Bop + l15 * 72 + ks * 32 + qq * 8);
        t16 = __builtin_amdgcn_mfma_f32_16x16x32_bf16(a, b, t16, 0, 0, 0);
        const bf16x8 akh = *(const bf16x8*)(KHr + l15 * 72 + ks * 32 + qq * 8);
        const bf16x8 arh = *(const bf16x8*)(RH + l15 * 72 + ks * 32 + qq * 8);
        const bf16x8 bs = *(const bf16x8*)(Sb + (16 * w + l15) * 72 + ks * 32 + qq * 8);
        g0 = __builtin_amdgcn_mfma_f32_16x16x32_bf16(akh, bs, g0, 0, 0, 0);
        oacc = __builtin_amdgcn_mfma_f32_16x16x32_bf16(arh, bs, oacc, 0, 0, 0);
      }
#pragma unroll
      for (int g = 0; g < 4; ++g) G0[(4 * qq + g) * 64 + 16 * w + l15] = g0[g];
      *(f32x4*)(MN + w * 256 + l15 * 16 + 4 * qq) = t16;
    }
    __syncthreads();
    if (w == 0) {
      const float* MrT = MN; const float* NrT = MN + 256;
      float acc[16];
#pragma unroll
      for (int t = 0; t < 16; ++t) acc[t] = G0[t * 64 + lane];
      f32x4 nr[4], mr[4]; float vvj, n2s;
#pragma unroll
      for (int t4 = 0; t4 < 4; ++t4) { nr[t4] = *(const f32x4*)(NrT + 4 * t4); mr[t4] = *(const f32x4*)(MrT + 4 * t4); }
      vvj = shV[lane]; n2s = npart[0] + npart[16] + npart[32] + npart[48];
#pragma unroll
      for (int j = 0; j < 16; ++j) {
        f32x4 nrn[4], mrn[4]; float vvn = 0.f, n2n = 1.f;
#pragma unroll
        for (int t4 = 0; t4 < 4; ++t4) { nrn[t4] = (f32x4){0.f, 0.f, 0.f, 0.f}; mrn[t4] = (f32x4){0.f, 0.f, 0.f, 0.f}; }
        if (j + 1 < 16) {
#pragma unroll
          for (int t4 = 0; t4 < 4; ++t4) if (4 * t4 + 3 > j + 1) { nrn[t4] = *(const f32x4*)(NrT + (j + 1) * 16 + 4 * t4); mrn[t4] = *(const f32x4*)(MrT + (j + 1) * 16 + 4 * t4); }
          vvn = shV[(j + 1) * 64 + lane]; n2n = npart[j + 1] + npart[16 + j + 1] + npart[32 + j + 1] + npart[48 + j + 1];
        }
        const float unj = -acc[j] / fmaxf(n2s, 1e-24f);
        UNT[lane * 40 + j] = f2bf(unj);
#pragma unroll
        for (int t4 = 0; t4 < 4; ++t4)
#pragma unroll
          for (int e = 0; e < 4; ++e) if (4 * t4 + e > j) acc[4 * t4 + e] += nr[t4][e] * vvj + mr[t4][e] * unj;
#pragma unroll
        for (int t4 = 0; t4 < 4; ++t4) { nr[t4] = nrn[t4]; mr[t4] = mrn[t4]; }
        vvj = vvn; n2s = n2n;
        __builtin_amdgcn_sched_barrier(0);
      }
    } else if (w < 3) {
      const float* src = MN + (w == 1 ? 512 : 768);
      bf16_t* dst = (w == 1) ? ArkM : ArbM;
#pragma unroll
      for (int i = 0; i < 4; ++i) { const int e = lane + 64 * i, j = e >> 4, t = e & 15; dst[t * 40 + j] = f2bf(j <= t ? src[e] : 0.f); }
    }
    __syncthreads();
    {
      const bf16x8 ak = *(const bf16x8*)(ArkM + l15 * 40 + qq * 8), ab = *(const bf16x8*)(ArbM + l15 * 40 + qq * 8);
      const bf16x8 bv = *(const bf16x8*)(VT + (16 * w + l15) * 40 + qq * 8), bu = *(const bf16x8*)(UNT + (16 * w + l15) * 40 + qq * 8);
      oacc = __builtin_amdgcn_mfma_f32_16x16x32_bf16(ak, bv, oacc, 0, 0, 0);
      oacc = __builtin_amdgcn_mfma_f32_16x16x32_bf16(ab, bu, oacc, 0, 0, 0);
#pragma unroll
      for (int g = 0; g < 4; ++g) {
        const int pos = ch * 16 + 4 * qq + g, t = d ? q.T - 1 - pos : pos;
        O[(size_t)(q.base + t) * 1024 + d * 512 + 64 * hh + 16 * w + l15] = f2bf(oacc[g]);
      }
      const float pl = PL[32 * kb + r32];
#pragma unroll
      for (int g = 0; g < 16; ++g) S[g] *= pl;
      const bf16x8 av_ = *(const bf16x8*)(VT + (32 * vb + r32) * 40 + 8 * h), au_ = *(const bf16x8*)(UNT + (32 * vb + r32) * 40 + 8 * h);
      const bf16x8 bk_ = *(const bf16x8*)(KBT + (32 * kb + r32) * 24 + 8 * h), bb_ = *(const bf16x8*)(BBT + (32 * kb + r32) * 24 + 8 * h);
      S = __builtin_amdgcn_mfma_f32_32x32x16_bf16(av_, bk_, S, 0, 0, 0);
      S = __builtin_amdgcn_mfma_f32_32x32x16_bf16(au_, bb_, S, 0, 0, 0);
    }
  }
  if (!q.sample) {
    float* dst = p.out + OUT_RW + ((((size_t)q.b * 2 + l) * 2 + d) * 8 + hh) * 4096;
#pragma unroll
    for (int g = 0; g < 16; ++g) dst[(32 * vb + crow(g, h)) * 64 + 32 * kb + r32] = S[g];
  }
}

DI void hgrn_item(const Params& p, int l, int s, int hh, int d, char* smem) {
  const Seq q = get_seq(s);
  const int tid = ltid(), lane = tid & 63, w = tid >> 6, r = lane & 31, h = lane >> 5;
  bf16_t* ZH = (bf16_t*)(p.ws + OFF_ZH);
  bf16_t* Qt = (bf16_t*)smem;
  bf16_t* Kt = Qt + 32 * 136;
  bf16_t* KhT = Kt + 32 * 136;
  bf16_t* VT = KhT + 128 * 40;
  bf16_t* Sb = VT + 128 * 40;
  bf16_t* At = Sb + 4 * 32 * 136;
  float* dL = (float*)(At + 32 * 40);
  float* tot = dL + 128;
  const float lb = ((const float*)(p.ws + OFF_LBS))[l * 512 + 128 * hh + (tid & 127)];
  f32x16 S[4];
  if (q.sample) {
    const float* st = p.in[I_SH] + ((((size_t)q.b * 2 + l) * 2 + d) * 4 + hh) * 16384;
#pragma unroll
    for (int kb = 0; kb < 4; ++kb)
#pragma unroll
      for (int g = 0; g < 16; ++g) S[kb][g] = st[(size_t)(32 * kb + crow(g, h)) * 128 + 32 * w + r];
  } else {
#pragma unroll
    for (int kb = 0; kb < 4; ++kb)
#pragma unroll
      for (int g = 0; g < 16; ++g) S[kb][g] = 0.f;
  }
  const int k = tid & 127, half = tid >> 7;
  const int nch = q.T / 32;
  u16x2 pzq[16], pv2[8];
#define HG_ISSUE(chn) { _Pragma("unroll") for (int jj = 0; jj < 16; ++jj) { const int pos = (chn) * 32 + half * 16 + jj, t = d ? q.T - 1 - pos : pos; \
      const size_t rowo = (size_t)(q.base + t) * ZHW + 128 * hh + k; pzq[jj][0] = ZH[rowo + 512 * (1 + d)]; pzq[jj][1] = ZH[rowo]; pv2[jj >> 1][jj & 1] = ZH[rowo + 1536]; } }
  HG_ISSUE(0)
#pragma unroll 1
  for (int ch = 0; ch < nch; ++ch) {
    __syncthreads();
    float bl[16], kc[16], qs[16];
    {
      float b = 0.f;
#pragma unroll
      for (int jj = 0; jj < 16; ++jj) {
        const float z = bf2f(pzq[jj][0]);
        const float kcoef = (1.0f - lb) * sigmoidf_(-z);
        const float f = 1.0f - kcoef;
        b += fmaxf(__logf(f), -80.f);
        bl[jj] = b; kc[jj] = kcoef; qs[jj] = bf2f(pzq[jj][1]) * 0.08838834764831845f;
      }
      *(u32x4*)(VT + k * 40 + half * 16) = (u32x4){__builtin_bit_cast(unsigned, pv2[0]), __builtin_bit_cast(unsigned, pv2[1]), __builtin_bit_cast(unsigned, pv2[2]), __builtin_bit_cast(unsigned, pv2[3])};
      *(u32x4*)(VT + k * 40 + half * 16 + 8) = (u32x4){__builtin_bit_cast(unsigned, pv2[4]), __builtin_bit_cast(unsigned, pv2[5]), __builtin_bit_cast(unsigned, pv2[6]), __builtin_bit_cast(unsigned, pv2[7])};
      tot[half * 128 + k] = b;
    }
    if (ch + 1 < nch) HG_ISSUE(ch + 1)
    __syncthreads();
    {
      const float off = half ? tot[k] : 0.f;
      const float bL = fmaxf(tot[k] + tot[128 + k], -80.f);
      if (half == 0) dL[k] = __expf(bL);
      float kh[16];
#pragma unroll
      for (int jj = 0; jj < 16; ++jj) {
        const int j = half * 16 + jj;
        const float bj = fmaxf(off + bl[jj], -80.f);
        Qt[j * 136 + k] = f2bf(qs[jj] * __expf(bj));
        Kt[j * 136 + k] = f2bf(kc[jj] * __expf(-bj));
        kh[jj] = kc[jj] * __expf(fminf(bL - bj, 0.f));
      }
      *(u32x4*)(KhT + k * 40 + half * 16) = (u32x4){pk2(kh[0], kh[1]), pk2(kh[2], kh[3]), pk2(kh[4], kh[5]), pk2(kh[6], kh[7])};
      *(u32x4*)(KhT + k * 40 + half * 16 + 8) = (u32x4){pk2(kh[8], kh[9]), pk2(kh[10], kh[11]), pk2(kh[12], kh[13]), pk2(kh[14], kh[15])};
    }
    bf16_t* Sbw = Sb + w * 32 * 136;
#pragma unroll
    for (int kb = 0; kb < 4; ++kb)
#pragma unroll
      for (int g4 = 0; g4 < 4; ++g4) *(u32x2*)(Sbw + r * 136 + 32 * kb + crow(4 * g4, h)) = (u32x2){pk2(S[kb][4 * g4], S[kb][4 * g4 + 1]), pk2(S[kb][4 * g4 + 2], S[kb][4 * g4 + 3])};
    __syncthreads();
    bf16_t* Atw = At;
    {
      f32x16 A;
#pragma unroll
      for (int g = 0; g < 16; ++g) A[g] = 0.f;
      mma32(A, Qt, 136, Kt, 136, 128, lane);
#pragma unroll
      for (int g = 0; g < 16; ++g) { const int t = crow(g, h); Atw[t * 40 + r] = f2bf(r <= t ? A[g] : 0.f); }
    }
    __syncthreads();
    {
      f32x16 o;
#pragma unroll
      for (int g = 0; g < 16; ++g) o[g] = 0.f;
      mma32(o, Atw, 40, VT + 32 * w * 40, 40, 32, lane);
      mma32(o, Qt, 136, Sbw, 136, 128, lane);
#pragma unroll
      for (int g = 0; g < 16; ++g) {
        const int j = crow(g, h), pos = ch * 32 + j, t = d ? q.T - 1 - pos : pos;
        ZH[(size_t)(q.base + t) * ZHW + 512 * (1 + d) + 128 * hh + 32 * w + r] = f2bf(o[g]);
      }
#pragma unroll
      for (int kb = 0; kb < 4; ++kb) {
#pragma unroll
        for (int g = 0; g < 16; ++g) S[kb][g] *= dL[32 * kb + crow(g, h)];
        mma32(S[kb], KhT + 32 * kb * 40, 40, VT + 32 * w * 40, 40, 32, lane);
      }
    }
  }
  if (!q.sample) {
    float* dst = p.out + OUT_HG + ((((size_t)q.b * 2 + l) * 2 + d) * 4 + hh) * 16384;
#pragma unroll
    for (int kb = 0; kb < 4; ++kb)
#pragma unroll
      for (int g = 0; g < 16; ++g) dst[(size_t)(32 * kb + crow(g, h)) * 128 + 32 * w + r] = S[kb][g];
  }
}

DI void mlstm_item(const Params& p, int l, int s, int hh, int d, char* smem) {
  const Seq q = get_seq(s);
  const int tid = ltid(), lane = tid & 63, w = tid >> 6, r = lane & 31, h = lane >> 5;
  const bf16_t* ZM = (const bf16_t*)(p.ws + OFF_ZM);
  const float* MG = (const float*)(p.ws + OFF_MG);
  bf16_t* Hb = (bf16_t*)(p.ws + OFF_H);
  bf16_t* Qm = (bf16_t*)smem;
  bf16_t* Km = Qm + 32 * 136;
  bf16_t* KwT = Km + 32 * 136;
  bf16_t* VT = KwT + 128 * 40;
  bf16_t* Cb = VT + 128 * 40;
  bf16_t* Pt = Cb + 4 * 32 * 136;
  float* nv = (float*)(Pt + 32 * 40);
  float* sc = nv + 128;
  float* ig = sc; float* lf = sc + 32; float* gg = sc + 64; float* mtv = sc + 96; float* wi = sc + 128; float* wsr = sc + 160; float* qn = sc + 192; float* misc = sc + 224;
  float* dnw = sc + 232;
  const float gbi = p.in[I_GB][l * 16 + (2 * d) * 4 + hh], gbf = p.in[I_GB][l * 16 + (2 * d + 1) * 4 + hh];
  f32x16 C[4];
  float m;
  __syncthreads();
  if (q.sample) {
    const size_t sb = (((size_t)q.b * 2 + l) * 2 + d) * 4 + hh;
    const float* st = p.in[I_SC] + sb * 16384;
#pragma unroll
    for (int kb = 0; kb < 4; ++kb)
#pragma unroll
      for (int g = 0; g < 16; ++g) C[kb][g] = st[(size_t)(32 * kb + crow(g, h)) * 128 + 32 * w + r];
    if (tid < 128) nv[tid] = p.in[I_SN][sb * 128 + tid];
    m = p.in[I_SM][sb];
  } else {
#pragma unroll
    for (int kb = 0; kb < 4; ++kb)
#pragma unroll
      for (int g = 0; g < 16; ++g) C[kb][g] = 0.f;
    if (tid < 128) nv[tid] = 0.f;
    m = 0.f;
  }
  const int nch = q.T / 32;
  const int dd = tid & 127, half = tid >> 7;
  u16x2 pqk[16], pv2[8]; float pgi = 0.f, pgf = 0.f;
#define ML_ISSUE(chn) { _Pragma("unroll") for (int jj = 0; jj < 16; ++jj) { const int pos = (chn) * 32 + half * 16 + jj, t = d ? q.T - 1 - pos : pos; \
      const size_t rowo = (size_t)(q.base + t) * ZMW + 128 * hh + dd; pqk[jj][0] = ZM[rowo]; pqk[jj][1] = ZM[rowo + 512]; pv2[jj >> 1][jj & 1] = ZM[rowo + 1024]; } \
    if (tid < 32) { const int pos = (chn) * 32 + tid, t = d ? q.T - 1 - pos : pos; const float* mg = MG + (size_t)(q.base + t) * 16; pgi = mg[(2 * d) * 4 + hh]; pgf = mg[(2 * d + 1) * 4 + hh]; } }
  ML_ISSUE(0)
#pragma unroll 1
  for (int ch = 0; ch < nch; ++ch) {
    __syncthreads();
    {
#pragma unroll
      for (int jj = 0; jj < 16; ++jj) {
        const int j = half * 16 + jj;
        Qm[j * 136 + dd] = pqk[jj][0];
        Km[j * 136 + dd] = f2bf(bf2f(pqk[jj][1]) * 0.08838834764831845f);
      }
      *(u32x4*)(VT + dd * 40 + half * 16) = (u32x4){__builtin_bit_cast(unsigned, pv2[0]), __builtin_bit_cast(unsigned, pv2[1]), __builtin_bit_cast(unsigned, pv2[2]), __builtin_bit_cast(unsigned, pv2[3])};
      *(u32x4*)(VT + dd * 40 + half * 16 + 8) = (u32x4){__builtin_bit_cast(unsigned, pv2[4]), __builtin_bit_cast(unsigned, pv2[5]), __builtin_bit_cast(unsigned, pv2[6]), __builtin_bit_cast(unsigned, pv2[7])};
      if (tid < 32) {
        const float igv = pgi + gbi;
        const float lfv = -softplusf_(-(pgf + gbf));
        float g = lfv;
#pragma unroll
        for (int o = 1; o < 32; o <<= 1) { const float tt = shfl_lane(g, (lane - o) & 63); if (tid >= o) g += tt; }
        const float cs = igv - g;
        float pm = cs;
#pragma unroll
        for (int o = 1; o < 32; o <<= 1) { const float tt = shfl_lane(pm, (lane - o) & 63); if (tid >= o) pm = fmaxf(pm, tt); }
        const float mt = g + fmaxf(m, pm);
        const float gend = shfl_lane(g, 31), mn = shfl_lane(mt, 31);
        ig[tid] = igv; gg[tid] = g; mtv[tid] = mt; wi[tid] = __expf(g + m - mt);
        wsr[tid] = __expf(gend + cs - mn);
        if (tid == 0) { misc[0] = mn; misc[1] = __expf(gend + m - mn); }
      }
    }
    if (ch + 1 < nch) ML_ISSUE(ch + 1)
    __syncthreads();
    {
      {
        float kw[16];
#pragma unroll
        for (int jj = 0; jj < 16; ++jj) { const int j = half * 16 + jj; kw[jj] = bf2f(Km[j * 136 + dd]) * wsr[j]; }
        *(u32x4*)(KwT + dd * 40 + half * 16) = (u32x4){pk2(kw[0], kw[1]), pk2(kw[2], kw[3]), pk2(kw[4], kw[5]), pk2(kw[6], kw[7])};
        *(u32x4*)(KwT + dd * 40 + half * 16 + 8) = (u32x4){pk2(kw[8], kw[9]), pk2(kw[10], kw[11]), pk2(kw[12], kw[13]), pk2(kw[14], kw[15])};
      }
      const int j = tid >> 3, seg = tid & 7;
      float a = 0.f;
#pragma unroll
      for (int i = 0; i < 16; ++i) a += bf2f(Qm[j * 136 + seg * 16 + i]) * nv[seg * 16 + i];
      a += SHX(a, 1); a += SHX(a, 2); a += SHX(a, 4);
      if (seg == 0) qn[j] = a;
    }
    const float m_new = misc[0], carry = misc[1];
    bf16_t* Cbw = Cb + w * 32 * 136; bf16_t* Ptw = Pt;
#pragma unroll
    for (int kb = 0; kb < 4; ++kb)
#pragma unroll
      for (int g4 = 0; g4 < 4; ++g4) *(u32x2*)(Cbw + r * 136 + 32 * kb + crow(4 * g4, h)) = (u32x2){pk2(C[kb][4 * g4], C[kb][4 * g4 + 1]), pk2(C[kb][4 * g4 + 2], C[kb][4 * g4 + 3])};
    {
      f32x16 Sc;
#pragma unroll
      for (int g = 0; g < 16; ++g) Sc[g] = 0.f;
      mma32(Sc, Qm, 136, Km, 136, 128, lane);
      const float gs = gg[r], is = ig[r];
#pragma unroll
      for (int g = 0; g < 16; ++g) {
        const int t = crow(g, h);
        const float pv = (r <= t) ? __expf(gg[t] - gs + is - mtv[t]) * Sc[g] : 0.f;
        Ptw[t * 40 + r] = f2bf(pv);
      }
    }
    __syncthreads();
    if (lane < 32) {
      float a = 0.f;
#pragma unroll 4
      for (int i = 0; i < 32; ++i) a += bf2f(Ptw[lane * 40 + i]);
      const float den = wi[lane] * qn[lane] + a;
      dnw[lane] = 1.0f / fmaxf(fabsf(den), __expf(-mtv[lane]));
    }
    if (tid < 128) {
      float a = 0.f;
#pragma unroll 4
      for (int i = 0; i < 32; ++i) a += bf2f(KwT[tid * 40 + i]);
      nv[tid] = carry * nv[tid] + a;
    }
    __syncthreads();
    {
      f32x16 a1;
#pragma unroll
      for (int g = 0; g < 16; ++g) a1[g] = 0.f;
      mma32(a1, Qm, 136, Cbw, 136, 128, lane);
#pragma unroll
      for (int g = 0; g < 16; ++g) a1[g] *= wi[crow(g, h)];
      mma32(a1, Ptw, 40, VT + 32 * w * 40, 40, 32, lane);
#pragma unroll
      for (int g = 0; g < 16; ++g) {
        const int j = crow(g, h), pos = ch * 32 + j, t = d ? q.T - 1 - pos : pos;
        const float hv = a1[g] * dnw[j];
        Hb[(size_t)(q.base + t) * 1024 + d * 512 + 128 * hh + 32 * w + r] = f2bf(hv);
      }
#pragma unroll
      for (int kb = 0; kb < 4; ++kb) {
#pragma unroll
        for (int g = 0; g < 16; ++g) C[kb][g] *= carry;
        mma32(C[kb], KwT + 32 * kb * 40, 40, VT + 32 * w * 40, 40, 32, lane);
      }
    }
    m = m_new;
  }
  __syncthreads();
  if (!q.sample) {
    const size_t sb = (((size_t)q.b * 2 + l) * 2 + d) * 4 + hh;
    float* dst = p.out + OUT_C + sb * 16384;
#pragma unroll
    for (int kb = 0; kb < 4; ++kb)
#pragma unroll
      for (int g = 0; g < 16; ++g) dst[(size_t)(32 * kb + crow(g, h)) * 128 + 32 * w + r] = C[kb][g];
    if (tid < 128) p.out[OUT_N + sb * 128 + tid] = nv[tid];
    if (tid == 0) p.out[OUT_M + sb] = m;
  }
}

DI void phase_scan(const Params& p, int l, char* smem) {
  int* ctrL = (int*)(p.ws + OFF_CTR) + 2 * l;
  int* ctrS = ctrL + 1;
  int* sit = (int*)(smem + LDS_BYTES - 16);
  const int role = p.role;
  bool longDone = false, shortDone = false;
  for (;;) {
    const bool wantLong = (role == 0) ? !longDone : shortDone;
    if (longDone && shortDone) break;
    __syncthreads();
    if (ltid() == 0) *sit = atomicAdd(wantLong ? ctrL : ctrS, 1);
    __syncthreads();
    int it = __builtin_amdgcn_readfirstlane(*sit);
    int ty, s_, hh_, d_, rb_ = 0;
    if (wantLong) {
      if (it >= 128) { longDone = true; continue; }
      if (it < 64) { ty = 0; d_ = it & 1; hh_ = (it >> 1) & 7; s_ = 32 + (it >> 4); }
      else if (it < 96) { it -= 64; ty = 1; s_ = 32 + (it >> 3); hh_ = (it >> 1) & 3; d_ = it & 1; }
      else { it -= 96; ty = 2; s_ = 32 + (it >> 3); hh_ = (it >> 1) & 3; d_ = it & 1; }
    } else {
      if (it >= 1024) { shortDone = true; continue; }
      if (it < 512) { ty = 0; s_ = it >> 4; hh_ = (it >> 1) & 7; d_ = it & 1; }
      else if (it < 768) { it -= 512; ty = 1; s_ = it >> 3; hh_ = (it >> 1) & 3; d_ = it & 1; }
      else { it -= 768; ty = 2; s_ = it >> 3; hh_ = (it >> 1) & 3; d_ = it & 1; }
    }
    if (ty == 0) rwkv_item(p, l, s_, hh_, d_, smem);
    else if (ty == 1) hgrn_item(p, l, s_, hh_, d_, smem);
    else mlstm_item(p, l, s_, hh_, d_, smem);
  }
}

DI void phase_combine(const Params& p, int l, char* smem) {
  const int tid = ltid(), lane = tid & 63, w = tid >> 6;
  bf16_t* ZH = (bf16_t*)(p.ws + OFF_ZH); bf16_t* ZM = (bf16_t*)(p.ws + OFF_ZM); const bf16_t* ZR = (const bf16_t*)(p.ws + OFF_ZR);
  bf16_t* O = (bf16_t*)(p.ws + OFF_O); const bf16_t* Hb = (const bf16_t*)(p.ws + OFF_H);
  const float* mu = p.in[I_MU] + (size_t)l * 4 * ZRW;
  const float* g2 = p.in[I_G2] + (size_t)l * 128 * 512;
  float* sg = (float*)smem;
  float* gt = sg + 128 * 16;
  for (int blk = blockIdx.x; blk < NT / 16; blk += gridDim.x) {
    const int tok0 = blk * 16;
    int sidx, t0;
    if (tok0 < 8192) { sidx = tok0 >> 8; t0 = tok0 & 255; } else { sidx = 32 + ((tok0 - 8192) >> 11); t0 = (tok0 - 8192) & 2047; }
    const Seq q = get_seq(sidx);
    __syncthreads();
    { const int j = tid >> 4, rr0 = (tid & 15) * 8; float val[8]; bf16x8 pv[5]; rw_load8(ZR, q.base, t0 + j, q.T, q.grid, 1792 + rr0, pv); rw_apply8(pv, mu, q.grid, 1792 + rr0, val);
#pragma unroll
      for (int e = 0; e < 8; ++e) sg[(rr0 + e) * 16 + j] = sigmoidf_(val[e]); }
    __syncthreads();
    {
      float a0[16], a1[16];
#pragma unroll
      for (int j = 0; j < 16; ++j) { a0[j] = 0.f; a1[j] = 0.f; }
#pragma unroll 1
      for (int r0 = 0; r0 < 128; r0 += 8) {
        float w0v[8], w1v[8];
#pragma unroll
        for (int q8 = 0; q8 < 8; ++q8) { w0v[q8] = g2[(r0 + q8) * 512 + tid]; w1v[q8] = g2[(r0 + q8) * 512 + 256 + tid]; }
#pragma unroll
        for (int q8 = 0; q8 < 8; ++q8) {
          const int rr = r0 + q8; const float w0 = w0v[q8], w1 = w1v[q8];
#pragma unroll
          for (int u = 0; u < 4; ++u) {
            f32x4 sv = *(const f32x4*)(sg + rr * 16 + 4 * u);
#pragma unroll
            for (int e = 0; e < 4; ++e) { a0[4 * u + e] += sv[e] * w0; a1[4 * u + e] += sv[e] * w1; }
          }
        }
      }
#pragma unroll
      for (int j = 0; j < 16; ++j) { gt[j * 512 + tid] = a0[j]; gt[j * 512 + 256 + tid] = a1[j]; }
    }
    __syncthreads();
#pragma unroll 1
    for (int jj = 0; jj < 4; ++jj) {
      const int j = w * 4 + jj, tok = tok0 + j, t = t0 + j; int c0 = lane * 8; asm volatile("" : "+v"(c0));
      {
        float o[8], rs[8], ks[8], vs[8];
        float sum = 0.f, bon = 0.f;
        {
          bf16x8 pr_[5], pk_[5], pv_[5];
          rw_load8(ZR, q.base, t, q.T, q.grid, c0, pr_); rw_load8(ZR, q.base, t, q.T, q.grid, 512 + c0, pk_); rw_load8(ZR, q.base, t, q.T, q.grid, 1024 + c0, pv_);
          rw_apply8(pr_, mu, q.grid, c0, rs); rw_apply8(pk_, mu, q.grid, 512 + c0, ks); rw_apply8(pv_, mu, q.grid, 1024 + c0, vs);
        }
        const bf16x8 of = *(const bf16x8*)(O + (size_t)tok * 1024 + c0), ob = *(const bf16x8*)(O + (size_t)tok * 1024 + 512 + c0);
        const f32x4 rk0 = *(const f32x4*)(p.in[I_RK] + l * 512 + c0), rk1 = *(const f32x4*)(p.in[I_RK] + l * 512 + c0 + 4);
#pragma unroll
        for (int e = 0; e < 8; ++e) {
          o[e] = bf2f((bf16_t)of[e]) + bf2f((bf16_t)ob[e]);
          sum += o[e];
          bon += rs[e] * ks[e] * (e < 4 ? rk0[e & 3] : rk1[e & 3]);
        }
        sum += SHX(sum, 1); sum += SHX(sum, 2); sum += SHX(sum, 4);
        bon += SHX(bon, 1); bon += SHX(bon, 2); bon += SHX(bon, 4);
        const float mean = sum * (1.0f / 64.f);
        float var = 0.f;
#pragma unroll
        for (int e = 0; e < 8; ++e) { const float dv = o[e] - mean; var += dv * dv; }
        var += SHX(var, 1); var += SHX(var, 2); var += SHX(var, 4);
        const float rstd = rsqrtf(var * (1.0f / 64.f) + 64e-5f);
        const f32x4 lw0 = *(const f32x4*)(p.in[I_LN] + (l * 2 + 0) * 512 + c0), lw1 = *(const f32x4*)(p.in[I_LN] + (l * 2 + 0) * 512 + c0 + 4);
        const f32x4 lb0 = *(const f32x4*)(p.in[I_LN] + (l * 2 + 1) * 512 + c0), lb1 = *(const f32x4*)(p.in[I_LN] + (l * 2 + 1) * 512 + c0 + 4);
        const f32x4 gt0 = *(const f32x4*)(gt + j * 512 + c0), gt1 = *(const f32x4*)(gt + j * 512 + c0 + 4);
        bf16x8 ov;
#pragma unroll
        for (int e = 0; e < 8; ++e) {
          const float ln = (o[e] - mean) * rstd * (e < 4 ? lw0[e & 3] : lw1[e & 3]) + (e < 4 ? lb0[e & 3] : lb1[e & 3]);
          ov[e] = (short)f2bf((ln + bon * vs[e]) * (e < 4 ? gt0[e & 3] : gt1[e & 3]));
        }
        *(bf16x8*)(O + (size_t)tok * 1024 + c0) = ov;
      }
      {
        float o[8]; float ss = 0.f;
        bf16_t* zr_ = ZH + (size_t)tok * ZHW + c0;
        const bf16x8 of = *(const bf16x8*)(zr_ + 512), ob = *(const bf16x8*)(zr_ + 1024), hgv = *(const bf16x8*)(zr_ + 2048);
        const f32x4 nw0 = *(const f32x4*)(p.in[I_HNORM] + l * 512 + c0), nw1 = *(const f32x4*)(p.in[I_HNORM] + l * 512 + c0 + 4);
#pragma unroll
        for (int e = 0; e < 8; ++e) { o[e] = bf2f((bf16_t)of[e]) + bf2f((bf16_t)ob[e]); ss += o[e] * o[e]; }
        ss += SHX(ss, 1); ss += SHX(ss, 2); ss += SHX(ss, 4); ss += SHX(ss, 8);
        const float rsd = rsqrtf(ss * (1.0f / 128.f) + 1e-6f);
        bf16x8 ov;
#pragma unroll
        for (int e = 0; e < 8; ++e) ov[e] = (short)f2bf(o[e] * rsd * (e < 4 ? nw0[e & 3] : nw1[e & 3]) * siluf_(bf2f((bf16_t)hgv[e])));
        *(bf16x8*)(zr_ + 2048) = ov;
      }
      {
        float o[8]; float ss = 0.f;
        bf16_t* zm_ = ZM + (size_t)tok * ZMW + 1536 + c0;
        const bf16x8 of = *(const bf16x8*)(Hb + (size_t)tok * 1024 + c0), ob = *(const bf16x8*)(Hb + (size_t)tok * 1024 + 512 + c0), mov = *(const bf16x8*)zm_;
        const f32x4 nw0 = *(const f32x4*)(p.in[I_MNORM] + l * 512 + c0), nw1 = *(const f32x4*)(p.in[I_MNORM] + l * 512 + c0 + 4);
#pragma unroll
        for (int e = 0; e < 8; ++e) { o[e] = bf2f((bf16_t)of[e]) + bf2f((bf16_t)ob[e]); ss += o[e] * o[e]; }
        ss += SHX(ss, 1); ss += SHX(ss, 2); ss += SHX(ss, 4); ss += SHX(ss, 8);
        const float rsd = rsqrtf(ss * (1.0f / 128.f) + 1e-6f);
        bf16x8 ov;
#pragma unroll
        for (int e = 0; e < 8; ++e) ov[e] = (short)f2bf(o[e] * rsd * (e < 4 ? nw0[e & 3] : nw1[e & 3]) * sigmoidf_(bf2f((bf16_t)mov[e])));
        *(bf16x8*)zm_ = ov;
      }
    }
    __syncthreads();
#pragma unroll 1
    for (int jj = 0; jj < 4; ++jj) tok_one(p, l, 3, tok0 + w * 4 + jj, lane);
  }
}

#define XB_TMO      128
#define XB_XCNT(j)  (256  + 64 * (j))
#define XB_XSUB(j)  (1280 + 64 * (j))
#define XB_XGEN(j)  (2304 + 64 * (j))
#define XB_TOP      3328
#define XB_TOPGEN   3392
#define XCD_BAR_WORDS 3456
#define XB_SPIN_CAP (1u << 20)
#define LAS __attribute__((address_space(3)))
DI unsigned xb_ld(unsigned* p)              { return __hip_atomic_load(p, __ATOMIC_RELAXED, __HIP_MEMORY_SCOPE_AGENT); }
DI unsigned xb_add(unsigned* p, unsigned v) { return __hip_atomic_fetch_add(p, v, __ATOMIC_RELAXED, __HIP_MEMORY_SCOPE_AGENT); }
DI unsigned xb_xcc_id() { return (unsigned)__builtin_amdgcn_s_getreg((3 << 11) | 20) & 0xFu; }
#define XB_SPIN(cond, bar) do { unsigned _sp = 0; while (cond) { __builtin_amdgcn_s_sleep(1); \
    if ((++_sp & 255u) == 0u) { if (xb_ld(&(bar)[XB_TMO])) break; if (_sp > XB_SPIN_CAP) { atomicAdd(&(bar)[XB_TMO], 1u); break; } } } } while (0)
struct XcdBarrier { unsigned* bar; unsigned x; volatile LAS unsigned* st; };
DI XcdBarrier xcd_barrier_post(const Params& p, unsigned* bar, volatile LAS unsigned* st) {
  XcdBarrier b; b.bar = bar; b.x = xb_xcc_id(); b.st = st;
  if (ltid() == 0) (void)xb_add(&bar[XB_XCNT(b.x)], 1u);
  return b;
}
DI void xcd_barrier_complete(unsigned* bar, unsigned x, unsigned& nloc, unsigned& nx) {
  const unsigned G = gridDim.x * gridDim.y * gridDim.z;
  unsigned sum, cnt, mine, sp = 0u;
  for (;;) {
    sum = 0u; cnt = 0u; mine = 0u;
#pragma unroll
    for (unsigned j = 0; j < 16; ++j) { const unsigned c = xb_ld(&bar[XB_XCNT(j)]); sum += c; cnt += (c > 0u) ? 1u : 0u; mine = (j == x) ? c : mine; }
    if (sum == G) break;
    __builtin_amdgcn_s_sleep(1);
    if ((++sp & 255u) == 0u) { if (xb_ld(&bar[XB_TMO])) break; if (sp > XB_SPIN_CAP) { atomicAdd(&bar[XB_TMO], 1u); break; } }
  }
  nloc = mine > 0u ? mine : 1u; nx = cnt > 0u ? cnt : 1u;
}
DI void xcd_barrier(const Params& p, const XcdBarrier& b) {
  asm volatile("s_waitcnt vmcnt(0)" ::: "memory");
  __syncthreads();
  if (ltid() == 0) {
    unsigned* bar = b.bar;
    __builtin_amdgcn_s_waitcnt(0);
    unsigned nloc = b.st[0], nx = b.st[1];
    if (nloc == 0u) { xcd_barrier_complete(bar, b.x, nloc, nx); b.st[0] = nloc; b.st[1] = nx; }
    const unsigned old = xb_add(&bar[XB_XSUB(b.x)], 1u);
    const unsigned gen = old / nloc;
    if (old + 1u == (gen + 1u) * nloc) {
      __builtin_amdgcn_fence(__ATOMIC_RELEASE, "agent");
      asm volatile("s_waitcnt vmcnt(0)" ::: "memory");
      const unsigned og = xb_add(&bar[XB_TOP], 1u);
      const unsigned tg = og / nx;
      if (og + 1u == (tg + 1u) * nx) xb_add(&bar[XB_TOPGEN], 1u);
      else XB_SPIN(xb_ld(&bar[XB_TOPGEN]) == tg, bar);
      __builtin_amdgcn_fence(__ATOMIC_ACQUIRE, "agent");
      xb_add(&bar[XB_XGEN(b.x)], 1u);
      asm volatile("s_waitcnt vmcnt(0)" ::: "memory");
    } else {
      XB_SPIN(xb_ld(&bar[XB_XGEN(b.x)]) == gen, bar);
      __builtin_amdgcn_fence(__ATOMIC_ACQUIRE, "agent");
      asm volatile("s_waitcnt vmcnt(0)" ::: "memory");
    }
  }
  __syncthreads();
}

constexpr int NPHASE = 3 + 9 * 2;
DI void run_phase(const Params& p0, int ph, char* smem) {
  Params p = p0;
  asm volatile("" : "+s"(p.ws), "+s"(p.out));
  p.ws = as_global(p.ws); p.out = as_global(p.out);
  if (ph == 0) { phase0(p, smem); return; }
  if (ph == 1) { phase1(p); return; }
  if (ph == 2) { tok_phase(p, 0, 0); return; }
  const int l = (ph - 3) / 9, s = (ph - 3) % 9;
  switch (s) {
    case 0: phase_inproj(p, smem); break;
    case 1: phase_scan(p, l, smem); break;
    case 2: phase_combine(p, l, smem); break;
    case 3: phase_merge(p, l, smem); break;
    case 4: phase_gemm_f32(p, (const bf16_t*)(p.ws + OFF_MERGED), 1024, (const bf16_t*)(p.ws + OFF_WTOUT), smem); break;
    case 5: tok_phase(p, l, 1); break;
    case 6: phase_ffn_in(p, smem); break;
    case 7: phase_gemm_f32(p, (const bf16_t*)(p.ws + OFF_ACT), DFF, (const bf16_t*)(p.ws + OFF_WTFO), smem); break;
    case 8:
      tok_phase(p, l, 2);
      if (l + 1 < 2) {
        conv_weight(p, p.in[I_WIN] + (size_t)(l + 1) * 1024 * DIN, DIN, (bf16_t*)(p.ws + OFF_WTIN), 1024, WTIN_ROWS, 0, (float*)smem, blockIdx.x, gridDim.x);
        for (int br = 0; br < 3; ++br) conv_weight(p, p.in[I_WBR] + ((size_t)(l + 1) * 3 + br) * 512 * 1024, 1024, (bf16_t*)(p.ws + OFF_WTBR) + (size_t)br * 1024 * 512, 512, 1024, 1, (float*)smem, blockIdx.x, gridDim.x);
      }
      break;
  }
}

template <bool COOP>
__global__ void __launch_bounds__(NTHR, 2) mega(Params pk, int lo, int hi) {
  __shared__ __attribute__((aligned(16))) char smem[LDS_BYTES];
  Params p = pk;
#pragma unroll
  for (int i = 0; i < N_IN; ++i) p.in[i] = as_global(p.in[i]);
  p.ws = as_global(p.ws); p.out = as_global(p.out);
  p.wb = __builtin_amdgcn_readfirstlane((int)threadIdx.x) & ~63;
  if (COOP) {
    volatile LAS unsigned* st = (volatile LAS unsigned*)(smem + LDS_BYTES - 32);
    if (ltid() == 0) { st[0] = 0u; st[1] = 0u; }
    __syncthreads();
    phase0(p, smem);
    cg::this_grid().sync();
    XcdBarrier b = xcd_barrier_post(p, (unsigned*)(p.ws + OFF_BAR), st);
    if (ltid() == 0) {
      const unsigned hwid = (unsigned)__builtin_amdgcn_s_getreg((31 << 11) | 4);
      const unsigned key = (xb_xcc_id() << 8) | ((hwid >> 8) & 0xFFu);
      ((int*)smem)[(LDS_BYTES - 12) / 4] = (int)xb_add((unsigned*)(p.ws + OFF_ROLE) + key, 1u);
    }
    __syncthreads();
    p.role = __builtin_amdgcn_readfirstlane(((int*)smem)[(LDS_BYTES - 12) / 4]);
    for (int ph = 1; ph < hi; ++ph) {
      run_phase(p, ph, smem);
      if (ph + 1 < hi) xcd_barrier(p, b);
    }
  } else {
    for (int ph = lo; ph < hi; ++ph) run_phase(p, ph, smem);
  }
}

extern "C" void kernel_launch(void* const* d_in, const int* in_sizes, int n_in, void* d_out, int out_size, void* d_ws, size_t ws_size, hipStream_t stream) {
  Params p{};
  for (int i = 0; i < N_IN; ++i) p.in[i] = (const float*)d_in[i];
  p.out = (float*)d_out; p.ws = (char*)d_ws;
  if (ws_size < WS_NEED) fprintf(stderr, "workspace too small: %zu < %zu\n", ws_size, (size_t)WS_NEED);
  static int grid_blocks = 0;
  if (!grid_blocks) {
    int dev = 0, cus = 0, per_cu = 0;
    hipGetDevice(&dev);
    hipDeviceGetAttribute(&cus, hipDeviceAttributeMultiprocessorCount, dev);
    hipOccupancyMaxActiveBlocksPerMultiprocessor(&per_cu, mega<true>, NTHR, 0);
    if (per_cu > 2) per_cu = 2;
    grid_blocks = cus * per_cu;
  }
  int lo = 0, hi = NPHASE;
  void* args[] = {&p, &lo, &hi};
  hipError_t e = hipLaunchCooperativeKernel((void*)mega<true>, dim3(grid_blocks), dim3(NTHR), args, 0, stream);
  if (e != hipSuccess) fprintf(stderr, "cooperative launch failed: %s (grid %d)\n", hipGetErrorString(e), grid_blocks);
}
```

```cpp
#include <hip/hip_runtime.h>
#include <hip/hip_cooperative_groups.h>
#include <cstdio>
namespace cg = cooperative_groups;

typedef unsigned short bf16_t;
typedef short bf16x8 __attribute__((ext_vector_type(8)));
typedef float f32x4 __attribute__((ext_vector_type(4)));
typedef float f32x2 __attribute__((ext_vector_type(2)));
typedef float f32x16 __attribute__((ext_vector_type(16)));
typedef unsigned short u16x4 __attribute__((ext_vector_type(4)));
typedef unsigned short u16x2 __attribute__((ext_vector_type(2)));
typedef unsigned u32x4 __attribute__((ext_vector_type(4)));
typedef unsigned u32x2 __attribute__((ext_vector_type(2)));
static __device__ __forceinline__ unsigned pk2(float lo, float hi) { typedef __bf16 b2 __attribute__((ext_vector_type(2))); typedef float f2 __attribute__((ext_vector_type(2))); return __builtin_bit_cast(unsigned, __builtin_convertvector((f2){lo, hi}, b2)); }

#define DI __device__ __forceinline__
#define GAS __attribute__((address_space(1)))
template <class T> static __device__ __forceinline__ T* as_global(T* q) { return (T*)(GAS T*)(unsigned long long)q; }

constexpr int NT = 16384;
constexpr int DM = 1024;
constexpr int NTHR = 256;
constexpr int DIN = 9616;
constexpr int ZHW = 2560, ZRW = 1920, ZMW = 2048;
constexpr int WTIN_ROWS = 9728;
constexpr int DFF = 2816;

constexpr size_t OFF_WTIN = 0;
constexpr size_t OFF_WTBR = OFF_WTIN + (size_t)WTIN_ROWS * 1024 * 2;
constexpr size_t OFF_H    = OFF_WTBR + (size_t)3 * 1024 * 512 * 2;
constexpr size_t OFF_ZH   = OFF_H + (size_t)NT * 1024 * 2;
constexpr size_t OFF_ZR   = OFF_ZH + (size_t)NT * ZHW * 2;
constexpr size_t OFF_ZM   = OFF_ZR + (size_t)NT * ZRW * 2;
constexpr size_t OFF_MG   = OFF_ZM + (size_t)NT * ZMW * 2;
constexpr size_t OFF_O    = OFF_MG + (size_t)NT * 16 * 4;
constexpr size_t OFF_MOD  = OFF_O + (size_t)NT * 1024 * 2;
constexpr size_t OFF_LBS  = OFF_MOD + (size_t)2 * 5 * 6144 * 4;
constexpr size_t OFF_CTR  = OFF_LBS + 2 * 512 * 4;
constexpr size_t OFF_BAR  = OFF_CTR + 256;
constexpr size_t OFF_ROLE = OFF_BAR + 3456 * 4;
constexpr size_t WS_NEED  = OFF_ROLE + 4096 * 4;
constexpr size_t OFF_MODP = OFF_ZH;
constexpr size_t OFF_WTOUT = OFF_ZR;
constexpr size_t OFF_WTFI  = OFF_WTOUT + (size_t)1024 * 1024 * 2;
constexpr size_t OFF_WTFO  = OFF_WTFI + (size_t)5632 * 1024 * 2;
constexpr size_t OFF_MERGED = OFF_WTFO + (size_t)1024 * 2816 * 2;
constexpr size_t OFF_Y    = OFF_ZH;
constexpr size_t OFF_ACT  = OFF_ZM;

constexpr size_t OUT_HG = 16777216, OUT_RW = 25165824, OUT_C = 29360128, OUT_N = 37748736, OUT_M = 37814272;

enum { I_XP = 0, I_XS, I_SH, I_SR, I_SC, I_SN, I_SM, I_C, I_CCTX, I_WADA, I_BADA, I_NORMS, I_WIN, I_HLB, I_HNORM, I_MU, I_W0, I_W2,
       I_A0, I_A2, I_G2, I_KK, I_KA, I_RK, I_LN, I_GB, I_MNORM, I_WBR, I_WOUT, I_WFI, I_WFO, N_IN };

struct Params { const float* in[N_IN]; float* out; char* ws; int wb; int role; };

constexpr int LDS_BYTES = 77824;

DI bf16_t f2bf(float f) { return __builtin_bit_cast(unsigned short, (__bf16)f); }
DI float bf2f(bf16_t h) { return __uint_as_float(((unsigned)h) << 16); }
DI float sigmoidf_(float x) { return 1.0f / (1.0f + __expf(-x)); }
DI float siluf_(float x) { return x / (1.0f + __expf(-x)); }
DI float softplusf_(float x) { return x > 20.f ? x : __logf(1.0f + __expf(x)); }
DI float dpp_xor1(float x) { return __int_as_float(__builtin_amdgcn_mov_dpp(__float_as_int(x), 0xB1, 0xF, 0xF, true)); }
DI float dpp_xor2(float x) { return __int_as_float(__builtin_amdgcn_mov_dpp(__float_as_int(x), 0x4E, 0xF, 0xF, true)); }
DI float shfl_lane(float v, int src) { return __int_as_float(__builtin_amdgcn_ds_bpermute(src << 2, __float_as_int(v))); }
#define SHX(v, m) shfl_lane((v), lane ^ (m))
DI float wave_sum(float v, int lane) { v += dpp_xor1(v); v += dpp_xor2(v); v += SHX(v, 4); v += SHX(v, 8); v += SHX(v, 16); v += SHX(v, 32); return v; }
DI int ltid_(int wb) { int t = wb + (int)__builtin_amdgcn_mbcnt_hi(~0u, __builtin_amdgcn_mbcnt_lo(~0u, 0u)); asm volatile("" : "+v"(t)); return t; }
#define ltid() ltid_(p.wb)
DI int crow(int reg, int h) { return (reg & 3) + 8 * (reg >> 2) + 4 * h; }

DI int tok_cond(int tok) { return tok < 8192 ? 0 : 1 + ((tok - 8192) >> 11); }
DI const float* x_in_row(const Params& p, int tok) { return tok < 8192 ? p.in[I_XP] + (size_t)tok * DM : p.in[I_XS] + (size_t)(tok - 8192) * DM; }

DI void mma32(f32x16& acc, const bf16_t* A, int lda, const bf16_t* B, int ldb, int K, int lane) {
  const int r = lane & 31, h = lane >> 5;
#pragma unroll 2
  for (int kk = 0; kk < K; kk += 16) {
    bf16x8 a = *(const bf16x8*)(A + r * lda + kk + 8 * h);
    bf16x8 b = *(const bf16x8*)(B + r * ldb + kk + 8 * h);
    acc = __builtin_amdgcn_mfma_f32_32x32x16_bf16(a, b, acc, 0, 0, 0);
  }
}

template <int BM, int BN, int BK>
DI void gemm_main(const Params& p, f32x4 (&acc)[BM / 32][BN / 32], const bf16_t* __restrict__ A, int lda, const bf16_t* __restrict__ B, int ldb, int K, bf16_t* sm) {
  constexpr int MI = BM / 32, NJ = BN / 32, LS = BK + 8, CPR = BK / 8, ACH = BM * BK / 2048, BCH = BN * BK / 2048, KS = BK / 32, RPI = 256 / CPR;
  const int tid = ltid(), lane = tid & 63, w = tid >> 6, wm = w >> 1, wn = w & 1;
  bf16_t* As = sm; bf16_t* Bs = sm + 2 * BM * LS;
  bf16x8 ra[ACH], rb[BCH];
  const int nk = K / BK;
  const int lrow = tid / CPR, lkc = (tid % CPR) * 8;
#pragma unroll
  for (int i = 0; i < ACH; ++i) ra[i] = *(const bf16x8*)(A + (size_t)(lrow + RPI * i) * lda + lkc);
#pragma unroll
  for (int i = 0; i < BCH; ++i) rb[i] = *(const bf16x8*)(B + (size_t)(lrow + RPI * i) * ldb + lkc);
  __syncthreads();
#pragma unroll
  for (int i = 0; i < ACH; ++i) *(bf16x8*)(As + (lrow + RPI * i) * LS + lkc) = ra[i];
#pragma unroll
  for (int i = 0; i < BCH; ++i) *(bf16x8*)(Bs + (lrow + RPI * i) * LS + lkc) = rb[i];
  __syncthreads();
  for (int kt = 0; kt < nk; ++kt) {
    const int buf = kt & 1;
    if (kt + 1 < nk) {
      const int k0 = (kt + 1) * BK + lkc;
#pragma unroll
      for (int i = 0; i < ACH; ++i) ra[i] = *(const bf16x8*)(A + (size_t)(lrow + RPI * i) * lda + k0);
#pragma unroll
      for (int i = 0; i < BCH; ++i) rb[i] = *(const bf16x8*)(B + (size_t)(lrow + RPI * i) * ldb + k0);
    }
    const bf16_t* as = As + buf * BM * LS + (wm * (BM / 2) + (lane & 15)) * LS + (lane >> 4) * 8;
    const bf16_t* bs = Bs + buf * BN * LS + (wn * (BN / 2) + (lane & 15)) * LS + (lane >> 4) * 8;
#pragma unroll
    for (int ks = 0; ks < KS; ++ks) {
      bf16x8 bfr[NJ];
#pragma unroll
      for (int j = 0; j < NJ; ++j) bfr[j] = *(const bf16x8*)(bs + j * 16 * LS + ks * 32);
      __builtin_amdgcn_s_setprio(1);
#pragma unroll
      for (int i = 0; i < MI; ++i) {
        const bf16x8 af = *(const bf16x8*)(as + i * 16 * LS + ks * 32);
#pragma unroll
        for (int j = 0; j < NJ; ++j) acc[i][j] = __builtin_amdgcn_mfma_f32_16x16x32_bf16(bfr[j], af, acc[i][j], 0, 0, 0);
      }
      __builtin_amdgcn_s_setprio(0);
    }
    if (kt + 1 < nk) {
      const int nb = buf ^ 1;
#pragma unroll
      for (int i = 0; i < ACH; ++i) *(bf16x8*)(As + nb * BM * LS + (lrow + RPI * i) * LS + lkc) = ra[i];
#pragma unroll
      for (int i = 0; i < BCH; ++i) *(bf16x8*)(Bs + nb * BN * LS + (lrow + RPI * i) * LS + lkc) = rb[i];
    }
    __syncthreads();
  }
}

template <int MI, int NJ> DI void zero_acc(f32x4 (&acc)[MI][NJ]) {
#pragma unroll
  for (int i = 0; i < MI; ++i)
#pragma unroll
    for (int j = 0; j < NJ; ++j) acc[i][j] = (f32x4){0.f, 0.f, 0.f, 0.f};
}
DI void store_bf4(bf16_t* dst, f32x4 v) { u16x4 o; o[0] = f2bf(v[0]); o[1] = f2bf(v[1]); o[2] = f2bf(v[2]); o[3] = f2bf(v[3]); *(u16x4*)dst = o; }

DI int map_col(int mode, int n) {
  if (mode == 0) return n < 6544 ? n : (n < 6656 ? -1 : n - 112);
  if (mode == 2) return ((n >> 4) & 1) ? DFF + (n >> 5) * 16 + (n & 15) : (n >> 5) * 16 + (n & 15);
  return n;
}
DI void conv_tile(const Params& p, const float* __restrict__ src, int ld_src, bf16_t* __restrict__ dst, int K, int mode, int tk, int tn, float* sm) {
  const int tid = ltid();
  __syncthreads();
  {
    const int nn = tid & 63, col = map_col(mode, tn * 64 + nn);
#pragma unroll
    for (int i = 0; i < 16; ++i) { int kk = (tid >> 6) + 4 * i; sm[kk * 65 + nn] = col >= 0 ? src[(size_t)(tk * 64 + kk) * ld_src + col] : 0.f; }
  }
  __syncthreads();
  {
    const int kk = tid & 63;
#pragma unroll
    for (int i = 0; i < 16; ++i) { int nn = (tid >> 6) + 4 * i; dst[(size_t)(tn * 64 + nn) * K + tk * 64 + kk] = f2bf(sm[kk * 65 + nn]); }
  }
}
DI void conv_weight(const Params& p, const float* src, int ld_src, bf16_t* dst, int K, int Ndst, int mode, float* sm, int bid, int nb) {
  const int tkn = K / 64, nt = tkn * (Ndst / 64);
  for (int t = bid; t < nt; t += nb) conv_tile(p, src, ld_src, dst, K, mode, t % tkn, t / tkn, sm);
}

DI void phase0(const Params& p, char* smem) {
  const int tid = ltid(), bid = blockIdx.x, nb = gridDim.x;
  float* MODP = (float*)(p.ws + OFF_MODP);
  float* sm = (float*)smem;
  if (bid == 0) { if (tid < 64) ((int*)(p.ws + OFF_CTR))[tid] = 0; for (int i = tid; i < 3456; i += NTHR) ((unsigned*)(p.ws + OFF_BAR))[i] = 0u; for (int i = tid; i < 4096; i += NTHR) ((unsigned*)(p.ws + OFF_ROLE))[i] = 0u; }
  for (int i = bid * NTHR + tid; i < 512; i += nb * NTHR) {
    float a = p.in[I_HLB][i], b = p.in[I_HLB][512 + i];
    float* L = (float*)(p.ws + OFF_LBS); L[i] = 0.f; L[512 + i] = 1.0f / (1.0f + expf(a - b));
  }
  for (int it = bid; it < 2 * 24 * 16; it += nb) {
    const int ks = it & 15, jb = (it >> 4) % 24, l = it / (16 * 24);
    __syncthreads();
    for (int e = tid; e < 5 * 64; e += NTHR) { int ci = e >> 6, k = ks * 64 + (e & 63); float cv = ci == 0 ? p.in[I_CCTX][k] : p.in[I_C][(ci - 1) * DM + k]; sm[e] = siluf_(cv); }
    __syncthreads();
    const int j = jb * 256 + tid;
    float a0 = 0, a1 = 0, a2 = 0, a3 = 0, a4 = 0;
    const float* W = p.in[I_WADA] + ((size_t)l * DM + ks * 64) * 6144 + j;
#pragma unroll 1
    for (int k0 = 0; k0 < 64; k0 += 16) {
      float wv[16];
#pragma unroll
      for (int u = 0; u < 16; ++u) wv[u] = W[(size_t)(k0 + u) * 6144];
#pragma unroll
      for (int u = 0; u < 16; ++u) { const int k = k0 + u; const float w = wv[u]; a0 += sm[k] * w; a1 += sm[64 + k] * w; a2 += sm[128 + k] * w; a3 += sm[192 + k] * w; a4 += sm[256 + k] * w; }
    }
    float* dst = MODP + ((size_t)(ks * 2 + l) * 5) * 6144 + j;
    dst[0] = a0; dst[6144] = a1; dst[2 * 6144] = a2; dst[3 * 6144] = a3; dst[4 * 6144] = a4;
  }
  conv_weight(p, p.in[I_WIN], DIN, (bf16_t*)(p.ws + OFF_WTIN), 1024, WTIN_ROWS, 0, sm, bid, nb);
  for (int br = 0; br < 3; ++br) conv_weight(p, p.in[I_WBR] + (size_t)br * 512 * 1024, 1024, (bf16_t*)(p.ws + OFF_WTBR) + (size_t)br * 1024 * 512, 512, 1024, 1, sm, bid, nb);
}
DI void phase1(const Params& p) {
  const float* MODP = (const float*)(p.ws + OFF_MODP);
  float* MOD = (float*)(p.ws + OFF_MOD);
  for (int i = blockIdx.x * NTHR + ltid(); i < 2 * 5 * 6144; i += gridDim.x * NTHR) {
    const int j = i % 6144, l = i / (5 * 6144);
    float s = p.in[I_BADA][l * 6144 + j];
    for (int ks = 0; ks < 16; ++ks) s += MODP[(size_t)ks * 2 * 5 * 6144 + i];
    MOD[i] = s;
  }
}

DI void norm_mod_store(const f32x4 (&x)[4], const float* nw, const float* sc, const float* sh, bf16_t* hrow, int lane) {
  float ss = 0.f;
#pragma unroll
  for (int i = 0; i < 4; ++i) ss += x[i][0] * x[i][0] + x[i][1] * x[i][1] + x[i][2] * x[i][2] + x[i][3] * x[i][3];
  ss = wave_sum(ss, lane);
  const float rs = rsqrtf(ss * (1.0f / DM) + 1e-6f);
#pragma unroll
  for (int i = 0; i < 4; ++i) {
    const int c = i * 256 + lane * 4;
    f32x4 w = *(const f32x4*)(nw + c), s1 = *(const f32x4*)(sc + c), s0 = *(const f32x4*)(sh + c), o;
#pragma unroll
    for (int e = 0; e < 4; ++e) o[e] = x[i][e] * rs * w[e] * (1.0f + s1[e]) + s0[e];
    store_bf4(hrow + c, o);
  }
}
DI void tok_one(const Params& p, int l, int mode, int tok, int lane) {
  const float* MOD = (const float*)(p.ws + OFF_MOD);
  bf16_t* H = (bf16_t*)(p.ws + OFF_H);
  const float* Y = (const float*)(p.ws + OFF_Y);
  const int ci = tok_cond(tok);
  const float* modl = MOD + (size_t)(l * 5 + ci) * 6144;
  const float* nwl = p.in[I_NORMS] + (size_t)l * 4 * DM;
  const bool from_in = (l == 0 && (mode == 0 || mode == 1 || mode == 3));
  const float* xr = from_in ? x_in_row(p, tok) : p.out + (size_t)tok * DM;
  f32x4 x[4];
#pragma unroll
  for (int i = 0; i < 4; ++i) x[i] = *(const f32x4*)(xr + i * 256 + lane * 4);
  if (mode == 1 || mode == 2) {
    f32x4 y[4]; float ss = 0.f;
#pragma unroll
    for (int i = 0; i < 4; ++i) { y[i] = *(const f32x4*)(Y + (size_t)tok * DM + i * 256 + lane * 4); ss += y[i][0] * y[i][0] + y[i][1] * y[i][1] + y[i][2] * y[i][2] + y[i][3] * y[i][3]; }
    ss = wave_sum(ss, lane);
    const float rs = rsqrtf(ss * (1.0f / DM) + 1e-6f);
    const float* nw = nwl + (mode == 1 ? 1 : 3) * DM;
    const float* g = modl + (mode == 1 ? 2 : 5) * DM;
#pragma unroll
    for (int i = 0; i < 4; ++i) {
      const int c = i * 256 + lane * 4;
      f32x4 w = *(const f32x4*)(nw + c), gg = *(const f32x4*)(g + c);
#pragma unroll
      for (int e = 0; e < 4; ++e) x[i][e] += gg[e] * (y[i][e] * rs * w[e]);
      *(f32x4*)(p.out + (size_t)tok * DM + c) = x[i];
    }
  }
  if (mode == 0 || mode == 3) norm_mod_store(x, nwl, modl + 1 * DM, modl + 0 * DM, H + (size_t)tok * DM, lane);
  else if (mode == 1) norm_mod_store(x, nwl + 2 * DM, modl + 4 * DM, modl + 3 * DM, H + (size_t)tok * DM, lane);
  else if (mode == 2 && l + 1 < 2) {
    const float* modn = MOD + (size_t)((l + 1) * 5 + ci) * 6144;
    norm_mod_store(x, p.in[I_NORMS] + (size_t)(l + 1) * 4 * DM, modn + 1 * DM, modn + 0 * DM, H + (size_t)tok * DM, lane);
  }
}
DI void tok_phase(const Params& p, int l, int mode) {
  const int lane = ltid() & 63, gw = blockIdx.x * 4 + (ltid() >> 6), nw = gridDim.x * 4;
  for (int tok = gw; tok < NT; tok += nw) tok_one(p, l, mode, tok, lane);
}

DI bool tile_xcd(int i, int NTN, int MTX, int& mt, int& nt) {
  const int G = gridDim.x, b = blockIdx.x, x = b & 7, j = b >> 3, nbx = (G - x + 7) >> 3;
  const int u = j + i * nbx;
  if (u >= MTX * NTN) return false;
  mt = MTX * x + (u % MTX); nt = u / MTX;
  return true;
}
DI void phase_inproj(const Params& p, char* smem) {
  const bf16_t* H = (const bf16_t*)(p.ws + OFF_H);
  const bf16_t* WT = (const bf16_t*)(p.ws + OFF_WTIN);
  bf16_t* ZH = (bf16_t*)(p.ws + OFF_ZH); bf16_t* ZR = (bf16_t*)(p.ws + OFF_ZR); bf16_t* ZM = (bf16_t*)(p.ws + OFF_ZM);
  float* MG = (float*)(p.ws + OFF_MG);
  const int lane = ltid() & 63, w = ltid() >> 6, wm = w >> 1, wn = w & 1;
  int mt, nt;
  for (int ti = 0; tile_xcd(ti, 52, 8, mt, nt); ++ti) {
    f32x4 acc[8][4]; zero_acc<8, 4>(acc);
    gemm_main<256, 128, 32>(p, acc, H + (size_t)mt * 256 * 1024, 1024, WT + (size_t)nt * 128 * 1024, 1024, 1024, (bf16_t*)smem);
    const int n0 = nt * 128;
#pragma unroll
    for (int i = 0; i < 8; ++i) {
      const int row = mt * 256 + wm * 128 + i * 16 + (lane & 15);
#pragma unroll
      for (int j = 0; j < 4; ++j) {
        const int col = n0 + wn * 64 + j * 16 + 4 * (lane >> 4);
        if (n0 < 2560) store_bf4(ZH + (size_t)row * ZHW + col, acc[i][j]);
        else if (n0 < 4480) store_bf4(ZR + (size_t)row * ZRW + (col - 2560), acc[i][j]);
        else if (n0 < 6528) store_bf4(ZM + (size_t)row * ZMW + (col - 4480), acc[i][j]);
        else if (col - 6528 < 16) *(f32x4*)(MG + (size_t)row * 16 + (col - 6528)) = acc[i][j];
      }
    }
  }
}

DI void phase_merge(const Params& p, int l, char* smem) {
  const bf16_t* H = (const bf16_t*)(p.ws + OFF_H);
  const bf16_t* WT = (const bf16_t*)(p.ws + OFF_WTIN);
  const bf16_t* WBR = (const bf16_t*)(p.ws + OFF_WTBR);
  const bf16_t* ZH = (const bf16_t*)(p.ws + OFF_ZH); const bf16_t* ZM = (const bf16_t*)(p.ws + OFF_ZM); const bf16_t* O = (const bf16_t*)(p.ws + OFF_O);
  bf16_t* MER = (bf16_t*)(p.ws + OFF_MERGED);
  const int lane = ltid() & 63, w = ltid() >> 6, wm = w >> 1, wn = w & 1;
  int mt, nt;
  for (int ti = 0; tile_xcd(ti, 16, 16, mt, nt); ++ti) {
    f32x4 accM[4][2]; zero_acc<4, 2>(accM);
#pragma unroll 1
    for (int br = 0; br < 3; ++br) {
      f32x4 accG[4][2], accP[4][2]; zero_acc<4, 2>(accG); zero_acc<4, 2>(accP);
      gemm_main<128, 64, 64>(p, accG, H + (size_t)mt * 128 * 1024, 1024, WT + (size_t)(6656 + br * 1024 + nt * 64) * 1024, 1024, 1024, (bf16_t*)smem);
      const bf16_t* Ab; int lda;
      if (br == 0) { Ab = ZH + 2048; lda = ZHW; } else if (br == 1) { Ab = O; lda = 1024; } else { Ab = ZM + 1536; lda = ZMW; }
      gemm_main<128, 64, 64>(p, accP, Ab + (size_t)mt * 128 * lda, lda, WBR + ((size_t)br * 1024 + nt * 64) * 512, 512, 512, (bf16_t*)smem);
#pragma unroll
      for (int i = 0; i < 4; ++i)
#pragma unroll
        for (int j = 0; j < 2; ++j)
#pragma unroll
          for (int e = 0; e < 4; ++e) accM[i][j][e] += sigmoidf_(accG[i][j][e]) * accP[i][j][e];
    }
#pragma unroll
    for (int i = 0; i < 4; ++i) {
      const int row = mt * 128 + wm * 64 + i * 16 + (lane & 15);
#pragma unroll
      for (int j = 0; j < 2; ++j) store_bf4(MER + (size_t)row * 1024 + nt * 64 + wn * 32 + j * 16 + 4 * (lane >> 4), accM[i][j]);
    }
  }
  float* sm = (float*)smem;
  conv_weight(p, p.in[I_WOUT] + (size_t)l * 1024 * 1024, 1024, (bf16_t*)(p.ws + OFF_WTOUT), 1024, 1024, 1, sm, blockIdx.x, gridDim.x);
  conv_weight(p, p.in[I_WFI] + (size_t)l * 1024 * 5632, 5632, (bf16_t*)(p.ws + OFF_WTFI), 1024, 5632, 2, sm, blockIdx.x, gridDim.x);
  conv_weight(p, p.in[I_WFO] + (size_t)l * DFF * 1024, 1024, (bf16_t*)(p.ws + OFF_WTFO), DFF, 1024, 1, sm, blockIdx.x, gridDim.x);
}

DI void phase_gemm_f32(const Params& p, const bf16_t* A, int K, const bf16_t* Wt, char* smem) {
  float* Y = (float*)(p.ws + OFF_Y);
  const int lane = ltid() & 63, w = ltid() >> 6, wm = w >> 1, wn = w & 1;
  int mt, nt;
  for (int ti = 0; tile_xcd(ti, 8, 8, mt, nt); ++ti) {
    f32x4 acc[8][4]; zero_acc<8, 4>(acc);
    gemm_main<256, 128, 32>(p, acc, A + (size_t)mt * 256 * K, K, Wt + (size_t)nt * 128 * K, K, K, (bf16_t*)smem);
#pragma unroll
    for (int i = 0; i < 8; ++i) {
      const int row = mt * 256 + wm * 128 + i * 16 + (lane & 15);
#pragma unroll
      for (int j = 0; j < 4; ++j) *(f32x4*)(Y + (size_t)row * 1024 + nt * 128 + wn * 64 + j * 16 + 4 * (lane >> 4)) = acc[i][j];
    }
  }
}
DI void phase_ffn_in(const Params& p, char* smem) {
  const bf16_t* H = (const bf16_t*)(p.ws + OFF_H);
  const bf16_t* Wt = (const bf16_t*)(p.ws + OFF_WTFI);
  bf16_t* ACT = (bf16_t*)(p.ws + OFF_ACT);
  const int lane = ltid() & 63, w = ltid() >> 6, wm = w >> 1, wn = w & 1;
  int mt, nt;
  for (int ti = 0; tile_xcd(ti, 44, 8, mt, nt); ++ti) {
    f32x4 acc[8][4]; zero_acc<8, 4>(acc);
    gemm_main<256, 128, 32>(p, acc, H + (size_t)mt * 256 * 1024, 1024, Wt + (size_t)nt * 128 * 1024, 1024, 1024, (bf16_t*)smem);
#pragma unroll
    for (int i = 0; i < 8; ++i) {
      const int row = mt * 256 + wm * 128 + i * 16 + (lane & 15);
#pragma unroll
      for (int jj = 0; jj < 2; ++jj) {
        f32x4 u = acc[i][2 * jj], g = acc[i][2 * jj + 1], o;
#pragma unroll
        for (int e = 0; e < 4; ++e) o[e] = siluf_(g[e]) * u[e];
        const int col = (nt * 128 + wn * 64 + jj * 32) / 2 + 4 * (lane >> 4);
        store_bf4(ACT + (size_t)row * DFF + col, o);
      }
    }
  }
}

struct Seq { int base, T, grid, b; bool sample; };
DI Seq get_seq(int s) { Seq q; if (s < 32) { q.base = s * 256; q.T = 256; q.grid = 0; q.b = s; q.sample = false; } else { q.b = s - 32; q.base = 8192 + q.b * 2048; q.T = 2048; q.grid = 1; q.sample = true; } return q; }

DI float rw_shift(const bf16_t* ZR, const float* mu, int base, int t, int T, int grid, int col) {
  const bf16_t* pp = ZR + (size_t)(base + t) * ZRW + col;
  const float y = bf2f(*pp);
  if (!grid) {
    const float prev = t > 0 ? bf2f(pp[-ZRW]) : 0.f, nxt = t < T - 1 ? bf2f(pp[ZRW]) : 0.f;
    return y + mu[col] * (prev - y) + mu[ZRW + col] * (nxt - y);
  }
  const int gc = t & 63, gr = t >> 6;
  const float left = gc > 0 ? bf2f(pp[-ZRW]) : 0.f, right = gc < 63 ? bf2f(pp[ZRW]) : 0.f;
  const float up = gr > 0 ? bf2f(pp[-64 * ZRW]) : 0.f, down = gr < 31 ? bf2f(pp[64 * ZRW]) : 0.f;
  return y + mu[col] * (left - y) + mu[ZRW + col] * (right - y) + mu[2 * ZRW + col] * (up - y) + mu[3 * ZRW + col] * (down - y);
}

DI void rw_shift8(const bf16_t* ZR, const float* mu, int base, int t, int T, int grid, int col0, float (&out)[8]) {
  const bf16_t* pp = ZR + (size_t)(base + t) * ZRW + col0;
  const bf16x8 y = *(const bf16x8*)pp;
  float yv[8];
#pragma unroll
  for (int e = 0; e < 8; ++e) { yv[e] = bf2f((bf16_t)y[e]); out[e] = yv[e]; }
  const int nn = grid ? 4 : 2;
#pragma unroll 1
  for (int n = 0; n < nn; ++n) {
    bool valid; int off;
    if (!grid) { valid = n == 0 ? t > 0 : t < T - 1; off = n == 0 ? -ZRW : ZRW; }
    else { const int gc = t & 63, gr = t >> 6; valid = n == 0 ? gc > 0 : n == 1 ? gc < 63 : n == 2 ? gr > 0 : gr < 31; off = n == 0 ? -ZRW : n == 1 ? ZRW : n == 2 ? -64 * ZRW : 64 * ZRW; }
    const f32x4 m0 = *(const f32x4*)(mu + n * ZRW + col0), m1 = *(const f32x4*)(mu + n * ZRW + col0 + 4);
    bf16x8 nb = y;
    if (valid) nb = *(const bf16x8*)(pp + off);
#pragma unroll
    for (int e = 0; e < 8; ++e) { const float nv_ = valid ? bf2f((bf16_t)nb[e]) : 0.f; const float mm = e < 4 ? m0[e & 3] : m1[e & 3]; out[e] += mm * (nv_ - yv[e]); }
  }
}

DI void rw_load8(const bf16_t* ZR, int base, int t, int T, int grid, int col0, bf16x8 (&v)[5]) {
  const bf16_t* pp = ZR + (size_t)(base + t) * ZRW + col0;
  const int gc = t & 63, gr = t >> 6;
  const int o1 = grid ? (gc > 0 ? -ZRW : 0) : (t > 0 ? -ZRW : 0);
  const int o2 = grid ? (gc < 63 ? ZRW : 0) : (t < T - 1 ? ZRW : 0);
  v[0] = *(const bf16x8*)pp;
  v[1] = *(const bf16x8*)(pp + o1);
  v[2] = *(const bf16x8*)(pp + o2);
  if (grid) {
    v[3] = *(const bf16x8*)(pp + (gr > 0 ? -64 * ZRW : 0)); v[4] = *(const bf16x8*)(pp + (gr < 31 ? 64 * ZRW : 0));
  } else {
    v[3] = (bf16x8){0, 0, 0, 0, 0, 0, 0, 0}; v[4] = (bf16x8){0, 0, 0, 0, 0, 0, 0, 0};
  }
}
DI unsigned rw_valid(int t, int T, int grid) {
  if (!grid) return (t > 0 ? 1u : 0u) | (t < T - 1 ? 2u : 0u);
  const int gc = t & 63, gr = t >> 6;
  return (gc > 0 ? 1u : 0u) | (gc < 63 ? 2u : 0u) | (gr > 0 ? 4u : 0u) | (gr < 31 ? 8u : 0u);
}
DI void rw_apply8(const bf16x8 (&v)[5], const float* mu, int grid, unsigned valid, int col0, float (&out)[8]) {
  float yv[8];
#pragma unroll
  for (int e = 0; e < 8; ++e) { yv[e] = bf2f((bf16_t)v[0][e]); out[e] = yv[e]; }
#pragma unroll
  for (int n = 0; n < 4; ++n) {
    if (n < 2 || grid) {
      const f32x4 m0 = *(const f32x4*)(mu + n * ZRW + col0), m1 = *(const f32x4*)(mu + n * ZRW + col0 + 4);
      const bool ok = (valid >> n) & 1u;
#pragma unroll
      for (int e = 0; e < 8; ++e) out[e] += (e < 4 ? m0[e & 3] : m1[e & 3]) * ((ok ? bf2f((bf16_t)v[1 + n][e]) : 0.f) - yv[e]);
    }
  }
}
DI void rw_apply8_lds(const bf16x8 (&v)[5], const float* mu5c, const float* c0c, int grid, unsigned valid, float (&out)[8]) {
  {
    const f32x4 c0 = *(const f32x4*)c0c, c1 = *(const f32x4*)(c0c + 4);
#pragma unroll
    for (int e = 0; e < 8; ++e) out[e] = bf2f((bf16_t)v[0][e]) * (e < 4 ? c0[e & 3] : c1[e & 3]);
  }
#pragma unroll
  for (int n = 0; n < 4; ++n) {
    if (n < 2 || grid) {
      const f32x4 m0 = *(const f32x4*)(mu5c + n * 320), m1 = *(const f32x4*)(mu5c + n * 320 + 4);
      const float ok = ((valid >> n) & 1u) ? 1.0f : 0.0f;
#pragma unroll
      for (int e = 0; e < 8; ++e) out[e] += (e < 4 ? m0[e & 3] : m1[e & 3]) * ok * bf2f((bf16_t)v[1 + n][e]);
    }
  }
}
DI float fast_tanh(float x) { return 1.0f - 2.0f / (1.0f + __expf(2.0f * x)); }
template <int N> DI float dpp_row_shr0(float x) { return __int_as_float(__builtin_amdgcn_update_dpp(0, __float_as_int(x), 0x110 + N, 0xF, 0xF, false)); }

DI void rwkv_item(const Params& p, int l, int s, int hh, int d, char* smem) {
  const Seq q = get_seq(s);
  const int tid0 = ltid();
  const int w = __builtin_amdgcn_readfirstlane(tid0 >> 6), vb = w >> 1, kb = w & 1;
  int tid = tid0, lane = tid & 63, l15 = lane & 15, qq = lane >> 4, r32 = lane & 31, h = lane >> 5;
  const bf16_t* ZR = (const bf16_t*)(p.ws + OFF_ZR);
  bf16_t* O = (bf16_t*)(p.ws + OFF_O);
  const float* mu = p.in[I_MU] + (size_t)l * 4 * ZRW;
  bf16_t* KHr = (bf16_t*)smem;
  bf16_t* BCr = KHr + 16 * 72;
  bf16_t* KC = BCr + 16 * 72;
  bf16_t* RH = KC + 16 * 72;
  bf16_t* Sb = RH + 16 * 72;
  bf16_t* Wb2 = (bf16_t*)smem;
  bf16_t* Ab2 = Wb2 + 64 * 72;
  float* mu5 = (float*)(smem + 18432);
  bf16_t* actW = (bf16_t*)(smem + 23552);
  bf16_t* actA = actW + 16 * 72;
  float* shR = (float*)(smem + 28160);
  float* shK = shR + 1024; float* shV = shK + 1024;
  bf16_t* VT = (bf16_t*)(smem + 40448);
  bf16_t* UNT = VT + 64 * 40;
  bf16_t* KBT = UNT + 64 * 40;
  bf16_t* BBT = KBT + 64 * 24;
  float* PL = (float*)(smem + 56832);
  float* npart = PL + 64;
  float* MN = (float*)(smem + 57344);
  float* G0 = (float*)(smem + 61440);
  bf16_t* ArkM = (bf16_t*)(smem + 65536);
  bf16_t* ArbM = ArkM + 16 * 40;
  float* c0t = (float*)(smem + 68096);
  __syncthreads();
  for (int e = tid; e < 4096; e += NTHR) {
    const int i = e >> 6, c = e & 63;
    Wb2[c * 72 + i] = f2bf(p.in[I_W2][((size_t)(l * 2 + d) * 64 + i) * 512 + 64 * hh + c]);
    Ab2[c * 72 + i] = f2bf(p.in[I_A2][((size_t)(l * 2 + d) * 64 + i) * 512 + 64 * hh + c]);
  }
  for (int e = tid; e < 1280; e += NTHR) {
    const int n = e / 320, rem = e % 320, arr = rem >> 6, c = rem & 63;
    const int col = arr == 0 ? 64 * hh + c : arr == 1 ? 512 + 64 * hh + c : arr == 2 ? 1024 + 64 * hh + c : arr == 3 ? 1536 + 64 * d + c : 1664 + 64 * d + c;
    mu5[e] = mu[n * ZRW + col];
  }
  for (int e = tid; e < 320; e += NTHR) {
    const int arr = e >> 6, c = e & 63;
    const int col = arr == 0 ? 64 * hh + c : arr == 1 ? 512 + 64 * hh + c : arr == 2 ? 1024 + 64 * hh + c : arr == 3 ? 1536 + 64 * d + c : 1664 + 64 * d + c;
    float sm_ = mu[col] + mu[ZRW + col];
    if (q.grid) sm_ += mu[2 * ZRW + col] + mu[3 * ZRW + col];
    c0t[e] = 1.0f - sm_;
  }
  const int cB0 = 16 * w + 4 * qq;
  float w0c[4], a0c[4], kkc[4], kac[4];
#pragma unroll
  for (int g = 0; g < 4; ++g) {
    w0c[g] = p.in[I_W0][(l * 2 + d) * 512 + 64 * hh + cB0 + g]; a0c[g] = p.in[I_A0][(l * 2 + d) * 512 + 64 * hh + cB0 + g];
    kkc[g] = p.in[I_KK][l * 512 + 64 * hh + cB0 + g]; kac[g] = p.in[I_KA][l * 512 + 64 * hh + cB0 + g];
  }
  f32x16 S;
  if (q.sample) {
    const float* st = p.in[I_SR] + ((((size_t)q.b * 2 + l) * 2 + d) * 8 + hh) * 4096;
#pragma unroll
    for (int g = 0; g < 16; ++g) S[g] = st[(32 * vb + crow(g, h)) * 64 + 32 * kb + r32];
  } else {
#pragma unroll
    for (int g = 0; g < 16; ++g) S[g] = 0.f;
  }
  __syncthreads();
  bf16x8 bW[2], bA[2];
#pragma unroll
  for (int ks = 0; ks < 2; ++ks) { bW[ks] = *(const bf16x8*)(Wb2 + (16 * w + l15) * 72 + ks * 32 + qq * 8); bA[ks] = *(const bf16x8*)(Ab2 + (16 * w + l15) * 72 + ks * 32 + qq * 8); }
  __syncthreads();
  for (int e = tid; e < (2 * 64 * 40 + 2 * 64 * 24) / 2; e += NTHR) ((unsigned*)VT)[e] = 0u;
  for (int e = tid; e < (2 * 16 * 40) / 2; e += NTHR) ((unsigned*)ArkM)[e] = 0u;
  const int nch = q.T / 16;
  bf16x8 pf[3][5];
  const int jA = (tid0 & 127) >> 3, c8A = (tid0 & 7) * 8, wh = w >> 1;
#define RW_CB(arr) ((arr) == 0 ? 64 * hh : (arr) == 1 ? 512 + 64 * hh : (arr) == 2 ? 1024 + 64 * hh : (arr) == 3 ? 1536 + 64 * d : 1664 + 64 * d)
#define RW_ISSUE(chn) { const int pos = (chn) * 16 + jA, t = d ? q.T - 1 - pos : pos; _Pragma("unroll") for (int gi = 0; gi < 3; ++gi) { if (gi < 2 || w < 2) { \
      rw_load8(ZR, q.base, t, q.T, q.grid, RW_CB(2 * gi + wh) + c8A, pf[gi]); } } }
#pragma unroll
  for (int g = 0; g < 4; ++g) asm volatile("" : "+v"(w0c[g]), "+v"(a0c[g]), "+v"(kkc[g]), "+v"(kac[g]));
  asm volatile("" : "+v"(S));
  RW_ISSUE(0)
#pragma unroll 1
  for (int ch = 0; ch < nch; ++ch) {
    tid = tid0; asm volatile("" : "+v"(tid));
    lane = tid & 63; l15 = lane & 15; qq = lane >> 4; r32 = lane & 31; h = lane >> 5;
    __syncthreads();
    {
      const int pos_ = ch * 16 + jA, t_ = d ? q.T - 1 - pos_ : pos_;
      const unsigned vd_ = rw_valid(t_, q.T, q.grid);
#pragma unroll
      for (int gi = 0; gi < 3; ++gi) {
        if (gi < 2 || w < 2) {
          const int arr = 2 * gi + wh;
          float val[8];
          rw_apply8_lds(pf[gi], mu5 + arr * 64 + c8A, c0t + arr * 64 + c8A, q.grid, vd_, val);
          if (arr < 3) {
            *(f32x4*)(shR + arr * 1024 + jA * 64 + c8A) = (f32x4){val[0], val[1], val[2], val[3]};
            *(f32x4*)(shR + arr * 1024 + jA * 64 + c8A + 4) = (f32x4){val[4], val[5], val[6], val[7]};
            if (arr == 2) {
#pragma unroll
              for (int e = 0; e < 8; ++e) VT[(c8A + e) * 40 + jA] = f2bf(val[e]);
            }
          } else if (arr == 3) {
            *(u32x4*)(actW + jA * 72 + c8A) = (u32x4){pk2(fast_tanh(val[0]), fast_tanh(val[1])), pk2(fast_tanh(val[2]), fast_tanh(val[3])), pk2(fast_tanh(val[4]), fast_tanh(val[5])), pk2(fast_tanh(val[6]), fast_tanh(val[7]))};
          } else {
            *(u32x4*)(actA + jA * 72 + c8A) = (u32x4){pk2(val[0], val[1]), pk2(val[2], val[3]), pk2(val[4], val[5]), pk2(val[6], val[7])};
          }
        }
      }
    }
    asm volatile("" ::: "memory"); __builtin_amdgcn_sched_barrier(0);
    if (ch + 1 < nch) RW_ISSUE(ch + 1)
    __syncthreads();
    {
      f32x4 aw = (f32x4){0.f, 0.f, 0.f, 0.f}, aa = (f32x4){0.f, 0.f, 0.f, 0.f};
#pragma unroll
      for (int ks = 0; ks < 2; ++ks) {
        const bf16x8 fw = *(const bf16x8*)(actW + l15 * 72 + ks * 32 + qq * 8);
        const bf16x8 fa = *(const bf16x8*)(actA + l15 * 72 + ks * 32 + qq * 8);
        aw = __builtin_amdgcn_mfma_f32_16x16x32_bf16(bW[ks], fw, aw, 0, 0, 0);
        aa = __builtin_amdgcn_mfma_f32_16x16x32_bf16(bA[ks], fa, aa, 0, 0, 0);
      }
      const f32x4 kv = *(const f32x4*)(shK + l15 * 64 + cB0), rv = *(const f32x4*)(shR + l15 * 64 + cB0);
      float lw[4], av[4], kkr[4], kd[4], Lp[4], LpL[4];
      float ssq = 0.f;
#pragma unroll
      for (int g = 0; g < 4; ++g) {
        const float wl = aw[g] + w0c[g], al = aa[g] + a0c[g];
        lw[g] = -__expf(-softplusf_(-wl) - 0.5f);
        av[g] = sigmoidf_(al);
        kkr[g] = kv[g] * kkc[g];
        kd[g] = kv[g] * (1.0f + (av[g] - 1.0f) * kac[g]);
        ssq += kkr[g] * kkr[g];
        float x = lw[g];
        x += dpp_row_shr0<1>(x); x += dpp_row_shr0<2>(x); x += dpp_row_shr0<4>(x); x += dpp_row_shr0<8>(x);
        Lp[g] = x;
      }
#pragma unroll
      for (int g = 0; g < 4; ++g) LpL[g] = shfl_lane(Lp[g], (lane & 48) | 15);
      ssq += SHX(ssq, 16); ssq += SHX(ssq, 32);
      if (qq == 0) npart[w * 16 + l15] = ssq;
      float e_m1[4], e_neg[4], e_pos[4], e_end[4];
#pragma unroll
      for (int g = 0; g < 4; ++g) { e_m1[g] = __expf(Lp[g] - lw[g]); e_neg[g] = __expf(-Lp[g]); e_pos[g] = __expf(Lp[g]); e_end[g] = __expf(LpL[g] - Lp[g]); }
      *(u32x2*)(KHr + l15 * 72 + cB0) = (u32x2){pk2(kkr[0] * e_m1[0], kkr[1] * e_m1[1]), pk2(kkr[2] * e_m1[2], kkr[3] * e_m1[3])};
      *(u32x2*)(BCr + l15 * 72 + cB0) = (u32x2){pk2(kkr[0] * av[0] * e_neg[0], kkr[1] * av[1] * e_neg[1]), pk2(kkr[2] * av[2] * e_neg[2], kkr[3] * av[3] * e_neg[3])};
      *(u32x2*)(KC + l15 * 72 + cB0) = (u32x2){pk2(kd[0] * e_neg[0], kd[1] * e_neg[1]), pk2(kd[2] * e_neg[2], kd[3] * e_neg[3])};
      *(u32x2*)(RH + l15 * 72 + cB0) = (u32x2){pk2(rv[0] * e_pos[0], rv[1] * e_pos[1]), pk2(rv[2] * e_pos[2], rv[3] * e_pos[3])};
#pragma unroll
      for (int g = 0; g < 4; ++g) {
        KBT[(cB0 + g) * 24 + l15] = f2bf(kd[g] * e_end[g]);
        BBT[(cB0 + g) * 24 + l15] = f2bf(kkr[g] * av[g] * e_end[g]);
      }
      if (l15 == 15) *(f32x4*)(PL + cB0) = (f32x4){e_pos[0], e_pos[1], e_pos[2], e_pos[3]};
#pragma unroll
      for (int g = 0; g < 16; ++g) Sb[(32 * vb + crow(g, h)) * 72 + 32 * kb + r32] = f2bf(S[g]);
    }
    __syncthreads();
    f32x4 oacc = (f32x4){0.f, 0.f, 0.f, 0.f};
    {
      const bf16_t* Aop = (w < 2) ? KHr : RH;
      const bf16_t* Bop = (w == 0 || w == 3) ? BCr : KC;
      f32x4 t16 = (f32x4){0.f, 0.f, 0.f, 0.f}, g0 = (f32x4){0.f, 0.f, 0.f, 0.f};
#pragma unroll
      for (int ks = 0; ks < 2; ++ks) {
        const bf16x8 a = *(const bf16x8*)(Aop + l15 * 72 + ks * 32 + qq * 8);
        const bf16x8 b = *(const bf16x8*)(Bop + l15 * 72 + ks * 32 + qq * 8);
        t16 = __builtin_amdgcn_mfma_f32_16x16x32_bf16(a, b, t16, 0, 0, 0);
        const bf16x8 akh = *(const bf16x8*)(KHr + l15 * 72 + ks * 32 + qq * 8);
        const bf16x8 arh = *(const bf16x8*)(RH + l15 * 72 + ks * 32 + qq * 8);
        const bf16x8 bs = *(const bf16x8*)(Sb + (16 * w + l15) * 72 + ks * 32 + qq * 8);
        g0 = __builtin_amdgcn_mfma_f32_16x16x32_bf16(akh, bs, g0, 0, 0, 0);
        oacc = __builtin_amdgcn_mfma_f32_16x16x32_bf16(arh, bs, oacc, 0, 0, 0);
      }
#pragma unroll
      for (int g = 0; g < 4; ++g) G0[(4 * qq + g) * 64 + 16 * w + l15] = g0[g];
      *(f32x4*)(MN + w * 256 + l15 * 16 + 4 * qq) = t16;
    }
    __syncthreads();
    if (w == 0) {
      const float* MrT = MN; const float* NrT = MN + 256;
      f32x2 acc2[8];
#pragma unroll
      for (int pq = 0; pq < 8; ++pq) acc2[pq] = (f32x2){G0[(2 * pq) * 64 + lane], G0[(2 * pq + 1) * 64 + lane]};
      f32x4 nr[4], mr[4]; float vvj, n2s;
#pragma unroll
      for (int t4 = 0; t4 < 4; ++t4) { nr[t4] = *(const f32x4*)(NrT + 4 * t4); mr[t4] = *(const f32x4*)(MrT + 4 * t4); }
      vvj = shV[lane]; n2s = npart[0] + npart[16] + npart[32] + npart[48];
#pragma unroll
      for (int j = 0; j < 16; ++j) {
        f32x4 nrn[4], mrn[4]; float vvn = 0.f, n2n = 1.f;
#pragma unroll
        for (int t4 = 0; t4 < 4; ++t4) { nrn[t4] = (f32x4){0.f, 0.f, 0.f, 0.f}; mrn[t4] = (f32x4){0.f, 0.f, 0.f, 0.f}; }
        if (j + 1 < 16) {
#pragma unroll
          for (int t4 = 0; t4 < 4; ++t4) if (4 * t4 + 3 > j + 1) { nrn[t4] = *(const f32x4*)(NrT + (j + 1) * 16 + 4 * t4); mrn[t4] = *(const f32x4*)(MrT + (j + 1) * 16 + 4 * t4); }
          vvn = shV[(j + 1) * 64 + lane]; n2n = npart[j + 1] + npart[16 + j + 1] + npart[32 + j + 1] + npart[48 + j + 1];
        }
        const float accj = acc2[j >> 1][j & 1];
        const float unj = -accj * __builtin_amdgcn_rcpf(fmaxf(n2s, 1e-24f));
        UNT[lane * 40 + j] = f2bf(unj);
        const f32x2 vv2 = (f32x2){vvj, vvj}, un2 = (f32x2){unj, unj};
#pragma unroll
        for (int pq = 0; pq < 8; ++pq)
          if (2 * pq + 1 > j) acc2[pq] += (f32x2){nr[pq >> 1][2 * (pq & 1)], nr[pq >> 1][2 * (pq & 1) + 1]} * vv2 + (f32x2){mr[pq >> 1][2 * (pq & 1)], mr[pq >> 1][2 * (pq & 1) + 1]} * un2;
#pragma unroll
        for (int t4 = 0; t4 < 4; ++t4) { nr[t4] = nrn[t4]; mr[t4] = mrn[t4]; }
        vvj = vvn; n2s = n2n;
        __builtin_amdgcn_sched_barrier(0);
      }
    } else if (w < 3) {
      const float* src = MN + (w == 1 ? 512 : 768);
      bf16_t* dst = (w == 1) ? ArkM : ArbM;
#pragma unroll
      for (int i = 0; i < 4; ++i) { const int e = lane + 64 * i, j = e >> 4, t = e & 15; dst[t * 40 + j] = f2bf(j <= t ? src[e] : 0.f); }
    }
    __syncthreads();
    {
      const bf16x8 ak = *(const bf16x8*)(ArkM + l15 * 40 + qq * 8), ab = *(const bf16x8*)(ArbM + l15 * 40 + qq * 8);
      const bf16x8 bv = *(const bf16x8*)(VT + (16 * w + l15) * 40 + qq * 8), bu = *(const bf16x8*)(UNT + (16 * w + l15) * 40 + qq * 8);
      oacc = __builtin_amdgcn_mfma_f32_16x16x32_bf16(ak, bv, oacc, 0, 0, 0);
      oacc = __builtin_amdgcn_mfma_f32_16x16x32_bf16(ab, bu, oacc, 0, 0, 0);
#pragma unroll
      for (int g = 0; g < 4; ++g) {
        const int pos = ch * 16 + 4 * qq + g, t = d ? q.T - 1 - pos : pos;
        O[(size_t)(q.base + t) * 1024 + d * 512 + 64 * hh + 16 * w + l15] = f2bf(oacc[g]);
      }
      const float pl = PL[32 * kb + r32];
#pragma unroll
      for (int g = 0; g < 16; ++g) S[g] *= pl;
      const bf16x8 av_ = *(const bf16x8*)(VT + (32 * vb + r32) * 40 + 8 * h), au_ = *(const bf16x8*)(UNT + (32 * vb + r32) * 40 + 8 * h);
      const bf16x8 bk_ = *(const bf16x8*)(KBT + (32 * kb + r32) * 24 + 8 * h), bb_ = *(const bf16x8*)(BBT + (32 * kb + r32) * 24 + 8 * h);
      S = __builtin_amdgcn_mfma_f32_32x32x16_bf16(av_, bk_, S, 0, 0, 0);
      S = __builtin_amdgcn_mfma_f32_32x32x16_bf16(au_, bb_, S, 0, 0, 0);
    }
  }
  if (!q.sample) {
    float* dst = p.out + OUT_RW + ((((size_t)q.b * 2 + l) * 2 + d) * 8 + hh) * 4096;
#pragma unroll
    for (int g = 0; g < 16; ++g) dst[(32 * vb + crow(g, h)) * 64 + 32 * kb + r32] = S[g];
  }
}

DI void hgrn_item(const Params& p, int l, int s, int hh, int d, char* smem) {
  const Seq q = get_seq(s);
  const int tid = ltid(), lane = tid & 63, w = tid >> 6, r = lane & 31, h = lane >> 5;
  bf16_t* ZH = (bf16_t*)(p.ws + OFF_ZH);
  bf16_t* Qt = (bf16_t*)smem;
  bf16_t* Kt = Qt + 32 * 136;
  bf16_t* KhT = Kt + 32 * 136;
  bf16_t* VT = KhT + 128 * 40;
  bf16_t* Sb = VT + 128 * 40;
  bf16_t* At = Sb + 4 * 32 * 136;
  float* dL = (float*)(At + 32 * 40);
  float* tot = dL + 128;
  const float lb = ((const float*)(p.ws + OFF_LBS))[l * 512 + 128 * hh + (tid & 127)];
  f32x16 S[4];
  if (q.sample) {
    const float* st = p.in[I_SH] + ((((size_t)q.b * 2 + l) * 2 + d) * 4 + hh) * 16384;
#pragma unroll
    for (int kb = 0; kb < 4; ++kb)
#pragma unroll
      for (int g = 0; g < 16; ++g) S[kb][g] = st[(size_t)(32 * kb + crow(g, h)) * 128 + 32 * w + r];
  } else {
#pragma unroll
    for (int kb = 0; kb < 4; ++kb)
#pragma unroll
      for (int g = 0; g < 16; ++g) S[kb][g] = 0.f;
  }
  const int k = tid & 127, half = tid >> 7;
  const int nch = q.T / 32;
  u16x2 pzq[16], pv2[8];
#define HG_ISSUE(chn) { _Pragma("unroll") for (int jj = 0; jj < 16; ++jj) { const int pos = (chn) * 32 + half * 16 + jj, t = d ? q.T - 1 - pos : pos; \
      const size_t rowo = (size_t)(q.base + t) * ZHW + 128 * hh + k; pzq[jj][0] = ZH[rowo + 512 * (1 + d)]; pzq[jj][1] = ZH[rowo]; pv2[jj >> 1][jj & 1] = ZH[rowo + 1536]; } }
  { float lb_ = lb; asm volatile("" : "+v"(lb_)); (void)lb_; }
#pragma unroll
  for (int kb = 0; kb < 4; ++kb) asm volatile("" : "+v"(S[kb]));
  HG_ISSUE(0)
#pragma unroll 1
  for (int ch = 0; ch < nch; ++ch) {
    __syncthreads();
    float bl[16], kc[16], qs[16];
    {
      float b = 0.f;
#pragma unroll
      for (int jj = 0; jj < 16; ++jj) {
        const float z = bf2f(pzq[jj][0]);
        const float kcoef = (1.0f - lb) * sigmoidf_(-z);
        const float f = 1.0f - kcoef;
        b += fmaxf(__logf(f), -80.f);
        bl[jj] = b; kc[jj] = kcoef; qs[jj] = bf2f(pzq[jj][1]) * 0.08838834764831845f;
      }
      *(u32x4*)(VT + k * 40 + half * 16) = (u32x4){__builtin_bit_cast(unsigned, pv2[0]), __builtin_bit_cast(unsigned, pv2[1]), __builtin_bit_cast(unsigned, pv2[2]), __builtin_bit_cast(unsigned, pv2[3])};
      *(u32x4*)(VT + k * 40 + half * 16 + 8) = (u32x4){__builtin_bit_cast(unsigned, pv2[4]), __builtin_bit_cast(unsigned, pv2[5]), __builtin_bit_cast(unsigned, pv2[6]), __builtin_bit_cast(unsigned, pv2[7])};
      tot[half * 128 + k] = b;
    }
    if (ch + 1 < nch) HG_ISSUE(ch + 1)
    __syncthreads();
    {
      const float off = half ? tot[k] : 0.f;
      const float bL = fmaxf(tot[k] + tot[128 + k], -80.f);
      if (half == 0) dL[k] = __expf(bL);
      float kh[16];
#pragma unroll
      for (int jj = 0; jj < 16; ++jj) {
        const int j = half * 16 + jj;
        const float bj = fmaxf(off + bl[jj], -80.f);
        Qt[j * 136 + k] = f2bf(qs[jj] * __expf(bj));
        Kt[j * 136 + k] = f2bf(kc[jj] * __expf(-bj));
        kh[jj] = kc[jj] * __expf(fminf(bL - bj, 0.f));
      }
      *(u32x4*)(KhT + k * 40 + half * 16) = (u32x4){pk2(kh[0], kh[1]), pk2(kh[2], kh[3]), pk2(kh[4], kh[5]), pk2(kh[6], kh[7])};
      *(u32x4*)(KhT + k * 40 + half * 16 + 8) = (u32x4){pk2(kh[8], kh[9]), pk2(kh[10], kh[11]), pk2(kh[12], kh[13]), pk2(kh[14], kh[15])};
    }
    bf16_t* Sbw = Sb + w * 32 * 136;
#pragma unroll
    for (int kb = 0; kb < 4; ++kb)
#pragma unroll
      for (int g4 = 0; g4 < 4; ++g4) *(u32x2*)(Sbw + r * 136 + 32 * kb + crow(4 * g4, h)) = (u32x2){pk2(S[kb][4 * g4], S[kb][4 * g4 + 1]), pk2(S[kb][4 * g4 + 2], S[kb][4 * g4 + 3])};
    __syncthreads();
    bf16_t* Atw = At;
    {
      f32x16 A;
#pragma unroll
      for (int g = 0; g < 16; ++g) A[g] = 0.f;
      mma32(A, Qt, 136, Kt, 136, 128, lane);
#pragma unroll
      for (int g = 0; g < 16; ++g) { const int t = crow(g, h); Atw[t * 40 + r] = f2bf(r <= t ? A[g] : 0.f); }
    }
    __syncthreads();
    {
      f32x16 o;
#pragma unroll
      for (int g = 0; g < 16; ++g) o[g] = 0.f;
      mma32(o, Atw, 40, VT + 32 * w * 40, 40, 32, lane);
      mma32(o, Qt, 136, Sbw, 136, 128, lane);
#pragma unroll
      for (int g = 0; g < 16; ++g) {
        const int j = crow(g, h), pos = ch * 32 + j, t = d ? q.T - 1 - pos : pos;
        ZH[(size_t)(q.base + t) * ZHW + 512 * (1 + d) + 128 * hh + 32 * w + r] = f2bf(o[g]);
      }
#pragma unroll
      for (int kb = 0; kb < 4; ++kb) {
#pragma unroll
        for (int g = 0; g < 16; ++g) S[kb][g] *= dL[32 * kb + crow(g, h)];
        mma32(S[kb], KhT + 32 * kb * 40, 40, VT + 32 * w * 40, 40, 32, lane);
      }
    }
  }
  if (!q.sample) {
    float* dst = p.out + OUT_HG + ((((size_t)q.b * 2 + l) * 2 + d) * 4 + hh) * 16384;
#pragma unroll
    for (int kb = 0; kb < 4; ++kb)
#pragma unroll
      for (int g = 0; g < 16; ++g) dst[(size_t)(32 * kb + crow(g, h)) * 128 + 32 * w + r] = S[kb][g];
  }
}

DI void mlstm_item(const Params& p, int l, int s, int hh, int d, char* smem) {
  const Seq q = get_seq(s);
  const int tid = ltid(), lane = tid & 63, w = tid >> 6, r = lane & 31, h = lane >> 5;
  const bf16_t* ZM = (const bf16_t*)(p.ws + OFF_ZM);
  const float* MG = (const float*)(p.ws + OFF_MG);
  bf16_t* Hb = (bf16_t*)(p.ws + OFF_H);
  bf16_t* Qm = (bf16_t*)smem;
  bf16_t* Km = Qm + 32 * 136;
  bf16_t* KwT = Km + 32 * 136;
  bf16_t* VT = KwT + 128 * 40;
  bf16_t* Cb = VT + 128 * 40;
  bf16_t* Pt = Cb + 4 * 32 * 136;
  float* nv = (float*)(Pt + 32 * 40);
  float* sc = nv + 128;
  float* ig = sc; float* lf = sc + 32; float* gg = sc + 64; float* mtv = sc + 96; float* wi = sc + 128; float* wsr = sc + 160; float* qn = sc + 192; float* misc = sc + 224;
  float* dnw = sc + 232;
  const float gbi = p.in[I_GB][l * 16 + (2 * d) * 4 + hh], gbf = p.in[I_GB][l * 16 + (2 * d + 1) * 4 + hh];
  f32x16 C[4];
  float m;
  __syncthreads();
  if (q.sample) {
    const size_t sb = (((size_t)q.b * 2 + l) * 2 + d) * 4 + hh;
    const float* st = p.in[I_SC] + sb * 16384;
#pragma unroll
    for (int kb = 0; kb < 4; ++kb)
#pragma unroll
      for (int g = 0; g < 16; ++g) C[kb][g] = st[(size_t)(32 * kb + crow(g, h)) * 128 + 32 * w + r];
    if (tid < 128) nv[tid] = p.in[I_SN][sb * 128 + tid];
    m = p.in[I_SM][sb];
  } else {
#pragma unroll
    for (int kb = 0; kb < 4; ++kb)
#pragma unroll
      for (int g = 0; g < 16; ++g) C[kb][g] = 0.f;
    if (tid < 128) nv[tid] = 0.f;
    m = 0.f;
  }
  const int nch = q.T / 32;
  const int dd = tid & 127, half = tid >> 7;
  u16x2 pqk[16], pv2[8]; float pgi = 0.f, pgf = 0.f;
#define ML_ISSUE(chn) { _Pragma("unroll") for (int jj = 0; jj < 16; ++jj) { const int pos = (chn) * 32 + half * 16 + jj, t = d ? q.T - 1 - pos : pos; \
      const size_t rowo = (size_t)(q.base + t) * ZMW + 128 * hh + dd; pqk[jj][0] = ZM[rowo]; pqk[jj][1] = ZM[rowo + 512]; pv2[jj >> 1][jj & 1] = ZM[rowo + 1024]; } \
    if (tid < 32) { const int pos = (chn) * 32 + tid, t = d ? q.T - 1 - pos : pos; const float* mg = MG + (size_t)(q.base + t) * 16; pgi = mg[(2 * d) * 4 + hh]; pgf = mg[(2 * d + 1) * 4 + hh]; } }
#pragma unroll
  for (int kb = 0; kb < 4; ++kb) asm volatile("" : "+v"(C[kb]));
  asm volatile("" : "+v"(m));
  ML_ISSUE(0)
#pragma unroll 1
  for (int ch = 0; ch < nch; ++ch) {
    __syncthreads();
    {
#pragma unroll
      for (int jj = 0; jj < 16; ++jj) {
        const int j = half * 16 + jj;
        Qm[j * 136 + dd] = pqk[jj][0];
        Km[j * 136 + dd] = f2bf(bf2f(pqk[jj][1]) * 0.08838834764831845f);
      }
      *(u32x4*)(VT + dd * 40 + half * 16) = (u32x4){__builtin_bit_cast(unsigned, pv2[0]), __builtin_bit_cast(unsigned, pv2[1]), __builtin_bit_cast(unsigned, pv2[2]), __builtin_bit_cast(unsigned, pv2[3])};
      *(u32x4*)(VT + dd * 40 + half * 16 + 8) = (u32x4){__builtin_bit_cast(unsigned, pv2[4]), __builtin_bit_cast(unsigned, pv2[5]), __builtin_bit_cast(unsigned, pv2[6]), __builtin_bit_cast(unsigned, pv2[7])};
      if (tid < 32) {
        const float igv = pgi + gbi;
        const float lfv = -softplusf_(-(pgf + gbf));
        float g = lfv;
#pragma unroll
        for (int o = 1; o < 32; o <<= 1) { const float tt = shfl_lane(g, (lane - o) & 63); if (tid >= o) g += tt; }
        const float cs = igv - g;
        float pm = cs;
#pragma unroll
        for (int o = 1; o < 32; o <<= 1) { const float tt = shfl_lane(pm, (lane - o) & 63); if (tid >= o) pm = fmaxf(pm, tt); }
        const float mt = g + fmaxf(m, pm);
        const float gend = shfl_lane(g, 31), mn = shfl_lane(mt, 31);
        ig[tid] = igv; gg[tid] = g; mtv[tid] = mt; wi[tid] = __expf(g + m - mt);
        wsr[tid] = __expf(gend + cs - mn);
        if (tid == 0) { misc[0] = mn; misc[1] = __expf(gend + m - mn); }
      }
    }
    if (ch + 1 < nch) ML_ISSUE(ch + 1)
    __syncthreads();
    {
      {
        float kw[16];
#pragma unroll
        for (int jj = 0; jj < 16; ++jj) { const int j = half * 16 + jj; kw[jj] = bf2f(Km[j * 136 + dd]) * wsr[j]; }
        *(u32x4*)(KwT + dd * 40 + half * 16) = (u32x4){pk2(kw[0], kw[1]), pk2(kw[2], kw[3]), pk2(kw[4], kw[5]), pk2(kw[6], kw[7])};
        *(u32x4*)(KwT + dd * 40 + half * 16 + 8) = (u32x4){pk2(kw[8], kw[9]), pk2(kw[10], kw[11]), pk2(kw[12], kw[13]), pk2(kw[14], kw[15])};
      }
      const int j = tid >> 3, seg = tid & 7;
      float a = 0.f;
#pragma unroll
      for (int i = 0; i < 16; ++i) a += bf2f(Qm[j * 136 + seg * 16 + i]) * nv[seg * 16 + i];
      a += SHX(a, 1); a += SHX(a, 2); a += SHX(a, 4);
      if (seg == 0) qn[j] = a;
    }
    const float m_new = misc[0], carry = misc[1];
    bf16_t* Cbw = Cb + w * 32 * 136; bf16_t* Ptw = Pt;
#pragma unroll
    for (int kb = 0; kb < 4; ++kb)
#pragma unroll
      for (int g4 = 0; g4 < 4; ++g4) *(u32x2*)(Cbw + r * 136 + 32 * kb + crow(4 * g4, h)) = (u32x2){pk2(C[kb][4 * g4], C[kb][4 * g4 + 1]), pk2(C[kb][4 * g4 + 2], C[kb][4 * g4 + 3])};
    {
      f32x16 Sc;
#pragma unroll
      for (int g = 0; g < 16; ++g) Sc[g] = 0.f;
      mma32(Sc, Qm, 136, Km, 136, 128, lane);
      const float gs = gg[r], is = ig[r];
#pragma unroll
      for (int g = 0; g < 16; ++g) {
        const int t = crow(g, h);
        const float pv = (r <= t) ? __expf(gg[t] - gs + is - mtv[t]) * Sc[g] : 0.f;
        Ptw[t * 40 + r] = f2bf(pv);
      }
    }
    __syncthreads();
    if (lane < 32) {
      float a = 0.f;
#pragma unroll 4
      for (int i = 0; i < 32; ++i) a += bf2f(Ptw[lane * 40 + i]);
      const float den = wi[lane] * qn[lane] + a;
      dnw[lane] = 1.0f / fmaxf(fabsf(den), __expf(-mtv[lane]));
    }
    if (tid < 128) {
      float a = 0.f;
#pragma unroll 4
      for (int i = 0; i < 32; ++i) a += bf2f(KwT[tid * 40 + i]);
      nv[tid] = carry * nv[tid] + a;
    }
    __syncthreads();
    {
      f32x16 a1;
#pragma unroll
      for (int g = 0; g < 16; ++g) a1[g] = 0.f;
      mma32(a1, Qm, 136, Cbw, 136, 128, lane);
#pragma unroll
      for (int g = 0; g < 16; ++g) a1[g] *= wi[crow(g, h)];
      mma32(a1, Ptw, 40, VT + 32 * w * 40, 40, 32, lane);
#pragma unroll
      for (int g = 0; g < 16; ++g) {
        const int j = crow(g, h), pos = ch * 32 + j, t = d ? q.T - 1 - pos : pos;
        const float hv = a1[g] * dnw[j];
        Hb[(size_t)(q.base + t) * 1024 + d * 512 + 128 * hh + 32 * w + r] = f2bf(hv);
      }
#pragma unroll
      for (int kb = 0; kb < 4; ++kb) {
#pragma unroll
        for (int g = 0; g < 16; ++g) C[kb][g] *= carry;
        mma32(C[kb], KwT + 32 * kb * 40, 40, VT + 32 * w * 40, 40, 32, lane);
      }
    }
    m = m_new;
  }
  __syncthreads();
  if (!q.sample) {
    const size_t sb = (((size_t)q.b * 2 + l) * 2 + d) * 4 + hh;
    float* dst = p.out + OUT_C + sb * 16384;
#pragma unroll
    for (int kb = 0; kb < 4; ++kb)
#pragma unroll
      for (int g = 0; g < 16; ++g) dst[(size_t)(32 * kb + crow(g, h)) * 128 + 32 * w + r] = C[kb][g];
    if (tid < 128) p.out[OUT_N + sb * 128 + tid] = nv[tid];
    if (tid == 0) p.out[OUT_M + sb] = m;
  }
}

DI void phase_scan(const Params& p, int l, char* smem) {
  int* ctrL = (int*)(p.ws + OFF_CTR) + 2 * l;
  int* ctrS = ctrL + 1;
  int* sit = (int*)(smem + LDS_BYTES - 16);
  const int role = p.role;
  bool longDone = false, shortDone = false;
  for (;;) {
    const bool wantLong = (role == 0) ? !longDone : shortDone;
    if (longDone && shortDone) break;
    __syncthreads();
    if (ltid() == 0) *sit = atomicAdd(wantLong ? ctrL : ctrS, 1);
    __syncthreads();
    int it = __builtin_amdgcn_readfirstlane(*sit);
    int ty, s_, hh_, d_, rb_ = 0;
    if (wantLong) {
      if (it >= 128) { longDone = true; continue; }
      if (it < 64) { ty = 0; d_ = it & 1; hh_ = (it >> 1) & 7; s_ = 32 + (it >> 4); }
      else if (it < 96) { it -= 64; ty = 1; s_ = 32 + (it >> 3); hh_ = (it >> 1) & 3; d_ = it & 1; }
      else { it -= 96; ty = 2; s_ = 32 + (it >> 3); hh_ = (it >> 1) & 3; d_ = it & 1; }
    } else {
      if (it >= 1024) { shortDone = true; continue; }
      if (it < 512) { ty = 0; s_ = it >> 4; hh_ = (it >> 1) & 7; d_ = it & 1; }
      else if (it < 768) { it -= 512; ty = 1; s_ = it >> 3; hh_ = (it >> 1) & 3; d_ = it & 1; }
      else { it -= 768; ty = 2; s_ = it >> 3; hh_ = (it >> 1) & 3; d_ = it & 1; }
    }
    if (ty == 0) rwkv_item(p, l, s_, hh_, d_, smem);
    else if (ty == 1) hgrn_item(p, l, s_, hh_, d_, smem);
    else mlstm_item(p, l, s_, hh_, d_, smem);
  }
}

DI void phase_combine(const Params& p, int l, char* smem) {
  const int tid = ltid(), lane = tid & 63, w = tid >> 6;
  bf16_t* ZH = (bf16_t*)(p.ws + OFF_ZH); bf16_t* ZM = (bf16_t*)(p.ws + OFF_ZM); const bf16_t* ZR = (const bf16_t*)(p.ws + OFF_ZR);
  bf16_t* O = (bf16_t*)(p.ws + OFF_O); const bf16_t* Hb = (const bf16_t*)(p.ws + OFF_H);
  const float* mu = p.in[I_MU] + (size_t)l * 4 * ZRW;
  const float* g2 = p.in[I_G2] + (size_t)l * 128 * 512;
  float* sg = (float*)smem;
  float* gt = sg + 128 * 16;
  for (int blk = blockIdx.x; blk < NT / 16; blk += gridDim.x) {
    const int tok0 = blk * 16;
    int sidx, t0;
    if (tok0 < 8192) { sidx = tok0 >> 8; t0 = tok0 & 255; } else { sidx = 32 + ((tok0 - 8192) >> 11); t0 = (tok0 - 8192) & 2047; }
    const Seq q = get_seq(sidx);
    __syncthreads();
    { const int j = tid >> 4, rr0 = (tid & 15) * 8; float val[8]; bf16x8 pv[5]; rw_load8(ZR, q.base, t0 + j, q.T, q.grid, 1792 + rr0, pv); rw_apply8(pv, mu, q.grid, rw_valid(t0 + j, q.T, q.grid), 1792 + rr0, val);
#pragma unroll
      for (int e = 0; e < 8; ++e) sg[(rr0 + e) * 16 + j] = sigmoidf_(val[e]); }
    __syncthreads();
    {
      float a0[16], a1[16];
#pragma unroll
      for (int j = 0; j < 16; ++j) { a0[j] = 0.f; a1[j] = 0.f; }
#pragma unroll 1
      for (int r0 = 0; r0 < 128; r0 += 8) {
        float w0v[8], w1v[8];
#pragma unroll
        for (int q8 = 0; q8 < 8; ++q8) { w0v[q8] = g2[(r0 + q8) * 512 + tid]; w1v[q8] = g2[(r0 + q8) * 512 + 256 + tid]; }
#pragma unroll
        for (int q8 = 0; q8 < 8; ++q8) {
          const int rr = r0 + q8; const float w0 = w0v[q8], w1 = w1v[q8];
#pragma unroll
          for (int u = 0; u < 4; ++u) {
            f32x4 sv = *(const f32x4*)(sg + rr * 16 + 4 * u);
#pragma unroll
            for (int e = 0; e < 4; ++e) { a0[4 * u + e] += sv[e] * w0; a1[4 * u + e] += sv[e] * w1; }
          }
        }
      }
#pragma unroll
      for (int j = 0; j < 16; ++j) { gt[j * 512 + tid] = a0[j]; gt[j * 512 + 256 + tid] = a1[j]; }
    }
    __syncthreads();
#pragma unroll 1
    for (int jj = 0; jj < 4; ++jj) {
      const int j = w * 4 + jj, tok = tok0 + j, t = t0 + j; int c0 = lane * 8; asm volatile("" : "+v"(c0));
      {
        float o[8], rs[8], ks[8], vs[8];
        float sum = 0.f, bon = 0.f;
        {
          bf16x8 pr_[5], pk_[5], pv_[5];
          rw_load8(ZR, q.base, t, q.T, q.grid, c0, pr_); rw_load8(ZR, q.base, t, q.T, q.grid, 512 + c0, pk_); rw_load8(ZR, q.base, t, q.T, q.grid, 1024 + c0, pv_);
          const unsigned vd_ = rw_valid(t, q.T, q.grid);
          rw_apply8(pr_, mu, q.grid, vd_, c0, rs); rw_apply8(pk_, mu, q.grid, vd_, 512 + c0, ks); rw_apply8(pv_, mu, q.grid, vd_, 1024 + c0, vs);
        }
        const bf16x8 of = *(const bf16x8*)(O + (size_t)tok * 1024 + c0), ob = *(const bf16x8*)(O + (size_t)tok * 1024 + 512 + c0);
        const f32x4 rk0 = *(const f32x4*)(p.in[I_RK] + l * 512 + c0), rk1 = *(const f32x4*)(p.in[I_RK] + l * 512 + c0 + 4);
#pragma unroll
        for (int e = 0; e < 8; ++e) {
          o[e] = bf2f((bf16_t)of[e]) + bf2f((bf16_t)ob[e]);
          sum += o[e];
          bon += rs[e] * ks[e] * (e < 4 ? rk0[e & 3] : rk1[e & 3]);
        }
        sum += SHX(sum, 1); sum += SHX(sum, 2); sum += SHX(sum, 4);
        bon += SHX(bon, 1); bon += SHX(bon, 2); bon += SHX(bon, 4);
        const float mean = sum * (1.0f / 64.f);
        float var = 0.f;
#pragma unroll
        for (int e = 0; e < 8; ++e) { const float dv = o[e] - mean; var += dv * dv; }
        var += SHX(var, 1); var += SHX(var, 2); var += SHX(var, 4);
        const float rstd = rsqrtf(var * (1.0f / 64.f) + 64e-5f);
        const f32x4 lw0 = *(const f32x4*)(p.in[I_LN] + (l * 2 + 0) * 512 + c0), lw1 = *(const f32x4*)(p.in[I_LN] + (l * 2 + 0) * 512 + c0 + 4);
        const f32x4 lb0 = *(const f32x4*)(p.in[I_LN] + (l * 2 + 1) * 512 + c0), lb1 = *(const f32x4*)(p.in[I_LN] + (l * 2 + 1) * 512 + c0 + 4);
        const f32x4 gt0 = *(const f32x4*)(gt + j * 512 + c0), gt1 = *(const f32x4*)(gt + j * 512 + c0 + 4);
        bf16x8 ov;
#pragma unroll
        for (int e = 0; e < 8; ++e) {
          const float ln = (o[e] - mean) * rstd * (e < 4 ? lw0[e & 3] : lw1[e & 3]) + (e < 4 ? lb0[e & 3] : lb1[e & 3]);
          ov[e] = (short)f2bf((ln + bon * vs[e]) * (e < 4 ? gt0[e & 3] : gt1[e & 3]));
        }
        *(bf16x8*)(O + (size_t)tok * 1024 + c0) = ov;
      }
      {
        float o[8]; float ss = 0.f;
        bf16_t* zr_ = ZH + (size_t)tok * ZHW + c0;
        const bf16x8 of = *(const bf16x8*)(zr_ + 512), ob = *(const bf16x8*)(zr_ + 1024), hgv = *(const bf16x8*)(zr_ + 2048);
        const f32x4 nw0 = *(const f32x4*)(p.in[I_HNORM] + l * 512 + c0), nw1 = *(const f32x4*)(p.in[I_HNORM] + l * 512 + c0 + 4);
#pragma unroll
        for (int e = 0; e < 8; ++e) { o[e] = bf2f((bf16_t)of[e]) + bf2f((bf16_t)ob[e]); ss += o[e] * o[e]; }
        ss += SHX(ss, 1); ss += SHX(ss, 2); ss += SHX(ss, 4); ss += SHX(ss, 8);
        const float rsd = rsqrtf(ss * (1.0f / 128.f) + 1e-6f);
        bf16x8 ov;
#pragma unroll
        for (int e = 0; e < 8; ++e) ov[e] = (short)f2bf(o[e] * rsd * (e < 4 ? nw0[e & 3] : nw1[e & 3]) * siluf_(bf2f((bf16_t)hgv[e])));
        *(bf16x8*)(zr_ + 2048) = ov;
      }
      {
        float o[8]; float ss = 0.f;
        bf16_t* zm_ = ZM + (size_t)tok * ZMW + 1536 + c0;
        const bf16x8 of = *(const bf16x8*)(Hb + (size_t)tok * 1024 + c0), ob = *(const bf16x8*)(Hb + (size_t)tok * 1024 + 512 + c0), mov = *(const bf16x8*)zm_;
        const f32x4 nw0 = *(const f32x4*)(p.in[I_MNORM] + l * 512 + c0), nw1 = *(const f32x4*)(p.in[I_MNORM] + l * 512 + c0 + 4);
#pragma unroll
        for (int e = 0; e < 8; ++e) { o[e] = bf2f((bf16_t)of[e]) + bf2f((bf16_t)ob[e]); ss += o[e] * o[e]; }
        ss += SHX(ss, 1); ss += SHX(ss, 2); ss += SHX(ss, 4); ss += SHX(ss, 8);
        const float rsd = rsqrtf(ss * (1.0f / 128.f) + 1e-6f);
        bf16x8 ov;
#pragma unroll
        for (int e = 0; e < 8; ++e) ov[e] = (short)f2bf(o[e] * rsd * (e < 4 ? nw0[e & 3] : nw1[e & 3]) * sigmoidf_(bf2f((bf16_t)mov[e])));
        *(bf16x8*)zm_ = ov;
      }
    }
    __syncthreads();
#pragma unroll 1
    for (int jj = 0; jj < 4; ++jj) tok_one(p, l, 3, tok0 + w * 4 + jj, lane);
  }
}

#define XB_TMO      128
#define XB_XCNT(j)  (256  + 64 * (j))
#define XB_XSUB(j)  (1280 + 64 * (j))
#define XB_XGEN(j)  (2304 + 64 * (j))
#define XB_TOP      3328
#define XB_TOPGEN   3392
#define XCD_BAR_WORDS 3456
#define XB_SPIN_CAP (1u << 20)
#define LAS __attribute__((address_space(3)))
DI unsigned xb_ld(unsigned* p)              { return __hip_atomic_load(p, __ATOMIC_RELAXED, __HIP_MEMORY_SCOPE_AGENT); }
DI unsigned xb_add(unsigned* p, unsigned v) { return __hip_atomic_fetch_add(p, v, __ATOMIC_RELAXED, __HIP_MEMORY_SCOPE_AGENT); }
DI unsigned xb_xcc_id() { return (unsigned)__builtin_amdgcn_s_getreg((3 << 11) | 20) & 0xFu; }
#define XB_SPIN(cond, bar) do { unsigned _sp = 0; while (cond) { __builtin_amdgcn_s_sleep(1); \
    if ((++_sp & 255u) == 0u) { if (xb_ld(&(bar)[XB_TMO])) break; if (_sp > XB_SPIN_CAP) { atomicAdd(&(bar)[XB_TMO], 1u); break; } } } } while (0)
struct XcdBarrier { unsigned* bar; unsigned x; volatile LAS unsigned* st; };
DI XcdBarrier xcd_barrier_post(const Params& p, unsigned* bar, volatile LAS unsigned* st) {
  XcdBarrier b; b.bar = bar; b.x = xb_xcc_id(); b.st = st;
  if (ltid() == 0) (void)xb_add(&bar[XB_XCNT(b.x)], 1u);
  return b;
}
DI void xcd_barrier_complete(unsigned* bar, unsigned x, unsigned& nloc, unsigned& nx) {
  const unsigned G = gridDim.x * gridDim.y * gridDim.z;
  unsigned sum, cnt, mine, sp = 0u;
  for (;;) {
    sum = 0u; cnt = 0u; mine = 0u;
#pragma unroll
    for (unsigned j = 0; j < 16; ++j) { const unsigned c = xb_ld(&bar[XB_XCNT(j)]); sum += c; cnt += (c > 0u) ? 1u : 0u; mine = (j == x) ? c : mine; }
    if (sum == G) break;
    __builtin_amdgcn_s_sleep(1);
    if ((++sp & 255u) == 0u) { if (xb_ld(&bar[XB_TMO])) break; if (sp > XB_SPIN_CAP) { atomicAdd(&bar[XB_TMO], 1u); break; } }
  }
  nloc = mine > 0u ? mine : 1u; nx = cnt > 0u ? cnt : 1u;
}
DI void xcd_barrier(const Params& p, const XcdBarrier& b) {
  asm volatile("s_waitcnt vmcnt(0)" ::: "memory");
  __syncthreads();
  if (ltid() == 0) {
    unsigned* bar = b.bar;
    __builtin_amdgcn_s_waitcnt(0);
    unsigned nloc = b.st[0], nx = b.st[1];
    if (nloc == 0u) { xcd_barrier_complete(bar, b.x, nloc, nx); b.st[0] = nloc; b.st[1] = nx; }
    const unsigned old = xb_add(&bar[XB_XSUB(b.x)], 1u);
    const unsigned gen = old / nloc;
    if (old + 1u == (gen + 1u) * nloc) {
      __builtin_amdgcn_fence(__ATOMIC_RELEASE, "agent");
      asm volatile("s_waitcnt vmcnt(0)" ::: "memory");
      const unsigned og = xb_add(&bar[XB_TOP], 1u);
      const unsigned tg = og / nx;
      if (og + 1u == (tg + 1u) * nx) xb_add(&bar[XB_TOPGEN], 1u);
      else XB_SPIN(xb_ld(&bar[XB_TOPGEN]) == tg, bar);
      __builtin_amdgcn_fence(__ATOMIC_ACQUIRE, "agent");
      xb_add(&bar[XB_XGEN(b.x)], 1u);
      asm volatile("s_waitcnt vmcnt(0)" ::: "memory");
    } else {
      XB_SPIN(xb_ld(&bar[XB_XGEN(b.x)]) == gen, bar);
      __builtin_amdgcn_fence(__ATOMIC_ACQUIRE, "agent");
      asm volatile("s_waitcnt vmcnt(0)" ::: "memory");
    }
  }
  __syncthreads();
}

constexpr int NPHASE = 3 + 9 * 2;
DI void run_phase(const Params& p0, int ph, char* smem) {
  Params p = p0;
  asm volatile("" : "+s"(p.ws), "+s"(p.out));
  p.ws = as_global(p.ws); p.out = as_global(p.out);
  if (ph == 0) { phase0(p, smem); return; }
  if (ph == 1) { phase1(p); return; }
  if (ph == 2) { tok_phase(p, 0, 0); return; }
  const int l = (ph - 3) / 9, s = (ph - 3) % 9;
  switch (s) {
    case 0: phase_inproj(p, smem); break;
    case 1: phase_scan(p, l, smem); break;
    case 2: phase_combine(p, l, smem); break;
    case 3: phase_merge(p, l, smem); break;
    case 4: phase_gemm_f32(p, (const bf16_t*)(p.ws + OFF_MERGED), 1024, (const bf16_t*)(p.ws + OFF_WTOUT), smem); break;
    case 5: tok_phase(p, l, 1); break;
    case 6: phase_ffn_in(p, smem); break;
    case 7: phase_gemm_f32(p, (const bf16_t*)(p.ws + OFF_ACT), DFF, (const bf16_t*)(p.ws + OFF_WTFO), smem); break;
    case 8:
      tok_phase(p, l, 2);
      if (l + 1 < 2) {
        conv_weight(p, p.in[I_WIN] + (size_t)(l + 1) * 1024 * DIN, DIN, (bf16_t*)(p.ws + OFF_WTIN), 1024, WTIN_ROWS, 0, (float*)smem, blockIdx.x, gridDim.x);
        for (int br = 0; br < 3; ++br) conv_weight(p, p.in[I_WBR] + ((size_t)(l + 1) * 3 + br) * 512 * 1024, 1024, (bf16_t*)(p.ws + OFF_WTBR) + (size_t)br * 1024 * 512, 512, 1024, 1, (float*)smem, blockIdx.x, gridDim.x);
      }
      break;
  }
}

template <bool COOP>
__global__ void __launch_bounds__(NTHR, 2) mega(Params pk, int lo, int hi) {
  __shared__ __attribute__((aligned(16))) char smem[LDS_BYTES];
  Params p = pk;
#pragma unroll
  for (int i = 0; i < N_IN; ++i) p.in[i] = as_global(p.in[i]);
  p.ws = as_global(p.ws); p.out = as_global(p.out);
  p.wb = __builtin_amdgcn_readfirstlane((int)threadIdx.x) & ~63;
  if (COOP) {
    volatile LAS unsigned* st = (volatile LAS unsigned*)(smem + LDS_BYTES - 32);
    if (ltid() == 0) { st[0] = 0u; st[1] = 0u; }
    __syncthreads();
    phase0(p, smem);
    cg::this_grid().sync();
    XcdBarrier b = xcd_barrier_post(p, (unsigned*)(p.ws + OFF_BAR), st);
    if (ltid() == 0) {
      const unsigned hwid = (unsigned)__builtin_amdgcn_s_getreg((31 << 11) | 4);
      const unsigned key = (xb_xcc_id() << 8) | ((hwid >> 8) & 0xFFu);
      ((int*)smem)[(LDS_BYTES - 12) / 4] = (int)xb_add((unsigned*)(p.ws + OFF_ROLE) + key, 1u);
    }
    __syncthreads();
    p.role = __builtin_amdgcn_readfirstlane(((int*)smem)[(LDS_BYTES - 12) / 4]);
    for (int ph = 1; ph < hi; ++ph) {
      run_phase(p, ph, smem);
      if (ph + 1 < hi) xcd_barrier(p, b);
    }
  } else {
    for (int ph = lo; ph < hi; ++ph) run_phase(p, ph, smem);
  }
}

extern "C" void kernel_launch(void* const* d_in, const int* in_sizes, int n_in, void* d_out, int out_size, void* d_ws, size_t ws_size, hipStream_t stream) {
  Params p{};
  for (int i = 0; i < N_IN; ++i) p.in[i] = (const float*)d_in[i];
  p.out = (float*)d_out; p.ws = (char*)d_ws;
  if (ws_size < WS_NEED) fprintf(stderr, "workspace too small: %zu < %zu\n", ws_size, (size_t)WS_NEED);
  static int grid_blocks = 0;
  if (!grid_blocks) {
    int dev = 0, cus = 0, per_cu = 0;
    hipGetDevice(&dev);
    hipDeviceGetAttribute(&cus, hipDeviceAttributeMultiprocessorCount, dev);
    hipOccupancyMaxActiveBlocksPerMultiprocessor(&per_cu, mega<true>, NTHR, 0);
    if (per_cu > 2) per_cu = 2;
    grid_blocks = cus * per_cu;
  }
  int lo = 0, hi = NPHASE;
  void* args[] = {&p, &lo, &hi};
  hipError_t e = hipLaunchCooperativeKernel((void*)mega<true>, dim3(grid_blocks), dim3(NTHR), args, 0, stream);
  if (e != hipSuccess) fprintf(stderr, "cooperative launch failed: %s (grid %d)\n", hipGetErrorString(e), grid_blocks);
}
```

```cpp
#include <hip/hip_runtime.h>
#include <hip/hip_cooperative_groups.h>
#include <cstdio>
namespace cg = cooperative_groups;

typedef unsigned short bf16_t;
typedef short bf16x8 __attribute__((ext_vector_type(8)));
typedef float f32x4 __attribute__((ext_vector_type(4)));
typedef float f32x2 __attribute__((ext_vector_type(2)));
typedef float f32x16 __attribute__((ext_vector_type(16)));
typedef unsigned short u16x4 __attribute__((ext_vector_type(4)));
typedef unsigned short u16x2 __attribute__((ext_vector_type(2)));
typedef unsigned u32x4 __attribute__((ext_vector_type(4)));
typedef unsigned u32x2 __attribute__((ext_vector_type(2)));
static __device__ __forceinline__ unsigned pk2(float lo, float hi) { typedef __bf16 b2 __attribute__((ext_vector_type(2))); typedef float f2 __attribute__((ext_vector_type(2))); return __builtin_bit_cast(unsigned, __builtin_convertvector((f2){lo, hi}, b2)); }

#define DI __device__ __forceinline__
#define GAS __attribute__((address_space(1)))
template <class T> static __device__ __forceinline__ T* as_global(T* q) { return (T*)(GAS T*)(unsigned long long)q; }

constexpr int NT = 16384;
constexpr int DM = 1024;
constexpr int NTHR = 256;
constexpr int DIN = 9616;
constexpr int ZHW = 2560, ZRW = 1920, ZMW = 2048;
constexpr int WTIN_ROWS = 9728;
constexpr int DFF = 2816;

constexpr size_t OFF_WTIN = 0;
constexpr size_t OFF_WTBR = OFF_WTIN + (size_t)WTIN_ROWS * 1024 * 2;
constexpr size_t OFF_H    = OFF_WTBR + (size_t)3 * 1024 * 512 * 2;
constexpr size_t OFF_ZH   = OFF_H + (size_t)NT * 1024 * 2;
constexpr size_t OFF_ZR   = OFF_ZH + (size_t)NT * ZHW * 2;
constexpr size_t OFF_ZM   = OFF_ZR + (size_t)NT * ZRW * 2;
constexpr size_t OFF_MG   = OFF_ZM + (size_t)NT * ZMW * 2;
constexpr size_t OFF_O    = OFF_MG + (size_t)NT * 16 * 4;
constexpr size_t OFF_MOD  = OFF_O + (size_t)NT * 1024 * 2;
constexpr size_t OFF_LBS  = OFF_MOD + (size_t)2 * 5 * 6144 * 4;
constexpr size_t OFF_CTR  = OFF_LBS + 2 * 512 * 4;
constexpr size_t OFF_BAR  = OFF_CTR + 256;
constexpr size_t OFF_ROLE = OFF_BAR + 3456 * 4;
constexpr size_t WS_NEED  = OFF_ROLE + 4096 * 4;
constexpr size_t OFF_MODP = OFF_ZH;
constexpr size_t OFF_WTOUT = OFF_ZR;
constexpr size_t OFF_WTFI  = OFF_WTOUT + (size_t)1024 * 1024 * 2;
constexpr size_t OFF_WTFO  = OFF_WTFI + (size_t)5632 * 1024 * 2;
constexpr size_t OFF_MERGED = OFF_WTFO + (size_t)1024 * 2816 * 2;
constexpr size_t OFF_Y    = OFF_ZH;
constexpr size_t OFF_ACT  = OFF_ZM;

constexpr size_t OUT_HG = 16777216, OUT_RW = 25165824, OUT_C = 29360128, OUT_N = 37748736, OUT_M = 37814272;

enum { I_XP = 0, I_XS, I_SH, I_SR, I_SC, I_SN, I_SM, I_C, I_CCTX, I_WADA, I_BADA, I_NORMS, I_WIN, I_HLB, I_HNORM, I_MU, I_W0, I_W2,
       I_A0, I_A2, I_G2, I_KK, I_KA, I_RK, I_LN, I_GB, I_MNORM, I_WBR, I_WOUT, I_WFI, I_WFO, N_IN };

struct Params { const float* in[N_IN]; float* out; char* ws; int wb; int role; };

constexpr int LDS_BYTES = 77824;

DI bf16_t f2bf(float f) { return __builtin_bit_cast(unsigned short, (__bf16)f); }
DI float bf2f(bf16_t h) { return __uint_as_float(((unsigned)h) << 16); }
DI float sigmoidf_(float x) { return 1.0f / (1.0f + __expf(-x)); }
DI float siluf_(float x) { return x / (1.0f + __expf(-x)); }
DI float softplusf_(float x) { return x > 20.f ? x : __logf(1.0f + __expf(x)); }
DI float dpp_xor1(float x) { return __int_as_float(__builtin_amdgcn_mov_dpp(__float_as_int(x), 0xB1, 0xF, 0xF, true)); }
DI float dpp_xor2(float x) { return __int_as_float(__builtin_amdgcn_mov_dpp(__float_as_int(x), 0x4E, 0xF, 0xF, true)); }
DI float shfl_lane(float v, int src) { return __int_as_float(__builtin_amdgcn_ds_bpermute(src << 2, __float_as_int(v))); }
#define SHX(v, m) shfl_lane((v), lane ^ (m))
DI float wave_sum(float v, int lane) { v += dpp_xor1(v); v += dpp_xor2(v); v += SHX(v, 4); v += SHX(v, 8); v += SHX(v, 16); v += SHX(v, 32); return v; }
DI int ltid_(int wb) { int t = wb + (int)__builtin_amdgcn_mbcnt_hi(~0u, __builtin_amdgcn_mbcnt_lo(~0u, 0u)); asm volatile("" : "+v"(t)); return t; }
#define ltid() ltid_(p.wb)
DI int crow(int reg, int h) { return (reg & 3) + 8 * (reg >> 2) + 4 * h; }

DI int tok_cond(int tok) { return tok < 8192 ? 0 : 1 + ((tok - 8192) >> 11); }
DI const float* x_in_row(const Params& p, int tok) { return tok < 8192 ? p.in[I_XP] + (size_t)tok * DM : p.in[I_XS] + (size_t)(tok - 8192) * DM; }

DI void mma32(f32x16& acc, const bf16_t* A, int lda, const bf16_t* B, int ldb, int K, int lane) {
  const int r = lane & 31, h = lane >> 5;
#pragma unroll 2
  for (int kk = 0; kk < K; kk += 16) {
    bf16x8 a = *(const bf16x8*)(A + r * lda + kk + 8 * h);
    bf16x8 b = *(const bf16x8*)(B + r * ldb + kk + 8 * h);
    acc = __builtin_amdgcn_mfma_f32_32x32x16_bf16(a, b, acc, 0, 0, 0);
  }
}

template <int BM, int BN, int BK>
DI void gemm_main(const Params& p, f32x4 (&acc)[BM / 32][BN / 32], const bf16_t* __restrict__ A, int lda, const bf16_t* __restrict__ B, int ldb, int K, bf16_t* sm) {
  constexpr int MI = BM / 32, NJ = BN / 32, LS = BK + 8, CPR = BK / 8, ACH = BM * BK / 2048, BCH = BN * BK / 2048, KS = BK / 32, RPI = 256 / CPR;
  const int tid = ltid(), lane = tid & 63, w = tid >> 6, wm = w >> 1, wn = w & 1;
  bf16_t* As = sm; bf16_t* Bs = sm + 2 * BM * LS;
  bf16x8 ra[ACH], rb[BCH];
  const int nk = K / BK;
  const int lrow = tid / CPR, lkc = (tid % CPR) * 8;
#pragma unroll
  for (int i = 0; i < ACH; ++i) ra[i] = *(const bf16x8*)(A + (size_t)(lrow + RPI * i) * lda + lkc);
#pragma unroll
  for (int i = 0; i < BCH; ++i) rb[i] = *(const bf16x8*)(B + (size_t)(lrow + RPI * i) * ldb + lkc);
  __syncthreads();
#pragma unroll
  for (int i = 0; i < ACH; ++i) *(bf16x8*)(As + (lrow + RPI * i) * LS + lkc) = ra[i];
#pragma unroll
  for (int i = 0; i < BCH; ++i) *(bf16x8*)(Bs + (lrow + RPI * i) * LS + lkc) = rb[i];
  __syncthreads();
  for (int kt = 0; kt < nk; ++kt) {
    const int buf = kt & 1;
    if (kt + 1 < nk) {
      const int k0 = (kt + 1) * BK + lkc;
#pragma unroll
      for (int i = 0; i < ACH; ++i) ra[i] = *(const bf16x8*)(A + (size_t)(lrow + RPI * i) * lda + k0);
#pragma unroll
      for (int i = 0; i < BCH; ++i) rb[i] = *(const bf16x8*)(B + (size_t)(lrow + RPI * i) * ldb + k0);
    }
    const bf16_t* as = As + buf * BM * LS + (wm * (BM / 2) + (lane & 15)) * LS + (lane >> 4) * 8;
    const bf16_t* bs = Bs + buf * BN * LS + (wn * (BN / 2) + (lane & 15)) * LS + (lane >> 4) * 8;
#pragma unroll
    for (int ks = 0; ks < KS; ++ks) {
      bf16x8 bfr[NJ];
#pragma unroll
      for (int j = 0; j < NJ; ++j) bfr[j] = *(const bf16x8*)(bs + j * 16 * LS + ks * 32);
      __builtin_amdgcn_s_setprio(1);
#pragma unroll
      for (int i = 0; i < MI; ++i) {
        const bf16x8 af = *(const bf16x8*)(as + i * 16 * LS + ks * 32);
#pragma unroll
        for (int j = 0; j < NJ; ++j) acc[i][j] = __builtin_amdgcn_mfma_f32_16x16x32_bf16(bfr[j], af, acc[i][j], 0, 0, 0);
      }
      __builtin_amdgcn_s_setprio(0);
    }
    if (kt + 1 < nk) {
      const int nb = buf ^ 1;
#pragma unroll
      for (int i = 0; i < ACH; ++i) *(bf16x8*)(As + nb * BM * LS + (lrow + RPI * i) * LS + lkc) = ra[i];
#pragma unroll
      for (int i = 0; i < BCH; ++i) *(bf16x8*)(Bs + nb * BN * LS + (lrow + RPI * i) * LS + lkc) = rb[i];
    }
    __syncthreads();
  }
}

template <int MI, int NJ> DI void zero_acc(f32x4 (&acc)[MI][NJ]) {
#pragma unroll
  for (int i = 0; i < MI; ++i)
#pragma unroll
    for (int j = 0; j < NJ; ++j) acc[i][j] = (f32x4){0.f, 0.f, 0.f, 0.f};
}
DI void store_bf4(bf16_t* dst, f32x4 v) { u16x4 o; o[0] = f2bf(v[0]); o[1] = f2bf(v[1]); o[2] = f2bf(v[2]); o[3] = f2bf(v[3]); *(u16x4*)dst = o; }

DI int map_col(int mode, int n) {
  if (mode == 0) return n < 6544 ? n : (n < 6656 ? -1 : n - 112);
  if (mode == 2) return ((n >> 4) & 1) ? DFF + (n >> 5) * 16 + (n & 15) : (n >> 5) * 16 + (n & 15);
  return n;
}
DI void conv_tile(const Params& p, const float* __restrict__ src, int ld_src, bf16_t* __restrict__ dst, int K, int mode, int tk, int tn, float* sm) {
  const int tid = ltid();
  __syncthreads();
  {
    const int nn = tid & 63, col = map_col(mode, tn * 64 + nn);
#pragma unroll
    for (int i = 0; i < 16; ++i) { int kk = (tid >> 6) + 4 * i; sm[kk * 65 + nn] = col >= 0 ? src[(size_t)(tk * 64 + kk) * ld_src + col] : 0.f; }
  }
  __syncthreads();
  {
    const int kk = tid & 63;
#pragma unroll
    for (int i = 0; i < 16; ++i) { int nn = (tid >> 6) + 4 * i; dst[(size_t)(tn * 64 + nn) * K + tk * 64 + kk] = f2bf(sm[kk * 65 + nn]); }
  }
}
DI void conv_weight(const Params& p, const float* src, int ld_src, bf16_t* dst, int K, int Ndst, int mode, float* sm, int bid, int nb) {
  const int tkn = K / 64, nt = tkn * (Ndst / 64);
  for (int t = bid; t < nt; t += nb) conv_tile(p, src, ld_src, dst, K, mode, t % tkn, t / tkn, sm);
}

DI void phase0(const Params& p, char* smem) {
  const int tid = ltid(), bid = blockIdx.x, nb = gridDim.x;
  float* MODP = (float*)(p.ws + OFF_MODP);
  float* sm = (float*)smem;
  if (bid == 0) { if (tid < 64) ((int*)(p.ws + OFF_CTR))[tid] = 0; for (int i = tid; i < 3456; i += NTHR) ((unsigned*)(p.ws + OFF_BAR))[i] = 0u; for (int i = tid; i < 4096; i += NTHR) ((unsigned*)(p.ws + OFF_ROLE))[i] = 0u; }
  for (int i = bid * NTHR + tid; i < 512; i += nb * NTHR) {
    float a = p.in[I_HLB][i], b = p.in[I_HLB][512 + i];
    float* L = (float*)(p.ws + OFF_LBS); L[i] = 0.f; L[512 + i] = 1.0f / (1.0f + expf(a - b));
  }
  for (int it = bid; it < 2 * 24 * 16; it += nb) {
    const int ks = it & 15, jb = (it >> 4) % 24, l = it / (16 * 24);
    __syncthreads();
    for (int e = tid; e < 5 * 64; e += NTHR) { int ci = e >> 6, k = ks * 64 + (e & 63); float cv = ci == 0 ? p.in[I_CCTX][k] : p.in[I_C][(ci - 1) * DM + k]; sm[e] = siluf_(cv); }
    __syncthreads();
    const int j = jb * 256 + tid;
    float a0 = 0, a1 = 0, a2 = 0, a3 = 0, a4 = 0;
    const float* W = p.in[I_WADA] + ((size_t)l * DM + ks * 64) * 6144 + j;
#pragma unroll 1
    for (int k0 = 0; k0 < 64; k0 += 16) {
      float wv[16];
#pragma unroll
      for (int u = 0; u < 16; ++u) wv[u] = W[(size_t)(k0 + u) * 6144];
#pragma unroll
      for (int u = 0; u < 16; ++u) { const int k = k0 + u; const float w = wv[u]; a0 += sm[k] * w; a1 += sm[64 + k] * w; a2 += sm[128 + k] * w; a3 += sm[192 + k] * w; a4 += sm[256 + k] * w; }
    }
    float* dst = MODP + ((size_t)(ks * 2 + l) * 5) * 6144 + j;
    dst[0] = a0; dst[6144] = a1; dst[2 * 6144] = a2; dst[3 * 6144] = a3; dst[4 * 6144] = a4;
  }
  conv_weight(p, p.in[I_WIN], DIN, (bf16_t*)(p.ws + OFF_WTIN), 1024, WTIN_ROWS, 0, sm, bid, nb);
  for (int br = 0; br < 3; ++br) conv_weight(p, p.in[I_WBR] + (size_t)br * 512 * 1024, 1024, (bf16_t*)(p.ws + OFF_WTBR) + (size_t)br * 1024 * 512, 512, 1024, 1, sm, bid, nb);
}
DI void phase1(const Params& p) {
  const float* MODP = (const float*)(p.ws + OFF_MODP);
  float* MOD = (float*)(p.ws + OFF_MOD);
  for (int i = blockIdx.x * NTHR + ltid(); i < 2 * 5 * 6144; i += gridDim.x * NTHR) {
    const int j = i % 6144, l = i / (5 * 6144);
    float s = p.in[I_BADA][l * 6144 + j];
    for (int ks = 0; ks < 16; ++ks) s += MODP[(size_t)ks * 2 * 5 * 6144 + i];
    MOD[i] = s;
  }
}

DI void norm_mod_store(const f32x4 (&x)[4], const float* nw, const float* sc, const float* sh, bf16_t* hrow, int lane) {
  float ss = 0.f;
#pragma unroll
  for (int i = 0; i < 4; ++i) ss += x[i][0] * x[i][0] + x[i][1] * x[i][1] + x[i][2] * x[i][2] + x[i][3] * x[i][3];
  ss = wave_sum(ss, lane);
  const float rs = rsqrtf(ss * (1.0f / DM) + 1e-6f);
#pragma unroll
  for (int i = 0; i < 4; ++i) {
    const int c = i * 256 + lane * 4;
    f32x4 w = *(const f32x4*)(nw + c), s1 = *(const f32x4*)(sc + c), s0 = *(const f32x4*)(sh + c), o;
#pragma unroll
    for (int e = 0; e < 4; ++e) o[e] = x[i][e] * rs * w[e] * (1.0f + s1[e]) + s0[e];
    store_bf4(hrow + c, o);
  }
}
DI void tok_one(const Params& p, int l, int mode, int tok, int lane) {
  const float* MOD = (const float*)(p.ws + OFF_MOD);
  bf16_t* H = (bf16_t*)(p.ws + OFF_H);
  const float* Y = (const float*)(p.ws + OFF_Y);
  const int ci = tok_cond(tok);
  const float* modl = MOD + (size_t)(l * 5 + ci) * 6144;
  const float* nwl = p.in[I_NORMS] + (size_t)l * 4 * DM;
  const bool from_in = (l == 0 && (mode == 0 || mode == 1 || mode == 3));
  const float* xr = from_in ? x_in_row(p, tok) : p.out + (size_t)tok * DM;
  f32x4 x[4];
#pragma unroll
  for (int i = 0; i < 4; ++i) x[i] = *(const f32x4*)(xr + i * 256 + lane * 4);
  if (mode == 1 || mode == 2) {
    f32x4 y[4]; float ss = 0.f;
#pragma unroll
    for (int i = 0; i < 4; ++i) { y[i] = *(const f32x4*)(Y + (size_t)tok * DM + i * 256 + lane * 4); ss += y[i][0] * y[i][0] + y[i][1] * y[i][1] + y[i][2] * y[i][2] + y[i][3] * y[i][3]; }
    ss = wave_sum(ss, lane);
    const float rs = rsqrtf(ss * (1.0f / DM) + 1e-6f);
    const float* nw = nwl + (mode == 1 ? 1 : 3) * DM;
    const float* g = modl + (mode == 1 ? 2 : 5) * DM;
#pragma unroll
    for (int i = 0; i < 4; ++i) {
      const int c = i * 256 + lane * 4;
      f32x4 w = *(const f32x4*)(nw + c), gg = *(const f32x4*)(g + c);
#pragma unroll
      for (int e = 0; e < 4; ++e) x[i][e] += gg[e] * (y[i][e] * rs * w[e]);
      *(f32x4*)(p.out + (size_t)tok * DM + c) = x[i];
    }
  }
  if (mode == 0 || mode == 3) norm_mod_store(x, nwl, modl + 1 * DM, modl + 0 * DM, H + (size_t)tok * DM, lane);
  else if (mode == 1) norm_mod_store(x, nwl + 2 * DM, modl + 4 * DM, modl + 3 * DM, H + (size_t)tok * DM, lane);
  else if (mode == 2 && l + 1 < 2) {
    const float* modn = MOD + (size_t)((l + 1) * 5 + ci) * 6144;
    norm_mod_store(x, p.in[I_NORMS] + (size_t)(l + 1) * 4 * DM, modn + 1 * DM, modn + 0 * DM, H + (size_t)tok * DM, lane);
  }
}
DI void tok_phase(const Params& p, int l, int mode) {
  const int lane = ltid() & 63, gw = blockIdx.x * 4 + (ltid() >> 6), nw = gridDim.x * 4;
  for (int tok = gw; tok < NT; tok += nw) tok_one(p, l, mode, tok, lane);
}

DI bool tile_xcd(int i, int NTN, int MTX, int& mt, int& nt) {
  const int G = gridDim.x, b = blockIdx.x, x = b & 7, j = b >> 3, nbx = (G - x + 7) >> 3;
  const int u = j + i * nbx;
  if (u >= MTX * NTN) return false;
  mt = MTX * x + (u % MTX); nt = u / MTX;
  return true;
}
DI void phase_inproj(const Params& p, char* smem) {
  const bf16_t* H = (const bf16_t*)(p.ws + OFF_H);
  const bf16_t* WT = (const bf16_t*)(p.ws + OFF_WTIN);
  bf16_t* ZH = (bf16_t*)(p.ws + OFF_ZH); bf16_t* ZR = (bf16_t*)(p.ws + OFF_ZR); bf16_t* ZM = (bf16_t*)(p.ws + OFF_ZM);
  float* MG = (float*)(p.ws + OFF_MG);
  const int lane = ltid() & 63, w = ltid() >> 6, wm = w >> 1, wn = w & 1;
  int mt, nt;
  for (int ti = 0; tile_xcd(ti, 52, 8, mt, nt); ++ti) {
    f32x4 acc[8][4]; zero_acc<8, 4>(acc);
    gemm_main<256, 128, 32>(p, acc, H + (size_t)mt * 256 * 1024, 1024, WT + (size_t)nt * 128 * 1024, 1024, 1024, (bf16_t*)smem);
    const int n0 = nt * 128;
#pragma unroll
    for (int i = 0; i < 8; ++i) {
      const int row = mt * 256 + wm * 128 + i * 16 + (lane & 15);
#pragma unroll
      for (int j = 0; j < 4; ++j) {
        const int col = n0 + wn * 64 + j * 16 + 4 * (lane >> 4);
        if (n0 < 2560) store_bf4(ZH + (size_t)row * ZHW + col, acc[i][j]);
        else if (n0 < 4480) store_bf4(ZR + (size_t)row * ZRW + (col - 2560), acc[i][j]);
        else if (n0 < 6528) store_bf4(ZM + (size_t)row * ZMW + (col - 4480), acc[i][j]);
        else if (col - 6528 < 16) *(f32x4*)(MG + (size_t)row * 16 + (col - 6528)) = acc[i][j];
      }
    }
  }
}

DI void phase_merge(const Params& p, int l, char* smem) {
  const bf16_t* H = (const bf16_t*)(p.ws + OFF_H);
  const bf16_t* WT = (const bf16_t*)(p.ws + OFF_WTIN);
  const bf16_t* WBR = (const bf16_t*)(p.ws + OFF_WTBR);
  const bf16_t* ZH = (const bf16_t*)(p.ws + OFF_ZH); const bf16_t* ZM = (const bf16_t*)(p.ws + OFF_ZM); const bf16_t* O = (const bf16_t*)(p.ws + OFF_O);
  bf16_t* MER = (bf16_t*)(p.ws + OFF_MERGED);
  const int lane = ltid() & 63, w = ltid() >> 6, wm = w >> 1, wn = w & 1;
  int mt, nt;
  for (int ti = 0; tile_xcd(ti, 16, 16, mt, nt); ++ti) {
    f32x4 accM[4][2]; zero_acc<4, 2>(accM);
#pragma unroll 1
    for (int br = 0; br < 3; ++br) {
      f32x4 accG[4][2], accP[4][2]; zero_acc<4, 2>(accG); zero_acc<4, 2>(accP);
      gemm_main<128, 64, 64>(p, accG, H + (size_t)mt * 128 * 1024, 1024, WT + (size_t)(6656 + br * 1024 + nt * 64) * 1024, 1024, 1024, (bf16_t*)smem);
      const bf16_t* Ab; int lda;
      if (br == 0) { Ab = ZH + 2048; lda = ZHW; } else if (br == 1) { Ab = O; lda = 1024; } else { Ab = ZM + 1536; lda = ZMW; }
      gemm_main<128, 64, 64>(p, accP, Ab + (size_t)mt * 128 * lda, lda, WBR + ((size_t)br * 1024 + nt * 64) * 512, 512, 512, (bf16_t*)smem);
#pragma unroll
      for (int i = 0; i < 4; ++i)
#pragma unroll
        for (int j = 0; j < 2; ++j)
#pragma unroll
          for (int e = 0; e < 4; ++e) accM[i][j][e] += sigmoidf_(accG[i][j][e]) * accP[i][j][e];
    }
#pragma unroll
    for (int i = 0; i < 4; ++i) {
      const int row = mt * 128 + wm * 64 + i * 16 + (lane & 15);
#pragma unroll
      for (int j = 0; j < 2; ++j) store_bf4(MER + (size_t)row * 1024 + nt * 64 + wn * 32 + j * 16 + 4 * (lane >> 4), accM[i][j]);
    }
  }
  float* sm = (float*)smem;
  conv_weight(p, p.in[I_WOUT] + (size_t)l * 1024 * 1024, 1024, (bf16_t*)(p.ws + OFF_WTOUT), 1024, 1024, 1, sm, blockIdx.x, gridDim.x);
  conv_weight(p, p.in[I_WFI] + (size_t)l * 1024 * 5632, 5632, (bf16_t*)(p.ws + OFF_WTFI), 1024, 5632, 2, sm, blockIdx.x, gridDim.x);
  conv_weight(p, p.in[I_WFO] + (size_t)l * DFF * 1024, 1024, (bf16_t*)(p.ws + OFF_WTFO), DFF, 1024, 1, sm, blockIdx.x, gridDim.x);
}

DI void phase_gemm_f32(const Params& p, const bf16_t* A, int K, const bf16_t* Wt, char* smem) {
  float* Y = (float*)(p.ws + OFF_Y);
  const int lane = ltid() & 63, w = ltid() >> 6, wm = w >> 1, wn = w & 1;
  int mt, nt;
  for (int ti = 0; tile_xcd(ti, 8, 8, mt, nt); ++ti) {
    f32x4 acc[8][4]; zero_acc<8, 4>(acc);
    gemm_main<256, 128, 32>(p, acc, A + (size_t)mt * 256 * K, K, Wt + (size_t)nt * 128 * K, K, K, (bf16_t*)smem);
#pragma unroll
    for (int i = 0; i < 8; ++i) {
      const int row = mt * 256 + wm * 128 + i * 16 + (lane & 15);
#pragma unroll
      for (int j = 0; j < 4; ++j) *(f32x4*)(Y + (size_t)row * 1024 + nt * 128 + wn * 64 + j * 16 + 4 * (lane >> 4)) = acc[i][j];
    }
  }
}
DI void phase_ffn_in(const Params& p, char* smem) {
  const bf16_t* H = (const bf16_t*)(p.ws + OFF_H);
  const bf16_t* Wt = (const bf16_t*)(p.ws + OFF_WTFI);
  bf16_t* ACT = (bf16_t*)(p.ws + OFF_ACT);
  const int lane = ltid() & 63, w = ltid() >> 6, wm = w >> 1, wn = w & 1;
  int mt, nt;
  for (int ti = 0; tile_xcd(ti, 44, 8, mt, nt); ++ti) {
    f32x4 acc[8][4]; zero_acc<8, 4>(acc);
    gemm_main<256, 128, 32>(p, acc, H + (size_t)mt * 256 * 1024, 1024, Wt + (size_t)nt * 128 * 1024, 1024, 1024, (bf16_t*)smem);
#pragma unroll
    for (int i = 0; i < 8; ++i) {
      const int row = mt * 256 + wm * 128 + i * 16 + (lane & 15);
#pragma unroll
      for (int jj = 0; jj < 2; ++jj) {
        f32x4 u = acc[i][2 * jj], g = acc[i][2 * jj + 1], o;
#pragma unroll
        for (int e = 0; e < 4; ++e) o[e] = siluf_(g[e]) * u[e];
        const int col = (nt * 128 + wn * 64 + jj * 32) / 2 + 4 * (lane >> 4);
        store_bf4(ACT + (size_t)row * DFF + col, o);
      }
    }
  }
}

struct Seq { int base, T, grid, b; bool sample; };
DI Seq get_seq(int s) { Seq q; if (s < 32) { q.base = s * 256; q.T = 256; q.grid = 0; q.b = s; q.sample = false; } else { q.b = s - 32; q.base = 8192 + q.b * 2048; q.T = 2048; q.grid = 1; q.sample = true; } return q; }

DI float rw_shift(const bf16_t* ZR, const float* mu, int base, int t, int T, int grid, int col) {
  const bf16_t* pp = ZR + (size_t)(base + t) * ZRW + col;
  const float y = bf2f(*pp);
  if (!grid) {
    const float prev = t > 0 ? bf2f(pp[-ZRW]) : 0.f, nxt = t < T - 1 ? bf2f(pp[ZRW]) : 0.f;
    return y + mu[col] * (prev - y) + mu[ZRW + col] * (nxt - y);
  }
  const int gc = t & 63, gr = t >> 6;
  const float left = gc > 0 ? bf2f(pp[-ZRW]) : 0.f, right = gc < 63 ? bf2f(pp[ZRW]) : 0.f;
  const float up = gr > 0 ? bf2f(pp[-64 * ZRW]) : 0.f, down = gr < 31 ? bf2f(pp[64 * ZRW]) : 0.f;
  return y + mu[col] * (left - y) + mu[ZRW + col] * (right - y) + mu[2 * ZRW + col] * (up - y) + mu[3 * ZRW + col] * (down - y);
}

DI void rw_shift8(const bf16_t* ZR, const float* mu, int base, int t, int T, int grid, int col0, float (&out)[8]) {
  const bf16_t* pp = ZR + (size_t)(base + t) * ZRW + col0;
  const bf16x8 y = *(const bf16x8*)pp;
  float yv[8];
#pragma unroll
  for (int e = 0; e < 8; ++e) { yv[e] = bf2f((bf16_t)y[e]); out[e] = yv[e]; }
  const int nn = grid ? 4 : 2;
#pragma unroll 1
  for (int n = 0; n < nn; ++n) {
    bool valid; int off;
    if (!grid) { valid = n == 0 ? t > 0 : t < T - 1; off = n == 0 ? -ZRW : ZRW; }
    else { const int gc = t & 63, gr = t >> 6; valid = n == 0 ? gc > 0 : n == 1 ? gc < 63 : n == 2 ? gr > 0 : gr < 31; off = n == 0 ? -ZRW : n == 1 ? ZRW : n == 2 ? -64 * ZRW : 64 * ZRW; }
    const f32x4 m0 = *(const f32x4*)(mu + n * ZRW + col0), m1 = *(const f32x4*)(mu + n * ZRW + col0 + 4);
    bf16x8 nb = y;
    if (valid) nb = *(const bf16x8*)(pp + off);
#pragma unroll
    for (int e = 0; e < 8; ++e) { const float nv_ = valid ? bf2f((bf16_t)nb[e]) : 0.f; const float mm = e < 4 ? m0[e & 3] : m1[e & 3]; out[e] += mm * (nv_ - yv[e]); }
  }
}

DI void rw_load8(const bf16_t* ZR, int base, int t, int T, int grid, int col0, bf16x8 (&v)[5]) {
  const bf16_t* pp = ZR + (size_t)(base + t) * ZRW + col0;
  const int gc = t & 63, gr = t >> 6;
  const int o1 = grid ? (gc > 0 ? -ZRW : 0) : (t > 0 ? -ZRW : 0);
  const int o2 = grid ? (gc < 63 ? ZRW : 0) : (t < T - 1 ? ZRW : 0);
  v[0] = *(const bf16x8*)pp;
  v[1] = *(const bf16x8*)(pp + o1);
  v[2] = *(const bf16x8*)(pp + o2);
  if (grid) {
    v[3] = *(const bf16x8*)(pp + (gr > 0 ? -64 * ZRW : 0)); v[4] = *(const bf16x8*)(pp + (gr < 31 ? 64 * ZRW : 0));
  } else {
    v[3] = (bf16x8){0, 0, 0, 0, 0, 0, 0, 0}; v[4] = (bf16x8){0, 0, 0, 0, 0, 0, 0, 0};
  }
}
DI unsigned rw_valid(int t, int T, int grid) {
  if (!grid) return (t > 0 ? 1u : 0u) | (t < T - 1 ? 2u : 0u);
  const int gc = t & 63, gr = t >> 6;
  return (gc > 0 ? 1u : 0u) | (gc < 63 ? 2u : 0u) | (gr > 0 ? 4u : 0u) | (gr < 31 ? 8u : 0u);
}
DI void rw_apply8(const bf16x8 (&v)[5], const float* mu, int grid, unsigned valid, int col0, float (&out)[8]) {
  float yv[8];
#pragma unroll
  for (int e = 0; e < 8; ++e) { yv[e] = bf2f((bf16_t)v[0][e]); out[e] = yv[e]; }
#pragma unroll
  for (int n = 0; n < 4; ++n) {
    if (n < 2 || grid) {
      const f32x4 m0 = *(const f32x4*)(mu + n * ZRW + col0), m1 = *(const f32x4*)(mu + n * ZRW + col0 + 4);
      const bool ok = (valid >> n) & 1u;
#pragma unroll
      for (int e = 0; e < 8; ++e) out[e] += (e < 4 ? m0[e & 3] : m1[e & 3]) * ((ok ? bf2f((bf16_t)v[1 + n][e]) : 0.f) - yv[e]);
    }
  }
}
DI void rw_apply8_lds(const bf16x8 (&v)[5], const float* mu5c, const float* c0c, int grid, unsigned valid, float (&out)[8]) {
  {
    const f32x4 c0 = *(const f32x4*)c0c, c1 = *(const f32x4*)(c0c + 4);
#pragma unroll
    for (int e = 0; e < 8; ++e) out[e] = bf2f((bf16_t)v[0][e]) * (e < 4 ? c0[e & 3] : c1[e & 3]);
  }
#pragma unroll
  for (int n = 0; n < 4; ++n) {
    if (n < 2 || grid) {
      const f32x4 m0 = *(const f32x4*)(mu5c + n * 320), m1 = *(const f32x4*)(mu5c + n * 320 + 4);
      const float ok = ((valid >> n) & 1u) ? 1.0f : 0.0f;
#pragma unroll
      for (int e = 0; e < 8; ++e) out[e] += (e < 4 ? m0[e & 3] : m1[e & 3]) * ok * bf2f((bf16_t)v[1 + n][e]);
    }
  }
}
DI float fast_tanh(float x) { return 1.0f - 2.0f / (1.0f + __expf(2.0f * x)); }
template <int N> DI float dpp_row_shr0(float x) { return __int_as_float(__builtin_amdgcn_update_dpp(0, __float_as_int(x), 0x110 + N, 0xF, 0xF, false)); }

DI void rwkv_item(const Params& p, int l, int s, int hh, int d, char* smem) {
  const Seq q = get_seq(s);
  const int tid0 = ltid();
  const int w = __builtin_amdgcn_readfirstlane(tid0 >> 6), vb = w >> 1, kb = w & 1;
  int tid = tid0, lane = tid & 63, l15 = lane & 15, qq = lane >> 4, r32 = lane & 31, h = lane >> 5;
  const bf16_t* ZR = (const bf16_t*)(p.ws + OFF_ZR);
  bf16_t* O = (bf16_t*)(p.ws + OFF_O);
  const float* mu = p.in[I_MU] + (size_t)l * 4 * ZRW;
  bf16_t* KHr = (bf16_t*)smem;
  bf16_t* BCr = KHr + 16 * 72;
  bf16_t* KC = BCr + 16 * 72;
  bf16_t* RH = KC + 16 * 72;
  bf16_t* Sb = RH + 16 * 72;
  bf16_t* Wb2 = (bf16_t*)smem;
  bf16_t* Ab2 = Wb2 + 64 * 72;
  float* mu5 = (float*)(smem + 18432);
  bf16_t* actW = (bf16_t*)(smem + 23552);
  bf16_t* actA = actW + 16 * 72;
  float* shR = (float*)(smem + 28160);
  float* shK = shR + 1024; float* shV = shK + 1024;
  bf16_t* VT = (bf16_t*)(smem + 40448);
  bf16_t* UNT = VT + 64 * 40;
  bf16_t* KBT = UNT + 64 * 40;
  bf16_t* BBT = KBT + 64 * 24;
  float* PL = (float*)(smem + 56832);
  float* npart = PL + 64;
  float* MN = (float*)(smem + 57344);
  float* G0 = (float*)(smem + 61440);
  bf16_t* ArkM = (bf16_t*)(smem + 65536);
  bf16_t* ArbM = ArkM + 16 * 40;
  float* c0t = (float*)(smem + 68096);
  __syncthreads();
  for (int e = tid; e < 4096; e += NTHR) {
    const int i = e >> 6, c = e & 63;
    Wb2[c * 72 + i] = f2bf(p.in[I_W2][((size_t)(l * 2 + d) * 64 + i) * 512 + 64 * hh + c]);
    Ab2[c * 72 + i] = f2bf(p.in[I_A2][((size_t)(l * 2 + d) * 64 + i) * 512 + 64 * hh + c]);
  }
  for (int e = tid; e < 1280; e += NTHR) {
    const int n = e / 320, rem = e % 320, arr = rem >> 6, c = rem & 63;
    const int col = arr == 0 ? 64 * hh + c : arr == 1 ? 512 + 64 * hh + c : arr == 2 ? 1024 + 64 * hh + c : arr == 3 ? 1536 + 64 * d + c : 1664 + 64 * d + c;
    mu5[e] = mu[n * ZRW + col];
  }
  for (int e = tid; e < 320; e += NTHR) {
    const int arr = e >> 6, c = e & 63;
    const int col = arr == 0 ? 64 * hh + c : arr == 1 ? 512 + 64 * hh + c : arr == 2 ? 1024 + 64 * hh + c : arr == 3 ? 1536 + 64 * d + c : 1664 + 64 * d + c;
    float sm_ = mu[col] + mu[ZRW + col];
    if (q.grid) sm_ += mu[2 * ZRW + col] + mu[3 * ZRW + col];
    c0t[e] = 1.0f - sm_;
  }
  const int cB0 = 16 * w + 4 * qq;
  float w0c[4], a0c[4], kkc[4], kac[4];
#pragma unroll
  for (int g = 0; g < 4; ++g) {
    w0c[g] = p.in[I_W0][(l * 2 + d) * 512 + 64 * hh + cB0 + g]; a0c[g] = p.in[I_A0][(l * 2 + d) * 512 + 64 * hh + cB0 + g];
    kkc[g] = p.in[I_KK][l * 512 + 64 * hh + cB0 + g]; kac[g] = p.in[I_KA][l * 512 + 64 * hh + cB0 + g];
  }
  f32x16 S;
  if (q.sample) {
    const float* st = p.in[I_SR] + ((((size_t)q.b * 2 + l) * 2 + d) * 8 + hh) * 4096;
#pragma unroll
    for (int g = 0; g < 16; ++g) S[g] = st[(32 * vb + crow(g, h)) * 64 + 32 * kb + r32];
  } else {
#pragma unroll
    for (int g = 0; g < 16; ++g) S[g] = 0.f;
  }
  __syncthreads();
  bf16x8 bW[2], bA[2];
#pragma unroll
  for (int ks = 0; ks < 2; ++ks) { bW[ks] = *(const bf16x8*)(Wb2 + (16 * w + l15) * 72 + ks * 32 + qq * 8); bA[ks] = *(const bf16x8*)(Ab2 + (16 * w + l15) * 72 + ks * 32 + qq * 8); }
  __syncthreads();
  for (int e = tid; e < (2 * 64 * 40 + 2 * 64 * 24) / 2; e += NTHR) ((unsigned*)VT)[e] = 0u;
  for (int e = tid; e < (2 * 16 * 40) / 2; e += NTHR) ((unsigned*)ArkM)[e] = 0u;
  const int nch = q.T / 16;
  bf16x8 pf[3][5];
  const int jA = (tid0 & 127) >> 3, c8A = (tid0 & 7) * 8, wh = w >> 1;
#define RW_CB(arr) ((arr) == 0 ? 64 * hh : (arr) == 1 ? 512 + 64 * hh : (arr) == 2 ? 1024 + 64 * hh : (arr) == 3 ? 1536 + 64 * d : 1664 + 64 * d)
#define RW_ISSUE(chn) { const int pos = (chn) * 16 + jA, t = d ? q.T - 1 - pos : pos; _Pragma("unroll") for (int gi = 0; gi < 3; ++gi) { if (gi < 2 || w < 2) { \
      rw_load8(ZR, q.base, t, q.T, q.grid, RW_CB(2 * gi + wh) + c8A, pf[gi]); } } }
#pragma unroll
  for (int g = 0; g < 4; ++g) asm volatile("" : "+v"(w0c[g]), "+v"(a0c[g]), "+v"(kkc[g]), "+v"(kac[g]));
  asm volatile("" : "+v"(S));
  RW_ISSUE(0)
#pragma unroll 1
  for (int ch = 0; ch < nch; ++ch) {
    tid = tid0; asm volatile("" : "+v"(tid));
    lane = tid & 63; l15 = lane & 15; qq = lane >> 4; r32 = lane & 31; h = lane >> 5;
    __syncthreads();
    {
      const int pos_ = ch * 16 + jA, t_ = d ? q.T - 1 - pos_ : pos_;
      const unsigned vd_ = rw_valid(t_, q.T, q.grid);
#pragma unroll
      for (int gi = 0; gi < 3; ++gi) {
        if (gi < 2 || w < 2) {
          const int arr = 2 * gi + wh;
          float val[8];
          rw_apply8_lds(pf[gi], mu5 + arr * 64 + c8A, c0t + arr * 64 + c8A, q.grid, vd_, val);
          if (arr < 3) {
            *(f32x4*)(shR + arr * 1024 + jA * 64 + c8A) = (f32x4){val[0], val[1], val[2], val[3]};
            *(f32x4*)(shR + arr * 1024 + jA * 64 + c8A + 4) = (f32x4){val[4], val[5], val[6], val[7]};
            if (arr == 2) {
#pragma unroll
              for (int e = 0; e < 8; ++e) VT[(c8A + e) * 40 + jA] = f2bf(val[e]);
            }
          } else if (arr == 3) {
            *(u32x4*)(actW + jA * 72 + c8A) = (u32x4){pk2(fast_tanh(val[0]), fast_tanh(val[1])), pk2(fast_tanh(val[2]), fast_tanh(val[3])), pk2(fast_tanh(val[4]), fast_tanh(val[5])), pk2(fast_tanh(val[6]), fast_tanh(val[7]))};
          } else {
            *(u32x4*)(actA + jA * 72 + c8A) = (u32x4){pk2(val[0], val[1]), pk2(val[2], val[3]), pk2(val[4], val[5]), pk2(val[6], val[7])};
          }
        }
      }
    }
    asm volatile("" ::: "memory"); __builtin_amdgcn_sched_barrier(0);
    if (ch + 1 < nch) RW_ISSUE(ch + 1)
    __syncthreads();
    {
      f32x4 aw = (f32x4){0.f, 0.f, 0.f, 0.f}, aa = (f32x4){0.f, 0.f, 0.f, 0.f};
#pragma unroll
      for (int ks = 0; ks < 2; ++ks) {
        const bf16x8 fw = *(const bf16x8*)(actW + l15 * 72 + ks * 32 + qq * 8);
        const bf16x8 fa = *(const bf16x8*)(actA + l15 * 72 + ks * 32 + qq * 8);
        aw = __builtin_amdgcn_mfma_f32_16x16x32_bf16(bW[ks], fw, aw, 0, 0, 0);
        aa = __builtin_amdgcn_mfma_f32_16x16x32_bf16(bA[ks], fa, aa, 0, 0, 0);
      }
      const f32x4 kv = *(const f32x4*)(shK + l15 * 64 + cB0), rv = *(const f32x4*)(shR + l15 * 64 + cB0);
      float lw[4], av[4], kkr[4], kd[4], Lp[4], LpL[4];
      float ssq = 0.f;
#pragma unroll
      for (int g = 0; g < 4; ++g) {
        const float wl = aw[g] + w0c[g], al = aa[g] + a0c[g];
        lw[g] = -__expf(-softplusf_(-wl) - 0.5f);
        av[g] = sigmoidf_(al);
        kkr[g] = kv[g] * kkc[g];
        kd[g] = kv[g] * (1.0f + (av[g] - 1.0f) * kac[g]);
        ssq += kkr[g] * kkr[g];
        float x = lw[g];
        x += dpp_row_shr0<1>(x); x += dpp_row_shr0<2>(x); x += dpp_row_shr0<4>(x); x += dpp_row_shr0<8>(x);
        Lp[g] = x;
      }
#pragma unroll
      for (int g = 0; g < 4; ++g) LpL[g] = shfl_lane(Lp[g], (lane & 48) | 15);
      ssq += SHX(ssq, 16); ssq += SHX(ssq, 32);
      if (qq == 0) npart[w * 16 + l15] = ssq;
      float e_m1[4], e_neg[4], e_pos[4], e_end[4];
#pragma unroll
      for (int g = 0; g < 4; ++g) { e_m1[g] = __expf(Lp[g] - lw[g]); e_neg[g] = __expf(-Lp[g]); e_pos[g] = __expf(Lp[g]); e_end[g] = __expf(LpL[g] - Lp[g]); }
      *(u32x2*)(KHr + l15 * 72 + cB0) = (u32x2){pk2(kkr[0] * e_m1[0], kkr[1] * e_m1[1]), pk2(kkr[2] * e_m1[2], kkr[3] * e_m1[3])};
      *(u32x2*)(BCr + l15 * 72 + cB0) = (u32x2){pk2(kkr[0] * av[0] * e_neg[0], kkr[1] * av[1] * e_neg[1]), pk2(kkr[2] * av[2] * e_neg[2], kkr[3] * av[3] * e_neg[3])};
      *(u32x2*)(KC + l15 * 72 + cB0) = (u32x2){pk2(kd[0] * e_neg[0], kd[1] * e_neg[1]), pk2(kd[2] * e_neg[2], kd[3] * e_neg[3])};
      *(u32x2*)(RH + l15 * 72 + cB0) = (u32x2){pk2(rv[0] * e_pos[0], rv[1] * e_pos[1]), pk2(rv[2] * e_pos[2], rv[3] * e_pos[3])};
#pragma unroll
      for (int g = 0; g < 4; ++g) {
        KBT[(cB0 + g) * 24 + l15] = f2bf(kd[g] * e_end[g]);
        BBT[(cB0 + g) * 24 + l15] = f2bf(kkr[g] * av[g] * e_end[g]);
      }
      if (l15 == 15) *(f32x4*)(PL + cB0) = (f32x4){e_pos[0], e_pos[1], e_pos[2], e_pos[3]};
#pragma unroll
      for (int g = 0; g < 16; ++g) Sb[(32 * vb + crow(g, h)) * 72 + 32 * kb + r32] = f2bf(S[g]);
    }
    __syncthreads();
    f32x4 oacc = (f32x4){0.f, 0.f, 0.f, 0.f};
    {
      const bf16_t* Aop = (w < 2) ? KHr : RH;
      const bf16_t* Bop = (w == 0 || w == 3) ? BCr : KC;
      f32x4 t16 = (f32x4){0.f, 0.f, 0.f, 0.f}, g0 = (f32x4){0.f, 0.f, 0.f, 0.f};
#pragma unroll
      for (int ks = 0; ks < 2; ++ks) {
        const bf16x8 a = *(const bf16x8*)(Aop + l15 * 72 + ks * 32 + qq * 8);
        const bf16x8 b = *(const bf16x8*)(Bop + l15 * 72 + ks * 32 + qq * 8);
        t16 = __builtin_amdgcn_mfma_f32_16x16x32_bf16(a, b, t16, 0, 0, 0);
        const bf16x8 akh = *(const bf16x8*)(KHr + l15 * 72 + ks * 32 + qq * 8);
        const bf16x8 arh = *(const bf16x8*)(RH + l15 * 72 + ks * 32 + qq * 8);
        const bf16x8 bs = *(const bf16x8*)(Sb + (16 * w + l15) * 72 + ks * 32 + qq * 8);
        g0 = __builtin_amdgcn_mfma_f32_16x16x32_bf16(akh, bs, g0, 0, 0, 0);
        oacc = __builtin_amdgcn_mfma_f32_16x16x32_bf16(arh, bs, oacc, 0, 0, 0);
      }
#pragma unroll
      for (int g = 0; g < 4; ++g) G0[(4 * qq + g) * 64 + 16 * w + l15] = g0[g];
      *(f32x4*)(MN + w * 256 + l15 * 16 + 4 * qq) = t16;
    }
    __syncthreads();
    if (w == 0) {
      const float* MrT = MN; const float* NrT = MN + 256;
      f32x2 acc2[8];
#pragma unroll
      for (int pq = 0; pq < 8; ++pq) acc2[pq] = (f32x2){G0[(2 * pq) * 64 + lane], G0[(2 * pq + 1) * 64 + lane]};
      float vv[16], un[16];
#pragma unroll
      for (int j = 0; j < 16; ++j) vv[j] = shV[j * 64 + lane];
      const float n2v = __builtin_amdgcn_rcpf(fmaxf(npart[l15] + npart[16 + l15] + npart[32 + l15] + npart[48 + l15], 1e-24f));
      f32x4 nr[4], mr[4];
#pragma unroll
      for (int t4 = 0; t4 < 4; ++t4) { nr[t4] = *(const f32x4*)(NrT + 4 * t4); mr[t4] = *(const f32x4*)(MrT + 4 * t4); }
#pragma unroll
      for (int j = 0; j < 16; ++j) {
        f32x4 nrn[4], mrn[4];
#pragma unroll
        for (int t4 = 0; t4 < 4; ++t4) { nrn[t4] = (f32x4){0.f, 0.f, 0.f, 0.f}; mrn[t4] = (f32x4){0.f, 0.f, 0.f, 0.f}; }
        if (j + 1 < 16) {
#pragma unroll
          for (int t4 = 0; t4 < 4; ++t4) if (4 * t4 + 3 > j + 1) { nrn[t4] = *(const f32x4*)(NrT + (j + 1) * 16 + 4 * t4); mrn[t4] = *(const f32x4*)(MrT + (j + 1) * 16 + 4 * t4); }
        }
        const float n2s = __int_as_float(__builtin_amdgcn_readlane(__float_as_int(n2v), j));
        const float unj = -acc2[j >> 1][j & 1] * n2s;
        un[j] = unj;
        const f32x2 vv2 = (f32x2){vv[j], vv[j]}, un2 = (f32x2){unj, unj};
#pragma unroll
        for (int pq = 0; pq < 8; ++pq)
          if (2 * pq + 1 > j) acc2[pq] += (f32x2){nr[pq >> 1][2 * (pq & 1)], nr[pq >> 1][2 * (pq & 1) + 1]} * vv2 + (f32x2){mr[pq >> 1][2 * (pq & 1)], mr[pq >> 1][2 * (pq & 1) + 1]} * un2;
#pragma unroll
        for (int t4 = 0; t4 < 4; ++t4) { nr[t4] = nrn[t4]; mr[t4] = mrn[t4]; }
        __builtin_amdgcn_sched_barrier(0);
      }
      *(u32x4*)(UNT + lane * 40) = (u32x4){pk2(un[0], un[1]), pk2(un[2], un[3]), pk2(un[4], un[5]), pk2(un[6], un[7])};
      *(u32x4*)(UNT + lane * 40 + 8) = (u32x4){pk2(un[8], un[9]), pk2(un[10], un[11]), pk2(un[12], un[13]), pk2(un[14], un[15])};
    } else if (w < 3) {
      const float* src = MN + (w == 1 ? 512 : 768);
      bf16_t* dst = (w == 1) ? ArkM : ArbM;
#pragma unroll
      for (int i = 0; i < 4; ++i) { const int e = lane + 64 * i, j = e >> 4, t = e & 15; dst[t * 40 + j] = f2bf(j <= t ? src[e] : 0.f); }
    }
    __syncthreads();
    {
      const bf16x8 ak = *(const bf16x8*)(ArkM + l15 * 40 + qq * 8), ab = *(const bf16x8*)(ArbM + l15 * 40 + qq * 8);
      const bf16x8 bv = *(const bf16x8*)(VT + (16 * w + l15) * 40 + qq * 8), bu = *(const bf16x8*)(UNT + (16 * w + l15) * 40 + qq * 8);
      oacc = __builtin_amdgcn_mfma_f32_16x16x32_bf16(ak, bv, oacc, 0, 0, 0);
      oacc = __builtin_amdgcn_mfma_f32_16x16x32_bf16(ab, bu, oacc, 0, 0, 0);
#pragma unroll
      for (int g = 0; g < 4; ++g) {
        const int pos = ch * 16 + 4 * qq + g, t = d ? q.T - 1 - pos : pos;
        O[(size_t)(q.base + t) * 1024 + d * 512 + 64 * hh + 16 * w + l15] = f2bf(oacc[g]);
      }
      const float pl = PL[32 * kb + r32];
#pragma unroll
      for (int g = 0; g < 16; ++g) S[g] *= pl;
      const bf16x8 av_ = *(const bf16x8*)(VT + (32 * vb + r32) * 40 + 8 * h), au_ = *(const bf16x8*)(UNT + (32 * vb + r32) * 40 + 8 * h);
      const bf16x8 bk_ = *(const bf16x8*)(KBT + (32 * kb + r32) * 24 + 8 * h), bb_ = *(const bf16x8*)(BBT + (32 * kb + r32) * 24 + 8 * h);
      S = __builtin_amdgcn_mfma_f32_32x32x16_bf16(av_, bk_, S, 0, 0, 0);
      S = __builtin_amdgcn_mfma_f32_32x32x16_bf16(au_, bb_, S, 0, 0, 0);
    }
  }
  if (!q.sample) {
    float* dst = p.out + OUT_RW + ((((size_t)q.b * 2 + l) * 2 + d) * 8 + hh) * 4096;
#pragma unroll
    for (int g = 0; g < 16; ++g) dst[(32 * vb + crow(g, h)) * 64 + 32 * kb + r32] = S[g];
  }
}

DI void hgrn_item(const Params& p, int l, int s, int hh, int d, char* smem) {
  const Seq q = get_seq(s);
  const int tid = ltid(), lane = tid & 63, w = tid >> 6, r = lane & 31, h = lane >> 5;
  bf16_t* ZH = (bf16_t*)(p.ws + OFF_ZH);
  bf16_t* Qt = (bf16_t*)smem;
  bf16_t* Kt = Qt + 32 * 136;
  bf16_t* KhT = Kt + 32 * 136;
  bf16_t* VT = KhT + 128 * 40;
  bf16_t* Sb = VT + 128 * 40;
  bf16_t* At = Sb + 4 * 32 * 136;
  float* dL = (float*)(At + 32 * 40);
  float* tot = dL + 128;
  const float lb = ((const float*)(p.ws + OFF_LBS))[l * 512 + 128 * hh + (tid & 127)];
  f32x16 S[4];
  if (q.sample) {
    const float* st = p.in[I_SH] + ((((size_t)q.b * 2 + l) * 2 + d) * 4 + hh) * 16384;
#pragma unroll
    for (int kb = 0; kb < 4; ++kb)
#pragma unroll
      for (int g = 0; g < 16; ++g) S[kb][g] = st[(size_t)(32 * kb + crow(g, h)) * 128 + 32 * w + r];
  } else {
#pragma unroll
    for (int kb = 0; kb < 4; ++kb)
#pragma unroll
      for (int g = 0; g < 16; ++g) S[kb][g] = 0.f;
  }
  const int k = tid & 127, half = tid >> 7;
  const int nch = q.T / 32;
  u16x2 pzq[16], pv2[8];
#define HG_ISSUE(chn) { _Pragma("unroll") for (int jj = 0; jj < 16; ++jj) { const int pos = (chn) * 32 + half * 16 + jj, t = d ? q.T - 1 - pos : pos; \
      const size_t rowo = (size_t)(q.base + t) * ZHW + 128 * hh + k; pzq[jj][0] = ZH[rowo + 512 * (1 + d)]; pzq[jj][1] = ZH[rowo]; pv2[jj >> 1][jj & 1] = ZH[rowo + 1536]; } }
  { float lb_ = lb; asm volatile("" : "+v"(lb_)); (void)lb_; }
#pragma unroll
  for (int kb = 0; kb < 4; ++kb) asm volatile("" : "+v"(S[kb]));
  HG_ISSUE(0)
#pragma unroll 1
  for (int ch = 0; ch < nch; ++ch) {
    __syncthreads();
    float bl[16], kc[16], qs[16];
    {
      float b = 0.f;
#pragma unroll
      for (int jj = 0; jj < 16; ++jj) {
        const float z = bf2f(pzq[jj][0]);
        const float kcoef = (1.0f - lb) * sigmoidf_(-z);
        const float f = 1.0f - kcoef;
        b += fmaxf(__logf(f), -80.f);
        bl[jj] = b; kc[jj] = kcoef; qs[jj] = bf2f(pzq[jj][1]) * 0.08838834764831845f;
      }
      *(u32x4*)(VT + k * 40 + half * 16) = (u32x4){__builtin_bit_cast(unsigned, pv2[0]), __builtin_bit_cast(unsigned, pv2[1]), __builtin_bit_cast(unsigned, pv2[2]), __builtin_bit_cast(unsigned, pv2[3])};
      *(u32x4*)(VT + k * 40 + half * 16 + 8) = (u32x4){__builtin_bit_cast(unsigned, pv2[4]), __builtin_bit_cast(unsigned, pv2[5]), __builtin_bit_cast(unsigned, pv2[6]), __builtin_bit_cast(unsigned, pv2[7])};
      tot[half * 128 + k] = b;
    }
    if (ch + 1 < nch) HG_ISSUE(ch + 1)
    __syncthreads();
    {
      const float off = half ? tot[k] : 0.f;
      const float bL = fmaxf(tot[k] + tot[128 + k], -80.f);
      if (half == 0) dL[k] = __expf(bL);
      float kh[16];
#pragma unroll
      for (int jj = 0; jj < 16; ++jj) {
        const int j = half * 16 + jj;
        const float bj = fmaxf(off + bl[jj], -80.f);
        Qt[j * 136 + k] = f2bf(qs[jj] * __expf(bj));
        Kt[j * 136 + k] = f2bf(kc[jj] * __expf(-bj));
        kh[jj] = kc[jj] * __expf(fminf(bL - bj, 0.f));
      }
      *(u32x4*)(KhT + k * 40 + half * 16) = (u32x4){pk2(kh[0], kh[1]), pk2(kh[2], kh[3]), pk2(kh[4], kh[5]), pk2(kh[6], kh[7])};
      *(u32x4*)(KhT + k * 40 + half * 16 + 8) = (u32x4){pk2(kh[8], kh[9]), pk2(kh[10], kh[11]), pk2(kh[12], kh[13]), pk2(kh[14], kh[15])};
    }
    bf16_t* Sbw = Sb + w * 32 * 136;
#pragma unroll
    for (int kb = 0; kb < 4; ++kb)
#pragma unroll
      for (int g4 = 0; g4 < 4; ++g4) *(u32x2*)(Sbw + r * 136 + 32 * kb + crow(4 * g4, h)) = (u32x2){pk2(S[kb][4 * g4], S[kb][4 * g4 + 1]), pk2(S[kb][4 * g4 + 2], S[kb][4 * g4 + 3])};
    __syncthreads();
    bf16_t* Atw = At;
    {
      f32x16 A;
#pragma unroll
      for (int g = 0; g < 16; ++g) A[g] = 0.f;
      mma32(A, Qt, 136, Kt, 136, 128, lane);
#pragma unroll
      for (int g = 0; g < 16; ++g) { const int t = crow(g, h); Atw[t * 40 + r] = f2bf(r <= t ? A[g] : 0.f); }
    }
    __syncthreads();
    {
      f32x16 o;
#pragma unroll
      for (int g = 0; g < 16; ++g) o[g] = 0.f;
      mma32(o, Atw, 40, VT + 32 * w * 40, 40, 32, lane);
      mma32(o, Qt, 136, Sbw, 136, 128, lane);
#pragma unroll
      for (int g = 0; g < 16; ++g) {
        const int j = crow(g, h), pos = ch * 32 + j, t = d ? q.T - 1 - pos : pos;
        ZH[(size_t)(q.base + t) * ZHW + 512 * (1 + d) + 128 * hh + 32 * w + r] = f2bf(o[g]);
      }
#pragma unroll
      for (int kb = 0; kb < 4; ++kb) {
#pragma unroll
        for (int g = 0; g < 16; ++g) S[kb][g] *= dL[32 * kb + crow(g, h)];
        mma32(S[kb], KhT + 32 * kb * 40, 40, VT + 32 * w * 40, 40, 32, lane);
      }
    }
  }
  if (!q.sample) {
    float* dst = p.out + OUT_HG + ((((size_t)q.b * 2 + l) * 2 + d) * 4 + hh) * 16384;
#pragma unroll
    for (int kb = 0; kb < 4; ++kb)
#pragma unroll
      for (int g = 0; g < 16; ++g) dst[(size_t)(32 * kb + crow(g, h)) * 128 + 32 * w + r] = S[kb][g];
  }
}

DI void mlstm_item(const Params& p, int l, int s, int hh, int d, char* smem) {
  const Seq q = get_seq(s);
  const int tid = ltid(), lane = tid & 63, w = tid >> 6, r = lane & 31, h = lane >> 5;
  const bf16_t* ZM = (const bf16_t*)(p.ws + OFF_ZM);
  const float* MG = (const float*)(p.ws + OFF_MG);
  bf16_t* Hb = (bf16_t*)(p.ws + OFF_H);
  bf16_t* Qm = (bf16_t*)smem;
  bf16_t* Km = Qm + 32 * 136;
  bf16_t* KwT = Km + 32 * 136;
  bf16_t* VT = KwT + 128 * 40;
  bf16_t* Cb = VT + 128 * 40;
  bf16_t* Pt = Cb + 4 * 32 * 136;
  float* nv = (float*)(Pt + 32 * 40);
  float* sc = nv + 128;
  float* ig = sc; float* lf = sc + 32; float* gg = sc + 64; float* mtv = sc + 96; float* wi = sc + 128; float* wsr = sc + 160; float* qn = sc + 192; float* misc = sc + 224;
  float* dnw = sc + 232;
  const float gbi = p.in[I_GB][l * 16 + (2 * d) * 4 + hh], gbf = p.in[I_GB][l * 16 + (2 * d + 1) * 4 + hh];
  f32x16 C[4];
  float m;
  __syncthreads();
  if (q.sample) {
    const size_t sb = (((size_t)q.b * 2 + l) * 2 + d) * 4 + hh;
    const float* st = p.in[I_SC] + sb * 16384;
#pragma unroll
    for (int kb = 0; kb < 4; ++kb)
#pragma unroll
      for (int g = 0; g < 16; ++g) C[kb][g] = st[(size_t)(32 * kb + crow(g, h)) * 128 + 32 * w + r];
    if (tid < 128) nv[tid] = p.in[I_SN][sb * 128 + tid];
    m = p.in[I_SM][sb];
  } else {
#pragma unroll
    for (int kb = 0; kb < 4; ++kb)
#pragma unroll
      for (int g = 0; g < 16; ++g) C[kb][g] = 0.f;
    if (tid < 128) nv[tid] = 0.f;
    m = 0.f;
  }
  const int nch = q.T / 32;
  const int dd = tid & 127, half = tid >> 7;
  u16x2 pqk[16], pv2[8]; float pgi = 0.f, pgf = 0.f;
#define ML_ISSUE(chn) { _Pragma("unroll") for (int jj = 0; jj < 16; ++jj) { const int pos = (chn) * 32 + half * 16 + jj, t = d ? q.T - 1 - pos : pos; \
      const size_t rowo = (size_t)(q.base + t) * ZMW + 128 * hh + dd; pqk[jj][0] = ZM[rowo]; pqk[jj][1] = ZM[rowo + 512]; pv2[jj >> 1][jj & 1] = ZM[rowo + 1024]; } \
    if (tid < 32) { const int pos = (chn) * 32 + tid, t = d ? q.T - 1 - pos : pos; const float* mg = MG + (size_t)(q.base + t) * 16; pgi = mg[(2 * d) * 4 + hh]; pgf = mg[(2 * d + 1) * 4 + hh]; } }
#pragma unroll
  for (int kb = 0; kb < 4; ++kb) asm volatile("" : "+v"(C[kb]));
  asm volatile("" : "+v"(m));
  ML_ISSUE(0)
#pragma unroll 1
  for (int ch = 0; ch < nch; ++ch) {
    __syncthreads();
    {
#pragma unroll
      for (int jj = 0; jj < 16; ++jj) {
        const int j = half * 16 + jj;
        Qm[j * 136 + dd] = pqk[jj][0];
        Km[j * 136 + dd] = f2bf(bf2f(pqk[jj][1]) * 0.08838834764831845f);
      }
      *(u32x4*)(VT + dd * 40 + half * 16) = (u32x4){__builtin_bit_cast(unsigned, pv2[0]), __builtin_bit_cast(unsigned, pv2[1]), __builtin_bit_cast(unsigned, pv2[2]), __builtin_bit_cast(unsigned, pv2[3])};
      *(u32x4*)(VT + dd * 40 + half * 16 + 8) = (u32x4){__builtin_bit_cast(unsigned, pv2[4]), __builtin_bit_cast(unsigned, pv2[5]), __builtin_bit_cast(unsigned, pv2[6]), __builtin_bit_cast(unsigned, pv2[7])};
      if (tid < 32) {
        const float igv = pgi + gbi;
        const float lfv = -softplusf_(-(pgf + gbf));
        float g = lfv;
#pragma unroll
        for (int o = 1; o < 32; o <<= 1) { const float tt = shfl_lane(g, (lane - o) & 63); if (tid >= o) g += tt; }
        const float cs = igv - g;
        float pm = cs;
#pragma unroll
        for (int o = 1; o < 32; o <<= 1) { const float tt = shfl_lane(pm, (lane - o) & 63); if (tid >= o) pm = fmaxf(pm, tt); }
        const float mt = g + fmaxf(m, pm);
        const float gend = shfl_lane(g, 31), mn = shfl_lane(mt, 31);
        ig[tid] = igv; gg[tid] = g; mtv[tid] = mt; wi[tid] = __expf(g + m - mt);
        wsr[tid] = __expf(gend + cs - mn);
        if (tid == 0) { misc[0] = mn; misc[1] = __expf(gend + m - mn); }
      }
    }
    if (ch + 1 < nch) ML_ISSUE(ch + 1)
    __syncthreads();
    {
      {
        float kw[16];
#pragma unroll
        for (int jj = 0; jj < 16; ++jj) { const int j = half * 16 + jj; kw[jj] = bf2f(Km[j * 136 + dd]) * wsr[j]; }
        *(u32x4*)(KwT + dd * 40 + half * 16) = (u32x4){pk2(kw[0], kw[1]), pk2(kw[2], kw[3]), pk2(kw[4], kw[5]), pk2(kw[6], kw[7])};
        *(u32x4*)(KwT + dd * 40 + half * 16 + 8) = (u32x4){pk2(kw[8], kw[9]), pk2(kw[10], kw[11]), pk2(kw[12], kw[13]), pk2(kw[14], kw[15])};
      }
      const int j = tid >> 3, seg = tid & 7;
      float a = 0.f;
#pragma unroll
      for (int i = 0; i < 16; ++i) a += bf2f(Qm[j * 136 + seg * 16 + i]) * nv[seg * 16 + i];
      a += SHX(a, 1); a += SHX(a, 2); a += SHX(a, 4);
      if (seg == 0) qn[j] = a;
    }
    const float m_new = misc[0], carry = misc[1];
    bf16_t* Cbw = Cb + w * 32 * 136; bf16_t* Ptw = Pt;
#pragma unroll
    for (int kb = 0; kb < 4; ++kb)
#pragma unroll
      for (int g4 = 0; g4 < 4; ++g4) *(u32x2*)(Cbw + r * 136 + 32 * kb + crow(4 * g4, h)) = (u32x2){pk2(C[kb][4 * g4], C[kb][4 * g4 + 1]), pk2(C[kb][4 * g4 + 2], C[kb][4 * g4 + 3])};
    {
      f32x16 Sc;
#pragma unroll
      for (int g = 0; g < 16; ++g) Sc[g] = 0.f;
      mma32(Sc, Qm, 136, Km, 136, 128, lane);
      const float gs = gg[r], is = ig[r];
#pragma unroll
      for (int g = 0; g < 16; ++g) {
        const int t = crow(g, h);
        const float pv = (r <= t) ? __expf(gg[t] - gs + is - mtv[t]) * Sc[g] : 0.f;
        Ptw[t * 40 + r] = f2bf(pv);
      }
    }
    __syncthreads();
    if (lane < 32) {
      float a = 0.f;
#pragma unroll 4
      for (int i = 0; i < 32; ++i) a += bf2f(Ptw[lane * 40 + i]);
      const float den = wi[lane] * qn[lane] + a;
      dnw[lane] = 1.0f / fmaxf(fabsf(den), __expf(-mtv[lane]));
    }
    if (tid < 128) {
      float a = 0.f;
#pragma unroll 4
      for (int i = 0; i < 32; ++i) a += bf2f(KwT[tid * 40 + i]);
      nv[tid] = carry * nv[tid] + a;
    }
    __syncthreads();
    {
      f32x16 a1;
#pragma unroll
      for (int g = 0; g < 16; ++g) a1[g] = 0.f;
      mma32(a1, Qm, 136, Cbw, 136, 128, lane);
#pragma unroll
      for (int g = 0; g < 16; ++g) a1[g] *= wi[crow(g, h)];
      mma32(a1, Ptw, 40, VT + 32 * w * 40, 40, 32, lane);
#pragma unroll
      for (int g = 0; g < 16; ++g) {
        const int j = crow(g, h), pos = ch * 32 + j, t = d ? q.T - 1 - pos : pos;
        const float hv = a1[g] * dnw[j];
        Hb[(size_t)(q.base + t) * 1024 + d * 512 + 128 * hh + 32 * w + r] = f2bf(hv);
      }
#pragma unroll
      for (int kb = 0; kb < 4; ++kb) {
#pragma unroll
        for (int g = 0; g < 16; ++g) C[kb][g] *= carry;
        mma32(C[kb], KwT + 32 * kb * 40, 40, VT + 32 * w * 40, 40, 32, lane);
      }
    }
    m = m_new;
  }
  __syncthreads();
  if (!q.sample) {
    const size_t sb = (((size_t)q.b * 2 + l) * 2 + d) * 4 + hh;
    float* dst = p.out + OUT_C + sb * 16384;
#pragma unroll
    for (int kb = 0; kb < 4; ++kb)
#pragma unroll
      for (int g = 0; g < 16; ++g) dst[(size_t)(32 * kb + crow(g, h)) * 128 + 32 * w + r] = C[kb][g];
    if (tid < 128) p.out[OUT_N + sb * 128 + tid] = nv[tid];
    if (tid == 0) p.out[OUT_M + sb] = m;
  }
}

DI void phase_scan(const Params& p, int l, char* smem) {
  int* ctrL = (int*)(p.ws + OFF_CTR) + 2 * l;
  int* ctrS = ctrL + 1;
  int* sit = (int*)(smem + LDS_BYTES - 16);
  const int role = p.role;
  bool longDone = false, shortDone = false;
  for (;;) {
    const bool wantLong = (role == 0) ? !longDone : shortDone;
    if (longDone && shortDone) break;
    __syncthreads();
    if (ltid() == 0) *sit = atomicAdd(wantLong ? ctrL : ctrS, 1);
    __syncthreads();
    int it = __builtin_amdgcn_readfirstlane(*sit);
    int ty, s_, hh_, d_, rb_ = 0;
    if (wantLong) {
      if (it >= 128) { longDone = true; continue; }
      if (it < 64) { ty = 0; d_ = it & 1; hh_ = (it >> 1) & 7; s_ = 32 + (it >> 4); }
      else if (it < 96) { it -= 64; ty = 1; s_ = 32 + (it >> 3); hh_ = (it >> 1) & 3; d_ = it & 1; }
      else { it -= 96; ty = 2; s_ = 32 + (it >> 3); hh_ = (it >> 1) & 3; d_ = it & 1; }
    } else {
      if (it >= 1024) { shortDone = true; continue; }
      if (it < 512) { ty = 0; s_ = it >> 4; hh_ = (it >> 1) & 7; d_ = it & 1; }
      else if (it < 768) { it -= 512; ty = 1; s_ = it >> 3; hh_ = (it >> 1) & 3; d_ = it & 1; }
      else { it -= 768; ty = 2; s_ = it >> 3; hh_ = (it >> 1) & 3; d_ = it & 1; }
    }
    if (ty == 0) rwkv_item(p, l, s_, hh_, d_, smem);
    else if (ty == 1) hgrn_item(p, l, s_, hh_, d_, smem);
    else mlstm_item(p, l, s_, hh_, d_, smem);
  }
}

DI void phase_combine(const Params& p, int l, char* smem) {
  const int tid = ltid(), lane = tid & 63, w = tid >> 6;
  bf16_t* ZH = (bf16_t*)(p.ws + OFF_ZH); bf16_t* ZM = (bf16_t*)(p.ws + OFF_ZM); const bf16_t* ZR = (const bf16_t*)(p.ws + OFF_ZR);
  bf16_t* O = (bf16_t*)(p.ws + OFF_O); const bf16_t* Hb = (const bf16_t*)(p.ws + OFF_H);
  const float* mu = p.in[I_MU] + (size_t)l * 4 * ZRW;
  const float* g2 = p.in[I_G2] + (size_t)l * 128 * 512;
  float* sg = (float*)smem;
  float* gt = sg + 128 * 16;
  for (int blk = blockIdx.x; blk < NT / 16; blk += gridDim.x) {
    const int tok0 = blk * 16;
    int sidx, t0;
    if (tok0 < 8192) { sidx = tok0 >> 8; t0 = tok0 & 255; } else { sidx = 32 + ((tok0 - 8192) >> 11); t0 = (tok0 - 8192) & 2047; }
    const Seq q = get_seq(sidx);
    __syncthreads();
    { const int j = tid >> 4, rr0 = (tid & 15) * 8; float val[8]; bf16x8 pv[5]; rw_load8(ZR, q.base, t0 + j, q.T, q.grid, 1792 + rr0, pv); rw_apply8(pv, mu, q.grid, rw_valid(t0 + j, q.T, q.grid), 1792 + rr0, val);
#pragma unroll
      for (int e = 0; e < 8; ++e) sg[(rr0 + e) * 16 + j] = sigmoidf_(val[e]); }
    __syncthreads();
    {
      float a0[16], a1[16];
#pragma unroll
      for (int j = 0; j < 16; ++j) { a0[j] = 0.f; a1[j] = 0.f; }
#pragma unroll 1
      for (int r0 = 0; r0 < 128; r0 += 8) {
        float w0v[8], w1v[8];
#pragma unroll
        for (int q8 = 0; q8 < 8; ++q8) { w0v[q8] = g2[(r0 + q8) * 512 + tid]; w1v[q8] = g2[(r0 + q8) * 512 + 256 + tid]; }
#pragma unroll
        for (int q8 = 0; q8 < 8; ++q8) {
          const int rr = r0 + q8; const float w0 = w0v[q8], w1 = w1v[q8];
#pragma unroll
          for (int u = 0; u < 4; ++u) {
            f32x4 sv = *(const f32x4*)(sg + rr * 16 + 4 * u);
#pragma unroll
            for (int e = 0; e < 4; ++e) { a0[4 * u + e] += sv[e] * w0; a1[4 * u + e] += sv[e] * w1; }
          }
        }
      }
#pragma unroll
      for (int j = 0; j < 16; ++j) { gt[j * 512 + tid] = a0[j]; gt[j * 512 + 256 + tid] = a1[j]; }
    }
    __syncthreads();
#pragma unroll 1
    for (int jj = 0; jj < 4; ++jj) {
      const int j = w * 4 + jj, tok = tok0 + j, t = t0 + j; int c0 = lane * 8; asm volatile("" : "+v"(c0));
      {
        float o[8], rs[8], ks[8], vs[8];
        float sum = 0.f, bon = 0.f;
        {
          bf16x8 pr_[5], pk_[5], pv_[5];
          rw_load8(ZR, q.base, t, q.T, q.grid, c0, pr_); rw_load8(ZR, q.base, t, q.T, q.grid, 512 + c0, pk_); rw_load8(ZR, q.base, t, q.T, q.grid, 1024 + c0, pv_);
          const unsigned vd_ = rw_valid(t, q.T, q.grid);
          rw_apply8(pr_, mu, q.grid, vd_, c0, rs); rw_apply8(pk_, mu, q.grid, vd_, 512 + c0, ks); rw_apply8(pv_, mu, q.grid, vd_, 1024 + c0, vs);
        }
        const bf16x8 of = *(const bf16x8*)(O + (size_t)tok * 1024 + c0), ob = *(const bf16x8*)(O + (size_t)tok * 1024 + 512 + c0);
        const f32x4 rk0 = *(const f32x4*)(p.in[I_RK] + l * 512 + c0), rk1 = *(const f32x4*)(p.in[I_RK] + l * 512 + c0 + 4);
#pragma unroll
        for (int e = 0; e < 8; ++e) {
          o[e] = bf2f((bf16_t)of[e]) + bf2f((bf16_t)ob[e]);
          sum += o[e];
          bon += rs[e] * ks[e] * (e < 4 ? rk0[e & 3] : rk1[e & 3]);
        }
        sum += SHX(sum, 1); sum += SHX(sum, 2); sum += SHX(sum, 4);
        bon += SHX(bon, 1); bon += SHX(bon, 2); bon += SHX(bon, 4);
        const float mean = sum * (1.0f / 64.f);
        float var = 0.f;
#pragma unroll
        for (int e = 0; e < 8; ++e) { const float dv = o[e] - mean; var += dv * dv; }
        var += SHX(var, 1); var += SHX(var, 2); var += SHX(var, 4);
        const float rstd = rsqrtf(var * (1.0f / 64.f) + 64e-5f);
        const f32x4 lw0 = *(const f32x4*)(p.in[I_LN] + (l * 2 + 0) * 512 + c0), lw1 = *(const f32x4*)(p.in[I_LN] + (l * 2 + 0) * 512 + c0 + 4);
        const f32x4 lb0 = *(const f32x4*)(p.in[I_LN] + (l * 2 + 1) * 512 + c0), lb1 = *(const f32x4*)(p.in[I_LN] + (l * 2 + 1) * 512 + c0 + 4);
        const f32x4 gt0 = *(const f32x4*)(gt + j * 512 + c0), gt1 = *(const f32x4*)(gt + j * 512 + c0 + 4);
        bf16x8 ov;
#pragma unroll
        for (int e = 0; e < 8; ++e) {
          const float ln = (o[e] - mean) * rstd * (e < 4 ? lw0[e & 3] : lw1[e & 3]) + (e < 4 ? lb0[e & 3] : lb1[e & 3]);
          ov[e] = (short)f2bf((ln + bon * vs[e]) * (e < 4 ? gt0[e & 3] : gt1[e & 3]));
        }
        *(bf16x8*)(O + (size_t)tok * 1024 + c0) = ov;
      }
      {
        float o[8]; float ss = 0.f;
        bf16_t* zr_ = ZH + (size_t)tok * ZHW + c0;
        const bf16x8 of = *(const bf16x8*)(zr_ + 512), ob = *(const bf16x8*)(zr_ + 1024), hgv = *(const bf16x8*)(zr_ + 2048);
        const f32x4 nw0 = *(const f32x4*)(p.in[I_HNORM] + l * 512 + c0), nw1 = *(const f32x4*)(p.in[I_HNORM] + l * 512 + c0 + 4);
#pragma unroll
        for (int e = 0; e < 8; ++e) { o[e] = bf2f((bf16_t)of[e]) + bf2f((bf16_t)ob[e]); ss += o[e] * o[e]; }
        ss += SHX(ss, 1); ss += SHX(ss, 2); ss += SHX(ss, 4); ss += SHX(ss, 8);
        const float rsd = rsqrtf(ss * (1.0f / 128.f) + 1e-6f);
        bf16x8 ov;
#pragma unroll
        for (int e = 0; e < 8; ++e) ov[e] = (short)f2bf(o[e] * rsd * (e < 4 ? nw0[e & 3] : nw1[e & 3]) * siluf_(bf2f((bf16_t)hgv[e])));
        *(bf16x8*)(zr_ + 2048) = ov;
      }
      {
        float o[8]; float ss = 0.f;
        bf16_t* zm_ = ZM + (size_t)tok * ZMW + 1536 + c0;
        const bf16x8 of = *(const bf16x8*)(Hb + (size_t)tok * 1024 + c0), ob = *(const bf16x8*)(Hb + (size_t)tok * 1024 + 512 + c0), mov = *(const bf16x8*)zm_;
        const f32x4 nw0 = *(const f32x4*)(p.in[I_MNORM] + l * 512 + c0), nw1 = *(const f32x4*)(p.in[I_MNORM] + l * 512 + c0 + 4);
#pragma unroll
        for (int e = 0; e < 8; ++e) { o[e] = bf2f((bf16_t)of[e]) + bf2f((bf16_t)ob[e]); ss += o[e] * o[e]; }
        ss += SHX(ss, 1); ss += SHX(ss, 2); ss += SHX(ss, 4); ss += SHX(ss, 8);
        const float rsd = rsqrtf(ss * (1.0f / 128.f) + 1e-6f);
        bf16x8 ov;
#pragma unroll
        for (int e = 0; e < 8; ++e) ov[e] = (short)f2bf(o[e] * rsd * (e < 4 ? nw0[e & 3] : nw1[e & 3]) * sigmoidf_(bf2f((bf16_t)mov[e])));
        *(bf16x8*)zm_ = ov;
      }
    }
    __syncthreads();
#pragma unroll 1
    for (int jj = 0; jj < 4; ++jj) tok_one(p, l, 3, tok0 + w * 4 + jj, lane);
  }
}

#define XB_TMO      128
#define XB_XCNT(j)  (256  + 64 * (j))
#define XB_XSUB(j)  (1280 + 64 * (j))
#define XB_XGEN(j)  (2304 + 64 * (j))
#define XB_TOP      3328
#define XB_TOPGEN   3392
#define XCD_BAR_WORDS 3456
#define XB_SPIN_CAP (1u << 20)
#define LAS __attribute__((address_space(3)))
DI unsigned xb_ld(unsigned* p)              { return __hip_atomic_load(p, __ATOMIC_RELAXED, __HIP_MEMORY_SCOPE_AGENT); }
DI unsigned xb_add(unsigned* p, unsigned v) { return __hip_atomic_fetch_add(p, v, __ATOMIC_RELAXED, __HIP_MEMORY_SCOPE_AGENT); }
DI unsigned xb_xcc_id() { return (unsigned)__builtin_amdgcn_s_getreg((3 << 11) | 20) & 0xFu; }
#define XB_SPIN(cond, bar) do { unsigned _sp = 0; while (cond) { __builtin_amdgcn_s_sleep(1); \
    if ((++_sp & 255u) == 0u) { if (xb_ld(&(bar)[XB_TMO])) break; if (_sp > XB_SPIN_CAP) { atomicAdd(&(bar)[XB_TMO], 1u); break; } } } } while (0)
struct XcdBarrier { unsigned* bar; unsigned x; volatile LAS unsigned* st; };
DI XcdBarrier xcd_barrier_post(const Params& p, unsigned* bar, volatile LAS unsigned* st) {
  XcdBarrier b; b.bar = bar; b.x = xb_xcc_id(); b.st = st;
  if (ltid() == 0) (void)xb_add(&bar[XB_XCNT(b.x)], 1u);
  return b;
}
DI void xcd_barrier_complete(unsigned* bar, unsigned x, unsigned& nloc, unsigned& nx) {
  const unsigned G = gridDim.x * gridDim.y * gridDim.z;
  unsigned sum, cnt, mine, sp = 0u;
  for (;;) {
    sum = 0u; cnt = 0u; mine = 0u;
#pragma unroll
    for (unsigned j = 0; j < 16; ++j) { const unsigned c = xb_ld(&bar[XB_XCNT(j)]); sum += c; cnt += (c > 0u) ? 1u : 0u; mine = (j == x) ? c : mine; }
    if (sum == G) break;
    __builtin_amdgcn_s_sleep(1);
    if ((++sp & 255u) == 0u) { if (xb_ld(&bar[XB_TMO])) break; if (sp > XB_SPIN_CAP) { atomicAdd(&bar[XB_TMO], 1u); break; } }
  }
  nloc = mine > 0u ? mine : 1u; nx = cnt > 0u ? cnt : 1u;
}
DI void xcd_barrier(const Params& p, const XcdBarrier& b) {
  asm volatile("s_waitcnt vmcnt(0)" ::: "memory");
  __syncthreads();
  if (ltid() == 0) {
    unsigned* bar = b.bar;
    __builtin_amdgcn_s_waitcnt(0);
    unsigned nloc = b.st[0], nx = b.st[1];
    if (nloc == 0u) { xcd_barrier_complete(bar, b.x, nloc, nx); b.st[0] = nloc; b.st[1] = nx; }
    const unsigned old = xb_add(&bar[XB_XSUB(b.x)], 1u);
    const unsigned gen = old / nloc;
    if (old + 1u == (gen + 1u) * nloc) {
      __builtin_amdgcn_fence(__ATOMIC_RELEASE, "agent");
      asm volatile("s_waitcnt vmcnt(0)" ::: "memory");
      const unsigned og = xb_add(&bar[XB_TOP], 1u);
      const unsigned tg = og / nx;
      if (og + 1u == (tg + 1u) * nx) xb_add(&bar[XB_TOPGEN], 1u);
      else XB_SPIN(xb_ld(&bar[XB_TOPGEN]) == tg, bar);
      __builtin_amdgcn_fence(__ATOMIC_ACQUIRE, "agent");
      xb_add(&bar[XB_XGEN(b.x)], 1u);
      asm volatile("s_waitcnt vmcnt(0)" ::: "memory");
    } else {
      XB_SPIN(xb_ld(&bar[XB_XGEN(b.x)]) == gen, bar);
      __builtin_amdgcn_fence(__ATOMIC_ACQUIRE, "agent");
      asm volatile("s_waitcnt vmcnt(0)" ::: "memory");
    }
  }
  __syncthreads();
}

constexpr int NPHASE = 3 + 9 * 2;
DI void run_phase(const Params& p0, int ph, char* smem) {
  Params p = p0;
  asm volatile("" : "+s"(p.ws), "+s"(p.out));
  p.ws = as_global(p.ws); p.out = as_global(p.out);
  if (ph == 0) { phase0(p, smem); return; }
  if (ph == 1) { phase1(p); return; }
  if (ph == 2) { tok_phase(p, 0, 0); return; }
  const int l = (ph - 3) / 9, s = (ph - 3) % 9;
  switch (s) {
    case 0: phase_inproj(p, smem); break;
    case 1: phase_scan(p, l, smem); break;
    case 2: phase_combine(p, l, smem); break;
    case 3: phase_merge(p, l, smem); break;
    case 4: phase_gemm_f32(p, (const bf16_t*)(p.ws + OFF_MERGED), 1024, (const bf16_t*)(p.ws + OFF_WTOUT), smem); break;
    case 5: tok_phase(p, l, 1); break;
    case 6: phase_ffn_in(p, smem); break;
    case 7: phase_gemm_f32(p, (const bf16_t*)(p.ws + OFF_ACT), DFF, (const bf16_t*)(p.ws + OFF_WTFO), smem); break;
    case 8:
      tok_phase(p, l, 2);
      if (l + 1 < 2) {
        conv_weight(p, p.in[I_WIN] + (size_t)(l + 1) * 1024 * DIN, DIN, (bf16_t*)(p.ws + OFF_WTIN), 1024, WTIN_ROWS, 0, (float*)smem, blockIdx.x, gridDim.x);
        for (int br = 0; br < 3; ++br) conv_weight(p, p.in[I_WBR] + ((size_t)(l + 1) * 3 + br) * 512 * 1024, 1024, (bf16_t*)(p.ws + OFF_WTBR) + (size_t)br * 1024 * 512, 512, 1024, 1, (float*)smem, blockIdx.x, gridDim.x);
      }
      break;
  }
}

template <bool COOP>
__global__ void __launch_bounds__(NTHR, 2) mega(Params pk, int lo, int hi) {
  __shared__ __attribute__((aligned(16))) char smem[LDS_BYTES];
  Params p = pk;
#pragma unroll
  for (int i = 0; i < N_IN; ++i) p.in[i] = as_global(p.in[i]);
  p.ws = as_global(p.ws); p.out = as_global(p.out);
  p.wb = __builtin_amdgcn_readfirstlane((int)threadIdx.x) & ~63;
  if (COOP) {
    volatile LAS unsigned* st = (volatile LAS unsigned*)(smem + LDS_BYTES - 32);
    if (ltid() == 0) { st[0] = 0u; st[1] = 0u; }
    __syncthreads();
    phase0(p, smem);
    cg::this_grid().sync();
    XcdBarrier b = xcd_barrier_post(p, (unsigned*)(p.ws + OFF_BAR), st);
    if (ltid() == 0) {
      const unsigned hwid = (unsigned)__builtin_amdgcn_s_getreg((31 << 11) | 4);
      const unsigned key = (xb_xcc_id() << 8) | ((hwid >> 8) & 0xFFu);
      ((int*)smem)[(LDS_BYTES - 12) / 4] = (int)xb_add((unsigned*)(p.ws + OFF_ROLE) + key, 1u);
    }
    __syncthreads();
    p.role = __builtin_amdgcn_readfirstlane(((int*)smem)[(LDS_BYTES - 12) / 4]);
    for (int ph = 1; ph < hi; ++ph) {
      run_phase(p, ph, smem);
      if (ph + 1 < hi) xcd_barrier(p, b);
    }
  } else {
    for (int ph = lo; ph < hi; ++ph) run_phase(p, ph, smem);
  }
}

extern "C" void kernel_launch(void* const* d_in, const int* in_sizes, int n_in, void* d_out, int out_size, void* d_ws, size_t ws_size, hipStream_t stream) {
  Params p{};
  for (int i = 0; i < N_IN; ++i) p.in[i] = (const float*)d_in[i];
  p.out = (float*)d_out; p.ws = (char*)d_ws;
  if (ws_size < WS_NEED) fprintf(stderr, "workspace too small: %zu < %zu\n", ws_size, (size_t)WS_NEED);
  static int grid_blocks = 0;
  if (!grid_blocks) {
    int dev = 0, cus = 0, per_cu = 0;
    hipGetDevice(&dev);
    hipDeviceGetAttribute(&cus, hipDeviceAttributeMultiprocessorCount, dev);
    hipOccupancyMaxActiveBlocksPerMultiprocessor(&per_cu, mega<true>, NTHR, 0);
    if (per_cu > 2) per_cu = 2;
    grid_blocks = cus * per_cu;
  }
  int lo = 0, hi = NPHASE;
  void* args[] = {&p, &lo, &hi};
  hipError_t e = hipLaunchCooperativeKernel((void*)mega<true>, dim3(grid_blocks), dim3(NTHR), args, 0, stream);
  if (e != hipSuccess) fprintf(stderr, "cooperative launch failed: %s (grid %d)\n", hipGetErrorString(e), grid_blocks);
}
```

```cpp
#include <hip/hip_runtime.h>
#include <hip/hip_cooperative_groups.h>
#include <cstdio>
namespace cg = cooperative_groups;

typedef unsigned short bf16_t;
typedef short bf16x8 __attribute__((ext_vector_type(8)));
typedef float f32x4 __attribute__((ext_vector_type(4)));
typedef float f32x2 __attribute__((ext_vector_type(2)));
typedef float f32x16 __attribute__((ext_vector_type(16)));
typedef unsigned short u16x4 __attribute__((ext_vector_type(4)));
typedef unsigned short u16x2 __attribute__((ext_vector_type(2)));
typedef unsigned u32x4 __attribute__((ext_vector_type(4)));
typedef unsigned u32x2 __attribute__((ext_vector_type(2)));
static __device__ __forceinline__ unsigned pk2(float lo, float hi) { typedef __bf16 b2 __attribute__((ext_vector_type(2))); typedef float f2 __attribute__((ext_vector_type(2))); return __builtin_bit_cast(unsigned, __builtin_convertvector((f2){lo, hi}, b2)); }

#define DI __device__ __forceinline__
#define GAS __attribute__((address_space(1)))
template <class T> static __device__ __forceinline__ T* as_global(T* q) { return (T*)(GAS T*)(unsigned long long)q; }

constexpr int NT = 16384;
constexpr int DM = 1024;
constexpr int NTHR = 256;
constexpr int DIN = 9616;
constexpr int ZHW = 2560, ZRW = 1920, ZMW = 2048;
constexpr int WTIN_ROWS = 9728;
constexpr int DFF = 2816;

constexpr size_t OFF_WTIN = 0;
constexpr size_t OFF_WTBR = OFF_WTIN + (size_t)WTIN_ROWS * 1024 * 2;
constexpr size_t OFF_H    = OFF_WTBR + (size_t)3 * 1024 * 512 * 2;
constexpr size_t OFF_ZH   = OFF_H + (size_t)NT * 1024 * 2;
constexpr size_t OFF_ZR   = OFF_ZH + (size_t)NT * ZHW * 2;
constexpr size_t OFF_ZM   = OFF_ZR + (size_t)NT * ZRW * 2;
constexpr size_t OFF_MG   = OFF_ZM + (size_t)NT * ZMW * 2;
constexpr size_t OFF_O    = OFF_MG + (size_t)NT * 16 * 4;
constexpr size_t OFF_MOD  = OFF_O + (size_t)NT * 1024 * 2;
constexpr size_t OFF_LBS  = OFF_MOD + (size_t)2 * 5 * 6144 * 4;
constexpr size_t OFF_CTR  = OFF_LBS + 2 * 512 * 4;
constexpr size_t OFF_BAR  = OFF_CTR + 256;
constexpr size_t OFF_ROLE = OFF_BAR + 3456 * 4;
constexpr size_t WS_NEED  = OFF_ROLE + 4096 * 4;
constexpr size_t OFF_MODP = OFF_ZH;
constexpr size_t OFF_WTOUT = OFF_ZR;
constexpr size_t OFF_WTFI  = OFF_WTOUT + (size_t)1024 * 1024 * 2;
constexpr size_t OFF_WTFO  = OFF_WTFI + (size_t)5632 * 1024 * 2;
constexpr size_t OFF_MERGED = OFF_WTFO + (size_t)1024 * 2816 * 2;
constexpr size_t OFF_Y    = OFF_ZH;
constexpr size_t OFF_ACT  = OFF_ZM;

constexpr size_t OUT_HG = 16777216, OUT_RW = 25165824, OUT_C = 29360128, OUT_N = 37748736, OUT_M = 37814272;

enum { I_XP = 0, I_XS, I_SH, I_SR, I_SC, I_SN, I_SM, I_C, I_CCTX, I_WADA, I_BADA, I_NORMS, I_WIN, I_HLB, I_HNORM, I_MU, I_W0, I_W2,
       I_A0, I_A2, I_G2, I_KK, I_KA, I_RK, I_LN, I_GB, I_MNORM, I_WBR, I_WOUT, I_WFI, I_WFO, N_IN };

struct Params { const float* in[N_IN]; float* out; char* ws; int wb; int role; };

constexpr int LDS_BYTES = 77824;

DI bf16_t f2bf(float f) { return __builtin_bit_cast(unsigned short, (__bf16)f); }
DI float bf2f(bf16_t h) { return __uint_as_float(((unsigned)h) << 16); }
DI float sigmoidf_(float x) { return 1.0f / (1.0f + __expf(-x)); }
DI float siluf_(float x) { return x / (1.0f + __expf(-x)); }
DI float softplusf_(float x) { return x > 20.f ? x : __logf(1.0f + __expf(x)); }
DI float dpp_xor1(float x) { return __int_as_float(__builtin_amdgcn_mov_dpp(__float_as_int(x), 0xB1, 0xF, 0xF, true)); }
DI float dpp_xor2(float x) { return __int_as_float(__builtin_amdgcn_mov_dpp(__float_as_int(x), 0x4E, 0xF, 0xF, true)); }
DI float shfl_lane(float v, int src) { return __int_as_float(__builtin_amdgcn_ds_bpermute(src << 2, __float_as_int(v))); }
#define SHX(v, m) shfl_lane((v), lane ^ (m))
DI float wave_sum(float v, int lane) { v += dpp_xor1(v); v += dpp_xor2(v); v += SHX(v, 4); v += SHX(v, 8); v += SHX(v, 16); v += SHX(v, 32); return v; }
DI int ltid_(int wb) { int t = wb + (int)__builtin_amdgcn_mbcnt_hi(~0u, __builtin_amdgcn_mbcnt_lo(~0u, 0u)); asm volatile("" : "+v"(t)); return t; }
#define ltid() ltid_(p.wb)
DI int crow(int reg, int h) { return (reg & 3) + 8 * (reg >> 2) + 4 * h; }

DI int tok_cond(int tok) { return tok < 8192 ? 0 : 1 + ((tok - 8192) >> 11); }
DI const float* x_in_row(const Params& p, int tok) { return tok < 8192 ? p.in[I_XP] + (size_t)tok * DM : p.in[I_XS] + (size_t)(tok - 8192) * DM; }

DI void mma32(f32x16& acc, const bf16_t* A, int lda, const bf16_t* B, int ldb, int K, int lane) {
  const int r = lane & 31, h = lane >> 5;
#pragma unroll 2
  for (int kk = 0; kk < K; kk += 16) {
    bf16x8 a = *(const bf16x8*)(A + r * lda + kk + 8 * h);
    bf16x8 b = *(const bf16x8*)(B + r * ldb + kk + 8 * h);
    acc = __builtin_amdgcn_mfma_f32_32x32x16_bf16(a, b, acc, 0, 0, 0);
  }
}

template <int BM, int BN, int BK>
DI void gemm_main(const Params& p, f32x4 (&acc)[BM / 32][BN / 32], const bf16_t* __restrict__ A, int lda, const bf16_t* __restrict__ B, int ldb, int K, bf16_t* sm) {
  constexpr int MI = BM / 32, NJ = BN / 32, LS = BK + 8, CPR = BK / 8, ACH = BM * BK / 2048, BCH = BN * BK / 2048, KS = BK / 32, RPI = 256 / CPR;
  const int tid = ltid(), lane = tid & 63, w = tid >> 6, wm = w >> 1, wn = w & 1;
  bf16_t* As = sm; bf16_t* Bs = sm + 2 * BM * LS;
  bf16x8 ra[ACH], rb[BCH];
  const int nk = K / BK;
  const int lrow = tid / CPR, lkc = (tid % CPR) * 8;
#pragma unroll
  for (int i = 0; i < ACH; ++i) ra[i] = *(const bf16x8*)(A + (size_t)(lrow + RPI * i) * lda + lkc);
#pragma unroll
  for (int i = 0; i < BCH; ++i) rb[i] = *(const bf16x8*)(B + (size_t)(lrow + RPI * i) * ldb + lkc);
  __syncthreads();
#pragma unroll
  for (int i = 0; i < ACH; ++i) *(bf16x8*)(As + (lrow + RPI * i) * LS + lkc) = ra[i];
#pragma unroll
  for (int i = 0; i < BCH; ++i) *(bf16x8*)(Bs + (lrow + RPI * i) * LS + lkc) = rb[i];
  __syncthreads();
  for (int kt = 0; kt < nk; ++kt) {
    const int buf = kt & 1;
    if (kt + 1 < nk) {
      const int k0 = (kt + 1) * BK + lkc;
#pragma unroll
      for (int i = 0; i < ACH; ++i) ra[i] = *(const bf16x8*)(A + (size_t)(lrow + RPI * i) * lda + k0);
#pragma unroll
      for (int i = 0; i < BCH; ++i) rb[i] = *(const bf16x8*)(B + (size_t)(lrow + RPI * i) * ldb + k0);
    }
    const bf16_t* as = As + buf * BM * LS + (wm * (BM / 2) + (lane & 15)) * LS + (lane >> 4) * 8;
    const bf16_t* bs = Bs + buf * BN * LS + (wn * (BN / 2) + (lane & 15)) * LS + (lane >> 4) * 8;
#pragma unroll
    for (int ks = 0; ks < KS; ++ks) {
      bf16x8 bfr[NJ];
#pragma unroll
      for (int j = 0; j < NJ; ++j) bfr[j] = *(const bf16x8*)(bs + j * 16 * LS + ks * 32);
      __builtin_amdgcn_s_setprio(1);
#pragma unroll
      for (int i = 0; i < MI; ++i) {
        const bf16x8 af = *(const bf16x8*)(as + i * 16 * LS + ks * 32);
#pragma unroll
        for (int j = 0; j < NJ; ++j) acc[i][j] = __builtin_amdgcn_mfma_f32_16x16x32_bf16(bfr[j], af, acc[i][j], 0, 0, 0);
      }
      __builtin_amdgcn_s_setprio(0);
    }
    if (kt + 1 < nk) {
      const int nb = buf ^ 1;
#pragma unroll
      for (int i = 0; i < ACH; ++i) *(bf16x8*)(As + nb * BM * LS + (lrow + RPI * i) * LS + lkc) = ra[i];
#pragma unroll
      for (int i = 0; i < BCH; ++i) *(bf16x8*)(Bs + nb * BN * LS + (lrow + RPI * i) * LS + lkc) = rb[i];
    }
    __syncthreads();
  }
}

template <int MI, int NJ> DI void zero_acc(f32x4 (&acc)[MI][NJ]) {
#pragma unroll
  for (int i = 0; i < MI; ++i)
#pragma unroll
    for (int j = 0; j < NJ; ++j) acc[i][j] = (f32x4){0.f, 0.f, 0.f, 0.f};
}
DI void store_bf4(bf16_t* dst, f32x4 v) { u16x4 o; o[0] = f2bf(v[0]); o[1] = f2bf(v[1]); o[2] = f2bf(v[2]); o[3] = f2bf(v[3]); *(u16x4*)dst = o; }

DI int map_col(int mode, int n) {
  if (mode == 0) return n < 6544 ? n : (n < 6656 ? -1 : n - 112);
  if (mode == 2) return ((n >> 4) & 1) ? DFF + (n >> 5) * 16 + (n & 15) : (n >> 5) * 16 + (n & 15);
  return n;
}
DI void conv_tile(const Params& p, const float* __restrict__ src, int ld_src, bf16_t* __restrict__ dst, int K, int mode, int tk, int tn, float* sm) {
  const int tid = ltid();
  __syncthreads();
  {
    const int nn = tid & 63, col = map_col(mode, tn * 64 + nn);
#pragma unroll
    for (int i = 0; i < 16; ++i) { int kk = (tid >> 6) + 4 * i; sm[kk * 65 + nn] = col >= 0 ? src[(size_t)(tk * 64 + kk) * ld_src + col] : 0.f; }
  }
  __syncthreads();
  {
    const int kk = tid & 63;
#pragma unroll
    for (int i = 0; i < 16; ++i) { int nn = (tid >> 6) + 4 * i; dst[(size_t)(tn * 64 + nn) * K + tk * 64 + kk] = f2bf(sm[kk * 65 + nn]); }
  }
}
DI void conv_weight(const Params& p, const float* src, int ld_src, bf16_t* dst, int K, int Ndst, int mode, float* sm, int bid, int nb) {
  const int tkn = K / 64, nt = tkn * (Ndst / 64);
  for (int t = bid; t < nt; t += nb) conv_tile(p, src, ld_src, dst, K, mode, t % tkn, t / tkn, sm);
}

DI void phase0(const Params& p, char* smem) {
  const int tid = ltid(), bid = blockIdx.x, nb = gridDim.x;
  float* MODP = (float*)(p.ws + OFF_MODP);
  float* sm = (float*)smem;
  if (bid == 0) { if (tid < 64) ((int*)(p.ws + OFF_CTR))[tid] = 0; for (int i = tid; i < 3456; i += NTHR) ((unsigned*)(p.ws + OFF_BAR))[i] = 0u; for (int i = tid; i < 4096; i += NTHR) ((unsigned*)(p.ws + OFF_ROLE))[i] = 0u; }
  for (int i = bid * NTHR + tid; i < 512; i += nb * NTHR) {
    float a = p.in[I_HLB][i], b = p.in[I_HLB][512 + i];
    float* L = (float*)(p.ws + OFF_LBS); L[i] = 0.f; L[512 + i] = 1.0f / (1.0f + expf(a - b));
  }
  for (int it = bid; it < 2 * 24 * 16; it += nb) {
    const int ks = it & 15, jb = (it >> 4) % 24, l = it / (16 * 24);
    __syncthreads();
    for (int e = tid; e < 5 * 64; e += NTHR) { int ci = e >> 6, k = ks * 64 + (e & 63); float cv = ci == 0 ? p.in[I_CCTX][k] : p.in[I_C][(ci - 1) * DM + k]; sm[e] = siluf_(cv); }
    __syncthreads();
    const int j = jb * 256 + tid;
    float a0 = 0, a1 = 0, a2 = 0, a3 = 0, a4 = 0;
    const float* W = p.in[I_WADA] + ((size_t)l * DM + ks * 64) * 6144 + j;
#pragma unroll 1
    for (int k0 = 0; k0 < 64; k0 += 16) {
      float wv[16];
#pragma unroll
      for (int u = 0; u < 16; ++u) wv[u] = W[(size_t)(k0 + u) * 6144];
#pragma unroll
      for (int u = 0; u < 16; ++u) { const int k = k0 + u; const float w = wv[u]; a0 += sm[k] * w; a1 += sm[64 + k] * w; a2 += sm[128 + k] * w; a3 += sm[192 + k] * w; a4 += sm[256 + k] * w; }
    }
    float* dst = MODP + ((size_t)(ks * 2 + l) * 5) * 6144 + j;
    dst[0] = a0; dst[6144] = a1; dst[2 * 6144] = a2; dst[3 * 6144] = a3; dst[4 * 6144] = a4;
  }
  conv_weight(p, p.in[I_WIN], DIN, (bf16_t*)(p.ws + OFF_WTIN), 1024, WTIN_ROWS, 0, sm, bid, nb);
  for (int br = 0; br < 3; ++br) conv_weight(p, p.in[I_WBR] + (size_t)br * 512 * 1024, 1024, (bf16_t*)(p.ws + OFF_WTBR) + (size_t)br * 1024 * 512, 512, 1024, 1, sm, bid, nb);
}
DI void phase1(const Params& p) {
  const float* MODP = (const float*)(p.ws + OFF_MODP);
  float* MOD = (float*)(p.ws + OFF_MOD);
  for (int i = blockIdx.x * NTHR + ltid(); i < 2 * 5 * 6144; i += gridDim.x * NTHR) {
    const int j = i % 6144, l = i / (5 * 6144);
    float s = p.in[I_BADA][l * 6144 + j];
    for (int ks = 0; ks < 16; ++ks) s += MODP[(size_t)ks * 2 * 5 * 6144 + i];
    MOD[i] = s;
  }
}

DI void norm_mod_store(const f32x4 (&x)[4], const float* nw, const float* sc, const float* sh, bf16_t* hrow, int lane) {
  float ss = 0.f;
#pragma unroll
  for (int i = 0; i < 4; ++i) ss += x[i][0] * x[i][0] + x[i][1] * x[i][1] + x[i][2] * x[i][2] + x[i][3] * x[i][3];
  ss = wave_sum(ss, lane);
  const float rs = rsqrtf(ss * (1.0f / DM) + 1e-6f);
#pragma unroll
  for (int i = 0; i < 4; ++i) {
    const int c = i * 256 + lane * 4;
    f32x4 w = *(const f32x4*)(nw + c), s1 = *(const f32x4*)(sc + c), s0 = *(const f32x4*)(sh + c), o;
#pragma unroll
    for (int e = 0; e < 4; ++e) o[e] = x[i][e] * rs * w[e] * (1.0f + s1[e]) + s0[e];
    store_bf4(hrow + c, o);
  }
}
DI void tok_one(const Params& p, int l, int mode, int tok, int lane) {
  const float* MOD = (const float*)(p.ws + OFF_MOD);
  bf16_t* H = (bf16_t*)(p.ws + OFF_H);
  const float* Y = (const float*)(p.ws + OFF_Y);
  const int ci = tok_cond(tok);
  const float* modl = MOD + (size_t)(l * 5 + ci) * 6144;
  const float* nwl = p.in[I_NORMS] + (size_t)l * 4 * DM;
  const bool from_in = (l == 0 && (mode == 0 || mode == 1 || mode == 3));
  const float* xr = from_in ? x_in_row(p, tok) : p.out + (size_t)tok * DM;
  const bool has_y = (mode == 1 || mode == 2);
  const bool has_h = !(mode == 2 && l + 1 >= 2);
  const float* modn = (mode == 2 && has_h) ? MOD + (size_t)((l + 1) * 5 + ci) * 6144 : modl;
  const float* nw2 = mode == 1 ? nwl + 2 * DM : (mode == 2 ? p.in[I_NORMS] + (size_t)(has_h ? l + 1 : l) * 4 * DM : nwl);
  const float* sc2 = mode == 1 ? modl + 4 * DM : modn + 1 * DM;
  const float* sh2 = mode == 1 ? modl + 3 * DM : modn + 0 * DM;
  const float* nwy = nwl + (mode == 1 ? 1 : 3) * DM;
  const float* gy = modl + (mode == 1 ? 2 : 5) * DM;
  f32x4 x[4], y[4], wy[4], gg[4], w2[4], s1[4], s0[4];
#pragma unroll
  for (int i = 0; i < 4; ++i) {
    const int c = i * 256 + lane * 4;
    x[i] = *(const f32x4*)(xr + c);
    if (has_y) { y[i] = *(const f32x4*)(Y + (size_t)tok * DM + c); wy[i] = *(const f32x4*)(nwy + c); gg[i] = *(const f32x4*)(gy + c); }
    if (has_h) { w2[i] = *(const f32x4*)(nw2 + c); s1[i] = *(const f32x4*)(sc2 + c); s0[i] = *(const f32x4*)(sh2 + c); }
  }
  if (has_y) {
    float ss = 0.f;
#pragma unroll
    for (int i = 0; i < 4; ++i) ss += y[i][0] * y[i][0] + y[i][1] * y[i][1] + y[i][2] * y[i][2] + y[i][3] * y[i][3];
    ss = wave_sum(ss, lane);
    const float rs = rsqrtf(ss * (1.0f / DM) + 1e-6f);
#pragma unroll
    for (int i = 0; i < 4; ++i) {
      const int c = i * 256 + lane * 4;
#pragma unroll
      for (int e = 0; e < 4; ++e) x[i][e] += gg[i][e] * (y[i][e] * rs * wy[i][e]);
      *(f32x4*)(p.out + (size_t)tok * DM + c) = x[i];
    }
  }
  if (has_h) {
    float ss = 0.f;
#pragma unroll
    for (int i = 0; i < 4; ++i) ss += x[i][0] * x[i][0] + x[i][1] * x[i][1] + x[i][2] * x[i][2] + x[i][3] * x[i][3];
    ss = wave_sum(ss, lane);
    const float rs = rsqrtf(ss * (1.0f / DM) + 1e-6f);
#pragma unroll
    for (int i = 0; i < 4; ++i) {
      f32x4 o;
#pragma unroll
      for (int e = 0; e < 4; ++e) o[e] = x[i][e] * rs * w2[i][e] * (1.0f + s1[i][e]) + s0[i][e];
      store_bf4(H + (size_t)tok * DM + i * 256 + lane * 4, o);
    }
  }
}
DI void tok_phase(const Params& p, int l, int mode) {
  const int lane = ltid() & 63, gw = blockIdx.x * 4 + (ltid() >> 6), nw = gridDim.x * 4;
  for (int tok = gw; tok < NT; tok += nw) tok_one(p, l, mode, tok, lane);
}

DI bool tile_xcd(int i, int NTN, int MTX, int& mt, int& nt) {
  const int G = gridDim.x, b = blockIdx.x, x = b & 7, j = b >> 3, nbx = (G - x + 7) >> 3;
  const int u = j + i * nbx;
  if (u >= MTX * NTN) return false;
  mt = MTX * x + (u % MTX); nt = u / MTX;
  return true;
}
DI void phase_inproj(const Params& p, char* smem) {
  const bf16_t* H = (const bf16_t*)(p.ws + OFF_H);
  const bf16_t* WT = (const bf16_t*)(p.ws + OFF_WTIN);
  bf16_t* ZH = (bf16_t*)(p.ws + OFF_ZH); bf16_t* ZR = (bf16_t*)(p.ws + OFF_ZR); bf16_t* ZM = (bf16_t*)(p.ws + OFF_ZM);
  float* MG = (float*)(p.ws + OFF_MG);
  const int lane = ltid() & 63, w = ltid() >> 6, wm = w >> 1, wn = w & 1;
  int mt, nt;
  for (int ti = 0; tile_xcd(ti, 52, 8, mt, nt); ++ti) {
    f32x4 acc[8][4]; zero_acc<8, 4>(acc);
    gemm_main<256, 128, 32>(p, acc, H + (size_t)mt * 256 * 1024, 1024, WT + (size_t)nt * 128 * 1024, 1024, 1024, (bf16_t*)smem);
    const int n0 = nt * 128;
#pragma unroll
    for (int i = 0; i < 8; ++i) {
      const int row = mt * 256 + wm * 128 + i * 16 + (lane & 15);
#pragma unroll
      for (int j = 0; j < 4; ++j) {
        const int col = n0 + wn * 64 + j * 16 + 4 * (lane >> 4);
        if (n0 < 2560) store_bf4(ZH + (size_t)row * ZHW + col, acc[i][j]);
        else if (n0 < 4480) store_bf4(ZR + (size_t)row * ZRW + (col - 2560), acc[i][j]);
        else if (n0 < 6528) store_bf4(ZM + (size_t)row * ZMW + (col - 4480), acc[i][j]);
        else if (col - 6528 < 16) *(f32x4*)(MG + (size_t)row * 16 + (col - 6528)) = acc[i][j];
      }
    }
  }
}

DI void phase_merge(const Params& p, int l, char* smem) {
  const bf16_t* H = (const bf16_t*)(p.ws + OFF_H);
  const bf16_t* WT = (const bf16_t*)(p.ws + OFF_WTIN);
  const bf16_t* WBR = (const bf16_t*)(p.ws + OFF_WTBR);
  const bf16_t* ZH = (const bf16_t*)(p.ws + OFF_ZH); const bf16_t* ZM = (const bf16_t*)(p.ws + OFF_ZM); const bf16_t* O = (const bf16_t*)(p.ws + OFF_O);
  bf16_t* MER = (bf16_t*)(p.ws + OFF_MERGED);
  const int lane = ltid() & 63, w = ltid() >> 6, wm = w >> 1, wn = w & 1;
  int mt, nt;
  for (int ti = 0; tile_xcd(ti, 16, 16, mt, nt); ++ti) {
    f32x4 accM[4][2]; zero_acc<4, 2>(accM);
#pragma unroll 1
    for (int br = 0; br < 3; ++br) {
      f32x4 accG[4][2], accP[4][2]; zero_acc<4, 2>(accG); zero_acc<4, 2>(accP);
      gemm_main<128, 64, 64>(p, accG, H + (size_t)mt * 128 * 1024, 1024, WT + (size_t)(6656 + br * 1024 + nt * 64) * 1024, 1024, 1024, (bf16_t*)smem);
      const bf16_t* Ab; int lda;
      if (br == 0) { Ab = ZH + 2048; lda = ZHW; } else if (br == 1) { Ab = O; lda = 1024; } else { Ab = ZM + 1536; lda = ZMW; }
      gemm_main<128, 64, 64>(p, accP, Ab + (size_t)mt * 128 * lda, lda, WBR + ((size_t)br * 1024 + nt * 64) * 512, 512, 512, (bf16_t*)smem);
#pragma unroll
      for (int i = 0; i < 4; ++i)
#pragma unroll
        for (int j = 0; j < 2; ++j)
#pragma unroll
          for (int e = 0; e < 4; ++e) accM[i][j][e] += sigmoidf_(accG[i][j][e]) * accP[i][j][e];
    }
#pragma unroll
    for (int i = 0; i < 4; ++i) {
      const int row = mt * 128 + wm * 64 + i * 16 + (lane & 15);
#pragma unroll
      for (int j = 0; j < 2; ++j) store_bf4(MER + (size_t)row * 1024 + nt * 64 + wn * 32 + j * 16 + 4 * (lane >> 4), accM[i][j]);
    }
  }
  float* sm = (float*)smem;
  conv_weight(p, p.in[I_WOUT] + (size_t)l * 1024 * 1024, 1024, (bf16_t*)(p.ws + OFF_WTOUT), 1024, 1024, 1, sm, blockIdx.x, gridDim.x);
  conv_weight(p, p.in[I_WFI] + (size_t)l * 1024 * 5632, 5632, (bf16_t*)(p.ws + OFF_WTFI), 1024, 5632, 2, sm, blockIdx.x, gridDim.x);
  conv_weight(p, p.in[I_WFO] + (size_t)l * DFF * 1024, 1024, (bf16_t*)(p.ws + OFF_WTFO), DFF, 1024, 1, sm, blockIdx.x, gridDim.x);
}

DI void phase_gemm_f32(const Params& p, const bf16_t* A, int K, const bf16_t* Wt, char* smem) {
  float* Y = (float*)(p.ws + OFF_Y);
  const int lane = ltid() & 63, w = ltid() >> 6, wm = w >> 1, wn = w & 1;
  int mt, nt;
  for (int ti = 0; tile_xcd(ti, 8, 8, mt, nt); ++ti) {
    f32x4 acc[8][4]; zero_acc<8, 4>(acc);
    gemm_main<256, 128, 32>(p, acc, A + (size_t)mt * 256 * K, K, Wt + (size_t)nt * 128 * K, K, K, (bf16_t*)smem);
#pragma unroll
    for (int i = 0; i < 8; ++i) {
      const int row = mt * 256 + wm * 128 + i * 16 + (lane & 15);
#pragma unroll
      for (int j = 0; j < 4; ++j) *(f32x4*)(Y + (size_t)row * 1024 + nt * 128 + wn * 64 + j * 16 + 4 * (lane >> 4)) = acc[i][j];
    }
  }
}
DI void phase_ffn_in(const Params& p, char* smem) {
  const bf16_t* H = (const bf16_t*)(p.ws + OFF_H);
  const bf16_t* Wt = (const bf16_t*)(p.ws + OFF_WTFI);
  bf16_t* ACT = (bf16_t*)(p.ws + OFF_ACT);
  const int lane = ltid() & 63, w = ltid() >> 6, wm = w >> 1, wn = w & 1;
  int mt, nt;
  for (int ti = 0; tile_xcd(ti, 44, 8, mt, nt); ++ti) {
    f32x4 acc[8][4]; zero_acc<8, 4>(acc);
    gemm_main<256, 128, 32>(p, acc, H + (size_t)mt * 256 * 1024, 1024, Wt + (size_t)nt * 128 * 1024, 1024, 1024, (bf16_t*)smem);
#pragma unroll
    for (int i = 0; i < 8; ++i) {
      const int row = mt * 256 + wm * 128 + i * 16 + (lane & 15);
#pragma unroll
      for (int jj = 0; jj < 2; ++jj) {
        f32x4 u = acc[i][2 * jj], g = acc[i][2 * jj + 1], o;
#pragma unroll
        for (int e = 0; e < 4; ++e) o[e] = siluf_(g[e]) * u[e];
        const int col = (nt * 128 + wn * 64 + jj * 32) / 2 + 4 * (lane >> 4);
        store_bf4(ACT + (size_t)row * DFF + col, o);
      }
    }
  }
}

struct Seq { int base, T, grid, b; bool sample; };
DI Seq get_seq(int s) { Seq q; if (s < 32) { q.base = s * 256; q.T = 256; q.grid = 0; q.b = s; q.sample = false; } else { q.b = s - 32; q.base = 8192 + q.b * 2048; q.T = 2048; q.grid = 1; q.sample = true; } return q; }

DI float rw_shift(const bf16_t* ZR, const float* mu, int base, int t, int T, int grid, int col) {
  const bf16_t* pp = ZR + (size_t)(base + t) * ZRW + col;
  const float y = bf2f(*pp);
  if (!grid) {
    const float prev = t > 0 ? bf2f(pp[-ZRW]) : 0.f, nxt = t < T - 1 ? bf2f(pp[ZRW]) : 0.f;
    return y + mu[col] * (prev - y) + mu[ZRW + col] * (nxt - y);
  }
  const int gc = t & 63, gr = t >> 6;
  const float left = gc > 0 ? bf2f(pp[-ZRW]) : 0.f, right = gc < 63 ? bf2f(pp[ZRW]) : 0.f;
  const float up = gr > 0 ? bf2f(pp[-64 * ZRW]) : 0.f, down = gr < 31 ? bf2f(pp[64 * ZRW]) : 0.f;
  return y + mu[col] * (left - y) + mu[ZRW + col] * (right - y) + mu[2 * ZRW + col] * (up - y) + mu[3 * ZRW + col] * (down - y);
}

DI void rw_shift8(const bf16_t* ZR, const float* mu, int base, int t, int T, int grid, int col0, float (&out)[8]) {
  const bf16_t* pp = ZR + (size_t)(base + t) * ZRW + col0;
  const bf16x8 y = *(const bf16x8*)pp;
  float yv[8];
#pragma unroll
  for (int e = 0; e < 8; ++e) { yv[e] = bf2f((bf16_t)y[e]); out[e] = yv[e]; }
  const int nn = grid ? 4 : 2;
#pragma unroll 1
  for (int n = 0; n < nn; ++n) {
    bool valid; int off;
    if (!grid) { valid = n == 0 ? t > 0 : t < T - 1; off = n == 0 ? -ZRW : ZRW; }
    else { const int gc = t & 63, gr = t >> 6; valid = n == 0 ? gc > 0 : n == 1 ? gc < 63 : n == 2 ? gr > 0 : gr < 31; off = n == 0 ? -ZRW : n == 1 ? ZRW : n == 2 ? -64 * ZRW : 64 * ZRW; }
    const f32x4 m0 = *(const f32x4*)(mu + n * ZRW + col0), m1 = *(const f32x4*)(mu + n * ZRW + col0 + 4);
    bf16x8 nb = y;
    if (valid) nb = *(const bf16x8*)(pp + off);
#pragma unroll
    for (int e = 0; e < 8; ++e) { const float nv_ = valid ? bf2f((bf16_t)nb[e]) : 0.f; const float mm = e < 4 ? m0[e & 3] : m1[e & 3]; out[e] += mm * (nv_ - yv[e]); }
  }
}

DI void rw_load8(const bf16_t* ZR, int base, int t, int T, int grid, int col0, bf16x8 (&v)[5]) {
  const bf16_t* pp = ZR + (size_t)(base + t) * ZRW + col0;
  const int gc = t & 63, gr = t >> 6;
  const int o1 = grid ? (gc > 0 ? -ZRW : 0) : (t > 0 ? -ZRW : 0);
  const int o2 = grid ? (gc < 63 ? ZRW : 0) : (t < T - 1 ? ZRW : 0);
  v[0] = *(const bf16x8*)pp;
  v[1] = *(const bf16x8*)(pp + o1);
  v[2] = *(const bf16x8*)(pp + o2);
  if (grid) {
    v[3] = *(const bf16x8*)(pp + (gr > 0 ? -64 * ZRW : 0)); v[4] = *(const bf16x8*)(pp + (gr < 31 ? 64 * ZRW : 0));
  } else {
    v[3] = (bf16x8){0, 0, 0, 0, 0, 0, 0, 0}; v[4] = (bf16x8){0, 0, 0, 0, 0, 0, 0, 0};
  }
}
DI unsigned rw_valid(int t, int T, int grid) {
  if (!grid) return (t > 0 ? 1u : 0u) | (t < T - 1 ? 2u : 0u);
  const int gc = t & 63, gr = t >> 6;
  return (gc > 0 ? 1u : 0u) | (gc < 63 ? 2u : 0u) | (gr > 0 ? 4u : 0u) | (gr < 31 ? 8u : 0u);
}
DI void rw_apply8(const bf16x8 (&v)[5], const float* mu, int grid, unsigned valid, int col0, float (&out)[8]) {
  float yv[8];
#pragma unroll
  for (int e = 0; e < 8; ++e) { yv[e] = bf2f((bf16_t)v[0][e]); out[e] = yv[e]; }
#pragma unroll
  for (int n = 0; n < 4; ++n) {
    if (n < 2 || grid) {
      const f32x4 m0 = *(const f32x4*)(mu + n * ZRW + col0), m1 = *(const f32x4*)(mu + n * ZRW + col0 + 4);
      const bool ok = (valid >> n) & 1u;
#pragma unroll
      for (int e = 0; e < 8; ++e) out[e] += (e < 4 ? m0[e & 3] : m1[e & 3]) * ((ok ? bf2f((bf16_t)v[1 + n][e]) : 0.f) - yv[e]);
    }
  }
}
DI void rw_apply8_lds(const bf16x8 (&v)[5], const float* mu5c, const float* c0c, int grid, unsigned valid, float (&out)[8]) {
  {
    const f32x4 c0 = *(const f32x4*)c0c, c1 = *(const f32x4*)(c0c + 4);
#pragma unroll
    for (int e = 0; e < 8; ++e) out[e] = bf2f((bf16_t)v[0][e]) * (e < 4 ? c0[e & 3] : c1[e & 3]);
  }
#pragma unroll
  for (int n = 0; n < 4; ++n) {
    if (n < 2 || grid) {
      const f32x4 m0 = *(const f32x4*)(mu5c + n * 320), m1 = *(const f32x4*)(mu5c + n * 320 + 4);
      const float ok = ((valid >> n) & 1u) ? 1.0f : 0.0f;
#pragma unroll
      for (int e = 0; e < 8; ++e) out[e] += (e < 4 ? m0[e & 3] : m1[e & 3]) * ok * bf2f((bf16_t)v[1 + n][e]);
    }
  }
}
DI float fast_tanh(float x) { return 1.0f - 2.0f / (1.0f + __expf(2.0f * x)); }
template <int N> DI float dpp_row_shr0(float x) { return __int_as_float(__builtin_amdgcn_update_dpp(0, __float_as_int(x), 0x110 + N, 0xF, 0xF, false)); }

DI void rwkv_item(const Params& p, int l, int s, int hh, int d, char* smem) {
  const Seq q = get_seq(s);
  const int tid0 = ltid();
  const int w = __builtin_amdgcn_readfirstlane(tid0 >> 6), vb = w >> 1, kb = w & 1;
  int tid = tid0, lane = tid & 63, l15 = lane & 15, qq = lane >> 4, r32 = lane & 31, h = lane >> 5;
  const bf16_t* ZR = (const bf16_t*)(p.ws + OFF_ZR);
  bf16_t* O = (bf16_t*)(p.ws + OFF_O);
  const float* mu = p.in[I_MU] + (size_t)l * 4 * ZRW;
  bf16_t* KHr = (bf16_t*)smem;
  bf16_t* BCr = KHr + 16 * 72;
  bf16_t* KC = BCr + 16 * 72;
  bf16_t* RH = KC + 16 * 72;
  bf16_t* Sb = RH + 16 * 72;
  bf16_t* Wb2 = (bf16_t*)smem;
  bf16_t* Ab2 = Wb2 + 64 * 72;
  float* mu5 = (float*)(smem + 18432);
  bf16_t* actW = (bf16_t*)(smem + 23552);
  bf16_t* actA = actW + 16 * 72;
  float* shR = (float*)(smem + 28160);
  float* shK = shR + 1024; float* shV = shK + 1024;
  bf16_t* VT = (bf16_t*)(smem + 40448);
  bf16_t* UNT = VT + 64 * 40;
  bf16_t* KBT = UNT + 64 * 40;
  bf16_t* BBT = KBT + 64 * 24;
  float* PL = (float*)(smem + 56832);
  float* npart = PL + 64;
  float* MN = (float*)(smem + 57344);
  float* G0 = (float*)(smem + 61440);
  bf16_t* ArkM = (bf16_t*)(smem + 65536);
  bf16_t* ArbM = ArkM + 16 * 40;
  float* c0t = (float*)(smem + 68096);
  __syncthreads();
  for (int e = tid; e < 4096; e += NTHR) {
    const int i = e >> 6, c = e & 63;
    Wb2[c * 72 + i] = f2bf(p.in[I_W2][((size_t)(l * 2 + d) * 64 + i) * 512 + 64 * hh + c]);
    Ab2[c * 72 + i] = f2bf(p.in[I_A2][((size_t)(l * 2 + d) * 64 + i) * 512 + 64 * hh + c]);
  }
  for (int e = tid; e < 1280; e += NTHR) {
    const int n = e / 320, rem = e % 320, arr = rem >> 6, c = rem & 63;
    const int col = arr == 0 ? 64 * hh + c : arr == 1 ? 512 + 64 * hh + c : arr == 2 ? 1024 + 64 * hh + c : arr == 3 ? 1536 + 64 * d + c : 1664 + 64 * d + c;
    mu5[e] = mu[n * ZRW + col];
  }
  for (int e = tid; e < 320; e += NTHR) {
    const int arr = e >> 6, c = e & 63;
    const int col = arr == 0 ? 64 * hh + c : arr == 1 ? 512 + 64 * hh + c : arr == 2 ? 1024 + 64 * hh + c : arr == 3 ? 1536 + 64 * d + c : 1664 + 64 * d + c;
    float sm_ = mu[col] + mu[ZRW + col];
    if (q.grid) sm_ += mu[2 * ZRW + col] + mu[3 * ZRW + col];
    c0t[e] = 1.0f - sm_;
  }
  const int cB0 = 16 * w + 4 * qq;
  float w0c[4], a0c[4], kkc[4], kac[4];
#pragma unroll
  for (int g = 0; g < 4; ++g) {
    w0c[g] = p.in[I_W0][(l * 2 + d) * 512 + 64 * hh + cB0 + g]; a0c[g] = p.in[I_A0][(l * 2 + d) * 512 + 64 * hh + cB0 + g];
    kkc[g] = p.in[I_KK][l * 512 + 64 * hh + cB0 + g]; kac[g] = p.in[I_KA][l * 512 + 64 * hh + cB0 + g];
  }
  f32x16 S;
  if (q.sample) {
    const float* st = p.in[I_SR] + ((((size_t)q.b * 2 + l) * 2 + d) * 8 + hh) * 4096;
#pragma unroll
    for (int g = 0; g < 16; ++g) S[g] = st[(32 * vb + crow(g, h)) * 64 + 32 * kb + r32];
  } else {
#pragma unroll
    for (int g = 0; g < 16; ++g) S[g] = 0.f;
  }
  __syncthreads();
  bf16x8 bW[2], bA[2];
#pragma unroll
  for (int ks = 0; ks < 2; ++ks) { bW[ks] = *(const bf16x8*)(Wb2 + (16 * w + l15) * 72 + ks * 32 + qq * 8); bA[ks] = *(const bf16x8*)(Ab2 + (16 * w + l15) * 72 + ks * 32 + qq * 8); }
  __syncthreads();
  for (int e = tid; e < (2 * 64 * 40 + 2 * 64 * 24) / 2; e += NTHR) ((unsigned*)VT)[e] = 0u;
  for (int e = tid; e < (2 * 16 * 40) / 2; e += NTHR) ((unsigned*)ArkM)[e] = 0u;
  const int nch = q.T / 16;
  bf16x8 pf[3][5];
  const int jA = (tid0 & 127) >> 3, c8A = (tid0 & 7) * 8, wh = w >> 1;
#define RW_CB(arr) ((arr) == 0 ? 64 * hh : (arr) == 1 ? 512 + 64 * hh : (arr) == 2 ? 1024 + 64 * hh : (arr) == 3 ? 1536 + 64 * d : 1664 + 64 * d)
#define RW_ISSUE(chn) { const int pos = (chn) * 16 + jA, t = d ? q.T - 1 - pos : pos; _Pragma("unroll") for (int gi = 0; gi < 3; ++gi) { if (gi < 2 || w < 2) { \
      rw_load8(ZR, q.base, t, q.T, q.grid, RW_CB(2 * gi + wh) + c8A, pf[gi]); } } }
#pragma unroll
  for (int g = 0; g < 4; ++g) asm volatile("" : "+v"(w0c[g]), "+v"(a0c[g]), "+v"(kkc[g]), "+v"(kac[g]));
  asm volatile("" : "+v"(S));
  RW_ISSUE(0)
#pragma unroll 1
  for (int ch = 0; ch < nch; ++ch) {
    tid = tid0; asm volatile("" : "+v"(tid));
    lane = tid & 63; l15 = lane & 15; qq = lane >> 4; r32 = lane & 31; h = lane >> 5;
    __syncthreads();
    {
      const int pos_ = ch * 16 + jA, t_ = d ? q.T - 1 - pos_ : pos_;
      const unsigned vd_ = rw_valid(t_, q.T, q.grid);
#pragma unroll
      for (int gi = 0; gi < 3; ++gi) {
        if (gi < 2 || w < 2) {
          const int arr = 2 * gi + wh;
          float val[8];
          rw_apply8_lds(pf[gi], mu5 + arr * 64 + c8A, c0t + arr * 64 + c8A, q.grid, vd_, val);
          if (arr < 3) {
            *(f32x4*)(shR + arr * 1024 + jA * 64 + c8A) = (f32x4){val[0], val[1], val[2], val[3]};
            *(f32x4*)(shR + arr * 1024 + jA * 64 + c8A + 4) = (f32x4){val[4], val[5], val[6], val[7]};
            if (arr == 2) {
#pragma unroll
              for (int e = 0; e < 8; ++e) VT[(c8A + e) * 40 + jA] = f2bf(val[e]);
            }
          } else if (arr == 3) {
            *(u32x4*)(actW + jA * 72 + c8A) = (u32x4){pk2(fast_tanh(val[0]), fast_tanh(val[1])), pk2(fast_tanh(val[2]), fast_tanh(val[3])), pk2(fast_tanh(val[4]), fast_tanh(val[5])), pk2(fast_tanh(val[6]), fast_tanh(val[7]))};
          } else {
            *(u32x4*)(actA + jA * 72 + c8A) = (u32x4){pk2(val[0], val[1]), pk2(val[2], val[3]), pk2(val[4], val[5]), pk2(val[6], val[7])};
          }
        }
      }
    }
    asm volatile("" ::: "memory"); __builtin_amdgcn_sched_barrier(0);
    if (ch + 1 < nch) RW_ISSUE(ch + 1)
    __syncthreads();
    {
      f32x4 aw = (f32x4){0.f, 0.f, 0.f, 0.f}, aa = (f32x4){0.f, 0.f, 0.f, 0.f};
#pragma unroll
      for (int ks = 0; ks < 2; ++ks) {
        const bf16x8 fw = *(const bf16x8*)(actW + l15 * 72 + ks * 32 + qq * 8);
        const bf16x8 fa = *(const bf16x8*)(actA + l15 * 72 + ks * 32 + qq * 8);
        aw = __builtin_amdgcn_mfma_f32_16x16x32_bf16(bW[ks], fw, aw, 0, 0, 0);
        aa = __builtin_amdgcn_mfma_f32_16x16x32_bf16(bA[ks], fa, aa, 0, 0, 0);
      }
      const f32x4 kv = *(const f32x4*)(shK + l15 * 64 + cB0), rv = *(const f32x4*)(shR + l15 * 64 + cB0);
      float lw[4], av[4], kkr[4], kd[4], Lp[4], LpL[4];
      float ssq = 0.f;
#pragma unroll
      for (int g = 0; g < 4; ++g) {
        const float wl = aw[g] + w0c[g], al = aa[g] + a0c[g];
        lw[g] = -__expf(-softplusf_(-wl) - 0.5f);
        av[g] = sigmoidf_(al);
        kkr[g] = kv[g] * kkc[g];
        kd[g] = kv[g] * (1.0f + (av[g] - 1.0f) * kac[g]);
        ssq += kkr[g] * kkr[g];
        float x = lw[g];
        x += dpp_row_shr0<1>(x); x += dpp_row_shr0<2>(x); x += dpp_row_shr0<4>(x); x += dpp_row_shr0<8>(x);
        Lp[g] = x;
      }
#pragma unroll
      for (int g = 0; g < 4; ++g) { float x = Lp[g];
        x = fminf(x, __int_as_float(__builtin_amdgcn_mov_dpp(__float_as_int(x), 0x128, 0xF, 0xF, true))); x = fminf(x, __int_as_float(__builtin_amdgcn_mov_dpp(__float_as_int(x), 0x124, 0xF, 0xF, true)));
        x = fminf(x, dpp_xor2(x)); x = fminf(x, dpp_xor1(x)); LpL[g] = x; }
      ssq += SHX(ssq, 16); ssq += SHX(ssq, 32);
      if (qq == 0) npart[w * 16 + l15] = ssq;
      float e_m1[4], e_neg[4], e_pos[4], e_end[4];
#pragma unroll
      for (int g = 0; g < 4; ++g) { e_m1[g] = __expf(Lp[g] - lw[g]); e_neg[g] = __expf(-Lp[g]); e_pos[g] = __expf(Lp[g]); e_end[g] = __expf(LpL[g] - Lp[g]); }
      *(u32x2*)(KHr + l15 * 72 + cB0) = (u32x2){pk2(kkr[0] * e_m1[0], kkr[1] * e_m1[1]), pk2(kkr[2] * e_m1[2], kkr[3] * e_m1[3])};
      *(u32x2*)(BCr + l15 * 72 + cB0) = (u32x2){pk2(kkr[0] * av[0] * e_neg[0], kkr[1] * av[1] * e_neg[1]), pk2(kkr[2] * av[2] * e_neg[2], kkr[3] * av[3] * e_neg[3])};
      *(u32x2*)(KC + l15 * 72 + cB0) = (u32x2){pk2(kd[0] * e_neg[0], kd[1] * e_neg[1]), pk2(kd[2] * e_neg[2], kd[3] * e_neg[3])};
      *(u32x2*)(RH + l15 * 72 + cB0) = (u32x2){pk2(rv[0] * e_pos[0], rv[1] * e_pos[1]), pk2(rv[2] * e_pos[2], rv[3] * e_pos[3])};
#pragma unroll
      for (int g = 0; g < 4; ++g) {
        KBT[(cB0 + g) * 24 + l15] = f2bf(kd[g] * e_end[g]);
        BBT[(cB0 + g) * 24 + l15] = f2bf(kkr[g] * av[g] * e_end[g]);
      }
      if (l15 == 15) *(f32x4*)(PL + cB0) = (f32x4){e_pos[0], e_pos[1], e_pos[2], e_pos[3]};
#pragma unroll
      for (int g = 0; g < 16; ++g) Sb[(32 * vb + crow(g, h)) * 72 + 32 * kb + r32] = f2bf(S[g]);
    }
    __syncthreads();
    f32x4 oacc = (f32x4){0.f, 0.f, 0.f, 0.f};
    {
      const bf16_t* Aop = (w < 2) ? KHr : RH;
      const bf16_t* Bop = (w == 0 || w == 3) ? BCr : KC;
      f32x4 t16 = (f32x4){0.f, 0.f, 0.f, 0.f}, g0 = (f32x4){0.f, 0.f, 0.f, 0.f};
#pragma unroll
      for (int ks = 0; ks < 2; ++ks) {
        const bf16x8 a = *(const bf16x8*)(Aop + l15 * 72 + ks * 32 + qq * 8);
        const bf16x8 b = *(const bf16x8*)(Bop + l15 * 72 + ks * 32 + qq * 8);
        t16 = __builtin_amdgcn_mfma_f32_16x16x32_bf16(a, b, t16, 0, 0, 0);
        const bf16x8 akh = *(const bf16x8*)(KHr + l15 * 72 + ks * 32 + qq * 8);
        const bf16x8 arh = *(const bf16x8*)(RH + l15 * 72 + ks * 32 + qq * 8);
        const bf16x8 bs = *(const bf16x8*)(Sb + (16 * w + l15) * 72 + ks * 32 + qq * 8);
        g0 = __builtin_amdgcn_mfma_f32_16x16x32_bf16(akh, bs, g0, 0, 0, 0);
        oacc = __builtin_amdgcn_mfma_f32_16x16x32_bf16(arh, bs, oacc, 0, 0, 0);
      }
#pragma unroll
      for (int g = 0; g < 4; ++g) G0[(4 * qq + g) * 64 + 16 * w + l15] = g0[g];
      *(f32x4*)(MN + w * 256 + l15 * 16 + 4 * qq) = t16;
    }
    __syncthreads();
    if (w == 0) {
      const float* MrT = MN; const float* NrT = MN + 256;
      f32x2 acc2[8];
#pragma unroll
      for (int pq = 0; pq < 8; ++pq) acc2[pq] = (f32x2){G0[(2 * pq) * 64 + lane], G0[(2 * pq + 1) * 64 + lane]};
      float vv[16], un[16];
#pragma unroll
      for (int j = 0; j < 16; ++j) vv[j] = shV[j * 64 + lane];
      const float n2v = __builtin_amdgcn_rcpf(fmaxf(npart[l15] + npart[16 + l15] + npart[32 + l15] + npart[48 + l15], 1e-24f));
      f32x4 nr[4], mr[4];
#pragma unroll
      for (int t4 = 0; t4 < 4; ++t4) { nr[t4] = *(const f32x4*)(NrT + 4 * t4); mr[t4] = *(const f32x4*)(MrT + 4 * t4); }
#pragma unroll
      for (int j = 0; j < 16; ++j) {
        f32x4 nrn[4], mrn[4];
#pragma unroll
        for (int t4 = 0; t4 < 4; ++t4) { nrn[t4] = (f32x4){0.f, 0.f, 0.f, 0.f}; mrn[t4] = (f32x4){0.f, 0.f, 0.f, 0.f}; }
        if (j + 1 < 16) {
#pragma unroll
          for (int t4 = 0; t4 < 4; ++t4) if (4 * t4 + 3 > j + 1) { nrn[t4] = *(const f32x4*)(NrT + (j + 1) * 16 + 4 * t4); mrn[t4] = *(const f32x4*)(MrT + (j + 1) * 16 + 4 * t4); }
        }
        const float n2s = __int_as_float(__builtin_amdgcn_readlane(__float_as_int(n2v), j));
        const float unj = -acc2[j >> 1][j & 1] * n2s;
        un[j] = unj;
        const f32x2 vv2 = (f32x2){vv[j], vv[j]}, un2 = (f32x2){unj, unj};
#pragma unroll
        for (int pq = 0; pq < 8; ++pq)
          if (2 * pq + 1 > j) acc2[pq] += (f32x2){nr[pq >> 1][2 * (pq & 1)], nr[pq >> 1][2 * (pq & 1) + 1]} * vv2 + (f32x2){mr[pq >> 1][2 * (pq & 1)], mr[pq >> 1][2 * (pq & 1) + 1]} * un2;
#pragma unroll
        for (int t4 = 0; t4 < 4; ++t4) { nr[t4] = nrn[t4]; mr[t4] = mrn[t4]; }
        __builtin_amdgcn_sched_barrier(0);
      }
      *(u32x4*)(UNT + lane * 40) = (u32x4){pk2(un[0], un[1]), pk2(un[2], un[3]), pk2(un[4], un[5]), pk2(un[6], un[7])};
      *(u32x4*)(UNT + lane * 40 + 8) = (u32x4){pk2(un[8], un[9]), pk2(un[10], un[11]), pk2(un[12], un[13]), pk2(un[14], un[15])};
    } else if (w < 3) {
      const float* src = MN + (w == 1 ? 512 : 768);
      bf16_t* dst = (w == 1) ? ArkM : ArbM;
#pragma unroll
      for (int i = 0; i < 4; ++i) { const int e = lane + 64 * i, j = e >> 4, t = e & 15; dst[t * 40 + j] = f2bf(j <= t ? src[e] : 0.f); }
    }
    __syncthreads();
    {
      const bf16x8 ak = *(const bf16x8*)(ArkM + l15 * 40 + qq * 8), ab = *(const bf16x8*)(ArbM + l15 * 40 + qq * 8);
      const bf16x8 bv = *(const bf16x8*)(VT + (16 * w + l15) * 40 + qq * 8), bu = *(const bf16x8*)(UNT + (16 * w + l15) * 40 + qq * 8);
      oacc = __builtin_amdgcn_mfma_f32_16x16x32_bf16(ak, bv, oacc, 0, 0, 0);
      oacc = __builtin_amdgcn_mfma_f32_16x16x32_bf16(ab, bu, oacc, 0, 0, 0);
#pragma unroll
      for (int g = 0; g < 4; ++g) {
        const int pos = ch * 16 + 4 * qq + g, t = d ? q.T - 1 - pos : pos;
        O[(size_t)(q.base + t) * 1024 + d * 512 + 64 * hh + 16 * w + l15] = f2bf(oacc[g]);
      }
      const float pl = PL[32 * kb + r32];
#pragma unroll
      for (int g = 0; g < 16; ++g) S[g] *= pl;
      const bf16x8 av_ = *(const bf16x8*)(VT + (32 * vb + r32) * 40 + 8 * h), au_ = *(const bf16x8*)(UNT + (32 * vb + r32) * 40 + 8 * h);
      const bf16x8 bk_ = *(const bf16x8*)(KBT + (32 * kb + r32) * 24 + 8 * h), bb_ = *(const bf16x8*)(BBT + (32 * kb + r32) * 24 + 8 * h);
      S = __builtin_amdgcn_mfma_f32_32x32x16_bf16(av_, bk_, S, 0, 0, 0);
      S = __builtin_amdgcn_mfma_f32_32x32x16_bf16(au_, bb_, S, 0, 0, 0);
    }
  }
  if (!q.sample) {
    float* dst = p.out + OUT_RW + ((((size_t)q.b * 2 + l) * 2 + d) * 8 + hh) * 4096;
#pragma unroll
    for (int g = 0; g < 16; ++g) dst[(32 * vb + crow(g, h)) * 64 + 32 * kb + r32] = S[g];
  }
}

DI void hgrn_item(const Params& p, int l, int s, int hh, int d, char* smem) {
  const Seq q = get_seq(s);
  const int tid = ltid(), lane = tid & 63, w = tid >> 6, r = lane & 31, h = lane >> 5;
  bf16_t* ZH = (bf16_t*)(p.ws + OFF_ZH);
  bf16_t* Qt = (bf16_t*)smem;
  bf16_t* Kt = Qt + 32 * 136;
  bf16_t* KhT = Kt + 32 * 136;
  bf16_t* VT = KhT + 128 * 40;
  bf16_t* Sb = VT + 128 * 40;
  bf16_t* At = Sb + 4 * 32 * 136;
  float* dL = (float*)(At + 32 * 40);
  float* tot = dL + 128;
  const float lb = ((const float*)(p.ws + OFF_LBS))[l * 512 + 128 * hh + (tid & 127)];
  f32x16 S[4];
  if (q.sample) {
    const float* st = p.in[I_SH] + ((((size_t)q.b * 2 + l) * 2 + d) * 4 + hh) * 16384;
#pragma unroll
    for (int kb = 0; kb < 4; ++kb)
#pragma unroll
      for (int g = 0; g < 16; ++g) S[kb][g] = st[(size_t)(32 * kb + crow(g, h)) * 128 + 32 * w + r];
  } else {
#pragma unroll
    for (int kb = 0; kb < 4; ++kb)
#pragma unroll
      for (int g = 0; g < 16; ++g) S[kb][g] = 0.f;
  }
  const int k = tid & 127, half = tid >> 7;
  const int nch = q.T / 32;
  u16x2 pzq[16], pv2[8];
#define HG_ISSUE(chn) { _Pragma("unroll") for (int jj = 0; jj < 16; ++jj) { const int pos = (chn) * 32 + half * 16 + jj, t = d ? q.T - 1 - pos : pos; \
      const size_t rowo = (size_t)(q.base + t) * ZHW + 128 * hh + k; pzq[jj][0] = ZH[rowo + 512 * (1 + d)]; pzq[jj][1] = ZH[rowo]; pv2[jj >> 1][jj & 1] = ZH[rowo + 1536]; } }
  { float lb_ = lb; asm volatile("" : "+v"(lb_)); (void)lb_; }
#pragma unroll
  for (int kb = 0; kb < 4; ++kb) asm volatile("" : "+v"(S[kb]));
  HG_ISSUE(0)
#pragma unroll 1
  for (int ch = 0; ch < nch; ++ch) {
    __syncthreads();
    float bl[16], kc[16], qs[16];
    {
      float b = 0.f;
#pragma unroll
      for (int jj = 0; jj < 16; ++jj) {
        const float z = bf2f(pzq[jj][0]);
        const float kcoef = (1.0f - lb) * sigmoidf_(-z);
        const float f = 1.0f - kcoef;
        b += fmaxf(__logf(f), -80.f);
        bl[jj] = b; kc[jj] = kcoef; qs[jj] = bf2f(pzq[jj][1]) * 0.08838834764831845f;
      }
      *(u32x4*)(VT + k * 40 + half * 16) = (u32x4){__builtin_bit_cast(unsigned, pv2[0]), __builtin_bit_cast(unsigned, pv2[1]), __builtin_bit_cast(unsigned, pv2[2]), __builtin_bit_cast(unsigned, pv2[3])};
      *(u32x4*)(VT + k * 40 + half * 16 + 8) = (u32x4){__builtin_bit_cast(unsigned, pv2[4]), __builtin_bit_cast(unsigned, pv2[5]), __builtin_bit_cast(unsigned, pv2[6]), __builtin_bit_cast(unsigned, pv2[7])};
      tot[half * 128 + k] = b;
    }
    if (ch + 1 < nch) HG_ISSUE(ch + 1)
    __syncthreads();
    {
      const float off = half ? tot[k] : 0.f;
      const float bL = fmaxf(tot[k] + tot[128 + k], -80.f);
      if (half == 0) dL[k] = __expf(bL);
      float kh[16];
#pragma unroll
      for (int jj = 0; jj < 16; ++jj) {
        const int j = half * 16 + jj;
        const float bj = fmaxf(off + bl[jj], -80.f);
        Qt[j * 136 + k] = f2bf(qs[jj] * __expf(bj));
        Kt[j * 136 + k] = f2bf(kc[jj] * __expf(-bj));
        kh[jj] = kc[jj] * __expf(fminf(bL - bj, 0.f));
      }
      *(u32x4*)(KhT + k * 40 + half * 16) = (u32x4){pk2(kh[0], kh[1]), pk2(kh[2], kh[3]), pk2(kh[4], kh[5]), pk2(kh[6], kh[7])};
      *(u32x4*)(KhT + k * 40 + half * 16 + 8) = (u32x4){pk2(kh[8], kh[9]), pk2(kh[10], kh[11]), pk2(kh[12], kh[13]), pk2(kh[14], kh[15])};
    }
    bf16_t* Sbw = Sb + w * 32 * 136;
#pragma unroll
    for (int kb = 0; kb < 4; ++kb)
#pragma unroll
      for (int g4 = 0; g4 < 4; ++g4) *(u32x2*)(Sbw + r * 136 + 32 * kb + crow(4 * g4, h)) = (u32x2){pk2(S[kb][4 * g4], S[kb][4 * g4 + 1]), pk2(S[kb][4 * g4 + 2], S[kb][4 * g4 + 3])};
    __syncthreads();
    bf16_t* Atw = At;
    {
      f32x16 A;
#pragma unroll
      for (int g = 0; g < 16; ++g) A[g] = 0.f;
      mma32(A, Qt, 136, Kt, 136, 128, lane);
#pragma unroll
      for (int g = 0; g < 16; ++g) { const int t = crow(g, h); Atw[t * 40 + r] = f2bf(r <= t ? A[g] : 0.f); }
    }
    __syncthreads();
    {
      f32x16 o;
#pragma unroll
      for (int g = 0; g < 16; ++g) o[g] = 0.f;
      mma32(o, Atw, 40, VT + 32 * w * 40, 40, 32, lane);
      mma32(o, Qt, 136, Sbw, 136, 128, lane);
#pragma unroll
      for (int g = 0; g < 16; ++g) {
        const int j = crow(g, h), pos = ch * 32 + j, t = d ? q.T - 1 - pos : pos;
        ZH[(size_t)(q.base + t) * ZHW + 512 * (1 + d) + 128 * hh + 32 * w + r] = f2bf(o[g]);
      }
#pragma unroll
      for (int kb = 0; kb < 4; ++kb) {
#pragma unroll
        for (int g = 0; g < 16; ++g) S[kb][g] *= dL[32 * kb + crow(g, h)];
        mma32(S[kb], KhT + 32 * kb * 40, 40, VT + 32 * w * 40, 40, 32, lane);
      }
    }
  }
  if (!q.sample) {
    float* dst = p.out + OUT_HG + ((((size_t)q.b * 2 + l) * 2 + d) * 4 + hh) * 16384;
#pragma unroll
    for (int kb = 0; kb < 4; ++kb)
#pragma unroll
      for (int g = 0; g < 16; ++g) dst[(size_t)(32 * kb + crow(g, h)) * 128 + 32 * w + r] = S[kb][g];
  }
}

DI void mlstm_item(const Params& p, int l, int s, int hh, int d, char* smem) {
  const Seq q = get_seq(s);
  const int tid = ltid(), lane = tid & 63, w = tid >> 6, r = lane & 31, h = lane >> 5;
  const bf16_t* ZM = (const bf16_t*)(p.ws + OFF_ZM);
  const float* MG = (const float*)(p.ws + OFF_MG);
  bf16_t* Hb = (bf16_t*)(p.ws + OFF_H);
  bf16_t* Qm = (bf16_t*)smem;
  bf16_t* Km = Qm + 32 * 136;
  bf16_t* KwT = Km + 32 * 136;
  bf16_t* VT = KwT + 128 * 40;
  bf16_t* Cb = VT + 128 * 40;
  bf16_t* Pt = Cb + 4 * 32 * 136;
  float* nv = (float*)(Pt + 32 * 40);
  float* sc = nv + 128;
  float* ig = sc; float* lf = sc + 32; float* gg = sc + 64; float* mtv = sc + 96; float* wi = sc + 128; float* wsr = sc + 160; float* qn = sc + 192; float* misc = sc + 224;
  float* dnw = sc + 232;
  const float gbi = p.in[I_GB][l * 16 + (2 * d) * 4 + hh], gbf = p.in[I_GB][l * 16 + (2 * d + 1) * 4 + hh];
  f32x16 C[4];
  float m;
  __syncthreads();
  if (q.sample) {
    const size_t sb = (((size_t)q.b * 2 + l) * 2 + d) * 4 + hh;
    const float* st = p.in[I_SC] + sb * 16384;
#pragma unroll
    for (int kb = 0; kb < 4; ++kb)
#pragma unroll
      for (int g = 0; g < 16; ++g) C[kb][g] = st[(size_t)(32 * kb + crow(g, h)) * 128 + 32 * w + r];
    if (tid < 128) nv[tid] = p.in[I_SN][sb * 128 + tid];
    m = p.in[I_SM][sb];
  } else {
#pragma unroll
    for (int kb = 0; kb < 4; ++kb)
#pragma unroll
      for (int g = 0; g < 16; ++g) C[kb][g] = 0.f;
    if (tid < 128) nv[tid] = 0.f;
    m = 0.f;
  }
  const int nch = q.T / 32;
  const int dd = tid & 127, half = tid >> 7;
  u16x2 pqk[16], pv2[8]; float pgi = 0.f, pgf = 0.f;
#define ML_ISSUE(chn) { _Pragma("unroll") for (int jj = 0; jj < 16; ++jj) { const int pos = (chn) * 32 + half * 16 + jj, t = d ? q.T - 1 - pos : pos; \
      const size_t rowo = (size_t)(q.base + t) * ZMW + 128 * hh + dd; pqk[jj][0] = ZM[rowo]; pqk[jj][1] = ZM[rowo + 512]; pv2[jj >> 1][jj & 1] = ZM[rowo + 1024]; } \
    if (tid < 32) { const int pos = (chn) * 32 + tid, t = d ? q.T - 1 - pos : pos; const float* mg = MG + (size_t)(q.base + t) * 16; pgi = mg[(2 * d) * 4 + hh]; pgf = mg[(2 * d + 1) * 4 + hh]; } }
#pragma unroll
  for (int kb = 0; kb < 4; ++kb) asm volatile("" : "+v"(C[kb]));
  asm volatile("" : "+v"(m));
  ML_ISSUE(0)
#pragma unroll 1
  for (int ch = 0; ch < nch; ++ch) {
    __syncthreads();
    {
#pragma unroll
      for (int jj = 0; jj < 16; ++jj) {
        const int j = half * 16 + jj;
        Qm[j * 136 + dd] = pqk[jj][0];
        Km[j * 136 + dd] = f2bf(bf2f(pqk[jj][1]) * 0.08838834764831845f);
      }
      *(u32x4*)(VT + dd * 40 + half * 16) = (u32x4){__builtin_bit_cast(unsigned, pv2[0]), __builtin_bit_cast(unsigned, pv2[1]), __builtin_bit_cast(unsigned, pv2[2]), __builtin_bit_cast(unsigned, pv2[3])};
      *(u32x4*)(VT + dd * 40 + half * 16 + 8) = (u32x4){__builtin_bit_cast(unsigned, pv2[4]), __builtin_bit_cast(unsigned, pv2[5]), __builtin_bit_cast(unsigned, pv2[6]), __builtin_bit_cast(unsigned, pv2[7])};
      if (tid < 32) {
        const float igv = pgi + gbi;
        const float lfv = -softplusf_(-(pgf + gbf));
        float g = lfv;
#pragma unroll
        for (int o = 1; o < 32; o <<= 1) { const float tt = shfl_lane(g, (lane - o) & 63); if (tid >= o) g += tt; }
        const float cs = igv - g;
        float pm = cs;
#pragma unroll
        for (int o = 1; o < 32; o <<= 1) { const float tt = shfl_lane(pm, (lane - o) & 63); if (tid >= o) pm = fmaxf(pm, tt); }
        const float mt = g + fmaxf(m, pm);
        const float gend = shfl_lane(g, 31), mn = shfl_lane(mt, 31);
        ig[tid] = igv; gg[tid] = g; mtv[tid] = mt; wi[tid] = __expf(g + m - mt);
        wsr[tid] = __expf(gend + cs - mn);
        if (tid == 0) { misc[0] = mn; misc[1] = __expf(gend + m - mn); }
      }
    }
    if (ch + 1 < nch) ML_ISSUE(ch + 1)
    __syncthreads();
    {
      {
        float kw[16];
#pragma unroll
        for (int jj = 0; jj < 16; ++jj) { const int j = half * 16 + jj; kw[jj] = bf2f(Km[j * 136 + dd]) * wsr[j]; }
        *(u32x4*)(KwT + dd * 40 + half * 16) = (u32x4){pk2(kw[0], kw[1]), pk2(kw[2], kw[3]), pk2(kw[4], kw[5]), pk2(kw[6], kw[7])};
        *(u32x4*)(KwT + dd * 40 + half * 16 + 8) = (u32x4){pk2(kw[8], kw[9]), pk2(kw[10], kw[11]), pk2(kw[12], kw[13]), pk2(kw[14], kw[15])};
      }
      const int j = tid >> 3, seg = tid & 7;
      float a = 0.f;
#pragma unroll
      for (int i = 0; i < 16; ++i) a += bf2f(Qm[j * 136 + seg * 16 + i]) * nv[seg * 16 + i];
      a += SHX(a, 1); a += SHX(a, 2); a += SHX(a, 4);
      if (seg == 0) qn[j] = a;
    }
    const float m_new = misc[0], carry = misc[1];
    bf16_t* Cbw = Cb + w * 32 * 136; bf16_t* Ptw = Pt;
#pragma unroll
    for (int kb = 0; kb < 4; ++kb)
#pragma unroll
      for (int g4 = 0; g4 < 4; ++g4) *(u32x2*)(Cbw + r * 136 + 32 * kb + crow(4 * g4, h)) = (u32x2){pk2(C[kb][4 * g4], C[kb][4 * g4 + 1]), pk2(C[kb][4 * g4 + 2], C[kb][4 * g4 + 3])};
    {
      f32x16 Sc;
#pragma unroll
      for (int g = 0; g < 16; ++g) Sc[g] = 0.f;
      mma32(Sc, Qm, 136, Km, 136, 128, lane);
      const float gs = gg[r], is = ig[r];
#pragma unroll
      for (int g = 0; g < 16; ++g) {
        const int t = crow(g, h);
        const float pv = (r <= t) ? __expf(gg[t] - gs + is - mtv[t]) * Sc[g] : 0.f;
        Ptw[t * 40 + r] = f2bf(pv);
      }
    }
    __syncthreads();
    if (lane < 32) {
      float a = 0.f;
#pragma unroll 4
      for (int i = 0; i < 32; ++i) a += bf2f(Ptw[lane * 40 + i]);
      const float den = wi[lane] * qn[lane] + a;
      dnw[lane] = 1.0f / fmaxf(fabsf(den), __expf(-mtv[lane]));
    }
    if (tid < 128) {
      float a = 0.f;
#pragma unroll 4
      for (int i = 0; i < 32; ++i) a += bf2f(KwT[tid * 40 + i]);
      nv[tid] = carry * nv[tid] + a;
    }
    __syncthreads();
    {
      f32x16 a1;
#pragma unroll
      for (int g = 0; g < 16; ++g) a1[g] = 0.f;
      mma32(a1, Qm, 136, Cbw, 136, 128, lane);
#pragma unroll
      for (int g = 0; g < 16; ++g) a1[g] *= wi[crow(g, h)];
      mma32(a1, Ptw, 40, VT + 32 * w * 40, 40, 32, lane);
#pragma unroll
      for (int g = 0; g < 16; ++g) {
        const int j = crow(g, h), pos = ch * 32 + j, t = d ? q.T - 1 - pos : pos;
        const float hv = a1[g] * dnw[j];
        Hb[(size_t)(q.base + t) * 1024 + d * 512 + 128 * hh + 32 * w + r] = f2bf(hv);
      }
#pragma unroll
      for (int kb = 0; kb < 4; ++kb) {
#pragma unroll
        for (int g = 0; g < 16; ++g) C[kb][g] *= carry;
        mma32(C[kb], KwT + 32 * kb * 40, 40, VT + 32 * w * 40, 40, 32, lane);
      }
    }
    m = m_new;
  }
  __syncthreads();
  if (!q.sample) {
    const size_t sb = (((size_t)q.b * 2 + l) * 2 + d) * 4 + hh;
    float* dst = p.out + OUT_C + sb * 16384;
#pragma unroll
    for (int kb = 0; kb < 4; ++kb)
#pragma unroll
      for (int g = 0; g < 16; ++g) dst[(size_t)(32 * kb + crow(g, h)) * 128 + 32 * w + r] = C[kb][g];
    if (tid < 128) p.out[OUT_N + sb * 128 + tid] = nv[tid];
    if (tid == 0) p.out[OUT_M + sb] = m;
  }
}

DI void phase_scan(const Params& p, int l, char* smem) {
  int* ctrL = (int*)(p.ws + OFF_CTR) + 2 * l;
  int* ctrS = ctrL + 1;
  int* sit = (int*)(smem + LDS_BYTES - 16);
  const int role = p.role;
  bool longDone = false, shortDone = false;
  for (;;) {
    const bool wantLong = (role == 0) ? !longDone : shortDone;
    if (longDone && shortDone) break;
    __syncthreads();
    if (ltid() == 0) *sit = atomicAdd(wantLong ? ctrL : ctrS, 1);
    __syncthreads();
    int it = __builtin_amdgcn_readfirstlane(*sit);
    int ty, s_, hh_, d_, rb_ = 0;
    if (wantLong) {
      if (it >= 128) { longDone = true; continue; }
      if (it < 64) { ty = 0; d_ = it & 1; hh_ = (it >> 1) & 7; s_ = 32 + (it >> 4); }
      else if (it < 96) { it -= 64; ty = 1; s_ = 32 + (it >> 3); hh_ = (it >> 1) & 3; d_ = it & 1; }
      else { it -= 96; ty = 2; s_ = 32 + (it >> 3); hh_ = (it >> 1) & 3; d_ = it & 1; }
    } else {
      if (it >= 1024) { shortDone = true; continue; }
      if (it < 512) { ty = 0; s_ = it >> 4; hh_ = (it >> 1) & 7; d_ = it & 1; }
      else if (it < 768) { it -= 512; ty = 1; s_ = it >> 3; hh_ = (it >> 1) & 3; d_ = it & 1; }
      else { it -= 768; ty = 2; s_ = it >> 3; hh_ = (it >> 1) & 3; d_ = it & 1; }
    }
    if (ty == 0) rwkv_item(p, l, s_, hh_, d_, smem);
    else if (ty == 1) hgrn_item(p, l, s_, hh_, d_, smem);
    else mlstm_item(p, l, s_, hh_, d_, smem);
  }
}

DI void phase_combine(const Params& p, int l, char* smem) {
  const int tid = ltid(), lane = tid & 63, w = tid >> 6;
  bf16_t* ZH = (bf16_t*)(p.ws + OFF_ZH); bf16_t* ZM = (bf16_t*)(p.ws + OFF_ZM); const bf16_t* ZR = (const bf16_t*)(p.ws + OFF_ZR);
  bf16_t* O = (bf16_t*)(p.ws + OFF_O); const bf16_t* Hb = (const bf16_t*)(p.ws + OFF_H);
  const float* mu = p.in[I_MU] + (size_t)l * 4 * ZRW;
  const float* g2 = p.in[I_G2] + (size_t)l * 128 * 512;
  float* sg = (float*)smem;
  float* gt = sg + 128 * 16;
  for (int blk = blockIdx.x; blk < NT / 16; blk += gridDim.x) {
    const int tok0 = blk * 16;
    int sidx, t0;
    if (tok0 < 8192) { sidx = tok0 >> 8; t0 = tok0 & 255; } else { sidx = 32 + ((tok0 - 8192) >> 11); t0 = (tok0 - 8192) & 2047; }
    const Seq q = get_seq(sidx);
    __syncthreads();
    { const int j = tid >> 4, rr0 = (tid & 15) * 8; float val[8]; bf16x8 pv[5]; rw_load8(ZR, q.base, t0 + j, q.T, q.grid, 1792 + rr0, pv); rw_apply8(pv, mu, q.grid, rw_valid(t0 + j, q.T, q.grid), 1792 + rr0, val);
#pragma unroll
      for (int e = 0; e < 8; ++e) sg[(rr0 + e) * 16 + j] = sigmoidf_(val[e]); }
    __syncthreads();
    {
      float a0[16], a1[16];
#pragma unroll
      for (int j = 0; j < 16; ++j) { a0[j] = 0.f; a1[j] = 0.f; }
#pragma unroll 1
      for (int r0 = 0; r0 < 128; r0 += 8) {
        float w0v[8], w1v[8];
#pragma unroll
        for (int q8 = 0; q8 < 8; ++q8) { w0v[q8] = g2[(r0 + q8) * 512 + tid]; w1v[q8] = g2[(r0 + q8) * 512 + 256 + tid]; }
#pragma unroll
        for (int q8 = 0; q8 < 8; ++q8) {
          const int rr = r0 + q8; const float w0 = w0v[q8], w1 = w1v[q8];
#pragma unroll
          for (int u = 0; u < 4; ++u) {
            f32x4 sv = *(const f32x4*)(sg + rr * 16 + 4 * u);
#pragma unroll
            for (int e = 0; e < 4; ++e) { a0[4 * u + e] += sv[e] * w0; a1[4 * u + e] += sv[e] * w1; }
          }
        }
      }
#pragma unroll
      for (int j = 0; j < 16; ++j) { gt[j * 512 + tid] = a0[j]; gt[j * 512 + 256 + tid] = a1[j]; }
    }
    __syncthreads();
#pragma unroll 1
    for (int jj = 0; jj < 4; ++jj) {
      const int j = w * 4 + jj, tok = tok0 + j, t = t0 + j; int c0 = lane * 8; asm volatile("" : "+v"(c0));
      {
        float o[8], rs[8], ks[8], vs[8];
        float sum = 0.f, bon = 0.f;
        {
          bf16x8 pr_[5], pk_[5], pv_[5];
          rw_load8(ZR, q.base, t, q.T, q.grid, c0, pr_); rw_load8(ZR, q.base, t, q.T, q.grid, 512 + c0, pk_); rw_load8(ZR, q.base, t, q.T, q.grid, 1024 + c0, pv_);
          const unsigned vd_ = rw_valid(t, q.T, q.grid);
          rw_apply8(pr_, mu, q.grid, vd_, c0, rs); rw_apply8(pk_, mu, q.grid, vd_, 512 + c0, ks); rw_apply8(pv_, mu, q.grid, vd_, 1024 + c0, vs);
        }
        const bf16x8 of = *(const bf16x8*)(O + (size_t)tok * 1024 + c0), ob = *(const bf16x8*)(O + (size_t)tok * 1024 + 512 + c0);
        const f32x4 rk0 = *(const f32x4*)(p.in[I_RK] + l * 512 + c0), rk1 = *(const f32x4*)(p.in[I_RK] + l * 512 + c0 + 4);
#pragma unroll
        for (int e = 0; e < 8; ++e) {
          o[e] = bf2f((bf16_t)of[e]) + bf2f((bf16_t)ob[e]);
          sum += o[e];
          bon += rs[e] * ks[e] * (e < 4 ? rk0[e & 3] : rk1[e & 3]);
        }
        sum += SHX(sum, 1); sum += SHX(sum, 2); sum += SHX(sum, 4);
        bon += SHX(bon, 1); bon += SHX(bon, 2); bon += SHX(bon, 4);
        const float mean = sum * (1.0f / 64.f);
        float var = 0.f;
#pragma unroll
        for (int e = 0; e < 8; ++e) { const float dv = o[e] - mean; var += dv * dv; }
        var += SHX(var, 1); var += SHX(var, 2); var += SHX(var, 4);
        const float rstd = rsqrtf(var * (1.0f / 64.f) + 64e-5f);
        const f32x4 lw0 = *(const f32x4*)(p.in[I_LN] + (l * 2 + 0) * 512 + c0), lw1 = *(const f32x4*)(p.in[I_LN] + (l * 2 + 0) * 512 + c0 + 4);
        const f32x4 lb0 = *(const f32x4*)(p.in[I_LN] + (l * 2 + 1) * 512 + c0), lb1 = *(const f32x4*)(p.in[I_LN] + (l * 2 + 1) * 512 + c0 + 4);
        const f32x4 gt0 = *(const f32x4*)(gt + j * 512 + c0), gt1 = *(const f32x4*)(gt + j * 512 + c0 + 4);
        bf16x8 ov;
#pragma unroll
        for (int e = 0; e < 8; ++e) {
          const float ln = (o[e] - mean) * rstd * (e < 4 ? lw0[e & 3] : lw1[e & 3]) + (e < 4 ? lb0[e & 3] : lb1[e & 3]);
          ov[e] = (short)f2bf((ln + bon * vs[e]) * (e < 4 ? gt0[e & 3] : gt1[e & 3]));
        }
        *(bf16x8*)(O + (size_t)tok * 1024 + c0) = ov;
      }
      {
        float o[8]; float ss = 0.f;
        bf16_t* zr_ = ZH + (size_t)tok * ZHW + c0;
        const bf16x8 of = *(const bf16x8*)(zr_ + 512), ob = *(const bf16x8*)(zr_ + 1024), hgv = *(const bf16x8*)(zr_ + 2048);
        const f32x4 nw0 = *(const f32x4*)(p.in[I_HNORM] + l * 512 + c0), nw1 = *(const f32x4*)(p.in[I_HNORM] + l * 512 + c0 + 4);
#pragma unroll
        for (int e = 0; e < 8; ++e) { o[e] = bf2f((bf16_t)of[e]) + bf2f((bf16_t)ob[e]); ss += o[e] * o[e]; }
        ss += SHX(ss, 1); ss += SHX(ss, 2); ss += SHX(ss, 4); ss += SHX(ss, 8);
        const float rsd = rsqrtf(ss * (1.0f / 128.f) + 1e-6f);
        bf16x8 ov;
#pragma unroll
        for (int e = 0; e < 8; ++e) ov[e] = (short)f2bf(o[e] * rsd * (e < 4 ? nw0[e & 3] : nw1[e & 3]) * siluf_(bf2f((bf16_t)hgv[e])));
        *(bf16x8*)(zr_ + 2048) = ov;
      }
      {
        float o[8]; float ss = 0.f;
        bf16_t* zm_ = ZM + (size_t)tok * ZMW + 1536 + c0;
        const bf16x8 of = *(const bf16x8*)(Hb + (size_t)tok * 1024 + c0), ob = *(const bf16x8*)(Hb + (size_t)tok * 1024 + 512 + c0), mov = *(const bf16x8*)zm_;
        const f32x4 nw0 = *(const f32x4*)(p.in[I_MNORM] + l * 512 + c0), nw1 = *(const f32x4*)(p.in[I_MNORM] + l * 512 + c0 + 4);
#pragma unroll
        for (int e = 0; e < 8; ++e) { o[e] = bf2f((bf16_t)of[e]) + bf2f((bf16_t)ob[e]); ss += o[e] * o[e]; }
        ss += SHX(ss, 1); ss += SHX(ss, 2); ss += SHX(ss, 4); ss += SHX(ss, 8);
        const float rsd = rsqrtf(ss * (1.0f / 128.f) + 1e-6f);
        bf16x8 ov;
#pragma unroll
        for (int e = 0; e < 8; ++e) ov[e] = (short)f2bf(o[e] * rsd * (e < 4 ? nw0[e & 3] : nw1[e & 3]) * sigmoidf_(bf2f((bf16_t)mov[e])));
        *(bf16x8*)zm_ = ov;
      }
    }
    __syncthreads();
#pragma unroll 1
    for (int jj = 0; jj < 4; ++jj) tok_one(p, l, 3, tok0 + w * 4 + jj, lane);
  }
}

#define XB_TMO      128
#define XB_XCNT(j)  (256  + 64 * (j))
#define XB_XSUB(j)  (1280 + 64 * (j))
#define XB_XGEN(j)  (2304 + 64 * (j))
#define XB_TOP      3328
#define XB_TOPGEN   3392
#define XCD_BAR_WORDS 3456
#define XB_SPIN_CAP (1u << 20)
#define LAS __attribute__((address_space(3)))
DI unsigned xb_ld(unsigned* p)              { return __hip_atomic_load(p, __ATOMIC_RELAXED, __HIP_MEMORY_SCOPE_AGENT); }
DI unsigned xb_add(unsigned* p, unsigned v) { return __hip_atomic_fetch_add(p, v, __ATOMIC_RELAXED, __HIP_MEMORY_SCOPE_AGENT); }
DI unsigned xb_xcc_id() { return (unsigned)__builtin_amdgcn_s_getreg((3 << 11) | 20) & 0xFu; }
#define XB_SPIN(cond, bar) do { unsigned _sp = 0; while (cond) { __builtin_amdgcn_s_sleep(1); \
    if ((++_sp & 255u) == 0u) { if (xb_ld(&(bar)[XB_TMO])) break; if (_sp > XB_SPIN_CAP) { atomicAdd(&(bar)[XB_TMO], 1u); break; } } } } while (0)
struct XcdBarrier { unsigned* bar; unsigned x; volatile LAS unsigned* st; };
DI XcdBarrier xcd_barrier_post(const Params& p, unsigned* bar, volatile LAS unsigned* st) {
  XcdBarrier b; b.bar = bar; b.x = xb_xcc_id(); b.st = st;
  if (ltid() == 0) (void)xb_add(&bar[XB_XCNT(b.x)], 1u);
  return b;
}
DI void xcd_barrier_complete(unsigned* bar, unsigned x, unsigned& nloc, unsigned& nx) {
  const unsigned G = gridDim.x * gridDim.y * gridDim.z;
  unsigned sum, cnt, mine, sp = 0u;
  for (;;) {
    sum = 0u; cnt = 0u; mine = 0u;
#pragma unroll
    for (unsigned j = 0; j < 16; ++j) { const unsigned c = xb_ld(&bar[XB_XCNT(j)]); sum += c; cnt += (c > 0u) ? 1u : 0u; mine = (j == x) ? c : mine; }
    if (sum == G) break;
    __builtin_amdgcn_s_sleep(1);
    if ((++sp & 255u) == 0u) { if (xb_ld(&bar[XB_TMO])) break; if (sp > XB_SPIN_CAP) { atomicAdd(&bar[XB_TMO], 1u); break; } }
  }
  nloc = mine > 0u ? mine : 1u; nx = cnt > 0u ? cnt : 1u;
}
DI void xcd_barrier(const Params& p, const XcdBarrier& b) {
  asm volatile("s_waitcnt vmcnt(0)" ::: "memory");
  __syncthreads();
  if (ltid() == 0) {
    unsigned* bar = b.bar;
    __builtin_amdgcn_s_waitcnt(0);
    unsigned nloc = b.st[0], nx = b.st[1];
    if (nloc == 0u) { xcd_barrier_complete(bar, b.x, nloc, nx); b.st[0] = nloc; b.st[1] = nx; }
    const unsigned old = xb_add(&bar[XB_XSUB(b.x)], 1u);
    const unsigned gen = old / nloc;
    if (old + 1u == (gen + 1u) * nloc) {
      __builtin_amdgcn_fence(__ATOMIC_RELEASE, "agent");
      asm volatile("s_waitcnt vmcnt(0)" ::: "memory");
      const unsigned og = xb_add(&bar[XB_TOP], 1u);
      const unsigned tg = og / nx;
      if (og + 1u == (tg + 1u) * nx) xb_add(&bar[XB_TOPGEN], 1u);
      else XB_SPIN(xb_ld(&bar[XB_TOPGEN]) == tg, bar);
      __builtin_amdgcn_fence(__ATOMIC_ACQUIRE, "agent");
      xb_add(&bar[XB_XGEN(b.x)], 1u);
      asm volatile("s_waitcnt vmcnt(0)" ::: "memory");
    } else {
      XB_SPIN(xb_ld(&bar[XB_XGEN(b.x)]) == gen, bar);
      __builtin_amdgcn_fence(__ATOMIC_ACQUIRE, "agent");
      asm volatile("s_waitcnt vmcnt(0)" ::: "memory");
    }
  }
  __syncthreads();
}

constexpr int NPHASE = 3 + 9 * 2;
DI void run_phase(const Params& p0, int ph, char* smem) {
  Params p = p0;
  asm volatile("" : "+s"(p.ws), "+s"(p.out));
  p.ws = as_global(p.ws); p.out = as_global(p.out);
  if (ph == 0) { phase0(p, smem); return; }
  if (ph == 1) { phase1(p); return; }
  if (ph == 2) { tok_phase(p, 0, 0); return; }
  const int l = (ph - 3) / 9, s = (ph - 3) % 9;
  switch (s) {
    case 0: phase_inproj(p, smem); break;
    case 1: phase_scan(p, l, smem); break;
    case 2: phase_combine(p, l, smem); break;
    case 3: phase_merge(p, l, smem); break;
    case 4: phase_gemm_f32(p, (const bf16_t*)(p.ws + OFF_MERGED), 1024, (const bf16_t*)(p.ws + OFF_WTOUT), smem); break;
    case 5: tok_phase(p, l, 1); break;
    case 6: phase_ffn_in(p, smem); break;
    case 7: phase_gemm_f32(p, (const bf16_t*)(p.ws + OFF_ACT), DFF, (const bf16_t*)(p.ws + OFF_WTFO), smem); break;
    case 8:
      tok_phase(p, l, 2);
      if (l + 1 < 2) {
        conv_weight(p, p.in[I_WIN] + (size_t)(l + 1) * 1024 * DIN, DIN, (bf16_t*)(p.ws + OFF_WTIN), 1024, WTIN_ROWS, 0, (float*)smem, blockIdx.x, gridDim.x);
        for (int br = 0; br < 3; ++br) conv_weight(p, p.in[I_WBR] + ((size_t)(l + 1) * 3 + br) * 512 * 1024, 1024, (bf16_t*)(p.ws + OFF_WTBR) + (size_t)br * 1024 * 512, 512, 1024, 1, (float*)smem, blockIdx.x, gridDim.x);
      }
      break;
  }
}

template <bool COOP>
__global__ void __launch_bounds__(NTHR, 2) mega(Params pk, int lo, int hi) {
  __shared__ __attribute__((aligned(16))) char smem[LDS_BYTES];
  Params p = pk;
#pragma unroll
  for (int i = 0; i < N_IN; ++i) p.in[i] = as_global(p.in[i]);
  p.ws = as_global(p.ws); p.out = as_global(p.out);
  p.wb = __builtin_amdgcn_readfirstlane((int)threadIdx.x) & ~63;
  if (COOP) {
    volatile LAS unsigned* st = (volatile LAS unsigned*)(smem + LDS_BYTES - 32);
    if (ltid() == 0) { st[0] = 0u; st[1] = 0u; }
    __syncthreads();
    phase0(p, smem);
    cg::this_grid().sync();
    XcdBarrier b = xcd_barrier_post(p, (unsigned*)(p.ws + OFF_BAR), st);
    if (ltid() == 0) {
      const unsigned hwid = (unsigned)__builtin_amdgcn_s_getreg((31 << 11) | 4);
      const unsigned key = (xb_xcc_id() << 8) | ((hwid >> 8) & 0xFFu);
      ((int*)smem)[(LDS_BYTES - 12) / 4] = (int)xb_add((unsigned*)(p.ws + OFF_ROLE) + key, 1u);
    }
    __syncthreads();
    p.role = __builtin_amdgcn_readfirstlane(((int*)smem)[(LDS_BYTES - 12) / 4]);
    for (int ph = 1; ph < hi; ++ph) {
      run_phase(p, ph, smem);
      if (ph + 1 < hi) xcd_barrier(p, b);
    }
  } else {
    for (int ph = lo; ph < hi; ++ph) run_phase(p, ph, smem);
  }
}

extern "C" void kernel_launch(void* const* d_in, const int* in_sizes, int n_in, void* d_out, int out_size, void* d_ws, size_t ws_size, hipStream_t stream) {
  Params p{};
  for (int i = 0; i < N_IN; ++i) p.in[i] = (const float*)d_in[i];
  p.out = (float*)d_out; p.ws = (char*)d_ws;
  if (ws_size < WS_NEED) fprintf(stderr, "workspace too small: %zu < %zu\n", ws_size, (size_t)WS_NEED);
  static int grid_blocks = 0;
  if (!grid_blocks) {
    int dev = 0, cus = 0, per_cu = 0;
    hipGetDevice(&dev);
    hipDeviceGetAttribute(&cus, hipDeviceAttributeMultiprocessorCount, dev);
    hipOccupancyMaxActiveBlocksPerMultiprocessor(&per_cu, mega<true>, NTHR, 0);
    if (per_cu > 2) per_cu = 2;
    grid_blocks = cus * per_cu;
  }
  int lo = 0, hi = NPHASE;
  void* args[] = {&p, &lo, &hi};
  hipError_t e = hipLaunchCooperativeKernel((void*)mega<true>, dim3(grid_blocks), dim3(NTHR), args, 0, stream);
  if (e != hipSuccess) fprintf(stderr, "cooperative launch failed: %s (grid %d)\n", hipGetErrorString(e), grid_blocks);
}
```

```cpp
#include <hip/hip_runtime.h>
#include <hip/hip_cooperative_groups.h>
#include <cstdio>
namespace cg = cooperative_groups;

typedef unsigned short bf16_t;
typedef short bf16x8 __attribute__((ext_vector_type(8)));
typedef float f32x4 __attribute__((ext_vector_type(4)));
typedef float f32x2 __attribute__((ext_vector_type(2)));
typedef float f32x16 __attribute__((ext_vector_type(16)));
typedef unsigned short u16x4 __attribute__((ext_vector_type(4)));
typedef unsigned short u16x2 __attribute__((ext_vector_type(2)));
typedef unsigned u32x4 __attribute__((ext_vector_type(4)));
typedef unsigned u32x2 __attribute__((ext_vector_type(2)));
static __device__ __forceinline__ unsigned pk2(float lo, float hi) { typedef __bf16 b2 __attribute__((ext_vector_type(2))); typedef float f2 __attribute__((ext_vector_type(2))); return __builtin_bit_cast(unsigned, __builtin_convertvector((f2){lo, hi}, b2)); }

#define DI __device__ __forceinline__
#define GAS __attribute__((address_space(1)))
template <class T> static __device__ __forceinline__ T* as_global(T* q) { return (T*)(GAS T*)(unsigned long long)q; }

constexpr int NT = 16384;
constexpr int DM = 1024;
constexpr int NTHR = 256;
constexpr int DIN = 9616;
constexpr int ZHW = 2560, ZRW = 1920, ZMW = 2048;
constexpr int WTIN_ROWS = 9728;
constexpr int DFF = 2816;

constexpr size_t OFF_WTIN = 0;
constexpr size_t OFF_WTBR = OFF_WTIN + (size_t)WTIN_ROWS * 1024 * 2;
constexpr size_t OFF_H    = OFF_WTBR + (size_t)3 * 1024 * 512 * 2;
constexpr size_t OFF_ZH   = OFF_H + (size_t)NT * 1024 * 2;
constexpr size_t OFF_ZR   = OFF_ZH + (size_t)NT * ZHW * 2;
constexpr size_t OFF_ZM   = OFF_ZR + (size_t)NT * ZRW * 2;
constexpr size_t OFF_MG   = OFF_ZM + (size_t)NT * ZMW * 2;
constexpr size_t OFF_O    = OFF_MG + (size_t)NT * 16 * 4;
constexpr size_t OFF_MOD  = OFF_O + (size_t)NT * 1024 * 2;
constexpr size_t OFF_LBS  = OFF_MOD + (size_t)2 * 5 * 6144 * 4;
constexpr size_t OFF_CTR  = OFF_LBS + 2 * 512 * 4;
constexpr size_t OFF_BAR  = OFF_CTR + 256;
constexpr size_t OFF_ROLE = OFF_BAR + 3456 * 4;
constexpr size_t WS_NEED  = OFF_ROLE + 4096 * 4;
constexpr size_t OFF_MODP = OFF_ZH;
constexpr size_t OFF_WTOUT = OFF_ZR;
constexpr size_t OFF_WTFI  = OFF_WTOUT + (size_t)1024 * 1024 * 2;
constexpr size_t OFF_WTFO  = OFF_WTFI + (size_t)5632 * 1024 * 2;
constexpr size_t OFF_MERGED = OFF_WTFO + (size_t)1024 * 2816 * 2;
constexpr size_t OFF_Y    = OFF_ZH;
constexpr size_t OFF_ACT  = OFF_ZM;

constexpr size_t OUT_HG = 16777216, OUT_RW = 25165824, OUT_C = 29360128, OUT_N = 37748736, OUT_M = 37814272;

enum { I_XP = 0, I_XS, I_SH, I_SR, I_SC, I_SN, I_SM, I_C, I_CCTX, I_WADA, I_BADA, I_NORMS, I_WIN, I_HLB, I_HNORM, I_MU, I_W0, I_W2,
       I_A0, I_A2, I_G2, I_KK, I_KA, I_RK, I_LN, I_GB, I_MNORM, I_WBR, I_WOUT, I_WFI, I_WFO, N_IN };

struct Params { const float* in[N_IN]; float* out; char* ws; int wb; int role; };

constexpr int LDS_BYTES = 77824;

DI bf16_t f2bf(float f) { return __builtin_bit_cast(unsigned short, (__bf16)f); }
DI float bf2f(bf16_t h) { return __uint_as_float(((unsigned)h) << 16); }
DI float sigmoidf_(float x) { return 1.0f / (1.0f + __expf(-x)); }
DI float siluf_(float x) { return x / (1.0f + __expf(-x)); }
DI float softplusf_(float x) { return x > 20.f ? x : __logf(1.0f + __expf(x)); }
DI float dpp_xor1(float x) { return __int_as_float(__builtin_amdgcn_mov_dpp(__float_as_int(x), 0xB1, 0xF, 0xF, true)); }
DI float dpp_xor2(float x) { return __int_as_float(__builtin_amdgcn_mov_dpp(__float_as_int(x), 0x4E, 0xF, 0xF, true)); }
DI float shfl_lane(float v, int src) { return __int_as_float(__builtin_amdgcn_ds_bpermute(src << 2, __float_as_int(v))); }
#define SHX(v, m) shfl_lane((v), lane ^ (m))
DI float wave_sum(float v, int lane) { v += dpp_xor1(v); v += dpp_xor2(v); v += SHX(v, 4); v += SHX(v, 8); v += SHX(v, 16); v += SHX(v, 32); return v; }
DI int ltid_(int wb) { int t = wb + (int)__builtin_amdgcn_mbcnt_hi(~0u, __builtin_amdgcn_mbcnt_lo(~0u, 0u)); asm volatile("" : "+v"(t)); return t; }
#define ltid() ltid_(p.wb)
DI int crow(int reg, int h) { return (reg & 3) + 8 * (reg >> 2) + 4 * h; }

DI int tok_cond(int tok) { return tok < 8192 ? 0 : 1 + ((tok - 8192) >> 11); }
DI const float* x_in_row(const Params& p, int tok) { return tok < 8192 ? p.in[I_XP] + (size_t)tok * DM : p.in[I_XS] + (size_t)(tok - 8192) * DM; }

DI void mma32(f32x16& acc, const bf16_t* A, int lda, const bf16_t* B, int ldb, int K, int lane) {
  const int r = lane & 31, h = lane >> 5;
#pragma unroll 2
  for (int kk = 0; kk < K; kk += 16) {
    bf16x8 a = *(const bf16x8*)(A + r * lda + kk + 8 * h);
    bf16x8 b = *(const bf16x8*)(B + r * ldb + kk + 8 * h);
    acc = __builtin_amdgcn_mfma_f32_32x32x16_bf16(a, b, acc, 0, 0, 0);
  }
}

template <int BM, int BN, int BK, bool WR, bool LD>
DI void gemm_ktile(f32x4 (&acc)[BM / 32][BN / 32], bf16x8 (&ra)[BM * BK / 2048], bf16x8 (&rb)[BN * BK / 2048],
                   const bf16_t* __restrict__ A, int lda, const bf16_t* __restrict__ B, int ldb, int k2,
                   const bf16_t* as, const bf16_t* bs, bf16_t* Aw, bf16_t* Bw) {
  constexpr int MI = BM / 32, NJ = BN / 32, LS = BK + 8, ACH = BM * BK / 2048, BCH = BN * BK / 2048, KS = BK / 32, RPI = 256 / (BK / 8);
  static_assert(KS * MI >= ACH + BCH, "not enough MFMA row blocks to carry the staging");
#pragma unroll
  for (int ks = 0; ks < KS; ++ks) {
    bf16x8 bfr[NJ];
#pragma unroll
    for (int j = 0; j < NJ; ++j) bfr[j] = *(const bf16x8*)(bs + j * 16 * LS + ks * 32);
    bf16x8 afn = *(const bf16x8*)(as + ks * 32);
#pragma unroll
    for (int i = 0; i < MI; ++i) {
      const bf16x8 af = afn;
      if (i + 1 < MI) afn = *(const bf16x8*)(as + (i + 1) * 16 * LS + ks * 32);
      __builtin_amdgcn_s_setprio(1);
#pragma unroll
      for (int j = 0; j < NJ; ++j) acc[i][j] = __builtin_amdgcn_mfma_f32_16x16x32_bf16(bfr[j], af, acc[i][j], 0, 0, 0);
      __builtin_amdgcn_s_setprio(0);
      const int s = ks * MI + i;
      if (s < ACH) {
        if (WR) *(bf16x8*)(Aw + RPI * s * LS) = ra[s < ACH ? s : 0];
        if (LD) ra[s < ACH ? s : 0] = *(const bf16x8*)(A + (size_t)(RPI * s) * lda + k2);
      } else if (s < ACH + BCH) {
        const int c = s - ACH;
        if (WR) *(bf16x8*)(Bw + RPI * c * LS) = rb[(c >= 0 && c < BCH) ? c : 0];
        if (LD) rb[(c >= 0 && c < BCH) ? c : 0] = *(const bf16x8*)(B + (size_t)(RPI * c) * ldb + k2);
      }
      __builtin_amdgcn_sched_barrier(0);
    }
  }
}

template <int BM, int BN, int BK>
DI void gemm_main(const Params& p, f32x4 (&acc)[BM / 32][BN / 32], const bf16_t* __restrict__ A, int lda, const bf16_t* __restrict__ B, int ldb, int K, bf16_t* sm) {
  constexpr int LS = BK + 8, CPR = BK / 8, ACH = BM * BK / 2048, BCH = BN * BK / 2048, RPI = 256 / CPR;
  const int tid = ltid(), lane = tid & 63, w = tid >> 6, wm = w >> 1, wn = w & 1;
  bf16_t* As = sm; bf16_t* Bs = sm + 2 * BM * LS;
  bf16x8 ra[ACH], rb[BCH];
  const int nk = K / BK;
  const int lrow = tid / CPR, lkc = (tid % CPR) * 8;
  const bf16_t* Ag = A + (size_t)lrow * lda + lkc;
  const bf16_t* Bg = B + (size_t)lrow * ldb + lkc;
  bf16_t* Al = As + lrow * LS + lkc; bf16_t* Bl = Bs + lrow * LS + lkc;
#pragma unroll
  for (int i = 0; i < ACH; ++i) ra[i] = *(const bf16x8*)(Ag + (size_t)(RPI * i) * lda);
#pragma unroll
  for (int i = 0; i < BCH; ++i) rb[i] = *(const bf16x8*)(Bg + (size_t)(RPI * i) * ldb);
  __syncthreads();
#pragma unroll
  for (int i = 0; i < ACH; ++i) *(bf16x8*)(Al + RPI * i * LS) = ra[i];
#pragma unroll
  for (int i = 0; i < BCH; ++i) *(bf16x8*)(Bl + RPI * i * LS) = rb[i];
  if (nk > 1) {
#pragma unroll
    for (int i = 0; i < ACH; ++i) ra[i] = *(const bf16x8*)(Ag + (size_t)(RPI * i) * lda + BK);
#pragma unroll
    for (int i = 0; i < BCH; ++i) rb[i] = *(const bf16x8*)(Bg + (size_t)(RPI * i) * ldb + BK);
  }
  __syncthreads();
  const bf16_t* as0 = As + (wm * (BM / 2) + (lane & 15)) * LS + (lane >> 4) * 8;
  const bf16_t* bs0 = Bs + (wn * (BN / 2) + (lane & 15)) * LS + (lane >> 4) * 8;
  int kt = 0;
  for (; kt + 2 < nk; ++kt) {
    const int buf = kt & 1, nb = buf ^ 1;
    gemm_ktile<BM, BN, BK, true, true>(acc, ra, rb, Ag, lda, Bg, ldb, (kt + 2) * BK, as0 + buf * BM * LS, bs0 + buf * BN * LS, Al + nb * BM * LS, Bl + nb * BN * LS);
    __syncthreads();
  }
  for (; kt < nk; ++kt) {
    const int buf = kt & 1, nb = buf ^ 1;
    if (kt + 1 < nk) gemm_ktile<BM, BN, BK, true, false>(acc, ra, rb, Ag, lda, Bg, ldb, 0, as0 + buf * BM * LS, bs0 + buf * BN * LS, Al + nb * BM * LS, Bl + nb * BN * LS);
    else gemm_ktile<BM, BN, BK, false, false>(acc, ra, rb, Ag, lda, Bg, ldb, 0, as0 + buf * BM * LS, bs0 + buf * BN * LS, Al + nb * BM * LS, Bl + nb * BN * LS);
    __syncthreads();
  }
}

template <int MI, int NJ> DI void zero_acc(f32x4 (&acc)[MI][NJ]) {
#pragma unroll
  for (int i = 0; i < MI; ++i)
#pragma unroll
    for (int j = 0; j < NJ; ++j) acc[i][j] = (f32x4){0.f, 0.f, 0.f, 0.f};
}
DI void store_bf4(bf16_t* dst, f32x4 v) { u16x4 o; o[0] = f2bf(v[0]); o[1] = f2bf(v[1]); o[2] = f2bf(v[2]); o[3] = f2bf(v[3]); *(u16x4*)dst = o; }

DI int map_col(int mode, int n) {
  if (mode == 0) return n < 6544 ? n : (n < 6656 ? -1 : n - 112);
  if (mode == 2) return ((n >> 4) & 1) ? DFF + (n >> 5) * 16 + (n & 15) : (n >> 5) * 16 + (n & 15);
  return n;
}
DI void conv_tile(const Params& p, const float* __restrict__ src, int ld_src, bf16_t* __restrict__ dst, int K, int mode, int tk, int tn, float* sm) {
  const int tid = ltid();
  __syncthreads();
  {
    const int nn = tid & 63, col = map_col(mode, tn * 64 + nn);
#pragma unroll
    for (int i = 0; i < 16; ++i) { int kk = (tid >> 6) + 4 * i; sm[kk * 65 + nn] = col >= 0 ? src[(size_t)(tk * 64 + kk) * ld_src + col] : 0.f; }
  }
  __syncthreads();
  {
    const int kk = tid & 63;
#pragma unroll
    for (int i = 0; i < 16; ++i) { int nn = (tid >> 6) + 4 * i; dst[(size_t)(tn * 64 + nn) * K + tk * 64 + kk] = f2bf(sm[kk * 65 + nn]); }
  }
}
DI void conv_weight(const Params& p, const float* src, int ld_src, bf16_t* dst, int K, int Ndst, int mode, float* sm, int bid, int nb) {
  const int tkn = K / 64, nt = tkn * (Ndst / 64);
  for (int t = bid; t < nt; t += nb) conv_tile(p, src, ld_src, dst, K, mode, t % tkn, t / tkn, sm);
}

DI void phase0(const Params& p, char* smem) {
  const int tid = ltid(), bid = blockIdx.x, nb = gridDim.x;
  float* MODP = (float*)(p.ws + OFF_MODP);
  float* sm = (float*)smem;
  if (bid == 0) { if (tid < 64) ((int*)(p.ws + OFF_CTR))[tid] = 0; for (int i = tid; i < 3456; i += NTHR) ((unsigned*)(p.ws + OFF_BAR))[i] = 0u; for (int i = tid; i < 4096; i += NTHR) ((unsigned*)(p.ws + OFF_ROLE))[i] = 0u; }
  for (int i = bid * NTHR + tid; i < 512; i += nb * NTHR) {
    float a = p.in[I_HLB][i], b = p.in[I_HLB][512 + i];
    float* L = (float*)(p.ws + OFF_LBS); L[i] = 0.f; L[512 + i] = 1.0f / (1.0f + expf(a - b));
  }
  for (int it = bid; it < 2 * 24 * 16; it += nb) {
    const int ks = it & 15, jb = (it >> 4) % 24, l = it / (16 * 24);
    __syncthreads();
    for (int e = tid; e < 5 * 64; e += NTHR) { int ci = e >> 6, k = ks * 64 + (e & 63); float cv = ci == 0 ? p.in[I_CCTX][k] : p.in[I_C][(ci - 1) * DM + k]; sm[e] = siluf_(cv); }
    __syncthreads();
    const int j = jb * 256 + tid;
    float a0 = 0, a1 = 0, a2 = 0, a3 = 0, a4 = 0;
    const float* W = p.in[I_WADA] + ((size_t)l * DM + ks * 64) * 6144 + j;
#pragma unroll 1
    for (int k0 = 0; k0 < 64; k0 += 16) {
      float wv[16];
#pragma unroll
      for (int u = 0; u < 16; ++u) wv[u] = W[(size_t)(k0 + u) * 6144];
#pragma unroll
      for (int u = 0; u < 16; ++u) { const int k = k0 + u; const float w = wv[u]; a0 += sm[k] * w; a1 += sm[64 + k] * w; a2 += sm[128 + k] * w; a3 += sm[192 + k] * w; a4 += sm[256 + k] * w; }
    }
    float* dst = MODP + ((size_t)(ks * 2 + l) * 5) * 6144 + j;
    dst[0] = a0; dst[6144] = a1; dst[2 * 6144] = a2; dst[3 * 6144] = a3; dst[4 * 6144] = a4;
  }
  conv_weight(p, p.in[I_WIN], DIN, (bf16_t*)(p.ws + OFF_WTIN), 1024, WTIN_ROWS, 0, sm, bid, nb);
  for (int br = 0; br < 3; ++br) conv_weight(p, p.in[I_WBR] + (size_t)br * 512 * 1024, 1024, (bf16_t*)(p.ws + OFF_WTBR) + (size_t)br * 1024 * 512, 512, 1024, 1, sm, bid, nb);
}
DI void phase1(const Params& p) {
  const float* MODP = (const float*)(p.ws + OFF_MODP);
  float* MOD = (float*)(p.ws + OFF_MOD);
  for (int i = blockIdx.x * NTHR + ltid(); i < 2 * 5 * 6144; i += gridDim.x * NTHR) {
    const int j = i % 6144, l = i / (5 * 6144);
    float s = p.in[I_BADA][l * 6144 + j];
    for (int ks = 0; ks < 16; ++ks) s += MODP[(size_t)ks * 2 * 5 * 6144 + i];
    MOD[i] = s;
  }
}

DI void norm_mod_store(const f32x4 (&x)[4], const float* nw, const float* sc, const float* sh, bf16_t* hrow, int lane) {
  float ss = 0.f;
#pragma unroll
  for (int i = 0; i < 4; ++i) ss += x[i][0] * x[i][0] + x[i][1] * x[i][1] + x[i][2] * x[i][2] + x[i][3] * x[i][3];
  ss = wave_sum(ss, lane);
  const float rs = rsqrtf(ss * (1.0f / DM) + 1e-6f);
#pragma unroll
  for (int i = 0; i < 4; ++i) {
    const int c = i * 256 + lane * 4;
    f32x4 w = *(const f32x4*)(nw + c), s1 = *(const f32x4*)(sc + c), s0 = *(const f32x4*)(sh + c), o;
#pragma unroll
    for (int e = 0; e < 4; ++e) o[e] = x[i][e] * rs * w[e] * (1.0f + s1[e]) + s0[e];
    store_bf4(hrow + c, o);
  }
}
DI void tok_one(const Params& p, int l, int mode, int tok, int lane) {
  const float* MOD = (const float*)(p.ws + OFF_MOD);
  bf16_t* H = (bf16_t*)(p.ws + OFF_H);
  const float* Y = (const float*)(p.ws + OFF_Y);
  const int ci = tok_cond(tok);
  const float* modl = MOD + (size_t)(l * 5 + ci) * 6144;
  const float* nwl = p.in[I_NORMS] + (size_t)l * 4 * DM;
  const bool from_in = (l == 0 && (mode == 0 || mode == 1 || mode == 3));
  const float* xr = from_in ? x_in_row(p, tok) : p.out + (size_t)tok * DM;
  const bool has_y = (mode == 1 || mode == 2);
  const bool has_h = !(mode == 2 && l + 1 >= 2);
  const float* modn = (mode == 2 && has_h) ? MOD + (size_t)((l + 1) * 5 + ci) * 6144 : modl;
  const float* nw2 = mode == 1 ? nwl + 2 * DM : (mode == 2 ? p.in[I_NORMS] + (size_t)(has_h ? l + 1 : l) * 4 * DM : nwl);
  const float* sc2 = mode == 1 ? modl + 4 * DM : modn + 1 * DM;
  const float* sh2 = mode == 1 ? modl + 3 * DM : modn + 0 * DM;
  const float* nwy = nwl + (mode == 1 ? 1 : 3) * DM;
  const float* gy = modl + (mode == 1 ? 2 : 5) * DM;
  f32x4 x[4], y[4], wy[4], gg[4], w2[4], s1[4], s0[4];
#pragma unroll
  for (int i = 0; i < 4; ++i) {
    const int c = i * 256 + lane * 4;
    x[i] = *(const f32x4*)(xr + c);
    if (has_y) { y[i] = *(const f32x4*)(Y + (size_t)tok * DM + c); wy[i] = *(const f32x4*)(nwy + c); gg[i] = *(const f32x4*)(gy + c); }
    if (has_h) { w2[i] = *(const f32x4*)(nw2 + c); s1[i] = *(const f32x4*)(sc2 + c); s0[i] = *(const f32x4*)(sh2 + c); }
  }
  if (has_y) {
    float ss = 0.f;
#pragma unroll
    for (int i = 0; i < 4; ++i) ss += y[i][0] * y[i][0] + y[i][1] * y[i][1] + y[i][2] * y[i][2] + y[i][3] * y[i][3];
    ss = wave_sum(ss, lane);
    const float rs = rsqrtf(ss * (1.0f / DM) + 1e-6f);
#pragma unroll
    for (int i = 0; i < 4; ++i) {
      const int c = i * 256 + lane * 4;
#pragma unroll
      for (int e = 0; e < 4; ++e) x[i][e] += gg[i][e] * (y[i][e] * rs * wy[i][e]);
      *(f32x4*)(p.out + (size_t)tok * DM + c) = x[i];
    }
  }
  if (has_h) {
    float ss = 0.f;
#pragma unroll
    for (int i = 0; i < 4; ++i) ss += x[i][0] * x[i][0] + x[i][1] * x[i][1] + x[i][2] * x[i][2] + x[i][3] * x[i][3];
    ss = wave_sum(ss, lane);
    const float rs = rsqrtf(ss * (1.0f / DM) + 1e-6f);
#pragma unroll
    for (int i = 0; i < 4; ++i) {
      f32x4 o;
#pragma unroll
      for (int e = 0; e < 4; ++e) o[e] = x[i][e] * rs * w2[i][e] * (1.0f + s1[i][e]) + s0[i][e];
      store_bf4(H + (size_t)tok * DM + i * 256 + lane * 4, o);
    }
  }
}
DI void tok_phase(const Params& p, int l, int mode) {
  const int lane = ltid() & 63, gw = blockIdx.x * 4 + (ltid() >> 6), nw = gridDim.x * 4;
  for (int tok = gw; tok < NT; tok += nw) tok_one(p, l, mode, tok, lane);
}

DI bool tile_xcd(int i, int NTN, int MTX, int& mt, int& nt) {
  const int G = gridDim.x, b = blockIdx.x, x = b & 7, j = b >> 3, nbx = (G - x + 7) >> 3;
  const int u = j + i * nbx;
  if (u >= MTX * NTN) return false;
  mt = MTX * x + (u % MTX); nt = u / MTX;
  return true;
}
DI void phase_inproj(const Params& p, char* smem) {
  const bf16_t* H = (const bf16_t*)(p.ws + OFF_H);
  const bf16_t* WT = (const bf16_t*)(p.ws + OFF_WTIN);
  bf16_t* ZH = (bf16_t*)(p.ws + OFF_ZH); bf16_t* ZR = (bf16_t*)(p.ws + OFF_ZR); bf16_t* ZM = (bf16_t*)(p.ws + OFF_ZM);
  float* MG = (float*)(p.ws + OFF_MG);
  const int lane = ltid() & 63, w = ltid() >> 6, wm = w >> 1, wn = w & 1;
  int mt, nt;
  for (int ti = 0; tile_xcd(ti, 52, 8, mt, nt); ++ti) {
    f32x4 acc[8][4]; zero_acc<8, 4>(acc);
    gemm_main<256, 128, 32>(p, acc, H + (size_t)mt * 256 * 1024, 1024, WT + (size_t)nt * 128 * 1024, 1024, 1024, (bf16_t*)smem);
    const int n0 = nt * 128;
#pragma unroll
    for (int i = 0; i < 8; ++i) {
      const int row = mt * 256 + wm * 128 + i * 16 + (lane & 15);
#pragma unroll
      for (int j = 0; j < 4; ++j) {
        const int col = n0 + wn * 64 + j * 16 + 4 * (lane >> 4);
        if (n0 < 2560) store_bf4(ZH + (size_t)row * ZHW + col, acc[i][j]);
        else if (n0 < 4480) store_bf4(ZR + (size_t)row * ZRW + (col - 2560), acc[i][j]);
        else if (n0 < 6528) store_bf4(ZM + (size_t)row * ZMW + (col - 4480), acc[i][j]);
        else if (col - 6528 < 16) *(f32x4*)(MG + (size_t)row * 16 + (col - 6528)) = acc[i][j];
      }
    }
  }
}

DI void phase_merge(const Params& p, int l, char* smem) {
  const bf16_t* H = (const bf16_t*)(p.ws + OFF_H);
  const bf16_t* WT = (const bf16_t*)(p.ws + OFF_WTIN);
  const bf16_t* WBR = (const bf16_t*)(p.ws + OFF_WTBR);
  const bf16_t* ZH = (const bf16_t*)(p.ws + OFF_ZH); const bf16_t* ZM = (const bf16_t*)(p.ws + OFF_ZM); const bf16_t* O = (const bf16_t*)(p.ws + OFF_O);
  bf16_t* MER = (bf16_t*)(p.ws + OFF_MERGED);
  const int lane = ltid() & 63, w = ltid() >> 6, wm = w >> 1, wn = w & 1;
  int mt, nt;
  for (int ti = 0; tile_xcd(ti, 16, 16, mt, nt); ++ti) {
    f32x4 accM[4][2]; zero_acc<4, 2>(accM);
#pragma unroll 1
    for (int br = 0; br < 3; ++br) {
      f32x4 accG[4][2], accP[4][2]; zero_acc<4, 2>(accG); zero_acc<4, 2>(accP);
      gemm_main<128, 64, 64>(p, accG, H + (size_t)mt * 128 * 1024, 1024, WT + (size_t)(6656 + br * 1024 + nt * 64) * 1024, 1024, 1024, (bf16_t*)smem);
      const bf16_t* Ab; int lda;
      if (br == 0) { Ab = ZH + 2048; lda = ZHW; } else if (br == 1) { Ab = O; lda = 1024; } else { Ab = ZM + 1536; lda = ZMW; }
      gemm_main<128, 64, 64>(p, accP, Ab + (size_t)mt * 128 * lda, lda, WBR + ((size_t)br * 1024 + nt * 64) * 512, 512, 512, (bf16_t*)smem);
#pragma unroll
      for (int i = 0; i < 4; ++i)
#pragma unroll
        for (int j = 0; j < 2; ++j)
#pragma unroll
          for (int e = 0; e < 4; ++e) accM[i][j][e] += sigmoidf_(accG[i][j][e]) * accP[i][j][e];
    }
#pragma unroll
    for (int i = 0; i < 4; ++i) {
      const int row = mt * 128 + wm * 64 + i * 16 + (lane & 15);
#pragma unroll
      for (int j = 0; j < 2; ++j) store_bf4(MER + (size_t)row * 1024 + nt * 64 + wn * 32 + j * 16 + 4 * (lane >> 4), accM[i][j]);
    }
  }
  float* sm = (float*)smem;
  conv_weight(p, p.in[I_WOUT] + (size_t)l * 1024 * 1024, 1024, (bf16_t*)(p.ws + OFF_WTOUT), 1024, 1024, 1, sm, blockIdx.x, gridDim.x);
  conv_weight(p, p.in[I_WFI] + (size_t)l * 1024 * 5632, 5632, (bf16_t*)(p.ws + OFF_WTFI), 1024, 5632, 2, sm, blockIdx.x, gridDim.x);
  conv_weight(p, p.in[I_WFO] + (size_t)l * DFF * 1024, 1024, (bf16_t*)(p.ws + OFF_WTFO), DFF, 1024, 1, sm, blockIdx.x, gridDim.x);
}

DI void phase_gemm_f32(const Params& p, const bf16_t* A, int K, const bf16_t* Wt, char* smem) {
  float* Y = (float*)(p.ws + OFF_Y);
  const int lane = ltid() & 63, w = ltid() >> 6, wm = w >> 1, wn = w & 1;
  int mt, nt;
  for (int ti = 0; tile_xcd(ti, 8, 8, mt, nt); ++ti) {
    f32x4 acc[8][4]; zero_acc<8, 4>(acc);
    gemm_main<256, 128, 32>(p, acc, A + (size_t)mt * 256 * K, K, Wt + (size_t)nt * 128 * K, K, K, (bf16_t*)smem);
#pragma unroll
    for (int i = 0; i < 8; ++i) {
      const int row = mt * 256 + wm * 128 + i * 16 + (lane & 15);
#pragma unroll
      for (int j = 0; j < 4; ++j) *(f32x4*)(Y + (size_t)row * 1024 + nt * 128 + wn * 64 + j * 16 + 4 * (lane >> 4)) = acc[i][j];
    }
  }
}
DI void phase_ffn_in(const Params& p, char* smem) {
  const bf16_t* H = (const bf16_t*)(p.ws + OFF_H);
  const bf16_t* Wt = (const bf16_t*)(p.ws + OFF_WTFI);
  bf16_t* ACT = (bf16_t*)(p.ws + OFF_ACT);
  const int lane = ltid() & 63, w = ltid() >> 6, wm = w >> 1, wn = w & 1;
  int mt, nt;
  for (int ti = 0; tile_xcd(ti, 44, 8, mt, nt); ++ti) {
    f32x4 acc[8][4]; zero_acc<8, 4>(acc);
    gemm_main<256, 128, 32>(p, acc, H + (size_t)mt * 256 * 1024, 1024, Wt + (size_t)nt * 128 * 1024, 1024, 1024, (bf16_t*)smem);
#pragma unroll
    for (int i = 0; i < 8; ++i) {
      const int row = mt * 256 + wm * 128 + i * 16 + (lane & 15);
#pragma unroll
      for (int jj = 0; jj < 2; ++jj) {
        f32x4 u = acc[i][2 * jj], g = acc[i][2 * jj + 1], o;
#pragma unroll
        for (int e = 0; e < 4; ++e) o[e] = siluf_(g[e]) * u[e];
        const int col = (nt * 128 + wn * 64 + jj * 32) / 2 + 4 * (lane >> 4);
        store_bf4(ACT + (size_t)row * DFF + col, o);
      }
    }
  }
}

struct Seq { int base, T, grid, b; bool sample; };
DI Seq get_seq(int s) { Seq q; if (s < 32) { q.base = s * 256; q.T = 256; q.grid = 0; q.b = s; q.sample = false; } else { q.b = s - 32; q.base = 8192 + q.b * 2048; q.T = 2048; q.grid = 1; q.sample = true; } return q; }

DI float rw_shift(const bf16_t* ZR, const float* mu, int base, int t, int T, int grid, int col) {
  const bf16_t* pp = ZR + (size_t)(base + t) * ZRW + col;
  const float y = bf2f(*pp);
  if (!grid) {
    const float prev = t > 0 ? bf2f(pp[-ZRW]) : 0.f, nxt = t < T - 1 ? bf2f(pp[ZRW]) : 0.f;
    return y + mu[col] * (prev - y) + mu[ZRW + col] * (nxt - y);
  }
  const int gc = t & 63, gr = t >> 6;
  const float left = gc > 0 ? bf2f(pp[-ZRW]) : 0.f, right = gc < 63 ? bf2f(pp[ZRW]) : 0.f;
  const float up = gr > 0 ? bf2f(pp[-64 * ZRW]) : 0.f, down = gr < 31 ? bf2f(pp[64 * ZRW]) : 0.f;
  return y + mu[col] * (left - y) + mu[ZRW + col] * (right - y) + mu[2 * ZRW + col] * (up - y) + mu[3 * ZRW + col] * (down - y);
}

DI void rw_shift8(const bf16_t* ZR, const float* mu, int base, int t, int T, int grid, int col0, float (&out)[8]) {
  const bf16_t* pp = ZR + (size_t)(base + t) * ZRW + col0;
  const bf16x8 y = *(const bf16x8*)pp;
  float yv[8];
#pragma unroll
  for (int e = 0; e < 8; ++e) { yv[e] = bf2f((bf16_t)y[e]); out[e] = yv[e]; }
  const int nn = grid ? 4 : 2;
#pragma unroll 1
  for (int n = 0; n < nn; ++n) {
    bool valid; int off;
    if (!grid) { valid = n == 0 ? t > 0 : t < T - 1; off = n == 0 ? -ZRW : ZRW; }
    else { const int gc = t & 63, gr = t >> 6; valid = n == 0 ? gc > 0 : n == 1 ? gc < 63 : n == 2 ? gr > 0 : gr < 31; off = n == 0 ? -ZRW : n == 1 ? ZRW : n == 2 ? -64 * ZRW : 64 * ZRW; }
    const f32x4 m0 = *(const f32x4*)(mu + n * ZRW + col0), m1 = *(const f32x4*)(mu + n * ZRW + col0 + 4);
    bf16x8 nb = y;
    if (valid) nb = *(const bf16x8*)(pp + off);
#pragma unroll
    for (int e = 0; e < 8; ++e) { const float nv_ = valid ? bf2f((bf16_t)nb[e]) : 0.f; const float mm = e < 4 ? m0[e & 3] : m1[e & 3]; out[e] += mm * (nv_ - yv[e]); }
  }
}

DI void rw_load8(const bf16_t* ZR, int base, int t, int T, int grid, int col0, bf16x8 (&v)[5]) {
  const bf16_t* pp = ZR + (size_t)(base + t) * ZRW + col0;
  const int gc = t & 63, gr = t >> 6;
  const int o1 = grid ? (gc > 0 ? -ZRW : 0) : (t > 0 ? -ZRW : 0);
  const int o2 = grid ? (gc < 63 ? ZRW : 0) : (t < T - 1 ? ZRW : 0);
  v[0] = *(const bf16x8*)pp;
  v[1] = *(const bf16x8*)(pp + o1);
  v[2] = *(const bf16x8*)(pp + o2);
  if (grid) {
    v[3] = *(const bf16x8*)(pp + (gr > 0 ? -64 * ZRW : 0)); v[4] = *(const bf16x8*)(pp + (gr < 31 ? 64 * ZRW : 0));
  } else {
    v[3] = (bf16x8){0, 0, 0, 0, 0, 0, 0, 0}; v[4] = (bf16x8){0, 0, 0, 0, 0, 0, 0, 0};
  }
}
DI unsigned rw_valid(int t, int T, int grid) {
  if (!grid) return (t > 0 ? 1u : 0u) | (t < T - 1 ? 2u : 0u);
  const int gc = t & 63, gr = t >> 6;
  return (gc > 0 ? 1u : 0u) | (gc < 63 ? 2u : 0u) | (gr > 0 ? 4u : 0u) | (gr < 31 ? 8u : 0u);
}
DI void rw_apply8(const bf16x8 (&v)[5], const float* mu, int grid, unsigned valid, int col0, float (&out)[8]) {
  float yv[8];
#pragma unroll
  for (int e = 0; e < 8; ++e) { yv[e] = bf2f((bf16_t)v[0][e]); out[e] = yv[e]; }
#pragma unroll
  for (int n = 0; n < 4; ++n) {
    if (n < 2 || grid) {
      const f32x4 m0 = *(const f32x4*)(mu + n * ZRW + col0), m1 = *(const f32x4*)(mu + n * ZRW + col0 + 4);
      const bool ok = (valid >> n) & 1u;
#pragma unroll
      for (int e = 0; e < 8; ++e) out[e] += (e < 4 ? m0[e & 3] : m1[e & 3]) * ((ok ? bf2f((bf16_t)v[1 + n][e]) : 0.f) - yv[e]);
    }
  }
}
DI void rw_apply8_lds(const bf16x8 (&v)[5], const float* mu5c, const float* c0c, int grid, unsigned valid, float (&out)[8]) {
  {
    const f32x4 c0 = *(const f32x4*)c0c, c1 = *(const f32x4*)(c0c + 4);
#pragma unroll
    for (int e = 0; e < 8; ++e) out[e] = bf2f((bf16_t)v[0][e]) * (e < 4 ? c0[e & 3] : c1[e & 3]);
  }
#pragma unroll
  for (int n = 0; n < 4; ++n) {
    if (n < 2 || grid) {
      const f32x4 m0 = *(const f32x4*)(mu5c + n * 320), m1 = *(const f32x4*)(mu5c + n * 320 + 4);
      const float ok = ((valid >> n) & 1u) ? 1.0f : 0.0f;
#pragma unroll
      for (int e = 0; e < 8; ++e) out[e] += (e < 4 ? m0[e & 3] : m1[e & 3]) * ok * bf2f((bf16_t)v[1 + n][e]);
    }
  }
}
DI float fast_tanh(float x) { return 1.0f - 2.0f / (1.0f + __expf(2.0f * x)); }
template <int N> DI float dpp_row_shr0(float x) { return __int_as_float(__builtin_amdgcn_update_dpp(0, __float_as_int(x), 0x110 + N, 0xF, 0xF, false)); }

DI void rwkv_item(const Params& p, int l, int s, int hh, int d, char* smem) {
  const Seq q = get_seq(s);
  const int tid0 = ltid();
  const int w = __builtin_amdgcn_readfirstlane(tid0 >> 6), vb = w >> 1, kb = w & 1;
  int tid = tid0, lane = tid & 63, l15 = lane & 15, qq = lane >> 4, r32 = lane & 31, h = lane >> 5;
  const bf16_t* ZR = (const bf16_t*)(p.ws + OFF_ZR);
  bf16_t* O = (bf16_t*)(p.ws + OFF_O);
  const float* mu = p.in[I_MU] + (size_t)l * 4 * ZRW;
  bf16_t* KHr = (bf16_t*)smem;
  bf16_t* BCr = KHr + 16 * 72;
  bf16_t* KC = BCr + 16 * 72;
  bf16_t* RH = KC + 16 * 72;
  bf16_t* Sb = RH + 16 * 72;
  bf16_t* Wb2 = (bf16_t*)smem;
  bf16_t* Ab2 = Wb2 + 64 * 72;
  float* mu5 = (float*)(smem + 18432);
  bf16_t* actW = (bf16_t*)(smem + 23552);
  bf16_t* actA = actW + 16 * 72;
  float* shR = (float*)(smem + 28160);
  float* shK = shR + 1024; float* shV = shK + 1024;
  bf16_t* VT = (bf16_t*)(smem + 40448);
  bf16_t* UNT = VT + 64 * 40;
  bf16_t* KBT = UNT + 64 * 40;
  bf16_t* BBT = KBT + 64 * 24;
  float* PL = (float*)(smem + 56832);
  float* npart = PL + 64;
  float* MN = (float*)(smem + 57344);
  float* G0 = (float*)(smem + 61440);
  bf16_t* ArkM = (bf16_t*)(smem + 65536);
  bf16_t* ArbM = ArkM + 16 * 40;
  float* c0t = (float*)(smem + 68096);
  __syncthreads();
  for (int e = tid; e < 4096; e += NTHR) {
    const int i = e >> 6, c = e & 63;
    Wb2[c * 72 + i] = f2bf(p.in[I_W2][((size_t)(l * 2 + d) * 64 + i) * 512 + 64 * hh + c]);
    Ab2[c * 72 + i] = f2bf(p.in[I_A2][((size_t)(l * 2 + d) * 64 + i) * 512 + 64 * hh + c]);
  }
  for (int e = tid; e < 1280; e += NTHR) {
    const int n = e / 320, rem = e % 320, arr = rem >> 6, c = rem & 63;
    const int col = arr == 0 ? 64 * hh + c : arr == 1 ? 512 + 64 * hh + c : arr == 2 ? 1024 + 64 * hh + c : arr == 3 ? 1536 + 64 * d + c : 1664 + 64 * d + c;
    mu5[e] = mu[n * ZRW + col];
  }
  for (int e = tid; e < 320; e += NTHR) {
    const int arr = e >> 6, c = e & 63;
    const int col = arr == 0 ? 64 * hh + c : arr == 1 ? 512 + 64 * hh + c : arr == 2 ? 1024 + 64 * hh + c : arr == 3 ? 1536 + 64 * d + c : 1664 + 64 * d + c;
    float sm_ = mu[col] + mu[ZRW + col];
    if (q.grid) sm_ += mu[2 * ZRW + col] + mu[3 * ZRW + col];
    c0t[e] = 1.0f - sm_;
  }
  const int cB0 = 16 * w + 4 * qq;
  float w0c[4], a0c[4], kkc[4], kac[4];
#pragma unroll
  for (int g = 0; g < 4; ++g) {
    w0c[g] = p.in[I_W0][(l * 2 + d) * 512 + 64 * hh + cB0 + g]; a0c[g] = p.in[I_A0][(l * 2 + d) * 512 + 64 * hh + cB0 + g];
    kkc[g] = p.in[I_KK][l * 512 + 64 * hh + cB0 + g]; kac[g] = p.in[I_KA][l * 512 + 64 * hh + cB0 + g];
  }
  f32x16 S;
  if (q.sample) {
    const float* st = p.in[I_SR] + ((((size_t)q.b * 2 + l) * 2 + d) * 8 + hh) * 4096;
#pragma unroll
    for (int g = 0; g < 16; ++g) S[g] = st[(32 * vb + crow(g, h)) * 64 + 32 * kb + r32];
  } else {
#pragma unroll
    for (int g = 0; g < 16; ++g) S[g] = 0.f;
  }
  __syncthreads();
  bf16x8 bW[2], bA[2];
#pragma unroll
  for (int ks = 0; ks < 2; ++ks) { bW[ks] = *(const bf16x8*)(Wb2 + (16 * w + l15) * 72 + ks * 32 + qq * 8); bA[ks] = *(const bf16x8*)(Ab2 + (16 * w + l15) * 72 + ks * 32 + qq * 8); }
  __syncthreads();
  for (int e = tid; e < (2 * 64 * 40 + 2 * 64 * 24) / 2; e += NTHR) ((unsigned*)VT)[e] = 0u;
  for (int e = tid; e < (2 * 16 * 40) / 2; e += NTHR) ((unsigned*)ArkM)[e] = 0u;
  const int nch = q.T / 16;
  bf16x8 pf[3][5];
  const int jA = (tid0 & 127) >> 3, c8A = (tid0 & 7) * 8, wh = w >> 1;
#define RW_CB(arr) ((arr) == 0 ? 64 * hh : (arr) == 1 ? 512 + 64 * hh : (arr) == 2 ? 1024 + 64 * hh : (arr) == 3 ? 1536 + 64 * d : 1664 + 64 * d)
#define RW_ISSUE(chn) { const int pos = (chn) * 16 + jA, t = d ? q.T - 1 - pos : pos; _Pragma("unroll") for (int gi = 0; gi < 3; ++gi) { if (gi < 2 || w < 2) { \
      rw_load8(ZR, q.base, t, q.T, q.grid, RW_CB(2 * gi + wh) + c8A, pf[gi]); } } }
#pragma unroll
  for (int g = 0; g < 4; ++g) asm volatile("" : "+v"(w0c[g]), "+v"(a0c[g]), "+v"(kkc[g]), "+v"(kac[g]));
  asm volatile("" : "+v"(S));
  RW_ISSUE(0)
#pragma unroll 1
  for (int ch = 0; ch < nch; ++ch) {
    tid = tid0; asm volatile("" : "+v"(tid));
    lane = tid & 63; l15 = lane & 15; qq = lane >> 4; r32 = lane & 31; h = lane >> 5;
    __syncthreads();
    {
      const int pos_ = ch * 16 + jA, t_ = d ? q.T - 1 - pos_ : pos_;
      const unsigned vd_ = rw_valid(t_, q.T, q.grid);
#pragma unroll
      for (int gi = 0; gi < 3; ++gi) {
        if (gi < 2 || w < 2) {
          const int arr = 2 * gi + wh;
          float val[8];
          rw_apply8_lds(pf[gi], mu5 + arr * 64 + c8A, c0t + arr * 64 + c8A, q.grid, vd_, val);
          if (arr < 3) {
            *(f32x4*)(shR + arr * 1024 + jA * 64 + c8A) = (f32x4){val[0], val[1], val[2], val[3]};
            *(f32x4*)(shR + arr * 1024 + jA * 64 + c8A + 4) = (f32x4){val[4], val[5], val[6], val[7]};
            if (arr == 2) {
#pragma unroll
              for (int e = 0; e < 8; ++e) VT[(c8A + e) * 40 + jA] = f2bf(val[e]);
            }
          } else if (arr == 3) {
            *(u32x4*)(actW + jA * 72 + c8A) = (u32x4){pk2(fast_tanh(val[0]), fast_tanh(val[1])), pk2(fast_tanh(val[2]), fast_tanh(val[3])), pk2(fast_tanh(val[4]), fast_tanh(val[5])), pk2(fast_tanh(val[6]), fast_tanh(val[7]))};
          } else {
            *(u32x4*)(actA + jA * 72 + c8A) = (u32x4){pk2(val[0], val[1]), pk2(val[2], val[3]), pk2(val[4], val[5]), pk2(val[6], val[7])};
          }
        }
      }
    }
    asm volatile("" ::: "memory"); __builtin_amdgcn_sched_barrier(0);
    if (ch + 1 < nch) RW_ISSUE(ch + 1)
    __syncthreads();
    {
      f32x4 aw = (f32x4){0.f, 0.f, 0.f, 0.f}, aa = (f32x4){0.f, 0.f, 0.f, 0.f};
#pragma unroll
      for (int ks = 0; ks < 2; ++ks) {
        const bf16x8 fw = *(const bf16x8*)(actW + l15 * 72 + ks * 32 + qq * 8);
        const bf16x8 fa = *(const bf16x8*)(actA + l15 * 72 + ks * 32 + qq * 8);
        aw = __builtin_amdgcn_mfma_f32_16x16x32_bf16(bW[ks], fw, aw, 0, 0, 0);
        aa = __builtin_amdgcn_mfma_f32_16x16x32_bf16(bA[ks], fa, aa, 0, 0, 0);
      }
      const f32x4 kv = *(const f32x4*)(shK + l15 * 64 + cB0), rv = *(const f32x4*)(shR + l15 * 64 + cB0);
      float lw[4], av[4], kkr[4], kd[4], Lp[4], LpL[4];
      float ssq = 0.f;
#pragma unroll
      for (int g = 0; g < 4; ++g) {
        const float wl = aw[g] + w0c[g], al = aa[g] + a0c[g];
        lw[g] = -__expf(-softplusf_(-wl) - 0.5f);
        av[g] = sigmoidf_(al);
        kkr[g] = kv[g] * kkc[g];
        kd[g] = kv[g] * (1.0f + (av[g] - 1.0f) * kac[g]);
        ssq += kkr[g] * kkr[g];
        float x = lw[g];
        x += dpp_row_shr0<1>(x); x += dpp_row_shr0<2>(x); x += dpp_row_shr0<4>(x); x += dpp_row_shr0<8>(x);
        Lp[g] = x;
      }
#pragma unroll
      for (int g = 0; g < 4; ++g) { float x = Lp[g];
        x = fminf(x, __int_as_float(__builtin_amdgcn_mov_dpp(__float_as_int(x), 0x128, 0xF, 0xF, true))); x = fminf(x, __int_as_float(__builtin_amdgcn_mov_dpp(__float_as_int(x), 0x124, 0xF, 0xF, true)));
        x = fminf(x, dpp_xor2(x)); x = fminf(x, dpp_xor1(x)); LpL[g] = x; }
      ssq += SHX(ssq, 16); ssq += SHX(ssq, 32);
      if (qq == 0) npart[w * 16 + l15] = ssq;
      float e_m1[4], e_neg[4], e_pos[4], e_end[4];
#pragma unroll
      for (int g = 0; g < 4; ++g) { e_m1[g] = __expf(Lp[g] - lw[g]); e_neg[g] = __expf(-Lp[g]); e_pos[g] = __expf(Lp[g]); e_end[g] = __expf(LpL[g] - Lp[g]); }
      *(u32x2*)(KHr + l15 * 72 + cB0) = (u32x2){pk2(kkr[0] * e_m1[0], kkr[1] * e_m1[1]), pk2(kkr[2] * e_m1[2], kkr[3] * e_m1[3])};
      *(u32x2*)(BCr + l15 * 72 + cB0) = (u32x2){pk2(kkr[0] * av[0] * e_neg[0], kkr[1] * av[1] * e_neg[1]), pk2(kkr[2] * av[2] * e_neg[2], kkr[3] * av[3] * e_neg[3])};
      *(u32x2*)(KC + l15 * 72 + cB0) = (u32x2){pk2(kd[0] * e_neg[0], kd[1] * e_neg[1]), pk2(kd[2] * e_neg[2], kd[3] * e_neg[3])};
      *(u32x2*)(RH + l15 * 72 + cB0) = (u32x2){pk2(rv[0] * e_pos[0], rv[1] * e_pos[1]), pk2(rv[2] * e_pos[2], rv[3] * e_pos[3])};
#pragma unroll
      for (int g = 0; g < 4; ++g) {
        KBT[(cB0 + g) * 24 + l15] = f2bf(kd[g] * e_end[g]);
        BBT[(cB0 + g) * 24 + l15] = f2bf(kkr[g] * av[g] * e_end[g]);
      }
      if (l15 == 15) *(f32x4*)(PL + cB0) = (f32x4){e_pos[0], e_pos[1], e_pos[2], e_pos[3]};
#pragma unroll
      for (int g = 0; g < 16; ++g) Sb[(32 * vb + crow(g, h)) * 72 + 32 * kb + r32] = f2bf(S[g]);
    }
    __syncthreads();
    f32x4 oacc = (f32x4){0.f, 0.f, 0.f, 0.f};
    {
      const bf16_t* Aop = (w < 2) ? KHr : RH;
      const bf16_t* Bop = (w == 0 || w == 3) ? BCr : KC;
      f32x4 t16 = (f32x4){0.f, 0.f, 0.f, 0.f}, g0 = (f32x4){0.f, 0.f, 0.f, 0.f};
#pragma unroll
      for (int ks = 0; ks < 2; ++ks) {
        const bf16x8 a = *(const bf16x8*)(Aop + l15 * 72 + ks * 32 + qq * 8);
        const bf16x8 b = *(const bf16x8*)(Bop + l15 * 72 + ks * 32 + qq * 8);
        t16 = __builtin_amdgcn_mfma_f32_16x16x32_bf16(a, b, t16, 0, 0, 0);
        const bf16x8 akh = *(const bf16x8*)(KHr + l15 * 72 + ks * 32 + qq * 8);
        const bf16x8 arh = *(const bf16x8*)(RH + l15 * 72 + ks * 32 + qq * 8);
        const bf16x8 bs = *(const bf16x8*)(Sb + (16 * w + l15) * 72 + ks * 32 + qq * 8);
        g0 = __builtin_amdgcn_mfma_f32_16x16x32_bf16(akh, bs, g0, 0, 0, 0);
        oacc = __builtin_amdgcn_mfma_f32_16x16x32_bf16(arh, bs, oacc, 0, 0, 0);
      }
#pragma unroll
      for (int g = 0; g < 4; ++g) G0[(4 * qq + g) * 64 + 16 * w + l15] = g0[g];
      *(f32x4*)(MN + w * 256 + l15 * 16 + 4 * qq) = t16;
    }
    __syncthreads();
    if (w == 0) {
      const float* MrT = MN; const float* NrT = MN + 256;
      f32x2 acc2[8];
#pragma unroll
      for (int pq = 0; pq < 8; ++pq) acc2[pq] = (f32x2){G0[(2 * pq) * 64 + lane], G0[(2 * pq + 1) * 64 + lane]};
      float vv[16], un[16];
#pragma unroll
      for (int j = 0; j < 16; ++j) vv[j] = shV[j * 64 + lane];
      const float n2v = __builtin_amdgcn_rcpf(fmaxf(npart[l15] + npart[16 + l15] + npart[32 + l15] + npart[48 + l15], 1e-24f));
      f32x4 nr[4], mr[4];
#pragma unroll
      for (int t4 = 0; t4 < 4; ++t4) { nr[t4] = *(const f32x4*)(NrT + 4 * t4); mr[t4] = *(const f32x4*)(MrT + 4 * t4); }
#pragma unroll
      for (int j = 0; j < 16; ++j) {
        f32x4 nrn[4], mrn[4];
#pragma unroll
        for (int t4 = 0; t4 < 4; ++t4) { nrn[t4] = (f32x4){0.f, 0.f, 0.f, 0.f}; mrn[t4] = (f32x4){0.f, 0.f, 0.f, 0.f}; }
        if (j + 1 < 16) {
#pragma unroll
          for (int t4 = 0; t4 < 4; ++t4) if (4 * t4 + 3 > j + 1) { nrn[t4] = *(const f32x4*)(NrT + (j + 1) * 16 + 4 * t4); mrn[t4] = *(const f32x4*)(MrT + (j + 1) * 16 + 4 * t4); }
        }
        const float n2s = __int_as_float(__builtin_amdgcn_readlane(__float_as_int(n2v), j));
        const float unj = -acc2[j >> 1][j & 1] * n2s;
        un[j] = unj;
        const f32x2 vv2 = (f32x2){vv[j], vv[j]}, un2 = (f32x2){unj, unj};
#pragma unroll
        for (int pq = 0; pq < 8; ++pq)
          if (2 * pq + 1 > j) acc2[pq] += (f32x2){nr[pq >> 1][2 * (pq & 1)], nr[pq >> 1][2 * (pq & 1) + 1]} * vv2 + (f32x2){mr[pq >> 1][2 * (pq & 1)], mr[pq >> 1][2 * (pq & 1) + 1]} * un2;
#pragma unroll
        for (int t4 = 0; t4 < 4; ++t4) { nr[t4] = nrn[t4]; mr[t4] = mrn[t4]; }
        __builtin_amdgcn_sched_barrier(0);
      }
      *(u32x4*)(UNT + lane * 40) = (u32x4){pk2(un[0], un[1]), pk2(un[2], un[3]), pk2(un[4], un[5]), pk2(un[6], un[7])};
      *(u32x4*)(UNT + lane * 40 + 8) = (u32x4){pk2(un[8], un[9]), pk2(un[10], un[11]), pk2(un[12], un[13]), pk2(un[14], un[15])};
    } else if (w < 3) {
      const float* src = MN + (w == 1 ? 512 : 768);
      bf16_t* dst = (w == 1) ? ArkM : ArbM;
#pragma unroll
      for (int i = 0; i < 4; ++i) { const int e = lane + 64 * i, j = e >> 4, t = e & 15; dst[t * 40 + j] = f2bf(j <= t ? src[e] : 0.f); }
    }
    __syncthreads();
    {
      const bf16x8 ak = *(const bf16x8*)(ArkM + l15 * 40 + qq * 8), ab = *(const bf16x8*)(ArbM + l15 * 40 + qq * 8);
      const bf16x8 bv = *(const bf16x8*)(VT + (16 * w + l15) * 40 + qq * 8), bu = *(const bf16x8*)(UNT + (16 * w + l15) * 40 + qq * 8);
      oacc = __builtin_amdgcn_mfma_f32_16x16x32_bf16(ak, bv, oacc, 0, 0, 0);
      oacc = __builtin_amdgcn_mfma_f32_16x16x32_bf16(ab, bu, oacc, 0, 0, 0);
#pragma unroll
      for (int g = 0; g < 4; ++g) {
        const int pos = ch * 16 + 4 * qq + g, t = d ? q.T - 1 - pos : pos;
        O[(size_t)(q.base + t) * 1024 + d * 512 + 64 * hh + 16 * w + l15] = f2bf(oacc[g]);
      }
      const float pl = PL[32 * kb + r32];
#pragma unroll
      for (int g = 0; g < 16; ++g) S[g] *= pl;
      const bf16x8 av_ = *(const bf16x8*)(VT + (32 * vb + r32) * 40 + 8 * h), au_ = *(const bf16x8*)(UNT + (32 * vb + r32) * 40 + 8 * h);
      const bf16x8 bk_ = *(const bf16x8*)(KBT + (32 * kb + r32) * 24 + 8 * h), bb_ = *(const bf16x8*)(BBT + (32 * kb + r32) * 24 + 8 * h);
      S = __builtin_amdgcn_mfma_f32_32x32x16_bf16(av_, bk_, S, 0, 0, 0);
      S = __builtin_amdgcn_mfma_f32_32x32x16_bf16(au_, bb_, S, 0, 0, 0);
    }
  }
  if (!q.sample) {
    float* dst = p.out + OUT_RW + ((((size_t)q.b * 2 + l) * 2 + d) * 8 + hh) * 4096;
#pragma unroll
    for (int g = 0; g < 16; ++g) dst[(32 * vb + crow(g, h)) * 64 + 32 * kb + r32] = S[g];
  }
}

DI void hgrn_item(const Params& p, int l, int s, int hh, int d, char* smem) {
  const Seq q = get_seq(s);
  const int tid = ltid(), lane = tid & 63, w = tid >> 6, r = lane & 31, h = lane >> 5;
  bf16_t* ZH = (bf16_t*)(p.ws + OFF_ZH);
  bf16_t* Qt = (bf16_t*)smem;
  bf16_t* Kt = Qt + 32 * 136;
  bf16_t* KhT = Kt + 32 * 136;
  bf16_t* VT = KhT + 128 * 40;
  bf16_t* Sb = VT + 128 * 40;
  bf16_t* At = Sb + 4 * 32 * 136;
  float* dL = (float*)(At + 32 * 40);
  float* tot = dL + 128;
  const float lb = ((const float*)(p.ws + OFF_LBS))[l * 512 + 128 * hh + (tid & 127)];
  f32x16 S[4];
  if (q.sample) {
    const float* st = p.in[I_SH] + ((((size_t)q.b * 2 + l) * 2 + d) * 4 + hh) * 16384;
#pragma unroll
    for (int kb = 0; kb < 4; ++kb)
#pragma unroll
      for (int g = 0; g < 16; ++g) S[kb][g] = st[(size_t)(32 * kb + crow(g, h)) * 128 + 32 * w + r];
  } else {
#pragma unroll
    for (int kb = 0; kb < 4; ++kb)
#pragma unroll
      for (int g = 0; g < 16; ++g) S[kb][g] = 0.f;
  }
  const int k = tid & 127, half = tid >> 7;
  const int nch = q.T / 32;
  u16x2 pzq[16], pv2[8];
#define HG_ISSUE(chn) { _Pragma("unroll") for (int jj = 0; jj < 16; ++jj) { const int pos = (chn) * 32 + half * 16 + jj, t = d ? q.T - 1 - pos : pos; \
      const size_t rowo = (size_t)(q.base + t) * ZHW + 128 * hh + k; pzq[jj][0] = ZH[rowo + 512 * (1 + d)]; pzq[jj][1] = ZH[rowo]; pv2[jj >> 1][jj & 1] = ZH[rowo + 1536]; } }
  { float lb_ = lb; asm volatile("" : "+v"(lb_)); (void)lb_; }
#pragma unroll
  for (int kb = 0; kb < 4; ++kb) asm volatile("" : "+v"(S[kb]));
  HG_ISSUE(0)
#pragma unroll 1
  for (int ch = 0; ch < nch; ++ch) {
    __syncthreads();
    float bl[16], kc[16], qs[16];
    {
      float b = 0.f;
#pragma unroll
      for (int jj = 0; jj < 16; ++jj) {
        const float z = bf2f(pzq[jj][0]);
        const float kcoef = (1.0f - lb) * sigmoidf_(-z);
        const float f = 1.0f - kcoef;
        b += fmaxf(__logf(f), -80.f);
        bl[jj] = b; kc[jj] = kcoef; qs[jj] = bf2f(pzq[jj][1]) * 0.08838834764831845f;
      }
      *(u32x4*)(VT + k * 40 + half * 16) = (u32x4){__builtin_bit_cast(unsigned, pv2[0]), __builtin_bit_cast(unsigned, pv2[1]), __builtin_bit_cast(unsigned, pv2[2]), __builtin_bit_cast(unsigned, pv2[3])};
      *(u32x4*)(VT + k * 40 + half * 16 + 8) = (u32x4){__builtin_bit_cast(unsigned, pv2[4]), __builtin_bit_cast(unsigned, pv2[5]), __builtin_bit_cast(unsigned, pv2[6]), __builtin_bit_cast(unsigned, pv2[7])};
      tot[half * 128 + k] = b;
    }
    if (ch + 1 < nch) HG_ISSUE(ch + 1)
    __syncthreads();
    {
      const float off = half ? tot[k] : 0.f;
      const float bL = fmaxf(tot[k] + tot[128 + k], -80.f);
      if (half == 0) dL[k] = __expf(bL);
      float kh[16];
#pragma unroll
      for (int jj = 0; jj < 16; ++jj) {
        const int j = half * 16 + jj;
        const float bj = fmaxf(off + bl[jj], -80.f);
        Qt[j * 136 + k] = f2bf(qs[jj] * __expf(bj));
        Kt[j * 136 + k] = f2bf(kc[jj] * __expf(-bj));
        kh[jj] = kc[jj] * __expf(fminf(bL - bj, 0.f));
      }
      *(u32x4*)(KhT + k * 40 + half * 16) = (u32x4){pk2(kh[0], kh[1]), pk2(kh[2], kh[3]), pk2(kh[4], kh[5]), pk2(kh[6], kh[7])};
      *(u32x4*)(KhT + k * 40 + half * 16 + 8) = (u32x4){pk2(kh[8], kh[9]), pk2(kh[10], kh[11]), pk2(kh[12], kh[13]), pk2(kh[14], kh[15])};
    }
    bf16_t* Sbw = Sb + w * 32 * 136;
#pragma unroll
    for (int kb = 0; kb < 4; ++kb)
#pragma unroll
      for (int g4 = 0; g4 < 4; ++g4) *(u32x2*)(Sbw + r * 136 + 32 * kb + crow(4 * g4, h)) = (u32x2){pk2(S[kb][4 * g4], S[kb][4 * g4 + 1]), pk2(S[kb][4 * g4 + 2], S[kb][4 * g4 + 3])};
    __syncthreads();
    bf16_t* Atw = At;
    {
      f32x16 A;
#pragma unroll
      for (int g = 0; g < 16; ++g) A[g] = 0.f;
      mma32(A, Qt, 136, Kt, 136, 128, lane);
#pragma unroll
      for (int g = 0; g < 16; ++g) { const int t = crow(g, h); Atw[t * 40 + r] = f2bf(r <= t ? A[g] : 0.f); }
    }
    __syncthreads();
    {
      f32x16 o;
#pragma unroll
      for (int g = 0; g < 16; ++g) o[g] = 0.f;
      mma32(o, Atw, 40, VT + 32 * w * 40, 40, 32, lane);
      mma32(o, Qt, 136, Sbw, 136, 128, lane);
#pragma unroll
      for (int g = 0; g < 16; ++g) {
        const int j = crow(g, h), pos = ch * 32 + j, t = d ? q.T - 1 - pos : pos;
        ZH[(size_t)(q.base + t) * ZHW + 512 * (1 + d) + 128 * hh + 32 * w + r] = f2bf(o[g]);
      }
#pragma unroll
      for (int kb = 0; kb < 4; ++kb) {
#pragma unroll
        for (int g = 0; g < 16; ++g) S[kb][g] *= dL[32 * kb + crow(g, h)];
        mma32(S[kb], KhT + 32 * kb * 40, 40, VT + 32 * w * 40, 40, 32, lane);
      }
    }
  }
  if (!q.sample) {
    float* dst = p.out + OUT_HG + ((((size_t)q.b * 2 + l) * 2 + d) * 4 + hh) * 16384;
#pragma unroll
    for (int kb = 0; kb < 4; ++kb)
#pragma unroll
      for (int g = 0; g < 16; ++g) dst[(size_t)(32 * kb + crow(g, h)) * 128 + 32 * w + r] = S[kb][g];
  }
}

DI void mlstm_item(const Params& p, int l, int s, int hh, int d, char* smem) {
  const Seq q = get_seq(s);
  const int tid = ltid(), lane = tid & 63, w = tid >> 6, r = lane & 31, h = lane >> 5;
  const bf16_t* ZM = (const bf16_t*)(p.ws + OFF_ZM);
  const float* MG = (const float*)(p.ws + OFF_MG);
  bf16_t* Hb = (bf16_t*)(p.ws + OFF_H);
  bf16_t* Qm = (bf16_t*)smem;
  bf16_t* Km = Qm + 32 * 136;
  bf16_t* KwT = Km + 32 * 136;
  bf16_t* VT = KwT + 128 * 40;
  bf16_t* Cb = VT + 128 * 40;
  bf16_t* Pt = Cb + 4 * 32 * 136;
  float* nv = (float*)(Pt + 32 * 40);
  float* sc = nv + 128;
  float* ig = sc; float* lf = sc + 32; float* gg = sc + 64; float* mtv = sc + 96; float* wi = sc + 128; float* wsr = sc + 160; float* qn = sc + 192; float* misc = sc + 224;
  float* dnw = sc + 232;
  const float gbi = p.in[I_GB][l * 16 + (2 * d) * 4 + hh], gbf = p.in[I_GB][l * 16 + (2 * d + 1) * 4 + hh];
  f32x16 C[4];
  float m;
  __syncthreads();
  if (q.sample) {
    const size_t sb = (((size_t)q.b * 2 + l) * 2 + d) * 4 + hh;
    const float* st = p.in[I_SC] + sb * 16384;
#pragma unroll
    for (int kb = 0; kb < 4; ++kb)
#pragma unroll
      for (int g = 0; g < 16; ++g) C[kb][g] = st[(size_t)(32 * kb + crow(g, h)) * 128 + 32 * w + r];
    if (tid < 128) nv[tid] = p.in[I_SN][sb * 128 + tid];
    m = p.in[I_SM][sb];
  } else {
#pragma unroll
    for (int kb = 0; kb < 4; ++kb)
#pragma unroll
      for (int g = 0; g < 16; ++g) C[kb][g] = 0.f;
    if (tid < 128) nv[tid] = 0.f;
    m = 0.f;
  }
  const int nch = q.T / 32;
  const int dd = tid & 127, half = tid >> 7;
  u16x2 pqk[16], pv2[8]; float pgi = 0.f, pgf = 0.f;
#define ML_ISSUE(chn) { _Pragma("unroll") for (int jj = 0; jj < 16; ++jj) { const int pos = (chn) * 32 + half * 16 + jj, t = d ? q.T - 1 - pos : pos; \
      const size_t rowo = (size_t)(q.base + t) * ZMW + 128 * hh + dd; pqk[jj][0] = ZM[rowo]; pqk[jj][1] = ZM[rowo + 512]; pv2[jj >> 1][jj & 1] = ZM[rowo + 1024]; } \
    if (tid < 32) { const int pos = (chn) * 32 + tid, t = d ? q.T - 1 - pos : pos; const float* mg = MG + (size_t)(q.base + t) * 16; pgi = mg[(2 * d) * 4 + hh]; pgf = mg[(2 * d + 1) * 4 + hh]; } }
#pragma unroll
  for (int kb = 0; kb < 4; ++kb) asm volatile("" : "+v"(C[kb]));
  asm volatile("" : "+v"(m));
  ML_ISSUE(0)
#pragma unroll 1
  for (int ch = 0; ch < nch; ++ch) {
    __syncthreads();
    {
#pragma unroll
      for (int jj = 0; jj < 16; ++jj) {
        const int j = half * 16 + jj;
        Qm[j * 136 + dd] = pqk[jj][0];
        Km[j * 136 + dd] = f2bf(bf2f(pqk[jj][1]) * 0.08838834764831845f);
      }
      *(u32x4*)(VT + dd * 40 + half * 16) = (u32x4){__builtin_bit_cast(unsigned, pv2[0]), __builtin_bit_cast(unsigned, pv2[1]), __builtin_bit_cast(unsigned, pv2[2]), __builtin_bit_cast(unsigned, pv2[3])};
      *(u32x4*)(VT + dd * 40 + half * 16 + 8) = (u32x4){__builtin_bit_cast(unsigned, pv2[4]), __builtin_bit_cast(unsigned, pv2[5]), __builtin_bit_cast(unsigned, pv2[6]), __builtin_bit_cast(unsigned, pv2[7])};
      if (tid < 32) {
        const float igv = pgi + gbi;
        const float lfv = -softplusf_(-(pgf + gbf));
        float g = lfv;
#pragma unroll
        for (int o = 1; o < 32; o <<= 1) { const float tt = shfl_lane(g, (lane - o) & 63); if (tid >= o) g += tt; }
        const float cs = igv - g;
        float pm = cs;
#pragma unroll
        for (int o = 1; o < 32; o <<= 1) { const float tt = shfl_lane(pm, (lane - o) & 63); if (tid >= o) pm = fmaxf(pm, tt); }
        const float mt = g + fmaxf(m, pm);
        const float gend = shfl_lane(g, 31), mn = shfl_lane(mt, 31);
        ig[tid] = igv; gg[tid] = g; mtv[tid] = mt; wi[tid] = __expf(g + m - mt);
        wsr[tid] = __expf(gend + cs - mn);
        if (tid == 0) { misc[0] = mn; misc[1] = __expf(gend + m - mn); }
      }
    }
    if (ch + 1 < nch) ML_ISSUE(ch + 1)
    __syncthreads();
    {
      {
        float kw[16];
#pragma unroll
        for (int jj = 0; jj < 16; ++jj) { const int j = half * 16 + jj; kw[jj] = bf2f(Km[j * 136 + dd]) * wsr[j]; }
        *(u32x4*)(KwT + dd * 40 + half * 16) = (u32x4){pk2(kw[0], kw[1]), pk2(kw[2], kw[3]), pk2(kw[4], kw[5]), pk2(kw[6], kw[7])};
        *(u32x4*)(KwT + dd * 40 + half * 16 + 8) = (u32x4){pk2(kw[8], kw[9]), pk2(kw[10], kw[11]), pk2(kw[12], kw[13]), pk2(kw[14], kw[15])};
      }
      const int j = tid >> 3, seg = tid & 7;
      float a = 0.f;
#pragma unroll
      for (int i = 0; i < 16; ++i) a += bf2f(Qm[j * 136 + seg * 16 + i]) * nv[seg * 16 + i];
      a += SHX(a, 1); a += SHX(a, 2); a += SHX(a, 4);
      if (seg == 0) qn[j] = a;
    }
    const float m_new = misc[0], carry = misc[1];
    bf16_t* Cbw = Cb + w * 32 * 136; bf16_t* Ptw = Pt;
#pragma unroll
    for (int kb = 0; kb < 4; ++kb)
#pragma unroll
      for (int g4 = 0; g4 < 4; ++g4) *(u32x2*)(Cbw + r * 136 + 32 * kb + crow(4 * g4, h)) = (u32x2){pk2(C[kb][4 * g4], C[kb][4 * g4 + 1]), pk2(C[kb][4 * g4 + 2], C[kb][4 * g4 + 3])};
    {
      f32x16 Sc;
#pragma unroll
      for (int g = 0; g < 16; ++g) Sc[g] = 0.f;
      mma32(Sc, Qm, 136, Km, 136, 128, lane);
      const float gs = gg[r], is = ig[r];
#pragma unroll
      for (int g = 0; g < 16; ++g) {
        const int t = crow(g, h);
        const float pv = (r <= t) ? __expf(gg[t] - gs + is - mtv[t]) * Sc[g] : 0.f;
        Ptw[t * 40 + r] = f2bf(pv);
      }
    }
    __syncthreads();
    if (lane < 32) {
      float a = 0.f;
#pragma unroll 4
      for (int i = 0; i < 32; ++i) a += bf2f(Ptw[lane * 40 + i]);
      const float den = wi[lane] * qn[lane] + a;
      dnw[lane] = 1.0f / fmaxf(fabsf(den), __expf(-mtv[lane]));
    }
    if (tid < 128) {
      float a = 0.f;
#pragma unroll 4
      for (int i = 0; i < 32; ++i) a += bf2f(KwT[tid * 40 + i]);
      nv[tid] = carry * nv[tid] + a;
    }
    __syncthreads();
    {
      f32x16 a1;
#pragma unroll
      for (int g = 0; g < 16; ++g) a1[g] = 0.f;
      mma32(a1, Qm, 136, Cbw, 136, 128, lane);
#pragma unroll
      for (int g = 0; g < 16; ++g) a1[g] *= wi[crow(g, h)];
      mma32(a1, Ptw, 40, VT + 32 * w * 40, 40, 32, lane);
#pragma unroll
      for (int g = 0; g < 16; ++g) {
        const int j = crow(g, h), pos = ch * 32 + j, t = d ? q.T - 1 - pos : pos;
        const float hv = a1[g] * dnw[j];
        Hb[(size_t)(q.base + t) * 1024 + d * 512 + 128 * hh + 32 * w + r] = f2bf(hv);
      }
#pragma unroll
      for (int kb = 0; kb < 4; ++kb) {
#pragma unroll
        for (int g = 0; g < 16; ++g) C[kb][g] *= carry;
        mma32(C[kb], KwT + 32 * kb * 40, 40, VT + 32 * w * 40, 40, 32, lane);
      }
    }
    m = m_new;
  }
  __syncthreads();
  if (!q.sample) {
    const size_t sb = (((size_t)q.b * 2 + l) * 2 + d) * 4 + hh;
    float* dst = p.out + OUT_C + sb * 16384;
#pragma unroll
    for (int kb = 0; kb < 4; ++kb)
#pragma unroll
      for (int g = 0; g < 16; ++g) dst[(size_t)(32 * kb + crow(g, h)) * 128 + 32 * w + r] = C[kb][g];
    if (tid < 128) p.out[OUT_N + sb * 128 + tid] = nv[tid];
    if (tid == 0) p.out[OUT_M + sb] = m;
  }
}

DI void phase_scan(const Params& p, int l, char* smem) {
  int* ctrL = (int*)(p.ws + OFF_CTR) + 2 * l;
  int* ctrS = ctrL + 1;
  int* sit = (int*)(smem + LDS_BYTES - 16);
  const int role = p.role;
  bool longDone = false, shortDone = false;
  for (;;) {
    const bool wantLong = (role == 0) ? !longDone : shortDone;
    if (longDone && shortDone) break;
    __syncthreads();
    if (ltid() == 0) *sit = atomicAdd(wantLong ? ctrL : ctrS, 1);
    __syncthreads();
    int it = __builtin_amdgcn_readfirstlane(*sit);
    int ty, s_, hh_, d_, rb_ = 0;
    if (wantLong) {
      if (it >= 128) { longDone = true; continue; }
      if (it < 64) { ty = 0; d_ = it & 1; hh_ = (it >> 1) & 7; s_ = 32 + (it >> 4); }
      else if (it < 96) { it -= 64; ty = 1; s_ = 32 + (it >> 3); hh_ = (it >> 1) & 3; d_ = it & 1; }
      else { it -= 96; ty = 2; s_ = 32 + (it >> 3); hh_ = (it >> 1) & 3; d_ = it & 1; }
    } else {
      if (it >= 1024) { shortDone = true; continue; }
      if (it < 512) { ty = 0; s_ = it >> 4; hh_ = (it >> 1) & 7; d_ = it & 1; }
      else if (it < 768) { it -= 512; ty = 1; s_ = it >> 3; hh_ = (it >> 1) & 3; d_ = it & 1; }
      else { it -= 768; ty = 2; s_ = it >> 3; hh_ = (it >> 1) & 3; d_ = it & 1; }
    }
    if (ty == 0) rwkv_item(p, l, s_, hh_, d_, smem);
    else if (ty == 1) hgrn_item(p, l, s_, hh_, d_, smem);
    else mlstm_item(p, l, s_, hh_, d_, smem);
  }
}

DI void phase_combine(const Params& p, int l, char* smem) {
  const int tid = ltid(), lane = tid & 63, w = tid >> 6;
  bf16_t* ZH = (bf16_t*)(p.ws + OFF_ZH); bf16_t* ZM = (bf16_t*)(p.ws + OFF_ZM); const bf16_t* ZR = (const bf16_t*)(p.ws + OFF_ZR);
  bf16_t* O = (bf16_t*)(p.ws + OFF_O); const bf16_t* Hb = (const bf16_t*)(p.ws + OFF_H);
  const float* mu = p.in[I_MU] + (size_t)l * 4 * ZRW;
  const float* g2 = p.in[I_G2] + (size_t)l * 128 * 512;
  float* sg = (float*)smem;
  float* gt = sg + 128 * 16;
  for (int blk = blockIdx.x; blk < NT / 16; blk += gridDim.x) {
    const int tok0 = blk * 16;
    int sidx, t0;
    if (tok0 < 8192) { sidx = tok0 >> 8; t0 = tok0 & 255; } else { sidx = 32 + ((tok0 - 8192) >> 11); t0 = (tok0 - 8192) & 2047; }
    const Seq q = get_seq(sidx);
    __syncthreads();
    { const int j = tid >> 4, rr0 = (tid & 15) * 8; float val[8]; bf16x8 pv[5]; rw_load8(ZR, q.base, t0 + j, q.T, q.grid, 1792 + rr0, pv); rw_apply8(pv, mu, q.grid, rw_valid(t0 + j, q.T, q.grid), 1792 + rr0, val);
#pragma unroll
      for (int e = 0; e < 8; ++e) sg[(rr0 + e) * 16 + j] = sigmoidf_(val[e]); }
    __syncthreads();
    {
      float a0[16], a1[16];
#pragma unroll
      for (int j = 0; j < 16; ++j) { a0[j] = 0.f; a1[j] = 0.f; }
#pragma unroll 1
      for (int r0 = 0; r0 < 128; r0 += 8) {
        float w0v[8], w1v[8];
#pragma unroll
        for (int q8 = 0; q8 < 8; ++q8) { w0v[q8] = g2[(r0 + q8) * 512 + tid]; w1v[q8] = g2[(r0 + q8) * 512 + 256 + tid]; }
#pragma unroll
        for (int q8 = 0; q8 < 8; ++q8) {
          const int rr = r0 + q8; const float w0 = w0v[q8], w1 = w1v[q8];
#pragma unroll
          for (int u = 0; u < 4; ++u) {
            f32x4 sv = *(const f32x4*)(sg + rr * 16 + 4 * u);
#pragma unroll
            for (int e = 0; e < 4; ++e) { a0[4 * u + e] += sv[e] * w0; a1[4 * u + e] += sv[e] * w1; }
          }
        }
      }
#pragma unroll
      for (int j = 0; j < 16; ++j) { gt[j * 512 + tid] = a0[j]; gt[j * 512 + 256 + tid] = a1[j]; }
    }
    __syncthreads();
#pragma unroll 1
    for (int jj = 0; jj < 4; ++jj) {
      const int j = w * 4 + jj, tok = tok0 + j, t = t0 + j; int c0 = lane * 8; asm volatile("" : "+v"(c0));
      {
        float o[8], rs[8], ks[8], vs[8];
        float sum = 0.f, bon = 0.f;
        {
          bf16x8 pr_[5], pk_[5], pv_[5];
          rw_load8(ZR, q.base, t, q.T, q.grid, c0, pr_); rw_load8(ZR, q.base, t, q.T, q.grid, 512 + c0, pk_); rw_load8(ZR, q.base, t, q.T, q.grid, 1024 + c0, pv_);
          const unsigned vd_ = rw_valid(t, q.T, q.grid);
          rw_apply8(pr_, mu, q.grid, vd_, c0, rs); rw_apply8(pk_, mu, q.grid, vd_, 512 + c0, ks); rw_apply8(pv_, mu, q.grid, vd_, 1024 + c0, vs);
        }
        const bf16x8 of = *(const bf16x8*)(O + (size_t)tok * 1024 + c0), ob = *(const bf16x8*)(O + (size_t)tok * 1024 + 512 + c0);
        const f32x4 rk0 = *(const f32x4*)(p.in[I_RK] + l * 512 + c0), rk1 = *(const f32x4*)(p.in[I_RK] + l * 512 + c0 + 4);
#pragma unroll
        for (int e = 0; e < 8; ++e) {
          o[e] = bf2f((bf16_t)of[e]) + bf2f((bf16_t)ob[e]);
          sum += o[e];
          bon += rs[e] * ks[e] * (e < 4 ? rk0[e & 3] : rk1[e & 3]);
        }
        sum += SHX(sum, 1); sum += SHX(sum, 2); sum += SHX(sum, 4);
        bon += SHX(bon, 1); bon += SHX(bon, 2); bon += SHX(bon, 4);
        const float mean = sum * (1.0f / 64.f);
        float var = 0.f;
#pragma unroll
        for (int e = 0; e < 8; ++e) { const float dv = o[e] - mean; var += dv * dv; }
        var += SHX(var, 1); var += SHX(var, 2); var += SHX(var, 4);
        const float rstd = rsqrtf(var * (1.0f / 64.f) + 64e-5f);
        const f32x4 lw0 = *(const f32x4*)(p.in[I_LN] + (l * 2 + 0) * 512 + c0), lw1 = *(const f32x4*)(p.in[I_LN] + (l * 2 + 0) * 512 + c0 + 4);
        const f32x4 lb0 = *(const f32x4*)(p.in[I_LN] + (l * 2 + 1) * 512 + c0), lb1 = *(const f32x4*)(p.in[I_LN] + (l * 2 + 1) * 512 + c0 + 4);
        const f32x4 gt0 = *(const f32x4*)(gt + j * 512 + c0), gt1 = *(const f32x4*)(gt + j * 512 + c0 + 4);
        bf16x8 ov;
#pragma unroll
        for (int e = 0; e < 8; ++e) {
          const float ln = (o[e] - mean) * rstd * (e < 4 ? lw0[e & 3] : lw1[e & 3]) + (e < 4 ? lb0[e & 3] : lb1[e & 3]);
          ov[e] = (short)f2bf((ln + bon * vs[e]) * (e < 4 ? gt0[e & 3] : gt1[e & 3]));
        }
        *(bf16x8*)(O + (size_t)tok * 1024 + c0) = ov;
      }
      {
        float o[8]; float ss = 0.f;
        bf16_t* zr_ = ZH + (size_t)tok * ZHW + c0;
        const bf16x8 of = *(const bf16x8*)(zr_ + 512), ob = *(const bf16x8*)(zr_ + 1024), hgv = *(const bf16x8*)(zr_ + 2048);
        const f32x4 nw0 = *(const f32x4*)(p.in[I_HNORM] + l * 512 + c0), nw1 = *(const f32x4*)(p.in[I_HNORM] + l * 512 + c0 + 4);
#pragma unroll
        for (int e = 0; e < 8; ++e) { o[e] = bf2f((bf16_t)of[e]) + bf2f((bf16_t)ob[e]); ss += o[e] * o[e]; }
        ss += SHX(ss, 1); ss += SHX(ss, 2); ss += SHX(ss, 4); ss += SHX(ss, 8);
        const float rsd = rsqrtf(ss * (1.0f / 128.f) + 1e-6f);
        bf16x8 ov;
#pragma unroll
        for (int e = 0; e < 8; ++e) ov[e] = (short)f2bf(o[e] * rsd * (e < 4 ? nw0[e & 3] : nw1[e & 3]) * siluf_(bf2f((bf16_t)hgv[e])));
        *(bf16x8*)(zr_ + 2048) = ov;
      }
      {
        float o[8]; float ss = 0.f;
        bf16_t* zm_ = ZM + (size_t)tok * ZMW + 1536 + c0;
        const bf16x8 of = *(const bf16x8*)(Hb + (size_t)tok * 1024 + c0), ob = *(const bf16x8*)(Hb + (size_t)tok * 1024 + 512 + c0), mov = *(const bf16x8*)zm_;
        const f32x4 nw0 = *(const f32x4*)(p.in[I_MNORM] + l * 512 + c0), nw1 = *(const f32x4*)(p.in[I_MNORM] + l * 512 + c0 + 4);
#pragma unroll
        for (int e = 0; e < 8; ++e) { o[e] = bf2f((bf16_t)of[e]) + bf2f((bf16_t)ob[e]); ss += o[e] * o[e]; }
        ss += SHX(ss, 1); ss += SHX(ss, 2); ss += SHX(ss, 4); ss += SHX(ss, 8);
        const float rsd = rsqrtf(ss * (1.0f / 128.f) + 1e-6f);
        bf16x8 ov;
#pragma unroll
        for (int e = 0; e < 8; ++e) ov[e] = (short)f2bf(o[e] * rsd * (e < 4 ? nw0[e & 3] : nw1[e & 3]) * sigmoidf_(bf2f((bf16_t)mov[e])));
        *(bf16x8*)zm_ = ov;
      }
    }
    __syncthreads();
#pragma unroll 1
    for (int jj = 0; jj < 4; ++jj) tok_one(p, l, 3, tok0 + w * 4 + jj, lane);
  }
}

#define XB_TMO      128
#define XB_XCNT(j)  (256  + 64 * (j))
#define XB_XSUB(j)  (1280 + 64 * (j))
#define XB_XGEN(j)  (2304 + 64 * (j))
#define XB_TOP      3328
#define XB_TOPGEN   3392
#define XCD_BAR_WORDS 3456
#define XB_SPIN_CAP (1u << 20)
#define LAS __attribute__((address_space(3)))
DI unsigned xb_ld(unsigned* p)              { return __hip_atomic_load(p, __ATOMIC_RELAXED, __HIP_MEMORY_SCOPE_AGENT); }
DI unsigned xb_add(unsigned* p, unsigned v) { return __hip_atomic_fetch_add(p, v, __ATOMIC_RELAXED, __HIP_MEMORY_SCOPE_AGENT); }
DI unsigned xb_xcc_id() { return (unsigned)__builtin_amdgcn_s_getreg((3 << 11) | 20) & 0xFu; }
#define XB_SPIN(cond, bar) do { unsigned _sp = 0; while (cond) { __builtin_amdgcn_s_sleep(1); \
    if ((++_sp & 255u) == 0u) { if (xb_ld(&(bar)[XB_TMO])) break; if (_sp > XB_SPIN_CAP) { atomicAdd(&(bar)[XB_TMO], 1u); break; } } } } while (0)
struct XcdBarrier { unsigned* bar; unsigned x; volatile LAS unsigned* st; };
DI XcdBarrier xcd_barrier_post(const Params& p, unsigned* bar, volatile LAS unsigned* st) {
  XcdBarrier b; b.bar = bar; b.x = xb_xcc_id(); b.st = st;
  if (ltid() == 0) (void)xb_add(&bar[XB_XCNT(b.x)], 1u);
  return b;
}
DI void xcd_barrier_complete(unsigned* bar, unsigned x, unsigned& nloc, unsigned& nx) {
  const unsigned G = gridDim.x * gridDim.y * gridDim.z;
  unsigned sum, cnt, mine, sp = 0u;
  for (;;) {
    sum = 0u; cnt = 0u; mine = 0u;
#pragma unroll
    for (unsigned j = 0; j < 16; ++j) { const unsigned c = xb_ld(&bar[XB_XCNT(j)]); sum += c; cnt += (c > 0u) ? 1u : 0u; mine = (j == x) ? c : mine; }
    if (sum == G) break;
    __builtin_amdgcn_s_sleep(1);
    if ((++sp & 255u) == 0u) { if (xb_ld(&bar[XB_TMO])) break; if (sp > XB_SPIN_CAP) { atomicAdd(&bar[XB_TMO], 1u); break; } }
  }
  nloc = mine > 0u ? mine : 1u; nx = cnt > 0u ? cnt : 1u;
}
DI void xcd_barrier(const Params& p, const XcdBarrier& b) {
  asm volatile("s_waitcnt vmcnt(0)" ::: "memory");
  __syncthreads();
  if (ltid() == 0) {
    unsigned* bar = b.bar;
    __builtin_amdgcn_s_waitcnt(0);
    unsigned nloc = b.st[0], nx = b.st[1];
    if (nloc == 0u) { xcd_barrier_complete(bar, b.x, nloc, nx); b.st[0] = nloc; b.st[1] = nx; }
    const unsigned old = xb_add(&bar[XB_XSUB(b.x)], 1u);
    const unsigned gen = old / nloc;
    if (old + 1u == (gen + 1u) * nloc) {
      __builtin_amdgcn_fence(__ATOMIC_RELEASE, "agent");
      asm volatile("s_waitcnt vmcnt(0)" ::: "memory");
      const unsigned og = xb_add(&bar[XB_TOP], 1u);
      const unsigned tg = og / nx;
      if (og + 1u == (tg + 1u) * nx) xb_add(&bar[XB_TOPGEN], 1u);
      else XB_SPIN(xb_ld(&bar[XB_TOPGEN]) == tg, bar);
      __builtin_amdgcn_fence(__ATOMIC_ACQUIRE, "agent");
      xb_add(&bar[XB_XGEN(b.x)], 1u);
      asm volatile("s_waitcnt vmcnt(0)" ::: "memory");
    } else {
      XB_SPIN(xb_ld(&bar[XB_XGEN(b.x)]) == gen, bar);
      __builtin_amdgcn_fence(__ATOMIC_ACQUIRE, "agent");
      asm volatile("s_waitcnt vmcnt(0)" ::: "memory");
    }
  }
  __syncthreads();
}

constexpr int NPHASE = 3 + 9 * 2;
DI void run_phase(const Params& p0, int ph, char* smem) {
  Params p = p0;
  asm volatile("" : "+s"(p.ws), "+s"(p.out));
  p.ws = as_global(p.ws); p.out = as_global(p.out);
  if (ph == 0) { phase0(p, smem); return; }
  if (ph == 1) { phase1(p); return; }
  if (ph == 2) { tok_phase(p, 0, 0); return; }
  const int l = (ph - 3) / 9, s = (ph - 3) % 9;
  switch (s) {
    case 0: phase_inproj(p, smem); break;
    case 1: phase_scan(p, l, smem); break;
    case 2: phase_combine(p, l, smem); break;
    case 3: phase_merge(p, l, smem); break;
    case 4: phase_gemm_f32(p, (const bf16_t*)(p.ws + OFF_MERGED), 1024, (const bf16_t*)(p.ws + OFF_WTOUT), smem); break;
    case 5: tok_phase(p, l, 1); break;
    case 6: phase_ffn_in(p, smem); break;
    case 7: phase_gemm_f32(p, (const bf16_t*)(p.ws + OFF_ACT), DFF, (const bf16_t*)(p.ws + OFF_WTFO), smem); break;
    case 8:
      tok_phase(p, l, 2);
      if (l + 1 < 2) {
        conv_weight(p, p.in[I_WIN] + (size_t)(l + 1) * 1024 * DIN, DIN, (bf16_t*)(p.ws + OFF_WTIN), 1024, WTIN_ROWS, 0, (float*)smem, blockIdx.x, gridDim.x);
        for (int br = 0; br < 3; ++br) conv_weight(p, p.in[I_WBR] + ((size_t)(l + 1) * 3 + br) * 512 * 1024, 1024, (bf16_t*)(p.ws + OFF_WTBR) + (size_t)br * 1024 * 512, 512, 1024, 1, (float*)smem, blockIdx.x, gridDim.x);
      }
      break;
  }
}

template <bool COOP>
__global__ void __launch_bounds__(NTHR, 2) mega(Params pk, int lo, int hi) {
  __shared__ __attribute__((aligned(16))) char smem[LDS_BYTES];
  Params p = pk;
#pragma unroll
  for (int i = 0; i < N_IN; ++i) p.in[i] = as_global(p.in[i]);
  p.ws = as_global(p.ws); p.out = as_global(p.out);
  p.wb = __builtin_amdgcn_readfirstlane((int)threadIdx.x) & ~63;
  if (COOP) {
    volatile LAS unsigned* st = (volatile LAS unsigned*)(smem + LDS_BYTES - 32);
    if (ltid() == 0) { st[0] = 0u; st[1] = 0u; }
    __syncthreads();
    phase0(p, smem);
    cg::this_grid().sync();
    XcdBarrier b = xcd_barrier_post(p, (unsigned*)(p.ws + OFF_BAR), st);
    if (ltid() == 0) {
      const unsigned hwid = (unsigned)__builtin_amdgcn_s_getreg((31 << 11) | 4);
      const unsigned key = (xb_xcc_id() << 8) | ((hwid >> 8) & 0xFFu);
      ((int*)smem)[(LDS_BYTES - 12) / 4] = (int)xb_add((unsigned*)(p.ws + OFF_ROLE) + key, 1u);
    }
    __syncthreads();
    p.role = __builtin_amdgcn_readfirstlane(((int*)smem)[(LDS_BYTES - 12) / 4]);
    for (int ph = 1; ph < hi; ++ph) {
      run_phase(p, ph, smem);
      if (ph + 1 < hi) xcd_barrier(p, b);
    }
  } else {
    for (int ph = lo; ph < hi; ++ph) run_phase(p, ph, smem);
  }
}

extern "C" void kernel_launch(void* const* d_in, const int* in_sizes, int n_in, void* d_out, int out_size, void* d_ws, size_t ws_size, hipStream_t stream) {
  Params p{};
  for (int i = 0; i < N_IN; ++i) p.in[i] = (const float*)d_in[i];
  p.out = (float*)d_out; p.ws = (char*)d_ws;
  if (ws_size < WS_NEED) fprintf(stderr, "workspace too small: %zu < %zu\n", ws_size, (size_t)WS_NEED);
  static int grid_blocks = 0;
  if (!grid_blocks) {
    int dev = 0, cus = 0, per_cu = 0;
    hipGetDevice(&dev);
    hipDeviceGetAttribute(&cus, hipDeviceAttributeMultiprocessorCount, dev);
    hipOccupancyMaxActiveBlocksPerMultiprocessor(&per_cu, mega<true>, NTHR, 0);
    if (per_cu > 2) per_cu = 2;
    grid_blocks = cus * per_cu;
  }
  int lo = 0, hi = NPHASE;
  void* args[] = {&p, &lo, &hi};
  hipError_t e = hipLaunchCooperativeKernel((void*)mega<true>, dim3(grid_blocks), dim3(NTHR), args, 0, stream);
  if (e != hipSuccess) fprintf(stderr, "cooperative launch failed: %s (grid %d)\n", hipGetErrorString(e), grid_blocks);
}
```

```cpp
#include <hip/hip_runtime.h>
#include <hip/hip_cooperative_groups.h>
#include <cstdio>
namespace cg = cooperative_groups;

typedef unsigned short bf16_t;
typedef short bf16x8 __attribute__((ext_vector_type(8)));
typedef float f32x4 __attribute__((ext_vector_type(4)));
typedef float f32x2 __attribute__((ext_vector_type(2)));
typedef float f32x16 __attribute__((ext_vector_type(16)));
typedef unsigned short u16x4 __attribute__((ext_vector_type(4)));
typedef unsigned short u16x2 __attribute__((ext_vector_type(2)));
typedef unsigned u32x4 __attribute__((ext_vector_type(4)));
typedef unsigned u32x2 __attribute__((ext_vector_type(2)));
static __device__ __forceinline__ unsigned pk2(float lo, float hi) { typedef __bf16 b2 __attribute__((ext_vector_type(2))); typedef float f2 __attribute__((ext_vector_type(2))); return __builtin_bit_cast(unsigned, __builtin_convertvector((f2){lo, hi}, b2)); }

#define DI __device__ __forceinline__
#define GAS __attribute__((address_space(1)))
template <class T> static __device__ __forceinline__ T* as_global(T* q) { return (T*)(GAS T*)(unsigned long long)q; }

constexpr int NT = 16384;
constexpr int DM = 1024;
constexpr int NTHR = 256;
constexpr int DIN = 9616;
constexpr int ZHW = 2560, ZRW = 1920, ZMW = 2048;
constexpr int WTIN_ROWS = 9728;
constexpr int DFF = 2816;

constexpr size_t OFF_WTIN = 0;
constexpr size_t OFF_WTBR = OFF_WTIN + (size_t)WTIN_ROWS * 1024 * 2;
constexpr size_t OFF_H    = OFF_WTBR + (size_t)3 * 1024 * 512 * 2;
constexpr size_t OFF_ZH   = OFF_H + (size_t)NT * 1024 * 2;
constexpr size_t OFF_ZR   = OFF_ZH + (size_t)NT * ZHW * 2;
constexpr size_t OFF_ZM   = OFF_ZR + (size_t)NT * ZRW * 2;
constexpr size_t OFF_MG   = OFF_ZM + (size_t)NT * ZMW * 2;
constexpr size_t OFF_O    = OFF_MG + (size_t)NT * 16 * 4;
constexpr size_t OFF_MOD  = OFF_O + (size_t)NT * 1024 * 2;
constexpr size_t OFF_LBS  = OFF_MOD + (size_t)2 * 5 * 6144 * 4;
constexpr size_t OFF_CTR  = OFF_LBS + 2 * 512 * 4;
constexpr size_t OFF_BAR  = OFF_CTR + 256;
constexpr size_t OFF_ROLE = OFF_BAR + 3456 * 4;
constexpr size_t WS_NEED  = OFF_ROLE + 4096 * 4;
constexpr size_t OFF_MODP = OFF_ZH;
constexpr size_t OFF_WTOUT = OFF_ZR;
constexpr size_t OFF_WTFI  = OFF_WTOUT + (size_t)1024 * 1024 * 2;
constexpr size_t OFF_WTFO  = OFF_WTFI + (size_t)5632 * 1024 * 2;
constexpr size_t OFF_MERGED = OFF_WTFO + (size_t)1024 * 2816 * 2;
constexpr size_t OFF_Y    = OFF_ZH;
constexpr size_t OFF_ACT  = OFF_ZM;

constexpr size_t OUT_HG = 16777216, OUT_RW = 25165824, OUT_C = 29360128, OUT_N = 37748736, OUT_M = 37814272;

enum { I_XP = 0, I_XS, I_SH, I_SR, I_SC, I_SN, I_SM, I_C, I_CCTX, I_WADA, I_BADA, I_NORMS, I_WIN, I_HLB, I_HNORM, I_MU, I_W0, I_W2,
       I_A0, I_A2, I_G2, I_KK, I_KA, I_RK, I_LN, I_GB, I_MNORM, I_WBR, I_WOUT, I_WFI, I_WFO, N_IN };

struct Params { const float* in[N_IN]; float* out; char* ws; int wb; int role; };

constexpr int LDS_BYTES = 77824;

DI bf16_t f2bf(float f) { return __builtin_bit_cast(unsigned short, (__bf16)f); }
DI float bf2f(bf16_t h) { return __uint_as_float(((unsigned)h) << 16); }
DI float sigmoidf_(float x) { return 1.0f / (1.0f + __expf(-x)); }
DI float siluf_(float x) { return x / (1.0f + __expf(-x)); }
DI float softplusf_(float x) { return x > 20.f ? x : __logf(1.0f + __expf(x)); }
DI float dpp_xor1(float x) { return __int_as_float(__builtin_amdgcn_mov_dpp(__float_as_int(x), 0xB1, 0xF, 0xF, true)); }
DI float dpp_xor2(float x) { return __int_as_float(__builtin_amdgcn_mov_dpp(__float_as_int(x), 0x4E, 0xF, 0xF, true)); }
DI float shfl_lane(float v, int src) { return __int_as_float(__builtin_amdgcn_ds_bpermute(src << 2, __float_as_int(v))); }
#define SHX(v, m) shfl_lane((v), lane ^ (m))
DI float wave_sum(float v, int lane) { v += dpp_xor1(v); v += dpp_xor2(v); v += SHX(v, 4); v += SHX(v, 8); v += SHX(v, 16); v += SHX(v, 32); return v; }
DI int ltid_(int wb) { int t = wb + (int)__builtin_amdgcn_mbcnt_hi(~0u, __builtin_amdgcn_mbcnt_lo(~0u, 0u)); asm volatile("" : "+v"(t)); return t; }
#define ltid() ltid_(p.wb)
DI int crow(int reg, int h) { return (reg & 3) + 8 * (reg >> 2) + 4 * h; }

DI int tok_cond(int tok) { return tok < 8192 ? 0 : 1 + ((tok - 8192) >> 11); }
DI const float* x_in_row(const Params& p, int tok) { return tok < 8192 ? p.in[I_XP] + (size_t)tok * DM : p.in[I_XS] + (size_t)(tok - 8192) * DM; }

DI void mma32(f32x16& acc, const bf16_t* A, int lda, const bf16_t* B, int ldb, int K, int lane) {
  const int r = lane & 31, h = lane >> 5;
#pragma unroll 2
  for (int kk = 0; kk < K; kk += 16) {
    bf16x8 a = *(const bf16x8*)(A + r * lda + kk + 8 * h);
    bf16x8 b = *(const bf16x8*)(B + r * ldb + kk + 8 * h);
    acc = __builtin_amdgcn_mfma_f32_32x32x16_bf16(a, b, acc, 0, 0, 0);
  }
}

template <int BM, int BN, int BK, bool WR, bool LD>
DI void gemm_ktile(f32x4 (&acc)[BM / 32][BN / 32], bf16x8 (&ra)[BM * BK / 2048], bf16x8 (&rb)[BN * BK / 2048],
                   const bf16_t* __restrict__ A, int lda, const bf16_t* __restrict__ B, int ldb, int k2,
                   const bf16_t* as, const bf16_t* bs, bf16_t* Aw, bf16_t* Bw) {
  constexpr int MI = BM / 32, NJ = BN / 32, LS = BK + 8, ACH = BM * BK / 2048, BCH = BN * BK / 2048, KS = BK / 32, RPI = 256 / (BK / 8);
  static_assert(KS * MI >= ACH + BCH, "not enough MFMA row blocks to carry the staging");
  __builtin_amdgcn_s_setprio(1);
#pragma unroll
  for (int ks = 0; ks < KS; ++ks) {
    bf16x8 bfr[NJ];
#pragma unroll
    for (int j = 0; j < NJ; ++j) bfr[j] = *(const bf16x8*)(bs + j * 16 * LS + ks * 32);
    bf16x8 afn = *(const bf16x8*)(as + ks * 32);
#pragma unroll
    for (int i = 0; i < MI; ++i) {
      const bf16x8 af = afn;
      if (i + 1 < MI) afn = *(const bf16x8*)(as + (i + 1) * 16 * LS + ks * 32);
#pragma unroll
      for (int j = 0; j < NJ; ++j) acc[i][j] = __builtin_amdgcn_mfma_f32_16x16x32_bf16(bfr[j], af, acc[i][j], 0, 0, 0);
      const int s = ks * MI + i;
      if (s < ACH) {
        if (WR) *(bf16x8*)(Aw + RPI * s * LS) = ra[s < ACH ? s : 0];
        if (LD) ra[s < ACH ? s : 0] = *(const bf16x8*)(A + (size_t)(RPI * s) * lda + k2);
      } else if (s < ACH + BCH) {
        const int c = s - ACH;
        if (WR) *(bf16x8*)(Bw + RPI * c * LS) = rb[(c >= 0 && c < BCH) ? c : 0];
        if (LD) rb[(c >= 0 && c < BCH) ? c : 0] = *(const bf16x8*)(B + (size_t)(RPI * c) * ldb + k2);
      }
      __builtin_amdgcn_sched_barrier(0);
    }
  }
  __builtin_amdgcn_s_setprio(0);
}

template <int BM, int BN, int BK>
DI void gemm_main(const Params& p, f32x4 (&acc)[BM / 32][BN / 32], const bf16_t* __restrict__ A, int lda, const bf16_t* __restrict__ B, int ldb, int K, bf16_t* sm) {
  constexpr int LS = BK + 8, CPR = BK / 8, ACH = BM * BK / 2048, BCH = BN * BK / 2048, RPI = 256 / CPR;
  const int tid = ltid(), lane = tid & 63, w = tid >> 6, wm = w >> 1, wn = w & 1;
  bf16_t* As = sm; bf16_t* Bs = sm + 2 * BM * LS;
  bf16x8 ra[ACH], rb[BCH];
  const int nk = K / BK;
  const int lrow = tid / CPR, lkc = (tid % CPR) * 8;
  const bf16_t* Ag = A + (size_t)lrow * lda + lkc;
  const bf16_t* Bg = B + (size_t)lrow * ldb + lkc;
  bf16_t* Al = As + lrow * LS + lkc; bf16_t* Bl = Bs + lrow * LS + lkc;
#pragma unroll
  for (int i = 0; i < ACH; ++i) ra[i] = *(const bf16x8*)(Ag + (size_t)(RPI * i) * lda);
#pragma unroll
  for (int i = 0; i < BCH; ++i) rb[i] = *(const bf16x8*)(Bg + (size_t)(RPI * i) * ldb);
  __syncthreads();
#pragma unroll
  for (int i = 0; i < ACH; ++i) *(bf16x8*)(Al + RPI * i * LS) = ra[i];
#pragma unroll
  for (int i = 0; i < BCH; ++i) *(bf16x8*)(Bl + RPI * i * LS) = rb[i];
  if (nk > 1) {
#pragma unroll
    for (int i = 0; i < ACH; ++i) ra[i] = *(const bf16x8*)(Ag + (size_t)(RPI * i) * lda + BK);
#pragma unroll
    for (int i = 0; i < BCH; ++i) rb[i] = *(const bf16x8*)(Bg + (size_t)(RPI * i) * ldb + BK);
  }
  __syncthreads();
  const bf16_t* as0 = As + (wm * (BM / 2) + (lane & 15)) * LS + (lane >> 4) * 8;
  const bf16_t* bs0 = Bs + (wn * (BN / 2) + (lane & 15)) * LS + (lane >> 4) * 8;
  int kt = 0;
  for (; kt + 2 < nk; ++kt) {
    const int buf = kt & 1, nb = buf ^ 1;
    gemm_ktile<BM, BN, BK, true, true>(acc, ra, rb, Ag, lda, Bg, ldb, (kt + 2) * BK, as0 + buf * BM * LS, bs0 + buf * BN * LS, Al + nb * BM * LS, Bl + nb * BN * LS);
    __syncthreads();
  }
  for (; kt < nk; ++kt) {
    const int buf = kt & 1, nb = buf ^ 1;
    if (kt + 1 < nk) gemm_ktile<BM, BN, BK, true, false>(acc, ra, rb, Ag, lda, Bg, ldb, 0, as0 + buf * BM * LS, bs0 + buf * BN * LS, Al + nb * BM * LS, Bl + nb * BN * LS);
    else gemm_ktile<BM, BN, BK, false, false>(acc, ra, rb, Ag, lda, Bg, ldb, 0, as0 + buf * BM * LS, bs0 + buf * BN * LS, Al + nb * BM * LS, Bl + nb * BN * LS);
    __syncthreads();
  }
}

template <int MI, int NJ> DI void zero_acc(f32x4 (&acc)[MI][NJ]) {
#pragma unroll
  for (int i = 0; i < MI; ++i)
#pragma unroll
    for (int j = 0; j < NJ; ++j) acc[i][j] = (f32x4){0.f, 0.f, 0.f, 0.f};
}
DI void store_bf4(bf16_t* dst, f32x4 v) { u16x4 o; o[0] = f2bf(v[0]); o[1] = f2bf(v[1]); o[2] = f2bf(v[2]); o[3] = f2bf(v[3]); *(u16x4*)dst = o; }

DI int map_col(int mode, int n) {
  if (mode == 0) return n < 6544 ? n : (n < 6656 ? -1 : n - 112);
  if (mode == 2) return ((n >> 4) & 1) ? DFF + (n >> 5) * 16 + (n & 15) : (n >> 5) * 16 + (n & 15);
  return n;
}
DI void conv_tile(const Params& p, const float* __restrict__ src, int ld_src, bf16_t* __restrict__ dst, int K, int mode, int tk, int tn, float* sm) {
  const int tid = ltid();
  __syncthreads();
  {
    const int nn = tid & 63, col = map_col(mode, tn * 64 + nn);
#pragma unroll
    for (int i = 0; i < 16; ++i) { int kk = (tid >> 6) + 4 * i; sm[kk * 65 + nn] = col >= 0 ? src[(size_t)(tk * 64 + kk) * ld_src + col] : 0.f; }
  }
  __syncthreads();
  {
    const int kk = tid & 63;
#pragma unroll
    for (int i = 0; i < 16; ++i) { int nn = (tid >> 6) + 4 * i; dst[(size_t)(tn * 64 + nn) * K + tk * 64 + kk] = f2bf(sm[kk * 65 + nn]); }
  }
}
DI void conv_weight(const Params& p, const float* src, int ld_src, bf16_t* dst, int K, int Ndst, int mode, float* sm, int bid, int nb) {
  const int tkn = K / 64, nt = tkn * (Ndst / 64);
  for (int t = bid; t < nt; t += nb) conv_tile(p, src, ld_src, dst, K, mode, t % tkn, t / tkn, sm);
}

DI void phase0(const Params& p, char* smem) {
  const int tid = ltid(), bid = blockIdx.x, nb = gridDim.x;
  float* MODP = (float*)(p.ws + OFF_MODP);
  float* sm = (float*)smem;
  if (bid == 0) { if (tid < 64) ((int*)(p.ws + OFF_CTR))[tid] = 0; for (int i = tid; i < 3456; i += NTHR) ((unsigned*)(p.ws + OFF_BAR))[i] = 0u; for (int i = tid; i < 4096; i += NTHR) ((unsigned*)(p.ws + OFF_ROLE))[i] = 0u; }
  for (int i = bid * NTHR + tid; i < 512; i += nb * NTHR) {
    float a = p.in[I_HLB][i], b = p.in[I_HLB][512 + i];
    float* L = (float*)(p.ws + OFF_LBS); L[i] = 0.f; L[512 + i] = 1.0f / (1.0f + expf(a - b));
  }
  for (int it = bid; it < 2 * 24 * 16; it += nb) {
    const int ks = it & 15, jb = (it >> 4) % 24, l = it / (16 * 24);
    __syncthreads();
    for (int e = tid; e < 5 * 64; e += NTHR) { int ci = e >> 6, k = ks * 64 + (e & 63); float cv = ci == 0 ? p.in[I_CCTX][k] : p.in[I_C][(ci - 1) * DM + k]; sm[e] = siluf_(cv); }
    __syncthreads();
    const int j = jb * 256 + tid;
    float a0 = 0, a1 = 0, a2 = 0, a3 = 0, a4 = 0;
    const float* W = p.in[I_WADA] + ((size_t)l * DM + ks * 64) * 6144 + j;
#pragma unroll 1
    for (int k0 = 0; k0 < 64; k0 += 16) {
      float wv[16];
#pragma unroll
      for (int u = 0; u < 16; ++u) wv[u] = W[(size_t)(k0 + u) * 6144];
#pragma unroll
      for (int u = 0; u < 16; ++u) { const int k = k0 + u; const float w = wv[u]; a0 += sm[k] * w; a1 += sm[64 + k] * w; a2 += sm[128 + k] * w; a3 += sm[192 + k] * w; a4 += sm[256 + k] * w; }
    }
    float* dst = MODP + ((size_t)(ks * 2 + l) * 5) * 6144 + j;
    dst[0] = a0; dst[6144] = a1; dst[2 * 6144] = a2; dst[3 * 6144] = a3; dst[4 * 6144] = a4;
  }
  conv_weight(p, p.in[I_WIN], DIN, (bf16_t*)(p.ws + OFF_WTIN), 1024, WTIN_ROWS, 0, sm, bid, nb);
  for (int br = 0; br < 3; ++br) conv_weight(p, p.in[I_WBR] + (size_t)br * 512 * 1024, 1024, (bf16_t*)(p.ws + OFF_WTBR) + (size_t)br * 1024 * 512, 512, 1024, 1, sm, bid, nb);
}
DI void phase1(const Params& p) {
  const float* MODP = (const float*)(p.ws + OFF_MODP);
  float* MOD = (float*)(p.ws + OFF_MOD);
  for (int i = blockIdx.x * NTHR + ltid(); i < 2 * 5 * 6144; i += gridDim.x * NTHR) {
    const int j = i % 6144, l = i / (5 * 6144);
    float s = p.in[I_BADA][l * 6144 + j];
    for (int ks = 0; ks < 16; ++ks) s += MODP[(size_t)ks * 2 * 5 * 6144 + i];
    MOD[i] = s;
  }
}

DI void norm_mod_store(const f32x4 (&x)[4], const float* nw, const float* sc, const float* sh, bf16_t* hrow, int lane) {
  float ss = 0.f;
#pragma unroll
  for (int i = 0; i < 4; ++i) ss += x[i][0] * x[i][0] + x[i][1] * x[i][1] + x[i][2] * x[i][2] + x[i][3] * x[i][3];
  ss = wave_sum(ss, lane);
  const float rs = rsqrtf(ss * (1.0f / DM) + 1e-6f);
#pragma unroll
  for (int i = 0; i < 4; ++i) {
    const int c = i * 256 + lane * 4;
    f32x4 w = *(const f32x4*)(nw + c), s1 = *(const f32x4*)(sc + c), s0 = *(const f32x4*)(sh + c), o;
#pragma unroll
    for (int e = 0; e < 4; ++e) o[e] = x[i][e] * rs * w[e] * (1.0f + s1[e]) + s0[e];
    store_bf4(hrow + c, o);
  }
}
DI void tok_one(const Params& p, int l, int mode, int tok, int lane) {
  const float* MOD = (const float*)(p.ws + OFF_MOD);
  bf16_t* H = (bf16_t*)(p.ws + OFF_H);
  const float* Y = (const float*)(p.ws + OFF_Y);
  const int ci = tok_cond(tok);
  const float* modl = MOD + (size_t)(l * 5 + ci) * 6144;
  const float* nwl = p.in[I_NORMS] + (size_t)l * 4 * DM;
  const bool from_in = (l == 0 && (mode == 0 || mode == 1 || mode == 3));
  const float* xr = from_in ? x_in_row(p, tok) : p.out + (size_t)tok * DM;
  const bool has_y = (mode == 1 || mode == 2);
  const bool has_h = !(mode == 2 && l + 1 >= 2);
  const float* modn = (mode == 2 && has_h) ? MOD + (size_t)((l + 1) * 5 + ci) * 6144 : modl;
  const float* nw2 = mode == 1 ? nwl + 2 * DM : (mode == 2 ? p.in[I_NORMS] + (size_t)(has_h ? l + 1 : l) * 4 * DM : nwl);
  const float* sc2 = mode == 1 ? modl + 4 * DM : modn + 1 * DM;
  const float* sh2 = mode == 1 ? modl + 3 * DM : modn + 0 * DM;
  const float* nwy = nwl + (mode == 1 ? 1 : 3) * DM;
  const float* gy = modl + (mode == 1 ? 2 : 5) * DM;
  f32x4 x[4], y[4], wy[4], gg[4], w2[4], s1[4], s0[4];
#pragma unroll
  for (int i = 0; i < 4; ++i) {
    const int c = i * 256 + lane * 4;
    x[i] = *(const f32x4*)(xr + c);
    if (has_y) { y[i] = *(const f32x4*)(Y + (size_t)tok * DM + c); wy[i] = *(const f32x4*)(nwy + c); gg[i] = *(const f32x4*)(gy + c); }
    if (has_h) { w2[i] = *(const f32x4*)(nw2 + c); s1[i] = *(const f32x4*)(sc2 + c); s0[i] = *(const f32x4*)(sh2 + c); }
  }
  if (has_y) {
    float ss = 0.f;
#pragma unroll
    for (int i = 0; i < 4; ++i) ss += y[i][0] * y[i][0] + y[i][1] * y[i][1] + y[i][2] * y[i][2] + y[i][3] * y[i][3];
    ss = wave_sum(ss, lane);
    const float rs = rsqrtf(ss * (1.0f / DM) + 1e-6f);
#pragma unroll
    for (int i = 0; i < 4; ++i) {
      const int c = i * 256 + lane * 4;
#pragma unroll
      for (int e = 0; e < 4; ++e) x[i][e] += gg[i][e] * (y[i][e] * rs * wy[i][e]);
      *(f32x4*)(p.out + (size_t)tok * DM + c) = x[i];
    }
  }
  if (has_h) {
    float ss = 0.f;
#pragma unroll
    for (int i = 0; i < 4; ++i) ss += x[i][0] * x[i][0] + x[i][1] * x[i][1] + x[i][2] * x[i][2] + x[i][3] * x[i][3];
    ss = wave_sum(ss, lane);
    const float rs = rsqrtf(ss * (1.0f / DM) + 1e-6f);
#pragma unroll
    for (int i = 0; i < 4; ++i) {
      f32x4 o;
#pragma unroll
      for (int e = 0; e < 4; ++e) o[e] = x[i][e] * rs * w2[i][e] * (1.0f + s1[i][e]) + s0[i][e];
      store_bf4(H + (size_t)tok * DM + i * 256 + lane * 4, o);
    }
  }
}
DI void tok_phase(const Params& p, int l, int mode) {
  const int lane = ltid() & 63, gw = blockIdx.x * 4 + (ltid() >> 6), nw = gridDim.x * 4;
  for (int tok = gw; tok < NT; tok += nw) tok_one(p, l, mode, tok, lane);
}

DI bool tile_xcd(int i, int NTN, int MTX, int& mt, int& nt) {
  const int G = gridDim.x, b = blockIdx.x, x = b & 7, j = b >> 3, nbx = (G - x + 7) >> 3;
  const int u = j + i * nbx;
  if (u >= MTX * NTN) return false;
  mt = MTX * x + (u % MTX); nt = u / MTX;
  return true;
}
DI void phase_inproj(const Params& p, char* smem) {
  const bf16_t* H = (const bf16_t*)(p.ws + OFF_H);
  const bf16_t* WT = (const bf16_t*)(p.ws + OFF_WTIN);
  bf16_t* ZH = (bf16_t*)(p.ws + OFF_ZH); bf16_t* ZR = (bf16_t*)(p.ws + OFF_ZR); bf16_t* ZM = (bf16_t*)(p.ws + OFF_ZM);
  float* MG = (float*)(p.ws + OFF_MG);
  const int lane = ltid() & 63, w = ltid() >> 6, wm = w >> 1, wn = w & 1;
  int mt, nt;
  for (int ti = 0; tile_xcd(ti, 52, 8, mt, nt); ++ti) {
    f32x4 acc[8][4]; zero_acc<8, 4>(acc);
    gemm_main<256, 128, 32>(p, acc, H + (size_t)mt * 256 * 1024, 1024, WT + (size_t)nt * 128 * 1024, 1024, 1024, (bf16_t*)smem);
    const int n0 = nt * 128;
#pragma unroll
    for (int i = 0; i < 8; ++i) {
      const int row = mt * 256 + wm * 128 + i * 16 + (lane & 15);
#pragma unroll
      for (int j = 0; j < 4; ++j) {
        const int col = n0 + wn * 64 + j * 16 + 4 * (lane >> 4);
        if (n0 < 2560) store_bf4(ZH + (size_t)row * ZHW + col, acc[i][j]);
        else if (n0 < 4480) store_bf4(ZR + (size_t)row * ZRW + (col - 2560), acc[i][j]);
        else if (n0 < 6528) store_bf4(ZM + (size_t)row * ZMW + (col - 4480), acc[i][j]);
        else if (col - 6528 < 16) *(f32x4*)(MG + (size_t)row * 16 + (col - 6528)) = acc[i][j];
      }
    }
  }
}

DI void phase_merge(const Params& p, int l, char* smem) {
  const bf16_t* H = (const bf16_t*)(p.ws + OFF_H);
  const bf16_t* WT = (const bf16_t*)(p.ws + OFF_WTIN);
  const bf16_t* WBR = (const bf16_t*)(p.ws + OFF_WTBR);
  const bf16_t* ZH = (const bf16_t*)(p.ws + OFF_ZH); const bf16_t* ZM = (const bf16_t*)(p.ws + OFF_ZM); const bf16_t* O = (const bf16_t*)(p.ws + OFF_O);
  bf16_t* MER = (bf16_t*)(p.ws + OFF_MERGED);
  const int lane = ltid() & 63, w = ltid() >> 6, wm = w >> 1, wn = w & 1;
  int mt, nt;
  for (int ti = 0; tile_xcd(ti, 16, 16, mt, nt); ++ti) {
    f32x4 accM[4][2]; zero_acc<4, 2>(accM);
#pragma unroll 1
    for (int br = 0; br < 3; ++br) {
      f32x4 accG[4][2], accP[4][2]; zero_acc<4, 2>(accG); zero_acc<4, 2>(accP);
      gemm_main<128, 64, 64>(p, accG, H + (size_t)mt * 128 * 1024, 1024, WT + (size_t)(6656 + br * 1024 + nt * 64) * 1024, 1024, 1024, (bf16_t*)smem);
      const bf16_t* Ab; int lda;
      if (br == 0) { Ab = ZH + 2048; lda = ZHW; } else if (br == 1) { Ab = O; lda = 1024; } else { Ab = ZM + 1536; lda = ZMW; }
      gemm_main<128, 64, 64>(p, accP, Ab + (size_t)mt * 128 * lda, lda, WBR + ((size_t)br * 1024 + nt * 64) * 512, 512, 512, (bf16_t*)smem);
#pragma unroll
      for (int i = 0; i < 4; ++i)
#pragma unroll
        for (int j = 0; j < 2; ++j)
#pragma unroll
          for (int e = 0; e < 4; ++e) accM[i][j][e] += sigmoidf_(accG[i][j][e]) * accP[i][j][e];
    }
#pragma unroll
    for (int i = 0; i < 4; ++i) {
      const int row = mt * 128 + wm * 64 + i * 16 + (lane & 15);
#pragma unroll
      for (int j = 0; j < 2; ++j) store_bf4(MER + (size_t)row * 1024 + nt * 64 + wn * 32 + j * 16 + 4 * (lane >> 4), accM[i][j]);
    }
  }
  float* sm = (float*)smem;
  conv_weight(p, p.in[I_WOUT] + (size_t)l * 1024 * 1024, 1024, (bf16_t*)(p.ws + OFF_WTOUT), 1024, 1024, 1, sm, blockIdx.x, gridDim.x);
  conv_weight(p, p.in[I_WFI] + (size_t)l * 1024 * 5632, 5632, (bf16_t*)(p.ws + OFF_WTFI), 1024, 5632, 2, sm, blockIdx.x, gridDim.x);
  conv_weight(p, p.in[I_WFO] + (size_t)l * DFF * 1024, 1024, (bf16_t*)(p.ws + OFF_WTFO), DFF, 1024, 1, sm, blockIdx.x, gridDim.x);
}

DI void phase_gemm_f32(const Params& p, const bf16_t* A, int K, const bf16_t* Wt, char* smem) {
  float* Y = (float*)(p.ws + OFF_Y);
  const int lane = ltid() & 63, w = ltid() >> 6, wm = w >> 1, wn = w & 1;
  int mt, nt;
  for (int ti = 0; tile_xcd(ti, 8, 8, mt, nt); ++ti) {
    f32x4 acc[8][4]; zero_acc<8, 4>(acc);
    gemm_main<256, 128, 32>(p, acc, A + (size_t)mt * 256 * K, K, Wt + (size_t)nt * 128 * K, K, K, (bf16_t*)smem);
#pragma unroll
    for (int i = 0; i < 8; ++i) {
      const int row = mt * 256 + wm * 128 + i * 16 + (lane & 15);
#pragma unroll
      for (int j = 0; j < 4; ++j) *(f32x4*)(Y + (size_t)row * 1024 + nt * 128 + wn * 64 + j * 16 + 4 * (lane >> 4)) = acc[i][j];
    }
  }
}
DI void phase_ffn_in(const Params& p, char* smem) {
  const bf16_t* H = (const bf16_t*)(p.ws + OFF_H);
  const bf16_t* Wt = (const bf16_t*)(p.ws + OFF_WTFI);
  bf16_t* ACT = (bf16_t*)(p.ws + OFF_ACT);
  const int lane = ltid() & 63, w = ltid() >> 6, wm = w >> 1, wn = w & 1;
  int mt, nt;
  for (int ti = 0; tile_xcd(ti, 44, 8, mt, nt); ++ti) {
    f32x4 acc[8][4]; zero_acc<8, 4>(acc);
    gemm_main<256, 128, 32>(p, acc, H + (size_t)mt * 256 * 1024, 1024, Wt + (size_t)nt * 128 * 1024, 1024, 1024, (bf16_t*)smem);
#pragma unroll
    for (int i = 0; i < 8; ++i) {
      const int row = mt * 256 + wm * 128 + i * 16 + (lane & 15);
#pragma unroll
      for (int jj = 0; jj < 2; ++jj) {
        f32x4 u = acc[i][2 * jj], g = acc[i][2 * jj + 1], o;
#pragma unroll
        for (int e = 0; e < 4; ++e) o[e] = siluf_(g[e]) * u[e];
        const int col = (nt * 128 + wn * 64 + jj * 32) / 2 + 4 * (lane >> 4);
        store_bf4(ACT + (size_t)row * DFF + col, o);
      }
    }
  }
}

struct Seq { int base, T, grid, b; bool sample; };
DI Seq get_seq(int s) { Seq q; if (s < 32) { q.base = s * 256; q.T = 256; q.grid = 0; q.b = s; q.sample = false; } else { q.b = s - 32; q.base = 8192 + q.b * 2048; q.T = 2048; q.grid = 1; q.sample = true; } return q; }

DI float rw_shift(const bf16_t* ZR, const float* mu, int base, int t, int T, int grid, int col) {
  const bf16_t* pp = ZR + (size_t)(base + t) * ZRW + col;
  const float y = bf2f(*pp);
  if (!grid) {
    const float prev = t > 0 ? bf2f(pp[-ZRW]) : 0.f, nxt = t < T - 1 ? bf2f(pp[ZRW]) : 0.f;
    return y + mu[col] * (prev - y) + mu[ZRW + col] * (nxt - y);
  }
  const int gc = t & 63, gr = t >> 6;
  const float left = gc > 0 ? bf2f(pp[-ZRW]) : 0.f, right = gc < 63 ? bf2f(pp[ZRW]) : 0.f;
  const float up = gr > 0 ? bf2f(pp[-64 * ZRW]) : 0.f, down = gr < 31 ? bf2f(pp[64 * ZRW]) : 0.f;
  return y + mu[col] * (left - y) + mu[ZRW + col] * (right - y) + mu[2 * ZRW + col] * (up - y) + mu[3 * ZRW + col] * (down - y);
}

DI void rw_shift8(const bf16_t* ZR, const float* mu, int base, int t, int T, int grid, int col0, float (&out)[8]) {
  const bf16_t* pp = ZR + (size_t)(base + t) * ZRW + col0;
  const bf16x8 y = *(const bf16x8*)pp;
  float yv[8];
#pragma unroll
  for (int e = 0; e < 8; ++e) { yv[e] = bf2f((bf16_t)y[e]); out[e] = yv[e]; }
  const int nn = grid ? 4 : 2;
#pragma unroll 1
  for (int n = 0; n < nn; ++n) {
    bool valid; int off;
    if (!grid) { valid = n == 0 ? t > 0 : t < T - 1; off = n == 0 ? -ZRW : ZRW; }
    else { const int gc = t & 63, gr = t >> 6; valid = n == 0 ? gc > 0 : n == 1 ? gc < 63 : n == 2 ? gr > 0 : gr < 31; off = n == 0 ? -ZRW : n == 1 ? ZRW : n == 2 ? -64 * ZRW : 64 * ZRW; }
    const f32x4 m0 = *(const f32x4*)(mu + n * ZRW + col0), m1 = *(const f32x4*)(mu + n * ZRW + col0 + 4);
    bf16x8 nb = y;
    if (valid) nb = *(const bf16x8*)(pp + off);
#pragma unroll
    for (int e = 0; e < 8; ++e) { const float nv_ = valid ? bf2f((bf16_t)nb[e]) : 0.f; const float mm = e < 4 ? m0[e & 3] : m1[e & 3]; out[e] += mm * (nv_ - yv[e]); }
  }
}

DI void rw_load8(const bf16_t* ZR, int base, int t, int T, int grid, int col0, bf16x8 (&v)[5]) {
  const bf16_t* pp = ZR + (size_t)(base + t) * ZRW + col0;
  const int gc = t & 63, gr = t >> 6;
  const int o1 = grid ? (gc > 0 ? -ZRW : 0) : (t > 0 ? -ZRW : 0);
  const int o2 = grid ? (gc < 63 ? ZRW : 0) : (t < T - 1 ? ZRW : 0);
  v[0] = *(const bf16x8*)pp;
  v[1] = *(const bf16x8*)(pp + o1);
  v[2] = *(const bf16x8*)(pp + o2);
  if (grid) {
    v[3] = *(const bf16x8*)(pp + (gr > 0 ? -64 * ZRW : 0)); v[4] = *(const bf16x8*)(pp + (gr < 31 ? 64 * ZRW : 0));
  } else {
    v[3] = (bf16x8){0, 0, 0, 0, 0, 0, 0, 0}; v[4] = (bf16x8){0, 0, 0, 0, 0, 0, 0, 0};
  }
}
DI unsigned rw_valid(int t, int T, int grid) {
  if (!grid) return (t > 0 ? 1u : 0u) | (t < T - 1 ? 2u : 0u);
  const int gc = t & 63, gr = t >> 6;
  return (gc > 0 ? 1u : 0u) | (gc < 63 ? 2u : 0u) | (gr > 0 ? 4u : 0u) | (gr < 31 ? 8u : 0u);
}
DI void rw_apply8(const bf16x8 (&v)[5], const float* mu, int grid, unsigned valid, int col0, float (&out)[8]) {
  float yv[8];
#pragma unroll
  for (int e = 0; e < 8; ++e) { yv[e] = bf2f((bf16_t)v[0][e]); out[e] = yv[e]; }
#pragma unroll
  for (int n = 0; n < 4; ++n) {
    if (n < 2 || grid) {
      const f32x4 m0 = *(const f32x4*)(mu + n * ZRW + col0), m1 = *(const f32x4*)(mu + n * ZRW + col0 + 4);
      const bool ok = (valid >> n) & 1u;
#pragma unroll
      for (int e = 0; e < 8; ++e) out[e] += (e < 4 ? m0[e & 3] : m1[e & 3]) * ((ok ? bf2f((bf16_t)v[1 + n][e]) : 0.f) - yv[e]);
    }
  }
}
DI void rw_apply8_lds(const bf16x8 (&v)[5], const float* mu5c, const float* c0c, int grid, unsigned valid, float (&out)[8]) {
  {
    const f32x4 c0 = *(const f32x4*)c0c, c1 = *(const f32x4*)(c0c + 4);
#pragma unroll
    for (int e = 0; e < 8; ++e) out[e] = bf2f((bf16_t)v[0][e]) * (e < 4 ? c0[e & 3] : c1[e & 3]);
  }
#pragma unroll
  for (int n = 0; n < 4; ++n) {
    if (n < 2 || grid) {
      const f32x4 m0 = *(const f32x4*)(mu5c + n * 320), m1 = *(const f32x4*)(mu5c + n * 320 + 4);
      const float ok = ((valid >> n) & 1u) ? 1.0f : 0.0f;
#pragma unroll
      for (int e = 0; e < 8; ++e) out[e] += (e < 4 ? m0[e & 3] : m1[e & 3]) * ok * bf2f((bf16_t)v[1 + n][e]);
    }
  }
}
DI float fast_tanh(float x) { return 1.0f - 2.0f / (1.0f + __expf(2.0f * x)); }
template <int N> DI float dpp_row_shr0(float x) { return __int_as_float(__builtin_amdgcn_update_dpp(0, __float_as_int(x), 0x110 + N, 0xF, 0xF, false)); }

DI void rwkv_item(const Params& p, int l, int s, int hh, int d, char* smem) {
  const Seq q = get_seq(s);
  const int tid0 = ltid();
  const int w = __builtin_amdgcn_readfirstlane(tid0 >> 6), vb = w >> 1, kb = w & 1;
  int tid = tid0, lane = tid & 63, l15 = lane & 15, qq = lane >> 4, r32 = lane & 31, h = lane >> 5;
  const bf16_t* ZR = (const bf16_t*)(p.ws + OFF_ZR);
  bf16_t* O = (bf16_t*)(p.ws + OFF_O);
  const float* mu = p.in[I_MU] + (size_t)l * 4 * ZRW;
  bf16_t* KHr = (bf16_t*)smem;
  bf16_t* BCr = KHr + 16 * 72;
  bf16_t* KC = BCr + 16 * 72;
  bf16_t* RH = KC + 16 * 72;
  bf16_t* Sb = RH + 16 * 72;
  bf16_t* Wb2 = (bf16_t*)smem;
  bf16_t* Ab2 = Wb2 + 64 * 72;
  float* mu5 = (float*)(smem + 18432);
  bf16_t* actW = (bf16_t*)(smem + 23552);
  bf16_t* actA = actW + 16 * 72;
  float* shR = (float*)(smem + 28160);
  float* shK = shR + 1024; float* shV = shK + 1024;
  bf16_t* VT = (bf16_t*)(smem + 40448);
  bf16_t* UNT = VT + 64 * 40;
  bf16_t* KBT = UNT + 64 * 40;
  bf16_t* BBT = KBT + 64 * 24;
  float* PL = (float*)(smem + 56832);
  float* npart = PL + 64;
  float* MN = (float*)(smem + 57344);
  float* G0 = (float*)(smem + 61440);
  bf16_t* ArkM = (bf16_t*)(smem + 65536);
  bf16_t* ArbM = ArkM + 16 * 40;
  float* c0t = (float*)(smem + 68096);
  __syncthreads();
  for (int e = tid; e < 4096; e += NTHR) {
    const int i = e >> 6, c = e & 63;
    Wb2[c * 72 + i] = f2bf(p.in[I_W2][((size_t)(l * 2 + d) * 64 + i) * 512 + 64 * hh + c]);
    Ab2[c * 72 + i] = f2bf(p.in[I_A2][((size_t)(l * 2 + d) * 64 + i) * 512 + 64 * hh + c]);
  }
  for (int e = tid; e < 1280; e += NTHR) {
    const int n = e / 320, rem = e % 320, arr = rem >> 6, c = rem & 63;
    const int col = arr == 0 ? 64 * hh + c : arr == 1 ? 512 + 64 * hh + c : arr == 2 ? 1024 + 64 * hh + c : arr == 3 ? 1536 + 64 * d + c : 1664 + 64 * d + c;
    mu5[e] = mu[n * ZRW + col];
  }
  for (int e = tid; e < 320; e += NTHR) {
    const int arr = e >> 6, c = e & 63;
    const int col = arr == 0 ? 64 * hh + c : arr == 1 ? 512 + 64 * hh + c : arr == 2 ? 1024 + 64 * hh + c : arr == 3 ? 1536 + 64 * d + c : 1664 + 64 * d + c;
    float sm_ = mu[col] + mu[ZRW + col];
    if (q.grid) sm_ += mu[2 * ZRW + col] + mu[3 * ZRW + col];
    c0t[e] = 1.0f - sm_;
  }
  const int cB0 = 16 * w + 4 * qq;
  float w0c[4], a0c[4], kkc[4], kac[4];
#pragma unroll
  for (int g = 0; g < 4; ++g) {
    w0c[g] = p.in[I_W0][(l * 2 + d) * 512 + 64 * hh + cB0 + g]; a0c[g] = p.in[I_A0][(l * 2 + d) * 512 + 64 * hh + cB0 + g];
    kkc[g] = p.in[I_KK][l * 512 + 64 * hh + cB0 + g]; kac[g] = p.in[I_KA][l * 512 + 64 * hh + cB0 + g];
  }
  f32x16 S;
  if (q.sample) {
    const float* st = p.in[I_SR] + ((((size_t)q.b * 2 + l) * 2 + d) * 8 + hh) * 4096;
#pragma unroll
    for (int g = 0; g < 16; ++g) S[g] = st[(32 * vb + crow(g, h)) * 64 + 32 * kb + r32];
  } else {
#pragma unroll
    for (int g = 0; g < 16; ++g) S[g] = 0.f;
  }
  __syncthreads();
  bf16x8 bW[2], bA[2];
#pragma unroll
  for (int ks = 0; ks < 2; ++ks) { bW[ks] = *(const bf16x8*)(Wb2 + (16 * w + l15) * 72 + ks * 32 + qq * 8); bA[ks] = *(const bf16x8*)(Ab2 + (16 * w + l15) * 72 + ks * 32 + qq * 8); }
  __syncthreads();
  for (int e = tid; e < (2 * 64 * 40 + 2 * 64 * 24) / 2; e += NTHR) ((unsigned*)VT)[e] = 0u;
  for (int e = tid; e < (2 * 16 * 40) / 2; e += NTHR) ((unsigned*)ArkM)[e] = 0u;
  const int nch = q.T / 16;
  bf16x8 pf[3][5];
  const int jA = (tid0 & 127) >> 3, c8A = (tid0 & 7) * 8, wh = w >> 1;
#define RW_CB(arr) ((arr) == 0 ? 64 * hh : (arr) == 1 ? 512 + 64 * hh : (arr) == 2 ? 1024 + 64 * hh : (arr) == 3 ? 1536 + 64 * d : 1664 + 64 * d)
#define RW_ISSUE(chn) { const int pos = (chn) * 16 + jA, t = d ? q.T - 1 - pos : pos; _Pragma("unroll") for (int gi = 0; gi < 3; ++gi) { if (gi < 2 || w < 2) { \
      rw_load8(ZR, q.base, t, q.T, q.grid, RW_CB(2 * gi + wh) + c8A, pf[gi]); } } }
#pragma unroll
  for (int g = 0; g < 4; ++g) asm volatile("" : "+v"(w0c[g]), "+v"(a0c[g]), "+v"(kkc[g]), "+v"(kac[g]));
  asm volatile("" : "+v"(S));
  RW_ISSUE(0)
#pragma unroll 1
  for (int ch = 0; ch < nch; ++ch) {
    tid = tid0; asm volatile("" : "+v"(tid));
    lane = tid & 63; l15 = lane & 15; qq = lane >> 4; r32 = lane & 31; h = lane >> 5;
    __syncthreads();
    {
      const int pos_ = ch * 16 + jA, t_ = d ? q.T - 1 - pos_ : pos_;
      const unsigned vd_ = rw_valid(t_, q.T, q.grid);
#pragma unroll
      for (int gi = 0; gi < 3; ++gi) {
        if (gi < 2 || w < 2) {
          const int arr = 2 * gi + wh;
          float val[8];
          rw_apply8_lds(pf[gi], mu5 + arr * 64 + c8A, c0t + arr * 64 + c8A, q.grid, vd_, val);
          if (arr < 3) {
            *(f32x4*)(shR + arr * 1024 + jA * 64 + c8A) = (f32x4){val[0], val[1], val[2], val[3]};
            *(f32x4*)(shR + arr * 1024 + jA * 64 + c8A + 4) = (f32x4){val[4], val[5], val[6], val[7]};
            if (arr == 2) {
#pragma unroll
              for (int e = 0; e < 8; ++e) VT[(c8A + e) * 40 + jA] = f2bf(val[e]);
            }
          } else if (arr == 3) {
            *(u32x4*)(actW + jA * 72 + c8A) = (u32x4){pk2(fast_tanh(val[0]), fast_tanh(val[1])), pk2(fast_tanh(val[2]), fast_tanh(val[3])), pk2(fast_tanh(val[4]), fast_tanh(val[5])), pk2(fast_tanh(val[6]), fast_tanh(val[7]))};
          } else {
            *(u32x4*)(actA + jA * 72 + c8A) = (u32x4){pk2(val[0], val[1]), pk2(val[2], val[3]), pk2(val[4], val[5]), pk2(val[6], val[7])};
          }
        }
      }
    }
    asm volatile("" ::: "memory"); __builtin_amdgcn_sched_barrier(0);
    if (ch + 1 < nch) RW_ISSUE(ch + 1)
    __syncthreads();
    {
      f32x4 aw = (f32x4){0.f, 0.f, 0.f, 0.f}, aa = (f32x4){0.f, 0.f, 0.f, 0.f};
#pragma unroll
      for (int ks = 0; ks < 2; ++ks) {
        const bf16x8 fw = *(const bf16x8*)(actW + l15 * 72 + ks * 32 + qq * 8);
        const bf16x8 fa = *(const bf16x8*)(actA + l15 * 72 + ks * 32 + qq * 8);
        aw = __builtin_amdgcn_mfma_f32_16x16x32_bf16(bW[ks], fw, aw, 0, 0, 0);
        aa = __builtin_amdgcn_mfma_f32_16x16x32_bf16(bA[ks], fa, aa, 0, 0, 0);
      }
      const f32x4 kv = *(const f32x4*)(shK + l15 * 64 + cB0), rv = *(const f32x4*)(shR + l15 * 64 + cB0);
      float lw[4], av[4], kkr[4], kd[4], Lp[4], LpL[4];
      float ssq = 0.f;
#pragma unroll
      for (int g = 0; g < 4; ++g) {
        const float wl = aw[g] + w0c[g], al = aa[g] + a0c[g];
        lw[g] = -__expf(-softplusf_(-wl) - 0.5f);
        av[g] = sigmoidf_(al);
        kkr[g] = kv[g] * kkc[g];
        kd[g] = kv[g] * (1.0f + (av[g] - 1.0f) * kac[g]);
        ssq += kkr[g] * kkr[g];
        float x = lw[g];
        x += dpp_row_shr0<1>(x); x += dpp_row_shr0<2>(x); x += dpp_row_shr0<4>(x); x += dpp_row_shr0<8>(x);
        Lp[g] = x;
      }
#pragma unroll
      for (int g = 0; g < 4; ++g) { float x = Lp[g];
        x = fminf(x, __int_as_float(__builtin_amdgcn_mov_dpp(__float_as_int(x), 0x128, 0xF, 0xF, true))); x = fminf(x, __int_as_float(__builtin_amdgcn_mov_dpp(__float_as_int(x), 0x124, 0xF, 0xF, true)));
        x = fminf(x, dpp_xor2(x)); x = fminf(x, dpp_xor1(x)); LpL[g] = x; }
      ssq += SHX(ssq, 16); ssq += SHX(ssq, 32);
      if (qq == 0) npart[w * 16 + l15] = ssq;
      float e_m1[4], e_neg[4], e_pos[4], e_end[4];
#pragma unroll
      for (int g = 0; g < 4; ++g) { e_m1[g] = __expf(Lp[g] - lw[g]); e_neg[g] = __expf(-Lp[g]); e_pos[g] = __expf(Lp[g]); e_end[g] = __expf(LpL[g] - Lp[g]); }
      *(u32x2*)(KHr + l15 * 72 + cB0) = (u32x2){pk2(kkr[0] * e_m1[0], kkr[1] * e_m1[1]), pk2(kkr[2] * e_m1[2], kkr[3] * e_m1[3])};
      *(u32x2*)(BCr + l15 * 72 + cB0) = (u32x2){pk2(kkr[0] * av[0] * e_neg[0], kkr[1] * av[1] * e_neg[1]), pk2(kkr[2] * av[2] * e_neg[2], kkr[3] * av[3] * e_neg[3])};
      *(u32x2*)(KC + l15 * 72 + cB0) = (u32x2){pk2(kd[0] * e_neg[0], kd[1] * e_neg[1]), pk2(kd[2] * e_neg[2], kd[3] * e_neg[3])};
      *(u32x2*)(RH + l15 * 72 + cB0) = (u32x2){pk2(rv[0] * e_pos[0], rv[1] * e_pos[1]), pk2(rv[2] * e_pos[2], rv[3] * e_pos[3])};
#pragma unroll
      for (int g = 0; g < 4; ++g) {
        KBT[(cB0 + g) * 24 + l15] = f2bf(kd[g] * e_end[g]);
        BBT[(cB0 + g) * 24 + l15] = f2bf(kkr[g] * av[g] * e_end[g]);
      }
      if (l15 == 15) *(f32x4*)(PL + cB0) = (f32x4){e_pos[0], e_pos[1], e_pos[2], e_pos[3]};
#pragma unroll
      for (int g = 0; g < 16; ++g) Sb[(32 * vb + crow(g, h)) * 72 + 32 * kb + r32] = f2bf(S[g]);
    }
    __syncthreads();
    f32x4 oacc = (f32x4){0.f, 0.f, 0.f, 0.f};
    {
      const bf16_t* Aop = (w < 2) ? KHr : RH;
      const bf16_t* Bop = (w == 0 || w == 3) ? BCr : KC;
      f32x4 t16 = (f32x4){0.f, 0.f, 0.f, 0.f}, g0 = (f32x4){0.f, 0.f, 0.f, 0.f};
#pragma unroll
      for (int ks = 0; ks < 2; ++ks) {
        const bf16x8 a = *(const bf16x8*)(Aop + l15 * 72 + ks * 32 + qq * 8);
        const bf16x8 b = *(const bf16x8*)(Bop + l15 * 72 + ks * 32 + qq * 8);
        t16 = __builtin_amdgcn_mfma_f32_16x16x32_bf16(a, b, t16, 0, 0, 0);
        const bf16x8 akh = *(const bf16x8*)(KHr + l15 * 72 + ks * 32 + qq * 8);
        const bf16x8 arh = *(const bf16x8*)(RH + l15 * 72 + ks * 32 + qq * 8);
        const bf16x8 bs = *(const bf16x8*)(Sb + (16 * w + l15) * 72 + ks * 32 + qq * 8);
        g0 = __builtin_amdgcn_mfma_f32_16x16x32_bf16(akh, bs, g0, 0, 0, 0);
        oacc = __builtin_amdgcn_mfma_f32_16x16x32_bf16(arh, bs, oacc, 0, 0, 0);
      }
#pragma unroll
      for (int g = 0; g < 4; ++g) G0[(4 * qq + g) * 64 + 16 * w + l15] = g0[g];
      *(f32x4*)(MN + w * 256 + l15 * 16 + 4 * qq) = t16;
    }
    __syncthreads();
    if (w == 0) {
      const float* MrT = MN; const float* NrT = MN + 256;
      f32x2 acc2[8];
#pragma unroll
      for (int pq = 0; pq < 8; ++pq) acc2[pq] = (f32x2){G0[(2 * pq) * 64 + lane], G0[(2 * pq + 1) * 64 + lane]};
      float vv[16], un[16];
#pragma unroll
      for (int j = 0; j < 16; ++j) vv[j] = shV[j * 64 + lane];
      const float n2v = __builtin_amdgcn_rcpf(fmaxf(npart[l15] + npart[16 + l15] + npart[32 + l15] + npart[48 + l15], 1e-24f));
      f32x4 nr[4], mr[4];
#pragma unroll
      for (int t4 = 0; t4 < 4; ++t4) { nr[t4] = *(const f32x4*)(NrT + 4 * t4); mr[t4] = *(const f32x4*)(MrT + 4 * t4); }
#pragma unroll
      for (int j = 0; j < 16; ++j) {
        f32x4 nrn[4], mrn[4];
#pragma unroll
        for (int t4 = 0; t4 < 4; ++t4) { nrn[t4] = (f32x4){0.f, 0.f, 0.f, 0.f}; mrn[t4] = (f32x4){0.f, 0.f, 0.f, 0.f}; }
        if (j + 1 < 16) {
#pragma unroll
          for (int t4 = 0; t4 < 4; ++t4) if (4 * t4 + 3 > j + 1) { nrn[t4] = *(const f32x4*)(NrT + (j + 1) * 16 + 4 * t4); mrn[t4] = *(const f32x4*)(MrT + (j + 1) * 16 + 4 * t4); }
        }
        const float n2s = __int_as_float(__builtin_amdgcn_readlane(__float_as_int(n2v), j));
        const float unj = -acc2[j >> 1][j & 1] * n2s;
        un[j] = unj;
        const f32x2 vv2 = (f32x2){vv[j], vv[j]}, un2 = (f32x2){unj, unj};
#pragma unroll
        for (int pq = 0; pq < 8; ++pq)
          if (2 * pq + 1 > j) acc2[pq] += (f32x2){nr[pq >> 1][2 * (pq & 1)], nr[pq >> 1][2 * (pq & 1) + 1]} * vv2 + (f32x2){mr[pq >> 1][2 * (pq & 1)], mr[pq >> 1][2 * (pq & 1) + 1]} * un2;
#pragma unroll
        for (int t4 = 0; t4 < 4; ++t4) { nr[t4] = nrn[t4]; mr[t4] = mrn[t4]; }
        __builtin_amdgcn_sched_barrier(0);
      }
      *(u32x4*)(UNT + lane * 40) = (u32x4){pk2(un[0], un[1]), pk2(un[2], un[3]), pk2(un[4], un[5]), pk2(un[6], un[7])};
      *(u32x4*)(UNT + lane * 40 + 8) = (u32x4){pk2(un[8], un[9]), pk2(un[10], un[11]), pk2(un[12], un[13]), pk2(un[14], un[15])};
    } else if (w < 3) {
      const float* src = MN + (w == 1 ? 512 : 768);
      bf16_t* dst = (w == 1) ? ArkM : ArbM;
#pragma unroll
      for (int i = 0; i < 4; ++i) { const int e = lane + 64 * i, j = e >> 4, t = e & 15; dst[t * 40 + j] = f2bf(j <= t ? src[e] : 0.f); }
    }
    __syncthreads();
    {
      const bf16x8 ak = *(const bf16x8*)(ArkM + l15 * 40 + qq * 8), ab = *(const bf16x8*)(ArbM + l15 * 40 + qq * 8);
      const bf16x8 bv = *(const bf16x8*)(VT + (16 * w + l15) * 40 + qq * 8), bu = *(const bf16x8*)(UNT + (16 * w + l15) * 40 + qq * 8);
      oacc = __builtin_amdgcn_mfma_f32_16x16x32_bf16(ak, bv, oacc, 0, 0, 0);
      oacc = __builtin_amdgcn_mfma_f32_16x16x32_bf16(ab, bu, oacc, 0, 0, 0);
#pragma unroll
      for (int g = 0; g < 4; ++g) {
        const int pos = ch * 16 + 4 * qq + g, t = d ? q.T - 1 - pos : pos;
        O[(size_t)(q.base + t) * 1024 + d * 512 + 64 * hh + 16 * w + l15] = f2bf(oacc[g]);
      }
      const float pl = PL[32 * kb + r32];
#pragma unroll
      for (int g = 0; g < 16; ++g) S[g] *= pl;
      const bf16x8 av_ = *(const bf16x8*)(VT + (32 * vb + r32) * 40 + 8 * h), au_ = *(const bf16x8*)(UNT + (32 * vb + r32) * 40 + 8 * h);
      const bf16x8 bk_ = *(const bf16x8*)(KBT + (32 * kb + r32) * 24 + 8 * h), bb_ = *(const bf16x8*)(BBT + (32 * kb + r32) * 24 + 8 * h);
      S = __builtin_amdgcn_mfma_f32_32x32x16_bf16(av_, bk_, S, 0, 0, 0);
      S = __builtin_amdgcn_mfma_f32_32x32x16_bf16(au_, bb_, S, 0, 0, 0);
    }
  }
  if (!q.sample) {
    float* dst = p.out + OUT_RW + ((((size_t)q.b * 2 + l) * 2 + d) * 8 + hh) * 4096;
#pragma unroll
    for (int g = 0; g < 16; ++g) dst[(32 * vb + crow(g, h)) * 64 + 32 * kb + r32] = S[g];
  }
}

DI void hgrn_item(const Params& p, int l, int s, int hh, int d, char* smem) {
  const Seq q = get_seq(s);
  const int tid = ltid(), lane = tid & 63, w = tid >> 6, r = lane & 31, h = lane >> 5;
  bf16_t* ZH = (bf16_t*)(p.ws + OFF_ZH);
  bf16_t* Qt = (bf16_t*)smem;
  bf16_t* Kt = Qt + 32 * 136;
  bf16_t* KhT = Kt + 32 * 136;
  bf16_t* VT = KhT + 128 * 40;
  bf16_t* Sb = VT + 128 * 40;
  bf16_t* At = Sb + 4 * 32 * 136;
  float* dL = (float*)(At + 32 * 40);
  float* tot = dL + 128;
  const float lb = ((const float*)(p.ws + OFF_LBS))[l * 512 + 128 * hh + (tid & 127)];
  f32x16 S[4];
  if (q.sample) {
    const float* st = p.in[I_SH] + ((((size_t)q.b * 2 + l) * 2 + d) * 4 + hh) * 16384;
#pragma unroll
    for (int kb = 0; kb < 4; ++kb)
#pragma unroll
      for (int g = 0; g < 16; ++g) S[kb][g] = st[(size_t)(32 * kb + crow(g, h)) * 128 + 32 * w + r];
  } else {
#pragma unroll
    for (int kb = 0; kb < 4; ++kb)
#pragma unroll
      for (int g = 0; g < 16; ++g) S[kb][g] = 0.f;
  }
  const int k = tid & 127, half = tid >> 7;
  const int nch = q.T / 32;
  u16x2 pzq[16], pv2[8];
#define HG_ISSUE(chn) { _Pragma("unroll") for (int jj = 0; jj < 16; ++jj) { const int pos = (chn) * 32 + half * 16 + jj, t = d ? q.T - 1 - pos : pos; \
      const size_t rowo = (size_t)(q.base + t) * ZHW + 128 * hh + k; pzq[jj][0] = ZH[rowo + 512 * (1 + d)]; pzq[jj][1] = ZH[rowo]; pv2[jj >> 1][jj & 1] = ZH[rowo + 1536]; } }
  { float lb_ = lb; asm volatile("" : "+v"(lb_)); (void)lb_; }
#pragma unroll
  for (int kb = 0; kb < 4; ++kb) asm volatile("" : "+v"(S[kb]));
  HG_ISSUE(0)
#pragma unroll 1
  for (int ch = 0; ch < nch; ++ch) {
    __syncthreads();
    float bl[16], kc[16], qs[16];
    {
      float b = 0.f;
#pragma unroll
      for (int jj = 0; jj < 16; ++jj) {
        const float z = bf2f(pzq[jj][0]);
        const float kcoef = (1.0f - lb) * sigmoidf_(-z);
        const float f = 1.0f - kcoef;
        b += fmaxf(__logf(f), -80.f);
        bl[jj] = b; kc[jj] = kcoef; qs[jj] = bf2f(pzq[jj][1]) * 0.08838834764831845f;
      }
      *(u32x4*)(VT + k * 40 + half * 16) = (u32x4){__builtin_bit_cast(unsigned, pv2[0]), __builtin_bit_cast(unsigned, pv2[1]), __builtin_bit_cast(unsigned, pv2[2]), __builtin_bit_cast(unsigned, pv2[3])};
      *(u32x4*)(VT + k * 40 + half * 16 + 8) = (u32x4){__builtin_bit_cast(unsigned, pv2[4]), __builtin_bit_cast(unsigned, pv2[5]), __builtin_bit_cast(unsigned, pv2[6]), __builtin_bit_cast(unsigned, pv2[7])};
      tot[half * 128 + k] = b;
    }
    if (ch + 1 < nch) HG_ISSUE(ch + 1)
    __syncthreads();
    {
      const float off = half ? tot[k] : 0.f;
      const float bL = fmaxf(tot[k] + tot[128 + k], -80.f);
      if (half == 0) dL[k] = __expf(bL);
      float kh[16];
#pragma unroll
      for (int jj = 0; jj < 16; ++jj) {
        const int j = half * 16 + jj;
        const float bj = fmaxf(off + bl[jj], -80.f);
        Qt[j * 136 + k] = f2bf(qs[jj] * __expf(bj));
        Kt[j * 136 + k] = f2bf(kc[jj] * __expf(-bj));
        kh[jj] = kc[jj] * __expf(fminf(bL - bj, 0.f));
      }
      *(u32x4*)(KhT + k * 40 + half * 16) = (u32x4){pk2(kh[0], kh[1]), pk2(kh[2], kh[3]), pk2(kh[4], kh[5]), pk2(kh[6], kh[7])};
      *(u32x4*)(KhT + k * 40 + half * 16 + 8) = (u32x4){pk2(kh[8], kh[9]), pk2(kh[10], kh[11]), pk2(kh[12], kh[13]), pk2(kh[14], kh[15])};
    }
    bf16_t* Sbw = Sb + w * 32 * 136;
#pragma unroll
    for (int kb = 0; kb < 4; ++kb)
#pragma unroll
      for (int g4 = 0; g4 < 4; ++g4) *(u32x2*)(Sbw + r * 136 + 32 * kb + crow(4 * g4, h)) = (u32x2){pk2(S[kb][4 * g4], S[kb][4 * g4 + 1]), pk2(S[kb][4 * g4 + 2], S[kb][4 * g4 + 3])};
    __syncthreads();
    bf16_t* Atw = At;
    {
      f32x16 A;
#pragma unroll
      for (int g = 0; g < 16; ++g) A[g] = 0.f;
      mma32(A, Qt, 136, Kt, 136, 128, lane);
#pragma unroll
      for (int g = 0; g < 16; ++g) { const int t = crow(g, h); Atw[t * 40 + r] = f2bf(r <= t ? A[g] : 0.f); }
    }
    __syncthreads();
    {
      f32x16 o;
#pragma unroll
      for (int g = 0; g < 16; ++g) o[g] = 0.f;
      mma32(o, Atw, 40, VT + 32 * w * 40, 40, 32, lane);
      mma32(o, Qt, 136, Sbw, 136, 128, lane);
#pragma unroll
      for (int g = 0; g < 16; ++g) {
        const int j = crow(g, h), pos = ch * 32 + j, t = d ? q.T - 1 - pos : pos;
        ZH[(size_t)(q.base + t) * ZHW + 512 * (1 + d) + 128 * hh + 32 * w + r] = f2bf(o[g]);
      }
#pragma unroll
      for (int kb = 0; kb < 4; ++kb) {
#pragma unroll
        for (int g = 0; g < 16; ++g) S[kb][g] *= dL[32 * kb + crow(g, h)];
        mma32(S[kb], KhT + 32 * kb * 40, 40, VT + 32 * w * 40, 40, 32, lane);
      }
    }
  }
  if (!q.sample) {
    float* dst = p.out + OUT_HG + ((((size_t)q.b * 2 + l) * 2 + d) * 4 + hh) * 16384;
#pragma unroll
    for (int kb = 0; kb < 4; ++kb)
#pragma unroll
      for (int g = 0; g < 16; ++g) dst[(size_t)(32 * kb + crow(g, h)) * 128 + 32 * w + r] = S[kb][g];
  }
}

DI void mlstm_item(const Params& p, int l, int s, int hh, int d, char* smem) {
  const Seq q = get_seq(s);
  const int tid = ltid(), lane = tid & 63, w = tid >> 6, r = lane & 31, h = lane >> 5;
  const bf16_t* ZM = (const bf16_t*)(p.ws + OFF_ZM);
  const float* MG = (const float*)(p.ws + OFF_MG);
  bf16_t* Hb = (bf16_t*)(p.ws + OFF_H);
  bf16_t* Qm = (bf16_t*)smem;
  bf16_t* Km = Qm + 32 * 136;
  bf16_t* KwT = Km + 32 * 136;
  bf16_t* VT = KwT + 128 * 40;
  bf16_t* Cb = VT + 128 * 40;
  bf16_t* Pt = Cb + 4 * 32 * 136;
  float* nv = (float*)(Pt + 32 * 40);
  float* sc = nv + 128;
  float* ig = sc; float* lf = sc + 32; float* gg = sc + 64; float* mtv = sc + 96; float* wi = sc + 128; float* wsr = sc + 160; float* qn = sc + 192; float* misc = sc + 224;
  float* dnw = sc + 232;
  const float gbi = p.in[I_GB][l * 16 + (2 * d) * 4 + hh], gbf = p.in[I_GB][l * 16 + (2 * d + 1) * 4 + hh];
  f32x16 C[4];
  float m;
  __syncthreads();
  if (q.sample) {
    const size_t sb = (((size_t)q.b * 2 + l) * 2 + d) * 4 + hh;
    const float* st = p.in[I_SC] + sb * 16384;
#pragma unroll
    for (int kb = 0; kb < 4; ++kb)
#pragma unroll
      for (int g = 0; g < 16; ++g) C[kb][g] = st[(size_t)(32 * kb + crow(g, h)) * 128 + 32 * w + r];
    if (tid < 128) nv[tid] = p.in[I_SN][sb * 128 + tid];
    m = p.in[I_SM][sb];
  } else {
#pragma unroll
    for (int kb = 0; kb < 4; ++kb)
#pragma unroll
      for (int g = 0; g < 16; ++g) C[kb][g] = 0.f;
    if (tid < 128) nv[tid] = 0.f;
    m = 0.f;
  }
  const int nch = q.T / 32;
  const int dd = tid & 127, half = tid >> 7;
  u16x2 pqk[16], pv2[8]; float pgi = 0.f, pgf = 0.f;
#define ML_ISSUE(chn) { _Pragma("unroll") for (int jj = 0; jj < 16; ++jj) { const int pos = (chn) * 32 + half * 16 + jj, t = d ? q.T - 1 - pos : pos; \
      const size_t rowo = (size_t)(q.base + t) * ZMW + 128 * hh + dd; pqk[jj][0] = ZM[rowo]; pqk[jj][1] = ZM[rowo + 512]; pv2[jj >> 1][jj & 1] = ZM[rowo + 1024]; } \
    if (tid < 32) { const int pos = (chn) * 32 + tid, t = d ? q.T - 1 - pos : pos; const float* mg = MG + (size_t)(q.base + t) * 16; pgi = mg[(2 * d) * 4 + hh]; pgf = mg[(2 * d + 1) * 4 + hh]; } }
#pragma unroll
  for (int kb = 0; kb < 4; ++kb) asm volatile("" : "+v"(C[kb]));
  asm volatile("" : "+v"(m));
  ML_ISSUE(0)
#pragma unroll 1
  for (int ch = 0; ch < nch; ++ch) {
    __syncthreads();
    {
#pragma unroll
      for (int jj = 0; jj < 16; ++jj) {
        const int j = half * 16 + jj;
        Qm[j * 136 + dd] = pqk[jj][0];
        Km[j * 136 + dd] = f2bf(bf2f(pqk[jj][1]) * 0.08838834764831845f);
      }
      *(u32x4*)(VT + dd * 40 + half * 16) = (u32x4){__builtin_bit_cast(unsigned, pv2[0]), __builtin_bit_cast(unsigned, pv2[1]), __builtin_bit_cast(unsigned, pv2[2]), __builtin_bit_cast(unsigned, pv2[3])};
      *(u32x4*)(VT + dd * 40 + half * 16 + 8) = (u32x4){__builtin_bit_cast(unsigned, pv2[4]), __builtin_bit_cast(unsigned, pv2[5]), __builtin_bit_cast(unsigned, pv2[6]), __builtin_bit_cast(unsigned, pv2[7])};
      if (tid < 32) {
        const float igv = pgi + gbi;
        const float lfv = -softplusf_(-(pgf + gbf));
        float g = lfv;
#pragma unroll
        for (int o = 1; o < 32; o <<= 1) { const float tt = shfl_lane(g, (lane - o) & 63); if (tid >= o) g += tt; }
        const float cs = igv - g;
        float pm = cs;
#pragma unroll
        for (int o = 1; o < 32; o <<= 1) { const float tt = shfl_lane(pm, (lane - o) & 63); if (tid >= o) pm = fmaxf(pm, tt); }
        const float mt = g + fmaxf(m, pm);
        const float gend = shfl_lane(g, 31), mn = shfl_lane(mt, 31);
        ig[tid] = igv; gg[tid] = g; mtv[tid] = mt; wi[tid] = __expf(g + m - mt);
        wsr[tid] = __expf(gend + cs - mn);
        if (tid == 0) { misc[0] = mn; misc[1] = __expf(gend + m - mn); }
      }
    }
    if (ch + 1 < nch) ML_ISSUE(ch + 1)
    __syncthreads();
    {
      {
        float kw[16];
#pragma unroll
        for (int jj = 0; jj < 16; ++jj) { const int j = half * 16 + jj; kw[jj] = bf2f(Km[j * 136 + dd]) * wsr[j]; }
        *(u32x4*)(KwT + dd * 40 + half * 16) = (u32x4){pk2(kw[0], kw[1]), pk2(kw[2], kw[3]), pk2(kw[4], kw[5]), pk2(kw[6], kw[7])};
        *(u32x4*)(KwT + dd * 40 + half * 16 + 8) = (u32x4){pk2(kw[8], kw[9]), pk2(kw[10], kw[11]), pk2(kw[12], kw[13]), pk2(kw[14], kw[15])};
      }
      const int j = tid >> 3, seg = tid & 7;
      float a = 0.f;
#pragma unroll
      for (int i = 0; i < 16; ++i) a += bf2f(Qm[j * 136 + seg * 16 + i]) * nv[seg * 16 + i];
      a += SHX(a, 1); a += SHX(a, 2); a += SHX(a, 4);
      if (seg == 0) qn[j] = a;
    }
    const float m_new = misc[0], carry = misc[1];
    bf16_t* Cbw = Cb + w * 32 * 136; bf16_t* Ptw = Pt;
#pragma unroll
    for (int kb = 0; kb < 4; ++kb)
#pragma unroll
      for (int g4 = 0; g4 < 4; ++g4) *(u32x2*)(Cbw + r * 136 + 32 * kb + crow(4 * g4, h)) = (u32x2){pk2(C[kb][4 * g4], C[kb][4 * g4 + 1]), pk2(C[kb][4 * g4 + 2], C[kb][4 * g4 + 3])};
    {
      f32x16 Sc;
#pragma unroll
      for (int g = 0; g < 16; ++g) Sc[g] = 0.f;
      mma32(Sc, Qm, 136, Km, 136, 128, lane);
      const float gs = gg[r], is = ig[r];
#pragma unroll
      for (int g = 0; g < 16; ++g) {
        const int t = crow(g, h);
        const float pv = (r <= t) ? __expf(gg[t] - gs + is - mtv[t]) * Sc[g] : 0.f;
        Ptw[t * 40 + r] = f2bf(pv);
      }
    }
    __syncthreads();
    if (lane < 32) {
      float a = 0.f;
#pragma unroll 4
      for (int i = 0; i < 32; ++i) a += bf2f(Ptw[lane * 40 + i]);
      const float den = wi[lane] * qn[lane] + a;
      dnw[lane] = 1.0f / fmaxf(fabsf(den), __expf(-mtv[lane]));
    }
    if (tid < 128) {
      float a = 0.f;
#pragma unroll 4
      for (int i = 0; i < 32; ++i) a += bf2f(KwT[tid * 40 + i]);
      nv[tid] = carry * nv[tid] + a;
    }
    __syncthreads();
    {
      f32x16 a1;
#pragma unroll
      for (int g = 0; g < 16; ++g) a1[g] = 0.f;
      mma32(a1, Qm, 136, Cbw, 136, 128, lane);
#pragma unroll
      for (int g = 0; g < 16; ++g) a1[g] *= wi[crow(g, h)];
      mma32(a1, Ptw, 40, VT + 32 * w * 40, 40, 32, lane);
#pragma unroll
      for (int g = 0; g < 16; ++g) {
        const int j = crow(g, h), pos = ch * 32 + j, t = d ? q.T - 1 - pos : pos;
        const float hv = a1[g] * dnw[j];
        Hb[(size_t)(q.base + t) * 1024 + d * 512 + 128 * hh + 32 * w + r] = f2bf(hv);
      }
#pragma unroll
      for (int kb = 0; kb < 4; ++kb) {
#pragma unroll
        for (int g = 0; g < 16; ++g) C[kb][g] *= carry;
        mma32(C[kb], KwT + 32 * kb * 40, 40, VT + 32 * w * 40, 40, 32, lane);
      }
    }
    m = m_new;
  }
  __syncthreads();
  if (!q.sample) {
    const size_t sb = (((size_t)q.b * 2 + l) * 2 + d) * 4 + hh;
    float* dst = p.out + OUT_C + sb * 16384;
#pragma unroll
    for (int kb = 0; kb < 4; ++kb)
#pragma unroll
      for (int g = 0; g < 16; ++g) dst[(size_t)(32 * kb + crow(g, h)) * 128 + 32 * w + r] = C[kb][g];
    if (tid < 128) p.out[OUT_N + sb * 128 + tid] = nv[tid];
    if (tid == 0) p.out[OUT_M + sb] = m;
  }
}

DI void phase_scan(const Params& p, int l, char* smem) {
  int* ctrL = (int*)(p.ws + OFF_CTR) + 2 * l;
  int* ctrS = ctrL + 1;
  int* sit = (int*)(smem + LDS_BYTES - 16);
  const int role = p.role;
  bool longDone = false, shortDone = false;
  for (;;) {
    const bool wantLong = (role == 0) ? !longDone : shortDone;
    if (longDone && shortDone) break;
    __syncthreads();
    if (ltid() == 0) *sit = atomicAdd(wantLong ? ctrL : ctrS, 1);
    __syncthreads();
    int it = __builtin_amdgcn_readfirstlane(*sit);
    int ty, s_, hh_, d_, rb_ = 0;
    if (wantLong) {
      if (it >= 128) { longDone = true; continue; }
      if (it < 64) { ty = 0; d_ = it & 1; hh_ = (it >> 1) & 7; s_ = 32 + (it >> 4); }
      else if (it < 96) { it -= 64; ty = 1; s_ = 32 + (it >> 3); hh_ = (it >> 1) & 3; d_ = it & 1; }
      else { it -= 96; ty = 2; s_ = 32 + (it >> 3); hh_ = (it >> 1) & 3; d_ = it & 1; }
    } else {
      if (it >= 1024) { shortDone = true; continue; }
      if (it < 512) { ty = 0; s_ = it >> 4; hh_ = (it >> 1) & 7; d_ = it & 1; }
      else if (it < 768) { it -= 512; ty = 1; s_ = it >> 3; hh_ = (it >> 1) & 3; d_ = it & 1; }
      else { it -= 768; ty = 2; s_ = it >> 3; hh_ = (it >> 1) & 3; d_ = it & 1; }
    }
    if (ty == 0) rwkv_item(p, l, s_, hh_, d_, smem);
    else if (ty == 1) hgrn_item(p, l, s_, hh_, d_, smem);
    else mlstm_item(p, l, s_, hh_, d_, smem);
  }
}

DI void phase_combine(const Params& p, int l, char* smem) {
  const int tid = ltid(), lane = tid & 63, w = tid >> 6;
  bf16_t* ZH = (bf16_t*)(p.ws + OFF_ZH); bf16_t* ZM = (bf16_t*)(p.ws + OFF_ZM); const bf16_t* ZR = (const bf16_t*)(p.ws + OFF_ZR);
  bf16_t* O = (bf16_t*)(p.ws + OFF_O); const bf16_t* Hb = (const bf16_t*)(p.ws + OFF_H);
  const float* mu = p.in[I_MU] + (size_t)l * 4 * ZRW;
  const float* g2 = p.in[I_G2] + (size_t)l * 128 * 512;
  float* sg = (float*)smem;
  float* gt = sg + 128 * 16;
  for (int blk = blockIdx.x; blk < NT / 16; blk += gridDim.x) {
    const int tok0 = blk * 16;
    int sidx, t0;
    if (tok0 < 8192) { sidx = tok0 >> 8; t0 = tok0 & 255; } else { sidx = 32 + ((tok0 - 8192) >> 11); t0 = (tok0 - 8192) & 2047; }
    const Seq q = get_seq(sidx);
    __syncthreads();
    { const int j = tid >> 4, rr0 = (tid & 15) * 8; float val[8]; bf16x8 pv[5]; rw_load8(ZR, q.base, t0 + j, q.T, q.grid, 1792 + rr0, pv); rw_apply8(pv, mu, q.grid, rw_valid(t0 + j, q.T, q.grid), 1792 + rr0, val);
#pragma unroll
      for (int e = 0; e < 8; ++e) sg[(rr0 + e) * 16 + j] = sigmoidf_(val[e]); }
    __syncthreads();
    {
      float a0[16], a1[16];
#pragma unroll
      for (int j = 0; j < 16; ++j) { a0[j] = 0.f; a1[j] = 0.f; }
#pragma unroll 1
      for (int r0 = 0; r0 < 128; r0 += 8) {
        float w0v[8], w1v[8];
#pragma unroll
        for (int q8 = 0; q8 < 8; ++q8) { w0v[q8] = g2[(r0 + q8) * 512 + tid]; w1v[q8] = g2[(r0 + q8) * 512 + 256 + tid]; }
#pragma unroll
        for (int q8 = 0; q8 < 8; ++q8) {
          const int rr = r0 + q8; const float w0 = w0v[q8], w1 = w1v[q8];
#pragma unroll
          for (int u = 0; u < 4; ++u) {
            f32x4 sv = *(const f32x4*)(sg + rr * 16 + 4 * u);
#pragma unroll
            for (int e = 0; e < 4; ++e) { a0[4 * u + e] += sv[e] * w0; a1[4 * u + e] += sv[e] * w1; }
          }
        }
      }
#pragma unroll
      for (int j = 0; j < 16; ++j) { gt[j * 512 + tid] = a0[j]; gt[j * 512 + 256 + tid] = a1[j]; }
    }
    __syncthreads();
#pragma unroll 1
    for (int jj = 0; jj < 4; ++jj) {
      const int j = w * 4 + jj, tok = tok0 + j, t = t0 + j; int c0 = lane * 8; asm volatile("" : "+v"(c0));
      {
        float o[8], rs[8], ks[8], vs[8];
        float sum = 0.f, bon = 0.f;
        {
          bf16x8 pr_[5], pk_[5], pv_[5];
          rw_load8(ZR, q.base, t, q.T, q.grid, c0, pr_); rw_load8(ZR, q.base, t, q.T, q.grid, 512 + c0, pk_); rw_load8(ZR, q.base, t, q.T, q.grid, 1024 + c0, pv_);
          const unsigned vd_ = rw_valid(t, q.T, q.grid);
          rw_apply8(pr_, mu, q.grid, vd_, c0, rs); rw_apply8(pk_, mu, q.grid, vd_, 512 + c0, ks); rw_apply8(pv_, mu, q.grid, vd_, 1024 + c0, vs);
        }
        const bf16x8 of = *(const bf16x8*)(O + (size_t)tok * 1024 + c0), ob = *(const bf16x8*)(O + (size_t)tok * 1024 + 512 + c0);
        const f32x4 rk0 = *(const f32x4*)(p.in[I_RK] + l * 512 + c0), rk1 = *(const f32x4*)(p.in[I_RK] + l * 512 + c0 + 4);
#pragma unroll
        for (int e = 0; e < 8; ++e) {
          o[e] = bf2f((bf16_t)of[e]) + bf2f((bf16_t)ob[e]);
          sum += o[e];
          bon += rs[e] * ks[e] * (e < 4 ? rk0[e & 3] : rk1[e & 3]);
        }
        sum += SHX(sum, 1); sum += SHX(sum, 2); sum += SHX(sum, 4);
        bon += SHX(bon, 1); bon += SHX(bon, 2); bon += SHX(bon, 4);
        const float mean = sum * (1.0f / 64.f);
        float var = 0.f;
#pragma unroll
        for (int e = 0; e < 8; ++e) { const float dv = o[e] - mean; var += dv * dv; }
        var += SHX(var, 1); var += SHX(var, 2); var += SHX(var, 4);
        const float rstd = rsqrtf(var * (1.0f / 64.f) + 64e-5f);
        const f32x4 lw0 = *(const f32x4*)(p.in[I_LN] + (l * 2 + 0) * 512 + c0), lw1 = *(const f32x4*)(p.in[I_LN] + (l * 2 + 0) * 512 + c0 + 4);
        const f32x4 lb0 = *(const f32x4*)(p.in[I_LN] + (l * 2 + 1) * 512 + c0), lb1 = *(const f32x4*)(p.in[I_LN] + (l * 2 + 1) * 512 + c0 + 4);
        const f32x4 gt0 = *(const f32x4*)(gt + j * 512 + c0), gt1 = *(const f32x4*)(gt + j * 512 + c0 + 4);
        bf16x8 ov;
#pragma unroll
        for (int e = 0; e < 8; ++e) {
          const float ln = (o[e] - mean) * rstd * (e < 4 ? lw0[e & 3] : lw1[e & 3]) + (e < 4 ? lb0[e & 3] : lb1[e & 3]);
          ov[e] = (short)f2bf((ln + bon * vs[e]) * (e < 4 ? gt0[e & 3] : gt1[e & 3]));
        }
        *(bf16x8*)(O + (size_t)tok * 1024 + c0) = ov;
      }
      {
        float o[8]; float ss = 0.f;
        bf16_t* zr_ = ZH + (size_t)tok * ZHW + c0;
        const bf16x8 of = *(const bf16x8*)(zr_ + 512), ob = *(const bf16x8*)(zr_ + 1024), hgv = *(const bf16x8*)(zr_ + 2048);
        const f32x4 nw0 = *(const f32x4*)(p.in[I_HNORM] + l * 512 + c0), nw1 = *(const f32x4*)(p.in[I_HNORM] + l * 512 + c0 + 4);
#pragma unroll
        for (int e = 0; e < 8; ++e) { o[e] = bf2f((bf16_t)of[e]) + bf2f((bf16_t)ob[e]); ss += o[e] * o[e]; }
        ss += SHX(ss, 1); ss += SHX(ss, 2); ss += SHX(ss, 4); ss += SHX(ss, 8);
        const float rsd = rsqrtf(ss * (1.0f / 128.f) + 1e-6f);
        bf16x8 ov;
#pragma unroll
        for (int e = 0; e < 8; ++e) ov[e] = (short)f2bf(o[e] * rsd * (e < 4 ? nw0[e & 3] : nw1[e & 3]) * siluf_(bf2f((bf16_t)hgv[e])));
        *(bf16x8*)(zr_ + 2048) = ov;
      }
      {
        float o[8]; float ss = 0.f;
        bf16_t* zm_ = ZM + (size_t)tok * ZMW + 1536 + c0;
        const bf16x8 of = *(const bf16x8*)(Hb + (size_t)tok * 1024 + c0), ob = *(const bf16x8*)(Hb + (size_t)tok * 1024 + 512 + c0), mov = *(const bf16x8*)zm_;
        const f32x4 nw0 = *(const f32x4*)(p.in[I_MNORM] + l * 512 + c0), nw1 = *(const f32x4*)(p.in[I_MNORM] + l * 512 + c0 + 4);
#pragma unroll
        for (int e = 0; e < 8; ++e) { o[e] = bf2f((bf16_t)of[e]) + bf2f((bf16_t)ob[e]); ss += o[e] * o[e]; }
        ss += SHX(ss, 1); ss += SHX(ss, 2); ss += SHX(ss, 4); ss += SHX(ss, 8);
        const float rsd = rsqrtf(ss * (1.0f / 128.f) + 1e-6f);
        bf16x8 ov;
#pragma unroll
        for (int e = 0; e < 8; ++e) ov[e] = (short)f2bf(o[e] * rsd * (e < 4 ? nw0[e & 3] : nw1[e & 3]) * sigmoidf_(bf2f((bf16_t)mov[e])));
        *(bf16x8*)zm_ = ov;
      }
    }
    __syncthreads();
#pragma unroll 1
    for (int jj = 0; jj < 4; ++jj) tok_one(p, l, 3, tok0 + w * 4 + jj, lane);
  }
}

#define XB_TMO      128
#define XB_XCNT(j)  (256  + 64 * (j))
#define XB_XSUB(j)  (1280 + 64 * (j))
#define XB_XGEN(j)  (2304 + 64 * (j))
#define XB_TOP      3328
#define XB_TOPGEN   3392
#define XCD_BAR_WORDS 3456
#define XB_SPIN_CAP (1u << 20)
#define LAS __attribute__((address_space(3)))
DI unsigned xb_ld(unsigned* p)              { return __hip_atomic_load(p, __ATOMIC_RELAXED, __HIP_MEMORY_SCOPE_AGENT); }
DI unsigned xb_add(unsigned* p, unsigned v) { return __hip_atomic_fetch_add(p, v, __ATOMIC_RELAXED, __HIP_MEMORY_SCOPE_AGENT); }
DI unsigned xb_xcc_id() { return (unsigned)__builtin_amdgcn_s_getreg((3 << 11) | 20) & 0xFu; }
#define XB_SPIN(cond, bar) do { unsigned _sp = 0; while (cond) { __builtin_amdgcn_s_sleep(1); \
    if ((++_sp & 255u) == 0u) { if (xb_ld(&(bar)[XB_TMO])) break; if (_sp > XB_SPIN_CAP) { atomicAdd(&(bar)[XB_TMO], 1u); break; } } } } while (0)
struct XcdBarrier { unsigned* bar; unsigned x; volatile LAS unsigned* st; };
DI XcdBarrier xcd_barrier_post(const Params& p, unsigned* bar, volatile LAS unsigned* st) {
  XcdBarrier b; b.bar = bar; b.x = xb_xcc_id(); b.st = st;
  if (ltid() == 0) (void)xb_add(&bar[XB_XCNT(b.x)], 1u);
  return b;
}
DI void xcd_barrier_complete(unsigned* bar, unsigned x, unsigned& nloc, unsigned& nx) {
  const unsigned G = gridDim.x * gridDim.y * gridDim.z;
  unsigned sum, cnt, mine, sp = 0u;
  for (;;) {
    sum = 0u; cnt = 0u; mine = 0u;
#pragma unroll
    for (unsigned j = 0; j < 16; ++j) { const unsigned c = xb_ld(&bar[XB_XCNT(j)]); sum += c; cnt += (c > 0u) ? 1u : 0u; mine = (j == x) ? c : mine; }
    if (sum == G) break;
    __builtin_amdgcn_s_sleep(1);
    if ((++sp & 255u) == 0u) { if (xb_ld(&bar[XB_TMO])) break; if (sp > XB_SPIN_CAP) { atomicAdd(&bar[XB_TMO], 1u); break; } }
  }
  nloc = mine > 0u ? mine : 1u; nx = cnt > 0u ? cnt : 1u;
}
DI void xcd_barrier(const Params& p, const XcdBarrier& b) {
  asm volatile("s_waitcnt vmcnt(0)" ::: "memory");
  __syncthreads();
  if (ltid() == 0) {
    unsigned* bar = b.bar;
    __builtin_amdgcn_s_waitcnt(0);
    unsigned nloc = b.st[0], nx = b.st[1];
    if (nloc == 0u) { xcd_barrier_complete(bar, b.x, nloc, nx); b.st[0] = nloc; b.st[1] = nx; }
    const unsigned old = xb_add(&bar[XB_XSUB(b.x)], 1u);
    const unsigned gen = old / nloc;
    if (old + 1u == (gen + 1u) * nloc) {
      __builtin_amdgcn_fence(__ATOMIC_RELEASE, "agent");
      asm volatile("s_waitcnt vmcnt(0)" ::: "memory");
      const unsigned og = xb_add(&bar[XB_TOP], 1u);
      const unsigned tg = og / nx;
      if (og + 1u == (tg + 1u) * nx) xb_add(&bar[XB_TOPGEN], 1u);
      else XB_SPIN(xb_ld(&bar[XB_TOPGEN]) == tg, bar);
      __builtin_amdgcn_fence(__ATOMIC_ACQUIRE, "agent");
      xb_add(&bar[XB_XGEN(b.x)], 1u);
      asm volatile("s_waitcnt vmcnt(0)" ::: "memory");
    } else {
      XB_SPIN(xb_ld(&bar[XB_XGEN(b.x)]) == gen, bar);
      __builtin_amdgcn_fence(__ATOMIC_ACQUIRE, "agent");
      asm volatile("s_waitcnt vmcnt(0)" ::: "memory");
    }
  }
  __syncthreads();
}

constexpr int NPHASE = 3 + 9 * 2;
DI void run_phase(const Params& p0, int ph, char* smem) {
  Params p = p0;
  asm volatile("" : "+s"(p.ws), "+s"(p.out));
  p.ws = as_global(p.ws); p.out = as_global(p.out);
  if (ph == 0) { phase0(p, smem); return; }
  if (ph == 1) { phase1(p); return; }
  if (ph == 2) { tok_phase(p, 0, 0); return; }
  const int l = (ph - 3) / 9, s = (ph - 3) % 9;
  switch (s) {
    case 0: phase_inproj(p, smem); break;
    case 1: phase_scan(p, l, smem); break;
    case 2: phase_combine(p, l, smem); break;
    case 3: phase_merge(p, l, smem); break;
    case 4: phase_gemm_f32(p, (const bf16_t*)(p.ws + OFF_MERGED), 1024, (const bf16_t*)(p.ws + OFF_WTOUT), smem); break;
    case 5: tok_phase(p, l, 1); break;
    case 6: phase_ffn_in(p, smem); break;
    case 7: phase_gemm_f32(p, (const bf16_t*)(p.ws + OFF_ACT), DFF, (const bf16_t*)(p.ws + OFF_WTFO), smem); break;
    case 8:
      tok_phase(p, l, 2);
      if (l + 1 < 2) {
        conv_weight(p, p.in[I_WIN] + (size_t)(l + 1) * 1024 * DIN, DIN, (bf16_t*)(p.ws + OFF_WTIN), 1024, WTIN_ROWS, 0, (float*)smem, blockIdx.x, gridDim.x);
        for (int br = 0; br < 3; ++br) conv_weight(p, p.in[I_WBR] + ((size_t)(l + 1) * 3 + br) * 512 * 1024, 1024, (bf16_t*)(p.ws + OFF_WTBR) + (size_t)br * 1024 * 512, 512, 1024, 1, (float*)smem, blockIdx.x, gridDim.x);
      }
      break;
  }
}

template <bool COOP>
__global__ void __launch_bounds__(NTHR, 2) mega(Params pk, int lo, int hi) {
  __shared__ __attribute__((aligned(16))) char smem[LDS_BYTES];
  Params p = pk;
#pragma unroll
  for (int i = 0; i < N_IN; ++i) p.in[i] = as_global(p.in[i]);
  p.ws = as_global(p.ws); p.out = as_global(p.out);
  p.wb = __builtin_amdgcn_readfirstlane((int)threadIdx.x) & ~63;
  if (COOP) {
    volatile LAS unsigned* st = (volatile LAS unsigned*)(smem + LDS_BYTES - 32);
    if (ltid() == 0) { st[0] = 0u; st[1] = 0u; }
    __syncthreads();
    phase0(p, smem);
    cg::this_grid().sync();
    XcdBarrier b = xcd_barrier_post(p, (unsigned*)(p.ws + OFF_BAR), st);
    if (ltid() == 0) {
      const unsigned hwid = (unsigned)__builtin_amdgcn_s_getreg((31 << 11) | 4);
      const unsigned key = (xb_xcc_id() << 8) | ((hwid >> 8) & 0xFFu);
      ((int*)smem)[(LDS_BYTES - 12) / 4] = (int)xb_add((unsigned*)(p.ws + OFF_ROLE) + key, 1u);
    }
    __syncthreads();
    p.role = __builtin_amdgcn_readfirstlane(((int*)smem)[(LDS_BYTES - 12) / 4]);
    for (int ph = 1; ph < hi; ++ph) {
      run_phase(p, ph, smem);
      if (ph + 1 < hi) xcd_barrier(p, b);
    }
  } else {
    for (int ph = lo; ph < hi; ++ph) run_phase(p, ph, smem);
  }
}

extern "C" void kernel_launch(void* const* d_in, const int* in_sizes, int n_in, void* d_out, int out_size, void* d_ws, size_t ws_size, hipStream_t stream) {
  Params p{};
  for (int i = 0; i < N_IN; ++i) p.in[i] = (const float*)d_in[i];
  p.out = (float*)d_out; p.ws = (char*)d_ws;
  if (ws_size < WS_NEED) fprintf(stderr, "workspace too small: %zu < %zu\n", ws_size, (size_t)WS_NEED);
  static int grid_blocks = 0;
  if (!grid_blocks) {
    int dev = 0, cus = 0, per_cu = 0;
    hipGetDevice(&dev);
    hipDeviceGetAttribute(&cus, hipDeviceAttributeMultiprocessorCount, dev);
    hipOccupancyMaxActiveBlocksPerMultiprocessor(&per_cu, mega<true>, NTHR, 0);
    if (per_cu > 2) per_cu = 2;
    grid_blocks = cus * per_cu;
  }
  int lo = 0, hi = NPHASE;
  void* args[] = {&p, &lo, &hi};
  hipError_t e = hipLaunchCooperativeKernel((void*)mega<true>, dim3(grid_blocks), dim3(NTHR), args, 0, stream);
  if (e != hipSuccess) fprintf(stderr, "cooperative launch failed: %s (grid %d)\n", hipGetErrorString(e), grid_blocks);
}
```

```cpp
#include <hip/hip_runtime.h>
#include <hip/hip_cooperative_groups.h>
#include <cstdio>
namespace cg = cooperative_groups;

typedef unsigned short bf16_t;
typedef short bf16x8 __attribute__((ext_vector_type(8)));
typedef float f32x4 __attribute__((ext_vector_type(4)));
typedef float f32x2 __attribute__((ext_vector_type(2)));
typedef float f32x16 __attribute__((ext_vector_type(16)));
typedef unsigned short u16x4 __attribute__((ext_vector_type(4)));
typedef unsigned short u16x2 __attribute__((ext_vector_type(2)));
typedef unsigned u32x4 __attribute__((ext_vector_type(4)));
typedef unsigned u32x2 __attribute__((ext_vector_type(2)));
static __device__ __forceinline__ unsigned pk2(float lo, float hi) { typedef __bf16 b2 __attribute__((ext_vector_type(2))); typedef float f2 __attribute__((ext_vector_type(2))); return __builtin_bit_cast(unsigned, __builtin_convertvector((f2){lo, hi}, b2)); }

#define DI __device__ __forceinline__
#define GAS __attribute__((address_space(1)))
template <class T> static __device__ __forceinline__ T* as_global(T* q) { return (T*)(GAS T*)(unsigned long long)q; }

constexpr int NT = 16384;
constexpr int DM = 1024;
constexpr int NTHR = 256;
constexpr int DIN = 9616;
constexpr int ZHW = 2560, ZRW = 1920, ZMW = 2048;
constexpr int WTIN_ROWS = 9728;
constexpr int DFF = 2816;

constexpr size_t OFF_WTIN = 0;
constexpr size_t OFF_WTBR = OFF_WTIN + (size_t)WTIN_ROWS * 1024 * 2;
constexpr size_t OFF_H    = OFF_WTBR + (size_t)3 * 1024 * 512 * 2;
constexpr size_t OFF_ZH   = OFF_H + (size_t)NT * 1024 * 2;
constexpr size_t OFF_ZR   = OFF_ZH + (size_t)NT * ZHW * 2;
constexpr size_t OFF_ZM   = OFF_ZR + (size_t)NT * ZRW * 2;
constexpr size_t OFF_MG   = OFF_ZM + (size_t)NT * ZMW * 2;
constexpr size_t OFF_O    = OFF_MG + (size_t)NT * 16 * 4;
constexpr size_t OFF_MOD  = OFF_O + (size_t)NT * 1024 * 2;
constexpr size_t OFF_LBS  = OFF_MOD + (size_t)2 * 5 * 6144 * 4;
constexpr size_t OFF_CTR  = OFF_LBS + 2 * 512 * 4;
constexpr size_t OFF_BAR  = OFF_CTR + 256;
constexpr size_t OFF_ROLE = OFF_BAR + 3456 * 4;
constexpr size_t WS_NEED  = OFF_ROLE + 4096 * 4;
constexpr size_t OFF_MODP = OFF_ZH;
constexpr size_t OFF_WTOUT = OFF_ZR;
constexpr size_t OFF_WTFI  = OFF_WTOUT + (size_t)1024 * 1024 * 2;
constexpr size_t OFF_WTFO  = OFF_WTFI + (size_t)5632 * 1024 * 2;
constexpr size_t OFF_MERGED = OFF_WTFO + (size_t)1024 * 2816 * 2;
constexpr size_t OFF_Y    = OFF_ZH;
constexpr size_t OFF_ACT  = OFF_ZM;

constexpr size_t OUT_HG = 16777216, OUT_RW = 25165824, OUT_C = 29360128, OUT_N = 37748736, OUT_M = 37814272;

enum { I_XP = 0, I_XS, I_SH, I_SR, I_SC, I_SN, I_SM, I_C, I_CCTX, I_WADA, I_BADA, I_NORMS, I_WIN, I_HLB, I_HNORM, I_MU, I_W0, I_W2,
       I_A0, I_A2, I_G2, I_KK, I_KA, I_RK, I_LN, I_GB, I_MNORM, I_WBR, I_WOUT, I_WFI, I_WFO, N_IN };

struct Params { const float* in[N_IN]; float* out; char* ws; int wb; int role; };

constexpr int LDS_BYTES = 77824;

DI bf16_t f2bf(float f) { return __builtin_bit_cast(unsigned short, (__bf16)f); }
DI float bf2f(bf16_t h) { return __uint_as_float(((unsigned)h) << 16); }
DI float sigmoidf_(float x) { return 1.0f / (1.0f + __expf(-x)); }
DI float siluf_(float x) { return x / (1.0f + __expf(-x)); }
DI float softplusf_(float x) { return x > 20.f ? x : __logf(1.0f + __expf(x)); }
DI float dpp_xor1(float x) { return __int_as_float(__builtin_amdgcn_mov_dpp(__float_as_int(x), 0xB1, 0xF, 0xF, true)); }
DI float dpp_xor2(float x) { return __int_as_float(__builtin_amdgcn_mov_dpp(__float_as_int(x), 0x4E, 0xF, 0xF, true)); }
DI float shfl_lane(float v, int src) { return __int_as_float(__builtin_amdgcn_ds_bpermute(src << 2, __float_as_int(v))); }
#define SHX(v, m) shfl_lane((v), lane ^ (m))
DI float wave_sum(float v, int lane) { v += dpp_xor1(v); v += dpp_xor2(v); v += SHX(v, 4); v += SHX(v, 8); v += SHX(v, 16); v += SHX(v, 32); return v; }
DI int ltid_(int wb) { int t = wb + (int)__builtin_amdgcn_mbcnt_hi(~0u, __builtin_amdgcn_mbcnt_lo(~0u, 0u)); asm volatile("" : "+v"(t)); return t; }
#define ltid() ltid_(p.wb)
DI int crow(int reg, int h) { return (reg & 3) + 8 * (reg >> 2) + 4 * h; }

DI int tok_cond(int tok) { return tok < 8192 ? 0 : 1 + ((tok - 8192) >> 11); }
DI const float* x_in_row(const Params& p, int tok) { return tok < 8192 ? p.in[I_XP] + (size_t)tok * DM : p.in[I_XS] + (size_t)(tok - 8192) * DM; }

DI void mma32(f32x16& acc, const bf16_t* A, int lda, const bf16_t* B, int ldb, int K, int lane) {
  const int r = lane & 31, h = lane >> 5;
#pragma unroll 2
  for (int kk = 0; kk < K; kk += 16) {
    bf16x8 a = *(const bf16x8*)(A + r * lda + kk + 8 * h);
    bf16x8 b = *(const bf16x8*)(B + r * ldb + kk + 8 * h);
    acc = __builtin_amdgcn_mfma_f32_32x32x16_bf16(a, b, acc, 0, 0, 0);
  }
}

template <int BM, int BN, int BK, bool WR, bool LD>
DI void gemm_ktile(f32x4 (&acc)[BM / 32][BN / 32], bf16x8 (&ra)[BM * BK / 2048], bf16x8 (&rb)[BN * BK / 2048],
                   const bf16_t* __restrict__ A, int lda, const bf16_t* __restrict__ B, int ldb, int k2,
                   const bf16_t* as, const bf16_t* bs, bf16_t* Aw, bf16_t* Bw) {
  constexpr int MI = BM / 32, NJ = BN / 32, LS = BK + 8, ACH = BM * BK / 2048, BCH = BN * BK / 2048, KS = BK / 32, RPI = 256 / (BK / 8);
  static_assert(KS * MI >= ACH + BCH, "not enough MFMA row blocks to carry the staging");
  __builtin_amdgcn_s_setprio(1);
#pragma unroll
  for (int ks = 0; ks < KS; ++ks) {
    bf16x8 bfr[NJ];
#pragma unroll
    for (int j = 0; j < NJ; ++j) bfr[j] = *(const bf16x8*)(bs + j * 16 * LS + ks * 32);
    bf16x8 afn = *(const bf16x8*)(as + ks * 32);
#pragma unroll
    for (int i = 0; i < MI; ++i) {
      const bf16x8 af = afn;
      if (i + 1 < MI) afn = *(const bf16x8*)(as + (i + 1) * 16 * LS + ks * 32);
#pragma unroll
      for (int j = 0; j < NJ; ++j) acc[i][j] = __builtin_amdgcn_mfma_f32_16x16x32_bf16(bfr[j], af, acc[i][j], 0, 0, 0);
      const int s = ks * MI + i;
      if (s < ACH) {
        if (WR) *(bf16x8*)(Aw + RPI * s * LS) = ra[s < ACH ? s : 0];
        if (LD) ra[s < ACH ? s : 0] = *(const bf16x8*)(A + (size_t)(RPI * s) * lda + k2);
      } else if (s < ACH + BCH) {
        const int c = s - ACH;
        if (WR) *(bf16x8*)(Bw + RPI * c * LS) = rb[(c >= 0 && c < BCH) ? c : 0];
        if (LD) rb[(c >= 0 && c < BCH) ? c : 0] = *(const bf16x8*)(B + (size_t)(RPI * c) * ldb + k2);
      }
      __builtin_amdgcn_sched_barrier(0);
    }
  }
  __builtin_amdgcn_s_setprio(0);
}

template <int BM, int BN, int BK>
DI void gemm_main(const Params& p, f32x4 (&acc)[BM / 32][BN / 32], const bf16_t* __restrict__ A, int lda, const bf16_t* __restrict__ B, int ldb, int K, bf16_t* sm) {
  constexpr int LS = BK + 8, CPR = BK / 8, ACH = BM * BK / 2048, BCH = BN * BK / 2048, RPI = 256 / CPR;
  const int tid = ltid(), lane = tid & 63, w = tid >> 6, wm = w >> 1, wn = w & 1;
  bf16_t* As = sm; bf16_t* Bs = sm + 2 * BM * LS;
  bf16x8 ra[ACH], rb[BCH];
  const int nk = K / BK;
  const int lrow = tid / CPR, lkc = (tid % CPR) * 8;
  const bf16_t* Ag = A + (size_t)lrow * lda + lkc;
  const bf16_t* Bg = B + (size_t)lrow * ldb + lkc;
  bf16_t* Al = As + lrow * LS + lkc; bf16_t* Bl = Bs + lrow * LS + lkc;
#pragma unroll
  for (int i = 0; i < ACH; ++i) ra[i] = *(const bf16x8*)(Ag + (size_t)(RPI * i) * lda);
#pragma unroll
  for (int i = 0; i < BCH; ++i) rb[i] = *(const bf16x8*)(Bg + (size_t)(RPI * i) * ldb);
  __syncthreads();
#pragma unroll
  for (int i = 0; i < ACH; ++i) *(bf16x8*)(Al + RPI * i * LS) = ra[i];
#pragma unroll
  for (int i = 0; i < BCH; ++i) *(bf16x8*)(Bl + RPI * i * LS) = rb[i];
  if (nk > 1) {
#pragma unroll
    for (int i = 0; i < ACH; ++i) ra[i] = *(const bf16x8*)(Ag + (size_t)(RPI * i) * lda + BK);
#pragma unroll
    for (int i = 0; i < BCH; ++i) rb[i] = *(const bf16x8*)(Bg + (size_t)(RPI * i) * ldb + BK);
  }
  __syncthreads();
  const bf16_t* as0 = As + (wm * (BM / 2) + (lane & 15)) * LS + (lane >> 4) * 8;
  const bf16_t* bs0 = Bs + (wn * (BN / 2) + (lane & 15)) * LS + (lane >> 4) * 8;
  int kt = 0;
  for (; kt + 2 < nk; ++kt) {
    const int buf = kt & 1, nb = buf ^ 1;
    gemm_ktile<BM, BN, BK, true, true>(acc, ra, rb, Ag, lda, Bg, ldb, (kt + 2) * BK, as0 + buf * BM * LS, bs0 + buf * BN * LS, Al + nb * BM * LS, Bl + nb * BN * LS);
    __syncthreads();
  }
  for (; kt < nk; ++kt) {
    const int buf = kt & 1, nb = buf ^ 1;
    if (kt + 1 < nk) gemm_ktile<BM, BN, BK, true, false>(acc, ra, rb, Ag, lda, Bg, ldb, 0, as0 + buf * BM * LS, bs0 + buf * BN * LS, Al + nb * BM * LS, Bl + nb * BN * LS);
    else gemm_ktile<BM, BN, BK, false, false>(acc, ra, rb, Ag, lda, Bg, ldb, 0, as0 + buf * BM * LS, bs0 + buf * BN * LS, Al + nb * BM * LS, Bl + nb * BN * LS);
    __syncthreads();
  }
}

template <int MI, int NJ> DI void zero_acc(f32x4 (&acc)[MI][NJ]) {
#pragma unroll
  for (int i = 0; i < MI; ++i)
#pragma unroll
    for (int j = 0; j < NJ; ++j) acc[i][j] = (f32x4){0.f, 0.f, 0.f, 0.f};
}
DI void store_bf4(bf16_t* dst, f32x4 v) { u16x4 o; o[0] = f2bf(v[0]); o[1] = f2bf(v[1]); o[2] = f2bf(v[2]); o[3] = f2bf(v[3]); *(u16x4*)dst = o; }

DI int map_col(int mode, int n) {
  if (mode == 0) return n < 6544 ? n : (n < 6656 ? -1 : n - 112);
  if (mode == 2) return ((n >> 4) & 1) ? DFF + (n >> 5) * 16 + (n & 15) : (n >> 5) * 16 + (n & 15);
  return n;
}
DI void conv_tile(const Params& p, const float* __restrict__ src, int ld_src, bf16_t* __restrict__ dst, int K, int mode, int tk, int tn, float* sm) {
  const int tid = ltid();
  __syncthreads();
  {
    const int nn = tid & 63, col = map_col(mode, tn * 64 + nn);
#pragma unroll
    for (int i = 0; i < 16; ++i) { int kk = (tid >> 6) + 4 * i; sm[kk * 65 + nn] = col >= 0 ? src[(size_t)(tk * 64 + kk) * ld_src + col] : 0.f; }
  }
  __syncthreads();
  {
    const int kk = tid & 63;
#pragma unroll
    for (int i = 0; i < 16; ++i) { int nn = (tid >> 6) + 4 * i; dst[(size_t)(tn * 64 + nn) * K + tk * 64 + kk] = f2bf(sm[kk * 65 + nn]); }
  }
}
DI void conv_weight(const Params& p, const float* src, int ld_src, bf16_t* dst, int K, int Ndst, int mode, float* sm, int bid, int nb) {
  const int tkn = K / 64, nt = tkn * (Ndst / 64);
  for (int t = bid; t < nt; t += nb) conv_tile(p, src, ld_src, dst, K, mode, t % tkn, t / tkn, sm);
}

DI void phase0(const Params& p, char* smem) {
  const int tid = ltid(), bid = blockIdx.x, nb = gridDim.x;
  float* MODP = (float*)(p.ws + OFF_MODP);
  float* sm = (float*)smem;
  if (bid == 0) { if (tid < 64) ((int*)(p.ws + OFF_CTR))[tid] = 0; for (int i = tid; i < 3456; i += NTHR) ((unsigned*)(p.ws + OFF_BAR))[i] = 0u; for (int i = tid; i < 4096; i += NTHR) ((unsigned*)(p.ws + OFF_ROLE))[i] = 0u; }
  for (int i = bid * NTHR + tid; i < 512; i += nb * NTHR) {
    float a = p.in[I_HLB][i], b = p.in[I_HLB][512 + i];
    float* L = (float*)(p.ws + OFF_LBS); L[i] = 0.f; L[512 + i] = 1.0f / (1.0f + expf(a - b));
  }
  for (int it = bid; it < 2 * 24 * 16; it += nb) {
    const int ks = it & 15, jb = (it >> 4) % 24, l = it / (16 * 24);
    __syncthreads();
    for (int e = tid; e < 5 * 64; e += NTHR) { int ci = e >> 6, k = ks * 64 + (e & 63); float cv = ci == 0 ? p.in[I_CCTX][k] : p.in[I_C][(ci - 1) * DM + k]; sm[e] = siluf_(cv); }
    __syncthreads();
    const int j = jb * 256 + tid;
    float a0 = 0, a1 = 0, a2 = 0, a3 = 0, a4 = 0;
    const float* W = p.in[I_WADA] + ((size_t)l * DM + ks * 64) * 6144 + j;
#pragma unroll 1
    for (int k0 = 0; k0 < 64; k0 += 16) {
      float wv[16];
#pragma unroll
      for (int u = 0; u < 16; ++u) wv[u] = W[(size_t)(k0 + u) * 6144];
#pragma unroll
      for (int u = 0; u < 16; ++u) { const int k = k0 + u; const float w = wv[u]; a0 += sm[k] * w; a1 += sm[64 + k] * w; a2 += sm[128 + k] * w; a3 += sm[192 + k] * w; a4 += sm[256 + k] * w; }
    }
    float* dst = MODP + ((size_t)(ks * 2 + l) * 5) * 6144 + j;
    dst[0] = a0; dst[6144] = a1; dst[2 * 6144] = a2; dst[3 * 6144] = a3; dst[4 * 6144] = a4;
  }
  conv_weight(p, p.in[I_WIN], DIN, (bf16_t*)(p.ws + OFF_WTIN), 1024, WTIN_ROWS, 0, sm, bid, nb);
  for (int br = 0; br < 3; ++br) conv_weight(p, p.in[I_WBR] + (size_t)br * 512 * 1024, 1024, (bf16_t*)(p.ws + OFF_WTBR) + (size_t)br * 1024 * 512, 512, 1024, 1, sm, bid, nb);
}
DI void phase1(const Params& p) {
  const float* MODP = (const float*)(p.ws + OFF_MODP);
  float* MOD = (float*)(p.ws + OFF_MOD);
  for (int i = blockIdx.x * NTHR + ltid(); i < 2 * 5 * 6144; i += gridDim.x * NTHR) {
    const int j = i % 6144, l = i / (5 * 6144);
    float s = p.in[I_BADA][l * 6144 + j];
    for (int ks = 0; ks < 16; ++ks) s += MODP[(size_t)ks * 2 * 5 * 6144 + i];
    MOD[i] = s;
  }
}

DI void norm_mod_store(const f32x4 (&x)[4], const float* nw, const float* sc, const float* sh, bf16_t* hrow, int lane) {
  float ss = 0.f;
#pragma unroll
  for (int i = 0; i < 4; ++i) ss += x[i][0] * x[i][0] + x[i][1] * x[i][1] + x[i][2] * x[i][2] + x[i][3] * x[i][3];
  ss = wave_sum(ss, lane);
  const float rs = rsqrtf(ss * (1.0f / DM) + 1e-6f);
#pragma unroll
  for (int i = 0; i < 4; ++i) {
    const int c = i * 256 + lane * 4;
    f32x4 w = *(const f32x4*)(nw + c), s1 = *(const f32x4*)(sc + c), s0 = *(const f32x4*)(sh + c), o;
#pragma unroll
    for (int e = 0; e < 4; ++e) o[e] = x[i][e] * rs * w[e] * (1.0f + s1[e]) + s0[e];
    store_bf4(hrow + c, o);
  }
}
DI void tok_one(const Params& p, int l, int mode, int tok, int lane) {
  const float* MOD = (const float*)(p.ws + OFF_MOD);
  bf16_t* H = (bf16_t*)(p.ws + OFF_H);
  const float* Y = (const float*)(p.ws + OFF_Y);
  const int ci = tok_cond(tok);
  const float* modl = MOD + (size_t)(l * 5 + ci) * 6144;
  const float* nwl = p.in[I_NORMS] + (size_t)l * 4 * DM;
  const bool from_in = (l == 0 && (mode == 0 || mode == 1 || mode == 3));
  const float* xr = from_in ? x_in_row(p, tok) : p.out + (size_t)tok * DM;
  const bool has_y = (mode == 1 || mode == 2);
  const bool has_h = !(mode == 2 && l + 1 >= 2);
  const float* modn = (mode == 2 && has_h) ? MOD + (size_t)((l + 1) * 5 + ci) * 6144 : modl;
  const float* nw2 = mode == 1 ? nwl + 2 * DM : (mode == 2 ? p.in[I_NORMS] + (size_t)(has_h ? l + 1 : l) * 4 * DM : nwl);
  const float* sc2 = mode == 1 ? modl + 4 * DM : modn + 1 * DM;
  const float* sh2 = mode == 1 ? modl + 3 * DM : modn + 0 * DM;
  const float* nwy = nwl + (mode == 1 ? 1 : 3) * DM;
  const float* gy = modl + (mode == 1 ? 2 : 5) * DM;
  f32x4 x[4], y[4], wy[4], gg[4], w2[4], s1[4], s0[4];
#pragma unroll
  for (int i = 0; i < 4; ++i) {
    const int c = i * 256 + lane * 4;
    x[i] = *(const f32x4*)(xr + c);
    if (has_y) { y[i] = *(const f32x4*)(Y + (size_t)tok * DM + c); wy[i] = *(const f32x4*)(nwy + c); gg[i] = *(const f32x4*)(gy + c); }
    if (has_h) { w2[i] = *(const f32x4*)(nw2 + c); s1[i] = *(const f32x4*)(sc2 + c); s0[i] = *(const f32x4*)(sh2 + c); }
  }
  if (has_y) {
    float ss = 0.f;
#pragma unroll
    for (int i = 0; i < 4; ++i) ss += y[i][0] * y[i][0] + y[i][1] * y[i][1] + y[i][2] * y[i][2] + y[i][3] * y[i][3];
    ss = wave_sum(ss, lane);
    const float rs = rsqrtf(ss * (1.0f / DM) + 1e-6f);
#pragma unroll
    for (int i = 0; i < 4; ++i) {
      const int c = i * 256 + lane * 4;
#pragma unroll
      for (int e = 0; e < 4; ++e) x[i][e] += gg[i][e] * (y[i][e] * rs * wy[i][e]);
      *(f32x4*)(p.out + (size_t)tok * DM + c) = x[i];
    }
  }
  if (has_h) {
    float ss = 0.f;
#pragma unroll
    for (int i = 0; i < 4; ++i) ss += x[i][0] * x[i][0] + x[i][1] * x[i][1] + x[i][2] * x[i][2] + x[i][3] * x[i][3];
    ss = wave_sum(ss, lane);
    const float rs = rsqrtf(ss * (1.0f / DM) + 1e-6f);
#pragma unroll
    for (int i = 0; i < 4; ++i) {
      f32x4 o;
#pragma unroll
      for (int e = 0; e < 4; ++e) o[e] = x[i][e] * rs * w2[i][e] * (1.0f + s1[i][e]) + s0[i][e];
      store_bf4(H + (size_t)tok * DM + i * 256 + lane * 4, o);
    }
  }
}
DI void tok_phase(const Params& p, int l, int mode) {
  const int lane = ltid() & 63, gw = blockIdx.x * 4 + (ltid() >> 6), nw = gridDim.x * 4;
  for (int tok = gw; tok < NT; tok += nw) tok_one(p, l, mode, tok, lane);
}

DI bool tile_xcd(int i, int NTN, int MTX, int& mt, int& nt) {
  const int G = gridDim.x, b = blockIdx.x, x = b & 7, j = b >> 3, nbx = (G - x + 7) >> 3;
  const int u = j + i * nbx;
  if (u >= MTX * NTN) return false;
  mt = MTX * x + (u % MTX); nt = u / MTX;
  return true;
}
DI void phase_inproj(const Params& p, char* smem) {
  const bf16_t* H = (const bf16_t*)(p.ws + OFF_H);
  const bf16_t* WT = (const bf16_t*)(p.ws + OFF_WTIN);
  bf16_t* ZH = (bf16_t*)(p.ws + OFF_ZH); bf16_t* ZR = (bf16_t*)(p.ws + OFF_ZR); bf16_t* ZM = (bf16_t*)(p.ws + OFF_ZM);
  float* MG = (float*)(p.ws + OFF_MG);
  const int lane = ltid() & 63, w = ltid() >> 6, wm = w >> 1, wn = w & 1;
  int mt, nt;
  for (int ti = 0; tile_xcd(ti, 52, 8, mt, nt); ++ti) {
    f32x4 acc[8][4]; zero_acc<8, 4>(acc);
    gemm_main<256, 128, 32>(p, acc, H + (size_t)mt * 256 * 1024, 1024, WT + (size_t)nt * 128 * 1024, 1024, 1024, (bf16_t*)smem);
    const int n0 = nt * 128;
#pragma unroll
    for (int i = 0; i < 8; ++i) {
      const int row = mt * 256 + wm * 128 + i * 16 + (lane & 15);
#pragma unroll
      for (int j = 0; j < 4; ++j) {
        const int col = n0 + wn * 64 + j * 16 + 4 * (lane >> 4);
        if (n0 < 2560) store_bf4(ZH + (size_t)row * ZHW + col, acc[i][j]);
        else if (n0 < 4480) store_bf4(ZR + (size_t)row * ZRW + (col - 2560), acc[i][j]);
        else if (n0 < 6528) store_bf4(ZM + (size_t)row * ZMW + (col - 4480), acc[i][j]);
        else if (col - 6528 < 16) *(f32x4*)(MG + (size_t)row * 16 + (col - 6528)) = acc[i][j];
      }
    }
  }
}

DI void phase_merge(const Params& p, int l, char* smem) {
  const bf16_t* H = (const bf16_t*)(p.ws + OFF_H);
  const bf16_t* WT = (const bf16_t*)(p.ws + OFF_WTIN);
  const bf16_t* WBR = (const bf16_t*)(p.ws + OFF_WTBR);
  const bf16_t* ZH = (const bf16_t*)(p.ws + OFF_ZH); const bf16_t* ZM = (const bf16_t*)(p.ws + OFF_ZM); const bf16_t* O = (const bf16_t*)(p.ws + OFF_O);
  bf16_t* MER = (bf16_t*)(p.ws + OFF_MERGED);
  const int lane = ltid() & 63, w = ltid() >> 6, wm = w >> 1, wn = w & 1;
  int mt, nt;
  for (int ti = 0; tile_xcd(ti, 16, 16, mt, nt); ++ti) {
    f32x4 accM[4][2]; zero_acc<4, 2>(accM);
#pragma unroll 1
    for (int br = 0; br < 3; ++br) {
      f32x4 accG[4][2], accP[4][2]; zero_acc<4, 2>(accG); zero_acc<4, 2>(accP);
      gemm_main<128, 64, 64>(p, accG, H + (size_t)mt * 128 * 1024, 1024, WT + (size_t)(6656 + br * 1024 + nt * 64) * 1024, 1024, 1024, (bf16_t*)smem);
      const bf16_t* Ab; int lda;
      if (br == 0) { Ab = ZH + 2048; lda = ZHW; } else if (br == 1) { Ab = O; lda = 1024; } else { Ab = ZM + 1536; lda = ZMW; }
      gemm_main<128, 64, 64>(p, accP, Ab + (size_t)mt * 128 * lda, lda, WBR + ((size_t)br * 1024 + nt * 64) * 512, 512, 512, (bf16_t*)smem);
#pragma unroll
      for (int i = 0; i < 4; ++i)
#pragma unroll
        for (int j = 0; j < 2; ++j)
#pragma unroll
          for (int e = 0; e < 4; ++e) accM[i][j][e] += sigmoidf_(accG[i][j][e]) * accP[i][j][e];
    }
#pragma unroll
    for (int i = 0; i < 4; ++i) {
      const int row = mt * 128 + wm * 64 + i * 16 + (lane & 15);
#pragma unroll
      for (int j = 0; j < 2; ++j) store_bf4(MER + (size_t)row * 1024 + nt * 64 + wn * 32 + j * 16 + 4 * (lane >> 4), accM[i][j]);
    }
  }
  float* sm = (float*)smem;
  conv_weight(p, p.in[I_WOUT] + (size_t)l * 1024 * 1024, 1024, (bf16_t*)(p.ws + OFF_WTOUT), 1024, 1024, 1, sm, blockIdx.x, gridDim.x);
  conv_weight(p, p.in[I_WFI] + (size_t)l * 1024 * 5632, 5632, (bf16_t*)(p.ws + OFF_WTFI), 1024, 5632, 2, sm, blockIdx.x, gridDim.x);
  conv_weight(p, p.in[I_WFO] + (size_t)l * DFF * 1024, 1024, (bf16_t*)(p.ws + OFF_WTFO), DFF, 1024, 1, sm, blockIdx.x, gridDim.x);
}

DI void phase_gemm_f32(const Params& p, const bf16_t* A, int K, const bf16_t* Wt, char* smem) {
  float* Y = (float*)(p.ws + OFF_Y);
  const int lane = ltid() & 63, w = ltid() >> 6, wm = w >> 1, wn = w & 1;
  int mt, nt;
  for (int ti = 0; tile_xcd(ti, 8, 8, mt, nt); ++ti) {
    f32x4 acc[8][4]; zero_acc<8, 4>(acc);
    gemm_main<256, 128, 32>(p, acc, A + (size_t)mt * 256 * K, K, Wt + (size_t)nt * 128 * K, K, K, (bf16_t*)smem);
#pragma unroll
    for (int i = 0; i < 8; ++i) {
      const int row = mt * 256 + wm * 128 + i * 16 + (lane & 15);
#pragma unroll
      for (int j = 0; j < 4; ++j) *(f32x4*)(Y + (size_t)row * 1024 + nt * 128 + wn * 64 + j * 16 + 4 * (lane >> 4)) = acc[i][j];
    }
  }
}
DI void phase_ffn_in(const Params& p, char* smem) {
  const bf16_t* H = (const bf16_t*)(p.ws + OFF_H);
  const bf16_t* Wt = (const bf16_t*)(p.ws + OFF_WTFI);
  bf16_t* ACT = (bf16_t*)(p.ws + OFF_ACT);
  const int lane = ltid() & 63, w = ltid() >> 6, wm = w >> 1, wn = w & 1;
  int mt, nt;
  for (int ti = 0; tile_xcd(ti, 44, 8, mt, nt); ++ti) {
    f32x4 acc[8][4]; zero_acc<8, 4>(acc);
    gemm_main<256, 128, 32>(p, acc, H + (size_t)mt * 256 * 1024, 1024, Wt + (size_t)nt * 128 * 1024, 1024, 1024, (bf16_t*)smem);
#pragma unroll
    for (int i = 0; i < 8; ++i) {
      const int row = mt * 256 + wm * 128 + i * 16 + (lane & 15);
#pragma unroll
      for (int jj = 0; jj < 2; ++jj) {
        f32x4 u = acc[i][2 * jj], g = acc[i][2 * jj + 1], o;
#pragma unroll
        for (int e = 0; e < 4; ++e) o[e] = siluf_(g[e]) * u[e];
        const int col = (nt * 128 + wn * 64 + jj * 32) / 2 + 4 * (lane >> 4);
        store_bf4(ACT + (size_t)row * DFF + col, o);
      }
    }
  }
}

struct Seq { int base, T, grid, b; bool sample; };
DI Seq get_seq(int s) { Seq q; if (s < 32) { q.base = s * 256; q.T = 256; q.grid = 0; q.b = s; q.sample = false; } else { q.b = s - 32; q.base = 8192 + q.b * 2048; q.T = 2048; q.grid = 1; q.sample = true; } return q; }

DI float rw_shift(const bf16_t* ZR, const float* mu, int base, int t, int T, int grid, int col) {
  const bf16_t* pp = ZR + (size_t)(base + t) * ZRW + col;
  const float y = bf2f(*pp);
  if (!grid) {
    const float prev = t > 0 ? bf2f(pp[-ZRW]) : 0.f, nxt = t < T - 1 ? bf2f(pp[ZRW]) : 0.f;
    return y + mu[col] * (prev - y) + mu[ZRW + col] * (nxt - y);
  }
  const int gc = t & 63, gr = t >> 6;
  const float left = gc > 0 ? bf2f(pp[-ZRW]) : 0.f, right = gc < 63 ? bf2f(pp[ZRW]) : 0.f;
  const float up = gr > 0 ? bf2f(pp[-64 * ZRW]) : 0.f, down = gr < 31 ? bf2f(pp[64 * ZRW]) : 0.f;
  return y + mu[col] * (left - y) + mu[ZRW + col] * (right - y) + mu[2 * ZRW + col] * (up - y) + mu[3 * ZRW + col] * (down - y);
}

DI void rw_shift8(const bf16_t* ZR, const float* mu, int base, int t, int T, int grid, int col0, float (&out)[8]) {
  const bf16_t* pp = ZR + (size_t)(base + t) * ZRW + col0;
  const bf16x8 y = *(const bf16x8*)pp;
  float yv[8];
#pragma unroll
  for (int e = 0; e < 8; ++e) { yv[e] = bf2f((bf16_t)y[e]); out[e] = yv[e]; }
  const int nn = grid ? 4 : 2;
#pragma unroll 1
  for (int n = 0; n < nn; ++n) {
    bool valid; int off;
    if (!grid) { valid = n == 0 ? t > 0 : t < T - 1; off = n == 0 ? -ZRW : ZRW; }
    else { const int gc = t & 63, gr = t >> 6; valid = n == 0 ? gc > 0 : n == 1 ? gc < 63 : n == 2 ? gr > 0 : gr < 31; off = n == 0 ? -ZRW : n == 1 ? ZRW : n == 2 ? -64 * ZRW : 64 * ZRW; }
    const f32x4 m0 = *(const f32x4*)(mu + n * ZRW + col0), m1 = *(const f32x4*)(mu + n * ZRW + col0 + 4);
    bf16x8 nb = y;
    if (valid) nb = *(const bf16x8*)(pp + off);
#pragma unroll
    for (int e = 0; e < 8; ++e) { const float nv_ = valid ? bf2f((bf16_t)nb[e]) : 0.f; const float mm = e < 4 ? m0[e & 3] : m1[e & 3]; out[e] += mm * (nv_ - yv[e]); }
  }
}

DI void rw_load8(const bf16_t* ZR, int base, int t, int T, int grid, int col0, bf16x8 (&v)[5]) {
  const bf16_t* pp = ZR + (size_t)(base + t) * ZRW + col0;
  const int gc = t & 63, gr = t >> 6;
  const int o1 = grid ? (gc > 0 ? -ZRW : 0) : (t > 0 ? -ZRW : 0);
  const int o2 = grid ? (gc < 63 ? ZRW : 0) : (t < T - 1 ? ZRW : 0);
  v[0] = *(const bf16x8*)pp;
  v[1] = *(const bf16x8*)(pp + o1);
  v[2] = *(const bf16x8*)(pp + o2);
  if (grid) {
    v[3] = *(const bf16x8*)(pp + (gr > 0 ? -64 * ZRW : 0)); v[4] = *(const bf16x8*)(pp + (gr < 31 ? 64 * ZRW : 0));
  } else {
    v[3] = (bf16x8){0, 0, 0, 0, 0, 0, 0, 0}; v[4] = (bf16x8){0, 0, 0, 0, 0, 0, 0, 0};
  }
}
DI unsigned rw_valid(int t, int T, int grid) {
  if (!grid) return (t > 0 ? 1u : 0u) | (t < T - 1 ? 2u : 0u);
  const int gc = t & 63, gr = t >> 6;
  return (gc > 0 ? 1u : 0u) | (gc < 63 ? 2u : 0u) | (gr > 0 ? 4u : 0u) | (gr < 31 ? 8u : 0u);
}
DI void rw_apply8(const bf16x8 (&v)[5], const float* mu, int grid, unsigned valid, int col0, float (&out)[8]) {
  float yv[8];
#pragma unroll
  for (int e = 0; e < 8; ++e) { yv[e] = bf2f((bf16_t)v[0][e]); out[e] = yv[e]; }
#pragma unroll
  for (int n = 0; n < 4; ++n) {
    if (n < 2 || grid) {
      const f32x4 m0 = *(const f32x4*)(mu + n * ZRW + col0), m1 = *(const f32x4*)(mu + n * ZRW + col0 + 4);
      const bool ok = (valid >> n) & 1u;
#pragma unroll
      for (int e = 0; e < 8; ++e) out[e] += (e < 4 ? m0[e & 3] : m1[e & 3]) * ((ok ? bf2f((bf16_t)v[1 + n][e]) : 0.f) - yv[e]);
    }
  }
}
DI void rw_apply8_lds(const bf16x8 (&v)[5], const float* mu5c, const float* c0c, int grid, unsigned valid, float (&out)[8]) {
  {
    const f32x4 c0 = *(const f32x4*)c0c, c1 = *(const f32x4*)(c0c + 4);
#pragma unroll
    for (int e = 0; e < 8; ++e) out[e] = bf2f((bf16_t)v[0][e]) * (e < 4 ? c0[e & 3] : c1[e & 3]);
  }
#pragma unroll
  for (int n = 0; n < 4; ++n) {
    if (n < 2 || grid) {
      const f32x4 m0 = *(const f32x4*)(mu5c + n * 320), m1 = *(const f32x4*)(mu5c + n * 320 + 4);
      const float ok = ((valid >> n) & 1u) ? 1.0f : 0.0f;
#pragma unroll
      for (int e = 0; e < 8; ++e) out[e] += (e < 4 ? m0[e & 3] : m1[e & 3]) * ok * bf2f((bf16_t)v[1 + n][e]);
    }
  }
}
DI float fast_tanh(float x) { return 1.0f - 2.0f / (1.0f + __expf(2.0f * x)); }
template <int N> DI float dpp_row_shr0(float x) { return __int_as_float(__builtin_amdgcn_update_dpp(0, __float_as_int(x), 0x110 + N, 0xF, 0xF, false)); }

DI void rwkv_item(const Params& p, int l, int s, int hh, int d, char* smem) {
  const Seq q = get_seq(s);
  const int tid0 = ltid();
  const int w = __builtin_amdgcn_readfirstlane(tid0 >> 6), vb = w >> 1, kb = w & 1;
  int tid = tid0, lane = tid & 63, l15 = lane & 15, qq = lane >> 4, r32 = lane & 31, h = lane >> 5;
  const bf16_t* ZR = (const bf16_t*)(p.ws + OFF_ZR);
  bf16_t* O = (bf16_t*)(p.ws + OFF_O);
  const float* mu = p.in[I_MU] + (size_t)l * 4 * ZRW;
  bf16_t* KHr = (bf16_t*)smem;
  bf16_t* BCr = KHr + 16 * 72;
  bf16_t* KC = BCr + 16 * 72;
  bf16_t* RH = KC + 16 * 72;
  bf16_t* Sb = RH + 16 * 72;
  bf16_t* Wb2 = (bf16_t*)smem;
  bf16_t* Ab2 = Wb2 + 64 * 72;
  float* mu5 = (float*)(smem + 18432);
  bf16_t* actW = (bf16_t*)(smem + 23552);
  bf16_t* actA = actW + 16 * 72;
  float* shR = (float*)(smem + 28160);
  float* shK = shR + 1024; float* shV = shK + 1024;
  bf16_t* VT0 = (bf16_t*)(smem + 40448);
  bf16_t* VT1 = (bf16_t*)(smem + 69376);
  bf16_t* UNT = VT0 + 64 * 40;
  bf16_t* KBT = UNT + 64 * 40;
  bf16_t* BBT = KBT + 64 * 24;
  float* PL = (float*)(smem + 56832);
  float* npart = PL + 64;
  float* MN = (float*)(smem + 57344);
  float* G0 = (float*)(smem + 61440);
  bf16_t* ArkM = (bf16_t*)(smem + 65536);
  bf16_t* ArbM = ArkM + 16 * 40;
  float* c0t = (float*)(smem + 68096);
  __syncthreads();
  for (int e = tid; e < 4096; e += NTHR) {
    const int i = e >> 6, c = e & 63;
    Wb2[c * 72 + i] = f2bf(p.in[I_W2][((size_t)(l * 2 + d) * 64 + i) * 512 + 64 * hh + c]);
    Ab2[c * 72 + i] = f2bf(p.in[I_A2][((size_t)(l * 2 + d) * 64 + i) * 512 + 64 * hh + c]);
  }
  for (int e = tid; e < 1280; e += NTHR) {
    const int n = e / 320, rem = e % 320, arr = rem >> 6, c = rem & 63;
    const int col = arr == 0 ? 64 * hh + c : arr == 1 ? 512 + 64 * hh + c : arr == 2 ? 1024 + 64 * hh + c : arr == 3 ? 1536 + 64 * d + c : 1664 + 64 * d + c;
    mu5[e] = mu[n * ZRW + col];
  }
  for (int e = tid; e < 320; e += NTHR) {
    const int arr = e >> 6, c = e & 63;
    const int col = arr == 0 ? 64 * hh + c : arr == 1 ? 512 + 64 * hh + c : arr == 2 ? 1024 + 64 * hh + c : arr == 3 ? 1536 + 64 * d + c : 1664 + 64 * d + c;
    float sm_ = mu[col] + mu[ZRW + col];
    if (q.grid) sm_ += mu[2 * ZRW + col] + mu[3 * ZRW + col];
    c0t[e] = 1.0f - sm_;
  }
  const int cB0 = 16 * w + 4 * qq;
  float w0c[4], a0c[4], kkc[4], kac[4];
#pragma unroll
  for (int g = 0; g < 4; ++g) {
    w0c[g] = p.in[I_W0][(l * 2 + d) * 512 + 64 * hh + cB0 + g]; a0c[g] = p.in[I_A0][(l * 2 + d) * 512 + 64 * hh + cB0 + g];
    kkc[g] = p.in[I_KK][l * 512 + 64 * hh + cB0 + g]; kac[g] = p.in[I_KA][l * 512 + 64 * hh + cB0 + g];
  }
  f32x16 S;
  if (q.sample) {
    const float* st = p.in[I_SR] + ((((size_t)q.b * 2 + l) * 2 + d) * 8 + hh) * 4096;
#pragma unroll
    for (int g = 0; g < 16; ++g) S[g] = st[(32 * vb + crow(g, h)) * 64 + 32 * kb + r32];
  } else {
#pragma unroll
    for (int g = 0; g < 16; ++g) S[g] = 0.f;
  }
  __syncthreads();
  bf16x8 bW[2], bA[2];
#pragma unroll
  for (int ks = 0; ks < 2; ++ks) { bW[ks] = *(const bf16x8*)(Wb2 + (16 * w + l15) * 72 + ks * 32 + qq * 8); bA[ks] = *(const bf16x8*)(Ab2 + (16 * w + l15) * 72 + ks * 32 + qq * 8); }
  __syncthreads();
  for (int e = tid; e < (2 * 64 * 40 + 2 * 64 * 24) / 2; e += NTHR) ((unsigned*)VT0)[e] = 0u;
  for (int e = tid; e < (64 * 40) / 2; e += NTHR) ((unsigned*)VT1)[e] = 0u;
  for (int e = tid; e < (2 * 16 * 40) / 2; e += NTHR) ((unsigned*)ArkM)[e] = 0u;
  __syncthreads();
  const int nch = q.T / 16;
  bf16x8 pf[3][5];
  const int jA = (tid0 & 127) >> 3, c8A = (tid0 & 7) * 8, wh = w >> 1;
#define RW_CB(arr) ((arr) == 0 ? 64 * hh : (arr) == 1 ? 512 + 64 * hh : (arr) == 2 ? 1024 + 64 * hh : (arr) == 3 ? 1536 + 64 * d : 1664 + 64 * d)
#define RW_ISSUE(chn) { const int pos = (chn) * 16 + jA, t = d ? q.T - 1 - pos : pos; _Pragma("unroll") for (int gi = 0; gi < 3; ++gi) { if (gi < 2 || w < 2) { \
      rw_load8(ZR, q.base, t, q.T, q.grid, RW_CB(2 * gi + wh) + c8A, pf[gi]); } } }
#pragma unroll
  for (int g = 0; g < 4; ++g) asm volatile("" : "+v"(w0c[g]), "+v"(a0c[g]), "+v"(kkc[g]), "+v"(kac[g]));
  asm volatile("" : "+v"(S));
  RW_ISSUE(0)
#pragma unroll 1
  for (int ch = 0; ch < nch; ++ch) {
    tid = tid0; asm volatile("" : "+v"(tid));
    lane = tid & 63; l15 = lane & 15; qq = lane >> 4; r32 = lane & 31; h = lane >> 5;
    bf16_t* VT = (ch & 1) ? VT1 : VT0;
    {
      const int pos_ = ch * 16 + jA, t_ = d ? q.T - 1 - pos_ : pos_;
      const unsigned vd_ = rw_valid(t_, q.T, q.grid);
#pragma unroll
      for (int gi = 0; gi < 3; ++gi) {
        if (gi < 2 || w < 2) {
          const int arr = 2 * gi + wh;
          float val[8];
          rw_apply8_lds(pf[gi], mu5 + arr * 64 + c8A, c0t + arr * 64 + c8A, q.grid, vd_, val);
          if (arr < 3) {
            *(f32x4*)(shR + arr * 1024 + jA * 64 + c8A) = (f32x4){val[0], val[1], val[2], val[3]};
            *(f32x4*)(shR + arr * 1024 + jA * 64 + c8A + 4) = (f32x4){val[4], val[5], val[6], val[7]};
            if (arr == 2) {
#pragma unroll
              for (int e = 0; e < 8; ++e) VT[(c8A + e) * 40 + jA] = f2bf(val[e]);
            }
          } else if (arr == 3) {
            *(u32x4*)(actW + jA * 72 + c8A) = (u32x4){pk2(fast_tanh(val[0]), fast_tanh(val[1])), pk2(fast_tanh(val[2]), fast_tanh(val[3])), pk2(fast_tanh(val[4]), fast_tanh(val[5])), pk2(fast_tanh(val[6]), fast_tanh(val[7]))};
          } else {
            *(u32x4*)(actA + jA * 72 + c8A) = (u32x4){pk2(val[0], val[1]), pk2(val[2], val[3]), pk2(val[4], val[5]), pk2(val[6], val[7])};
          }
        }
      }
    }
    asm volatile("" ::: "memory"); __builtin_amdgcn_sched_barrier(0);
    if (ch + 1 < nch) RW_ISSUE(ch + 1)
    __syncthreads();
    {
      f32x4 aw = (f32x4){0.f, 0.f, 0.f, 0.f}, aa = (f32x4){0.f, 0.f, 0.f, 0.f};
#pragma unroll
      for (int ks = 0; ks < 2; ++ks) {
        const bf16x8 fw = *(const bf16x8*)(actW + l15 * 72 + ks * 32 + qq * 8);
        const bf16x8 fa = *(const bf16x8*)(actA + l15 * 72 + ks * 32 + qq * 8);
        aw = __builtin_amdgcn_mfma_f32_16x16x32_bf16(bW[ks], fw, aw, 0, 0, 0);
        aa = __builtin_amdgcn_mfma_f32_16x16x32_bf16(bA[ks], fa, aa, 0, 0, 0);
      }
      const f32x4 kv = *(const f32x4*)(shK + l15 * 64 + cB0), rv = *(const f32x4*)(shR + l15 * 64 + cB0);
      float lw[4], av[4], kkr[4], kd[4], Lp[4], LpL[4];
      float ssq = 0.f;
#pragma unroll
      for (int g = 0; g < 4; ++g) {
        const float wl = aw[g] + w0c[g], al = aa[g] + a0c[g];
        lw[g] = -__expf(-softplusf_(-wl) - 0.5f);
        av[g] = sigmoidf_(al);
        kkr[g] = kv[g] * kkc[g];
        kd[g] = kv[g] * (1.0f + (av[g] - 1.0f) * kac[g]);
        ssq += kkr[g] * kkr[g];
        float x = lw[g];
        x += dpp_row_shr0<1>(x); x += dpp_row_shr0<2>(x); x += dpp_row_shr0<4>(x); x += dpp_row_shr0<8>(x);
        Lp[g] = x;
      }
#pragma unroll
      for (int g = 0; g < 4; ++g) { float x = Lp[g];
        x = fminf(x, __int_as_float(__builtin_amdgcn_mov_dpp(__float_as_int(x), 0x128, 0xF, 0xF, true))); x = fminf(x, __int_as_float(__builtin_amdgcn_mov_dpp(__float_as_int(x), 0x124, 0xF, 0xF, true)));
        x = fminf(x, dpp_xor2(x)); x = fminf(x, dpp_xor1(x)); LpL[g] = x; }
      ssq += SHX(ssq, 16); ssq += SHX(ssq, 32);
      if (qq == 0) npart[w * 16 + l15] = ssq;
      float e_m1[4], e_neg[4], e_pos[4], e_end[4];
#pragma unroll
      for (int g = 0; g < 4; ++g) { e_m1[g] = __expf(Lp[g] - lw[g]); e_neg[g] = __expf(-Lp[g]); e_pos[g] = __expf(Lp[g]); e_end[g] = __expf(LpL[g] - Lp[g]); }
      *(u32x2*)(KHr + l15 * 72 + cB0) = (u32x2){pk2(kkr[0] * e_m1[0], kkr[1] * e_m1[1]), pk2(kkr[2] * e_m1[2], kkr[3] * e_m1[3])};
      *(u32x2*)(BCr + l15 * 72 + cB0) = (u32x2){pk2(kkr[0] * av[0] * e_neg[0], kkr[1] * av[1] * e_neg[1]), pk2(kkr[2] * av[2] * e_neg[2], kkr[3] * av[3] * e_neg[3])};
      *(u32x2*)(KC + l15 * 72 + cB0) = (u32x2){pk2(kd[0] * e_neg[0], kd[1] * e_neg[1]), pk2(kd[2] * e_neg[2], kd[3] * e_neg[3])};
      *(u32x2*)(RH + l15 * 72 + cB0) = (u32x2){pk2(rv[0] * e_pos[0], rv[1] * e_pos[1]), pk2(rv[2] * e_pos[2], rv[3] * e_pos[3])};
#pragma unroll
      for (int g = 0; g < 4; ++g) {
        KBT[(cB0 + g) * 24 + l15] = f2bf(kd[g] * e_end[g]);
        BBT[(cB0 + g) * 24 + l15] = f2bf(kkr[g] * av[g] * e_end[g]);
      }
      if (l15 == 15) *(f32x4*)(PL + cB0) = (f32x4){e_pos[0], e_pos[1], e_pos[2], e_pos[3]};
#pragma unroll
      for (int g = 0; g < 16; ++g) Sb[(32 * vb + crow(g, h)) * 72 + 32 * kb + r32] = f2bf(S[g]);
    }
    __syncthreads();
    f32x4 oacc = (f32x4){0.f, 0.f, 0.f, 0.f};
    {
      const bf16_t* Aop = (w < 2) ? KHr : RH;
      const bf16_t* Bop = (w == 0 || w == 3) ? BCr : KC;
      f32x4 t16 = (f32x4){0.f, 0.f, 0.f, 0.f}, g0 = (f32x4){0.f, 0.f, 0.f, 0.f};
#pragma unroll
      for (int ks = 0; ks < 2; ++ks) {
        const bf16x8 a = *(const bf16x8*)(Aop + l15 * 72 + ks * 32 + qq * 8);
        const bf16x8 b = *(const bf16x8*)(Bop + l15 * 72 + ks * 32 + qq * 8);
        t16 = __builtin_amdgcn_mfma_f32_16x16x32_bf16(a, b, t16, 0, 0, 0);
        const bf16x8 akh = *(const bf16x8*)(KHr + l15 * 72 + ks * 32 + qq * 8);
        const bf16x8 arh = *(const bf16x8*)(RH + l15 * 72 + ks * 32 + qq * 8);
        const bf16x8 bs = *(const bf16x8*)(Sb + (16 * w + l15) * 72 + ks * 32 + qq * 8);
        g0 = __builtin_amdgcn_mfma_f32_16x16x32_bf16(akh, bs, g0, 0, 0, 0);
        oacc = __builtin_amdgcn_mfma_f32_16x16x32_bf16(arh, bs, oacc, 0, 0, 0);
      }
#pragma unroll
      for (int g = 0; g < 4; ++g) G0[(4 * qq + g) * 64 + 16 * w + l15] = g0[g];
      *(f32x4*)(MN + w * 256 + l15 * 16 + 4 * qq) = t16;
    }
    __syncthreads();
    if (w == 0) {
      const float* MrT = MN; const float* NrT = MN + 256;
      f32x2 acc2[8];
#pragma unroll
      for (int pq = 0; pq < 8; ++pq) acc2[pq] = (f32x2){G0[(2 * pq) * 64 + lane], G0[(2 * pq + 1) * 64 + lane]};
      float vv[16], un[16];
#pragma unroll
      for (int j = 0; j < 16; ++j) vv[j] = shV[j * 64 + lane];
      const float n2v = __builtin_amdgcn_rcpf(fmaxf(npart[l15] + npart[16 + l15] + npart[32 + l15] + npart[48 + l15], 1e-24f));
      f32x4 nr[4], mr[4];
#pragma unroll
      for (int t4 = 0; t4 < 4; ++t4) { nr[t4] = *(const f32x4*)(NrT + 4 * t4); mr[t4] = *(const f32x4*)(MrT + 4 * t4); }
#pragma unroll
      for (int j = 0; j < 16; ++j) {
        f32x4 nrn[4], mrn[4];
#pragma unroll
        for (int t4 = 0; t4 < 4; ++t4) { nrn[t4] = (f32x4){0.f, 0.f, 0.f, 0.f}; mrn[t4] = (f32x4){0.f, 0.f, 0.f, 0.f}; }
        if (j + 1 < 16) {
#pragma unroll
          for (int t4 = 0; t4 < 4; ++t4) if (4 * t4 + 3 > j + 1) { nrn[t4] = *(const f32x4*)(NrT + (j + 1) * 16 + 4 * t4); mrn[t4] = *(const f32x4*)(MrT + (j + 1) * 16 + 4 * t4); }
        }
        const float n2s = __int_as_float(__builtin_amdgcn_readlane(__float_as_int(n2v), j));
        const float unj = -acc2[j >> 1][j & 1] * n2s;
        un[j] = unj;
        const f32x2 vv2 = (f32x2){vv[j], vv[j]}, un2 = (f32x2){unj, unj};
#pragma unroll
        for (int pq = 0; pq < 8; ++pq)
          if (2 * pq + 1 > j) acc2[pq] += (f32x2){nr[pq >> 1][2 * (pq & 1)], nr[pq >> 1][2 * (pq & 1) + 1]} * vv2 + (f32x2){mr[pq >> 1][2 * (pq & 1)], mr[pq >> 1][2 * (pq & 1) + 1]} * un2;
#pragma unroll
        for (int t4 = 0; t4 < 4; ++t4) { nr[t4] = nrn[t4]; mr[t4] = mrn[t4]; }
        __builtin_amdgcn_sched_barrier(0);
      }
      *(u32x4*)(UNT + lane * 40) = (u32x4){pk2(un[0], un[1]), pk2(un[2], un[3]), pk2(un[4], un[5]), pk2(un[6], un[7])};
      *(u32x4*)(UNT + lane * 40 + 8) = (u32x4){pk2(un[8], un[9]), pk2(un[10], un[11]), pk2(un[12], un[13]), pk2(un[14], un[15])};
    } else if (w < 3) {
      const float* src = MN + (w == 1 ? 512 : 768);
      bf16_t* dst = (w == 1) ? ArkM : ArbM;
#pragma unroll
      for (int i = 0; i < 4; ++i) { const int e = lane + 64 * i, j = e >> 4, t = e & 15; dst[t * 40 + j] = f2bf(j <= t ? src[e] : 0.f); }
    }
    __syncthreads();
    {
      const bf16x8 ak = *(const bf16x8*)(ArkM + l15 * 40 + qq * 8), ab = *(const bf16x8*)(ArbM + l15 * 40 + qq * 8);
      const bf16x8 bv = *(const bf16x8*)(VT + (16 * w + l15) * 40 + qq * 8), bu = *(const bf16x8*)(UNT + (16 * w + l15) * 40 + qq * 8);
      oacc = __builtin_amdgcn_mfma_f32_16x16x32_bf16(ak, bv, oacc, 0, 0, 0);
      oacc = __builtin_amdgcn_mfma_f32_16x16x32_bf16(ab, bu, oacc, 0, 0, 0);
#pragma unroll
      for (int g = 0; g < 4; ++g) {
        const int pos = ch * 16 + 4 * qq + g, t = d ? q.T - 1 - pos : pos;
        O[(size_t)(q.base + t) * 1024 + d * 512 + 64 * hh + 16 * w + l15] = f2bf(oacc[g]);
      }
      const float pl = PL[32 * kb + r32];
#pragma unroll
      for (int g = 0; g < 16; ++g) S[g] *= pl;
      const bf16x8 av_ = *(const bf16x8*)(VT + (32 * vb + r32) * 40 + 8 * h), au_ = *(const bf16x8*)(UNT + (32 * vb + r32) * 40 + 8 * h);
      const bf16x8 bk_ = *(const bf16x8*)(KBT + (32 * kb + r32) * 24 + 8 * h), bb_ = *(const bf16x8*)(BBT + (32 * kb + r32) * 24 + 8 * h);
      S = __builtin_amdgcn_mfma_f32_32x32x16_bf16(av_, bk_, S, 0, 0, 0);
      S = __builtin_amdgcn_mfma_f32_32x32x16_bf16(au_, bb_, S, 0, 0, 0);
    }
  }
  if (!q.sample) {
    float* dst = p.out + OUT_RW + ((((size_t)q.b * 2 + l) * 2 + d) * 8 + hh) * 4096;
#pragma unroll
    for (int g = 0; g < 16; ++g) dst[(32 * vb + crow(g, h)) * 64 + 32 * kb + r32] = S[g];
  }
}

DI void hgrn_item(const Params& p, int l, int s, int hh, int d, char* smem) {
  const Seq q = get_seq(s);
  const int tid = ltid(), lane = tid & 63, w = tid >> 6, r = lane & 31, h = lane >> 5;
  bf16_t* ZH = (bf16_t*)(p.ws + OFF_ZH);
  bf16_t* Qt = (bf16_t*)smem;
  bf16_t* Kt = Qt + 32 * 136;
  bf16_t* KhT = Kt + 32 * 136;
  bf16_t* VT = KhT + 128 * 40;
  bf16_t* Sb = VT + 128 * 40;
  bf16_t* At = Sb + 4 * 32 * 136;
  float* dL = (float*)(At + 32 * 40);
  float* tot = dL + 128;
  const float lb = ((const float*)(p.ws + OFF_LBS))[l * 512 + 128 * hh + (tid & 127)];
  f32x16 S[4];
  if (q.sample) {
    const float* st = p.in[I_SH] + ((((size_t)q.b * 2 + l) * 2 + d) * 4 + hh) * 16384;
#pragma unroll
    for (int kb = 0; kb < 4; ++kb)
#pragma unroll
      for (int g = 0; g < 16; ++g) S[kb][g] = st[(size_t)(32 * kb + crow(g, h)) * 128 + 32 * w + r];
  } else {
#pragma unroll
    for (int kb = 0; kb < 4; ++kb)
#pragma unroll
      for (int g = 0; g < 16; ++g) S[kb][g] = 0.f;
  }
  const int k = tid & 127, half = tid >> 7;
  const int nch = q.T / 32;
  u16x2 pzq[16], pv2[8];
#define HG_ISSUE(chn) { _Pragma("unroll") for (int jj = 0; jj < 16; ++jj) { const int pos = (chn) * 32 + half * 16 + jj, t = d ? q.T - 1 - pos : pos; \
      const size_t rowo = (size_t)(q.base + t) * ZHW + 128 * hh + k; pzq[jj][0] = ZH[rowo + 512 * (1 + d)]; pzq[jj][1] = ZH[rowo]; pv2[jj >> 1][jj & 1] = ZH[rowo + 1536]; } }
  { float lb_ = lb; asm volatile("" : "+v"(lb_)); (void)lb_; }
#pragma unroll
  for (int kb = 0; kb < 4; ++kb) asm volatile("" : "+v"(S[kb]));
  HG_ISSUE(0)
#pragma unroll 1
  for (int ch = 0; ch < nch; ++ch) {
    __syncthreads();
    float bl[16], kc[16], qs[16];
    {
      float b = 0.f;
#pragma unroll
      for (int jj = 0; jj < 16; ++jj) {
        const float z = bf2f(pzq[jj][0]);
        const float kcoef = (1.0f - lb) * sigmoidf_(-z);
        const float f = 1.0f - kcoef;
        b += fmaxf(__logf(f), -80.f);
        bl[jj] = b; kc[jj] = kcoef; qs[jj] = bf2f(pzq[jj][1]) * 0.08838834764831845f;
      }
      *(u32x4*)(VT + k * 40 + half * 16) = (u32x4){__builtin_bit_cast(unsigned, pv2[0]), __builtin_bit_cast(unsigned, pv2[1]), __builtin_bit_cast(unsigned, pv2[2]), __builtin_bit_cast(unsigned, pv2[3])};
      *(u32x4*)(VT + k * 40 + half * 16 + 8) = (u32x4){__builtin_bit_cast(unsigned, pv2[4]), __builtin_bit_cast(unsigned, pv2[5]), __builtin_bit_cast(unsigned, pv2[6]), __builtin_bit_cast(unsigned, pv2[7])};
      tot[half * 128 + k] = b;
    }
    if (ch + 1 < nch) HG_ISSUE(ch + 1)
    __syncthreads();
    {
      const float off = half ? tot[k] : 0.f;
      const float bL = fmaxf(tot[k] + tot[128 + k], -80.f);
      if (half == 0) dL[k] = __expf(bL);
      float kh[16];
#pragma unroll
      for (int jj = 0; jj < 16; ++jj) {
        const int j = half * 16 + jj;
        const float bj = fmaxf(off + bl[jj], -80.f);
        Qt[j * 136 + k] = f2bf(qs[jj] * __expf(bj));
        Kt[j * 136 + k] = f2bf(kc[jj] * __expf(-bj));
        kh[jj] = kc[jj] * __expf(fminf(bL - bj, 0.f));
      }
      *(u32x4*)(KhT + k * 40 + half * 16) = (u32x4){pk2(kh[0], kh[1]), pk2(kh[2], kh[3]), pk2(kh[4], kh[5]), pk2(kh[6], kh[7])};
      *(u32x4*)(KhT + k * 40 + half * 16 + 8) = (u32x4){pk2(kh[8], kh[9]), pk2(kh[10], kh[11]), pk2(kh[12], kh[13]), pk2(kh[14], kh[15])};
    }
    bf16_t* Sbw = Sb + w * 32 * 136;
#pragma unroll
    for (int kb = 0; kb < 4; ++kb)
#pragma unroll
      for (int g4 = 0; g4 < 4; ++g4) *(u32x2*)(Sbw + r * 136 + 32 * kb + crow(4 * g4, h)) = (u32x2){pk2(S[kb][4 * g4], S[kb][4 * g4 + 1]), pk2(S[kb][4 * g4 + 2], S[kb][4 * g4 + 3])};
    __syncthreads();
    bf16_t* Atw = At;
    {
      f32x16 A;
#pragma unroll
      for (int g = 0; g < 16; ++g) A[g] = 0.f;
      mma32(A, Qt, 136, Kt, 136, 128, lane);
#pragma unroll
      for (int g = 0; g < 16; ++g) { const int t = crow(g, h); Atw[t * 40 + r] = f2bf(r <= t ? A[g] : 0.f); }
    }
    __syncthreads();
    {
      f32x16 o;
#pragma unroll
      for (int g = 0; g < 16; ++g) o[g] = 0.f;
      mma32(o, Atw, 40, VT + 32 * w * 40, 40, 32, lane);
      mma32(o, Qt, 136, Sbw, 136, 128, lane);
#pragma unroll
      for (int g = 0; g < 16; ++g) {
        const int j = crow(g, h), pos = ch * 32 + j, t = d ? q.T - 1 - pos : pos;
        ZH[(size_t)(q.base + t) * ZHW + 512 * (1 + d) + 128 * hh + 32 * w + r] = f2bf(o[g]);
      }
#pragma unroll
      for (int kb = 0; kb < 4; ++kb) {
#pragma unroll
        for (int g = 0; g < 16; ++g) S[kb][g] *= dL[32 * kb + crow(g, h)];
        mma32(S[kb], KhT + 32 * kb * 40, 40, VT + 32 * w * 40, 40, 32, lane);
      }
    }
  }
  if (!q.sample) {
    float* dst = p.out + OUT_HG + ((((size_t)q.b * 2 + l) * 2 + d) * 4 + hh) * 16384;
#pragma unroll
    for (int kb = 0; kb < 4; ++kb)
#pragma unroll
      for (int g = 0; g < 16; ++g) dst[(size_t)(32 * kb + crow(g, h)) * 128 + 32 * w + r] = S[kb][g];
  }
}

DI void mlstm_item(const Params& p, int l, int s, int hh, int d, char* smem) {
  const Seq q = get_seq(s);
  const int tid = ltid(), lane = tid & 63, w = tid >> 6, r = lane & 31, h = lane >> 5;
  const bf16_t* ZM = (const bf16_t*)(p.ws + OFF_ZM);
  const float* MG = (const float*)(p.ws + OFF_MG);
  bf16_t* Hb = (bf16_t*)(p.ws + OFF_H);
  bf16_t* Qm = (bf16_t*)smem;
  bf16_t* Km = Qm + 32 * 136;
  bf16_t* KwT = Km + 32 * 136;
  bf16_t* VT = KwT + 128 * 40;
  bf16_t* Cb = VT + 128 * 40;
  bf16_t* Pt = Cb + 4 * 32 * 136;
  float* nv = (float*)(Pt + 32 * 40);
  float* sc = nv + 128;
  float* ig = sc; float* lf = sc + 32; float* gg = sc + 64; float* mtv = sc + 96; float* wi = sc + 128; float* wsr = sc + 160; float* qn = sc + 192; float* misc = sc + 224;
  float* dnw = sc + 232;
  const float gbi = p.in[I_GB][l * 16 + (2 * d) * 4 + hh], gbf = p.in[I_GB][l * 16 + (2 * d + 1) * 4 + hh];
  f32x16 C[4];
  float m;
  __syncthreads();
  if (q.sample) {
    const size_t sb = (((size_t)q.b * 2 + l) * 2 + d) * 4 + hh;
    const float* st = p.in[I_SC] + sb * 16384;
#pragma unroll
    for (int kb = 0; kb < 4; ++kb)
#pragma unroll
      for (int g = 0; g < 16; ++g) C[kb][g] = st[(size_t)(32 * kb + crow(g, h)) * 128 + 32 * w + r];
    if (tid < 128) nv[tid] = p.in[I_SN][sb * 128 + tid];
    m = p.in[I_SM][sb];
  } else {
#pragma unroll
    for (int kb = 0; kb < 4; ++kb)
#pragma unroll
      for (int g = 0; g < 16; ++g) C[kb][g] = 0.f;
    if (tid < 128) nv[tid] = 0.f;
    m = 0.f;
  }
  const int nch = q.T / 32;
  const int dd = tid & 127, half = tid >> 7;
  u16x2 pqk[16], pv2[8]; float pgi = 0.f, pgf = 0.f;
#define ML_ISSUE(chn) { _Pragma("unroll") for (int jj = 0; jj < 16; ++jj) { const int pos = (chn) * 32 + half * 16 + jj, t = d ? q.T - 1 - pos : pos; \
      const size_t rowo = (size_t)(q.base + t) * ZMW + 128 * hh + dd; pqk[jj][0] = ZM[rowo]; pqk[jj][1] = ZM[rowo + 512]; pv2[jj >> 1][jj & 1] = ZM[rowo + 1024]; } \
    if (tid < 32) { const int pos = (chn) * 32 + tid, t = d ? q.T - 1 - pos : pos; const float* mg = MG + (size_t)(q.base + t) * 16; pgi = mg[(2 * d) * 4 + hh]; pgf = mg[(2 * d + 1) * 4 + hh]; } }
#pragma unroll
  for (int kb = 0; kb < 4; ++kb) asm volatile("" : "+v"(C[kb]));
  asm volatile("" : "+v"(m));
  ML_ISSUE(0)
#pragma unroll 1
  for (int ch = 0; ch < nch; ++ch) {
    __syncthreads();
    {
#pragma unroll
      for (int jj = 0; jj < 16; ++jj) {
        const int j = half * 16 + jj;
        Qm[j * 136 + dd] = pqk[jj][0];
        Km[j * 136 + dd] = f2bf(bf2f(pqk[jj][1]) * 0.08838834764831845f);
      }
      *(u32x4*)(VT + dd * 40 + half * 16) = (u32x4){__builtin_bit_cast(unsigned, pv2[0]), __builtin_bit_cast(unsigned, pv2[1]), __builtin_bit_cast(unsigned, pv2[2]), __builtin_bit_cast(unsigned, pv2[3])};
      *(u32x4*)(VT + dd * 40 + half * 16 + 8) = (u32x4){__builtin_bit_cast(unsigned, pv2[4]), __builtin_bit_cast(unsigned, pv2[5]), __builtin_bit_cast(unsigned, pv2[6]), __builtin_bit_cast(unsigned, pv2[7])};
      if (tid < 32) {
        const float igv = pgi + gbi;
        const float lfv = -softplusf_(-(pgf + gbf));
        float g = lfv;
#pragma unroll
        for (int o = 1; o < 32; o <<= 1) { const float tt = shfl_lane(g, (lane - o) & 63); if (tid >= o) g += tt; }
        const float cs = igv - g;
        float pm = cs;
#pragma unroll
        for (int o = 1; o < 32; o <<= 1) { const float tt = shfl_lane(pm, (lane - o) & 63); if (tid >= o) pm = fmaxf(pm, tt); }
        const float mt = g + fmaxf(m, pm);
        const float gend = shfl_lane(g, 31), mn = shfl_lane(mt, 31);
        ig[tid] = igv; gg[tid] = g; mtv[tid] = mt; wi[tid] = __expf(g + m - mt);
        wsr[tid] = __expf(gend + cs - mn);
        if (tid == 0) { misc[0] = mn; misc[1] = __expf(gend + m - mn); }
      }
    }
    if (ch + 1 < nch) ML_ISSUE(ch + 1)
    __syncthreads();
    {
      {
        float kw[16];
#pragma unroll
        for (int jj = 0; jj < 16; ++jj) { const int j = half * 16 + jj; kw[jj] = bf2f(Km[j * 136 + dd]) * wsr[j]; }
        *(u32x4*)(KwT + dd * 40 + half * 16) = (u32x4){pk2(kw[0], kw[1]), pk2(kw[2], kw[3]), pk2(kw[4], kw[5]), pk2(kw[6], kw[7])};
        *(u32x4*)(KwT + dd * 40 + half * 16 + 8) = (u32x4){pk2(kw[8], kw[9]), pk2(kw[10], kw[11]), pk2(kw[12], kw[13]), pk2(kw[14], kw[15])};
      }
      const int j = tid >> 3, seg = tid & 7;
      float a = 0.f;
#pragma unroll
      for (int i = 0; i < 16; ++i) a += bf2f(Qm[j * 136 + seg * 16 + i]) * nv[seg * 16 + i];
      a += SHX(a, 1); a += SHX(a, 2); a += SHX(a, 4);
      if (seg == 0) qn[j] = a;
    }
    const float m_new = misc[0], carry = misc[1];
    bf16_t* Cbw = Cb + w * 32 * 136; bf16_t* Ptw = Pt;
#pragma unroll
    for (int kb = 0; kb < 4; ++kb)
#pragma unroll
      for (int g4 = 0; g4 < 4; ++g4) *(u32x2*)(Cbw + r * 136 + 32 * kb + crow(4 * g4, h)) = (u32x2){pk2(C[kb][4 * g4], C[kb][4 * g4 + 1]), pk2(C[kb][4 * g4 + 2], C[kb][4 * g4 + 3])};
    {
      f32x16 Sc;
#pragma unroll
      for (int g = 0; g < 16; ++g) Sc[g] = 0.f;
      mma32(Sc, Qm, 136, Km, 136, 128, lane);
      const float gs = gg[r], is = ig[r];
#pragma unroll
      for (int g = 0; g < 16; ++g) {
        const int t = crow(g, h);
        const float pv = (r <= t) ? __expf(gg[t] - gs + is - mtv[t]) * Sc[g] : 0.f;
        Ptw[t * 40 + r] = f2bf(pv);
      }
    }
    __syncthreads();
    if (lane < 32) {
      float a = 0.f;
#pragma unroll 4
      for (int i = 0; i < 32; ++i) a += bf2f(Ptw[lane * 40 + i]);
      const float den = wi[lane] * qn[lane] + a;
      dnw[lane] = 1.0f / fmaxf(fabsf(den), __expf(-mtv[lane]));
    }
    if (tid < 128) {
      float a = 0.f;
#pragma unroll 4
      for (int i = 0; i < 32; ++i) a += bf2f(KwT[tid * 40 + i]);
      nv[tid] = carry * nv[tid] + a;
    }
    __syncthreads();
    {
      f32x16 a1;
#pragma unroll
      for (int g = 0; g < 16; ++g) a1[g] = 0.f;
      mma32(a1, Qm, 136, Cbw, 136, 128, lane);
#pragma unroll
      for (int g = 0; g < 16; ++g) a1[g] *= wi[crow(g, h)];
      mma32(a1, Ptw, 40, VT + 32 * w * 40, 40, 32, lane);
#pragma unroll
      for (int g = 0; g < 16; ++g) {
        const int j = crow(g, h), pos = ch * 32 + j, t = d ? q.T - 1 - pos : pos;
        const float hv = a1[g] * dnw[j];
        Hb[(size_t)(q.base + t) * 1024 + d * 512 + 128 * hh + 32 * w + r] = f2bf(hv);
      }
#pragma unroll
      for (int kb = 0; kb < 4; ++kb) {
#pragma unroll
        for (int g = 0; g < 16; ++g) C[kb][g] *= carry;
        mma32(C[kb], KwT + 32 * kb * 40, 40, VT + 32 * w * 40, 40, 32, lane);
      }
    }
    m = m_new;
  }
  __syncthreads();
  if (!q.sample) {
    const size_t sb = (((size_t)q.b * 2 + l) * 2 + d) * 4 + hh;
    float* dst = p.out + OUT_C + sb * 16384;
#pragma unroll
    for (int kb = 0; kb < 4; ++kb)
#pragma unroll
      for (int g = 0; g < 16; ++g) dst[(size_t)(32 * kb + crow(g, h)) * 128 + 32 * w + r] = C[kb][g];
    if (tid < 128) p.out[OUT_N + sb * 128 + tid] = nv[tid];
    if (tid == 0) p.out[OUT_M + sb] = m;
  }
}

DI void phase_scan(const Params& p, int l, char* smem) {
  int* ctrL = (int*)(p.ws + OFF_CTR) + 2 * l;
  int* ctrS = ctrL + 1;
  int* sit = (int*)(smem + LDS_BYTES - 16);
  const int role = p.role;
  bool longDone = false, shortDone = false;
  for (;;) {
    const bool wantLong = (role == 0) ? !longDone : shortDone;
    if (longDone && shortDone) break;
    __syncthreads();
    if (ltid() == 0) *sit = atomicAdd(wantLong ? ctrL : ctrS, 1);
    __syncthreads();
    int it = __builtin_amdgcn_readfirstlane(*sit);
    int ty, s_, hh_, d_, rb_ = 0;
    if (wantLong) {
      if (it >= 128) { longDone = true; continue; }
      if (it < 64) { ty = 0; d_ = it & 1; hh_ = (it >> 1) & 7; s_ = 32 + (it >> 4); }
      else if (it < 96) { it -= 64; ty = 1; s_ = 32 + (it >> 3); hh_ = (it >> 1) & 3; d_ = it & 1; }
      else { it -= 96; ty = 2; s_ = 32 + (it >> 3); hh_ = (it >> 1) & 3; d_ = it & 1; }
    } else {
      if (it >= 1024) { shortDone = true; continue; }
      if (it < 512) { ty = 0; s_ = it >> 4; hh_ = (it >> 1) & 7; d_ = it & 1; }
      else if (it < 768) { it -= 512; ty = 1; s_ = it >> 3; hh_ = (it >> 1) & 3; d_ = it & 1; }
      else { it -= 768; ty = 2; s_ = it >> 3; hh_ = (it >> 1) & 3; d_ = it & 1; }
    }
    if (ty == 0) rwkv_item(p, l, s_, hh_, d_, smem);
    else if (ty == 1) hgrn_item(p, l, s_, hh_, d_, smem);
    else mlstm_item(p, l, s_, hh_, d_, smem);
  }
}

DI void phase_combine(const Params& p, int l, char* smem) {
  const int tid = ltid(), lane = tid & 63, w = tid >> 6;
  bf16_t* ZH = (bf16_t*)(p.ws + OFF_ZH); bf16_t* ZM = (bf16_t*)(p.ws + OFF_ZM); const bf16_t* ZR = (const bf16_t*)(p.ws + OFF_ZR);
  bf16_t* O = (bf16_t*)(p.ws + OFF_O); const bf16_t* Hb = (const bf16_t*)(p.ws + OFF_H);
  const float* mu = p.in[I_MU] + (size_t)l * 4 * ZRW;
  const float* g2 = p.in[I_G2] + (size_t)l * 128 * 512;
  float* sg = (float*)smem;
  float* gt = sg + 128 * 16;
  for (int blk = blockIdx.x; blk < NT / 16; blk += gridDim.x) {
    const int tok0 = blk * 16;
    int sidx, t0;
    if (tok0 < 8192) { sidx = tok0 >> 8; t0 = tok0 & 255; } else { sidx = 32 + ((tok0 - 8192) >> 11); t0 = (tok0 - 8192) & 2047; }
    const Seq q = get_seq(sidx);
    __syncthreads();
    { const int j = tid >> 4, rr0 = (tid & 15) * 8; float val[8]; bf16x8 pv[5]; rw_load8(ZR, q.base, t0 + j, q.T, q.grid, 1792 + rr0, pv); rw_apply8(pv, mu, q.grid, rw_valid(t0 + j, q.T, q.grid), 1792 + rr0, val);
#pragma unroll
      for (int e = 0; e < 8; ++e) sg[(rr0 + e) * 16 + j] = sigmoidf_(val[e]); }
    __syncthreads();
    {
      float a0[16], a1[16];
#pragma unroll
      for (int j = 0; j < 16; ++j) { a0[j] = 0.f; a1[j] = 0.f; }
#pragma unroll 1
      for (int r0 = 0; r0 < 128; r0 += 8) {
        float w0v[8], w1v[8];
#pragma unroll
        for (int q8 = 0; q8 < 8; ++q8) { w0v[q8] = g2[(r0 + q8) * 512 + tid]; w1v[q8] = g2[(r0 + q8) * 512 + 256 + tid]; }
#pragma unroll
        for (int q8 = 0; q8 < 8; ++q8) {
          const int rr = r0 + q8; const float w0 = w0v[q8], w1 = w1v[q8];
#pragma unroll
          for (int u = 0; u < 4; ++u) {
            f32x4 sv = *(const f32x4*)(sg + rr * 16 + 4 * u);
#pragma unroll
            for (int e = 0; e < 4; ++e) { a0[4 * u + e] += sv[e] * w0; a1[4 * u + e] += sv[e] * w1; }
          }
        }
      }
#pragma unroll
      for (int j = 0; j < 16; ++j) { gt[j * 512 + tid] = a0[j]; gt[j * 512 + 256 + tid] = a1[j]; }
    }
    __syncthreads();
#pragma unroll 1
    for (int jj = 0; jj < 4; ++jj) {
      const int j = w * 4 + jj, tok = tok0 + j, t = t0 + j; int c0 = lane * 8; asm volatile("" : "+v"(c0));
      {
        float o[8], rs[8], ks[8], vs[8];
        float sum = 0.f, bon = 0.f;
        {
          bf16x8 pr_[5], pk_[5], pv_[5];
          rw_load8(ZR, q.base, t, q.T, q.grid, c0, pr_); rw_load8(ZR, q.base, t, q.T, q.grid, 512 + c0, pk_); rw_load8(ZR, q.base, t, q.T, q.grid, 1024 + c0, pv_);
          const unsigned vd_ = rw_valid(t, q.T, q.grid);
          rw_apply8(pr_, mu, q.grid, vd_, c0, rs); rw_apply8(pk_, mu, q.grid, vd_, 512 + c0, ks); rw_apply8(pv_, mu, q.grid, vd_, 1024 + c0, vs);
        }
        const bf16x8 of = *(const bf16x8*)(O + (size_t)tok * 1024 + c0), ob = *(const bf16x8*)(O + (size_t)tok * 1024 + 512 + c0);
        const f32x4 rk0 = *(const f32x4*)(p.in[I_RK] + l * 512 + c0), rk1 = *(const f32x4*)(p.in[I_RK] + l * 512 + c0 + 4);
#pragma unroll
        for (int e = 0; e < 8; ++e) {
          o[e] = bf2f((bf16_t)of[e]) + bf2f((bf16_t)ob[e]);
          sum += o[e];
          bon += rs[e] * ks[e] * (e < 4 ? rk0[e & 3] : rk1[e & 3]);
        }
        sum += SHX(sum, 1); sum += SHX(sum, 2); sum += SHX(sum, 4);
        bon += SHX(bon, 1); bon += SHX(bon, 2); bon += SHX(bon, 4);
        const float mean = sum * (1.0f / 64.f);
        float var = 0.f;
#pragma unroll
        for (int e = 0; e < 8; ++e) { const float dv = o[e] - mean; var += dv * dv; }
        var += SHX(var, 1); var += SHX(var, 2); var += SHX(var, 4);
        const float rstd = rsqrtf(var * (1.0f / 64.f) + 64e-5f);
        const f32x4 lw0 = *(const f32x4*)(p.in[I_LN] + (l * 2 + 0) * 512 + c0), lw1 = *(const f32x4*)(p.in[I_LN] + (l * 2 + 0) * 512 + c0 + 4);
        const f32x4 lb0 = *(const f32x4*)(p.in[I_LN] + (l * 2 + 1) * 512 + c0), lb1 = *(const f32x4*)(p.in[I_LN] + (l * 2 + 1) * 512 + c0 + 4);
        const f32x4 gt0 = *(const f32x4*)(gt + j * 512 + c0), gt1 = *(const f32x4*)(gt + j * 512 + c0 + 4);
        bf16x8 ov;
#pragma unroll
        for (int e = 0; e < 8; ++e) {
          const float ln = (o[e] - mean) * rstd * (e < 4 ? lw0[e & 3] : lw1[e & 3]) + (e < 4 ? lb0[e & 3] : lb1[e & 3]);
          ov[e] = (short)f2bf((ln + bon * vs[e]) * (e < 4 ? gt0[e & 3] : gt1[e & 3]));
        }
        *(bf16x8*)(O + (size_t)tok * 1024 + c0) = ov;
      }
      {
        float o[8]; float ss = 0.f;
        bf16_t* zr_ = ZH + (size_t)tok * ZHW + c0;
        const bf16x8 of = *(const bf16x8*)(zr_ + 512), ob = *(const bf16x8*)(zr_ + 1024), hgv = *(const bf16x8*)(zr_ + 2048);
        const f32x4 nw0 = *(const f32x4*)(p.in[I_HNORM] + l * 512 + c0), nw1 = *(const f32x4*)(p.in[I_HNORM] + l * 512 + c0 + 4);
#pragma unroll
        for (int e = 0; e < 8; ++e) { o[e] = bf2f((bf16_t)of[e]) + bf2f((bf16_t)ob[e]); ss += o[e] * o[e]; }
        ss += SHX(ss, 1); ss += SHX(ss, 2); ss += SHX(ss, 4); ss += SHX(ss, 8);
        const float rsd = rsqrtf(ss * (1.0f / 128.f) + 1e-6f);
        bf16x8 ov;
#pragma unroll
        for (int e = 0; e < 8; ++e) ov[e] = (short)f2bf(o[e] * rsd * (e < 4 ? nw0[e & 3] : nw1[e & 3]) * siluf_(bf2f((bf16_t)hgv[e])));
        *(bf16x8*)(zr_ + 2048) = ov;
      }
      {
        float o[8]; float ss = 0.f;
        bf16_t* zm_ = ZM + (size_t)tok * ZMW + 1536 + c0;
        const bf16x8 of = *(const bf16x8*)(Hb + (size_t)tok * 1024 + c0), ob = *(const bf16x8*)(Hb + (size_t)tok * 1024 + 512 + c0), mov = *(const bf16x8*)zm_;
        const f32x4 nw0 = *(const f32x4*)(p.in[I_MNORM] + l * 512 + c0), nw1 = *(const f32x4*)(p.in[I_MNORM] + l * 512 + c0 + 4);
#pragma unroll
        for (int e = 0; e < 8; ++e) { o[e] = bf2f((bf16_t)of[e]) + bf2f((bf16_t)ob[e]); ss += o[e] * o[e]; }
        ss += SHX(ss, 1); ss += SHX(ss, 2); ss += SHX(ss, 4); ss += SHX(ss, 8);
        const float rsd = rsqrtf(ss * (1.0f / 128.f) + 1e-6f);
        bf16x8 ov;
#pragma unroll
        for (int e = 0; e < 8; ++e) ov[e] = (short)f2bf(o[e] * rsd * (e < 4 ? nw0[e & 3] : nw1[e & 3]) * sigmoidf_(bf2f((bf16_t)mov[e])));
        *(bf16x8*)zm_ = ov;
      }
    }
    __syncthreads();
#pragma unroll 1
    for (int jj = 0; jj < 4; ++jj) tok_one(p, l, 3, tok0 + w * 4 + jj, lane);
  }
}

#define XB_TMO      128
#define XB_XCNT(j)  (256  + 64 * (j))
#define XB_XSUB(j)  (1280 + 64 * (j))
#define XB_XGEN(j)  (2304 + 64 * (j))
#define XB_TOP      3328
#define XB_TOPGEN   3392
#define XCD_BAR_WORDS 3456
#define XB_SPIN_CAP (1u << 20)
#define LAS __attribute__((address_space(3)))
DI unsigned xb_ld(unsigned* p)              { return __hip_atomic_load(p, __ATOMIC_RELAXED, __HIP_MEMORY_SCOPE_AGENT); }
DI unsigned xb_add(unsigned* p, unsigned v) { return __hip_atomic_fetch_add(p, v, __ATOMIC_RELAXED, __HIP_MEMORY_SCOPE_AGENT); }
DI unsigned xb_xcc_id() { return (unsigned)__builtin_amdgcn_s_getreg((3 << 11) | 20) & 0xFu; }
#define XB_SPIN(cond, bar) do { unsigned _sp = 0; while (cond) { __builtin_amdgcn_s_sleep(1); \
    if ((++_sp & 255u) == 0u) { if (xb_ld(&(bar)[XB_TMO])) break; if (_sp > XB_SPIN_CAP) { atomicAdd(&(bar)[XB_TMO], 1u); break; } } } } while (0)
struct XcdBarrier { unsigned* bar; unsigned x; volatile LAS unsigned* st; };
DI XcdBarrier xcd_barrier_post(const Params& p, unsigned* bar, volatile LAS unsigned* st) {
  XcdBarrier b; b.bar = bar; b.x = xb_xcc_id(); b.st = st;
  if (ltid() == 0) (void)xb_add(&bar[XB_XCNT(b.x)], 1u);
  return b;
}
DI void xcd_barrier_complete(unsigned* bar, unsigned x, unsigned& nloc, unsigned& nx) {
  const unsigned G = gridDim.x * gridDim.y * gridDim.z;
  unsigned sum, cnt, mine, sp = 0u;
  for (;;) {
    sum = 0u; cnt = 0u; mine = 0u;
#pragma unroll
    for (unsigned j = 0; j < 16; ++j) { const unsigned c = xb_ld(&bar[XB_XCNT(j)]); sum += c; cnt += (c > 0u) ? 1u : 0u; mine = (j == x) ? c : mine; }
    if (sum == G) break;
    __builtin_amdgcn_s_sleep(1);
    if ((++sp & 255u) == 0u) { if (xb_ld(&bar[XB_TMO])) break; if (sp > XB_SPIN_CAP) { atomicAdd(&bar[XB_TMO], 1u); break; } }
  }
  nloc = mine > 0u ? mine : 1u; nx = cnt > 0u ? cnt : 1u;
}
DI void xcd_barrier(const Params& p, const XcdBarrier& b) {
  asm volatile("s_waitcnt vmcnt(0)" ::: "memory");
  __syncthreads();
  if (ltid() == 0) {
    unsigned* bar = b.bar;
    __builtin_amdgcn_s_waitcnt(0);
    unsigned nloc = b.st[0], nx = b.st[1];
    if (nloc == 0u) { xcd_barrier_complete(bar, b.x, nloc, nx); b.st[0] = nloc; b.st[1] = nx; }
    const unsigned old = xb_add(&bar[XB_XSUB(b.x)], 1u);
    const unsigned gen = old / nloc;
    if (old + 1u == (gen + 1u) * nloc) {
      __builtin_amdgcn_fence(__ATOMIC_RELEASE, "agent");
      asm volatile("s_waitcnt vmcnt(0)" ::: "memory");
      const unsigned og = xb_add(&bar[XB_TOP], 1u);
      const unsigned tg = og / nx;
      if (og + 1u == (tg + 1u) * nx) xb_add(&bar[XB_TOPGEN], 1u);
      else XB_SPIN(xb_ld(&bar[XB_TOPGEN]) == tg, bar);
      __builtin_amdgcn_fence(__ATOMIC_ACQUIRE, "agent");
      xb_add(&bar[XB_XGEN(b.x)], 1u);
      asm volatile("s_waitcnt vmcnt(0)" ::: "memory");
    } else {
      XB_SPIN(xb_ld(&bar[XB_XGEN(b.x)]) == gen, bar);
      __builtin_amdgcn_fence(__ATOMIC_ACQUIRE, "agent");
      asm volatile("s_waitcnt vmcnt(0)" ::: "memory");
    }
  }
  __syncthreads();
}

constexpr int NPHASE = 3 + 9 * 2;
DI void run_phase(const Params& p0, int ph, char* smem) {
  Params p = p0;
  asm volatile("" : "+s"(p.ws), "+s"(p.out));
  p.ws = as_global(p.ws); p.out = as_global(p.out);
  if (ph == 0) { phase0(p, smem); return; }
  if (ph == 1) { phase1(p); return; }
  if (ph == 2) { tok_phase(p, 0, 0); return; }
  const int l = (ph - 3) / 9, s = (ph - 3) % 9;
  switch (s) {
    case 0: phase_inproj(p, smem); break;
    case 1: phase_scan(p, l, smem); break;
    case 2: phase_combine(p, l, smem); break;
    case 3: phase_merge(p, l, smem); break;
    case 4: phase_gemm_f32(p, (const bf16_t*)(p.ws + OFF_MERGED), 1024, (const bf16_t*)(p.ws + OFF_WTOUT), smem); break;
    case 5: tok_phase(p, l, 1); break;
    case 6: phase_ffn_in(p, smem); break;
    case 7: phase_gemm_f32(p, (const bf16_t*)(p.ws + OFF_ACT), DFF, (const bf16_t*)(p.ws + OFF_WTFO), smem); break;
    case 8:
      tok_phase(p, l, 2);
      if (l + 1 < 2) {
        conv_weight(p, p.in[I_WIN] + (size_t)(l + 1) * 1024 * DIN, DIN, (bf16_t*)(p.ws + OFF_WTIN), 1024, WTIN_ROWS, 0, (float*)smem, blockIdx.x, gridDim.x);
        for (int br = 0; br < 3; ++br) conv_weight(p, p.in[I_WBR] + ((size_t)(l + 1) * 3 + br) * 512 * 1024, 1024, (bf16_t*)(p.ws + OFF_WTBR) + (size_t)br * 1024 * 512, 512, 1024, 1, (float*)smem, blockIdx.x, gridDim.x);
      }
      break;
  }
}

template <bool COOP>
__global__ void __launch_bounds__(NTHR, 2) mega(Params pk, int lo, int hi) {
  __shared__ __attribute__((aligned(16))) char smem[LDS_BYTES];
  Params p = pk;
#pragma unroll
  for (int i = 0; i < N_IN; ++i) p.in[i] = as_global(p.in[i]);
  p.ws = as_global(p.ws); p.out = as_global(p.out);
  p.wb = __builtin_amdgcn_readfirstlane((int)threadIdx.x) & ~63;
  if (COOP) {
    volatile LAS unsigned* st = (volatile LAS unsigned*)(smem + LDS_BYTES - 32);
    if (ltid() == 0) { st[0] = 0u; st[1] = 0u; }
    __syncthreads();
    phase0(p, smem);
    cg::this_grid().sync();
    XcdBarrier b = xcd_barrier_post(p, (unsigned*)(p.ws + OFF_BAR), st);
    if (ltid() == 0) {
      const unsigned hwid = (unsigned)__builtin_amdgcn_s_getreg((31 << 11) | 4);
      const unsigned key = (xb_xcc_id() << 8) | ((hwid >> 8) & 0xFFu);
      ((int*)smem)[(LDS_BYTES - 12) / 4] = (int)xb_add((unsigned*)(p.ws + OFF_ROLE) + key, 1u);
    }
    __syncthreads();
    p.role = __builtin_amdgcn_readfirstlane(((int*)smem)[(LDS_BYTES - 12) / 4]);
    for (int ph = 1; ph < hi; ++ph) {
      run_phase(p, ph, smem);
      if (ph + 1 < hi) xcd_barrier(p, b);
    }
  } else {
    for (int ph = lo; ph < hi; ++ph) run_phase(p, ph, smem);
  }
}

extern "C" void kernel_launch(void* const* d_in, const int* in_sizes, int n_in, void* d_out, int out_size, void* d_ws, size_t ws_size, hipStream_t stream) {
  Params p{};
  for (int i = 0; i < N_IN; ++i) p.in[i] = (const float*)d_in[i];
  p.out = (float*)d_out; p.ws = (char*)d_ws;
  if (ws_size < WS_NEED) fprintf(stderr, "workspace too small: %zu < %zu\n", ws_size, (size_t)WS_NEED);
  static int grid_blocks = 0;
  if (!grid_blocks) {
    int dev = 0, cus = 0, per_cu = 0;
    hipGetDevice(&dev);
    hipDeviceGetAttribute(&cus, hipDeviceAttributeMultiprocessorCount, dev);
    hipOccupancyMaxActiveBlocksPerMultiprocessor(&per_cu, mega<true>, NTHR, 0);
    if (per_cu > 2) per_cu = 2;
    grid_blocks = cus * per_cu;
  }
  int lo = 0, hi = NPHASE;
  void* args[] = {&p, &lo, &hi};
  hipError_t e = hipLaunchCooperativeKernel((void*)mega<true>, dim3(grid_blocks), dim3(NTHR), args, 0, stream);
  if (e != hipSuccess) fprintf(stderr, "cooperative launch failed: %s (grid %d)\n", hipGetErrorString(e), grid_blocks);
}
```

```cpp
#include <hip/hip_runtime.h>
#include <hip/hip_cooperative_groups.h>
#include <cstdio>
namespace cg = cooperative_groups;

typedef unsigned short bf16_t;
typedef short bf16x8 __attribute__((ext_vector_type(8)));
typedef float f32x4 __attribute__((ext_vector_type(4)));
typedef float f32x2 __attribute__((ext_vector_type(2)));
typedef float f32x16 __attribute__((ext_vector_type(16)));
typedef unsigned short u16x4 __attribute__((ext_vector_type(4)));
typedef unsigned short u16x2 __attribute__((ext_vector_type(2)));
typedef unsigned u32x4 __attribute__((ext_vector_type(4)));
typedef unsigned u32x2 __attribute__((ext_vector_type(2)));
static __device__ __forceinline__ unsigned pk2(float lo, float hi) { typedef __bf16 b2 __attribute__((ext_vector_type(2))); typedef float f2 __attribute__((ext_vector_type(2))); return __builtin_bit_cast(unsigned, __builtin_convertvector((f2){lo, hi}, b2)); }

#define DI __device__ __forceinline__
#define GAS __attribute__((address_space(1)))
template <class T> static __device__ __forceinline__ T* as_global(T* q) { return (T*)(GAS T*)(unsigned long long)q; }

constexpr int NT = 16384;
constexpr int DM = 1024;
constexpr int NTHR = 256;
constexpr int DIN = 9616;
constexpr int ZHW = 2560, ZRW = 1920, ZMW = 2048;
constexpr int WTIN_ROWS = 9728;
constexpr int DFF = 2816;

constexpr size_t OFF_WTIN = 0;
constexpr size_t OFF_WTBR = OFF_WTIN + (size_t)WTIN_ROWS * 1024 * 2;
constexpr size_t OFF_H    = OFF_WTBR + (size_t)3 * 1024 * 512 * 2;
constexpr size_t OFF_ZH   = OFF_H + (size_t)NT * 1024 * 2;
constexpr size_t OFF_ZR   = OFF_ZH + (size_t)NT * ZHW * 2;
constexpr size_t OFF_ZM   = OFF_ZR + (size_t)NT * ZRW * 2;
constexpr size_t OFF_MG   = OFF_ZM + (size_t)NT * ZMW * 2;
constexpr size_t OFF_O    = OFF_MG + (size_t)NT * 16 * 4;
constexpr size_t OFF_MOD  = OFF_O + (size_t)NT * 1024 * 2;
constexpr size_t OFF_LBS  = OFF_MOD + (size_t)2 * 5 * 6144 * 4;
constexpr size_t OFF_CTR  = OFF_LBS + 2 * 512 * 4;
constexpr size_t OFF_BAR  = OFF_CTR + 256;
constexpr size_t OFF_ROLE = OFF_BAR + 3456 * 4;
constexpr size_t WS_NEED  = OFF_ROLE + 4096 * 4;
constexpr size_t OFF_MODP = OFF_ZH;
constexpr size_t OFF_WTOUT = OFF_ZR;
constexpr size_t OFF_WTFI  = OFF_WTOUT + (size_t)1024 * 1024 * 2;
constexpr size_t OFF_WTFO  = OFF_WTFI + (size_t)5632 * 1024 * 2;
constexpr size_t OFF_MERGED = OFF_WTFO + (size_t)1024 * 2816 * 2;
constexpr size_t OFF_Y    = OFF_ZH;
constexpr size_t OFF_ACT  = OFF_ZM;

constexpr size_t OUT_HG = 16777216, OUT_RW = 25165824, OUT_C = 29360128, OUT_N = 37748736, OUT_M = 37814272;

enum { I_XP = 0, I_XS, I_SH, I_SR, I_SC, I_SN, I_SM, I_C, I_CCTX, I_WADA, I_BADA, I_NORMS, I_WIN, I_HLB, I_HNORM, I_MU, I_W0, I_W2,
       I_A0, I_A2, I_G2, I_KK, I_KA, I_RK, I_LN, I_GB, I_MNORM, I_WBR, I_WOUT, I_WFI, I_WFO, N_IN };

struct Params { const float* in[N_IN]; float* out; char* ws; int wb; int role; };

constexpr int LDS_BYTES = 77824;

DI bf16_t f2bf(float f) { return __builtin_bit_cast(unsigned short, (__bf16)f); }
DI float bf2f(bf16_t h) { return __uint_as_float(((unsigned)h) << 16); }
DI float sigmoidf_(float x) { return 1.0f / (1.0f + __expf(-x)); }
DI float siluf_(float x) { return x / (1.0f + __expf(-x)); }
DI float softplusf_(float x) { return x > 20.f ? x : __logf(1.0f + __expf(x)); }
DI float dpp_xor1(float x) { return __int_as_float(__builtin_amdgcn_mov_dpp(__float_as_int(x), 0xB1, 0xF, 0xF, true)); }
DI float dpp_xor2(float x) { return __int_as_float(__builtin_amdgcn_mov_dpp(__float_as_int(x), 0x4E, 0xF, 0xF, true)); }
DI float shfl_lane(float v, int src) { return __int_as_float(__builtin_amdgcn_ds_bpermute(src << 2, __float_as_int(v))); }
#define SHX(v, m) shfl_lane((v), lane ^ (m))
DI float wave_sum(float v, int lane) { v += dpp_xor1(v); v += dpp_xor2(v); v += SHX(v, 4); v += SHX(v, 8); v += SHX(v, 16); v += SHX(v, 32); return v; }
DI int ltid_(int wb) { int t = wb + (int)__builtin_amdgcn_mbcnt_hi(~0u, __builtin_amdgcn_mbcnt_lo(~0u, 0u)); asm volatile("" : "+v"(t)); return t; }
#define ltid() ltid_(p.wb)
DI int crow(int reg, int h) { return (reg & 3) + 8 * (reg >> 2) + 4 * h; }

DI int tok_cond(int tok) { return tok < 8192 ? 0 : 1 + ((tok - 8192) >> 11); }
DI const float* x_in_row(const Params& p, int tok) { return tok < 8192 ? p.in[I_XP] + (size_t)tok * DM : p.in[I_XS] + (size_t)(tok - 8192) * DM; }

DI void mma32(f32x16& acc, const bf16_t* A, int lda, const bf16_t* B, int ldb, int K, int lane) {
  const int r = lane & 31, h = lane >> 5;
#pragma unroll 2
  for (int kk = 0; kk < K; kk += 16) {
    bf16x8 a = *(const bf16x8*)(A + r * lda + kk + 8 * h);
    bf16x8 b = *(const bf16x8*)(B + r * ldb + kk + 8 * h);
    acc = __builtin_amdgcn_mfma_f32_32x32x16_bf16(a, b, acc, 0, 0, 0);
  }
}

template <int BM, int BN, int BK, bool WR, bool LD>
DI void gemm_ktile(f32x4 (&acc)[BM / 32][BN / 32], bf16x8 (&ra)[BM * BK / 2048], bf16x8 (&rb)[BN * BK / 2048],
                   const bf16_t* __restrict__ A, int lda, const bf16_t* __restrict__ B, int ldb, int k2,
                   const bf16_t* as, const bf16_t* bs, bf16_t* Aw, bf16_t* Bw) {
  constexpr int MI = BM / 32, NJ = BN / 32, LS = BK + 8, ACH = BM * BK / 2048, BCH = BN * BK / 2048, KS = BK / 32, RPI = 256 / (BK / 8);
  static_assert(KS * MI >= ACH + BCH, "not enough MFMA row blocks to carry the staging");
  __builtin_amdgcn_s_setprio(1);
#pragma unroll
  for (int ks = 0; ks < KS; ++ks) {
    bf16x8 bfr[NJ];
#pragma unroll
    for (int j = 0; j < NJ; ++j) bfr[j] = *(const bf16x8*)(bs + j * 16 * LS + ks * 32);
    bf16x8 afn = *(const bf16x8*)(as + ks * 32);
#pragma unroll
    for (int i = 0; i < MI; ++i) {
      const bf16x8 af = afn;
      if (i + 1 < MI) afn = *(const bf16x8*)(as + (i + 1) * 16 * LS + ks * 32);
#pragma unroll
      for (int j = 0; j < NJ; ++j) acc[i][j] = __builtin_amdgcn_mfma_f32_16x16x32_bf16(bfr[j], af, acc[i][j], 0, 0, 0);
      const int s = ks * MI + i;
      if (s < ACH) {
        if (WR) *(bf16x8*)(Aw + RPI * s * LS) = ra[s < ACH ? s : 0];
        if (LD) ra[s < ACH ? s : 0] = *(const bf16x8*)(A + (size_t)(RPI * s) * lda + k2);
      } else if (s < ACH + BCH) {
        const int c = s - ACH;
        if (WR) *(bf16x8*)(Bw + RPI * c * LS) = rb[(c >= 0 && c < BCH) ? c : 0];
        if (LD) rb[(c >= 0 && c < BCH) ? c : 0] = *(const bf16x8*)(B + (size_t)(RPI * c) * ldb + k2);
      }
      __builtin_amdgcn_sched_barrier(0);
    }
  }
  __builtin_amdgcn_s_setprio(0);
}

template <int BM, int BN, int BK>
DI void gemm_main(const Params& p, f32x4 (&acc)[BM / 32][BN / 32], bf16x8 (&ra)[BM * BK / 2048], bf16x8 (&rb)[BN * BK / 2048], bool primed,
                  const bf16_t* __restrict__ A, int lda, const bf16_t* __restrict__ B, int ldb, int K,
                  const bf16_t* __restrict__ An, int ldan, const bf16_t* __restrict__ Bn, int ldbn, bf16_t* sm) {
  constexpr int LS = BK + 8, CPR = BK / 8, ACH = BM * BK / 2048, BCH = BN * BK / 2048, RPI = 256 / CPR;
  const int tid = ltid(), lane = tid & 63, w = tid >> 6, wm = w >> 1, wn = w & 1;
  bf16_t* As = sm; bf16_t* Bs = sm + 2 * BM * LS;
  const int nk = K / BK;
  const int lrow = tid / CPR, lkc = (tid % CPR) * 8;
  const bf16_t* Ag = A + (size_t)lrow * lda + lkc;
  const bf16_t* Bg = B + (size_t)lrow * ldb + lkc;
  bf16_t* Al = As + lrow * LS + lkc; bf16_t* Bl = Bs + lrow * LS + lkc;
  if (!primed) {
#pragma unroll
    for (int i = 0; i < ACH; ++i) ra[i] = *(const bf16x8*)(Ag + (size_t)(RPI * i) * lda);
#pragma unroll
    for (int i = 0; i < BCH; ++i) rb[i] = *(const bf16x8*)(Bg + (size_t)(RPI * i) * ldb);
    __syncthreads();
#pragma unroll
    for (int i = 0; i < ACH; ++i) *(bf16x8*)(Al + RPI * i * LS) = ra[i];
#pragma unroll
    for (int i = 0; i < BCH; ++i) *(bf16x8*)(Bl + RPI * i * LS) = rb[i];
#pragma unroll
    for (int i = 0; i < ACH; ++i) ra[i] = *(const bf16x8*)(Ag + (size_t)(RPI * i) * lda + BK);
#pragma unroll
    for (int i = 0; i < BCH; ++i) rb[i] = *(const bf16x8*)(Bg + (size_t)(RPI * i) * ldb + BK);
    __syncthreads();
  }
  const bf16_t* as0 = As + (wm * (BM / 2) + (lane & 15)) * LS + (lane >> 4) * 8;
  const bf16_t* bs0 = Bs + (wn * (BN / 2) + (lane & 15)) * LS + (lane >> 4) * 8;
  int kt = 0;
  for (; kt + 2 < nk; ++kt) {
    const int buf = kt & 1, nb = buf ^ 1;
    gemm_ktile<BM, BN, BK, true, true>(acc, ra, rb, Ag, lda, Bg, ldb, (kt + 2) * BK, as0 + buf * BM * LS, bs0 + buf * BN * LS, Al + nb * BM * LS, Bl + nb * BN * LS);
    __syncthreads();
  }
  {
    const bf16_t* Agn = An + (size_t)lrow * ldan + lkc;
    const bf16_t* Bgn = Bn + (size_t)lrow * ldbn + lkc;
    gemm_ktile<BM, BN, BK, true, true>(acc, ra, rb, Agn, ldan, Bgn, ldbn, 0, as0, bs0, Al + BM * LS, Bl + BN * LS);
    __syncthreads();
    gemm_ktile<BM, BN, BK, true, true>(acc, ra, rb, Agn, ldan, Bgn, ldbn, BK, as0 + BM * LS, bs0 + BN * LS, Al, Bl);
    __syncthreads();
  }
}

template <int MI, int NJ> DI void zero_acc(f32x4 (&acc)[MI][NJ]) {
#pragma unroll
  for (int i = 0; i < MI; ++i)
#pragma unroll
    for (int j = 0; j < NJ; ++j) acc[i][j] = (f32x4){0.f, 0.f, 0.f, 0.f};
}
DI void store_bf4(bf16_t* dst, f32x4 v) { u16x4 o; o[0] = f2bf(v[0]); o[1] = f2bf(v[1]); o[2] = f2bf(v[2]); o[3] = f2bf(v[3]); *(u16x4*)dst = o; }

DI int map_col(int mode, int n) {
  if (mode == 0) return n < 6544 ? n : (n < 6656 ? -1 : n - 112);
  if (mode == 2) return ((n >> 4) & 1) ? DFF + (n >> 5) * 16 + (n & 15) : (n >> 5) * 16 + (n & 15);
  return n;
}
DI void conv_tile(const Params& p, const float* __restrict__ src, int ld_src, bf16_t* __restrict__ dst, int K, int mode, int tk, int tn, float* sm) {
  const int tid = ltid();
  __syncthreads();
  {
    const int nn = tid & 63, col = map_col(mode, tn * 64 + nn);
#pragma unroll
    for (int i = 0; i < 16; ++i) { int kk = (tid >> 6) + 4 * i; sm[kk * 65 + nn] = col >= 0 ? src[(size_t)(tk * 64 + kk) * ld_src + col] : 0.f; }
  }
  __syncthreads();
  {
    const int kk = tid & 63;
#pragma unroll
    for (int i = 0; i < 16; ++i) { int nn = (tid >> 6) + 4 * i; dst[(size_t)(tn * 64 + nn) * K + tk * 64 + kk] = f2bf(sm[kk * 65 + nn]); }
  }
}
DI void conv_weight(const Params& p, const float* src, int ld_src, bf16_t* dst, int K, int Ndst, int mode, float* sm, int bid, int nb) {
  const int tkn = K / 64, nt = tkn * (Ndst / 64);
  for (int t = bid; t < nt; t += nb) conv_tile(p, src, ld_src, dst, K, mode, t % tkn, t / tkn, sm);
}

DI void phase0(const Params& p, char* smem) {
  const int tid = ltid(), bid = blockIdx.x, nb = gridDim.x;
  float* MODP = (float*)(p.ws + OFF_MODP);
  float* sm = (float*)smem;
  if (bid == 0) { if (tid < 64) ((int*)(p.ws + OFF_CTR))[tid] = 0; for (int i = tid; i < 3456; i += NTHR) ((unsigned*)(p.ws + OFF_BAR))[i] = 0u; for (int i = tid; i < 4096; i += NTHR) ((unsigned*)(p.ws + OFF_ROLE))[i] = 0u; }
  for (int i = bid * NTHR + tid; i < 512; i += nb * NTHR) {
    float a = p.in[I_HLB][i], b = p.in[I_HLB][512 + i];
    float* L = (float*)(p.ws + OFF_LBS); L[i] = 0.f; L[512 + i] = 1.0f / (1.0f + expf(a - b));
  }
  for (int it = bid; it < 2 * 24 * 16; it += nb) {
    const int ks = it & 15, jb = (it >> 4) % 24, l = it / (16 * 24);
    __syncthreads();
    for (int e = tid; e < 5 * 64; e += NTHR) { int ci = e >> 6, k = ks * 64 + (e & 63); float cv = ci == 0 ? p.in[I_CCTX][k] : p.in[I_C][(ci - 1) * DM + k]; sm[e] = siluf_(cv); }
    __syncthreads();
    const int j = jb * 256 + tid;
    float a0 = 0, a1 = 0, a2 = 0, a3 = 0, a4 = 0;
    const float* W = p.in[I_WADA] + ((size_t)l * DM + ks * 64) * 6144 + j;
#pragma unroll 1
    for (int k0 = 0; k0 < 64; k0 += 16) {
      float wv[16];
#pragma unroll
      for (int u = 0; u < 16; ++u) wv[u] = W[(size_t)(k0 + u) * 6144];
#pragma unroll
      for (int u = 0; u < 16; ++u) { const int k = k0 + u; const float w = wv[u]; a0 += sm[k] * w; a1 += sm[64 + k] * w; a2 += sm[128 + k] * w; a3 += sm[192 + k] * w; a4 += sm[256 + k] * w; }
    }
    float* dst = MODP + ((size_t)(ks * 2 + l) * 5) * 6144 + j;
    dst[0] = a0; dst[6144] = a1; dst[2 * 6144] = a2; dst[3 * 6144] = a3; dst[4 * 6144] = a4;
  }
  conv_weight(p, p.in[I_WIN], DIN, (bf16_t*)(p.ws + OFF_WTIN), 1024, WTIN_ROWS, 0, sm, bid, nb);
  for (int br = 0; br < 3; ++br) conv_weight(p, p.in[I_WBR] + (size_t)br * 512 * 1024, 1024, (bf16_t*)(p.ws + OFF_WTBR) + (size_t)br * 1024 * 512, 512, 1024, 1, sm, bid, nb);
}
DI void phase1(const Params& p) {
  const float* MODP = (const float*)(p.ws + OFF_MODP);
  float* MOD = (float*)(p.ws + OFF_MOD);
  for (int i = blockIdx.x * NTHR + ltid(); i < 2 * 5 * 6144; i += gridDim.x * NTHR) {
    const int j = i % 6144, l = i / (5 * 6144);
    float s = p.in[I_BADA][l * 6144 + j];
    for (int ks = 0; ks < 16; ++ks) s += MODP[(size_t)ks * 2 * 5 * 6144 + i];
    MOD[i] = s;
  }
}

DI void norm_mod_store(const f32x4 (&x)[4], const float* nw, const float* sc, const float* sh, bf16_t* hrow, int lane) {
  float ss = 0.f;
#pragma unroll
  for (int i = 0; i < 4; ++i) ss += x[i][0] * x[i][0] + x[i][1] * x[i][1] + x[i][2] * x[i][2] + x[i][3] * x[i][3];
  ss = wave_sum(ss, lane);
  const float rs = rsqrtf(ss * (1.0f / DM) + 1e-6f);
#pragma unroll
  for (int i = 0; i < 4; ++i) {
    const int c = i * 256 + lane * 4;
    f32x4 w = *(const f32x4*)(nw + c), s1 = *(const f32x4*)(sc + c), s0 = *(const f32x4*)(sh + c), o;
#pragma unroll
    for (int e = 0; e < 4; ++e) o[e] = x[i][e] * rs * w[e] * (1.0f + s1[e]) + s0[e];
    store_bf4(hrow + c, o);
  }
}
DI void tok_one(const Params& p, int l, int mode, int tok, int lane) {
  const float* MOD = (const float*)(p.ws + OFF_MOD);
  bf16_t* H = (bf16_t*)(p.ws + OFF_H);
  const float* Y = (const float*)(p.ws + OFF_Y);
  const int ci = tok_cond(tok);
  const float* modl = MOD + (size_t)(l * 5 + ci) * 6144;
  const float* nwl = p.in[I_NORMS] + (size_t)l * 4 * DM;
  const bool from_in = (l == 0 && (mode == 0 || mode == 1 || mode == 3));
  const float* xr = from_in ? x_in_row(p, tok) : p.out + (size_t)tok * DM;
  const bool has_y = (mode == 1 || mode == 2);
  const bool has_h = !(mode == 2 && l + 1 >= 2);
  const float* modn = (mode == 2 && has_h) ? MOD + (size_t)((l + 1) * 5 + ci) * 6144 : modl;
  const float* nw2 = mode == 1 ? nwl + 2 * DM : (mode == 2 ? p.in[I_NORMS] + (size_t)(has_h ? l + 1 : l) * 4 * DM : nwl);
  const float* sc2 = mode == 1 ? modl + 4 * DM : modn + 1 * DM;
  const float* sh2 = mode == 1 ? modl + 3 * DM : modn + 0 * DM;
  const float* nwy = nwl + (mode == 1 ? 1 : 3) * DM;
  const float* gy = modl + (mode == 1 ? 2 : 5) * DM;
  f32x4 x[4], y[4], wy[4], gg[4], w2[4], s1[4], s0[4];
#pragma unroll
  for (int i = 0; i < 4; ++i) {
    const int c = i * 256 + lane * 4;
    x[i] = *(const f32x4*)(xr + c);
    if (has_y) { y[i] = *(const f32x4*)(Y + (size_t)tok * DM + c); wy[i] = *(const f32x4*)(nwy + c); gg[i] = *(const f32x4*)(gy + c); }
    if (has_h) { w2[i] = *(const f32x4*)(nw2 + c); s1[i] = *(const f32x4*)(sc2 + c); s0[i] = *(const f32x4*)(sh2 + c); }
  }
  if (has_y) {
    float ss = 0.f;
#pragma unroll
    for (int i = 0; i < 4; ++i) ss += y[i][0] * y[i][0] + y[i][1] * y[i][1] + y[i][2] * y[i][2] + y[i][3] * y[i][3];
    ss = wave_sum(ss, lane);
    const float rs = rsqrtf(ss * (1.0f / DM) + 1e-6f);
#pragma unroll
    for (int i = 0; i < 4; ++i) {
      const int c = i * 256 + lane * 4;
#pragma unroll
      for (int e = 0; e < 4; ++e) x[i][e] += gg[i][e] * (y[i][e] * rs * wy[i][e]);
      *(f32x4*)(p.out + (size_t)tok * DM + c) = x[i];
    }
  }
  if (has_h) {
    float ss = 0.f;
#pragma unroll
    for (int i = 0; i < 4; ++i) ss += x[i][0] * x[i][0] + x[i][1] * x[i][1] + x[i][2] * x[i][2] + x[i][3] * x[i][3];
    ss = wave_sum(ss, lane);
    const float rs = rsqrtf(ss * (1.0f / DM) + 1e-6f);
#pragma unroll
    for (int i = 0; i < 4; ++i) {
      f32x4 o;
#pragma unroll
      for (int e = 0; e < 4; ++e) o[e] = x[i][e] * rs * w2[i][e] * (1.0f + s1[i][e]) + s0[i][e];
      store_bf4(H + (size_t)tok * DM + i * 256 + lane * 4, o);
    }
  }
}
DI void tok_phase(const Params& p, int l, int mode) {
  const int lane = ltid() & 63, gw = blockIdx.x * 4 + (ltid() >> 6), nw = gridDim.x * 4;
  for (int tok = gw; tok < NT; tok += nw) tok_one(p, l, mode, tok, lane);
}

DI bool tile_xcd(int i, int NTN, int MTX, int& mt, int& nt) {
  const int G = gridDim.x, b = blockIdx.x, x = b & 7, j = b >> 3, nbx = (G - x + 7) >> 3;
  const int u = j + i * nbx;
  if (u >= MTX * NTN) return false;
  mt = MTX * x + (u % MTX); nt = u / MTX;
  return true;
}
DI void phase_inproj(const Params& p, char* smem) {
  const bf16_t* H = (const bf16_t*)(p.ws + OFF_H);
  const bf16_t* WT = (const bf16_t*)(p.ws + OFF_WTIN);
  bf16_t* ZH = (bf16_t*)(p.ws + OFF_ZH); bf16_t* ZR = (bf16_t*)(p.ws + OFF_ZR); bf16_t* ZM = (bf16_t*)(p.ws + OFF_ZM);
  float* MG = (float*)(p.ws + OFF_MG);
  bf16x8 ra[4], rb[2]; bool primed = false;
  int mt, nt; bool have = tile_xcd(0, 52, 8, mt, nt);
  for (int ti = 0; have; ++ti) {
    int mtn = 0, ntn = 0; const bool haven = tile_xcd(ti + 1, 52, 8, mtn, ntn);
    f32x4 acc[8][4]; zero_acc<8, 4>(acc);
    gemm_main<256, 128, 32>(p, acc, ra, rb, primed, H + (size_t)mt * 256 * 1024, 1024, WT + (size_t)nt * 128 * 1024, 1024, 1024,
                            H + (size_t)(haven ? mtn : mt) * 256 * 1024, 1024, WT + (size_t)(haven ? ntn : nt) * 128 * 1024, 1024, (bf16_t*)smem);
    primed = haven;
    const int lane = ltid() & 63, w = ltid() >> 6, wm = w >> 1, wn = w & 1; (void)wm; (void)wn;
    const int n0 = nt * 128;
#pragma unroll
    for (int i = 0; i < 8; ++i) {
      asm volatile("" ::: "memory");
      const int row = mt * 256 + wm * 128 + i * 16 + (lane & 15);
#pragma unroll
      for (int j = 0; j < 4; ++j) {
        const int col = n0 + wn * 64 + j * 16 + 4 * (lane >> 4);
        if (n0 < 2560) store_bf4(ZH + (size_t)row * ZHW + col, acc[i][j]);
        else if (n0 < 4480) store_bf4(ZR + (size_t)row * ZRW + (col - 2560), acc[i][j]);
        else if (n0 < 6528) store_bf4(ZM + (size_t)row * ZMW + (col - 4480), acc[i][j]);
        else if (col - 6528 < 16) *(f32x4*)(MG + (size_t)row * 16 + (col - 6528)) = acc[i][j];
      }
    }
    mt = mtn; nt = ntn; have = haven;
  }
}

DI void merge_sub(const Params& p, int mt, int nt, int s, const bf16_t*& A_, int& lda_, const bf16_t*& B_, int& ldb_, int& K_) {
  const bf16_t* H = (const bf16_t*)(p.ws + OFF_H);
  const bf16_t* WT = (const bf16_t*)(p.ws + OFF_WTIN);
  const bf16_t* WBR = (const bf16_t*)(p.ws + OFF_WTBR);
  const bf16_t* ZH = (const bf16_t*)(p.ws + OFF_ZH); const bf16_t* ZM = (const bf16_t*)(p.ws + OFF_ZM); const bf16_t* O = (const bf16_t*)(p.ws + OFF_O);
  const int br = s >> 1;
  if (!(s & 1)) { A_ = H + (size_t)mt * 128 * 1024; lda_ = 1024; B_ = WT + (size_t)(6656 + br * 1024 + nt * 64) * 1024; ldb_ = 1024; K_ = 1024; }
  else {
    const bf16_t* Ab; int lda;
    if (br == 0) { Ab = ZH + 2048; lda = ZHW; } else if (br == 1) { Ab = O; lda = 1024; } else { Ab = ZM + 1536; lda = ZMW; }
    A_ = Ab + (size_t)mt * 128 * lda; lda_ = lda; B_ = WBR + ((size_t)br * 1024 + nt * 64) * 512; ldb_ = 512; K_ = 512;
  }
}
DI void phase_merge(const Params& p, int l, char* smem) {
  bf16_t* MER = (bf16_t*)(p.ws + OFF_MERGED);
  bf16x8 ra[4], rb[2]; bool primed = false;
  int mt, nt; bool have = tile_xcd(0, 16, 16, mt, nt);
  for (int ti = 0; have; ++ti) {
    int mtn = 0, ntn = 0; const bool haven = tile_xcd(ti + 1, 16, 16, mtn, ntn);
    f32x4 accM[4][2]; zero_acc<4, 2>(accM);
#pragma unroll 1
    for (int br = 0; br < 3; ++br) {
      f32x4 accG[4][2], accP[4][2]; zero_acc<4, 2>(accG); zero_acc<4, 2>(accP);
      const bf16_t *A0, *B0, *A1, *B1, *A2, *B2; int la0, lb0, k0, la1, lb1, k1, la2, lb2, k2;
      merge_sub(p, mt, nt, 2 * br, A0, la0, B0, lb0, k0);
      merge_sub(p, mt, nt, 2 * br + 1, A1, la1, B1, lb1, k1);
      const bool more = (br < 2) || haven;
      if (br < 2) merge_sub(p, mt, nt, 2 * br + 2, A2, la2, B2, lb2, k2); else merge_sub(p, haven ? mtn : mt, haven ? ntn : nt, 0, A2, la2, B2, lb2, k2);
      gemm_main<128, 64, 64>(p, accG, ra, rb, primed, A0, la0, B0, lb0, k0, A1, la1, B1, lb1, (bf16_t*)smem);
      gemm_main<128, 64, 64>(p, accP, ra, rb, true, A1, la1, B1, lb1, k1, A2, la2, B2, lb2, (bf16_t*)smem);
      primed = more;
#pragma unroll
      for (int i = 0; i < 4; ++i)
#pragma unroll
        for (int j = 0; j < 2; ++j)
#pragma unroll
          for (int e = 0; e < 4; ++e) accM[i][j][e] += sigmoidf_(accG[i][j][e]) * accP[i][j][e];
    }
    const int lane = ltid() & 63, w = ltid() >> 6, wm = w >> 1, wn = w & 1;
#pragma unroll
    for (int i = 0; i < 4; ++i) {
      const int row = mt * 128 + wm * 64 + i * 16 + (lane & 15);
#pragma unroll
      for (int j = 0; j < 2; ++j) store_bf4(MER + (size_t)row * 1024 + nt * 64 + wn * 32 + j * 16 + 4 * (lane >> 4), accM[i][j]);
    }
    mt = mtn; nt = ntn; have = haven;
  }
  float* sm = (float*)smem;
  conv_weight(p, p.in[I_WOUT] + (size_t)l * 1024 * 1024, 1024, (bf16_t*)(p.ws + OFF_WTOUT), 1024, 1024, 1, sm, blockIdx.x, gridDim.x);
  conv_weight(p, p.in[I_WFI] + (size_t)l * 1024 * 5632, 5632, (bf16_t*)(p.ws + OFF_WTFI), 1024, 5632, 2, sm, blockIdx.x, gridDim.x);
  conv_weight(p, p.in[I_WFO] + (size_t)l * DFF * 1024, 1024, (bf16_t*)(p.ws + OFF_WTFO), DFF, 1024, 1, sm, blockIdx.x, gridDim.x);
}

DI void phase_gemm_f32(const Params& p, const bf16_t* A, int K, const bf16_t* Wt, char* smem) {
  float* Y = (float*)(p.ws + OFF_Y);
  bf16x8 ra[4], rb[2]; bool primed = false;
  int mt, nt; bool have = tile_xcd(0, 8, 8, mt, nt);
  for (int ti = 0; have; ++ti) {
    int mtn = 0, ntn = 0; const bool haven = tile_xcd(ti + 1, 8, 8, mtn, ntn);
    f32x4 acc[8][4]; zero_acc<8, 4>(acc);
    gemm_main<256, 128, 32>(p, acc, ra, rb, primed, A + (size_t)mt * 256 * K, K, Wt + (size_t)nt * 128 * K, K, K,
                            A + (size_t)(haven ? mtn : mt) * 256 * K, K, Wt + (size_t)(haven ? ntn : nt) * 128 * K, K, (bf16_t*)smem);
    primed = haven;
    const int lane = ltid() & 63, w = ltid() >> 6, wm = w >> 1, wn = w & 1; (void)wm; (void)wn;
#pragma unroll
    for (int i = 0; i < 8; ++i) {
      asm volatile("" ::: "memory");
      const int row = mt * 256 + wm * 128 + i * 16 + (lane & 15);
#pragma unroll
      for (int j = 0; j < 4; ++j) *(f32x4*)(Y + (size_t)row * 1024 + nt * 128 + wn * 64 + j * 16 + 4 * (lane >> 4)) = acc[i][j];
    }
    mt = mtn; nt = ntn; have = haven;
  }
}
DI void phase_ffn_in(const Params& p, char* smem) {
  const bf16_t* H = (const bf16_t*)(p.ws + OFF_H);
  const bf16_t* Wt = (const bf16_t*)(p.ws + OFF_WTFI);
  bf16_t* ACT = (bf16_t*)(p.ws + OFF_ACT);
  bf16x8 ra[4], rb[2]; bool primed = false;
  int mt, nt; bool have = tile_xcd(0, 44, 8, mt, nt);
  for (int ti = 0; have; ++ti) {
    int mtn = 0, ntn = 0; const bool haven = tile_xcd(ti + 1, 44, 8, mtn, ntn);
    f32x4 acc[8][4]; zero_acc<8, 4>(acc);
    gemm_main<256, 128, 32>(p, acc, ra, rb, primed, H + (size_t)mt * 256 * 1024, 1024, Wt + (size_t)nt * 128 * 1024, 1024, 1024,
                            H + (size_t)(haven ? mtn : mt) * 256 * 1024, 1024, Wt + (size_t)(haven ? ntn : nt) * 128 * 1024, 1024, (bf16_t*)smem);
    primed = haven;
    const int lane = ltid() & 63, w = ltid() >> 6, wm = w >> 1, wn = w & 1; (void)wm; (void)wn;
#pragma unroll
    for (int i = 0; i < 8; ++i) {
      asm volatile("" ::: "memory");
      const int row = mt * 256 + wm * 128 + i * 16 + (lane & 15);
#pragma unroll
      for (int jj = 0; jj < 2; ++jj) {
        f32x4 u = acc[i][2 * jj], g = acc[i][2 * jj + 1], o;
#pragma unroll
        for (int e = 0; e < 4; ++e) o[e] = siluf_(g[e]) * u[e];
        const int col = (nt * 128 + wn * 64 + jj * 32) / 2 + 4 * (lane >> 4);
        store_bf4(ACT + (size_t)row * DFF + col, o);
      }
    }
    mt = mtn; nt = ntn; have = haven;
  }
}

struct Seq { int base, T, grid, b; bool sample; };
DI Seq get_seq(int s) { Seq q; if (s < 32) { q.base = s * 256; q.T = 256; q.grid = 0; q.b = s; q.sample = false; } else { q.b = s - 32; q.base = 8192 + q.b * 2048; q.T = 2048; q.grid = 1; q.sample = true; } return q; }

DI float rw_shift(const bf16_t* ZR, const float* mu, int base, int t, int T, int grid, int col) {
  const bf16_t* pp = ZR + (size_t)(base + t) * ZRW + col;
  const float y = bf2f(*pp);
  if (!grid) {
    const float prev = t > 0 ? bf2f(pp[-ZRW]) : 0.f, nxt = t < T - 1 ? bf2f(pp[ZRW]) : 0.f;
    return y + mu[col] * (prev - y) + mu[ZRW + col] * (nxt - y);
  }
  const int gc = t & 63, gr = t >> 6;
  const float left = gc > 0 ? bf2f(pp[-ZRW]) : 0.f, right = gc < 63 ? bf2f(pp[ZRW]) : 0.f;
  const float up = gr > 0 ? bf2f(pp[-64 * ZRW]) : 0.f, down = gr < 31 ? bf2f(pp[64 * ZRW]) : 0.f;
  return y + mu[col] * (left - y) + mu[ZRW + col] * (right - y) + mu[2 * ZRW + col] * (up - y) + mu[3 * ZRW + col] * (down - y);
}

DI void rw_shift8(const bf16_t* ZR, const float* mu, int base, int t, int T, int grid, int col0, float (&out)[8]) {
  const bf16_t* pp = ZR + (size_t)(base + t) * ZRW + col0;
  const bf16x8 y = *(const bf16x8*)pp;
  float yv[8];
#pragma unroll
  for (int e = 0; e < 8; ++e) { yv[e] = bf2f((bf16_t)y[e]); out[e] = yv[e]; }
  const int nn = grid ? 4 : 2;
#pragma unroll 1
  for (int n = 0; n < nn; ++n) {
    bool valid; int off;
    if (!grid) { valid = n == 0 ? t > 0 : t < T - 1; off = n == 0 ? -ZRW : ZRW; }
    else { const int gc = t & 63, gr = t >> 6; valid = n == 0 ? gc > 0 : n == 1 ? gc < 63 : n == 2 ? gr > 0 : gr < 31; off = n == 0 ? -ZRW : n == 1 ? ZRW : n == 2 ? -64 * ZRW : 64 * ZRW; }
    const f32x4 m0 = *(const f32x4*)(mu + n * ZRW + col0), m1 = *(const f32x4*)(mu + n * ZRW + col0 + 4);
    bf16x8 nb = y;
    if (valid) nb = *(const bf16x8*)(pp + off);
#pragma unroll
    for (int e = 0; e < 8; ++e) { const float nv_ = valid ? bf2f((bf16_t)nb[e]) : 0.f; const float mm = e < 4 ? m0[e & 3] : m1[e & 3]; out[e] += mm * (nv_ - yv[e]); }
  }
}

DI void rw_load8(const bf16_t* ZR, int base, int t, int T, int grid, int col0, bf16x8 (&v)[5]) {
  const bf16_t* pp = ZR + (size_t)(base + t) * ZRW + col0;
  const int gc = t & 63, gr = t >> 6;
  const int o1 = grid ? (gc > 0 ? -ZRW : 0) : (t > 0 ? -ZRW : 0);
  const int o2 = grid ? (gc < 63 ? ZRW : 0) : (t < T - 1 ? ZRW : 0);
  v[0] = *(const bf16x8*)pp;
  v[1] = *(const bf16x8*)(pp + o1);
  v[2] = *(const bf16x8*)(pp + o2);
  if (grid) {
    v[3] = *(const bf16x8*)(pp + (gr > 0 ? -64 * ZRW : 0)); v[4] = *(const bf16x8*)(pp + (gr < 31 ? 64 * ZRW : 0));
  } else {
    v[3] = (bf16x8){0, 0, 0, 0, 0, 0, 0, 0}; v[4] = (bf16x8){0, 0, 0, 0, 0, 0, 0, 0};
  }
}
DI unsigned rw_valid(int t, int T, int grid) {
  if (!grid) return (t > 0 ? 1u : 0u) | (t < T - 1 ? 2u : 0u);
  const int gc = t & 63, gr = t >> 6;
  return (gc > 0 ? 1u : 0u) | (gc < 63 ? 2u : 0u) | (gr > 0 ? 4u : 0u) | (gr < 31 ? 8u : 0u);
}
DI void rw_apply8(const bf16x8 (&v)[5], const float* mu, int grid, unsigned valid, int col0, float (&out)[8]) {
  float yv[8];
#pragma unroll
  for (int e = 0; e < 8; ++e) { yv[e] = bf2f((bf16_t)v[0][e]); out[e] = yv[e]; }
#pragma unroll
  for (int n = 0; n < 4; ++n) {
    if (n < 2 || grid) {
      const f32x4 m0 = *(const f32x4*)(mu + n * ZRW + col0), m1 = *(const f32x4*)(mu + n * ZRW + col0 + 4);
      const bool ok = (valid >> n) & 1u;
#pragma unroll
      for (int e = 0; e < 8; ++e) out[e] += (e < 4 ? m0[e & 3] : m1[e & 3]) * ((ok ? bf2f((bf16_t)v[1 + n][e]) : 0.f) - yv[e]);
    }
  }
}
DI void rw_apply8_lds(const bf16x8 (&v)[5], const float* mu5c, const float* c0c, int grid, unsigned valid, float (&out)[8]) {
  {
    const f32x4 c0 = *(const f32x4*)c0c, c1 = *(const f32x4*)(c0c + 4);
#pragma unroll
    for (int e = 0; e < 8; ++e) out[e] = bf2f((bf16_t)v[0][e]) * (e < 4 ? c0[e & 3] : c1[e & 3]);
  }
#pragma unroll
  for (int n = 0; n < 4; ++n) {
    if (n < 2 || grid) {
      const f32x4 m0 = *(const f32x4*)(mu5c + n * 320), m1 = *(const f32x4*)(mu5c + n * 320 + 4);
      const float ok = ((valid >> n) & 1u) ? 1.0f : 0.0f;
#pragma unroll
      for (int e = 0; e < 8; ++e) out[e] += (e < 4 ? m0[e & 3] : m1[e & 3]) * ok * bf2f((bf16_t)v[1 + n][e]);
    }
  }
}
DI float fast_tanh(float x) { return 1.0f - 2.0f / (1.0f + __expf(2.0f * x)); }
template <int N> DI float dpp_row_shr0(float x) { return __int_as_float(__builtin_amdgcn_update_dpp(0, __float_as_int(x), 0x110 + N, 0xF, 0xF, false)); }

DI void rwkv_item(const Params& p, int l, int s, int hh, int d, char* smem) {
  const Seq q = get_seq(s);
  const int tid0 = ltid();
  const int w = __builtin_amdgcn_readfirstlane(tid0 >> 6), vb = w >> 1, kb = w & 1;
  int tid = tid0, lane = tid & 63, l15 = lane & 15, qq = lane >> 4, r32 = lane & 31, h = lane >> 5;
  const bf16_t* ZR = (const bf16_t*)(p.ws + OFF_ZR);
  bf16_t* O = (bf16_t*)(p.ws + OFF_O);
  const float* mu = p.in[I_MU] + (size_t)l * 4 * ZRW;
  bf16_t* KHr = (bf16_t*)smem;
  bf16_t* BCr = KHr + 16 * 72;
  bf16_t* KC = BCr + 16 * 72;
  bf16_t* RH = KC + 16 * 72;
  bf16_t* Sb = RH + 16 * 72;
  bf16_t* Wb2 = (bf16_t*)smem;
  bf16_t* Ab2 = Wb2 + 64 * 72;
  float* mu5 = (float*)(smem + 18432);
  bf16_t* actW = (bf16_t*)(smem + 23552);
  bf16_t* actA = actW + 16 * 72;
  float* shR = (float*)(smem + 28160);
  float* shK = shR + 1024; float* shV = shK + 1024;
  bf16_t* VT0 = (bf16_t*)(smem + 40448);
  bf16_t* VT1 = (bf16_t*)(smem + 69376);
  bf16_t* UNT = VT0 + 64 * 40;
  bf16_t* KBT = UNT + 64 * 40;
  bf16_t* BBT = KBT + 64 * 24;
  float* PL = (float*)(smem + 56832);
  float* npart = PL + 64;
  float* MN = (float*)(smem + 57344);
  float* G0 = (float*)(smem + 61440);
  bf16_t* ArkM = (bf16_t*)(smem + 65536);
  bf16_t* ArbM = ArkM + 16 * 40;
  float* c0t = (float*)(smem + 68096);
  __syncthreads();
  for (int e = tid; e < 4096; e += NTHR) {
    const int i = e >> 6, c = e & 63;
    Wb2[c * 72 + i] = f2bf(p.in[I_W2][((size_t)(l * 2 + d) * 64 + i) * 512 + 64 * hh + c]);
    Ab2[c * 72 + i] = f2bf(p.in[I_A2][((size_t)(l * 2 + d) * 64 + i) * 512 + 64 * hh + c]);
  }
  for (int e = tid; e < 1280; e += NTHR) {
    const int n = e / 320, rem = e % 320, arr = rem >> 6, c = rem & 63;
    const int col = arr == 0 ? 64 * hh + c : arr == 1 ? 512 + 64 * hh + c : arr == 2 ? 1024 + 64 * hh + c : arr == 3 ? 1536 + 64 * d + c : 1664 + 64 * d + c;
    mu5[e] = mu[n * ZRW + col];
  }
  for (int e = tid; e < 320; e += NTHR) {
    const int arr = e >> 6, c = e & 63;
    const int col = arr == 0 ? 64 * hh + c : arr == 1 ? 512 + 64 * hh + c : arr == 2 ? 1024 + 64 * hh + c : arr == 3 ? 1536 + 64 * d + c : 1664 + 64 * d + c;
    float sm_ = mu[col] + mu[ZRW + col];
    if (q.grid) sm_ += mu[2 * ZRW + col] + mu[3 * ZRW + col];
    c0t[e] = 1.0f - sm_;
  }
  const int cB0 = 16 * w + 4 * qq;
  float w0c[4], a0c[4], kkc[4], kac[4];
#pragma unroll
  for (int g = 0; g < 4; ++g) {
    w0c[g] = p.in[I_W0][(l * 2 + d) * 512 + 64 * hh + cB0 + g]; a0c[g] = p.in[I_A0][(l * 2 + d) * 512 + 64 * hh + cB0 + g];
    kkc[g] = p.in[I_KK][l * 512 + 64 * hh + cB0 + g]; kac[g] = p.in[I_KA][l * 512 + 64 * hh + cB0 + g];
  }
  f32x16 S;
  if (q.sample) {
    const float* st = p.in[I_SR] + ((((size_t)q.b * 2 + l) * 2 + d) * 8 + hh) * 4096;
#pragma unroll
    for (int g = 0; g < 16; ++g) S[g] = st[(32 * vb + crow(g, h)) * 64 + 32 * kb + r32];
  } else {
#pragma unroll
    for (int g = 0; g < 16; ++g) S[g] = 0.f;
  }
  __syncthreads();
  bf16x8 bW[2], bA[2];
#pragma unroll
  for (int ks = 0; ks < 2; ++ks) { bW[ks] = *(const bf16x8*)(Wb2 + (16 * w + l15) * 72 + ks * 32 + qq * 8); bA[ks] = *(const bf16x8*)(Ab2 + (16 * w + l15) * 72 + ks * 32 + qq * 8); }
  __syncthreads();
  for (int e = tid; e < (2 * 64 * 40 + 2 * 64 * 24) / 2; e += NTHR) ((unsigned*)VT0)[e] = 0u;
  for (int e = tid; e < (64 * 40) / 2; e += NTHR) ((unsigned*)VT1)[e] = 0u;
  for (int e = tid; e < (2 * 16 * 40) / 2; e += NTHR) ((unsigned*)ArkM)[e] = 0u;
  __syncthreads();
  const int nch = q.T / 16;
  bf16x8 pf[3][5];
  const int jA = (tid0 & 127) >> 3, c8A = (tid0 & 7) * 8, wh = w >> 1;
#define RW_CB(arr) ((arr) == 0 ? 64 * hh : (arr) == 1 ? 512 + 64 * hh : (arr) == 2 ? 1024 + 64 * hh : (arr) == 3 ? 1536 + 64 * d : 1664 + 64 * d)
#define RW_ISSUE(chn) { const int pos = (chn) * 16 + jA, t = d ? q.T - 1 - pos : pos; _Pragma("unroll") for (int gi = 0; gi < 3; ++gi) { if (gi < 2 || w < 2) { \
      rw_load8(ZR, q.base, t, q.T, q.grid, RW_CB(2 * gi + wh) + c8A, pf[gi]); } } }
#pragma unroll
  for (int g = 0; g < 4; ++g) asm volatile("" : "+v"(w0c[g]), "+v"(a0c[g]), "+v"(kkc[g]), "+v"(kac[g]));
  asm volatile("" : "+v"(S));
  RW_ISSUE(0)
#pragma unroll 1
  for (int ch = 0; ch < nch; ++ch) {
    tid = tid0; asm volatile("" : "+v"(tid));
    lane = tid & 63; l15 = lane & 15; qq = lane >> 4; r32 = lane & 31; h = lane >> 5;
    bf16_t* VT = (ch & 1) ? VT1 : VT0;
    {
      const int pos_ = ch * 16 + jA, t_ = d ? q.T - 1 - pos_ : pos_;
      const unsigned vd_ = rw_valid(t_, q.T, q.grid);
#pragma unroll
      for (int gi = 0; gi < 3; ++gi) {
        if (gi < 2 || w < 2) {
          const int arr = 2 * gi + wh;
          float val[8];
          rw_apply8_lds(pf[gi], mu5 + arr * 64 + c8A, c0t + arr * 64 + c8A, q.grid, vd_, val);
          if (arr < 3) {
            *(f32x4*)(shR + arr * 1024 + jA * 64 + c8A) = (f32x4){val[0], val[1], val[2], val[3]};
            *(f32x4*)(shR + arr * 1024 + jA * 64 + c8A + 4) = (f32x4){val[4], val[5], val[6], val[7]};
            if (arr == 2) {
#pragma unroll
              for (int e = 0; e < 8; ++e) VT[(c8A + e) * 40 + jA] = f2bf(val[e]);
            }
          } else if (arr == 3) {
            *(u32x4*)(actW + jA * 72 + c8A) = (u32x4){pk2(fast_tanh(val[0]), fast_tanh(val[1])), pk2(fast_tanh(val[2]), fast_tanh(val[3])), pk2(fast_tanh(val[4]), fast_tanh(val[5])), pk2(fast_tanh(val[6]), fast_tanh(val[7]))};
          } else {
            *(u32x4*)(actA + jA * 72 + c8A) = (u32x4){pk2(val[0], val[1]), pk2(val[2], val[3]), pk2(val[4], val[5]), pk2(val[6], val[7])};
          }
        }
      }
    }
    asm volatile("" ::: "memory"); __builtin_amdgcn_sched_barrier(0);
    if (ch + 1 < nch) RW_ISSUE(ch + 1)
    __syncthreads();
    {
      f32x4 aw = (f32x4){0.f, 0.f, 0.f, 0.f}, aa = (f32x4){0.f, 0.f, 0.f, 0.f};
#pragma unroll
      for (int ks = 0; ks < 2; ++ks) {
        const bf16x8 fw = *(const bf16x8*)(actW + l15 * 72 + ks * 32 + qq * 8);
        const bf16x8 fa = *(const bf16x8*)(actA + l15 * 72 + ks * 32 + qq * 8);
        aw = __builtin_amdgcn_mfma_f32_16x16x32_bf16(bW[ks], fw, aw, 0, 0, 0);
        aa = __builtin_amdgcn_mfma_f32_16x16x32_bf16(bA[ks], fa, aa, 0, 0, 0);
      }
      const f32x4 kv = *(const f32x4*)(shK + l15 * 64 + cB0), rv = *(const f32x4*)(shR + l15 * 64 + cB0);
      float lw[4], av[4], kkr[4], kd[4], Lp[4], LpL[4];
      float ssq = 0.f;
#pragma unroll
      for (int g = 0; g < 4; ++g) {
        const float wl = aw[g] + w0c[g], al = aa[g] + a0c[g];
        lw[g] = -__expf(-softplusf_(-wl) - 0.5f);
        av[g] = sigmoidf_(al);
        kkr[g] = kv[g] * kkc[g];
        kd[g] = kv[g] * (1.0f + (av[g] - 1.0f) * kac[g]);
        ssq += kkr[g] * kkr[g];
        float x = lw[g];
        x += dpp_row_shr0<1>(x); x += dpp_row_shr0<2>(x); x += dpp_row_shr0<4>(x); x += dpp_row_shr0<8>(x);
        Lp[g] = x;
      }
#pragma unroll
      for (int g = 0; g < 4; ++g) { float x = Lp[g];
        x = fminf(x, __int_as_float(__builtin_amdgcn_mov_dpp(__float_as_int(x), 0x128, 0xF, 0xF, true))); x = fminf(x, __int_as_float(__builtin_amdgcn_mov_dpp(__float_as_int(x), 0x124, 0xF, 0xF, true)));
        x = fminf(x, dpp_xor2(x)); x = fminf(x, dpp_xor1(x)); LpL[g] = x; }
      ssq += SHX(ssq, 16); ssq += SHX(ssq, 32);
      if (qq == 0) npart[w * 16 + l15] = ssq;
      float e_m1[4], e_neg[4], e_pos[4], e_end[4];
#pragma unroll
      for (int g = 0; g < 4; ++g) { e_m1[g] = __expf(Lp[g] - lw[g]); e_neg[g] = __expf(-Lp[g]); e_pos[g] = __expf(Lp[g]); e_end[g] = __expf(LpL[g] - Lp[g]); }
      *(u32x2*)(KHr + l15 * 72 + cB0) = (u32x2){pk2(kkr[0] * e_m1[0], kkr[1] * e_m1[1]), pk2(kkr[2] * e_m1[2], kkr[3] * e_m1[3])};
      *(u32x2*)(BCr + l15 * 72 + cB0) = (u32x2){pk2(kkr[0] * av[0] * e_neg[0], kkr[1] * av[1] * e_neg[1]), pk2(kkr[2] * av[2] * e_neg[2], kkr[3] * av[3] * e_neg[3])};
      *(u32x2*)(KC + l15 * 72 + cB0) = (u32x2){pk2(kd[0] * e_neg[0], kd[1] * e_neg[1]), pk2(kd[2] * e_neg[2], kd[3] * e_neg[3])};
      *(u32x2*)(RH + l15 * 72 + cB0) = (u32x2){pk2(rv[0] * e_pos[0], rv[1] * e_pos[1]), pk2(rv[2] * e_pos[2], rv[3] * e_pos[3])};
#pragma unroll
      for (int g = 0; g < 4; ++g) {
        KBT[(cB0 + g) * 24 + l15] = f2bf(kd[g] * e_end[g]);
        BBT[(cB0 + g) * 24 + l15] = f2bf(kkr[g] * av[g] * e_end[g]);
      }
      if (l15 == 15) *(f32x4*)(PL + cB0) = (f32x4){e_pos[0], e_pos[1], e_pos[2], e_pos[3]};
#pragma unroll
      for (int g = 0; g < 16; ++g) Sb[(32 * vb + crow(g, h)) * 72 + 32 * kb + r32] = f2bf(S[g]);
    }
    __syncthreads();
    f32x4 oacc = (f32x4){0.f, 0.f, 0.f, 0.f};
    {
      const bf16_t* Aop = (w < 2) ? KHr : RH;
      const bf16_t* Bop = (w == 0 || w == 3) ? BCr : KC;
      f32x4 t16 = (f32x4){0.f, 0.f, 0.f, 0.f}, g0 = (f32x4){0.f, 0.f, 0.f, 0.f};
#pragma unroll
      for (int ks = 0; ks < 2; ++ks) {
        const bf16x8 a = *(const bf16x8*)(Aop + l15 * 72 + ks * 32 + qq * 8);
        const bf16x8 b = *(const bf16x8*)(Bop + l15 * 72 + ks * 32 + qq * 8);
        t16 = __builtin_amdgcn_mfma_f32_16x16x32_bf16(a, b, t16, 0, 0, 0);
        const bf16x8 akh = *(const bf16x8*)(KHr + l15 * 72 + ks * 32 + qq * 8);
        const bf16x8 arh = *(const bf16x8*)(RH + l15 * 72 + ks * 32 + qq * 8);
        const bf16x8 bs = *(const bf16x8*)(Sb + (16 * w + l15) * 72 + ks * 32 + qq * 8);
        g0 = __builtin_amdgcn_mfma_f32_16x16x32_bf16(akh, bs, g0, 0, 0, 0);
        oacc = __builtin_amdgcn_mfma_f32_16x16x32_bf16(arh, bs, oacc, 0, 0, 0);
      }
#pragma unroll
      for (int g = 0; g < 4; ++g) G0[(4 * qq + g) * 64 + 16 * w + l15] = g0[g];
      *(f32x4*)(MN + w * 256 + l15 * 16 + 4 * qq) = t16;
    }
    __syncthreads();
    if (w == 0) {
      const float* MrT = MN; const float* NrT = MN + 256;
      f32x2 acc2[8];
#pragma unroll
      for (int pq = 0; pq < 8; ++pq) acc2[pq] = (f32x2){G0[(2 * pq) * 64 + lane], G0[(2 * pq + 1) * 64 + lane]};
      float vv[16], un[16];
#pragma unroll
      for (int j = 0; j < 16; ++j) vv[j] = shV[j * 64 + lane];
      const float n2v = __builtin_amdgcn_rcpf(fmaxf(npart[l15] + npart[16 + l15] + npart[32 + l15] + npart[48 + l15], 1e-24f));
      f32x4 nr[4], mr[4];
#pragma unroll
      for (int t4 = 0; t4 < 4; ++t4) { nr[t4] = *(const f32x4*)(NrT + 4 * t4); mr[t4] = *(const f32x4*)(MrT + 4 * t4); }
#pragma unroll
      for (int j = 0; j < 16; ++j) {
        f32x4 nrn[4], mrn[4];
#pragma unroll
        for (int t4 = 0; t4 < 4; ++t4) { nrn[t4] = (f32x4){0.f, 0.f, 0.f, 0.f}; mrn[t4] = (f32x4){0.f, 0.f, 0.f, 0.f}; }
        if (j + 1 < 16) {
#pragma unroll
          for (int t4 = 0; t4 < 4; ++t4) if (4 * t4 + 3 > j + 1) { nrn[t4] = *(const f32x4*)(NrT + (j + 1) * 16 + 4 * t4); mrn[t4] = *(const f32x4*)(MrT + (j + 1) * 16 + 4 * t4); }
        }
        const float n2s = __int_as_float(__builtin_amdgcn_readlane(__float_as_int(n2v), j));
        const float unj = -acc2[j >> 1][j & 1] * n2s;
        un[j] = unj;
        const f32x2 vv2 = (f32x2){vv[j], vv[j]}, un2 = (f32x2){unj, unj};
#pragma unroll
        for (int pq = 0; pq < 8; ++pq)
          if (2 * pq + 1 > j) acc2[pq] += (f32x2){nr[pq >> 1][2 * (pq & 1)], nr[pq >> 1][2 * (pq & 1) + 1]} * vv2 + (f32x2){mr[pq >> 1][2 * (pq & 1)], mr[pq >> 1][2 * (pq & 1) + 1]} * un2;
#pragma unroll
        for (int t4 = 0; t4 < 4; ++t4) { nr[t4] = nrn[t4]; mr[t4] = mrn[t4]; }
        __builtin_amdgcn_sched_barrier(0);
      }
      *(u32x4*)(UNT + lane * 40) = (u32x4){pk2(un[0], un[1]), pk2(un[2], un[3]), pk2(un[4], un[5]), pk2(un[6], un[7])};
      *(u32x4*)(UNT + lane * 40 + 8) = (u32x4){pk2(un[8], un[9]), pk2(un[10], un[11]), pk2(un[12], un[13]), pk2(un[14], un[15])};
    } else if (w < 3) {
      const float* src = MN + (w == 1 ? 512 : 768);
      bf16_t* dst = (w == 1) ? ArkM : ArbM;
#pragma unroll
      for (int i = 0; i < 4; ++i) { const int e = lane + 64 * i, j = e >> 4, t = e & 15; dst[t * 40 + j] = f2bf(j <= t ? src[e] : 0.f); }
    }
    __syncthreads();
    {
      const bf16x8 ak = *(const bf16x8*)(ArkM + l15 * 40 + qq * 8), ab = *(const bf16x8*)(ArbM + l15 * 40 + qq * 8);
      const bf16x8 bv = *(const bf16x8*)(VT + (16 * w + l15) * 40 + qq * 8), bu = *(const bf16x8*)(UNT + (16 * w + l15) * 40 + qq * 8);
      oacc = __builtin_amdgcn_mfma_f32_16x16x32_bf16(ak, bv, oacc, 0, 0, 0);
      oacc = __builtin_amdgcn_mfma_f32_16x16x32_bf16(ab, bu, oacc, 0, 0, 0);
#pragma unroll
      for (int g = 0; g < 4; ++g) {
        const int pos = ch * 16 + 4 * qq + g, t = d ? q.T - 1 - pos : pos;
        O[(size_t)(q.base + t) * 1024 + d * 512 + 64 * hh + 16 * w + l15] = f2bf(oacc[g]);
      }
      const float pl = PL[32 * kb + r32];
#pragma unroll
      for (int g = 0; g < 16; ++g) S[g] *= pl;
      const bf16x8 av_ = *(const bf16x8*)(VT + (32 * vb + r32) * 40 + 8 * h), au_ = *(const bf16x8*)(UNT + (32 * vb + r32) * 40 + 8 * h);
      const bf16x8 bk_ = *(const bf16x8*)(KBT + (32 * kb + r32) * 24 + 8 * h), bb_ = *(const bf16x8*)(BBT + (32 * kb + r32) * 24 + 8 * h);
      S = __builtin_amdgcn_mfma_f32_32x32x16_bf16(av_, bk_, S, 0, 0, 0);
      S = __builtin_amdgcn_mfma_f32_32x32x16_bf16(au_, bb_, S, 0, 0, 0);
    }
  }
  if (!q.sample) {
    float* dst = p.out + OUT_RW + ((((size_t)q.b * 2 + l) * 2 + d) * 8 + hh) * 4096;
#pragma unroll
    for (int g = 0; g < 16; ++g) dst[(32 * vb + crow(g, h)) * 64 + 32 * kb + r32] = S[g];
  }
}

DI void hgrn_item(const Params& p, int l, int s, int hh, int d, char* smem) {
  const Seq q = get_seq(s);
  const int tid = ltid(), lane = tid & 63, w = tid >> 6, r = lane & 31, h = lane >> 5;
  bf16_t* ZH = (bf16_t*)(p.ws + OFF_ZH);
  bf16_t* Qt = (bf16_t*)smem;
  bf16_t* Kt = Qt + 32 * 136;
  bf16_t* KhT = Kt + 32 * 136;
  bf16_t* VT = KhT + 128 * 40;
  bf16_t* Sb = VT + 128 * 40;
  bf16_t* At = Sb + 4 * 32 * 136;
  float* dL = (float*)(At + 32 * 40);
  float* tot = dL + 128;
  const float lb = ((const float*)(p.ws + OFF_LBS))[l * 512 + 128 * hh + (tid & 127)];
  f32x16 S[4];
  if (q.sample) {
    const float* st = p.in[I_SH] + ((((size_t)q.b * 2 + l) * 2 + d) * 4 + hh) * 16384;
#pragma unroll
    for (int kb = 0; kb < 4; ++kb)
#pragma unroll
      for (int g = 0; g < 16; ++g) S[kb][g] = st[(size_t)(32 * kb + crow(g, h)) * 128 + 32 * w + r];
  } else {
#pragma unroll
    for (int kb = 0; kb < 4; ++kb)
#pragma unroll
      for (int g = 0; g < 16; ++g) S[kb][g] = 0.f;
  }
  const int k = tid & 127, half = tid >> 7;
  const int nch = q.T / 32;
  u16x2 pzq[16], pv2[8];
#define HG_ISSUE(chn) { _Pragma("unroll") for (int jj = 0; jj < 16; ++jj) { const int pos = (chn) * 32 + half * 16 + jj, t = d ? q.T - 1 - pos : pos; \
      const size_t rowo = (size_t)(q.base + t) * ZHW + 128 * hh + k; pzq[jj][0] = ZH[rowo + 512 * (1 + d)]; pzq[jj][1] = ZH[rowo]; pv2[jj >> 1][jj & 1] = ZH[rowo + 1536]; } }
  { float lb_ = lb; asm volatile("" : "+v"(lb_)); (void)lb_; }
#pragma unroll
  for (int kb = 0; kb < 4; ++kb) asm volatile("" : "+v"(S[kb]));
  HG_ISSUE(0)
#pragma unroll 1
  for (int ch = 0; ch < nch; ++ch) {
    __syncthreads();
    float bl[16], kc[16], qs[16];
    {
      float b = 0.f;
#pragma unroll
      for (int jj = 0; jj < 16; ++jj) {
        const float z = bf2f(pzq[jj][0]);
        const float kcoef = (1.0f - lb) * sigmoidf_(-z);
        const float f = 1.0f - kcoef;
        b += fmaxf(__logf(f), -80.f);
        bl[jj] = b; kc[jj] = kcoef; qs[jj] = bf2f(pzq[jj][1]) * 0.08838834764831845f;
      }
      *(u32x4*)(VT + k * 40 + half * 16) = (u32x4){__builtin_bit_cast(unsigned, pv2[0]), __builtin_bit_cast(unsigned, pv2[1]), __builtin_bit_cast(unsigned, pv2[2]), __builtin_bit_cast(unsigned, pv2[3])};
      *(u32x4*)(VT + k * 40 + half * 16 + 8) = (u32x4){__builtin_bit_cast(unsigned, pv2[4]), __builtin_bit_cast(unsigned, pv2[5]), __builtin_bit_cast(unsigned, pv2[6]), __builtin_bit_cast(unsigned, pv2[7])};
      tot[half * 128 + k] = b;
    }
    if (ch + 1 < nch) HG_ISSUE(ch + 1)
    __syncthreads();
    {
      const float off = half ? tot[k] : 0.f;
      const float bL = fmaxf(tot[k] + tot[128 + k], -80.f);
      if (half == 0) dL[k] = __expf(bL);
      float kh[16];
#pragma unroll
      for (int jj = 0; jj < 16; ++jj) {
        const int j = half * 16 + jj;
        const float bj = fmaxf(off + bl[jj], -80.f);
        Qt[j * 136 + k] = f2bf(qs[jj] * __expf(bj));
        Kt[j * 136 + k] = f2bf(kc[jj] * __expf(-bj));
        kh[jj] = kc[jj] * __expf(fminf(bL - bj, 0.f));
      }
      *(u32x4*)(KhT + k * 40 + half * 16) = (u32x4){pk2(kh[0], kh[1]), pk2(kh[2], kh[3]), pk2(kh[4], kh[5]), pk2(kh[6], kh[7])};
      *(u32x4*)(KhT + k * 40 + half * 16 + 8) = (u32x4){pk2(kh[8], kh[9]), pk2(kh[10], kh[11]), pk2(kh[12], kh[13]), pk2(kh[14], kh[15])};
    }
    bf16_t* Sbw = Sb + w * 32 * 136;
#pragma unroll
    for (int kb = 0; kb < 4; ++kb)
#pragma unroll
      for (int g4 = 0; g4 < 4; ++g4) *(u32x2*)(Sbw + r * 136 + 32 * kb + crow(4 * g4, h)) = (u32x2){pk2(S[kb][4 * g4], S[kb][4 * g4 + 1]), pk2(S[kb][4 * g4 + 2], S[kb][4 * g4 + 3])};
    __syncthreads();
    bf16_t* Atw = At;
    {
      f32x16 A;
#pragma unroll
      for (int g = 0; g < 16; ++g) A[g] = 0.f;
      mma32(A, Qt, 136, Kt, 136, 128, lane);
#pragma unroll
      for (int g = 0; g < 16; ++g) { const int t = crow(g, h); Atw[t * 40 + r] = f2bf(r <= t ? A[g] : 0.f); }
    }
    __syncthreads();
    {
      f32x16 o;
#pragma unroll
      for (int g = 0; g < 16; ++g) o[g] = 0.f;
      mma32(o, Atw, 40, VT + 32 * w * 40, 40, 32, lane);
      mma32(o, Qt, 136, Sbw, 136, 128, lane);
#pragma unroll
      for (int g = 0; g < 16; ++g) {
        const int j = crow(g, h), pos = ch * 32 + j, t = d ? q.T - 1 - pos : pos;
        ZH[(size_t)(q.base + t) * ZHW + 512 * (1 + d) + 128 * hh + 32 * w + r] = f2bf(o[g]);
      }
#pragma unroll
      for (int kb = 0; kb < 4; ++kb) {
#pragma unroll
        for (int g = 0; g < 16; ++g) S[kb][g] *= dL[32 * kb + crow(g, h)];
        mma32(S[kb], KhT + 32 * kb * 40, 40, VT + 32 * w * 40, 40, 32, lane);
      }
    }
  }
  if (!q.sample) {
    float* dst = p.out + OUT_HG + ((((size_t)q.b * 2 + l) * 2 + d) * 4 + hh) * 16384;
#pragma unroll
    for (int kb = 0; kb < 4; ++kb)
#pragma unroll
      for (int g = 0; g < 16; ++g) dst[(size_t)(32 * kb + crow(g, h)) * 128 + 32 * w + r] = S[kb][g];
  }
}

DI void mlstm_item(const Params& p, int l, int s, int hh, int d, char* smem) {
  const Seq q = get_seq(s);
  const int tid = ltid(), lane = tid & 63, w = tid >> 6, r = lane & 31, h = lane >> 5;
  const bf16_t* ZM = (const bf16_t*)(p.ws + OFF_ZM);
  const float* MG = (const float*)(p.ws + OFF_MG);
  bf16_t* Hb = (bf16_t*)(p.ws + OFF_H);
  bf16_t* Qm = (bf16_t*)smem;
  bf16_t* Km = Qm + 32 * 136;
  bf16_t* KwT = Km + 32 * 136;
  bf16_t* VT = KwT + 128 * 40;
  bf16_t* Cb = VT + 128 * 40;
  bf16_t* Pt = Cb + 4 * 32 * 136;
  float* nv = (float*)(Pt + 32 * 40);
  float* sc = nv + 128;
  float* ig = sc; float* lf = sc + 32; float* gg = sc + 64; float* mtv = sc + 96; float* wi = sc + 128; float* wsr = sc + 160; float* qn = sc + 192; float* misc = sc + 224;
  float* dnw = sc + 232;
  const float gbi = p.in[I_GB][l * 16 + (2 * d) * 4 + hh], gbf = p.in[I_GB][l * 16 + (2 * d + 1) * 4 + hh];
  f32x16 C[4];
  float m;
  __syncthreads();
  if (q.sample) {
    const size_t sb = (((size_t)q.b * 2 + l) * 2 + d) * 4 + hh;
    const float* st = p.in[I_SC] + sb * 16384;
#pragma unroll
    for (int kb = 0; kb < 4; ++kb)
#pragma unroll
      for (int g = 0; g < 16; ++g) C[kb][g] = st[(size_t)(32 * kb + crow(g, h)) * 128 + 32 * w + r];
    if (tid < 128) nv[tid] = p.in[I_SN][sb * 128 + tid];
    m = p.in[I_SM][sb];
  } else {
#pragma unroll
    for (int kb = 0; kb < 4; ++kb)
#pragma unroll
      for (int g = 0; g < 16; ++g) C[kb][g] = 0.f;
    if (tid < 128) nv[tid] = 0.f;
    m = 0.f;
  }
  const int nch = q.T / 32;
  const int dd = tid & 127, half = tid >> 7;
  u16x2 pqk[16], pv2[8]; float pgi = 0.f, pgf = 0.f;
#define ML_ISSUE(chn) { _Pragma("unroll") for (int jj = 0; jj < 16; ++jj) { const int pos = (chn) * 32 + half * 16 + jj, t = d ? q.T - 1 - pos : pos; \
      const size_t rowo = (size_t)(q.base + t) * ZMW + 128 * hh + dd; pqk[jj][0] = ZM[rowo]; pqk[jj][1] = ZM[rowo + 512]; pv2[jj >> 1][jj & 1] = ZM[rowo + 1024]; } \
    if (tid < 32) { const int pos = (chn) * 32 + tid, t = d ? q.T - 1 - pos : pos; const float* mg = MG + (size_t)(q.base + t) * 16; pgi = mg[(2 * d) * 4 + hh]; pgf = mg[(2 * d + 1) * 4 + hh]; } }
#pragma unroll
  for (int kb = 0; kb < 4; ++kb) asm volatile("" : "+v"(C[kb]));
  asm volatile("" : "+v"(m));
  ML_ISSUE(0)
#pragma unroll 1
  for (int ch = 0; ch < nch; ++ch) {
    __syncthreads();
    {
#pragma unroll
      for (int jj = 0; jj < 16; ++jj) {
        const int j = half * 16 + jj;
        Qm[j * 136 + dd] = pqk[jj][0];
        Km[j * 136 + dd] = f2bf(bf2f(pqk[jj][1]) * 0.08838834764831845f);
      }
      *(u32x4*)(VT + dd * 40 + half * 16) = (u32x4){__builtin_bit_cast(unsigned, pv2[0]), __builtin_bit_cast(unsigned, pv2[1]), __builtin_bit_cast(unsigned, pv2[2]), __builtin_bit_cast(unsigned, pv2[3])};
      *(u32x4*)(VT + dd * 40 + half * 16 + 8) = (u32x4){__builtin_bit_cast(unsigned, pv2[4]), __builtin_bit_cast(unsigned, pv2[5]), __builtin_bit_cast(unsigned, pv2[6]), __builtin_bit_cast(unsigned, pv2[7])};
      if (tid < 32) {
        const float igv = pgi + gbi;
        const float lfv = -softplusf_(-(pgf + gbf));
        float g = lfv;
#pragma unroll
        for (int o = 1; o < 32; o <<= 1) { const float tt = shfl_lane(g, (lane - o) & 63); if (tid >= o) g += tt; }
        const float cs = igv - g;
        float pm = cs;
#pragma unroll
        for (int o = 1; o < 32; o <<= 1) { const float tt = shfl_lane(pm, (lane - o) & 63); if (tid >= o) pm = fmaxf(pm, tt); }
        const float mt = g + fmaxf(m, pm);
        const float gend = shfl_lane(g, 31), mn = shfl_lane(mt, 31);
        ig[tid] = igv; gg[tid] = g; mtv[tid] = mt; wi[tid] = __expf(g + m - mt);
        wsr[tid] = __expf(gend + cs - mn);
        if (tid == 0) { misc[0] = mn; misc[1] = __expf(gend + m - mn); }
      }
    }
    if (ch + 1 < nch) ML_ISSUE(ch + 1)
    __syncthreads();
    {
      {
        float kw[16];
#pragma unroll
        for (int jj = 0; jj < 16; ++jj) { const int j = half * 16 + jj; kw[jj] = bf2f(Km[j * 136 + dd]) * wsr[j]; }
        *(u32x4*)(KwT + dd * 40 + half * 16) = (u32x4){pk2(kw[0], kw[1]), pk2(kw[2], kw[3]), pk2(kw[4], kw[5]), pk2(kw[6], kw[7])};
        *(u32x4*)(KwT + dd * 40 + half * 16 + 8) = (u32x4){pk2(kw[8], kw[9]), pk2(kw[10], kw[11]), pk2(kw[12], kw[13]), pk2(kw[14], kw[15])};
      }
      const int j = tid >> 3, seg = tid & 7;
      float a = 0.f;
#pragma unroll
      for (int i = 0; i < 16; ++i) a += bf2f(Qm[j * 136 + seg * 16 + i]) * nv[seg * 16 + i];
      a += SHX(a, 1); a += SHX(a, 2); a += SHX(a, 4);
      if (seg == 0) qn[j] = a;
    }
    const float m_new = misc[0], carry = misc[1];
    bf16_t* Cbw = Cb + w * 32 * 136; bf16_t* Ptw = Pt;
#pragma unroll
    for (int kb = 0; kb < 4; ++kb)
#pragma unroll
      for (int g4 = 0; g4 < 4; ++g4) *(u32x2*)(Cbw + r * 136 + 32 * kb + crow(4 * g4, h)) = (u32x2){pk2(C[kb][4 * g4], C[kb][4 * g4 + 1]), pk2(C[kb][4 * g4 + 2], C[kb][4 * g4 + 3])};
    {
      f32x16 Sc;
#pragma unroll
      for (int g = 0; g < 16; ++g) Sc[g] = 0.f;
      mma32(Sc, Qm, 136, Km, 136, 128, lane);
      const float gs = gg[r], is = ig[r];
#pragma unroll
      for (int g = 0; g < 16; ++g) {
        const int t = crow(g, h);
        const float pv = (r <= t) ? __expf(gg[t] - gs + is - mtv[t]) * Sc[g] : 0.f;
        Ptw[t * 40 + r] = f2bf(pv);
      }
    }
    __syncthreads();
    if (lane < 32) {
      float a = 0.f;
#pragma unroll 4
      for (int i = 0; i < 32; ++i) a += bf2f(Ptw[lane * 40 + i]);
      const float den = wi[lane] * qn[lane] + a;
      dnw[lane] = 1.0f / fmaxf(fabsf(den), __expf(-mtv[lane]));
    }
    if (tid < 128) {
      float a = 0.f;
#pragma unroll 4
      for (int i = 0; i < 32; ++i) a += bf2f(KwT[tid * 40 + i]);
      nv[tid] = carry * nv[tid] + a;
    }
    __syncthreads();
    {
      f32x16 a1;
#pragma unroll
      for (int g = 0; g < 16; ++g) a1[g] = 0.f;
      mma32(a1, Qm, 136, Cbw, 136, 128, lane);
#pragma unroll
      for (int g = 0; g < 16; ++g) a1[g] *= wi[crow(g, h)];
      mma32(a1, Ptw, 40, VT + 32 * w * 40, 40, 32, lane);
#pragma unroll
      for (int g = 0; g < 16; ++g) {
        const int j = crow(g, h), pos = ch * 32 + j, t = d ? q.T - 1 - pos : pos;
        const float hv = a1[g] * dnw[j];
        Hb[(size_t)(q.base + t) * 1024 + d * 512 + 128 * hh + 32 * w + r] = f2bf(hv);
      }
#pragma unroll
      for (int kb = 0; kb < 4; ++kb) {
#pragma unroll
        for (int g = 0; g < 16; ++g) C[kb][g] *= carry;
        mma32(C[kb], KwT + 32 * kb * 40, 40, VT + 32 * w * 40, 40, 32, lane);
      }
    }
    m = m_new;
  }
  __syncthreads();
  if (!q.sample) {
    const size_t sb = (((size_t)q.b * 2 + l) * 2 + d) * 4 + hh;
    float* dst = p.out + OUT_C + sb * 16384;
#pragma unroll
    for (int kb = 0; kb < 4; ++kb)
#pragma unroll
      for (int g = 0; g < 16; ++g) dst[(size_t)(32 * kb + crow(g, h)) * 128 + 32 * w + r] = C[kb][g];
    if (tid < 128) p.out[OUT_N + sb * 128 + tid] = nv[tid];
    if (tid == 0) p.out[OUT_M + sb] = m;
  }
}

DI void phase_scan(const Params& p, int l, char* smem) {
  int* ctrL = (int*)(p.ws + OFF_CTR) + 2 * l;
  int* ctrS = ctrL + 1;
  int* sit = (int*)(smem + LDS_BYTES - 16);
  const int role = p.role;
  bool longDone = false, shortDone = false;
  for (;;) {
    const bool wantLong = (role == 0) ? !longDone : shortDone;
    if (longDone && shortDone) break;
    __syncthreads();
    if (ltid() == 0) *sit = atomicAdd(wantLong ? ctrL : ctrS, 1);
    __syncthreads();
    int it = __builtin_amdgcn_readfirstlane(*sit);
    int ty, s_, hh_, d_, rb_ = 0;
    if (wantLong) {
      if (it >= 128) { longDone = true; continue; }
      if (it < 64) { ty = 0; d_ = it & 1; hh_ = (it >> 1) & 7; s_ = 32 + (it >> 4); }
      else if (it < 96) { it -= 64; ty = 1; s_ = 32 + (it >> 3); hh_ = (it >> 1) & 3; d_ = it & 1; }
      else { it -= 96; ty = 2; s_ = 32 + (it >> 3); hh_ = (it >> 1) & 3; d_ = it & 1; }
    } else {
      if (it >= 1024) { shortDone = true; continue; }
      if (it < 512) { ty = 0; s_ = it >> 4; hh_ = (it >> 1) & 7; d_ = it & 1; }
      else if (it < 768) { it -= 512; ty = 1; s_ = it >> 3; hh_ = (it >> 1) & 3; d_ = it & 1; }
      else { it -= 768; ty = 2; s_ = it >> 3; hh_ = (it >> 1) & 3; d_ = it & 1; }
    }
    if (ty == 0) rwkv_item(p, l, s_, hh_, d_, smem);
    else if (ty == 1) hgrn_item(p, l, s_, hh_, d_, smem);
    else mlstm_item(p, l, s_, hh_, d_, smem);
  }
}

DI void phase_combine(const Params& p, int l, char* smem) {
  const int tid = ltid(), lane = tid & 63, w = tid >> 6;
  bf16_t* ZH = (bf16_t*)(p.ws + OFF_ZH); bf16_t* ZM = (bf16_t*)(p.ws + OFF_ZM); const bf16_t* ZR = (const bf16_t*)(p.ws + OFF_ZR);
  bf16_t* O = (bf16_t*)(p.ws + OFF_O); const bf16_t* Hb = (const bf16_t*)(p.ws + OFF_H);
  const float* mu = p.in[I_MU] + (size_t)l * 4 * ZRW;
  const float* g2 = p.in[I_G2] + (size_t)l * 128 * 512;
  float* sg = (float*)smem;
  float* gt = sg + 128 * 16;
  for (int blk = blockIdx.x; blk < NT / 16; blk += gridDim.x) {
    const int tok0 = blk * 16;
    int sidx, t0;
    if (tok0 < 8192) { sidx = tok0 >> 8; t0 = tok0 & 255; } else { sidx = 32 + ((tok0 - 8192) >> 11); t0 = (tok0 - 8192) & 2047; }
    const Seq q = get_seq(sidx);
    __syncthreads();
    { const int j = tid >> 4, rr0 = (tid & 15) * 8; float val[8]; bf16x8 pv[5]; rw_load8(ZR, q.base, t0 + j, q.T, q.grid, 1792 + rr0, pv); rw_apply8(pv, mu, q.grid, rw_valid(t0 + j, q.T, q.grid), 1792 + rr0, val);
#pragma unroll
      for (int e = 0; e < 8; ++e) sg[(rr0 + e) * 16 + j] = sigmoidf_(val[e]); }
    __syncthreads();
    {
      float a0[16], a1[16];
#pragma unroll
      for (int j = 0; j < 16; ++j) { a0[j] = 0.f; a1[j] = 0.f; }
#pragma unroll 1
      for (int r0 = 0; r0 < 128; r0 += 8) {
        float w0v[8], w1v[8];
#pragma unroll
        for (int q8 = 0; q8 < 8; ++q8) { w0v[q8] = g2[(r0 + q8) * 512 + tid]; w1v[q8] = g2[(r0 + q8) * 512 + 256 + tid]; }
#pragma unroll
        for (int q8 = 0; q8 < 8; ++q8) {
          const int rr = r0 + q8; const float w0 = w0v[q8], w1 = w1v[q8];
#pragma unroll
          for (int u = 0; u < 4; ++u) {
            f32x4 sv = *(const f32x4*)(sg + rr * 16 + 4 * u);
#pragma unroll
            for (int e = 0; e < 4; ++e) { a0[4 * u + e] += sv[e] * w0; a1[4 * u + e] += sv[e] * w1; }
          }
        }
      }
#pragma unroll
      for (int j = 0; j < 16; ++j) { gt[j * 512 + tid] = a0[j]; gt[j * 512 + 256 + tid] = a1[j]; }
    }
    __syncthreads();
#pragma unroll 1
    for (int jj = 0; jj < 4; ++jj) {
      const int j = w * 4 + jj, tok = tok0 + j, t = t0 + j; int c0 = lane * 8; asm volatile("" : "+v"(c0));
      {
        float o[8], rs[8], ks[8], vs[8];
        float sum = 0.f, bon = 0.f;
        {
          bf16x8 pr_[5], pk_[5], pv_[5];
          rw_load8(ZR, q.base, t, q.T, q.grid, c0, pr_); rw_load8(ZR, q.base, t, q.T, q.grid, 512 + c0, pk_); rw_load8(ZR, q.base, t, q.T, q.grid, 1024 + c0, pv_);
          const unsigned vd_ = rw_valid(t, q.T, q.grid);
          rw_apply8(pr_, mu, q.grid, vd_, c0, rs); rw_apply8(pk_, mu, q.grid, vd_, 512 + c0, ks); rw_apply8(pv_, mu, q.grid, vd_, 1024 + c0, vs);
        }
        const bf16x8 of = *(const bf16x8*)(O + (size_t)tok * 1024 + c0), ob = *(const bf16x8*)(O + (size_t)tok * 1024 + 512 + c0);
        const f32x4 rk0 = *(const f32x4*)(p.in[I_RK] + l * 512 + c0), rk1 = *(const f32x4*)(p.in[I_RK] + l * 512 + c0 + 4);
#pragma unroll
        for (int e = 0; e < 8; ++e) {
          o[e] = bf2f((bf16_t)of[e]) + bf2f((bf16_t)ob[e]);
          sum += o[e];
          bon += rs[e] * ks[e] * (e < 4 ? rk0[e & 3] : rk1[e & 3]);
        }
        sum += SHX(sum, 1); sum += SHX(sum, 2); sum += SHX(sum, 4);
        bon += SHX(bon, 1); bon += SHX(bon, 2); bon += SHX(bon, 4);
        const float mean = sum * (1.0f / 64.f);
        float var = 0.f;
#pragma unroll
        for (int e = 0; e < 8; ++e) { const float dv = o[e] - mean; var += dv * dv; }
        var += SHX(var, 1); var += SHX(var, 2); var += SHX(var, 4);
        const float rstd = rsqrtf(var * (1.0f / 64.f) + 64e-5f);
        const f32x4 lw0 = *(const f32x4*)(p.in[I_LN] + (l * 2 + 0) * 512 + c0), lw1 = *(const f32x4*)(p.in[I_LN] + (l * 2 + 0) * 512 + c0 + 4);
        const f32x4 lb0 = *(const f32x4*)(p.in[I_LN] + (l * 2 + 1) * 512 + c0), lb1 = *(const f32x4*)(p.in[I_LN] + (l * 2 + 1) * 512 + c0 + 4);
        const f32x4 gt0 = *(const f32x4*)(gt + j * 512 + c0), gt1 = *(const f32x4*)(gt + j * 512 + c0 + 4);
        bf16x8 ov;
#pragma unroll
        for (int e = 0; e < 8; ++e) {
          const float ln = (o[e] - mean) * rstd * (e < 4 ? lw0[e & 3] : lw1[e & 3]) + (e < 4 ? lb0[e & 3] : lb1[e & 3]);
          ov[e] = (short)f2bf((ln + bon * vs[e]) * (e < 4 ? gt0[e & 3] : gt1[e & 3]));
        }
        *(bf16x8*)(O + (size_t)tok * 1024 + c0) = ov;
      }
      {
        float o[8]; float ss = 0.f;
        bf16_t* zr_ = ZH + (size_t)tok * ZHW + c0;
        const bf16x8 of = *(const bf16x8*)(zr_ + 512), ob = *(const bf16x8*)(zr_ + 1024), hgv = *(const bf16x8*)(zr_ + 2048);
        const f32x4 nw0 = *(const f32x4*)(p.in[I_HNORM] + l * 512 + c0), nw1 = *(const f32x4*)(p.in[I_HNORM] + l * 512 + c0 + 4);
#pragma unroll
        for (int e = 0; e < 8; ++e) { o[e] = bf2f((bf16_t)of[e]) + bf2f((bf16_t)ob[e]); ss += o[e] * o[e]; }
        ss += SHX(ss, 1); ss += SHX(ss, 2); ss += SHX(ss, 4); ss += SHX(ss, 8);
        const float rsd = rsqrtf(ss * (1.0f / 128.f) + 1e-6f);
        bf16x8 ov;
#pragma unroll
        for (int e = 0; e < 8; ++e) ov[e] = (short)f2bf(o[e] * rsd * (e < 4 ? nw0[e & 3] : nw1[e & 3]) * siluf_(bf2f((bf16_t)hgv[e])));
        *(bf16x8*)(zr_ + 2048) = ov;
      }
      {
        float o[8]; float ss = 0.f;
        bf16_t* zm_ = ZM + (size_t)tok * ZMW + 1536 + c0;
        const bf16x8 of = *(const bf16x8*)(Hb + (size_t)tok * 1024 + c0), ob = *(const bf16x8*)(Hb + (size_t)tok * 1024 + 512 + c0), mov = *(const bf16x8*)zm_;
        const f32x4 nw0 = *(const f32x4*)(p.in[I_MNORM] + l * 512 + c0), nw1 = *(const f32x4*)(p.in[I_MNORM] + l * 512 + c0 + 4);
#pragma unroll
        for (int e = 0; e < 8; ++e) { o[e] = bf2f((bf16_t)of[e]) + bf2f((bf16_t)ob[e]); ss += o[e] * o[e]; }
        ss += SHX(ss, 1); ss += SHX(ss, 2); ss += SHX(ss, 4); ss += SHX(ss, 8);
        const float rsd = rsqrtf(ss * (1.0f / 128.f) + 1e-6f);
        bf16x8 ov;
#pragma unroll
        for (int e = 0; e < 8; ++e) ov[e] = (short)f2bf(o[e] * rsd * (e < 4 ? nw0[e & 3] : nw1[e & 3]) * sigmoidf_(bf2f((bf16_t)mov[e])));
        *(bf16x8*)zm_ = ov;
      }
    }
    __syncthreads();
#pragma unroll 1
    for (int jj = 0; jj < 4; ++jj) tok_one(p, l, 3, tok0 + w * 4 + jj, lane);
  }
}

#define XB_TMO      128
#define XB_XCNT(j)  (256  + 64 * (j))
#define XB_XSUB(j)  (1280 + 64 * (j))
#define XB_XGEN(j)  (2304 + 64 * (j))
#define XB_TOP      3328
#define XB_TOPGEN   3392
#define XCD_BAR_WORDS 3456
#define XB_SPIN_CAP (1u << 20)
#define LAS __attribute__((address_space(3)))
DI unsigned xb_ld(unsigned* p)              { return __hip_atomic_load(p, __ATOMIC_RELAXED, __HIP_MEMORY_SCOPE_AGENT); }
DI unsigned xb_add(unsigned* p, unsigned v) { return __hip_atomic_fetch_add(p, v, __ATOMIC_RELAXED, __HIP_MEMORY_SCOPE_AGENT); }
DI unsigned xb_xcc_id() { return (unsigned)__builtin_amdgcn_s_getreg((3 << 11) | 20) & 0xFu; }
#define XB_SPIN(cond, bar) do { unsigned _sp = 0; while (cond) { __builtin_amdgcn_s_sleep(1); \
    if ((++_sp & 255u) == 0u) { if (xb_ld(&(bar)[XB_TMO])) break; if (_sp > XB_SPIN_CAP) { atomicAdd(&(bar)[XB_TMO], 1u); break; } } } } while (0)
struct XcdBarrier { unsigned* bar; unsigned x; volatile LAS unsigned* st; };
DI XcdBarrier xcd_barrier_post(const Params& p, unsigned* bar, volatile LAS unsigned* st) {
  XcdBarrier b; b.bar = bar; b.x = xb_xcc_id(); b.st = st;
  if (ltid() == 0) (void)xb_add(&bar[XB_XCNT(b.x)], 1u);
  return b;
}
DI void xcd_barrier_complete(unsigned* bar, unsigned x, unsigned& nloc, unsigned& nx) {
  const unsigned G = gridDim.x * gridDim.y * gridDim.z;
  unsigned sum, cnt, mine, sp = 0u;
  for (;;) {
    sum = 0u; cnt = 0u; mine = 0u;
#pragma unroll
    for (unsigned j = 0; j < 16; ++j) { const unsigned c = xb_ld(&bar[XB_XCNT(j)]); sum += c; cnt += (c > 0u) ? 1u : 0u; mine = (j == x) ? c : mine; }
    if (sum == G) break;
    __builtin_amdgcn_s_sleep(1);
    if ((++sp & 255u) == 0u) { if (xb_ld(&bar[XB_TMO])) break; if (sp > XB_SPIN_CAP) { atomicAdd(&bar[XB_TMO], 1u); break; } }
  }
  nloc = mine > 0u ? mine : 1u; nx = cnt > 0u ? cnt : 1u;
}
DI void xcd_barrier(const Params& p, const XcdBarrier& b) {
  asm volatile("s_waitcnt vmcnt(0)" ::: "memory");
  __syncthreads();
  if (ltid() == 0) {
    unsigned* bar = b.bar;
    __builtin_amdgcn_s_waitcnt(0);
    unsigned nloc = b.st[0], nx = b.st[1];
    if (nloc == 0u) { xcd_barrier_complete(bar, b.x, nloc, nx); b.st[0] = nloc; b.st[1] = nx; }
    const unsigned old = xb_add(&bar[XB_XSUB(b.x)], 1u);
    const unsigned gen = old / nloc;
    if (old + 1u == (gen + 1u) * nloc) {
      __builtin_amdgcn_fence(__ATOMIC_RELEASE, "agent");
      asm volatile("s_waitcnt vmcnt(0)" ::: "memory");
      const unsigned og = xb_add(&bar[XB_TOP], 1u);
      const unsigned tg = og / nx;
      if (og + 1u == (tg + 1u) * nx) xb_add(&bar[XB_TOPGEN], 1u);
      else XB_SPIN(xb_ld(&bar[XB_TOPGEN]) == tg, bar);
      __builtin_amdgcn_fence(__ATOMIC_ACQUIRE, "agent");
      xb_add(&bar[XB_XGEN(b.x)], 1u);
      asm volatile("s_waitcnt vmcnt(0)" ::: "memory");
    } else {
      XB_SPIN(xb_ld(&bar[XB_XGEN(b.x)]) == gen, bar);
      __builtin_amdgcn_fence(__ATOMIC_ACQUIRE, "agent");
      asm volatile("s_waitcnt vmcnt(0)" ::: "memory");
    }
  }
  __syncthreads();
}

constexpr int NPHASE = 3 + 9 * 2;
DI void run_phase(const Params& p0, int ph, char* smem) {
  Params p = p0;
  asm volatile("" : "+s"(p.ws), "+s"(p.out));
  p.ws = as_global(p.ws); p.out = as_global(p.out);
  if (ph == 0) { phase0(p, smem); return; }
  if (ph == 1) { phase1(p); return; }
  if (ph == 2) { tok_phase(p, 0, 0); return; }
  const int l = (ph - 3) / 9, s = (ph - 3) % 9;
  switch (s) {
    case 0: phase_inproj(p, smem); break;
    case 1: phase_scan(p, l, smem); break;
    case 2: phase_combine(p, l, smem); break;
    case 3: phase_merge(p, l, smem); break;
    case 4: phase_gemm_f32(p, (const bf16_t*)(p.ws + OFF_MERGED), 1024, (const bf16_t*)(p.ws + OFF_WTOUT), smem); break;
    case 5: tok_phase(p, l, 1); break;
    case 6: phase_ffn_in(p, smem); break;
    case 7: phase_gemm_f32(p, (const bf16_t*)(p.ws + OFF_ACT), DFF, (const bf16_t*)(p.ws + OFF_WTFO), smem); break;
    case 8:
      tok_phase(p, l, 2);
      if (l + 1 < 2) {
        conv_weight(p, p.in[I_WIN] + (size_t)(l + 1) * 1024 * DIN, DIN, (bf16_t*)(p.ws + OFF_WTIN), 1024, WTIN_ROWS, 0, (float*)smem, blockIdx.x, gridDim.x);
        for (int br = 0; br < 3; ++br) conv_weight(p, p.in[I_WBR] + ((size_t)(l + 1) * 3 + br) * 512 * 1024, 1024, (bf16_t*)(p.ws + OFF_WTBR) + (size_t)br * 1024 * 512, 512, 1024, 1, (float*)smem, blockIdx.x, gridDim.x);
      }
      break;
  }
}

template <bool COOP>
__global__ void __launch_bounds__(NTHR, 2) mega(Params pk, int lo, int hi) {
  __shared__ __attribute__((aligned(16))) char smem[LDS_BYTES];
  Params p = pk;
#pragma unroll
  for (int i = 0; i < N_IN; ++i) p.in[i] = as_global(p.in[i]);
  p.ws = as_global(p.ws); p.out = as_global(p.out);
  p.wb = __builtin_amdgcn_readfirstlane((int)threadIdx.x) & ~63;
  if (COOP) {
    volatile LAS unsigned* st = (volatile LAS unsigned*)(smem + LDS_BYTES - 32);
    if (ltid() == 0) { st[0] = 0u; st[1] = 0u; }
    __syncthreads();
    phase0(p, smem);
    cg::this_grid().sync();
    XcdBarrier b = xcd_barrier_post(p, (unsigned*)(p.ws + OFF_BAR), st);
    if (ltid() == 0) {
      const unsigned hwid = (unsigned)__builtin_amdgcn_s_getreg((31 << 11) | 4);
      const unsigned key = (xb_xcc_id() << 8) | ((hwid >> 8) & 0xFFu);
      ((int*)smem)[(LDS_BYTES - 12) / 4] = (int)xb_add((unsigned*)(p.ws + OFF_ROLE) + key, 1u);
    }
    __syncthreads();
    p.role = __builtin_amdgcn_readfirstlane(((int*)smem)[(LDS_BYTES - 12) / 4]);
    for (int ph = 1; ph < hi; ++ph) {
      run_phase(p, ph, smem);
      if (ph + 1 < hi) xcd_barrier(p, b);
    }
  } else {
    for (int ph = lo; ph < hi; ++ph) run_phase(p, ph, smem);
  }
}

extern "C" void kernel_launch(void* const* d_in, const int* in_sizes, int n_in, void* d_out, int out_size, void* d_ws, size_t ws_size, hipStream_t stream) {
  Params p{};
  for (int i = 0; i < N_IN; ++i) p.in[i] = (const float*)d_in[i];
  p.out = (float*)d_out; p.ws = (char*)d_ws;
  if (ws_size < WS_NEED) fprintf(stderr, "workspace too small: %zu < %zu\n", ws_size, (size_t)WS_NEED);
  static int grid_blocks = 0;
  if (!grid_blocks) {
    int dev = 0, cus = 0, per_cu = 0;
    hipGetDevice(&dev);
    hipDeviceGetAttribute(&cus, hipDeviceAttributeMultiprocessorCount, dev);
    hipOccupancyMaxActiveBlocksPerMultiprocessor(&per_cu, mega<true>, NTHR, 0);
    if (per_cu > 2) per_cu = 2;
    grid_blocks = cus * per_cu;
  }
  int lo = 0, hi = NPHASE;
  void* args[] = {&p, &lo, &hi};
  hipError_t e = hipLaunchCooperativeKernel((void*)mega<true>, dim3(grid_blocks), dim3(NTHR), args, 0, stream);
  if (e != hipSuccess) fprintf(stderr, "cooperative launch failed: %s (grid %d)\n", hipGetErrorString(e), grid_blocks);
}
```

```cpp
#include <hip/hip_runtime.h>
#include <hip/hip_cooperative_groups.h>
#include <cstdio>
namespace cg = cooperative_groups;

typedef unsigned short bf16_t;
typedef short bf16x8 __attribute__((ext_vector_type(8)));
typedef float f32x4 __attribute__((ext_vector_type(4)));
typedef float f32x2 __attribute__((ext_vector_type(2)));
typedef float f32x16 __attribute__((ext_vector_type(16)));
typedef unsigned short u16x4 __attribute__((ext_vector_type(4)));
typedef unsigned short u16x2 __attribute__((ext_vector_type(2)));
typedef unsigned u32x4 __attribute__((ext_vector_type(4)));
typedef unsigned u32x2 __attribute__((ext_vector_type(2)));
static __device__ __forceinline__ unsigned pk2(float lo, float hi) { typedef __bf16 b2 __attribute__((ext_vector_type(2))); typedef float f2 __attribute__((ext_vector_type(2))); return __builtin_bit_cast(unsigned, __builtin_convertvector((f2){lo, hi}, b2)); }

#define DI __device__ __forceinline__
#define GAS __attribute__((address_space(1)))
template <class T> static __device__ __forceinline__ T* as_global(T* q) { return (T*)(GAS T*)(unsigned long long)q; }

constexpr int NT = 16384;
constexpr int DM = 1024;
constexpr int NTHR = 256;
constexpr int DIN = 9616;
constexpr int ZHW = 2560, ZRW = 1920, ZMW = 2048;
constexpr int WTIN_ROWS = 9728;
constexpr int DFF = 2816;

constexpr size_t OFF_WTIN = 0;
constexpr size_t OFF_WTBR = OFF_WTIN + (size_t)WTIN_ROWS * 1024 * 2;
constexpr size_t OFF_H    = OFF_WTBR + (size_t)3 * 1024 * 512 * 2;
constexpr size_t OFF_ZH   = OFF_H + (size_t)NT * 1024 * 2;
constexpr size_t OFF_ZR   = OFF_ZH + (size_t)NT * ZHW * 2;
constexpr size_t OFF_ZM   = OFF_ZR + (size_t)NT * ZRW * 2;
constexpr size_t OFF_MG   = OFF_ZM + (size_t)NT * ZMW * 2;
constexpr size_t OFF_O    = OFF_MG + (size_t)NT * 16 * 4;
constexpr size_t OFF_MOD  = OFF_O + (size_t)NT * 1024 * 2;
constexpr size_t OFF_LBS  = OFF_MOD + (size_t)2 * 5 * 6144 * 4;
constexpr size_t OFF_CTR  = OFF_LBS + 2 * 512 * 4;
constexpr size_t OFF_BAR  = OFF_CTR + 256;
constexpr size_t OFF_ROLE = OFF_BAR + 3456 * 4;
constexpr size_t WS_NEED  = OFF_ROLE + 4096 * 4;
constexpr size_t OFF_MODP = OFF_ZH;
constexpr size_t OFF_WTOUT = OFF_ZR;
constexpr size_t OFF_WTFI  = OFF_WTOUT + (size_t)1024 * 1024 * 2;
constexpr size_t OFF_WTFO  = OFF_WTFI + (size_t)5632 * 1024 * 2;
constexpr size_t OFF_MERGED = OFF_WTFO + (size_t)1024 * 2816 * 2;
constexpr size_t OFF_Y    = OFF_ZH;
constexpr size_t OFF_ACT  = OFF_ZM;

constexpr size_t OUT_HG = 16777216, OUT_RW = 25165824, OUT_C = 29360128, OUT_N = 37748736, OUT_M = 37814272;

enum { I_XP = 0, I_XS, I_SH, I_SR, I_SC, I_SN, I_SM, I_C, I_CCTX, I_WADA, I_BADA, I_NORMS, I_WIN, I_HLB, I_HNORM, I_MU, I_W0, I_W2,
       I_A0, I_A2, I_G2, I_KK, I_KA, I_RK, I_LN, I_GB, I_MNORM, I_WBR, I_WOUT, I_WFI, I_WFO, N_IN };

struct Params { const float* in[N_IN]; float* out; char* ws; int wb; int role; };

constexpr int LDS_BYTES = 77824;

DI bf16_t f2bf(float f) { return __builtin_bit_cast(unsigned short, (__bf16)f); }
DI float bf2f(bf16_t h) { return __uint_as_float(((unsigned)h) << 16); }
DI float sigmoidf_(float x) { return 1.0f / (1.0f + __expf(-x)); }
DI float siluf_(float x) { return x / (1.0f + __expf(-x)); }
DI float softplusf_(float x) { return x > 20.f ? x : __logf(1.0f + __expf(x)); }
DI float dpp_xor1(float x) { return __int_as_float(__builtin_amdgcn_mov_dpp(__float_as_int(x), 0xB1, 0xF, 0xF, true)); }
DI float dpp_xor2(float x) { return __int_as_float(__builtin_amdgcn_mov_dpp(__float_as_int(x), 0x4E, 0xF, 0xF, true)); }
DI float shfl_lane(float v, int src) { return __int_as_float(__builtin_amdgcn_ds_bpermute(src << 2, __float_as_int(v))); }
#define SHX(v, m) shfl_lane((v), lane ^ (m))
DI float wave_sum(float v, int lane) { v += dpp_xor1(v); v += dpp_xor2(v); v += SHX(v, 4); v += SHX(v, 8); v += SHX(v, 16); v += SHX(v, 32); return v; }
DI int ltid_(int wb) { int t = wb + (int)__builtin_amdgcn_mbcnt_hi(~0u, __builtin_amdgcn_mbcnt_lo(~0u, 0u)); asm volatile("" : "+v"(t)); return t; }
#define ltid() ltid_(p.wb)
DI int crow(int reg, int h) { return (reg & 3) + 8 * (reg >> 2) + 4 * h; }

DI int tok_cond(int tok) { return tok < 8192 ? 0 : 1 + ((tok - 8192) >> 11); }
DI const float* x_in_row(const Params& p, int tok) { return tok < 8192 ? p.in[I_XP] + (size_t)tok * DM : p.in[I_XS] + (size_t)(tok - 8192) * DM; }

DI void mma32(f32x16& acc, const bf16_t* A, int lda, const bf16_t* B, int ldb, int K, int lane) {
  const int r = lane & 31, h = lane >> 5;
#pragma unroll 2
  for (int kk = 0; kk < K; kk += 16) {
    bf16x8 a = *(const bf16x8*)(A + r * lda + kk + 8 * h);
    bf16x8 b = *(const bf16x8*)(B + r * ldb + kk + 8 * h);
    acc = __builtin_amdgcn_mfma_f32_32x32x16_bf16(a, b, acc, 0, 0, 0);
  }
}

template <int BM, int BN, int BK, bool WR, bool LD>
DI void gemm_ktile(f32x4 (&acc)[BM / 32][BN / 32], bf16x8 (&ra)[BM * BK / 2048], bf16x8 (&rb)[BN * BK / 2048],
                   const bf16_t* __restrict__ A, int lda, const bf16_t* __restrict__ B, int ldb, int k2,
                   const bf16_t* as, const bf16_t* bs, bf16_t* Aw, bf16_t* Bw) {
  constexpr int MI = BM / 32, NJ = BN / 32, LS = BK + 8, ACH = BM * BK / 2048, BCH = BN * BK / 2048, KS = BK / 32, RPI = 256 / (BK / 8);
  static_assert(KS * MI >= ACH + BCH, "not enough MFMA row blocks to carry the staging");
  __builtin_amdgcn_s_setprio(1);
#pragma unroll
  for (int ks = 0; ks < KS; ++ks) {
    bf16x8 bfr[NJ];
#pragma unroll
    for (int j = 0; j < NJ; ++j) bfr[j] = *(const bf16x8*)(bs + j * 16 * LS + ks * 32);
    bf16x8 afn = *(const bf16x8*)(as + ks * 32);
#pragma unroll
    for (int i = 0; i < MI; ++i) {
      const bf16x8 af = afn;
      if (i + 1 < MI) afn = *(const bf16x8*)(as + (i + 1) * 16 * LS + ks * 32);
#pragma unroll
      for (int j = 0; j < NJ; ++j) acc[i][j] = __builtin_amdgcn_mfma_f32_16x16x32_bf16(bfr[j], af, acc[i][j], 0, 0, 0);
      const int s = ks * MI + i;
      if (s < ACH) {
        if (WR) *(bf16x8*)(Aw + RPI * s * LS) = ra[s < ACH ? s : 0];
        if (LD) ra[s < ACH ? s : 0] = *(const bf16x8*)(A + (size_t)(RPI * s) * lda + k2);
      } else if (s < ACH + BCH) {
        const int c = s - ACH;
        if (WR) *(bf16x8*)(Bw + RPI * c * LS) = rb[(c >= 0 && c < BCH) ? c : 0];
        if (LD) rb[(c >= 0 && c < BCH) ? c : 0] = *(const bf16x8*)(B + (size_t)(RPI * c) * ldb + k2);
      }
      __builtin_amdgcn_sched_barrier(0);
    }
  }
  __builtin_amdgcn_s_setprio(0);
}

template <int BM, int BN, int BK>
DI void gemm_main(const Params& p, f32x4 (&acc)[BM / 32][BN / 32], bf16x8 (&ra)[BM * BK / 2048], bf16x8 (&rb)[BN * BK / 2048], bool primed,
                  const bf16_t* __restrict__ A, int lda, const bf16_t* __restrict__ B, int ldb, int K,
                  const bf16_t* __restrict__ An, int ldan, const bf16_t* __restrict__ Bn, int ldbn, bf16_t* sm) {
  constexpr int LS = BK + 8, CPR = BK / 8, ACH = BM * BK / 2048, BCH = BN * BK / 2048, RPI = 256 / CPR;
  const int tid = ltid(), lane = tid & 63, w = tid >> 6, wm = w >> 1, wn = w & 1;
  bf16_t* As = sm; bf16_t* Bs = sm + 2 * BM * LS;
  const int nk = K / BK;
  const int lrow = tid / CPR, lkc = (tid % CPR) * 8;
  const bf16_t* Ag = A + (size_t)lrow * lda + lkc;
  const bf16_t* Bg = B + (size_t)lrow * ldb + lkc;
  bf16_t* Al = As + lrow * LS + lkc; bf16_t* Bl = Bs + lrow * LS + lkc;
  if (!primed) {
#pragma unroll
    for (int i = 0; i < ACH; ++i) ra[i] = *(const bf16x8*)(Ag + (size_t)(RPI * i) * lda);
#pragma unroll
    for (int i = 0; i < BCH; ++i) rb[i] = *(const bf16x8*)(Bg + (size_t)(RPI * i) * ldb);
    __syncthreads();
#pragma unroll
    for (int i = 0; i < ACH; ++i) *(bf16x8*)(Al + RPI * i * LS) = ra[i];
#pragma unroll
    for (int i = 0; i < BCH; ++i) *(bf16x8*)(Bl + RPI * i * LS) = rb[i];
#pragma unroll
    for (int i = 0; i < ACH; ++i) ra[i] = *(const bf16x8*)(Ag + (size_t)(RPI * i) * lda + BK);
#pragma unroll
    for (int i = 0; i < BCH; ++i) rb[i] = *(const bf16x8*)(Bg + (size_t)(RPI * i) * ldb + BK);
    __syncthreads();
  }
  const bf16_t* as0 = As + (wm * (BM / 2) + (lane & 15)) * LS + (lane >> 4) * 8;
  const bf16_t* bs0 = Bs + (wn * (BN / 2) + (lane & 15)) * LS + (lane >> 4) * 8;
  int kt = 0;
  for (; kt + 2 < nk; ++kt) {
    const int buf = kt & 1, nb = buf ^ 1;
    gemm_ktile<BM, BN, BK, true, true>(acc, ra, rb, Ag, lda, Bg, ldb, (kt + 2) * BK, as0 + buf * BM * LS, bs0 + buf * BN * LS, Al + nb * BM * LS, Bl + nb * BN * LS);
    __syncthreads();
  }
  {
    const bf16_t* Agn = An + (size_t)lrow * ldan + lkc;
    const bf16_t* Bgn = Bn + (size_t)lrow * ldbn + lkc;
    gemm_ktile<BM, BN, BK, true, true>(acc, ra, rb, Agn, ldan, Bgn, ldbn, 0, as0, bs0, Al + BM * LS, Bl + BN * LS);
    __syncthreads();
    gemm_ktile<BM, BN, BK, true, true>(acc, ra, rb, Agn, ldan, Bgn, ldbn, BK, as0 + BM * LS, bs0 + BN * LS, Al, Bl);
    __syncthreads();
  }
}

template <int MI, int NJ> DI void zero_acc(f32x4 (&acc)[MI][NJ]) {
#pragma unroll
  for (int i = 0; i < MI; ++i)
#pragma unroll
    for (int j = 0; j < NJ; ++j) acc[i][j] = (f32x4){0.f, 0.f, 0.f, 0.f};
}
DI void store_bf4(bf16_t* dst, f32x4 v) { u16x4 o; o[0] = f2bf(v[0]); o[1] = f2bf(v[1]); o[2] = f2bf(v[2]); o[3] = f2bf(v[3]); *(u16x4*)dst = o; }

DI int map_col(int mode, int n) {
  if (mode == 0) return n < 6544 ? n : (n < 6656 ? -1 : n - 112);
  if (mode == 2) return ((n >> 4) & 1) ? DFF + (n >> 5) * 16 + (n & 15) : (n >> 5) * 16 + (n & 15);
  return n;
}
DI void conv_tile(const Params& p, const float* __restrict__ src, int ld_src, bf16_t* __restrict__ dst, int K, int mode, int tk, int tn, float* sm) {
  const int tid = ltid();
  __syncthreads();
  {
    const int nn = tid & 63, col = map_col(mode, tn * 64 + nn);
#pragma unroll
    for (int i = 0; i < 16; ++i) { int kk = (tid >> 6) + 4 * i; sm[kk * 65 + nn] = col >= 0 ? src[(size_t)(tk * 64 + kk) * ld_src + col] : 0.f; }
  }
  __syncthreads();
  {
    const int kk = tid & 63;
#pragma unroll
    for (int i = 0; i < 16; ++i) { int nn = (tid >> 6) + 4 * i; dst[(size_t)(tn * 64 + nn) * K + tk * 64 + kk] = f2bf(sm[kk * 65 + nn]); }
  }
}
DI void conv_weight(const Params& p, const float* src, int ld_src, bf16_t* dst, int K, int Ndst, int mode, float* sm, int bid, int nb) {
  const int tkn = K / 64, nt = tkn * (Ndst / 64);
  for (int t = bid; t < nt; t += nb) conv_tile(p, src, ld_src, dst, K, mode, t % tkn, t / tkn, sm);
}

DI void phase0(const Params& p, char* smem) {
  const int tid = ltid(), bid = blockIdx.x, nb = gridDim.x;
  float* MODP = (float*)(p.ws + OFF_MODP);
  float* sm = (float*)smem;
  if (bid == 0) { if (tid < 64) ((int*)(p.ws + OFF_CTR))[tid] = 0; for (int i = tid; i < 3456; i += NTHR) ((unsigned*)(p.ws + OFF_BAR))[i] = 0u; for (int i = tid; i < 4096; i += NTHR) ((unsigned*)(p.ws + OFF_ROLE))[i] = 0u; }
  for (int i = bid * NTHR + tid; i < 512; i += nb * NTHR) {
    float a = p.in[I_HLB][i], b = p.in[I_HLB][512 + i];
    float* L = (float*)(p.ws + OFF_LBS); L[i] = 0.f; L[512 + i] = 1.0f / (1.0f + expf(a - b));
  }
  for (int it = bid; it < 2 * 24 * 16; it += nb) {
    const int ks = it & 15, jb = (it >> 4) % 24, l = it / (16 * 24);
    __syncthreads();
    for (int e = tid; e < 5 * 64; e += NTHR) { int ci = e >> 6, k = ks * 64 + (e & 63); float cv = ci == 0 ? p.in[I_CCTX][k] : p.in[I_C][(ci - 1) * DM + k]; sm[e] = siluf_(cv); }
    __syncthreads();
    const int j = jb * 256 + tid;
    float a0 = 0, a1 = 0, a2 = 0, a3 = 0, a4 = 0;
    const float* W = p.in[I_WADA] + ((size_t)l * DM + ks * 64) * 6144 + j;
#pragma unroll 1
    for (int k0 = 0; k0 < 64; k0 += 16) {
      float wv[16];
#pragma unroll
      for (int u = 0; u < 16; ++u) wv[u] = W[(size_t)(k0 + u) * 6144];
#pragma unroll
      for (int u = 0; u < 16; ++u) { const int k = k0 + u; const float w = wv[u]; a0 += sm[k] * w; a1 += sm[64 + k] * w; a2 += sm[128 + k] * w; a3 += sm[192 + k] * w; a4 += sm[256 + k] * w; }
    }
    float* dst = MODP + ((size_t)(ks * 2 + l) * 5) * 6144 + j;
    dst[0] = a0; dst[6144] = a1; dst[2 * 6144] = a2; dst[3 * 6144] = a3; dst[4 * 6144] = a4;
  }
  conv_weight(p, p.in[I_WIN], DIN, (bf16_t*)(p.ws + OFF_WTIN), 1024, WTIN_ROWS, 0, sm, bid, nb);
  for (int br = 0; br < 3; ++br) conv_weight(p, p.in[I_WBR] + (size_t)br * 512 * 1024, 1024, (bf16_t*)(p.ws + OFF_WTBR) + (size_t)br * 1024 * 512, 512, 1024, 1, sm, bid, nb);
}
DI void phase1(const Params& p) {
  const float* MODP = (const float*)(p.ws + OFF_MODP);
  float* MOD = (float*)(p.ws + OFF_MOD);
  for (int i = blockIdx.x * NTHR + ltid(); i < 2 * 5 * 6144; i += gridDim.x * NTHR) {
    const int j = i % 6144, l = i / (5 * 6144);
    float s = p.in[I_BADA][l * 6144 + j];
    for (int ks = 0; ks < 16; ++ks) s += MODP[(size_t)ks * 2 * 5 * 6144 + i];
    MOD[i] = s;
  }
}

DI void norm_mod_store(const f32x4 (&x)[4], const float* nw, const float* sc, const float* sh, bf16_t* hrow, int lane) {
  float ss = 0.f;
#pragma unroll
  for (int i = 0; i < 4; ++i) ss += x[i][0] * x[i][0] + x[i][1] * x[i][1] + x[i][2] * x[i][2] + x[i][3] * x[i][3];
  ss = wave_sum(ss, lane);
  const float rs = rsqrtf(ss * (1.0f / DM) + 1e-6f);
#pragma unroll
  for (int i = 0; i < 4; ++i) {
    const int c = i * 256 + lane * 4;
    f32x4 w = *(const f32x4*)(nw + c), s1 = *(const f32x4*)(sc + c), s0 = *(const f32x4*)(sh + c), o;
#pragma unroll
    for (int e = 0; e < 4; ++e) o[e] = x[i][e] * rs * w[e] * (1.0f + s1[e]) + s0[e];
    store_bf4(hrow + c, o);
  }
}
DI void tok_one(const Params& p, int l, int mode, int tok, int lane) {
  const float* MOD = (const float*)(p.ws + OFF_MOD);
  bf16_t* H = (bf16_t*)(p.ws + OFF_H);
  const float* Y = (const float*)(p.ws + OFF_Y);
  const int ci = tok_cond(tok);
  const float* modl = MOD + (size_t)(l * 5 + ci) * 6144;
  const float* nwl = p.in[I_NORMS] + (size_t)l * 4 * DM;
  const bool from_in = (l == 0 && (mode == 0 || mode == 1 || mode == 3));
  const float* xr = from_in ? x_in_row(p, tok) : p.out + (size_t)tok * DM;
  const bool has_y = (mode == 1 || mode == 2);
  const bool has_h = !(mode == 2 && l + 1 >= 2);
  const float* modn = (mode == 2 && has_h) ? MOD + (size_t)((l + 1) * 5 + ci) * 6144 : modl;
  const float* nw2 = mode == 1 ? nwl + 2 * DM : (mode == 2 ? p.in[I_NORMS] + (size_t)(has_h ? l + 1 : l) * 4 * DM : nwl);
  const float* sc2 = mode == 1 ? modl + 4 * DM : modn + 1 * DM;
  const float* sh2 = mode == 1 ? modl + 3 * DM : modn + 0 * DM;
  const float* nwy = nwl + (mode == 1 ? 1 : 3) * DM;
  const float* gy = modl + (mode == 1 ? 2 : 5) * DM;
  f32x4 x[4], y[4], wy[4], gg[4], w2[4], s1[4], s0[4];
#pragma unroll
  for (int i = 0; i < 4; ++i) {
    const int c = i * 256 + lane * 4;
    x[i] = *(const f32x4*)(xr + c);
    if (has_y) { y[i] = *(const f32x4*)(Y + (size_t)tok * DM + c); wy[i] = *(const f32x4*)(nwy + c); gg[i] = *(const f32x4*)(gy + c); }
    if (has_h) { w2[i] = *(const f32x4*)(nw2 + c); s1[i] = *(const f32x4*)(sc2 + c); s0[i] = *(const f32x4*)(sh2 + c); }
  }
  if (has_y) {
    float ss = 0.f;
#pragma unroll
    for (int i = 0; i < 4; ++i) ss += y[i][0] * y[i][0] + y[i][1] * y[i][1] + y[i][2] * y[i][2] + y[i][3] * y[i][3];
    ss = wave_sum(ss, lane);
    const float rs = rsqrtf(ss * (1.0f / DM) + 1e-6f);
#pragma unroll
    for (int i = 0; i < 4; ++i) {
      const int c = i * 256 + lane * 4;
#pragma unroll
      for (int e = 0; e < 4; ++e) x[i][e] += gg[i][e] * (y[i][e] * rs * wy[i][e]);
      *(f32x4*)(p.out + (size_t)tok * DM + c) = x[i];
    }
  }
  if (has_h) {
    float ss = 0.f;
#pragma unroll
    for (int i = 0; i < 4; ++i) ss += x[i][0] * x[i][0] + x[i][1] * x[i][1] + x[i][2] * x[i][2] + x[i][3] * x[i][3];
    ss = wave_sum(ss, lane);
    const float rs = rsqrtf(ss * (1.0f / DM) + 1e-6f);
#pragma unroll
    for (int i = 0; i < 4; ++i) {
      f32x4 o;
#pragma unroll
      for (int e = 0; e < 4; ++e) o[e] = x[i][e] * rs * w2[i][e] * (1.0f + s1[i][e]) + s0[i][e];
      store_bf4(H + (size_t)tok * DM + i * 256 + lane * 4, o);
    }
  }
}
DI void tok_phase(const Params& p, int l, int mode) {
  const int lane = ltid() & 63, gw = blockIdx.x * 4 + (ltid() >> 6), nw = gridDim.x * 4;
  for (int tok = gw; tok < NT; tok += nw) tok_one(p, l, mode, tok, lane);
}

DI bool tile_xcd(int i, int NTN, int MTX, int& mt, int& nt) {
  const int G = gridDim.x, b = blockIdx.x, x = b & 7, j = b >> 3, nbx = (G - x + 7) >> 3;
  const int u = j + i * nbx;
  if (u >= MTX * NTN) return false;
  mt = MTX * x + (u % MTX); nt = u / MTX;
  return true;
}
DI void phase_inproj(const Params& p, char* smem) {
  const bf16_t* H = (const bf16_t*)(p.ws + OFF_H);
  const bf16_t* WT = (const bf16_t*)(p.ws + OFF_WTIN);
  bf16_t* ZH = (bf16_t*)(p.ws + OFF_ZH); bf16_t* ZR = (bf16_t*)(p.ws + OFF_ZR); bf16_t* ZM = (bf16_t*)(p.ws + OFF_ZM);
  float* MG = (float*)(p.ws + OFF_MG);
  bf16x8 ra[4], rb[2]; bool primed = false;
  int mt, nt; bool have = tile_xcd(0, 52, 8, mt, nt);
  for (int ti = 0; have; ++ti) {
    int mtn = 0, ntn = 0; const bool haven = tile_xcd(ti + 1, 52, 8, mtn, ntn);
    f32x4 acc[8][4]; zero_acc<8, 4>(acc);
    gemm_main<256, 128, 32>(p, acc, ra, rb, primed, H + (size_t)mt * 256 * 1024, 1024, WT + (size_t)nt * 128 * 1024, 1024, 1024,
                            H + (size_t)(haven ? mtn : mt) * 256 * 1024, 1024, WT + (size_t)(haven ? ntn : nt) * 128 * 1024, 1024, (bf16_t*)smem);
    primed = haven;
    const int lane = ltid() & 63, w = ltid() >> 6, wm = w >> 1, wn = w & 1; (void)wm; (void)wn;
    const int n0 = nt * 128;
#pragma unroll
    for (int i = 0; i < 8; ++i) {
      asm volatile("" ::: "memory");
      const int row = mt * 256 + wm * 128 + i * 16 + (lane & 15);
#pragma unroll
      for (int j = 0; j < 4; ++j) {
        const int col = n0 + wn * 64 + j * 16 + 4 * (lane >> 4);
        if (n0 < 2560) store_bf4(ZH + (size_t)row * ZHW + col, acc[i][j]);
        else if (n0 < 4480) store_bf4(ZR + (size_t)row * ZRW + (col - 2560), acc[i][j]);
        else if (n0 < 6528) store_bf4(ZM + (size_t)row * ZMW + (col - 4480), acc[i][j]);
        else if (col - 6528 < 16) *(f32x4*)(MG + (size_t)row * 16 + (col - 6528)) = acc[i][j];
      }
    }
    mt = mtn; nt = ntn; have = haven;
  }
}

DI void merge_sub(const Params& p, int mt, int nt, int s, const bf16_t*& A_, int& lda_, const bf16_t*& B_, int& ldb_, int& K_) {
  const bf16_t* H = (const bf16_t*)(p.ws + OFF_H);
  const bf16_t* WT = (const bf16_t*)(p.ws + OFF_WTIN);
  const bf16_t* WBR = (const bf16_t*)(p.ws + OFF_WTBR);
  const bf16_t* ZH = (const bf16_t*)(p.ws + OFF_ZH); const bf16_t* ZM = (const bf16_t*)(p.ws + OFF_ZM); const bf16_t* O = (const bf16_t*)(p.ws + OFF_O);
  const int br = s >> 1;
  if (!(s & 1)) { A_ = H + (size_t)mt * 128 * 1024; lda_ = 1024; B_ = WT + (size_t)(6656 + br * 1024 + nt * 128) * 1024; ldb_ = 1024; K_ = 1024; }
  else {
    const bf16_t* Ab; int lda;
    if (br == 0) { Ab = ZH + 2048; lda = ZHW; } else if (br == 1) { Ab = O; lda = 1024; } else { Ab = ZM + 1536; lda = ZMW; }
    A_ = Ab + (size_t)mt * 128 * lda; lda_ = lda; B_ = WBR + ((size_t)br * 1024 + nt * 128) * 512; ldb_ = 512; K_ = 512;
  }
}
DI void phase_merge(const Params& p, int l, char* smem) {
  bf16_t* MER = (bf16_t*)(p.ws + OFF_MERGED);
  unsigned* gsc = (unsigned*)(smem + 40960);
  bf16x8 ra[2], rb[2]; bool primed = false;
  int mt, nt; bool have = tile_xcd(0, 8, 16, mt, nt);
  for (int ti = 0; have; ++ti) {
    int mtn = 0, ntn = 0; const bool haven = tile_xcd(ti + 1, 8, 16, mtn, ntn);
    f32x4 accM[4][4]; zero_acc<4, 4>(accM);
#pragma unroll 1
    for (int br = 0; br < 3; ++br) {
      f32x4 acc[4][4]; zero_acc<4, 4>(acc);
      const bf16_t *A0, *B0, *A1, *B1, *A2, *B2; int la0, lb0, k0, la1, lb1, k1, la2, lb2, k2;
      merge_sub(p, mt, nt, 2 * br, A0, la0, B0, lb0, k0);
      merge_sub(p, mt, nt, 2 * br + 1, A1, la1, B1, lb1, k1);
      const bool more = (br < 2) || haven;
      if (br < 2) merge_sub(p, mt, nt, 2 * br + 2, A2, la2, B2, lb2, k2); else merge_sub(p, haven ? mtn : mt, haven ? ntn : nt, 0, A2, la2, B2, lb2, k2);
      gemm_main<128, 128, 32>(p, acc, ra, rb, primed, A0, la0, B0, lb0, k0, A1, la1, B1, lb1, (bf16_t*)smem);
      {
        const int tid_ = ltid();
#pragma unroll
        for (int i = 0; i < 4; ++i)
#pragma unroll
          for (int j = 0; j < 4; ++j) {
            gsc[((i * 4 + j) * 2 + 0) * 256 + tid_] = pk2(sigmoidf_(acc[i][j][0]), sigmoidf_(acc[i][j][1]));
            gsc[((i * 4 + j) * 2 + 1) * 256 + tid_] = pk2(sigmoidf_(acc[i][j][2]), sigmoidf_(acc[i][j][3]));
            acc[i][j] = (f32x4){0.f, 0.f, 0.f, 0.f};
          }
      }
      gemm_main<128, 128, 32>(p, acc, ra, rb, true, A1, la1, B1, lb1, k1, A2, la2, B2, lb2, (bf16_t*)smem);
      primed = more;
      {
        const int tid_ = ltid();
#pragma unroll
        for (int i = 0; i < 4; ++i)
#pragma unroll
          for (int j = 0; j < 4; ++j) {
            const unsigned g0 = gsc[((i * 4 + j) * 2 + 0) * 256 + tid_], g1 = gsc[((i * 4 + j) * 2 + 1) * 256 + tid_];
            accM[i][j][0] += __uint_as_float(g0 << 16) * acc[i][j][0]; accM[i][j][1] += __uint_as_float(g0 & 0xffff0000u) * acc[i][j][1];
            accM[i][j][2] += __uint_as_float(g1 << 16) * acc[i][j][2]; accM[i][j][3] += __uint_as_float(g1 & 0xffff0000u) * acc[i][j][3];
          }
      }
    }
    const int lane = ltid() & 63, w = ltid() >> 6, wm = w >> 1, wn = w & 1;
#pragma unroll
    for (int i = 0; i < 4; ++i) {
      const int row = mt * 128 + wm * 64 + i * 16 + (lane & 15);
#pragma unroll
      for (int j = 0; j < 4; ++j) store_bf4(MER + (size_t)row * 1024 + nt * 128 + wn * 64 + j * 16 + 4 * (lane >> 4), accM[i][j]);
    }
    mt = mtn; nt = ntn; have = haven;
  }
  float* sm = (float*)smem;
  conv_weight(p, p.in[I_WOUT] + (size_t)l * 1024 * 1024, 1024, (bf16_t*)(p.ws + OFF_WTOUT), 1024, 1024, 1, sm, blockIdx.x, gridDim.x);
  conv_weight(p, p.in[I_WFI] + (size_t)l * 1024 * 5632, 5632, (bf16_t*)(p.ws + OFF_WTFI), 1024, 5632, 2, sm, blockIdx.x, gridDim.x);
  conv_weight(p, p.in[I_WFO] + (size_t)l * DFF * 1024, 1024, (bf16_t*)(p.ws + OFF_WTFO), DFF, 1024, 1, sm, blockIdx.x, gridDim.x);
}

DI void phase_gemm_f32(const Params& p, const bf16_t* A, int K, const bf16_t* Wt, char* smem) {
  float* Y = (float*)(p.ws + OFF_Y);
  bf16x8 ra[4], rb[2]; bool primed = false;
  int mt, nt; bool have = tile_xcd(0, 8, 8, mt, nt);
  for (int ti = 0; have; ++ti) {
    int mtn = 0, ntn = 0; const bool haven = tile_xcd(ti + 1, 8, 8, mtn, ntn);
    f32x4 acc[8][4]; zero_acc<8, 4>(acc);
    gemm_main<256, 128, 32>(p, acc, ra, rb, primed, A + (size_t)mt * 256 * K, K, Wt + (size_t)nt * 128 * K, K, K,
                            A + (size_t)(haven ? mtn : mt) * 256 * K, K, Wt + (size_t)(haven ? ntn : nt) * 128 * K, K, (bf16_t*)smem);
    primed = haven;
    const int lane = ltid() & 63, w = ltid() >> 6, wm = w >> 1, wn = w & 1; (void)wm; (void)wn;
#pragma unroll
    for (int i = 0; i < 8; ++i) {
      asm volatile("" ::: "memory");
      const int row = mt * 256 + wm * 128 + i * 16 + (lane & 15);
#pragma unroll
      for (int j = 0; j < 4; ++j) *(f32x4*)(Y + (size_t)row * 1024 + nt * 128 + wn * 64 + j * 16 + 4 * (lane >> 4)) = acc[i][j];
    }
    mt = mtn; nt = ntn; have = haven;
  }
}
DI void phase_ffn_in(const Params& p, char* smem) {
  const bf16_t* H = (const bf16_t*)(p.ws + OFF_H);
  const bf16_t* Wt = (const bf16_t*)(p.ws + OFF_WTFI);
  bf16_t* ACT = (bf16_t*)(p.ws + OFF_ACT);
  bf16x8 ra[4], rb[2]; bool primed = false;
  int mt, nt; bool have = tile_xcd(0, 44, 8, mt, nt);
  for (int ti = 0; have; ++ti) {
    int mtn = 0, ntn = 0; const bool haven = tile_xcd(ti + 1, 44, 8, mtn, ntn);
    f32x4 acc[8][4]; zero_acc<8, 4>(acc);
    gemm_main<256, 128, 32>(p, acc, ra, rb, primed, H + (size_t)mt * 256 * 1024, 1024, Wt + (size_t)nt * 128 * 1024, 1024, 1024,
                            H + (size_t)(haven ? mtn : mt) * 256 * 1024, 1024, Wt + (size_t)(haven ? ntn : nt) * 128 * 1024, 1024, (bf16_t*)smem);
    primed = haven;
    const int lane = ltid() & 63, w = ltid() >> 6, wm = w >> 1, wn = w & 1; (void)wm; (void)wn;
#pragma unroll
    for (int i = 0; i < 8; ++i) {
      asm volatile("" ::: "memory");
      const int row = mt * 256 + wm * 128 + i * 16 + (lane & 15);
#pragma unroll
      for (int jj = 0; jj < 2; ++jj) {
        f32x4 u = acc[i][2 * jj], g = acc[i][2 * jj + 1], o;
#pragma unroll
        for (int e = 0; e < 4; ++e) o[e] = siluf_(g[e]) * u[e];
        const int col = (nt * 128 + wn * 64 + jj * 32) / 2 + 4 * (lane >> 4);
        store_bf4(ACT + (size_t)row * DFF + col, o);
      }
    }
    mt = mtn; nt = ntn; have = haven;
  }
}

struct Seq { int base, T, grid, b; bool sample; };
DI Seq get_seq(int s) { Seq q; if (s < 32) { q.base = s * 256; q.T = 256; q.grid = 0; q.b = s; q.sample = false; } else { q.b = s - 32; q.base = 8192 + q.b * 2048; q.T = 2048; q.grid = 1; q.sample = true; } return q; }

DI float rw_shift(const bf16_t* ZR, const float* mu, int base, int t, int T, int grid, int col) {
  const bf16_t* pp = ZR + (size_t)(base + t) * ZRW + col;
  const float y = bf2f(*pp);
  if (!grid) {
    const float prev = t > 0 ? bf2f(pp[-ZRW]) : 0.f, nxt = t < T - 1 ? bf2f(pp[ZRW]) : 0.f;
    return y + mu[col] * (prev - y) + mu[ZRW + col] * (nxt - y);
  }
  const int gc = t & 63, gr = t >> 6;
  const float left = gc > 0 ? bf2f(pp[-ZRW]) : 0.f, right = gc < 63 ? bf2f(pp[ZRW]) : 0.f;
  const float up = gr > 0 ? bf2f(pp[-64 * ZRW]) : 0.f, down = gr < 31 ? bf2f(pp[64 * ZRW]) : 0.f;
  return y + mu[col] * (left - y) + mu[ZRW + col] * (right - y) + mu[2 * ZRW + col] * (up - y) + mu[3 * ZRW + col] * (down - y);
}

DI void rw_shift8(const bf16_t* ZR, const float* mu, int base, int t, int T, int grid, int col0, float (&out)[8]) {
  const bf16_t* pp = ZR + (size_t)(base + t) * ZRW + col0;
  const bf16x8 y = *(const bf16x8*)pp;
  float yv[8];
#pragma unroll
  for (int e = 0; e < 8; ++e) { yv[e] = bf2f((bf16_t)y[e]); out[e] = yv[e]; }
  const int nn = grid ? 4 : 2;
#pragma unroll 1
  for (int n = 0; n < nn; ++n) {
    bool valid; int off;
    if (!grid) { valid = n == 0 ? t > 0 : t < T - 1; off = n == 0 ? -ZRW : ZRW; }
    else { const int gc = t & 63, gr = t >> 6; valid = n == 0 ? gc > 0 : n == 1 ? gc < 63 : n == 2 ? gr > 0 : gr < 31; off = n == 0 ? -ZRW : n == 1 ? ZRW : n == 2 ? -64 * ZRW : 64 * ZRW; }
    const f32x4 m0 = *(const f32x4*)(mu + n * ZRW + col0), m1 = *(const f32x4*)(mu + n * ZRW + col0 + 4);
    bf16x8 nb = y;
    if (valid) nb = *(const bf16x8*)(pp + off);
#pragma unroll
    for (int e = 0; e < 8; ++e) { const float nv_ = valid ? bf2f((bf16_t)nb[e]) : 0.f; const float mm = e < 4 ? m0[e & 3] : m1[e & 3]; out[e] += mm * (nv_ - yv[e]); }
  }
}

DI void rw_load8(const bf16_t* ZR, int base, int t, int T, int grid, int col0, bf16x8 (&v)[5]) {
  const bf16_t* pp = ZR + (size_t)(base + t) * ZRW + col0;
  const int gc = t & 63, gr = t >> 6;
  const int o1 = grid ? (gc > 0 ? -ZRW : 0) : (t > 0 ? -ZRW : 0);
  const int o2 = grid ? (gc < 63 ? ZRW : 0) : (t < T - 1 ? ZRW : 0);
  v[0] = *(const bf16x8*)pp;
  v[1] = *(const bf16x8*)(pp + o1);
  v[2] = *(const bf16x8*)(pp + o2);
  if (grid) {
    v[3] = *(const bf16x8*)(pp + (gr > 0 ? -64 * ZRW : 0)); v[4] = *(const bf16x8*)(pp + (gr < 31 ? 64 * ZRW : 0));
  } else {
    v[3] = (bf16x8){0, 0, 0, 0, 0, 0, 0, 0}; v[4] = (bf16x8){0, 0, 0, 0, 0, 0, 0, 0};
  }
}
DI unsigned rw_valid(int t, int T, int grid) {
  if (!grid) return (t > 0 ? 1u : 0u) | (t < T - 1 ? 2u : 0u);
  const int gc = t & 63, gr = t >> 6;
  return (gc > 0 ? 1u : 0u) | (gc < 63 ? 2u : 0u) | (gr > 0 ? 4u : 0u) | (gr < 31 ? 8u : 0u);
}
DI void rw_apply8(const bf16x8 (&v)[5], const float* mu, int grid, unsigned valid, int col0, float (&out)[8]) {
  float yv[8];
#pragma unroll
  for (int e = 0; e < 8; ++e) { yv[e] = bf2f((bf16_t)v[0][e]); out[e] = yv[e]; }
#pragma unroll
  for (int n = 0; n < 4; ++n) {
    if (n < 2 || grid) {
      const f32x4 m0 = *(const f32x4*)(mu + n * ZRW + col0), m1 = *(const f32x4*)(mu + n * ZRW + col0 + 4);
      const bool ok = (valid >> n) & 1u;
#pragma unroll
      for (int e = 0; e < 8; ++e) out[e] += (e < 4 ? m0[e & 3] : m1[e & 3]) * ((ok ? bf2f((bf16_t)v[1 + n][e]) : 0.f) - yv[e]);
    }
  }
}
DI void rw_apply8_lds(const bf16x8 (&v)[5], const float* mu5c, const float* c0c, int grid, unsigned valid, float (&out)[8]) {
  {
    const f32x4 c0 = *(const f32x4*)c0c, c1 = *(const f32x4*)(c0c + 4);
#pragma unroll
    for (int e = 0; e < 8; ++e) out[e] = bf2f((bf16_t)v[0][e]) * (e < 4 ? c0[e & 3] : c1[e & 3]);
  }
#pragma unroll
  for (int n = 0; n < 4; ++n) {
    if (n < 2 || grid) {
      const f32x4 m0 = *(const f32x4*)(mu5c + n * 320), m1 = *(const f32x4*)(mu5c + n * 320 + 4);
      const float ok = ((valid >> n) & 1u) ? 1.0f : 0.0f;
#pragma unroll
      for (int e = 0; e < 8; ++e) out[e] += (e < 4 ? m0[e & 3] : m1[e & 3]) * ok * bf2f((bf16_t)v[1 + n][e]);
    }
  }
}
DI float fast_tanh(float x) { return 1.0f - 2.0f / (1.0f + __expf(2.0f * x)); }
template <int N> DI float dpp_row_shr0(float x) { return __int_as_float(__builtin_amdgcn_update_dpp(0, __float_as_int(x), 0x110 + N, 0xF, 0xF, false)); }

DI void rwkv_item(const Params& p, int l, int s, int hh, int d, char* smem) {
  const Seq q = get_seq(s);
  const int tid0 = ltid();
  const int w = __builtin_amdgcn_readfirstlane(tid0 >> 6), vb = w >> 1, kb = w & 1;
  int tid = tid0, lane = tid & 63, l15 = lane & 15, qq = lane >> 4, r32 = lane & 31, h = lane >> 5;
  const bf16_t* ZR = (const bf16_t*)(p.ws + OFF_ZR);
  bf16_t* O = (bf16_t*)(p.ws + OFF_O);
  const float* mu = p.in[I_MU] + (size_t)l * 4 * ZRW;
  bf16_t* KHr = (bf16_t*)smem;
  bf16_t* BCr = KHr + 16 * 72;
  bf16_t* KC = BCr + 16 * 72;
  bf16_t* RH = KC + 16 * 72;
  bf16_t* Sb = RH + 16 * 72;
  bf16_t* Wb2 = (bf16_t*)smem;
  bf16_t* Ab2 = Wb2 + 64 * 72;
  float* mu5 = (float*)(smem + 18432);
  bf16_t* actW = (bf16_t*)(smem + 23552);
  bf16_t* actA = actW + 16 * 72;
  float* shR = (float*)(smem + 28160);
  float* shK = shR + 1024; float* shV = shK + 1024;
  bf16_t* VT0 = (bf16_t*)(smem + 40448);
  bf16_t* VT1 = (bf16_t*)(smem + 69376);
  bf16_t* UNT = VT0 + 64 * 40;
  bf16_t* KBT = UNT + 64 * 40;
  bf16_t* BBT = KBT + 64 * 24;
  float* PL = (float*)(smem + 56832);
  float* npart = PL + 64;
  float* MN = (float*)(smem + 57344);
  float* G0 = (float*)(smem + 61440);
  bf16_t* ArkM = (bf16_t*)(smem + 65536);
  bf16_t* ArbM = ArkM + 16 * 40;
  float* c0t = (float*)(smem + 68096);
  __syncthreads();
  for (int e = tid; e < 4096; e += NTHR) {
    const int i = e >> 6, c = e & 63;
    Wb2[c * 72 + i] = f2bf(p.in[I_W2][((size_t)(l * 2 + d) * 64 + i) * 512 + 64 * hh + c]);
    Ab2[c * 72 + i] = f2bf(p.in[I_A2][((size_t)(l * 2 + d) * 64 + i) * 512 + 64 * hh + c]);
  }
  for (int e = tid; e < 1280; e += NTHR) {
    const int n = e / 320, rem = e % 320, arr = rem >> 6, c = rem & 63;
    const int col = arr == 0 ? 64 * hh + c : arr == 1 ? 512 + 64 * hh + c : arr == 2 ? 1024 + 64 * hh + c : arr == 3 ? 1536 + 64 * d + c : 1664 + 64 * d + c;
    mu5[e] = mu[n * ZRW + col];
  }
  for (int e = tid; e < 320; e += NTHR) {
    const int arr = e >> 6, c = e & 63;
    const int col = arr == 0 ? 64 * hh + c : arr == 1 ? 512 + 64 * hh + c : arr == 2 ? 1024 + 64 * hh + c : arr == 3 ? 1536 + 64 * d + c : 1664 + 64 * d + c;
    float sm_ = mu[col] + mu[ZRW + col];
    if (q.grid) sm_ += mu[2 * ZRW + col] + mu[3 * ZRW + col];
    c0t[e] = 1.0f - sm_;
  }
  const int cB0 = 16 * w + 4 * qq;
  float w0c[4], a0c[4], kkc[4], kac[4];
#pragma unroll
  for (int g = 0; g < 4; ++g) {
    w0c[g] = p.in[I_W0][(l * 2 + d) * 512 + 64 * hh + cB0 + g]; a0c[g] = p.in[I_A0][(l * 2 + d) * 512 + 64 * hh + cB0 + g];
    kkc[g] = p.in[I_KK][l * 512 + 64 * hh + cB0 + g]; kac[g] = p.in[I_KA][l * 512 + 64 * hh + cB0 + g];
  }
  f32x16 S;
  if (q.sample) {
    const float* st = p.in[I_SR] + ((((size_t)q.b * 2 + l) * 2 + d) * 8 + hh) * 4096;
#pragma unroll
    for (int g = 0; g < 16; ++g) S[g] = st[(32 * vb + crow(g, h)) * 64 + 32 * kb + r32];
  } else {
#pragma unroll
    for (int g = 0; g < 16; ++g) S[g] = 0.f;
  }
  __syncthreads();
  bf16x8 bW[2], bA[2];
#pragma unroll
  for (int ks = 0; ks < 2; ++ks) { bW[ks] = *(const bf16x8*)(Wb2 + (16 * w + l15) * 72 + ks * 32 + qq * 8); bA[ks] = *(const bf16x8*)(Ab2 + (16 * w + l15) * 72 + ks * 32 + qq * 8); }
  __syncthreads();
  for (int e = tid; e < (2 * 64 * 40 + 2 * 64 * 24) / 2; e += NTHR) ((unsigned*)VT0)[e] = 0u;
  for (int e = tid; e < (64 * 40) / 2; e += NTHR) ((unsigned*)VT1)[e] = 0u;
  for (int e = tid; e < (2 * 16 * 40) / 2; e += NTHR) ((unsigned*)ArkM)[e] = 0u;
  __syncthreads();
  const int nch = q.T / 16;
  bf16x8 pf[3][5];
  const int jA = (tid0 & 127) >> 3, c8A = (tid0 & 7) * 8, wh = w >> 1;
#define RW_CB(arr) ((arr) == 0 ? 64 * hh : (arr) == 1 ? 512 + 64 * hh : (arr) == 2 ? 1024 + 64 * hh : (arr) == 3 ? 1536 + 64 * d : 1664 + 64 * d)
#define RW_ISSUE(chn) { const int pos = (chn) * 16 + jA, t = d ? q.T - 1 - pos : pos; _Pragma("unroll") for (int gi = 0; gi < 3; ++gi) { if (gi < 2 || w < 2) { \
      rw_load8(ZR, q.base, t, q.T, q.grid, RW_CB(2 * gi + wh) + c8A, pf[gi]); } } }
#pragma unroll
  for (int g = 0; g < 4; ++g) asm volatile("" : "+v"(w0c[g]), "+v"(a0c[g]), "+v"(kkc[g]), "+v"(kac[g]));
  asm volatile("" : "+v"(S));
  RW_ISSUE(0)
#pragma unroll 1
  for (int ch = 0; ch < nch; ++ch) {
    tid = tid0; asm volatile("" : "+v"(tid));
    lane = tid & 63; l15 = lane & 15; qq = lane >> 4; r32 = lane & 31; h = lane >> 5;
    bf16_t* VT = (ch & 1) ? VT1 : VT0;
    {
      const int pos_ = ch * 16 + jA, t_ = d ? q.T - 1 - pos_ : pos_;
      const unsigned vd_ = rw_valid(t_, q.T, q.grid);
#pragma unroll
      for (int gi = 0; gi < 3; ++gi) {
        if (gi < 2 || w < 2) {
          const int arr = 2 * gi + wh;
          float val[8];
          rw_apply8_lds(pf[gi], mu5 + arr * 64 + c8A, c0t + arr * 64 + c8A, q.grid, vd_, val);
          if (arr < 3) {
            *(f32x4*)(shR + arr * 1024 + jA * 64 + c8A) = (f32x4){val[0], val[1], val[2], val[3]};
            *(f32x4*)(shR + arr * 1024 + jA * 64 + c8A + 4) = (f32x4){val[4], val[5], val[6], val[7]};
            if (arr == 2) {
#pragma unroll
              for (int e = 0; e < 8; ++e) VT[(c8A + e) * 40 + jA] = f2bf(val[e]);
            }
          } else if (arr == 3) {
            *(u32x4*)(actW + jA * 72 + c8A) = (u32x4){pk2(fast_tanh(val[0]), fast_tanh(val[1])), pk2(fast_tanh(val[2]), fast_tanh(val[3])), pk2(fast_tanh(val[4]), fast_tanh(val[5])), pk2(fast_tanh(val[6]), fast_tanh(val[7]))};
          } else {
            *(u32x4*)(actA + jA * 72 + c8A) = (u32x4){pk2(val[0], val[1]), pk2(val[2], val[3]), pk2(val[4], val[5]), pk2(val[6], val[7])};
          }
        }
      }
    }
    asm volatile("" ::: "memory"); __builtin_amdgcn_sched_barrier(0);
    if (ch + 1 < nch) RW_ISSUE(ch + 1)
    __syncthreads();
    {
      f32x4 aw = (f32x4){0.f, 0.f, 0.f, 0.f}, aa = (f32x4){0.f, 0.f, 0.f, 0.f};
#pragma unroll
      for (int ks = 0; ks < 2; ++ks) {
        const bf16x8 fw = *(const bf16x8*)(actW + l15 * 72 + ks * 32 + qq * 8);
        const bf16x8 fa = *(const bf16x8*)(actA + l15 * 72 + ks * 32 + qq * 8);
        aw = __builtin_amdgcn_mfma_f32_16x16x32_bf16(bW[ks], fw, aw, 0, 0, 0);
        aa = __builtin_amdgcn_mfma_f32_16x16x32_bf16(bA[ks], fa, aa, 0, 0, 0);
      }
      const f32x4 kv = *(const f32x4*)(shK + l15 * 64 + cB0), rv = *(const f32x4*)(shR + l15 * 64 + cB0);
      float lw[4], av[4], kkr[4], kd[4], Lp[4], LpL[4];
      float ssq = 0.f;
#pragma unroll
      for (int g = 0; g < 4; ++g) {
        const float wl = aw[g] + w0c[g], al = aa[g] + a0c[g];
        lw[g] = -__expf(-softplusf_(-wl) - 0.5f);
        av[g] = sigmoidf_(al);
        kkr[g] = kv[g] * kkc[g];
        kd[g] = kv[g] * (1.0f + (av[g] - 1.0f) * kac[g]);
        ssq += kkr[g] * kkr[g];
        float x = lw[g];
        x += dpp_row_shr0<1>(x); x += dpp_row_shr0<2>(x); x += dpp_row_shr0<4>(x); x += dpp_row_shr0<8>(x);
        Lp[g] = x;
      }
#pragma unroll
      for (int g = 0; g < 4; ++g) { float x = Lp[g];
        x = fminf(x, __int_as_float(__builtin_amdgcn_mov_dpp(__float_as_int(x), 0x128, 0xF, 0xF, true))); x = fminf(x, __int_as_float(__builtin_amdgcn_mov_dpp(__float_as_int(x), 0x124, 0xF, 0xF, true)));
        x = fminf(x, dpp_xor2(x)); x = fminf(x, dpp_xor1(x)); LpL[g] = x; }
      ssq += SHX(ssq, 16); ssq += SHX(ssq, 32);
      if (qq == 0) npart[w * 16 + l15] = ssq;
      float e_m1[4], e_neg[4], e_pos[4], e_end[4];
#pragma unroll
      for (int g = 0; g < 4; ++g) { e_m1[g] = __expf(Lp[g] - lw[g]); e_neg[g] = __expf(-Lp[g]); e_pos[g] = __expf(Lp[g]); e_end[g] = __expf(LpL[g] - Lp[g]); }
      *(u32x2*)(KHr + l15 * 72 + cB0) = (u32x2){pk2(kkr[0] * e_m1[0], kkr[1] * e_m1[1]), pk2(kkr[2] * e_m1[2], kkr[3] * e_m1[3])};
      *(u32x2*)(BCr + l15 * 72 + cB0) = (u32x2){pk2(kkr[0] * av[0] * e_neg[0], kkr[1] * av[1] * e_neg[1]), pk2(kkr[2] * av[2] * e_neg[2], kkr[3] * av[3] * e_neg[3])};
      *(u32x2*)(KC + l15 * 72 + cB0) = (u32x2){pk2(kd[0] * e_neg[0], kd[1] * e_neg[1]), pk2(kd[2] * e_neg[2], kd[3] * e_neg[3])};
      *(u32x2*)(RH + l15 * 72 + cB0) = (u32x2){pk2(rv[0] * e_pos[0], rv[1] * e_pos[1]), pk2(rv[2] * e_pos[2], rv[3] * e_pos[3])};
#pragma unroll
      for (int g = 0; g < 4; ++g) {
        KBT[(cB0 + g) * 24 + l15] = f2bf(kd[g] * e_end[g]);
        BBT[(cB0 + g) * 24 + l15] = f2bf(kkr[g] * av[g] * e_end[g]);
      }
      if (l15 == 15) *(f32x4*)(PL + cB0) = (f32x4){e_pos[0], e_pos[1], e_pos[2], e_pos[3]};
#pragma unroll
      for (int g = 0; g < 16; ++g) Sb[(32 * vb + crow(g, h)) * 72 + 32 * kb + r32] = f2bf(S[g]);
    }
    __syncthreads();
    f32x4 oacc = (f32x4){0.f, 0.f, 0.f, 0.f};
    {
      const bf16_t* Aop = (w < 2) ? KHr : RH;
      const bf16_t* Bop = (w == 0 || w == 3) ? BCr : KC;
      f32x4 t16 = (f32x4){0.f, 0.f, 0.f, 0.f}, g0 = (f32x4){0.f, 0.f, 0.f, 0.f};
#pragma unroll
      for (int ks = 0; ks < 2; ++ks) {
        const bf16x8 a = *(const bf16x8*)(Aop + l15 * 72 + ks * 32 + qq * 8);
        const bf16x8 b = *(const bf16x8*)(Bop + l15 * 72 + ks * 32 + qq * 8);
        t16 = __builtin_amdgcn_mfma_f32_16x16x32_bf16(a, b, t16, 0, 0, 0);
        const bf16x8 akh = *(const bf16x8*)(KHr + l15 * 72 + ks * 32 + qq * 8);
        const bf16x8 arh = *(const bf16x8*)(RH + l15 * 72 + ks * 32 + qq * 8);
        const bf16x8 bs = *(const bf16x8*)(Sb + (16 * w + l15) * 72 + ks * 32 + qq * 8);
        g0 = __builtin_amdgcn_mfma_f32_16x16x32_bf16(akh, bs, g0, 0, 0, 0);
        oacc = __builtin_amdgcn_mfma_f32_16x16x32_bf16(arh, bs, oacc, 0, 0, 0);
      }
#pragma unroll
      for (int g = 0; g < 4; ++g) G0[(4 * qq + g) * 64 + 16 * w + l15] = g0[g];
      *(f32x4*)(MN + w * 256 + l15 * 16 + 4 * qq) = t16;
    }
    __syncthreads();
    if (w == 0) {
      const float* MrT = MN; const float* NrT = MN + 256;
      f32x2 acc2[8];
#pragma unroll
      for (int pq = 0; pq < 8; ++pq) acc2[pq] = (f32x2){G0[(2 * pq) * 64 + lane], G0[(2 * pq + 1) * 64 + lane]};
      float vv[16], un[16];
#pragma unroll
      for (int j = 0; j < 16; ++j) vv[j] = shV[j * 64 + lane];
      const float n2v = __builtin_amdgcn_rcpf(fmaxf(npart[l15] + npart[16 + l15] + npart[32 + l15] + npart[48 + l15], 1e-24f));
      f32x4 nr[4], mr[4];
#pragma unroll
      for (int t4 = 0; t4 < 4; ++t4) { nr[t4] = *(const f32x4*)(NrT + 4 * t4); mr[t4] = *(const f32x4*)(MrT + 4 * t4); }
#pragma unroll
      for (int j = 0; j < 16; ++j) {
        f32x4 nrn[4], mrn[4];
#pragma unroll
        for (int t4 = 0; t4 < 4; ++t4) { nrn[t4] = (f32x4){0.f, 0.f, 0.f, 0.f}; mrn[t4] = (f32x4){0.f, 0.f, 0.f, 0.f}; }
        if (j + 1 < 16) {
#pragma unroll
          for (int t4 = 0; t4 < 4; ++t4) if (4 * t4 + 3 > j + 1) { nrn[t4] = *(const f32x4*)(NrT + (j + 1) * 16 + 4 * t4); mrn[t4] = *(const f32x4*)(MrT + (j + 1) * 16 + 4 * t4); }
        }
        const float n2s = __int_as_float(__builtin_amdgcn_readlane(__float_as_int(n2v), j));
        const float unj = -acc2[j >> 1][j & 1] * n2s;
        un[j] = unj;
        const f32x2 vv2 = (f32x2){vv[j], vv[j]}, un2 = (f32x2){unj, unj};
#pragma unroll
        for (int pq = 0; pq < 8; ++pq)
          if (2 * pq + 1 > j) acc2[pq] += (f32x2){nr[pq >> 1][2 * (pq & 1)], nr[pq >> 1][2 * (pq & 1) + 1]} * vv2 + (f32x2){mr[pq >> 1][2 * (pq & 1)], mr[pq >> 1][2 * (pq & 1) + 1]} * un2;
#pragma unroll
        for (int t4 = 0; t4 < 4; ++t4) { nr[t4] = nrn[t4]; mr[t4] = mrn[t4]; }
        __builtin_amdgcn_sched_barrier(0);
      }
      *(u32x4*)(UNT + lane * 40) = (u32x4){pk2(un[0], un[1]), pk2(un[2], un[3]), pk2(un[4], un[5]), pk2(un[6], un[7])};
      *(u32x4*)(UNT + lane * 40 + 8) = (u32x4){pk2(un[8], un[9]), pk2(un[10], un[11]), pk2(un[12], un[13]), pk2(un[14], un[15])};
    } else if (w < 3) {
      const float* src = MN + (w == 1 ? 512 : 768);
      bf16_t* dst = (w == 1) ? ArkM : ArbM;
#pragma unroll
      for (int i = 0; i < 4; ++i) { const int e = lane + 64 * i, j = e >> 4, t = e & 15; dst[t * 40 + j] = f2bf(j <= t ? src[e] : 0.f); }
    }
    __syncthreads();
    {
      const bf16x8 ak = *(const bf16x8*)(ArkM + l15 * 40 + qq * 8), ab = *(const bf16x8*)(ArbM + l15 * 40 + qq * 8);
      const bf16x8 bv = *(const bf16x8*)(VT + (16 * w + l15) * 40 + qq * 8), bu = *(const bf16x8*)(UNT + (16 * w + l15) * 40 + qq * 8);
      oacc = __builtin_amdgcn_mfma_f32_16x16x32_bf16(ak, bv, oacc, 0, 0, 0);
      oacc = __builtin_amdgcn_mfma_f32_16x16x32_bf16(ab, bu, oacc, 0, 0, 0);
#pragma unroll
      for (int g = 0; g < 4; ++g) {
        const int pos = ch * 16 + 4 * qq + g, t = d ? q.T - 1 - pos : pos;
        O[(size_t)(q.base + t) * 1024 + d * 512 + 64 * hh + 16 * w + l15] = f2bf(oacc[g]);
      }
      const float pl = PL[32 * kb + r32];
#pragma unroll
      for (int g = 0; g < 16; ++g) S[g] *= pl;
      const bf16x8 av_ = *(const bf16x8*)(VT + (32 * vb + r32) * 40 + 8 * h), au_ = *(const bf16x8*)(UNT + (32 * vb + r32) * 40 + 8 * h);
      const bf16x8 bk_ = *(const bf16x8*)(KBT + (32 * kb + r32) * 24 + 8 * h), bb_ = *(const bf16x8*)(BBT + (32 * kb + r32) * 24 + 8 * h);
      S = __builtin_amdgcn_mfma_f32_32x32x16_bf16(av_, bk_, S, 0, 0, 0);
      S = __builtin_amdgcn_mfma_f32_32x32x16_bf16(au_, bb_, S, 0, 0, 0);
    }
  }
  if (!q.sample) {
    float* dst = p.out + OUT_RW + ((((size_t)q.b * 2 + l) * 2 + d) * 8 + hh) * 4096;
#pragma unroll
    for (int g = 0; g < 16; ++g) dst[(32 * vb + crow(g, h)) * 64 + 32 * kb + r32] = S[g];
  }
}

DI void hgrn_item(const Params& p, int l, int s, int hh, int d, char* smem) {
  const Seq q = get_seq(s);
  const int tid = ltid(), lane = tid & 63, w = tid >> 6, r = lane & 31, h = lane >> 5;
  bf16_t* ZH = (bf16_t*)(p.ws + OFF_ZH);
  bf16_t* Qt = (bf16_t*)smem;
  bf16_t* Kt = Qt + 32 * 136;
  bf16_t* KhT = Kt + 32 * 136;
  bf16_t* VT = KhT + 128 * 40;
  bf16_t* Sb = VT + 128 * 40;
  bf16_t* At = Sb + 4 * 32 * 136;
  float* dL = (float*)(At + 32 * 40);
  float* tot = dL + 128;
  const float lb = ((const float*)(p.ws + OFF_LBS))[l * 512 + 128 * hh + (tid & 127)];
  f32x16 S[4];
  if (q.sample) {
    const float* st = p.in[I_SH] + ((((size_t)q.b * 2 + l) * 2 + d) * 4 + hh) * 16384;
#pragma unroll
    for (int kb = 0; kb < 4; ++kb)
#pragma unroll
      for (int g = 0; g < 16; ++g) S[kb][g] = st[(size_t)(32 * kb + crow(g, h)) * 128 + 32 * w + r];
  } else {
#pragma unroll
    for (int kb = 0; kb < 4; ++kb)
#pragma unroll
      for (int g = 0; g < 16; ++g) S[kb][g] = 0.f;
  }
  const int k = tid & 127, half = tid >> 7;
  const int nch = q.T / 32;
  u16x2 pzq[16], pv2[8];
#define HG_ISSUE(chn) { _Pragma("unroll") for (int jj = 0; jj < 16; ++jj) { const int pos = (chn) * 32 + half * 16 + jj, t = d ? q.T - 1 - pos : pos; \
      const size_t rowo = (size_t)(q.base + t) * ZHW + 128 * hh + k; pzq[jj][0] = ZH[rowo + 512 * (1 + d)]; pzq[jj][1] = ZH[rowo]; pv2[jj >> 1][jj & 1] = ZH[rowo + 1536]; } }
  { float lb_ = lb; asm volatile("" : "+v"(lb_)); (void)lb_; }
#pragma unroll
  for (int kb = 0; kb < 4; ++kb) asm volatile("" : "+v"(S[kb]));
  HG_ISSUE(0)
#pragma unroll 1
  for (int ch = 0; ch < nch; ++ch) {
    __syncthreads();
    float bl[16], kc[16], qs[16];
    {
      float b = 0.f;
#pragma unroll
      for (int jj = 0; jj < 16; ++jj) {
        const float z = bf2f(pzq[jj][0]);
        const float kcoef = (1.0f - lb) * sigmoidf_(-z);
        const float f = 1.0f - kcoef;
        b += fmaxf(__logf(f), -80.f);
        bl[jj] = b; kc[jj] = kcoef; qs[jj] = bf2f(pzq[jj][1]) * 0.08838834764831845f;
      }
      *(u32x4*)(VT + k * 40 + half * 16) = (u32x4){__builtin_bit_cast(unsigned, pv2[0]), __builtin_bit_cast(unsigned, pv2[1]), __builtin_bit_cast(unsigned, pv2[2]), __builtin_bit_cast(unsigned, pv2[3])};
      *(u32x4*)(VT + k * 40 + half * 16 + 8) = (u32x4){__builtin_bit_cast(unsigned, pv2[4]), __builtin_bit_cast(unsigned, pv2[5]), __builtin_bit_cast(unsigned, pv2[6]), __builtin_bit_cast(unsigned, pv2[7])};
      tot[half * 128 + k] = b;
    }
    if (ch + 1 < nch) HG_ISSUE(ch + 1)
    __syncthreads();
    {
      const float off = half ? tot[k] : 0.f;
      const float bL = fmaxf(tot[k] + tot[128 + k], -80.f);
      if (half == 0) dL[k] = __expf(bL);
      float kh[16];
#pragma unroll
      for (int jj = 0; jj < 16; ++jj) {
        const int j = half * 16 + jj;
        const float bj = fmaxf(off + bl[jj], -80.f);
        Qt[j * 136 + k] = f2bf(qs[jj] * __expf(bj));
        Kt[j * 136 + k] = f2bf(kc[jj] * __expf(-bj));
        kh[jj] = kc[jj] * __expf(fminf(bL - bj, 0.f));
      }
      *(u32x4*)(KhT + k * 40 + half * 16) = (u32x4){pk2(kh[0], kh[1]), pk2(kh[2], kh[3]), pk2(kh[4], kh[5]), pk2(kh[6], kh[7])};
      *(u32x4*)(KhT + k * 40 + half * 16 + 8) = (u32x4){pk2(kh[8], kh[9]), pk2(kh[10], kh[11]), pk2(kh[12], kh[13]), pk2(kh[14], kh[15])};
    }
    bf16_t* Sbw = Sb + w * 32 * 136;
#pragma unroll
    for (int kb = 0; kb < 4; ++kb)
#pragma unroll
      for (int g4 = 0; g4 < 4; ++g4) *(u32x2*)(Sbw + r * 136 + 32 * kb + crow(4 * g4, h)) = (u32x2){pk2(S[kb][4 * g4], S[kb][4 * g4 + 1]), pk2(S[kb][4 * g4 + 2], S[kb][4 * g4 + 3])};
    __syncthreads();
    bf16_t* Atw = At;
    {
      f32x16 A;
#pragma unroll
      for (int g = 0; g < 16; ++g) A[g] = 0.f;
      mma32(A, Qt, 136, Kt, 136, 128, lane);
#pragma unroll
      for (int g = 0; g < 16; ++g) { const int t = crow(g, h); Atw[t * 40 + r] = f2bf(r <= t ? A[g] : 0.f); }
    }
    __syncthreads();
    {
      f32x16 o;
#pragma unroll
      for (int g = 0; g < 16; ++g) o[g] = 0.f;
      mma32(o, Atw, 40, VT + 32 * w * 40, 40, 32, lane);
      mma32(o, Qt, 136, Sbw, 136, 128, lane);
#pragma unroll
      for (int g = 0; g < 16; ++g) {
        const int j = crow(g, h), pos = ch * 32 + j, t = d ? q.T - 1 - pos : pos;
        ZH[(size_t)(q.base + t) * ZHW + 512 * (1 + d) + 128 * hh + 32 * w + r] = f2bf(o[g]);
      }
#pragma unroll
      for (int kb = 0; kb < 4; ++kb) {
#pragma unroll
        for (int g = 0; g < 16; ++g) S[kb][g] *= dL[32 * kb + crow(g, h)];
        mma32(S[kb], KhT + 32 * kb * 40, 40, VT + 32 * w * 40, 40, 32, lane);
      }
    }
  }
  if (!q.sample) {
    float* dst = p.out + OUT_HG + ((((size_t)q.b * 2 + l) * 2 + d) * 4 + hh) * 16384;
#pragma unroll
    for (int kb = 0; kb < 4; ++kb)
#pragma unroll
      for (int g = 0; g < 16; ++g) dst[(size_t)(32 * kb + crow(g, h)) * 128 + 32 * w + r] = S[kb][g];
  }
}

DI void mlstm_item(const Params& p, int l, int s, int hh, int d, char* smem) {
  const Seq q = get_seq(s);
  const int tid = ltid(), lane = tid & 63, w = tid >> 6, r = lane & 31, h = lane >> 5;
  const bf16_t* ZM = (const bf16_t*)(p.ws + OFF_ZM);
  const float* MG = (const float*)(p.ws + OFF_MG);
  bf16_t* Hb = (bf16_t*)(p.ws + OFF_H);
  bf16_t* Qm = (bf16_t*)smem;
  bf16_t* Km = Qm + 32 * 136;
  bf16_t* KwT = Km + 32 * 136;
  bf16_t* VT = KwT + 128 * 40;
  bf16_t* Cb = VT + 128 * 40;
  bf16_t* Pt = Cb + 4 * 32 * 136;
  float* nv = (float*)(Pt + 32 * 40);
  float* sc = nv + 128;
  float* ig = sc; float* lf = sc + 32; float* gg = sc + 64; float* mtv = sc + 96; float* wi = sc + 128; float* wsr = sc + 160; float* qn = sc + 192; float* misc = sc + 224;
  float* dnw = sc + 232;
  const float gbi = p.in[I_GB][l * 16 + (2 * d) * 4 + hh], gbf = p.in[I_GB][l * 16 + (2 * d + 1) * 4 + hh];
  f32x16 C[4];
  float m;
  __syncthreads();
  if (q.sample) {
    const size_t sb = (((size_t)q.b * 2 + l) * 2 + d) * 4 + hh;
    const float* st = p.in[I_SC] + sb * 16384;
#pragma unroll
    for (int kb = 0; kb < 4; ++kb)
#pragma unroll
      for (int g = 0; g < 16; ++g) C[kb][g] = st[(size_t)(32 * kb + crow(g, h)) * 128 + 32 * w + r];
    if (tid < 128) nv[tid] = p.in[I_SN][sb * 128 + tid];
    m = p.in[I_SM][sb];
  } else {
#pragma unroll
    for (int kb = 0; kb < 4; ++kb)
#pragma unroll
      for (int g = 0; g < 16; ++g) C[kb][g] = 0.f;
    if (tid < 128) nv[tid] = 0.f;
    m = 0.f;
  }
  const int nch = q.T / 32;
  const int dd = tid & 127, half = tid >> 7;
  u16x2 pqk[16], pv2[8]; float pgi = 0.f, pgf = 0.f;
#define ML_ISSUE(chn) { _Pragma("unroll") for (int jj = 0; jj < 16; ++jj) { const int pos = (chn) * 32 + half * 16 + jj, t = d ? q.T - 1 - pos : pos; \
      const size_t rowo = (size_t)(q.base + t) * ZMW + 128 * hh + dd; pqk[jj][0] = ZM[rowo]; pqk[jj][1] = ZM[rowo + 512]; pv2[jj >> 1][jj & 1] = ZM[rowo + 1024]; } \
    if (tid < 32) { const int pos = (chn) * 32 + tid, t = d ? q.T - 1 - pos : pos; const float* mg = MG + (size_t)(q.base + t) * 16; pgi = mg[(2 * d) * 4 + hh]; pgf = mg[(2 * d + 1) * 4 + hh]; } }
#pragma unroll
  for (int kb = 0; kb < 4; ++kb) asm volatile("" : "+v"(C[kb]));
  asm volatile("" : "+v"(m));
  ML_ISSUE(0)
#pragma unroll 1
  for (int ch = 0; ch < nch; ++ch) {
    __syncthreads();
    {
#pragma unroll
      for (int jj = 0; jj < 16; ++jj) {
        const int j = half * 16 + jj;
        Qm[j * 136 + dd] = pqk[jj][0];
        Km[j * 136 + dd] = f2bf(bf2f(pqk[jj][1]) * 0.08838834764831845f);
      }
      *(u32x4*)(VT + dd * 40 + half * 16) = (u32x4){__builtin_bit_cast(unsigned, pv2[0]), __builtin_bit_cast(unsigned, pv2[1]), __builtin_bit_cast(unsigned, pv2[2]), __builtin_bit_cast(unsigned, pv2[3])};
      *(u32x4*)(VT + dd * 40 + half * 16 + 8) = (u32x4){__builtin_bit_cast(unsigned, pv2[4]), __builtin_bit_cast(unsigned, pv2[5]), __builtin_bit_cast(unsigned, pv2[6]), __builtin_bit_cast(unsigned, pv2[7])};
      if (tid < 32) {
        const float igv = pgi + gbi;
        const float lfv = -softplusf_(-(pgf + gbf));
        float g = lfv;
#pragma unroll
        for (int o = 1; o < 32; o <<= 1) { const float tt = shfl_lane(g, (lane - o) & 63); if (tid >= o) g += tt; }
        const float cs = igv - g;
        float pm = cs;
#pragma unroll
        for (int o = 1; o < 32; o <<= 1) { const float tt = shfl_lane(pm, (lane - o) & 63); if (tid >= o) pm = fmaxf(pm, tt); }
        const float mt = g + fmaxf(m, pm);
        const float gend = shfl_lane(g, 31), mn = shfl_lane(mt, 31);
        ig[tid] = igv; gg[tid] = g; mtv[tid] = mt; wi[tid] = __expf(g + m - mt);
        wsr[tid] = __expf(gend + cs - mn);
        if (tid == 0) { misc[0] = mn; misc[1] = __expf(gend + m - mn); }
      }
    }
    if (ch + 1 < nch) ML_ISSUE(ch + 1)
    __syncthreads();
    {
      {
        float kw[16];
#pragma unroll
        for (int jj = 0; jj < 16; ++jj) { const int j = half * 16 + jj; kw[jj] = bf2f(Km[j * 136 + dd]) * wsr[j]; }
        *(u32x4*)(KwT + dd * 40 + half * 16) = (u32x4){pk2(kw[0], kw[1]), pk2(kw[2], kw[3]), pk2(kw[4], kw[5]), pk2(kw[6], kw[7])};
        *(u32x4*)(KwT + dd * 40 + half * 16 + 8) = (u32x4){pk2(kw[8], kw[9]), pk2(kw[10], kw[11]), pk2(kw[12], kw[13]), pk2(kw[14], kw[15])};
      }
      const int j = tid >> 3, seg = tid & 7;
      float a = 0.f;
#pragma unroll
      for (int i = 0; i < 16; ++i) a += bf2f(Qm[j * 136 + seg * 16 + i]) * nv[seg * 16 + i];
      a += SHX(a, 1); a += SHX(a, 2); a += SHX(a, 4);
      if (seg == 0) qn[j] = a;
    }
    const float m_new = misc[0], carry = misc[1];
    bf16_t* Cbw = Cb + w * 32 * 136; bf16_t* Ptw = Pt;
#pragma unroll
    for (int kb = 0; kb < 4; ++kb)
#pragma unroll
      for (int g4 = 0; g4 < 4; ++g4) *(u32x2*)(Cbw + r * 136 + 32 * kb + crow(4 * g4, h)) = (u32x2){pk2(C[kb][4 * g4], C[kb][4 * g4 + 1]), pk2(C[kb][4 * g4 + 2], C[kb][4 * g4 + 3])};
    {
      f32x16 Sc;
#pragma unroll
      for (int g = 0; g < 16; ++g) Sc[g] = 0.f;
      mma32(Sc, Qm, 136, Km, 136, 128, lane);
      const float gs = gg[r], is = ig[r];
#pragma unroll
      for (int g = 0; g < 16; ++g) {
        const int t = crow(g, h);
        const float pv = (r <= t) ? __expf(gg[t] - gs + is - mtv[t]) * Sc[g] : 0.f;
        Ptw[t * 40 + r] = f2bf(pv);
      }
    }
    __syncthreads();
    if (lane < 32) {
      float a = 0.f;
#pragma unroll 4
      for (int i = 0; i < 32; ++i) a += bf2f(Ptw[lane * 40 + i]);
      const float den = wi[lane] * qn[lane] + a;
      dnw[lane] = 1.0f / fmaxf(fabsf(den), __expf(-mtv[lane]));
    }
    if (tid < 128) {
      float a = 0.f;
#pragma unroll 4
      for (int i = 0; i < 32; ++i) a += bf2f(KwT[tid * 40 + i]);
      nv[tid] = carry * nv[tid] + a;
    }
    __syncthreads();
    {
      f32x16 a1;
#pragma unroll
      for (int g = 0; g < 16; ++g) a1[g] = 0.f;
      mma32(a1, Qm, 136, Cbw, 136, 128, lane);
#pragma unroll
      for (int g = 0; g < 16; ++g) a1[g] *= wi[crow(g, h)];
      mma32(a1, Ptw, 40, VT + 32 * w * 40, 40, 32, lane);
#pragma unroll
      for (int g = 0; g < 16; ++g) {
        const int j = crow(g, h), pos = ch * 32 + j, t = d ? q.T - 1 - pos : pos;
        const float hv = a1[g] * dnw[j];
        Hb[(size_t)(q.base + t) * 1024 + d * 512 + 128 * hh + 32 * w + r] = f2bf(hv);
      }
#pragma unroll
      for (int kb = 0; kb < 4; ++kb) {
#pragma unroll
        for (int g = 0; g < 16; ++g) C[kb][g] *= carry;
        mma32(C[kb], KwT + 32 * kb * 40, 40, VT + 32 * w * 40, 40, 32, lane);
      }
    }
    m = m_new;
  }
  __syncthreads();
  if (!q.sample) {
    const size_t sb = (((size_t)q.b * 2 + l) * 2 + d) * 4 + hh;
    float* dst = p.out + OUT_C + sb * 16384;
#pragma unroll
    for (int kb = 0; kb < 4; ++kb)
#pragma unroll
      for (int g = 0; g < 16; ++g) dst[(size_t)(32 * kb + crow(g, h)) * 128 + 32 * w + r] = C[kb][g];
    if (tid < 128) p.out[OUT_N + sb * 128 + tid] = nv[tid];
    if (tid == 0) p.out[OUT_M + sb] = m;
  }
}

DI void phase_scan(const Params& p, int l, char* smem) {
  int* ctrL = (int*)(p.ws + OFF_CTR) + 2 * l;
  int* ctrS = ctrL + 1;
  int* sit = (int*)(smem + LDS_BYTES - 16);
  const int role = p.role;
  bool longDone = false, shortDone = false;
  for (;;) {
    const bool wantLong = (role == 0) ? !longDone : shortDone;
    if (longDone && shortDone) break;
    __syncthreads();
    if (ltid() == 0) *sit = atomicAdd(wantLong ? ctrL : ctrS, 1);
    __syncthreads();
    int it = __builtin_amdgcn_readfirstlane(*sit);
    int ty, s_, hh_, d_, rb_ = 0;
    if (wantLong) {
      if (it >= 128) { longDone = true; continue; }
      if (it < 64) { ty = 0; d_ = it & 1; hh_ = (it >> 1) & 7; s_ = 32 + (it >> 4); }
      else if (it < 96) { it -= 64; ty = 1; s_ = 32 + (it >> 3); hh_ = (it >> 1) & 3; d_ = it & 1; }
      else { it -= 96; ty = 2; s_ = 32 + (it >> 3); hh_ = (it >> 1) & 3; d_ = it & 1; }
    } else {
      if (it >= 1024) { shortDone = true; continue; }
      if (it < 512) { ty = 0; s_ = it >> 4; hh_ = (it >> 1) & 7; d_ = it & 1; }
      else if (it < 768) { it -= 512; ty = 1; s_ = it >> 3; hh_ = (it >> 1) & 3; d_ = it & 1; }
      else { it -= 768; ty = 2; s_ = it >> 3; hh_ = (it >> 1) & 3; d_ = it & 1; }
    }
    if (ty == 0) rwkv_item(p, l, s_, hh_, d_, smem);
    else if (ty == 1) hgrn_item(p, l, s_, hh_, d_, smem);
    else mlstm_item(p, l, s_, hh_, d_, smem);
  }
}

DI void phase_combine(const Params& p, int l, char* smem) {
  const int tid = ltid(), lane = tid & 63, w = tid >> 6;
  bf16_t* ZH = (bf16_t*)(p.ws + OFF_ZH); bf16_t* ZM = (bf16_t*)(p.ws + OFF_ZM); const bf16_t* ZR = (const bf16_t*)(p.ws + OFF_ZR);
  bf16_t* O = (bf16_t*)(p.ws + OFF_O); const bf16_t* Hb = (const bf16_t*)(p.ws + OFF_H);
  const float* mu = p.in[I_MU] + (size_t)l * 4 * ZRW;
  const float* g2 = p.in[I_G2] + (size_t)l * 128 * 512;
  float* sg = (float*)smem;
  float* gt = sg + 128 * 16;
  for (int blk = blockIdx.x; blk < NT / 16; blk += gridDim.x) {
    const int tok0 = blk * 16;
    int sidx, t0;
    if (tok0 < 8192) { sidx = tok0 >> 8; t0 = tok0 & 255; } else { sidx = 32 + ((tok0 - 8192) >> 11); t0 = (tok0 - 8192) & 2047; }
    const Seq q = get_seq(sidx);
    __syncthreads();
    { const int j = tid >> 4, rr0 = (tid & 15) * 8; float val[8]; bf16x8 pv[5]; rw_load8(ZR, q.base, t0 + j, q.T, q.grid, 1792 + rr0, pv); rw_apply8(pv, mu, q.grid, rw_valid(t0 + j, q.T, q.grid), 1792 + rr0, val);
#pragma unroll
      for (int e = 0; e < 8; ++e) sg[(rr0 + e) * 16 + j] = sigmoidf_(val[e]); }
    __syncthreads();
    {
      float a0[16], a1[16];
#pragma unroll
      for (int j = 0; j < 16; ++j) { a0[j] = 0.f; a1[j] = 0.f; }
#pragma unroll 1
      for (int r0 = 0; r0 < 128; r0 += 8) {
        float w0v[8], w1v[8];
#pragma unroll
        for (int q8 = 0; q8 < 8; ++q8) { w0v[q8] = g2[(r0 + q8) * 512 + tid]; w1v[q8] = g2[(r0 + q8) * 512 + 256 + tid]; }
#pragma unroll
        for (int q8 = 0; q8 < 8; ++q8) {
          const int rr = r0 + q8; const float w0 = w0v[q8], w1 = w1v[q8];
#pragma unroll
          for (int u = 0; u < 4; ++u) {
            f32x4 sv = *(const f32x4*)(sg + rr * 16 + 4 * u);
#pragma unroll
            for (int e = 0; e < 4; ++e) { a0[4 * u + e] += sv[e] * w0; a1[4 * u + e] += sv[e] * w1; }
          }
        }
      }
#pragma unroll
      for (int j = 0; j < 16; ++j) { gt[j * 512 + tid] = a0[j]; gt[j * 512 + 256 + tid] = a1[j]; }
    }
    __syncthreads();
#pragma unroll 1
    for (int jj = 0; jj < 4; ++jj) {
      const int j = w * 4 + jj, tok = tok0 + j, t = t0 + j; int c0 = lane * 8; asm volatile("" : "+v"(c0));
      {
        float o[8], rs[8], ks[8], vs[8];
        float sum = 0.f, bon = 0.f;
        {
          bf16x8 pr_[5], pk_[5], pv_[5];
          rw_load8(ZR, q.base, t, q.T, q.grid, c0, pr_); rw_load8(ZR, q.base, t, q.T, q.grid, 512 + c0, pk_); rw_load8(ZR, q.base, t, q.T, q.grid, 1024 + c0, pv_);
          const unsigned vd_ = rw_valid(t, q.T, q.grid);
          rw_apply8(pr_, mu, q.grid, vd_, c0, rs); rw_apply8(pk_, mu, q.grid, vd_, 512 + c0, ks); rw_apply8(pv_, mu, q.grid, vd_, 1024 + c0, vs);
        }
        const bf16x8 of = *(const bf16x8*)(O + (size_t)tok * 1024 + c0), ob = *(const bf16x8*)(O + (size_t)tok * 1024 + 512 + c0);
        const f32x4 rk0 = *(const f32x4*)(p.in[I_RK] + l * 512 + c0), rk1 = *(const f32x4*)(p.in[I_RK] + l * 512 + c0 + 4);
#pragma unroll
        for (int e = 0; e < 8; ++e) {
          o[e] = bf2f((bf16_t)of[e]) + bf2f((bf16_t)ob[e]);
          sum += o[e];
          bon += rs[e] * ks[e] * (e < 4 ? rk0[e & 3] : rk1[e & 3]);
        }
        sum += SHX(sum, 1); sum += SHX(sum, 2); sum += SHX(sum, 4);
        bon += SHX(bon, 1); bon += SHX(bon, 2); bon += SHX(bon, 4);
        const float mean = sum * (1.0f / 64.f);
        float var = 0.f;
#pragma unroll
        for (int e = 0; e < 8; ++e) { const float dv = o[e] - mean; var += dv * dv; }
        var += SHX(var, 1); var += SHX(var, 2); var += SHX(var, 4);
        const float rstd = rsqrtf(var * (1.0f / 64.f) + 64e-5f);
        const f32x4 lw0 = *(const f32x4*)(p.in[I_LN] + (l * 2 + 0) * 512 + c0), lw1 = *(const f32x4*)(p.in[I_LN] + (l * 2 + 0) * 512 + c0 + 4);
        const f32x4 lb0 = *(const f32x4*)(p.in[I_LN] + (l * 2 + 1) * 512 + c0), lb1 = *(const f32x4*)(p.in[I_LN] + (l * 2 + 1) * 512 + c0 + 4);
        const f32x4 gt0 = *(const f32x4*)(gt + j * 512 + c0), gt1 = *(const f32x4*)(gt + j * 512 + c0 + 4);
        bf16x8 ov;
#pragma unroll
        for (int e = 0; e < 8; ++e) {
          const float ln = (o[e] - mean) * rstd * (e < 4 ? lw0[e & 3] : lw1[e & 3]) + (e < 4 ? lb0[e & 3] : lb1[e & 3]);
          ov[e] = (short)f2bf((ln + bon * vs[e]) * (e < 4 ? gt0[e & 3] : gt1[e & 3]));
        }
        *(bf16x8*)(O + (size_t)tok * 1024 + c0) = ov;
      }
      {
        float o[8]; float ss = 0.f;
        bf16_t* zr_ = ZH + (size_t)tok * ZHW + c0;
        const bf16x8 of = *(const bf16x8*)(zr_ + 512), ob = *(const bf16x8*)(zr_ + 1024), hgv = *(const bf16x8*)(zr_ + 2048);
        const f32x4 nw0 = *(const f32x4*)(p.in[I_HNORM] + l * 512 + c0), nw1 = *(const f32x4*)(p.in[I_HNORM] + l * 512 + c0 + 4);
#pragma unroll
        for (int e = 0; e < 8; ++e) { o[e] = bf2f((bf16_t)of[e]) + bf2f((bf16_t)ob[e]); ss += o[e] * o[e]; }
        ss += SHX(ss, 1); ss += SHX(ss, 2); ss += SHX(ss, 4); ss += SHX(ss, 8);
        const float rsd = rsqrtf(ss * (1.0f / 128.f) + 1e-6f);
        bf16x8 ov;
#pragma unroll
        for (int e = 0; e < 8; ++e) ov[e] = (short)f2bf(o[e] * rsd * (e < 4 ? nw0[e & 3] : nw1[e & 3]) * siluf_(bf2f((bf16_t)hgv[e])));
        *(bf16x8*)(zr_ + 2048) = ov;
      }
      {
        float o[8]; float ss = 0.f;
        bf16_t* zm_ = ZM + (size_t)tok * ZMW + 1536 + c0;
        const bf16x8 of = *(const bf16x8*)(Hb + (size_t)tok * 1024 + c0), ob = *(const bf16x8*)(Hb + (size_t)tok * 1024 + 512 + c0), mov = *(const bf16x8*)zm_;
        const f32x4 nw0 = *(const f32x4*)(p.in[I_MNORM] + l * 512 + c0), nw1 = *(const f32x4*)(p.in[I_MNORM] + l * 512 + c0 + 4);
#pragma unroll
        for (int e = 0; e < 8; ++e) { o[e] = bf2f((bf16_t)of[e]) + bf2f((bf16_t)ob[e]); ss += o[e] * o[e]; }
        ss += SHX(ss, 1); ss += SHX(ss, 2); ss += SHX(ss, 4); ss += SHX(ss, 8);
        const float rsd = rsqrtf(ss * (1.0f / 128.f) + 1e-6f);
        bf16x8 ov;
#pragma unroll
        for (int e = 0; e < 8; ++e) ov[e] = (short)f2bf(o[e] * rsd * (e < 4 ? nw0[e & 3] : nw1[e & 3]) * sigmoidf_(bf2f((bf16_t)mov[e])));
        *(bf16x8*)zm_ = ov;
      }
    }
    __syncthreads();
#pragma unroll 1
    for (int jj = 0; jj < 4; ++jj) tok_one(p, l, 3, tok0 + w * 4 + jj, lane);
  }
}

#define XB_TMO      128
#define XB_XCNT(j)  (256  + 64 * (j))
#define XB_XSUB(j)  (1280 + 64 * (j))
#define XB_XGEN(j)  (2304 + 64 * (j))
#define XB_TOP      3328
#define XB_TOPGEN   3392
#define XCD_BAR_WORDS 3456
#define XB_SPIN_CAP (1u << 20)
#define LAS __attribute__((address_space(3)))
DI unsigned xb_ld(unsigned* p)              { return __hip_atomic_load(p, __ATOMIC_RELAXED, __HIP_MEMORY_SCOPE_AGENT); }
DI unsigned xb_add(unsigned* p, unsigned v) { return __hip_atomic_fetch_add(p, v, __ATOMIC_RELAXED, __HIP_MEMORY_SCOPE_AGENT); }
DI unsigned xb_xcc_id() { return (unsigned)__builtin_amdgcn_s_getreg((3 << 11) | 20) & 0xFu; }
#define XB_SPIN(cond, bar) do { unsigned _sp = 0; while (cond) { __builtin_amdgcn_s_sleep(1); \
    if ((++_sp & 255u) == 0u) { if (xb_ld(&(bar)[XB_TMO])) break; if (_sp > XB_SPIN_CAP) { atomicAdd(&(bar)[XB_TMO], 1u); break; } } } } while (0)
struct XcdBarrier { unsigned* bar; unsigned x; volatile LAS unsigned* st; };
DI XcdBarrier xcd_barrier_post(const Params& p, unsigned* bar, volatile LAS unsigned* st) {
  XcdBarrier b; b.bar = bar; b.x = xb_xcc_id(); b.st = st;
  if (ltid() == 0) (void)xb_add(&bar[XB_XCNT(b.x)], 1u);
  return b;
}
DI void xcd_barrier_complete(unsigned* bar, unsigned x, unsigned& nloc, unsigned& nx) {
  const unsigned G = gridDim.x * gridDim.y * gridDim.z;
  unsigned sum, cnt, mine, sp = 0u;
  for (;;) {
    sum = 0u; cnt = 0u; mine = 0u;
#pragma unroll
    for (unsigned j = 0; j < 16; ++j) { const unsigned c = xb_ld(&bar[XB_XCNT(j)]); sum += c; cnt += (c > 0u) ? 1u : 0u; mine = (j == x) ? c : mine; }
    if (sum == G) break;
    __builtin_amdgcn_s_sleep(1);
    if ((++sp & 255u) == 0u) { if (xb_ld(&bar[XB_TMO])) break; if (sp > XB_SPIN_CAP) { atomicAdd(&bar[XB_TMO], 1u); break; } }
  }
  nloc = mine > 0u ? mine : 1u; nx = cnt > 0u ? cnt : 1u;
}
DI void xcd_barrier(const Params& p, const XcdBarrier& b) {
  asm volatile("s_waitcnt vmcnt(0)" ::: "memory");
  __syncthreads();
  if (ltid() == 0) {
    unsigned* bar = b.bar;
    __builtin_amdgcn_s_waitcnt(0);
    unsigned nloc = b.st[0], nx = b.st[1];
    if (nloc == 0u) { xcd_barrier_complete(bar, b.x, nloc, nx); b.st[0] = nloc; b.st[1] = nx; }
    const unsigned old = xb_add(&bar[XB_XSUB(b.x)], 1u);
    const unsigned gen = old / nloc;
    if (old + 1u == (gen + 1u) * nloc) {
      __builtin_amdgcn_fence(__ATOMIC_RELEASE, "agent");
      asm volatile("s_waitcnt vmcnt(0)" ::: "memory");
      const unsigned og = xb_add(&bar[XB_TOP], 1u);
      const unsigned tg = og / nx;
      if (og + 1u == (tg + 1u) * nx) xb_add(&bar[XB_TOPGEN], 1u);
      else XB_SPIN(xb_ld(&bar[XB_TOPGEN]) == tg, bar);
      __builtin_amdgcn_fence(__ATOMIC_ACQUIRE, "agent");
      xb_add(&bar[XB_XGEN(b.x)], 1u);
      asm volatile("s_waitcnt vmcnt(0)" ::: "memory");
    } else {
      XB_SPIN(xb_ld(&bar[XB_XGEN(b.x)]) == gen, bar);
      __builtin_amdgcn_fence(__ATOMIC_ACQUIRE, "agent");
      asm volatile("s_waitcnt vmcnt(0)" ::: "memory");
    }
  }
  __syncthreads();
}

constexpr int NPHASE = 3 + 9 * 2;
DI void run_phase(const Params& p0, int ph, char* smem) {
  Params p = p0;
  asm volatile("" : "+s"(p.ws), "+s"(p.out));
  p.ws = as_global(p.ws); p.out = as_global(p.out);
  if (ph == 0) { phase0(p, smem); return; }
  if (ph == 1) { phase1(p); return; }
  if (ph == 2) { tok_phase(p, 0, 0); return; }
  const int l = (ph - 3) / 9, s = (ph - 3) % 9;
  switch (s) {
    case 0: phase_inproj(p, smem); break;
    case 1: phase_scan(p, l, smem); break;
    case 2: phase_combine(p, l, smem); break;
    case 3: phase_merge(p, l, smem); break;
    case 4: phase_gemm_f32(p, (const bf16_t*)(p.ws + OFF_MERGED), 1024, (const bf16_t*)(p.ws + OFF_WTOUT), smem); break;
    case 5: tok_phase(p, l, 1); break;
    case 6: phase_ffn_in(p, smem); break;
    case 7: phase_gemm_f32(p, (const bf16_t*)(p.ws + OFF_ACT), DFF, (const bf16_t*)(p.ws + OFF_WTFO), smem); break;
    case 8:
      tok_phase(p, l, 2);
      if (l + 1 < 2) {
        conv_weight(p, p.in[I_WIN] + (size_t)(l + 1) * 1024 * DIN, DIN, (bf16_t*)(p.ws + OFF_WTIN), 1024, WTIN_ROWS, 0, (float*)smem, blockIdx.x, gridDim.x);
        for (int br = 0; br < 3; ++br) conv_weight(p, p.in[I_WBR] + ((size_t)(l + 1) * 3 + br) * 512 * 1024, 1024, (bf16_t*)(p.ws + OFF_WTBR) + (size_t)br * 1024 * 512, 512, 1024, 1, (float*)smem, blockIdx.x, gridDim.x);
      }
      break;
  }
}

template <bool COOP>
__global__ void __launch_bounds__(NTHR, 2) mega(Params pk, int lo, int hi) {
  __shared__ __attribute__((aligned(16))) char smem[LDS_BYTES];
  Params p = pk;
#pragma unroll
  for (int i = 0; i < N_IN; ++i) p.in[i] = as_global(p.in[i]);
  p.ws = as_global(p.ws); p.out = as_global(p.out);
  p.wb = __builtin_amdgcn_readfirstlane((int)threadIdx.x) & ~63;
  if (COOP) {
    volatile LAS unsigned* st = (volatile LAS unsigned*)(smem + LDS_BYTES - 32);
    if (ltid() == 0) { st[0] = 0u; st[1] = 0u; }
    __syncthreads();
    phase0(p, smem);
    cg::this_grid().sync();
    XcdBarrier b = xcd_barrier_post(p, (unsigned*)(p.ws + OFF_BAR), st);
    if (ltid() == 0) {
      const unsigned hwid = (unsigned)__builtin_amdgcn_s_getreg((31 << 11) | 4);
      const unsigned key = (xb_xcc_id() << 8) | ((hwid >> 8) & 0xFFu);
      ((int*)smem)[(LDS_BYTES - 12) / 4] = (int)xb_add((unsigned*)(p.ws + OFF_ROLE) + key, 1u);
    }
    __syncthreads();
    p.role = __builtin_amdgcn_readfirstlane(((int*)smem)[(LDS_BYTES - 12) / 4]);
    for (int ph = 1; ph < hi; ++ph) {
      run_phase(p, ph, smem);
      if (ph + 1 < hi) xcd_barrier(p, b);
    }
  } else {
    for (int ph = lo; ph < hi; ++ph) run_phase(p, ph, smem);
  }
}

extern "C" void kernel_launch(void* const* d_in, const int* in_sizes, int n_in, void* d_out, int out_size, void* d_ws, size_t ws_size, hipStream_t stream) {
  Params p{};
  for (int i = 0; i < N_IN; ++i) p.in[i] = (const float*)d_in[i];
  p.out = (float*)d_out; p.ws = (char*)d_ws;
  if (ws_size < WS_NEED) fprintf(stderr, "workspace too small: %zu < %zu\n", ws_size, (size_t)WS_NEED);
  static int grid_blocks = 0;
  if (!grid_blocks) {
    int dev = 0, cus = 0, per_cu = 0;
    hipGetDevice(&dev);
    hipDeviceGetAttribute(&cus, hipDeviceAttributeMultiprocessorCount, dev);
    hipOccupancyMaxActiveBlocksPerMultiprocessor(&per_cu, mega<true>, NTHR, 0);
    if (per_cu > 2) per_cu = 2;
    grid_blocks = cus * per_cu;
  }
  int lo = 0, hi = NPHASE;
  void* args[] = {&p, &lo, &hi};
  hipError_t e = hipLaunchCooperativeKernel((void*)mega<true>, dim3(grid_blocks), dim3(NTHR), args, 0, stream);
  if (e != hipSuccess) fprintf(stderr, "cooperative launch failed: %s (grid %d)\n", hipGetErrorString(e), grid_blocks);
}
```

```cpp
#include <hip/hip_runtime.h>
#include <hip/hip_cooperative_groups.h>
#include <cstdio>
namespace cg = cooperative_groups;

typedef unsigned short bf16_t;
typedef short bf16x8 __attribute__((ext_vector_type(8)));
typedef float f32x4 __attribute__((ext_vector_type(4)));
typedef float f32x2 __attribute__((ext_vector_type(2)));
typedef float f32x16 __attribute__((ext_vector_type(16)));
typedef unsigned short u16x4 __attribute__((ext_vector_type(4)));
typedef unsigned short u16x2 __attribute__((ext_vector_type(2)));
typedef unsigned u32x4 __attribute__((ext_vector_type(4)));
typedef unsigned u32x2 __attribute__((ext_vector_type(2)));
static __device__ __forceinline__ unsigned pk2(float lo, float hi) { typedef __bf16 b2 __attribute__((ext_vector_type(2))); typedef float f2 __attribute__((ext_vector_type(2))); return __builtin_bit_cast(unsigned, __builtin_convertvector((f2){lo, hi}, b2)); }

#define DI __device__ __forceinline__
#define GAS __attribute__((address_space(1)))
template <class T> static __device__ __forceinline__ T* as_global(T* q) { return (T*)(GAS T*)(unsigned long long)q; }

constexpr int NT = 16384;
constexpr int DM = 1024;
constexpr int NTHR = 256;
constexpr int DIN = 9616;
constexpr int ZHW = 2560, ZRW = 1920, ZMW = 2048;
constexpr int WTIN_ROWS = 9728;
constexpr int DFF = 2816;

constexpr size_t OFF_WTIN = 0;
constexpr size_t OFF_WTBR = OFF_WTIN + (size_t)WTIN_ROWS * 1024 * 2;
constexpr size_t OFF_H    = OFF_WTBR + (size_t)3 * 1024 * 512 * 2;
constexpr size_t OFF_ZH   = OFF_H + (size_t)NT * 1024 * 2;
constexpr size_t OFF_ZR   = OFF_ZH + (size_t)NT * ZHW * 2;
constexpr size_t OFF_ZM   = OFF_ZR + (size_t)NT * ZRW * 2;
constexpr size_t OFF_MG   = OFF_ZM + (size_t)NT * ZMW * 2;
constexpr size_t OFF_O    = OFF_MG + (size_t)NT * 16 * 4;
constexpr size_t OFF_MOD  = OFF_O + (size_t)NT * 1024 * 2;
constexpr size_t OFF_LBS  = OFF_MOD + (size_t)2 * 5 * 6144 * 4;
constexpr size_t OFF_CTR  = OFF_LBS + 2 * 512 * 4;
constexpr size_t OFF_BAR  = OFF_CTR + 256;
constexpr size_t OFF_ROLE = OFF_BAR + 3456 * 4;
constexpr size_t WS_NEED  = OFF_ROLE + 4096 * 4;
constexpr size_t OFF_MODP = OFF_ZH;
constexpr size_t OFF_WTOUT = OFF_ZR;
constexpr size_t OFF_WTFI  = OFF_WTOUT + (size_t)1024 * 1024 * 2;
constexpr size_t OFF_WTFO  = OFF_WTFI + (size_t)5632 * 1024 * 2;
constexpr size_t OFF_MERGED = OFF_WTFO + (size_t)1024 * 2816 * 2;
constexpr size_t OFF_Y    = OFF_ZH;
constexpr size_t OFF_ACT  = OFF_ZM;

constexpr size_t OUT_HG = 16777216, OUT_RW = 25165824, OUT_C = 29360128, OUT_N = 37748736, OUT_M = 37814272;

enum { I_XP = 0, I_XS, I_SH, I_SR, I_SC, I_SN, I_SM, I_C, I_CCTX, I_WADA, I_BADA, I_NORMS, I_WIN, I_HLB, I_HNORM, I_MU, I_W0, I_W2,
       I_A0, I_A2, I_G2, I_KK, I_KA, I_RK, I_LN, I_GB, I_MNORM, I_WBR, I_WOUT, I_WFI, I_WFO, N_IN };

struct Params { const float* in[N_IN]; float* out; char* ws; int wb; int role; };

constexpr int LDS_BYTES = 77824;

DI bf16_t f2bf(float f) { return __builtin_bit_cast(unsigned short, (__bf16)f); }
DI float bf2f(bf16_t h) { return __uint_as_float(((unsigned)h) << 16); }
DI float sigmoidf_(float x) { return 1.0f / (1.0f + __expf(-x)); }
DI float siluf_(float x) { return x / (1.0f + __expf(-x)); }
DI float softplusf_(float x) { return x > 20.f ? x : __logf(1.0f + __expf(x)); }
DI float dpp_xor1(float x) { return __int_as_float(__builtin_amdgcn_mov_dpp(__float_as_int(x), 0xB1, 0xF, 0xF, true)); }
DI float dpp_xor2(float x) { return __int_as_float(__builtin_amdgcn_mov_dpp(__float_as_int(x), 0x4E, 0xF, 0xF, true)); }
DI float shfl_lane(float v, int src) { return __int_as_float(__builtin_amdgcn_ds_bpermute(src << 2, __float_as_int(v))); }
#define SHX(v, m) shfl_lane((v), lane ^ (m))
DI float wave_sum(float v, int lane) { v += dpp_xor1(v); v += dpp_xor2(v); v += SHX(v, 4); v += SHX(v, 8); v += SHX(v, 16); v += SHX(v, 32); return v; }
DI int ltid_(int wb) { int t = wb + (int)__builtin_amdgcn_mbcnt_hi(~0u, __builtin_amdgcn_mbcnt_lo(~0u, 0u)); asm volatile("" : "+v"(t)); return t; }
#define ltid() ltid_(p.wb)
DI int crow(int reg, int h) { return (reg & 3) + 8 * (reg >> 2) + 4 * h; }

DI int tok_cond(int tok) { return tok < 8192 ? 0 : 1 + ((tok - 8192) >> 11); }
DI const float* x_in_row(const Params& p, int tok) { return tok < 8192 ? p.in[I_XP] + (size_t)tok * DM : p.in[I_XS] + (size_t)(tok - 8192) * DM; }

DI void mma32(f32x16& acc, const bf16_t* A, int lda, const bf16_t* B, int ldb, int K, int lane) {
  const int r = lane & 31, h = lane >> 5;
#pragma unroll 2
  for (int kk = 0; kk < K; kk += 16) {
    bf16x8 a = *(const bf16x8*)(A + r * lda + kk + 8 * h);
    bf16x8 b = *(const bf16x8*)(B + r * ldb + kk + 8 * h);
    acc = __builtin_amdgcn_mfma_f32_32x32x16_bf16(a, b, acc, 0, 0, 0);
  }
}

template <int BM, int BN, int BK, bool WR, bool LD>
DI void gemm_ktile(f32x4 (&acc)[BM / 32][BN / 32], bf16x8 (&ra)[BM * BK / 2048], bf16x8 (&rb)[BN * BK / 2048],
                   const bf16_t* __restrict__ A, int lda, const bf16_t* __restrict__ B, int ldb, int k2,
                   const bf16_t* as, const bf16_t* bs, bf16_t* Aw, bf16_t* Bw) {
  constexpr int MI = BM / 32, NJ = BN / 32, LS = BK + 8, ACH = BM * BK / 2048, BCH = BN * BK / 2048, KS = BK / 32, RPI = 256 / (BK / 8);
  static_assert(KS * MI >= ACH + BCH, "not enough MFMA row blocks to carry the staging");
  __builtin_amdgcn_s_setprio(1);
#pragma unroll
  for (int ks = 0; ks < KS; ++ks) {
    bf16x8 afn = *(const bf16x8*)(as + ks * 32);
    bf16x8 bfr[NJ];
#pragma unroll
    for (int j = 0; j < NJ; ++j) bfr[j] = *(const bf16x8*)(bs + j * 16 * LS + ks * 32);
#pragma unroll
    for (int i = 0; i < MI; ++i) {
      const bf16x8 af = afn;
      if (i + 1 < MI) afn = *(const bf16x8*)(as + (i + 1) * 16 * LS + ks * 32);
#pragma unroll
      for (int j = 0; j < NJ; ++j) acc[i][j] = __builtin_amdgcn_mfma_f32_16x16x32_bf16(bfr[j], af, acc[i][j], 0, 0, 0);
      const int s = ks * MI + i;
      if (s < ACH) {
        if (WR) *(bf16x8*)(Aw + RPI * s * LS) = ra[s < ACH ? s : 0];
        if (LD) ra[s < ACH ? s : 0] = *(const bf16x8*)(A + (size_t)(RPI * s) * lda + k2);
      } else if (s < ACH + BCH) {
        const int c = s - ACH;
        if (WR) *(bf16x8*)(Bw + RPI * c * LS) = rb[(c >= 0 && c < BCH) ? c : 0];
        if (LD) rb[(c >= 0 && c < BCH) ? c : 0] = *(const bf16x8*)(B + (size_t)(RPI * c) * ldb + k2);
      }
      __builtin_amdgcn_sched_barrier(0);
    }
  }
  __builtin_amdgcn_s_setprio(0);
}

template <int BM, int BN, int BK>
DI void gemm_main(const Params& p, f32x4 (&acc)[BM / 32][BN / 32], bf16x8 (&ra)[BM * BK / 2048], bf16x8 (&rb)[BN * BK / 2048], bool primed,
                  const bf16_t* __restrict__ A, int lda, const bf16_t* __restrict__ B, int ldb, int K,
                  const bf16_t* __restrict__ An, int ldan, const bf16_t* __restrict__ Bn, int ldbn, bf16_t* sm) {
  constexpr int LS = BK + 8, CPR = BK / 8, ACH = BM * BK / 2048, BCH = BN * BK / 2048, RPI = 256 / CPR;
  const int tid = ltid(), lane = tid & 63, w = tid >> 6, wm = w >> 1, wn = w & 1;
  bf16_t* As = sm; bf16_t* Bs = sm + 2 * BM * LS;
  const int nk = K / BK;
  const int lrow = tid / CPR, lkc = (tid % CPR) * 8;
  const bf16_t* Ag = A + (size_t)lrow * lda + lkc;
  const bf16_t* Bg = B + (size_t)lrow * ldb + lkc;
  bf16_t* Al = As + lrow * LS + lkc; bf16_t* Bl = Bs + lrow * LS + lkc;
  if (!primed) {
#pragma unroll
    for (int i = 0; i < ACH; ++i) ra[i] = *(const bf16x8*)(Ag + (size_t)(RPI * i) * lda);
#pragma unroll
    for (int i = 0; i < BCH; ++i) rb[i] = *(const bf16x8*)(Bg + (size_t)(RPI * i) * ldb);
    __syncthreads();
#pragma unroll
    for (int i = 0; i < ACH; ++i) *(bf16x8*)(Al + RPI * i * LS) = ra[i];
#pragma unroll
    for (int i = 0; i < BCH; ++i) *(bf16x8*)(Bl + RPI * i * LS) = rb[i];
#pragma unroll
    for (int i = 0; i < ACH; ++i) ra[i] = *(const bf16x8*)(Ag + (size_t)(RPI * i) * lda + BK);
#pragma unroll
    for (int i = 0; i < BCH; ++i) rb[i] = *(const bf16x8*)(Bg + (size_t)(RPI * i) * ldb + BK);
    __syncthreads();
  }
  const bf16_t* as0 = As + (wm * (BM / 2) + (lane & 15)) * LS + (lane >> 4) * 8;
  const bf16_t* bs0 = Bs + (wn * (BN / 2) + (lane & 15)) * LS + (lane >> 4) * 8;
  int kt = 0;
  for (; kt + 2 < nk; ++kt) {
    const int buf = kt & 1, nb = buf ^ 1;
    gemm_ktile<BM, BN, BK, true, true>(acc, ra, rb, Ag, lda, Bg, ldb, (kt + 2) * BK, as0 + buf * BM * LS, bs0 + buf * BN * LS, Al + nb * BM * LS, Bl + nb * BN * LS);
    __syncthreads();
  }
  {
    const bf16_t* Agn = An + (size_t)lrow * ldan + lkc;
    const bf16_t* Bgn = Bn + (size_t)lrow * ldbn + lkc;
    gemm_ktile<BM, BN, BK, true, true>(acc, ra, rb, Agn, ldan, Bgn, ldbn, 0, as0, bs0, Al + BM * LS, Bl + BN * LS);
    __syncthreads();
    gemm_ktile<BM, BN, BK, true, true>(acc, ra, rb, Agn, ldan, Bgn, ldbn, BK, as0 + BM * LS, bs0 + BN * LS, Al, Bl);
    __syncthreads();
  }
}

template <int MI, int NJ> DI void zero_acc(f32x4 (&acc)[MI][NJ]) {
#pragma unroll
  for (int i = 0; i < MI; ++i)
#pragma unroll
    for (int j = 0; j < NJ; ++j) acc[i][j] = (f32x4){0.f, 0.f, 0.f, 0.f};
}
DI void store_bf4(bf16_t* dst, f32x4 v) { u16x4 o; o[0] = f2bf(v[0]); o[1] = f2bf(v[1]); o[2] = f2bf(v[2]); o[3] = f2bf(v[3]); *(u16x4*)dst = o; }

DI int map_col(int mode, int n) {
  if (mode == 0) return n < 6544 ? n : (n < 6656 ? -1 : n - 112);
  if (mode == 2) return ((n >> 4) & 1) ? DFF + (n >> 5) * 16 + (n & 15) : (n >> 5) * 16 + (n & 15);
  return n;
}
DI void conv_tile(const Params& p, const float* __restrict__ src, int ld_src, bf16_t* __restrict__ dst, int K, int mode, int tk, int tn, float* sm) {
  const int tid = ltid();
  __syncthreads();
  {
    const int nn = tid & 63, col = map_col(mode, tn * 64 + nn);
#pragma unroll
    for (int i = 0; i < 16; ++i) { int kk = (tid >> 6) + 4 * i; sm[kk * 65 + nn] = col >= 0 ? src[(size_t)(tk * 64 + kk) * ld_src + col] : 0.f; }
  }
  __syncthreads();
  {
    const int kk = tid & 63;
#pragma unroll
    for (int i = 0; i < 16; ++i) { int nn = (tid >> 6) + 4 * i; dst[(size_t)(tn * 64 + nn) * K + tk * 64 + kk] = f2bf(sm[kk * 65 + nn]); }
  }
}
DI void conv_weight(const Params& p, const float* src, int ld_src, bf16_t* dst, int K, int Ndst, int mode, float* sm, int bid, int nb) {
  const int tkn = K / 64, nt = tkn * (Ndst / 64);
  for (int t = bid; t < nt; t += nb) conv_tile(p, src, ld_src, dst, K, mode, t % tkn, t / tkn, sm);
}

DI void phase0(const Params& p, char* smem) {
  const int tid = ltid(), bid = blockIdx.x, nb = gridDim.x;
  float* MODP = (float*)(p.ws + OFF_MODP);
  float* sm = (float*)smem;
  if (bid == 0) { if (tid < 64) ((int*)(p.ws + OFF_CTR))[tid] = 0; for (int i = tid; i < 3456; i += NTHR) ((unsigned*)(p.ws + OFF_BAR))[i] = 0u; for (int i = tid; i < 4096; i += NTHR) ((unsigned*)(p.ws + OFF_ROLE))[i] = 0u; }
  for (int i = bid * NTHR + tid; i < 512; i += nb * NTHR) {
    float a = p.in[I_HLB][i], b = p.in[I_HLB][512 + i];
    float* L = (float*)(p.ws + OFF_LBS); L[i] = 0.f; L[512 + i] = 1.0f / (1.0f + expf(a - b));
  }
  for (int it = bid; it < 2 * 24 * 16; it += nb) {
    const int ks = it & 15, jb = (it >> 4) % 24, l = it / (16 * 24);
    __syncthreads();
    for (int e = tid; e < 5 * 64; e += NTHR) { int ci = e >> 6, k = ks * 64 + (e & 63); float cv = ci == 0 ? p.in[I_CCTX][k] : p.in[I_C][(ci - 1) * DM + k]; sm[e] = siluf_(cv); }
    __syncthreads();
    const int j = jb * 256 + tid;
    float a0 = 0, a1 = 0, a2 = 0, a3 = 0, a4 = 0;
    const float* W = p.in[I_WADA] + ((size_t)l * DM + ks * 64) * 6144 + j;
#pragma unroll 1
    for (int k0 = 0; k0 < 64; k0 += 16) {
      float wv[16];
#pragma unroll
      for (int u = 0; u < 16; ++u) wv[u] = W[(size_t)(k0 + u) * 6144];
#pragma unroll
      for (int u = 0; u < 16; ++u) { const int k = k0 + u; const float w = wv[u]; a0 += sm[k] * w; a1 += sm[64 + k] * w; a2 += sm[128 + k] * w; a3 += sm[192 + k] * w; a4 += sm[256 + k] * w; }
    }
    float* dst = MODP + ((size_t)(ks * 2 + l) * 5) * 6144 + j;
    dst[0] = a0; dst[6144] = a1; dst[2 * 6144] = a2; dst[3 * 6144] = a3; dst[4 * 6144] = a4;
  }
  conv_weight(p, p.in[I_WIN], DIN, (bf16_t*)(p.ws + OFF_WTIN), 1024, WTIN_ROWS, 0, sm, bid, nb);
  for (int br = 0; br < 3; ++br) conv_weight(p, p.in[I_WBR] + (size_t)br * 512 * 1024, 1024, (bf16_t*)(p.ws + OFF_WTBR) + (size_t)br * 1024 * 512, 512, 1024, 1, sm, bid, nb);
}
DI void phase1(const Params& p) {
  const float* MODP = (const float*)(p.ws + OFF_MODP);
  float* MOD = (float*)(p.ws + OFF_MOD);
  for (int i = blockIdx.x * NTHR + ltid(); i < 2 * 5 * 6144; i += gridDim.x * NTHR) {
    const int j = i % 6144, l = i / (5 * 6144);
    float s = p.in[I_BADA][l * 6144 + j];
    for (int ks = 0; ks < 16; ++ks) s += MODP[(size_t)ks * 2 * 5 * 6144 + i];
    MOD[i] = s;
  }
}

DI void norm_mod_store(const f32x4 (&x)[4], const float* nw, const float* sc, const float* sh, bf16_t* hrow, int lane) {
  float ss = 0.f;
#pragma unroll
  for (int i = 0; i < 4; ++i) ss += x[i][0] * x[i][0] + x[i][1] * x[i][1] + x[i][2] * x[i][2] + x[i][3] * x[i][3];
  ss = wave_sum(ss, lane);
  const float rs = rsqrtf(ss * (1.0f / DM) + 1e-6f);
#pragma unroll
  for (int i = 0; i < 4; ++i) {
    const int c = i * 256 + lane * 4;
    f32x4 w = *(const f32x4*)(nw + c), s1 = *(const f32x4*)(sc + c), s0 = *(const f32x4*)(sh + c), o;
#pragma unroll
    for (int e = 0; e < 4; ++e) o[e] = x[i][e] * rs * w[e] * (1.0f + s1[e]) + s0[e];
    store_bf4(hrow + c, o);
  }
}
DI void tok_one(const Params& p, int l, int mode, int tok, int lane) {
  const float* MOD = (const float*)(p.ws + OFF_MOD);
  bf16_t* H = (bf16_t*)(p.ws + OFF_H);
  const float* Y = (const float*)(p.ws + OFF_Y);
  const int ci = tok_cond(tok);
  const float* modl = MOD + (size_t)(l * 5 + ci) * 6144;
  const float* nwl = p.in[I_NORMS] + (size_t)l * 4 * DM;
  const bool from_in = (l == 0 && (mode == 0 || mode == 1 || mode == 3));
  const float* xr = from_in ? x_in_row(p, tok) : p.out + (size_t)tok * DM;
  const bool has_y = (mode == 1 || mode == 2);
  const bool has_h = !(mode == 2 && l + 1 >= 2);
  const float* modn = (mode == 2 && has_h) ? MOD + (size_t)((l + 1) * 5 + ci) * 6144 : modl;
  const float* nw2 = mode == 1 ? nwl + 2 * DM : (mode == 2 ? p.in[I_NORMS] + (size_t)(has_h ? l + 1 : l) * 4 * DM : nwl);
  const float* sc2 = mode == 1 ? modl + 4 * DM : modn + 1 * DM;
  const float* sh2 = mode == 1 ? modl + 3 * DM : modn + 0 * DM;
  const float* nwy = nwl + (mode == 1 ? 1 : 3) * DM;
  const float* gy = modl + (mode == 1 ? 2 : 5) * DM;
  f32x4 x[4], y[4], wy[4], gg[4], w2[4], s1[4], s0[4];
#pragma unroll
  for (int i = 0; i < 4; ++i) {
    const int c = i * 256 + lane * 4;
    x[i] = *(const f32x4*)(xr + c);
    if (has_y) { y[i] = *(const f32x4*)(Y + (size_t)tok * DM + c); wy[i] = *(const f32x4*)(nwy + c); gg[i] = *(const f32x4*)(gy + c); }
    if (has_h) { w2[i] = *(const f32x4*)(nw2 + c); s1[i] = *(const f32x4*)(sc2 + c); s0[i] = *(const f32x4*)(sh2 + c); }
  }
  if (has_y) {
    float ss = 0.f;
#pragma unroll
    for (int i = 0; i < 4; ++i) ss += y[i][0] * y[i][0] + y[i][1] * y[i][1] + y[i][2] * y[i][2] + y[i][3] * y[i][3];
    ss = wave_sum(ss, lane);
    const float rs = rsqrtf(ss * (1.0f / DM) + 1e-6f);
#pragma unroll
    for (int i = 0; i < 4; ++i) {
      const int c = i * 256 + lane * 4;
#pragma unroll
      for (int e = 0; e < 4; ++e) x[i][e] += gg[i][e] * (y[i][e] * rs * wy[i][e]);
      *(f32x4*)(p.out + (size_t)tok * DM + c) = x[i];
    }
  }
  if (has_h) {
    float ss = 0.f;
#pragma unroll
    for (int i = 0; i < 4; ++i) ss += x[i][0] * x[i][0] + x[i][1] * x[i][1] + x[i][2] * x[i][2] + x[i][3] * x[i][3];
    ss = wave_sum(ss, lane);
    const float rs = rsqrtf(ss * (1.0f / DM) + 1e-6f);
#pragma unroll
    for (int i = 0; i < 4; ++i) {
      f32x4 o;
#pragma unroll
      for (int e = 0; e < 4; ++e) o[e] = x[i][e] * rs * w2[i][e] * (1.0f + s1[i][e]) + s0[i][e];
      store_bf4(H + (size_t)tok * DM + i * 256 + lane * 4, o);
    }
  }
}
DI void tok_phase(const Params& p, int l, int mode) {
  const int lane = ltid() & 63, gw = blockIdx.x * 4 + (ltid() >> 6), nw = gridDim.x * 4;
  for (int tok = gw; tok < NT; tok += nw) tok_one(p, l, mode, tok, lane);
}

DI bool tile_xcd(int i, int NTN, int MTX, int& mt, int& nt) {
  const int G = gridDim.x, b = blockIdx.x, x = b & 7, j = b >> 3, nbx = (G - x + 7) >> 3;
  const int u = j + i * nbx;
  if (u >= MTX * NTN) return false;
  mt = MTX * x + (u % MTX); nt = u / MTX;
  return true;
}
DI void phase_inproj(const Params& p, char* smem) {
  const bf16_t* H = (const bf16_t*)(p.ws + OFF_H);
  const bf16_t* WT = (const bf16_t*)(p.ws + OFF_WTIN);
  bf16_t* ZH = (bf16_t*)(p.ws + OFF_ZH); bf16_t* ZR = (bf16_t*)(p.ws + OFF_ZR); bf16_t* ZM = (bf16_t*)(p.ws + OFF_ZM);
  float* MG = (float*)(p.ws + OFF_MG);
  bf16x8 ra[4], rb[2]; bool primed = false;
  int mt, nt; bool have = tile_xcd(0, 52, 8, mt, nt);
  for (int ti = 0; have; ++ti) {
    int mtn = 0, ntn = 0; const bool haven = tile_xcd(ti + 1, 52, 8, mtn, ntn);
    f32x4 acc[8][4]; zero_acc<8, 4>(acc);
    gemm_main<256, 128, 32>(p, acc, ra, rb, primed, H + (size_t)mt * 256 * 1024, 1024, WT + (size_t)nt * 128 * 1024, 1024, 1024,
                            H + (size_t)(haven ? mtn : mt) * 256 * 1024, 1024, WT + (size_t)(haven ? ntn : nt) * 128 * 1024, 1024, (bf16_t*)smem);
    primed = haven;
    const int lane = ltid() & 63, w = ltid() >> 6, wm = w >> 1, wn = w & 1; (void)wm; (void)wn;
    const int n0 = nt * 128;
#pragma unroll
    for (int i = 0; i < 8; ++i) {
      asm volatile("" ::: "memory");
      const int row = mt * 256 + wm * 128 + i * 16 + (lane & 15);
#pragma unroll
      for (int j = 0; j < 4; ++j) {
        const int col = n0 + wn * 64 + j * 16 + 4 * (lane >> 4);
        if (n0 < 2560) store_bf4(ZH + (size_t)row * ZHW + col, acc[i][j]);
        else if (n0 < 4480) store_bf4(ZR + (size_t)row * ZRW + (col - 2560), acc[i][j]);
        else if (n0 < 6528) store_bf4(ZM + (size_t)row * ZMW + (col - 4480), acc[i][j]);
        else if (col - 6528 < 16) *(f32x4*)(MG + (size_t)row * 16 + (col - 6528)) = acc[i][j];
      }
    }
    mt = mtn; nt = ntn; have = haven;
  }
}

DI void merge_sub(const Params& p, int mt, int nt, int s, const bf16_t*& A_, int& lda_, const bf16_t*& B_, int& ldb_, int& K_) {
  const bf16_t* H = (const bf16_t*)(p.ws + OFF_H);
  const bf16_t* WT = (const bf16_t*)(p.ws + OFF_WTIN);
  const bf16_t* WBR = (const bf16_t*)(p.ws + OFF_WTBR);
  const bf16_t* ZH = (const bf16_t*)(p.ws + OFF_ZH); const bf16_t* ZM = (const bf16_t*)(p.ws + OFF_ZM); const bf16_t* O = (const bf16_t*)(p.ws + OFF_O);
  const int br = s >> 1;
  if (!(s & 1)) { A_ = H + (size_t)mt * 128 * 1024; lda_ = 1024; B_ = WT + (size_t)(6656 + br * 1024 + nt * 128) * 1024; ldb_ = 1024; K_ = 1024; }
  else {
    const bf16_t* Ab; int lda;
    if (br == 0) { Ab = ZH + 2048; lda = ZHW; } else if (br == 1) { Ab = O; lda = 1024; } else { Ab = ZM + 1536; lda = ZMW; }
    A_ = Ab + (size_t)mt * 128 * lda; lda_ = lda; B_ = WBR + ((size_t)br * 1024 + nt * 128) * 512; ldb_ = 512; K_ = 512;
  }
}
DI void phase_merge(const Params& p, int l, char* smem) {
  bf16_t* MER = (bf16_t*)(p.ws + OFF_MERGED);
  unsigned* gsc = (unsigned*)(smem + 40960);
  bf16x8 ra[2], rb[2]; bool primed = false;
  int mt, nt; bool have = tile_xcd(0, 8, 16, mt, nt);
  for (int ti = 0; have; ++ti) {
    int mtn = 0, ntn = 0; const bool haven = tile_xcd(ti + 1, 8, 16, mtn, ntn);
    f32x4 accM[4][4]; zero_acc<4, 4>(accM);
#pragma unroll 1
    for (int br = 0; br < 3; ++br) {
      f32x4 acc[4][4]; zero_acc<4, 4>(acc);
      const bf16_t *A0, *B0, *A1, *B1, *A2, *B2; int la0, lb0, k0, la1, lb1, k1, la2, lb2, k2;
      merge_sub(p, mt, nt, 2 * br, A0, la0, B0, lb0, k0);
      merge_sub(p, mt, nt, 2 * br + 1, A1, la1, B1, lb1, k1);
      const bool more = (br < 2) || haven;
      if (br < 2) merge_sub(p, mt, nt, 2 * br + 2, A2, la2, B2, lb2, k2); else merge_sub(p, haven ? mtn : mt, haven ? ntn : nt, 0, A2, la2, B2, lb2, k2);
      gemm_main<128, 128, 32>(p, acc, ra, rb, primed, A0, la0, B0, lb0, k0, A1, la1, B1, lb1, (bf16_t*)smem);
      {
        const int tid_ = ltid();
#pragma unroll
        for (int i = 0; i < 4; ++i)
#pragma unroll
          for (int j = 0; j < 4; ++j) {
            gsc[((i * 4 + j) * 2 + 0) * 256 + tid_] = pk2(sigmoidf_(acc[i][j][0]), sigmoidf_(acc[i][j][1]));
            gsc[((i * 4 + j) * 2 + 1) * 256 + tid_] = pk2(sigmoidf_(acc[i][j][2]), sigmoidf_(acc[i][j][3]));
            acc[i][j] = (f32x4){0.f, 0.f, 0.f, 0.f};
          }
      }
      gemm_main<128, 128, 32>(p, acc, ra, rb, true, A1, la1, B1, lb1, k1, A2, la2, B2, lb2, (bf16_t*)smem);
      primed = more;
      {
        const int tid_ = ltid();
#pragma unroll
        for (int i = 0; i < 4; ++i)
#pragma unroll
          for (int j = 0; j < 4; ++j) {
            const unsigned g0 = gsc[((i * 4 + j) * 2 + 0) * 256 + tid_], g1 = gsc[((i * 4 + j) * 2 + 1) * 256 + tid_];
            accM[i][j][0] += __uint_as_float(g0 << 16) * acc[i][j][0]; accM[i][j][1] += __uint_as_float(g0 & 0xffff0000u) * acc[i][j][1];
            accM[i][j][2] += __uint_as_float(g1 << 16) * acc[i][j][2]; accM[i][j][3] += __uint_as_float(g1 & 0xffff0000u) * acc[i][j][3];
          }
      }
    }
    const int lane = ltid() & 63, w = ltid() >> 6, wm = w >> 1, wn = w & 1;
#pragma unroll
    for (int i = 0; i < 4; ++i) {
      const int row = mt * 128 + wm * 64 + i * 16 + (lane & 15);
#pragma unroll
      for (int j = 0; j < 4; ++j) store_bf4(MER + (size_t)row * 1024 + nt * 128 + wn * 64 + j * 16 + 4 * (lane >> 4), accM[i][j]);
    }
    mt = mtn; nt = ntn; have = haven;
  }
  float* sm = (float*)smem;
  conv_weight(p, p.in[I_WOUT] + (size_t)l * 1024 * 1024, 1024, (bf16_t*)(p.ws + OFF_WTOUT), 1024, 1024, 1, sm, blockIdx.x, gridDim.x);
  conv_weight(p, p.in[I_WFI] + (size_t)l * 1024 * 5632, 5632, (bf16_t*)(p.ws + OFF_WTFI), 1024, 5632, 2, sm, blockIdx.x, gridDim.x);
  conv_weight(p, p.in[I_WFO] + (size_t)l * DFF * 1024, 1024, (bf16_t*)(p.ws + OFF_WTFO), DFF, 1024, 1, sm, blockIdx.x, gridDim.x);
}

DI void phase_gemm_f32(const Params& p, const bf16_t* A, int K, const bf16_t* Wt, char* smem) {
  float* Y = (float*)(p.ws + OFF_Y);
  bf16x8 ra[4], rb[2]; bool primed = false;
  int mt, nt; bool have = tile_xcd(0, 8, 8, mt, nt);
  for (int ti = 0; have; ++ti) {
    int mtn = 0, ntn = 0; const bool haven = tile_xcd(ti + 1, 8, 8, mtn, ntn);
    f32x4 acc[8][4]; zero_acc<8, 4>(acc);
    gemm_main<256, 128, 32>(p, acc, ra, rb, primed, A + (size_t)mt * 256 * K, K, Wt + (size_t)nt * 128 * K, K, K,
                            A + (size_t)(haven ? mtn : mt) * 256 * K, K, Wt + (size_t)(haven ? ntn : nt) * 128 * K, K, (bf16_t*)smem);
    primed = haven;
    const int lane = ltid() & 63, w = ltid() >> 6, wm = w >> 1, wn = w & 1; (void)wm; (void)wn;
#pragma unroll
    for (int i = 0; i < 8; ++i) {
      asm volatile("" ::: "memory");
      const int row = mt * 256 + wm * 128 + i * 16 + (lane & 15);
#pragma unroll
      for (int j = 0; j < 4; ++j) *(f32x4*)(Y + (size_t)row * 1024 + nt * 128 + wn * 64 + j * 16 + 4 * (lane >> 4)) = acc[i][j];
    }
    mt = mtn; nt = ntn; have = haven;
  }
}
DI void phase_ffn_in(const Params& p, char* smem) {
  const bf16_t* H = (const bf16_t*)(p.ws + OFF_H);
  const bf16_t* Wt = (const bf16_t*)(p.ws + OFF_WTFI);
  bf16_t* ACT = (bf16_t*)(p.ws + OFF_ACT);
  bf16x8 ra[4], rb[2]; bool primed = false;
  int mt, nt; bool have = tile_xcd(0, 44, 8, mt, nt);
  for (int ti = 0; have; ++ti) {
    int mtn = 0, ntn = 0; const bool haven = tile_xcd(ti + 1, 44, 8, mtn, ntn);
    f32x4 acc[8][4]; zero_acc<8, 4>(acc);
    gemm_main<256, 128, 32>(p, acc, ra, rb, primed, H + (size_t)mt * 256 * 1024, 1024, Wt + (size_t)nt * 128 * 1024, 1024, 1024,
                            H + (size_t)(haven ? mtn : mt) * 256 * 1024, 1024, Wt + (size_t)(haven ? ntn : nt) * 128 * 1024, 1024, (bf16_t*)smem);
    primed = haven;
    const int lane = ltid() & 63, w = ltid() >> 6, wm = w >> 1, wn = w & 1; (void)wm; (void)wn;
#pragma unroll
    for (int i = 0; i < 8; ++i) {
      asm volatile("" ::: "memory");
      const int row = mt * 256 + wm * 128 + i * 16 + (lane & 15);
#pragma unroll
      for (int jj = 0; jj < 2; ++jj) {
        f32x4 u = acc[i][2 * jj], g = acc[i][2 * jj + 1], o;
#pragma unroll
        for (int e = 0; e < 4; ++e) o[e] = siluf_(g[e]) * u[e];
        const int col = (nt * 128 + wn * 64 + jj * 32) / 2 + 4 * (lane >> 4);
        store_bf4(ACT + (size_t)row * DFF + col, o);
      }
    }
    mt = mtn; nt = ntn; have = haven;
  }
}

struct Seq { int base, T, grid, b; bool sample; };
DI Seq get_seq(int s) { Seq q; if (s < 32) { q.base = s * 256; q.T = 256; q.grid = 0; q.b = s; q.sample = false; } else { q.b = s - 32; q.base = 8192 + q.b * 2048; q.T = 2048; q.grid = 1; q.sample = true; } return q; }

DI float rw_shift(const bf16_t* ZR, const float* mu, int base, int t, int T, int grid, int col) {
  const bf16_t* pp = ZR + (size_t)(base + t) * ZRW + col;
  const float y = bf2f(*pp);
  if (!grid) {
    const float prev = t > 0 ? bf2f(pp[-ZRW]) : 0.f, nxt = t < T - 1 ? bf2f(pp[ZRW]) : 0.f;
    return y + mu[col] * (prev - y) + mu[ZRW + col] * (nxt - y);
  }
  const int gc = t & 63, gr = t >> 6;
  const float left = gc > 0 ? bf2f(pp[-ZRW]) : 0.f, right = gc < 63 ? bf2f(pp[ZRW]) : 0.f;
  const float up = gr > 0 ? bf2f(pp[-64 * ZRW]) : 0.f, down = gr < 31 ? bf2f(pp[64 * ZRW]) : 0.f;
  return y + mu[col] * (left - y) + mu[ZRW + col] * (right - y) + mu[2 * ZRW + col] * (up - y) + mu[3 * ZRW + col] * (down - y);
}

DI void rw_shift8(const bf16_t* ZR, const float* mu, int base, int t, int T, int grid, int col0, float (&out)[8]) {
  const bf16_t* pp = ZR + (size_t)(base + t) * ZRW + col0;
  const bf16x8 y = *(const bf16x8*)pp;
  float yv[8];
#pragma unroll
  for (int e = 0; e < 8; ++e) { yv[e] = bf2f((bf16_t)y[e]); out[e] = yv[e]; }
  const int nn = grid ? 4 : 2;
#pragma unroll 1
  for (int n = 0; n < nn; ++n) {
    bool valid; int off;
    if (!grid) { valid = n == 0 ? t > 0 : t < T - 1; off = n == 0 ? -ZRW : ZRW; }
    else { const int gc = t & 63, gr = t >> 6; valid = n == 0 ? gc > 0 : n == 1 ? gc < 63 : n == 2 ? gr > 0 : gr < 31; off = n == 0 ? -ZRW : n == 1 ? ZRW : n == 2 ? -64 * ZRW : 64 * ZRW; }
    const f32x4 m0 = *(const f32x4*)(mu + n * ZRW + col0), m1 = *(const f32x4*)(mu + n * ZRW + col0 + 4);
    bf16x8 nb = y;
    if (valid) nb = *(const bf16x8*)(pp + off);
#pragma unroll
    for (int e = 0; e < 8; ++e) { const float nv_ = valid ? bf2f((bf16_t)nb[e]) : 0.f; const float mm = e < 4 ? m0[e & 3] : m1[e & 3]; out[e] += mm * (nv_ - yv[e]); }
  }
}

DI void rw_load8(const bf16_t* ZR, int base, int t, int T, int grid, int col0, bf16x8 (&v)[5]) {
  const bf16_t* pp = ZR + (size_t)(base + t) * ZRW + col0;
  const int gc = t & 63, gr = t >> 6;
  const int o1 = grid ? (gc > 0 ? -ZRW : 0) : (t > 0 ? -ZRW : 0);
  const int o2 = grid ? (gc < 63 ? ZRW : 0) : (t < T - 1 ? ZRW : 0);
  v[0] = *(const bf16x8*)pp;
  v[1] = *(const bf16x8*)(pp + o1);
  v[2] = *(const bf16x8*)(pp + o2);
  if (grid) {
    v[3] = *(const bf16x8*)(pp + (gr > 0 ? -64 * ZRW : 0)); v[4] = *(const bf16x8*)(pp + (gr < 31 ? 64 * ZRW : 0));
  } else {
    v[3] = (bf16x8){0, 0, 0, 0, 0, 0, 0, 0}; v[4] = (bf16x8){0, 0, 0, 0, 0, 0, 0, 0};
  }
}
DI unsigned rw_valid(int t, int T, int grid) {
  if (!grid) return (t > 0 ? 1u : 0u) | (t < T - 1 ? 2u : 0u);
  const int gc = t & 63, gr = t >> 6;
  return (gc > 0 ? 1u : 0u) | (gc < 63 ? 2u : 0u) | (gr > 0 ? 4u : 0u) | (gr < 31 ? 8u : 0u);
}
DI void rw_apply8(const bf16x8 (&v)[5], const float* mu, int grid, unsigned valid, int col0, float (&out)[8]) {
  float yv[8];
#pragma unroll
  for (int e = 0; e < 8; ++e) { yv[e] = bf2f((bf16_t)v[0][e]); out[e] = yv[e]; }
#pragma unroll
  for (int n = 0; n < 4; ++n) {
    if (n < 2 || grid) {
      const f32x4 m0 = *(const f32x4*)(mu + n * ZRW + col0), m1 = *(const f32x4*)(mu + n * ZRW + col0 + 4);
      const bool ok = (valid >> n) & 1u;
#pragma unroll
      for (int e = 0; e < 8; ++e) out[e] += (e < 4 ? m0[e & 3] : m1[e & 3]) * ((ok ? bf2f((bf16_t)v[1 + n][e]) : 0.f) - yv[e]);
    }
  }
}
DI void rw_apply8_lds(const bf16x8 (&v)[5], const float* mu5c, const float* c0c, int grid, unsigned valid, float (&out)[8]) {
  {
    const f32x4 c0 = *(const f32x4*)c0c, c1 = *(const f32x4*)(c0c + 4);
#pragma unroll
    for (int e = 0; e < 8; ++e) out[e] = bf2f((bf16_t)v[0][e]) * (e < 4 ? c0[e & 3] : c1[e & 3]);
  }
#pragma unroll
  for (int n = 0; n < 4; ++n) {
    if (n < 2 || grid) {
      const f32x4 m0 = *(const f32x4*)(mu5c + n * 320), m1 = *(const f32x4*)(mu5c + n * 320 + 4);
      const float ok = ((valid >> n) & 1u) ? 1.0f : 0.0f;
#pragma unroll
      for (int e = 0; e < 8; ++e) out[e] += (e < 4 ? m0[e & 3] : m1[e & 3]) * ok * bf2f((bf16_t)v[1 + n][e]);
    }
  }
}
DI float fast_tanh(float x) { return 1.0f - 2.0f / (1.0f + __expf(2.0f * x)); }
template <int N> DI float dpp_row_shr0(float x) { return __int_as_float(__builtin_amdgcn_update_dpp(0, __float_as_int(x), 0x110 + N, 0xF, 0xF, false)); }

DI void rwkv_item(const Params& p, int l, int s, int hh, int d, char* smem) {
  const Seq q = get_seq(s);
  const int tid0 = ltid();
  const int w = __builtin_amdgcn_readfirstlane(tid0 >> 6), vb = w >> 1, kb = w & 1;
  int tid = tid0, lane = tid & 63, l15 = lane & 15, qq = lane >> 4, r32 = lane & 31, h = lane >> 5;
  const bf16_t* ZR = (const bf16_t*)(p.ws + OFF_ZR);
  bf16_t* O = (bf16_t*)(p.ws + OFF_O);
  const float* mu = p.in[I_MU] + (size_t)l * 4 * ZRW;
  bf16_t* KHr = (bf16_t*)smem;
  bf16_t* BCr = KHr + 16 * 72;
  bf16_t* KC = BCr + 16 * 72;
  bf16_t* RH = KC + 16 * 72;
  bf16_t* Sb = RH + 16 * 72;
  bf16_t* Wb2 = (bf16_t*)smem;
  bf16_t* Ab2 = Wb2 + 64 * 72;
  float* mu5 = (float*)(smem + 18432);
  bf16_t* actW = (bf16_t*)(smem + 23552);
  bf16_t* actA = actW + 16 * 72;
  float* shR = (float*)(smem + 28160);
  float* shK = shR + 1024; float* shV = shK + 1024;
  bf16_t* VT0 = (bf16_t*)(smem + 40448);
  bf16_t* VT1 = (bf16_t*)(smem + 69376);
  bf16_t* UNT = VT0 + 64 * 40;
  bf16_t* KBT = UNT + 64 * 40;
  bf16_t* BBT = KBT + 64 * 24;
  float* PL = (float*)(smem + 56832);
  float* npart = PL + 64;
  float* MN = (float*)(smem + 57344);
  float* G0 = (float*)(smem + 61440);
  bf16_t* ArkM = (bf16_t*)(smem + 65536);
  bf16_t* ArbM = ArkM + 16 * 40;
  float* c0t = (float*)(smem + 68096);
  __syncthreads();
  for (int e = tid; e < 4096; e += NTHR) {
    const int i = e >> 6, c = e & 63;
    Wb2[c * 72 + i] = f2bf(p.in[I_W2][((size_t)(l * 2 + d) * 64 + i) * 512 + 64 * hh + c]);
    Ab2[c * 72 + i] = f2bf(p.in[I_A2][((size_t)(l * 2 + d) * 64 + i) * 512 + 64 * hh + c]);
  }
  for (int e = tid; e < 1280; e += NTHR) {
    const int n = e / 320, rem = e % 320, arr = rem >> 6, c = rem & 63;
    const int col = arr == 0 ? 64 * hh + c : arr == 1 ? 512 + 64 * hh + c : arr == 2 ? 1024 + 64 * hh + c : arr == 3 ? 1536 + 64 * d + c : 1664 + 64 * d + c;
    mu5[e] = mu[n * ZRW + col];
  }
  for (int e = tid; e < 320; e += NTHR) {
    const int arr = e >> 6, c = e & 63;
    const int col = arr == 0 ? 64 * hh + c : arr == 1 ? 512 + 64 * hh + c : arr == 2 ? 1024 + 64 * hh + c : arr == 3 ? 1536 + 64 * d + c : 1664 + 64 * d + c;
    float sm_ = mu[col] + mu[ZRW + col];
    if (q.grid) sm_ += mu[2 * ZRW + col] + mu[3 * ZRW + col];
    c0t[e] = 1.0f - sm_;
  }
  const int cB0 = 16 * w + 4 * qq;
  float w0c[4], a0c[4], kkc[4], kac[4];
#pragma unroll
  for (int g = 0; g < 4; ++g) {
    w0c[g] = p.in[I_W0][(l * 2 + d) * 512 + 64 * hh + cB0 + g]; a0c[g] = p.in[I_A0][(l * 2 + d) * 512 + 64 * hh + cB0 + g];
    kkc[g] = p.in[I_KK][l * 512 + 64 * hh + cB0 + g]; kac[g] = p.in[I_KA][l * 512 + 64 * hh + cB0 + g];
  }
  f32x16 S;
  if (q.sample) {
    const float* st = p.in[I_SR] + ((((size_t)q.b * 2 + l) * 2 + d) * 8 + hh) * 4096;
#pragma unroll
    for (int g = 0; g < 16; ++g) S[g] = st[(32 * vb + crow(g, h)) * 64 + 32 * kb + r32];
  } else {
#pragma unroll
    for (int g = 0; g < 16; ++g) S[g] = 0.f;
  }
  __syncthreads();
  bf16x8 bW[2], bA[2];
#pragma unroll
  for (int ks = 0; ks < 2; ++ks) { bW[ks] = *(const bf16x8*)(Wb2 + (16 * w + l15) * 72 + ks * 32 + qq * 8); bA[ks] = *(const bf16x8*)(Ab2 + (16 * w + l15) * 72 + ks * 32 + qq * 8); }
  __syncthreads();
  for (int e = tid; e < (2 * 64 * 40 + 2 * 64 * 24) / 2; e += NTHR) ((unsigned*)VT0)[e] = 0u;
  for (int e = tid; e < (64 * 40) / 2; e += NTHR) ((unsigned*)VT1)[e] = 0u;
  for (int e = tid; e < (2 * 16 * 40) / 2; e += NTHR) ((unsigned*)ArkM)[e] = 0u;
  __syncthreads();
  const int nch = q.T / 16;
  bf16x8 pf[3][5];
  const int jA = (tid0 & 127) >> 3, c8A = (tid0 & 7) * 8, wh = w >> 1;
#define RW_CB(arr) ((arr) == 0 ? 64 * hh : (arr) == 1 ? 512 + 64 * hh : (arr) == 2 ? 1024 + 64 * hh : (arr) == 3 ? 1536 + 64 * d : 1664 + 64 * d)
#define RW_ISSUE(chn) { const int pos = (chn) * 16 + jA, t = d ? q.T - 1 - pos : pos; _Pragma("unroll") for (int gi = 0; gi < 3; ++gi) { if (gi < 2 || w < 2) { \
      rw_load8(ZR, q.base, t, q.T, q.grid, RW_CB(2 * gi + wh) + c8A, pf[gi]); } } }
#pragma unroll
  for (int g = 0; g < 4; ++g) asm volatile("" : "+v"(w0c[g]), "+v"(a0c[g]), "+v"(kkc[g]), "+v"(kac[g]));
  asm volatile("" : "+v"(S));
  RW_ISSUE(0)
#pragma unroll 1
  for (int ch = 0; ch < nch; ++ch) {
    tid = tid0; asm volatile("" : "+v"(tid));
    lane = tid & 63; l15 = lane & 15; qq = lane >> 4; r32 = lane & 31; h = lane >> 5;
    bf16_t* VT = (ch & 1) ? VT1 : VT0;
    {
      const int pos_ = ch * 16 + jA, t_ = d ? q.T - 1 - pos_ : pos_;
      const unsigned vd_ = rw_valid(t_, q.T, q.grid);
#pragma unroll
      for (int gi = 0; gi < 3; ++gi) {
        if (gi < 2 || w < 2) {
          const int arr = 2 * gi + wh;
          float val[8];
          rw_apply8_lds(pf[gi], mu5 + arr * 64 + c8A, c0t + arr * 64 + c8A, q.grid, vd_, val);
          if (arr < 3) {
            *(f32x4*)(shR + arr * 1024 + jA * 64 + c8A) = (f32x4){val[0], val[1], val[2], val[3]};
            *(f32x4*)(shR + arr * 1024 + jA * 64 + c8A + 4) = (f32x4){val[4], val[5], val[6], val[7]};
            if (arr == 2) {
#pragma unroll
              for (int e = 0; e < 8; ++e) VT[(c8A + e) * 40 + jA] = f2bf(val[e]);
            }
          } else if (arr == 3) {
            *(u32x4*)(actW + jA * 72 + c8A) = (u32x4){pk2(fast_tanh(val[0]), fast_tanh(val[1])), pk2(fast_tanh(val[2]), fast_tanh(val[3])), pk2(fast_tanh(val[4]), fast_tanh(val[5])), pk2(fast_tanh(val[6]), fast_tanh(val[7]))};
          } else {
            *(u32x4*)(actA + jA * 72 + c8A) = (u32x4){pk2(val[0], val[1]), pk2(val[2], val[3]), pk2(val[4], val[5]), pk2(val[6], val[7])};
          }
        }
      }
    }
    asm volatile("" ::: "memory"); __builtin_amdgcn_sched_barrier(0);
    if (ch + 1 < nch) RW_ISSUE(ch + 1)
    __syncthreads();
    {
      f32x4 aw = (f32x4){0.f, 0.f, 0.f, 0.f}, aa = (f32x4){0.f, 0.f, 0.f, 0.f};
#pragma unroll
      for (int ks = 0; ks < 2; ++ks) {
        const bf16x8 fw = *(const bf16x8*)(actW + l15 * 72 + ks * 32 + qq * 8);
        const bf16x8 fa = *(const bf16x8*)(actA + l15 * 72 + ks * 32 + qq * 8);
        aw = __builtin_amdgcn_mfma_f32_16x16x32_bf16(bW[ks], fw, aw, 0, 0, 0);
        aa = __builtin_amdgcn_mfma_f32_16x16x32_bf16(bA[ks], fa, aa, 0, 0, 0);
      }
      const f32x4 kv = *(const f32x4*)(shK + l15 * 64 + cB0), rv = *(const f32x4*)(shR + l15 * 64 + cB0);
      float lw[4], av[4], kkr[4], kd[4], Lp[4], LpL[4];
      float ssq = 0.f;
#pragma unroll
      for (int g = 0; g < 4; ++g) {
        const float wl = aw[g] + w0c[g], al = aa[g] + a0c[g];
        lw[g] = -__expf(-softplusf_(-wl) - 0.5f);
        av[g] = sigmoidf_(al);
        kkr[g] = kv[g] * kkc[g];
        kd[g] = kv[g] * (1.0f + (av[g] - 1.0f) * kac[g]);
        ssq += kkr[g] * kkr[g];
        float x = lw[g];
        x += dpp_row_shr0<1>(x); x += dpp_row_shr0<2>(x); x += dpp_row_shr0<4>(x); x += dpp_row_shr0<8>(x);
        Lp[g] = x;
      }
#pragma unroll
      for (int g = 0; g < 4; ++g) { float x = Lp[g];
        x = fminf(x, __int_as_float(__builtin_amdgcn_mov_dpp(__float_as_int(x), 0x128, 0xF, 0xF, true))); x = fminf(x, __int_as_float(__builtin_amdgcn_mov_dpp(__float_as_int(x), 0x124, 0xF, 0xF, true)));
        x = fminf(x, dpp_xor2(x)); x = fminf(x, dpp_xor1(x)); LpL[g] = x; }
      ssq += SHX(ssq, 16); ssq += SHX(ssq, 32);
      if (qq == 0) npart[w * 16 + l15] = ssq;
      float e_m1[4], e_neg[4], e_pos[4], e_end[4];
#pragma unroll
      for (int g = 0; g < 4; ++g) { e_m1[g] = __expf(Lp[g] - lw[g]); e_neg[g] = __expf(-Lp[g]); e_pos[g] = __expf(Lp[g]); e_end[g] = __expf(LpL[g] - Lp[g]); }
      *(u32x2*)(KHr + l15 * 72 + cB0) = (u32x2){pk2(kkr[0] * e_m1[0], kkr[1] * e_m1[1]), pk2(kkr[2] * e_m1[2], kkr[3] * e_m1[3])};
      *(u32x2*)(BCr + l15 * 72 + cB0) = (u32x2){pk2(kkr[0] * av[0] * e_neg[0], kkr[1] * av[1] * e_neg[1]), pk2(kkr[2] * av[2] * e_neg[2], kkr[3] * av[3] * e_neg[3])};
      *(u32x2*)(KC + l15 * 72 + cB0) = (u32x2){pk2(kd[0] * e_neg[0], kd[1] * e_neg[1]), pk2(kd[2] * e_neg[2], kd[3] * e_neg[3])};
      *(u32x2*)(RH + l15 * 72 + cB0) = (u32x2){pk2(rv[0] * e_pos[0], rv[1] * e_pos[1]), pk2(rv[2] * e_pos[2], rv[3] * e_pos[3])};
#pragma unroll
      for (int g = 0; g < 4; ++g) {
        KBT[(cB0 + g) * 24 + l15] = f2bf(kd[g] * e_end[g]);
        BBT[(cB0 + g) * 24 + l15] = f2bf(kkr[g] * av[g] * e_end[g]);
      }
      if (l15 == 15) *(f32x4*)(PL + cB0) = (f32x4){e_pos[0], e_pos[1], e_pos[2], e_pos[3]};
#pragma unroll
      for (int g = 0; g < 16; ++g) Sb[(32 * vb + crow(g, h)) * 72 + 32 * kb + r32] = f2bf(S[g]);
    }
    __syncthreads();
    f32x4 oacc = (f32x4){0.f, 0.f, 0.f, 0.f};
    {
      const bf16_t* Aop = (w < 2) ? KHr : RH;
      const bf16_t* Bop = (w == 0 || w == 3) ? BCr : KC;
      f32x4 t16 = (f32x4){0.f, 0.f, 0.f, 0.f}, g0 = (f32x4){0.f, 0.f, 0.f, 0.f};
#pragma unroll
      for (int ks = 0; ks < 2; ++ks) {
        const bf16x8 a = *(const bf16x8*)(Aop + l15 * 72 + ks * 32 + qq * 8);
        const bf16x8 b = *(const bf16x8*)(Bop + l15 * 72 + ks * 32 + qq * 8);
        t16 = __builtin_amdgcn_mfma_f32_16x16x32_bf16(a, b, t16, 0, 0, 0);
        const bf16x8 akh = *(const bf16x8*)(KHr + l15 * 72 + ks * 32 + qq * 8);
        const bf16x8 arh = *(const bf16x8*)(RH + l15 * 72 + ks * 32 + qq * 8);
        const bf16x8 bs = *(const bf16x8*)(Sb + (16 * w + l15) * 72 + ks * 32 + qq * 8);
        g0 = __builtin_amdgcn_mfma_f32_16x16x32_bf16(akh, bs, g0, 0, 0, 0);
        oacc = __builtin_amdgcn_mfma_f32_16x16x32_bf16(arh, bs, oacc, 0, 0, 0);
      }
#pragma unroll
      for (int g = 0; g < 4; ++g) G0[(4 * qq + g) * 64 + 16 * w + l15] = g0[g];
      *(f32x4*)(MN + w * 256 + l15 * 16 + 4 * qq) = t16;
    }
    __syncthreads();
    if (w == 0) {
      const float* MrT = MN; const float* NrT = MN + 256;
      f32x2 acc2[8];
#pragma unroll
      for (int pq = 0; pq < 8; ++pq) acc2[pq] = (f32x2){G0[(2 * pq) * 64 + lane], G0[(2 * pq + 1) * 64 + lane]};
      float vv[16], un[16];
#pragma unroll
      for (int j = 0; j < 16; ++j) vv[j] = shV[j * 64 + lane];
      const float n2v = __builtin_amdgcn_rcpf(fmaxf(npart[l15] + npart[16 + l15] + npart[32 + l15] + npart[48 + l15], 1e-24f));
      f32x4 nr[4], mr[4];
#pragma unroll
      for (int t4 = 0; t4 < 4; ++t4) { nr[t4] = *(const f32x4*)(NrT + 4 * t4); mr[t4] = *(const f32x4*)(MrT + 4 * t4); }
#pragma unroll
      for (int j = 0; j < 16; ++j) {
        f32x4 nrn[4], mrn[4];
#pragma unroll
        for (int t4 = 0; t4 < 4; ++t4) { nrn[t4] = (f32x4){0.f, 0.f, 0.f, 0.f}; mrn[t4] = (f32x4){0.f, 0.f, 0.f, 0.f}; }
        if (j + 1 < 16) {
#pragma unroll
          for (int t4 = 0; t4 < 4; ++t4) if (4 * t4 + 3 > j + 1) { nrn[t4] = *(const f32x4*)(NrT + (j + 1) * 16 + 4 * t4); mrn[t4] = *(const f32x4*)(MrT + (j + 1) * 16 + 4 * t4); }
        }
        const float n2s = __int_as_float(__builtin_amdgcn_readlane(__float_as_int(n2v), j));
        const float unj = -acc2[j >> 1][j & 1] * n2s;
        un[j] = unj;
        const f32x2 vv2 = (f32x2){vv[j], vv[j]}, un2 = (f32x2){unj, unj};
#pragma unroll
        for (int pq = 0; pq < 8; ++pq)
          if (2 * pq + 1 > j) acc2[pq] += (f32x2){nr[pq >> 1][2 * (pq & 1)], nr[pq >> 1][2 * (pq & 1) + 1]} * vv2 + (f32x2){mr[pq >> 1][2 * (pq & 1)], mr[pq >> 1][2 * (pq & 1) + 1]} * un2;
#pragma unroll
        for (int t4 = 0; t4 < 4; ++t4) { nr[t4] = nrn[t4]; mr[t4] = mrn[t4]; }
        __builtin_amdgcn_sched_barrier(0);
      }
      *(u32x4*)(UNT + lane * 40) = (u32x4){pk2(un[0], un[1]), pk2(un[2], un[3]), pk2(un[4], un[5]), pk2(un[6], un[7])};
      *(u32x4*)(UNT + lane * 40 + 8) = (u32x4){pk2(un[8], un[9]), pk2(un[10], un[11]), pk2(un[12], un[13]), pk2(un[14], un[15])};
    } else if (w < 3) {
      const float* src = MN + (w == 1 ? 512 : 768);
      bf16_t* dst = (w == 1) ? ArkM : ArbM;
#pragma unroll
      for (int i = 0; i < 4; ++i) { const int e = lane + 64 * i, j = e >> 4, t = e & 15; dst[t * 40 + j] = f2bf(j <= t ? src[e] : 0.f); }
    }
    __syncthreads();
    {
      const bf16x8 ak = *(const bf16x8*)(ArkM + l15 * 40 + qq * 8), ab = *(const bf16x8*)(ArbM + l15 * 40 + qq * 8);
      const bf16x8 bv = *(const bf16x8*)(VT + (16 * w + l15) * 40 + qq * 8), bu = *(const bf16x8*)(UNT + (16 * w + l15) * 40 + qq * 8);
      oacc = __builtin_amdgcn_mfma_f32_16x16x32_bf16(ak, bv, oacc, 0, 0, 0);
      oacc = __builtin_amdgcn_mfma_f32_16x16x32_bf16(ab, bu, oacc, 0, 0, 0);
#pragma unroll
      for (int g = 0; g < 4; ++g) {
        const int pos = ch * 16 + 4 * qq + g, t = d ? q.T - 1 - pos : pos;
        O[(size_t)(q.base + t) * 1024 + d * 512 + 64 * hh + 16 * w + l15] = f2bf(oacc[g]);
      }
      const float pl = PL[32 * kb + r32];
#pragma unroll
      for (int g = 0; g < 16; ++g) S[g] *= pl;
      const bf16x8 av_ = *(const bf16x8*)(VT + (32 * vb + r32) * 40 + 8 * h), au_ = *(const bf16x8*)(UNT + (32 * vb + r32) * 40 + 8 * h);
      const bf16x8 bk_ = *(const bf16x8*)(KBT + (32 * kb + r32) * 24 + 8 * h), bb_ = *(const bf16x8*)(BBT + (32 * kb + r32) * 24 + 8 * h);
      S = __builtin_amdgcn_mfma_f32_32x32x16_bf16(av_, bk_, S, 0, 0, 0);
      S = __builtin_amdgcn_mfma_f32_32x32x16_bf16(au_, bb_, S, 0, 0, 0);
    }
  }
  if (!q.sample) {
    float* dst = p.out + OUT_RW + ((((size_t)q.b * 2 + l) * 2 + d) * 8 + hh) * 4096;
#pragma unroll
    for (int g = 0; g < 16; ++g) dst[(32 * vb + crow(g, h)) * 64 + 32 * kb + r32] = S[g];
  }
}

DI void hgrn_item(const Params& p, int l, int s, int hh, int d, char* smem) {
  const Seq q = get_seq(s);
  const int tid = ltid(), lane = tid & 63, w = tid >> 6, r = lane & 31, h = lane >> 5;
  bf16_t* ZH = (bf16_t*)(p.ws + OFF_ZH);
  bf16_t* Qt = (bf16_t*)smem;
  bf16_t* Kt = Qt + 32 * 136;
  bf16_t* KhT = Kt + 32 * 136;
  bf16_t* VT = KhT + 128 * 40;
  bf16_t* Sb = VT + 128 * 40;
  bf16_t* At = Sb + 4 * 32 * 136;
  float* dL = (float*)(At + 32 * 40);
  float* tot = dL + 128;
  const float lb = ((const float*)(p.ws + OFF_LBS))[l * 512 + 128 * hh + (tid & 127)];
  f32x16 S[4];
  if (q.sample) {
    const float* st = p.in[I_SH] + ((((size_t)q.b * 2 + l) * 2 + d) * 4 + hh) * 16384;
#pragma unroll
    for (int kb = 0; kb < 4; ++kb)
#pragma unroll
      for (int g = 0; g < 16; ++g) S[kb][g] = st[(size_t)(32 * kb + crow(g, h)) * 128 + 32 * w + r];
  } else {
#pragma unroll
    for (int kb = 0; kb < 4; ++kb)
#pragma unroll
      for (int g = 0; g < 16; ++g) S[kb][g] = 0.f;
  }
  const int k = tid & 127, half = tid >> 7;
  const int nch = q.T / 32;
  u16x2 pzq[16], pv2[8];
#define HG_ISSUE(chn) { _Pragma("unroll") for (int jj = 0; jj < 16; ++jj) { const int pos = (chn) * 32 + half * 16 + jj, t = d ? q.T - 1 - pos : pos; \
      const size_t rowo = (size_t)(q.base + t) * ZHW + 128 * hh + k; pzq[jj][0] = ZH[rowo + 512 * (1 + d)]; pzq[jj][1] = ZH[rowo]; pv2[jj >> 1][jj & 1] = ZH[rowo + 1536]; } }
  { float lb_ = lb; asm volatile("" : "+v"(lb_)); (void)lb_; }
#pragma unroll
  for (int kb = 0; kb < 4; ++kb) asm volatile("" : "+v"(S[kb]));
  HG_ISSUE(0)
#pragma unroll 1
  for (int ch = 0; ch < nch; ++ch) {
    __syncthreads();
    float bl[16], kc[16], qs[16];
    {
      float b = 0.f;
#pragma unroll
      for (int jj = 0; jj < 16; ++jj) {
        const float z = bf2f(pzq[jj][0]);
        const float kcoef = (1.0f - lb) * sigmoidf_(-z);
        const float f = 1.0f - kcoef;
        b += fmaxf(__logf(f), -80.f);
        bl[jj] = b; kc[jj] = kcoef; qs[jj] = bf2f(pzq[jj][1]) * 0.08838834764831845f;
      }
      *(u32x4*)(VT + k * 40 + half * 16) = (u32x4){__builtin_bit_cast(unsigned, pv2[0]), __builtin_bit_cast(unsigned, pv2[1]), __builtin_bit_cast(unsigned, pv2[2]), __builtin_bit_cast(unsigned, pv2[3])};
      *(u32x4*)(VT + k * 40 + half * 16 + 8) = (u32x4){__builtin_bit_cast(unsigned, pv2[4]), __builtin_bit_cast(unsigned, pv2[5]), __builtin_bit_cast(unsigned, pv2[6]), __builtin_bit_cast(unsigned, pv2[7])};
      tot[half * 128 + k] = b;
    }
    if (ch + 1 < nch) HG_ISSUE(ch + 1)
    __syncthreads();
    {
      const float off = half ? tot[k] : 0.f;
      const float bL = fmaxf(tot[k] + tot[128 + k], -80.f);
      if (half == 0) dL[k] = __expf(bL);
      float kh[16];
#pragma unroll
      for (int jj = 0; jj < 16; ++jj) {
        const int j = half * 16 + jj;
        const float bj = fmaxf(off + bl[jj], -80.f);
        Qt[j * 136 + k] = f2bf(qs[jj] * __expf(bj));
        Kt[j * 136 + k] = f2bf(kc[jj] * __expf(-bj));
        kh[jj] = kc[jj] * __expf(fminf(bL - bj, 0.f));
      }
      *(u32x4*)(KhT + k * 40 + half * 16) = (u32x4){pk2(kh[0], kh[1]), pk2(kh[2], kh[3]), pk2(kh[4], kh[5]), pk2(kh[6], kh[7])};
      *(u32x4*)(KhT + k * 40 + half * 16 + 8) = (u32x4){pk2(kh[8], kh[9]), pk2(kh[10], kh[11]), pk2(kh[12], kh[13]), pk2(kh[14], kh[15])};
    }
    bf16_t* Sbw = Sb + w * 32 * 136;
#pragma unroll
    for (int kb = 0; kb < 4; ++kb)
#pragma unroll
      for (int g4 = 0; g4 < 4; ++g4) *(u32x2*)(Sbw + r * 136 + 32 * kb + crow(4 * g4, h)) = (u32x2){pk2(S[kb][4 * g4], S[kb][4 * g4 + 1]), pk2(S[kb][4 * g4 + 2], S[kb][4 * g4 + 3])};
    __syncthreads();
    bf16_t* Atw = At;
    {
      f32x16 A;
#pragma unroll
      for (int g = 0; g < 16; ++g) A[g] = 0.f;
      mma32(A, Qt, 136, Kt, 136, 128, lane);
#pragma unroll
      for (int g = 0; g < 16; ++g) { const int t = crow(g, h); Atw[t * 40 + r] = f2bf(r <= t ? A[g] : 0.f); }
    }
    __syncthreads();
    {
      f32x16 o;
#pragma unroll
      for (int g = 0; g < 16; ++g) o[g] = 0.f;
      mma32(o, Atw, 40, VT + 32 * w * 40, 40, 32, lane);
      mma32(o, Qt, 136, Sbw, 136, 128, lane);
#pragma unroll
      for (int g = 0; g < 16; ++g) {
        const int j = crow(g, h), pos = ch * 32 + j, t = d ? q.T - 1 - pos : pos;
        ZH[(size_t)(q.base + t) * ZHW + 512 * (1 + d) + 128 * hh + 32 * w + r] = f2bf(o[g]);
      }
#pragma unroll
      for (int kb = 0; kb < 4; ++kb) {
#pragma unroll
        for (int g = 0; g < 16; ++g) S[kb][g] *= dL[32 * kb + crow(g, h)];
        mma32(S[kb], KhT + 32 * kb * 40, 40, VT + 32 * w * 40, 40, 32, lane);
      }
    }
  }
  if (!q.sample) {
    float* dst = p.out + OUT_HG + ((((size_t)q.b * 2 + l) * 2 + d) * 4 + hh) * 16384;
#pragma unroll
    for (int kb = 0; kb < 4; ++kb)
#pragma unroll
      for (int g = 0; g < 16; ++g) dst[(size_t)(32 * kb + crow(g, h)) * 128 + 32 * w + r] = S[kb][g];
  }
}

DI void mlstm_item(const Params& p, int l, int s, int hh, int d, char* smem) {
  const Seq q = get_seq(s);
  const int tid = ltid(), lane = tid & 63, w = tid >> 6, r = lane & 31, h = lane >> 5;
  const bf16_t* ZM = (const bf16_t*)(p.ws + OFF_ZM);
  const float* MG = (const float*)(p.ws + OFF_MG);
  bf16_t* Hb = (bf16_t*)(p.ws + OFF_H);
  bf16_t* Qm = (bf16_t*)smem;
  bf16_t* Km = Qm + 32 * 136;
  bf16_t* KwT = Km + 32 * 136;
  bf16_t* VT = KwT + 128 * 40;
  bf16_t* Cb = VT + 128 * 40;
  bf16_t* Pt = Cb + 4 * 32 * 136;
  float* nv = (float*)(Pt + 32 * 40);
  float* sc = nv + 128;
  float* ig = sc; float* lf = sc + 32; float* gg = sc + 64; float* mtv = sc + 96; float* wi = sc + 128; float* wsr = sc + 160; float* qn = sc + 192; float* misc = sc + 224;
  float* dnw = sc + 232;
  const float gbi = p.in[I_GB][l * 16 + (2 * d) * 4 + hh], gbf = p.in[I_GB][l * 16 + (2 * d + 1) * 4 + hh];
  f32x16 C[4];
  float m;
  __syncthreads();
  if (q.sample) {
    const size_t sb = (((size_t)q.b * 2 + l) * 2 + d) * 4 + hh;
    const float* st = p.in[I_SC] + sb * 16384;
#pragma unroll
    for (int kb = 0; kb < 4; ++kb)
#pragma unroll
      for (int g = 0; g < 16; ++g) C[kb][g] = st[(size_t)(32 * kb + crow(g, h)) * 128 + 32 * w + r];
    if (tid < 128) nv[tid] = p.in[I_SN][sb * 128 + tid];
    m = p.in[I_SM][sb];
  } else {
#pragma unroll
    for (int kb = 0; kb < 4; ++kb)
#pragma unroll
      for (int g = 0; g < 16; ++g) C[kb][g] = 0.f;
    if (tid < 128) nv[tid] = 0.f;
    m = 0.f;
  }
  const int nch = q.T / 32;
  const int dd = tid & 127, half = tid >> 7;
  u16x2 pqk[16], pv2[8]; float pgi = 0.f, pgf = 0.f;
#define ML_ISSUE(chn) { _Pragma("unroll") for (int jj = 0; jj < 16; ++jj) { const int pos = (chn) * 32 + half * 16 + jj, t = d ? q.T - 1 - pos : pos; \
      const size_t rowo = (size_t)(q.base + t) * ZMW + 128 * hh + dd; pqk[jj][0] = ZM[rowo]; pqk[jj][1] = ZM[rowo + 512]; pv2[jj >> 1][jj & 1] = ZM[rowo + 1024]; } \
    if (tid < 32) { const int pos = (chn) * 32 + tid, t = d ? q.T - 1 - pos : pos; const float* mg = MG + (size_t)(q.base + t) * 16; pgi = mg[(2 * d) * 4 + hh]; pgf = mg[(2 * d + 1) * 4 + hh]; } }
#pragma unroll
  for (int kb = 0; kb < 4; ++kb) asm volatile("" : "+v"(C[kb]));
  asm volatile("" : "+v"(m));
  ML_ISSUE(0)
#pragma unroll 1
  for (int ch = 0; ch < nch; ++ch) {
    __syncthreads();
    {
#pragma unroll
      for (int jj = 0; jj < 16; ++jj) {
        const int j = half * 16 + jj;
        Qm[j * 136 + dd] = pqk[jj][0];
        Km[j * 136 + dd] = f2bf(bf2f(pqk[jj][1]) * 0.08838834764831845f);
      }
      *(u32x4*)(VT + dd * 40 + half * 16) = (u32x4){__builtin_bit_cast(unsigned, pv2[0]), __builtin_bit_cast(unsigned, pv2[1]), __builtin_bit_cast(unsigned, pv2[2]), __builtin_bit_cast(unsigned, pv2[3])};
      *(u32x4*)(VT + dd * 40 + half * 16 + 8) = (u32x4){__builtin_bit_cast(unsigned, pv2[4]), __builtin_bit_cast(unsigned, pv2[5]), __builtin_bit_cast(unsigned, pv2[6]), __builtin_bit_cast(unsigned, pv2[7])};
      if (tid < 32) {
        const float igv = pgi + gbi;
        const float lfv = -softplusf_(-(pgf + gbf));
        float g = lfv;
#pragma unroll
        for (int o = 1; o < 32; o <<= 1) { const float tt = shfl_lane(g, (lane - o) & 63); if (tid >= o) g += tt; }
        const float cs = igv - g;
        float pm = cs;
#pragma unroll
        for (int o = 1; o < 32; o <<= 1) { const float tt = shfl_lane(pm, (lane - o) & 63); if (tid >= o) pm = fmaxf(pm, tt); }
        const float mt = g + fmaxf(m, pm);
        const float gend = shfl_lane(g, 31), mn = shfl_lane(mt, 31);
        ig[tid] = igv; gg[tid] = g; mtv[tid] = mt; wi[tid] = __expf(g + m - mt);
        wsr[tid] = __expf(gend + cs - mn);
        if (tid == 0) { misc[0] = mn; misc[1] = __expf(gend + m - mn); }
      }
    }
    if (ch + 1 < nch) ML_ISSUE(ch + 1)
    __syncthreads();
    {
      {
        float kw[16];
#pragma unroll
        for (int jj = 0; jj < 16; ++jj) { const int j = half * 16 + jj; kw[jj] = bf2f(Km[j * 136 + dd]) * wsr[j]; }
        *(u32x4*)(KwT + dd * 40 + half * 16) = (u32x4){pk2(kw[0], kw[1]), pk2(kw[2], kw[3]), pk2(kw[4], kw[5]), pk2(kw[6], kw[7])};
        *(u32x4*)(KwT + dd * 40 + half * 16 + 8) = (u32x4){pk2(kw[8], kw[9]), pk2(kw[10], kw[11]), pk2(kw[12], kw[13]), pk2(kw[14], kw[15])};
      }
      const int j = tid >> 3, seg = tid & 7;
      float a = 0.f;
#pragma unroll
      for (int i = 0; i < 16; ++i) a += bf2f(Qm[j * 136 + seg * 16 + i]) * nv[seg * 16 + i];
      a += SHX(a, 1); a += SHX(a, 2); a += SHX(a, 4);
      if (seg == 0) qn[j] = a;
    }
    const float m_new = misc[0], carry = misc[1];
    bf16_t* Cbw = Cb + w * 32 * 136; bf16_t* Ptw = Pt;
#pragma unroll
    for (int kb = 0; kb < 4; ++kb)
#pragma unroll
      for (int g4 = 0; g4 < 4; ++g4) *(u32x2*)(Cbw + r * 136 + 32 * kb + crow(4 * g4, h)) = (u32x2){pk2(C[kb][4 * g4], C[kb][4 * g4 + 1]), pk2(C[kb][4 * g4 + 2], C[kb][4 * g4 + 3])};
    {
      f32x16 Sc;
#pragma unroll
      for (int g = 0; g < 16; ++g) Sc[g] = 0.f;
      mma32(Sc, Qm, 136, Km, 136, 128, lane);
      const float gs = gg[r], is = ig[r];
#pragma unroll
      for (int g = 0; g < 16; ++g) {
        const int t = crow(g, h);
        const float pv = (r <= t) ? __expf(gg[t] - gs + is - mtv[t]) * Sc[g] : 0.f;
        Ptw[t * 40 + r] = f2bf(pv);
      }
    }
    __syncthreads();
    if (lane < 32) {
      float a = 0.f;
#pragma unroll 4
      for (int i = 0; i < 32; ++i) a += bf2f(Ptw[lane * 40 + i]);
      const float den = wi[lane] * qn[lane] + a;
      dnw[lane] = 1.0f / fmaxf(fabsf(den), __expf(-mtv[lane]));
    }
    if (tid < 128) {
      float a = 0.f;
#pragma unroll 4
      for (int i = 0; i < 32; ++i) a += bf2f(KwT[tid * 40 + i]);
      nv[tid] = carry * nv[tid] + a;
    }
    __syncthreads();
    {
      f32x16 a1;
#pragma unroll
      for (int g = 0; g < 16; ++g) a1[g] = 0.f;
      mma32(a1, Qm, 136, Cbw, 136, 128, lane);
#pragma unroll
      for (int g = 0; g < 16; ++g) a1[g] *= wi[crow(g, h)];
      mma32(a1, Ptw, 40, VT + 32 * w * 40, 40, 32, lane);
#pragma unroll
      for (int g = 0; g < 16; ++g) {
        const int j = crow(g, h), pos = ch * 32 + j, t = d ? q.T - 1 - pos : pos;
        const float hv = a1[g] * dnw[j];
        Hb[(size_t)(q.base + t) * 1024 + d * 512 + 128 * hh + 32 * w + r] = f2bf(hv);
      }
#pragma unroll
      for (int kb = 0; kb < 4; ++kb) {
#pragma unroll
        for (int g = 0; g < 16; ++g) C[kb][g] *= carry;
        mma32(C[kb], KwT + 32 * kb * 40, 40, VT + 32 * w * 40, 40, 32, lane);
      }
    }
    m = m_new;
  }
  __syncthreads();
  if (!q.sample) {
    const size_t sb = (((size_t)q.b * 2 + l) * 2 + d) * 4 + hh;
    float* dst = p.out + OUT_C + sb * 16384;
#pragma unroll
    for (int kb = 0; kb < 4; ++kb)
#pragma unroll
      for (int g = 0; g < 16; ++g) dst[(size_t)(32 * kb + crow(g, h)) * 128 + 32 * w + r] = C[kb][g];
    if (tid < 128) p.out[OUT_N + sb * 128 + tid] = nv[tid];
    if (tid == 0) p.out[OUT_M + sb] = m;
  }
}

DI void phase_scan(const Params& p, int l, char* smem) {
  int* ctrL = (int*)(p.ws + OFF_CTR) + 2 * l;
  int* ctrS = ctrL + 1;
  int* sit = (int*)(smem + LDS_BYTES - 16);
  const int role = p.role;
  bool longDone = false, shortDone = false;
  for (;;) {
    const bool wantLong = (role == 0) ? !longDone : shortDone;
    if (longDone && shortDone) break;
    __syncthreads();
    if (ltid() == 0) *sit = atomicAdd(wantLong ? ctrL : ctrS, 1);
    __syncthreads();
    int it = __builtin_amdgcn_readfirstlane(*sit);
    int ty, s_, hh_, d_, rb_ = 0;
    if (wantLong) {
      if (it >= 128) { longDone = true; continue; }
      if (it < 64) { ty = 0; d_ = it & 1; hh_ = (it >> 1) & 7; s_ = 32 + (it >> 4); }
      else if (it < 96) { it -= 64; ty = 1; s_ = 32 + (it >> 3); hh_ = (it >> 1) & 3; d_ = it & 1; }
      else { it -= 96; ty = 2; s_ = 32 + (it >> 3); hh_ = (it >> 1) & 3; d_ = it & 1; }
    } else {
      if (it >= 1024) { shortDone = true; continue; }
      if (it < 512) { ty = 0; s_ = it >> 4; hh_ = (it >> 1) & 7; d_ = it & 1; }
      else if (it < 768) { it -= 512; ty = 1; s_ = it >> 3; hh_ = (it >> 1) & 3; d_ = it & 1; }
      else { it -= 768; ty = 2; s_ = it >> 3; hh_ = (it >> 1) & 3; d_ = it & 1; }
    }
    if (ty == 0) rwkv_item(p, l, s_, hh_, d_, smem);
    else if (ty == 1) hgrn_item(p, l, s_, hh_, d_, smem);
    else mlstm_item(p, l, s_, hh_, d_, smem);
  }
}

DI void phase_combine(const Params& p, int l, char* smem) {
  const int tid = ltid(), lane = tid & 63, w = tid >> 6;
  bf16_t* ZH = (bf16_t*)(p.ws + OFF_ZH); bf16_t* ZM = (bf16_t*)(p.ws + OFF_ZM); const bf16_t* ZR = (const bf16_t*)(p.ws + OFF_ZR);
  bf16_t* O = (bf16_t*)(p.ws + OFF_O); const bf16_t* Hb = (const bf16_t*)(p.ws + OFF_H);
  const float* mu = p.in[I_MU] + (size_t)l * 4 * ZRW;
  const float* g2 = p.in[I_G2] + (size_t)l * 128 * 512;
  float* sg = (float*)smem;
  float* gt = sg + 128 * 16;
  for (int blk = blockIdx.x; blk < NT / 16; blk += gridDim.x) {
    const int tok0 = blk * 16;
    int sidx, t0;
    if (tok0 < 8192) { sidx = tok0 >> 8; t0 = tok0 & 255; } else { sidx = 32 + ((tok0 - 8192) >> 11); t0 = (tok0 - 8192) & 2047; }
    const Seq q = get_seq(sidx);
    __syncthreads();
    { const int j = tid >> 4, rr0 = (tid & 15) * 8; float val[8]; bf16x8 pv[5]; rw_load8(ZR, q.base, t0 + j, q.T, q.grid, 1792 + rr0, pv); rw_apply8(pv, mu, q.grid, rw_valid(t0 + j, q.T, q.grid), 1792 + rr0, val);
#pragma unroll
      for (int e = 0; e < 8; ++e) sg[(rr0 + e) * 16 + j] = sigmoidf_(val[e]); }
    __syncthreads();
    {
      float a0[16], a1[16];
#pragma unroll
      for (int j = 0; j < 16; ++j) { a0[j] = 0.f; a1[j] = 0.f; }
#pragma unroll 1
      for (int r0 = 0; r0 < 128; r0 += 8) {
        float w0v[8], w1v[8];
#pragma unroll
        for (int q8 = 0; q8 < 8; ++q8) { w0v[q8] = g2[(r0 + q8) * 512 + tid]; w1v[q8] = g2[(r0 + q8) * 512 + 256 + tid]; }
#pragma unroll
        for (int q8 = 0; q8 < 8; ++q8) {
          const int rr = r0 + q8; const float w0 = w0v[q8], w1 = w1v[q8];
#pragma unroll
          for (int u = 0; u < 4; ++u) {
            f32x4 sv = *(const f32x4*)(sg + rr * 16 + 4 * u);
#pragma unroll
            for (int e = 0; e < 4; ++e) { a0[4 * u + e] += sv[e] * w0; a1[4 * u + e] += sv[e] * w1; }
          }
        }
      }
#pragma unroll
      for (int j = 0; j < 16; ++j) { gt[j * 512 + tid] = a0[j]; gt[j * 512 + 256 + tid] = a1[j]; }
    }
    __syncthreads();
#pragma unroll 1
    for (int jj = 0; jj < 4; ++jj) {
      const int j = w * 4 + jj, tok = tok0 + j, t = t0 + j; int c0 = lane * 8; asm volatile("" : "+v"(c0));
      {
        float o[8], rs[8], ks[8], vs[8];
        float sum = 0.f, bon = 0.f;
        {
          bf16x8 pr_[5], pk_[5], pv_[5];
          rw_load8(ZR, q.base, t, q.T, q.grid, c0, pr_); rw_load8(ZR, q.base, t, q.T, q.grid, 512 + c0, pk_); rw_load8(ZR, q.base, t, q.T, q.grid, 1024 + c0, pv_);
          const unsigned vd_ = rw_valid(t, q.T, q.grid);
          rw_apply8(pr_, mu, q.grid, vd_, c0, rs); rw_apply8(pk_, mu, q.grid, vd_, 512 + c0, ks); rw_apply8(pv_, mu, q.grid, vd_, 1024 + c0, vs);
        }
        const bf16x8 of = *(const bf16x8*)(O + (size_t)tok * 1024 + c0), ob = *(const bf16x8*)(O + (size_t)tok * 1024 + 512 + c0);
        const f32x4 rk0 = *(const f32x4*)(p.in[I_RK] + l * 512 + c0), rk1 = *(const f32x4*)(p.in[I_RK] + l * 512 + c0 + 4);
#pragma unroll
        for (int e = 0; e < 8; ++e) {
          o[e] = bf2f((bf16_t)of[e]) + bf2f((bf16_t)ob[e]);
          sum += o[e];
          bon += rs[e] * ks[e] * (e < 4 ? rk0[e & 3] : rk1[e & 3]);
        }
        sum += SHX(sum, 1); sum += SHX(sum, 2); sum += SHX(sum, 4);
        bon += SHX(bon, 1); bon += SHX(bon, 2); bon += SHX(bon, 4);
        const float mean = sum * (1.0f / 64.f);
        float var = 0.f;
#pragma unroll
        for (int e = 0; e < 8; ++e) { const float dv = o[e] - mean; var += dv * dv; }
        var += SHX(var, 1); var += SHX(var, 2); var += SHX(var, 4);
        const float rstd = rsqrtf(var * (1.0f / 64.f) + 64e-5f);
        const f32x4 lw0 = *(const f32x4*)(p.in[I_LN] + (l * 2 + 0) * 512 + c0), lw1 = *(const f32x4*)(p.in[I_LN] + (l * 2 + 0) * 512 + c0 + 4);
        const f32x4 lb0 = *(const f32x4*)(p.in[I_LN] + (l * 2 + 1) * 512 + c0), lb1 = *(const f32x4*)(p.in[I_LN] + (l * 2 + 1) * 512 + c0 + 4);
        const f32x4 gt0 = *(const f32x4*)(gt + j * 512 + c0), gt1 = *(const f32x4*)(gt + j * 512 + c0 + 4);
        bf16x8 ov;
#pragma unroll
        for (int e = 0; e < 8; ++e) {
          const float ln = (o[e] - mean) * rstd * (e < 4 ? lw0[e & 3] : lw1[e & 3]) + (e < 4 ? lb0[e & 3] : lb1[e & 3]);
          ov[e] = (short)f2bf((ln + bon * vs[e]) * (e < 4 ? gt0[e & 3] : gt1[e & 3]));
        }
        *(bf16x8*)(O + (size_t)tok * 1024 + c0) = ov;
      }
      {
        float o[8]; float ss = 0.f;
        bf16_t* zr_ = ZH + (size_t)tok * ZHW + c0;
        const bf16x8 of = *(const bf16x8*)(zr_ + 512), ob = *(const bf16x8*)(zr_ + 1024), hgv = *(const bf16x8*)(zr_ + 2048);
        const f32x4 nw0 = *(const f32x4*)(p.in[I_HNORM] + l * 512 + c0), nw1 = *(const f32x4*)(p.in[I_HNORM] + l * 512 + c0 + 4);
#pragma unroll
        for (int e = 0; e < 8; ++e) { o[e] = bf2f((bf16_t)of[e]) + bf2f((bf16_t)ob[e]); ss += o[e] * o[e]; }
        ss += SHX(ss, 1); ss += SHX(ss, 2); ss += SHX(ss, 4); ss += SHX(ss, 8);
        const float rsd = rsqrtf(ss * (1.0f / 128.f) + 1e-6f);
        bf16x8 ov;
#pragma unroll
        for (int e = 0; e < 8; ++e) ov[e] = (short)f2bf(o[e] * rsd * (e < 4 ? nw0[e & 3] : nw1[e & 3]) * siluf_(bf2f((bf16_t)hgv[e])));
        *(bf16x8*)(zr_ + 2048) = ov;
      }
      {
        float o[8]; float ss = 0.f;
        bf16_t* zm_ = ZM + (size_t)tok * ZMW + 1536 + c0;
        const bf16x8 of = *(const bf16x8*)(Hb + (size_t)tok * 1024 + c0), ob = *(const bf16x8*)(Hb + (size_t)tok * 1024 + 512 + c0), mov = *(const bf16x8*)zm_;
        const f32x4 nw0 = *(const f32x4*)(p.in[I_MNORM] + l * 512 + c0), nw1 = *(const f32x4*)(p.in[I_MNORM] + l * 512 + c0 + 4);
#pragma unroll
        for (int e = 0; e < 8; ++e) { o[e] = bf2f((bf16_t)of[e]) + bf2f((bf16_t)ob[e]); ss += o[e] * o[e]; }
        ss += SHX(ss, 1); ss += SHX(ss, 2); ss += SHX(ss, 4); ss += SHX(ss, 8);
        const float rsd = rsqrtf(ss * (1.0f / 128.f) + 1e-6f);
        bf16x8 ov;
#pragma unroll
        for (int e = 0; e < 8; ++e) ov[e] = (short)f2bf(o[e] * rsd * (e < 4 ? nw0[e & 3] : nw1[e & 3]) * sigmoidf_(bf2f((bf16_t)mov[e])));
        *(bf16x8*)zm_ = ov;
      }
    }
    __syncthreads();
#pragma unroll 1
    for (int jj = 0; jj < 4; ++jj) tok_one(p, l, 3, tok0 + w * 4 + jj, lane);
  }
}

#define XB_TMO      128
#define XB_XCNT(j)  (256  + 64 * (j))
#define XB_XSUB(j)  (1280 + 64 * (j))
#define XB_XGEN(j)  (2304 + 64 * (j))
#define XB_TOP      3328
#define XB_TOPGEN   3392
#define XCD_BAR_WORDS 3456
#define XB_SPIN_CAP (1u << 20)
#define LAS __attribute__((address_space(3)))
DI unsigned xb_ld(unsigned* p)              { return __hip_atomic_load(p, __ATOMIC_RELAXED, __HIP_MEMORY_SCOPE_AGENT); }
DI unsigned xb_add(unsigned* p, unsigned v) { return __hip_atomic_fetch_add(p, v, __ATOMIC_RELAXED, __HIP_MEMORY_SCOPE_AGENT); }
DI unsigned xb_xcc_id() { return (unsigned)__builtin_amdgcn_s_getreg((3 << 11) | 20) & 0xFu; }
#define XB_SPIN(cond, bar) do { unsigned _sp = 0; while (cond) { __builtin_amdgcn_s_sleep(1); \
    if ((++_sp & 255u) == 0u) { if (xb_ld(&(bar)[XB_TMO])) break; if (_sp > XB_SPIN_CAP) { atomicAdd(&(bar)[XB_TMO], 1u); break; } } } } while (0)
struct XcdBarrier { unsigned* bar; unsigned x; volatile LAS unsigned* st; };
DI XcdBarrier xcd_barrier_post(const Params& p, unsigned* bar, volatile LAS unsigned* st) {
  XcdBarrier b; b.bar = bar; b.x = xb_xcc_id(); b.st = st;
  if (ltid() == 0) (void)xb_add(&bar[XB_XCNT(b.x)], 1u);
  return b;
}
DI void xcd_barrier_complete(unsigned* bar, unsigned x, unsigned& nloc, unsigned& nx) {
  const unsigned G = gridDim.x * gridDim.y * gridDim.z;
  unsigned sum, cnt, mine, sp = 0u;
  for (;;) {
    sum = 0u; cnt = 0u; mine = 0u;
#pragma unroll
    for (unsigned j = 0; j < 16; ++j) { const unsigned c = xb_ld(&bar[XB_XCNT(j)]); sum += c; cnt += (c > 0u) ? 1u : 0u; mine = (j == x) ? c : mine; }
    if (sum == G) break;
    __builtin_amdgcn_s_sleep(1);
    if ((++sp & 255u) == 0u) { if (xb_ld(&bar[XB_TMO])) break; if (sp > XB_SPIN_CAP) { atomicAdd(&bar[XB_TMO], 1u); break; } }
  }
  nloc = mine > 0u ? mine : 1u; nx = cnt > 0u ? cnt : 1u;
}
DI void xcd_barrier(const Params& p, const XcdBarrier& b) {
  asm volatile("s_waitcnt vmcnt(0)" ::: "memory");
  __syncthreads();
  if (ltid() == 0) {
    unsigned* bar = b.bar;
    __builtin_amdgcn_s_waitcnt(0);
    unsigned nloc = b.st[0], nx = b.st[1];
    if (nloc == 0u) { xcd_barrier_complete(bar, b.x, nloc, nx); b.st[0] = nloc; b.st[1] = nx; }
    const unsigned old = xb_add(&bar[XB_XSUB(b.x)], 1u);
    const unsigned gen = old / nloc;
    if (old + 1u == (gen + 1u) * nloc) {
      __builtin_amdgcn_fence(__ATOMIC_RELEASE, "agent");
      asm volatile("s_waitcnt vmcnt(0)" ::: "memory");
      const unsigned og = xb_add(&bar[XB_TOP], 1u);
      const unsigned tg = og / nx;
      if (og + 1u == (tg + 1u) * nx) xb_add(&bar[XB_TOPGEN], 1u);
      else XB_SPIN(xb_ld(&bar[XB_TOPGEN]) == tg, bar);
      __builtin_amdgcn_fence(__ATOMIC_ACQUIRE, "agent");
      xb_add(&bar[XB_XGEN(b.x)], 1u);
      asm volatile("s_waitcnt vmcnt(0)" ::: "memory");
    } else {
      XB_SPIN(xb_ld(&bar[XB_XGEN(b.x)]) == gen, bar);
      __builtin_amdgcn_fence(__ATOMIC_ACQUIRE, "agent");
      asm volatile("s_waitcnt vmcnt(0)" ::: "memory");
    }
  }
  __syncthreads();
}

constexpr int NPHASE = 3 + 9 * 2;
DI void run_phase(const Params& p0, int ph, char* smem) {
  Params p = p0;
  asm volatile("" : "+s"(p.ws), "+s"(p.out));
  p.ws = as_global(p.ws); p.out = as_global(p.out);
  if (ph == 0) { phase0(p, smem); return; }
  if (ph == 1) { phase1(p); return; }
  if (ph == 2) { tok_phase(p, 0, 0); return; }
  const int l = (ph - 3) / 9, s = (ph - 3) % 9;
  switch (s) {
    case 0: phase_inproj(p, smem); break;
    case 1: phase_scan(p, l, smem); break;
    case 2: phase_combine(p, l, smem); break;
    case 3: phase_merge(p, l, smem); break;
    case 4: phase_gemm_f32(p, (const bf16_t*)(p.ws + OFF_MERGED), 1024, (const bf16_t*)(p.ws + OFF_WTOUT), smem); break;
    case 5: tok_phase(p, l, 1); break;
    case 6: phase_ffn_in(p, smem); break;
    case 7: phase_gemm_f32(p, (const bf16_t*)(p.ws + OFF_ACT), DFF, (const bf16_t*)(p.ws + OFF_WTFO), smem); break;
    case 8:
      tok_phase(p, l, 2);
      if (l + 1 < 2) {
        conv_weight(p, p.in[I_WIN] + (size_t)(l + 1) * 1024 * DIN, DIN, (bf16_t*)(p.ws + OFF_WTIN), 1024, WTIN_ROWS, 0, (float*)smem, blockIdx.x, gridDim.x);
        for (int br = 0; br < 3; ++br) conv_weight(p, p.in[I_WBR] + ((size_t)(l + 1) * 3 + br) * 512 * 1024, 1024, (bf16_t*)(p.ws + OFF_WTBR) + (size_t)br * 1024 * 512, 512, 1024, 1, (float*)smem, blockIdx.x, gridDim.x);
      }
      break;
  }
}

template <bool COOP>
__global__ void __launch_bounds__(NTHR, 2) mega(Params pk, int lo, int hi) {
  __shared__ __attribute__((aligned(16))) char smem[LDS_BYTES];
  Params p = pk;
#pragma unroll
  for (int i = 0; i < N_IN; ++i) p.in[i] = as_global(p.in[i]);
  p.ws = as_global(p.ws); p.out = as_global(p.out);
  p.wb = __builtin_amdgcn_readfirstlane((int)threadIdx.x) & ~63;
  if (COOP) {
    volatile LAS unsigned* st = (volatile LAS unsigned*)(smem + LDS_BYTES - 32);
    if (ltid() == 0) { st[0] = 0u; st[1] = 0u; }
    __syncthreads();
    phase0(p, smem);
    cg::this_grid().sync();
    XcdBarrier b = xcd_barrier_post(p, (unsigned*)(p.ws + OFF_BAR), st);
    if (ltid() == 0) {
      const unsigned hwid = (unsigned)__builtin_amdgcn_s_getreg((31 << 11) | 4);
      const unsigned key = (xb_xcc_id() << 8) | ((hwid >> 8) & 0xFFu);
      ((int*)smem)[(LDS_BYTES - 12) / 4] = (int)xb_add((unsigned*)(p.ws + OFF_ROLE) + key, 1u);
    }
    __syncthreads();
    p.role = __builtin_amdgcn_readfirstlane(((int*)smem)[(LDS_BYTES - 12) / 4]);
    for (int ph = 1; ph < hi; ++ph) {
      run_phase(p, ph, smem);
      if (ph + 1 < hi) xcd_barrier(p, b);
    }
  } else {
    for (int ph = lo; ph < hi; ++ph) run_phase(p, ph, smem);
  }
}

extern "C" void kernel_launch(void* const* d_in, const int* in_sizes, int n_in, void* d_out, int out_size, void* d_ws, size_t ws_size, hipStream_t stream) {
  Params p{};
  for (int i = 0; i < N_IN; ++i) p.in[i] = (const float*)d_in[i];
  p.out = (float*)d_out; p.ws = (char*)d_ws;
  if (ws_size < WS_NEED) fprintf(stderr, "workspace too small: %zu < %zu\n", ws_size, (size_t)WS_NEED);
  static int grid_blocks = 0;
  if (!grid_blocks) {
    int dev = 0, cus = 0, per_cu = 0;
    hipGetDevice(&dev);
    hipDeviceGetAttribute(&cus, hipDeviceAttributeMultiprocessorCount, dev);
    hipOccupancyMaxActiveBlocksPerMultiprocessor(&per_cu, mega<true>, NTHR, 0);
    if (per_cu > 2) per_cu = 2;
    grid_blocks = cus * per_cu;
  }
  int lo = 0, hi = NPHASE;
  void* args[] = {&p, &lo, &hi};
  hipError_t e = hipLaunchCooperativeKernel((void*)mega<true>, dim3(grid_blocks), dim3(NTHR), args, 0, stream);
  if (e != hipSuccess) fprintf(stderr, "cooperative launch failed: %s (grid %d)\n", hipGetErrorString(e), grid_blocks);
}
```

```cpp
#include <hip/hip_runtime.h>
#include <hip/hip_cooperative_groups.h>
#include <cstdio>
namespace cg = cooperative_groups;

typedef unsigned short bf16_t;
typedef short bf16x8 __attribute__((ext_vector_type(8)));
typedef float f32x4 __attribute__((ext_vector_type(4)));
typedef float f32x2 __attribute__((ext_vector_type(2)));
typedef float f32x16 __attribute__((ext_vector_type(16)));
typedef unsigned short u16x4 __attribute__((ext_vector_type(4)));
typedef unsigned short u16x2 __attribute__((ext_vector_type(2)));
typedef unsigned u32x4 __attribute__((ext_vector_type(4)));
typedef unsigned u32x2 __attribute__((ext_vector_type(2)));
static __device__ __forceinline__ unsigned pk2(float lo, float hi) { typedef __bf16 b2 __attribute__((ext_vector_type(2))); typedef float f2 __attribute__((ext_vector_type(2))); return __builtin_bit_cast(unsigned, __builtin_convertvector((f2){lo, hi}, b2)); }

#define DI __device__ __forceinline__
#define GAS __attribute__((address_space(1)))
template <class T> static __device__ __forceinline__ T* as_global(T* q) { return (T*)(GAS T*)(unsigned long long)q; }

constexpr int NT = 16384;
constexpr int DM = 1024;
constexpr int NTHR = 256;
constexpr int DIN = 9616;
constexpr int ZHW = 2560, ZRW = 1920, ZMW = 2048;
constexpr int WTIN_ROWS = 9728;
constexpr int DFF = 2816;

constexpr size_t OFF_WTIN = 0;
constexpr size_t OFF_WTBR = OFF_WTIN + (size_t)WTIN_ROWS * 1024 * 2;
constexpr size_t OFF_H    = OFF_WTBR + (size_t)3 * 1024 * 512 * 2;
constexpr size_t OFF_ZH   = OFF_H + (size_t)NT * 1024 * 2;
constexpr size_t OFF_ZR   = OFF_ZH + (size_t)NT * ZHW * 2;
constexpr size_t OFF_ZM   = OFF_ZR + (size_t)NT * ZRW * 2;
constexpr size_t OFF_MG   = OFF_ZM + (size_t)NT * ZMW * 2;
constexpr size_t OFF_O    = OFF_MG + (size_t)NT * 16 * 4;
constexpr size_t OFF_MOD  = OFF_O + (size_t)NT * 1024 * 2;
constexpr size_t OFF_LBS  = OFF_MOD + (size_t)2 * 5 * 6144 * 4;
constexpr size_t OFF_CTR  = OFF_LBS + 2 * 512 * 4;
constexpr size_t OFF_BAR  = OFF_CTR + 256;
constexpr size_t OFF_ROLE = OFF_BAR + 3456 * 4;
constexpr size_t WS_NEED  = OFF_ROLE + 4096 * 4;
constexpr size_t OFF_MODP = OFF_ZH;
constexpr size_t OFF_WTOUT = OFF_ZR;
constexpr size_t OFF_WTFI  = OFF_WTOUT + (size_t)1024 * 1024 * 2;
constexpr size_t OFF_WTFO  = OFF_WTFI + (size_t)5632 * 1024 * 2;
constexpr size_t OFF_MERGED = OFF_WTFO + (size_t)1024 * 2816 * 2;
constexpr size_t OFF_Y    = OFF_ZH;
constexpr size_t OFF_ACT  = OFF_ZM;

constexpr size_t OUT_HG = 16777216, OUT_RW = 25165824, OUT_C = 29360128, OUT_N = 37748736, OUT_M = 37814272;

enum { I_XP = 0, I_XS, I_SH, I_SR, I_SC, I_SN, I_SM, I_C, I_CCTX, I_WADA, I_BADA, I_NORMS, I_WIN, I_HLB, I_HNORM, I_MU, I_W0, I_W2,
       I_A0, I_A2, I_G2, I_KK, I_KA, I_RK, I_LN, I_GB, I_MNORM, I_WBR, I_WOUT, I_WFI, I_WFO, N_IN };

struct Params { const float* in[N_IN]; float* out; char* ws; int wb; int role; };

constexpr int LDS_BYTES = 77824;

DI bf16_t f2bf(float f) { return __builtin_bit_cast(unsigned short, (__bf16)f); }
DI float bf2f(bf16_t h) { return __uint_as_float(((unsigned)h) << 16); }
DI float sigmoidf_(float x) { return 1.0f / (1.0f + __expf(-x)); }
DI float siluf_(float x) { return x / (1.0f + __expf(-x)); }
DI float softplusf_(float x) { return x > 20.f ? x : __logf(1.0f + __expf(x)); }
DI float dpp_xor1(float x) { return __int_as_float(__builtin_amdgcn_mov_dpp(__float_as_int(x), 0xB1, 0xF, 0xF, true)); }
DI float dpp_xor2(float x) { return __int_as_float(__builtin_amdgcn_mov_dpp(__float_as_int(x), 0x4E, 0xF, 0xF, true)); }
DI float shfl_lane(float v, int src) { return __int_as_float(__builtin_amdgcn_ds_bpermute(src << 2, __float_as_int(v))); }
#define SHX(v, m) shfl_lane((v), lane ^ (m))
DI float wave_sum(float v, int lane) { v += dpp_xor1(v); v += dpp_xor2(v); v += SHX(v, 4); v += SHX(v, 8); v += SHX(v, 16); v += SHX(v, 32); return v; }
DI int ltid_(int wb) { int t = wb + (int)__builtin_amdgcn_mbcnt_hi(~0u, __builtin_amdgcn_mbcnt_lo(~0u, 0u)); asm volatile("" : "+v"(t)); return t; }
#define ltid() ltid_(p.wb)
DI int crow(int reg, int h) { return (reg & 3) + 8 * (reg >> 2) + 4 * h; }

DI int tok_cond(int tok) { return tok < 8192 ? 0 : 1 + ((tok - 8192) >> 11); }
DI const float* x_in_row(const Params& p, int tok) { return tok < 8192 ? p.in[I_XP] + (size_t)tok * DM : p.in[I_XS] + (size_t)(tok - 8192) * DM; }

DI void mma32(f32x16& acc, const bf16_t* A, int lda, const bf16_t* B, int ldb, int K, int lane) {
  const int r = lane & 31, h = lane >> 5;
#pragma unroll 2
  for (int kk = 0; kk < K; kk += 16) {
    bf16x8 a = *(const bf16x8*)(A + r * lda + kk + 8 * h);
    bf16x8 b = *(const bf16x8*)(B + r * ldb + kk + 8 * h);
    acc = __builtin_amdgcn_mfma_f32_32x32x16_bf16(a, b, acc, 0, 0, 0);
  }
}

template <int BM, int BN, int BK, bool WR, bool LD>
DI void gemm_ktile(f32x4 (&acc)[BM / 32][BN / 32], bf16x8 (&ra)[BM * BK / 2048], bf16x8 (&rb)[BN * BK / 2048],
                   const bf16_t* __restrict__ A, int lda, const bf16_t* __restrict__ B, int ldb, int k2,
                   const bf16_t* as, const bf16_t* bs, bf16_t* Aw, bf16_t* Bw) {
  constexpr int MI = BM / 32, NJ = BN / 32, LS = BK + 8, ACH = BM * BK / 2048, BCH = BN * BK / 2048, KS = BK / 32, RPI = 256 / (BK / 8);
  static_assert(KS * MI >= ACH + BCH, "not enough MFMA row blocks to carry the staging");
  __builtin_amdgcn_s_setprio(1);
#pragma unroll
  for (int ks = 0; ks < KS; ++ks) {
    bf16x8 afn = *(const bf16x8*)(as + ks * 32);
    bf16x8 bfr[NJ];
#pragma unroll
    for (int j = 0; j < NJ; ++j) bfr[j] = *(const bf16x8*)(bs + j * 16 * LS + ks * 32);
#pragma unroll
    for (int i = 0; i < MI; ++i) {
      const bf16x8 af = afn;
      if (i + 1 < MI) afn = *(const bf16x8*)(as + (i + 1) * 16 * LS + ks * 32);
#pragma unroll
      for (int j = 0; j < NJ; ++j) acc[i][j] = __builtin_amdgcn_mfma_f32_16x16x32_bf16(bfr[j], af, acc[i][j], 0, 0, 0);
      const int s = ks * MI + i;
      if (s < ACH) {
        if (WR) *(bf16x8*)(Aw + RPI * s * LS) = ra[s < ACH ? s : 0];
        if (LD) ra[s < ACH ? s : 0] = *(const bf16x8*)(A + (size_t)(RPI * s) * lda + k2);
      } else if (s < ACH + BCH) {
        const int c = s - ACH;
        if (WR) *(bf16x8*)(Bw + RPI * c * LS) = rb[(c >= 0 && c < BCH) ? c : 0];
        if (LD) rb[(c >= 0 && c < BCH) ? c : 0] = *(const bf16x8*)(B + (size_t)(RPI * c) * ldb + k2);
      }
      __builtin_amdgcn_sched_barrier(0);
    }
  }
  __builtin_amdgcn_s_setprio(0);
}

template <int BM, int BN, int BK>
DI void gemm_main(const Params& p, f32x4 (&acc)[BM / 32][BN / 32], bf16x8 (&ra)[BM * BK / 2048], bf16x8 (&rb)[BN * BK / 2048], bool primed,
                  const bf16_t* __restrict__ A, int lda, const bf16_t* __restrict__ B, int ldb, int K,
                  const bf16_t* __restrict__ An, int ldan, const bf16_t* __restrict__ Bn, int ldbn, bf16_t* sm) {
  constexpr int LS = BK + 8, CPR = BK / 8, ACH = BM * BK / 2048, BCH = BN * BK / 2048, RPI = 256 / CPR;
  const int tid = ltid(), lane = tid & 63, w = tid >> 6, wm = w >> 1, wn = w & 1;
  bf16_t* As = sm; bf16_t* Bs = sm + 2 * BM * LS;
  const int nk = K / BK;
  const int lrow = tid / CPR, lkc = (tid % CPR) * 8;
  const bf16_t* Ag = A + (size_t)lrow * lda + lkc;
  const bf16_t* Bg = B + (size_t)lrow * ldb + lkc;
  bf16_t* Al = As + lrow * LS + lkc; bf16_t* Bl = Bs + lrow * LS + lkc;
  if (!primed) {
#pragma unroll
    for (int i = 0; i < ACH; ++i) ra[i] = *(const bf16x8*)(Ag + (size_t)(RPI * i) * lda);
#pragma unroll
    for (int i = 0; i < BCH; ++i) rb[i] = *(const bf16x8*)(Bg + (size_t)(RPI * i) * ldb);
    __syncthreads();
#pragma unroll
    for (int i = 0; i < ACH; ++i) *(bf16x8*)(Al + RPI * i * LS) = ra[i];
#pragma unroll
    for (int i = 0; i < BCH; ++i) *(bf16x8*)(Bl + RPI * i * LS) = rb[i];
#pragma unroll
    for (int i = 0; i < ACH; ++i) ra[i] = *(const bf16x8*)(Ag + (size_t)(RPI * i) * lda + BK);
#pragma unroll
    for (int i = 0; i < BCH; ++i) rb[i] = *(const bf16x8*)(Bg + (size_t)(RPI * i) * ldb + BK);
    __syncthreads();
  }
  const bf16_t* as0 = As + (wm * (BM / 2) + (lane & 15)) * LS + (lane >> 4) * 8;
  const bf16_t* bs0 = Bs + (wn * (BN / 2) + (lane & 15)) * LS + (lane >> 4) * 8;
  int kt = 0;
  for (; kt + 2 < nk; ++kt) {
    const int buf = kt & 1, nb = buf ^ 1;
    gemm_ktile<BM, BN, BK, true, true>(acc, ra, rb, Ag, lda, Bg, ldb, (kt + 2) * BK, as0 + buf * BM * LS, bs0 + buf * BN * LS, Al + nb * BM * LS, Bl + nb * BN * LS);
    __syncthreads();
  }
  {
    const bf16_t* Agn = An + (size_t)lrow * ldan + lkc;
    const bf16_t* Bgn = Bn + (size_t)lrow * ldbn + lkc;
    gemm_ktile<BM, BN, BK, true, true>(acc, ra, rb, Agn, ldan, Bgn, ldbn, 0, as0, bs0, Al + BM * LS, Bl + BN * LS);
    __syncthreads();
    gemm_ktile<BM, BN, BK, true, true>(acc, ra, rb, Agn, ldan, Bgn, ldbn, BK, as0 + BM * LS, bs0 + BN * LS, Al, Bl);
    __syncthreads();
  }
}

template <int MI, int NJ> DI void zero_acc(f32x4 (&acc)[MI][NJ]) {
#pragma unroll
  for (int i = 0; i < MI; ++i)
#pragma unroll
    for (int j = 0; j < NJ; ++j) acc[i][j] = (f32x4){0.f, 0.f, 0.f, 0.f};
}
DI void store_bf4(bf16_t* dst, f32x4 v) { u16x4 o; o[0] = f2bf(v[0]); o[1] = f2bf(v[1]); o[2] = f2bf(v[2]); o[3] = f2bf(v[3]); *(u16x4*)dst = o; }

DI int map_col(int mode, int n) {
  if (mode == 0) return n < 6544 ? n : (n < 6656 ? -1 : n - 112);
  if (mode == 2) return ((n >> 4) & 1) ? DFF + (n >> 5) * 16 + (n & 15) : (n >> 5) * 16 + (n & 15);
  return n;
}
DI void conv_tile(const Params& p, const float* __restrict__ src, int ld_src, bf16_t* __restrict__ dst, int K, int mode, int tk, int tn, float* sm) {
  const int tid = ltid();
  __syncthreads();
  {
    const int nn = tid & 63, col = map_col(mode, tn * 64 + nn);
#pragma unroll
    for (int i = 0; i < 16; ++i) { int kk = (tid >> 6) + 4 * i; sm[kk * 65 + nn] = col >= 0 ? src[(size_t)(tk * 64 + kk) * ld_src + col] : 0.f; }
  }
  __syncthreads();
  {
    const int kk = tid & 63;
#pragma unroll
    for (int i = 0; i < 16; ++i) { int nn = (tid >> 6) + 4 * i; dst[(size_t)(tn * 64 + nn) * K + tk * 64 + kk] = f2bf(sm[kk * 65 + nn]); }
  }
}
DI void conv_weight(const Params& p, const float* src, int ld_src, bf16_t* dst, int K, int Ndst, int mode, float* sm, int bid, int nb) {
  const int tkn = K / 64, nt = tkn * (Ndst / 64);
  for (int t = bid; t < nt; t += nb) conv_tile(p, src, ld_src, dst, K, mode, t % tkn, t / tkn, sm);
}

DI void phase0(const Params& p, char* smem) {
  const int tid = ltid(), bid = blockIdx.x, nb = gridDim.x;
  float* MODP = (float*)(p.ws + OFF_MODP);
  float* sm = (float*)smem;
  if (bid == 0) { if (tid < 64) ((int*)(p.ws + OFF_CTR))[tid] = 0; for (int i = tid; i < 3456; i += NTHR) ((unsigned*)(p.ws + OFF_BAR))[i] = 0u; for (int i = tid; i < 4096; i += NTHR) ((unsigned*)(p.ws + OFF_ROLE))[i] = 0u; }
  for (int i = bid * NTHR + tid; i < 512; i += nb * NTHR) {
    float a = p.in[I_HLB][i], b = p.in[I_HLB][512 + i];
    float* L = (float*)(p.ws + OFF_LBS); L[i] = 0.f; L[512 + i] = 1.0f / (1.0f + expf(a - b));
  }
  for (int it = bid; it < 2 * 24 * 16; it += nb) {
    const int ks = it & 15, jb = (it >> 4) % 24, l = it / (16 * 24);
    __syncthreads();
    for (int e = tid; e < 5 * 64; e += NTHR) { int ci = e >> 6, k = ks * 64 + (e & 63); float cv = ci == 0 ? p.in[I_CCTX][k] : p.in[I_C][(ci - 1) * DM + k]; sm[e] = siluf_(cv); }
    __syncthreads();
    const int j = jb * 256 + tid;
    float a0 = 0, a1 = 0, a2 = 0, a3 = 0, a4 = 0;
    const float* W = p.in[I_WADA] + ((size_t)l * DM + ks * 64) * 6144 + j;
#pragma unroll 1
    for (int k0 = 0; k0 < 64; k0 += 16) {
      float wv[16];
#pragma unroll
      for (int u = 0; u < 16; ++u) wv[u] = W[(size_t)(k0 + u) * 6144];
#pragma unroll
      for (int u = 0; u < 16; ++u) { const int k = k0 + u; const float w = wv[u]; a0 += sm[k] * w; a1 += sm[64 + k] * w; a2 += sm[128 + k] * w; a3 += sm[192 + k] * w; a4 += sm[256 + k] * w; }
    }
    float* dst = MODP + ((size_t)(ks * 2 + l) * 5) * 6144 + j;
    dst[0] = a0; dst[6144] = a1; dst[2 * 6144] = a2; dst[3 * 6144] = a3; dst[4 * 6144] = a4;
  }
  conv_weight(p, p.in[I_WIN], DIN, (bf16_t*)(p.ws + OFF_WTIN), 1024, WTIN_ROWS, 0, sm, bid, nb);
  for (int br = 0; br < 3; ++br) conv_weight(p, p.in[I_WBR] + (size_t)br * 512 * 1024, 1024, (bf16_t*)(p.ws + OFF_WTBR) + (size_t)br * 1024 * 512, 512, 1024, 1, sm, bid, nb);
}
DI void phase1(const Params& p) {
  const float* MODP = (const float*)(p.ws + OFF_MODP);
  float* MOD = (float*)(p.ws + OFF_MOD);
  for (int i = blockIdx.x * NTHR + ltid(); i < 2 * 5 * 6144; i += gridDim.x * NTHR) {
    const int j = i % 6144, l = i / (5 * 6144);
    float s = p.in[I_BADA][l * 6144 + j];
    for (int ks = 0; ks < 16; ++ks) s += MODP[(size_t)ks * 2 * 5 * 6144 + i];
    MOD[i] = s;
  }
}

DI void norm_mod_store(const f32x4 (&x)[4], const float* nw, const float* sc, const float* sh, bf16_t* hrow, int lane) {
  float ss = 0.f;
#pragma unroll
  for (int i = 0; i < 4; ++i) ss += x[i][0] * x[i][0] + x[i][1] * x[i][1] + x[i][2] * x[i][2] + x[i][3] * x[i][3];
  ss = wave_sum(ss, lane);
  const float rs = rsqrtf(ss * (1.0f / DM) + 1e-6f);
#pragma unroll
  for (int i = 0; i < 4; ++i) {
    const int c = i * 256 + lane * 4;
    f32x4 w = *(const f32x4*)(nw + c), s1 = *(const f32x4*)(sc + c), s0 = *(const f32x4*)(sh + c), o;
#pragma unroll
    for (int e = 0; e < 4; ++e) o[e] = x[i][e] * rs * w[e] * (1.0f + s1[e]) + s0[e];
    store_bf4(hrow + c, o);
  }
}
DI const float* tok_xrow(const Params& p, int l, int mode, int tok) { const bool from_in = (l == 0 && (mode == 0 || mode == 1 || mode == 3)); return from_in ? x_in_row(p, tok) : p.out + (size_t)tok * DM; }
DI void tok_body(const Params& p, int l, int mode, int tok, int lane, f32x4 (&x)[4], f32x4 (&y)[4]) {
  const float* MOD = (const float*)(p.ws + OFF_MOD);
  bf16_t* H = (bf16_t*)(p.ws + OFF_H);
  const float* Y = (const float*)(p.ws + OFF_Y);
  const int ci = tok_cond(tok);
  const float* modl = MOD + (size_t)(l * 5 + ci) * 6144;
  const float* nwl = p.in[I_NORMS] + (size_t)l * 4 * DM;
  const bool has_y = (mode == 1 || mode == 2);
  const bool has_h = !(mode == 2 && l + 1 >= 2);
  const float* modn = (mode == 2 && has_h) ? MOD + (size_t)((l + 1) * 5 + ci) * 6144 : modl;
  const float* nw2 = mode == 1 ? nwl + 2 * DM : (mode == 2 ? p.in[I_NORMS] + (size_t)(has_h ? l + 1 : l) * 4 * DM : nwl);
  const float* sc2 = mode == 1 ? modl + 4 * DM : modn + 1 * DM;
  const float* sh2 = mode == 1 ? modl + 3 * DM : modn + 0 * DM;
  const float* nwy = nwl + (mode == 1 ? 1 : 3) * DM;
  const float* gy = modl + (mode == 1 ? 2 : 5) * DM;
  f32x4 wy[4], gg[4], w2[4], s1[4], s0[4];
#pragma unroll
  for (int i = 0; i < 4; ++i) {
    const int c = i * 256 + lane * 4;
    if (has_y) { wy[i] = *(const f32x4*)(nwy + c); gg[i] = *(const f32x4*)(gy + c); }
    if (has_h) { w2[i] = *(const f32x4*)(nw2 + c); s1[i] = *(const f32x4*)(sc2 + c); s0[i] = *(const f32x4*)(sh2 + c); }
  }
  if (has_y) {
    float ss = 0.f;
#pragma unroll
    for (int i = 0; i < 4; ++i) ss += y[i][0] * y[i][0] + y[i][1] * y[i][1] + y[i][2] * y[i][2] + y[i][3] * y[i][3];
    ss = wave_sum(ss, lane);
    const float rs = rsqrtf(ss * (1.0f / DM) + 1e-6f);
#pragma unroll
    for (int i = 0; i < 4; ++i) {
      const int c = i * 256 + lane * 4;
#pragma unroll
      for (int e = 0; e < 4; ++e) x[i][e] += gg[i][e] * (y[i][e] * rs * wy[i][e]);
      *(f32x4*)(p.out + (size_t)tok * DM + c) = x[i];
    }
  }
  if (has_h) {
    float ss = 0.f;
#pragma unroll
    for (int i = 0; i < 4; ++i) ss += x[i][0] * x[i][0] + x[i][1] * x[i][1] + x[i][2] * x[i][2] + x[i][3] * x[i][3];
    ss = wave_sum(ss, lane);
    const float rs = rsqrtf(ss * (1.0f / DM) + 1e-6f);
#pragma unroll
    for (int i = 0; i < 4; ++i) {
      f32x4 o;
#pragma unroll
      for (int e = 0; e < 4; ++e) o[e] = x[i][e] * rs * w2[i][e] * (1.0f + s1[i][e]) + s0[i][e];
      store_bf4(H + (size_t)tok * DM + i * 256 + lane * 4, o);
    }
  }
}
DI void tok_rows(const Params& p, int l, int mode, int tok, int lane, f32x4 (&x)[4], f32x4 (&y)[4]) {
  const float* xr = tok_xrow(p, l, mode, tok);
  const float* Y = (const float*)(p.ws + OFF_Y);
#pragma unroll
  for (int i = 0; i < 4; ++i) {
    const int c = i * 256 + lane * 4;
    x[i] = *(const f32x4*)(xr + c);
    if (mode == 1 || mode == 2) y[i] = *(const f32x4*)(Y + (size_t)tok * DM + c); else y[i] = (f32x4){0.f, 0.f, 0.f, 0.f};
  }
}
DI void tok_one(const Params& p, int l, int mode, int tok, int lane) {
  f32x4 x[4], y[4];
  tok_rows(p, l, mode, tok, lane, x, y);
  tok_body(p, l, mode, tok, lane, x, y);
}
DI void tok_phase(const Params& p, int l, int mode) {
  const int lane = ltid() & 63, gw = blockIdx.x * 4 + (ltid() >> 6), nw = gridDim.x * 4;
  f32x4 xn[4], yn[4];
  if (gw < NT) tok_rows(p, l, mode, gw, lane, xn, yn);
  for (int tok = gw; tok < NT; tok += nw) {
    f32x4 x[4], y[4];
#pragma unroll
    for (int i = 0; i < 4; ++i) { x[i] = xn[i]; y[i] = yn[i]; }
    if (tok + nw < NT) tok_rows(p, l, mode, tok + nw, lane, xn, yn);
    tok_body(p, l, mode, tok, lane, x, y);
  }
}

DI bool tile_xcd(int i, int NTN, int MTX, int& mt, int& nt) {
  const int G = gridDim.x, b = blockIdx.x, x = b & 7, j = b >> 3, nbx = (G - x + 7) >> 3;
  const int u = j + i * nbx;
  if (u >= MTX * NTN) return false;
  mt = MTX * x + (u % MTX); nt = u / MTX;
  return true;
}
DI void phase_inproj(const Params& p, char* smem) {
  const bf16_t* H = (const bf16_t*)(p.ws + OFF_H);
  const bf16_t* WT = (const bf16_t*)(p.ws + OFF_WTIN);
  bf16_t* ZH = (bf16_t*)(p.ws + OFF_ZH); bf16_t* ZR = (bf16_t*)(p.ws + OFF_ZR); bf16_t* ZM = (bf16_t*)(p.ws + OFF_ZM);
  float* MG = (float*)(p.ws + OFF_MG);
  bf16x8 ra[4], rb[2]; bool primed = false;
  int mt, nt; bool have = tile_xcd(0, 52, 8, mt, nt);
  for (int ti = 0; have; ++ti) {
    int mtn = 0, ntn = 0; const bool haven = tile_xcd(ti + 1, 52, 8, mtn, ntn);
    f32x4 acc[8][4]; zero_acc<8, 4>(acc);
    gemm_main<256, 128, 32>(p, acc, ra, rb, primed, H + (size_t)mt * 256 * 1024, 1024, WT + (size_t)nt * 128 * 1024, 1024, 1024,
                            H + (size_t)(haven ? mtn : mt) * 256 * 1024, 1024, WT + (size_t)(haven ? ntn : nt) * 128 * 1024, 1024, (bf16_t*)smem);
    primed = haven;
    const int lane = ltid() & 63, w = ltid() >> 6, wm = w >> 1, wn = w & 1; (void)wm; (void)wn;
    const int n0 = nt * 128;
#pragma unroll
    for (int i = 0; i < 8; ++i) {
      asm volatile("" ::: "memory");
      const int row = mt * 256 + wm * 128 + i * 16 + (lane & 15);
#pragma unroll
      for (int j = 0; j < 4; ++j) {
        const int col = n0 + wn * 64 + j * 16 + 4 * (lane >> 4);
        if (n0 < 2560) store_bf4(ZH + (size_t)row * ZHW + col, acc[i][j]);
        else if (n0 < 4480) store_bf4(ZR + (size_t)row * ZRW + (col - 2560), acc[i][j]);
        else if (n0 < 6528) store_bf4(ZM + (size_t)row * ZMW + (col - 4480), acc[i][j]);
        else if (col - 6528 < 16) *(f32x4*)(MG + (size_t)row * 16 + (col - 6528)) = acc[i][j];
      }
    }
    mt = mtn; nt = ntn; have = haven;
  }
}

DI void merge_sub(const Params& p, int mt, int nt, int s, const bf16_t*& A_, int& lda_, const bf16_t*& B_, int& ldb_, int& K_) {
  const bf16_t* H = (const bf16_t*)(p.ws + OFF_H);
  const bf16_t* WT = (const bf16_t*)(p.ws + OFF_WTIN);
  const bf16_t* WBR = (const bf16_t*)(p.ws + OFF_WTBR);
  const bf16_t* ZH = (const bf16_t*)(p.ws + OFF_ZH); const bf16_t* ZM = (const bf16_t*)(p.ws + OFF_ZM); const bf16_t* O = (const bf16_t*)(p.ws + OFF_O);
  const int br = s >> 1;
  if (!(s & 1)) { A_ = H + (size_t)mt * 128 * 1024; lda_ = 1024; B_ = WT + (size_t)(6656 + br * 1024 + nt * 128) * 1024; ldb_ = 1024; K_ = 1024; }
  else {
    const bf16_t* Ab; int lda;
    if (br == 0) { Ab = ZH + 2048; lda = ZHW; } else if (br == 1) { Ab = O; lda = 1024; } else { Ab = ZM + 1536; lda = ZMW; }
    A_ = Ab + (size_t)mt * 128 * lda; lda_ = lda; B_ = WBR + ((size_t)br * 1024 + nt * 128) * 512; ldb_ = 512; K_ = 512;
  }
}
DI void phase_merge(const Params& p, int l, char* smem) {
  bf16_t* MER = (bf16_t*)(p.ws + OFF_MERGED);
  unsigned* gsc = (unsigned*)(smem + 40960);
  bf16x8 ra[2], rb[2]; bool primed = false;
  int mt, nt; bool have = tile_xcd(0, 8, 16, mt, nt);
  for (int ti = 0; have; ++ti) {
    int mtn = 0, ntn = 0; const bool haven = tile_xcd(ti + 1, 8, 16, mtn, ntn);
    f32x4 accM[4][4]; zero_acc<4, 4>(accM);
#pragma unroll 1
    for (int br = 0; br < 3; ++br) {
      f32x4 acc[4][4]; zero_acc<4, 4>(acc);
      const bf16_t *A0, *B0, *A1, *B1, *A2, *B2; int la0, lb0, k0, la1, lb1, k1, la2, lb2, k2;
      merge_sub(p, mt, nt, 2 * br, A0, la0, B0, lb0, k0);
      merge_sub(p, mt, nt, 2 * br + 1, A1, la1, B1, lb1, k1);
      const bool more = (br < 2) || haven;
      if (br < 2) merge_sub(p, mt, nt, 2 * br + 2, A2, la2, B2, lb2, k2); else merge_sub(p, haven ? mtn : mt, haven ? ntn : nt, 0, A2, la2, B2, lb2, k2);
      gemm_main<128, 128, 32>(p, acc, ra, rb, primed, A0, la0, B0, lb0, k0, A1, la1, B1, lb1, (bf16_t*)smem);
      {
        const int tid_ = ltid();
#pragma unroll
        for (int i = 0; i < 4; ++i)
#pragma unroll
          for (int j = 0; j < 4; ++j) {
            gsc[((i * 4 + j) * 2 + 0) * 256 + tid_] = pk2(sigmoidf_(acc[i][j][0]), sigmoidf_(acc[i][j][1]));
            gsc[((i * 4 + j) * 2 + 1) * 256 + tid_] = pk2(sigmoidf_(acc[i][j][2]), sigmoidf_(acc[i][j][3]));
            acc[i][j] = (f32x4){0.f, 0.f, 0.f, 0.f};
          }
      }
      gemm_main<128, 128, 32>(p, acc, ra, rb, true, A1, la1, B1, lb1, k1, A2, la2, B2, lb2, (bf16_t*)smem);
      primed = more;
      {
        const int tid_ = ltid();
#pragma unroll
        for (int i = 0; i < 4; ++i)
#pragma unroll
          for (int j = 0; j < 4; ++j) {
            const unsigned g0 = gsc[((i * 4 + j) * 2 + 0) * 256 + tid_], g1 = gsc[((i * 4 + j) * 2 + 1) * 256 + tid_];
            accM[i][j][0] += __uint_as_float(g0 << 16) * acc[i][j][0]; accM[i][j][1] += __uint_as_float(g0 & 0xffff0000u) * acc[i][j][1];
            accM[i][j][2] += __uint_as_float(g1 << 16) * acc[i][j][2]; accM[i][j][3] += __uint_as_float(g1 & 0xffff0000u) * acc[i][j][3];
          }
      }
    }
    const int lane = ltid() & 63, w = ltid() >> 6, wm = w >> 1, wn = w & 1;
#pragma unroll
    for (int i = 0; i < 4; ++i) {
      const int row = mt * 128 + wm * 64 + i * 16 + (lane & 15);
#pragma unroll
      for (int j = 0; j < 4; ++j) store_bf4(MER + (size_t)row * 1024 + nt * 128 + wn * 64 + j * 16 + 4 * (lane >> 4), accM[i][j]);
    }
    mt = mtn; nt = ntn; have = haven;
  }
  float* sm = (float*)smem;
  conv_weight(p, p.in[I_WOUT] + (size_t)l * 1024 * 1024, 1024, (bf16_t*)(p.ws + OFF_WTOUT), 1024, 1024, 1, sm, blockIdx.x, gridDim.x);
  conv_weight(p, p.in[I_WFI] + (size_t)l * 1024 * 5632, 5632, (bf16_t*)(p.ws + OFF_WTFI), 1024, 5632, 2, sm, blockIdx.x, gridDim.x);
  conv_weight(p, p.in[I_WFO] + (size_t)l * DFF * 1024, 1024, (bf16_t*)(p.ws + OFF_WTFO), DFF, 1024, 1, sm, blockIdx.x, gridDim.x);
}

DI void phase_gemm_f32(const Params& p, const bf16_t* A, int K, const bf16_t* Wt, char* smem) {
  float* Y = (float*)(p.ws + OFF_Y);
  bf16x8 ra[4], rb[2]; bool primed = false;
  int mt, nt; bool have = tile_xcd(0, 8, 8, mt, nt);
  for (int ti = 0; have; ++ti) {
    int mtn = 0, ntn = 0; const bool haven = tile_xcd(ti + 1, 8, 8, mtn, ntn);
    f32x4 acc[8][4]; zero_acc<8, 4>(acc);
    gemm_main<256, 128, 32>(p, acc, ra, rb, primed, A + (size_t)mt * 256 * K, K, Wt + (size_t)nt * 128 * K, K, K,
                            A + (size_t)(haven ? mtn : mt) * 256 * K, K, Wt + (size_t)(haven ? ntn : nt) * 128 * K, K, (bf16_t*)smem);
    primed = haven;
    const int lane = ltid() & 63, w = ltid() >> 6, wm = w >> 1, wn = w & 1; (void)wm; (void)wn;
#pragma unroll
    for (int i = 0; i < 8; ++i) {
      asm volatile("" ::: "memory");
      const int row = mt * 256 + wm * 128 + i * 16 + (lane & 15);
#pragma unroll
      for (int j = 0; j < 4; ++j) *(f32x4*)(Y + (size_t)row * 1024 + nt * 128 + wn * 64 + j * 16 + 4 * (lane >> 4)) = acc[i][j];
    }
    mt = mtn; nt = ntn; have = haven;
  }
}
DI void phase_ffn_in(const Params& p, char* smem) {
  const bf16_t* H = (const bf16_t*)(p.ws + OFF_H);
  const bf16_t* Wt = (const bf16_t*)(p.ws + OFF_WTFI);
  bf16_t* ACT = (bf16_t*)(p.ws + OFF_ACT);
  bf16x8 ra[4], rb[2]; bool primed = false;
  int mt, nt; bool have = tile_xcd(0, 44, 8, mt, nt);
  for (int ti = 0; have; ++ti) {
    int mtn = 0, ntn = 0; const bool haven = tile_xcd(ti + 1, 44, 8, mtn, ntn);
    f32x4 acc[8][4]; zero_acc<8, 4>(acc);
    gemm_main<256, 128, 32>(p, acc, ra, rb, primed, H + (size_t)mt * 256 * 1024, 1024, Wt + (size_t)nt * 128 * 1024, 1024, 1024,
                            H + (size_t)(haven ? mtn : mt) * 256 * 1024, 1024, Wt + (size_t)(haven ? ntn : nt) * 128 * 1024, 1024, (bf16_t*)smem);
    primed = haven;
    const int lane = ltid() & 63, w = ltid() >> 6, wm = w >> 1, wn = w & 1; (void)wm; (void)wn;
#pragma unroll
    for (int i = 0; i < 8; ++i) {
      asm volatile("" ::: "memory");
      const int row = mt * 256 + wm * 128 + i * 16 + (lane & 15);
#pragma unroll
      for (int jj = 0; jj < 2; ++jj) {
        f32x4 u = acc[i][2 * jj], g = acc[i][2 * jj + 1], o;
#pragma unroll
        for (int e = 0; e < 4; ++e) o[e] = siluf_(g[e]) * u[e];
        const int col = (nt * 128 + wn * 64 + jj * 32) / 2 + 4 * (lane >> 4);
        store_bf4(ACT + (size_t)row * DFF + col, o);
      }
    }
    mt = mtn; nt = ntn; have = haven;
  }
}

struct Seq { int base, T, grid, b; bool sample; };
DI Seq get_seq(int s) { Seq q; if (s < 32) { q.base = s * 256; q.T = 256; q.grid = 0; q.b = s; q.sample = false; } else { q.b = s - 32; q.base = 8192 + q.b * 2048; q.T = 2048; q.grid = 1; q.sample = true; } return q; }

DI float rw_shift(const bf16_t* ZR, const float* mu, int base, int t, int T, int grid, int col) {
  const bf16_t* pp = ZR + (size_t)(base + t) * ZRW + col;
  const float y = bf2f(*pp);
  if (!grid) {
    const float prev = t > 0 ? bf2f(pp[-ZRW]) : 0.f, nxt = t < T - 1 ? bf2f(pp[ZRW]) : 0.f;
    return y + mu[col] * (prev - y) + mu[ZRW + col] * (nxt - y);
  }
  const int gc = t & 63, gr = t >> 6;
  const float left = gc > 0 ? bf2f(pp[-ZRW]) : 0.f, right = gc < 63 ? bf2f(pp[ZRW]) : 0.f;
  const float up = gr > 0 ? bf2f(pp[-64 * ZRW]) : 0.f, down = gr < 31 ? bf2f(pp[64 * ZRW]) : 0.f;
  return y + mu[col] * (left - y) + mu[ZRW + col] * (right - y) + mu[2 * ZRW + col] * (up - y) + mu[3 * ZRW + col] * (down - y);
}

DI void rw_shift8(const bf16_t* ZR, const float* mu, int base, int t, int T, int grid, int col0, float (&out)[8]) {
  const bf16_t* pp = ZR + (size_t)(base + t) * ZRW + col0;
  const bf16x8 y = *(const bf16x8*)pp;
  float yv[8];
#pragma unroll
  for (int e = 0; e < 8; ++e) { yv[e] = bf2f((bf16_t)y[e]); out[e] = yv[e]; }
  const int nn = grid ? 4 : 2;
#pragma unroll 1
  for (int n = 0; n < nn; ++n) {
    bool valid; int off;
    if (!grid) { valid = n == 0 ? t > 0 : t < T - 1; off = n == 0 ? -ZRW : ZRW; }
    else { const int gc = t & 63, gr = t >> 6; valid = n == 0 ? gc > 0 : n == 1 ? gc < 63 : n == 2 ? gr > 0 : gr < 31; off = n == 0 ? -ZRW : n == 1 ? ZRW : n == 2 ? -64 * ZRW : 64 * ZRW; }
    const f32x4 m0 = *(const f32x4*)(mu + n * ZRW + col0), m1 = *(const f32x4*)(mu + n * ZRW + col0 + 4);
    bf16x8 nb = y;
    if (valid) nb = *(const bf16x8*)(pp + off);
#pragma unroll
    for (int e = 0; e < 8; ++e) { const float nv_ = valid ? bf2f((bf16_t)nb[e]) : 0.f; const float mm = e < 4 ? m0[e & 3] : m1[e & 3]; out[e] += mm * (nv_ - yv[e]); }
  }
}

DI void rw_load8(const bf16_t* ZR, int base, int t, int T, int grid, int col0, bf16x8 (&v)[5]) {
  const bf16_t* pp = ZR + (size_t)(base + t) * ZRW + col0;
  const int gc = t & 63, gr = t >> 6;
  const int o1 = grid ? (gc > 0 ? -ZRW : 0) : (t > 0 ? -ZRW : 0);
  const int o2 = grid ? (gc < 63 ? ZRW : 0) : (t < T - 1 ? ZRW : 0);
  v[0] = *(const bf16x8*)pp;
  v[1] = *(const bf16x8*)(pp + o1);
  v[2] = *(const bf16x8*)(pp + o2);
  if (grid) {
    v[3] = *(const bf16x8*)(pp + (gr > 0 ? -64 * ZRW : 0)); v[4] = *(const bf16x8*)(pp + (gr < 31 ? 64 * ZRW : 0));
  } else {
    v[3] = (bf16x8){0, 0, 0, 0, 0, 0, 0, 0}; v[4] = (bf16x8){0, 0, 0, 0, 0, 0, 0, 0};
  }
}
DI unsigned rw_valid(int t, int T, int grid) {
  if (!grid) return (t > 0 ? 1u : 0u) | (t < T - 1 ? 2u : 0u);
  const int gc = t & 63, gr = t >> 6;
  return (gc > 0 ? 1u : 0u) | (gc < 63 ? 2u : 0u) | (gr > 0 ? 4u : 0u) | (gr < 31 ? 8u : 0u);
}
DI void rw_apply8(const bf16x8 (&v)[5], const float* mu, int grid, unsigned valid, int col0, float (&out)[8]) {
  float yv[8];
#pragma unroll
  for (int e = 0; e < 8; ++e) { yv[e] = bf2f((bf16_t)v[0][e]); out[e] = yv[e]; }
#pragma unroll
  for (int n = 0; n < 4; ++n) {
    if (n < 2 || grid) {
      const f32x4 m0 = *(const f32x4*)(mu + n * ZRW + col0), m1 = *(const f32x4*)(mu + n * ZRW + col0 + 4);
      const bool ok = (valid >> n) & 1u;
#pragma unroll
      for (int e = 0; e < 8; ++e) out[e] += (e < 4 ? m0[e & 3] : m1[e & 3]) * ((ok ? bf2f((bf16_t)v[1 + n][e]) : 0.f) - yv[e]);
    }
  }
}
DI void rw_apply8_lds(const bf16x8 (&v)[5], const float* mu5c, const float* c0c, int grid, unsigned valid, float (&out)[8]) {
  {
    const f32x4 c0 = *(const f32x4*)c0c, c1 = *(const f32x4*)(c0c + 4);
#pragma unroll
    for (int e = 0; e < 8; ++e) out[e] = bf2f((bf16_t)v[0][e]) * (e < 4 ? c0[e & 3] : c1[e & 3]);
  }
#pragma unroll
  for (int n = 0; n < 4; ++n) {
    if (n < 2 || grid) {
      const f32x4 m0 = *(const f32x4*)(mu5c + n * 320), m1 = *(const f32x4*)(mu5c + n * 320 + 4);
      const float ok = ((valid >> n) & 1u) ? 1.0f : 0.0f;
#pragma unroll
      for (int e = 0; e < 8; ++e) out[e] += (e < 4 ? m0[e & 3] : m1[e & 3]) * ok * bf2f((bf16_t)v[1 + n][e]);
    }
  }
}
DI float fast_tanh(float x) { return 1.0f - 2.0f / (1.0f + __expf(2.0f * x)); }
template <int N> DI float dpp_row_shr0(float x) { return __int_as_float(__builtin_amdgcn_update_dpp(0, __float_as_int(x), 0x110 + N, 0xF, 0xF, false)); }

DI void rwkv_item(const Params& p, int l, int s, int hh, int d, char* smem) {
  const Seq q = get_seq(s);
  const int tid0 = ltid();
  const int w = __builtin_amdgcn_readfirstlane(tid0 >> 6), vb = w >> 1, kb = w & 1;
  int tid = tid0, lane = tid & 63, l15 = lane & 15, qq = lane >> 4, r32 = lane & 31, h = lane >> 5;
  const bf16_t* ZR = (const bf16_t*)(p.ws + OFF_ZR);
  bf16_t* O = (bf16_t*)(p.ws + OFF_O);
  const float* mu = p.in[I_MU] + (size_t)l * 4 * ZRW;
  bf16_t* KHr = (bf16_t*)smem;
  bf16_t* BCr = KHr + 16 * 72;
  bf16_t* KC = BCr + 16 * 72;
  bf16_t* RH = KC + 16 * 72;
  bf16_t* Sb = RH + 16 * 72;
  bf16_t* Wb2 = (bf16_t*)smem;
  bf16_t* Ab2 = Wb2 + 64 * 72;
  float* mu5 = (float*)(smem + 18432);
  bf16_t* actW = (bf16_t*)(smem + 23552);
  bf16_t* actA = actW + 16 * 72;
  float* shR = (float*)(smem + 28160);
  float* shK = shR + 1024; float* shV = shK + 1024;
  bf16_t* VT0 = (bf16_t*)(smem + 40448);
  bf16_t* VT1 = (bf16_t*)(smem + 69376);
  bf16_t* UNT = VT0 + 64 * 40;
  bf16_t* KBT = UNT + 64 * 40;
  bf16_t* BBT = KBT + 64 * 24;
  float* PL = (float*)(smem + 56832);
  float* npart = PL + 64;
  float* MN = (float*)(smem + 57344);
  float* G0 = (float*)(smem + 61440);
  bf16_t* ArkM = (bf16_t*)(smem + 65536);
  bf16_t* ArbM = ArkM + 16 * 40;
  float* c0t = (float*)(smem + 68096);
  __syncthreads();
  for (int e = tid; e < 4096; e += NTHR) {
    const int i = e >> 6, c = e & 63;
    Wb2[c * 72 + i] = f2bf(p.in[I_W2][((size_t)(l * 2 + d) * 64 + i) * 512 + 64 * hh + c]);
    Ab2[c * 72 + i] = f2bf(p.in[I_A2][((size_t)(l * 2 + d) * 64 + i) * 512 + 64 * hh + c]);
  }
  for (int e = tid; e < 1280; e += NTHR) {
    const int n = e / 320, rem = e % 320, arr = rem >> 6, c = rem & 63;
    const int col = arr == 0 ? 64 * hh + c : arr == 1 ? 512 + 64 * hh + c : arr == 2 ? 1024 + 64 * hh + c : arr == 3 ? 1536 + 64 * d + c : 1664 + 64 * d + c;
    mu5[e] = mu[n * ZRW + col];
  }
  for (int e = tid; e < 320; e += NTHR) {
    const int arr = e >> 6, c = e & 63;
    const int col = arr == 0 ? 64 * hh + c : arr == 1 ? 512 + 64 * hh + c : arr == 2 ? 1024 + 64 * hh + c : arr == 3 ? 1536 + 64 * d + c : 1664 + 64 * d + c;
    float sm_ = mu[col] + mu[ZRW + col];
    if (q.grid) sm_ += mu[2 * ZRW + col] + mu[3 * ZRW + col];
    c0t[e] = 1.0f - sm_;
  }
  const int cB0 = 16 * w + 4 * qq;
  float w0c[4], a0c[4], kkc[4], kac[4];
#pragma unroll
  for (int g = 0; g < 4; ++g) {
    w0c[g] = p.in[I_W0][(l * 2 + d) * 512 + 64 * hh + cB0 + g]; a0c[g] = p.in[I_A0][(l * 2 + d) * 512 + 64 * hh + cB0 + g];
    kkc[g] = p.in[I_KK][l * 512 + 64 * hh + cB0 + g]; kac[g] = p.in[I_KA][l * 512 + 64 * hh + cB0 + g];
  }
  f32x16 S;
  if (q.sample) {
    const float* st = p.in[I_SR] + ((((size_t)q.b * 2 + l) * 2 + d) * 8 + hh) * 4096;
#pragma unroll
    for (int g = 0; g < 16; ++g) S[g] = st[(32 * vb + crow(g, h)) * 64 + 32 * kb + r32];
  } else {
#pragma unroll
    for (int g = 0; g < 16; ++g) S[g] = 0.f;
  }
  __syncthreads();
  bf16x8 bW[2], bA[2];
#pragma unroll
  for (int ks = 0; ks < 2; ++ks) { bW[ks] = *(const bf16x8*)(Wb2 + (16 * w + l15) * 72 + ks * 32 + qq * 8); bA[ks] = *(const bf16x8*)(Ab2 + (16 * w + l15) * 72 + ks * 32 + qq * 8); }
  __syncthreads();
  for (int e = tid; e < (2 * 64 * 40 + 2 * 64 * 24) / 2; e += NTHR) ((unsigned*)VT0)[e] = 0u;
  for (int e = tid; e < (64 * 40) / 2; e += NTHR) ((unsigned*)VT1)[e] = 0u;
  for (int e = tid; e < (2 * 16 * 40) / 2; e += NTHR) ((unsigned*)ArkM)[e] = 0u;
  __syncthreads();
  const int nch = q.T / 16;
  bf16x8 pf[3][5];
  const int jA = (tid0 & 127) >> 3, c8A = (tid0 & 7) * 8, wh = w >> 1;
#define RW_CB(arr) ((arr) == 0 ? 64 * hh : (arr) == 1 ? 512 + 64 * hh : (arr) == 2 ? 1024 + 64 * hh : (arr) == 3 ? 1536 + 64 * d : 1664 + 64 * d)
#define RW_ISSUE(chn) { const int pos = (chn) * 16 + jA, t = d ? q.T - 1 - pos : pos; _Pragma("unroll") for (int gi = 0; gi < 3; ++gi) { if (gi < 2 || w < 2) { \
      rw_load8(ZR, q.base, t, q.T, q.grid, RW_CB(2 * gi + wh) + c8A, pf[gi]); } } }
#pragma unroll
  for (int g = 0; g < 4; ++g) asm volatile("" : "+v"(w0c[g]), "+v"(a0c[g]), "+v"(kkc[g]), "+v"(kac[g]));
  asm volatile("" : "+v"(S));
  RW_ISSUE(0)
#pragma unroll 1
  for (int ch = 0; ch < nch; ++ch) {
    tid = tid0; asm volatile("" : "+v"(tid));
    lane = tid & 63; l15 = lane & 15; qq = lane >> 4; r32 = lane & 31; h = lane >> 5;
    bf16_t* VT = (ch & 1) ? VT1 : VT0;
    {
      const int pos_ = ch * 16 + jA, t_ = d ? q.T - 1 - pos_ : pos_;
      const unsigned vd_ = rw_valid(t_, q.T, q.grid);
#pragma unroll
      for (int gi = 0; gi < 3; ++gi) {
        if (gi < 2 || w < 2) {
          const int arr = 2 * gi + wh;
          float val[8];
          rw_apply8_lds(pf[gi], mu5 + arr * 64 + c8A, c0t + arr * 64 + c8A, q.grid, vd_, val);
          if (arr < 3) {
            *(f32x4*)(shR + arr * 1024 + jA * 64 + c8A) = (f32x4){val[0], val[1], val[2], val[3]};
            *(f32x4*)(shR + arr * 1024 + jA * 64 + c8A + 4) = (f32x4){val[4], val[5], val[6], val[7]};
            if (arr == 2) {
#pragma unroll
              for (int e = 0; e < 8; ++e) VT[(c8A + e) * 40 + jA] = f2bf(val[e]);
            }
          } else if (arr == 3) {
            *(u32x4*)(actW + jA * 72 + c8A) = (u32x4){pk2(fast_tanh(val[0]), fast_tanh(val[1])), pk2(fast_tanh(val[2]), fast_tanh(val[3])), pk2(fast_tanh(val[4]), fast_tanh(val[5])), pk2(fast_tanh(val[6]), fast_tanh(val[7]))};
          } else {
            *(u32x4*)(actA + jA * 72 + c8A) = (u32x4){pk2(val[0], val[1]), pk2(val[2], val[3]), pk2(val[4], val[5]), pk2(val[6], val[7])};
          }
        }
      }
    }
    asm volatile("" ::: "memory"); __builtin_amdgcn_sched_barrier(0);
    if (ch + 1 < nch) RW_ISSUE(ch + 1)
    __syncthreads();
    {
      f32x4 aw = (f32x4){0.f, 0.f, 0.f, 0.f}, aa = (f32x4){0.f, 0.f, 0.f, 0.f};
#pragma unroll
      for (int ks = 0; ks < 2; ++ks) {
        const bf16x8 fw = *(const bf16x8*)(actW + l15 * 72 + ks * 32 + qq * 8);
        const bf16x8 fa = *(const bf16x8*)(actA + l15 * 72 + ks * 32 + qq * 8);
        aw = __builtin_amdgcn_mfma_f32_16x16x32_bf16(bW[ks], fw, aw, 0, 0, 0);
        aa = __builtin_amdgcn_mfma_f32_16x16x32_bf16(bA[ks], fa, aa, 0, 0, 0);
      }
      const f32x4 kv = *(const f32x4*)(shK + l15 * 64 + cB0), rv = *(const f32x4*)(shR + l15 * 64 + cB0);
      float lw[4], av[4], kkr[4], kd[4], Lp[4], LpL[4];
      float ssq = 0.f;
#pragma unroll
      for (int g = 0; g < 4; ++g) {
        const float wl = aw[g] + w0c[g], al = aa[g] + a0c[g];
        lw[g] = -__expf(-softplusf_(-wl) - 0.5f);
        av[g] = sigmoidf_(al);
        kkr[g] = kv[g] * kkc[g];
        kd[g] = kv[g] * (1.0f + (av[g] - 1.0f) * kac[g]);
        ssq += kkr[g] * kkr[g];
        float x = lw[g];
        x += dpp_row_shr0<1>(x); x += dpp_row_shr0<2>(x); x += dpp_row_shr0<4>(x); x += dpp_row_shr0<8>(x);
        Lp[g] = x;
      }
#pragma unroll
      for (int g = 0; g < 4; ++g) { float x = Lp[g];
        x = fminf(x, __int_as_float(__builtin_amdgcn_mov_dpp(__float_as_int(x), 0x128, 0xF, 0xF, true))); x = fminf(x, __int_as_float(__builtin_amdgcn_mov_dpp(__float_as_int(x), 0x124, 0xF, 0xF, true)));
        x = fminf(x, dpp_xor2(x)); x = fminf(x, dpp_xor1(x)); LpL[g] = x; }
      ssq += SHX(ssq, 16); ssq += SHX(ssq, 32);
      if (qq == 0) npart[w * 16 + l15] = ssq;
      float e_m1[4], e_neg[4], e_pos[4], e_end[4];
#pragma unroll
      for (int g = 0; g < 4; ++g) { e_m1[g] = __expf(Lp[g] - lw[g]); e_neg[g] = __expf(-Lp[g]); e_pos[g] = __expf(Lp[g]); e_end[g] = __expf(LpL[g] - Lp[g]); }
      *(u32x2*)(KHr + l15 * 72 + cB0) = (u32x2){pk2(kkr[0] * e_m1[0], kkr[1] * e_m1[1]), pk2(kkr[2] * e_m1[2], kkr[3] * e_m1[3])};
      *(u32x2*)(BCr + l15 * 72 + cB0) = (u32x2){pk2(kkr[0] * av[0] * e_neg[0], kkr[1] * av[1] * e_neg[1]), pk2(kkr[2] * av[2] * e_neg[2], kkr[3] * av[3] * e_neg[3])};
      *(u32x2*)(KC + l15 * 72 + cB0) = (u32x2){pk2(kd[0] * e_neg[0], kd[1] * e_neg[1]), pk2(kd[2] * e_neg[2], kd[3] * e_neg[3])};
      *(u32x2*)(RH + l15 * 72 + cB0) = (u32x2){pk2(rv[0] * e_pos[0], rv[1] * e_pos[1]), pk2(rv[2] * e_pos[2], rv[3] * e_pos[3])};
#pragma unroll
      for (int g = 0; g < 4; ++g) {
        KBT[(cB0 + g) * 24 + l15] = f2bf(kd[g] * e_end[g]);
        BBT[(cB0 + g) * 24 + l15] = f2bf(kkr[g] * av[g] * e_end[g]);
      }
      if (l15 == 15) *(f32x4*)(PL + cB0) = (f32x4){e_pos[0], e_pos[1], e_pos[2], e_pos[3]};
#pragma unroll
      for (int g = 0; g < 16; ++g) Sb[(32 * vb + crow(g, h)) * 72 + 32 * kb + r32] = f2bf(S[g]);
    }
    __syncthreads();
    f32x4 oacc = (f32x4){0.f, 0.f, 0.f, 0.f};
    {
      const bf16_t* Aop = (w < 2) ? KHr : RH;
      const bf16_t* Bop = (w == 0 || w == 3) ? BCr : KC;
      f32x4 t16 = (f32x4){0.f, 0.f, 0.f, 0.f}, g0 = (f32x4){0.f, 0.f, 0.f, 0.f};
#pragma unroll
      for (int ks = 0; ks < 2; ++ks) {
        const bf16x8 a = *(const bf16x8*)(Aop + l15 * 72 + ks * 32 + qq * 8);
        const bf16x8 b = *(const bf16x8*)(Bop + l15 * 72 + ks * 32 + qq * 8);
        t16 = __builtin_amdgcn_mfma_f32_16x16x32_bf16(a, b, t16, 0, 0, 0);
        const bf16x8 akh = *(const bf16x8*)(KHr + l15 * 72 + ks * 32 + qq * 8);
        const bf16x8 arh = *(const bf16x8*)(RH + l15 * 72 + ks * 32 + qq * 8);
        const bf16x8 bs = *(const bf16x8*)(Sb + (16 * w + l15) * 72 + ks * 32 + qq * 8);
        g0 = __builtin_amdgcn_mfma_f32_16x16x32_bf16(akh, bs, g0, 0, 0, 0);
        oacc = __builtin_amdgcn_mfma_f32_16x16x32_bf16(arh, bs, oacc, 0, 0, 0);
      }
#pragma unroll
      for (int g = 0; g < 4; ++g) G0[(4 * qq + g) * 64 + 16 * w + l15] = g0[g];
      *(f32x4*)(MN + w * 256 + l15 * 16 + 4 * qq) = t16;
    }
    __syncthreads();
    if (w == 0) {
      const float* MrT = MN; const float* NrT = MN + 256;
      f32x2 acc2[8];
#pragma unroll
      for (int pq = 0; pq < 8; ++pq) acc2[pq] = (f32x2){G0[(2 * pq) * 64 + lane], G0[(2 * pq + 1) * 64 + lane]};
      float vv[16], un[16];
#pragma unroll
      for (int j = 0; j < 16; ++j) vv[j] = shV[j * 64 + lane];
      const float n2v = __builtin_amdgcn_rcpf(fmaxf(npart[l15] + npart[16 + l15] + npart[32 + l15] + npart[48 + l15], 1e-24f));
      f32x4 nr[4], mr[4];
#pragma unroll
      for (int t4 = 0; t4 < 4; ++t4) { nr[t4] = *(const f32x4*)(NrT + 4 * t4); mr[t4] = *(const f32x4*)(MrT + 4 * t4); }
#pragma unroll
      for (int j = 0; j < 16; ++j) {
        f32x4 nrn[4], mrn[4];
#pragma unroll
        for (int t4 = 0; t4 < 4; ++t4) { nrn[t4] = (f32x4){0.f, 0.f, 0.f, 0.f}; mrn[t4] = (f32x4){0.f, 0.f, 0.f, 0.f}; }
        if (j + 1 < 16) {
#pragma unroll
          for (int t4 = 0; t4 < 4; ++t4) if (4 * t4 + 3 > j + 1) { nrn[t4] = *(const f32x4*)(NrT + (j + 1) * 16 + 4 * t4); mrn[t4] = *(const f32x4*)(MrT + (j + 1) * 16 + 4 * t4); }
        }
        const float n2s = __int_as_float(__builtin_amdgcn_readlane(__float_as_int(n2v), j));
        const float unj = -acc2[j >> 1][j & 1] * n2s;
        un[j] = unj;
        const f32x2 vv2 = (f32x2){vv[j], vv[j]}, un2 = (f32x2){unj, unj};
#pragma unroll
        for (int pq = 0; pq < 8; ++pq)
          if (2 * pq + 1 > j) acc2[pq] += (f32x2){nr[pq >> 1][2 * (pq & 1)], nr[pq >> 1][2 * (pq & 1) + 1]} * vv2 + (f32x2){mr[pq >> 1][2 * (pq & 1)], mr[pq >> 1][2 * (pq & 1) + 1]} * un2;
#pragma unroll
        for (int t4 = 0; t4 < 4; ++t4) { nr[t4] = nrn[t4]; mr[t4] = mrn[t4]; }
        __builtin_amdgcn_sched_barrier(0);
      }
      *(u32x4*)(UNT + lane * 40) = (u32x4){pk2(un[0], un[1]), pk2(un[2], un[3]), pk2(un[4], un[5]), pk2(un[6], un[7])};
      *(u32x4*)(UNT + lane * 40 + 8) = (u32x4){pk2(un[8], un[9]), pk2(un[10], un[11]), pk2(un[12], un[13]), pk2(un[14], un[15])};
    } else if (w < 3) {
      const float* src = MN + (w == 1 ? 512 : 768);
      bf16_t* dst = (w == 1) ? ArkM : ArbM;
#pragma unroll
      for (int i = 0; i < 4; ++i) { const int e = lane + 64 * i, j = e >> 4, t = e & 15; dst[t * 40 + j] = f2bf(j <= t ? src[e] : 0.f); }
    }
    __syncthreads();
    {
      const bf16x8 ak = *(const bf16x8*)(ArkM + l15 * 40 + qq * 8), ab = *(const bf16x8*)(ArbM + l15 * 40 + qq * 8);
      const bf16x8 bv = *(const bf16x8*)(VT + (16 * w + l15) * 40 + qq * 8), bu = *(const bf16x8*)(UNT + (16 * w + l15) * 40 + qq * 8);
      oacc = __builtin_amdgcn_mfma_f32_16x16x32_bf16(ak, bv, oacc, 0, 0, 0);
      oacc = __builtin_amdgcn_mfma_f32_16x16x32_bf16(ab, bu, oacc, 0, 0, 0);
#pragma unroll
      for (int g = 0; g < 4; ++g) {
        const int pos = ch * 16 + 4 * qq + g, t = d ? q.T - 1 - pos : pos;
        O[(size_t)(q.base + t) * 1024 + d * 512 + 64 * hh + 16 * w + l15] = f2bf(oacc[g]);
      }
      const float pl = PL[32 * kb + r32];
#pragma unroll
      for (int g = 0; g < 16; ++g) S[g] *= pl;
      const bf16x8 av_ = *(const bf16x8*)(VT + (32 * vb + r32) * 40 + 8 * h), au_ = *(const bf16x8*)(UNT + (32 * vb + r32) * 40 + 8 * h);
      const bf16x8 bk_ = *(const bf16x8*)(KBT + (32 * kb + r32) * 24 + 8 * h), bb_ = *(const bf16x8*)(BBT + (32 * kb + r32) * 24 + 8 * h);
      S = __builtin_amdgcn_mfma_f32_32x32x16_bf16(av_, bk_, S, 0, 0, 0);
      S = __builtin_amdgcn_mfma_f32_32x32x16_bf16(au_, bb_, S, 0, 0, 0);
    }
  }
  if (!q.sample) {
    float* dst = p.out + OUT_RW + ((((size_t)q.b * 2 + l) * 2 + d) * 8 + hh) * 4096;
#pragma unroll
    for (int g = 0; g < 16; ++g) dst[(32 * vb + crow(g, h)) * 64 + 32 * kb + r32] = S[g];
  }
}

DI void hgrn_item(const Params& p, int l, int s, int hh, int d, char* smem) {
  const Seq q = get_seq(s);
  const int tid = ltid(), lane = tid & 63, w = tid >> 6, r = lane & 31, h = lane >> 5;
  bf16_t* ZH = (bf16_t*)(p.ws + OFF_ZH);
  bf16_t* Qt = (bf16_t*)smem;
  bf16_t* Kt = Qt + 32 * 136;
  bf16_t* KhT = Kt + 32 * 136;
  bf16_t* VT = KhT + 128 * 40;
  bf16_t* Sb = VT + 128 * 40;
  bf16_t* At = Sb + 4 * 32 * 136;
  float* dL = (float*)(At + 32 * 40);
  float* tot = dL + 128;
  const float lb = ((const float*)(p.ws + OFF_LBS))[l * 512 + 128 * hh + (tid & 127)];
  f32x16 S[4];
  if (q.sample) {
    const float* st = p.in[I_SH] + ((((size_t)q.b * 2 + l) * 2 + d) * 4 + hh) * 16384;
#pragma unroll
    for (int kb = 0; kb < 4; ++kb)
#pragma unroll
      for (int g = 0; g < 16; ++g) S[kb][g] = st[(size_t)(32 * kb + crow(g, h)) * 128 + 32 * w + r];
  } else {
#pragma unroll
    for (int kb = 0; kb < 4; ++kb)
#pragma unroll
      for (int g = 0; g < 16; ++g) S[kb][g] = 0.f;
  }
  const int k = tid & 127, half = tid >> 7;
  const int nch = q.T / 32;
  u16x2 pzq[16], pv2[8];
#define HG_ISSUE(chn) { _Pragma("unroll") for (int jj = 0; jj < 16; ++jj) { const int pos = (chn) * 32 + half * 16 + jj, t = d ? q.T - 1 - pos : pos; \
      const size_t rowo = (size_t)(q.base + t) * ZHW + 128 * hh + k; pzq[jj][0] = ZH[rowo + 512 * (1 + d)]; pzq[jj][1] = ZH[rowo]; pv2[jj >> 1][jj & 1] = ZH[rowo + 1536]; } }
  { float lb_ = lb; asm volatile("" : "+v"(lb_)); (void)lb_; }
#pragma unroll
  for (int kb = 0; kb < 4; ++kb) asm volatile("" : "+v"(S[kb]));
  HG_ISSUE(0)
#pragma unroll 1
  for (int ch = 0; ch < nch; ++ch) {
    __syncthreads();
    float bl[16], kc[16], qs[16];
    {
      float b = 0.f;
#pragma unroll
      for (int jj = 0; jj < 16; ++jj) {
        const float z = bf2f(pzq[jj][0]);
        const float kcoef = (1.0f - lb) * sigmoidf_(-z);
        const float f = 1.0f - kcoef;
        b += fmaxf(__logf(f), -80.f);
        bl[jj] = b; kc[jj] = kcoef; qs[jj] = bf2f(pzq[jj][1]) * 0.08838834764831845f;
      }
      *(u32x4*)(VT + k * 40 + half * 16) = (u32x4){__builtin_bit_cast(unsigned, pv2[0]), __builtin_bit_cast(unsigned, pv2[1]), __builtin_bit_cast(unsigned, pv2[2]), __builtin_bit_cast(unsigned, pv2[3])};
      *(u32x4*)(VT + k * 40 + half * 16 + 8) = (u32x4){__builtin_bit_cast(unsigned, pv2[4]), __builtin_bit_cast(unsigned, pv2[5]), __builtin_bit_cast(unsigned, pv2[6]), __builtin_bit_cast(unsigned, pv2[7])};
      tot[half * 128 + k] = b;
    }
    if (ch + 1 < nch) HG_ISSUE(ch + 1)
    __syncthreads();
    {
      const float off = half ? tot[k] : 0.f;
      const float bL = fmaxf(tot[k] + tot[128 + k], -80.f);
      if (half == 0) dL[k] = __expf(bL);
      float kh[16];
#pragma unroll
      for (int jj = 0; jj < 16; ++jj) {
        const int j = half * 16 + jj;
        const float bj = fmaxf(off + bl[jj], -80.f);
        Qt[j * 136 + k] = f2bf(qs[jj] * __expf(bj));
        Kt[j * 136 + k] = f2bf(kc[jj] * __expf(-bj));
        kh[jj] = kc[jj] * __expf(fminf(bL - bj, 0.f));
      }
      *(u32x4*)(KhT + k * 40 + half * 16) = (u32x4){pk2(kh[0], kh[1]), pk2(kh[2], kh[3]), pk2(kh[4], kh[5]), pk2(kh[6], kh[7])};
      *(u32x4*)(KhT + k * 40 + half * 16 + 8) = (u32x4){pk2(kh[8], kh[9]), pk2(kh[10], kh[11]), pk2(kh[12], kh[13]), pk2(kh[14], kh[15])};
    }
    bf16_t* Sbw = Sb + w * 32 * 136;
#pragma unroll
    for (int kb = 0; kb < 4; ++kb)
#pragma unroll
      for (int g4 = 0; g4 < 4; ++g4) *(u32x2*)(Sbw + r * 136 + 32 * kb + crow(4 * g4, h)) = (u32x2){pk2(S[kb][4 * g4], S[kb][4 * g4 + 1]), pk2(S[kb][4 * g4 + 2], S[kb][4 * g4 + 3])};
    __syncthreads();
    bf16_t* Atw = At;
    {
      f32x16 A;
#pragma unroll
      for (int g = 0; g < 16; ++g) A[g] = 0.f;
      mma32(A, Qt, 136, Kt, 136, 128, lane);
#pragma unroll
      for (int g = 0; g < 16; ++g) { const int t = crow(g, h); Atw[t * 40 + r] = f2bf(r <= t ? A[g] : 0.f); }
    }
    __syncthreads();
    {
      f32x16 o;
#pragma unroll
      for (int g = 0; g < 16; ++g) o[g] = 0.f;
      mma32(o, Atw, 40, VT + 32 * w * 40, 40, 32, lane);
      mma32(o, Qt, 136, Sbw, 136, 128, lane);
#pragma unroll
      for (int g = 0; g < 16; ++g) {
        const int j = crow(g, h), pos = ch * 32 + j, t = d ? q.T - 1 - pos : pos;
        ZH[(size_t)(q.base + t) * ZHW + 512 * (1 + d) + 128 * hh + 32 * w + r] = f2bf(o[g]);
      }
#pragma unroll
      for (int kb = 0; kb < 4; ++kb) {
#pragma unroll
        for (int g = 0; g < 16; ++g) S[kb][g] *= dL[32 * kb + crow(g, h)];
        mma32(S[kb], KhT + 32 * kb * 40, 40, VT + 32 * w * 40, 40, 32, lane);
      }
    }
  }
  if (!q.sample) {
    float* dst = p.out + OUT_HG + ((((size_t)q.b * 2 + l) * 2 + d) * 4 + hh) * 16384;
#pragma unroll
    for (int kb = 0; kb < 4; ++kb)
#pragma unroll
      for (int g = 0; g < 16; ++g) dst[(size_t)(32 * kb + crow(g, h)) * 128 + 32 * w + r] = S[kb][g];
  }
}

DI void mlstm_item(const Params& p, int l, int s, int hh, int d, char* smem) {
  const Seq q = get_seq(s);
  const int tid = ltid(), lane = tid & 63, w = tid >> 6, r = lane & 31, h = lane >> 5;
  const bf16_t* ZM = (const bf16_t*)(p.ws + OFF_ZM);
  const float* MG = (const float*)(p.ws + OFF_MG);
  bf16_t* Hb = (bf16_t*)(p.ws + OFF_H);
  bf16_t* Qm = (bf16_t*)smem;
  bf16_t* Km = Qm + 32 * 136;
  bf16_t* KwT = Km + 32 * 136;
  bf16_t* VT = KwT + 128 * 40;
  bf16_t* Cb = VT + 128 * 40;
  bf16_t* Pt = Cb + 4 * 32 * 136;
  float* nv = (float*)(Pt + 32 * 40);
  float* sc = nv + 128;
  float* ig = sc; float* lf = sc + 32; float* gg = sc + 64; float* mtv = sc + 96; float* wi = sc + 128; float* wsr = sc + 160; float* qn = sc + 192; float* misc = sc + 224;
  float* dnw = sc + 232;
  const float gbi = p.in[I_GB][l * 16 + (2 * d) * 4 + hh], gbf = p.in[I_GB][l * 16 + (2 * d + 1) * 4 + hh];
  f32x16 C[4];
  float m;
  __syncthreads();
  if (q.sample) {
    const size_t sb = (((size_t)q.b * 2 + l) * 2 + d) * 4 + hh;
    const float* st = p.in[I_SC] + sb * 16384;
#pragma unroll
    for (int kb = 0; kb < 4; ++kb)
#pragma unroll
      for (int g = 0; g < 16; ++g) C[kb][g] = st[(size_t)(32 * kb + crow(g, h)) * 128 + 32 * w + r];
    if (tid < 128) nv[tid] = p.in[I_SN][sb * 128 + tid];
    m = p.in[I_SM][sb];
  } else {
#pragma unroll
    for (int kb = 0; kb < 4; ++kb)
#pragma unroll
      for (int g = 0; g < 16; ++g) C[kb][g] = 0.f;
    if (tid < 128) nv[tid] = 0.f;
    m = 0.f;
  }
  const int nch = q.T / 32;
  const int dd = tid & 127, half = tid >> 7;
  u16x2 pqk[16], pv2[8]; float pgi = 0.f, pgf = 0.f;
#define ML_ISSUE(chn) { _Pragma("unroll") for (int jj = 0; jj < 16; ++jj) { const int pos = (chn) * 32 + half * 16 + jj, t = d ? q.T - 1 - pos : pos; \
      const size_t rowo = (size_t)(q.base + t) * ZMW + 128 * hh + dd; pqk[jj][0] = ZM[rowo]; pqk[jj][1] = ZM[rowo + 512]; pv2[jj >> 1][jj & 1] = ZM[rowo + 1024]; } \
    if (tid < 32) { const int pos = (chn) * 32 + tid, t = d ? q.T - 1 - pos : pos; const float* mg = MG + (size_t)(q.base + t) * 16; pgi = mg[(2 * d) * 4 + hh]; pgf = mg[(2 * d + 1) * 4 + hh]; } }
#pragma unroll
  for (int kb = 0; kb < 4; ++kb) asm volatile("" : "+v"(C[kb]));
  asm volatile("" : "+v"(m));
  ML_ISSUE(0)
#pragma unroll 1
  for (int ch = 0; ch < nch; ++ch) {
    __syncthreads();
    {
#pragma unroll
      for (int jj = 0; jj < 16; ++jj) {
        const int j = half * 16 + jj;
        Qm[j * 136 + dd] = pqk[jj][0];
        Km[j * 136 + dd] = f2bf(bf2f(pqk[jj][1]) * 0.08838834764831845f);
      }
      *(u32x4*)(VT + dd * 40 + half * 16) = (u32x4){__builtin_bit_cast(unsigned, pv2[0]), __builtin_bit_cast(unsigned, pv2[1]), __builtin_bit_cast(unsigned, pv2[2]), __builtin_bit_cast(unsigned, pv2[3])};
      *(u32x4*)(VT + dd * 40 + half * 16 + 8) = (u32x4){__builtin_bit_cast(unsigned, pv2[4]), __builtin_bit_cast(unsigned, pv2[5]), __builtin_bit_cast(unsigned, pv2[6]), __builtin_bit_cast(unsigned, pv2[7])};
      if (tid < 32) {
        const float igv = pgi + gbi;
        const float lfv = -softplusf_(-(pgf + gbf));
        float g = lfv;
#pragma unroll
        for (int o = 1; o < 32; o <<= 1) { const float tt = shfl_lane(g, (lane - o) & 63); if (tid >= o) g += tt; }
        const float cs = igv - g;
        float pm = cs;
#pragma unroll
        for (int o = 1; o < 32; o <<= 1) { const float tt = shfl_lane(pm, (lane - o) & 63); if (tid >= o) pm = fmaxf(pm, tt); }
        const float mt = g + fmaxf(m, pm);
        const float gend = shfl_lane(g, 31), mn = shfl_lane(mt, 31);
        ig[tid] = igv; gg[tid] = g; mtv[tid] = mt; wi[tid] = __expf(g + m - mt);
        wsr[tid] = __expf(gend + cs - mn);
        if (tid == 0) { misc[0] = mn; misc[1] = __expf(gend + m - mn); }
      }
    }
    if (ch + 1 < nch) ML_ISSUE(ch + 1)
    __syncthreads();
    {
      {
        float kw[16];
#pragma unroll
        for (int jj = 0; jj < 16; ++jj) { const int j = half * 16 + jj; kw[jj] = bf2f(Km[j * 136 + dd]) * wsr[j]; }
        *(u32x4*)(KwT + dd * 40 + half * 16) = (u32x4){pk2(kw[0], kw[1]), pk2(kw[2], kw[3]), pk2(kw[4], kw[5]), pk2(kw[6], kw[7])};
        *(u32x4*)(KwT + dd * 40 + half * 16 + 8) = (u32x4){pk2(kw[8], kw[9]), pk2(kw[10], kw[11]), pk2(kw[12], kw[13]), pk2(kw[14], kw[15])};
      }
      const int j = tid >> 3, seg = tid & 7;
      float a = 0.f;
#pragma unroll
      for (int i = 0; i < 16; ++i) a += bf2f(Qm[j * 136 + seg * 16 + i]) * nv[seg * 16 + i];
      a += SHX(a, 1); a += SHX(a, 2); a += SHX(a, 4);
      if (seg == 0) qn[j] = a;
    }
    const float m_new = misc[0], carry = misc[1];
    bf16_t* Cbw = Cb + w * 32 * 136; bf16_t* Ptw = Pt;
#pragma unroll
    for (int kb = 0; kb < 4; ++kb)
#pragma unroll
      for (int g4 = 0; g4 < 4; ++g4) *(u32x2*)(Cbw + r * 136 + 32 * kb + crow(4 * g4, h)) = (u32x2){pk2(C[kb][4 * g4], C[kb][4 * g4 + 1]), pk2(C[kb][4 * g4 + 2], C[kb][4 * g4 + 3])};
    {
      f32x16 Sc;
#pragma unroll
      for (int g = 0; g < 16; ++g) Sc[g] = 0.f;
      mma32(Sc, Qm, 136, Km, 136, 128, lane);
      const float gs = gg[r], is = ig[r];
#pragma unroll
      for (int g = 0; g < 16; ++g) {
        const int t = crow(g, h);
        const float pv = (r <= t) ? __expf(gg[t] - gs + is - mtv[t]) * Sc[g] : 0.f;
        Ptw[t * 40 + r] = f2bf(pv);
      }
    }
    __syncthreads();
    if (lane < 32) {
      float a = 0.f;
#pragma unroll 4
      for (int i = 0; i < 32; ++i) a += bf2f(Ptw[lane * 40 + i]);
      const float den = wi[lane] * qn[lane] + a;
      dnw[lane] = 1.0f / fmaxf(fabsf(den), __expf(-mtv[lane]));
    }
    if (tid < 128) {
      float a = 0.f;
#pragma unroll 4
      for (int i = 0; i < 32; ++i) a += bf2f(KwT[tid * 40 + i]);
      nv[tid] = carry * nv[tid] + a;
    }
    __syncthreads();
    {
      f32x16 a1;
#pragma unroll
      for (int g = 0; g < 16; ++g) a1[g] = 0.f;
      mma32(a1, Qm, 136, Cbw, 136, 128, lane);
#pragma unroll
      for (int g = 0; g < 16; ++g) a1[g] *= wi[crow(g, h)];
      mma32(a1, Ptw, 40, VT + 32 * w * 40, 40, 32, lane);
#pragma unroll
      for (int g = 0; g < 16; ++g) {
        const int j = crow(g, h), pos = ch * 32 + j, t = d ? q.T - 1 - pos : pos;
        const float hv = a1[g] * dnw[j];
        Hb[(size_t)(q.base + t) * 1024 + d * 512 + 128 * hh + 32 * w + r] = f2bf(hv);
      }
#pragma unroll
      for (int kb = 0; kb < 4; ++kb) {
#pragma unroll
        for (int g = 0; g < 16; ++g) C[kb][g] *= carry;
        mma32(C[kb], KwT + 32 * kb * 40, 40, VT + 32 * w * 40, 40, 32, lane);
      }
    }
    m = m_new;
  }
  __syncthreads();
  if (!q.sample) {
    const size_t sb = (((size_t)q.b * 2 + l) * 2 + d) * 4 + hh;
    float* dst = p.out + OUT_C + sb * 16384;
#pragma unroll
    for (int kb = 0; kb < 4; ++kb)
#pragma unroll
      for (int g = 0; g < 16; ++g) dst[(size_t)(32 * kb + crow(g, h)) * 128 + 32 * w + r] = C[kb][g];
    if (tid < 128) p.out[OUT_N + sb * 128 + tid] = nv[tid];
    if (tid == 0) p.out[OUT_M + sb] = m;
  }
}

DI void phase_scan(const Params& p, int l, char* smem) {
  int* ctrL = (int*)(p.ws + OFF_CTR) + 2 * l;
  int* ctrS = ctrL + 1;
  int* sit = (int*)(smem + LDS_BYTES - 16);
  const int role = p.role;
  bool longDone = false, shortDone = false;
  for (;;) {
    const bool wantLong = (role == 0) ? !longDone : shortDone;
    if (longDone && shortDone) break;
    __syncthreads();
    if (ltid() == 0) *sit = atomicAdd(wantLong ? ctrL : ctrS, 1);
    __syncthreads();
    int it = __builtin_amdgcn_readfirstlane(*sit);
    int ty, s_, hh_, d_, rb_ = 0;
    if (wantLong) {
      if (it >= 128) { longDone = true; continue; }
      if (it < 64) { ty = 0; d_ = it & 1; hh_ = (it >> 1) & 7; s_ = 32 + (it >> 4); }
      else if (it < 96) { it -= 64; ty = 1; s_ = 32 + (it >> 3); hh_ = (it >> 1) & 3; d_ = it & 1; }
      else { it -= 96; ty = 2; s_ = 32 + (it >> 3); hh_ = (it >> 1) & 3; d_ = it & 1; }
    } else {
      if (it >= 1024) { shortDone = true; continue; }
      if (it < 512) { ty = 0; s_ = it >> 4; hh_ = (it >> 1) & 7; d_ = it & 1; }
      else if (it < 768) { it -= 512; ty = 1; s_ = it >> 3; hh_ = (it >> 1) & 3; d_ = it & 1; }
      else { it -= 768; ty = 2; s_ = it >> 3; hh_ = (it >> 1) & 3; d_ = it & 1; }
    }
    if (ty == 0) rwkv_item(p, l, s_, hh_, d_, smem);
    else if (ty == 1) hgrn_item(p, l, s_, hh_, d_, smem);
    else mlstm_item(p, l, s_, hh_, d_, smem);
  }
}

DI void phase_combine(const Params& p, int l, char* smem) {
  const int tid = ltid(), lane = tid & 63, w = tid >> 6;
  bf16_t* ZH = (bf16_t*)(p.ws + OFF_ZH); bf16_t* ZM = (bf16_t*)(p.ws + OFF_ZM); const bf16_t* ZR = (const bf16_t*)(p.ws + OFF_ZR);
  bf16_t* O = (bf16_t*)(p.ws + OFF_O); const bf16_t* Hb = (const bf16_t*)(p.ws + OFF_H);
  const float* mu = p.in[I_MU] + (size_t)l * 4 * ZRW;
  const float* g2 = p.in[I_G2] + (size_t)l * 128 * 512;
  float* sg = (float*)smem;
  float* gt = sg + 128 * 16;
  for (int blk = blockIdx.x; blk < NT / 16; blk += gridDim.x) {
    const int tok0 = blk * 16;
    int sidx, t0;
    if (tok0 < 8192) { sidx = tok0 >> 8; t0 = tok0 & 255; } else { sidx = 32 + ((tok0 - 8192) >> 11); t0 = (tok0 - 8192) & 2047; }
    const Seq q = get_seq(sidx);
    __syncthreads();
    { const int j = tid >> 4, rr0 = (tid & 15) * 8; float val[8]; bf16x8 pv[5]; rw_load8(ZR, q.base, t0 + j, q.T, q.grid, 1792 + rr0, pv); rw_apply8(pv, mu, q.grid, rw_valid(t0 + j, q.T, q.grid), 1792 + rr0, val);
#pragma unroll
      for (int e = 0; e < 8; ++e) sg[(rr0 + e) * 16 + j] = sigmoidf_(val[e]); }
    __syncthreads();
    {
      float a0[16], a1[16];
#pragma unroll
      for (int j = 0; j < 16; ++j) { a0[j] = 0.f; a1[j] = 0.f; }
#pragma unroll 1
      for (int r0 = 0; r0 < 128; r0 += 8) {
        float w0v[8], w1v[8];
#pragma unroll
        for (int q8 = 0; q8 < 8; ++q8) { w0v[q8] = g2[(r0 + q8) * 512 + tid]; w1v[q8] = g2[(r0 + q8) * 512 + 256 + tid]; }
#pragma unroll
        for (int q8 = 0; q8 < 8; ++q8) {
          const int rr = r0 + q8; const float w0 = w0v[q8], w1 = w1v[q8];
#pragma unroll
          for (int u = 0; u < 4; ++u) {
            f32x4 sv = *(const f32x4*)(sg + rr * 16 + 4 * u);
#pragma unroll
            for (int e = 0; e < 4; ++e) { a0[4 * u + e] += sv[e] * w0; a1[4 * u + e] += sv[e] * w1; }
          }
        }
      }
#pragma unroll
      for (int j = 0; j < 16; ++j) { gt[j * 512 + tid] = a0[j]; gt[j * 512 + 256 + tid] = a1[j]; }
    }
    __syncthreads();
#pragma unroll 1
    for (int jj = 0; jj < 4; ++jj) {
      const int j = w * 4 + jj, tok = tok0 + j, t = t0 + j; int c0 = lane * 8; asm volatile("" : "+v"(c0));
      {
        float o[8], rs[8], ks[8], vs[8];
        float sum = 0.f, bon = 0.f;
        {
          bf16x8 pr_[5], pk_[5], pv_[5];
          rw_load8(ZR, q.base, t, q.T, q.grid, c0, pr_); rw_load8(ZR, q.base, t, q.T, q.grid, 512 + c0, pk_); rw_load8(ZR, q.base, t, q.T, q.grid, 1024 + c0, pv_);
          const unsigned vd_ = rw_valid(t, q.T, q.grid);
          rw_apply8(pr_, mu, q.grid, vd_, c0, rs); rw_apply8(pk_, mu, q.grid, vd_, 512 + c0, ks); rw_apply8(pv_, mu, q.grid, vd_, 1024 + c0, vs);
        }
        const bf16x8 of = *(const bf16x8*)(O + (size_t)tok * 1024 + c0), ob = *(const bf16x8*)(O + (size_t)tok * 1024 + 512 + c0);
        const f32x4 rk0 = *(const f32x4*)(p.in[I_RK] + l * 512 + c0), rk1 = *(const f32x4*)(p.in[I_RK] + l * 512 + c0 + 4);
#pragma unroll
        for (int e = 0; e < 8; ++e) {
          o[e] = bf2f((bf16_t)of[e]) + bf2f((bf16_t)ob[e]);
          sum += o[e];
          bon += rs[e] * ks[e] * (e < 4 ? rk0[e & 3] : rk1[e & 3]);
        }
        sum += SHX(sum, 1); sum += SHX(sum, 2); sum += SHX(sum, 4);
        bon += SHX(bon, 1); bon += SHX(bon, 2); bon += SHX(bon, 4);
        const float mean = sum * (1.0f / 64.f);
        float var = 0.f;
#pragma unroll
        for (int e = 0; e < 8; ++e) { const float dv = o[e] - mean; var += dv * dv; }
        var += SHX(var, 1); var += SHX(var, 2); var += SHX(var, 4);
        const float rstd = rsqrtf(var * (1.0f / 64.f) + 64e-5f);
        const f32x4 lw0 = *(const f32x4*)(p.in[I_LN] + (l * 2 + 0) * 512 + c0), lw1 = *(const f32x4*)(p.in[I_LN] + (l * 2 + 0) * 512 + c0 + 4);
        const f32x4 lb0 = *(const f32x4*)(p.in[I_LN] + (l * 2 + 1) * 512 + c0), lb1 = *(const f32x4*)(p.in[I_LN] + (l * 2 + 1) * 512 + c0 + 4);
        const f32x4 gt0 = *(const f32x4*)(gt + j * 512 + c0), gt1 = *(const f32x4*)(gt + j * 512 + c0 + 4);
        bf16x8 ov;
#pragma unroll
        for (int e = 0; e < 8; ++e) {
          const float ln = (o[e] - mean) * rstd * (e < 4 ? lw0[e & 3] : lw1[e & 3]) + (e < 4 ? lb0[e & 3] : lb1[e & 3]);
          ov[e] = (short)f2bf((ln + bon * vs[e]) * (e < 4 ? gt0[e & 3] : gt1[e & 3]));
        }
        *(bf16x8*)(O + (size_t)tok * 1024 + c0) = ov;
      }
      {
        float o[8]; float ss = 0.f;
        bf16_t* zr_ = ZH + (size_t)tok * ZHW + c0;
        const bf16x8 of = *(const bf16x8*)(zr_ + 512), ob = *(const bf16x8*)(zr_ + 1024), hgv = *(const bf16x8*)(zr_ + 2048);
        const f32x4 nw0 = *(const f32x4*)(p.in[I_HNORM] + l * 512 + c0), nw1 = *(const f32x4*)(p.in[I_HNORM] + l * 512 + c0 + 4);
#pragma unroll
        for (int e = 0; e < 8; ++e) { o[e] = bf2f((bf16_t)of[e]) + bf2f((bf16_t)ob[e]); ss += o[e] * o[e]; }
        ss += SHX(ss, 1); ss += SHX(ss, 2); ss += SHX(ss, 4); ss += SHX(ss, 8);
        const float rsd = rsqrtf(ss * (1.0f / 128.f) + 1e-6f);
        bf16x8 ov;
#pragma unroll
        for (int e = 0; e < 8; ++e) ov[e] = (short)f2bf(o[e] * rsd * (e < 4 ? nw0[e & 3] : nw1[e & 3]) * siluf_(bf2f((bf16_t)hgv[e])));
        *(bf16x8*)(zr_ + 2048) = ov;
      }
      {
        float o[8]; float ss = 0.f;
        bf16_t* zm_ = ZM + (size_t)tok * ZMW + 1536 + c0;
        const bf16x8 of = *(const bf16x8*)(Hb + (size_t)tok * 1024 + c0), ob = *(const bf16x8*)(Hb + (size_t)tok * 1024 + 512 + c0), mov = *(const bf16x8*)zm_;
        const f32x4 nw0 = *(const f32x4*)(p.in[I_MNORM] + l * 512 + c0), nw1 = *(const f32x4*)(p.in[I_MNORM] + l * 512 + c0 + 4);
#pragma unroll
        for (int e = 0; e < 8; ++e) { o[e] = bf2f((bf16_t)of[e]) + bf2f((bf16_t)ob[e]); ss += o[e] * o[e]; }
        ss += SHX(ss, 1); ss += SHX(ss, 2); ss += SHX(ss, 4); ss += SHX(ss, 8);
        const float rsd = rsqrtf(ss * (1.0f / 128.f) + 1e-6f);
        bf16x8 ov;
#pragma unroll
        for (int e = 0; e < 8; ++e) ov[e] = (short)f2bf(o[e] * rsd * (e < 4 ? nw0[e & 3] : nw1[e & 3]) * sigmoidf_(bf2f((bf16_t)mov[e])));
        *(bf16x8*)zm_ = ov;
      }
    }
    __syncthreads();
#pragma unroll 1
    for (int jj = 0; jj < 4; ++jj) tok_one(p, l, 3, tok0 + w * 4 + jj, lane);
  }
}

#define XB_TMO      128
#define XB_XCNT(j)  (256  + 64 * (j))
#define XB_XSUB(j)  (1280 + 64 * (j))
#define XB_XGEN(j)  (2304 + 64 * (j))
#define XB_TOP      3328
#define XB_TOPGEN   3392
#define XCD_BAR_WORDS 3456
#define XB_SPIN_CAP (1u << 20)
#define LAS __attribute__((address_space(3)))
DI unsigned xb_ld(unsigned* p)              { return __hip_atomic_load(p, __ATOMIC_RELAXED, __HIP_MEMORY_SCOPE_AGENT); }
DI unsigned xb_add(unsigned* p, unsigned v) { return __hip_atomic_fetch_add(p, v, __ATOMIC_RELAXED, __HIP_MEMORY_SCOPE_AGENT); }
DI unsigned xb_xcc_id() { return (unsigned)__builtin_amdgcn_s_getreg((3 << 11) | 20) & 0xFu; }
#define XB_SPIN(cond, bar) do { unsigned _sp = 0; while (cond) { __builtin_amdgcn_s_sleep(1); \
    if ((++_sp & 255u) == 0u) { if (xb_ld(&(bar)[XB_TMO])) break; if (_sp > XB_SPIN_CAP) { atomicAdd(&(bar)[XB_TMO], 1u); break; } } } } while (0)
struct XcdBarrier { unsigned* bar; unsigned x; volatile LAS unsigned* st; };
DI XcdBarrier xcd_barrier_post(const Params& p, unsigned* bar, volatile LAS unsigned* st) {
  XcdBarrier b; b.bar = bar; b.x = xb_xcc_id(); b.st = st;
  if (ltid() == 0) (void)xb_add(&bar[XB_XCNT(b.x)], 1u);
  return b;
}
DI void xcd_barrier_complete(unsigned* bar, unsigned x, unsigned& nloc, unsigned& nx) {
  const unsigned G = gridDim.x * gridDim.y * gridDim.z;
  unsigned sum, cnt, mine, sp = 0u;
  for (;;) {
    sum = 0u; cnt = 0u; mine = 0u;
#pragma unroll
    for (unsigned j = 0; j < 16; ++j) { const unsigned c = xb_ld(&bar[XB_XCNT(j)]); sum += c; cnt += (c > 0u) ? 1u : 0u; mine = (j == x) ? c : mine; }
    if (sum == G) break;
    __builtin_amdgcn_s_sleep(1);
    if ((++sp & 255u) == 0u) { if (xb_ld(&bar[XB_TMO])) break; if (sp > XB_SPIN_CAP) { atomicAdd(&bar[XB_TMO], 1u); break; } }
  }
  nloc = mine > 0u ? mine : 1u; nx = cnt > 0u ? cnt : 1u;
}
DI void xcd_barrier(const Params& p, const XcdBarrier& b) {
  asm volatile("s_waitcnt vmcnt(0)" ::: "memory");
  __syncthreads();
  if (ltid() == 0) {
    unsigned* bar = b.bar;
    __builtin_amdgcn_s_waitcnt(0);
    unsigned nloc = b.st[0], nx = b.st[1];
    if (nloc == 0u) { xcd_barrier_complete(bar, b.x, nloc, nx); b.st[0] = nloc; b.st[1] = nx; }
    const unsigned old = xb_add(&bar[XB_XSUB(b.x)], 1u);
    const unsigned gen = old / nloc;
    if (old + 1u == (gen + 1u) * nloc) {
      __builtin_amdgcn_fence(__ATOMIC_RELEASE, "agent");
      asm volatile("s_waitcnt vmcnt(0)" ::: "memory");
      const unsigned og = xb_add(&bar[XB_TOP], 1u);
      const unsigned tg = og / nx;
      if (og + 1u == (tg + 1u) * nx) xb_add(&bar[XB_TOPGEN], 1u);
      else XB_SPIN(xb_ld(&bar[XB_TOPGEN]) == tg, bar);
      __builtin_amdgcn_fence(__ATOMIC_ACQUIRE, "agent");
      xb_add(&bar[XB_XGEN(b.x)], 1u);
      asm volatile("s_waitcnt vmcnt(0)" ::: "memory");
    } else {
      XB_SPIN(xb_ld(&bar[XB_XGEN(b.x)]) == gen, bar);
      __builtin_amdgcn_fence(__ATOMIC_ACQUIRE, "agent");
      asm volatile("s_waitcnt vmcnt(0)" ::: "memory");
    }
  }
  __syncthreads();
}

constexpr int NPHASE = 3 + 9 * 2;
DI void run_phase(const Params& p0, int ph, char* smem) {
  Params p = p0;
  asm volatile("" : "+s"(p.ws), "+s"(p.out));
  p.ws = as_global(p.ws); p.out = as_global(p.out);
  if (ph == 0) { phase0(p, smem); return; }
  if (ph == 1) { phase1(p); return; }
  if (ph == 2) { tok_phase(p, 0, 0); return; }
  const int l = (ph - 3) / 9, s = (ph - 3) % 9;
  switch (s) {
    case 0: phase_inproj(p, smem); break;
    case 1: phase_scan(p, l, smem); break;
    case 2: phase_combine(p, l, smem); break;
    case 3: phase_merge(p, l, smem); break;
    case 4: phase_gemm_f32(p, (const bf16_t*)(p.ws + OFF_MERGED), 1024, (const bf16_t*)(p.ws + OFF_WTOUT), smem); break;
    case 5: tok_phase(p, l, 1); break;
    case 6: phase_ffn_in(p, smem); break;
    case 7: phase_gemm_f32(p, (const bf16_t*)(p.ws + OFF_ACT), DFF, (const bf16_t*)(p.ws + OFF_WTFO), smem); break;
    case 8:
      tok_phase(p, l, 2);
      if (l + 1 < 2) {
        conv_weight(p, p.in[I_WIN] + (size_t)(l + 1) * 1024 * DIN, DIN, (bf16_t*)(p.ws + OFF_WTIN), 1024, WTIN_ROWS, 0, (float*)smem, blockIdx.x, gridDim.x);
        for (int br = 0; br < 3; ++br) conv_weight(p, p.in[I_WBR] + ((size_t)(l + 1) * 3 + br) * 512 * 1024, 1024, (bf16_t*)(p.ws + OFF_WTBR) + (size_t)br * 1024 * 512, 512, 1024, 1, (float*)smem, blockIdx.x, gridDim.x);
      }
      break;
  }
}

template <bool COOP>
__global__ void __launch_bounds__(NTHR, 2) mega(Params pk, int lo, int hi) {
  __shared__ __attribute__((aligned(16))) char smem[LDS_BYTES];
  Params p = pk;
#pragma unroll
  for (int i = 0; i < N_IN; ++i) p.in[i] = as_global(p.in[i]);
  p.ws = as_global(p.ws); p.out = as_global(p.out);
  p.wb = __builtin_amdgcn_readfirstlane((int)threadIdx.x) & ~63;
  if (COOP) {
    volatile LAS unsigned* st = (volatile LAS unsigned*)(smem + LDS_BYTES - 32);
    if (ltid() == 0) { st[0] = 0u; st[1] = 0u; }
    __syncthreads();
    phase0(p, smem);
    cg::this_grid().sync();
    XcdBarrier b = xcd_barrier_post(p, (unsigned*)(p.ws + OFF_BAR), st);
    if (ltid() == 0) {
      const unsigned hwid = (unsigned)__builtin_amdgcn_s_getreg((31 << 11) | 4);
      const unsigned key = (xb_xcc_id() << 8) | ((hwid >> 8) & 0xFFu);
      ((int*)smem)[(LDS_BYTES - 12) / 4] = (int)xb_add((unsigned*)(p.ws + OFF_ROLE) + key, 1u);
    }
    __syncthreads();
    p.role = __builtin_amdgcn_readfirstlane(((int*)smem)[(LDS_BYTES - 12) / 4]);
    for (int ph = 1; ph < hi; ++ph) {
      run_phase(p, ph, smem);
      if (ph + 1 < hi) xcd_barrier(p, b);
    }
  } else {
    for (int ph = lo; ph < hi; ++ph) run_phase(p, ph, smem);
  }
}

extern "C" void kernel_launch(void* const* d_in, const int* in_sizes, int n_in, void* d_out, int out_size, void* d_ws, size_t ws_size, hipStream_t stream) {
  Params p{};
  for (int i = 0; i < N_IN; ++i) p.in[i] = (const float*)d_in[i];
  p.out = (float*)d_out; p.ws = (char*)d_ws;
  if (ws_size < WS_NEED) fprintf(stderr, "workspace too small: %zu < %zu\n", ws_size, (size_t)WS_NEED);
  static int grid_blocks = 0;
  if (!grid_blocks) {
    int dev = 0, cus = 0, per_cu = 0;
    hipGetDevice(&dev);
    hipDeviceGetAttribute(&cus, hipDeviceAttributeMultiprocessorCount, dev);
    hipOccupancyMaxActiveBlocksPerMultiprocessor(&per_cu, mega<true>, NTHR, 0);
    if (per_cu > 2) per_cu = 2;
    grid_blocks = cus * per_cu;
  }
  int lo = 0, hi = NPHASE;
  void* args[] = {&p, &lo, &hi};
  hipError_t e = hipLaunchCooperativeKernel((void*)mega<true>, dim3(grid_blocks), dim3(NTHR), args, 0, stream);
  if (e != hipSuccess) fprintf(stderr, "cooperative launch failed: %s (grid %d)\n", hipGetErrorString(e), grid_blocks);
}
```

```cpp
#include <hip/hip_runtime.h>
#include <hip/hip_cooperative_groups.h>
#include <cstdio>
namespace cg = cooperative_groups;

typedef unsigned short bf16_t;
typedef short bf16x8 __attribute__((ext_vector_type(8)));
typedef float f32x4 __attribute__((ext_vector_type(4)));
typedef float f32x2 __attribute__((ext_vector_type(2)));
typedef float f32x16 __attribute__((ext_vector_type(16)));
typedef unsigned short u16x4 __attribute__((ext_vector_type(4)));
typedef unsigned short u16x2 __attribute__((ext_vector_type(2)));
typedef unsigned u32x4 __attribute__((ext_vector_type(4)));
typedef unsigned u32x2 __attribute__((ext_vector_type(2)));
static __device__ __forceinline__ unsigned pk2(float lo, float hi) { typedef __bf16 b2 __attribute__((ext_vector_type(2))); typedef float f2 __attribute__((ext_vector_type(2))); return __builtin_bit_cast(unsigned, __builtin_convertvector((f2){lo, hi}, b2)); }

#define DI __device__ __forceinline__
#define GAS __attribute__((address_space(1)))
template <class T> static __device__ __forceinline__ T* as_global(T* q) { return (T*)(GAS T*)(unsigned long long)q; }

constexpr int NT = 16384;
constexpr int DM = 1024;
constexpr int NTHR = 256;
constexpr int DIN = 9616;
constexpr int ZHW = 2560, ZRW = 1920, ZMW = 2048;
constexpr int WTIN_ROWS = 9728;
constexpr int DFF = 2816;

constexpr size_t OFF_WTIN = 0;
constexpr size_t OFF_WTBR = OFF_WTIN + (size_t)WTIN_ROWS * 1024 * 2;
constexpr size_t OFF_H    = OFF_WTBR + (size_t)3 * 1024 * 512 * 2;
constexpr size_t OFF_ZH   = OFF_H + (size_t)NT * 1024 * 2;
constexpr size_t OFF_ZR   = OFF_ZH + (size_t)NT * ZHW * 2;
constexpr size_t OFF_ZM   = OFF_ZR + (size_t)NT * ZRW * 2;
constexpr size_t OFF_MG   = OFF_ZM + (size_t)NT * ZMW * 2;
constexpr size_t OFF_O    = OFF_MG + (size_t)NT * 16 * 4;
constexpr size_t OFF_MOD  = OFF_O + (size_t)NT * 1024 * 2;
constexpr size_t OFF_LBS  = OFF_MOD + (size_t)2 * 5 * 6144 * 4;
constexpr size_t OFF_CTR  = OFF_LBS + 2 * 512 * 4;
constexpr size_t OFF_BAR  = OFF_CTR + 256;
constexpr size_t OFF_ROLE = OFF_BAR + 3456 * 4;
constexpr size_t WS_NEED  = OFF_ROLE + 4096 * 4;
constexpr size_t OFF_MODP = OFF_ZH;
constexpr size_t OFF_WTOUT = OFF_ZR;
constexpr size_t OFF_WTFI  = OFF_WTOUT + (size_t)1024 * 1024 * 2;
constexpr size_t OFF_WTFO  = OFF_WTFI + (size_t)5632 * 1024 * 2;
constexpr size_t OFF_MERGED = OFF_WTFO + (size_t)1024 * 2816 * 2;
constexpr size_t OFF_Y    = OFF_ZH;
constexpr size_t OFF_ACT  = OFF_ZM;

constexpr size_t OUT_HG = 16777216, OUT_RW = 25165824, OUT_C = 29360128, OUT_N = 37748736, OUT_M = 37814272;

enum { I_XP = 0, I_XS, I_SH, I_SR, I_SC, I_SN, I_SM, I_C, I_CCTX, I_WADA, I_BADA, I_NORMS, I_WIN, I_HLB, I_HNORM, I_MU, I_W0, I_W2,
       I_A0, I_A2, I_G2, I_KK, I_KA, I_RK, I_LN, I_GB, I_MNORM, I_WBR, I_WOUT, I_WFI, I_WFO, N_IN };

struct Params { const float* in[N_IN]; float* out; char* ws; int wb; int role; };

constexpr int LDS_BYTES = 77824;

DI bf16_t f2bf(float f) { return __builtin_bit_cast(unsigned short, (__bf16)f); }
DI float bf2f(bf16_t h) { return __uint_as_float(((unsigned)h) << 16); }
DI float sigmoidf_(float x) { return __builtin_amdgcn_rcpf(1.0f + __expf(-x)); }
DI float siluf_(float x) { return x * __builtin_amdgcn_rcpf(1.0f + __expf(-x)); }
DI float softplusf_(float x) { return x > 20.f ? x : __logf(1.0f + __expf(x)); }
DI float dpp_xor1(float x) { return __int_as_float(__builtin_amdgcn_mov_dpp(__float_as_int(x), 0xB1, 0xF, 0xF, true)); }
DI float dpp_xor2(float x) { return __int_as_float(__builtin_amdgcn_mov_dpp(__float_as_int(x), 0x4E, 0xF, 0xF, true)); }
DI float shfl_lane(float v, int src) { return __int_as_float(__builtin_amdgcn_ds_bpermute(src << 2, __float_as_int(v))); }
#define SHX(v, m) shfl_lane((v), lane ^ (m))
DI float wave_sum(float v, int lane) { v += dpp_xor1(v); v += dpp_xor2(v); v += SHX(v, 4); v += SHX(v, 8); v += SHX(v, 16); v += SHX(v, 32); return v; }
DI int ltid_(int wb) { int t = wb + (int)__builtin_amdgcn_mbcnt_hi(~0u, __builtin_amdgcn_mbcnt_lo(~0u, 0u)); asm volatile("" : "+v"(t)); return t; }
#define ltid() ltid_(p.wb)
DI int crow(int reg, int h) { return (reg & 3) + 8 * (reg >> 2) + 4 * h; }

DI int tok_cond(int tok) { return tok < 8192 ? 0 : 1 + ((tok - 8192) >> 11); }
DI const float* x_in_row(const Params& p, int tok) { return tok < 8192 ? p.in[I_XP] + (size_t)tok * DM : p.in[I_XS] + (size_t)(tok - 8192) * DM; }

DI void mma32(f32x16& acc, const bf16_t* A, int lda, const bf16_t* B, int ldb, int K, int lane) {
  const int r = lane & 31, h = lane >> 5;
#pragma unroll 2
  for (int kk = 0; kk < K; kk += 16) {
    bf16x8 a = *(const bf16x8*)(A + r * lda + kk + 8 * h);
    bf16x8 b = *(const bf16x8*)(B + r * ldb + kk + 8 * h);
    acc = __builtin_amdgcn_mfma_f32_32x32x16_bf16(a, b, acc, 0, 0, 0);
  }
}

template <int BM, int BN, int BK, bool WR, bool LD>
DI void gemm_ktile(f32x4 (&acc)[BM / 32][BN / 32], bf16x8 (&ra)[BM * BK / 2048], bf16x8 (&rb)[BN * BK / 2048],
                   const bf16_t* __restrict__ A, int lda, const bf16_t* __restrict__ B, int ldb, int k2,
                   const bf16_t* as, const bf16_t* bs, bf16_t* Aw, bf16_t* Bw) {
  constexpr int MI = BM / 32, NJ = BN / 32, LS = BK + 8, ACH = BM * BK / 2048, BCH = BN * BK / 2048, KS = BK / 32, RPI = 256 / (BK / 8);
  static_assert(KS * MI >= ACH + BCH, "not enough MFMA row blocks to carry the staging");
  __builtin_amdgcn_s_setprio(1);
#pragma unroll
  for (int ks = 0; ks < KS; ++ks) {
    bf16x8 afn = *(const bf16x8*)(as + ks * 32);
    bf16x8 bfr[NJ];
#pragma unroll
    for (int j = 0; j < NJ; ++j) bfr[j] = *(const bf16x8*)(bs + j * 16 * LS + ks * 32);
#pragma unroll
    for (int i = 0; i < MI; ++i) {
      const bf16x8 af = afn;
      if (i + 1 < MI) afn = *(const bf16x8*)(as + (i + 1) * 16 * LS + ks * 32);
#pragma unroll
      for (int j = 0; j < NJ; ++j) acc[i][j] = __builtin_amdgcn_mfma_f32_16x16x32_bf16(bfr[j], af, acc[i][j], 0, 0, 0);
      const int s = ks * MI + i;
      if (s < ACH) {
        if (WR) *(bf16x8*)(Aw + RPI * s * LS) = ra[s < ACH ? s : 0];
        if (LD) ra[s < ACH ? s : 0] = *(const bf16x8*)(A + (size_t)(RPI * s) * lda + k2);
      } else if (s < ACH + BCH) {
        const int c = s - ACH;
        if (WR) *(bf16x8*)(Bw + RPI * c * LS) = rb[(c >= 0 && c < BCH) ? c : 0];
        if (LD) rb[(c >= 0 && c < BCH) ? c : 0] = *(const bf16x8*)(B + (size_t)(RPI * c) * ldb + k2);
      }
      __builtin_amdgcn_sched_barrier(0);
    }
  }
  __builtin_amdgcn_s_setprio(0);
}

template <int BM, int BN, int BK>
DI void gemm_main(const Params& p, f32x4 (&acc)[BM / 32][BN / 32], bf16x8 (&ra)[BM * BK / 2048], bf16x8 (&rb)[BN * BK / 2048], bool primed,
                  const bf16_t* __restrict__ A, int lda, const bf16_t* __restrict__ B, int ldb, int K,
                  const bf16_t* __restrict__ An, int ldan, const bf16_t* __restrict__ Bn, int ldbn, bf16_t* sm) {
  constexpr int LS = BK + 8, CPR = BK / 8, ACH = BM * BK / 2048, BCH = BN * BK / 2048, RPI = 256 / CPR;
  const int tid = ltid(), lane = tid & 63, w = tid >> 6, wm = w >> 1, wn = w & 1;
  bf16_t* As = sm; bf16_t* Bs = sm + 2 * BM * LS;
  const int nk = K / BK;
  const int lrow = tid / CPR, lkc = (tid % CPR) * 8;
  const bf16_t* Ag = A + (size_t)lrow * lda + lkc;
  const bf16_t* Bg = B + (size_t)lrow * ldb + lkc;
  bf16_t* Al = As + lrow * LS + lkc; bf16_t* Bl = Bs + lrow * LS + lkc;
  if (!primed) {
#pragma unroll
    for (int i = 0; i < ACH; ++i) ra[i] = *(const bf16x8*)(Ag + (size_t)(RPI * i) * lda);
#pragma unroll
    for (int i = 0; i < BCH; ++i) rb[i] = *(const bf16x8*)(Bg + (size_t)(RPI * i) * ldb);
    __syncthreads();
#pragma unroll
    for (int i = 0; i < ACH; ++i) *(bf16x8*)(Al + RPI * i * LS) = ra[i];
#pragma unroll
    for (int i = 0; i < BCH; ++i) *(bf16x8*)(Bl + RPI * i * LS) = rb[i];
#pragma unroll
    for (int i = 0; i < ACH; ++i) ra[i] = *(const bf16x8*)(Ag + (size_t)(RPI * i) * lda + BK);
#pragma unroll
    for (int i = 0; i < BCH; ++i) rb[i] = *(const bf16x8*)(Bg + (size_t)(RPI * i) * ldb + BK);
    __syncthreads();
  }
  const bf16_t* as0 = As + (wm * (BM / 2) + (lane & 15)) * LS + (lane >> 4) * 8;
  const bf16_t* bs0 = Bs + (wn * (BN / 2) + (lane & 15)) * LS + (lane >> 4) * 8;
  int kt = 0;
  for (; kt + 2 < nk; ++kt) {
    const int buf = kt & 1, nb = buf ^ 1;
    gemm_ktile<BM, BN, BK, true, true>(acc, ra, rb, Ag, lda, Bg, ldb, (kt + 2) * BK, as0 + buf * BM * LS, bs0 + buf * BN * LS, Al + nb * BM * LS, Bl + nb * BN * LS);
    __syncthreads();
  }
  {
    const bf16_t* Agn = An + (size_t)lrow * ldan + lkc;
    const bf16_t* Bgn = Bn + (size_t)lrow * ldbn + lkc;
    gemm_ktile<BM, BN, BK, true, true>(acc, ra, rb, Agn, ldan, Bgn, ldbn, 0, as0, bs0, Al + BM * LS, Bl + BN * LS);
    __syncthreads();
    gemm_ktile<BM, BN, BK, true, true>(acc, ra, rb, Agn, ldan, Bgn, ldbn, BK, as0 + BM * LS, bs0 + BN * LS, Al, Bl);
    __syncthreads();
  }
}

template <int MI, int NJ> DI void zero_acc(f32x4 (&acc)[MI][NJ]) {
#pragma unroll
  for (int i = 0; i < MI; ++i)
#pragma unroll
    for (int j = 0; j < NJ; ++j) acc[i][j] = (f32x4){0.f, 0.f, 0.f, 0.f};
}
DI void store_bf4(bf16_t* dst, f32x4 v) { u16x4 o; o[0] = f2bf(v[0]); o[1] = f2bf(v[1]); o[2] = f2bf(v[2]); o[3] = f2bf(v[3]); *(u16x4*)dst = o; }

DI int map_col(int mode, int n) {
  if (mode == 0) return n < 6544 ? n : (n < 6656 ? -1 : n - 112);
  if (mode == 2) return ((n >> 4) & 1) ? DFF + (n >> 5) * 16 + (n & 15) : (n >> 5) * 16 + (n & 15);
  return n;
}
DI void conv_tile(const Params& p, const float* __restrict__ src, int ld_src, bf16_t* __restrict__ dst, int K, int mode, int tk, int tn, float* sm) {
  const int tid = ltid();
  __syncthreads();
  {
    const int nn = tid & 63, col = map_col(mode, tn * 64 + nn);
#pragma unroll
    for (int i = 0; i < 16; ++i) { int kk = (tid >> 6) + 4 * i; sm[kk * 65 + nn] = col >= 0 ? src[(size_t)(tk * 64 + kk) * ld_src + col] : 0.f; }
  }
  __syncthreads();
  {
    const int kk = tid & 63;
#pragma unroll
    for (int i = 0; i < 16; ++i) { int nn = (tid >> 6) + 4 * i; dst[(size_t)(tn * 64 + nn) * K + tk * 64 + kk] = f2bf(sm[kk * 65 + nn]); }
  }
}
DI void conv_weight(const Params& p, const float* src, int ld_src, bf16_t* dst, int K, int Ndst, int mode, float* sm, int bid, int nb) {
  const int tkn = K / 64, nt = tkn * (Ndst / 64);
  for (int t = bid; t < nt; t += nb) conv_tile(p, src, ld_src, dst, K, mode, t % tkn, t / tkn, sm);
}

DI void phase0(const Params& p, char* smem) {
  const int tid = ltid(), bid = blockIdx.x, nb = gridDim.x;
  float* MODP = (float*)(p.ws + OFF_MODP);
  float* sm = (float*)smem;
  if (bid == 0) { if (tid < 64) ((int*)(p.ws + OFF_CTR))[tid] = 0; for (int i = tid; i < 3456; i += NTHR) ((unsigned*)(p.ws + OFF_BAR))[i] = 0u; for (int i = tid; i < 4096; i += NTHR) ((unsigned*)(p.ws + OFF_ROLE))[i] = 0u; }
  for (int i = bid * NTHR + tid; i < 512; i += nb * NTHR) {
    float a = p.in[I_HLB][i], b = p.in[I_HLB][512 + i];
    float* L = (float*)(p.ws + OFF_LBS); L[i] = 0.f; L[512 + i] = 1.0f / (1.0f + expf(a - b));
  }
  for (int it = bid; it < 2 * 24 * 16; it += nb) {
    const int ks = it & 15, jb = (it >> 4) % 24, l = it / (16 * 24);
    __syncthreads();
    for (int e = tid; e < 5 * 64; e += NTHR) { int ci = e >> 6, k = ks * 64 + (e & 63); float cv = ci == 0 ? p.in[I_CCTX][k] : p.in[I_C][(ci - 1) * DM + k]; sm[e] = siluf_(cv); }
    __syncthreads();
    const int j = jb * 256 + tid;
    float a0 = 0, a1 = 0, a2 = 0, a3 = 0, a4 = 0;
    const float* W = p.in[I_WADA] + ((size_t)l * DM + ks * 64) * 6144 + j;
#pragma unroll 1
    for (int k0 = 0; k0 < 64; k0 += 16) {
      float wv[16];
#pragma unroll
      for (int u = 0; u < 16; ++u) wv[u] = W[(size_t)(k0 + u) * 6144];
#pragma unroll
      for (int u = 0; u < 16; ++u) { const int k = k0 + u; const float w = wv[u]; a0 += sm[k] * w; a1 += sm[64 + k] * w; a2 += sm[128 + k] * w; a3 += sm[192 + k] * w; a4 += sm[256 + k] * w; }
    }
    float* dst = MODP + ((size_t)(ks * 2 + l) * 5) * 6144 + j;
    dst[0] = a0; dst[6144] = a1; dst[2 * 6144] = a2; dst[3 * 6144] = a3; dst[4 * 6144] = a4;
  }
  conv_weight(p, p.in[I_WIN], DIN, (bf16_t*)(p.ws + OFF_WTIN), 1024, WTIN_ROWS, 0, sm, bid, nb);
  for (int br = 0; br < 3; ++br) conv_weight(p, p.in[I_WBR] + (size_t)br * 512 * 1024, 1024, (bf16_t*)(p.ws + OFF_WTBR) + (size_t)br * 1024 * 512, 512, 1024, 1, sm, bid, nb);
}
DI void phase1(const Params& p) {
  const float* MODP = (const float*)(p.ws + OFF_MODP);
  float* MOD = (float*)(p.ws + OFF_MOD);
  for (int i = blockIdx.x * NTHR + ltid(); i < 2 * 5 * 6144; i += gridDim.x * NTHR) {
    const int j = i % 6144, l = i / (5 * 6144);
    float s = p.in[I_BADA][l * 6144 + j];
    for (int ks = 0; ks < 16; ++ks) s += MODP[(size_t)ks * 2 * 5 * 6144 + i];
    MOD[i] = s;
  }
}

DI void norm_mod_store(const f32x4 (&x)[4], const float* nw, const float* sc, const float* sh, bf16_t* hrow, int lane) {
  float ss = 0.f;
#pragma unroll
  for (int i = 0; i < 4; ++i) ss += x[i][0] * x[i][0] + x[i][1] * x[i][1] + x[i][2] * x[i][2] + x[i][3] * x[i][3];
  ss = wave_sum(ss, lane);
  const float rs = rsqrtf(ss * (1.0f / DM) + 1e-6f);
#pragma unroll
  for (int i = 0; i < 4; ++i) {
    const int c = i * 256 + lane * 4;
    f32x4 w = *(const f32x4*)(nw + c), s1 = *(const f32x4*)(sc + c), s0 = *(const f32x4*)(sh + c), o;
#pragma unroll
    for (int e = 0; e < 4; ++e) o[e] = x[i][e] * rs * w[e] * (1.0f + s1[e]) + s0[e];
    store_bf4(hrow + c, o);
  }
}
DI const float* tok_xrow(const Params& p, int l, int mode, int tok) { const bool from_in = (l == 0 && (mode == 0 || mode == 1 || mode == 3)); return from_in ? x_in_row(p, tok) : p.out + (size_t)tok * DM; }
DI void tok_body(const Params& p, int l, int mode, int tok, int lane, f32x4 (&x)[4], f32x4 (&y)[4]) {
  const float* MOD = (const float*)(p.ws + OFF_MOD);
  bf16_t* H = (bf16_t*)(p.ws + OFF_H);
  const float* Y = (const float*)(p.ws + OFF_Y);
  const int ci = tok_cond(tok);
  const float* modl = MOD + (size_t)(l * 5 + ci) * 6144;
  const float* nwl = p.in[I_NORMS] + (size_t)l * 4 * DM;
  const bool has_y = (mode == 1 || mode == 2);
  const bool has_h = !(mode == 2 && l + 1 >= 2);
  const float* modn = (mode == 2 && has_h) ? MOD + (size_t)((l + 1) * 5 + ci) * 6144 : modl;
  const float* nw2 = mode == 1 ? nwl + 2 * DM : (mode == 2 ? p.in[I_NORMS] + (size_t)(has_h ? l + 1 : l) * 4 * DM : nwl);
  const float* sc2 = mode == 1 ? modl + 4 * DM : modn + 1 * DM;
  const float* sh2 = mode == 1 ? modl + 3 * DM : modn + 0 * DM;
  const float* nwy = nwl + (mode == 1 ? 1 : 3) * DM;
  const float* gy = modl + (mode == 1 ? 2 : 5) * DM;
  f32x4 wy[4], gg[4], w2[4], s1[4], s0[4];
#pragma unroll
  for (int i = 0; i < 4; ++i) {
    const int c = i * 256 + lane * 4;
    if (has_y) { wy[i] = *(const f32x4*)(nwy + c); gg[i] = *(const f32x4*)(gy + c); }
    if (has_h) { w2[i] = *(const f32x4*)(nw2 + c); s1[i] = *(const f32x4*)(sc2 + c); s0[i] = *(const f32x4*)(sh2 + c); }
  }
  if (has_y) {
    float ss = 0.f;
#pragma unroll
    for (int i = 0; i < 4; ++i) ss += y[i][0] * y[i][0] + y[i][1] * y[i][1] + y[i][2] * y[i][2] + y[i][3] * y[i][3];
    ss = wave_sum(ss, lane);
    const float rs = rsqrtf(ss * (1.0f / DM) + 1e-6f);
#pragma unroll
    for (int i = 0; i < 4; ++i) {
      const int c = i * 256 + lane * 4;
#pragma unroll
      for (int e = 0; e < 4; ++e) x[i][e] += gg[i][e] * (y[i][e] * rs * wy[i][e]);
      *(f32x4*)(p.out + (size_t)tok * DM + c) = x[i];
    }
  }
  if (has_h) {
    float ss = 0.f;
#pragma unroll
    for (int i = 0; i < 4; ++i) ss += x[i][0] * x[i][0] + x[i][1] * x[i][1] + x[i][2] * x[i][2] + x[i][3] * x[i][3];
    ss = wave_sum(ss, lane);
    const float rs = rsqrtf(ss * (1.0f / DM) + 1e-6f);
#pragma unroll
    for (int i = 0; i < 4; ++i) {
      f32x4 o;
#pragma unroll
      for (int e = 0; e < 4; ++e) o[e] = x[i][e] * rs * w2[i][e] * (1.0f + s1[i][e]) + s0[i][e];
      store_bf4(H + (size_t)tok * DM + i * 256 + lane * 4, o);
    }
  }
}
DI void tok_rows(const Params& p, int l, int mode, int tok, int lane, f32x4 (&x)[4], f32x4 (&y)[4]) {
  const float* xr = tok_xrow(p, l, mode, tok);
  const float* Y = (const float*)(p.ws + OFF_Y);
#pragma unroll
  for (int i = 0; i < 4; ++i) {
    const int c = i * 256 + lane * 4;
    x[i] = *(const f32x4*)(xr + c);
    if (mode == 1 || mode == 2) y[i] = *(const f32x4*)(Y + (size_t)tok * DM + c); else y[i] = (f32x4){0.f, 0.f, 0.f, 0.f};
  }
}
DI void tok_one(const Params& p, int l, int mode, int tok, int lane) {
  f32x4 x[4], y[4];
  tok_rows(p, l, mode, tok, lane, x, y);
  tok_body(p, l, mode, tok, lane, x, y);
}
DI void tok_phase(const Params& p, int l, int mode) {
  const int lane = ltid() & 63, gw = blockIdx.x * 4 + (ltid() >> 6), nw = gridDim.x * 4;
  f32x4 xn[4], yn[4];
  if (gw < NT) tok_rows(p, l, mode, gw, lane, xn, yn);
  for (int tok = gw; tok < NT; tok += nw) {
    f32x4 x[4], y[4];
#pragma unroll
    for (int i = 0; i < 4; ++i) { x[i] = xn[i]; y[i] = yn[i]; }
    if (tok + nw < NT) tok_rows(p, l, mode, tok + nw, lane, xn, yn);
    tok_body(p, l, mode, tok, lane, x, y);
  }
}

DI bool tile_xcd(int i, int NTN, int MTX, int& mt, int& nt) {
  const int G = gridDim.x, b = blockIdx.x, x = b & 7, j = b >> 3, nbx = (G - x + 7) >> 3;
  const int u = j + i * nbx;
  if (u >= MTX * NTN) return false;
  mt = MTX * x + (u % MTX); nt = u / MTX;
  return true;
}
DI void phase_inproj(const Params& p, char* smem) {
  const bf16_t* H = (const bf16_t*)(p.ws + OFF_H);
  const bf16_t* WT = (const bf16_t*)(p.ws + OFF_WTIN);
  bf16_t* ZH = (bf16_t*)(p.ws + OFF_ZH); bf16_t* ZR = (bf16_t*)(p.ws + OFF_ZR); bf16_t* ZM = (bf16_t*)(p.ws + OFF_ZM);
  float* MG = (float*)(p.ws + OFF_MG);
  bf16x8 ra[4], rb[2]; bool primed = false;
  int mt, nt; bool have = tile_xcd(0, 52, 8, mt, nt);
  for (int ti = 0; have; ++ti) {
    int mtn = 0, ntn = 0; const bool haven = tile_xcd(ti + 1, 52, 8, mtn, ntn);
    f32x4 acc[8][4]; zero_acc<8, 4>(acc);
    gemm_main<256, 128, 32>(p, acc, ra, rb, primed, H + (size_t)mt * 256 * 1024, 1024, WT + (size_t)nt * 128 * 1024, 1024, 1024,
                            H + (size_t)(haven ? mtn : mt) * 256 * 1024, 1024, WT + (size_t)(haven ? ntn : nt) * 128 * 1024, 1024, (bf16_t*)smem);
    primed = haven;
    const int lane = ltid() & 63, w = ltid() >> 6, wm = w >> 1, wn = w & 1; (void)wm; (void)wn;
    const int n0 = nt * 128;
#pragma unroll
    for (int i = 0; i < 8; ++i) {
      asm volatile("" ::: "memory");
      const int row = mt * 256 + wm * 128 + i * 16 + (lane & 15);
#pragma unroll
      for (int j = 0; j < 4; ++j) {
        const int col = n0 + wn * 64 + j * 16 + 4 * (lane >> 4);
        if (n0 < 2560) store_bf4(ZH + (size_t)row * ZHW + col, acc[i][j]);
        else if (n0 < 4480) store_bf4(ZR + (size_t)row * ZRW + (col - 2560), acc[i][j]);
        else if (n0 < 6528) store_bf4(ZM + (size_t)row * ZMW + (col - 4480), acc[i][j]);
        else if (col - 6528 < 16) *(f32x4*)(MG + (size_t)row * 16 + (col - 6528)) = acc[i][j];
      }
    }
    mt = mtn; nt = ntn; have = haven;
  }
}

DI void merge_sub(const Params& p, int mt, int nt, int s, const bf16_t*& A_, int& lda_, const bf16_t*& B_, int& ldb_, int& K_) {
  const bf16_t* H = (const bf16_t*)(p.ws + OFF_H);
  const bf16_t* WT = (const bf16_t*)(p.ws + OFF_WTIN);
  const bf16_t* WBR = (const bf16_t*)(p.ws + OFF_WTBR);
  const bf16_t* ZH = (const bf16_t*)(p.ws + OFF_ZH); const bf16_t* ZM = (const bf16_t*)(p.ws + OFF_ZM); const bf16_t* O = (const bf16_t*)(p.ws + OFF_O);
  const int br = s >> 1;
  if (!(s & 1)) { A_ = H + (size_t)mt * 128 * 1024; lda_ = 1024; B_ = WT + (size_t)(6656 + br * 1024 + nt * 128) * 1024; ldb_ = 1024; K_ = 1024; }
  else {
    const bf16_t* Ab; int lda;
    if (br == 0) { Ab = ZH + 2048; lda = ZHW; } else if (br == 1) { Ab = O; lda = 1024; } else { Ab = ZM + 1536; lda = ZMW; }
    A_ = Ab + (size_t)mt * 128 * lda; lda_ = lda; B_ = WBR + ((size_t)br * 1024 + nt * 128) * 512; ldb_ = 512; K_ = 512;
  }
}
DI void phase_merge(const Params& p, int l, char* smem) {
  bf16_t* MER = (bf16_t*)(p.ws + OFF_MERGED);
  unsigned* gsc = (unsigned*)(smem + 40960);
  bf16x8 ra[2], rb[2]; bool primed = false;
  int mt, nt; bool have = tile_xcd(0, 8, 16, mt, nt);
  for (int ti = 0; have; ++ti) {
    int mtn = 0, ntn = 0; const bool haven = tile_xcd(ti + 1, 8, 16, mtn, ntn);
    f32x4 accM[4][4]; zero_acc<4, 4>(accM);
#pragma unroll 1
    for (int br = 0; br < 3; ++br) {
      f32x4 acc[4][4]; zero_acc<4, 4>(acc);
      const bf16_t *A0, *B0, *A1, *B1, *A2, *B2; int la0, lb0, k0, la1, lb1, k1, la2, lb2, k2;
      merge_sub(p, mt, nt, 2 * br, A0, la0, B0, lb0, k0);
      merge_sub(p, mt, nt, 2 * br + 1, A1, la1, B1, lb1, k1);
      const bool more = (br < 2) || haven;
      if (br < 2) merge_sub(p, mt, nt, 2 * br + 2, A2, la2, B2, lb2, k2); else merge_sub(p, haven ? mtn : mt, haven ? ntn : nt, 0, A2, la2, B2, lb2, k2);
      gemm_main<128, 128, 32>(p, acc, ra, rb, primed, A0, la0, B0, lb0, k0, A1, la1, B1, lb1, (bf16_t*)smem);
      {
        const int tid_ = ltid();
#pragma unroll
        for (int i = 0; i < 4; ++i)
#pragma unroll
          for (int j = 0; j < 4; ++j) {
            gsc[((i * 4 + j) * 2 + 0) * 256 + tid_] = pk2(sigmoidf_(acc[i][j][0]), sigmoidf_(acc[i][j][1]));
            gsc[((i * 4 + j) * 2 + 1) * 256 + tid_] = pk2(sigmoidf_(acc[i][j][2]), sigmoidf_(acc[i][j][3]));
            acc[i][j] = (f32x4){0.f, 0.f, 0.f, 0.f};
          }
      }
      gemm_main<128, 128, 32>(p, acc, ra, rb, true, A1, la1, B1, lb1, k1, A2, la2, B2, lb2, (bf16_t*)smem);
      primed = more;
      {
        const int tid_ = ltid();
#pragma unroll
        for (int i = 0; i < 4; ++i)
#pragma unroll
          for (int j = 0; j < 4; ++j) {
            const unsigned g0 = gsc[((i * 4 + j) * 2 + 0) * 256 + tid_], g1 = gsc[((i * 4 + j) * 2 + 1) * 256 + tid_];
            accM[i][j][0] += __uint_as_float(g0 << 16) * acc[i][j][0]; accM[i][j][1] += __uint_as_float(g0 & 0xffff0000u) * acc[i][j][1];
            accM[i][j][2] += __uint_as_float(g1 << 16) * acc[i][j][2]; accM[i][j][3] += __uint_as_float(g1 & 0xffff0000u) * acc[i][j][3];
          }
      }
    }
    const int lane = ltid() & 63, w = ltid() >> 6, wm = w >> 1, wn = w & 1;
#pragma unroll
    for (int i = 0; i < 4; ++i) {
      const int row = mt * 128 + wm * 64 + i * 16 + (lane & 15);
#pragma unroll
      for (int j = 0; j < 4; ++j) store_bf4(MER + (size_t)row * 1024 + nt * 128 + wn * 64 + j * 16 + 4 * (lane >> 4), accM[i][j]);
    }
    mt = mtn; nt = ntn; have = haven;
  }
  float* sm = (float*)smem;
  conv_weight(p, p.in[I_WOUT] + (size_t)l * 1024 * 1024, 1024, (bf16_t*)(p.ws + OFF_WTOUT), 1024, 1024, 1, sm, blockIdx.x, gridDim.x);
  conv_weight(p, p.in[I_WFI] + (size_t)l * 1024 * 5632, 5632, (bf16_t*)(p.ws + OFF_WTFI), 1024, 5632, 2, sm, blockIdx.x, gridDim.x);
  conv_weight(p, p.in[I_WFO] + (size_t)l * DFF * 1024, 1024, (bf16_t*)(p.ws + OFF_WTFO), DFF, 1024, 1, sm, blockIdx.x, gridDim.x);
}

DI void phase_gemm_f32(const Params& p, const bf16_t* A, int K, const bf16_t* Wt, char* smem) {
  float* Y = (float*)(p.ws + OFF_Y);
  bf16x8 ra[4], rb[2]; bool primed = false;
  int mt, nt; bool have = tile_xcd(0, 8, 8, mt, nt);
  for (int ti = 0; have; ++ti) {
    int mtn = 0, ntn = 0; const bool haven = tile_xcd(ti + 1, 8, 8, mtn, ntn);
    f32x4 acc[8][4]; zero_acc<8, 4>(acc);
    gemm_main<256, 128, 32>(p, acc, ra, rb, primed, A + (size_t)mt * 256 * K, K, Wt + (size_t)nt * 128 * K, K, K,
                            A + (size_t)(haven ? mtn : mt) * 256 * K, K, Wt + (size_t)(haven ? ntn : nt) * 128 * K, K, (bf16_t*)smem);
    primed = haven;
    const int lane = ltid() & 63, w = ltid() >> 6, wm = w >> 1, wn = w & 1; (void)wm; (void)wn;
#pragma unroll
    for (int i = 0; i < 8; ++i) {
      asm volatile("" ::: "memory");
      const int row = mt * 256 + wm * 128 + i * 16 + (lane & 15);
#pragma unroll
      for (int j = 0; j < 4; ++j) *(f32x4*)(Y + (size_t)row * 1024 + nt * 128 + wn * 64 + j * 16 + 4 * (lane >> 4)) = acc[i][j];
    }
    mt = mtn; nt = ntn; have = haven;
  }
}
DI void phase_ffn_in(const Params& p, char* smem) {
  const bf16_t* H = (const bf16_t*)(p.ws + OFF_H);
  const bf16_t* Wt = (const bf16_t*)(p.ws + OFF_WTFI);
  bf16_t* ACT = (bf16_t*)(p.ws + OFF_ACT);
  bf16x8 ra[4], rb[2]; bool primed = false;
  int mt, nt; bool have = tile_xcd(0, 44, 8, mt, nt);
  for (int ti = 0; have; ++ti) {
    int mtn = 0, ntn = 0; const bool haven = tile_xcd(ti + 1, 44, 8, mtn, ntn);
    f32x4 acc[8][4]; zero_acc<8, 4>(acc);
    gemm_main<256, 128, 32>(p, acc, ra, rb, primed, H + (size_t)mt * 256 * 1024, 1024, Wt + (size_t)nt * 128 * 1024, 1024, 1024,
                            H + (size_t)(haven ? mtn : mt) * 256 * 1024, 1024, Wt + (size_t)(haven ? ntn : nt) * 128 * 1024, 1024, (bf16_t*)smem);
    primed = haven;
    const int lane = ltid() & 63, w = ltid() >> 6, wm = w >> 1, wn = w & 1; (void)wm; (void)wn;
#pragma unroll
    for (int i = 0; i < 8; ++i) {
      asm volatile("" ::: "memory");
      const int row = mt * 256 + wm * 128 + i * 16 + (lane & 15);
#pragma unroll
      for (int jj = 0; jj < 2; ++jj) {
        f32x4 u = acc[i][2 * jj], g = acc[i][2 * jj + 1], o;
#pragma unroll
        for (int e = 0; e < 4; ++e) o[e] = siluf_(g[e]) * u[e];
        const int col = (nt * 128 + wn * 64 + jj * 32) / 2 + 4 * (lane >> 4);
        store_bf4(ACT + (size_t)row * DFF + col, o);
      }
    }
    mt = mtn; nt = ntn; have = haven;
  }
}

struct Seq { int base, T, grid, b; bool sample; };
DI Seq get_seq(int s) { Seq q; if (s < 32) { q.base = s * 256; q.T = 256; q.grid = 0; q.b = s; q.sample = false; } else { q.b = s - 32; q.base = 8192 + q.b * 2048; q.T = 2048; q.grid = 1; q.sample = true; } return q; }

DI float rw_shift(const bf16_t* ZR, const float* mu, int base, int t, int T, int grid, int col) {
  const bf16_t* pp = ZR + (size_t)(base + t) * ZRW + col;
  const float y = bf2f(*pp);
  if (!grid) {
    const float prev = t > 0 ? bf2f(pp[-ZRW]) : 0.f, nxt = t < T - 1 ? bf2f(pp[ZRW]) : 0.f;
    return y + mu[col] * (prev - y) + mu[ZRW + col] * (nxt - y);
  }
  const int gc = t & 63, gr = t >> 6;
  const float left = gc > 0 ? bf2f(pp[-ZRW]) : 0.f, right = gc < 63 ? bf2f(pp[ZRW]) : 0.f;
  const float up = gr > 0 ? bf2f(pp[-64 * ZRW]) : 0.f, down = gr < 31 ? bf2f(pp[64 * ZRW]) : 0.f;
  return y + mu[col] * (left - y) + mu[ZRW + col] * (right - y) + mu[2 * ZRW + col] * (up - y) + mu[3 * ZRW + col] * (down - y);
}

DI void rw_shift8(const bf16_t* ZR, const float* mu, int base, int t, int T, int grid, int col0, float (&out)[8]) {
  const bf16_t* pp = ZR + (size_t)(base + t) * ZRW + col0;
  const bf16x8 y = *(const bf16x8*)pp;
  float yv[8];
#pragma unroll
  for (int e = 0; e < 8; ++e) { yv[e] = bf2f((bf16_t)y[e]); out[e] = yv[e]; }
  const int nn = grid ? 4 : 2;
#pragma unroll 1
  for (int n = 0; n < nn; ++n) {
    bool valid; int off;
    if (!grid) { valid = n == 0 ? t > 0 : t < T - 1; off = n == 0 ? -ZRW : ZRW; }
    else { const int gc = t & 63, gr = t >> 6; valid = n == 0 ? gc > 0 : n == 1 ? gc < 63 : n == 2 ? gr > 0 : gr < 31; off = n == 0 ? -ZRW : n == 1 ? ZRW : n == 2 ? -64 * ZRW : 64 * ZRW; }
    const f32x4 m0 = *(const f32x4*)(mu + n * ZRW + col0), m1 = *(const f32x4*)(mu + n * ZRW + col0 + 4);
    bf16x8 nb = y;
    if (valid) nb = *(const bf16x8*)(pp + off);
#pragma unroll
    for (int e = 0; e < 8; ++e) { const float nv_ = valid ? bf2f((bf16_t)nb[e]) : 0.f; const float mm = e < 4 ? m0[e & 3] : m1[e & 3]; out[e] += mm * (nv_ - yv[e]); }
  }
}

DI void rw_load8(const bf16_t* ZR, int base, int t, int T, int grid, int col0, bf16x8 (&v)[5]) {
  const bf16_t* pp = ZR + (size_t)(base + t) * ZRW + col0;
  const int gc = t & 63, gr = t >> 6;
  const int o1 = grid ? (gc > 0 ? -ZRW : 0) : (t > 0 ? -ZRW : 0);
  const int o2 = grid ? (gc < 63 ? ZRW : 0) : (t < T - 1 ? ZRW : 0);
  v[0] = *(const bf16x8*)pp;
  v[1] = *(const bf16x8*)(pp + o1);
  v[2] = *(const bf16x8*)(pp + o2);
  if (grid) {
    v[3] = *(const bf16x8*)(pp + (gr > 0 ? -64 * ZRW : 0)); v[4] = *(const bf16x8*)(pp + (gr < 31 ? 64 * ZRW : 0));
  } else {
    v[3] = (bf16x8){0, 0, 0, 0, 0, 0, 0, 0}; v[4] = (bf16x8){0, 0, 0, 0, 0, 0, 0, 0};
  }
}
DI unsigned rw_valid(int t, int T, int grid) {
  if (!grid) return (t > 0 ? 1u : 0u) | (t < T - 1 ? 2u : 0u);
  const int gc = t & 63, gr = t >> 6;
  return (gc > 0 ? 1u : 0u) | (gc < 63 ? 2u : 0u) | (gr > 0 ? 4u : 0u) | (gr < 31 ? 8u : 0u);
}
DI void rw_apply8(const bf16x8 (&v)[5], const float* mu, int grid, unsigned valid, int col0, float (&out)[8]) {
  float yv[8];
#pragma unroll
  for (int e = 0; e < 8; ++e) { yv[e] = bf2f((bf16_t)v[0][e]); out[e] = yv[e]; }
#pragma unroll
  for (int n = 0; n < 4; ++n) {
    if (n < 2 || grid) {
      const f32x4 m0 = *(const f32x4*)(mu + n * ZRW + col0), m1 = *(const f32x4*)(mu + n * ZRW + col0 + 4);
      const bool ok = (valid >> n) & 1u;
#pragma unroll
      for (int e = 0; e < 8; ++e) out[e] += (e < 4 ? m0[e & 3] : m1[e & 3]) * ((ok ? bf2f((bf16_t)v[1 + n][e]) : 0.f) - yv[e]);
    }
  }
}
DI void rw_apply8_lds(const bf16x8 (&v)[5], const float* mu5c, const float* c0c, int grid, unsigned valid, float (&out)[8]) {
  {
    const f32x4 c0 = *(const f32x4*)c0c, c1 = *(const f32x4*)(c0c + 4);
#pragma unroll
    for (int e = 0; e < 8; ++e) out[e] = bf2f((bf16_t)v[0][e]) * (e < 4 ? c0[e & 3] : c1[e & 3]);
  }
#pragma unroll
  for (int n = 0; n < 4; ++n) {
    if (n < 2 || grid) {
      const f32x4 m0 = *(const f32x4*)(mu5c + n * 320), m1 = *(const f32x4*)(mu5c + n * 320 + 4);
      const float ok = ((valid >> n) & 1u) ? 1.0f : 0.0f;
#pragma unroll
      for (int e = 0; e < 8; ++e) out[e] += (e < 4 ? m0[e & 3] : m1[e & 3]) * ok * bf2f((bf16_t)v[1 + n][e]);
    }
  }
}
DI float fast_tanh(float x) { return 1.0f - 2.0f * __builtin_amdgcn_rcpf(1.0f + __expf(2.0f * x)); }
template <int N> DI float dpp_row_shr0(float x) { return __int_as_float(__builtin_amdgcn_update_dpp(0, __float_as_int(x), 0x110 + N, 0xF, 0xF, false)); }

DI void rwkv_item(const Params& p, int l, int s, int hh, int d, char* smem) {
  const Seq q = get_seq(s);
  const int tid0 = ltid();
  const int w = __builtin_amdgcn_readfirstlane(tid0 >> 6), vb = w >> 1, kb = w & 1;
  int tid = tid0, lane = tid & 63, l15 = lane & 15, qq = lane >> 4, r32 = lane & 31, h = lane >> 5;
  const bf16_t* ZR = (const bf16_t*)(p.ws + OFF_ZR);
  bf16_t* O = (bf16_t*)(p.ws + OFF_O);
  const float* mu = p.in[I_MU] + (size_t)l * 4 * ZRW;
  bf16_t* KHr = (bf16_t*)smem;
  bf16_t* BCr = KHr + 16 * 72;
  bf16_t* KC = BCr + 16 * 72;
  bf16_t* RH = KC + 16 * 72;
  bf16_t* Sb = RH + 16 * 72;
  bf16_t* Wb2 = (bf16_t*)smem;
  bf16_t* Ab2 = Wb2 + 64 * 72;
  float* mu5 = (float*)(smem + 18432);
  bf16_t* actW = (bf16_t*)(smem + 23552);
  bf16_t* actA = actW + 16 * 72;
  float* shR = (float*)(smem + 28160);
  float* shK = shR + 1024; float* shV = shK + 1024;
  bf16_t* VT0 = (bf16_t*)(smem + 40448);
  bf16_t* VT1 = (bf16_t*)(smem + 69376);
  bf16_t* UNT = VT0 + 64 * 40;
  bf16_t* KBT = UNT + 64 * 40;
  bf16_t* BBT = KBT + 64 * 24;
  float* PL = (float*)(smem + 56832);
  float* npart = PL + 64;
  float* MN = (float*)(smem + 57344);
  float* G0 = (float*)(smem + 61440);
  bf16_t* ArkM = (bf16_t*)(smem + 65536);
  bf16_t* ArbM = ArkM + 16 * 40;
  float* c0t = (float*)(smem + 68096);
  __syncthreads();
  for (int e = tid; e < 4096; e += NTHR) {
    const int i = e >> 6, c = e & 63;
    Wb2[c * 72 + i] = f2bf(p.in[I_W2][((size_t)(l * 2 + d) * 64 + i) * 512 + 64 * hh + c]);
    Ab2[c * 72 + i] = f2bf(p.in[I_A2][((size_t)(l * 2 + d) * 64 + i) * 512 + 64 * hh + c]);
  }
  for (int e = tid; e < 1280; e += NTHR) {
    const int n = e / 320, rem = e % 320, arr = rem >> 6, c = rem & 63;
    const int col = arr == 0 ? 64 * hh + c : arr == 1 ? 512 + 64 * hh + c : arr == 2 ? 1024 + 64 * hh + c : arr == 3 ? 1536 + 64 * d + c : 1664 + 64 * d + c;
    mu5[e] = mu[n * ZRW + col];
  }
  for (int e = tid; e < 320; e += NTHR) {
    const int arr = e >> 6, c = e & 63;
    const int col = arr == 0 ? 64 * hh + c : arr == 1 ? 512 + 64 * hh + c : arr == 2 ? 1024 + 64 * hh + c : arr == 3 ? 1536 + 64 * d + c : 1664 + 64 * d + c;
    float sm_ = mu[col] + mu[ZRW + col];
    if (q.grid) sm_ += mu[2 * ZRW + col] + mu[3 * ZRW + col];
    c0t[e] = 1.0f - sm_;
  }
  const int cB0 = 16 * w + 4 * qq;
  float w0c[4], a0c[4], kkc[4], kac[4];
#pragma unroll
  for (int g = 0; g < 4; ++g) {
    w0c[g] = p.in[I_W0][(l * 2 + d) * 512 + 64 * hh + cB0 + g]; a0c[g] = p.in[I_A0][(l * 2 + d) * 512 + 64 * hh + cB0 + g];
    kkc[g] = p.in[I_KK][l * 512 + 64 * hh + cB0 + g]; kac[g] = p.in[I_KA][l * 512 + 64 * hh + cB0 + g];
  }
  f32x16 S;
  if (q.sample) {
    const float* st = p.in[I_SR] + ((((size_t)q.b * 2 + l) * 2 + d) * 8 + hh) * 4096;
#pragma unroll
    for (int g = 0; g < 16; ++g) S[g] = st[(32 * vb + crow(g, h)) * 64 + 32 * kb + r32];
  } else {
#pragma unroll
    for (int g = 0; g < 16; ++g) S[g] = 0.f;
  }
  __syncthreads();
  bf16x8 bW[2], bA[2];
#pragma unroll
  for (int ks = 0; ks < 2; ++ks) { bW[ks] = *(const bf16x8*)(Wb2 + (16 * w + l15) * 72 + ks * 32 + qq * 8); bA[ks] = *(const bf16x8*)(Ab2 + (16 * w + l15) * 72 + ks * 32 + qq * 8); }
  __syncthreads();
  for (int e = tid; e < (2 * 64 * 40 + 2 * 64 * 24) / 2; e += NTHR) ((unsigned*)VT0)[e] = 0u;
  for (int e = tid; e < (64 * 40) / 2; e += NTHR) ((unsigned*)VT1)[e] = 0u;
  for (int e = tid; e < (2 * 16 * 40) / 2; e += NTHR) ((unsigned*)ArkM)[e] = 0u;
  __syncthreads();
  const int nch = q.T / 16;
  bf16x8 pf[3][5];
  const int jA = (tid0 & 127) >> 3, c8A = (tid0 & 7) * 8, wh = w >> 1;
#define RW_CB(arr) ((arr) == 0 ? 64 * hh : (arr) == 1 ? 512 + 64 * hh : (arr) == 2 ? 1024 + 64 * hh : (arr) == 3 ? 1536 + 64 * d : 1664 + 64 * d)
#define RW_ISSUE(chn) { const int pos = (chn) * 16 + jA, t = d ? q.T - 1 - pos : pos; _Pragma("unroll") for (int gi = 0; gi < 3; ++gi) { if (gi < 2 || w < 2) { \
      rw_load8(ZR, q.base, t, q.T, q.grid, RW_CB(2 * gi + wh) + c8A, pf[gi]); } } }
#pragma unroll
  for (int g = 0; g < 4; ++g) asm volatile("" : "+v"(w0c[g]), "+v"(a0c[g]), "+v"(kkc[g]), "+v"(kac[g]));
  asm volatile("" : "+v"(S));
  RW_ISSUE(0)
#pragma unroll 1
  for (int ch = 0; ch < nch; ++ch) {
    tid = tid0; asm volatile("" : "+v"(tid));
    lane = tid & 63; l15 = lane & 15; qq = lane >> 4; r32 = lane & 31; h = lane >> 5;
    bf16_t* VT = (ch & 1) ? VT1 : VT0;
    {
      const int pos_ = ch * 16 + jA, t_ = d ? q.T - 1 - pos_ : pos_;
      const unsigned vd_ = rw_valid(t_, q.T, q.grid);
#pragma unroll
      for (int gi = 0; gi < 3; ++gi) {
        if (gi < 2 || w < 2) {
          const int arr = 2 * gi + wh;
          float val[8];
          rw_apply8_lds(pf[gi], mu5 + arr * 64 + c8A, c0t + arr * 64 + c8A, q.grid, vd_, val);
          if (arr < 3) {
            *(f32x4*)(shR + arr * 1024 + jA * 64 + c8A) = (f32x4){val[0], val[1], val[2], val[3]};
            *(f32x4*)(shR + arr * 1024 + jA * 64 + c8A + 4) = (f32x4){val[4], val[5], val[6], val[7]};
            if (arr == 2) {
#pragma unroll
              for (int e = 0; e < 8; ++e) VT[(c8A + e) * 40 + jA] = f2bf(val[e]);
            }
          } else if (arr == 3) {
            *(u32x4*)(actW + jA * 72 + c8A) = (u32x4){pk2(fast_tanh(val[0]), fast_tanh(val[1])), pk2(fast_tanh(val[2]), fast_tanh(val[3])), pk2(fast_tanh(val[4]), fast_tanh(val[5])), pk2(fast_tanh(val[6]), fast_tanh(val[7]))};
          } else {
            *(u32x4*)(actA + jA * 72 + c8A) = (u32x4){pk2(val[0], val[1]), pk2(val[2], val[3]), pk2(val[4], val[5]), pk2(val[6], val[7])};
          }
        }
      }
    }
    asm volatile("" ::: "memory"); __builtin_amdgcn_sched_barrier(0);
    if (ch + 1 < nch) RW_ISSUE(ch + 1)
    __syncthreads();
    {
      f32x4 aw = (f32x4){0.f, 0.f, 0.f, 0.f}, aa = (f32x4){0.f, 0.f, 0.f, 0.f};
#pragma unroll
      for (int ks = 0; ks < 2; ++ks) {
        const bf16x8 fw = *(const bf16x8*)(actW + l15 * 72 + ks * 32 + qq * 8);
        const bf16x8 fa = *(const bf16x8*)(actA + l15 * 72 + ks * 32 + qq * 8);
        aw = __builtin_amdgcn_mfma_f32_16x16x32_bf16(bW[ks], fw, aw, 0, 0, 0);
        aa = __builtin_amdgcn_mfma_f32_16x16x32_bf16(bA[ks], fa, aa, 0, 0, 0);
      }
      const f32x4 kv = *(const f32x4*)(shK + l15 * 64 + cB0), rv = *(const f32x4*)(shR + l15 * 64 + cB0);
      float lw[4], av[4], kkr[4], kd[4], Lp[4], LpL[4];
      float ssq = 0.f;
#pragma unroll
      for (int g = 0; g < 4; ++g) {
        const float wl = aw[g] + w0c[g], al = aa[g] + a0c[g];
        lw[g] = -__expf(-softplusf_(-wl) - 0.5f);
        av[g] = sigmoidf_(al);
        kkr[g] = kv[g] * kkc[g];
        kd[g] = kv[g] * (1.0f + (av[g] - 1.0f) * kac[g]);
        ssq += kkr[g] * kkr[g];
        float x = lw[g];
        x += dpp_row_shr0<1>(x); x += dpp_row_shr0<2>(x); x += dpp_row_shr0<4>(x); x += dpp_row_shr0<8>(x);
        Lp[g] = x;
      }
#pragma unroll
      for (int g = 0; g < 4; ++g) { float x = Lp[g];
        x = fminf(x, __int_as_float(__builtin_amdgcn_mov_dpp(__float_as_int(x), 0x128, 0xF, 0xF, true))); x = fminf(x, __int_as_float(__builtin_amdgcn_mov_dpp(__float_as_int(x), 0x124, 0xF, 0xF, true)));
        x = fminf(x, dpp_xor2(x)); x = fminf(x, dpp_xor1(x)); LpL[g] = x; }
      ssq += SHX(ssq, 16); ssq += SHX(ssq, 32);
      if (qq == 0) npart[w * 16 + l15] = ssq;
      float e_m1[4], e_neg[4], e_pos[4], e_end[4];
#pragma unroll
      for (int g = 0; g < 4; ++g) { e_m1[g] = __expf(Lp[g] - lw[g]); e_neg[g] = __expf(-Lp[g]); e_pos[g] = __expf(Lp[g]); e_end[g] = __expf(LpL[g] - Lp[g]); }
      *(u32x2*)(KHr + l15 * 72 + cB0) = (u32x2){pk2(kkr[0] * e_m1[0], kkr[1] * e_m1[1]), pk2(kkr[2] * e_m1[2], kkr[3] * e_m1[3])};
      *(u32x2*)(BCr + l15 * 72 + cB0) = (u32x2){pk2(kkr[0] * av[0] * e_neg[0], kkr[1] * av[1] * e_neg[1]), pk2(kkr[2] * av[2] * e_neg[2], kkr[3] * av[3] * e_neg[3])};
      *(u32x2*)(KC + l15 * 72 + cB0) = (u32x2){pk2(kd[0] * e_neg[0], kd[1] * e_neg[1]), pk2(kd[2] * e_neg[2], kd[3] * e_neg[3])};
      *(u32x2*)(RH + l15 * 72 + cB0) = (u32x2){pk2(rv[0] * e_pos[0], rv[1] * e_pos[1]), pk2(rv[2] * e_pos[2], rv[3] * e_pos[3])};
#pragma unroll
      for (int g = 0; g < 4; ++g) {
        KBT[(cB0 + g) * 24 + l15] = f2bf(kd[g] * e_end[g]);
        BBT[(cB0 + g) * 24 + l15] = f2bf(kkr[g] * av[g] * e_end[g]);
      }
      if (l15 == 15) *(f32x4*)(PL + cB0) = (f32x4){e_pos[0], e_pos[1], e_pos[2], e_pos[3]};
#pragma unroll
      for (int g = 0; g < 16; ++g) Sb[(32 * vb + crow(g, h)) * 72 + 32 * kb + r32] = f2bf(S[g]);
    }
    __syncthreads();
    f32x4 oacc = (f32x4){0.f, 0.f, 0.f, 0.f};
    {
      const bf16_t* Aop = (w < 2) ? KHr : RH;
      const bf16_t* Bop = (w == 0 || w == 3) ? BCr : KC;
      f32x4 t16 = (f32x4){0.f, 0.f, 0.f, 0.f}, g0 = (f32x4){0.f, 0.f, 0.f, 0.f};
#pragma unroll
      for (int ks = 0; ks < 2; ++ks) {
        const bf16x8 a = *(const bf16x8*)(Aop + l15 * 72 + ks * 32 + qq * 8);
        const bf16x8 b = *(const bf16x8*)(Bop + l15 * 72 + ks * 32 + qq * 8);
        t16 = __builtin_amdgcn_mfma_f32_16x16x32_bf16(a, b, t16, 0, 0, 0);
        const bf16x8 akh = *(const bf16x8*)(KHr + l15 * 72 + ks * 32 + qq * 8);
        const bf16x8 arh = *(const bf16x8*)(RH + l15 * 72 + ks * 32 + qq * 8);
        const bf16x8 bs = *(const bf16x8*)(Sb + (16 * w + l15) * 72 + ks * 32 + qq * 8);
        g0 = __builtin_amdgcn_mfma_f32_16x16x32_bf16(akh, bs, g0, 0, 0, 0);
        oacc = __builtin_amdgcn_mfma_f32_16x16x32_bf16(arh, bs, oacc, 0, 0, 0);
      }
#pragma unroll
      for (int g = 0; g < 4; ++g) G0[(4 * qq + g) * 64 + 16 * w + l15] = g0[g];
      *(f32x4*)(MN + w * 256 + l15 * 16 + 4 * qq) = t16;
    }
    __syncthreads();
    if (w == 0) {
      const float* MrT = MN; const float* NrT = MN + 256;
      f32x2 acc2[8];
#pragma unroll
      for (int pq = 0; pq < 8; ++pq) acc2[pq] = (f32x2){G0[(2 * pq) * 64 + lane], G0[(2 * pq + 1) * 64 + lane]};
      float vv[16], un[16];
#pragma unroll
      for (int j = 0; j < 16; ++j) vv[j] = shV[j * 64 + lane];
      const float n2v = __builtin_amdgcn_rcpf(fmaxf(npart[l15] + npart[16 + l15] + npart[32 + l15] + npart[48 + l15], 1e-24f));
      f32x4 nr[4], mr[4];
#pragma unroll
      for (int t4 = 0; t4 < 4; ++t4) { nr[t4] = *(const f32x4*)(NrT + 4 * t4); mr[t4] = *(const f32x4*)(MrT + 4 * t4); }
#pragma unroll
      for (int j = 0; j < 16; ++j) {
        f32x4 nrn[4], mrn[4];
#pragma unroll
        for (int t4 = 0; t4 < 4; ++t4) { nrn[t4] = (f32x4){0.f, 0.f, 0.f, 0.f}; mrn[t4] = (f32x4){0.f, 0.f, 0.f, 0.f}; }
        if (j + 1 < 16) {
#pragma unroll
          for (int t4 = 0; t4 < 4; ++t4) if (4 * t4 + 3 > j + 1) { nrn[t4] = *(const f32x4*)(NrT + (j + 1) * 16 + 4 * t4); mrn[t4] = *(const f32x4*)(MrT + (j + 1) * 16 + 4 * t4); }
        }
        const float n2s = __int_as_float(__builtin_amdgcn_readlane(__float_as_int(n2v), j));
        const float unj = -acc2[j >> 1][j & 1] * n2s;
        un[j] = unj;
        const f32x2 vv2 = (f32x2){vv[j], vv[j]}, un2 = (f32x2){unj, unj};
#pragma unroll
        for (int pq = 0; pq < 8; ++pq)
          if (2 * pq + 1 > j) acc2[pq] += (f32x2){nr[pq >> 1][2 * (pq & 1)], nr[pq >> 1][2 * (pq & 1) + 1]} * vv2 + (f32x2){mr[pq >> 1][2 * (pq & 1)], mr[pq >> 1][2 * (pq & 1) + 1]} * un2;
#pragma unroll
        for (int t4 = 0; t4 < 4; ++t4) { nr[t4] = nrn[t4]; mr[t4] = mrn[t4]; }
        __builtin_amdgcn_sched_barrier(0);
      }
      *(u32x4*)(UNT + lane * 40) = (u32x4){pk2(un[0], un[1]), pk2(un[2], un[3]), pk2(un[4], un[5]), pk2(un[6], un[7])};
      *(u32x4*)(UNT + lane * 40 + 8) = (u32x4){pk2(un[8], un[9]), pk2(un[10], un[11]), pk2(un[12], un[13]), pk2(un[14], un[15])};
    } else if (w < 3) {
      const float* src = MN + (w == 1 ? 512 : 768);
      bf16_t* dst = (w == 1) ? ArkM : ArbM;
#pragma unroll
      for (int i = 0; i < 4; ++i) { const int e = lane + 64 * i, j = e >> 4, t = e & 15; dst[t * 40 + j] = f2bf(j <= t ? src[e] : 0.f); }
    }
    __syncthreads();
    {
      const bf16x8 ak = *(const bf16x8*)(ArkM + l15 * 40 + qq * 8), ab = *(const bf16x8*)(ArbM + l15 * 40 + qq * 8);
      const bf16x8 bv = *(const bf16x8*)(VT + (16 * w + l15) * 40 + qq * 8), bu = *(const bf16x8*)(UNT + (16 * w + l15) * 40 + qq * 8);
      oacc = __builtin_amdgcn_mfma_f32_16x16x32_bf16(ak, bv, oacc, 0, 0, 0);
      oacc = __builtin_amdgcn_mfma_f32_16x16x32_bf16(ab, bu, oacc, 0, 0, 0);
#pragma unroll
      for (int g = 0; g < 4; ++g) {
        const int pos = ch * 16 + 4 * qq + g, t = d ? q.T - 1 - pos : pos;
        O[(size_t)(q.base + t) * 1024 + d * 512 + 64 * hh + 16 * w + l15] = f2bf(oacc[g]);
      }
      const float pl = PL[32 * kb + r32];
#pragma unroll
      for (int g = 0; g < 16; ++g) S[g] *= pl;
      const bf16x8 av_ = *(const bf16x8*)(VT + (32 * vb + r32) * 40 + 8 * h), au_ = *(const bf16x8*)(UNT + (32 * vb + r32) * 40 + 8 * h);
      const bf16x8 bk_ = *(const bf16x8*)(KBT + (32 * kb + r32) * 24 + 8 * h), bb_ = *(const bf16x8*)(BBT + (32 * kb + r32) * 24 + 8 * h);
      S = __builtin_amdgcn_mfma_f32_32x32x16_bf16(av_, bk_, S, 0, 0, 0);
      S = __builtin_amdgcn_mfma_f32_32x32x16_bf16(au_, bb_, S, 0, 0, 0);
    }
  }
  if (!q.sample) {
    float* dst = p.out + OUT_RW + ((((size_t)q.b * 2 + l) * 2 + d) * 8 + hh) * 4096;
#pragma unroll
    for (int g = 0; g < 16; ++g) dst[(32 * vb + crow(g, h)) * 64 + 32 * kb + r32] = S[g];
  }
}

DI void hgrn_item(const Params& p, int l, int s, int hh, int d, char* smem) {
  const Seq q = get_seq(s);
  const int tid = ltid(), lane = tid & 63, w = tid >> 6, r = lane & 31, h = lane >> 5;
  bf16_t* ZH = (bf16_t*)(p.ws + OFF_ZH);
  bf16_t* Qt = (bf16_t*)smem;
  bf16_t* Kt = Qt + 32 * 136;
  bf16_t* KhT = Kt + 32 * 136;
  bf16_t* VT = KhT + 128 * 40;
  bf16_t* Sb = VT + 128 * 40;
  bf16_t* At = Sb + 4 * 32 * 136;
  float* dL = (float*)(At + 32 * 40);
  float* tot = dL + 128;
  const float lb = ((const float*)(p.ws + OFF_LBS))[l * 512 + 128 * hh + (tid & 127)];
  f32x16 S[4];
  if (q.sample) {
    const float* st = p.in[I_SH] + ((((size_t)q.b * 2 + l) * 2 + d) * 4 + hh) * 16384;
#pragma unroll
    for (int kb = 0; kb < 4; ++kb)
#pragma unroll
      for (int g = 0; g < 16; ++g) S[kb][g] = st[(size_t)(32 * kb + crow(g, h)) * 128 + 32 * w + r];
  } else {
#pragma unroll
    for (int kb = 0; kb < 4; ++kb)
#pragma unroll
      for (int g = 0; g < 16; ++g) S[kb][g] = 0.f;
  }
  const int k = tid & 127, half = tid >> 7;
  const int nch = q.T / 32;
  u16x2 pzq[16], pv2[8];
#define HG_ISSUE(chn) { _Pragma("unroll") for (int jj = 0; jj < 16; ++jj) { const int pos = (chn) * 32 + half * 16 + jj, t = d ? q.T - 1 - pos : pos; \
      const size_t rowo = (size_t)(q.base + t) * ZHW + 128 * hh + k; pzq[jj][0] = ZH[rowo + 512 * (1 + d)]; pzq[jj][1] = ZH[rowo]; pv2[jj >> 1][jj & 1] = ZH[rowo + 1536]; } }
  { float lb_ = lb; asm volatile("" : "+v"(lb_)); (void)lb_; }
#pragma unroll
  for (int kb = 0; kb < 4; ++kb) asm volatile("" : "+v"(S[kb]));
  HG_ISSUE(0)
#pragma unroll 1
  for (int ch = 0; ch < nch; ++ch) {
    __syncthreads();
    float bl[16], kc[16], qs[16];
    {
      float b = 0.f;
#pragma unroll
      for (int jj = 0; jj < 16; ++jj) {
        const float z = bf2f(pzq[jj][0]);
        const float kcoef = (1.0f - lb) * sigmoidf_(-z);
        const float f = 1.0f - kcoef;
        b += fmaxf(__logf(f), -80.f);
        bl[jj] = b; kc[jj] = kcoef; qs[jj] = bf2f(pzq[jj][1]) * 0.08838834764831845f;
      }
      *(u32x4*)(VT + k * 40 + half * 16) = (u32x4){__builtin_bit_cast(unsigned, pv2[0]), __builtin_bit_cast(unsigned, pv2[1]), __builtin_bit_cast(unsigned, pv2[2]), __builtin_bit_cast(unsigned, pv2[3])};
      *(u32x4*)(VT + k * 40 + half * 16 + 8) = (u32x4){__builtin_bit_cast(unsigned, pv2[4]), __builtin_bit_cast(unsigned, pv2[5]), __builtin_bit_cast(unsigned, pv2[6]), __builtin_bit_cast(unsigned, pv2[7])};
      tot[half * 128 + k] = b;
    }
    if (ch + 1 < nch) HG_ISSUE(ch + 1)
    __syncthreads();
    {
      const float off = half ? tot[k] : 0.f;
      const float bL = fmaxf(tot[k] + tot[128 + k], -80.f);
      if (half == 0) dL[k] = __expf(bL);
      float kh[16];
#pragma unroll
      for (int jj = 0; jj < 16; ++jj) {
        const int j = half * 16 + jj;
        const float bj = fmaxf(off + bl[jj], -80.f);
        Qt[j * 136 + k] = f2bf(qs[jj] * __expf(bj));
        Kt[j * 136 + k] = f2bf(kc[jj] * __expf(-bj));
        kh[jj] = kc[jj] * __expf(fminf(bL - bj, 0.f));
      }
      *(u32x4*)(KhT + k * 40 + half * 16) = (u32x4){pk2(kh[0], kh[1]), pk2(kh[2], kh[3]), pk2(kh[4], kh[5]), pk2(kh[6], kh[7])};
      *(u32x4*)(KhT + k * 40 + half * 16 + 8) = (u32x4){pk2(kh[8], kh[9]), pk2(kh[10], kh[11]), pk2(kh[12], kh[13]), pk2(kh[14], kh[15])};
    }
    bf16_t* Sbw = Sb + w * 32 * 136;
#pragma unroll
    for (int kb = 0; kb < 4; ++kb)
#pragma unroll
      for (int g4 = 0; g4 < 4; ++g4) *(u32x2*)(Sbw + r * 136 + 32 * kb + crow(4 * g4, h)) = (u32x2){pk2(S[kb][4 * g4], S[kb][4 * g4 + 1]), pk2(S[kb][4 * g4 + 2], S[kb][4 * g4 + 3])};
    __syncthreads();
    bf16_t* Atw = At;
    {
      f32x16 A;
#pragma unroll
      for (int g = 0; g < 16; ++g) A[g] = 0.f;
      mma32(A, Qt, 136, Kt, 136, 128, lane);
#pragma unroll
      for (int g = 0; g < 16; ++g) { const int t = crow(g, h); Atw[t * 40 + r] = f2bf(r <= t ? A[g] : 0.f); }
    }
    __syncthreads();
    {
      f32x16 o;
#pragma unroll
      for (int g = 0; g < 16; ++g) o[g] = 0.f;
      mma32(o, Atw, 40, VT + 32 * w * 40, 40, 32, lane);
      mma32(o, Qt, 136, Sbw, 136, 128, lane);
#pragma unroll
      for (int g = 0; g < 16; ++g) {
        const int j = crow(g, h), pos = ch * 32 + j, t = d ? q.T - 1 - pos : pos;
        ZH[(size_t)(q.base + t) * ZHW + 512 * (1 + d) + 128 * hh + 32 * w + r] = f2bf(o[g]);
      }
#pragma unroll
      for (int kb = 0; kb < 4; ++kb) {
#pragma unroll
        for (int g = 0; g < 16; ++g) S[kb][g] *= dL[32 * kb + crow(g, h)];
        mma32(S[kb], KhT + 32 * kb * 40, 40, VT + 32 * w * 40, 40, 32, lane);
      }
    }
  }
  if (!q.sample) {
    float* dst = p.out + OUT_HG + ((((size_t)q.b * 2 + l) * 2 + d) * 4 + hh) * 16384;
#pragma unroll
    for (int kb = 0; kb < 4; ++kb)
#pragma unroll
      for (int g = 0; g < 16; ++g) dst[(size_t)(32 * kb + crow(g, h)) * 128 + 32 * w + r] = S[kb][g];
  }
}

DI void mlstm_item(const Params& p, int l, int s, int hh, int d, char* smem) {
  const Seq q = get_seq(s);
  const int tid = ltid(), lane = tid & 63, w = tid >> 6, r = lane & 31, h = lane >> 5;
  const bf16_t* ZM = (const bf16_t*)(p.ws + OFF_ZM);
  const float* MG = (const float*)(p.ws + OFF_MG);
  bf16_t* Hb = (bf16_t*)(p.ws + OFF_H);
  bf16_t* Qm = (bf16_t*)smem;
  bf16_t* Km = Qm + 32 * 136;
  bf16_t* KwT = Km + 32 * 136;
  bf16_t* VT = KwT + 128 * 40;
  bf16_t* Cb = VT + 128 * 40;
  bf16_t* Pt = Cb + 4 * 32 * 136;
  float* nv = (float*)(Pt + 32 * 40);
  float* sc = nv + 128;
  float* ig = sc; float* lf = sc + 32; float* gg = sc + 64; float* mtv = sc + 96; float* wi = sc + 128; float* wsr = sc + 160; float* qn = sc + 192; float* misc = sc + 224;
  float* dnw = sc + 232;
  const float gbi = p.in[I_GB][l * 16 + (2 * d) * 4 + hh], gbf = p.in[I_GB][l * 16 + (2 * d + 1) * 4 + hh];
  f32x16 C[4];
  float m;
  __syncthreads();
  if (q.sample) {
    const size_t sb = (((size_t)q.b * 2 + l) * 2 + d) * 4 + hh;
    const float* st = p.in[I_SC] + sb * 16384;
#pragma unroll
    for (int kb = 0; kb < 4; ++kb)
#pragma unroll
      for (int g = 0; g < 16; ++g) C[kb][g] = st[(size_t)(32 * kb + crow(g, h)) * 128 + 32 * w + r];
    if (tid < 128) nv[tid] = p.in[I_SN][sb * 128 + tid];
    m = p.in[I_SM][sb];
  } else {
#pragma unroll
    for (int kb = 0; kb < 4; ++kb)
#pragma unroll
      for (int g = 0; g < 16; ++g) C[kb][g] = 0.f;
    if (tid < 128) nv[tid] = 0.f;
    m = 0.f;
  }
  const int nch = q.T / 32;
  const int dd = tid & 127, half = tid >> 7;
  u16x2 pqk[16], pv2[8]; float pgi = 0.f, pgf = 0.f;
#define ML_ISSUE(chn) { _Pragma("unroll") for (int jj = 0; jj < 16; ++jj) { const int pos = (chn) * 32 + half * 16 + jj, t = d ? q.T - 1 - pos : pos; \
      const size_t rowo = (size_t)(q.base + t) * ZMW + 128 * hh + dd; pqk[jj][0] = ZM[rowo]; pqk[jj][1] = ZM[rowo + 512]; pv2[jj >> 1][jj & 1] = ZM[rowo + 1024]; } \
    if (tid < 32) { const int pos = (chn) * 32 + tid, t = d ? q.T - 1 - pos : pos; const float* mg = MG + (size_t)(q.base + t) * 16; pgi = mg[(2 * d) * 4 + hh]; pgf = mg[(2 * d + 1) * 4 + hh]; } }
#pragma unroll
  for (int kb = 0; kb < 4; ++kb) asm volatile("" : "+v"(C[kb]));
  asm volatile("" : "+v"(m));
  ML_ISSUE(0)
#pragma unroll 1
  for (int ch = 0; ch < nch; ++ch) {
    __syncthreads();
    {
#pragma unroll
      for (int jj = 0; jj < 16; ++jj) {
        const int j = half * 16 + jj;
        Qm[j * 136 + dd] = pqk[jj][0];
        Km[j * 136 + dd] = f2bf(bf2f(pqk[jj][1]) * 0.08838834764831845f);
      }
      *(u32x4*)(VT + dd * 40 + half * 16) = (u32x4){__builtin_bit_cast(unsigned, pv2[0]), __builtin_bit_cast(unsigned, pv2[1]), __builtin_bit_cast(unsigned, pv2[2]), __builtin_bit_cast(unsigned, pv2[3])};
      *(u32x4*)(VT + dd * 40 + half * 16 + 8) = (u32x4){__builtin_bit_cast(unsigned, pv2[4]), __builtin_bit_cast(unsigned, pv2[5]), __builtin_bit_cast(unsigned, pv2[6]), __builtin_bit_cast(unsigned, pv2[7])};
      if (tid < 32) {
        const float igv = pgi + gbi;
        const float lfv = -softplusf_(-(pgf + gbf));
        float g = lfv;
#pragma unroll
        for (int o = 1; o < 32; o <<= 1) { const float tt = shfl_lane(g, (lane - o) & 63); if (tid >= o) g += tt; }
        const float cs = igv - g;
        float pm = cs;
#pragma unroll
        for (int o = 1; o < 32; o <<= 1) { const float tt = shfl_lane(pm, (lane - o) & 63); if (tid >= o) pm = fmaxf(pm, tt); }
        const float mt = g + fmaxf(m, pm);
        const float gend = shfl_lane(g, 31), mn = shfl_lane(mt, 31);
        ig[tid] = igv; gg[tid] = g; mtv[tid] = mt; wi[tid] = __expf(g + m - mt);
        wsr[tid] = __expf(gend + cs - mn);
        if (tid == 0) { misc[0] = mn; misc[1] = __expf(gend + m - mn); }
      }
    }
    if (ch + 1 < nch) ML_ISSUE(ch + 1)
    __syncthreads();
    {
      {
        float kw[16];
#pragma unroll
        for (int jj = 0; jj < 16; ++jj) { const int j = half * 16 + jj; kw[jj] = bf2f(Km[j * 136 + dd]) * wsr[j]; }
        *(u32x4*)(KwT + dd * 40 + half * 16) = (u32x4){pk2(kw[0], kw[1]), pk2(kw[2], kw[3]), pk2(kw[4], kw[5]), pk2(kw[6], kw[7])};
        *(u32x4*)(KwT + dd * 40 + half * 16 + 8) = (u32x4){pk2(kw[8], kw[9]), pk2(kw[10], kw[11]), pk2(kw[12], kw[13]), pk2(kw[14], kw[15])};
      }
      const int j = tid >> 3, seg = tid & 7;
      float a = 0.f;
#pragma unroll
      for (int i = 0; i < 16; ++i) a += bf2f(Qm[j * 136 + seg * 16 + i]) * nv[seg * 16 + i];
      a += SHX(a, 1); a += SHX(a, 2); a += SHX(a, 4);
      if (seg == 0) qn[j] = a;
    }
    const float m_new = misc[0], carry = misc[1];
    bf16_t* Cbw = Cb + w * 32 * 136; bf16_t* Ptw = Pt;
#pragma unroll
    for (int kb = 0; kb < 4; ++kb)
#pragma unroll
      for (int g4 = 0; g4 < 4; ++g4) *(u32x2*)(Cbw + r * 136 + 32 * kb + crow(4 * g4, h)) = (u32x2){pk2(C[kb][4 * g4], C[kb][4 * g4 + 1]), pk2(C[kb][4 * g4 + 2], C[kb][4 * g4 + 3])};
    {
      f32x16 Sc;
#pragma unroll
      for (int g = 0; g < 16; ++g) Sc[g] = 0.f;
      mma32(Sc, Qm, 136, Km, 136, 128, lane);
      const float gs = gg[r], is = ig[r];
#pragma unroll
      for (int g = 0; g < 16; ++g) {
        const int t = crow(g, h);
        const float pv = (r <= t) ? __expf(gg[t] - gs + is - mtv[t]) * Sc[g] : 0.f;
        Ptw[t * 40 + r] = f2bf(pv);
      }
    }
    __syncthreads();
    if (lane < 32) {
      float a = 0.f;
#pragma unroll 4
      for (int i = 0; i < 32; ++i) a += bf2f(Ptw[lane * 40 + i]);
      const float den = wi[lane] * qn[lane] + a;
      dnw[lane] = 1.0f / fmaxf(fabsf(den), __expf(-mtv[lane]));
    }
    if (tid < 128) {
      float a = 0.f;
#pragma unroll 4
      for (int i = 0; i < 32; ++i) a += bf2f(KwT[tid * 40 + i]);
      nv[tid] = carry * nv[tid] + a;
    }
    __syncthreads();
    {
      f32x16 a1;
#pragma unroll
      for (int g = 0; g < 16; ++g) a1[g] = 0.f;
      mma32(a1, Qm, 136, Cbw, 136, 128, lane);
#pragma unroll
      for (int g = 0; g < 16; ++g) a1[g] *= wi[crow(g, h)];
      mma32(a1, Ptw, 40, VT + 32 * w * 40, 40, 32, lane);
#pragma unroll
      for (int g = 0; g < 16; ++g) {
        const int j = crow(g, h), pos = ch * 32 + j, t = d ? q.T - 1 - pos : pos;
        const float hv = a1[g] * dnw[j];
        Hb[(size_t)(q.base + t) * 1024 + d * 512 + 128 * hh + 32 * w + r] = f2bf(hv);
      }
#pragma unroll
      for (int kb = 0; kb < 4; ++kb) {
#pragma unroll
        for (int g = 0; g < 16; ++g) C[kb][g] *= carry;
        mma32(C[kb], KwT + 32 * kb * 40, 40, VT + 32 * w * 40, 40, 32, lane);
      }
    }
    m = m_new;
  }
  __syncthreads();
  if (!q.sample) {
    const size_t sb = (((size_t)q.b * 2 + l) * 2 + d) * 4 + hh;
    float* dst = p.out + OUT_C + sb * 16384;
#pragma unroll
    for (int kb = 0; kb < 4; ++kb)
#pragma unroll
      for (int g = 0; g < 16; ++g) dst[(size_t)(32 * kb + crow(g, h)) * 128 + 32 * w + r] = C[kb][g];
    if (tid < 128) p.out[OUT_N + sb * 128 + tid] = nv[tid];
    if (tid == 0) p.out[OUT_M + sb] = m;
  }
}

DI void phase_scan(const Params& p, int l, char* smem) {
  int* ctrL = (int*)(p.ws + OFF_CTR) + 2 * l;
  int* ctrS = ctrL + 1;
  int* sit = (int*)(smem + LDS_BYTES - 16);
  const int role = p.role;
  bool longDone = false, shortDone = false;
  for (;;) {
    const bool wantLong = (role == 0) ? !longDone : shortDone;
    if (longDone && shortDone) break;
    __syncthreads();
    if (ltid() == 0) *sit = atomicAdd(wantLong ? ctrL : ctrS, 1);
    __syncthreads();
    int it = __builtin_amdgcn_readfirstlane(*sit);
    int ty, s_, hh_, d_, rb_ = 0;
    if (wantLong) {
      if (it >= 128) { longDone = true; continue; }
      if (it < 64) { ty = 0; d_ = it & 1; hh_ = (it >> 1) & 7; s_ = 32 + (it >> 4); }
      else if (it < 96) { it -= 64; ty = 1; s_ = 32 + (it >> 3); hh_ = (it >> 1) & 3; d_ = it & 1; }
      else { it -= 96; ty = 2; s_ = 32 + (it >> 3); hh_ = (it >> 1) & 3; d_ = it & 1; }
    } else {
      if (it >= 1024) { shortDone = true; continue; }
      if (it < 512) { ty = 0; s_ = it >> 4; hh_ = (it >> 1) & 7; d_ = it & 1; }
      else if (it < 768) { it -= 512; ty = 1; s_ = it >> 3; hh_ = (it >> 1) & 3; d_ = it & 1; }
      else { it -= 768; ty = 2; s_ = it >> 3; hh_ = (it >> 1) & 3; d_ = it & 1; }
    }
    if (ty == 0) rwkv_item(p, l, s_, hh_, d_, smem);
    else if (ty == 1) hgrn_item(p, l, s_, hh_, d_, smem);
    else mlstm_item(p, l, s_, hh_, d_, smem);
  }
}

DI void phase_combine(const Params& p, int l, char* smem) {
  const int tid = ltid(), lane = tid & 63, w = tid >> 6;
  bf16_t* ZH = (bf16_t*)(p.ws + OFF_ZH); bf16_t* ZM = (bf16_t*)(p.ws + OFF_ZM); const bf16_t* ZR = (const bf16_t*)(p.ws + OFF_ZR);
  bf16_t* O = (bf16_t*)(p.ws + OFF_O); const bf16_t* Hb = (const bf16_t*)(p.ws + OFF_H);
  const float* mu = p.in[I_MU] + (size_t)l * 4 * ZRW;
  const float* g2 = p.in[I_G2] + (size_t)l * 128 * 512;
  float* sg = (float*)smem;
  float* gt = sg + 128 * 16;
  for (int blk = blockIdx.x; blk < NT / 16; blk += gridDim.x) {
    const int tok0 = blk * 16;
    int sidx, t0;
    if (tok0 < 8192) { sidx = tok0 >> 8; t0 = tok0 & 255; } else { sidx = 32 + ((tok0 - 8192) >> 11); t0 = (tok0 - 8192) & 2047; }
    const Seq q = get_seq(sidx);
    __syncthreads();
    { const int j = tid >> 4, rr0 = (tid & 15) * 8; float val[8]; bf16x8 pv[5]; rw_load8(ZR, q.base, t0 + j, q.T, q.grid, 1792 + rr0, pv); rw_apply8(pv, mu, q.grid, rw_valid(t0 + j, q.T, q.grid), 1792 + rr0, val);
#pragma unroll
      for (int e = 0; e < 8; ++e) sg[(rr0 + e) * 16 + j] = sigmoidf_(val[e]); }
    __syncthreads();
    {
      float a0[16], a1[16];
#pragma unroll
      for (int j = 0; j < 16; ++j) { a0[j] = 0.f; a1[j] = 0.f; }
#pragma unroll 1
      for (int r0 = 0; r0 < 128; r0 += 8) {
        float w0v[8], w1v[8];
#pragma unroll
        for (int q8 = 0; q8 < 8; ++q8) { w0v[q8] = g2[(r0 + q8) * 512 + tid]; w1v[q8] = g2[(r0 + q8) * 512 + 256 + tid]; }
#pragma unroll
        for (int q8 = 0; q8 < 8; ++q8) {
          const int rr = r0 + q8; const float w0 = w0v[q8], w1 = w1v[q8];
#pragma unroll
          for (int u = 0; u < 4; ++u) {
            f32x4 sv = *(const f32x4*)(sg + rr * 16 + 4 * u);
#pragma unroll
            for (int e = 0; e < 4; ++e) { a0[4 * u + e] += sv[e] * w0; a1[4 * u + e] += sv[e] * w1; }
          }
        }
      }
#pragma unroll
      for (int j = 0; j < 16; ++j) { gt[j * 512 + tid] = a0[j]; gt[j * 512 + 256 + tid] = a1[j]; }
    }
    __syncthreads();
#pragma unroll 1
    for (int jj = 0; jj < 4; ++jj) {
      const int j = w * 4 + jj, tok = tok0 + j, t = t0 + j; int c0 = lane * 8; asm volatile("" : "+v"(c0));
      {
        float o[8], rs[8], ks[8], vs[8];
        float sum = 0.f, bon = 0.f;
        {
          bf16x8 pr_[5], pk_[5], pv_[5];
          rw_load8(ZR, q.base, t, q.T, q.grid, c0, pr_); rw_load8(ZR, q.base, t, q.T, q.grid, 512 + c0, pk_); rw_load8(ZR, q.base, t, q.T, q.grid, 1024 + c0, pv_);
          const unsigned vd_ = rw_valid(t, q.T, q.grid);
          rw_apply8(pr_, mu, q.grid, vd_, c0, rs); rw_apply8(pk_, mu, q.grid, vd_, 512 + c0, ks); rw_apply8(pv_, mu, q.grid, vd_, 1024 + c0, vs);
        }
        const bf16x8 of = *(const bf16x8*)(O + (size_t)tok * 1024 + c0), ob = *(const bf16x8*)(O + (size_t)tok * 1024 + 512 + c0);
        const f32x4 rk0 = *(const f32x4*)(p.in[I_RK] + l * 512 + c0), rk1 = *(const f32x4*)(p.in[I_RK] + l * 512 + c0 + 4);
#pragma unroll
        for (int e = 0; e < 8; ++e) {
          o[e] = bf2f((bf16_t)of[e]) + bf2f((bf16_t)ob[e]);
          sum += o[e];
          bon += rs[e] * ks[e] * (e < 4 ? rk0[e & 3] : rk1[e & 3]);
        }
        sum += SHX(sum, 1); sum += SHX(sum, 2); sum += SHX(sum, 4);
        bon += SHX(bon, 1); bon += SHX(bon, 2); bon += SHX(bon, 4);
        const float mean = sum * (1.0f / 64.f);
        float var = 0.f;
#pragma unroll
        for (int e = 0; e < 8; ++e) { const float dv = o[e] - mean; var += dv * dv; }
        var += SHX(var, 1); var += SHX(var, 2); var += SHX(var, 4);
        const float rstd = rsqrtf(var * (1.0f / 64.f) + 64e-5f);
        const f32x4 lw0 = *(const f32x4*)(p.in[I_LN] + (l * 2 + 0) * 512 + c0), lw1 = *(const f32x4*)(p.in[I_LN] + (l * 2 + 0) * 512 + c0 + 4);
        const f32x4 lb0 = *(const f32x4*)(p.in[I_LN] + (l * 2 + 1) * 512 + c0), lb1 = *(const f32x4*)(p.in[I_LN] + (l * 2 + 1) * 512 + c0 + 4);
        const f32x4 gt0 = *(const f32x4*)(gt + j * 512 + c0), gt1 = *(const f32x4*)(gt + j * 512 + c0 + 4);
        bf16x8 ov;
#pragma unroll
        for (int e = 0; e < 8; ++e) {
          const float ln = (o[e] - mean) * rstd * (e < 4 ? lw0[e & 3] : lw1[e & 3]) + (e < 4 ? lb0[e & 3] : lb1[e & 3]);
          ov[e] = (short)f2bf((ln + bon * vs[e]) * (e < 4 ? gt0[e & 3] : gt1[e & 3]));
        }
        *(bf16x8*)(O + (size_t)tok * 1024 + c0) = ov;
      }
      {
        float o[8]; float ss = 0.f;
        bf16_t* zr_ = ZH + (size_t)tok * ZHW + c0;
        const bf16x8 of = *(const bf16x8*)(zr_ + 512), ob = *(const bf16x8*)(zr_ + 1024), hgv = *(const bf16x8*)(zr_ + 2048);
        const f32x4 nw0 = *(const f32x4*)(p.in[I_HNORM] + l * 512 + c0), nw1 = *(const f32x4*)(p.in[I_HNORM] + l * 512 + c0 + 4);
#pragma unroll
        for (int e = 0; e < 8; ++e) { o[e] = bf2f((bf16_t)of[e]) + bf2f((bf16_t)ob[e]); ss += o[e] * o[e]; }
        ss += SHX(ss, 1); ss += SHX(ss, 2); ss += SHX(ss, 4); ss += SHX(ss, 8);
        const float rsd = rsqrtf(ss * (1.0f / 128.f) + 1e-6f);
        bf16x8 ov;
#pragma unroll
        for (int e = 0; e < 8; ++e) ov[e] = (short)f2bf(o[e] * rsd * (e < 4 ? nw0[e & 3] : nw1[e & 3]) * siluf_(bf2f((bf16_t)hgv[e])));
        *(bf16x8*)(zr_ + 2048) = ov;
      }
      {
        float o[8]; float ss = 0.f;
        bf16_t* zm_ = ZM + (size_t)tok * ZMW + 1536 + c0;
        const bf16x8 of = *(const bf16x8*)(Hb + (size_t)tok * 1024 + c0), ob = *(const bf16x8*)(Hb + (size_t)tok * 1024 + 512 + c0), mov = *(const bf16x8*)zm_;
        const f32x4 nw0 = *(const f32x4*)(p.in[I_MNORM] + l * 512 + c0), nw1 = *(const f32x4*)(p.in[I_MNORM] + l * 512 + c0 + 4);
#pragma unroll
        for (int e = 0; e < 8; ++e) { o[e] = bf2f((bf16_t)of[e]) + bf2f((bf16_t)ob[e]); ss += o[e] * o[e]; }
        ss += SHX(ss, 1); ss += SHX(ss, 2); ss += SHX(ss, 4); ss += SHX(ss, 8);
        const float rsd = rsqrtf(ss * (1.0f / 128.f) + 1e-6f);
        bf16x8 ov;
#pragma unroll
        for (int e = 0; e < 8; ++e) ov[e] = (short)f2bf(o[e] * rsd * (e < 4 ? nw0[e & 3] : nw1[e & 3]) * sigmoidf_(bf2f((bf16_t)mov[e])));
        *(bf16x8*)zm_ = ov;
      }
    }
    __syncthreads();
#pragma unroll 1
    for (int jj = 0; jj < 4; ++jj) tok_one(p, l, 3, tok0 + w * 4 + jj, lane);
  }
}

#define XB_TMO      128
#define XB_XCNT(j)  (256  + 64 * (j))
#define XB_XSUB(j)  (1280 + 64 * (j))
#define XB_XGEN(j)  (2304 + 64 * (j))
#define XB_TOP      3328
#define XB_TOPGEN   3392
#define XCD_BAR_WORDS 3456
#define XB_SPIN_CAP (1u << 20)
#define LAS __attribute__((address_space(3)))
DI unsigned xb_ld(unsigned* p)              { return __hip_atomic_load(p, __ATOMIC_RELAXED, __HIP_MEMORY_SCOPE_AGENT); }
DI unsigned xb_add(unsigned* p, unsigned v) { return __hip_atomic_fetch_add(p, v, __ATOMIC_RELAXED, __HIP_MEMORY_SCOPE_AGENT); }
DI unsigned xb_xcc_id() { return (unsigned)__builtin_amdgcn_s_getreg((3 << 11) | 20) & 0xFu; }
#define XB_SPIN(cond, bar) do { unsigned _sp = 0; while (cond) { __builtin_amdgcn_s_sleep(1); \
    if ((++_sp & 255u) == 0u) { if (xb_ld(&(bar)[XB_TMO])) break; if (_sp > XB_SPIN_CAP) { atomicAdd(&(bar)[XB_TMO], 1u); break; } } } } while (0)
struct XcdBarrier { unsigned* bar; unsigned x; volatile LAS unsigned* st; };
DI XcdBarrier xcd_barrier_post(const Params& p, unsigned* bar, volatile LAS unsigned* st) {
  XcdBarrier b; b.bar = bar; b.x = xb_xcc_id(); b.st = st;
  if (ltid() == 0) (void)xb_add(&bar[XB_XCNT(b.x)], 1u);
  return b;
}
DI void xcd_barrier_complete(unsigned* bar, unsigned x, unsigned& nloc, unsigned& nx) {
  const unsigned G = gridDim.x * gridDim.y * gridDim.z;
  unsigned sum, cnt, mine, sp = 0u;
  for (;;) {
    sum = 0u; cnt = 0u; mine = 0u;
#pragma unroll
    for (unsigned j = 0; j < 16; ++j) { const unsigned c = xb_ld(&bar[XB_XCNT(j)]); sum += c; cnt += (c > 0u) ? 1u : 0u; mine = (j == x) ? c : mine; }
    if (sum == G) break;
    __builtin_amdgcn_s_sleep(1);
    if ((++sp & 255u) == 0u) { if (xb_ld(&bar[XB_TMO])) break; if (sp > XB_SPIN_CAP) { atomicAdd(&bar[XB_TMO], 1u); break; } }
  }
  nloc = mine > 0u ? mine : 1u; nx = cnt > 0u ? cnt : 1u;
}
DI void xcd_barrier(const Params& p, const XcdBarrier& b) {
  asm volatile("s_waitcnt vmcnt(0)" ::: "memory");
  __syncthreads();
  if (ltid() == 0) {
    unsigned* bar = b.bar;
    __builtin_amdgcn_s_waitcnt(0);
    unsigned nloc = b.st[0], nx = b.st[1];
    if (nloc == 0u) { xcd_barrier_complete(bar, b.x, nloc, nx); b.st[0] = nloc; b.st[1] = nx; }
    const unsigned old = xb_add(&bar[XB_XSUB(b.x)], 1u);
    const unsigned gen = old / nloc;
    if (old + 1u == (gen + 1u) * nloc) {
      __builtin_amdgcn_fence(__ATOMIC_RELEASE, "agent");
      asm volatile("s_waitcnt vmcnt(0)" ::: "memory");
      const unsigned og = xb_add(&bar[XB_TOP], 1u);
      const unsigned tg = og / nx;
      if (og + 1u == (tg + 1u) * nx) xb_add(&bar[XB_TOPGEN], 1u);
      else XB_SPIN(xb_ld(&bar[XB_TOPGEN]) == tg, bar);
      __builtin_amdgcn_fence(__ATOMIC_ACQUIRE, "agent");
      xb_add(&bar[XB_XGEN(b.x)], 1u);
      asm volatile("s_waitcnt vmcnt(0)" ::: "memory");
    } else {
      XB_SPIN(xb_ld(&bar[XB_XGEN(b.x)]) == gen, bar);
      __builtin_amdgcn_fence(__ATOMIC_ACQUIRE, "agent");
      asm volatile("s_waitcnt vmcnt(0)" ::: "memory");
    }
  }
  __syncthreads();
}

constexpr int NPHASE = 3 + 9 * 2;
DI void run_phase(const Params& p0, int ph, char* smem) {
  Params p = p0;
  asm volatile("" : "+s"(p.ws), "+s"(p.out));
  p.ws = as_global(p.ws); p.out = as_global(p.out);
  if (ph == 0) { phase0(p, smem); return; }
  if (ph == 1) { phase1(p); return; }
  if (ph == 2) { tok_phase(p, 0, 0); return; }
  const int l = (ph - 3) / 9, s = (ph - 3) % 9;
  switch (s) {
    case 0: phase_inproj(p, smem); break;
    case 1: phase_scan(p, l, smem); break;
    case 2: phase_combine(p, l, smem); break;
    case 3: phase_merge(p, l, smem); break;
    case 4: phase_gemm_f32(p, (const bf16_t*)(p.ws + OFF_MERGED), 1024, (const bf16_t*)(p.ws + OFF_WTOUT), smem); break;
    case 5: tok_phase(p, l, 1); break;
    case 6: phase_ffn_in(p, smem); break;
    case 7: phase_gemm_f32(p, (const bf16_t*)(p.ws + OFF_ACT), DFF, (const bf16_t*)(p.ws + OFF_WTFO), smem); break;
    case 8:
      tok_phase(p, l, 2);
      if (l + 1 < 2) {
        conv_weight(p, p.in[I_WIN] + (size_t)(l + 1) * 1024 * DIN, DIN, (bf16_t*)(p.ws + OFF_WTIN), 1024, WTIN_ROWS, 0, (float*)smem, blockIdx.x, gridDim.x);
        for (int br = 0; br < 3; ++br) conv_weight(p, p.in[I_WBR] + ((size_t)(l + 1) * 3 + br) * 512 * 1024, 1024, (bf16_t*)(p.ws + OFF_WTBR) + (size_t)br * 1024 * 512, 512, 1024, 1, (float*)smem, blockIdx.x, gridDim.x);
      }
      break;
  }
}

template <bool COOP>
__global__ void __launch_bounds__(NTHR, 2) mega(Params pk, int lo, int hi) {
  __shared__ __attribute__((aligned(16))) char smem[LDS_BYTES];
  Params p = pk;
#pragma unroll
  for (int i = 0; i < N_IN; ++i) p.in[i] = as_global(p.in[i]);
  p.ws = as_global(p.ws); p.out = as_global(p.out);
  p.wb = __builtin_amdgcn_readfirstlane((int)threadIdx.x) & ~63;
  if (COOP) {
    volatile LAS unsigned* st = (volatile LAS unsigned*)(smem + LDS_BYTES - 32);
    if (ltid() == 0) { st[0] = 0u; st[1] = 0u; }
    __syncthreads();
    phase0(p, smem);
    cg::this_grid().sync();
    XcdBarrier b = xcd_barrier_post(p, (unsigned*)(p.ws + OFF_BAR), st);
    if (ltid() == 0) {
      const unsigned hwid = (unsigned)__builtin_amdgcn_s_getreg((31 << 11) | 4);
      const unsigned key = (xb_xcc_id() << 8) | ((hwid >> 8) & 0xFFu);
      ((int*)smem)[(LDS_BYTES - 12) / 4] = (int)xb_add((unsigned*)(p.ws + OFF_ROLE) + key, 1u);
    }
    __syncthreads();
    p.role = __builtin_amdgcn_readfirstlane(((int*)smem)[(LDS_BYTES - 12) / 4]);
    for (int ph = 1; ph < hi; ++ph) {
      run_phase(p, ph, smem);
      if (ph + 1 < hi) xcd_barrier(p, b);
    }
  } else {
    for (int ph = lo; ph < hi; ++ph) run_phase(p, ph, smem);
  }
}

extern "C" void kernel_launch(void* const* d_in, const int* in_sizes, int n_in, void* d_out, int out_size, void* d_ws, size_t ws_size, hipStream_t stream) {
  Params p{};
  for (int i = 0; i < N_IN; ++i) p.in[i] = (const float*)d_in[i];
  p.out = (float*)d_out; p.ws = (char*)d_ws;
  if (ws_size < WS_NEED) fprintf(stderr, "workspace too small: %zu < %zu\n", ws_size, (size_t)WS_NEED);
  static int grid_blocks = 0;
  if (!grid_blocks) {
    int dev = 0, cus = 0, per_cu = 0;
    hipGetDevice(&dev);
    hipDeviceGetAttribute(&cus, hipDeviceAttributeMultiprocessorCount, dev);
    hipOccupancyMaxActiveBlocksPerMultiprocessor(&per_cu, mega<true>, NTHR, 0);
    if (per_cu > 2) per_cu = 2;
    grid_blocks = cus * per_cu;
  }
  int lo = 0, hi = NPHASE;
  void* args[] = {&p, &lo, &hi};
  hipError_t e = hipLaunchCooperativeKernel((void*)mega<true>, dim3(grid_blocks), dim3(NTHR), args, 0, stream);
  if (e != hipSuccess) fprintf(stderr, "cooperative launch failed: %s (grid %d)\n", hipGetErrorString(e), grid_blocks);
}
```
